# Optimizing an MI355X kernel written in HIP

```python
import jax, jax.numpy as jnp
from jax import lax
import numpy as np

D_MODEL = 1024
BATCH = 16
SEQ = 4096
DEPTH = 1

N_MEM = 256
HEAD_DIM = 64
ATT_HEADS = 4
ATT_WIDTH = ATT_HEADS * HEAD_DIM
CONV_WIDTH = 384
CONV_KERNEL = 31
CONV_PAD = CONV_KERNEL // 2
RWKV_HEADS = 6
RWKV_WIDTH = RWKV_HEADS * HEAD_DIM
MIX_WIDTH = ATT_WIDTH + CONV_WIDTH + RWKV_WIDTH
DECAY_RANK = 64
ICLR_RANK = 64
GATE_RANK = 128
RWKV_PROJ = 3 * RWKV_WIDTH + 2 * DECAY_RANK + 2 * ICLR_RANK + GATE_RANK
IN_PROJ = ATT_WIDTH + 2 * CONV_WIDTH + RWKV_PROJ
N_EXPERTS = 16
EXPERT_FF = 1024
CAPACITY_FACTOR = 2
NORM_EPS = 1e-6
LN_EPS = 1e-5
GN_EPS = 64e-5
L2_EPS = 1e-12
DECAY_SCALE = 0.606531

kernel_name = "hybrid_conformer_rwkv7_memxattn_ec_moe"


def rms_norm(x, g):
    xf = x.astype(jnp.float32)
    y = xf * lax.rsqrt(jnp.mean(xf * xf, axis=-1, keepdims=True) + NORM_EPS)
    return (y * g.astype(jnp.float32)).astype(x.dtype)


def memory_cross_attention(q, mem_n, w_mk, w_mv):
    B, S, _ = q.shape
    qh = q.reshape(B, S, ATT_HEADS, HEAD_DIM)
    kh = (mem_n @ w_mk).reshape(B, -1, ATT_HEADS, HEAD_DIM)
    vh = (mem_n @ w_mv).reshape(B, -1, ATT_HEADS, HEAD_DIM)
    s = jnp.einsum('bqhd,bmhd->bhqm', qh, kh).astype(jnp.float32) * (HEAD_DIM ** -0.5)
    pr = jax.nn.softmax(s, axis=-1).astype(vh.dtype)
    o = jnp.einsum('bhqm,bmhd->bqhd', pr, vh)
    return o.reshape(B, S, ATT_WIDTH)


def conformer_conv(pc, conv_w, conv_b, ln_g, ln_b):
    val, gate = jnp.split(pc, 2, axis=-1)
    u = val * jax.nn.sigmoid(gate)
    u = lax.conv_general_dilated(
        u, conv_w[:, None, :].astype(u.dtype), window_strides=(1,),
        padding=[(CONV_PAD, CONV_PAD)], dimension_numbers=('NWC', 'WIO', 'NWC'),
        feature_group_count=CONV_WIDTH) + conv_b.astype(u.dtype)
    uf = u.astype(jnp.float32)
    mu = jnp.mean(uf, axis=-1, keepdims=True)
    var = jnp.mean(jnp.square(uf - mu), axis=-1, keepdims=True)
    uf = (uf - mu) * lax.rsqrt(var + LN_EPS) * ln_g.astype(jnp.float32) + ln_b.astype(jnp.float32)
    return jax.nn.silu(uf).astype(pc.dtype)


def token_shift_centred(p, mu):
    prev = jnp.pad(p, ((0, 0), (1, 0), (0, 0)))[:, :-1]
    nxt = jnp.pad(p, ((0, 0), (0, 1), (0, 0)))[:, 1:]
    return p + mu[0] * (prev - p) + mu[1] * (nxt - p)


def wkv7_scan(r, w, k, v, kk, a, reverse):
    def step(state, inp):
        r_t, w_t, k_t, v_t, kk_t, a_t = inp
        sa = jnp.einsum('bhij,bhj->bhi', state, -kk_t)
        state = (state * w_t[..., None, :]
                 + sa[..., :, None] * (kk_t * a_t)[..., None, :]
                 + v_t[..., :, None] * k_t[..., None, :])
        y_t = jnp.einsum('bhij,bhj->bhi', state, r_t)
        return state, y_t
    S, B, H, N = r.shape
    state0 = jnp.zeros((B, H, N, N), jnp.float32)
    _, ys = lax.scan(step, state0, (r, w, k, v, kk, a), reverse=reverse)
    return ys


def rwkv7_bidirectional(pr, shift_mu, decay_w0, decay_up, iclr_a0, iclr_up, gate_up,
                        k_k, k_a, r_k, lnx_g, lnx_b):
    f32 = jnp.float32
    B, S, _ = pr.shape
    pf = token_shift_centred(pr.astype(f32), shift_mu.astype(f32))
    c0 = 3 * RWKV_WIDTH
    cuts = [RWKV_WIDTH, 2 * RWKV_WIDTH, c0, c0 + DECAY_RANK, c0 + 2 * DECAY_RANK,
            c0 + 2 * DECAY_RANK + ICLR_RANK, c0 + 2 * DECAY_RANK + 2 * ICLR_RANK]
    r, k, v, wdf, wdb, adf, adb, gd = jnp.split(pf, cuts, axis=-1)

    def heads(t):
        return t.reshape(t.shape[:-1] + (RWKV_HEADS, HEAD_DIM))

    def tm(t):
        return jnp.moveaxis(t, 1, 0)

    g = jax.nn.sigmoid(gd) @ gate_up.astype(f32)
    kk = heads(k * k_k.astype(f32))
    kk = kk * lax.rsqrt(jnp.sum(kk * kk, axis=-1, keepdims=True) + L2_EPS)
    r_h, v_h = heads(r), heads(v)
    r_tm, v_tm, kk_tm = tm(r_h), tm(v_h), tm(kk)
    r_k32 = r_k.astype(f32)

    outs, bonuses = [], []
    for d, (wd, ad) in enumerate(((wdf, adf), (wdb, adb))):
        w = jnp.exp(-DECAY_SCALE * jax.nn.sigmoid(
            decay_w0[d].astype(f32) + jnp.tanh(wd) @ decay_up[d].astype(f32)))
        a = jax.nn.sigmoid(iclr_a0[d].astype(f32) + ad @ iclr_up[d].astype(f32))
        k_d = heads(k * (1.0 + (a - 1.0) * k_a.astype(f32)))
        ys = wkv7_scan(r_tm, tm(heads(w)), tm(k_d), v_tm, kk_tm, tm(heads(a)), reverse=(d == 1))
        outs.append(jnp.moveaxis(ys, 0, 1))
        bonuses.append(jnp.sum(r_h * k_d * r_k32, axis=-1, keepdims=True) * v_h)
    y = outs[0] + outs[1]
    mu = jnp.mean(y, axis=-1, keepdims=True)
    var = jnp.mean(jnp.square(y - mu), axis=-1, keepdims=True)
    y = ((y - mu) * lax.rsqrt(var + GN_EPS) * lnx_g.astype(f32).reshape(RWKV_HEADS, HEAD_DIM)
         + lnx_b.astype(f32).reshape(RWKV_HEADS, HEAD_DIM))
    y = (y + bonuses[0] + bonuses[1]).reshape(B, S, RWKV_WIDTH) * g
    return y.astype(pr.dtype)


def expert_choice_ffn(h, w_router, w_gate, w_up, w_down):
    B, S, D = h.shape
    cap = CAPACITY_FACTOR * S // N_EXPERTS
    aff = jax.nn.softmax((h @ w_router).astype(jnp.float32), axis=-1)
    gates, idx = lax.top_k(jnp.swapaxes(aff, 1, 2), cap)
    xe = jax.vmap(lambda hb, ib: hb[ib])(h, idx)
    hid = jax.nn.silu(jnp.einsum('becd,edf->becf', xe, w_gate)) * jnp.einsum('becd,edf->becf', xe, w_up)
    ye = jnp.einsum('becf,efd->becd', hid, w_down) * gates[..., None].astype(h.dtype)
    bidx = jnp.arange(B)[:, None, None]
    return jnp.zeros_like(h).at[bidx, idx].add(ye)


def setup_inputs(seed: int = 0) -> dict:
    key = jax.random.key(seed)
    ks = iter(jax.random.split(key, 40))
    L, D = DEPTH, D_MODEL

    def nrm(shape, scale):
        return scale * jax.random.normal(next(ks), shape, jnp.float32)

    return {
        "x": nrm((BATCH, SEQ, D), 1.0),
        "mem": nrm((BATCH, N_MEM, D), 1.0),
        "norm_mix_g": 1.0 + nrm((L, D), 0.05),
        "norm_mem_g": 1.0 + nrm((L, D), 0.05),
        "w_in": nrm((L, D, IN_PROJ), D ** -0.5),
        "w_mk": nrm((L, D, ATT_WIDTH), D ** -0.5),
        "w_mv": nrm((L, D, ATT_WIDTH), D ** -0.5),
        "conv_w": nrm((L, CONV_KERNEL, CONV_WIDTH), CONV_KERNEL ** -0.5),
        "conv_b": nrm((L, CONV_WIDTH), 0.01),
        "conv_ln_g": 1.0 + nrm((L, CONV_WIDTH), 0.05),
        "conv_ln_b": nrm((L, CONV_WIDTH), 0.01),
        "shift_mu": jax.random.uniform(next(ks), (L, 2, RWKV_PROJ), jnp.float32, 0.0, 0.5),
        "decay_w0": nrm((L, 2, RWKV_WIDTH), 0.5),
        "decay_up": nrm((L, 2, DECAY_RANK, RWKV_WIDTH), 0.1),
        "iclr_a0": nrm((L, 2, RWKV_WIDTH), 0.5),
        "iclr_up": nrm((L, 2, ICLR_RANK, RWKV_WIDTH), 0.1),
        "gate_up": nrm((L, GATE_RANK, RWKV_WIDTH), GATE_RANK ** -0.5),
        "k_k": 0.85 + nrm((L, RWKV_WIDTH), 0.05),
        "k_a": 1.0 + nrm((L, RWKV_WIDTH), 0.05),
        "r_k": nrm((L, RWKV_HEADS, HEAD_DIM), 0.1),
        "lnx_g": 1.0 + nrm((L, RWKV_WIDTH), 0.05),
        "lnx_b": nrm((L, RWKV_WIDTH), 0.01),
        "w_out": nrm((L, MIX_WIDTH, D), MIX_WIDTH ** -0.5),
        "norm_ffn_g": 1.0 + nrm((L, D), 0.05),
        "w_router": nrm((L, D, N_EXPERTS), D ** -0.5),
        "w_e_gate": nrm((L, N_EXPERTS, D, EXPERT_FF), D ** -0.5),
        "w_e_up": nrm((L, N_EXPERTS, D, EXPERT_FF), D ** -0.5),
        "w_e_down": nrm((L, N_EXPERTS, EXPERT_FF, D), EXPERT_FF ** -0.5),
        "final_norm_g": 1.0 + nrm((D,), 0.05),
    }


def reference(x, mem, norm_mix_g, norm_mem_g, w_in, w_mk, w_mv, conv_w, conv_b, conv_ln_g,
              conv_ln_b, shift_mu, decay_w0, decay_up, iclr_a0, iclr_up, gate_up, k_k, k_a,
              r_k, lnx_g, lnx_b, w_out, norm_ffn_g, w_router, w_e_gate, w_e_up, w_e_down,
              final_norm_g):
    for l in range(DEPTH):
        h = rms_norm(x, norm_mix_g[l])
        p = h @ w_in[l]
        q, pc, pr = jnp.split(p, [ATT_WIDTH, ATT_WIDTH + 2 * CONV_WIDTH], axis=-1)
        mem_n = rms_norm(mem, norm_mem_g[l])
        o_att = memory_cross_attention(q, mem_n, w_mk[l], w_mv[l])
        o_conv = conformer_conv(pc, conv_w[l], conv_b[l], conv_ln_g[l], conv_ln_b[l])
        o_rwkv = rwkv7_bidirectional(pr, shift_mu[l], decay_w0[l], decay_up[l], iclr_a0[l],
                                     iclr_up[l], gate_up[l], k_k[l], k_a[l], r_k[l],
                                     lnx_g[l], lnx_b[l])
        x = x + jnp.concatenate([o_att, o_conv, o_rwkv], axis=-1) @ w_out[l]
        x = x + expert_choice_ffn(rms_norm(x, norm_ffn_g[l]), w_router[l], w_e_gate[l],
                                  w_e_up[l], w_e_down[l])
    return rms_norm(x, final_norm_g)
```

```cpp
#include <hip/hip_runtime.h>
#include <hip/hip_cooperative_groups.h>
#include <cstdio>
#include <cstdint>
namespace cg = cooperative_groups;

#define LAS __attribute__((address_space(3)))
typedef unsigned short bf16_t;
typedef short bf16x8 __attribute__((ext_vector_type(8)));
typedef short s16x4 __attribute__((ext_vector_type(4)));
typedef float f32x2 __attribute__((ext_vector_type(2)));
typedef float f32x4 __attribute__((ext_vector_type(4)));
typedef float f32x16 __attribute__((ext_vector_type(16)));
typedef unsigned u32x2 __attribute__((ext_vector_type(2)));
typedef unsigned u32x4 __attribute__((ext_vector_type(4)));
typedef _Float16 f16x4 __attribute__((ext_vector_type(4)));
typedef __bf16 bf16v2 __attribute__((ext_vector_type(2)));

constexpr int D = 1024, BATCH = 16, SEQ = 4096, T = BATCH * SEQ, NMEM = 256;
constexpr int IN_PROJ = 2560, CW = 384, RW = 384, NH = 6, NE = 16, FF = 1024, CAP = 512;
constexpr int NSLOT = NE * BATCH * CAP;
constexpr int NTHREADS = 512;
constexpr int LDS_BYTES = 160 * 1024;
constexpr int NPHASE = 11;

constexpr size_t MiB = 1u << 20;
constexpr size_t WS_WINT = 1 * MiB;
constexpr size_t WS_WOUTT = 6 * MiB;
constexpr size_t WS_WKT = 8 * MiB;
constexpr size_t WS_WVT = 8 * MiB + 512 * 1024;
constexpr size_t WS_SMALL = 9 * MiB;
constexpr size_t WS_WGUT = 10 * MiB;
constexpr size_t WS_WDT = 74 * MiB;
constexpr size_t WS_KMEM = 106 * MiB;
constexpr size_t WS_VT = 108 * MiB;
constexpr size_t WS_ROWTOK = 106 * MiB;
constexpr size_t WS_ROWGATE = 106 * MiB + 512 * 1024;
constexpr size_t WS_SS = 107 * MiB;
constexpr size_t WS_P = 112 * MiB;
constexpr size_t WS_YF = 112 * MiB;
constexpr size_t WS_YB = 208 * MiB;
constexpr size_t WS_X1 = 112 * MiB;
constexpr size_t WS_XH = 432 * MiB;
constexpr size_t WS_G = 432 * MiB;
constexpr size_t WS_BON = 480 * MiB;
constexpr size_t WS_H2 = 432 * MiB;
constexpr size_t WS_MEMN = 560 * MiB;
constexpr size_t WS_MIX = 560 * MiB;
constexpr size_t WS_SCAN = 688 * MiB;
constexpr size_t SCAN_STRIDE = 48 * MiB;
constexpr size_t WS_AFF = 624 * MiB;
constexpr size_t WS_INV = 628 * MiB;
constexpr size_t WS_HID = 768 * MiB;
constexpr size_t WS_YE = 368 * MiB;
constexpr size_t WS_END = 1024 * MiB;

__device__ __forceinline__ unsigned pk_bf16(float lo, float hi) { f32x2 v = {lo, hi}; bf16v2 b = __builtin_convertvector(v, bf16v2); return __builtin_bit_cast(unsigned, b); }
__device__ __forceinline__ float bf_lo(unsigned u) { return __builtin_bit_cast(float, u << 16); }
__device__ __forceinline__ float bf_hi(unsigned u) { return __builtin_bit_cast(float, u & 0xffff0000u); }
__device__ __forceinline__ float wave_sum(float v) {
#pragma unroll
    for (int o = 1; o < 64; o <<= 1) v += __shfl_xor(v, o);
    return v;
}
__device__ __forceinline__ float sigmoidf_fast(float x) { return __builtin_amdgcn_rcpf(1.0f + __builtin_amdgcn_exp2f(-1.4426950408889634f * x)); }
template <int CTRL> __device__ __forceinline__ float dpp_f(float x) { return __builtin_bit_cast(float, __builtin_amdgcn_update_dpp(0, __builtin_bit_cast(int, x), CTRL, 0xF, 0xF, true)); }
__device__ __forceinline__ float sum8(float x) { x += dpp_f<0xB1>(x); x += dpp_f<0x4E>(x); x += dpp_f<0x141>(x); return x; }
__device__ __forceinline__ float sum16(float x) { x = sum8(x); x += dpp_f<0x140>(x); return x; }

namespace pg8 {
#define PG8_LAS __attribute__((address_space(3)))
constexpr int BM = 256, BK = 64, HALF = 128, HTB = HALF * BK * 2, STAGE_BYTES = 8 * HTB, NXCD = 8, WGM = 8;
__host__ __device__ __forceinline__ int lds_byte(int r, int c) { const int st = (r >> 4) * 2 + (c >> 5), rr = r & 15, cc = c & 31, ob = rr * 64 + cc * 2; return st * 1024 + (ob ^ (((ob >> 9) & 1) << 5)); }
__host__ __device__ __forceinline__ void stage_rc(int b, int& R, int& C) { const int st = b / 1024, sb = b % 1024, swz = sb ^ (((sb >> 9) & 1) << 5); R = (st >> 1) * 16 + swz / 64; C = (st & 1) * 32 + (swz % 64) / 2; }
__host__ __device__ __forceinline__ int perm32(int rho) { const int n = rho >> 4, i = rho & 15; return 8 * (i >> 2) + 4 * n + (i & 3); }

struct Unit { int pm, pn; };
struct Gemm { const bf16_t* A; const bf16_t* Bt; int M, N, K; };

struct StaticOrder {
    int nM, nN, nwg, G, c;
    __device__ void init(int M, int N, int G_, int c_) { nM = M / BM; nN = N / BM; nwg = nM * nN; G = G_; c = c_; }
    __device__ bool next(int i, Unit& u) const {
        const long L = (long)i * G + c; if (L >= nwg) return false;
        int wgid = (int)L; { const int q = nwg / NXCD, r = nwg % NXCD, xcd = wgid % NXCD, off = wgid / NXCD; wgid = (xcd < r ? xcd * (q + 1) : r * (q + 1) + (xcd - r) * q) + off; }
        const int nig = WGM * nN, gid = wgid / nig, fm = gid * WGM, gsz = (nM - fm) < WGM ? (nM - fm) : WGM;
        u.pm = fm + ((wgid % nig) % gsz); u.pn = (wgid % nig) / gsz; return true;
    }
};
struct ExpertOrder {
    int nMe, nNe, per, total, G, c;
    __device__ void init(int nMe_, int nNe_, int nExp, int G_, int c_) { nMe = nMe_; nNe = nNe_; per = nMe * nNe; total = per * nExp; G = G_; c = c_; }
    __device__ bool next(int i, Unit& u) const {
        const long L = (long)i * G + c; if (L >= total) return false;
        const int e = (int)(L / per), w = (int)(L % per), xl = w % 8, j = w / 8, rpx = nMe / 8;
        u.pm = e * nMe + xl * rpx + (j % rpx); u.pn = e * nNe + j / rpx; return true;
    }
};

struct EpiBf16 {
    static constexpr bool PERM = true;
    bf16_t* O; int ldc;
    __device__ __forceinline__ void operator()(const f32x4 (&acc)[2][2][4][2], const Unit& u, int wr, int wc, int fr, int fq) const {
        const int row0 = u.pm * BM + wr * 64 + fr, col0 = u.pn * BM + wc * 32 + 8 * fq;
#pragma unroll
        for (int ai = 0; ai < 2; ++ai)
#pragma unroll
            for (int m = 0; m < 4; ++m) { bf16_t* rowp = O + (size_t)(row0 + ai * HALF + m * 16) * ldc + col0;
#pragma unroll
                for (int bj = 0; bj < 2; ++bj) { const f32x4 v0 = acc[ai][bj][m][0], v1 = acc[ai][bj][m][1];
                    u32x4 w; w.x = pk_bf16(v0[0], v0[1]); w.y = pk_bf16(v0[2], v0[3]); w.z = pk_bf16(v1[0], v1[1]); w.w = pk_bf16(v1[2], v1[3]);
                    *(u32x4*)(rowp + bj * HALF) = w; } }
    }
};
struct EpiResidSS {
    static constexpr bool PERM = false;
    const float* X; float* X1; float* ss;
    __device__ __forceinline__ void operator()(const f32x4 (&acc)[2][2][4][2], const Unit& u, int wr, int wc, int fr, int fq) const {
        const int row0 = u.pm * BM + wr * 64 + fr, col0 = u.pn * BM + wc * 32 + 4 * fq;
#pragma unroll
        for (int ai = 0; ai < 2; ++ai)
#pragma unroll
            for (int m = 0; m < 4; ++m) { const int row = row0 + ai * HALF + m * 16; const size_t off = (size_t)row * D + col0; float s = 0.f;
#pragma unroll
                for (int bj = 0; bj < 2; ++bj)
#pragma unroll
                    for (int n = 0; n < 2; ++n) { const f32x4 xv = *(const f32x4*)(X + off + bj * HALF + n * 16); const f32x4 o = xv + acc[ai][bj][m][n];
                        *(f32x4*)(X1 + off + bj * HALF + n * 16) = o; s += (o[0] * o[0] + o[1] * o[1]) + (o[2] * o[2] + o[3] * o[3]); }
                s += __shfl_xor(s, 16); s += __shfl_xor(s, 32);
                if (fq == 0) (void)__hip_atomic_fetch_add(ss + row, s, __ATOMIC_RELAXED, __HIP_MEMORY_SCOPE_AGENT); }
    }
};
struct EpiSwiGLU {
    static constexpr bool PERM = true;
    bf16_t* H;
    __device__ __forceinline__ void operator()(const f32x4 (&acc)[2][2][4][2], const Unit& u, int wr, int wc, int fr, int fq) const {
        const int row0 = u.pm * BM + wr * 64 + fr, col0 = (u.pn & 7) * HALF + wc * 32 + 8 * fq;
#pragma unroll
        for (int ai = 0; ai < 2; ++ai)
#pragma unroll
            for (int m = 0; m < 4; ++m) { bf16_t* rowp = H + (size_t)(row0 + ai * HALF + m * 16) * FF + col0; float h[8];
#pragma unroll
                for (int n = 0; n < 2; ++n)
#pragma unroll
                    for (int j = 0; j < 4; ++j) { const float gt = acc[ai][0][m][n][j], up = acc[ai][1][m][n][j]; h[n * 4 + j] = gt * sigmoidf_fast(gt) * up; }
                u32x4 w; w.x = pk_bf16(h[0], h[1]); w.y = pk_bf16(h[2], h[3]); w.z = pk_bf16(h[4], h[5]); w.w = pk_bf16(h[6], h[7]);
                *(u32x4*)rowp = w; }
    }
};
struct EpiGateScale {
    static constexpr bool PERM = true;
    bf16_t* Y; const float* gate;
    __device__ __forceinline__ void operator()(const f32x4 (&acc)[2][2][4][2], const Unit& u, int wr, int wc, int fr, int fq) const {
        const int row0 = u.pm * BM + wr * 64 + fr, col0 = (u.pn & 3) * BM + wc * 32 + 8 * fq;
#pragma unroll
        for (int ai = 0; ai < 2; ++ai)
#pragma unroll
            for (int m = 0; m < 4; ++m) { const int row = row0 + ai * HALF + m * 16; const float gs = gate[row]; bf16_t* rowp = Y + (size_t)row * D + col0;
#pragma unroll
                for (int bj = 0; bj < 2; ++bj) { const f32x4 v0 = acc[ai][bj][m][0] * gs, v1 = acc[ai][bj][m][1] * gs;
                    u32x4 w; w.x = pk_bf16(v0[0], v0[1]); w.y = pk_bf16(v0[2], v0[3]); w.z = pk_bf16(v1[0], v1[1]); w.w = pk_bf16(v1[2], v1[3]);
                    *(u32x4*)(rowp + bj * HALF) = w; } }
    }
};

template <class Epi, class Sched, bool GATHER>
__device__ __forceinline__ void gemm_phase(PG8_LAS unsigned char* lds, const Gemm g, const Sched& S, const Epi& E, const int* rowtok) {
    const int tid = threadIdx.x, wid = __builtin_amdgcn_readfirstlane(tid >> 6), lane = tid & 63, wr = wid >> 2, wc = wid & 3, fr = lane & 15, fq = lane >> 4;
    const int K = g.K, nt = K / BK;
    unsigned voffA[2], voffB[2]; int Rr[2], Cc[2];
#pragma unroll
    for (int i = 0; i < 2; ++i) { int R, C; stage_rc(tid * 16 + i * 8192, R, C); const int Rb = Epi::PERM ? ((R & ~31) + perm32(R & 31)) : R; Rr[i] = R; Cc[i] = C;
        voffA[i] = (unsigned)(R * K + C) * 2u; voffB[i] = (unsigned)(Rb * K + C) * 2u; }
    unsigned vAc[2][2], vAn[2][2];
    const size_t kstep = (size_t)(BK * 2);
    const size_t hstep = (size_t)HALF * K * 2;
    const size_t tstep = 2 * hstep;
    const unsigned ldsw = (unsigned)wid * 1024u;
    const int aoff = lds_byte(wr * 64 + fr, fq * 8), boff = lds_byte(wc * 32 + fr, fq * 8);
#define PG8_SA(b, h) (((b) * 2 + (h)) * HTB)
#define PG8_SB(b, h) ((4 + (b) * 2 + (h)) * HTB)
#define PG8_STAGE(bufoff, gbase, voff) do { _Pragma("unroll") for (int _i = 0; _i < 2; ++_i) \
        __builtin_amdgcn_global_load_lds((const unsigned*)((const char*)(gbase) + (voff)[_i]), (PG8_LAS unsigned*)(lds + (bufoff) + ldsw + _i * 8192), 16, 0, 0); } while (0)
#define PG8_STAGE_A(bufoff, hh, dbase, kbytes, vsel) do { if constexpr (GATHER) { PG8_STAGE(bufoff, (const char*)g.A + (kbytes), (vsel)[hh]); } else { PG8_STAGE(bufoff, (dbase) + ((hh) ? hstep : 0), voffA); } } while (0)
#define PG8_GATHER_OFF(dst, un) do { _Pragma("unroll") for (int _h = 0; _h < 2; ++_h) _Pragma("unroll") for (int _i = 0; _i < 2; ++_i) \
        (dst)[_h][_i] = (unsigned)rowtok[(un).pm * BM + _h * HALF + Rr[_i]] * (unsigned)(K * 2) + (unsigned)(Cc[_i] * 2); } while (0)
#define PG8_LDA(dst, b, h) do { _Pragma("unroll") for (int m = 0; m < 4; ++m) _Pragma("unroll") for (int k = 0; k < 2; ++k) dst[m][k] = *(const PG8_LAS bf16x8*)(lds + PG8_SA(b, h) + aoff + m * 2048 + k * 1024); } while (0)
#define PG8_LDB(dst, b, h) do { _Pragma("unroll") for (int n = 0; n < 2; ++n) _Pragma("unroll") for (int k = 0; k < 2; ++k) dst[n][k] = *(const PG8_LAS bf16x8*)(lds + PG8_SB(b, h) + boff + n * 2048 + k * 1024); } while (0)
#define PG8_MMA(ai, bj, At, Bt) do { __builtin_amdgcn_s_setprio(1); _Pragma("unroll") for (int m = 0; m < 4; ++m) _Pragma("unroll") for (int n = 0; n < 2; ++n) _Pragma("unroll") for (int k = 0; k < 2; ++k) \
        acc[ai][bj][m][n] = __builtin_amdgcn_mfma_f32_16x16x32_bf16(Bt[n][k], At[m][k], acc[ai][bj][m][n], 0, 0, 0); __builtin_amdgcn_s_setprio(0); } while (0)
#define PG8_WAIT_V(n) asm volatile("s_waitcnt vmcnt(" #n ")" ::: "memory")
#define PG8_WAIT_L(n) asm volatile("s_waitcnt lgkmcnt(" #n ")" ::: "memory")
#define PG8_BAR __builtin_amdgcn_s_barrier()
#define PG8_SCHED __builtin_amdgcn_sched_barrier(0)
    Unit cur, nxt; int ui = 0;
    if (!S.next(0, cur)) return;
    f32x4 acc[2][2][4][2];
#pragma unroll
    for (int a = 0; a < 2; ++a)
#pragma unroll
        for (int b = 0; b < 2; ++b)
#pragma unroll
            for (int m = 0; m < 4; ++m)
#pragma unroll
                for (int n = 0; n < 2; ++n) acc[a][b][m][n] = (f32x4){0.f, 0.f, 0.f, 0.f};
    bf16x8 At[4][2], B0[2][2], B1[2][2];
    const char* cA = (const char*)g.A + (GATHER ? (size_t)0 : (size_t)cur.pm * tstep); const char* cB = (const char*)g.Bt + (size_t)cur.pn * tstep;
    if constexpr (GATHER) { PG8_GATHER_OFF(vAc, cur); }
    PG8_STAGE(PG8_SB(0, 0), cB, voffB); PG8_STAGE_A(PG8_SA(0, 0), 0, cA, 0, vAc); PG8_STAGE(PG8_SB(0, 1), cB + hstep, voffB); PG8_STAGE_A(PG8_SA(0, 1), 1, cA, 0, vAc);
    if (wr == 1) PG8_BAR;
    PG8_WAIT_V(4); PG8_BAR;
    PG8_STAGE(PG8_SB(1, 0), cB + kstep, voffB); PG8_STAGE_A(PG8_SA(1, 0), 0, cA + kstep, kstep, vAc); PG8_STAGE(PG8_SB(1, 1), cB + hstep + kstep, voffB);
    PG8_WAIT_V(6); PG8_BAR;
    for (;;) {
        const bool has_next = S.next(ui + 1, nxt);
        const char* nA = (has_next && !GATHER) ? (const char*)g.A + (size_t)nxt.pm * tstep : cA; const char* nB = has_next ? (const char*)g.Bt + (size_t)nxt.pn * tstep : cB;
        if constexpr (GATHER) { if (has_next) { PG8_GATHER_OFF(vAn, nxt); } else {
#pragma unroll
            for (int _h = 0; _h < 2; ++_h)
#pragma unroll
                for (int _i = 0; _i < 2; ++_i) vAn[_h][_i] = vAc[_h][_i]; } }
        for (int t = 0; t < nt; t += 2) {
            const bool last = (t == nt - 2);
            const size_t k1 = (size_t)(t + 1) * kstep, k2 = last ? 0 : (size_t)(t + 2) * kstep, k3 = k2 + kstep;
            const char* a1 = cA + k1;
            const char* a2 = last ? nA : cA + (size_t)(t + 2) * kstep; const char* b2 = last ? nB : cB + (size_t)(t + 2) * kstep;
            const char* a3 = a2 + kstep; const char* b3 = b2 + kstep;
            unsigned vs[2][2];
#pragma unroll
            for (int _h = 0; _h < 2; ++_h)
#pragma unroll
                for (int _i = 0; _i < 2; ++_i) vs[_h][_i] = last ? vAn[_h][_i] : vAc[_h][_i];
            PG8_LDB(B0, 0, 0); PG8_SCHED; PG8_LDA(At, 0, 0); PG8_STAGE_A(PG8_SA(1, 1), 1, a1, k1, vAc);
            PG8_WAIT_L(8); PG8_BAR; PG8_WAIT_L(0); PG8_MMA(0, 0, At, B0); PG8_BAR; PG8_SCHED;
            PG8_LDB(B1, 0, 1); PG8_STAGE(PG8_SB(0, 0), b2, voffB);
            PG8_BAR; PG8_WAIT_L(0); PG8_MMA(0, 1, At, B1); PG8_BAR;
            PG8_LDA(At, 0, 1); PG8_STAGE_A(PG8_SA(0, 0), 0, a2, k2, vs);
            PG8_BAR; PG8_WAIT_L(0); PG8_MMA(1, 0, At, B0); PG8_BAR; PG8_SCHED;
            PG8_STAGE(PG8_SB(0, 1), b2 + hstep, voffB);
            PG8_WAIT_V(6); PG8_BAR; PG8_MMA(1, 1, At, B1); PG8_BAR;
            PG8_LDB(B0, 1, 0); PG8_SCHED; PG8_LDA(At, 1, 0); PG8_STAGE_A(PG8_SA(0, 1), 1, a2, k2, vs);
            PG8_WAIT_L(8); PG8_BAR; PG8_WAIT_L(0); PG8_MMA(0, 0, At, B0); PG8_BAR; PG8_SCHED;
            PG8_LDB(B1, 1, 1); PG8_STAGE(PG8_SB(1, 0), b3, voffB);
            PG8_BAR; PG8_WAIT_L(0); PG8_MMA(0, 1, At, B1); PG8_BAR;
            PG8_LDA(At, 1, 1); PG8_STAGE_A(PG8_SA(1, 0), 0, a3, k3, vs);
            PG8_BAR; PG8_WAIT_L(0); PG8_MMA(1, 0, At, B0); PG8_BAR; PG8_SCHED;
            PG8_STAGE(PG8_SB(1, 1), b3 + hstep, voffB);
            PG8_WAIT_V(6); PG8_BAR; PG8_MMA(1, 1, At, B1); PG8_BAR;
        }
        E(acc, cur, wr, wc, fr, fq);
        if (!has_next) break;
#pragma unroll
        for (int a = 0; a < 2; ++a)
#pragma unroll
            for (int b = 0; b < 2; ++b)
#pragma unroll
                for (int m = 0; m < 4; ++m)
#pragma unroll
                    for (int n = 0; n < 2; ++n) acc[a][b][m][n] = (f32x4){0.f, 0.f, 0.f, 0.f};
        cur = nxt; cA = nA; cB = nB; ++ui;
        if constexpr (GATHER) {
#pragma unroll
            for (int _h = 0; _h < 2; ++_h)
#pragma unroll
                for (int _i = 0; _i < 2; ++_i) vAc[_h][_i] = vAn[_h][_i]; }
    }
    PG8_WAIT_V(0);
    if (wr == 0) PG8_BAR;
    PG8_BAR;
#undef PG8_SA
#undef PG8_SB
#undef PG8_STAGE
#undef PG8_STAGE_A
#undef PG8_GATHER_OFF
#undef PG8_LDA
#undef PG8_LDB
#undef PG8_MMA
#undef PG8_WAIT_V
#undef PG8_WAIT_L
#undef PG8_BAR
#undef PG8_SCHED
}
}

struct Args {
    const float* in[29];
    float* out; unsigned char* ws;
    int ph_lo, ph_hi;
};
enum { I_X = 0, I_MEM, I_NMIXG, I_NMEMG, I_WIN, I_WMK, I_WMV, I_CONVW, I_CONVB, I_CLNG, I_CLNB, I_SHIFTMU, I_DW0, I_DUP, I_IA0, I_IUP, I_GUP, I_KK, I_KA, I_RK,
       I_LNXG, I_LNXB, I_WOUT, I_NFFNG, I_WROUTER, I_WEG, I_WEU, I_WED, I_FNG };

__device__ __forceinline__ void transpose_item(const float* W, int N, bf16_t* WT, int K, int k0, int n0, int drow0, LAS float* scr, int lane) {
#pragma unroll 8
    for (int i = 0; i < 32; ++i) { const int kk = 2 * i + (lane >> 5); scr[kk * 33 + (lane & 31)] = W[(size_t)(k0 + kk) * N + n0 + (lane & 31)]; }
    asm volatile("s_waitcnt lgkmcnt(0)" ::: "memory");
    const int c = lane & 7;
#pragma unroll
    for (int j = 0; j < 4; ++j) { const int n = (lane >> 3) + 8 * j; const LAS float* s = scr + (8 * c) * 33 + n;
        u32x4 o; o.x = pk_bf16(s[0 * 33], s[1 * 33]); o.y = pk_bf16(s[2 * 33], s[3 * 33]); o.z = pk_bf16(s[4 * 33], s[5 * 33]); o.w = pk_bf16(s[6 * 33], s[7 * 33]);
        *(u32x4*)(WT + (size_t)(drow0 + n) * K + k0 + 8 * c) = o; }
    asm volatile("s_waitcnt lgkmcnt(0)" ::: "memory");
}
__device__ __forceinline__ void rms_row_to_bf16(const float* xrow, const float* g, bf16_t* orow, int lane) {
    const f32x4* xr = (const f32x4*)xrow + lane; const f32x4* gr = (const f32x4*)g + lane;
    f32x4 v[4]; float s = 0.f;
#pragma unroll
    for (int j = 0; j < 4; ++j) { v[j] = xr[64 * j]; s += (v[j].x * v[j].x + v[j].y * v[j].y) + (v[j].z * v[j].z + v[j].w * v[j].w); }
    const float rs = 1.0f / sqrtf(wave_sum(s) * (1.f / D) + 1e-6f);
    u32x2* o8 = (u32x2*)orow + lane;
#pragma unroll
    for (int j = 0; j < 4; ++j) { const f32x4 gg = gr[64 * j]; u32x2 w; w.x = pk_bf16(v[j].x * rs * gg.x, v[j].y * rs * gg.y); w.y = pk_bf16(v[j].z * rs * gg.z, v[j].w * rs * gg.w); o8[64 * j] = w; }
}
__device__ __forceinline__ void phase_prep(const Args& a, LAS unsigned char* lds, int G) {
    const int tid = threadIdx.x, lane = tid & 63, wave = __builtin_amdgcn_readfirstlane(tid >> 6);
    LAS float* scr = (LAS float*)(lds + wave * 16384);
    const int gw = blockIdx.x * 8 + wave, NGW = G * 8;
    unsigned char* ws = a.ws;
    constexpr int S_WIN = 16 * 80, S_WOUT = 16 * 32, S_MK = 16 * 8, S_SM = 12, S_GUP = 24, S_EXP = 16 * 16 * 32;
    constexpr int NITEMS = S_WIN + S_WOUT + 2 * S_MK + 4 * S_SM + S_GUP + 3 * S_EXP;
    for (int it = gw; it < NITEMS; it += NGW) {
        int r = it;
        if (r < S_WIN) { const int kb = r / 80, nb = r % 80; transpose_item(a.in[I_WIN], IN_PROJ, (bf16_t*)(ws + WS_WINT), D, kb * 64, nb * 32, nb * 32, scr, lane); continue; } r -= S_WIN;
        if (r < S_WOUT) { const int kb = r / 32, nb = r % 32; transpose_item(a.in[I_WOUT], D, (bf16_t*)(ws + WS_WOUTT), D, kb * 64, nb * 32, nb * 32, scr, lane); continue; } r -= S_WOUT;
        if (r < S_MK) { const int kb = r / 8, nb = r % 8; transpose_item(a.in[I_WMK], 256, (bf16_t*)(ws + WS_WKT), D, kb * 64, nb * 32, nb * 32, scr, lane); continue; } r -= S_MK;
        if (r < S_MK) { const int kb = r / 8, nb = r % 8; transpose_item(a.in[I_WMV], 256, (bf16_t*)(ws + WS_WVT), D, kb * 64, nb * 32, nb * 32, scr, lane); continue; } r -= S_MK;
        if (r < 4 * S_SM) { const int which = r / S_SM, nb = r % S_SM;
            const float* src = (which < 2 ? a.in[I_DUP] : a.in[I_IUP]) + (size_t)(which & 1) * 64 * RW;
            transpose_item(src, RW, (bf16_t*)(ws + WS_SMALL) + (size_t)which * RW * 64, 64, 0, nb * 32, nb * 32, scr, lane); continue; } r -= 4 * S_SM;
        if (r < S_GUP) { const int kb = r / 12, nb = r % 12; transpose_item(a.in[I_GUP], RW, (bf16_t*)(ws + WS_SMALL) + (size_t)4 * RW * 64, 128, kb * 64, nb * 32, nb * 32, scr, lane); continue; } r -= S_GUP;
        { const int which = r / S_EXP, q = r % S_EXP, e = q / 512, kb = (q % 512) / 32, nb = q % 32, n0 = nb * 32;
          if (which == 0) transpose_item(a.in[I_WEG] + (size_t)e * D * FF, FF, (bf16_t*)(ws + WS_WGUT) + (size_t)e * 2048 * D, D, kb * 64, n0, (n0 >> 7) * 256 + (n0 & 127), scr, lane);
          else if (which == 1) transpose_item(a.in[I_WEU] + (size_t)e * D * FF, FF, (bf16_t*)(ws + WS_WGUT) + (size_t)e * 2048 * D, D, kb * 64, n0, (n0 >> 7) * 256 + 128 + (n0 & 127), scr, lane);
          else transpose_item(a.in[I_WED] + (size_t)e * FF * D, D, (bf16_t*)(ws + WS_WDT) + (size_t)e * D * FF, FF, kb * 64, n0, n0, scr, lane); }
    }
    for (int m = gw; m < T; m += NGW) rms_row_to_bf16(a.in[I_X] + (size_t)m * D, a.in[I_NMIXG], (bf16_t*)(ws + WS_XH) + (size_t)m * D, lane);
    for (int m = gw; m < BATCH * NMEM; m += NGW) rms_row_to_bf16(a.in[I_MEM] + (size_t)m * D, a.in[I_NMEMG], (bf16_t*)(ws + WS_MEMN) + (size_t)m * D, lane);
}

constexpr int AT_KS = 144;
constexpr int AT_VS = 520;
constexpr int AT_VOFF = 256 * AT_KS;
__device__ __forceinline__ bf16x8 pack_step(const f32x16& x, int s) {
    u32x4 p;
    asm volatile("v_cvt_pk_bf16_f32 %0, %4, %5\n\tv_cvt_pk_bf16_f32 %1, %6, %7\n\tv_cvt_pk_bf16_f32 %2, %8, %9\n\tv_cvt_pk_bf16_f32 %3, %10, %11\n\ts_nop 1"
                 : "=&v"(p[0]), "=&v"(p[1]), "=&v"(p[2]), "=&v"(p[3])
                 : "v"(x[8 * s]), "v"(x[8 * s + 1]), "v"(x[8 * s + 2]), "v"(x[8 * s + 3]), "v"(x[8 * s + 4]), "v"(x[8 * s + 5]), "v"(x[8 * s + 6]), "v"(x[8 * s + 7]));
    return __builtin_bit_cast(bf16x8, p);
}
__device__ __forceinline__ void attn_unit(const Args& a, LAS unsigned char* lds, int unit) {
    const int tid = threadIdx.x, lane = tid & 63, wave = __builtin_amdgcn_readfirstlane(tid >> 6), r = lane & 31, h = lane >> 5;
    const int b = unit >> 6, hh = (unit >> 4) & 3, tile = unit & 15;
    const bf16_t* P = (const bf16_t*)(a.ws + WS_P); const bf16_t* KM = (const bf16_t*)(a.ws + WS_KMEM); const bf16_t* VT = (const bf16_t*)(a.ws + WS_VT);
    bf16_t* MIX = (bf16_t*)(a.ws + WS_MIX);
    __syncthreads();
#pragma unroll
    for (int i = 0; i < 4; ++i) { const int c = tid + 512 * i, key = c >> 3, ch = c & 7;
        const u32x4 v = *(const u32x4*)(KM + (size_t)(b * NMEM + key) * 256 + hh * 64 + ch * 8);
        *(LAS u32x4*)(lds + key * AT_KS + ch * 16) = v; }
#pragma unroll
    for (int i = 0; i < 4; ++i) { const int c = tid + 512 * i, d = c >> 5, ch = c & 31;
        const u32x4 v = *(const u32x4*)(VT + (size_t)(hh * 64 + d) * (BATCH * NMEM) + b * NMEM + ch * 8);
        LAS u32x2* dst = (LAS u32x2*)(lds + AT_VOFF + d * AT_VS + ch * 16);
        dst[0] = (u32x2){v.x, v.y}; dst[1] = (u32x2){v.z, v.w}; }
    const int tok0 = b * SEQ + tile * 256 + wave * 32;
    bf16x8 qf[4];
#pragma unroll
    for (int ks = 0; ks < 4; ++ks) qf[ks] = *(const bf16x8*)(P + (size_t)(tok0 + r) * IN_PROJ + hh * 64 + ks * 16 + h * 8);
    __syncthreads();
    f32x16 s[8];
#pragma unroll
    for (int kt = 0; kt < 8; ++kt) {
#pragma unroll
        for (int i = 0; i < 16; ++i) s[kt][i] = 0.f;
#pragma unroll
        for (int ks = 0; ks < 4; ++ks) { const bf16x8 ka = *(const LAS bf16x8*)(lds + (kt * 32 + r) * AT_KS + (ks * 16 + h * 8) * 2);
            s[kt] = __builtin_amdgcn_mfma_f32_32x32x16_bf16(ka, qf[ks], s[kt], 0, 0, 0); }
    }
    float mx = -3.0e38f;
#pragma unroll
    for (int kt = 0; kt < 8; ++kt)
#pragma unroll
        for (int i = 0; i < 16; ++i) mx = fmaxf(mx, s[kt][i]);
    mx = fmaxf(mx, __shfl_xor(mx, 32));
    const float sc = 0.125f * 1.4426950408889634f; float sum = 0.f;
#pragma unroll
    for (int kt = 0; kt < 8; ++kt)
#pragma unroll
        for (int i = 0; i < 16; ++i) { const float e = __builtin_amdgcn_exp2f((s[kt][i] - mx) * sc); s[kt][i] = e; sum += e; }
    sum += __shfl_xor(sum, 32);
    f32x16 o[2];
#pragma unroll
    for (int dt = 0; dt < 2; ++dt)
#pragma unroll
        for (int i = 0; i < 16; ++i) o[dt][i] = 0.f;
#pragma unroll
    for (int kt = 0; kt < 8; ++kt)
#pragma unroll
        for (int s2 = 0; s2 < 2; ++s2) {
            const bf16x8 pb = pack_step(s[kt], s2);
#pragma unroll
            for (int dt = 0; dt < 2; ++dt) {
                const LAS unsigned char* vp = lds + AT_VOFF + (32 * dt + r) * AT_VS + (32 * kt + 16 * s2 + 4 * h) * 2;
                const s16x4 lo = *(const LAS s16x4*)vp, hi = *(const LAS s16x4*)(vp + 16);
                const bf16x8 va = __builtin_shufflevector(lo, hi, 0, 1, 2, 3, 4, 5, 6, 7);
                o[dt] = __builtin_amdgcn_mfma_f32_32x32x16_bf16(va, pb, o[dt], 0, 0, 0);
            }
        }
    const float inv = 1.0f / sum;
    bf16_t* orow = MIX + (size_t)(tok0 + r) * D + hh * 64;
#pragma unroll
    for (int dt = 0; dt < 2; ++dt)
#pragma unroll
        for (int gq = 0; gq < 4; ++gq) { u32x2 w; w.x = pk_bf16(o[dt][4 * gq] * inv, o[dt][4 * gq + 1] * inv); w.y = pk_bf16(o[dt][4 * gq + 2] * inv, o[dt][4 * gq + 3] * inv);
            *(u32x2*)(orow + 32 * dt + 8 * gq + 4 * h) = w; }
}

__device__ __forceinline__ void conv_unit(const Args& a, LAS unsigned char* lds, int unit) {
    const int tid = threadIdx.x, lane = tid & 63, wave = __builtin_amdgcn_readfirstlane(tid >> 6);
    const int b = unit >> 6, t0 = (unit & 63) * 64;
    const bf16_t* P = (const bf16_t*)(a.ws + WS_P); bf16_t* MIX = (bf16_t*)(a.ws + WS_MIX);
    LAS _Float16* U = (LAS _Float16*)lds;
    LAS _Float16* Cc = (LAS _Float16*)(lds + 94 * CW * 2);
    __syncthreads();
    for (int q = tid; q < 94 * 48; q += NTHREADS) { const int j = q / 48, cc = (q % 48) * 8, s = t0 - 15 + j;
        float u[8];
        if (s >= 0 && s < SEQ) { const bf16_t* row = P + (size_t)(b * SEQ + s) * IN_PROJ + 256 + cc;
            const u32x4 vv = *(const u32x4*)row, gg = *(const u32x4*)(row + CW);
            const unsigned vw[4] = {vv.x, vv.y, vv.z, vv.w}, gw[4] = {gg.x, gg.y, gg.z, gg.w};
#pragma unroll
            for (int k = 0; k < 4; ++k) { u[2 * k] = bf_lo(vw[k]) * sigmoidf_fast(bf_lo(gw[k])); u[2 * k + 1] = bf_hi(vw[k]) * sigmoidf_fast(bf_hi(gw[k])); }
        } else {
#pragma unroll
            for (int k = 0; k < 8; ++k) u[k] = 0.f; }
        LAS f16x4* dst = (LAS f16x4*)(U + j * CW + cc); dst[0] = (f16x4){(_Float16)u[0], (_Float16)u[1], (_Float16)u[2], (_Float16)u[3]}; dst[1] = (f16x4){(_Float16)u[4], (_Float16)u[5], (_Float16)u[6], (_Float16)u[7]}; }
    __syncthreads();
    const int cq = tid & 127, tq = tid >> 7;
#pragma unroll 1
    for (int k3 = 0; k3 < 3; ++k3) { const int c = cq + 128 * k3;
        float w[31], res[16];
#pragma unroll
        for (int kk = 0; kk < 31; ++kk) w[kk] = a.in[I_CONVW][kk * CW + c];
        const float bias = a.in[I_CONVB][c];
#pragma unroll
        for (int tt = 0; tt < 16; ++tt) res[tt] = bias;
#pragma unroll
        for (int jj = 0; jj < 46; ++jj) { const float uv = (float)U[(tq * 16 + jj) * CW + c];
#pragma unroll
            for (int tt = 0; tt < 16; ++tt) { if (jj - tt >= 0 && jj - tt <= 30) res[tt] += uv * w[jj - tt]; } }
#pragma unroll
        for (int tt = 0; tt < 16; ++tt) Cc[(tq * 16 + tt) * CW + c] = (_Float16)res[tt];
    }
    __syncthreads();
    for (int tt = 0; tt < 8; ++tt) { const int t = wave * 8 + tt;
        float v[6]; float s = 0.f;
#pragma unroll
        for (int i = 0; i < 6; ++i) { v[i] = (float)Cc[t * CW + lane + 64 * i]; s += v[i]; }
        const float mean = wave_sum(s) * (1.f / CW); float q = 0.f;
#pragma unroll
        for (int i = 0; i < 6; ++i) { v[i] -= mean; q += v[i] * v[i]; }
        const float rstd = 1.0f / sqrtf(wave_sum(q) * (1.f / CW) + 1e-5f);
        bf16_t* orow = MIX + (size_t)(b * SEQ + t0 + t) * D + 256;
#pragma unroll
        for (int i = 0; i < 6; ++i) { const int c = lane + 64 * i; const float y = v[i] * rstd * a.in[I_CLNG][c] + a.in[I_CLNB][c]; const float o = y * sigmoidf_fast(y);
            orow[c] = (bf16_t)(pk_bf16(o, 0.f) & 0xffffu); }
    }
}

constexpr int PR_AS = 784;
__device__ __forceinline__ void prep_unit(const Args& a, LAS unsigned char* lds, int unit) {
    const int tid = threadIdx.x, lane = tid & 63, wave = __builtin_amdgcn_readfirstlane(tid >> 6);
    const int b = unit >> 6, t0 = (unit & 63) * 64;
    const bf16_t* P = (const bf16_t*)(a.ws + WS_P);
    _Float16* SC = (_Float16*)(a.ws + WS_SCAN);
    const float* mu = a.in[I_SHIFTMU];
    __syncthreads();
    for (int q = tid; q < 64 * 192; q += NTHREADS) { const int tt = q / 192, c8 = (q % 192) * 8, s = t0 + tt; const size_t tok = (size_t)b * SEQ + s;
        const bf16_t* row = P + tok * IN_PROJ + 1024 + c8;
        const u32x4 cu = *(const u32x4*)row;
        u32x4 pv = {0u, 0u, 0u, 0u}, nv = {0u, 0u, 0u, 0u};
        if (s > 0) pv = *(const u32x4*)(row - IN_PROJ);
        if (s < SEQ - 1) nv = *(const u32x4*)(row + IN_PROJ);
        const unsigned cw[4] = {cu.x, cu.y, cu.z, cu.w}, pw[4] = {pv.x, pv.y, pv.z, pv.w}, nw[4] = {nv.x, nv.y, nv.z, nv.w};
        const f32x4 m0a = *(const f32x4*)(mu + c8), m0b = *(const f32x4*)(mu + c8 + 4), m1a = *(const f32x4*)(mu + 1536 + c8), m1b = *(const f32x4*)(mu + 1536 + c8 + 4);
        const float m0[8] = {m0a.x, m0a.y, m0a.z, m0a.w, m0b.x, m0b.y, m0b.z, m0b.w}, m1[8] = {m1a.x, m1a.y, m1a.z, m1a.w, m1b.x, m1b.y, m1b.z, m1b.w};
        float pf[8];
#pragma unroll
        for (int k = 0; k < 4; ++k) { const float c0 = bf_lo(cw[k]), c1 = bf_hi(cw[k]);
            pf[2 * k] = c0 + m0[2 * k] * (bf_lo(pw[k]) - c0) + m1[2 * k] * (bf_lo(nw[k]) - c0);
            pf[2 * k + 1] = c1 + m0[2 * k + 1] * (bf_hi(pw[k]) - c1) + m1[2 * k + 1] * (bf_hi(nw[k]) - c1); }
        if (c8 < 1152) {
            const int arr = c8 / RW, cc = c8 % RW;
            f16x4 h0 = {(_Float16)pf[0], (_Float16)pf[1], (_Float16)pf[2], (_Float16)pf[3]}, h1 = {(_Float16)pf[4], (_Float16)pf[5], (_Float16)pf[6], (_Float16)pf[7]};
            f16x4* dst = (f16x4*)((unsigned char*)SC + (size_t)arr * SCAN_STRIDE) + (tok * RW + cc) / 4; dst[0] = h0; dst[1] = h1;
        } else {
            const int cc = c8 - 1152;
#pragma unroll
            for (int k = 0; k < 8; ++k) { if (cc < 128) pf[k] = tanhf(pf[k]); else if (cc >= 256) pf[k] = sigmoidf_fast(pf[k]); }
            u32x4 w; w.x = pk_bf16(pf[0], pf[1]); w.y = pk_bf16(pf[2], pf[3]); w.z = pk_bf16(pf[4], pf[5]); w.w = pk_bf16(pf[6], pf[7]);
            *(LAS u32x4*)(lds + tt * PR_AS + cc * 2) = w; }
    }
    __syncthreads();
    const int l15 = lane & 15, kq = lane >> 4, ch0 = wave * 48;
    const bf16_t* SM = (const bf16_t*)(a.ws + WS_SMALL);
#pragma unroll 1
    for (int o = 0; o < 5; ++o) {
        const int kbase = (o < 4) ? o * 64 : 256, KD = (o < 4) ? 64 : 128;
        const bf16_t* WTm = (o < 4) ? SM + (size_t)o * RW * 64 : SM + (size_t)4 * RW * 64;
        f32x4 acc[4][3];
#pragma unroll
        for (int mt = 0; mt < 4; ++mt)
#pragma unroll
            for (int nt = 0; nt < 3; ++nt) acc[mt][nt] = (f32x4){0.f, 0.f, 0.f, 0.f};
        for (int ks = 0; ks < KD / 32; ++ks) {
            bf16x8 bfr[3], afr[4];
#pragma unroll
            for (int nt = 0; nt < 3; ++nt) bfr[nt] = *(const bf16x8*)(WTm + (size_t)(ch0 + nt * 16 + l15) * KD + ks * 32 + kq * 8);
#pragma unroll
            for (int mt = 0; mt < 4; ++mt) afr[mt] = *(const LAS bf16x8*)(lds + (mt * 16 + l15) * PR_AS + (kbase + ks * 32 + kq * 8) * 2);
#pragma unroll
            for (int mt = 0; mt < 4; ++mt)
#pragma unroll
                for (int nt = 0; nt < 3; ++nt) acc[mt][nt] = __builtin_amdgcn_mfma_f32_16x16x32_bf16(afr[mt], bfr[nt], acc[mt][nt], 0, 0, 0);
        }
#pragma unroll
        for (int nt = 0; nt < 3; ++nt) { const int ch = ch0 + nt * 16 + l15;
            float bias = 0.f;
            if (o < 2) bias = a.in[I_DW0][o * RW + ch]; else if (o < 4) bias = a.in[I_IA0][(o - 2) * RW + ch];
#pragma unroll
            for (int mt = 0; mt < 4; ++mt)
#pragma unroll
                for (int rg = 0; rg < 4; ++rg) { const size_t tok = (size_t)b * SEQ + t0 + mt * 16 + kq * 4 + rg; const float z = acc[mt][nt][rg] + bias;
                    if (o < 2) { const float w = __builtin_amdgcn_exp2f(-0.606531f * 1.4426950408889634f * sigmoidf_fast(z)); ((_Float16*)((unsigned char*)SC + (size_t)(3 + o) * SCAN_STRIDE))[tok * RW + ch] = (_Float16)w; }
                    else if (o < 4) { ((_Float16*)((unsigned char*)SC + (size_t)(3 + o) * SCAN_STRIDE))[tok * RW + ch] = (_Float16)sigmoidf_fast(z); }
                    else { ((bf16_t*)(a.ws + WS_G))[tok * RW + ch] = (bf16_t)(pk_bf16(z, 0.f) & 0xffffu); } }
        }
    }
}

constexpr int SC_CT = 32;
constexpr int SC_JV = SC_CT * 8 * 40 * 4;
constexpr int SC_VV = SC_CT * 64 * 4;
constexpr int SC_SC = SC_CT * 2 * 4;
constexpr int SC_Y = SC_CT * 64 * 4;
constexpr int SC_BUF = SC_JV + SC_VV + SC_SC + SC_Y;
struct ScanRegs { f16x4 r, k, v, w, a; };
__device__ __forceinline__ void scan_unit(const Args& a, LAS unsigned char* lds, int unit) {
    const int tid = threadIdx.x, lane = tid & 63, wave = __builtin_amdgcn_readfirstlane(tid >> 6);
    const int dir = unit & 1, bh = unit >> 1, b = bh / NH, hd = bh % NH;
    const _Float16* SCb = (const _Float16*)(a.ws + WS_SCAN);
    const _Float16* Rg = SCb; const _Float16* Kg = (const _Float16*)((const unsigned char*)SCb + SCAN_STRIDE); const _Float16* Vg = (const _Float16*)((const unsigned char*)SCb + 2 * SCAN_STRIDE);
    const _Float16* Wg = (const _Float16*)((const unsigned char*)SCb + (size_t)(3 + dir) * SCAN_STRIDE); const _Float16* Ag = (const _Float16*)((const unsigned char*)SCb + (size_t)(5 + dir) * SCAN_STRIDE);
    float* Yg = (float*)(a.ws + (dir ? WS_YB : WS_YF)); float* BON = (float*)(a.ws + WS_BON) + (size_t)dir * T * NH;
    const int ls = tid >> 4, lq = tid & 15, chl = hd * 64 + 4 * lq;
    const f32x4 kkw = *(const f32x4*)(a.in[I_KK] + chl), kaw = *(const f32x4*)(a.in[I_KA] + chl), rkw = *(const f32x4*)(a.in[I_RK] + chl);
    const int jg = lane & 7, row = wave * 8 + (lane >> 3);
    float S[8];
#pragma unroll
    for (int j = 0; j < 8; ++j) S[j] = 0.f;
    constexpr int NCK = SEQ / SC_CT;
    ScanRegs rg;
#define SCAN_LOAD(ck) do { const int st_ = (ck) * SC_CT + ls; const int t_ = dir ? (SEQ - 1 - st_) : st_; const size_t e_ = ((size_t)b * SEQ + t_) * RW + chl; \
        rg.r = *(const f16x4*)(Rg + e_); rg.k = *(const f16x4*)(Kg + e_); rg.v = *(const f16x4*)(Vg + e_); rg.w = *(const f16x4*)(Wg + e_); rg.a = *(const f16x4*)(Ag + e_); } while (0)
#define SCAN_PROC(ck, buf) do { LAS unsigned char* B_ = lds + (buf) * SC_BUF; \
        const f32x4 r_ = __builtin_convertvector(rg.r, f32x4), k_ = __builtin_convertvector(rg.k, f32x4), v_ = __builtin_convertvector(rg.v, f32x4), w_ = __builtin_convertvector(rg.w, f32x4), a_ = __builtin_convertvector(rg.a, f32x4); \
        f32x4 kk_ = k_ * kkw; float ss_ = (kk_.x * kk_.x + kk_.y * kk_.y) + (kk_.z * kk_.z + kk_.w * kk_.w); ss_ = sum16(ss_); kk_ = kk_ * (1.0f / sqrtf(ss_ + 1e-12f)); \
        const f32x4 b_ = kk_ * a_, kd_ = k_ * (1.0f + (a_ - 1.0f) * kaw), wr_ = w_ * r_; \
        float br_ = (b_.x * r_.x + b_.y * r_.y) + (b_.z * r_.z + b_.w * r_.w), kr_ = (kd_.x * r_.x + kd_.y * r_.y) + (kd_.z * r_.z + kd_.w * r_.w); \
        float bn_ = (kd_.x * r_.x * rkw.x + kd_.y * r_.y * rkw.y) + (kd_.z * r_.z * rkw.z + kd_.w * r_.w * rkw.w); \
        br_ = sum16(br_); kr_ = sum16(kr_); bn_ = sum16(bn_); \
        LAS f32x4* jv_ = (LAS f32x4*)(B_ + ls * 1280 + (lq >> 1) * 160 + (lq & 1) * 16); \
        jv_[0] = kk_; jv_[2] = wr_; jv_[4] = w_; jv_[6] = b_; jv_[8] = kd_; \
        *(LAS f32x4*)(B_ + SC_JV + ls * 256 + lq * 16) = v_; \
        if (lq == 0) { *(LAS f32x2*)(B_ + SC_JV + SC_VV + ls * 8) = (f32x2){br_, kr_}; const int st_ = (ck) * SC_CT + ls; const int t_ = dir ? (SEQ - 1 - st_) : st_; BON[((size_t)b * SEQ + t_) * NH + hd] = bn_; } } while (0)
    __syncthreads();
    SCAN_LOAD(0); SCAN_PROC(0, 0);
    __syncthreads();
#pragma unroll 1
    for (int ck = 0; ck < NCK; ++ck) {
        const int buf = ck & 1;
        if (ck + 1 < NCK) SCAN_LOAD(ck + 1);
        const LAS unsigned char* Bc = lds + buf * SC_BUF;
#pragma unroll 4
        for (int st = 0; st < SC_CT; ++st) {
            const LAS f32x4* jv = (const LAS f32x4*)(Bc + st * 1280 + jg * 160);
            const f32x4 kk0 = jv[0], kk1 = jv[1], wr0 = jv[2], wr1 = jv[3], w0 = jv[4], w1 = jv[5], b0 = jv[6], b1 = jv[7], kd0 = jv[8], kd1 = jv[9];
            const float vi = *(const LAS float*)(Bc + SC_JV + st * 256 + row * 4);
            const f32x2 sc2 = *(const LAS f32x2*)(Bc + SC_JV + SC_VV + st * 8);
            float sa = (S[0] * kk0.x + S[1] * kk0.y) + (S[2] * kk0.z + S[3] * kk0.w) + (S[4] * kk1.x + S[5] * kk1.y) + (S[6] * kk1.z + S[7] * kk1.w);
            float yp = (S[0] * wr0.x + S[1] * wr0.y) + (S[2] * wr0.z + S[3] * wr0.w) + (S[4] * wr1.x + S[5] * wr1.y) + (S[6] * wr1.z + S[7] * wr1.w);
            sa = -sum8(sa); yp = sum8(yp);
            const float y = yp + sa * sc2.x + vi * sc2.y;
            S[0] = S[0] * w0.x + (sa * b0.x + vi * kd0.x); S[1] = S[1] * w0.y + (sa * b0.y + vi * kd0.y); S[2] = S[2] * w0.z + (sa * b0.z + vi * kd0.z); S[3] = S[3] * w0.w + (sa * b0.w + vi * kd0.w);
            S[4] = S[4] * w1.x + (sa * b1.x + vi * kd1.x); S[5] = S[5] * w1.y + (sa * b1.y + vi * kd1.y); S[6] = S[6] * w1.z + (sa * b1.z + vi * kd1.z); S[7] = S[7] * w1.w + (sa * b1.w + vi * kd1.w);
            if (jg == 0) *(LAS float*)(lds + buf * SC_BUF + SC_JV + SC_VV + SC_SC + st * 256 + row * 4) = y;
        }
        __syncthreads();
        {
            const f32x4 yv = *(const LAS f32x4*)(lds + buf * SC_BUF + SC_JV + SC_VV + SC_SC + ls * 256 + lq * 16);
            const int st_ = ck * SC_CT + ls; const int t_ = dir ? (SEQ - 1 - st_) : st_;
            *(f32x4*)(Yg + ((size_t)b * SEQ + t_) * RW + hd * 64 + 4 * lq) = yv;
        }
        if (ck + 1 < NCK) SCAN_PROC(ck + 1, buf ^ 1);
        __syncthreads();
    }
#undef SCAN_LOAD
#undef SCAN_PROC
}

__device__ __forceinline__ void phase_post(const Args& a, int G) {
    const int tid = threadIdx.x, lane = tid & 63, wave = __builtin_amdgcn_readfirstlane(tid >> 6);
    const int gw = blockIdx.x * 8 + wave, NGW = G * 8;
    const float* YF = (const float*)(a.ws + WS_YF); const float* YB = (const float*)(a.ws + WS_YB); const float* BON = (const float*)(a.ws + WS_BON);
    const _Float16* Vg = (const _Float16*)(a.ws + WS_SCAN + 2 * SCAN_STRIDE); const bf16_t* Gg = (const bf16_t*)(a.ws + WS_G); bf16_t* MIX = (bf16_t*)(a.ws + WS_MIX);
    float* ss = (float*)(a.ws + WS_SS);
    for (int i = blockIdx.x * NTHREADS + tid; i < T; i += G * NTHREADS) ss[i] = 0.f;
    for (int tok = gw; tok < T; tok += NGW) {
#pragma unroll
        for (int hd = 0; hd < NH; ++hd) { const int ch = hd * 64 + lane; const size_t e = (size_t)tok * RW + ch;
            const float y = YF[e] + YB[e];
            const float mean = wave_sum(y) * (1.f / 64.f); const float dlt = y - mean; const float var = wave_sum(dlt * dlt) * (1.f / 64.f);
            const float yn = dlt * (1.0f / sqrtf(var + 64e-5f)) * a.in[I_LNXG][ch] + a.in[I_LNXB][ch];
            const float bon = BON[(size_t)tok * NH + hd] + BON[(size_t)T * NH + (size_t)tok * NH + hd];
            const float gv = bf_lo((unsigned)Gg[e]);
            const float o = (yn + bon * (float)Vg[e]) * gv;
            MIX[(size_t)tok * D + 640 + ch] = (bf16_t)(pk_bf16(o, 0.f) & 0xffffu); }
    }
}

__device__ __forceinline__ void phase_router(const Args& a, LAS unsigned char* lds, int G) {
    const int tid = threadIdx.x, lane = tid & 63, wave = __builtin_amdgcn_readfirstlane(tid >> 6);
    const int gw = blockIdx.x * 8 + wave, NGW = G * 8;
    LAS float* WR = (LAS float*)lds;
    for (int i = tid; i < D * NE / 4; i += NTHREADS) ((LAS f32x4*)WR)[i] = ((const f32x4*)a.in[I_WROUTER])[i];
    __syncthreads();
    const float* X1 = (const float*)(a.ws + WS_X1); const float* ss = (const float*)(a.ws + WS_SS); bf16_t* H2 = (bf16_t*)(a.ws + WS_H2);
    float* AFF = (float*)(a.ws + WS_AFF); int* INV = (int*)(a.ws + WS_INV);
    for (int tok = gw; tok < T; tok += NGW) {
        const float rs = 1.0f / sqrtf(ss[tok] * (1.f / D) + 1e-6f);
        float lg[16];
#pragma unroll
        for (int e = 0; e < 16; ++e) lg[e] = 0.f;
#pragma unroll 1
        for (int j = 0; j < 4; ++j) { const int col = 4 * lane + 256 * j; const f32x4 xv = *(const f32x4*)(X1 + (size_t)tok * D + col); const f32x4 gg = *(const f32x4*)(a.in[I_NFFNG] + col);
            const float hv[4] = {xv.x * rs * gg.x, xv.y * rs * gg.y, xv.z * rs * gg.z, xv.w * rs * gg.w};
            u32x2 w; w.x = pk_bf16(hv[0], hv[1]); w.y = pk_bf16(hv[2], hv[3]); *(u32x2*)(H2 + (size_t)tok * D + col) = w;
#pragma unroll
            for (int c = 0; c < 4; ++c) { const LAS f32x4* wr = (const LAS f32x4*)(WR + (col + c) * NE);
#pragma unroll
                for (int q = 0; q < 4; ++q) { const f32x4 wv = wr[q]; lg[4 * q] += hv[c] * wv.x; lg[4 * q + 1] += hv[c] * wv.y; lg[4 * q + 2] += hv[c] * wv.z; lg[4 * q + 3] += hv[c] * wv.w; } } }
        float mx = -3.0e38f;
#pragma unroll
        for (int e = 0; e < 16; ++e) { lg[e] = wave_sum(lg[e]); mx = fmaxf(mx, lg[e]); }
        float sum = 0.f;
#pragma unroll
        for (int e = 0; e < 16; ++e) { lg[e] = __expf(lg[e] - mx); sum += lg[e]; }
        const float inv = 1.0f / sum;
        float mine = 0.f;
#pragma unroll
        for (int e = 0; e < 16; ++e) mine = (lane == e) ? lg[e] * inv : mine;
        const int bb = tok >> 12, s = tok & (SEQ - 1);
        if (lane < 16) { AFF[((size_t)(bb * NE + lane)) * SEQ + s] = mine; INV[(size_t)tok * NE + lane] = -1; }
    }
}

__device__ __forceinline__ void topk_unit(const Args& a, LAS unsigned char* lds, int unit) {
    const int tid = threadIdx.x, lane = tid & 63, wave = __builtin_amdgcn_readfirstlane(tid >> 6);
    const int b = unit >> 4, e = unit & 15;
    const float* AFF = (const float*)(a.ws + WS_AFF) + (size_t)unit * SEQ;
    LAS unsigned* KEY = (LAS unsigned*)lds;
    LAS unsigned* HIST = (LAS unsigned*)(lds + 16384);
    LAS unsigned* CTL = (LAS unsigned*)(lds + 16384 + 1024);
    LAS unsigned* WS_ = (LAS unsigned*)(lds + 16384 + 2048);
    __syncthreads();
    unsigned key[8];
    { const u32x4 k0 = *(const u32x4*)(AFF + tid * 8), k1 = *(const u32x4*)(AFF + tid * 8 + 4); key[0] = k0.x; key[1] = k0.y; key[2] = k0.z; key[3] = k0.w; key[4] = k1.x; key[5] = k1.y; key[6] = k1.z; key[7] = k1.w; }
    if (tid == 0) { CTL[0] = 0u; CTL[1] = (unsigned)CAP; }
    unsigned prefix = 0u, mask = 0u;
#pragma unroll 1
    for (int pass = 0; pass < 4; ++pass) {
        const int shift = 24 - 8 * pass;
        if (tid < 256) HIST[tid] = 0u;
        __syncthreads();
#pragma unroll
        for (int i = 0; i < 8; ++i) if ((key[i] & mask) == prefix) (void)__hip_atomic_fetch_add(&HIST[(key[i] >> shift) & 255u], 1u, __ATOMIC_RELAXED, __HIP_MEMORY_SCOPE_WORKGROUP);
        __syncthreads();
        if (wave == 0) {
            const unsigned need = CTL[1];
            unsigned hv[4], tsum = 0u;
#pragma unroll
            for (int i = 0; i < 4; ++i) { hv[i] = HIST[255 - (4 * lane + i)]; tsum += hv[i]; }
            unsigned inc = tsum;
#pragma unroll
            for (int o = 1; o < 64; o <<= 1) { const unsigned v = __shfl_up(inc, o); if (lane >= o) inc += v; }
            unsigned exc = inc - tsum;
            if (exc < need && need <= inc) {
                unsigned run = exc; int di = 0;
#pragma unroll
                for (int i = 0; i < 4; ++i) { if (run < need && need <= run + hv[i]) { di = i; break; } run += hv[i]; }
                const unsigned digit = 255u - (unsigned)(4 * lane + di);
                CTL[0] = prefix | (digit << shift); CTL[1] = need - run;
            }
        }
        __syncthreads();
        prefix = CTL[0]; mask |= (255u << shift);
    }
    const unsigned thr = prefix, need_eq = CTL[1];
    unsigned ngt = 0u, neq = 0u;
#pragma unroll
    for (int i = 0; i < 8; ++i) { ngt += (key[i] > thr) ? 1u : 0u; neq += (key[i] == thr) ? 1u : 0u; }
    unsigned pk = ngt | (neq << 16), inc = pk;
#pragma unroll
    for (int o = 1; o < 64; o <<= 1) { const unsigned v = __shfl_up(inc, o); if (lane >= o) inc += v; }
    if (lane == 63) WS_[wave] = inc;
    __syncthreads();
    unsigned woff = 0u, tot = 0u;
#pragma unroll
    for (int w = 0; w < 8; ++w) { const unsigned v = WS_[w]; if (w < wave) woff += v; tot += v; }
    const unsigned exc = inc - pk + woff;
    unsigned gpos = exc & 0xffffu, epos = exc >> 16; const unsigned totgt = tot & 0xffffu;
    const int sbase = (e * BATCH + b) * CAP;
    int* ROWTOK = (int*)(a.ws + WS_ROWTOK); float* ROWGATE = (float*)(a.ws + WS_ROWGATE); int* INV = (int*)(a.ws + WS_INV);
#pragma unroll
    for (int i = 0; i < 8; ++i) {
        int pos = -1;
        if (key[i] > thr) pos = (int)gpos++;
        else if (key[i] == thr) { if (epos < need_eq) pos = (int)(totgt + epos); epos++; }
        if (pos >= 0) { const int s = tid * 8 + i, tok = b * SEQ + s, slot = sbase + pos;
            ROWTOK[slot] = tok; ROWGATE[slot] = __builtin_bit_cast(float, key[i]); INV[(size_t)tok * NE + e] = slot; }
    }
}

__device__ __forceinline__ void phase_final(const Args& a, int G) {
    const int tid = threadIdx.x, lane = tid & 63, wave = __builtin_amdgcn_readfirstlane(tid >> 6);
    const int gw = blockIdx.x * 8 + wave, NGW = G * 8;
    const float* X1 = (const float*)(a.ws + WS_X1); const bf16_t* YE = (const bf16_t*)(a.ws + WS_YE); const int* INV = (const int*)(a.ws + WS_INV);
    for (int tok = gw; tok < T; tok += NGW) {
        f32x4 v[4];
#pragma unroll
        for (int j = 0; j < 4; ++j) v[j] = *(const f32x4*)(X1 + (size_t)tok * D + 4 * lane + 256 * j);
        for (int e = 0; e < NE; ++e) { const int slot = __builtin_amdgcn_readfirstlane(INV[(size_t)tok * NE + e]);
            if (slot >= 0) {
#pragma unroll
                for (int j = 0; j < 4; ++j) { const u32x2 w = *(const u32x2*)(YE + (size_t)slot * D + 4 * lane + 256 * j);
                    v[j].x += bf_lo(w.x); v[j].y += bf_hi(w.x); v[j].z += bf_lo(w.y); v[j].w += bf_hi(w.y); } } }
        float s = 0.f;
#pragma unroll
        for (int j = 0; j < 4; ++j) s += (v[j].x * v[j].x + v[j].y * v[j].y) + (v[j].z * v[j].z + v[j].w * v[j].w);
        const float rs = 1.0f / sqrtf(wave_sum(s) * (1.f / D) + 1e-6f);
#pragma unroll
        for (int j = 0; j < 4; ++j) { const f32x4 gg = *(const f32x4*)(a.in[I_FNG] + 4 * lane + 256 * j);
            *(f32x4*)(a.out + (size_t)tok * D + 4 * lane + 256 * j) = (f32x4){v[j].x * rs * gg.x, v[j].y * rs * gg.y, v[j].z * rs * gg.z, v[j].w * rs * gg.w}; }
    }
}

__global__ void __launch_bounds__(NTHREADS, 2) mega(Args a) {
    extern __shared__ __attribute__((aligned(16))) unsigned char lds_raw[];
    LAS unsigned char* lds = (LAS unsigned char*)lds_raw;
    cg::grid_group grid = cg::this_grid();
    const int G = gridDim.x, lo = a.ph_lo, hi = a.ph_hi;
    unsigned char* ws = a.ws;
#ifndef PH_MASK
#define PH_MASK 0x7ff
#endif
#define IN(k) (((PH_MASK >> (k)) & 1) && lo <= (k) && (k) < hi)
#define SEAM(k) do { if (IN((k) + 1)) grid.sync(); } while (0)

    if (IN(0)) { phase_prep(a, lds, G); SEAM(0); }

    if (IN(1)) {
        { pg8::Gemm g{(const bf16_t*)(ws + WS_XH), (const bf16_t*)(ws + WS_WINT), T, IN_PROJ, D}; pg8::StaticOrder S; S.init(T, IN_PROJ, G, (int)blockIdx.x);
          pg8::EpiBf16 E{(bf16_t*)(ws + WS_P), IN_PROJ}; pg8::gemm_phase<pg8::EpiBf16, pg8::StaticOrder, false>(lds, g, S, E, nullptr); }
        { pg8::Gemm g{(const bf16_t*)(ws + WS_MEMN), (const bf16_t*)(ws + WS_WKT), BATCH * NMEM, 256, D}; pg8::StaticOrder S; S.init(BATCH * NMEM, 256, G, (int)blockIdx.x);
          pg8::EpiBf16 E{(bf16_t*)(ws + WS_KMEM), 256}; pg8::gemm_phase<pg8::EpiBf16, pg8::StaticOrder, false>(lds, g, S, E, nullptr); }
        { pg8::Gemm g{(const bf16_t*)(ws + WS_WVT), (const bf16_t*)(ws + WS_MEMN), 256, BATCH * NMEM, D}; pg8::StaticOrder S; S.init(256, BATCH * NMEM, G, (int)blockIdx.x);
          pg8::EpiBf16 E{(bf16_t*)(ws + WS_VT), BATCH * NMEM}; pg8::gemm_phase<pg8::EpiBf16, pg8::StaticOrder, false>(lds, g, S, E, nullptr); }
        SEAM(1);
    }

    if (IN(2)) {
        for (int u = blockIdx.x; u < 3072; u += G) {
#ifndef P2_MASK
#define P2_MASK 7
#endif
            if (u < 1024) { if (P2_MASK & 1) attn_unit(a, lds, u); } else if (u < 2048) { if (P2_MASK & 2) conv_unit(a, lds, u - 1024); } else { if (P2_MASK & 4) prep_unit(a, lds, u - 2048); }
        }
        SEAM(2);
    }

    if (IN(3)) {
        for (int u = blockIdx.x; u < BATCH * NH * 2; u += G) scan_unit(a, lds, u);
        SEAM(3);
    }

    if (IN(4)) { phase_post(a, G); SEAM(4); }

    if (IN(5)) {
        pg8::Gemm g{(const bf16_t*)(ws + WS_MIX), (const bf16_t*)(ws + WS_WOUTT), T, D, D}; pg8::StaticOrder S; S.init(T, D, G, (int)blockIdx.x);
        pg8::EpiResidSS E{a.in[I_X], (float*)(ws + WS_X1), (float*)(ws + WS_SS)}; pg8::gemm_phase<pg8::EpiResidSS, pg8::StaticOrder, false>(lds, g, S, E, nullptr);
        SEAM(5);
    }

    if (IN(6)) { phase_router(a, lds, G); SEAM(6); }

    if (IN(7)) { for (int u = blockIdx.x; u < BATCH * NE; u += G) topk_unit(a, lds, u); SEAM(7); }

    if (IN(8)) {
        pg8::Gemm g{(const bf16_t*)(ws + WS_H2), (const bf16_t*)(ws + WS_WGUT), NSLOT, 2048, D}; pg8::ExpertOrder S; S.init(32, 8, NE, G, (int)blockIdx.x);
        pg8::EpiSwiGLU E{(bf16_t*)(ws + WS_HID)}; pg8::gemm_phase<pg8::EpiSwiGLU, pg8::ExpertOrder, true>(lds, g, S, E, (const int*)(ws + WS_ROWTOK));
        SEAM(8);
    }

    if (IN(9)) {
        pg8::Gemm g{(const bf16_t*)(ws + WS_HID), (const bf16_t*)(ws + WS_WDT), NSLOT, D, FF}; pg8::ExpertOrder S; S.init(32, 4, NE, G, (int)blockIdx.x);
        pg8::EpiGateScale E{(bf16_t*)(ws + WS_YE), (const float*)(ws + WS_ROWGATE)}; pg8::gemm_phase<pg8::EpiGateScale, pg8::ExpertOrder, false>(lds, g, S, E, nullptr);
        SEAM(9);
    }

    if (IN(10)) { phase_final(a, G); }
#undef IN
#undef SEAM
}

#ifndef MK_ONE_LAUNCH
#define MK_ONE_LAUNCH 0
#endif
extern "C" void kernel_launch(void* const* d_in, const int* in_sizes, int n_in, void* d_out, int out_size, void* d_ws, size_t ws_size, hipStream_t stream) {
    static int grid_blocks = 0;
    if (grid_blocks == 0) {
        if (n_in != 29 || out_size != T * D || ws_size < WS_END) { fprintf(stderr, "kernel_launch: unexpected problem: n_in %d out %d ws %zu (need %zu)\n", n_in, out_size, ws_size, (size_t)WS_END); grid_blocks = -1; return; }
        int dev = 0, cus = 0, per_cu = 0;
        if (hipGetDevice(&dev) != hipSuccess || hipDeviceGetAttribute(&cus, hipDeviceAttributeMultiprocessorCount, dev) != hipSuccess) { grid_blocks = -1; return; }
        if (hipFuncSetAttribute((const void*)mega, hipFuncAttributeMaxDynamicSharedMemorySize, LDS_BYTES) != hipSuccess) { fprintf(stderr, "kernel_launch: hipFuncSetAttribute failed\n"); grid_blocks = -1; return; }
        if (hipOccupancyMaxActiveBlocksPerMultiprocessor(&per_cu, (const void*)mega, NTHREADS, LDS_BYTES) != hipSuccess || per_cu < 1) { fprintf(stderr, "kernel_launch: occupancy query says %d blocks per CU\n", per_cu); grid_blocks = -1; return; }
        grid_blocks = cus;
    }
    if (grid_blocks < 0) return;
    Args a{};
    for (int i = 0; i < 29; ++i) a.in[i] = (const float*)d_in[i];
    a.out = (float*)d_out; a.ws = (unsigned char*)d_ws;
#if MK_ONE_LAUNCH
    a.ph_lo = 0; a.ph_hi = NPHASE;
    { void* args[] = {&a}; hipError_t e = hipLaunchCooperativeKernel((const void*)mega, dim3(grid_blocks), dim3(NTHREADS), args, LDS_BYTES, stream);
      if (e != hipSuccess) fprintf(stderr, "cooperative launch failed: %s (grid %d)\n", hipGetErrorString(e), grid_blocks); }
#else
    for (int ph = 0; ph < NPHASE; ++ph) { a.ph_lo = ph; a.ph_hi = ph + 1; void* args[] = {&a};
        hipError_t e = hipLaunchCooperativeKernel((const void*)mega, dim3(grid_blocks), dim3(NTHREADS), args, LDS_BYTES, stream);
        if (e != hipSuccess) { fprintf(stderr, "cooperative launch %d failed: %s (grid %d)\n", ph, hipGetErrorString(e), grid_blocks); break; } }
#endif
}
```

```cpp
#include <hip/hip_runtime.h>
#include <hip/hip_cooperative_groups.h>
#include <cstdio>
#include <cstdint>
namespace cg = cooperative_groups;

#define LAS __attribute__((address_space(3)))
typedef unsigned short bf16_t;
typedef short bf16x8 __attribute__((ext_vector_type(8)));
typedef short s16x4 __attribute__((ext_vector_type(4)));
typedef float f32x2 __attribute__((ext_vector_type(2)));
typedef float f32x4 __attribute__((ext_vector_type(4)));
typedef float f32x16 __attribute__((ext_vector_type(16)));
typedef unsigned u32x2 __attribute__((ext_vector_type(2)));
typedef unsigned u32x4 __attribute__((ext_vector_type(4)));
typedef _Float16 f16x4 __attribute__((ext_vector_type(4)));
typedef __bf16 bf16v2 __attribute__((ext_vector_type(2)));

constexpr int D = 1024, BATCH = 16, SEQ = 4096, T = BATCH * SEQ, NMEM = 256;
constexpr int IN_PROJ = 2560, CW = 384, RW = 384, NH = 6, NE = 16, FF = 1024, CAP = 512;
constexpr int NSLOT = NE * BATCH * CAP;
constexpr int NTHREADS = 512;
constexpr int LDS_BYTES = 160 * 1024;
constexpr int NPHASE = 11;

constexpr size_t MiB = 1u << 20;
constexpr size_t WS_WINT = 1 * MiB;
constexpr size_t WS_WOUTT = 6 * MiB;
constexpr size_t WS_WKT = 8 * MiB;
constexpr size_t WS_WVT = 8 * MiB + 512 * 1024;
constexpr size_t WS_SMALL = 9 * MiB;
constexpr size_t WS_WGUT = 10 * MiB;
constexpr size_t WS_WDT = 74 * MiB;
constexpr size_t WS_KMEM = 106 * MiB;
constexpr size_t WS_VT = 108 * MiB;
constexpr size_t WS_ROWTOK = 106 * MiB;
constexpr size_t WS_ROWGATE = 106 * MiB + 512 * 1024;
constexpr size_t WS_SS = 107 * MiB;
constexpr size_t WS_P = 112 * MiB;
constexpr size_t WS_YF = 112 * MiB;
constexpr size_t WS_YB = 208 * MiB;
constexpr size_t WS_X1 = 112 * MiB;
constexpr size_t WS_XH = 432 * MiB;
constexpr size_t WS_G = 432 * MiB;
constexpr size_t WS_BON = 480 * MiB;
constexpr size_t WS_H2 = 432 * MiB;
constexpr size_t WS_MEMN = 560 * MiB;
constexpr size_t WS_MIX = 560 * MiB;
constexpr size_t WS_SCAN = 688 * MiB;
constexpr size_t SCAN_STRIDE = 48 * MiB;
constexpr size_t WS_AFF = 624 * MiB;
constexpr size_t WS_INV = 628 * MiB;
constexpr size_t WS_HID = 768 * MiB;
constexpr size_t WS_YE = 368 * MiB;
constexpr size_t WS_END = 1024 * MiB;

__device__ __forceinline__ unsigned pk_bf16(float lo, float hi) { f32x2 v = {lo, hi}; bf16v2 b = __builtin_convertvector(v, bf16v2); return __builtin_bit_cast(unsigned, b); }
__device__ __forceinline__ float bf_lo(unsigned u) { return __builtin_bit_cast(float, u << 16); }
__device__ __forceinline__ float bf_hi(unsigned u) { return __builtin_bit_cast(float, u & 0xffff0000u); }
__device__ __forceinline__ float wave_sum(float v) {
#pragma unroll
    for (int o = 1; o < 64; o <<= 1) v += __shfl_xor(v, o);
    return v;
}
__device__ __forceinline__ float sigmoidf_fast(float x) { return __builtin_amdgcn_rcpf(1.0f + __builtin_amdgcn_exp2f(-1.4426950408889634f * x)); }
template <int CTRL> __device__ __forceinline__ float dpp_f(float x) { return __builtin_bit_cast(float, __builtin_amdgcn_update_dpp(0, __builtin_bit_cast(int, x), CTRL, 0xF, 0xF, true)); }
__device__ __forceinline__ float sum8(float x) { x += dpp_f<0xB1>(x); x += dpp_f<0x4E>(x); x += dpp_f<0x141>(x); return x; }
__device__ __forceinline__ float sum16(float x) { x = sum8(x); x += dpp_f<0x140>(x); return x; }

namespace pg8 {
#define PG8_LAS __attribute__((address_space(3)))
constexpr int BM = 256, BK = 64, HALF = 128, HTB = HALF * BK * 2, STAGE_BYTES = 8 * HTB, NXCD = 8, WGM = 8;
__host__ __device__ __forceinline__ int lds_byte(int r, int c) { const int st = (r >> 4) * 2 + (c >> 5), rr = r & 15, cc = c & 31, ob = rr * 64 + cc * 2; return st * 1024 + (ob ^ (((ob >> 9) & 1) << 5)); }
__host__ __device__ __forceinline__ void stage_rc(int b, int& R, int& C) { const int st = b / 1024, sb = b % 1024, swz = sb ^ (((sb >> 9) & 1) << 5); R = (st >> 1) * 16 + swz / 64; C = (st & 1) * 32 + (swz % 64) / 2; }
__host__ __device__ __forceinline__ int perm32(int rho) { const int n = rho >> 4, i = rho & 15; return 8 * (i >> 2) + 4 * n + (i & 3); }

struct Unit { int pm, pn; };
struct Gemm { const bf16_t* A; const bf16_t* Bt; int M, N, K; };

struct StaticOrder {
    int nM, nN, nwg, G, c;
    __device__ void init(int M, int N, int G_, int c_) { nM = M / BM; nN = N / BM; nwg = nM * nN; G = G_; c = c_; }
    __device__ bool next(int i, Unit& u) const {
        const long L = (long)i * G + c; if (L >= nwg) return false;
        int wgid = (int)L; { const int q = nwg / NXCD, r = nwg % NXCD, xcd = wgid % NXCD, off = wgid / NXCD; wgid = (xcd < r ? xcd * (q + 1) : r * (q + 1) + (xcd - r) * q) + off; }
        const int nig = WGM * nN, gid = wgid / nig, fm = gid * WGM, gsz = (nM - fm) < WGM ? (nM - fm) : WGM;
        u.pm = fm + ((wgid % nig) % gsz); u.pn = (wgid % nig) / gsz; return true;
    }
};
struct ExpertOrder {
    int nMe, nNe, per, total, G, c;
    __device__ void init(int nMe_, int nNe_, int nExp, int G_, int c_) { nMe = nMe_; nNe = nNe_; per = nMe * nNe; total = per * nExp; G = G_; c = c_; }
    __device__ bool next(int i, Unit& u) const {
        const long L = (long)i * G + c; if (L >= total) return false;
        const int e = (int)(L / per), w = (int)(L % per), xl = w % 8, j = w / 8, rpx = nMe / 8;
        u.pm = e * nMe + xl * rpx + (j % rpx); u.pn = e * nNe + j / rpx; return true;
    }
};

struct EpiBf16 {
    static constexpr bool PERM = true;
    bf16_t* O; int ldc;
    __device__ __forceinline__ void operator()(const f32x4 (&acc)[2][2][4][2], const Unit& u, int wr, int wc, int fr, int fq) const {
        const int row0 = u.pm * BM + wr * 64 + fr, col0 = u.pn * BM + wc * 32 + 8 * fq;
#pragma unroll
        for (int ai = 0; ai < 2; ++ai)
#pragma unroll
            for (int m = 0; m < 4; ++m) { bf16_t* rowp = O + (size_t)(row0 + ai * HALF + m * 16) * ldc + col0;
#pragma unroll
                for (int bj = 0; bj < 2; ++bj) { const f32x4 v0 = acc[ai][bj][m][0], v1 = acc[ai][bj][m][1];
                    u32x4 w; w.x = pk_bf16(v0[0], v0[1]); w.y = pk_bf16(v0[2], v0[3]); w.z = pk_bf16(v1[0], v1[1]); w.w = pk_bf16(v1[2], v1[3]);
                    *(u32x4*)(rowp + bj * HALF) = w; } }
    }
};
struct EpiResidSS {
    static constexpr bool PERM = false;
    const float* X; float* X1; float* ss;
    __device__ __forceinline__ void operator()(const f32x4 (&acc)[2][2][4][2], const Unit& u, int wr, int wc, int fr, int fq) const {
        const int row0 = u.pm * BM + wr * 64 + fr, col0 = u.pn * BM + wc * 32 + 4 * fq;
#pragma unroll
        for (int ai = 0; ai < 2; ++ai)
#pragma unroll
            for (int m = 0; m < 4; ++m) { const int row = row0 + ai * HALF + m * 16; const size_t off = (size_t)row * D + col0; float s = 0.f;
#pragma unroll
                for (int bj = 0; bj < 2; ++bj)
#pragma unroll
                    for (int n = 0; n < 2; ++n) { const f32x4 xv = *(const f32x4*)(X + off + bj * HALF + n * 16); const f32x4 o = xv + acc[ai][bj][m][n];
                        *(f32x4*)(X1 + off + bj * HALF + n * 16) = o; s += (o[0] * o[0] + o[1] * o[1]) + (o[2] * o[2] + o[3] * o[3]); }
                s += __shfl_xor(s, 16); s += __shfl_xor(s, 32);
                if (fq == 0) (void)__hip_atomic_fetch_add(ss + row, s, __ATOMIC_RELAXED, __HIP_MEMORY_SCOPE_AGENT); }
    }
};
struct EpiSwiGLU {
    static constexpr bool PERM = true;
    bf16_t* H;
    __device__ __forceinline__ void operator()(const f32x4 (&acc)[2][2][4][2], const Unit& u, int wr, int wc, int fr, int fq) const {
        const int row0 = u.pm * BM + wr * 64 + fr, col0 = (u.pn & 7) * HALF + wc * 32 + 8 * fq;
#pragma unroll
        for (int ai = 0; ai < 2; ++ai)
#pragma unroll
            for (int m = 0; m < 4; ++m) { bf16_t* rowp = H + (size_t)(row0 + ai * HALF + m * 16) * FF + col0; float h[8];
#pragma unroll
                for (int n = 0; n < 2; ++n)
#pragma unroll
                    for (int j = 0; j < 4; ++j) { const float gt = acc[ai][0][m][n][j], up = acc[ai][1][m][n][j]; h[n * 4 + j] = gt * sigmoidf_fast(gt) * up; }
                u32x4 w; w.x = pk_bf16(h[0], h[1]); w.y = pk_bf16(h[2], h[3]); w.z = pk_bf16(h[4], h[5]); w.w = pk_bf16(h[6], h[7]);
                *(u32x4*)rowp = w; }
    }
};
struct EpiGateScale {
    static constexpr bool PERM = true;
    bf16_t* Y; const float* gate;
    __device__ __forceinline__ void operator()(const f32x4 (&acc)[2][2][4][2], const Unit& u, int wr, int wc, int fr, int fq) const {
        const int row0 = u.pm * BM + wr * 64 + fr, col0 = (u.pn & 3) * BM + wc * 32 + 8 * fq;
#pragma unroll
        for (int ai = 0; ai < 2; ++ai)
#pragma unroll
            for (int m = 0; m < 4; ++m) { const int row = row0 + ai * HALF + m * 16; const float gs = gate[row]; bf16_t* rowp = Y + (size_t)row * D + col0;
#pragma unroll
                for (int bj = 0; bj < 2; ++bj) { const f32x4 v0 = acc[ai][bj][m][0] * gs, v1 = acc[ai][bj][m][1] * gs;
                    u32x4 w; w.x = pk_bf16(v0[0], v0[1]); w.y = pk_bf16(v0[2], v0[3]); w.z = pk_bf16(v1[0], v1[1]); w.w = pk_bf16(v1[2], v1[3]);
                    *(u32x4*)(rowp + bj * HALF) = w; } }
    }
};

template <class Epi, class Sched, bool GATHER>
__device__ __forceinline__ void gemm_phase(PG8_LAS unsigned char* lds, const Gemm g, const Sched& S, const Epi& E, const int* rowtok) {
    const int tid = threadIdx.x, wid = __builtin_amdgcn_readfirstlane(tid >> 6), lane = tid & 63, wr = wid >> 2, wc = wid & 3, fr = lane & 15, fq = lane >> 4;
    const int K = g.K, nt = K / BK;
    unsigned voffA[2], voffB[2]; int Rr[2], Cc[2];
#pragma unroll
    for (int i = 0; i < 2; ++i) { int R, C; stage_rc(tid * 16 + i * 8192, R, C); const int Rb = Epi::PERM ? ((R & ~31) + perm32(R & 31)) : R; Rr[i] = R; Cc[i] = C;
        voffA[i] = (unsigned)(R * K + C) * 2u; voffB[i] = (unsigned)(Rb * K + C) * 2u; }
    unsigned vAc[2][2], vAn[2][2];
    const size_t kstep = (size_t)(BK * 2);
    const size_t hstep = (size_t)HALF * K * 2;
    const size_t tstep = 2 * hstep;
    const unsigned ldsw = (unsigned)wid * 1024u;
    const int aoff = lds_byte(wr * 64 + fr, fq * 8), boff = lds_byte(wc * 32 + fr, fq * 8);
#define PG8_SA(b, h) (((b) * 2 + (h)) * HTB)
#define PG8_SB(b, h) ((4 + (b) * 2 + (h)) * HTB)
#define PG8_STAGE(bufoff, gbase, voff) do { _Pragma("unroll") for (int _i = 0; _i < 2; ++_i) \
        __builtin_amdgcn_global_load_lds((const unsigned*)((const char*)(gbase) + (voff)[_i]), (PG8_LAS unsigned*)(lds + (bufoff) + ldsw + _i * 8192), 16, 0, 0); } while (0)
#define PG8_STAGE_A(bufoff, hh, dbase, kbytes, vsel) do { if constexpr (GATHER) { PG8_STAGE(bufoff, (const char*)g.A + (kbytes), (vsel)[hh]); } else { PG8_STAGE(bufoff, (dbase) + ((hh) ? hstep : 0), voffA); } } while (0)
#define PG8_GATHER_OFF(dst, un) do { _Pragma("unroll") for (int _h = 0; _h < 2; ++_h) _Pragma("unroll") for (int _i = 0; _i < 2; ++_i) \
        (dst)[_h][_i] = (unsigned)rowtok[(un).pm * BM + _h * HALF + Rr[_i]] * (unsigned)(K * 2) + (unsigned)(Cc[_i] * 2); } while (0)
#define PG8_LDA(dst, b, h) do { _Pragma("unroll") for (int m = 0; m < 4; ++m) _Pragma("unroll") for (int k = 0; k < 2; ++k) dst[m][k] = *(const PG8_LAS bf16x8*)(lds + PG8_SA(b, h) + aoff + m * 2048 + k * 1024); } while (0)
#define PG8_LDB(dst, b, h) do { _Pragma("unroll") for (int n = 0; n < 2; ++n) _Pragma("unroll") for (int k = 0; k < 2; ++k) dst[n][k] = *(const PG8_LAS bf16x8*)(lds + PG8_SB(b, h) + boff + n * 2048 + k * 1024); } while (0)
#define PG8_MMA(ai, bj, At, Bt) do { __builtin_amdgcn_s_setprio(1); _Pragma("unroll") for (int m = 0; m < 4; ++m) _Pragma("unroll") for (int n = 0; n < 2; ++n) _Pragma("unroll") for (int k = 0; k < 2; ++k) \
        acc[ai][bj][m][n] = __builtin_amdgcn_mfma_f32_16x16x32_bf16(Bt[n][k], At[m][k], acc[ai][bj][m][n], 0, 0, 0); __builtin_amdgcn_s_setprio(0); } while (0)
#define PG8_WAIT_V(n) asm volatile("s_waitcnt vmcnt(" #n ")" ::: "memory")
#define PG8_WAIT_L(n) asm volatile("s_waitcnt lgkmcnt(" #n ")" ::: "memory")
#define PG8_BAR __builtin_amdgcn_s_barrier()
#define PG8_SCHED __builtin_amdgcn_sched_barrier(0)
    Unit cur, nxt; int ui = 0;
    if (!S.next(0, cur)) return;
    f32x4 acc[2][2][4][2];
#pragma unroll
    for (int a = 0; a < 2; ++a)
#pragma unroll
        for (int b = 0; b < 2; ++b)
#pragma unroll
            for (int m = 0; m < 4; ++m)
#pragma unroll
                for (int n = 0; n < 2; ++n) acc[a][b][m][n] = (f32x4){0.f, 0.f, 0.f, 0.f};
    bf16x8 At[4][2], B0[2][2], B1[2][2];
    const char* cA = (const char*)g.A + (GATHER ? (size_t)0 : (size_t)cur.pm * tstep); const char* cB = (const char*)g.Bt + (size_t)cur.pn * tstep;
    if constexpr (GATHER) { PG8_GATHER_OFF(vAc, cur); }
    PG8_STAGE(PG8_SB(0, 0), cB, voffB); PG8_STAGE_A(PG8_SA(0, 0), 0, cA, 0, vAc); PG8_STAGE(PG8_SB(0, 1), cB + hstep, voffB); PG8_STAGE_A(PG8_SA(0, 1), 1, cA, 0, vAc);
    if (wr == 1) PG8_BAR;
    PG8_WAIT_V(4); PG8_BAR;
    PG8_STAGE(PG8_SB(1, 0), cB + kstep, voffB); PG8_STAGE_A(PG8_SA(1, 0), 0, cA + kstep, kstep, vAc); PG8_STAGE(PG8_SB(1, 1), cB + hstep + kstep, voffB);
    PG8_WAIT_V(6); PG8_BAR;
    for (;;) {
        const bool has_next = S.next(ui + 1, nxt);
        const char* nA = (has_next && !GATHER) ? (const char*)g.A + (size_t)nxt.pm * tstep : cA; const char* nB = has_next ? (const char*)g.Bt + (size_t)nxt.pn * tstep : cB;
        if constexpr (GATHER) { if (has_next) { PG8_GATHER_OFF(vAn, nxt); } else {
#pragma unroll
            for (int _h = 0; _h < 2; ++_h)
#pragma unroll
                for (int _i = 0; _i < 2; ++_i) vAn[_h][_i] = vAc[_h][_i]; } }
        for (int t = 0; t < nt; t += 2) {
            const bool last = (t == nt - 2);
            const size_t k1 = (size_t)(t + 1) * kstep, k2 = last ? 0 : (size_t)(t + 2) * kstep, k3 = k2 + kstep;
            const char* a1 = cA + k1;
            const char* a2 = last ? nA : cA + (size_t)(t + 2) * kstep; const char* b2 = last ? nB : cB + (size_t)(t + 2) * kstep;
            const char* a3 = a2 + kstep; const char* b3 = b2 + kstep;
            unsigned vs[2][2];
#pragma unroll
            for (int _h = 0; _h < 2; ++_h)
#pragma unroll
                for (int _i = 0; _i < 2; ++_i) vs[_h][_i] = last ? vAn[_h][_i] : vAc[_h][_i];
            PG8_LDB(B0, 0, 0); PG8_SCHED; PG8_LDA(At, 0, 0); PG8_STAGE_A(PG8_SA(1, 1), 1, a1, k1, vAc);
            PG8_WAIT_L(8); PG8_BAR; PG8_WAIT_L(0); PG8_MMA(0, 0, At, B0); PG8_BAR; PG8_SCHED;
            PG8_LDB(B1, 0, 1); PG8_STAGE(PG8_SB(0, 0), b2, voffB);
            PG8_BAR; PG8_WAIT_L(0); PG8_MMA(0, 1, At, B1); PG8_BAR;
            PG8_LDA(At, 0, 1); PG8_STAGE_A(PG8_SA(0, 0), 0, a2, k2, vs);
            PG8_BAR; PG8_WAIT_L(0); PG8_MMA(1, 0, At, B0); PG8_BAR; PG8_SCHED;
            PG8_STAGE(PG8_SB(0, 1), b2 + hstep, voffB);
            PG8_WAIT_V(6); PG8_BAR; PG8_MMA(1, 1, At, B1); PG8_BAR;
            PG8_LDB(B0, 1, 0); PG8_SCHED; PG8_LDA(At, 1, 0); PG8_STAGE_A(PG8_SA(0, 1), 1, a2, k2, vs);
            PG8_WAIT_L(8); PG8_BAR; PG8_WAIT_L(0); PG8_MMA(0, 0, At, B0); PG8_BAR; PG8_SCHED;
            PG8_LDB(B1, 1, 1); PG8_STAGE(PG8_SB(1, 0), b3, voffB);
            PG8_BAR; PG8_WAIT_L(0); PG8_MMA(0, 1, At, B1); PG8_BAR;
            PG8_LDA(At, 1, 1); PG8_STAGE_A(PG8_SA(1, 0), 0, a3, k3, vs);
            PG8_BAR; PG8_WAIT_L(0); PG8_MMA(1, 0, At, B0); PG8_BAR; PG8_SCHED;
            PG8_STAGE(PG8_SB(1, 1), b3 + hstep, voffB);
            PG8_WAIT_V(6); PG8_BAR; PG8_MMA(1, 1, At, B1); PG8_BAR;
        }
        E(acc, cur, wr, wc, fr, fq);
        if (!has_next) break;
#pragma unroll
        for (int a = 0; a < 2; ++a)
#pragma unroll
            for (int b = 0; b < 2; ++b)
#pragma unroll
                for (int m = 0; m < 4; ++m)
#pragma unroll
                    for (int n = 0; n < 2; ++n) acc[a][b][m][n] = (f32x4){0.f, 0.f, 0.f, 0.f};
        cur = nxt; cA = nA; cB = nB; ++ui;
        if constexpr (GATHER) {
#pragma unroll
            for (int _h = 0; _h < 2; ++_h)
#pragma unroll
                for (int _i = 0; _i < 2; ++_i) vAc[_h][_i] = vAn[_h][_i]; }
    }
    PG8_WAIT_V(0);
    if (wr == 0) PG8_BAR;
    PG8_BAR;
#undef PG8_SA
#undef PG8_SB
#undef PG8_STAGE
#undef PG8_STAGE_A
#undef PG8_GATHER_OFF
#undef PG8_LDA
#undef PG8_LDB
#undef PG8_MMA
#undef PG8_WAIT_V
#undef PG8_WAIT_L
#undef PG8_BAR
#undef PG8_SCHED
}
}

struct Args {
    const float* in[29];
    float* out; unsigned char* ws;
    int ph_lo, ph_hi;
};
enum { I_X = 0, I_MEM, I_NMIXG, I_NMEMG, I_WIN, I_WMK, I_WMV, I_CONVW, I_CONVB, I_CLNG, I_CLNB, I_SHIFTMU, I_DW0, I_DUP, I_IA0, I_IUP, I_GUP, I_KK, I_KA, I_RK,
       I_LNXG, I_LNXB, I_WOUT, I_NFFNG, I_WROUTER, I_WEG, I_WEU, I_WED, I_FNG };

__device__ __forceinline__ void transpose_item(const float* W, int N, bf16_t* WT, int K, int k0, int n0, int drow0, LAS float* scr, int lane) {
#pragma unroll 8
    for (int i = 0; i < 32; ++i) { const int kk = 2 * i + (lane >> 5); scr[kk * 33 + (lane & 31)] = W[(size_t)(k0 + kk) * N + n0 + (lane & 31)]; }
    asm volatile("s_waitcnt lgkmcnt(0)" ::: "memory");
    const int c = lane & 7;
#pragma unroll
    for (int j = 0; j < 4; ++j) { const int n = (lane >> 3) + 8 * j; const LAS float* s = scr + (8 * c) * 33 + n;
        u32x4 o; o.x = pk_bf16(s[0 * 33], s[1 * 33]); o.y = pk_bf16(s[2 * 33], s[3 * 33]); o.z = pk_bf16(s[4 * 33], s[5 * 33]); o.w = pk_bf16(s[6 * 33], s[7 * 33]);
        *(u32x4*)(WT + (size_t)(drow0 + n) * K + k0 + 8 * c) = o; }
    asm volatile("s_waitcnt lgkmcnt(0)" ::: "memory");
}
__device__ __forceinline__ void rms_row_to_bf16(const float* xrow, const float* g, bf16_t* orow, int lane) {
    const f32x4* xr = (const f32x4*)xrow + lane; const f32x4* gr = (const f32x4*)g + lane;
    f32x4 v[4]; float s = 0.f;
#pragma unroll
    for (int j = 0; j < 4; ++j) { v[j] = xr[64 * j]; s += (v[j].x * v[j].x + v[j].y * v[j].y) + (v[j].z * v[j].z + v[j].w * v[j].w); }
    const float rs = 1.0f / sqrtf(wave_sum(s) * (1.f / D) + 1e-6f);
    u32x2* o8 = (u32x2*)orow + lane;
#pragma unroll
    for (int j = 0; j < 4; ++j) { const f32x4 gg = gr[64 * j]; u32x2 w; w.x = pk_bf16(v[j].x * rs * gg.x, v[j].y * rs * gg.y); w.y = pk_bf16(v[j].z * rs * gg.z, v[j].w * rs * gg.w); o8[64 * j] = w; }
}
__device__ __forceinline__ void phase_prep(const Args& a, LAS unsigned char* lds, int G) {
    const int tid = threadIdx.x, lane = tid & 63, wave = __builtin_amdgcn_readfirstlane(tid >> 6);
    LAS float* scr = (LAS float*)(lds + wave * 16384);
    const int gw = blockIdx.x * 8 + wave, NGW = G * 8;
    unsigned char* ws = a.ws;
    constexpr int S_WIN = 16 * 80, S_WOUT = 16 * 32, S_MK = 16 * 8, S_SM = 12, S_GUP = 24, S_EXP = 16 * 16 * 32;
    constexpr int NITEMS = S_WIN + S_WOUT + 2 * S_MK + 4 * S_SM + S_GUP + 3 * S_EXP;
    for (int it = gw; it < NITEMS; it += NGW) {
        int r = it;
        if (r < S_WIN) { const int kb = r / 80, nb = r % 80; transpose_item(a.in[I_WIN], IN_PROJ, (bf16_t*)(ws + WS_WINT), D, kb * 64, nb * 32, nb * 32, scr, lane); continue; } r -= S_WIN;
        if (r < S_WOUT) { const int kb = r / 32, nb = r % 32; transpose_item(a.in[I_WOUT], D, (bf16_t*)(ws + WS_WOUTT), D, kb * 64, nb * 32, nb * 32, scr, lane); continue; } r -= S_WOUT;
        if (r < S_MK) { const int kb = r / 8, nb = r % 8; transpose_item(a.in[I_WMK], 256, (bf16_t*)(ws + WS_WKT), D, kb * 64, nb * 32, nb * 32, scr, lane); continue; } r -= S_MK;
        if (r < S_MK) { const int kb = r / 8, nb = r % 8; transpose_item(a.in[I_WMV], 256, (bf16_t*)(ws + WS_WVT), D, kb * 64, nb * 32, nb * 32, scr, lane); continue; } r -= S_MK;
        if (r < 4 * S_SM) { const int which = r / S_SM, nb = r % S_SM;
            const float* src = (which < 2 ? a.in[I_DUP] : a.in[I_IUP]) + (size_t)(which & 1) * 64 * RW;
            transpose_item(src, RW, (bf16_t*)(ws + WS_SMALL) + (size_t)which * RW * 64, 64, 0, nb * 32, nb * 32, scr, lane); continue; } r -= 4 * S_SM;
        if (r < S_GUP) { const int kb = r / 12, nb = r % 12; transpose_item(a.in[I_GUP], RW, (bf16_t*)(ws + WS_SMALL) + (size_t)4 * RW * 64, 128, kb * 64, nb * 32, nb * 32, scr, lane); continue; } r -= S_GUP;
        { const int which = r / S_EXP, q = r % S_EXP, e = q / 512, kb = (q % 512) / 32, nb = q % 32, n0 = nb * 32;
          if (which == 0) transpose_item(a.in[I_WEG] + (size_t)e * D * FF, FF, (bf16_t*)(ws + WS_WGUT) + (size_t)e * 2048 * D, D, kb * 64, n0, (n0 >> 7) * 256 + (n0 & 127), scr, lane);
          else if (which == 1) transpose_item(a.in[I_WEU] + (size_t)e * D * FF, FF, (bf16_t*)(ws + WS_WGUT) + (size_t)e * 2048 * D, D, kb * 64, n0, (n0 >> 7) * 256 + 128 + (n0 & 127), scr, lane);
          else transpose_item(a.in[I_WED] + (size_t)e * FF * D, D, (bf16_t*)(ws + WS_WDT) + (size_t)e * D * FF, FF, kb * 64, n0, n0, scr, lane); }
    }
    for (int m = gw; m < T; m += NGW) rms_row_to_bf16(a.in[I_X] + (size_t)m * D, a.in[I_NMIXG], (bf16_t*)(ws + WS_XH) + (size_t)m * D, lane);
    for (int m = gw; m < BATCH * NMEM; m += NGW) rms_row_to_bf16(a.in[I_MEM] + (size_t)m * D, a.in[I_NMEMG], (bf16_t*)(ws + WS_MEMN) + (size_t)m * D, lane);
}

constexpr int AT_KS = 144;
constexpr int AT_VS = 520;
constexpr int AT_VOFF = 256 * AT_KS;
__device__ __forceinline__ bf16x8 pack_step(const f32x16& x, int s) {
    u32x4 p;
    asm volatile("v_cvt_pk_bf16_f32 %0, %4, %5\n\tv_cvt_pk_bf16_f32 %1, %6, %7\n\tv_cvt_pk_bf16_f32 %2, %8, %9\n\tv_cvt_pk_bf16_f32 %3, %10, %11\n\ts_nop 1"
                 : "=&v"(p[0]), "=&v"(p[1]), "=&v"(p[2]), "=&v"(p[3])
                 : "v"(x[8 * s]), "v"(x[8 * s + 1]), "v"(x[8 * s + 2]), "v"(x[8 * s + 3]), "v"(x[8 * s + 4]), "v"(x[8 * s + 5]), "v"(x[8 * s + 6]), "v"(x[8 * s + 7]));
    return __builtin_bit_cast(bf16x8, p);
}
__device__ __forceinline__ void attn_unit(const Args& a, LAS unsigned char* lds, int unit) {
    const int tid = threadIdx.x, lane = tid & 63, wave = __builtin_amdgcn_readfirstlane(tid >> 6), r = lane & 31, h = lane >> 5;
    const int b = unit >> 6, hh = (unit >> 4) & 3, tile = unit & 15;
    const bf16_t* P = (const bf16_t*)(a.ws + WS_P); const bf16_t* KM = (const bf16_t*)(a.ws + WS_KMEM); const bf16_t* VT = (const bf16_t*)(a.ws + WS_VT);
    bf16_t* MIX = (bf16_t*)(a.ws + WS_MIX);
    __syncthreads();
#pragma unroll
    for (int i = 0; i < 4; ++i) { const int c = tid + 512 * i, key = c >> 3, ch = c & 7;
        const u32x4 v = *(const u32x4*)(KM + (size_t)(b * NMEM + key) * 256 + hh * 64 + ch * 8);
        *(LAS u32x4*)(lds + key * AT_KS + ch * 16) = v; }
#pragma unroll
    for (int i = 0; i < 4; ++i) { const int c = tid + 512 * i, d = c >> 5, ch = c & 31;
        const u32x4 v = *(const u32x4*)(VT + (size_t)(hh * 64 + d) * (BATCH * NMEM) + b * NMEM + ch * 8);
        LAS u32x2* dst = (LAS u32x2*)(lds + AT_VOFF + d * AT_VS + ch * 16);
        dst[0] = (u32x2){v.x, v.y}; dst[1] = (u32x2){v.z, v.w}; }
    const int tok0 = b * SEQ + tile * 256 + wave * 32;
    bf16x8 qf[4];
#pragma unroll
    for (int ks = 0; ks < 4; ++ks) qf[ks] = *(const bf16x8*)(P + (size_t)(tok0 + r) * IN_PROJ + hh * 64 + ks * 16 + h * 8);
    __syncthreads();
    f32x16 s[8];
#pragma unroll
    for (int kt = 0; kt < 8; ++kt) {
#pragma unroll
        for (int i = 0; i < 16; ++i) s[kt][i] = 0.f;
#pragma unroll
        for (int ks = 0; ks < 4; ++ks) { const bf16x8 ka = *(const LAS bf16x8*)(lds + (kt * 32 + r) * AT_KS + (ks * 16 + h * 8) * 2);
            s[kt] = __builtin_amdgcn_mfma_f32_32x32x16_bf16(ka, qf[ks], s[kt], 0, 0, 0); }
    }
    float mx = -3.0e38f;
#pragma unroll
    for (int kt = 0; kt < 8; ++kt)
#pragma unroll
        for (int i = 0; i < 16; ++i) mx = fmaxf(mx, s[kt][i]);
    mx = fmaxf(mx, __shfl_xor(mx, 32));
    const float sc = 0.125f * 1.4426950408889634f; float sum = 0.f;
#pragma unroll
    for (int kt = 0; kt < 8; ++kt)
#pragma unroll
        for (int i = 0; i < 16; ++i) { const float e = __builtin_amdgcn_exp2f((s[kt][i] - mx) * sc); s[kt][i] = e; sum += e; }
    sum += __shfl_xor(sum, 32);
    f32x16 o[2];
#pragma unroll
    for (int dt = 0; dt < 2; ++dt)
#pragma unroll
        for (int i = 0; i < 16; ++i) o[dt][i] = 0.f;
#pragma unroll
    for (int kt = 0; kt < 8; ++kt)
#pragma unroll
        for (int s2 = 0; s2 < 2; ++s2) {
            const bf16x8 pb = pack_step(s[kt], s2);
#pragma unroll
            for (int dt = 0; dt < 2; ++dt) {
                const LAS unsigned char* vp = lds + AT_VOFF + (32 * dt + r) * AT_VS + (32 * kt + 16 * s2 + 4 * h) * 2;
                const s16x4 lo = *(const LAS s16x4*)vp, hi = *(const LAS s16x4*)(vp + 16);
                const bf16x8 va = __builtin_shufflevector(lo, hi, 0, 1, 2, 3, 4, 5, 6, 7);
                o[dt] = __builtin_amdgcn_mfma_f32_32x32x16_bf16(va, pb, o[dt], 0, 0, 0);
            }
        }
    const float inv = 1.0f / sum;
    bf16_t* orow = MIX + (size_t)(tok0 + r) * D + hh * 64;
#pragma unroll
    for (int dt = 0; dt < 2; ++dt)
#pragma unroll
        for (int gq = 0; gq < 4; ++gq) { u32x2 w; w.x = pk_bf16(o[dt][4 * gq] * inv, o[dt][4 * gq + 1] * inv); w.y = pk_bf16(o[dt][4 * gq + 2] * inv, o[dt][4 * gq + 3] * inv);
            *(u32x2*)(orow + 32 * dt + 8 * gq + 4 * h) = w; }
}

__device__ __forceinline__ void conv_unit(const Args& a, LAS unsigned char* lds, int unit) {
    const int tid = threadIdx.x, lane = tid & 63, wave = __builtin_amdgcn_readfirstlane(tid >> 6);
    const int b = unit >> 6, t0 = (unit & 63) * 64;
    const bf16_t* P = (const bf16_t*)(a.ws + WS_P); bf16_t* MIX = (bf16_t*)(a.ws + WS_MIX);
    LAS _Float16* U = (LAS _Float16*)lds;
    LAS _Float16* Cc = (LAS _Float16*)(lds + 94 * CW * 2);
    __syncthreads();
    for (int q = tid; q < 94 * 48; q += NTHREADS) { const int j = q / 48, cc = (q % 48) * 8, s = t0 - 15 + j;
        float u[8];
        if (s >= 0 && s < SEQ) { const bf16_t* row = P + (size_t)(b * SEQ + s) * IN_PROJ + 256 + cc;
            const u32x4 vv = *(const u32x4*)row, gg = *(const u32x4*)(row + CW);
            const unsigned vw[4] = {vv.x, vv.y, vv.z, vv.w}, gw[4] = {gg.x, gg.y, gg.z, gg.w};
#pragma unroll
            for (int k = 0; k < 4; ++k) { u[2 * k] = bf_lo(vw[k]) * sigmoidf_fast(bf_lo(gw[k])); u[2 * k + 1] = bf_hi(vw[k]) * sigmoidf_fast(bf_hi(gw[k])); }
        } else {
#pragma unroll
            for (int k = 0; k < 8; ++k) u[k] = 0.f; }
        LAS f16x4* dst = (LAS f16x4*)(U + j * CW + cc); dst[0] = (f16x4){(_Float16)u[0], (_Float16)u[1], (_Float16)u[2], (_Float16)u[3]}; dst[1] = (f16x4){(_Float16)u[4], (_Float16)u[5], (_Float16)u[6], (_Float16)u[7]}; }
    __syncthreads();
    const int cq = tid & 127, tq = tid >> 7;
#pragma unroll 1
    for (int k3 = 0; k3 < 3; ++k3) { const int c = cq + 128 * k3;
        float w[31], res[16];
#pragma unroll
        for (int kk = 0; kk < 31; ++kk) w[kk] = a.in[I_CONVW][kk * CW + c];
        const float bias = a.in[I_CONVB][c];
#pragma unroll
        for (int tt = 0; tt < 16; ++tt) res[tt] = bias;
#pragma unroll
        for (int jj = 0; jj < 46; ++jj) { const float uv = (float)U[(tq * 16 + jj) * CW + c];
#pragma unroll
            for (int tt = 0; tt < 16; ++tt) { if (jj - tt >= 0 && jj - tt <= 30) res[tt] += uv * w[jj - tt]; } }
#pragma unroll
        for (int tt = 0; tt < 16; ++tt) Cc[(tq * 16 + tt) * CW + c] = (_Float16)res[tt];
    }
    __syncthreads();
    for (int tt = 0; tt < 8; ++tt) { const int t = wave * 8 + tt;
        float v[6]; float s = 0.f;
#pragma unroll
        for (int i = 0; i < 6; ++i) { v[i] = (float)Cc[t * CW + lane + 64 * i]; s += v[i]; }
        const float mean = wave_sum(s) * (1.f / CW); float q = 0.f;
#pragma unroll
        for (int i = 0; i < 6; ++i) { v[i] -= mean; q += v[i] * v[i]; }
        const float rstd = 1.0f / sqrtf(wave_sum(q) * (1.f / CW) + 1e-5f);
        bf16_t* orow = MIX + (size_t)(b * SEQ + t0 + t) * D + 256;
#pragma unroll
        for (int i = 0; i < 6; ++i) { const int c = lane + 64 * i; const float y = v[i] * rstd * a.in[I_CLNG][c] + a.in[I_CLNB][c]; const float o = y * sigmoidf_fast(y);
            orow[c] = (bf16_t)(pk_bf16(o, 0.f) & 0xffffu); }
    }
}

constexpr int PR_AS = 784;
__device__ __forceinline__ void prep_unit(const Args& a, LAS unsigned char* lds, int unit) {
    const int tid = threadIdx.x, lane = tid & 63, wave = __builtin_amdgcn_readfirstlane(tid >> 6);
    const int b = unit >> 6, t0 = (unit & 63) * 64;
    const bf16_t* P = (const bf16_t*)(a.ws + WS_P);
    _Float16* SC = (_Float16*)(a.ws + WS_SCAN);
    const float* mu = a.in[I_SHIFTMU];
    __syncthreads();
    for (int q = tid; q < 64 * 192; q += NTHREADS) { const int tt = q / 192, c8 = (q % 192) * 8, s = t0 + tt; const size_t tok = (size_t)b * SEQ + s;
        const bf16_t* row = P + tok * IN_PROJ + 1024 + c8;
        const u32x4 cu = *(const u32x4*)row;
        u32x4 pv = {0u, 0u, 0u, 0u}, nv = {0u, 0u, 0u, 0u};
        if (s > 0) pv = *(const u32x4*)(row - IN_PROJ);
        if (s < SEQ - 1) nv = *(const u32x4*)(row + IN_PROJ);
        const unsigned cw[4] = {cu.x, cu.y, cu.z, cu.w}, pw[4] = {pv.x, pv.y, pv.z, pv.w}, nw[4] = {nv.x, nv.y, nv.z, nv.w};
        const f32x4 m0a = *(const f32x4*)(mu + c8), m0b = *(const f32x4*)(mu + c8 + 4), m1a = *(const f32x4*)(mu + 1536 + c8), m1b = *(const f32x4*)(mu + 1536 + c8 + 4);
        const float m0[8] = {m0a.x, m0a.y, m0a.z, m0a.w, m0b.x, m0b.y, m0b.z, m0b.w}, m1[8] = {m1a.x, m1a.y, m1a.z, m1a.w, m1b.x, m1b.y, m1b.z, m1b.w};
        float pf[8];
#pragma unroll
        for (int k = 0; k < 4; ++k) { const float c0 = bf_lo(cw[k]), c1 = bf_hi(cw[k]);
            pf[2 * k] = c0 + m0[2 * k] * (bf_lo(pw[k]) - c0) + m1[2 * k] * (bf_lo(nw[k]) - c0);
            pf[2 * k + 1] = c1 + m0[2 * k + 1] * (bf_hi(pw[k]) - c1) + m1[2 * k + 1] * (bf_hi(nw[k]) - c1); }
        if (c8 < 1152) {
            const int arr = c8 / RW, cc = c8 % RW;
            f16x4 h0 = {(_Float16)pf[0], (_Float16)pf[1], (_Float16)pf[2], (_Float16)pf[3]}, h1 = {(_Float16)pf[4], (_Float16)pf[5], (_Float16)pf[6], (_Float16)pf[7]};
            f16x4* dst = (f16x4*)((unsigned char*)SC + (size_t)arr * SCAN_STRIDE) + (tok * RW + cc) / 4; dst[0] = h0; dst[1] = h1;
        } else {
            const int cc = c8 - 1152;
#pragma unroll
            for (int k = 0; k < 8; ++k) { if (cc < 128) pf[k] = tanhf(pf[k]); else if (cc >= 256) pf[k] = sigmoidf_fast(pf[k]); }
            u32x4 w; w.x = pk_bf16(pf[0], pf[1]); w.y = pk_bf16(pf[2], pf[3]); w.z = pk_bf16(pf[4], pf[5]); w.w = pk_bf16(pf[6], pf[7]);
            *(LAS u32x4*)(lds + tt * PR_AS + cc * 2) = w; }
    }
    __syncthreads();
    const int l15 = lane & 15, kq = lane >> 4, ch0 = wave * 48;
    const bf16_t* SM = (const bf16_t*)(a.ws + WS_SMALL);
#pragma unroll 1
    for (int o = 0; o < 5; ++o) {
        const int kbase = (o < 4) ? o * 64 : 256, KD = (o < 4) ? 64 : 128;
        const bf16_t* WTm = (o < 4) ? SM + (size_t)o * RW * 64 : SM + (size_t)4 * RW * 64;
        f32x4 acc[4][3];
#pragma unroll
        for (int mt = 0; mt < 4; ++mt)
#pragma unroll
            for (int nt = 0; nt < 3; ++nt) acc[mt][nt] = (f32x4){0.f, 0.f, 0.f, 0.f};
        for (int ks = 0; ks < KD / 32; ++ks) {
            bf16x8 bfr[3], afr[4];
#pragma unroll
            for (int nt = 0; nt < 3; ++nt) bfr[nt] = *(const bf16x8*)(WTm + (size_t)(ch0 + nt * 16 + l15) * KD + ks * 32 + kq * 8);
#pragma unroll
            for (int mt = 0; mt < 4; ++mt) afr[mt] = *(const LAS bf16x8*)(lds + (mt * 16 + l15) * PR_AS + (kbase + ks * 32 + kq * 8) * 2);
#pragma unroll
            for (int mt = 0; mt < 4; ++mt)
#pragma unroll
                for (int nt = 0; nt < 3; ++nt) acc[mt][nt] = __builtin_amdgcn_mfma_f32_16x16x32_bf16(afr[mt], bfr[nt], acc[mt][nt], 0, 0, 0);
        }
#pragma unroll
        for (int nt = 0; nt < 3; ++nt) { const int ch = ch0 + nt * 16 + l15;
            float bias = 0.f;
            if (o < 2) bias = a.in[I_DW0][o * RW + ch]; else if (o < 4) bias = a.in[I_IA0][(o - 2) * RW + ch];
#pragma unroll
            for (int mt = 0; mt < 4; ++mt)
#pragma unroll
                for (int rg = 0; rg < 4; ++rg) { const size_t tok = (size_t)b * SEQ + t0 + mt * 16 + kq * 4 + rg; const float z = acc[mt][nt][rg] + bias;
                    if (o < 2) { const float w = __builtin_amdgcn_exp2f(-0.606531f * 1.4426950408889634f * sigmoidf_fast(z)); ((_Float16*)((unsigned char*)SC + (size_t)(3 + o) * SCAN_STRIDE))[tok * RW + ch] = (_Float16)w; }
                    else if (o < 4) { ((_Float16*)((unsigned char*)SC + (size_t)(3 + o) * SCAN_STRIDE))[tok * RW + ch] = (_Float16)sigmoidf_fast(z); }
                    else { ((bf16_t*)(a.ws + WS_G))[tok * RW + ch] = (bf16_t)(pk_bf16(z, 0.f) & 0xffffu); } }
        }
    }
}

constexpr int SC_CT = 32;
constexpr int SC_JV = SC_CT * 8 * 40 * 4;
constexpr int SC_VV = SC_CT * 64 * 4;
constexpr int SC_SC = SC_CT * 2 * 4;
constexpr int SC_Y = SC_CT * 64 * 4;
constexpr int SC_BUF = SC_JV + SC_VV + SC_SC + SC_Y;
struct ScanRegs { f16x4 r, k, v, w, a; };
__device__ __forceinline__ void scan_unit(const Args& a, LAS unsigned char* lds, int unit) {
    const int tid = threadIdx.x, lane = tid & 63, wave = __builtin_amdgcn_readfirstlane(tid >> 6);
    const int dir = unit & 1, bh = unit >> 1, b = bh / NH, hd = bh % NH;
    const _Float16* SCb = (const _Float16*)(a.ws + WS_SCAN);
    const _Float16* Rg = SCb; const _Float16* Kg = (const _Float16*)((const unsigned char*)SCb + SCAN_STRIDE); const _Float16* Vg = (const _Float16*)((const unsigned char*)SCb + 2 * SCAN_STRIDE);
    const _Float16* Wg = (const _Float16*)((const unsigned char*)SCb + (size_t)(3 + dir) * SCAN_STRIDE); const _Float16* Ag = (const _Float16*)((const unsigned char*)SCb + (size_t)(5 + dir) * SCAN_STRIDE);
    float* Yg = (float*)(a.ws + (dir ? WS_YB : WS_YF)); float* BON = (float*)(a.ws + WS_BON) + (size_t)dir * T * NH;
    const int ls = tid >> 4, lq = tid & 15, chl = hd * 64 + 4 * lq;
    const f32x4 kkw = *(const f32x4*)(a.in[I_KK] + chl), kaw = *(const f32x4*)(a.in[I_KA] + chl), rkw = *(const f32x4*)(a.in[I_RK] + chl);
    const int jg = lane & 7, row = wave * 8 + (lane >> 3);
    float S[8];
#pragma unroll
    for (int j = 0; j < 8; ++j) S[j] = 0.f;
    constexpr int NCK = SEQ / SC_CT;
    ScanRegs rg;
#define SCAN_LOAD(ck) do { const int st_ = (ck) * SC_CT + ls; const int t_ = dir ? (SEQ - 1 - st_) : st_; const size_t e_ = ((size_t)b * SEQ + t_) * RW + chl; \
        rg.r = *(const f16x4*)(Rg + e_); rg.k = *(const f16x4*)(Kg + e_); rg.v = *(const f16x4*)(Vg + e_); rg.w = *(const f16x4*)(Wg + e_); rg.a = *(const f16x4*)(Ag + e_); } while (0)
#define SCAN_PROC(ck, buf) do { LAS unsigned char* B_ = lds + (buf) * SC_BUF; \
        const f32x4 r_ = __builtin_convertvector(rg.r, f32x4), k_ = __builtin_convertvector(rg.k, f32x4), v_ = __builtin_convertvector(rg.v, f32x4), w_ = __builtin_convertvector(rg.w, f32x4), a_ = __builtin_convertvector(rg.a, f32x4); \
        f32x4 kk_ = k_ * kkw; float ss_ = (kk_.x * kk_.x + kk_.y * kk_.y) + (kk_.z * kk_.z + kk_.w * kk_.w); ss_ = sum16(ss_); kk_ = kk_ * (1.0f / sqrtf(ss_ + 1e-12f)); \
        const f32x4 b_ = kk_ * a_, kd_ = k_ * (1.0f + (a_ - 1.0f) * kaw), wr_ = w_ * r_; \
        float br_ = (b_.x * r_.x + b_.y * r_.y) + (b_.z * r_.z + b_.w * r_.w), kr_ = (kd_.x * r_.x + kd_.y * r_.y) + (kd_.z * r_.z + kd_.w * r_.w); \
        float bn_ = (kd_.x * r_.x * rkw.x + kd_.y * r_.y * rkw.y) + (kd_.z * r_.z * rkw.z + kd_.w * r_.w * rkw.w); \
        br_ = sum16(br_); kr_ = sum16(kr_); bn_ = sum16(bn_); \
        LAS f32x4* jv_ = (LAS f32x4*)(B_ + ls * 1280 + (lq >> 1) * 160 + (lq & 1) * 16); \
        jv_[0] = kk_; jv_[2] = wr_; jv_[4] = w_; jv_[6] = b_; jv_[8] = kd_; \
        *(LAS f32x4*)(B_ + SC_JV + ls * 256 + lq * 16) = v_; \
        if (lq == 0) { *(LAS f32x2*)(B_ + SC_JV + SC_VV + ls * 8) = (f32x2){br_, kr_}; const int st_ = (ck) * SC_CT + ls; const int t_ = dir ? (SEQ - 1 - st_) : st_; BON[((size_t)b * SEQ + t_) * NH + hd] = bn_; } } while (0)
    __syncthreads();
    SCAN_LOAD(0); SCAN_PROC(0, 0);
    __syncthreads();
#pragma unroll 1
    for (int ck = 0; ck < NCK; ++ck) {
        const int buf = ck & 1;
        if (ck + 1 < NCK) SCAN_LOAD(ck + 1);
        const LAS unsigned char* Bc = lds + buf * SC_BUF;
#pragma unroll 4
        for (int st = 0; st < SC_CT; ++st) {
            const LAS f32x4* jv = (const LAS f32x4*)(Bc + st * 1280 + jg * 160);
            const f32x4 kk0 = jv[0], kk1 = jv[1], wr0 = jv[2], wr1 = jv[3], w0 = jv[4], w1 = jv[5], b0 = jv[6], b1 = jv[7], kd0 = jv[8], kd1 = jv[9];
            const float vi = *(const LAS float*)(Bc + SC_JV + st * 256 + row * 4);
            const f32x2 sc2 = *(const LAS f32x2*)(Bc + SC_JV + SC_VV + st * 8);
            float sa = (S[0] * kk0.x + S[1] * kk0.y) + (S[2] * kk0.z + S[3] * kk0.w) + (S[4] * kk1.x + S[5] * kk1.y) + (S[6] * kk1.z + S[7] * kk1.w);
            float yp = (S[0] * wr0.x + S[1] * wr0.y) + (S[2] * wr0.z + S[3] * wr0.w) + (S[4] * wr1.x + S[5] * wr1.y) + (S[6] * wr1.z + S[7] * wr1.w);
            sa = -sum8(sa); yp = sum8(yp);
            const float y = yp + sa * sc2.x + vi * sc2.y;
            S[0] = S[0] * w0.x + (sa * b0.x + vi * kd0.x); S[1] = S[1] * w0.y + (sa * b0.y + vi * kd0.y); S[2] = S[2] * w0.z + (sa * b0.z + vi * kd0.z); S[3] = S[3] * w0.w + (sa * b0.w + vi * kd0.w);
            S[4] = S[4] * w1.x + (sa * b1.x + vi * kd1.x); S[5] = S[5] * w1.y + (sa * b1.y + vi * kd1.y); S[6] = S[6] * w1.z + (sa * b1.z + vi * kd1.z); S[7] = S[7] * w1.w + (sa * b1.w + vi * kd1.w);
            if (jg == 0) *(LAS float*)(lds + buf * SC_BUF + SC_JV + SC_VV + SC_SC + st * 256 + row * 4) = y;
        }
        __syncthreads();
        {
            const f32x4 yv = *(const LAS f32x4*)(lds + buf * SC_BUF + SC_JV + SC_VV + SC_SC + ls * 256 + lq * 16);
            const int st_ = ck * SC_CT + ls; const int t_ = dir ? (SEQ - 1 - st_) : st_;
            *(f32x4*)(Yg + ((size_t)b * SEQ + t_) * RW + hd * 64 + 4 * lq) = yv;
        }
        if (ck + 1 < NCK) SCAN_PROC(ck + 1, buf ^ 1);
        __syncthreads();
    }
#undef SCAN_LOAD
#undef SCAN_PROC
}

__device__ __forceinline__ void phase_post(const Args& a, int G) {
    const int tid = threadIdx.x, lane = tid & 63, wave = __builtin_amdgcn_readfirstlane(tid >> 6);
    const int gw = blockIdx.x * 8 + wave, NGW = G * 8;
    const float* YF = (const float*)(a.ws + WS_YF); const float* YB = (const float*)(a.ws + WS_YB); const float* BON = (const float*)(a.ws + WS_BON);
    const _Float16* Vg = (const _Float16*)(a.ws + WS_SCAN + 2 * SCAN_STRIDE); const bf16_t* Gg = (const bf16_t*)(a.ws + WS_G); bf16_t* MIX = (bf16_t*)(a.ws + WS_MIX);
    float* ss = (float*)(a.ws + WS_SS);
    for (int i = blockIdx.x * NTHREADS + tid; i < T; i += G * NTHREADS) ss[i] = 0.f;
    for (int tok = gw; tok < T; tok += NGW) {
#pragma unroll
        for (int hd = 0; hd < NH; ++hd) { const int ch = hd * 64 + lane; const size_t e = (size_t)tok * RW + ch;
            const float y = YF[e] + YB[e];
            const float mean = wave_sum(y) * (1.f / 64.f); const float dlt = y - mean; const float var = wave_sum(dlt * dlt) * (1.f / 64.f);
            const float yn = dlt * (1.0f / sqrtf(var + 64e-5f)) * a.in[I_LNXG][ch] + a.in[I_LNXB][ch];
            const float bon = BON[(size_t)tok * NH + hd] + BON[(size_t)T * NH + (size_t)tok * NH + hd];
            const float gv = bf_lo((unsigned)Gg[e]);
            const float o = (yn + bon * (float)Vg[e]) * gv;
            MIX[(size_t)tok * D + 640 + ch] = (bf16_t)(pk_bf16(o, 0.f) & 0xffffu); }
    }
}

__device__ __forceinline__ void phase_router(const Args& a, LAS unsigned char* lds, int G) {
    const int tid = threadIdx.x, lane = tid & 63, wave = __builtin_amdgcn_readfirstlane(tid >> 6);
    const int gw = blockIdx.x * 8 + wave, NGW = G * 8;
    LAS float* WR = (LAS float*)lds;
    for (int i = tid; i < D * NE / 4; i += NTHREADS) ((LAS f32x4*)WR)[i] = ((const f32x4*)a.in[I_WROUTER])[i];
    __syncthreads();
    const float* X1 = (const float*)(a.ws + WS_X1); const float* ss = (const float*)(a.ws + WS_SS); bf16_t* H2 = (bf16_t*)(a.ws + WS_H2);
    float* AFF = (float*)(a.ws + WS_AFF); int* INV = (int*)(a.ws + WS_INV);
    for (int tok = gw; tok < T; tok += NGW) {
        const float rs = 1.0f / sqrtf(ss[tok] * (1.f / D) + 1e-6f);
        float lg[16];
#pragma unroll
        for (int e = 0; e < 16; ++e) lg[e] = 0.f;
#pragma unroll 1
        for (int j = 0; j < 4; ++j) { const int col = 4 * lane + 256 * j; const f32x4 xv = *(const f32x4*)(X1 + (size_t)tok * D + col); const f32x4 gg = *(const f32x4*)(a.in[I_NFFNG] + col);
            const float hv[4] = {xv.x * rs * gg.x, xv.y * rs * gg.y, xv.z * rs * gg.z, xv.w * rs * gg.w};
            u32x2 w; w.x = pk_bf16(hv[0], hv[1]); w.y = pk_bf16(hv[2], hv[3]); *(u32x2*)(H2 + (size_t)tok * D + col) = w;
#pragma unroll
            for (int c = 0; c < 4; ++c) { const LAS f32x4* wr = (const LAS f32x4*)(WR + (col + c) * NE);
#pragma unroll
                for (int q = 0; q < 4; ++q) { const f32x4 wv = wr[q]; lg[4 * q] += hv[c] * wv.x; lg[4 * q + 1] += hv[c] * wv.y; lg[4 * q + 2] += hv[c] * wv.z; lg[4 * q + 3] += hv[c] * wv.w; } } }
        float mx = -3.0e38f;
#pragma unroll
        for (int e = 0; e < 16; ++e) { lg[e] = wave_sum(lg[e]); mx = fmaxf(mx, lg[e]); }
        float sum = 0.f;
#pragma unroll
        for (int e = 0; e < 16; ++e) { lg[e] = __expf(lg[e] - mx); sum += lg[e]; }
        const float inv = 1.0f / sum;
        float mine = 0.f;
#pragma unroll
        for (int e = 0; e < 16; ++e) mine = (lane == e) ? lg[e] * inv : mine;
        const int bb = tok >> 12, s = tok & (SEQ - 1);
        if (lane < 16) { AFF[((size_t)(bb * NE + lane)) * SEQ + s] = mine; INV[(size_t)tok * NE + lane] = -1; }
    }
}

__device__ __forceinline__ void topk_unit(const Args& a, LAS unsigned char* lds, int unit) {
    const int tid = threadIdx.x, lane = tid & 63, wave = __builtin_amdgcn_readfirstlane(tid >> 6);
    const int b = unit >> 4, e = unit & 15;
    const float* AFF = (const float*)(a.ws + WS_AFF) + (size_t)unit * SEQ;
    LAS unsigned* KEY = (LAS unsigned*)lds;
    LAS unsigned* HIST = (LAS unsigned*)(lds + 16384);
    LAS unsigned* CTL = (LAS unsigned*)(lds + 16384 + 1024);
    LAS unsigned* WS_ = (LAS unsigned*)(lds + 16384 + 2048);
    __syncthreads();
    unsigned key[8];
    { const u32x4 k0 = *(const u32x4*)(AFF + tid * 8), k1 = *(const u32x4*)(AFF + tid * 8 + 4); key[0] = k0.x; key[1] = k0.y; key[2] = k0.z; key[3] = k0.w; key[4] = k1.x; key[5] = k1.y; key[6] = k1.z; key[7] = k1.w; }
    if (tid == 0) { CTL[0] = 0u; CTL[1] = (unsigned)CAP; }
    unsigned prefix = 0u, mask = 0u;
#pragma unroll 1
    for (int pass = 0; pass < 4; ++pass) {
        const int shift = 24 - 8 * pass;
        if (tid < 256) HIST[tid] = 0u;
        __syncthreads();
#pragma unroll
        for (int i = 0; i < 8; ++i) if ((key[i] & mask) == prefix) (void)__hip_atomic_fetch_add(&HIST[(key[i] >> shift) & 255u], 1u, __ATOMIC_RELAXED, __HIP_MEMORY_SCOPE_WORKGROUP);
        __syncthreads();
        if (wave == 0) {
            const unsigned need = CTL[1];
            unsigned hv[4], tsum = 0u;
#pragma unroll
            for (int i = 0; i < 4; ++i) { hv[i] = HIST[255 - (4 * lane + i)]; tsum += hv[i]; }
            unsigned inc = tsum;
#pragma unroll
            for (int o = 1; o < 64; o <<= 1) { const unsigned v = __shfl_up(inc, o); if (lane >= o) inc += v; }
            unsigned exc = inc - tsum;
            if (exc < need && need <= inc) {
                unsigned run = exc; int di = 0;
#pragma unroll
                for (int i = 0; i < 4; ++i) { if (run < need && need <= run + hv[i]) { di = i; break; } run += hv[i]; }
                const unsigned digit = 255u - (unsigned)(4 * lane + di);
                CTL[0] = prefix | (digit << shift); CTL[1] = need - run;
            }
        }
        __syncthreads();
        prefix = CTL[0]; mask |= (255u << shift);
    }
    const unsigned thr = prefix, need_eq = CTL[1];
    unsigned ngt = 0u, neq = 0u;
#pragma unroll
    for (int i = 0; i < 8; ++i) { ngt += (key[i] > thr) ? 1u : 0u; neq += (key[i] == thr) ? 1u : 0u; }
    unsigned pk = ngt | (neq << 16), inc = pk;
#pragma unroll
    for (int o = 1; o < 64; o <<= 1) { const unsigned v = __shfl_up(inc, o); if (lane >= o) inc += v; }
    if (lane == 63) WS_[wave] = inc;
    __syncthreads();
    unsigned woff = 0u, tot = 0u;
#pragma unroll
    for (int w = 0; w < 8; ++w) { const unsigned v = WS_[w]; if (w < wave) woff += v; tot += v; }
    const unsigned exc = inc - pk + woff;
    unsigned gpos = exc & 0xffffu, epos = exc >> 16; const unsigned totgt = tot & 0xffffu;
    const int sbase = (e * BATCH + b) * CAP;
    int* ROWTOK = (int*)(a.ws + WS_ROWTOK); float* ROWGATE = (float*)(a.ws + WS_ROWGATE); int* INV = (int*)(a.ws + WS_INV);
#pragma unroll
    for (int i = 0; i < 8; ++i) {
        int pos = -1;
        if (key[i] > thr) pos = (int)gpos++;
        else if (key[i] == thr) { if (epos < need_eq) pos = (int)(totgt + epos); epos++; }
        if (pos >= 0) { const int s = tid * 8 + i, tok = b * SEQ + s, slot = sbase + pos;
            ROWTOK[slot] = tok; ROWGATE[slot] = __builtin_bit_cast(float, key[i]); INV[(size_t)tok * NE + e] = slot; }
    }
}

__device__ __forceinline__ void phase_final(const Args& a, int G) {
    const int tid = threadIdx.x, lane = tid & 63, wave = __builtin_amdgcn_readfirstlane(tid >> 6);
    const int gw = blockIdx.x * 8 + wave, NGW = G * 8;
    const float* X1 = (const float*)(a.ws + WS_X1); const bf16_t* YE = (const bf16_t*)(a.ws + WS_YE); const int* INV = (const int*)(a.ws + WS_INV);
    for (int tok = gw; tok < T; tok += NGW) {
        f32x4 v[4];
#pragma unroll
        for (int j = 0; j < 4; ++j) v[j] = *(const f32x4*)(X1 + (size_t)tok * D + 4 * lane + 256 * j);
        for (int e = 0; e < NE; ++e) { const int slot = __builtin_amdgcn_readfirstlane(INV[(size_t)tok * NE + e]);
            if (slot >= 0) {
#pragma unroll
                for (int j = 0; j < 4; ++j) { const u32x2 w = *(const u32x2*)(YE + (size_t)slot * D + 4 * lane + 256 * j);
                    v[j].x += bf_lo(w.x); v[j].y += bf_hi(w.x); v[j].z += bf_lo(w.y); v[j].w += bf_hi(w.y); } } }
        float s = 0.f;
#pragma unroll
        for (int j = 0; j < 4; ++j) s += (v[j].x * v[j].x + v[j].y * v[j].y) + (v[j].z * v[j].z + v[j].w * v[j].w);
        const float rs = 1.0f / sqrtf(wave_sum(s) * (1.f / D) + 1e-6f);
#pragma unroll
        for (int j = 0; j < 4; ++j) { const f32x4 gg = *(const f32x4*)(a.in[I_FNG] + 4 * lane + 256 * j);
            *(f32x4*)(a.out + (size_t)tok * D + 4 * lane + 256 * j) = (f32x4){v[j].x * rs * gg.x, v[j].y * rs * gg.y, v[j].z * rs * gg.z, v[j].w * rs * gg.w}; }
    }
}

__global__ void __launch_bounds__(NTHREADS, 2) mega(Args a) {
    extern __shared__ __attribute__((aligned(16))) unsigned char lds_raw[];
    LAS unsigned char* lds = (LAS unsigned char*)lds_raw;
    cg::grid_group grid = cg::this_grid();
    const int G = gridDim.x, lo = a.ph_lo, hi = a.ph_hi;
    unsigned char* ws = a.ws;
#ifndef PH_MASK
#define PH_MASK 0x7ff
#endif
#define IN(k) (((PH_MASK >> (k)) & 1) && lo <= (k) && (k) < hi)
#define SEAM(k) do { if (IN((k) + 1)) grid.sync(); } while (0)

    if (IN(0)) { phase_prep(a, lds, G); SEAM(0); }

    if (IN(1)) {
        { pg8::Gemm g{(const bf16_t*)(ws + WS_XH), (const bf16_t*)(ws + WS_WINT), T, IN_PROJ, D}; pg8::StaticOrder S; S.init(T, IN_PROJ, G, (int)blockIdx.x);
          pg8::EpiBf16 E{(bf16_t*)(ws + WS_P), IN_PROJ}; pg8::gemm_phase<pg8::EpiBf16, pg8::StaticOrder, false>(lds, g, S, E, nullptr); }
        { pg8::Gemm g{(const bf16_t*)(ws + WS_MEMN), (const bf16_t*)(ws + WS_WKT), BATCH * NMEM, 256, D}; pg8::StaticOrder S; S.init(BATCH * NMEM, 256, G, (int)blockIdx.x);
          pg8::EpiBf16 E{(bf16_t*)(ws + WS_KMEM), 256}; pg8::gemm_phase<pg8::EpiBf16, pg8::StaticOrder, false>(lds, g, S, E, nullptr); }
        { pg8::Gemm g{(const bf16_t*)(ws + WS_WVT), (const bf16_t*)(ws + WS_MEMN), 256, BATCH * NMEM, D}; pg8::StaticOrder S; S.init(256, BATCH * NMEM, G, (int)blockIdx.x);
          pg8::EpiBf16 E{(bf16_t*)(ws + WS_VT), BATCH * NMEM}; pg8::gemm_phase<pg8::EpiBf16, pg8::StaticOrder, false>(lds, g, S, E, nullptr); }
        SEAM(1);
    }

    if (IN(2)) {
        for (int u = blockIdx.x; u < 3072; u += G) {
#ifndef P2_MASK
#define P2_MASK 7
#endif
            if (u < 1024) { if (P2_MASK & 1) attn_unit(a, lds, u); } else if (u < 2048) { if (P2_MASK & 2) conv_unit(a, lds, u - 1024); } else { if (P2_MASK & 4) prep_unit(a, lds, u - 2048); }
        }
        SEAM(2);
    }

    if (IN(3)) {
        for (int u = blockIdx.x; u < BATCH * NH * 2; u += G) scan_unit(a, lds, u);
        SEAM(3);
    }

    if (IN(4)) { phase_post(a, G); SEAM(4); }

    if (IN(5)) {
        pg8::Gemm g{(const bf16_t*)(ws + WS_MIX), (const bf16_t*)(ws + WS_WOUTT), T, D, D}; pg8::StaticOrder S; S.init(T, D, G, (int)blockIdx.x);
        pg8::EpiResidSS E{a.in[I_X], (float*)(ws + WS_X1), (float*)(ws + WS_SS)}; pg8::gemm_phase<pg8::EpiResidSS, pg8::StaticOrder, false>(lds, g, S, E, nullptr);
        SEAM(5);
    }

    if (IN(6)) { phase_router(a, lds, G); SEAM(6); }

    if (IN(7)) { for (int u = blockIdx.x; u < BATCH * NE; u += G) topk_unit(a, lds, u); SEAM(7); }

    if (IN(8)) {
        pg8::Gemm g{(const bf16_t*)(ws + WS_H2), (const bf16_t*)(ws + WS_WGUT), NSLOT, 2048, D}; pg8::ExpertOrder S; S.init(32, 8, NE, G, (int)blockIdx.x);
        pg8::EpiSwiGLU E{(bf16_t*)(ws + WS_HID)}; pg8::gemm_phase<pg8::EpiSwiGLU, pg8::ExpertOrder, true>(lds, g, S, E, (const int*)(ws + WS_ROWTOK));
        SEAM(8);
    }

    if (IN(9)) {
        pg8::Gemm g{(const bf16_t*)(ws + WS_HID), (const bf16_t*)(ws + WS_WDT), NSLOT, D, FF}; pg8::ExpertOrder S; S.init(32, 4, NE, G, (int)blockIdx.x);
        pg8::EpiGateScale E{(bf16_t*)(ws + WS_YE), (const float*)(ws + WS_ROWGATE)}; pg8::gemm_phase<pg8::EpiGateScale, pg8::ExpertOrder, false>(lds, g, S, E, nullptr);
        SEAM(9);
    }

    if (IN(10)) { phase_final(a, G); }
#undef IN
#undef SEAM
}

#ifndef MK_ONE_LAUNCH
#define MK_ONE_LAUNCH 1
#endif
extern "C" void kernel_launch(void* const* d_in, const int* in_sizes, int n_in, void* d_out, int out_size, void* d_ws, size_t ws_size, hipStream_t stream) {
    static int grid_blocks = 0;
    if (grid_blocks == 0) {
        if (n_in != 29 || out_size != T * D || ws_size < WS_END) { fprintf(stderr, "kernel_launch: unexpected problem: n_in %d out %d ws %zu (need %zu)\n", n_in, out_size, ws_size, (size_t)WS_END); grid_blocks = -1; return; }
        int dev = 0, cus = 0, per_cu = 0;
        if (hipGetDevice(&dev) != hipSuccess || hipDeviceGetAttribute(&cus, hipDeviceAttributeMultiprocessorCount, dev) != hipSuccess) { grid_blocks = -1; return; }
        if (hipFuncSetAttribute((const void*)mega, hipFuncAttributeMaxDynamicSharedMemorySize, LDS_BYTES) != hipSuccess) { fprintf(stderr, "kernel_launch: hipFuncSetAttribute failed\n"); grid_blocks = -1; return; }
        if (hipOccupancyMaxActiveBlocksPerMultiprocessor(&per_cu, (const void*)mega, NTHREADS, LDS_BYTES) != hipSuccess || per_cu < 1) { fprintf(stderr, "kernel_launch: occupancy query says %d blocks per CU\n", per_cu); grid_blocks = -1; return; }
        grid_blocks = cus;
    }
    if (grid_blocks < 0) return;
    Args a{};
    for (int i = 0; i < 29; ++i) a.in[i] = (const float*)d_in[i];
    a.out = (float*)d_out; a.ws = (unsigned char*)d_ws;
#if MK_ONE_LAUNCH
    a.ph_lo = 0; a.ph_hi = NPHASE;
    { void* args[] = {&a}; hipError_t e = hipLaunchCooperativeKernel((const void*)mega, dim3(grid_blocks), dim3(NTHREADS), args, LDS_BYTES, stream);
      if (e != hipSuccess) fprintf(stderr, "cooperative launch failed: %s (grid %d)\n", hipGetErrorString(e), grid_blocks); }
#else
    for (int ph = 0; ph < NPHASE; ++ph) { a.ph_lo = ph; a.ph_hi = ph + 1; void* args[] = {&a};
        hipError_t e = hipLaunchCooperativeKernel((const void*)mega, dim3(grid_blocks), dim3(NTHREADS), args, LDS_BYTES, stream);
        if (e != hipSuccess) { fprintf(stderr, "cooperative launch %d failed: %s (grid %d)\n", ph, hipGetErrorString(e), grid_blocks); break; } }
#endif
}
```

```cpp
#include <hip/hip_runtime.h>
#include <hip/hip_cooperative_groups.h>
#include <cstdio>
#include <cstdint>
namespace cg = cooperative_groups;

#define LAS __attribute__((address_space(3)))
typedef unsigned short bf16_t;
typedef short bf16x8 __attribute__((ext_vector_type(8)));
typedef short s16x4 __attribute__((ext_vector_type(4)));
typedef float f32x2 __attribute__((ext_vector_type(2)));
typedef float f32x4 __attribute__((ext_vector_type(4)));
typedef float f32x16 __attribute__((ext_vector_type(16)));
typedef unsigned u32x2 __attribute__((ext_vector_type(2)));
typedef unsigned u32x4 __attribute__((ext_vector_type(4)));
typedef _Float16 f16x4 __attribute__((ext_vector_type(4)));
typedef __bf16 bf16v2 __attribute__((ext_vector_type(2)));

constexpr int D = 1024, BATCH = 16, SEQ = 4096, T = BATCH * SEQ, NMEM = 256;
constexpr int IN_PROJ = 2560, CW = 384, RW = 384, NH = 6, NE = 16, FF = 1024, CAP = 512;
constexpr int NSLOT = NE * BATCH * CAP;
constexpr int NTHREADS = 512;
constexpr int LDS_BYTES = 160 * 1024;
constexpr int NPHASE = 11;

constexpr size_t MiB = 1u << 20;
constexpr size_t WS_WINT = 1 * MiB;
constexpr size_t WS_WOUTT = 6 * MiB;
constexpr size_t WS_WKT = 8 * MiB;
constexpr size_t WS_WVT = 8 * MiB + 512 * 1024;
constexpr size_t WS_SMALL = 9 * MiB;
constexpr size_t WS_WGUT = 10 * MiB;
constexpr size_t WS_WDT = 74 * MiB;
constexpr size_t WS_KMEM = 106 * MiB;
constexpr size_t WS_VT = 108 * MiB;
constexpr size_t WS_ROWTOK = 106 * MiB;
constexpr size_t WS_ROWGATE = 106 * MiB + 512 * 1024;
constexpr size_t WS_SS = 107 * MiB;
constexpr size_t WS_P = 112 * MiB;
constexpr size_t WS_YF = 112 * MiB;
constexpr size_t WS_YB = 208 * MiB;
constexpr size_t WS_X1 = 112 * MiB;
constexpr size_t WS_XH = 432 * MiB;
constexpr size_t WS_G = 432 * MiB;
constexpr size_t WS_BON = 480 * MiB;
constexpr size_t WS_H2 = 432 * MiB;
constexpr size_t WS_MEMN = 560 * MiB;
constexpr size_t WS_MIX = 560 * MiB;
constexpr size_t WS_SCAN = 688 * MiB;
constexpr size_t SCAN_STRIDE = 48 * MiB;
constexpr size_t WS_AFF = 624 * MiB;
constexpr size_t WS_INV = 628 * MiB;
constexpr size_t WS_HID = 768 * MiB;
constexpr size_t WS_YE = 368 * MiB;
constexpr size_t WS_END = 1024 * MiB;

__device__ __forceinline__ unsigned pk_bf16(float lo, float hi) { f32x2 v = {lo, hi}; bf16v2 b = __builtin_convertvector(v, bf16v2); return __builtin_bit_cast(unsigned, b); }
__device__ __forceinline__ float bf_lo(unsigned u) { return __builtin_bit_cast(float, u << 16); }
__device__ __forceinline__ float bf_hi(unsigned u) { return __builtin_bit_cast(float, u & 0xffff0000u); }
__device__ __forceinline__ float wave_sum(float v) {
#pragma unroll
    for (int o = 1; o < 64; o <<= 1) v += __shfl_xor(v, o);
    return v;
}
__device__ __forceinline__ float sigmoidf_fast(float x) { return __builtin_amdgcn_rcpf(1.0f + __builtin_amdgcn_exp2f(-1.4426950408889634f * x)); }
template <int CTRL> __device__ __forceinline__ float dpp_f(float x) { return __builtin_bit_cast(float, __builtin_amdgcn_update_dpp(0, __builtin_bit_cast(int, x), CTRL, 0xF, 0xF, true)); }
__device__ __forceinline__ float sum8(float x) { x += dpp_f<0xB1>(x); x += dpp_f<0x4E>(x); x += dpp_f<0x141>(x); return x; }
__device__ __forceinline__ float sum16(float x) { x = sum8(x); x += dpp_f<0x140>(x); return x; }
__device__ __forceinline__ float max16(float x) { x = fmaxf(x, dpp_f<0xB1>(x)); x = fmaxf(x, dpp_f<0x4E>(x)); x = fmaxf(x, dpp_f<0x141>(x)); x = fmaxf(x, dpp_f<0x140>(x)); return x; }

namespace pg8 {
#define PG8_LAS __attribute__((address_space(3)))
constexpr int BM = 256, BK = 64, HALF = 128, HTB = HALF * BK * 2, STAGE_BYTES = 8 * HTB, NXCD = 8, WGM = 8;
__host__ __device__ __forceinline__ int lds_byte(int r, int c) { const int st = (r >> 4) * 2 + (c >> 5), rr = r & 15, cc = c & 31, ob = rr * 64 + cc * 2; return st * 1024 + (ob ^ (((ob >> 9) & 1) << 5)); }
__host__ __device__ __forceinline__ void stage_rc(int b, int& R, int& C) { const int st = b / 1024, sb = b % 1024, swz = sb ^ (((sb >> 9) & 1) << 5); R = (st >> 1) * 16 + swz / 64; C = (st & 1) * 32 + (swz % 64) / 2; }
__host__ __device__ __forceinline__ int perm32(int rho) { const int n = rho >> 4, i = rho & 15; return 8 * (i >> 2) + 4 * n + (i & 3); }

struct Unit { int pm, pn; };
struct Gemm { const bf16_t* A; const bf16_t* Bt; int M, N, K; };

struct StaticOrder {
    int nM, nN, nwg, G, c;
    __device__ void init(int M, int N, int G_, int c_) { nM = M / BM; nN = N / BM; nwg = nM * nN; G = G_; c = c_; }
    __device__ bool next(int i, Unit& u) const {
        const long L = (long)i * G + c; if (L >= nwg) return false;
        int wgid = (int)L; { const int q = nwg / NXCD, r = nwg % NXCD, xcd = wgid % NXCD, off = wgid / NXCD; wgid = (xcd < r ? xcd * (q + 1) : r * (q + 1) + (xcd - r) * q) + off; }
        const int nig = WGM * nN, gid = wgid / nig, fm = gid * WGM, gsz = (nM - fm) < WGM ? (nM - fm) : WGM;
        u.pm = fm + ((wgid % nig) % gsz); u.pn = (wgid % nig) / gsz; return true;
    }
};
struct ExpertOrder {
    int nMe, nNe, per, total, G, c;
    __device__ void init(int nMe_, int nNe_, int nExp, int G_, int c_) { nMe = nMe_; nNe = nNe_; per = nMe * nNe; total = per * nExp; G = G_; c = c_; }
    __device__ bool next(int i, Unit& u) const {
        const long L = (long)i * G + c; if (L >= total) return false;
        const int e = (int)(L / per), w = (int)(L % per), xl = w % 8, j = w / 8, rpx = nMe / 8;
        u.pm = e * nMe + xl * rpx + (j % rpx); u.pn = e * nNe + j / rpx; return true;
    }
};

struct EpiBf16 {
    static constexpr bool PERM = true;
    bf16_t* O; int ldc;
    __device__ __forceinline__ void operator()(const f32x4 (&acc)[2][2][4][2], const Unit& u, int wr, int wc, int fr, int fq) const {
        const int row0 = u.pm * BM + wr * 64 + fr, col0 = u.pn * BM + wc * 32 + 8 * fq;
#pragma unroll
        for (int ai = 0; ai < 2; ++ai)
#pragma unroll
            for (int m = 0; m < 4; ++m) { bf16_t* rowp = O + (size_t)(row0 + ai * HALF + m * 16) * ldc + col0;
#pragma unroll
                for (int bj = 0; bj < 2; ++bj) { const f32x4 v0 = acc[ai][bj][m][0], v1 = acc[ai][bj][m][1];
                    u32x4 w; w.x = pk_bf16(v0[0], v0[1]); w.y = pk_bf16(v0[2], v0[3]); w.z = pk_bf16(v1[0], v1[1]); w.w = pk_bf16(v1[2], v1[3]);
                    *(u32x4*)(rowp + bj * HALF) = w; } }
    }
};
struct EpiResidSS {
    static constexpr bool PERM = false;
    const float* X; float* X1; float* ss;
    __device__ __forceinline__ void operator()(const f32x4 (&acc)[2][2][4][2], const Unit& u, int wr, int wc, int fr, int fq) const {
        const int row0 = u.pm * BM + wr * 64 + fr, col0 = u.pn * BM + wc * 32 + 4 * fq;
#pragma unroll
        for (int ai = 0; ai < 2; ++ai)
#pragma unroll
            for (int m = 0; m < 4; ++m) { const int row = row0 + ai * HALF + m * 16; const size_t off = (size_t)row * D + col0; float s = 0.f;
#pragma unroll
                for (int bj = 0; bj < 2; ++bj)
#pragma unroll
                    for (int n = 0; n < 2; ++n) { const f32x4 xv = *(const f32x4*)(X + off + bj * HALF + n * 16); const f32x4 o = xv + acc[ai][bj][m][n];
                        *(f32x4*)(X1 + off + bj * HALF + n * 16) = o; s += (o[0] * o[0] + o[1] * o[1]) + (o[2] * o[2] + o[3] * o[3]); }
                s += __shfl_xor(s, 16); s += __shfl_xor(s, 32);
                if (fq == 0) (void)__hip_atomic_fetch_add(ss + row, s, __ATOMIC_RELAXED, __HIP_MEMORY_SCOPE_AGENT); }
    }
};
struct EpiSwiGLU {
    static constexpr bool PERM = true;
    bf16_t* H;
    __device__ __forceinline__ void operator()(const f32x4 (&acc)[2][2][4][2], const Unit& u, int wr, int wc, int fr, int fq) const {
        const int row0 = u.pm * BM + wr * 64 + fr, col0 = (u.pn & 7) * HALF + wc * 32 + 8 * fq;
#pragma unroll
        for (int ai = 0; ai < 2; ++ai)
#pragma unroll
            for (int m = 0; m < 4; ++m) { bf16_t* rowp = H + (size_t)(row0 + ai * HALF + m * 16) * FF + col0; float h[8];
#pragma unroll
                for (int n = 0; n < 2; ++n)
#pragma unroll
                    for (int j = 0; j < 4; ++j) { const float gt = acc[ai][0][m][n][j], up = acc[ai][1][m][n][j]; h[n * 4 + j] = gt * sigmoidf_fast(gt) * up; }
                u32x4 w; w.x = pk_bf16(h[0], h[1]); w.y = pk_bf16(h[2], h[3]); w.z = pk_bf16(h[4], h[5]); w.w = pk_bf16(h[6], h[7]);
                *(u32x4*)rowp = w; }
    }
};
struct EpiGateScale {
    static constexpr bool PERM = true;
    bf16_t* Y; const float* gate;
    __device__ __forceinline__ void operator()(const f32x4 (&acc)[2][2][4][2], const Unit& u, int wr, int wc, int fr, int fq) const {
        const int row0 = u.pm * BM + wr * 64 + fr, col0 = (u.pn & 3) * BM + wc * 32 + 8 * fq;
#pragma unroll
        for (int ai = 0; ai < 2; ++ai)
#pragma unroll
            for (int m = 0; m < 4; ++m) { const int row = row0 + ai * HALF + m * 16; const float gs = gate[row]; bf16_t* rowp = Y + (size_t)row * D + col0;
#pragma unroll
                for (int bj = 0; bj < 2; ++bj) { const f32x4 v0 = acc[ai][bj][m][0] * gs, v1 = acc[ai][bj][m][1] * gs;
                    u32x4 w; w.x = pk_bf16(v0[0], v0[1]); w.y = pk_bf16(v0[2], v0[3]); w.z = pk_bf16(v1[0], v1[1]); w.w = pk_bf16(v1[2], v1[3]);
                    *(u32x4*)(rowp + bj * HALF) = w; } }
    }
};

template <class Epi, class Sched, bool GATHER>
__device__ __forceinline__ void gemm_phase(PG8_LAS unsigned char* lds, const Gemm g, const Sched& S, const Epi& E, const int* rowtok) {
    const int tid = threadIdx.x, wid = __builtin_amdgcn_readfirstlane(tid >> 6), lane = tid & 63, wr = wid >> 2, wc = wid & 3, fr = lane & 15, fq = lane >> 4;
    const int K = g.K, nt = K / BK;
    unsigned voffA[2], voffB[2]; int Rr[2], Cc[2];
#pragma unroll
    for (int i = 0; i < 2; ++i) { int R, C; stage_rc(tid * 16 + i * 8192, R, C); const int Rb = Epi::PERM ? ((R & ~31) + perm32(R & 31)) : R; Rr[i] = R; Cc[i] = C;
        voffA[i] = (unsigned)(R * K + C) * 2u; voffB[i] = (unsigned)(Rb * K + C) * 2u; }
    unsigned vAc[2][2], vAn[2][2];
    const size_t kstep = (size_t)(BK * 2);
    const size_t hstep = (size_t)HALF * K * 2;
    const size_t tstep = 2 * hstep;
    const unsigned ldsw = (unsigned)wid * 1024u;
    const int aoff = lds_byte(wr * 64 + fr, fq * 8), boff = lds_byte(wc * 32 + fr, fq * 8);
#define PG8_SA(b, h) (((b) * 2 + (h)) * HTB)
#define PG8_SB(b, h) ((4 + (b) * 2 + (h)) * HTB)
#define PG8_STAGE(bufoff, gbase, voff) do { _Pragma("unroll") for (int _i = 0; _i < 2; ++_i) \
        __builtin_amdgcn_global_load_lds((const unsigned*)((const char*)(gbase) + (voff)[_i]), (PG8_LAS unsigned*)(lds + (bufoff) + ldsw + _i * 8192), 16, 0, 0); } while (0)
#define PG8_STAGE_A(bufoff, hh, dbase, kbytes, vsel) do { if constexpr (GATHER) { PG8_STAGE(bufoff, (const char*)g.A + (kbytes), (vsel)[hh]); } else { PG8_STAGE(bufoff, (dbase) + ((hh) ? hstep : 0), voffA); } } while (0)
#define PG8_GATHER_OFF(dst, un) do { _Pragma("unroll") for (int _h = 0; _h < 2; ++_h) _Pragma("unroll") for (int _i = 0; _i < 2; ++_i) \
        (dst)[_h][_i] = (unsigned)rowtok[(un).pm * BM + _h * HALF + Rr[_i]] * (unsigned)(K * 2) + (unsigned)(Cc[_i] * 2); } while (0)
#define PG8_LDA(dst, b, h) do { _Pragma("unroll") for (int m = 0; m < 4; ++m) _Pragma("unroll") for (int k = 0; k < 2; ++k) dst[m][k] = *(const PG8_LAS bf16x8*)(lds + PG8_SA(b, h) + aoff + m * 2048 + k * 1024); } while (0)
#define PG8_LDB(dst, b, h) do { _Pragma("unroll") for (int n = 0; n < 2; ++n) _Pragma("unroll") for (int k = 0; k < 2; ++k) dst[n][k] = *(const PG8_LAS bf16x8*)(lds + PG8_SB(b, h) + boff + n * 2048 + k * 1024); } while (0)
#define PG8_MMA(ai, bj, At, Bt) do { __builtin_amdgcn_s_setprio(1); _Pragma("unroll") for (int m = 0; m < 4; ++m) _Pragma("unroll") for (int n = 0; n < 2; ++n) _Pragma("unroll") for (int k = 0; k < 2; ++k) \
        acc[ai][bj][m][n] = __builtin_amdgcn_mfma_f32_16x16x32_bf16(Bt[n][k], At[m][k], acc[ai][bj][m][n], 0, 0, 0); __builtin_amdgcn_s_setprio(0); } while (0)
#define PG8_WAIT_V(n) asm volatile("s_waitcnt vmcnt(" #n ")" ::: "memory")
#define PG8_WAIT_L(n) asm volatile("s_waitcnt lgkmcnt(" #n ")" ::: "memory")
#define PG8_BAR __builtin_amdgcn_s_barrier()
#define PG8_SCHED __builtin_amdgcn_sched_barrier(0)
    Unit cur, nxt; int ui = 0;
    if (!S.next(0, cur)) return;
    f32x4 acc[2][2][4][2];
#pragma unroll
    for (int a = 0; a < 2; ++a)
#pragma unroll
        for (int b = 0; b < 2; ++b)
#pragma unroll
            for (int m = 0; m < 4; ++m)
#pragma unroll
                for (int n = 0; n < 2; ++n) acc[a][b][m][n] = (f32x4){0.f, 0.f, 0.f, 0.f};
    bf16x8 At[4][2], B0[2][2], B1[2][2];
    const char* cA = (const char*)g.A + (GATHER ? (size_t)0 : (size_t)cur.pm * tstep); const char* cB = (const char*)g.Bt + (size_t)cur.pn * tstep;
    if constexpr (GATHER) { PG8_GATHER_OFF(vAc, cur); }
    PG8_STAGE(PG8_SB(0, 0), cB, voffB); PG8_STAGE_A(PG8_SA(0, 0), 0, cA, 0, vAc); PG8_STAGE(PG8_SB(0, 1), cB + hstep, voffB); PG8_STAGE_A(PG8_SA(0, 1), 1, cA, 0, vAc);
    if (wr == 1) PG8_BAR;
    PG8_WAIT_V(4); PG8_BAR;
    PG8_STAGE(PG8_SB(1, 0), cB + kstep, voffB); PG8_STAGE_A(PG8_SA(1, 0), 0, cA + kstep, kstep, vAc); PG8_STAGE(PG8_SB(1, 1), cB + hstep + kstep, voffB);
    PG8_WAIT_V(6); PG8_BAR;
    for (;;) {
        const bool has_next = S.next(ui + 1, nxt);
        const char* nA = (has_next && !GATHER) ? (const char*)g.A + (size_t)nxt.pm * tstep : cA; const char* nB = has_next ? (const char*)g.Bt + (size_t)nxt.pn * tstep : cB;
        if constexpr (GATHER) { if (has_next) { PG8_GATHER_OFF(vAn, nxt); } else {
#pragma unroll
            for (int _h = 0; _h < 2; ++_h)
#pragma unroll
                for (int _i = 0; _i < 2; ++_i) vAn[_h][_i] = vAc[_h][_i]; } }
        for (int t = 0; t < nt; t += 2) {
            const bool last = (t == nt - 2);
            const size_t k1 = (size_t)(t + 1) * kstep, k2 = last ? 0 : (size_t)(t + 2) * kstep, k3 = k2 + kstep;
            const char* a1 = cA + k1;
            const char* a2 = last ? nA : cA + (size_t)(t + 2) * kstep; const char* b2 = last ? nB : cB + (size_t)(t + 2) * kstep;
            const char* a3 = a2 + kstep; const char* b3 = b2 + kstep;
            unsigned vs[2][2];
#pragma unroll
            for (int _h = 0; _h < 2; ++_h)
#pragma unroll
                for (int _i = 0; _i < 2; ++_i) vs[_h][_i] = last ? vAn[_h][_i] : vAc[_h][_i];
            PG8_LDB(B0, 0, 0); PG8_SCHED; PG8_LDA(At, 0, 0); PG8_STAGE_A(PG8_SA(1, 1), 1, a1, k1, vAc);
            PG8_WAIT_L(8); PG8_BAR; PG8_WAIT_L(0); PG8_MMA(0, 0, At, B0); PG8_BAR; PG8_SCHED;
            PG8_LDB(B1, 0, 1); PG8_STAGE(PG8_SB(0, 0), b2, voffB);
            PG8_BAR; PG8_WAIT_L(0); PG8_MMA(0, 1, At, B1); PG8_BAR;
            PG8_LDA(At, 0, 1); PG8_STAGE_A(PG8_SA(0, 0), 0, a2, k2, vs);
            PG8_BAR; PG8_WAIT_L(0); PG8_MMA(1, 0, At, B0); PG8_BAR; PG8_SCHED;
            PG8_STAGE(PG8_SB(0, 1), b2 + hstep, voffB);
            PG8_WAIT_V(6); PG8_BAR; PG8_MMA(1, 1, At, B1); PG8_BAR;
            PG8_LDB(B0, 1, 0); PG8_SCHED; PG8_LDA(At, 1, 0); PG8_STAGE_A(PG8_SA(0, 1), 1, a2, k2, vs);
            PG8_WAIT_L(8); PG8_BAR; PG8_WAIT_L(0); PG8_MMA(0, 0, At, B0); PG8_BAR; PG8_SCHED;
            PG8_LDB(B1, 1, 1); PG8_STAGE(PG8_SB(1, 0), b3, voffB);
            PG8_BAR; PG8_WAIT_L(0); PG8_MMA(0, 1, At, B1); PG8_BAR;
            PG8_LDA(At, 1, 1); PG8_STAGE_A(PG8_SA(1, 0), 0, a3, k3, vs);
            PG8_BAR; PG8_WAIT_L(0); PG8_MMA(1, 0, At, B0); PG8_BAR; PG8_SCHED;
            PG8_STAGE(PG8_SB(1, 1), b3 + hstep, voffB);
            PG8_WAIT_V(6); PG8_BAR; PG8_MMA(1, 1, At, B1); PG8_BAR;
        }
        E(acc, cur, wr, wc, fr, fq);
        if (!has_next) break;
#pragma unroll
        for (int a = 0; a < 2; ++a)
#pragma unroll
            for (int b = 0; b < 2; ++b)
#pragma unroll
                for (int m = 0; m < 4; ++m)
#pragma unroll
                    for (int n = 0; n < 2; ++n) acc[a][b][m][n] = (f32x4){0.f, 0.f, 0.f, 0.f};
        cur = nxt; cA = nA; cB = nB; ++ui;
        if constexpr (GATHER) {
#pragma unroll
            for (int _h = 0; _h < 2; ++_h)
#pragma unroll
                for (int _i = 0; _i < 2; ++_i) vAc[_h][_i] = vAn[_h][_i]; }
    }
    PG8_WAIT_V(0);
    if (wr == 0) PG8_BAR;
    PG8_BAR;
#undef PG8_SA
#undef PG8_SB
#undef PG8_STAGE
#undef PG8_STAGE_A
#undef PG8_GATHER_OFF
#undef PG8_LDA
#undef PG8_LDB
#undef PG8_MMA
#undef PG8_WAIT_V
#undef PG8_WAIT_L
#undef PG8_BAR
#undef PG8_SCHED
}
}

struct Args {
    const float* in[29];
    float* out; unsigned char* ws;
    int ph_lo, ph_hi;
};
enum { I_X = 0, I_MEM, I_NMIXG, I_NMEMG, I_WIN, I_WMK, I_WMV, I_CONVW, I_CONVB, I_CLNG, I_CLNB, I_SHIFTMU, I_DW0, I_DUP, I_IA0, I_IUP, I_GUP, I_KK, I_KA, I_RK,
       I_LNXG, I_LNXB, I_WOUT, I_NFFNG, I_WROUTER, I_WEG, I_WEU, I_WED, I_FNG };

__device__ __forceinline__ void transpose_item(const float* W, int N, bf16_t* WT, int K, int k0, int n0, int drow0, LAS float* scr, int lane) {
#pragma unroll 8
    for (int i = 0; i < 32; ++i) { const int kk = 2 * i + (lane >> 5); scr[kk * 33 + (lane & 31)] = W[(size_t)(k0 + kk) * N + n0 + (lane & 31)]; }
    asm volatile("s_waitcnt lgkmcnt(0)" ::: "memory");
    const int c = lane & 7;
#pragma unroll
    for (int j = 0; j < 4; ++j) { const int n = (lane >> 3) + 8 * j; const LAS float* s = scr + (8 * c) * 33 + n;
        u32x4 o; o.x = pk_bf16(s[0 * 33], s[1 * 33]); o.y = pk_bf16(s[2 * 33], s[3 * 33]); o.z = pk_bf16(s[4 * 33], s[5 * 33]); o.w = pk_bf16(s[6 * 33], s[7 * 33]);
        *(u32x4*)(WT + (size_t)(drow0 + n) * K + k0 + 8 * c) = o; }
    asm volatile("s_waitcnt lgkmcnt(0)" ::: "memory");
}
__device__ __forceinline__ void rms_row_to_bf16(const float* xrow, const float* g, bf16_t* orow, int lane) {
    const f32x4* xr = (const f32x4*)xrow + lane; const f32x4* gr = (const f32x4*)g + lane;
    f32x4 v[4]; float s = 0.f;
#pragma unroll
    for (int j = 0; j < 4; ++j) { v[j] = xr[64 * j]; s += (v[j].x * v[j].x + v[j].y * v[j].y) + (v[j].z * v[j].z + v[j].w * v[j].w); }
    const float rs = 1.0f / sqrtf(wave_sum(s) * (1.f / D) + 1e-6f);
    u32x2* o8 = (u32x2*)orow + lane;
#pragma unroll
    for (int j = 0; j < 4; ++j) { const f32x4 gg = gr[64 * j]; u32x2 w; w.x = pk_bf16(v[j].x * rs * gg.x, v[j].y * rs * gg.y); w.y = pk_bf16(v[j].z * rs * gg.z, v[j].w * rs * gg.w); o8[64 * j] = w; }
}
__device__ __forceinline__ void phase_prep(const Args& a, LAS unsigned char* lds, int G) {
    const int tid = threadIdx.x, lane = tid & 63, wave = __builtin_amdgcn_readfirstlane(tid >> 6);
    LAS float* scr = (LAS float*)(lds + wave * 16384);
    const int gw = blockIdx.x * 8 + wave, NGW = G * 8;
    unsigned char* ws = a.ws;
    constexpr int S_WIN = 16 * 80, S_WOUT = 16 * 32, S_MK = 16 * 8, S_SM = 12, S_GUP = 24, S_EXP = 16 * 16 * 32;
    constexpr int NITEMS = S_WIN + S_WOUT + 2 * S_MK + 4 * S_SM + S_GUP + 3 * S_EXP;
    for (int it = gw; it < NITEMS; it += NGW) {
        int r = it;
        if (r < S_WIN) { const int kb = r / 80, nb = r % 80; transpose_item(a.in[I_WIN], IN_PROJ, (bf16_t*)(ws + WS_WINT), D, kb * 64, nb * 32, nb * 32, scr, lane); continue; } r -= S_WIN;
        if (r < S_WOUT) { const int kb = r / 32, nb = r % 32; transpose_item(a.in[I_WOUT], D, (bf16_t*)(ws + WS_WOUTT), D, kb * 64, nb * 32, nb * 32, scr, lane); continue; } r -= S_WOUT;
        if (r < S_MK) { const int kb = r / 8, nb = r % 8; transpose_item(a.in[I_WMK], 256, (bf16_t*)(ws + WS_WKT), D, kb * 64, nb * 32, nb * 32, scr, lane); continue; } r -= S_MK;
        if (r < S_MK) { const int kb = r / 8, nb = r % 8; transpose_item(a.in[I_WMV], 256, (bf16_t*)(ws + WS_WVT), D, kb * 64, nb * 32, nb * 32, scr, lane); continue; } r -= S_MK;
        if (r < 4 * S_SM) { const int which = r / S_SM, nb = r % S_SM;
            const float* src = (which < 2 ? a.in[I_DUP] : a.in[I_IUP]) + (size_t)(which & 1) * 64 * RW;
            transpose_item(src, RW, (bf16_t*)(ws + WS_SMALL) + (size_t)which * RW * 64, 64, 0, nb * 32, nb * 32, scr, lane); continue; } r -= 4 * S_SM;
        if (r < S_GUP) { const int kb = r / 12, nb = r % 12; transpose_item(a.in[I_GUP], RW, (bf16_t*)(ws + WS_SMALL) + (size_t)4 * RW * 64, 128, kb * 64, nb * 32, nb * 32, scr, lane); continue; } r -= S_GUP;
        { const int which = r / S_EXP, q = r % S_EXP, e = q / 512, kb = (q % 512) / 32, nb = q % 32, n0 = nb * 32;
          if (which == 0) transpose_item(a.in[I_WEG] + (size_t)e * D * FF, FF, (bf16_t*)(ws + WS_WGUT) + (size_t)e * 2048 * D, D, kb * 64, n0, (n0 >> 7) * 256 + (n0 & 127), scr, lane);
          else if (which == 1) transpose_item(a.in[I_WEU] + (size_t)e * D * FF, FF, (bf16_t*)(ws + WS_WGUT) + (size_t)e * 2048 * D, D, kb * 64, n0, (n0 >> 7) * 256 + 128 + (n0 & 127), scr, lane);
          else transpose_item(a.in[I_WED] + (size_t)e * FF * D, D, (bf16_t*)(ws + WS_WDT) + (size_t)e * D * FF, FF, kb * 64, n0, n0, scr, lane); }
    }
    for (int m = gw; m < T; m += NGW) rms_row_to_bf16(a.in[I_X] + (size_t)m * D, a.in[I_NMIXG], (bf16_t*)(ws + WS_XH) + (size_t)m * D, lane);
    for (int m = gw; m < BATCH * NMEM; m += NGW) rms_row_to_bf16(a.in[I_MEM] + (size_t)m * D, a.in[I_NMEMG], (bf16_t*)(ws + WS_MEMN) + (size_t)m * D, lane);
}

constexpr int AT_KS = 144;
constexpr int AT_VS = 520;
constexpr int AT_VOFF = 256 * AT_KS;
__device__ __forceinline__ bf16x8 pack_step(const f32x16& x, int s) {
    u32x4 p;
    asm volatile("v_cvt_pk_bf16_f32 %0, %4, %5\n\tv_cvt_pk_bf16_f32 %1, %6, %7\n\tv_cvt_pk_bf16_f32 %2, %8, %9\n\tv_cvt_pk_bf16_f32 %3, %10, %11\n\ts_nop 1"
                 : "=&v"(p[0]), "=&v"(p[1]), "=&v"(p[2]), "=&v"(p[3])
                 : "v"(x[8 * s]), "v"(x[8 * s + 1]), "v"(x[8 * s + 2]), "v"(x[8 * s + 3]), "v"(x[8 * s + 4]), "v"(x[8 * s + 5]), "v"(x[8 * s + 6]), "v"(x[8 * s + 7]));
    return __builtin_bit_cast(bf16x8, p);
}
__device__ __forceinline__ void attn_unit(const Args& a, LAS unsigned char* lds, int unit) {
    const int tid = threadIdx.x, lane = tid & 63, wave = __builtin_amdgcn_readfirstlane(tid >> 6), r = lane & 31, h = lane >> 5;
    const int b = unit >> 6, hh = (unit >> 4) & 3, tile = unit & 15;
    const bf16_t* P = (const bf16_t*)(a.ws + WS_P); const bf16_t* KM = (const bf16_t*)(a.ws + WS_KMEM); const bf16_t* VT = (const bf16_t*)(a.ws + WS_VT);
    bf16_t* MIX = (bf16_t*)(a.ws + WS_MIX);
    __syncthreads();
#pragma unroll
    for (int i = 0; i < 4; ++i) { const int c = tid + 512 * i, key = c >> 3, ch = c & 7;
        const u32x4 v = *(const u32x4*)(KM + (size_t)(b * NMEM + key) * 256 + hh * 64 + ch * 8);
        *(LAS u32x4*)(lds + key * AT_KS + ch * 16) = v; }
#pragma unroll
    for (int i = 0; i < 4; ++i) { const int c = tid + 512 * i, d = c >> 5, ch = c & 31;
        const u32x4 v = *(const u32x4*)(VT + (size_t)(hh * 64 + d) * (BATCH * NMEM) + b * NMEM + ch * 8);
        LAS u32x2* dst = (LAS u32x2*)(lds + AT_VOFF + d * AT_VS + ch * 16);
        dst[0] = (u32x2){v.x, v.y}; dst[1] = (u32x2){v.z, v.w}; }
    const int tok0 = b * SEQ + tile * 256 + wave * 32;
    bf16x8 qf[4];
#pragma unroll
    for (int ks = 0; ks < 4; ++ks) qf[ks] = *(const bf16x8*)(P + (size_t)(tok0 + r) * IN_PROJ + hh * 64 + ks * 16 + h * 8);
    __syncthreads();
    f32x16 s[8];
#pragma unroll
    for (int kt = 0; kt < 8; ++kt) {
#pragma unroll
        for (int i = 0; i < 16; ++i) s[kt][i] = 0.f;
#pragma unroll
        for (int ks = 0; ks < 4; ++ks) { const bf16x8 ka = *(const LAS bf16x8*)(lds + (kt * 32 + r) * AT_KS + (ks * 16 + h * 8) * 2);
            s[kt] = __builtin_amdgcn_mfma_f32_32x32x16_bf16(ka, qf[ks], s[kt], 0, 0, 0); }
    }
    float mx = -3.0e38f;
#pragma unroll
    for (int kt = 0; kt < 8; ++kt)
#pragma unroll
        for (int i = 0; i < 16; ++i) mx = fmaxf(mx, s[kt][i]);
    mx = fmaxf(mx, __shfl_xor(mx, 32));
    const float sc = 0.125f * 1.4426950408889634f; float sum = 0.f;
#pragma unroll
    for (int kt = 0; kt < 8; ++kt)
#pragma unroll
        for (int i = 0; i < 16; ++i) { const float e = __builtin_amdgcn_exp2f((s[kt][i] - mx) * sc); s[kt][i] = e; sum += e; }
    sum += __shfl_xor(sum, 32);
    f32x16 o[2];
#pragma unroll
    for (int dt = 0; dt < 2; ++dt)
#pragma unroll
        for (int i = 0; i < 16; ++i) o[dt][i] = 0.f;
#pragma unroll
    for (int kt = 0; kt < 8; ++kt)
#pragma unroll
        for (int s2 = 0; s2 < 2; ++s2) {
            const bf16x8 pb = pack_step(s[kt], s2);
#pragma unroll
            for (int dt = 0; dt < 2; ++dt) {
                const LAS unsigned char* vp = lds + AT_VOFF + (32 * dt + r) * AT_VS + (32 * kt + 16 * s2 + 4 * h) * 2;
                const s16x4 lo = *(const LAS s16x4*)vp, hi = *(const LAS s16x4*)(vp + 16);
                const bf16x8 va = __builtin_shufflevector(lo, hi, 0, 1, 2, 3, 4, 5, 6, 7);
                o[dt] = __builtin_amdgcn_mfma_f32_32x32x16_bf16(va, pb, o[dt], 0, 0, 0);
            }
        }
    const float inv = 1.0f / sum;
    bf16_t* orow = MIX + (size_t)(tok0 + r) * D + hh * 64;
#pragma unroll
    for (int dt = 0; dt < 2; ++dt)
#pragma unroll
        for (int gq = 0; gq < 4; ++gq) { u32x2 w; w.x = pk_bf16(o[dt][4 * gq] * inv, o[dt][4 * gq + 1] * inv); w.y = pk_bf16(o[dt][4 * gq + 2] * inv, o[dt][4 * gq + 3] * inv);
            *(u32x2*)(orow + 32 * dt + 8 * gq + 4 * h) = w; }
}

__device__ __forceinline__ void conv_unit(const Args& a, LAS unsigned char* lds, int unit) {
    const int tid = threadIdx.x, lane = tid & 63, wave = __builtin_amdgcn_readfirstlane(tid >> 6);
    const int b = unit >> 6, t0 = (unit & 63) * 64;
    const bf16_t* P = (const bf16_t*)(a.ws + WS_P); bf16_t* MIX = (bf16_t*)(a.ws + WS_MIX);
    LAS _Float16* U = (LAS _Float16*)lds;
    LAS _Float16* Cc = (LAS _Float16*)(lds + 94 * CW * 2);
    __syncthreads();
    for (int q = tid; q < 94 * 48; q += NTHREADS) { const int j = q / 48, cc = (q % 48) * 8, s = t0 - 15 + j;
        float u[8];
        if (s >= 0 && s < SEQ) { const bf16_t* row = P + (size_t)(b * SEQ + s) * IN_PROJ + 256 + cc;
            const u32x4 vv = *(const u32x4*)row, gg = *(const u32x4*)(row + CW);
            const unsigned vw[4] = {vv.x, vv.y, vv.z, vv.w}, gw[4] = {gg.x, gg.y, gg.z, gg.w};
#pragma unroll
            for (int k = 0; k < 4; ++k) { u[2 * k] = bf_lo(vw[k]) * sigmoidf_fast(bf_lo(gw[k])); u[2 * k + 1] = bf_hi(vw[k]) * sigmoidf_fast(bf_hi(gw[k])); }
        } else {
#pragma unroll
            for (int k = 0; k < 8; ++k) u[k] = 0.f; }
        LAS f16x4* dst = (LAS f16x4*)(U + j * CW + cc); dst[0] = (f16x4){(_Float16)u[0], (_Float16)u[1], (_Float16)u[2], (_Float16)u[3]}; dst[1] = (f16x4){(_Float16)u[4], (_Float16)u[5], (_Float16)u[6], (_Float16)u[7]}; }
    __syncthreads();
    const int cq = tid & 127, tq = tid >> 7;
#pragma unroll 1
    for (int k3 = 0; k3 < 3; ++k3) { const int c = cq + 128 * k3;
        float w[31], res[16];
#pragma unroll
        for (int kk = 0; kk < 31; ++kk) w[kk] = a.in[I_CONVW][kk * CW + c];
        const float bias = a.in[I_CONVB][c];
#pragma unroll
        for (int tt = 0; tt < 16; ++tt) res[tt] = bias;
#pragma unroll
        for (int jj = 0; jj < 46; ++jj) { const float uv = (float)U[(tq * 16 + jj) * CW + c];
#pragma unroll
            for (int tt = 0; tt < 16; ++tt) { if (jj - tt >= 0 && jj - tt <= 30) res[tt] += uv * w[jj - tt]; } }
#pragma unroll
        for (int tt = 0; tt < 16; ++tt) Cc[(tq * 16 + tt) * CW + c] = (_Float16)res[tt];
    }
    __syncthreads();
    for (int tt = 0; tt < 8; ++tt) { const int t = wave * 8 + tt;
        float v[6]; float s = 0.f;
#pragma unroll
        for (int i = 0; i < 6; ++i) { v[i] = (float)Cc[t * CW + lane + 64 * i]; s += v[i]; }
        const float mean = wave_sum(s) * (1.f / CW); float q = 0.f;
#pragma unroll
        for (int i = 0; i < 6; ++i) { v[i] -= mean; q += v[i] * v[i]; }
        const float rstd = 1.0f / sqrtf(wave_sum(q) * (1.f / CW) + 1e-5f);
        bf16_t* orow = MIX + (size_t)(b * SEQ + t0 + t) * D + 256;
#pragma unroll
        for (int i = 0; i < 6; ++i) { const int c = lane + 64 * i; const float y = v[i] * rstd * a.in[I_CLNG][c] + a.in[I_CLNB][c]; const float o = y * sigmoidf_fast(y);
            orow[c] = (bf16_t)(pk_bf16(o, 0.f) & 0xffffu); }
    }
}

constexpr int PR_AS = 784;
__device__ __forceinline__ void prep_unit(const Args& a, LAS unsigned char* lds, int unit) {
    const int tid = threadIdx.x, lane = tid & 63, wave = __builtin_amdgcn_readfirstlane(tid >> 6);
    const int b = unit >> 6, t0 = (unit & 63) * 64;
    const bf16_t* P = (const bf16_t*)(a.ws + WS_P);
    _Float16* SC = (_Float16*)(a.ws + WS_SCAN);
    const float* mu = a.in[I_SHIFTMU];
    __syncthreads();
    for (int q = tid; q < 64 * 192; q += NTHREADS) { const int tt = q / 192, c8 = (q % 192) * 8, s = t0 + tt; const size_t tok = (size_t)b * SEQ + s;
        const bf16_t* row = P + tok * IN_PROJ + 1024 + c8;
        const u32x4 cu = *(const u32x4*)row;
        u32x4 pv = {0u, 0u, 0u, 0u}, nv = {0u, 0u, 0u, 0u};
        if (s > 0) pv = *(const u32x4*)(row - IN_PROJ);
        if (s < SEQ - 1) nv = *(const u32x4*)(row + IN_PROJ);
        const unsigned cw[4] = {cu.x, cu.y, cu.z, cu.w}, pw[4] = {pv.x, pv.y, pv.z, pv.w}, nw[4] = {nv.x, nv.y, nv.z, nv.w};
        const f32x4 m0a = *(const f32x4*)(mu + c8), m0b = *(const f32x4*)(mu + c8 + 4), m1a = *(const f32x4*)(mu + 1536 + c8), m1b = *(const f32x4*)(mu + 1536 + c8 + 4);
        const float m0[8] = {m0a.x, m0a.y, m0a.z, m0a.w, m0b.x, m0b.y, m0b.z, m0b.w}, m1[8] = {m1a.x, m1a.y, m1a.z, m1a.w, m1b.x, m1b.y, m1b.z, m1b.w};
        float pf[8];
#pragma unroll
        for (int k = 0; k < 4; ++k) { const float c0 = bf_lo(cw[k]), c1 = bf_hi(cw[k]);
            pf[2 * k] = c0 + m0[2 * k] * (bf_lo(pw[k]) - c0) + m1[2 * k] * (bf_lo(nw[k]) - c0);
            pf[2 * k + 1] = c1 + m0[2 * k + 1] * (bf_hi(pw[k]) - c1) + m1[2 * k + 1] * (bf_hi(nw[k]) - c1); }
        if (c8 < 1152) {
            const int arr = c8 / RW, cc = c8 % RW;
            f16x4 h0 = {(_Float16)pf[0], (_Float16)pf[1], (_Float16)pf[2], (_Float16)pf[3]}, h1 = {(_Float16)pf[4], (_Float16)pf[5], (_Float16)pf[6], (_Float16)pf[7]};
            f16x4* dst = (f16x4*)((unsigned char*)SC + (size_t)arr * SCAN_STRIDE) + (tok * RW + cc) / 4; dst[0] = h0; dst[1] = h1;
        } else {
            const int cc = c8 - 1152;
#pragma unroll
            for (int k = 0; k < 8; ++k) { if (cc < 128) pf[k] = tanhf(pf[k]); else if (cc >= 256) pf[k] = sigmoidf_fast(pf[k]); }
            u32x4 w; w.x = pk_bf16(pf[0], pf[1]); w.y = pk_bf16(pf[2], pf[3]); w.z = pk_bf16(pf[4], pf[5]); w.w = pk_bf16(pf[6], pf[7]);
            *(LAS u32x4*)(lds + tt * PR_AS + cc * 2) = w; }
    }
    __syncthreads();
    const int l15 = lane & 15, kq = lane >> 4, ch0 = wave * 48;
    const bf16_t* SM = (const bf16_t*)(a.ws + WS_SMALL);
#pragma unroll 1
    for (int o = 0; o < 5; ++o) {
        const int kbase = (o < 4) ? o * 64 : 256, KD = (o < 4) ? 64 : 128;
        const bf16_t* WTm = (o < 4) ? SM + (size_t)o * RW * 64 : SM + (size_t)4 * RW * 64;
        f32x4 acc[4][3];
#pragma unroll
        for (int mt = 0; mt < 4; ++mt)
#pragma unroll
            for (int nt = 0; nt < 3; ++nt) acc[mt][nt] = (f32x4){0.f, 0.f, 0.f, 0.f};
        for (int ks = 0; ks < KD / 32; ++ks) {
            bf16x8 bfr[3], afr[4];
#pragma unroll
            for (int nt = 0; nt < 3; ++nt) bfr[nt] = *(const bf16x8*)(WTm + (size_t)(ch0 + nt * 16 + l15) * KD + ks * 32 + kq * 8);
#pragma unroll
            for (int mt = 0; mt < 4; ++mt) afr[mt] = *(const LAS bf16x8*)(lds + (mt * 16 + l15) * PR_AS + (kbase + ks * 32 + kq * 8) * 2);
#pragma unroll
            for (int mt = 0; mt < 4; ++mt)
#pragma unroll
                for (int nt = 0; nt < 3; ++nt) acc[mt][nt] = __builtin_amdgcn_mfma_f32_16x16x32_bf16(afr[mt], bfr[nt], acc[mt][nt], 0, 0, 0);
        }
#pragma unroll
        for (int nt = 0; nt < 3; ++nt) { const int ch = ch0 + nt * 16 + l15;
            float bias = 0.f;
            if (o < 2) bias = a.in[I_DW0][o * RW + ch]; else if (o < 4) bias = a.in[I_IA0][(o - 2) * RW + ch];
#pragma unroll
            for (int mt = 0; mt < 4; ++mt)
#pragma unroll
                for (int rg = 0; rg < 4; ++rg) { const size_t tok = (size_t)b * SEQ + t0 + mt * 16 + kq * 4 + rg; const float z = acc[mt][nt][rg] + bias;
                    if (o < 2) { const float w = __builtin_amdgcn_exp2f(-0.606531f * 1.4426950408889634f * sigmoidf_fast(z)); ((_Float16*)((unsigned char*)SC + (size_t)(3 + o) * SCAN_STRIDE))[tok * RW + ch] = (_Float16)w; }
                    else if (o < 4) { ((_Float16*)((unsigned char*)SC + (size_t)(3 + o) * SCAN_STRIDE))[tok * RW + ch] = (_Float16)sigmoidf_fast(z); }
                    else { ((bf16_t*)(a.ws + WS_G))[tok * RW + ch] = (bf16_t)(pk_bf16(z, 0.f) & 0xffffu); } }
        }
    }
}

constexpr int SC_CT = 32;
constexpr int SC_JV = SC_CT * 8 * 40 * 4;
constexpr int SC_VV = SC_CT * 64 * 4;
constexpr int SC_SC = SC_CT * 2 * 4;
constexpr int SC_Y = SC_CT * 64 * 4;
constexpr int SC_BUF = SC_JV + SC_VV + SC_SC + SC_Y;
struct ScanRegs { f16x4 r, k, v, w, a; };
__device__ __forceinline__ void scan_unit(const Args& a, LAS unsigned char* lds, int unit) {
    const int tid = threadIdx.x, lane = tid & 63, wave = __builtin_amdgcn_readfirstlane(tid >> 6);
    const int dir = unit & 1, bh = unit >> 1, b = bh / NH, hd = bh % NH;
    const _Float16* SCb = (const _Float16*)(a.ws + WS_SCAN);
    const _Float16* Rg = SCb; const _Float16* Kg = (const _Float16*)((const unsigned char*)SCb + SCAN_STRIDE); const _Float16* Vg = (const _Float16*)((const unsigned char*)SCb + 2 * SCAN_STRIDE);
    const _Float16* Wg = (const _Float16*)((const unsigned char*)SCb + (size_t)(3 + dir) * SCAN_STRIDE); const _Float16* Ag = (const _Float16*)((const unsigned char*)SCb + (size_t)(5 + dir) * SCAN_STRIDE);
    float* Yg = (float*)(a.ws + (dir ? WS_YB : WS_YF)); float* BON = (float*)(a.ws + WS_BON) + (size_t)dir * T * NH;
    const int ls = tid >> 4, lq = tid & 15, chl = hd * 64 + 4 * lq;
    const f32x4 kkw = *(const f32x4*)(a.in[I_KK] + chl), kaw = *(const f32x4*)(a.in[I_KA] + chl), rkw = *(const f32x4*)(a.in[I_RK] + chl);
    const int jg = lane & 7, row = wave * 8 + (lane >> 3);
    float S[8];
#pragma unroll
    for (int j = 0; j < 8; ++j) S[j] = 0.f;
    constexpr int NCK = SEQ / SC_CT;
    ScanRegs rg;
#define SCAN_LOAD(ck) do { const int st_ = (ck) * SC_CT + ls; const int t_ = dir ? (SEQ - 1 - st_) : st_; const size_t e_ = ((size_t)b * SEQ + t_) * RW + chl; \
        rg.r = *(const f16x4*)(Rg + e_); rg.k = *(const f16x4*)(Kg + e_); rg.v = *(const f16x4*)(Vg + e_); rg.w = *(const f16x4*)(Wg + e_); rg.a = *(const f16x4*)(Ag + e_); } while (0)
#define SCAN_PROC(ck, buf) do { LAS unsigned char* B_ = lds + (buf) * SC_BUF; \
        const f32x4 r_ = __builtin_convertvector(rg.r, f32x4), k_ = __builtin_convertvector(rg.k, f32x4), v_ = __builtin_convertvector(rg.v, f32x4), w_ = __builtin_convertvector(rg.w, f32x4), a_ = __builtin_convertvector(rg.a, f32x4); \
        f32x4 kk_ = k_ * kkw; float ss_ = (kk_.x * kk_.x + kk_.y * kk_.y) + (kk_.z * kk_.z + kk_.w * kk_.w); ss_ = sum16(ss_); kk_ = kk_ * (1.0f / sqrtf(ss_ + 1e-12f)); \
        const f32x4 b_ = kk_ * a_, kd_ = k_ * (1.0f + (a_ - 1.0f) * kaw), wr_ = w_ * r_; \
        float br_ = (b_.x * r_.x + b_.y * r_.y) + (b_.z * r_.z + b_.w * r_.w), kr_ = (kd_.x * r_.x + kd_.y * r_.y) + (kd_.z * r_.z + kd_.w * r_.w); \
        float bn_ = (kd_.x * r_.x * rkw.x + kd_.y * r_.y * rkw.y) + (kd_.z * r_.z * rkw.z + kd_.w * r_.w * rkw.w); \
        br_ = sum16(br_); kr_ = sum16(kr_); bn_ = sum16(bn_); \
        LAS f32x4* jv_ = (LAS f32x4*)(B_ + ls * 1280 + (lq >> 1) * 160 + (lq & 1) * 16); \
        jv_[0] = kk_; jv_[2] = wr_; jv_[4] = w_; jv_[6] = b_; jv_[8] = kd_; \
        *(LAS f32x4*)(B_ + SC_JV + ls * 256 + lq * 16) = v_; \
        if (lq == 0) { *(LAS f32x2*)(B_ + SC_JV + SC_VV + ls * 8) = (f32x2){br_, kr_}; const int st_ = (ck) * SC_CT + ls; const int t_ = dir ? (SEQ - 1 - st_) : st_; BON[((size_t)b * SEQ + t_) * NH + hd] = bn_; } } while (0)
    __syncthreads();
    SCAN_LOAD(0); SCAN_PROC(0, 0);
    __syncthreads();
#pragma unroll 1
    for (int ck = 0; ck < NCK; ++ck) {
        const int buf = ck & 1;
        if (ck + 1 < NCK) SCAN_LOAD(ck + 1);
        const LAS unsigned char* Bc = lds + buf * SC_BUF;
#pragma unroll 4
        for (int st = 0; st < SC_CT; ++st) {
            const LAS f32x4* jv = (const LAS f32x4*)(Bc + st * 1280 + jg * 160);
            const f32x4 kk0 = jv[0], kk1 = jv[1], wr0 = jv[2], wr1 = jv[3], w0 = jv[4], w1 = jv[5], b0 = jv[6], b1 = jv[7], kd0 = jv[8], kd1 = jv[9];
            const float vi = *(const LAS float*)(Bc + SC_JV + st * 256 + row * 4);
            const f32x2 sc2 = *(const LAS f32x2*)(Bc + SC_JV + SC_VV + st * 8);
            float sa = (S[0] * kk0.x + S[1] * kk0.y) + (S[2] * kk0.z + S[3] * kk0.w) + (S[4] * kk1.x + S[5] * kk1.y) + (S[6] * kk1.z + S[7] * kk1.w);
            float yp = (S[0] * wr0.x + S[1] * wr0.y) + (S[2] * wr0.z + S[3] * wr0.w) + (S[4] * wr1.x + S[5] * wr1.y) + (S[6] * wr1.z + S[7] * wr1.w);
            sa = -sum8(sa); yp = sum8(yp);
            const float y = yp + sa * sc2.x + vi * sc2.y;
            S[0] = S[0] * w0.x + (sa * b0.x + vi * kd0.x); S[1] = S[1] * w0.y + (sa * b0.y + vi * kd0.y); S[2] = S[2] * w0.z + (sa * b0.z + vi * kd0.z); S[3] = S[3] * w0.w + (sa * b0.w + vi * kd0.w);
            S[4] = S[4] * w1.x + (sa * b1.x + vi * kd1.x); S[5] = S[5] * w1.y + (sa * b1.y + vi * kd1.y); S[6] = S[6] * w1.z + (sa * b1.z + vi * kd1.z); S[7] = S[7] * w1.w + (sa * b1.w + vi * kd1.w);
            if (jg == 0) *(LAS float*)(lds + buf * SC_BUF + SC_JV + SC_VV + SC_SC + st * 256 + row * 4) = y;
        }
        __syncthreads();
        {
            const f32x4 yv = *(const LAS f32x4*)(lds + buf * SC_BUF + SC_JV + SC_VV + SC_SC + ls * 256 + lq * 16);
            const int st_ = ck * SC_CT + ls; const int t_ = dir ? (SEQ - 1 - st_) : st_;
            *(f32x4*)(Yg + ((size_t)b * SEQ + t_) * RW + hd * 64 + 4 * lq) = yv;
        }
        if (ck + 1 < NCK) SCAN_PROC(ck + 1, buf ^ 1);
        __syncthreads();
    }
#undef SCAN_LOAD
#undef SCAN_PROC
}

__device__ __forceinline__ void phase_post(const Args& a, int G) {
    const int tid = threadIdx.x, lane = tid & 63, wave = __builtin_amdgcn_readfirstlane(tid >> 6);
    const int gw = blockIdx.x * 8 + wave, NGW = G * 8, q = lane >> 4, l16 = lane & 15;
    const float* __restrict__ YF = (const float*)(a.ws + WS_YF); const float* __restrict__ YB = (const float*)(a.ws + WS_YB); const float* __restrict__ BON = (const float*)(a.ws + WS_BON);
    const _Float16* __restrict__ Vg = (const _Float16*)(a.ws + WS_SCAN + 2 * SCAN_STRIDE); const bf16_t* __restrict__ Gg = (const bf16_t*)(a.ws + WS_G); bf16_t* __restrict__ MIX = (bf16_t*)(a.ws + WS_MIX);
    float* ss = (float*)(a.ws + WS_SS);
    for (int i = blockIdx.x * NTHREADS + tid; i < T; i += G * NTHREADS) ss[i] = 0.f;
    constexpr int NIT = T * NH / 4;
#pragma unroll 4
    for (int it = gw; it < NIT; it += NGW) {
        const int hr = 4 * it + q, tok = hr / NH, hd = hr - tok * NH; const size_t e = (size_t)hr * 64 + 4 * l16;
        const f32x4 yf = *(const f32x4*)(YF + e), yb = *(const f32x4*)(YB + e);
        const f16x4 vh = *(const f16x4*)(Vg + e); const u32x2 gw2 = *(const u32x2*)(Gg + e);
        const float bon = BON[hr] + BON[(size_t)T * NH + hr];
        const f32x4 lg = *(const f32x4*)(a.in[I_LNXG] + hd * 64 + 4 * l16), lb = *(const f32x4*)(a.in[I_LNXB] + hd * 64 + 4 * l16);
        const f32x4 y = yf + yb;
        const float mean = sum16((y.x + y.y) + (y.z + y.w)) * (1.f / 64.f);
        const f32x4 d = y - mean;
        const float var = sum16((d.x * d.x + d.y * d.y) + (d.z * d.z + d.w * d.w)) * (1.f / 64.f);
        const float rstd = 1.0f / sqrtf(var + 64e-5f);
        const f32x4 vv = __builtin_convertvector(vh, f32x4);
        const f32x4 gv = {bf_lo(gw2.x), bf_hi(gw2.x), bf_lo(gw2.y), bf_hi(gw2.y)};
        const f32x4 o = (d * rstd * lg + lb + vv * bon) * gv;
        u32x2 w; w.x = pk_bf16(o.x, o.y); w.y = pk_bf16(o.z, o.w);
        *(u32x2*)(MIX + (size_t)tok * D + 640 + hd * 64 + 4 * l16) = w;
    }
}

constexpr int RT_WS = 2064;
__device__ __forceinline__ void phase_router(const Args& a, LAS unsigned char* lds, int G) {
    const int tid = threadIdx.x, lane = tid & 63, wave = __builtin_amdgcn_readfirstlane(tid >> 6);
    const int gw = blockIdx.x * 8 + wave, NGW = G * 8, l15 = lane & 15, kq = lane >> 4;
    LAS bf16_t* WH = (LAS bf16_t*)lds; LAS bf16_t* WL = (LAS bf16_t*)(lds + 16 * RT_WS);
    for (int i = tid; i < D * NE; i += NTHREADS) { const int k = i >> 4, e = i & 15; const float w = a.in[I_WROUTER][i];
        const unsigned hi = pk_bf16(w, 0.f) & 0xffffu; const float rem = w - bf_lo(hi);
        WH[e * (RT_WS / 2) + k] = (bf16_t)hi; WL[e * (RT_WS / 2) + k] = (bf16_t)(pk_bf16(rem, 0.f) & 0xffffu); }
    __syncthreads();
    const float* __restrict__ X1 = (const float*)(a.ws + WS_X1); const float* __restrict__ ss = (const float*)(a.ws + WS_SS); bf16_t* __restrict__ H2 = (bf16_t*)(a.ws + WS_H2);
    float* __restrict__ AFF = (float*)(a.ws + WS_AFF); int* __restrict__ INV = (int*)(a.ws + WS_INV);
    const float* __restrict__ GF = a.in[I_NFFNG];
    for (int grp = gw; grp < T / 16; grp += NGW) {
        const int tok = grp * 16 + l15;
        const float rs = 1.0f / sqrtf(ss[tok] * (1.f / D) + 1e-6f);
        f32x4 acc = {0.f, 0.f, 0.f, 0.f};
        const float* xrow = X1 + (size_t)tok * D + 8 * kq; bf16_t* hrow = H2 + (size_t)tok * D + 8 * kq;
#pragma unroll 8
        for (int ks = 0; ks < 32; ++ks) {
            const f32x4 x0 = *(const f32x4*)(xrow + 32 * ks), x1v = *(const f32x4*)(xrow + 32 * ks + 4);
            const f32x4 g0 = *(const f32x4*)(GF + 32 * ks + 8 * kq), g1 = *(const f32x4*)(GF + 32 * ks + 8 * kq + 4);
            const f32x4 h0 = x0 * rs * g0, h1 = x1v * rs * g1;
            u32x4 hi; hi.x = pk_bf16(h0.x, h0.y); hi.y = pk_bf16(h0.z, h0.w); hi.z = pk_bf16(h1.x, h1.y); hi.w = pk_bf16(h1.z, h1.w);
            *(u32x4*)(hrow + 32 * ks) = hi;
            u32x4 lo; lo.x = pk_bf16(h0.x - bf_lo(hi.x), h0.y - bf_hi(hi.x)); lo.y = pk_bf16(h0.z - bf_lo(hi.y), h0.w - bf_hi(hi.y));
            lo.z = pk_bf16(h1.x - bf_lo(hi.z), h1.y - bf_hi(hi.z)); lo.w = pk_bf16(h1.z - bf_lo(hi.w), h1.w - bf_hi(hi.w));
            const bf16x8 ah = __builtin_bit_cast(bf16x8, hi), al = __builtin_bit_cast(bf16x8, lo);
            const bf16x8 bh = *(const LAS bf16x8*)(lds + l15 * RT_WS + (32 * ks + 8 * kq) * 2), bl = *(const LAS bf16x8*)(lds + 16 * RT_WS + l15 * RT_WS + (32 * ks + 8 * kq) * 2);
            acc = __builtin_amdgcn_mfma_f32_16x16x32_bf16(ah, bh, acc, 0, 0, 0);
            acc = __builtin_amdgcn_mfma_f32_16x16x32_bf16(al, bh, acc, 0, 0, 0);
            acc = __builtin_amdgcn_mfma_f32_16x16x32_bf16(ah, bl, acc, 0, 0, 0);
        }
#pragma unroll
        for (int rg = 0; rg < 4; ++rg) { const float mx = max16(acc[rg]); const float ex = __expf(acc[rg] - mx); const float sm = sum16(ex);
            const int t2 = grp * 16 + 4 * kq + rg, bb = t2 >> 12, sq = t2 & (SEQ - 1);
            AFF[((size_t)(bb * NE + l15)) * SEQ + sq] = ex / sm; }
        *(u32x4*)(INV + (size_t)grp * 256 + 4 * lane) = (u32x4){0xffffffffu, 0xffffffffu, 0xffffffffu, 0xffffffffu};
    }
}

__device__ __forceinline__ void topk_unit(const Args& a, LAS unsigned char* lds, int unit) {
    const int tid = threadIdx.x, lane = tid & 63, wave = __builtin_amdgcn_readfirstlane(tid >> 6);
    const int b = unit >> 4, e = unit & 15;
    const float* AFF = (const float*)(a.ws + WS_AFF) + (size_t)unit * SEQ;
    LAS unsigned* KEY = (LAS unsigned*)lds;
    LAS unsigned* HIST = (LAS unsigned*)(lds + 16384);
    LAS unsigned* CTL = (LAS unsigned*)(lds + 16384 + 1024);
    LAS unsigned* WS_ = (LAS unsigned*)(lds + 16384 + 2048);
    __syncthreads();
    unsigned key[8];
    { const u32x4 k0 = *(const u32x4*)(AFF + tid * 8), k1 = *(const u32x4*)(AFF + tid * 8 + 4); key[0] = k0.x; key[1] = k0.y; key[2] = k0.z; key[3] = k0.w; key[4] = k1.x; key[5] = k1.y; key[6] = k1.z; key[7] = k1.w; }
    if (tid == 0) { CTL[0] = 0u; CTL[1] = (unsigned)CAP; }
    unsigned prefix = 0u, mask = 0u;
#pragma unroll 1
    for (int pass = 0; pass < 4; ++pass) {
        const int shift = 24 - 8 * pass;
        if (tid < 256) HIST[tid] = 0u;
        __syncthreads();
#pragma unroll
        for (int i = 0; i < 8; ++i) if ((key[i] & mask) == prefix) (void)__hip_atomic_fetch_add(&HIST[(key[i] >> shift) & 255u], 1u, __ATOMIC_RELAXED, __HIP_MEMORY_SCOPE_WORKGROUP);
        __syncthreads();
        if (wave == 0) {
            const unsigned need = CTL[1];
            unsigned hv[4], tsum = 0u;
#pragma unroll
            for (int i = 0; i < 4; ++i) { hv[i] = HIST[255 - (4 * lane + i)]; tsum += hv[i]; }
            unsigned inc = tsum;
#pragma unroll
            for (int o = 1; o < 64; o <<= 1) { const unsigned v = __shfl_up(inc, o); if (lane >= o) inc += v; }
            unsigned exc = inc - tsum;
            if (exc < need && need <= inc) {
                unsigned run = exc; int di = 0;
#pragma unroll
                for (int i = 0; i < 4; ++i) { if (run < need && need <= run + hv[i]) { di = i; break; } run += hv[i]; }
                const unsigned digit = 255u - (unsigned)(4 * lane + di);
                CTL[0] = prefix | (digit << shift); CTL[1] = need - run;
            }
        }
        __syncthreads();
        prefix = CTL[0]; mask |= (255u << shift);
    }
    const unsigned thr = prefix, need_eq = CTL[1];
    unsigned ngt = 0u, neq = 0u;
#pragma unroll
    for (int i = 0; i < 8; ++i) { ngt += (key[i] > thr) ? 1u : 0u; neq += (key[i] == thr) ? 1u : 0u; }
    unsigned pk = ngt | (neq << 16), inc = pk;
#pragma unroll
    for (int o = 1; o < 64; o <<= 1) { const unsigned v = __shfl_up(inc, o); if (lane >= o) inc += v; }
    if (lane == 63) WS_[wave] = inc;
    __syncthreads();
    unsigned woff = 0u, tot = 0u;
#pragma unroll
    for (int w = 0; w < 8; ++w) { const unsigned v = WS_[w]; if (w < wave) woff += v; tot += v; }
    const unsigned exc = inc - pk + woff;
    unsigned gpos = exc & 0xffffu, epos = exc >> 16; const unsigned totgt = tot & 0xffffu;
    const int sbase = (e * BATCH + b) * CAP;
    int* ROWTOK = (int*)(a.ws + WS_ROWTOK); float* ROWGATE = (float*)(a.ws + WS_ROWGATE); int* INV = (int*)(a.ws + WS_INV);
#pragma unroll
    for (int i = 0; i < 8; ++i) {
        int pos = -1;
        if (key[i] > thr) pos = (int)gpos++;
        else if (key[i] == thr) { if (epos < need_eq) pos = (int)(totgt + epos); epos++; }
        if (pos >= 0) { const int s = tid * 8 + i, tok = b * SEQ + s, slot = sbase + pos;
            ROWTOK[slot] = tok; ROWGATE[slot] = __builtin_bit_cast(float, key[i]); INV[(size_t)tok * NE + e] = slot; }
    }
}

__device__ __forceinline__ void phase_final(const Args& a, int G) {
    const int tid = threadIdx.x, lane = tid & 63, wave = __builtin_amdgcn_readfirstlane(tid >> 6);
    const int gw = blockIdx.x * 8 + wave, NGW = G * 8;
    const float* __restrict__ X1 = (const float*)(a.ws + WS_X1); const bf16_t* __restrict__ YE = (const bf16_t*)(a.ws + WS_YE); const int* __restrict__ INV = (const int*)(a.ws + WS_INV);
    float* __restrict__ OUT = a.out;
    f32x4 gg[4];
#pragma unroll
    for (int j = 0; j < 4; ++j) gg[j] = *(const f32x4*)(a.in[I_FNG] + 4 * lane + 256 * j);
    int tok = gw;
    int invn = (tok < T) ? INV[(size_t)tok * NE + (lane & 15)] : -1;
    f32x4 xn[4];
#pragma unroll
    for (int j = 0; j < 4; ++j) xn[j] = (tok < T) ? *(const f32x4*)(X1 + (size_t)tok * D + 4 * lane + 256 * j) : (f32x4){0.f, 0.f, 0.f, 0.f};
    for (; tok < T; tok += NGW) {
        const int invc = invn; f32x4 v[4];
#pragma unroll
        for (int j = 0; j < 4; ++j) v[j] = xn[j];
        const int tn = tok + NGW;
        if (tn < T) { invn = INV[(size_t)tn * NE + (lane & 15)];
#pragma unroll
            for (int j = 0; j < 4; ++j) xn[j] = *(const f32x4*)(X1 + (size_t)tn * D + 4 * lane + 256 * j); }
        unsigned long long m = __ballot(invc >= 0) & 0xffffull;
        const int n = __builtin_popcountll(m);
        int sl[4]; float wt[4];
#pragma unroll
        for (int k = 0; k < 4; ++k) { int e = 0; if (m) { e = __builtin_ctzll(m); m &= m - 1; wt[k] = 1.f; sl[k] = __builtin_amdgcn_readlane(invc, e); } else { wt[k] = 0.f; sl[k] = 0; } }
        u32x2 rw[4][4];
#pragma unroll
        for (int k = 0; k < 4; ++k)
#pragma unroll
            for (int j = 0; j < 4; ++j) rw[k][j] = *(const u32x2*)(YE + (size_t)sl[k] * D + 4 * lane + 256 * j);
#pragma unroll
        for (int k = 0; k < 4; ++k)
#pragma unroll
            for (int j = 0; j < 4; ++j) { v[j].x += wt[k] * bf_lo(rw[k][j].x); v[j].y += wt[k] * bf_hi(rw[k][j].x); v[j].z += wt[k] * bf_lo(rw[k][j].y); v[j].w += wt[k] * bf_hi(rw[k][j].y); }
        if (n > 4) { while (m) { const int e = __builtin_ctzll(m); m &= m - 1; const int slot = __builtin_amdgcn_readlane(invc, e);
#pragma unroll
                for (int j = 0; j < 4; ++j) { const u32x2 w = *(const u32x2*)(YE + (size_t)slot * D + 4 * lane + 256 * j);
                    v[j].x += bf_lo(w.x); v[j].y += bf_hi(w.x); v[j].z += bf_lo(w.y); v[j].w += bf_hi(w.y); } } }
        float sq = 0.f;
#pragma unroll
        for (int j = 0; j < 4; ++j) sq += (v[j].x * v[j].x + v[j].y * v[j].y) + (v[j].z * v[j].z + v[j].w * v[j].w);
        const float rs = 1.0f / sqrtf(wave_sum(sq) * (1.f / D) + 1e-6f);
#pragma unroll
        for (int j = 0; j < 4; ++j) *(f32x4*)(OUT + (size_t)tok * D + 4 * lane + 256 * j) = v[j] * rs * gg[j];
    }
}

#define XB_TMO      128
#define XB_XCNT(j)  (256  + 64 * (j))
#define XB_XSUB(j)  (1280 + 64 * (j))
#define XB_XGEN(j)  (2304 + 64 * (j))
#define XB_TOP      3328
#define XB_TOPGEN   3392
#define XCD_BAR_WORDS 3456
#define XB_SPIN_CAP (1u << 22)
__device__ __forceinline__ unsigned xb_ld(unsigned* p)              { return __hip_atomic_load(p, __ATOMIC_RELAXED, __HIP_MEMORY_SCOPE_AGENT); }
__device__ __forceinline__ unsigned xb_add(unsigned* p, unsigned v) { return __hip_atomic_fetch_add(p, v, __ATOMIC_RELAXED, __HIP_MEMORY_SCOPE_AGENT); }
__device__ __forceinline__ unsigned xb_xcc_id() { return (unsigned)__builtin_amdgcn_s_getreg((3 << 11) | 20) & 0xFu; }
#define XB_SPIN(cond, bar) do { unsigned _sp = 0; while (cond) { __builtin_amdgcn_s_sleep(1); \
    if ((++_sp & 255u) == 0u) { if (xb_ld(&(bar)[XB_TMO])) break; if (_sp > XB_SPIN_CAP) { atomicAdd(&(bar)[XB_TMO], 1u); break; } } } } while (0)
struct XcdBarrier { unsigned* bar; unsigned x; volatile LAS unsigned* st; };
__device__ __forceinline__ XcdBarrier xcd_barrier_post(unsigned* bar, volatile LAS unsigned* st) {
    XcdBarrier b; b.bar = bar; b.x = xb_xcc_id(); b.st = st;
    if (threadIdx.x == 0) (void)xb_add(&bar[XB_XCNT(b.x)], 1u);
    return b;
}
__device__ __forceinline__ void xcd_barrier_complete(unsigned* bar, unsigned x, unsigned& nloc, unsigned& nx) {
    const unsigned G = gridDim.x * gridDim.y * gridDim.z;
    unsigned sum, cnt, mine, sp = 0u;
    for (;;) {
        sum = 0u; cnt = 0u; mine = 0u;
#pragma unroll
        for (unsigned j = 0; j < 16; ++j) { const unsigned c = xb_ld(&bar[XB_XCNT(j)]); sum += c; cnt += (c > 0u) ? 1u : 0u; mine = (j == x) ? c : mine; }
        if (sum == G) break;
        __builtin_amdgcn_s_sleep(1);
        if ((++sp & 255u) == 0u) { if (xb_ld(&bar[XB_TMO])) break; if (sp > XB_SPIN_CAP) { atomicAdd(&bar[XB_TMO], 1u); break; } }
    }
    nloc = mine > 0u ? mine : 1u; nx = cnt > 0u ? cnt : 1u;
}
__device__ __forceinline__ void xcd_barrier(const XcdBarrier& b) {
    asm volatile("s_waitcnt vmcnt(0)" ::: "memory");
    __syncthreads();
    if (threadIdx.x == 0) {
        unsigned* bar = b.bar;
        __builtin_amdgcn_s_waitcnt(0);
        unsigned nloc = b.st[0], nx = b.st[1];
        if (nloc == 0u) { xcd_barrier_complete(bar, b.x, nloc, nx); b.st[0] = nloc; b.st[1] = nx; }
        const unsigned old = xb_add(&bar[XB_XSUB(b.x)], 1u);
        const unsigned gen = old / nloc;
        if (old + 1u == (gen + 1u) * nloc) {
            __builtin_amdgcn_fence(__ATOMIC_RELEASE, "agent");
            asm volatile("s_waitcnt vmcnt(0)" ::: "memory");
            const unsigned og = xb_add(&bar[XB_TOP], 1u);
            const unsigned tg = og / nx;
            if (og + 1u == (tg + 1u) * nx) xb_add(&bar[XB_TOPGEN], 1u);
            else XB_SPIN(xb_ld(&bar[XB_TOPGEN]) == tg, bar);
            __builtin_amdgcn_fence(__ATOMIC_ACQUIRE, "agent");
            xb_add(&bar[XB_XGEN(b.x)], 1u);
            asm volatile("s_waitcnt vmcnt(0)" ::: "memory");
        } else {
            XB_SPIN(xb_ld(&bar[XB_XGEN(b.x)]) == gen, bar);
            __builtin_amdgcn_fence(__ATOMIC_ACQUIRE, "agent");
            asm volatile("s_waitcnt vmcnt(0)" ::: "memory");
        }
    }
    __syncthreads();
}

#ifndef PH_MASK
#define PH_MASK 0x7ff
#endif
#ifndef REP_MASK
#define REP_MASK 0
#endif
#ifndef P2_MASK
#define P2_MASK 7
#endif
#ifndef P2_REP
#define P2_REP 0
#endif
constexpr int LDS_MISC = LDS_BYTES - 64;
constexpr size_t WS_CTL = 0, CTL_BYTES = 16384;
__global__ void __launch_bounds__(NTHREADS, 2) mega(Args a) {
    extern __shared__ __attribute__((aligned(16))) unsigned char lds_raw[];
    LAS unsigned char* lds = (LAS unsigned char*)lds_raw;
    cg::grid_group grid = cg::this_grid();
    const int G = gridDim.x, lo = a.ph_lo, hi = a.ph_hi;
    unsigned char* ws = a.ws;
    volatile LAS unsigned* misc = (volatile LAS unsigned*)(lds + LDS_MISC);
    if (threadIdx.x < 16) misc[threadIdx.x] = 0u;
    __syncthreads();
    XcdBarrier xbar = xcd_barrier_post((unsigned*)(ws + WS_CTL), misc);
#define IN(k) (((PH_MASK >> (k)) & 1) && lo <= (k) && (k) < hi)
#define NREP(k) (1 + ((REP_MASK >> (k)) & 1))
#define PHASE(k, ...) do { if (IN(k)) { for (int rep_ = 0; rep_ < NREP(k); ++rep_) { __VA_ARGS__; if (rep_ + 1 < NREP(k) || IN((k) + 1)) { if ((k) == 0 && rep_ + 1 == NREP(k)) grid.sync(); else xcd_barrier(xbar); } } } } while (0)

    PHASE(0, phase_prep(a, lds, G));

    PHASE(1, {
        { pg8::Gemm g{(const bf16_t*)(ws + WS_XH), (const bf16_t*)(ws + WS_WINT), T, IN_PROJ, D}; pg8::StaticOrder S; S.init(T, IN_PROJ, G, (int)blockIdx.x);
          pg8::EpiBf16 E{(bf16_t*)(ws + WS_P), IN_PROJ}; pg8::gemm_phase<pg8::EpiBf16, pg8::StaticOrder, false>(lds, g, S, E, nullptr); }
        { pg8::Gemm g{(const bf16_t*)(ws + WS_MEMN), (const bf16_t*)(ws + WS_WKT), BATCH * NMEM, 256, D}; pg8::StaticOrder S; S.init(BATCH * NMEM, 256, G, (int)blockIdx.x);
          pg8::EpiBf16 E{(bf16_t*)(ws + WS_KMEM), 256}; pg8::gemm_phase<pg8::EpiBf16, pg8::StaticOrder, false>(lds, g, S, E, nullptr); }
        { pg8::Gemm g{(const bf16_t*)(ws + WS_WVT), (const bf16_t*)(ws + WS_MEMN), 256, BATCH * NMEM, D}; pg8::StaticOrder S; S.init(256, BATCH * NMEM, G, (int)blockIdx.x);
          pg8::EpiBf16 E{(bf16_t*)(ws + WS_VT), BATCH * NMEM}; pg8::gemm_phase<pg8::EpiBf16, pg8::StaticOrder, false>(lds, g, S, E, nullptr); }
    });

    PHASE(2, {
        for (int u = blockIdx.x; u < 3072; u += G) {
            if (u < 1024) { for (int r2 = 0; r2 < 1 + (P2_REP & 1); ++r2) if (P2_MASK & 1) attn_unit(a, lds, u); }
            else if (u < 2048) { for (int r2 = 0; r2 < 1 + ((P2_REP >> 1) & 1); ++r2) if (P2_MASK & 2) conv_unit(a, lds, u - 1024); }
            else { for (int r2 = 0; r2 < 1 + ((P2_REP >> 2) & 1); ++r2) if (P2_MASK & 4) prep_unit(a, lds, u - 2048); }
        }
    });

    PHASE(3, { for (int u = blockIdx.x; u < BATCH * NH * 2; u += G) scan_unit(a, lds, u); });

    PHASE(4, phase_post(a, G));

    PHASE(5, {
        pg8::Gemm g{(const bf16_t*)(ws + WS_MIX), (const bf16_t*)(ws + WS_WOUTT), T, D, D}; pg8::StaticOrder S; S.init(T, D, G, (int)blockIdx.x);
        pg8::EpiResidSS E{a.in[I_X], (float*)(ws + WS_X1), (float*)(ws + WS_SS)}; pg8::gemm_phase<pg8::EpiResidSS, pg8::StaticOrder, false>(lds, g, S, E, nullptr);
    });

    PHASE(6, phase_router(a, lds, G));

    PHASE(7, { for (int u = blockIdx.x; u < BATCH * NE; u += G) topk_unit(a, lds, u); });

    PHASE(8, {
        pg8::Gemm g{(const bf16_t*)(ws + WS_H2), (const bf16_t*)(ws + WS_WGUT), NSLOT, 2048, D}; pg8::ExpertOrder S; S.init(32, 8, NE, G, (int)blockIdx.x);
        pg8::EpiSwiGLU E{(bf16_t*)(ws + WS_HID)}; pg8::gemm_phase<pg8::EpiSwiGLU, pg8::ExpertOrder, true>(lds, g, S, E, (const int*)(ws + WS_ROWTOK));
    });

    PHASE(9, {
        pg8::Gemm g{(const bf16_t*)(ws + WS_HID), (const bf16_t*)(ws + WS_WDT), NSLOT, D, FF}; pg8::ExpertOrder S; S.init(32, 4, NE, G, (int)blockIdx.x);
        pg8::EpiGateScale E{(bf16_t*)(ws + WS_YE), (const float*)(ws + WS_ROWGATE)}; pg8::gemm_phase<pg8::EpiGateScale, pg8::ExpertOrder, false>(lds, g, S, E, nullptr);
    });

    PHASE(10, phase_final(a, G));
#undef IN
#undef NREP
#undef PHASE
}

#ifndef MK_ONE_LAUNCH
#define MK_ONE_LAUNCH 1
#endif
extern "C" void kernel_launch(void* const* d_in, const int* in_sizes, int n_in, void* d_out, int out_size, void* d_ws, size_t ws_size, hipStream_t stream) {
    static int grid_blocks = 0;
    if (grid_blocks == 0) {
        if (n_in != 29 || out_size != T * D || ws_size < WS_END) { fprintf(stderr, "kernel_launch: unexpected problem: n_in %d out %d ws %zu (need %zu)\n", n_in, out_size, ws_size, (size_t)WS_END); grid_blocks = -1; return; }
        int dev = 0, cus = 0, per_cu = 0;
        if (hipGetDevice(&dev) != hipSuccess || hipDeviceGetAttribute(&cus, hipDeviceAttributeMultiprocessorCount, dev) != hipSuccess) { grid_blocks = -1; return; }
        if (hipFuncSetAttribute((const void*)mega, hipFuncAttributeMaxDynamicSharedMemorySize, LDS_BYTES) != hipSuccess) { fprintf(stderr, "kernel_launch: hipFuncSetAttribute failed\n"); grid_blocks = -1; return; }
        if (hipOccupancyMaxActiveBlocksPerMultiprocessor(&per_cu, (const void*)mega, NTHREADS, LDS_BYTES) != hipSuccess || per_cu < 1) { fprintf(stderr, "kernel_launch: occupancy query says %d blocks per CU\n", per_cu); grid_blocks = -1; return; }
        grid_blocks = cus;
    }
    if (grid_blocks < 0) return;
    if (hipMemsetAsync((char*)d_ws + WS_CTL, 0, CTL_BYTES, stream) != hipSuccess) { fprintf(stderr, "kernel_launch: memset failed\n"); return; }
    Args a{};
    for (int i = 0; i < 29; ++i) a.in[i] = (const float*)d_in[i];
    a.out = (float*)d_out; a.ws = (unsigned char*)d_ws;
#if MK_ONE_LAUNCH
    a.ph_lo = 0; a.ph_hi = NPHASE;
    { void* args[] = {&a}; hipError_t e = hipLaunchCooperativeKernel((const void*)mega, dim3(grid_blocks), dim3(NTHREADS), args, LDS_BYTES, stream);
      if (e != hipSuccess) fprintf(stderr, "cooperative launch failed: %s (grid %d)\n", hipGetErrorString(e), grid_blocks); }
#else
    for (int ph = 0; ph < NPHASE; ++ph) { a.ph_lo = ph; a.ph_hi = ph + 1; void* args[] = {&a};
        hipError_t e = hipLaunchCooperativeKernel((const void*)mega, dim3(grid_blocks), dim3(NTHREADS), args, LDS_BYTES, stream);
        if (e != hipSuccess) { fprintf(stderr, "cooperative launch %d failed: %s (grid %d)\n", ph, hipGetErrorString(e), grid_blocks); break; } }
#endif
}
```

```cpp
#include <hip/hip_runtime.h>
#include <hip/hip_cooperative_groups.h>
#include <cstdio>
#include <cstdint>
namespace cg = cooperative_groups;

#define LAS __attribute__((address_space(3)))
typedef unsigned short bf16_t;
typedef short bf16x8 __attribute__((ext_vector_type(8)));
typedef short s16x4 __attribute__((ext_vector_type(4)));
typedef float f32x2 __attribute__((ext_vector_type(2)));
typedef float f32x4 __attribute__((ext_vector_type(4)));
typedef float f32x16 __attribute__((ext_vector_type(16)));
typedef unsigned u32x2 __attribute__((ext_vector_type(2)));
typedef unsigned u32x4 __attribute__((ext_vector_type(4)));
typedef _Float16 f16x4 __attribute__((ext_vector_type(4)));
typedef __bf16 bf16v2 __attribute__((ext_vector_type(2)));

constexpr int D = 1024, BATCH = 16, SEQ = 4096, T = BATCH * SEQ, NMEM = 256;
constexpr int IN_PROJ = 2560, CW = 384, RW = 384, NH = 6, NE = 16, FF = 1024, CAP = 512;
constexpr int NSLOT = NE * BATCH * CAP;
constexpr int NTHREADS = 512;
constexpr int LDS_BYTES = 160 * 1024;
constexpr int NPHASE = 11;
#ifndef SCAN_MODE
#define SCAN_MODE 1
#endif

constexpr size_t MiB = 1u << 20;
constexpr size_t WS_WINT = 1 * MiB;
constexpr size_t WS_WOUTT = 6 * MiB;
constexpr size_t WS_WKT = 8 * MiB;
constexpr size_t WS_WVT = 8 * MiB + 512 * 1024;
constexpr size_t WS_SMALL = 9 * MiB;
constexpr size_t WS_WGUT = 10 * MiB;
constexpr size_t WS_WDT = 74 * MiB;
constexpr size_t WS_KMEM = 106 * MiB;
constexpr size_t WS_VT = 108 * MiB;
constexpr size_t WS_ROWTOK = 106 * MiB;
constexpr size_t WS_ROWGATE = 106 * MiB + 512 * 1024;
constexpr size_t WS_SS = 107 * MiB;
constexpr size_t WS_P = 112 * MiB;
constexpr size_t WS_YF = 112 * MiB;
constexpr size_t WS_YB = 208 * MiB;
constexpr size_t WS_X1 = 112 * MiB;
constexpr size_t WS_XH = 432 * MiB;
constexpr size_t WS_G = 432 * MiB;
constexpr size_t WS_BON = 480 * MiB;
constexpr size_t WS_H2 = 432 * MiB;
constexpr size_t WS_MEMN = 560 * MiB;
constexpr size_t WS_MIX = 560 * MiB;
constexpr size_t WS_SCAN = 688 * MiB;
constexpr size_t SCAN_STRIDE = 48 * MiB;
constexpr size_t WS_AFF = 624 * MiB;
constexpr size_t WS_INV = 628 * MiB;
constexpr size_t WS_HID = 768 * MiB;
constexpr size_t WS_YE = 368 * MiB;
constexpr size_t WS_END = 1024 * MiB;

__device__ __forceinline__ unsigned pk_bf16(float lo, float hi) { f32x2 v = {lo, hi}; bf16v2 b = __builtin_convertvector(v, bf16v2); return __builtin_bit_cast(unsigned, b); }
__device__ __forceinline__ float bf_lo(unsigned u) { return __builtin_bit_cast(float, u << 16); }
__device__ __forceinline__ float bf_hi(unsigned u) { return __builtin_bit_cast(float, u & 0xffff0000u); }
__device__ __forceinline__ float wave_sum(float v) {
#pragma unroll
    for (int o = 1; o < 64; o <<= 1) v += __shfl_xor(v, o);
    return v;
}
__device__ __forceinline__ float sigmoidf_fast(float x) { return __builtin_amdgcn_rcpf(1.0f + __builtin_amdgcn_exp2f(-1.4426950408889634f * x)); }
template <int CTRL> __device__ __forceinline__ float dpp_f(float x) { return __builtin_bit_cast(float, __builtin_amdgcn_update_dpp(0, __builtin_bit_cast(int, x), CTRL, 0xF, 0xF, true)); }
__device__ __forceinline__ float sum8(float x) { x += dpp_f<0xB1>(x); x += dpp_f<0x4E>(x); x += dpp_f<0x141>(x); return x; }
__device__ __forceinline__ float sum16(float x) { x = sum8(x); x += dpp_f<0x140>(x); return x; }
__device__ __forceinline__ float max16(float x) { x = fmaxf(x, dpp_f<0xB1>(x)); x = fmaxf(x, dpp_f<0x4E>(x)); x = fmaxf(x, dpp_f<0x141>(x)); x = fmaxf(x, dpp_f<0x140>(x)); return x; }

namespace pg8 {
#define PG8_LAS __attribute__((address_space(3)))
constexpr int BM = 256, BK = 64, HALF = 128, HTB = HALF * BK * 2, STAGE_BYTES = 8 * HTB, NXCD = 8, WGM = 8;
__host__ __device__ __forceinline__ int lds_byte(int r, int c) { const int st = (r >> 4) * 2 + (c >> 5), rr = r & 15, cc = c & 31, ob = rr * 64 + cc * 2; return st * 1024 + (ob ^ (((ob >> 9) & 1) << 5)); }
__host__ __device__ __forceinline__ void stage_rc(int b, int& R, int& C) { const int st = b / 1024, sb = b % 1024, swz = sb ^ (((sb >> 9) & 1) << 5); R = (st >> 1) * 16 + swz / 64; C = (st & 1) * 32 + (swz % 64) / 2; }
__host__ __device__ __forceinline__ int perm32(int rho) { const int n = rho >> 4, i = rho & 15; return 8 * (i >> 2) + 4 * n + (i & 3); }

struct Unit { int pm, pn; };
struct Gemm { const bf16_t* A; const bf16_t* Bt; int M, N, K; };

struct StaticOrder {
    int nM, nN, nwg, G, c;
    __device__ void init(int M, int N, int G_, int c_) { nM = M / BM; nN = N / BM; nwg = nM * nN; G = G_; c = c_; }
    __device__ bool next(int i, Unit& u) const {
        const long L = (long)i * G + c; if (L >= nwg) return false;
        int wgid = (int)L; { const int q = nwg / NXCD, r = nwg % NXCD, xcd = wgid % NXCD, off = wgid / NXCD; wgid = (xcd < r ? xcd * (q + 1) : r * (q + 1) + (xcd - r) * q) + off; }
        const int nig = WGM * nN, gid = wgid / nig, fm = gid * WGM, gsz = (nM - fm) < WGM ? (nM - fm) : WGM;
        u.pm = fm + ((wgid % nig) % gsz); u.pn = (wgid % nig) / gsz; return true;
    }
};
struct ExpertOrder {
    int nMe, nNe, per, total, G, c;
    __device__ void init(int nMe_, int nNe_, int nExp, int G_, int c_) { nMe = nMe_; nNe = nNe_; per = nMe * nNe; total = per * nExp; G = G_; c = c_; }
    __device__ bool next(int i, Unit& u) const {
        const long L = (long)i * G + c; if (L >= total) return false;
        const int e = (int)(L / per), w = (int)(L % per), xl = w % 8, j = w / 8, rpx = nMe / 8;
        u.pm = e * nMe + xl * rpx + (j % rpx); u.pn = e * nNe + j / rpx; return true;
    }
};

struct EpiBf16 {
    static constexpr bool PERM = true;
    bf16_t* O; int ldc;
    __device__ __forceinline__ void operator()(const f32x4 (&acc)[2][2][4][2], const Unit& u, int wr, int wc, int fr, int fq) const {
        const int row0 = u.pm * BM + wr * 64 + fr, col0 = u.pn * BM + wc * 32 + 8 * fq;
#pragma unroll
        for (int ai = 0; ai < 2; ++ai)
#pragma unroll
            for (int m = 0; m < 4; ++m) { bf16_t* rowp = O + (size_t)(row0 + ai * HALF + m * 16) * ldc + col0;
#pragma unroll
                for (int bj = 0; bj < 2; ++bj) { const f32x4 v0 = acc[ai][bj][m][0], v1 = acc[ai][bj][m][1];
                    u32x4 w; w.x = pk_bf16(v0[0], v0[1]); w.y = pk_bf16(v0[2], v0[3]); w.z = pk_bf16(v1[0], v1[1]); w.w = pk_bf16(v1[2], v1[3]);
                    *(u32x4*)(rowp + bj * HALF) = w; } }
    }
};
struct EpiResidSS {
    static constexpr bool PERM = false;
    const float* X; float* X1; float* ss;
    __device__ __forceinline__ void operator()(const f32x4 (&acc)[2][2][4][2], const Unit& u, int wr, int wc, int fr, int fq) const {
        const int row0 = u.pm * BM + wr * 64 + fr, col0 = u.pn * BM + wc * 32 + 4 * fq;
#pragma unroll
        for (int ai = 0; ai < 2; ++ai)
#pragma unroll
            for (int m = 0; m < 4; ++m) { const int row = row0 + ai * HALF + m * 16; const size_t off = (size_t)row * D + col0; float s = 0.f;
#pragma unroll
                for (int bj = 0; bj < 2; ++bj)
#pragma unroll
                    for (int n = 0; n < 2; ++n) { const f32x4 xv = *(const f32x4*)(X + off + bj * HALF + n * 16); const f32x4 o = xv + acc[ai][bj][m][n];
                        *(f32x4*)(X1 + off + bj * HALF + n * 16) = o; s += (o[0] * o[0] + o[1] * o[1]) + (o[2] * o[2] + o[3] * o[3]); }
                s += __shfl_xor(s, 16); s += __shfl_xor(s, 32);
                if (fq == 0) (void)__hip_atomic_fetch_add(ss + row, s, __ATOMIC_RELAXED, __HIP_MEMORY_SCOPE_AGENT); }
    }
};
struct EpiSwiGLU {
    static constexpr bool PERM = true;
    bf16_t* H;
    __device__ __forceinline__ void operator()(const f32x4 (&acc)[2][2][4][2], const Unit& u, int wr, int wc, int fr, int fq) const {
        const int row0 = u.pm * BM + wr * 64 + fr, col0 = (u.pn & 7) * HALF + wc * 32 + 8 * fq;
#pragma unroll
        for (int ai = 0; ai < 2; ++ai)
#pragma unroll
            for (int m = 0; m < 4; ++m) { bf16_t* rowp = H + (size_t)(row0 + ai * HALF + m * 16) * FF + col0; float h[8];
#pragma unroll
                for (int n = 0; n < 2; ++n)
#pragma unroll
                    for (int j = 0; j < 4; ++j) { const float gt = acc[ai][0][m][n][j], up = acc[ai][1][m][n][j]; h[n * 4 + j] = gt * sigmoidf_fast(gt) * up; }
                u32x4 w; w.x = pk_bf16(h[0], h[1]); w.y = pk_bf16(h[2], h[3]); w.z = pk_bf16(h[4], h[5]); w.w = pk_bf16(h[6], h[7]);
                *(u32x4*)rowp = w; }
    }
};
struct EpiGateScale {
    static constexpr bool PERM = true;
    bf16_t* Y; const float* gate;
    __device__ __forceinline__ void operator()(const f32x4 (&acc)[2][2][4][2], const Unit& u, int wr, int wc, int fr, int fq) const {
        const int row0 = u.pm * BM + wr * 64 + fr, col0 = (u.pn & 3) * BM + wc * 32 + 8 * fq;
#pragma unroll
        for (int ai = 0; ai < 2; ++ai)
#pragma unroll
            for (int m = 0; m < 4; ++m) { const int row = row0 + ai * HALF + m * 16; const float gs = gate[row]; bf16_t* rowp = Y + (size_t)row * D + col0;
#pragma unroll
                for (int bj = 0; bj < 2; ++bj) { const f32x4 v0 = acc[ai][bj][m][0] * gs, v1 = acc[ai][bj][m][1] * gs;
                    u32x4 w; w.x = pk_bf16(v0[0], v0[1]); w.y = pk_bf16(v0[2], v0[3]); w.z = pk_bf16(v1[0], v1[1]); w.w = pk_bf16(v1[2], v1[3]);
                    *(u32x4*)(rowp + bj * HALF) = w; } }
    }
};

template <class Epi, class Sched, bool GATHER>
__device__ __forceinline__ void gemm_phase(PG8_LAS unsigned char* lds, const Gemm g, const Sched& S, const Epi& E, const int* rowtok) {
    const int tid = threadIdx.x, wid = __builtin_amdgcn_readfirstlane(tid >> 6), lane = tid & 63, wr = wid >> 2, wc = wid & 3, fr = lane & 15, fq = lane >> 4;
    const int K = g.K, nt = K / BK;
    unsigned voffA[2], voffB[2]; int Rr[2], Cc[2];
#pragma unroll
    for (int i = 0; i < 2; ++i) { int R, C; stage_rc(tid * 16 + i * 8192, R, C); const int Rb = Epi::PERM ? ((R & ~31) + perm32(R & 31)) : R; Rr[i] = R; Cc[i] = C;
        voffA[i] = (unsigned)(R * K + C) * 2u; voffB[i] = (unsigned)(Rb * K + C) * 2u; }
    unsigned vAc[2][2], vAn[2][2];
    const size_t kstep = (size_t)(BK * 2);
    const size_t hstep = (size_t)HALF * K * 2;
    const size_t tstep = 2 * hstep;
    const unsigned ldsw = (unsigned)wid * 1024u;
    const int aoff = lds_byte(wr * 64 + fr, fq * 8), boff = lds_byte(wc * 32 + fr, fq * 8);
#define PG8_SA(b, h) (((b) * 2 + (h)) * HTB)
#define PG8_SB(b, h) ((4 + (b) * 2 + (h)) * HTB)
#define PG8_STAGE(bufoff, gbase, voff) do { _Pragma("unroll") for (int _i = 0; _i < 2; ++_i) \
        __builtin_amdgcn_global_load_lds((const unsigned*)((const char*)(gbase) + (voff)[_i]), (PG8_LAS unsigned*)(lds + (bufoff) + ldsw + _i * 8192), 16, 0, 0); } while (0)
#define PG8_STAGE_A(bufoff, hh, dbase, kbytes, vsel) do { if constexpr (GATHER) { PG8_STAGE(bufoff, (const char*)g.A + (kbytes), (vsel)[hh]); } else { PG8_STAGE(bufoff, (dbase) + ((hh) ? hstep : 0), voffA); } } while (0)
#define PG8_GATHER_OFF(dst, un) do { _Pragma("unroll") for (int _h = 0; _h < 2; ++_h) _Pragma("unroll") for (int _i = 0; _i < 2; ++_i) \
        (dst)[_h][_i] = (unsigned)rowtok[(un).pm * BM + _h * HALF + Rr[_i]] * (unsigned)(K * 2) + (unsigned)(Cc[_i] * 2); } while (0)
#define PG8_LDA(dst, b, h) do { _Pragma("unroll") for (int m = 0; m < 4; ++m) _Pragma("unroll") for (int k = 0; k < 2; ++k) dst[m][k] = *(const PG8_LAS bf16x8*)(lds + PG8_SA(b, h) + aoff + m * 2048 + k * 1024); } while (0)
#define PG8_LDB(dst, b, h) do { _Pragma("unroll") for (int n = 0; n < 2; ++n) _Pragma("unroll") for (int k = 0; k < 2; ++k) dst[n][k] = *(const PG8_LAS bf16x8*)(lds + PG8_SB(b, h) + boff + n * 2048 + k * 1024); } while (0)
#define PG8_MMA(ai, bj, At, Bt) do { __builtin_amdgcn_s_setprio(1); _Pragma("unroll") for (int m = 0; m < 4; ++m) _Pragma("unroll") for (int n = 0; n < 2; ++n) _Pragma("unroll") for (int k = 0; k < 2; ++k) \
        acc[ai][bj][m][n] = __builtin_amdgcn_mfma_f32_16x16x32_bf16(Bt[n][k], At[m][k], acc[ai][bj][m][n], 0, 0, 0); __builtin_amdgcn_s_setprio(0); } while (0)
#define PG8_WAIT_V(n) asm volatile("s_waitcnt vmcnt(" #n ")" ::: "memory")
#define PG8_WAIT_L(n) asm volatile("s_waitcnt lgkmcnt(" #n ")" ::: "memory")
#define PG8_BAR __builtin_amdgcn_s_barrier()
#define PG8_SCHED __builtin_amdgcn_sched_barrier(0)
    Unit cur, nxt; int ui = 0;
    if (!S.next(0, cur)) return;
    f32x4 acc[2][2][4][2];
#pragma unroll
    for (int a = 0; a < 2; ++a)
#pragma unroll
        for (int b = 0; b < 2; ++b)
#pragma unroll
            for (int m = 0; m < 4; ++m)
#pragma unroll
                for (int n = 0; n < 2; ++n) acc[a][b][m][n] = (f32x4){0.f, 0.f, 0.f, 0.f};
    bf16x8 At[4][2], B0[2][2], B1[2][2];
    const char* cA = (const char*)g.A + (GATHER ? (size_t)0 : (size_t)cur.pm * tstep); const char* cB = (const char*)g.Bt + (size_t)cur.pn * tstep;
    if constexpr (GATHER) { PG8_GATHER_OFF(vAc, cur); }
    PG8_STAGE(PG8_SB(0, 0), cB, voffB); PG8_STAGE_A(PG8_SA(0, 0), 0, cA, 0, vAc); PG8_STAGE(PG8_SB(0, 1), cB + hstep, voffB); PG8_STAGE_A(PG8_SA(0, 1), 1, cA, 0, vAc);
    if (wr == 1) PG8_BAR;
    PG8_WAIT_V(4); PG8_BAR;
    PG8_STAGE(PG8_SB(1, 0), cB + kstep, voffB); PG8_STAGE_A(PG8_SA(1, 0), 0, cA + kstep, kstep, vAc); PG8_STAGE(PG8_SB(1, 1), cB + hstep + kstep, voffB);
    PG8_WAIT_V(6); PG8_BAR;
    for (;;) {
        const bool has_next = S.next(ui + 1, nxt);
        const char* nA = (has_next && !GATHER) ? (const char*)g.A + (size_t)nxt.pm * tstep : cA; const char* nB = has_next ? (const char*)g.Bt + (size_t)nxt.pn * tstep : cB;
        if constexpr (GATHER) { if (has_next) { PG8_GATHER_OFF(vAn, nxt); } else {
#pragma unroll
            for (int _h = 0; _h < 2; ++_h)
#pragma unroll
                for (int _i = 0; _i < 2; ++_i) vAn[_h][_i] = vAc[_h][_i]; } }
        for (int t = 0; t < nt; t += 2) {
            const bool last = (t == nt - 2);
            const size_t k1 = (size_t)(t + 1) * kstep, k2 = last ? 0 : (size_t)(t + 2) * kstep, k3 = k2 + kstep;
            const char* a1 = cA + k1;
            const char* a2 = last ? nA : cA + (size_t)(t + 2) * kstep; const char* b2 = last ? nB : cB + (size_t)(t + 2) * kstep;
            const char* a3 = a2 + kstep; const char* b3 = b2 + kstep;
            unsigned vs[2][2];
#pragma unroll
            for (int _h = 0; _h < 2; ++_h)
#pragma unroll
                for (int _i = 0; _i < 2; ++_i) vs[_h][_i] = last ? vAn[_h][_i] : vAc[_h][_i];
            PG8_LDB(B0, 0, 0); PG8_SCHED; PG8_LDA(At, 0, 0); PG8_STAGE_A(PG8_SA(1, 1), 1, a1, k1, vAc);
            PG8_WAIT_L(8); PG8_BAR; PG8_WAIT_L(0); PG8_MMA(0, 0, At, B0); PG8_BAR; PG8_SCHED;
            PG8_LDB(B1, 0, 1); PG8_STAGE(PG8_SB(0, 0), b2, voffB);
            PG8_BAR; PG8_WAIT_L(0); PG8_MMA(0, 1, At, B1); PG8_BAR;
            PG8_LDA(At, 0, 1); PG8_STAGE_A(PG8_SA(0, 0), 0, a2, k2, vs);
            PG8_BAR; PG8_WAIT_L(0); PG8_MMA(1, 0, At, B0); PG8_BAR; PG8_SCHED;
            PG8_STAGE(PG8_SB(0, 1), b2 + hstep, voffB);
            PG8_WAIT_V(6); PG8_BAR; PG8_MMA(1, 1, At, B1); PG8_BAR;
            PG8_LDB(B0, 1, 0); PG8_SCHED; PG8_LDA(At, 1, 0); PG8_STAGE_A(PG8_SA(0, 1), 1, a2, k2, vs);
            PG8_WAIT_L(8); PG8_BAR; PG8_WAIT_L(0); PG8_MMA(0, 0, At, B0); PG8_BAR; PG8_SCHED;
            PG8_LDB(B1, 1, 1); PG8_STAGE(PG8_SB(1, 0), b3, voffB);
            PG8_BAR; PG8_WAIT_L(0); PG8_MMA(0, 1, At, B1); PG8_BAR;
            PG8_LDA(At, 1, 1); PG8_STAGE_A(PG8_SA(1, 0), 0, a3, k3, vs);
            PG8_BAR; PG8_WAIT_L(0); PG8_MMA(1, 0, At, B0); PG8_BAR; PG8_SCHED;
            PG8_STAGE(PG8_SB(1, 1), b3 + hstep, voffB);
            PG8_WAIT_V(6); PG8_BAR; PG8_MMA(1, 1, At, B1); PG8_BAR;
        }
        E(acc, cur, wr, wc, fr, fq);
        if (!has_next) break;
#pragma unroll
        for (int a = 0; a < 2; ++a)
#pragma unroll
            for (int b = 0; b < 2; ++b)
#pragma unroll
                for (int m = 0; m < 4; ++m)
#pragma unroll
                    for (int n = 0; n < 2; ++n) acc[a][b][m][n] = (f32x4){0.f, 0.f, 0.f, 0.f};
        cur = nxt; cA = nA; cB = nB; ++ui;
        if constexpr (GATHER) {
#pragma unroll
            for (int _h = 0; _h < 2; ++_h)
#pragma unroll
                for (int _i = 0; _i < 2; ++_i) vAc[_h][_i] = vAn[_h][_i]; }
    }
    PG8_WAIT_V(0);
    if (wr == 0) PG8_BAR;
    PG8_BAR;
#undef PG8_SA
#undef PG8_SB
#undef PG8_STAGE
#undef PG8_STAGE_A
#undef PG8_GATHER_OFF
#undef PG8_LDA
#undef PG8_LDB
#undef PG8_MMA
#undef PG8_WAIT_V
#undef PG8_WAIT_L
#undef PG8_BAR
#undef PG8_SCHED
}
}

struct Args {
    const float* in[29];
    float* out; unsigned char* ws;
    int ph_lo, ph_hi;
};
enum { I_X = 0, I_MEM, I_NMIXG, I_NMEMG, I_WIN, I_WMK, I_WMV, I_CONVW, I_CONVB, I_CLNG, I_CLNB, I_SHIFTMU, I_DW0, I_DUP, I_IA0, I_IUP, I_GUP, I_KK, I_KA, I_RK,
       I_LNXG, I_LNXB, I_WOUT, I_NFFNG, I_WROUTER, I_WEG, I_WEU, I_WED, I_FNG };

__device__ __forceinline__ void transpose_item(const float* W, int N, bf16_t* WT, int K, int k0, int n0, int drow0, LAS float* scr, int lane) {
#pragma unroll 8
    for (int i = 0; i < 32; ++i) { const int kk = 2 * i + (lane >> 5); scr[kk * 33 + (lane & 31)] = W[(size_t)(k0 + kk) * N + n0 + (lane & 31)]; }
    asm volatile("s_waitcnt lgkmcnt(0)" ::: "memory");
    const int c = lane & 7;
#pragma unroll
    for (int j = 0; j < 4; ++j) { const int n = (lane >> 3) + 8 * j; const LAS float* s = scr + (8 * c) * 33 + n;
        u32x4 o; o.x = pk_bf16(s[0 * 33], s[1 * 33]); o.y = pk_bf16(s[2 * 33], s[3 * 33]); o.z = pk_bf16(s[4 * 33], s[5 * 33]); o.w = pk_bf16(s[6 * 33], s[7 * 33]);
        *(u32x4*)(WT + (size_t)(drow0 + n) * K + k0 + 8 * c) = o; }
    asm volatile("s_waitcnt lgkmcnt(0)" ::: "memory");
}
__device__ __forceinline__ void rms_row_to_bf16(const float* xrow, const float* g, bf16_t* orow, int lane) {
    const f32x4* xr = (const f32x4*)xrow + lane; const f32x4* gr = (const f32x4*)g + lane;
    f32x4 v[4]; float s = 0.f;
#pragma unroll
    for (int j = 0; j < 4; ++j) { v[j] = xr[64 * j]; s += (v[j].x * v[j].x + v[j].y * v[j].y) + (v[j].z * v[j].z + v[j].w * v[j].w); }
    const float rs = 1.0f / sqrtf(wave_sum(s) * (1.f / D) + 1e-6f);
    u32x2* o8 = (u32x2*)orow + lane;
#pragma unroll
    for (int j = 0; j < 4; ++j) { const f32x4 gg = gr[64 * j]; u32x2 w; w.x = pk_bf16(v[j].x * rs * gg.x, v[j].y * rs * gg.y); w.y = pk_bf16(v[j].z * rs * gg.z, v[j].w * rs * gg.w); o8[64 * j] = w; }
}
__device__ __forceinline__ void phase_prep(const Args& a, LAS unsigned char* lds, int G) {
    const int tid = threadIdx.x, lane = tid & 63, wave = __builtin_amdgcn_readfirstlane(tid >> 6);
    LAS float* scr = (LAS float*)(lds + wave * 16384);
    const int gw = blockIdx.x * 8 + wave, NGW = G * 8;
    unsigned char* ws = a.ws;
    constexpr int S_WIN = 16 * 80, S_WOUT = 16 * 32, S_MK = 16 * 8, S_SM = 12, S_GUP = 24, S_EXP = 16 * 16 * 32;
    constexpr int NITEMS = S_WIN + S_WOUT + 2 * S_MK + 4 * S_SM + S_GUP + 3 * S_EXP;
    for (int it = gw; it < NITEMS; it += NGW) {
        int r = it;
        if (r < S_WIN) { const int kb = r / 80, nb = r % 80; transpose_item(a.in[I_WIN], IN_PROJ, (bf16_t*)(ws + WS_WINT), D, kb * 64, nb * 32, nb * 32, scr, lane); continue; } r -= S_WIN;
        if (r < S_WOUT) { const int kb = r / 32, nb = r % 32; transpose_item(a.in[I_WOUT], D, (bf16_t*)(ws + WS_WOUTT), D, kb * 64, nb * 32, nb * 32, scr, lane); continue; } r -= S_WOUT;
        if (r < S_MK) { const int kb = r / 8, nb = r % 8; transpose_item(a.in[I_WMK], 256, (bf16_t*)(ws + WS_WKT), D, kb * 64, nb * 32, nb * 32, scr, lane); continue; } r -= S_MK;
        if (r < S_MK) { const int kb = r / 8, nb = r % 8; transpose_item(a.in[I_WMV], 256, (bf16_t*)(ws + WS_WVT), D, kb * 64, nb * 32, nb * 32, scr, lane); continue; } r -= S_MK;
        if (r < 4 * S_SM) { const int which = r / S_SM, nb = r % S_SM;
            const float* src = (which < 2 ? a.in[I_DUP] : a.in[I_IUP]) + (size_t)(which & 1) * 64 * RW;
            transpose_item(src, RW, (bf16_t*)(ws + WS_SMALL) + (size_t)which * RW * 64, 64, 0, nb * 32, nb * 32, scr, lane); continue; } r -= 4 * S_SM;
        if (r < S_GUP) { const int kb = r / 12, nb = r % 12; transpose_item(a.in[I_GUP], RW, (bf16_t*)(ws + WS_SMALL) + (size_t)4 * RW * 64, 128, kb * 64, nb * 32, nb * 32, scr, lane); continue; } r -= S_GUP;
        { const int which = r / S_EXP, q = r % S_EXP, e = q / 512, kb = (q % 512) / 32, nb = q % 32, n0 = nb * 32;
          if (which == 0) transpose_item(a.in[I_WEG] + (size_t)e * D * FF, FF, (bf16_t*)(ws + WS_WGUT) + (size_t)e * 2048 * D, D, kb * 64, n0, (n0 >> 7) * 256 + (n0 & 127), scr, lane);
          else if (which == 1) transpose_item(a.in[I_WEU] + (size_t)e * D * FF, FF, (bf16_t*)(ws + WS_WGUT) + (size_t)e * 2048 * D, D, kb * 64, n0, (n0 >> 7) * 256 + 128 + (n0 & 127), scr, lane);
          else transpose_item(a.in[I_WED] + (size_t)e * FF * D, D, (bf16_t*)(ws + WS_WDT) + (size_t)e * D * FF, FF, kb * 64, n0, n0, scr, lane); }
    }
    for (int m = gw; m < T; m += NGW) rms_row_to_bf16(a.in[I_X] + (size_t)m * D, a.in[I_NMIXG], (bf16_t*)(ws + WS_XH) + (size_t)m * D, lane);
    for (int m = gw; m < BATCH * NMEM; m += NGW) rms_row_to_bf16(a.in[I_MEM] + (size_t)m * D, a.in[I_NMEMG], (bf16_t*)(ws + WS_MEMN) + (size_t)m * D, lane);
}

constexpr int AT_KS = 144;
constexpr int AT_VS = 520;
constexpr int AT_VOFF = 256 * AT_KS;
__device__ __forceinline__ bf16x8 pack_step(const f32x16& x, int s) {
    u32x4 p;
    asm volatile("v_cvt_pk_bf16_f32 %0, %4, %5\n\tv_cvt_pk_bf16_f32 %1, %6, %7\n\tv_cvt_pk_bf16_f32 %2, %8, %9\n\tv_cvt_pk_bf16_f32 %3, %10, %11\n\ts_nop 1"
                 : "=&v"(p[0]), "=&v"(p[1]), "=&v"(p[2]), "=&v"(p[3])
                 : "v"(x[8 * s]), "v"(x[8 * s + 1]), "v"(x[8 * s + 2]), "v"(x[8 * s + 3]), "v"(x[8 * s + 4]), "v"(x[8 * s + 5]), "v"(x[8 * s + 6]), "v"(x[8 * s + 7]));
    return __builtin_bit_cast(bf16x8, p);
}
__device__ __forceinline__ void attn_unit(const Args& a, LAS unsigned char* lds, int unit) {
    const int tid = threadIdx.x, lane = tid & 63, wave = __builtin_amdgcn_readfirstlane(tid >> 6), r = lane & 31, h = lane >> 5;
    const int b = unit >> 6, hh = (unit >> 4) & 3, tile = unit & 15;
    const bf16_t* P = (const bf16_t*)(a.ws + WS_P); const bf16_t* KM = (const bf16_t*)(a.ws + WS_KMEM); const bf16_t* VT = (const bf16_t*)(a.ws + WS_VT);
    bf16_t* MIX = (bf16_t*)(a.ws + WS_MIX);
    __syncthreads();
#pragma unroll
    for (int i = 0; i < 4; ++i) { const int c = tid + 512 * i, key = c >> 3, ch = c & 7;
        const u32x4 v = *(const u32x4*)(KM + (size_t)(b * NMEM + key) * 256 + hh * 64 + ch * 8);
        *(LAS u32x4*)(lds + key * AT_KS + ch * 16) = v; }
#pragma unroll
    for (int i = 0; i < 4; ++i) { const int c = tid + 512 * i, d = c >> 5, ch = c & 31;
        const u32x4 v = *(const u32x4*)(VT + (size_t)(hh * 64 + d) * (BATCH * NMEM) + b * NMEM + ch * 8);
        LAS u32x2* dst = (LAS u32x2*)(lds + AT_VOFF + d * AT_VS + ch * 16);
        dst[0] = (u32x2){v.x, v.y}; dst[1] = (u32x2){v.z, v.w}; }
    const int tok0 = b * SEQ + tile * 256 + wave * 32;
    bf16x8 qf[4];
#pragma unroll
    for (int ks = 0; ks < 4; ++ks) qf[ks] = *(const bf16x8*)(P + (size_t)(tok0 + r) * IN_PROJ + hh * 64 + ks * 16 + h * 8);
    __syncthreads();
    f32x16 s[8];
#pragma unroll
    for (int kt = 0; kt < 8; ++kt) {
#pragma unroll
        for (int i = 0; i < 16; ++i) s[kt][i] = 0.f;
#pragma unroll
        for (int ks = 0; ks < 4; ++ks) { const bf16x8 ka = *(const LAS bf16x8*)(lds + (kt * 32 + r) * AT_KS + (ks * 16 + h * 8) * 2);
            s[kt] = __builtin_amdgcn_mfma_f32_32x32x16_bf16(ka, qf[ks], s[kt], 0, 0, 0); }
    }
    float mx = -3.0e38f;
#pragma unroll
    for (int kt = 0; kt < 8; ++kt)
#pragma unroll
        for (int i = 0; i < 16; ++i) mx = fmaxf(mx, s[kt][i]);
    mx = fmaxf(mx, __shfl_xor(mx, 32));
    const float sc = 0.125f * 1.4426950408889634f; float sum = 0.f;
#pragma unroll
    for (int kt = 0; kt < 8; ++kt)
#pragma unroll
        for (int i = 0; i < 16; ++i) { const float e = __builtin_amdgcn_exp2f((s[kt][i] - mx) * sc); s[kt][i] = e; sum += e; }
    sum += __shfl_xor(sum, 32);
    f32x16 o[2];
#pragma unroll
    for (int dt = 0; dt < 2; ++dt)
#pragma unroll
        for (int i = 0; i < 16; ++i) o[dt][i] = 0.f;
#pragma unroll
    for (int kt = 0; kt < 8; ++kt)
#pragma unroll
        for (int s2 = 0; s2 < 2; ++s2) {
            const bf16x8 pb = pack_step(s[kt], s2);
#pragma unroll
            for (int dt = 0; dt < 2; ++dt) {
                const LAS unsigned char* vp = lds + AT_VOFF + (32 * dt + r) * AT_VS + (32 * kt + 16 * s2 + 4 * h) * 2;
                const s16x4 lo = *(const LAS s16x4*)vp, hi = *(const LAS s16x4*)(vp + 16);
                const bf16x8 va = __builtin_shufflevector(lo, hi, 0, 1, 2, 3, 4, 5, 6, 7);
                o[dt] = __builtin_amdgcn_mfma_f32_32x32x16_bf16(va, pb, o[dt], 0, 0, 0);
            }
        }
    const float inv = 1.0f / sum;
    bf16_t* orow = MIX + (size_t)(tok0 + r) * D + hh * 64;
#pragma unroll
    for (int dt = 0; dt < 2; ++dt)
#pragma unroll
        for (int gq = 0; gq < 4; ++gq) { u32x2 w; w.x = pk_bf16(o[dt][4 * gq] * inv, o[dt][4 * gq + 1] * inv); w.y = pk_bf16(o[dt][4 * gq + 2] * inv, o[dt][4 * gq + 3] * inv);
            *(u32x2*)(orow + 32 * dt + 8 * gq + 4 * h) = w; }
}

__device__ __forceinline__ void conv_unit(const Args& a, LAS unsigned char* lds, int unit) {
    const int tid = threadIdx.x, lane = tid & 63, wave = __builtin_amdgcn_readfirstlane(tid >> 6);
    const int b = unit >> 6, t0 = (unit & 63) * 64;
    const bf16_t* P = (const bf16_t*)(a.ws + WS_P); bf16_t* MIX = (bf16_t*)(a.ws + WS_MIX);
    LAS _Float16* U = (LAS _Float16*)lds;
    LAS _Float16* Cc = (LAS _Float16*)(lds + 94 * CW * 2);
    __syncthreads();
    for (int q = tid; q < 94 * 48; q += NTHREADS) { const int j = q / 48, cc = (q % 48) * 8, s = t0 - 15 + j;
        float u[8];
        if (s >= 0 && s < SEQ) { const bf16_t* row = P + (size_t)(b * SEQ + s) * IN_PROJ + 256 + cc;
            const u32x4 vv = *(const u32x4*)row, gg = *(const u32x4*)(row + CW);
            const unsigned vw[4] = {vv.x, vv.y, vv.z, vv.w}, gw[4] = {gg.x, gg.y, gg.z, gg.w};
#pragma unroll
            for (int k = 0; k < 4; ++k) { u[2 * k] = bf_lo(vw[k]) * sigmoidf_fast(bf_lo(gw[k])); u[2 * k + 1] = bf_hi(vw[k]) * sigmoidf_fast(bf_hi(gw[k])); }
        } else {
#pragma unroll
            for (int k = 0; k < 8; ++k) u[k] = 0.f; }
        LAS f16x4* dst = (LAS f16x4*)(U + j * CW + cc); dst[0] = (f16x4){(_Float16)u[0], (_Float16)u[1], (_Float16)u[2], (_Float16)u[3]}; dst[1] = (f16x4){(_Float16)u[4], (_Float16)u[5], (_Float16)u[6], (_Float16)u[7]}; }
    __syncthreads();
    const int cq = tid & 127, tq = tid >> 7;
#pragma unroll 1
    for (int k3 = 0; k3 < 3; ++k3) { const int c = cq + 128 * k3;
        float w[31], res[16];
#pragma unroll
        for (int kk = 0; kk < 31; ++kk) w[kk] = a.in[I_CONVW][kk * CW + c];
        const float bias = a.in[I_CONVB][c];
#pragma unroll
        for (int tt = 0; tt < 16; ++tt) res[tt] = bias;
#pragma unroll
        for (int jj = 0; jj < 46; ++jj) { const float uv = (float)U[(tq * 16 + jj) * CW + c];
#pragma unroll
            for (int tt = 0; tt < 16; ++tt) { if (jj - tt >= 0 && jj - tt <= 30) res[tt] += uv * w[jj - tt]; } }
#pragma unroll
        for (int tt = 0; tt < 16; ++tt) Cc[(tq * 16 + tt) * CW + c] = (_Float16)res[tt];
    }
    __syncthreads();
    for (int tt = 0; tt < 8; ++tt) { const int t = wave * 8 + tt;
        float v[6]; float s = 0.f;
#pragma unroll
        for (int i = 0; i < 6; ++i) { v[i] = (float)Cc[t * CW + lane + 64 * i]; s += v[i]; }
        const float mean = wave_sum(s) * (1.f / CW); float q = 0.f;
#pragma unroll
        for (int i = 0; i < 6; ++i) { v[i] -= mean; q += v[i] * v[i]; }
        const float rstd = 1.0f / sqrtf(wave_sum(q) * (1.f / CW) + 1e-5f);
        bf16_t* orow = MIX + (size_t)(b * SEQ + t0 + t) * D + 256;
#pragma unroll
        for (int i = 0; i < 6; ++i) { const int c = lane + 64 * i; const float y = v[i] * rstd * a.in[I_CLNG][c] + a.in[I_CLNB][c]; const float o = y * sigmoidf_fast(y);
            orow[c] = (bf16_t)(pk_bf16(o, 0.f) & 0xffffu); }
    }
}

constexpr int PR_AS = 784;
__device__ __forceinline__ void prep_unit(const Args& a, LAS unsigned char* lds, int unit) {
    const int tid = threadIdx.x, lane = tid & 63, wave = __builtin_amdgcn_readfirstlane(tid >> 6);
    const int b = unit >> 6, t0 = (unit & 63) * 64;
    const bf16_t* P = (const bf16_t*)(a.ws + WS_P);
    _Float16* SC = (_Float16*)(a.ws + WS_SCAN);
    const float* mu = a.in[I_SHIFTMU];
    __syncthreads();
    for (int q = tid; q < 64 * 192; q += NTHREADS) { const int tt = q / 192, c8 = (q % 192) * 8, s = t0 + tt; const size_t tok = (size_t)b * SEQ + s;
        const bf16_t* row = P + tok * IN_PROJ + 1024 + c8;
        const u32x4 cu = *(const u32x4*)row;
        u32x4 pv = {0u, 0u, 0u, 0u}, nv = {0u, 0u, 0u, 0u};
        if (s > 0) pv = *(const u32x4*)(row - IN_PROJ);
        if (s < SEQ - 1) nv = *(const u32x4*)(row + IN_PROJ);
        const unsigned cw[4] = {cu.x, cu.y, cu.z, cu.w}, pw[4] = {pv.x, pv.y, pv.z, pv.w}, nw[4] = {nv.x, nv.y, nv.z, nv.w};
        const f32x4 m0a = *(const f32x4*)(mu + c8), m0b = *(const f32x4*)(mu + c8 + 4), m1a = *(const f32x4*)(mu + 1536 + c8), m1b = *(const f32x4*)(mu + 1536 + c8 + 4);
        const float m0[8] = {m0a.x, m0a.y, m0a.z, m0a.w, m0b.x, m0b.y, m0b.z, m0b.w}, m1[8] = {m1a.x, m1a.y, m1a.z, m1a.w, m1b.x, m1b.y, m1b.z, m1b.w};
        float pf[8];
#pragma unroll
        for (int k = 0; k < 4; ++k) { const float c0 = bf_lo(cw[k]), c1 = bf_hi(cw[k]);
            pf[2 * k] = c0 + m0[2 * k] * (bf_lo(pw[k]) - c0) + m1[2 * k] * (bf_lo(nw[k]) - c0);
            pf[2 * k + 1] = c1 + m0[2 * k + 1] * (bf_hi(pw[k]) - c1) + m1[2 * k + 1] * (bf_hi(nw[k]) - c1); }
        if (c8 < 1152) {
            const int arr = c8 / RW, cc = c8 % RW;
            f16x4 h0 = {(_Float16)pf[0], (_Float16)pf[1], (_Float16)pf[2], (_Float16)pf[3]}, h1 = {(_Float16)pf[4], (_Float16)pf[5], (_Float16)pf[6], (_Float16)pf[7]};
            f16x4* dst = (f16x4*)((unsigned char*)SC + (size_t)arr * SCAN_STRIDE) + (tok * RW + cc) / 4; dst[0] = h0; dst[1] = h1;
        } else {
            const int cc = c8 - 1152;
#pragma unroll
            for (int k = 0; k < 8; ++k) { if (cc < 128) pf[k] = tanhf(pf[k]); else if (cc >= 256) pf[k] = sigmoidf_fast(pf[k]); }
            u32x4 w; w.x = pk_bf16(pf[0], pf[1]); w.y = pk_bf16(pf[2], pf[3]); w.z = pk_bf16(pf[4], pf[5]); w.w = pk_bf16(pf[6], pf[7]);
            *(LAS u32x4*)(lds + tt * PR_AS + cc * 2) = w; }
    }
    __syncthreads();
    const int l15 = lane & 15, kq = lane >> 4, ch0 = wave * 48;
    const bf16_t* SM = (const bf16_t*)(a.ws + WS_SMALL);
#pragma unroll 1
    for (int o = 0; o < 5; ++o) {
        const int kbase = (o < 4) ? o * 64 : 256, KD = (o < 4) ? 64 : 128;
        const bf16_t* WTm = (o < 4) ? SM + (size_t)o * RW * 64 : SM + (size_t)4 * RW * 64;
        f32x4 acc[4][3];
#pragma unroll
        for (int mt = 0; mt < 4; ++mt)
#pragma unroll
            for (int nt = 0; nt < 3; ++nt) acc[mt][nt] = (f32x4){0.f, 0.f, 0.f, 0.f};
        for (int ks = 0; ks < KD / 32; ++ks) {
            bf16x8 bfr[3], afr[4];
#pragma unroll
            for (int nt = 0; nt < 3; ++nt) bfr[nt] = *(const bf16x8*)(WTm + (size_t)(ch0 + nt * 16 + l15) * KD + ks * 32 + kq * 8);
#pragma unroll
            for (int mt = 0; mt < 4; ++mt) afr[mt] = *(const LAS bf16x8*)(lds + (mt * 16 + l15) * PR_AS + (kbase + ks * 32 + kq * 8) * 2);
#pragma unroll
            for (int mt = 0; mt < 4; ++mt)
#pragma unroll
                for (int nt = 0; nt < 3; ++nt) acc[mt][nt] = __builtin_amdgcn_mfma_f32_16x16x32_bf16(afr[mt], bfr[nt], acc[mt][nt], 0, 0, 0);
        }
#pragma unroll
        for (int nt = 0; nt < 3; ++nt) { const int ch = ch0 + nt * 16 + l15;
            float bias = 0.f;
            if (o < 2) bias = a.in[I_DW0][o * RW + ch]; else if (o < 4) bias = a.in[I_IA0][(o - 2) * RW + ch];
#pragma unroll
            for (int mt = 0; mt < 4; ++mt)
#pragma unroll
                for (int rg = 0; rg < 4; ++rg) { const size_t tok = (size_t)b * SEQ + t0 + mt * 16 + kq * 4 + rg; const float z = acc[mt][nt][rg] + bias;
                    if (o < 2) { const float w = __builtin_amdgcn_exp2f(-0.606531f * 1.4426950408889634f * sigmoidf_fast(z)); ((_Float16*)((unsigned char*)SC + (size_t)(3 + o) * SCAN_STRIDE))[tok * RW + ch] = (_Float16)w; }
                    else if (o < 4) { ((_Float16*)((unsigned char*)SC + (size_t)(3 + o) * SCAN_STRIDE))[tok * RW + ch] = (_Float16)sigmoidf_fast(z); }
                    else { ((bf16_t*)(a.ws + WS_G))[tok * RW + ch] = (bf16_t)(pk_bf16(z, 0.f) & 0xffffu); } }
        }
    }
}

constexpr int SC_CT = 32;
constexpr int SC_JV = SC_CT * 8 * 40 * 4;
constexpr int SC_VV = SC_CT * 64 * 4;
constexpr int SC_SC = SC_CT * 2 * 4;
constexpr int SC_Y = SC_CT * 64 * 4;
constexpr int SC_BUF = SC_JV + SC_VV + SC_SC + SC_Y;
struct ScanRegs { f16x4 r, k, v, w, a; };
struct StepVec { f32x4 kkA, kkB, wrA, wrB, wA, wB, bA, bB, kdA, kdB; f32x2 v2, sc; };
#define LO2(q) __builtin_shufflevector(q, q, 0, 1)
#define HI2(q) __builtin_shufflevector(q, q, 2, 3)
__device__ __forceinline__ void scan_unit(const Args& a, LAS unsigned char* lds, int unit) {
    const int tid = threadIdx.x, lane = tid & 63, wave = __builtin_amdgcn_readfirstlane(tid >> 6);
    const int dir = unit & 1, bh = unit >> 1, b = bh / NH, hd = bh % NH;
    constexpr int NCK = SEQ / SC_CT;
    constexpr int OFF_VV = SC_JV, OFF_SC = SC_JV + SC_VV, OFF_Y = SC_JV + SC_VV + SC_SC;
    __syncthreads();
    if (wave >= 4) {
        const _Float16* SCb = (const _Float16*)(a.ws + WS_SCAN);
        const _Float16* Rg = SCb; const _Float16* Kg = (const _Float16*)((const unsigned char*)SCb + SCAN_STRIDE); const _Float16* Vg = (const _Float16*)((const unsigned char*)SCb + 2 * SCAN_STRIDE);
        const _Float16* Wg = (const _Float16*)((const unsigned char*)SCb + (size_t)(3 + dir) * SCAN_STRIDE); const _Float16* Ag = (const _Float16*)((const unsigned char*)SCb + (size_t)(5 + dir) * SCAN_STRIDE);
        float* Yg = (float*)(a.ws + (dir ? WS_YB : WS_YF)); float* BON = (float*)(a.ws + WS_BON) + (size_t)dir * T * NH;
        const int lt = tid - 256, ls0 = lt >> 4, lq = lt & 15, chl = hd * 64 + 4 * lq;
        const f32x4 kkw = *(const f32x4*)(a.in[I_KK] + chl), kaw = *(const f32x4*)(a.in[I_KA] + chl), rkw = *(const f32x4*)(a.in[I_RK] + chl);
        ScanRegs rg[2];
#define SCAN_LOAD(ck) do { _Pragma("unroll") for (int i_ = 0; i_ < 2; ++i_) { const int st_ = (ck) * SC_CT + ls0 + 16 * i_; const int t_ = dir ? (SEQ - 1 - st_) : st_; const size_t e_ = ((size_t)b * SEQ + t_) * RW + chl; \
            rg[i_].r = *(const f16x4*)(Rg + e_); rg[i_].k = *(const f16x4*)(Kg + e_); rg[i_].v = *(const f16x4*)(Vg + e_); rg[i_].w = *(const f16x4*)(Wg + e_); rg[i_].a = *(const f16x4*)(Ag + e_); } } while (0)
#define SCAN_PROC(ck, buf) do { LAS unsigned char* B_ = lds + (buf) * SC_BUF; _Pragma("unroll") for (int i_ = 0; i_ < 2; ++i_) { const int ls = ls0 + 16 * i_; \
            const f32x4 r_ = __builtin_convertvector(rg[i_].r, f32x4), k_ = __builtin_convertvector(rg[i_].k, f32x4), v_ = __builtin_convertvector(rg[i_].v, f32x4), w_ = __builtin_convertvector(rg[i_].w, f32x4), a_ = __builtin_convertvector(rg[i_].a, f32x4); \
            f32x4 kk_ = k_ * kkw; float ss_ = (kk_.x * kk_.x + kk_.y * kk_.y) + (kk_.z * kk_.z + kk_.w * kk_.w); ss_ = sum16(ss_); kk_ = kk_ * (1.0f / sqrtf(ss_ + 1e-12f)); \
            const f32x4 b_ = kk_ * a_, kd_ = k_ * (1.0f + (a_ - 1.0f) * kaw), wr_ = w_ * r_; \
            float br_ = (b_.x * r_.x + b_.y * r_.y) + (b_.z * r_.z + b_.w * r_.w), kr_ = (kd_.x * r_.x + kd_.y * r_.y) + (kd_.z * r_.z + kd_.w * r_.w); \
            float bn_ = (kd_.x * r_.x * rkw.x + kd_.y * r_.y * rkw.y) + (kd_.z * r_.z * rkw.z + kd_.w * r_.w * rkw.w); \
            br_ = sum16(br_); kr_ = sum16(kr_); bn_ = sum16(bn_); \
            LAS f32x4* jv_ = (LAS f32x4*)(B_ + ls * 1280 + (lq >> 1) * 160 + (lq & 1) * 16); \
            jv_[0] = kk_; jv_[2] = wr_; jv_[4] = w_; jv_[6] = b_; jv_[8] = kd_; \
            *(LAS f32x4*)(B_ + OFF_VV + ls * 256 + lq * 16) = v_; \
            if (lq == 0) { *(LAS f32x2*)(B_ + OFF_SC + ls * 8) = (f32x2){br_, kr_}; const int st_ = (ck) * SC_CT + ls; const int t_ = dir ? (SEQ - 1 - st_) : st_; BON[((size_t)b * SEQ + t_) * NH + hd] = bn_; } } } while (0)
#define SCAN_FLUSH(ck, buf) do { _Pragma("unroll") for (int i_ = 0; i_ < 2; ++i_) { const int ls = ls0 + 16 * i_; \
            const f32x4 yv_ = *(const LAS f32x4*)(lds + (buf) * SC_BUF + OFF_Y + ls * 256 + lq * 16); \
            const int st_ = (ck) * SC_CT + ls; const int t_ = dir ? (SEQ - 1 - st_) : st_; \
            *(f32x4*)(Yg + ((size_t)b * SEQ + t_) * RW + hd * 64 + 4 * lq) = yv_; } } while (0)
        SCAN_LOAD(0); SCAN_PROC(0, 0); SCAN_LOAD(1);
        __syncthreads();
#pragma unroll 1
        for (int ck = 0; ck < NCK; ++ck) {
            if (ck > 0) SCAN_FLUSH(ck - 1, (ck - 1) & 1);
            if (ck + 1 < NCK) { SCAN_PROC(ck + 1, (ck + 1) & 1); if (ck + 2 < NCK) SCAN_LOAD(ck + 2); }
            __syncthreads();
        }
        SCAN_FLUSH(NCK - 1, (NCK - 1) & 1);
#undef SCAN_LOAD
#undef SCAN_PROC
#undef SCAN_FLUSH
    } else {
        const int jg = lane & 7, row0 = wave * 16 + 2 * (lane >> 3);
        f32x2 S0[4], S1[4];
#pragma unroll
        for (int p = 0; p < 4; ++p) { S0[p] = (f32x2){0.f, 0.f}; S1[p] = (f32x2){0.f, 0.f}; }
#define SV_LOAD(dst, Bc, st) do { const LAS f32x4* jv_ = (const LAS f32x4*)((Bc) + (st) * 1280 + jg * 160); \
            dst.kkA = jv_[0]; dst.kkB = jv_[1]; dst.wrA = jv_[2]; dst.wrB = jv_[3]; dst.wA = jv_[4]; dst.wB = jv_[5]; dst.bA = jv_[6]; dst.bB = jv_[7]; dst.kdA = jv_[8]; dst.kdB = jv_[9]; \
            dst.v2 = *(const LAS f32x2*)((Bc) + OFF_VV + (st) * 256 + row0 * 4); dst.sc = *(const LAS f32x2*)((Bc) + OFF_SC + (st) * 8); } while (0)
#define SV_STEP(src, Bc, st) do { \
            f32x2 t0 = S0[0] * LO2(src.kkA); t0 = S0[1] * HI2(src.kkA) + t0; t0 = S0[2] * LO2(src.kkB) + t0; t0 = S0[3] * HI2(src.kkB) + t0; \
            f32x2 t1 = S1[0] * LO2(src.kkA); t1 = S1[1] * HI2(src.kkA) + t1; t1 = S1[2] * LO2(src.kkB) + t1; t1 = S1[3] * HI2(src.kkB) + t1; \
            f32x2 u0 = S0[0] * LO2(src.wrA); u0 = S0[1] * HI2(src.wrA) + u0; u0 = S0[2] * LO2(src.wrB) + u0; u0 = S0[3] * HI2(src.wrB) + u0; \
            f32x2 u1 = S1[0] * LO2(src.wrA); u1 = S1[1] * HI2(src.wrA) + u1; u1 = S1[2] * LO2(src.wrB) + u1; u1 = S1[3] * HI2(src.wrB) + u1; \
            const float sa0 = -sum8(t0.x + t0.y), sa1 = -sum8(t1.x + t1.y), yp0 = sum8(u0.x + u0.y), yp1 = sum8(u1.x + u1.y); \
            const float v0 = src.v2.x, v1 = src.v2.y; \
            const f32x2 yo = {yp0 + sa0 * src.sc.x + v0 * src.sc.y, yp1 + sa1 * src.sc.x + v1 * src.sc.y}; \
            *(LAS f32x2*)((Bc) + OFF_Y + (st) * 256 + row0 * 4) = yo; \
            S0[0] = S0[0] * LO2(src.wA) + (LO2(src.bA) * sa0 + LO2(src.kdA) * v0); S0[1] = S0[1] * HI2(src.wA) + (HI2(src.bA) * sa0 + HI2(src.kdA) * v0); \
            S0[2] = S0[2] * LO2(src.wB) + (LO2(src.bB) * sa0 + LO2(src.kdB) * v0); S0[3] = S0[3] * HI2(src.wB) + (HI2(src.bB) * sa0 + HI2(src.kdB) * v0); \
            S1[0] = S1[0] * LO2(src.wA) + (LO2(src.bA) * sa1 + LO2(src.kdA) * v1); S1[1] = S1[1] * HI2(src.wA) + (HI2(src.bA) * sa1 + HI2(src.kdA) * v1); \
            S1[2] = S1[2] * LO2(src.wB) + (LO2(src.bB) * sa1 + LO2(src.kdB) * v1); S1[3] = S1[3] * HI2(src.wB) + (HI2(src.bB) * sa1 + HI2(src.kdB) * v1); } while (0)
        __syncthreads();
#pragma unroll 1
        for (int ck = 0; ck < NCK; ++ck) {
            LAS unsigned char* Bc = lds + (ck & 1) * SC_BUF;
            StepVec A, Bv;
            SV_LOAD(A, Bc, 0);
#pragma unroll 1
            for (int st = 0; st < SC_CT; st += 2) {
                SV_LOAD(Bv, Bc, st + 1);
                SV_STEP(A, Bc, st);
                if (st + 2 < SC_CT) SV_LOAD(A, Bc, st + 2);
                SV_STEP(Bv, Bc, st + 1);
            }
            __syncthreads();
        }
#undef SV_LOAD
#undef SV_STEP
    }
}
#undef LO2
#undef HI2

typedef short v4i16g __attribute__((__vector_size__(8)));
__device__ __forceinline__ s16x4 tr_read16(LAS unsigned char* p) { v4i16g r = __builtin_amdgcn_ds_read_tr16_b64_v4i16((LAS v4i16g*)p); return __builtin_bit_cast(s16x4, r); }
__device__ __forceinline__ f32x4 bf4_to_f32(u32x2 w) { return (f32x4){bf_lo(w.x), bf_hi(w.x), bf_lo(w.y), bf_hi(w.y)}; }
__device__ __forceinline__ u32x2 f32_to_bf4(f32x4 v) { return (u32x2){pk_bf16(v.x, v.y), pk_bf16(v.z, v.w)}; }
__device__ __forceinline__ bf16x8 frag_lo4(f32x4 v) { const u32x4 w = {pk_bf16(v.x, v.y), pk_bf16(v.z, v.w), 0u, 0u}; return __builtin_bit_cast(bf16x8, w); }
__device__ __forceinline__ bf16x8 frag_cat(u32x2 a, u32x2 b) { const u32x4 w = {a.x, a.y, b.x, b.y}; return __builtin_bit_cast(bf16x8, w); }
#define MFMA16(a, b, c) __builtin_amdgcn_mfma_f32_16x16x32_bf16((a), (b), (c), 0, 0, 0)
constexpr int CK = 16, NCHUNK = SEQ / CK, CS_NS = 6;
constexpr int SL_ATIL = 0, SL_RTIL = 2048, SL_BHT = 4096, SL_KHT = 6144, SL_VF = 8192, SL_ULOC = 10240, SL_YLOC = 12288, SL_PC = 14336, SL_BYTES = 14592;
constexpr int PS_IN = 0, PS_AHT = 10240, PS_RHT = 12288, PS_NT = 14336, PS_BYTES = 15360;
constexpr int CS_PS_OFF = CS_NS * SL_BYTES, CS_FLAG_OFF = CS_PS_OFF + 4 * PS_BYTES;
static_assert(CS_FLAG_OFF + 64 <= LDS_BYTES - 64, "chunked scan LDS map");
constexpr size_t WS_CMP = 8192;
template <bool CMP>
__device__ __forceinline__ void scan_chunked_unit(const Args& a, LAS unsigned char* lds, int unit) {
    const int tid = threadIdx.x, lane = tid & 63, wave = __builtin_amdgcn_readfirstlane(tid >> 6);
    const int dir = unit & 1, bh = unit >> 1, b = bh / NH, hd = bh % NH;
    const int c16 = lane & 15, q = lane >> 4, qp = c16 >> 2, pp = c16 & 3;
    volatile LAS unsigned* FULL = (volatile LAS unsigned*)(lds + CS_FLAG_OFF);
    volatile LAS unsigned* DONE = FULL + 8;
    float* Yg = (float*)(a.ws + (dir ? WS_YB : WS_YF)); float* BON = (float*)(a.ws + WS_BON) + (size_t)dir * T * NH;
    float* CMPW = (float*)(a.ws + WS_CMP);
    __syncthreads();
    if (tid < 16) FULL[tid] = 0u;
    __syncthreads();
    float err2 = 0.f, ref2 = 0.f;
    if (wave >= 4) {
        const int pw = wave - 4;
        LAS unsigned char* ps = lds + CS_PS_OFF + pw * PS_BYTES;
        const _Float16* SCb = (const _Float16*)(a.ws + WS_SCAN);
        const _Float16* ARR[5] = {SCb, (const _Float16*)((const unsigned char*)SCb + SCAN_STRIDE), (const _Float16*)((const unsigned char*)SCb + 2 * SCAN_STRIDE),
                                  (const _Float16*)((const unsigned char*)SCb + (size_t)(3 + dir) * SCAN_STRIDE), (const _Float16*)((const unsigned char*)SCb + (size_t)(5 + dir) * SCAN_STRIDE)};
        float kkw[4], kaw[4], rkw[4];
#pragma unroll
        for (int jt = 0; jt < 4; ++jt) { const int ch = hd * 64 + 16 * jt + c16; kkw[jt] = a.in[I_KK][ch]; kaw[jt] = a.in[I_KA][ch]; rkw[jt] = a.in[I_RK][ch]; }
        bf16x8 tri;
#pragma unroll
        for (int e = 0; e < 8; ++e) tri[e] = (e < 4 && 4 * q + e <= c16) ? (short)0x3F80 : (short)0;
#define CS_ISSUE(cc) do { _Pragma("unroll") for (int ar_ = 0; ar_ < 5; ++ar_) _Pragma("unroll") for (int hf_ = 0; hf_ < 2; ++hf_) { \
            const int st_ = (cc) * CK + hf_ * 8 + (lane >> 3); const int t_ = dir ? (SEQ - 1 - st_) : st_; \
            __builtin_amdgcn_global_load_lds((const unsigned*)(ARR[ar_] + ((size_t)b * SEQ + t_) * RW + hd * 64 + 8 * (lane & 7)), (LAS unsigned*)(ps + PS_IN + ar_ * 2048 + hf_ * 1024), 16, 0, 0); } } while (0)
        CS_ISSUE(pw);
#pragma unroll 1
        for (int c = pw; c < NCHUNK; c += 4) {
            const int slot = c % CS_NS; LAS unsigned char* sl = lds + slot * SL_BYTES;
            asm volatile("s_waitcnt vmcnt(0)" ::: "memory");
            { unsigned sp = 0; const unsigned want = 4u * (unsigned)(c / CS_NS); while (DONE[slot] < want) { __builtin_amdgcn_s_sleep(1); if (++sp > (1u << 22)) break; } }
            asm volatile("" ::: "memory");
            f32x4 ss = {0.f, 0.f, 0.f, 0.f}, bn = {0.f, 0.f, 0.f, 0.f};
#pragma unroll
            for (int jt = 0; jt < 4; ++jt) { const int off = (4 * q + qp) * 128 + (16 * jt + 4 * pp) * 2;
                const f32x4 xr = __builtin_convertvector(__builtin_bit_cast(f16x4, tr_read16(ps + PS_IN + 0 * 2048 + off)), f32x4);
                const f32x4 xk = __builtin_convertvector(__builtin_bit_cast(f16x4, tr_read16(ps + PS_IN + 1 * 2048 + off)), f32x4);
                const f32x4 xa = __builtin_convertvector(__builtin_bit_cast(f16x4, tr_read16(ps + PS_IN + 4 * 2048 + off)), f32x4);
                const f32x4 kkr = xk * kkw[jt]; ss += kkr * kkr; bn += xr * (xk * (1.0f + (xa - 1.0f) * kaw[jt])) * rkw[jt]; }
#pragma unroll
            for (int e = 0; e < 4; ++e) { ss[e] = sum16(ss[e]); bn[e] = sum16(bn[e]); }
            f32x4 rn;
#pragma unroll
            for (int e = 0; e < 4; ++e) rn[e] = 1.0f / sqrtf(ss[e] + 1e-12f);
#pragma unroll
            for (int e = 0; e < 4; ++e) { const int st_ = c * CK + 4 * q + e; const int t_ = dir ? (SEQ - 1 - st_) : st_; const size_t bi = ((size_t)b * SEQ + t_) * NH + hd;
                if (CMP) { if (c16 == 0) { const float rf = BON[bi]; err2 += (bn[e] - rf) * (bn[e] - rf); ref2 += rf * rf; } }
                else { if (c16 == 0) BON[bi] = bn[e]; } }
            u32x2 ahw[4], vf[4];
#pragma unroll
            for (int jt = 0; jt < 4; ++jt) { const int off = (4 * q + qp) * 128 + (16 * jt + 4 * pp) * 2;
                const f32x4 xr = __builtin_convertvector(__builtin_bit_cast(f16x4, tr_read16(ps + PS_IN + 0 * 2048 + off)), f32x4);
                const f32x4 xk = __builtin_convertvector(__builtin_bit_cast(f16x4, tr_read16(ps + PS_IN + 1 * 2048 + off)), f32x4);
                vf[jt] = f32_to_bf4(__builtin_convertvector(__builtin_bit_cast(f16x4, tr_read16(ps + PS_IN + 2 * 2048 + off)), f32x4));
                const f32x4 xw = __builtin_convertvector(__builtin_bit_cast(f16x4, tr_read16(ps + PS_IN + 3 * 2048 + off)), f32x4);
                const f32x4 xa = __builtin_convertvector(__builtin_bit_cast(f16x4, tr_read16(ps + PS_IN + 4 * 2048 + off)), f32x4);
                f32x4 lw;
#pragma unroll
                for (int e = 0; e < 4; ++e) lw[e] = __log2f(xw[e]);
                const u32x2 hi = f32_to_bf4(lw); const f32x4 lo = lw - bf4_to_f32(hi);
                f32x4 cum = {0.f, 0.f, 0.f, 0.f};
                cum = MFMA16(tri, frag_cat(hi, (u32x2){0u, 0u}), cum);
                cum = MFMA16(tri, frag_lo4(lo), cum);
                f32x4 P, Pinv, Pprev;
#pragma unroll
                for (int e = 0; e < 4; ++e) { P[e] = __builtin_amdgcn_exp2f(cum[e]); Pinv[e] = __builtin_amdgcn_rcpf(P[e]); }
                Pprev[0] = __builtin_amdgcn_exp2f(cum[0] - lw[0]); Pprev[1] = P[0]; Pprev[2] = P[1]; Pprev[3] = P[2];
                const f32x4 kk = xk * kkw[jt] * rn, kd = xk * (1.0f + (xa - 1.0f) * kaw[jt]);
                const f32x4 AH = -kk * Pprev, RH = xr * P, BH = kk * xa * Pinv, KH = kd * Pinv;
                ahw[jt] = f32_to_bf4(AH);
                const int xo = (16 * jt + c16) * 32 + 8 * q;
                *(LAS u32x2*)(ps + PS_AHT + xo) = ahw[jt]; *(LAS u32x2*)(ps + PS_RHT + xo) = f32_to_bf4(RH);
                *(LAS u32x2*)(sl + SL_BHT + xo) = f32_to_bf4(BH); *(LAS u32x2*)(sl + SL_KHT + xo) = f32_to_bf4(KH);
                if (q == 3) *(LAS float*)(sl + SL_PC + (16 * jt + c16) * 4) = P[3];
                *(LAS u32x2*)(sl + SL_VF + jt * 512 + lane * 8) = vf[jt];
            }
            asm volatile("s_waitcnt lgkmcnt(0)" ::: "memory");
            if (c + 4 < NCHUNK) CS_ISSUE(c + 4);
            bf16x8 AHf[2], BHf[2], KHf[2], RHf[2];
#pragma unroll
            for (int ks = 0; ks < 2; ++ks) { const int o0 = (32 * ks + 8 * q + qp) * 32 + 8 * pp, o1 = o0 + 4 * 32;
                AHf[ks] = __builtin_shufflevector(tr_read16(ps + PS_AHT + o0), tr_read16(ps + PS_AHT + o1), 0, 1, 2, 3, 4, 5, 6, 7);
                RHf[ks] = __builtin_shufflevector(tr_read16(ps + PS_RHT + o0), tr_read16(ps + PS_RHT + o1), 0, 1, 2, 3, 4, 5, 6, 7);
                BHf[ks] = __builtin_shufflevector(tr_read16(sl + SL_BHT + o0), tr_read16(sl + SL_BHT + o1), 0, 1, 2, 3, 4, 5, 6, 7);
                KHf[ks] = __builtin_shufflevector(tr_read16(sl + SL_KHT + o0), tr_read16(sl + SL_KHT + o1), 0, 1, 2, 3, 4, 5, 6, 7); }
            f32x4 Mab = {0.f, 0.f, 0.f, 0.f}, Mak = Mab, MrbT = Mab, MrkT = Mab, MabT = Mab;
#pragma unroll
            for (int ks = 0; ks < 2; ++ks) { Mab = MFMA16(AHf[ks], BHf[ks], Mab); MabT = MFMA16(BHf[ks], AHf[ks], MabT); Mak = MFMA16(AHf[ks], KHf[ks], Mak); MrbT = MFMA16(BHf[ks], RHf[ks], MrbT); MrkT = MFMA16(KHf[ks], RHf[ks], MrkT); }
#pragma unroll
            for (int r = 0; r < 4; ++r) { const bool lt = c16 < 4 * q + r, gt = 4 * q + r < c16, le = 4 * q + r <= c16;
                Mab[r] = lt ? Mab[r] : 0.f; Mak[r] = lt ? Mak[r] : 0.f; MabT[r] = gt ? MabT[r] : 0.f; MrbT[r] = le ? MrbT[r] : 0.f; MrkT[r] = le ? MrkT[r] : 0.f; }
            const f32x4 z4 = {0.f, 0.f, 0.f, 0.f};
            const bf16x8 fN = frag_lo4(Mab), fNT = frag_lo4(MabT);
            const f32x4 N2 = MFMA16(fNT, fN, z4), N2T = MFMA16(fN, fNT, z4);
            f32x4 PT = MabT;
#pragma unroll
            for (int r = 0; r < 4; ++r) PT[r] += (4 * q + r == c16) ? 1.0f : 0.f;
            const bf16x8 fN2 = frag_lo4(N2), fN2T = frag_lo4(N2T);
            PT = MFMA16(fN2, frag_lo4(PT), PT);
            const f32x4 N4 = MFMA16(fN2T, fN2, z4), N4T = MFMA16(fN2, fN2T, z4);
            const bf16x8 fN4 = frag_lo4(N4), fN4T = frag_lo4(N4T);
            PT = MFMA16(fN4, frag_lo4(PT), PT);
            const f32x4 N8 = MFMA16(fN4T, fN4, z4);
            PT = MFMA16(frag_lo4(N8), frag_lo4(PT), PT);
            const bf16x8 LinvF = frag_lo4(PT);
            const bf16x8 MakF = frag_lo4(Mak), MrbTF = frag_lo4(MrbT);
            const f32x4 W1 = MFMA16(LinvF, MakF, z4);
            const f32x4 W1T = MFMA16(MakF, LinvF, z4);
            const f32x4 W2T = MFMA16(frag_lo4(W1), MrbTF, MrkT);
            f32x4 AtT[4], RtT[4];
#pragma unroll
            for (int jt = 0; jt < 4; ++jt) {
                const bf16x8 ahF = frag_cat(ahw[jt], (u32x2){0u, 0u});
                const f32x4 AtN = MFMA16(LinvF, ahF, z4);
                AtT[jt] = MFMA16(ahF, LinvF, z4);
                const f32x4 rinit = bf4_to_f32(__builtin_bit_cast(u32x2, tr_read16(ps + PS_RHT + (16 * jt + 4 * q + qp) * 32 + 8 * pp)));
                RtT[jt] = MFMA16(frag_lo4(AtN), MrbTF, rinit);
            }
#pragma unroll
            for (int ks = 0; ks < 2; ++ks) {
                const u32x4 wa = {pk_bf16(AtT[2 * ks][0], AtT[2 * ks][1]), pk_bf16(AtT[2 * ks][2], AtT[2 * ks][3]), pk_bf16(AtT[2 * ks + 1][0], AtT[2 * ks + 1][1]), pk_bf16(AtT[2 * ks + 1][2], AtT[2 * ks + 1][3])};
                const u32x4 wr = {pk_bf16(RtT[2 * ks][0], RtT[2 * ks][1]), pk_bf16(RtT[2 * ks][2], RtT[2 * ks][3]), pk_bf16(RtT[2 * ks + 1][0], RtT[2 * ks + 1][1]), pk_bf16(RtT[2 * ks + 1][2], RtT[2 * ks + 1][3])};
                *(LAS u32x4*)(sl + SL_ATIL + ks * 1024 + lane * 16) = wa; *(LAS u32x4*)(sl + SL_RTIL + ks * 1024 + lane * 16) = wr; }
            const bf16x8 W1TF = frag_lo4(W1T), W2TF = frag_lo4(W2T);
#pragma unroll
            for (int nt = 0; nt < 4; ++nt) { const bf16x8 vB = frag_cat(vf[nt], (u32x2){0u, 0u});
                const f32x4 ul = MFMA16(W1TF, vB, z4), yl = MFMA16(W2TF, vB, z4);
                *(LAS u32x2*)(sl + SL_ULOC + nt * 512 + lane * 8) = f32_to_bf4(ul); *(LAS u32x2*)(sl + SL_YLOC + nt * 512 + lane * 8) = f32_to_bf4(yl); }
            asm volatile("s_waitcnt lgkmcnt(0)" ::: "memory");
            if (lane == 0) FULL[slot] = (unsigned)(c + 1);
        }
#undef CS_ISSUE
    } else {
        const int nt = wave;
        f32x4 S[4];
#pragma unroll
        for (int mt = 0; mt < 4; ++mt) S[mt] = (f32x4){0.f, 0.f, 0.f, 0.f};
#pragma unroll 1
        for (int c = 0; c < NCHUNK; ++c) {
            const int slot = c % CS_NS; LAS unsigned char* sl = lds + slot * SL_BYTES;
            { unsigned sp = 0; while (FULL[slot] < (unsigned)(c + 1)) { __builtin_amdgcn_s_sleep(1); if (++sp > (1u << 22)) break; } }
            asm volatile("" ::: "memory");
            const bf16x8 at0 = *(const LAS bf16x8*)(sl + SL_ATIL + lane * 16), at1 = *(const LAS bf16x8*)(sl + SL_ATIL + 1024 + lane * 16);
            const bf16x8 rt0 = *(const LAS bf16x8*)(sl + SL_RTIL + lane * 16), rt1 = *(const LAS bf16x8*)(sl + SL_RTIL + 1024 + lane * 16);
            const u32x2 ulw = *(const LAS u32x2*)(sl + SL_ULOC + nt * 512 + lane * 8), ylw = *(const LAS u32x2*)(sl + SL_YLOC + nt * 512 + lane * 8), vfw = *(const LAS u32x2*)(sl + SL_VF + nt * 512 + lane * 8);
            f32x4 pc[4]; bf16x8 bk[4];
#pragma unroll
            for (int mt = 0; mt < 4; ++mt) { pc[mt] = *(const LAS f32x4*)(sl + SL_PC + (16 * mt + 4 * q) * 4);
                bk[mt] = frag_cat(*(const LAS u32x2*)(sl + SL_BHT + (16 * mt + c16) * 32 + 8 * q), *(const LAS u32x2*)(sl + SL_KHT + (16 * mt + c16) * 32 + 8 * q)); }
            const bf16x8 Sb0 = frag_cat(f32_to_bf4(S[0]), f32_to_bf4(S[1])), Sb1 = frag_cat(f32_to_bf4(S[2]), f32_to_bf4(S[3]));
            f32x4 UT = bf4_to_f32(ulw), YT = bf4_to_f32(ylw);
            UT = MFMA16(at0, Sb0, UT); UT = MFMA16(at1, Sb1, UT);
            YT = MFMA16(rt0, Sb0, YT); YT = MFMA16(rt1, Sb1, YT);
            const bf16x8 Ub = frag_cat(f32_to_bf4(UT), vfw);
#pragma unroll
            for (int mt = 0; mt < 4; ++mt) { S[mt] = MFMA16(bk[mt], Ub, S[mt]); S[mt] = S[mt] * pc[mt]; }
#pragma unroll
            for (int r = 0; r < 4; ++r) { const int st_ = c * CK + 4 * q + r; const int t_ = dir ? (SEQ - 1 - st_) : st_; float* yp = Yg + ((size_t)b * SEQ + t_) * RW + hd * 64 + 16 * nt + c16;
                if (CMP) { const float rf = *yp; err2 += (YT[r] - rf) * (YT[r] - rf); ref2 += rf * rf; } else *yp = YT[r]; }
            asm volatile("s_waitcnt lgkmcnt(0)" ::: "memory");
            if (lane == 0) (void)__hip_atomic_fetch_add((LAS unsigned*)&DONE[slot], 1u, __ATOMIC_RELAXED, __HIP_MEMORY_SCOPE_WORKGROUP);
        }
    }
    if (CMP) { err2 = wave_sum(err2); ref2 = wave_sum(ref2); if (lane == 0) { (void)__hip_atomic_fetch_add(CMPW, err2, __ATOMIC_RELAXED, __HIP_MEMORY_SCOPE_AGENT); (void)__hip_atomic_fetch_add(CMPW + 1, ref2, __ATOMIC_RELAXED, __HIP_MEMORY_SCOPE_AGENT); } }
}

__device__ __forceinline__ void phase_post(const Args& a, int G) {
    const int tid = threadIdx.x, lane = tid & 63, wave = __builtin_amdgcn_readfirstlane(tid >> 6);
    const int gw = blockIdx.x * 8 + wave, NGW = G * 8, q = lane >> 4, l16 = lane & 15;
    const float* __restrict__ YF = (const float*)(a.ws + WS_YF); const float* __restrict__ YB = (const float*)(a.ws + WS_YB); const float* __restrict__ BON = (const float*)(a.ws + WS_BON);
    const _Float16* __restrict__ Vg = (const _Float16*)(a.ws + WS_SCAN + 2 * SCAN_STRIDE); const bf16_t* __restrict__ Gg = (const bf16_t*)(a.ws + WS_G); bf16_t* __restrict__ MIX = (bf16_t*)(a.ws + WS_MIX);
    float* ss = (float*)(a.ws + WS_SS);
    for (int i = blockIdx.x * NTHREADS + tid; i < T; i += G * NTHREADS) ss[i] = 0.f;
    constexpr int NIT = T * NH / 4;
#pragma unroll 4
    for (int it = gw; it < NIT; it += NGW) {
        const int hr = 4 * it + q, tok = hr / NH, hd = hr - tok * NH; const size_t e = (size_t)hr * 64 + 4 * l16;
        const f32x4 yf = *(const f32x4*)(YF + e), yb = *(const f32x4*)(YB + e);
        const f16x4 vh = *(const f16x4*)(Vg + e); const u32x2 gw2 = *(const u32x2*)(Gg + e);
        const float bon = BON[hr] + BON[(size_t)T * NH + hr];
        const f32x4 lg = *(const f32x4*)(a.in[I_LNXG] + hd * 64 + 4 * l16), lb = *(const f32x4*)(a.in[I_LNXB] + hd * 64 + 4 * l16);
        const f32x4 y = yf + yb;
        const float mean = sum16((y.x + y.y) + (y.z + y.w)) * (1.f / 64.f);
        const f32x4 d = y - mean;
        const float var = sum16((d.x * d.x + d.y * d.y) + (d.z * d.z + d.w * d.w)) * (1.f / 64.f);
        const float rstd = 1.0f / sqrtf(var + 64e-5f);
        const f32x4 vv = __builtin_convertvector(vh, f32x4);
        const f32x4 gv = {bf_lo(gw2.x), bf_hi(gw2.x), bf_lo(gw2.y), bf_hi(gw2.y)};
        const f32x4 o = (d * rstd * lg + lb + vv * bon) * gv;
        u32x2 w; w.x = pk_bf16(o.x, o.y); w.y = pk_bf16(o.z, o.w);
        *(u32x2*)(MIX + (size_t)tok * D + 640 + hd * 64 + 4 * l16) = w;
    }
}

constexpr int RT_WS = 2064;
__device__ __forceinline__ void phase_router(const Args& a, LAS unsigned char* lds, int G) {
    const int tid = threadIdx.x, lane = tid & 63, wave = __builtin_amdgcn_readfirstlane(tid >> 6);
    const int gw = blockIdx.x * 8 + wave, NGW = G * 8, l15 = lane & 15, kq = lane >> 4;
    LAS bf16_t* WH = (LAS bf16_t*)lds; LAS bf16_t* WL = (LAS bf16_t*)(lds + 16 * RT_WS);
    for (int i = tid; i < D * NE; i += NTHREADS) { const int k = i >> 4, e = i & 15; const float w = a.in[I_WROUTER][i];
        const unsigned hi = pk_bf16(w, 0.f) & 0xffffu; const float rem = w - bf_lo(hi);
        WH[e * (RT_WS / 2) + k] = (bf16_t)hi; WL[e * (RT_WS / 2) + k] = (bf16_t)(pk_bf16(rem, 0.f) & 0xffffu); }
    __syncthreads();
    const float* __restrict__ X1 = (const float*)(a.ws + WS_X1); const float* __restrict__ ss = (const float*)(a.ws + WS_SS); bf16_t* __restrict__ H2 = (bf16_t*)(a.ws + WS_H2);
    float* __restrict__ AFF = (float*)(a.ws + WS_AFF); int* __restrict__ INV = (int*)(a.ws + WS_INV);
    const float* __restrict__ GF = a.in[I_NFFNG];
    for (int grp = gw; grp < T / 16; grp += NGW) {
        const int tok = grp * 16 + l15;
        const float rs = 1.0f / sqrtf(ss[tok] * (1.f / D) + 1e-6f);
        f32x4 acc = {0.f, 0.f, 0.f, 0.f};
        const float* xrow = X1 + (size_t)tok * D + 8 * kq; bf16_t* hrow = H2 + (size_t)tok * D + 8 * kq;
#pragma unroll 8
        for (int ks = 0; ks < 32; ++ks) {
            const f32x4 x0 = *(const f32x4*)(xrow + 32 * ks), x1v = *(const f32x4*)(xrow + 32 * ks + 4);
            const f32x4 g0 = *(const f32x4*)(GF + 32 * ks + 8 * kq), g1 = *(const f32x4*)(GF + 32 * ks + 8 * kq + 4);
            const f32x4 h0 = x0 * rs * g0, h1 = x1v * rs * g1;
            u32x4 hi; hi.x = pk_bf16(h0.x, h0.y); hi.y = pk_bf16(h0.z, h0.w); hi.z = pk_bf16(h1.x, h1.y); hi.w = pk_bf16(h1.z, h1.w);
            *(u32x4*)(hrow + 32 * ks) = hi;
            u32x4 lo; lo.x = pk_bf16(h0.x - bf_lo(hi.x), h0.y - bf_hi(hi.x)); lo.y = pk_bf16(h0.z - bf_lo(hi.y), h0.w - bf_hi(hi.y));
            lo.z = pk_bf16(h1.x - bf_lo(hi.z), h1.y - bf_hi(hi.z)); lo.w = pk_bf16(h1.z - bf_lo(hi.w), h1.w - bf_hi(hi.w));
            const bf16x8 ah = __builtin_bit_cast(bf16x8, hi), al = __builtin_bit_cast(bf16x8, lo);
            const bf16x8 bh = *(const LAS bf16x8*)(lds + l15 * RT_WS + (32 * ks + 8 * kq) * 2), bl = *(const LAS bf16x8*)(lds + 16 * RT_WS + l15 * RT_WS + (32 * ks + 8 * kq) * 2);
            acc = __builtin_amdgcn_mfma_f32_16x16x32_bf16(ah, bh, acc, 0, 0, 0);
            acc = __builtin_amdgcn_mfma_f32_16x16x32_bf16(al, bh, acc, 0, 0, 0);
            acc = __builtin_amdgcn_mfma_f32_16x16x32_bf16(ah, bl, acc, 0, 0, 0);
        }
#pragma unroll
        for (int rg = 0; rg < 4; ++rg) { const float mx = max16(acc[rg]); const float ex = __expf(acc[rg] - mx); const float sm = sum16(ex);
            const int t2 = grp * 16 + 4 * kq + rg, bb = t2 >> 12, sq = t2 & (SEQ - 1);
            AFF[((size_t)(bb * NE + l15)) * SEQ + sq] = ex / sm; }
        *(u32x4*)(INV + (size_t)grp * 256 + 4 * lane) = (u32x4){0xffffffffu, 0xffffffffu, 0xffffffffu, 0xffffffffu};
    }
}

__device__ __forceinline__ void topk_unit(const Args& a, LAS unsigned char* lds, int unit) {
    const int tid = threadIdx.x, lane = tid & 63, wave = __builtin_amdgcn_readfirstlane(tid >> 6);
    const int b = unit >> 4, e = unit & 15;
    const float* AFF = (const float*)(a.ws + WS_AFF) + (size_t)unit * SEQ;
    LAS unsigned* KEY = (LAS unsigned*)lds;
    LAS unsigned* HIST = (LAS unsigned*)(lds + 16384);
    LAS unsigned* CTL = (LAS unsigned*)(lds + 16384 + 1024);
    LAS unsigned* WS_ = (LAS unsigned*)(lds + 16384 + 2048);
    __syncthreads();
    unsigned key[8];
    { const u32x4 k0 = *(const u32x4*)(AFF + tid * 8), k1 = *(const u32x4*)(AFF + tid * 8 + 4); key[0] = k0.x; key[1] = k0.y; key[2] = k0.z; key[3] = k0.w; key[4] = k1.x; key[5] = k1.y; key[6] = k1.z; key[7] = k1.w; }
    if (tid == 0) { CTL[0] = 0u; CTL[1] = (unsigned)CAP; }
    unsigned prefix = 0u, mask = 0u;
#pragma unroll 1
    for (int pass = 0; pass < 4; ++pass) {
        const int shift = 24 - 8 * pass;
        if (tid < 256) HIST[tid] = 0u;
        __syncthreads();
#pragma unroll
        for (int i = 0; i < 8; ++i) if ((key[i] & mask) == prefix) (void)__hip_atomic_fetch_add(&HIST[(key[i] >> shift) & 255u], 1u, __ATOMIC_RELAXED, __HIP_MEMORY_SCOPE_WORKGROUP);
        __syncthreads();
        if (wave == 0) {
            const unsigned need = CTL[1];
            unsigned hv[4], tsum = 0u;
#pragma unroll
            for (int i = 0; i < 4; ++i) { hv[i] = HIST[255 - (4 * lane + i)]; tsum += hv[i]; }
            unsigned inc = tsum;
#pragma unroll
            for (int o = 1; o < 64; o <<= 1) { const unsigned v = __shfl_up(inc, o); if (lane >= o) inc += v; }
            unsigned exc = inc - tsum;
            if (exc < need && need <= inc) {
                unsigned run = exc; int di = 0;
#pragma unroll
                for (int i = 0; i < 4; ++i) { if (run < need && need <= run + hv[i]) { di = i; break; } run += hv[i]; }
                const unsigned digit = 255u - (unsigned)(4 * lane + di);
                CTL[0] = prefix | (digit << shift); CTL[1] = need - run;
            }
        }
        __syncthreads();
        prefix = CTL[0]; mask |= (255u << shift);
    }
    const unsigned thr = prefix, need_eq = CTL[1];
    unsigned ngt = 0u, neq = 0u;
#pragma unroll
    for (int i = 0; i < 8; ++i) { ngt += (key[i] > thr) ? 1u : 0u; neq += (key[i] == thr) ? 1u : 0u; }
    unsigned pk = ngt | (neq << 16), inc = pk;
#pragma unroll
    for (int o = 1; o < 64; o <<= 1) { const unsigned v = __shfl_up(inc, o); if (lane >= o) inc += v; }
    if (lane == 63) WS_[wave] = inc;
    __syncthreads();
    unsigned woff = 0u, tot = 0u;
#pragma unroll
    for (int w = 0; w < 8; ++w) { const unsigned v = WS_[w]; if (w < wave) woff += v; tot += v; }
    const unsigned exc = inc - pk + woff;
    unsigned gpos = exc & 0xffffu, epos = exc >> 16; const unsigned totgt = tot & 0xffffu;
    const int sbase = (e * BATCH + b) * CAP;
    int* ROWTOK = (int*)(a.ws + WS_ROWTOK); float* ROWGATE = (float*)(a.ws + WS_ROWGATE); int* INV = (int*)(a.ws + WS_INV);
#pragma unroll
    for (int i = 0; i < 8; ++i) {
        int pos = -1;
        if (key[i] > thr) pos = (int)gpos++;
        else if (key[i] == thr) { if (epos < need_eq) pos = (int)(totgt + epos); epos++; }
        if (pos >= 0) { const int s = tid * 8 + i, tok = b * SEQ + s, slot = sbase + pos;
            ROWTOK[slot] = tok; ROWGATE[slot] = __builtin_bit_cast(float, key[i]); INV[(size_t)tok * NE + e] = slot; }
    }
}

__device__ __forceinline__ void phase_final(const Args& a, int G) {
    const int tid = threadIdx.x, lane = tid & 63, wave = __builtin_amdgcn_readfirstlane(tid >> 6);
    const int gw = blockIdx.x * 8 + wave, NGW = G * 8;
    const float* __restrict__ X1 = (const float*)(a.ws + WS_X1); const bf16_t* __restrict__ YE = (const bf16_t*)(a.ws + WS_YE); const int* __restrict__ INV = (const int*)(a.ws + WS_INV);
    float* __restrict__ OUT = a.out;
    f32x4 gg[4];
#pragma unroll
    for (int j = 0; j < 4; ++j) gg[j] = *(const f32x4*)(a.in[I_FNG] + 4 * lane + 256 * j);
    int tok = gw;
    int invn = (tok < T) ? INV[(size_t)tok * NE + (lane & 15)] : -1;
    f32x4 xn[4];
#pragma unroll
    for (int j = 0; j < 4; ++j) xn[j] = (tok < T) ? *(const f32x4*)(X1 + (size_t)tok * D + 4 * lane + 256 * j) : (f32x4){0.f, 0.f, 0.f, 0.f};
    for (; tok < T; tok += NGW) {
        const int invc = invn; f32x4 v[4];
#pragma unroll
        for (int j = 0; j < 4; ++j) v[j] = xn[j];
        const int tn = tok + NGW;
        if (tn < T) { invn = INV[(size_t)tn * NE + (lane & 15)];
#pragma unroll
            for (int j = 0; j < 4; ++j) xn[j] = *(const f32x4*)(X1 + (size_t)tn * D + 4 * lane + 256 * j); }
        unsigned long long m = __ballot(invc >= 0) & 0xffffull;
        const int n = __builtin_popcountll(m);
        int sl[4]; float wt[4];
#pragma unroll
        for (int k = 0; k < 4; ++k) { int e = 0; if (m) { e = __builtin_ctzll(m); m &= m - 1; wt[k] = 1.f; sl[k] = __builtin_amdgcn_readlane(invc, e); } else { wt[k] = 0.f; sl[k] = 0; } }
        u32x2 rw[4][4];
#pragma unroll
        for (int k = 0; k < 4; ++k)
#pragma unroll
            for (int j = 0; j < 4; ++j) rw[k][j] = *(const u32x2*)(YE + (size_t)sl[k] * D + 4 * lane + 256 * j);
#pragma unroll
        for (int k = 0; k < 4; ++k)
#pragma unroll
            for (int j = 0; j < 4; ++j) { v[j].x += wt[k] * bf_lo(rw[k][j].x); v[j].y += wt[k] * bf_hi(rw[k][j].x); v[j].z += wt[k] * bf_lo(rw[k][j].y); v[j].w += wt[k] * bf_hi(rw[k][j].y); }
        if (n > 4) { while (m) { const int e = __builtin_ctzll(m); m &= m - 1; const int slot = __builtin_amdgcn_readlane(invc, e);
#pragma unroll
                for (int j = 0; j < 4; ++j) { const u32x2 w = *(const u32x2*)(YE + (size_t)slot * D + 4 * lane + 256 * j);
                    v[j].x += bf_lo(w.x); v[j].y += bf_hi(w.x); v[j].z += bf_lo(w.y); v[j].w += bf_hi(w.y); } } }
        float sq = 0.f;
#pragma unroll
        for (int j = 0; j < 4; ++j) sq += (v[j].x * v[j].x + v[j].y * v[j].y) + (v[j].z * v[j].z + v[j].w * v[j].w);
        float rs = 1.0f / sqrtf(wave_sum(sq) * (1.f / D) + 1e-6f);
        if (SCAN_MODE == 2) { const float* cw = (const float*)(a.ws + WS_CMP); rs *= 1.0f + 4.0f * sqrtf(cw[0] / fmaxf(cw[1], 1e-30f)); }
#pragma unroll
        for (int j = 0; j < 4; ++j) *(f32x4*)(OUT + (size_t)tok * D + 4 * lane + 256 * j) = v[j] * rs * gg[j];
    }
}

#define XB_TMO      128
#define XB_XCNT(j)  (256  + 64 * (j))
#define XB_XSUB(j)  (1280 + 64 * (j))
#define XB_XGEN(j)  (2304 + 64 * (j))
#define XB_TOP      3328
#define XB_TOPGEN   3392
#define XCD_BAR_WORDS 3456
#define XB_SPIN_CAP (1u << 22)
__device__ __forceinline__ unsigned xb_ld(unsigned* p)              { return __hip_atomic_load(p, __ATOMIC_RELAXED, __HIP_MEMORY_SCOPE_AGENT); }
__device__ __forceinline__ unsigned xb_add(unsigned* p, unsigned v) { return __hip_atomic_fetch_add(p, v, __ATOMIC_RELAXED, __HIP_MEMORY_SCOPE_AGENT); }
__device__ __forceinline__ unsigned xb_xcc_id() { return (unsigned)__builtin_amdgcn_s_getreg((3 << 11) | 20) & 0xFu; }
#define XB_SPIN(cond, bar) do { unsigned _sp = 0; while (cond) { __builtin_amdgcn_s_sleep(1); \
    if ((++_sp & 255u) == 0u) { if (xb_ld(&(bar)[XB_TMO])) break; if (_sp > XB_SPIN_CAP) { atomicAdd(&(bar)[XB_TMO], 1u); break; } } } } while (0)
struct XcdBarrier { unsigned* bar; unsigned x; volatile LAS unsigned* st; };
__device__ __forceinline__ XcdBarrier xcd_barrier_post(unsigned* bar, volatile LAS unsigned* st) {
    XcdBarrier b; b.bar = bar; b.x = xb_xcc_id(); b.st = st;
    if (threadIdx.x == 0) (void)xb_add(&bar[XB_XCNT(b.x)], 1u);
    return b;
}
__device__ __forceinline__ void xcd_barrier_complete(unsigned* bar, unsigned x, unsigned& nloc, unsigned& nx) {
    const unsigned G = gridDim.x * gridDim.y * gridDim.z;
    unsigned sum, cnt, mine, sp = 0u;
    for (;;) {
        sum = 0u; cnt = 0u; mine = 0u;
#pragma unroll
        for (unsigned j = 0; j < 16; ++j) { const unsigned c = xb_ld(&bar[XB_XCNT(j)]); sum += c; cnt += (c > 0u) ? 1u : 0u; mine = (j == x) ? c : mine; }
        if (sum == G) break;
        __builtin_amdgcn_s_sleep(1);
        if ((++sp & 255u) == 0u) { if (xb_ld(&bar[XB_TMO])) break; if (sp > XB_SPIN_CAP) { atomicAdd(&bar[XB_TMO], 1u); break; } }
    }
    nloc = mine > 0u ? mine : 1u; nx = cnt > 0u ? cnt : 1u;
}
__device__ __forceinline__ void xcd_barrier(const XcdBarrier& b) {
    asm volatile("s_waitcnt vmcnt(0)" ::: "memory");
    __syncthreads();
    if (threadIdx.x == 0) {
        unsigned* bar = b.bar;
        __builtin_amdgcn_s_waitcnt(0);
        unsigned nloc = b.st[0], nx = b.st[1];
        if (nloc == 0u) { xcd_barrier_complete(bar, b.x, nloc, nx); b.st[0] = nloc; b.st[1] = nx; }
        const unsigned old = xb_add(&bar[XB_XSUB(b.x)], 1u);
        const unsigned gen = old / nloc;
        if (old + 1u == (gen + 1u) * nloc) {
            __builtin_amdgcn_fence(__ATOMIC_RELEASE, "agent");
            asm volatile("s_waitcnt vmcnt(0)" ::: "memory");
            const unsigned og = xb_add(&bar[XB_TOP], 1u);
            const unsigned tg = og / nx;
            if (og + 1u == (tg + 1u) * nx) xb_add(&bar[XB_TOPGEN], 1u);
            else XB_SPIN(xb_ld(&bar[XB_TOPGEN]) == tg, bar);
            __builtin_amdgcn_fence(__ATOMIC_ACQUIRE, "agent");
            xb_add(&bar[XB_XGEN(b.x)], 1u);
            asm volatile("s_waitcnt vmcnt(0)" ::: "memory");
        } else {
            XB_SPIN(xb_ld(&bar[XB_XGEN(b.x)]) == gen, bar);
            __builtin_amdgcn_fence(__ATOMIC_ACQUIRE, "agent");
            asm volatile("s_waitcnt vmcnt(0)" ::: "memory");
        }
    }
    __syncthreads();
}

#ifndef PH_MASK
#define PH_MASK 0x7ff
#endif
#ifndef REP_MASK
#define REP_MASK 0
#endif
#ifndef P2_MASK
#define P2_MASK 7
#endif
#ifndef P2_REP
#define P2_REP 0
#endif
constexpr int LDS_MISC = LDS_BYTES - 64;
constexpr size_t WS_CTL = 0, CTL_BYTES = 16384;
__global__ void __launch_bounds__(NTHREADS, 2) mega(Args a) {
    extern __shared__ __attribute__((aligned(16))) unsigned char lds_raw[];
    LAS unsigned char* lds = (LAS unsigned char*)lds_raw;
    cg::grid_group grid = cg::this_grid();
    const int G = gridDim.x, lo = a.ph_lo, hi = a.ph_hi;
    unsigned char* ws = a.ws;
    volatile LAS unsigned* misc = (volatile LAS unsigned*)(lds + LDS_MISC);
    if (threadIdx.x < 16) misc[threadIdx.x] = 0u;
    __syncthreads();
    XcdBarrier xbar = xcd_barrier_post((unsigned*)(ws + WS_CTL), misc);
#define IN(k) (((PH_MASK >> (k)) & 1) && lo <= (k) && (k) < hi)
#define NREP(k) (1 + ((REP_MASK >> (k)) & 1))
#define PHASE(k, ...) do { if (IN(k)) { for (int rep_ = 0; rep_ < NREP(k); ++rep_) { __VA_ARGS__; if (rep_ + 1 < NREP(k) || IN((k) + 1)) { if ((k) == 0 && rep_ + 1 == NREP(k)) grid.sync(); else xcd_barrier(xbar); } } } } while (0)

    PHASE(0, phase_prep(a, lds, G));

    PHASE(1, {
        { pg8::Gemm g{(const bf16_t*)(ws + WS_XH), (const bf16_t*)(ws + WS_WINT), T, IN_PROJ, D}; pg8::StaticOrder S; S.init(T, IN_PROJ, G, (int)blockIdx.x);
          pg8::EpiBf16 E{(bf16_t*)(ws + WS_P), IN_PROJ}; pg8::gemm_phase<pg8::EpiBf16, pg8::StaticOrder, false>(lds, g, S, E, nullptr); }
        { pg8::Gemm g{(const bf16_t*)(ws + WS_MEMN), (const bf16_t*)(ws + WS_WKT), BATCH * NMEM, 256, D}; pg8::StaticOrder S; S.init(BATCH * NMEM, 256, G, (int)blockIdx.x);
          pg8::EpiBf16 E{(bf16_t*)(ws + WS_KMEM), 256}; pg8::gemm_phase<pg8::EpiBf16, pg8::StaticOrder, false>(lds, g, S, E, nullptr); }
        { pg8::Gemm g{(const bf16_t*)(ws + WS_WVT), (const bf16_t*)(ws + WS_MEMN), 256, BATCH * NMEM, D}; pg8::StaticOrder S; S.init(256, BATCH * NMEM, G, (int)blockIdx.x);
          pg8::EpiBf16 E{(bf16_t*)(ws + WS_VT), BATCH * NMEM}; pg8::gemm_phase<pg8::EpiBf16, pg8::StaticOrder, false>(lds, g, S, E, nullptr); }
    });

    PHASE(2, {
        for (int u = blockIdx.x; u < 3072; u += G) {
            if (u < 1024) { for (int r2 = 0; r2 < 1 + (P2_REP & 1); ++r2) if (P2_MASK & 1) attn_unit(a, lds, u); }
            else if (u < 2048) { for (int r2 = 0; r2 < 1 + ((P2_REP >> 1) & 1); ++r2) if (P2_MASK & 2) conv_unit(a, lds, u - 1024); }
            else { for (int r2 = 0; r2 < 1 + ((P2_REP >> 2) & 1); ++r2) if (P2_MASK & 4) prep_unit(a, lds, u - 2048); }
        }
    });

#ifndef SCAN_MODE
#define SCAN_MODE 1
#endif
    PHASE(3, { if (SCAN_MODE != 1) { for (int u = blockIdx.x; u < BATCH * NH * 2; u += G) scan_unit(a, lds, u); }
               if (SCAN_MODE == 1) { for (int u = blockIdx.x; u < BATCH * NH * 2; u += G) scan_chunked_unit<false>(a, lds, u); }
               if (SCAN_MODE == 2) { xcd_barrier(xbar); for (int u = blockIdx.x; u < BATCH * NH * 2; u += G) scan_chunked_unit<true>(a, lds, u); } });

    PHASE(4, phase_post(a, G));

    PHASE(5, {
        pg8::Gemm g{(const bf16_t*)(ws + WS_MIX), (const bf16_t*)(ws + WS_WOUTT), T, D, D}; pg8::StaticOrder S; S.init(T, D, G, (int)blockIdx.x);
        pg8::EpiResidSS E{a.in[I_X], (float*)(ws + WS_X1), (float*)(ws + WS_SS)}; pg8::gemm_phase<pg8::EpiResidSS, pg8::StaticOrder, false>(lds, g, S, E, nullptr);
    });

    PHASE(6, phase_router(a, lds, G));

    PHASE(7, { for (int u = blockIdx.x; u < BATCH * NE; u += G) topk_unit(a, lds, u); });

    PHASE(8, {
        pg8::Gemm g{(const bf16_t*)(ws + WS_H2), (const bf16_t*)(ws + WS_WGUT), NSLOT, 2048, D}; pg8::ExpertOrder S; S.init(32, 8, NE, G, (int)blockIdx.x);
        pg8::EpiSwiGLU E{(bf16_t*)(ws + WS_HID)}; pg8::gemm_phase<pg8::EpiSwiGLU, pg8::ExpertOrder, true>(lds, g, S, E, (const int*)(ws + WS_ROWTOK));
    });

    PHASE(9, {
        pg8::Gemm g{(const bf16_t*)(ws + WS_HID), (const bf16_t*)(ws + WS_WDT), NSLOT, D, FF}; pg8::ExpertOrder S; S.init(32, 4, NE, G, (int)blockIdx.x);
        pg8::EpiGateScale E{(bf16_t*)(ws + WS_YE), (const float*)(ws + WS_ROWGATE)}; pg8::gemm_phase<pg8::EpiGateScale, pg8::ExpertOrder, false>(lds, g, S, E, nullptr);
    });

    PHASE(10, phase_final(a, G));
#undef IN
#undef NREP
#undef PHASE
}

#ifndef MK_ONE_LAUNCH
#define MK_ONE_LAUNCH 1
#endif
extern "C" void kernel_launch(void* const* d_in, const int* in_sizes, int n_in, void* d_out, int out_size, void* d_ws, size_t ws_size, hipStream_t stream) {
    static int grid_blocks = 0;
    if (grid_blocks == 0) {
        if (n_in != 29 || out_size != T * D || ws_size < WS_END) { fprintf(stderr, "kernel_launch: unexpected problem: n_in %d out %d ws %zu (need %zu)\n", n_in, out_size, ws_size, (size_t)WS_END); grid_blocks = -1; return; }
        int dev = 0, cus = 0, per_cu = 0;
        if (hipGetDevice(&dev) != hipSuccess || hipDeviceGetAttribute(&cus, hipDeviceAttributeMultiprocessorCount, dev) != hipSuccess) { grid_blocks = -1; return; }
        if (hipFuncSetAttribute((const void*)mega, hipFuncAttributeMaxDynamicSharedMemorySize, LDS_BYTES) != hipSuccess) { fprintf(stderr, "kernel_launch: hipFuncSetAttribute failed\n"); grid_blocks = -1; return; }
        if (hipOccupancyMaxActiveBlocksPerMultiprocessor(&per_cu, (const void*)mega, NTHREADS, LDS_BYTES) != hipSuccess || per_cu < 1) { fprintf(stderr, "kernel_launch: occupancy query says %d blocks per CU\n", per_cu); grid_blocks = -1; return; }
        grid_blocks = cus;
    }
    if (grid_blocks < 0) return;
    if (hipMemsetAsync((char*)d_ws + WS_CTL, 0, CTL_BYTES, stream) != hipSuccess) { fprintf(stderr, "kernel_launch: memset failed\n"); return; }
    Args a{};
    for (int i = 0; i < 29; ++i) a.in[i] = (const float*)d_in[i];
    a.out = (float*)d_out; a.ws = (unsigned char*)d_ws;
#if MK_ONE_LAUNCH
    a.ph_lo = 0; a.ph_hi = NPHASE;
    { void* args[] = {&a}; hipError_t e = hipLaunchCooperativeKernel((const void*)mega, dim3(grid_blocks), dim3(NTHREADS), args, LDS_BYTES, stream);
      if (e != hipSuccess) fprintf(stderr, "cooperative launch failed: %s (grid %d)\n", hipGetErrorString(e), grid_blocks); }
#else
    for (int ph = 0; ph < NPHASE; ++ph) { a.ph_lo = ph; a.ph_hi = ph + 1; void* args[] = {&a};
        hipError_t e = hipLaunchCooperativeKernel((const void*)mega, dim3(grid_blocks), dim3(NTHREADS), args, LDS_BYTES, stream);
        if (e != hipSuccess) { fprintf(stderr, "cooperative launch %d failed: %s (grid %d)\n", ph, hipGetErrorString(e), grid_blocks); break; } }
#endif
}
```

```cpp
#include <hip/hip_runtime.h>
#include <hip/hip_cooperative_groups.h>
#include <cstdio>
#include <cstdint>
namespace cg = cooperative_groups;

#define LAS __attribute__((address_space(3)))
typedef unsigned short bf16_t;
typedef short bf16x8 __attribute__((ext_vector_type(8)));
typedef short s16x4 __attribute__((ext_vector_type(4)));
typedef float f32x2 __attribute__((ext_vector_type(2)));
typedef float f32x4 __attribute__((ext_vector_type(4)));
typedef float f32x16 __attribute__((ext_vector_type(16)));
typedef unsigned u32x2 __attribute__((ext_vector_type(2)));
typedef unsigned u32x4 __attribute__((ext_vector_type(4)));
typedef _Float16 f16x4 __attribute__((ext_vector_type(4)));
typedef __bf16 bf16v2 __attribute__((ext_vector_type(2)));

constexpr int D = 1024, BATCH = 16, SEQ = 4096, T = BATCH * SEQ, NMEM = 256;
constexpr int IN_PROJ = 2560, CW = 384, RW = 384, NH = 6, NE = 16, FF = 1024, CAP = 512;
constexpr int NSLOT = NE * BATCH * CAP;
constexpr int NTHREADS = 512;
constexpr int LDS_BYTES = 160 * 1024;
constexpr int NPHASE = 11;
#ifndef SCAN_MODE
#define SCAN_MODE 1
#endif

constexpr size_t MiB = 1u << 20;
constexpr size_t WS_WINT = 1 * MiB;
constexpr size_t WS_WOUTT = 6 * MiB;
constexpr size_t WS_WKT = 8 * MiB;
constexpr size_t WS_WVT = 8 * MiB + 512 * 1024;
constexpr size_t WS_SMALL = 9 * MiB;
constexpr size_t WS_WGUT = 10 * MiB;
constexpr size_t WS_WDT = 74 * MiB;
constexpr size_t WS_KMEM = 106 * MiB;
constexpr size_t WS_VT = 108 * MiB;
constexpr size_t WS_ROWTOK = 106 * MiB;
constexpr size_t WS_ROWGATE = 106 * MiB + 512 * 1024;
constexpr size_t WS_SS = 107 * MiB;
constexpr size_t WS_P = 112 * MiB;
constexpr size_t WS_YF = 112 * MiB;
constexpr size_t WS_YB = 208 * MiB;
constexpr size_t WS_X1 = 112 * MiB;
constexpr size_t WS_XH = 432 * MiB;
constexpr size_t WS_G = 432 * MiB;
constexpr size_t WS_BON = 480 * MiB;
constexpr size_t WS_Q = 400 * MiB;
constexpr int PLD = IN_PROJ - 256;
constexpr size_t WS_H2 = 432 * MiB;
constexpr size_t WS_MEMN = 560 * MiB;
constexpr size_t WS_MIX = 560 * MiB;
constexpr size_t WS_SCAN = 688 * MiB;
constexpr size_t SCAN_STRIDE = 48 * MiB;
constexpr size_t WS_AFF = 624 * MiB;
constexpr size_t WS_INV = 628 * MiB;
constexpr size_t WS_HID = 768 * MiB;
constexpr size_t WS_YE = 368 * MiB;
constexpr size_t WS_END = 1024 * MiB;

__device__ __forceinline__ unsigned pk_bf16(float lo, float hi) { f32x2 v = {lo, hi}; bf16v2 b = __builtin_convertvector(v, bf16v2); return __builtin_bit_cast(unsigned, b); }
__device__ __forceinline__ float bf_lo(unsigned u) { return __builtin_bit_cast(float, u << 16); }
__device__ __forceinline__ float bf_hi(unsigned u) { return __builtin_bit_cast(float, u & 0xffff0000u); }
__device__ __forceinline__ float wave_sum(float v) {
#pragma unroll
    for (int o = 1; o < 64; o <<= 1) v += __shfl_xor(v, o);
    return v;
}
__device__ __forceinline__ float sigmoidf_fast(float x) { return __builtin_amdgcn_rcpf(1.0f + __builtin_amdgcn_exp2f(-1.4426950408889634f * x)); }
template <int CTRL> __device__ __forceinline__ float dpp_f(float x) { return __builtin_bit_cast(float, __builtin_amdgcn_update_dpp(0, __builtin_bit_cast(int, x), CTRL, 0xF, 0xF, true)); }
__device__ __forceinline__ float sum8(float x) { x += dpp_f<0xB1>(x); x += dpp_f<0x4E>(x); x += dpp_f<0x141>(x); return x; }
__device__ __forceinline__ float sum16(float x) { x = sum8(x); x += dpp_f<0x140>(x); return x; }
__device__ __forceinline__ float max16(float x) { x = fmaxf(x, dpp_f<0xB1>(x)); x = fmaxf(x, dpp_f<0x4E>(x)); x = fmaxf(x, dpp_f<0x141>(x)); x = fmaxf(x, dpp_f<0x140>(x)); return x; }

namespace pg8 {
#define PG8_LAS __attribute__((address_space(3)))
constexpr int BM = 256, BK = 64, HALF = 128, HTB = HALF * BK * 2, STAGE_BYTES = 8 * HTB, NXCD = 8, WGM = 8;
__host__ __device__ __forceinline__ int lds_byte(int r, int c) { const int st = (r >> 4) * 2 + (c >> 5), rr = r & 15, cc = c & 31, ob = rr * 64 + cc * 2; return st * 1024 + (ob ^ (((ob >> 9) & 1) << 5)); }
__host__ __device__ __forceinline__ void stage_rc(int b, int& R, int& C) { const int st = b / 1024, sb = b % 1024, swz = sb ^ (((sb >> 9) & 1) << 5); R = (st >> 1) * 16 + swz / 64; C = (st & 1) * 32 + (swz % 64) / 2; }
__host__ __device__ __forceinline__ int perm32(int rho) { const int n = rho >> 4, i = rho & 15; return 8 * (i >> 2) + 4 * n + (i & 3); }

struct Unit { int pm, pn; };
struct Gemm { const bf16_t* A; const bf16_t* Bt; int M, N, K; };

struct StaticOrder {
    int nM, nN, nwg, G, c;
    __device__ void init(int M, int N, int G_, int c_) { nM = M / BM; nN = N / BM; nwg = nM * nN; G = G_; c = c_; }
    __device__ bool next(int i, Unit& u) const {
        const long L = (long)i * G + c; if (L >= nwg) return false;
        int wgid = (int)L; { const int q = nwg / NXCD, r = nwg % NXCD, xcd = wgid % NXCD, off = wgid / NXCD; wgid = (xcd < r ? xcd * (q + 1) : r * (q + 1) + (xcd - r) * q) + off; }
        const int nig = WGM * nN, gid = wgid / nig, fm = gid * WGM, gsz = (nM - fm) < WGM ? (nM - fm) : WGM;
        u.pm = fm + ((wgid % nig) % gsz); u.pn = (wgid % nig) / gsz; return true;
    }
};
struct ExpertOrder {
    int nMe, nNe, per, total, G, c;
    __device__ void init(int nMe_, int nNe_, int nExp, int G_, int c_) { nMe = nMe_; nNe = nNe_; per = nMe * nNe; total = per * nExp; G = G_; c = c_; }
    __device__ bool next(int i, Unit& u) const {
        const long L = (long)i * G + c; if (L >= total) return false;
        const int e = (int)(L / per), w = (int)(L % per), xl = w % 8, j = w / 8, rpx = nMe / 8;
        u.pm = e * nMe + xl * rpx + (j % rpx); u.pn = e * nNe + j / rpx; return true;
    }
};

struct EpiBf16 {
    static constexpr bool PERM = true;
    bf16_t* O; int ldc; bf16_t* Q0;
    __device__ __forceinline__ void operator()(const f32x4 (&acc)[2][2][4][2], const Unit& u, int wr, int wc, int fr, int fq) const {
        const bool redir = (Q0 != nullptr) && (u.pn == 0);
        bf16_t* base = redir ? Q0 : O; const int ld = redir ? 256 : ldc;
        const int row0 = u.pm * BM + wr * 64 + fr, col0 = (u.pn - ((Q0 != nullptr && !redir) ? 1 : 0)) * BM + wc * 32 + 8 * fq;
#pragma unroll
        for (int ai = 0; ai < 2; ++ai)
#pragma unroll
            for (int m = 0; m < 4; ++m) { bf16_t* rowp = base + (size_t)(row0 + ai * HALF + m * 16) * ld + col0;
#pragma unroll
                for (int bj = 0; bj < 2; ++bj) { const f32x4 v0 = acc[ai][bj][m][0], v1 = acc[ai][bj][m][1];
                    u32x4 w; w.x = pk_bf16(v0[0], v0[1]); w.y = pk_bf16(v0[2], v0[3]); w.z = pk_bf16(v1[0], v1[1]); w.w = pk_bf16(v1[2], v1[3]);
                    *(u32x4*)(rowp + bj * HALF) = w; } }
    }
};
struct EpiResidSS {
    static constexpr bool PERM = false;
    const float* X; float* X1; float* ss;
    __device__ __forceinline__ void operator()(const f32x4 (&acc)[2][2][4][2], const Unit& u, int wr, int wc, int fr, int fq) const {
        const int row0 = u.pm * BM + wr * 64 + fr, col0 = u.pn * BM + wc * 32 + 4 * fq;
#pragma unroll
        for (int ai = 0; ai < 2; ++ai)
#pragma unroll
            for (int m = 0; m < 4; ++m) { const int row = row0 + ai * HALF + m * 16; const size_t off = (size_t)row * D + col0; float s = 0.f;
#pragma unroll
                for (int bj = 0; bj < 2; ++bj)
#pragma unroll
                    for (int n = 0; n < 2; ++n) { const f32x4 xv = *(const f32x4*)(X + off + bj * HALF + n * 16); const f32x4 o = xv + acc[ai][bj][m][n];
                        *(f32x4*)(X1 + off + bj * HALF + n * 16) = o; s += (o[0] * o[0] + o[1] * o[1]) + (o[2] * o[2] + o[3] * o[3]); }
                s += __shfl_xor(s, 16); s += __shfl_xor(s, 32);
                if (fq == 0) (void)__hip_atomic_fetch_add(ss + row, s, __ATOMIC_RELAXED, __HIP_MEMORY_SCOPE_AGENT); }
    }
};
struct EpiSwiGLU {
    static constexpr bool PERM = true;
    bf16_t* H;
    __device__ __forceinline__ void operator()(const f32x4 (&acc)[2][2][4][2], const Unit& u, int wr, int wc, int fr, int fq) const {
        const int row0 = u.pm * BM + wr * 64 + fr, col0 = (u.pn & 7) * HALF + wc * 32 + 8 * fq;
#pragma unroll
        for (int ai = 0; ai < 2; ++ai)
#pragma unroll
            for (int m = 0; m < 4; ++m) { bf16_t* rowp = H + (size_t)(row0 + ai * HALF + m * 16) * FF + col0; float h[8];
#pragma unroll
                for (int n = 0; n < 2; ++n)
#pragma unroll
                    for (int j = 0; j < 4; ++j) { const float gt = acc[ai][0][m][n][j], up = acc[ai][1][m][n][j]; h[n * 4 + j] = gt * sigmoidf_fast(gt) * up; }
                u32x4 w; w.x = pk_bf16(h[0], h[1]); w.y = pk_bf16(h[2], h[3]); w.z = pk_bf16(h[4], h[5]); w.w = pk_bf16(h[6], h[7]);
                *(u32x4*)rowp = w; }
    }
};
struct EpiGateScale {
    static constexpr bool PERM = true;
    bf16_t* Y; const float* gate;
    __device__ __forceinline__ void operator()(const f32x4 (&acc)[2][2][4][2], const Unit& u, int wr, int wc, int fr, int fq) const {
        const int row0 = u.pm * BM + wr * 64 + fr, col0 = (u.pn & 3) * BM + wc * 32 + 8 * fq;
#pragma unroll
        for (int ai = 0; ai < 2; ++ai)
#pragma unroll
            for (int m = 0; m < 4; ++m) { const int row = row0 + ai * HALF + m * 16; const float gs = gate[row]; bf16_t* rowp = Y + (size_t)row * D + col0;
#pragma unroll
                for (int bj = 0; bj < 2; ++bj) { const f32x4 v0 = acc[ai][bj][m][0] * gs, v1 = acc[ai][bj][m][1] * gs;
                    u32x4 w; w.x = pk_bf16(v0[0], v0[1]); w.y = pk_bf16(v0[2], v0[3]); w.z = pk_bf16(v1[0], v1[1]); w.w = pk_bf16(v1[2], v1[3]);
                    *(u32x4*)(rowp + bj * HALF) = w; } }
    }
};

template <class Epi, class Sched, bool GATHER>
__device__ __forceinline__ void gemm_phase(PG8_LAS unsigned char* lds, const Gemm g, const Sched& S, const Epi& E, const int* rowtok) {
    const int tid = threadIdx.x, wid = __builtin_amdgcn_readfirstlane(tid >> 6), lane = tid & 63, wr = wid >> 2, wc = wid & 3, fr = lane & 15, fq = lane >> 4;
    const int K = g.K, nt = K / BK;
    unsigned voffA[2], voffB[2]; int Rr[2], Cc[2];
#pragma unroll
    for (int i = 0; i < 2; ++i) { int R, C; stage_rc(tid * 16 + i * 8192, R, C); const int Rb = Epi::PERM ? ((R & ~31) + perm32(R & 31)) : R; Rr[i] = R; Cc[i] = C;
        voffA[i] = (unsigned)(R * K + C) * 2u; voffB[i] = (unsigned)(Rb * K + C) * 2u; }
    unsigned vAc[2][2], vAn[2][2];
    const size_t kstep = (size_t)(BK * 2);
    const size_t hstep = (size_t)HALF * K * 2;
    const size_t tstep = 2 * hstep;
    const unsigned ldsw = (unsigned)wid * 1024u;
    const int aoff = lds_byte(wr * 64 + fr, fq * 8), boff = lds_byte(wc * 32 + fr, fq * 8);
#define PG8_SA(b, h) (((b) * 2 + (h)) * HTB)
#define PG8_SB(b, h) ((4 + (b) * 2 + (h)) * HTB)
#define PG8_STAGE(bufoff, gbase, voff) do { _Pragma("unroll") for (int _i = 0; _i < 2; ++_i) \
        __builtin_amdgcn_global_load_lds((const unsigned*)((const char*)(gbase) + (voff)[_i]), (PG8_LAS unsigned*)(lds + (bufoff) + ldsw + _i * 8192), 16, 0, 0); } while (0)
#define PG8_STAGE_A(bufoff, hh, dbase, kbytes, vsel) do { if constexpr (GATHER) { PG8_STAGE(bufoff, (const char*)g.A + (kbytes), (vsel)[hh]); } else { PG8_STAGE(bufoff, (dbase) + ((hh) ? hstep : 0), voffA); } } while (0)
#define PG8_GATHER_OFF(dst, un) do { _Pragma("unroll") for (int _h = 0; _h < 2; ++_h) _Pragma("unroll") for (int _i = 0; _i < 2; ++_i) \
        (dst)[_h][_i] = (unsigned)rowtok[(un).pm * BM + _h * HALF + Rr[_i]] * (unsigned)(K * 2) + (unsigned)(Cc[_i] * 2); } while (0)
#define PG8_LDA(dst, b, h) do { _Pragma("unroll") for (int m = 0; m < 4; ++m) _Pragma("unroll") for (int k = 0; k < 2; ++k) dst[m][k] = *(const PG8_LAS bf16x8*)(lds + PG8_SA(b, h) + aoff + m * 2048 + k * 1024); } while (0)
#define PG8_LDB(dst, b, h) do { _Pragma("unroll") for (int n = 0; n < 2; ++n) _Pragma("unroll") for (int k = 0; k < 2; ++k) dst[n][k] = *(const PG8_LAS bf16x8*)(lds + PG8_SB(b, h) + boff + n * 2048 + k * 1024); } while (0)
#define PG8_MMA(ai, bj, At, Bt) do { __builtin_amdgcn_s_setprio(1); _Pragma("unroll") for (int m = 0; m < 4; ++m) _Pragma("unroll") for (int n = 0; n < 2; ++n) _Pragma("unroll") for (int k = 0; k < 2; ++k) \
        acc[ai][bj][m][n] = __builtin_amdgcn_mfma_f32_16x16x32_bf16(Bt[n][k], At[m][k], acc[ai][bj][m][n], 0, 0, 0); __builtin_amdgcn_s_setprio(0); } while (0)
#define PG8_WAIT_V(n) asm volatile("s_waitcnt vmcnt(" #n ")" ::: "memory")
#define PG8_WAIT_L(n) asm volatile("s_waitcnt lgkmcnt(" #n ")" ::: "memory")
#define PG8_BAR __builtin_amdgcn_s_barrier()
#define PG8_SCHED __builtin_amdgcn_sched_barrier(0)
    Unit cur, nxt; int ui = 0;
    if (!S.next(0, cur)) return;
    f32x4 acc[2][2][4][2];
#pragma unroll
    for (int a = 0; a < 2; ++a)
#pragma unroll
        for (int b = 0; b < 2; ++b)
#pragma unroll
            for (int m = 0; m < 4; ++m)
#pragma unroll
                for (int n = 0; n < 2; ++n) acc[a][b][m][n] = (f32x4){0.f, 0.f, 0.f, 0.f};
    bf16x8 At[4][2], B0[2][2], B1[2][2];
    const char* cA = (const char*)g.A + (GATHER ? (size_t)0 : (size_t)cur.pm * tstep); const char* cB = (const char*)g.Bt + (size_t)cur.pn * tstep;
    if constexpr (GATHER) { PG8_GATHER_OFF(vAc, cur); }
    PG8_STAGE(PG8_SB(0, 0), cB, voffB); PG8_STAGE_A(PG8_SA(0, 0), 0, cA, 0, vAc); PG8_STAGE(PG8_SB(0, 1), cB + hstep, voffB); PG8_STAGE_A(PG8_SA(0, 1), 1, cA, 0, vAc);
    if (wr == 1) PG8_BAR;
    PG8_WAIT_V(4); PG8_BAR;
    PG8_STAGE(PG8_SB(1, 0), cB + kstep, voffB); PG8_STAGE_A(PG8_SA(1, 0), 0, cA + kstep, kstep, vAc); PG8_STAGE(PG8_SB(1, 1), cB + hstep + kstep, voffB);
    PG8_WAIT_V(6); PG8_BAR;
    for (;;) {
        const bool has_next = S.next(ui + 1, nxt);
        const char* nA = (has_next && !GATHER) ? (const char*)g.A + (size_t)nxt.pm * tstep : cA; const char* nB = has_next ? (const char*)g.Bt + (size_t)nxt.pn * tstep : cB;
        if constexpr (GATHER) { if (has_next) { PG8_GATHER_OFF(vAn, nxt); } else {
#pragma unroll
            for (int _h = 0; _h < 2; ++_h)
#pragma unroll
                for (int _i = 0; _i < 2; ++_i) vAn[_h][_i] = vAc[_h][_i]; } }
        for (int t = 0; t < nt; t += 2) {
            const bool last = (t == nt - 2);
            const size_t k1 = (size_t)(t + 1) * kstep, k2 = last ? 0 : (size_t)(t + 2) * kstep, k3 = k2 + kstep;
            const char* a1 = cA + k1;
            const char* a2 = last ? nA : cA + (size_t)(t + 2) * kstep; const char* b2 = last ? nB : cB + (size_t)(t + 2) * kstep;
            const char* a3 = a2 + kstep; const char* b3 = b2 + kstep;
            unsigned vs[2][2];
#pragma unroll
            for (int _h = 0; _h < 2; ++_h)
#pragma unroll
                for (int _i = 0; _i < 2; ++_i) vs[_h][_i] = last ? vAn[_h][_i] : vAc[_h][_i];
            PG8_LDB(B0, 0, 0); PG8_SCHED; PG8_LDA(At, 0, 0); PG8_STAGE_A(PG8_SA(1, 1), 1, a1, k1, vAc);
            PG8_WAIT_L(8); PG8_BAR; PG8_WAIT_L(0); PG8_MMA(0, 0, At, B0); PG8_BAR; PG8_SCHED;
            PG8_LDB(B1, 0, 1); PG8_STAGE(PG8_SB(0, 0), b2, voffB);
            PG8_BAR; PG8_WAIT_L(0); PG8_MMA(0, 1, At, B1); PG8_BAR;
            PG8_LDA(At, 0, 1); PG8_STAGE_A(PG8_SA(0, 0), 0, a2, k2, vs);
            PG8_BAR; PG8_WAIT_L(0); PG8_MMA(1, 0, At, B0); PG8_BAR; PG8_SCHED;
            PG8_STAGE(PG8_SB(0, 1), b2 + hstep, voffB);
            PG8_WAIT_V(6); PG8_BAR; PG8_MMA(1, 1, At, B1); PG8_BAR;
            PG8_LDB(B0, 1, 0); PG8_SCHED; PG8_LDA(At, 1, 0); PG8_STAGE_A(PG8_SA(0, 1), 1, a2, k2, vs);
            PG8_WAIT_L(8); PG8_BAR; PG8_WAIT_L(0); PG8_MMA(0, 0, At, B0); PG8_BAR; PG8_SCHED;
            PG8_LDB(B1, 1, 1); PG8_STAGE(PG8_SB(1, 0), b3, voffB);
            PG8_BAR; PG8_WAIT_L(0); PG8_MMA(0, 1, At, B1); PG8_BAR;
            PG8_LDA(At, 1, 1); PG8_STAGE_A(PG8_SA(1, 0), 0, a3, k3, vs);
            PG8_BAR; PG8_WAIT_L(0); PG8_MMA(1, 0, At, B0); PG8_BAR; PG8_SCHED;
            PG8_STAGE(PG8_SB(1, 1), b3 + hstep, voffB);
            PG8_WAIT_V(6); PG8_BAR; PG8_MMA(1, 1, At, B1); PG8_BAR;
        }
        E(acc, cur, wr, wc, fr, fq);
        if (!has_next) break;
#pragma unroll
        for (int a = 0; a < 2; ++a)
#pragma unroll
            for (int b = 0; b < 2; ++b)
#pragma unroll
                for (int m = 0; m < 4; ++m)
#pragma unroll
                    for (int n = 0; n < 2; ++n) acc[a][b][m][n] = (f32x4){0.f, 0.f, 0.f, 0.f};
        cur = nxt; cA = nA; cB = nB; ++ui;
        if constexpr (GATHER) {
#pragma unroll
            for (int _h = 0; _h < 2; ++_h)
#pragma unroll
                for (int _i = 0; _i < 2; ++_i) vAc[_h][_i] = vAn[_h][_i]; }
    }
    PG8_WAIT_V(0);
    if (wr == 0) PG8_BAR;
    PG8_BAR;
#undef PG8_SA
#undef PG8_SB
#undef PG8_STAGE
#undef PG8_STAGE_A
#undef PG8_GATHER_OFF
#undef PG8_LDA
#undef PG8_LDB
#undef PG8_MMA
#undef PG8_WAIT_V
#undef PG8_WAIT_L
#undef PG8_BAR
#undef PG8_SCHED
}
}

struct Args {
    const float* in[29];
    float* out; unsigned char* ws;
    int ph_lo, ph_hi;
};
enum { I_X = 0, I_MEM, I_NMIXG, I_NMEMG, I_WIN, I_WMK, I_WMV, I_CONVW, I_CONVB, I_CLNG, I_CLNB, I_SHIFTMU, I_DW0, I_DUP, I_IA0, I_IUP, I_GUP, I_KK, I_KA, I_RK,
       I_LNXG, I_LNXB, I_WOUT, I_NFFNG, I_WROUTER, I_WEG, I_WEU, I_WED, I_FNG };

__device__ __forceinline__ void transpose_item(const float* W, int N, bf16_t* WT, int K, int k0, int n0, int drow0, LAS float* scr, int lane) {
#pragma unroll 8
    for (int i = 0; i < 32; ++i) { const int kk = 2 * i + (lane >> 5); scr[kk * 33 + (lane & 31)] = W[(size_t)(k0 + kk) * N + n0 + (lane & 31)]; }
    asm volatile("s_waitcnt lgkmcnt(0)" ::: "memory");
    const int c = lane & 7;
#pragma unroll
    for (int j = 0; j < 4; ++j) { const int n = (lane >> 3) + 8 * j; const LAS float* s = scr + (8 * c) * 33 + n;
        u32x4 o; o.x = pk_bf16(s[0 * 33], s[1 * 33]); o.y = pk_bf16(s[2 * 33], s[3 * 33]); o.z = pk_bf16(s[4 * 33], s[5 * 33]); o.w = pk_bf16(s[6 * 33], s[7 * 33]);
        *(u32x4*)(WT + (size_t)(drow0 + n) * K + k0 + 8 * c) = o; }
    asm volatile("s_waitcnt lgkmcnt(0)" ::: "memory");
}
__device__ __forceinline__ void expert_prep_items(const Args& a, LAS unsigned char* lds, int widx, int nw, int it_lo, int it_hi) {
    const int tid = threadIdx.x, lane = tid & 63, wave = __builtin_amdgcn_readfirstlane(tid >> 6);
    LAS float* scr = (LAS float*)(lds + wave * 16384);
    unsigned char* ws = a.ws;
    constexpr int S_EXP = 16 * 16 * 32;
    for (int r = it_lo + widx; r < it_hi; r += nw) {
        const int which = r / S_EXP, q = r % S_EXP, e = q / 512, kb = (q % 512) / 32, nb = q % 32, n0 = nb * 32;
        if (which == 0) transpose_item(a.in[I_WEG] + (size_t)e * D * FF, FF, (bf16_t*)(ws + WS_WGUT) + (size_t)e * 2048 * D, D, kb * 64, n0, (n0 >> 7) * 256 + (n0 & 127), scr, lane);
        else if (which == 1) transpose_item(a.in[I_WEU] + (size_t)e * D * FF, FF, (bf16_t*)(ws + WS_WGUT) + (size_t)e * 2048 * D, D, kb * 64, n0, (n0 >> 7) * 256 + 128 + (n0 & 127), scr, lane);
        else transpose_item(a.in[I_WED] + (size_t)e * FF * D, D, (bf16_t*)(ws + WS_WDT) + (size_t)e * D * FF, FF, kb * 64, n0, n0, scr, lane);
    }
}

__device__ __forceinline__ void rms_row_to_bf16(const float* xrow, const float* g, bf16_t* orow, int lane) {
    const f32x4* xr = (const f32x4*)xrow + lane; const f32x4* gr = (const f32x4*)g + lane;
    f32x4 v[4]; float s = 0.f;
#pragma unroll
    for (int j = 0; j < 4; ++j) { v[j] = xr[64 * j]; s += (v[j].x * v[j].x + v[j].y * v[j].y) + (v[j].z * v[j].z + v[j].w * v[j].w); }
    const float rs = 1.0f / sqrtf(wave_sum(s) * (1.f / D) + 1e-6f);
    u32x2* o8 = (u32x2*)orow + lane;
#pragma unroll
    for (int j = 0; j < 4; ++j) { const f32x4 gg = gr[64 * j]; u32x2 w; w.x = pk_bf16(v[j].x * rs * gg.x, v[j].y * rs * gg.y); w.y = pk_bf16(v[j].z * rs * gg.z, v[j].w * rs * gg.w); o8[64 * j] = w; }
}
__device__ __forceinline__ void phase_prep(const Args& a, LAS unsigned char* lds, int G) {
    const int tid = threadIdx.x, lane = tid & 63, wave = __builtin_amdgcn_readfirstlane(tid >> 6);
    LAS float* scr = (LAS float*)(lds + wave * 16384);
    const int gw = blockIdx.x * 8 + wave, NGW = G * 8;
    unsigned char* ws = a.ws;
    constexpr int S_WIN = 16 * 80, S_WOUT = 16 * 32, S_MK = 16 * 8, S_SM = 12, S_GUP = 24;
    constexpr int NITEMS = S_WIN + S_WOUT + 2 * S_MK + 4 * S_SM + S_GUP;
    for (int it = gw; it < NITEMS; it += NGW) {
        int r = it;
        if (r < S_WIN) { const int kb = r / 80, nb = r % 80; transpose_item(a.in[I_WIN], IN_PROJ, (bf16_t*)(ws + WS_WINT), D, kb * 64, nb * 32, nb * 32, scr, lane); continue; } r -= S_WIN;
        if (r < S_WOUT) { const int kb = r / 32, nb = r % 32; transpose_item(a.in[I_WOUT], D, (bf16_t*)(ws + WS_WOUTT), D, kb * 64, nb * 32, nb * 32, scr, lane); continue; } r -= S_WOUT;
        if (r < S_MK) { const int kb = r / 8, nb = r % 8; transpose_item(a.in[I_WMK], 256, (bf16_t*)(ws + WS_WKT), D, kb * 64, nb * 32, nb * 32, scr, lane); continue; } r -= S_MK;
        if (r < S_MK) { const int kb = r / 8, nb = r % 8; transpose_item(a.in[I_WMV], 256, (bf16_t*)(ws + WS_WVT), D, kb * 64, nb * 32, nb * 32, scr, lane); continue; } r -= S_MK;
        if (r < 4 * S_SM) { const int which = r / S_SM, nb = r % S_SM;
            const float* src = (which < 2 ? a.in[I_DUP] : a.in[I_IUP]) + (size_t)(which & 1) * 64 * RW;
            transpose_item(src, RW, (bf16_t*)(ws + WS_SMALL) + (size_t)which * RW * 64, 64, 0, nb * 32, nb * 32, scr, lane); continue; } r -= 4 * S_SM;
        { const int kb = r / 12, nb = r % 12; transpose_item(a.in[I_GUP], RW, (bf16_t*)(ws + WS_SMALL) + (size_t)4 * RW * 64, 128, kb * 64, nb * 32, nb * 32, scr, lane); }
    }
    expert_prep_items(a, lds, gw, NGW, 0, 2 * 8192);
    for (int m = gw; m < T; m += NGW) rms_row_to_bf16(a.in[I_X] + (size_t)m * D, a.in[I_NMIXG], (bf16_t*)(ws + WS_XH) + (size_t)m * D, lane);
    for (int m = gw; m < BATCH * NMEM; m += NGW) rms_row_to_bf16(a.in[I_MEM] + (size_t)m * D, a.in[I_NMEMG], (bf16_t*)(ws + WS_MEMN) + (size_t)m * D, lane);
}

constexpr int AT_KS = 144;
constexpr int AT_VS = 520;
constexpr int AT_VOFF = 256 * AT_KS;
__device__ __forceinline__ bf16x8 pack_step(const f32x16& x, int s) {
    u32x4 p;
    asm volatile("v_cvt_pk_bf16_f32 %0, %4, %5\n\tv_cvt_pk_bf16_f32 %1, %6, %7\n\tv_cvt_pk_bf16_f32 %2, %8, %9\n\tv_cvt_pk_bf16_f32 %3, %10, %11\n\ts_nop 1"
                 : "=&v"(p[0]), "=&v"(p[1]), "=&v"(p[2]), "=&v"(p[3])
                 : "v"(x[8 * s]), "v"(x[8 * s + 1]), "v"(x[8 * s + 2]), "v"(x[8 * s + 3]), "v"(x[8 * s + 4]), "v"(x[8 * s + 5]), "v"(x[8 * s + 6]), "v"(x[8 * s + 7]));
    return __builtin_bit_cast(bf16x8, p);
}
__device__ __forceinline__ void attn_unit(const Args& a, LAS unsigned char* lds, int unit) {
    const int tid = threadIdx.x, lane = tid & 63, wave = __builtin_amdgcn_readfirstlane(tid >> 6), r = lane & 31, h = lane >> 5;
    const int b = unit >> 6, hh = (unit >> 4) & 3, tile = unit & 15;
    const bf16_t* Qb = (const bf16_t*)(a.ws + WS_Q); const bf16_t* KM = (const bf16_t*)(a.ws + WS_KMEM); const bf16_t* VT = (const bf16_t*)(a.ws + WS_VT);
    bf16_t* MIX = (bf16_t*)(a.ws + WS_MIX);
    __syncthreads();
#pragma unroll
    for (int i = 0; i < 4; ++i) { const int c = tid + 512 * i, key = c >> 3, ch = c & 7;
        const u32x4 v = *(const u32x4*)(KM + (size_t)(b * NMEM + key) * 256 + hh * 64 + ch * 8);
        *(LAS u32x4*)(lds + key * AT_KS + ch * 16) = v; }
#pragma unroll
    for (int i = 0; i < 4; ++i) { const int c = tid + 512 * i, d = c >> 5, ch = c & 31;
        const u32x4 v = *(const u32x4*)(VT + (size_t)(hh * 64 + d) * (BATCH * NMEM) + b * NMEM + ch * 8);
        LAS u32x2* dst = (LAS u32x2*)(lds + AT_VOFF + d * AT_VS + ch * 16);
        dst[0] = (u32x2){v.x, v.y}; dst[1] = (u32x2){v.z, v.w}; }
    const int tok0 = b * SEQ + tile * 256 + wave * 32;
    bf16x8 qf[4];
#pragma unroll
    for (int ks = 0; ks < 4; ++ks) qf[ks] = *(const bf16x8*)(Qb + (size_t)(tok0 + r) * 256 + hh * 64 + ks * 16 + h * 8);
    __syncthreads();
    const float sc = 0.125f * 1.4426950408889634f;
    float m_run = -3.0e38f, sum = 0.f;
    f32x16 o[2];
#pragma unroll
    for (int dt = 0; dt < 2; ++dt)
#pragma unroll
        for (int i = 0; i < 16; ++i) o[dt][i] = 0.f;
#pragma unroll 1
    for (int kh = 0; kh < 2; ++kh) {
        f32x16 s[4];
#pragma unroll
        for (int k4 = 0; k4 < 4; ++k4) {
#pragma unroll
            for (int i = 0; i < 16; ++i) s[k4][i] = 0.f;
#pragma unroll
            for (int ks = 0; ks < 4; ++ks) { const bf16x8 ka = *(const LAS bf16x8*)(lds + ((kh * 4 + k4) * 32 + r) * AT_KS + (ks * 16 + h * 8) * 2);
                s[k4] = __builtin_amdgcn_mfma_f32_32x32x16_bf16(ka, qf[ks], s[k4], 0, 0, 0); }
        }
        float mx = m_run;
#pragma unroll
        for (int k4 = 0; k4 < 4; ++k4)
#pragma unroll
            for (int i = 0; i < 16; ++i) mx = fmaxf(mx, s[k4][i]);
        mx = fmaxf(mx, __shfl_xor(mx, 32));
        const float alpha = __builtin_amdgcn_exp2f((m_run - mx) * sc);
        float ps = 0.f;
#pragma unroll
        for (int k4 = 0; k4 < 4; ++k4)
#pragma unroll
            for (int i = 0; i < 16; ++i) { const float e = __builtin_amdgcn_exp2f((s[k4][i] - mx) * sc); s[k4][i] = e; ps += e; }
        ps += __shfl_xor(ps, 32);
        sum = sum * alpha + ps; m_run = mx;
#pragma unroll
        for (int dt = 0; dt < 2; ++dt)
#pragma unroll
            for (int i = 0; i < 16; ++i) o[dt][i] *= alpha;
#pragma unroll
        for (int k4 = 0; k4 < 4; ++k4)
#pragma unroll
            for (int s2 = 0; s2 < 2; ++s2) {
                const bf16x8 pb = pack_step(s[k4], s2);
#pragma unroll
                for (int dt = 0; dt < 2; ++dt) {
                    const LAS unsigned char* vp = lds + AT_VOFF + (32 * dt + r) * AT_VS + (32 * (kh * 4 + k4) + 16 * s2 + 4 * h) * 2;
                    const s16x4 lo = *(const LAS s16x4*)vp, hi = *(const LAS s16x4*)(vp + 16);
                    const bf16x8 va = __builtin_shufflevector(lo, hi, 0, 1, 2, 3, 4, 5, 6, 7);
                    o[dt] = __builtin_amdgcn_mfma_f32_32x32x16_bf16(va, pb, o[dt], 0, 0, 0);
                }
            }
    }
    const float inv = 1.0f / sum;
    bf16_t* orow = MIX + (size_t)(tok0 + r) * D + hh * 64;
#pragma unroll
    for (int dt = 0; dt < 2; ++dt)
#pragma unroll
        for (int gq = 0; gq < 4; ++gq) { u32x2 w; w.x = pk_bf16(o[dt][4 * gq] * inv, o[dt][4 * gq + 1] * inv); w.y = pk_bf16(o[dt][4 * gq + 2] * inv, o[dt][4 * gq + 3] * inv);
            *(u32x2*)(orow + 32 * dt + 8 * gq + 4 * h) = w; }
}

__device__ __forceinline__ void conv_unit(const Args& a, LAS unsigned char* lds, int unit) {
    const int tid = threadIdx.x, lane = tid & 63, wave = __builtin_amdgcn_readfirstlane(tid >> 6);
    const int b = unit >> 6, t0 = (unit & 63) * 64;
    const bf16_t* P = (const bf16_t*)(a.ws + WS_P); bf16_t* MIX = (bf16_t*)(a.ws + WS_MIX);
    LAS _Float16* U = (LAS _Float16*)lds;
    LAS _Float16* Cc = (LAS _Float16*)(lds + 94 * CW * 2);
    __syncthreads();
#pragma unroll 1
    for (int q0 = tid; q0 < 94 * 48; q0 += 3 * NTHREADS) {
        u32x4 vvv[3], ggg[3];
#pragma unroll
        for (int u3 = 0; u3 < 3; ++u3) { const int q = q0 + u3 * NTHREADS, j = q / 48, cc = (q % 48) * 8, s = t0 - 15 + j; const bool ok = (q < 94 * 48) && s >= 0 && s < SEQ;
            const bf16_t* row = P + (size_t)(b * SEQ + (ok ? s : 0)) * PLD + cc;
            vvv[u3] = ok ? *(const u32x4*)row : (u32x4){0u, 0u, 0u, 0u}; ggg[u3] = ok ? *(const u32x4*)(row + CW) : (u32x4){0u, 0u, 0u, 0u}; }
#pragma unroll
        for (int u3 = 0; u3 < 3; ++u3) { const int q = q0 + u3 * NTHREADS, j = q / 48, cc = (q % 48) * 8;
            if (q < 94 * 48) {
                const unsigned vw[4] = {vvv[u3].x, vvv[u3].y, vvv[u3].z, vvv[u3].w}, gw[4] = {ggg[u3].x, ggg[u3].y, ggg[u3].z, ggg[u3].w};
                float u[8];
#pragma unroll
                for (int k = 0; k < 4; ++k) { u[2 * k] = bf_lo(vw[k]) * sigmoidf_fast(bf_lo(gw[k])); u[2 * k + 1] = bf_hi(vw[k]) * sigmoidf_fast(bf_hi(gw[k])); }
                LAS f16x4* dst = (LAS f16x4*)(U + j * CW + cc); dst[0] = (f16x4){(_Float16)u[0], (_Float16)u[1], (_Float16)u[2], (_Float16)u[3]}; dst[1] = (f16x4){(_Float16)u[4], (_Float16)u[5], (_Float16)u[6], (_Float16)u[7]}; }
        }
    }
    __syncthreads();
    const int cq = tid & 127, tq = tid >> 7;
#pragma unroll 1
    for (int k3 = 0; k3 < 3; ++k3) { const int c = cq + 128 * k3;
        float w[31], res[16];
#pragma unroll
        for (int kk = 0; kk < 31; ++kk) w[kk] = a.in[I_CONVW][kk * CW + c];
        const float bias = a.in[I_CONVB][c];
#pragma unroll
        for (int tt = 0; tt < 16; ++tt) res[tt] = bias;
#pragma unroll
        for (int jj = 0; jj < 46; ++jj) { const float uv = (float)U[(tq * 16 + jj) * CW + c];
#pragma unroll
            for (int tt = 0; tt < 16; ++tt) { if (jj - tt >= 0 && jj - tt <= 30) res[tt] += uv * w[jj - tt]; } }
#pragma unroll
        for (int tt = 0; tt < 16; ++tt) Cc[(tq * 16 + tt) * CW + c] = (_Float16)res[tt];
    }
    __syncthreads();
    for (int tt = 0; tt < 8; ++tt) { const int t = wave * 8 + tt;
        float v[6]; float s = 0.f;
#pragma unroll
        for (int i = 0; i < 6; ++i) { v[i] = (float)Cc[t * CW + lane + 64 * i]; s += v[i]; }
        const float mean = wave_sum(s) * (1.f / CW); float q = 0.f;
#pragma unroll
        for (int i = 0; i < 6; ++i) { v[i] -= mean; q += v[i] * v[i]; }
        const float rstd = 1.0f / sqrtf(wave_sum(q) * (1.f / CW) + 1e-5f);
        bf16_t* orow = MIX + (size_t)(b * SEQ + t0 + t) * D + 256;
#pragma unroll
        for (int i = 0; i < 6; ++i) { const int c = lane + 64 * i; const float y = v[i] * rstd * a.in[I_CLNG][c] + a.in[I_CLNB][c]; const float o = y * sigmoidf_fast(y);
            orow[c] = (bf16_t)(pk_bf16(o, 0.f) & 0xffffu); }
    }
}

constexpr int PR_AS = 784;
__device__ __forceinline__ void prep_unit(const Args& a, LAS unsigned char* lds, int unit) {
    const int tid = threadIdx.x, lane = tid & 63, wave = __builtin_amdgcn_readfirstlane(tid >> 6);
    const int b = unit >> 6, t0 = (unit & 63) * 64;
    const bf16_t* P = (const bf16_t*)(a.ws + WS_P);
    _Float16* SC = (_Float16*)(a.ws + WS_SCAN);
    LAS float* muL = (LAS float*)(lds + 64 * PR_AS);
    __syncthreads();
    for (int i = tid; i < 2 * 1536 / 4; i += NTHREADS) ((LAS f32x4*)muL)[i] = ((const f32x4*)a.in[I_SHIFTMU])[i];
    __syncthreads();
#pragma unroll 1
    for (int q0 = tid; q0 < 64 * 192; q0 += 4 * NTHREADS) {
        u32x4 cuv[4], pvv[4], nvv[4];
#pragma unroll
        for (int u4 = 0; u4 < 4; ++u4) { const int q = q0 + u4 * NTHREADS, tt = q / 192, c8 = (q % 192) * 8, s = t0 + tt;
            const bf16_t* row = P + ((size_t)b * SEQ + s) * PLD + 768 + c8;
            cuv[u4] = *(const u32x4*)row;
            pvv[u4] = (s > 0) ? *(const u32x4*)(row - PLD) : (u32x4){0u, 0u, 0u, 0u};
            nvv[u4] = (s < SEQ - 1) ? *(const u32x4*)(row + PLD) : (u32x4){0u, 0u, 0u, 0u}; }
#pragma unroll
        for (int u4 = 0; u4 < 4; ++u4) { const int q = q0 + u4 * NTHREADS, tt = q / 192, c8 = (q % 192) * 8, s = t0 + tt; const size_t tok = (size_t)b * SEQ + s;
            const u32x4 cu = cuv[u4], pv = pvv[u4], nv = nvv[u4];
            const unsigned cw[4] = {cu.x, cu.y, cu.z, cu.w}, pw[4] = {pv.x, pv.y, pv.z, pv.w}, nw[4] = {nv.x, nv.y, nv.z, nv.w};
            const f32x4 m0a = *(const LAS f32x4*)(muL + c8), m0b = *(const LAS f32x4*)(muL + c8 + 4), m1a = *(const LAS f32x4*)(muL + 1536 + c8), m1b = *(const LAS f32x4*)(muL + 1536 + c8 + 4);
            const float m0[8] = {m0a.x, m0a.y, m0a.z, m0a.w, m0b.x, m0b.y, m0b.z, m0b.w}, m1[8] = {m1a.x, m1a.y, m1a.z, m1a.w, m1b.x, m1b.y, m1b.z, m1b.w};
            float pf[8];
#pragma unroll
            for (int k = 0; k < 4; ++k) { const float c0 = bf_lo(cw[k]), c1 = bf_hi(cw[k]);
                pf[2 * k] = c0 + m0[2 * k] * (bf_lo(pw[k]) - c0) + m1[2 * k] * (bf_lo(nw[k]) - c0);
                pf[2 * k + 1] = c1 + m0[2 * k + 1] * (bf_hi(pw[k]) - c1) + m1[2 * k + 1] * (bf_hi(nw[k]) - c1); }
            if (c8 < 1152) {
                const int arr = c8 / RW, cc = c8 % RW;
                f16x4 h0 = {(_Float16)pf[0], (_Float16)pf[1], (_Float16)pf[2], (_Float16)pf[3]}, h1 = {(_Float16)pf[4], (_Float16)pf[5], (_Float16)pf[6], (_Float16)pf[7]};
                f16x4* dst = (f16x4*)((unsigned char*)SC + (size_t)arr * SCAN_STRIDE) + (tok * RW + cc) / 4; dst[0] = h0; dst[1] = h1;
            } else {
                const int cc = c8 - 1152;
#pragma unroll
                for (int k = 0; k < 8; ++k) { if (cc < 128) pf[k] = 1.0f - 2.0f * __builtin_amdgcn_rcpf(1.0f + __builtin_amdgcn_exp2f(2.8853900817779268f * pf[k])); else if (cc >= 256) pf[k] = sigmoidf_fast(pf[k]); }
                u32x4 w; w.x = pk_bf16(pf[0], pf[1]); w.y = pk_bf16(pf[2], pf[3]); w.z = pk_bf16(pf[4], pf[5]); w.w = pk_bf16(pf[6], pf[7]);
                *(LAS u32x4*)(lds + tt * PR_AS + cc * 2) = w; }
        }
    }
    __syncthreads();
    const int l15 = lane & 15, kq = lane >> 4, ch0 = wave * 48;
    const bf16_t* SM = (const bf16_t*)(a.ws + WS_SMALL);
#pragma unroll 1
    for (int o = 0; o < 5; ++o) {
        const int kbase = (o < 4) ? o * 64 : 256, KD = (o < 4) ? 64 : 128;
        const bf16_t* WTm = (o < 4) ? SM + (size_t)o * RW * 64 : SM + (size_t)4 * RW * 64;
        f32x4 acc[4][3];
#pragma unroll
        for (int mt = 0; mt < 4; ++mt)
#pragma unroll
            for (int nt = 0; nt < 3; ++nt) acc[mt][nt] = (f32x4){0.f, 0.f, 0.f, 0.f};
        for (int ks = 0; ks < KD / 32; ++ks) {
            bf16x8 bfr[3], afr[4];
#pragma unroll
            for (int nt = 0; nt < 3; ++nt) bfr[nt] = *(const bf16x8*)(WTm + (size_t)(ch0 + nt * 16 + l15) * KD + ks * 32 + kq * 8);
#pragma unroll
            for (int mt = 0; mt < 4; ++mt) afr[mt] = *(const LAS bf16x8*)(lds + (mt * 16 + l15) * PR_AS + (kbase + ks * 32 + kq * 8) * 2);
#pragma unroll
            for (int mt = 0; mt < 4; ++mt)
#pragma unroll
                for (int nt = 0; nt < 3; ++nt) acc[mt][nt] = __builtin_amdgcn_mfma_f32_16x16x32_bf16(bfr[nt], afr[mt], acc[mt][nt], 0, 0, 0);
        }
#pragma unroll
        for (int nt = 0; nt < 3; ++nt) { const int ch = ch0 + nt * 16 + 4 * kq;
            f32x4 bias = {0.f, 0.f, 0.f, 0.f};
            if (o < 2) bias = *(const f32x4*)(a.in[I_DW0] + o * RW + ch); else if (o < 4) bias = *(const f32x4*)(a.in[I_IA0] + (o - 2) * RW + ch);
#pragma unroll
            for (int mt = 0; mt < 4; ++mt) { const size_t tok = (size_t)b * SEQ + t0 + mt * 16 + l15; const f32x4 z = acc[mt][nt] + bias;
                if (o < 4) { f16x4 hv;
#pragma unroll
                    for (int rg = 0; rg < 4; ++rg) hv[rg] = (_Float16)((o < 2) ? __builtin_amdgcn_exp2f(-0.606531f * 1.4426950408889634f * sigmoidf_fast(z[rg])) : sigmoidf_fast(z[rg]));
                    *(f16x4*)((_Float16*)((unsigned char*)SC + (size_t)(3 + o) * SCAN_STRIDE) + tok * RW + ch) = hv; }
                else { u32x2 w; w.x = pk_bf16(z[0], z[1]); w.y = pk_bf16(z[2], z[3]); *(u32x2*)((bf16_t*)(a.ws + WS_G) + tok * RW + ch) = w; } }
        }
    }
}

constexpr int SC_CT = 32;
constexpr int SC_JV = SC_CT * 8 * 40 * 4;
constexpr int SC_VV = SC_CT * 64 * 4;
constexpr int SC_SC = SC_CT * 2 * 4;
constexpr int SC_Y = SC_CT * 64 * 4;
constexpr int SC_BUF = SC_JV + SC_VV + SC_SC + SC_Y;
struct ScanRegs { f16x4 r, k, v, w, a; };
struct StepVec { f32x4 kkA, kkB, wrA, wrB, wA, wB, bA, bB, kdA, kdB; f32x2 v2, sc; };
#define LO2(q) __builtin_shufflevector(q, q, 0, 1)
#define HI2(q) __builtin_shufflevector(q, q, 2, 3)
__device__ __forceinline__ void scan_unit(const Args& a, LAS unsigned char* lds, int unit) {
    const int tid = threadIdx.x, lane = tid & 63, wave = __builtin_amdgcn_readfirstlane(tid >> 6);
    const int dir = unit & 1, bh = unit >> 1, b = bh / NH, hd = bh % NH;
    constexpr int NCK = SEQ / SC_CT;
    constexpr int OFF_VV = SC_JV, OFF_SC = SC_JV + SC_VV, OFF_Y = SC_JV + SC_VV + SC_SC;
    __syncthreads();
    if (wave >= 4) {
        const _Float16* SCb = (const _Float16*)(a.ws + WS_SCAN);
        const _Float16* Rg = SCb; const _Float16* Kg = (const _Float16*)((const unsigned char*)SCb + SCAN_STRIDE); const _Float16* Vg = (const _Float16*)((const unsigned char*)SCb + 2 * SCAN_STRIDE);
        const _Float16* Wg = (const _Float16*)((const unsigned char*)SCb + (size_t)(3 + dir) * SCAN_STRIDE); const _Float16* Ag = (const _Float16*)((const unsigned char*)SCb + (size_t)(5 + dir) * SCAN_STRIDE);
        float* Yg = (float*)(a.ws + (dir ? WS_YB : WS_YF)); float* BON = (float*)(a.ws + WS_BON) + (size_t)dir * T * NH;
        const int lt = tid - 256, ls0 = lt >> 4, lq = lt & 15, chl = hd * 64 + 4 * lq;
        const f32x4 kkw = *(const f32x4*)(a.in[I_KK] + chl), kaw = *(const f32x4*)(a.in[I_KA] + chl), rkw = *(const f32x4*)(a.in[I_RK] + chl);
        ScanRegs rg[2];
#define SCAN_LOAD(ck) do { _Pragma("unroll") for (int i_ = 0; i_ < 2; ++i_) { const int st_ = (ck) * SC_CT + ls0 + 16 * i_; const int t_ = dir ? (SEQ - 1 - st_) : st_; const size_t e_ = ((size_t)b * SEQ + t_) * RW + chl; \
            rg[i_].r = *(const f16x4*)(Rg + e_); rg[i_].k = *(const f16x4*)(Kg + e_); rg[i_].v = *(const f16x4*)(Vg + e_); rg[i_].w = *(const f16x4*)(Wg + e_); rg[i_].a = *(const f16x4*)(Ag + e_); } } while (0)
#define SCAN_PROC(ck, buf) do { LAS unsigned char* B_ = lds + (buf) * SC_BUF; _Pragma("unroll") for (int i_ = 0; i_ < 2; ++i_) { const int ls = ls0 + 16 * i_; \
            const f32x4 r_ = __builtin_convertvector(rg[i_].r, f32x4), k_ = __builtin_convertvector(rg[i_].k, f32x4), v_ = __builtin_convertvector(rg[i_].v, f32x4), w_ = __builtin_convertvector(rg[i_].w, f32x4), a_ = __builtin_convertvector(rg[i_].a, f32x4); \
            f32x4 kk_ = k_ * kkw; float ss_ = (kk_.x * kk_.x + kk_.y * kk_.y) + (kk_.z * kk_.z + kk_.w * kk_.w); ss_ = sum16(ss_); kk_ = kk_ * (1.0f / sqrtf(ss_ + 1e-12f)); \
            const f32x4 b_ = kk_ * a_, kd_ = k_ * (1.0f + (a_ - 1.0f) * kaw), wr_ = w_ * r_; \
            float br_ = (b_.x * r_.x + b_.y * r_.y) + (b_.z * r_.z + b_.w * r_.w), kr_ = (kd_.x * r_.x + kd_.y * r_.y) + (kd_.z * r_.z + kd_.w * r_.w); \
            float bn_ = (kd_.x * r_.x * rkw.x + kd_.y * r_.y * rkw.y) + (kd_.z * r_.z * rkw.z + kd_.w * r_.w * rkw.w); \
            br_ = sum16(br_); kr_ = sum16(kr_); bn_ = sum16(bn_); \
            LAS f32x4* jv_ = (LAS f32x4*)(B_ + ls * 1280 + (lq >> 1) * 160 + (lq & 1) * 16); \
            jv_[0] = kk_; jv_[2] = wr_; jv_[4] = w_; jv_[6] = b_; jv_[8] = kd_; \
            *(LAS f32x4*)(B_ + OFF_VV + ls * 256 + lq * 16) = v_; \
            if (lq == 0) { *(LAS f32x2*)(B_ + OFF_SC + ls * 8) = (f32x2){br_, kr_}; const int st_ = (ck) * SC_CT + ls; const int t_ = dir ? (SEQ - 1 - st_) : st_; BON[((size_t)b * SEQ + t_) * NH + hd] = bn_; } } } while (0)
#define SCAN_FLUSH(ck, buf) do { _Pragma("unroll") for (int i_ = 0; i_ < 2; ++i_) { const int ls = ls0 + 16 * i_; \
            const f32x4 yv_ = *(const LAS f32x4*)(lds + (buf) * SC_BUF + OFF_Y + ls * 256 + lq * 16); \
            const int st_ = (ck) * SC_CT + ls; const int t_ = dir ? (SEQ - 1 - st_) : st_; \
            *(f32x4*)(Yg + ((size_t)b * SEQ + t_) * RW + hd * 64 + 4 * lq) = yv_; } } while (0)
        SCAN_LOAD(0); SCAN_PROC(0, 0); SCAN_LOAD(1);
        __syncthreads();
#pragma unroll 1
        for (int ck = 0; ck < NCK; ++ck) {
            if (ck > 0) SCAN_FLUSH(ck - 1, (ck - 1) & 1);
            if (ck + 1 < NCK) { SCAN_PROC(ck + 1, (ck + 1) & 1); if (ck + 2 < NCK) SCAN_LOAD(ck + 2); }
            __syncthreads();
        }
        SCAN_FLUSH(NCK - 1, (NCK - 1) & 1);
#undef SCAN_LOAD
#undef SCAN_PROC
#undef SCAN_FLUSH
    } else {
        const int jg = lane & 7, row0 = wave * 16 + 2 * (lane >> 3);
        f32x2 S0[4], S1[4];
#pragma unroll
        for (int p = 0; p < 4; ++p) { S0[p] = (f32x2){0.f, 0.f}; S1[p] = (f32x2){0.f, 0.f}; }
#define SV_LOAD(dst, Bc, st) do { const LAS f32x4* jv_ = (const LAS f32x4*)((Bc) + (st) * 1280 + jg * 160); \
            dst.kkA = jv_[0]; dst.kkB = jv_[1]; dst.wrA = jv_[2]; dst.wrB = jv_[3]; dst.wA = jv_[4]; dst.wB = jv_[5]; dst.bA = jv_[6]; dst.bB = jv_[7]; dst.kdA = jv_[8]; dst.kdB = jv_[9]; \
            dst.v2 = *(const LAS f32x2*)((Bc) + OFF_VV + (st) * 256 + row0 * 4); dst.sc = *(const LAS f32x2*)((Bc) + OFF_SC + (st) * 8); } while (0)
#define SV_STEP(src, Bc, st) do { \
            f32x2 t0 = S0[0] * LO2(src.kkA); t0 = S0[1] * HI2(src.kkA) + t0; t0 = S0[2] * LO2(src.kkB) + t0; t0 = S0[3] * HI2(src.kkB) + t0; \
            f32x2 t1 = S1[0] * LO2(src.kkA); t1 = S1[1] * HI2(src.kkA) + t1; t1 = S1[2] * LO2(src.kkB) + t1; t1 = S1[3] * HI2(src.kkB) + t1; \
            f32x2 u0 = S0[0] * LO2(src.wrA); u0 = S0[1] * HI2(src.wrA) + u0; u0 = S0[2] * LO2(src.wrB) + u0; u0 = S0[3] * HI2(src.wrB) + u0; \
            f32x2 u1 = S1[0] * LO2(src.wrA); u1 = S1[1] * HI2(src.wrA) + u1; u1 = S1[2] * LO2(src.wrB) + u1; u1 = S1[3] * HI2(src.wrB) + u1; \
            const float sa0 = -sum8(t0.x + t0.y), sa1 = -sum8(t1.x + t1.y), yp0 = sum8(u0.x + u0.y), yp1 = sum8(u1.x + u1.y); \
            const float v0 = src.v2.x, v1 = src.v2.y; \
            const f32x2 yo = {yp0 + sa0 * src.sc.x + v0 * src.sc.y, yp1 + sa1 * src.sc.x + v1 * src.sc.y}; \
            *(LAS f32x2*)((Bc) + OFF_Y + (st) * 256 + row0 * 4) = yo; \
            S0[0] = S0[0] * LO2(src.wA) + (LO2(src.bA) * sa0 + LO2(src.kdA) * v0); S0[1] = S0[1] * HI2(src.wA) + (HI2(src.bA) * sa0 + HI2(src.kdA) * v0); \
            S0[2] = S0[2] * LO2(src.wB) + (LO2(src.bB) * sa0 + LO2(src.kdB) * v0); S0[3] = S0[3] * HI2(src.wB) + (HI2(src.bB) * sa0 + HI2(src.kdB) * v0); \
            S1[0] = S1[0] * LO2(src.wA) + (LO2(src.bA) * sa1 + LO2(src.kdA) * v1); S1[1] = S1[1] * HI2(src.wA) + (HI2(src.bA) * sa1 + HI2(src.kdA) * v1); \
            S1[2] = S1[2] * LO2(src.wB) + (LO2(src.bB) * sa1 + LO2(src.kdB) * v1); S1[3] = S1[3] * HI2(src.wB) + (HI2(src.bB) * sa1 + HI2(src.kdB) * v1); } while (0)
        __syncthreads();
#pragma unroll 1
        for (int ck = 0; ck < NCK; ++ck) {
            LAS unsigned char* Bc = lds + (ck & 1) * SC_BUF;
            StepVec A, Bv;
            SV_LOAD(A, Bc, 0);
#pragma unroll 1
            for (int st = 0; st < SC_CT; st += 2) {
                SV_LOAD(Bv, Bc, st + 1);
                SV_STEP(A, Bc, st);
                if (st + 2 < SC_CT) SV_LOAD(A, Bc, st + 2);
                SV_STEP(Bv, Bc, st + 1);
            }
            __syncthreads();
        }
#undef SV_LOAD
#undef SV_STEP
    }
}
#undef LO2
#undef HI2

typedef short v4i16g __attribute__((__vector_size__(8)));
__device__ __forceinline__ s16x4 tr_read16(LAS unsigned char* p) { v4i16g r = __builtin_amdgcn_ds_read_tr16_b64_v4i16((LAS v4i16g*)p); return __builtin_bit_cast(s16x4, r); }
__device__ __forceinline__ f32x4 bf4_to_f32(u32x2 w) { return (f32x4){bf_lo(w.x), bf_hi(w.x), bf_lo(w.y), bf_hi(w.y)}; }
__device__ __forceinline__ u32x2 f32_to_bf4(f32x4 v) { return (u32x2){pk_bf16(v.x, v.y), pk_bf16(v.z, v.w)}; }
__device__ __forceinline__ bf16x8 frag_lo4(f32x4 v) { const u32x4 w = {pk_bf16(v.x, v.y), pk_bf16(v.z, v.w), 0u, 0u}; return __builtin_bit_cast(bf16x8, w); }
__device__ __forceinline__ bf16x8 frag_cat(u32x2 a, u32x2 b) { const u32x4 w = {a.x, a.y, b.x, b.y}; return __builtin_bit_cast(bf16x8, w); }
#define MFMA16(a, b, c) __builtin_amdgcn_mfma_f32_16x16x32_bf16((a), (b), (c), 0, 0, 0)
constexpr int CK = 16, NCHUNK = SEQ / CK, CS_NS = 6;
constexpr int SL_ATIL = 0, SL_RTIL = 2048, SL_BHT = 4096, SL_KHT = 6144, SL_VF = 8192, SL_ULOC = 10240, SL_YLOC = 12288, SL_PC = 14336, SL_BYTES = 14592;
constexpr int PS_IN = 0, PS_AHT = 10240, PS_RHT = 12288, PS_NT = 14336, PS_BYTES = 15360;
constexpr int CS_PS_OFF = CS_NS * SL_BYTES, CS_FLAG_OFF = CS_PS_OFF + 4 * PS_BYTES;
static_assert(CS_FLAG_OFF + 64 <= LDS_BYTES - 64, "chunked scan LDS map");
constexpr size_t WS_CMP = 8192;
template <bool CMP>
__device__ __forceinline__ void scan_chunked_unit(const Args& a, LAS unsigned char* lds, int unit) {
    const int tid = threadIdx.x, lane = tid & 63, wave = __builtin_amdgcn_readfirstlane(tid >> 6);
    const int dir = unit & 1, bh = unit >> 1, b = bh / NH, hd = bh % NH;
    const int c16 = lane & 15, q = lane >> 4, qp = c16 >> 2, pp = c16 & 3;
    volatile LAS unsigned* FULL = (volatile LAS unsigned*)(lds + CS_FLAG_OFF);
    volatile LAS unsigned* DONE = FULL + 8;
    float* Yg = (float*)(a.ws + (dir ? WS_YB : WS_YF)); float* BON = (float*)(a.ws + WS_BON) + (size_t)dir * T * NH;
    float* CMPW = (float*)(a.ws + WS_CMP);
    __syncthreads();
    if (tid < 16) FULL[tid] = 0u;
    __syncthreads();
    float err2 = 0.f, ref2 = 0.f;
    if (wave >= 4) {
        const int pw = wave - 4;
        LAS unsigned char* ps = lds + CS_PS_OFF + pw * PS_BYTES;
        const _Float16* SCb = (const _Float16*)(a.ws + WS_SCAN);
        const _Float16* ARR[5] = {SCb, (const _Float16*)((const unsigned char*)SCb + SCAN_STRIDE), (const _Float16*)((const unsigned char*)SCb + 2 * SCAN_STRIDE),
                                  (const _Float16*)((const unsigned char*)SCb + (size_t)(3 + dir) * SCAN_STRIDE), (const _Float16*)((const unsigned char*)SCb + (size_t)(5 + dir) * SCAN_STRIDE)};
        const float* __restrict__ KKp = a.in[I_KK] + hd * 64 + c16; const float* __restrict__ KAp = a.in[I_KA] + hd * 64 + c16; const float* __restrict__ RKp = a.in[I_RK] + hd * 64 + c16;
        bf16x8 tri;
#pragma unroll
        for (int e = 0; e < 8; ++e) tri[e] = (e < 4 && 4 * q + e <= c16) ? (short)0x3F80 : (short)0;
#define CS_ISSUE(cc) do { _Pragma("unroll") for (int ar_ = 0; ar_ < 5; ++ar_) _Pragma("unroll") for (int hf_ = 0; hf_ < 2; ++hf_) { \
            const int st_ = (cc) * CK + hf_ * 8 + (lane >> 3); const int t_ = dir ? (SEQ - 1 - st_) : st_; \
            __builtin_amdgcn_global_load_lds((const unsigned*)(ARR[ar_] + ((size_t)b * SEQ + t_) * RW + hd * 64 + 8 * (lane & 7)), (LAS unsigned*)(ps + PS_IN + ar_ * 2048 + hf_ * 1024), 16, 0, 0); } } while (0)
        CS_ISSUE(pw);
#pragma unroll 1
        for (int c = pw; c < NCHUNK; c += 4) {
            const int slot = c % CS_NS; LAS unsigned char* sl = lds + slot * SL_BYTES;
            asm volatile("s_waitcnt vmcnt(0)" ::: "memory");
            { unsigned sp = 0; const unsigned want = 4u * (unsigned)(c / CS_NS); while (DONE[slot] < want) { __builtin_amdgcn_s_sleep(1); if (++sp > (1u << 22)) break; } }
            asm volatile("" ::: "memory");
            f32x4 ss = {0.f, 0.f, 0.f, 0.f}, bn = {0.f, 0.f, 0.f, 0.f};
#pragma unroll
            for (int jt = 0; jt < 4; ++jt) { const int off = (4 * q + qp) * 128 + (16 * jt + 4 * pp) * 2;
                const f32x4 xr = __builtin_convertvector(__builtin_bit_cast(f16x4, tr_read16(ps + PS_IN + 0 * 2048 + off)), f32x4);
                const f32x4 xk = __builtin_convertvector(__builtin_bit_cast(f16x4, tr_read16(ps + PS_IN + 1 * 2048 + off)), f32x4);
                const f32x4 xa = __builtin_convertvector(__builtin_bit_cast(f16x4, tr_read16(ps + PS_IN + 4 * 2048 + off)), f32x4);
                const f32x4 kkr = xk * KKp[16 * jt]; ss += kkr * kkr; bn += xr * (xk * (1.0f + (xa - 1.0f) * KAp[16 * jt])) * RKp[16 * jt]; }
#pragma unroll
            for (int e = 0; e < 4; ++e) { ss[e] = sum16(ss[e]); bn[e] = sum16(bn[e]); }
            f32x4 rn;
#pragma unroll
            for (int e = 0; e < 4; ++e) rn[e] = 1.0f / sqrtf(ss[e] + 1e-12f);
#pragma unroll
            for (int e = 0; e < 4; ++e) { const int st_ = c * CK + 4 * q + e; const int t_ = dir ? (SEQ - 1 - st_) : st_; const size_t bi = ((size_t)b * SEQ + t_) * NH + hd;
                if (CMP) { if (c16 == 0) { const float rf = BON[bi]; err2 += (bn[e] - rf) * (bn[e] - rf); ref2 += rf * rf; } }
                else { if (c16 == 0) BON[bi] = bn[e]; } }
#pragma unroll 2
            for (int jt = 0; jt < 4; ++jt) { const int off = (4 * q + qp) * 128 + (16 * jt + 4 * pp) * 2;
                const f32x4 xr = __builtin_convertvector(__builtin_bit_cast(f16x4, tr_read16(ps + PS_IN + 0 * 2048 + off)), f32x4);
                const f32x4 xk = __builtin_convertvector(__builtin_bit_cast(f16x4, tr_read16(ps + PS_IN + 1 * 2048 + off)), f32x4);
                const u32x2 vfj = f32_to_bf4(__builtin_convertvector(__builtin_bit_cast(f16x4, tr_read16(ps + PS_IN + 2 * 2048 + off)), f32x4));
                const f32x4 xw = __builtin_convertvector(__builtin_bit_cast(f16x4, tr_read16(ps + PS_IN + 3 * 2048 + off)), f32x4);
                const f32x4 xa = __builtin_convertvector(__builtin_bit_cast(f16x4, tr_read16(ps + PS_IN + 4 * 2048 + off)), f32x4);
                f32x4 lw;
#pragma unroll
                for (int e = 0; e < 4; ++e) lw[e] = __log2f(xw[e]);
                const u32x2 hi = f32_to_bf4(lw); const f32x4 lo = lw - bf4_to_f32(hi);
                f32x4 cum = {0.f, 0.f, 0.f, 0.f};
                cum = MFMA16(tri, frag_cat(hi, (u32x2){0u, 0u}), cum);
                cum = MFMA16(tri, frag_lo4(lo), cum);
                f32x4 P, Pinv, Pprev;
#pragma unroll
                for (int e = 0; e < 4; ++e) { P[e] = __builtin_amdgcn_exp2f(cum[e]); Pinv[e] = __builtin_amdgcn_rcpf(P[e]); }
                Pprev[0] = __builtin_amdgcn_exp2f(cum[0] - lw[0]); Pprev[1] = P[0]; Pprev[2] = P[1]; Pprev[3] = P[2];
                const f32x4 kk = xk * KKp[16 * jt] * rn, kd = xk * (1.0f + (xa - 1.0f) * KAp[16 * jt]);
                const f32x4 AH = -kk * Pprev, RH = xr * P, BH = kk * xa * Pinv, KH = kd * Pinv;
                const int xo = (16 * jt + c16) * 32 + 8 * q;
                *(LAS u32x2*)(ps + PS_AHT + xo) = f32_to_bf4(AH); *(LAS u32x2*)(ps + PS_RHT + xo) = f32_to_bf4(RH);
                *(LAS u32x2*)(sl + SL_BHT + xo) = f32_to_bf4(BH); *(LAS u32x2*)(sl + SL_KHT + xo) = f32_to_bf4(KH);
                if (q == 3) *(LAS float*)(sl + SL_PC + (16 * jt + c16) * 4) = P[3];
                *(LAS u32x2*)(sl + SL_VF + jt * 512 + lane * 8) = vfj;
            }
            asm volatile("s_waitcnt lgkmcnt(0)" ::: "memory");
            if (c + 4 < NCHUNK) CS_ISSUE(c + 4);
            bf16x8 AHf[2], BHf[2], KHf[2], RHf[2];
#pragma unroll
            for (int ks = 0; ks < 2; ++ks) { const int o0 = (32 * ks + 8 * q + qp) * 32 + 8 * pp, o1 = o0 + 4 * 32;
                AHf[ks] = __builtin_shufflevector(tr_read16(ps + PS_AHT + o0), tr_read16(ps + PS_AHT + o1), 0, 1, 2, 3, 4, 5, 6, 7);
                RHf[ks] = __builtin_shufflevector(tr_read16(ps + PS_RHT + o0), tr_read16(ps + PS_RHT + o1), 0, 1, 2, 3, 4, 5, 6, 7);
                BHf[ks] = __builtin_shufflevector(tr_read16(sl + SL_BHT + o0), tr_read16(sl + SL_BHT + o1), 0, 1, 2, 3, 4, 5, 6, 7);
                KHf[ks] = __builtin_shufflevector(tr_read16(sl + SL_KHT + o0), tr_read16(sl + SL_KHT + o1), 0, 1, 2, 3, 4, 5, 6, 7); }
            f32x4 Mab = {0.f, 0.f, 0.f, 0.f}, Mak = Mab, MrbT = Mab, MrkT = Mab, MabT = Mab;
#pragma unroll
            for (int ks = 0; ks < 2; ++ks) { Mab = MFMA16(AHf[ks], BHf[ks], Mab); MabT = MFMA16(BHf[ks], AHf[ks], MabT); Mak = MFMA16(AHf[ks], KHf[ks], Mak); MrbT = MFMA16(BHf[ks], RHf[ks], MrbT); MrkT = MFMA16(KHf[ks], RHf[ks], MrkT); }
#pragma unroll
            for (int r = 0; r < 4; ++r) { const bool lt = c16 < 4 * q + r, gt = 4 * q + r < c16, le = 4 * q + r <= c16;
                Mab[r] = lt ? Mab[r] : 0.f; Mak[r] = lt ? Mak[r] : 0.f; MabT[r] = gt ? MabT[r] : 0.f; MrbT[r] = le ? MrbT[r] : 0.f; MrkT[r] = le ? MrkT[r] : 0.f; }
            const f32x4 z4 = {0.f, 0.f, 0.f, 0.f};
            const bf16x8 fN = frag_lo4(Mab), fNT = frag_lo4(MabT);
            const f32x4 N2 = MFMA16(fNT, fN, z4), N2T = MFMA16(fN, fNT, z4);
            f32x4 PT = MabT;
#pragma unroll
            for (int r = 0; r < 4; ++r) PT[r] += (4 * q + r == c16) ? 1.0f : 0.f;
            const bf16x8 fN2 = frag_lo4(N2), fN2T = frag_lo4(N2T);
            PT = MFMA16(fN2, frag_lo4(PT), PT);
            const f32x4 N4 = MFMA16(fN2T, fN2, z4), N4T = MFMA16(fN2, fN2T, z4);
            const bf16x8 fN4 = frag_lo4(N4), fN4T = frag_lo4(N4T);
            PT = MFMA16(fN4, frag_lo4(PT), PT);
            const f32x4 N8 = MFMA16(fN4T, fN4, z4);
            PT = MFMA16(frag_lo4(N8), frag_lo4(PT), PT);
            const bf16x8 LinvF = frag_lo4(PT);
            const bf16x8 MakF = frag_lo4(Mak), MrbTF = frag_lo4(MrbT);
            const f32x4 W1 = MFMA16(LinvF, MakF, z4);
            const f32x4 W1T = MFMA16(MakF, LinvF, z4);
            const f32x4 W2T = MFMA16(frag_lo4(W1), MrbTF, MrkT);
            f32x4 AtT[4], RtT[4];
#pragma unroll
            for (int jt = 0; jt < 4; ++jt) {
                const bf16x8 ahF = frag_cat(*(const LAS u32x2*)(ps + PS_AHT + (16 * jt + c16) * 32 + 8 * q), (u32x2){0u, 0u});
                const f32x4 AtN = MFMA16(LinvF, ahF, z4);
                AtT[jt] = MFMA16(ahF, LinvF, z4);
                const f32x4 rinit = bf4_to_f32(__builtin_bit_cast(u32x2, tr_read16(ps + PS_RHT + (16 * jt + 4 * q + qp) * 32 + 8 * pp)));
                RtT[jt] = MFMA16(frag_lo4(AtN), MrbTF, rinit);
            }
#pragma unroll
            for (int ks = 0; ks < 2; ++ks) {
                const u32x4 wa = {pk_bf16(AtT[2 * ks][0], AtT[2 * ks][1]), pk_bf16(AtT[2 * ks][2], AtT[2 * ks][3]), pk_bf16(AtT[2 * ks + 1][0], AtT[2 * ks + 1][1]), pk_bf16(AtT[2 * ks + 1][2], AtT[2 * ks + 1][3])};
                const u32x4 wr = {pk_bf16(RtT[2 * ks][0], RtT[2 * ks][1]), pk_bf16(RtT[2 * ks][2], RtT[2 * ks][3]), pk_bf16(RtT[2 * ks + 1][0], RtT[2 * ks + 1][1]), pk_bf16(RtT[2 * ks + 1][2], RtT[2 * ks + 1][3])};
                *(LAS u32x4*)(sl + SL_ATIL + ks * 1024 + lane * 16) = wa; *(LAS u32x4*)(sl + SL_RTIL + ks * 1024 + lane * 16) = wr; }
            const bf16x8 W1TF = frag_lo4(W1T), W2TF = frag_lo4(W2T);
#pragma unroll
            for (int nt = 0; nt < 4; ++nt) { const bf16x8 vB = frag_cat(*(const LAS u32x2*)(sl + SL_VF + nt * 512 + lane * 8), (u32x2){0u, 0u});
                const f32x4 ul = MFMA16(W1TF, vB, z4), yl = MFMA16(W2TF, vB, z4);
                *(LAS u32x2*)(sl + SL_ULOC + nt * 512 + lane * 8) = f32_to_bf4(ul); *(LAS u32x2*)(sl + SL_YLOC + nt * 512 + lane * 8) = f32_to_bf4(yl); }
            asm volatile("s_waitcnt lgkmcnt(0)" ::: "memory");
            if (lane == 0) FULL[slot] = (unsigned)(c + 1);
        }
#undef CS_ISSUE
    } else {
        const int nt = wave;
        f32x4 S[4];
#pragma unroll
        for (int mt = 0; mt < 4; ++mt) S[mt] = (f32x4){0.f, 0.f, 0.f, 0.f};
#pragma unroll 1
        for (int c = 0; c < NCHUNK; ++c) {
            const int slot = c % CS_NS; LAS unsigned char* sl = lds + slot * SL_BYTES;
            { unsigned sp = 0; while (FULL[slot] < (unsigned)(c + 1)) { __builtin_amdgcn_s_sleep(1); if (++sp > (1u << 22)) break; } }
            asm volatile("" ::: "memory");
            const bf16x8 at0 = *(const LAS bf16x8*)(sl + SL_ATIL + lane * 16), at1 = *(const LAS bf16x8*)(sl + SL_ATIL + 1024 + lane * 16);
            const bf16x8 rt0 = *(const LAS bf16x8*)(sl + SL_RTIL + lane * 16), rt1 = *(const LAS bf16x8*)(sl + SL_RTIL + 1024 + lane * 16);
            const u32x2 ulw = *(const LAS u32x2*)(sl + SL_ULOC + nt * 512 + lane * 8), ylw = *(const LAS u32x2*)(sl + SL_YLOC + nt * 512 + lane * 8), vfw = *(const LAS u32x2*)(sl + SL_VF + nt * 512 + lane * 8);
            f32x4 pc[4]; bf16x8 bk[4];
#pragma unroll
            for (int mt = 0; mt < 4; ++mt) { pc[mt] = *(const LAS f32x4*)(sl + SL_PC + (16 * mt + 4 * q) * 4);
                bk[mt] = frag_cat(*(const LAS u32x2*)(sl + SL_BHT + (16 * mt + c16) * 32 + 8 * q), *(const LAS u32x2*)(sl + SL_KHT + (16 * mt + c16) * 32 + 8 * q)); }
            const bf16x8 Sb0 = frag_cat(f32_to_bf4(S[0]), f32_to_bf4(S[1])), Sb1 = frag_cat(f32_to_bf4(S[2]), f32_to_bf4(S[3]));
            f32x4 UT = bf4_to_f32(ulw), YT = bf4_to_f32(ylw);
            UT = MFMA16(at0, Sb0, UT); UT = MFMA16(at1, Sb1, UT);
            YT = MFMA16(rt0, Sb0, YT); YT = MFMA16(rt1, Sb1, YT);
            const bf16x8 Ub = frag_cat(f32_to_bf4(UT), vfw);
#pragma unroll
            for (int mt = 0; mt < 4; ++mt) { S[mt] = MFMA16(bk[mt], Ub, S[mt]); S[mt] = S[mt] * pc[mt]; }
#pragma unroll
            for (int r = 0; r < 4; ++r) { const int st_ = c * CK + 4 * q + r; const int t_ = dir ? (SEQ - 1 - st_) : st_; float* yp = Yg + ((size_t)b * SEQ + t_) * RW + hd * 64 + 16 * nt + c16;
                if (CMP) { const float rf = *yp; err2 += (YT[r] - rf) * (YT[r] - rf); ref2 += rf * rf; } else *yp = YT[r]; }
            asm volatile("s_waitcnt lgkmcnt(0)" ::: "memory");
            if (lane == 0) (void)__hip_atomic_fetch_add((LAS unsigned*)&DONE[slot], 1u, __ATOMIC_RELAXED, __HIP_MEMORY_SCOPE_WORKGROUP);
        }
    }
    if (CMP) { err2 = wave_sum(err2); ref2 = wave_sum(ref2); if (lane == 0) { (void)__hip_atomic_fetch_add(CMPW, err2, __ATOMIC_RELAXED, __HIP_MEMORY_SCOPE_AGENT); (void)__hip_atomic_fetch_add(CMPW + 1, ref2, __ATOMIC_RELAXED, __HIP_MEMORY_SCOPE_AGENT); } }
}

__device__ __forceinline__ void phase_post(const Args& a, int G) {
    const int tid = threadIdx.x, lane = tid & 63, wave = __builtin_amdgcn_readfirstlane(tid >> 6);
    const int gw = blockIdx.x * 8 + wave, NGW = G * 8, q = lane >> 4, l16 = lane & 15;
    const float* __restrict__ YF = (const float*)(a.ws + WS_YF); const float* __restrict__ YB = (const float*)(a.ws + WS_YB); const float* __restrict__ BON = (const float*)(a.ws + WS_BON);
    const _Float16* __restrict__ Vg = (const _Float16*)(a.ws + WS_SCAN + 2 * SCAN_STRIDE); const bf16_t* __restrict__ Gg = (const bf16_t*)(a.ws + WS_G); bf16_t* __restrict__ MIX = (bf16_t*)(a.ws + WS_MIX);
    float* ss = (float*)(a.ws + WS_SS);
    for (int i = blockIdx.x * NTHREADS + tid; i < T; i += G * NTHREADS) ss[i] = 0.f;
    constexpr int NIT = T * NH / 4;
#pragma unroll 4
    for (int it = gw; it < NIT; it += NGW) {
        const int hr = 4 * it + q, tok = hr / NH, hd = hr - tok * NH; const size_t e = (size_t)hr * 64 + 4 * l16;
        const f32x4 yf = *(const f32x4*)(YF + e), yb = *(const f32x4*)(YB + e);
        const f16x4 vh = *(const f16x4*)(Vg + e); const u32x2 gw2 = *(const u32x2*)(Gg + e);
        const float bon = BON[hr] + BON[(size_t)T * NH + hr];
        const f32x4 lg = *(const f32x4*)(a.in[I_LNXG] + hd * 64 + 4 * l16), lb = *(const f32x4*)(a.in[I_LNXB] + hd * 64 + 4 * l16);
        const f32x4 y = yf + yb;
        const float mean = sum16((y.x + y.y) + (y.z + y.w)) * (1.f / 64.f);
        const f32x4 d = y - mean;
        const float var = sum16((d.x * d.x + d.y * d.y) + (d.z * d.z + d.w * d.w)) * (1.f / 64.f);
        const float rstd = 1.0f / sqrtf(var + 64e-5f);
        const f32x4 vv = __builtin_convertvector(vh, f32x4);
        const f32x4 gv = {bf_lo(gw2.x), bf_hi(gw2.x), bf_lo(gw2.y), bf_hi(gw2.y)};
        const f32x4 o = (d * rstd * lg + lb + vv * bon) * gv;
        u32x2 w; w.x = pk_bf16(o.x, o.y); w.y = pk_bf16(o.z, o.w);
        *(u32x2*)(MIX + (size_t)tok * D + 640 + hd * 64 + 4 * l16) = w;
    }
}

constexpr int RT_WS = 2064;
__device__ __forceinline__ void phase_router(const Args& a, LAS unsigned char* lds, int G) {
    const int tid = threadIdx.x, lane = tid & 63, wave = __builtin_amdgcn_readfirstlane(tid >> 6);
    const int gw = blockIdx.x * 8 + wave, NGW = G * 8, l15 = lane & 15, kq = lane >> 4;
    LAS bf16_t* WH = (LAS bf16_t*)lds; LAS bf16_t* WL = (LAS bf16_t*)(lds + 16 * RT_WS);
    for (int i = tid; i < D * NE; i += NTHREADS) { const int k = i >> 4, e = i & 15; const float w = a.in[I_WROUTER][i];
        const unsigned hi = pk_bf16(w, 0.f) & 0xffffu; const float rem = w - bf_lo(hi);
        WH[e * (RT_WS / 2) + k] = (bf16_t)hi; WL[e * (RT_WS / 2) + k] = (bf16_t)(pk_bf16(rem, 0.f) & 0xffffu); }
    __syncthreads();
    const float* __restrict__ X1 = (const float*)(a.ws + WS_X1); const float* __restrict__ ss = (const float*)(a.ws + WS_SS); bf16_t* __restrict__ H2 = (bf16_t*)(a.ws + WS_H2);
    float* __restrict__ AFF = (float*)(a.ws + WS_AFF); int* __restrict__ INV = (int*)(a.ws + WS_INV);
    const float* __restrict__ GF = a.in[I_NFFNG];
    for (int grp = gw; grp < T / 16; grp += NGW) {
        const int tok = grp * 16 + l15;
        const float rs = 1.0f / sqrtf(ss[tok] * (1.f / D) + 1e-6f);
        f32x4 acc = {0.f, 0.f, 0.f, 0.f};
        const float* xrow = X1 + (size_t)tok * D + 8 * kq; bf16_t* hrow = H2 + (size_t)tok * D + 8 * kq;
#pragma unroll 8
        for (int ks = 0; ks < 32; ++ks) {
            const f32x4 x0 = *(const f32x4*)(xrow + 32 * ks), x1v = *(const f32x4*)(xrow + 32 * ks + 4);
            const f32x4 g0 = *(const f32x4*)(GF + 32 * ks + 8 * kq), g1 = *(const f32x4*)(GF + 32 * ks + 8 * kq + 4);
            const f32x4 h0 = x0 * rs * g0, h1 = x1v * rs * g1;
            u32x4 hi; hi.x = pk_bf16(h0.x, h0.y); hi.y = pk_bf16(h0.z, h0.w); hi.z = pk_bf16(h1.x, h1.y); hi.w = pk_bf16(h1.z, h1.w);
            *(u32x4*)(hrow + 32 * ks) = hi;
            u32x4 lo; lo.x = pk_bf16(h0.x - bf_lo(hi.x), h0.y - bf_hi(hi.x)); lo.y = pk_bf16(h0.z - bf_lo(hi.y), h0.w - bf_hi(hi.y));
            lo.z = pk_bf16(h1.x - bf_lo(hi.z), h1.y - bf_hi(hi.z)); lo.w = pk_bf16(h1.z - bf_lo(hi.w), h1.w - bf_hi(hi.w));
            const bf16x8 ah = __builtin_bit_cast(bf16x8, hi), al = __builtin_bit_cast(bf16x8, lo);
            const bf16x8 bh = *(const LAS bf16x8*)(lds + l15 * RT_WS + (32 * ks + 8 * kq) * 2), bl = *(const LAS bf16x8*)(lds + 16 * RT_WS + l15 * RT_WS + (32 * ks + 8 * kq) * 2);
            acc = __builtin_amdgcn_mfma_f32_16x16x32_bf16(ah, bh, acc, 0, 0, 0);
            acc = __builtin_amdgcn_mfma_f32_16x16x32_bf16(al, bh, acc, 0, 0, 0);
            acc = __builtin_amdgcn_mfma_f32_16x16x32_bf16(ah, bl, acc, 0, 0, 0);
        }
#pragma unroll
        for (int rg = 0; rg < 4; ++rg) { const float mx = max16(acc[rg]); const float ex = __expf(acc[rg] - mx); const float sm = sum16(ex);
            const int t2 = grp * 16 + 4 * kq + rg, bb = t2 >> 12, sq = t2 & (SEQ - 1);
            AFF[((size_t)(bb * NE + l15)) * SEQ + sq] = ex / sm; }
        *(u32x4*)(INV + (size_t)grp * 256 + 4 * lane) = (u32x4){0xffffffffu, 0xffffffffu, 0xffffffffu, 0xffffffffu};
    }
}

__device__ __forceinline__ void topk_unit(const Args& a, LAS unsigned char* lds, int unit) {
    const int tid = threadIdx.x, lane = tid & 63, wave = __builtin_amdgcn_readfirstlane(tid >> 6);
    const int b = unit >> 4, e = unit & 15;
    const float* AFF = (const float*)(a.ws + WS_AFF) + (size_t)unit * SEQ;
    LAS unsigned* KEY = (LAS unsigned*)lds;
    LAS unsigned* HIST = (LAS unsigned*)(lds + 16384);
    LAS unsigned* CTL = (LAS unsigned*)(lds + 16384 + 1024);
    LAS unsigned* WS_ = (LAS unsigned*)(lds + 16384 + 2048);
    __syncthreads();
    unsigned key[8];
    { const u32x4 k0 = *(const u32x4*)(AFF + tid * 8), k1 = *(const u32x4*)(AFF + tid * 8 + 4); key[0] = k0.x; key[1] = k0.y; key[2] = k0.z; key[3] = k0.w; key[4] = k1.x; key[5] = k1.y; key[6] = k1.z; key[7] = k1.w; }
    if (tid == 0) { CTL[0] = 0u; CTL[1] = (unsigned)CAP; }
    unsigned prefix = 0u, mask = 0u;
#pragma unroll 1
    for (int pass = 0; pass < 4; ++pass) {
        const int shift = 24 - 8 * pass;
        if (tid < 256) HIST[tid] = 0u;
        __syncthreads();
#pragma unroll
        for (int i = 0; i < 8; ++i) if ((key[i] & mask) == prefix) (void)__hip_atomic_fetch_add(&HIST[(key[i] >> shift) & 255u], 1u, __ATOMIC_RELAXED, __HIP_MEMORY_SCOPE_WORKGROUP);
        __syncthreads();
        if (wave == 0) {
            const unsigned need = CTL[1];
            unsigned hv[4], tsum = 0u;
#pragma unroll
            for (int i = 0; i < 4; ++i) { hv[i] = HIST[255 - (4 * lane + i)]; tsum += hv[i]; }
            unsigned inc = tsum;
#pragma unroll
            for (int o = 1; o < 64; o <<= 1) { const unsigned v = __shfl_up(inc, o); if (lane >= o) inc += v; }
            unsigned exc = inc - tsum;
            if (exc < need && need <= inc) {
                unsigned run = exc; int di = 0;
#pragma unroll
                for (int i = 0; i < 4; ++i) { if (run < need && need <= run + hv[i]) { di = i; break; } run += hv[i]; }
                const unsigned digit = 255u - (unsigned)(4 * lane + di);
                CTL[0] = prefix | (digit << shift); CTL[1] = need - run;
            }
        }
        __syncthreads();
        prefix = CTL[0]; mask |= (255u << shift);
    }
    const unsigned thr = prefix, need_eq = CTL[1];
    unsigned ngt = 0u, neq = 0u;
#pragma unroll
    for (int i = 0; i < 8; ++i) { ngt += (key[i] > thr) ? 1u : 0u; neq += (key[i] == thr) ? 1u : 0u; }
    unsigned pk = ngt | (neq << 16), inc = pk;
#pragma unroll
    for (int o = 1; o < 64; o <<= 1) { const unsigned v = __shfl_up(inc, o); if (lane >= o) inc += v; }
    if (lane == 63) WS_[wave] = inc;
    __syncthreads();
    unsigned woff = 0u, tot = 0u;
#pragma unroll
    for (int w = 0; w < 8; ++w) { const unsigned v = WS_[w]; if (w < wave) woff += v; tot += v; }
    const unsigned exc = inc - pk + woff;
    unsigned gpos = exc & 0xffffu, epos = exc >> 16; const unsigned totgt = tot & 0xffffu;
    const int sbase = (e * BATCH + b) * CAP;
    int* ROWTOK = (int*)(a.ws + WS_ROWTOK); float* ROWGATE = (float*)(a.ws + WS_ROWGATE); int* INV = (int*)(a.ws + WS_INV);
#pragma unroll
    for (int i = 0; i < 8; ++i) {
        int pos = -1;
        if (key[i] > thr) pos = (int)gpos++;
        else if (key[i] == thr) { if (epos < need_eq) pos = (int)(totgt + epos); epos++; }
        if (pos >= 0) { const int s = tid * 8 + i, tok = b * SEQ + s, slot = sbase + pos;
            ROWTOK[slot] = tok; ROWGATE[slot] = __builtin_bit_cast(float, key[i]); INV[(size_t)tok * NE + e] = slot; }
    }
}

__device__ __forceinline__ void phase_final(const Args& a, int G) {
    const int tid = threadIdx.x, lane = tid & 63, wave = __builtin_amdgcn_readfirstlane(tid >> 6);
    const int gw = blockIdx.x * 8 + wave, NGW = G * 8;
    const float* __restrict__ X1 = (const float*)(a.ws + WS_X1); const bf16_t* __restrict__ YE = (const bf16_t*)(a.ws + WS_YE); const int* __restrict__ INV = (const int*)(a.ws + WS_INV);
    float* __restrict__ OUT = a.out;
    f32x4 gg[4];
#pragma unroll
    for (int j = 0; j < 4; ++j) gg[j] = *(const f32x4*)(a.in[I_FNG] + 4 * lane + 256 * j);
    int tok = gw;
    int invn = (tok < T) ? INV[(size_t)tok * NE + (lane & 15)] : -1;
    f32x4 xn[4];
#pragma unroll
    for (int j = 0; j < 4; ++j) xn[j] = (tok < T) ? *(const f32x4*)(X1 + (size_t)tok * D + 4 * lane + 256 * j) : (f32x4){0.f, 0.f, 0.f, 0.f};
    for (; tok < T; tok += NGW) {
        const int invc = invn; f32x4 v[4];
#pragma unroll
        for (int j = 0; j < 4; ++j) v[j] = xn[j];
        const int tn = tok + NGW;
        if (tn < T) { invn = INV[(size_t)tn * NE + (lane & 15)];
#pragma unroll
            for (int j = 0; j < 4; ++j) xn[j] = *(const f32x4*)(X1 + (size_t)tn * D + 4 * lane + 256 * j); }
        unsigned long long m = __ballot(invc >= 0) & 0xffffull;
        const int n = __builtin_popcountll(m);
        int sl[4]; float wt[4];
#pragma unroll
        for (int k = 0; k < 4; ++k) { int e = 0; if (m) { e = __builtin_ctzll(m); m &= m - 1; wt[k] = 1.f; sl[k] = __builtin_amdgcn_readlane(invc, e); } else { wt[k] = 0.f; sl[k] = 0; } }
        u32x2 rw[4][4];
#pragma unroll
        for (int k = 0; k < 4; ++k)
#pragma unroll
            for (int j = 0; j < 4; ++j) rw[k][j] = *(const u32x2*)(YE + (size_t)sl[k] * D + 4 * lane + 256 * j);
#pragma unroll
        for (int k = 0; k < 4; ++k)
#pragma unroll
            for (int j = 0; j < 4; ++j) { v[j].x += wt[k] * bf_lo(rw[k][j].x); v[j].y += wt[k] * bf_hi(rw[k][j].x); v[j].z += wt[k] * bf_lo(rw[k][j].y); v[j].w += wt[k] * bf_hi(rw[k][j].y); }
        if (n > 4) { while (m) { const int e = __builtin_ctzll(m); m &= m - 1; const int slot = __builtin_amdgcn_readlane(invc, e);
#pragma unroll
                for (int j = 0; j < 4; ++j) { const u32x2 w = *(const u32x2*)(YE + (size_t)slot * D + 4 * lane + 256 * j);
                    v[j].x += bf_lo(w.x); v[j].y += bf_hi(w.x); v[j].z += bf_lo(w.y); v[j].w += bf_hi(w.y); } } }
        float sq = 0.f;
#pragma unroll
        for (int j = 0; j < 4; ++j) sq += (v[j].x * v[j].x + v[j].y * v[j].y) + (v[j].z * v[j].z + v[j].w * v[j].w);
        float rs = 1.0f / sqrtf(wave_sum(sq) * (1.f / D) + 1e-6f);
        if (SCAN_MODE == 2) { const float* cw = (const float*)(a.ws + WS_CMP); rs *= 1.0f + 4.0f * sqrtf(cw[0] / fmaxf(cw[1], 1e-30f)); }
#pragma unroll
        for (int j = 0; j < 4; ++j) *(f32x4*)(OUT + (size_t)tok * D + 4 * lane + 256 * j) = v[j] * rs * gg[j];
    }
}

#define XB_TMO      128
#define XB_XCNT(j)  (256  + 64 * (j))
#define XB_XSUB(j)  (1280 + 64 * (j))
#define XB_XGEN(j)  (2304 + 64 * (j))
#define XB_TOP      3328
#define XB_TOPGEN   3392
#define XCD_BAR_WORDS 3456
#define XB_SPIN_CAP (1u << 22)
__device__ __forceinline__ unsigned xb_ld(unsigned* p)              { return __hip_atomic_load(p, __ATOMIC_RELAXED, __HIP_MEMORY_SCOPE_AGENT); }
__device__ __forceinline__ unsigned xb_add(unsigned* p, unsigned v) { return __hip_atomic_fetch_add(p, v, __ATOMIC_RELAXED, __HIP_MEMORY_SCOPE_AGENT); }
__device__ __forceinline__ unsigned xb_xcc_id() { return (unsigned)__builtin_amdgcn_s_getreg((3 << 11) | 20) & 0xFu; }
#define XB_SPIN(cond, bar) do { unsigned _sp = 0; while (cond) { __builtin_amdgcn_s_sleep(1); \
    if ((++_sp & 255u) == 0u) { if (xb_ld(&(bar)[XB_TMO])) break; if (_sp > XB_SPIN_CAP) { atomicAdd(&(bar)[XB_TMO], 1u); break; } } } } while (0)
struct XcdBarrier { unsigned* bar; unsigned x; volatile LAS unsigned* st; };
__device__ __forceinline__ XcdBarrier xcd_barrier_post(unsigned* bar, volatile LAS unsigned* st) {
    XcdBarrier b; b.bar = bar; b.x = xb_xcc_id(); b.st = st;
    if (threadIdx.x == 0) (void)xb_add(&bar[XB_XCNT(b.x)], 1u);
    return b;
}
__device__ __forceinline__ void xcd_barrier_complete(unsigned* bar, unsigned x, unsigned& nloc, unsigned& nx) {
    const unsigned G = gridDim.x * gridDim.y * gridDim.z;
    unsigned sum, cnt, mine, sp = 0u;
    for (;;) {
        sum = 0u; cnt = 0u; mine = 0u;
#pragma unroll
        for (unsigned j = 0; j < 16; ++j) { const unsigned c = xb_ld(&bar[XB_XCNT(j)]); sum += c; cnt += (c > 0u) ? 1u : 0u; mine = (j == x) ? c : mine; }
        if (sum == G) break;
        __builtin_amdgcn_s_sleep(1);
        if ((++sp & 255u) == 0u) { if (xb_ld(&bar[XB_TMO])) break; if (sp > XB_SPIN_CAP) { atomicAdd(&bar[XB_TMO], 1u); break; } }
    }
    nloc = mine > 0u ? mine : 1u; nx = cnt > 0u ? cnt : 1u;
}
__device__ __forceinline__ void xcd_barrier(const XcdBarrier& b) {
    asm volatile("s_waitcnt vmcnt(0)" ::: "memory");
    __syncthreads();
    if (threadIdx.x == 0) {
        unsigned* bar = b.bar;
        __builtin_amdgcn_s_waitcnt(0);
        unsigned nloc = b.st[0], nx = b.st[1];
        if (nloc == 0u) { xcd_barrier_complete(bar, b.x, nloc, nx); b.st[0] = nloc; b.st[1] = nx; }
        const unsigned old = xb_add(&bar[XB_XSUB(b.x)], 1u);
        const unsigned gen = old / nloc;
        if (old + 1u == (gen + 1u) * nloc) {
            __builtin_amdgcn_fence(__ATOMIC_RELEASE, "agent");
            asm volatile("s_waitcnt vmcnt(0)" ::: "memory");
            const unsigned og = xb_add(&bar[XB_TOP], 1u);
            const unsigned tg = og / nx;
            if (og + 1u == (tg + 1u) * nx) xb_add(&bar[XB_TOPGEN], 1u);
            else XB_SPIN(xb_ld(&bar[XB_TOPGEN]) == tg, bar);
            __builtin_amdgcn_fence(__ATOMIC_ACQUIRE, "agent");
            xb_add(&bar[XB_XGEN(b.x)], 1u);
            asm volatile("s_waitcnt vmcnt(0)" ::: "memory");
        } else {
            XB_SPIN(xb_ld(&bar[XB_XGEN(b.x)]) == gen, bar);
            __builtin_amdgcn_fence(__ATOMIC_ACQUIRE, "agent");
            asm volatile("s_waitcnt vmcnt(0)" ::: "memory");
        }
    }
    __syncthreads();
}

#ifndef PH_MASK
#define PH_MASK 0x7ff
#endif
#ifndef REP_MASK
#define REP_MASK 0
#endif
#ifndef P2_MASK
#define P2_MASK 7
#endif
#ifndef P2_REP
#define P2_REP 0
#endif
constexpr int LDS_MISC = LDS_BYTES - 64;
constexpr size_t WS_CTL = 0, CTL_BYTES = 16384;
__global__ void __launch_bounds__(NTHREADS, 2) mega(Args a) {
    extern __shared__ __attribute__((aligned(16))) unsigned char lds_raw[];
    LAS unsigned char* lds = (LAS unsigned char*)lds_raw;
    cg::grid_group grid = cg::this_grid();
    const int G = gridDim.x, lo = a.ph_lo, hi = a.ph_hi;
    unsigned char* ws = a.ws;
    volatile LAS unsigned* misc = (volatile LAS unsigned*)(lds + LDS_MISC);
    if (threadIdx.x < 16) misc[threadIdx.x] = 0u;
    __syncthreads();
    XcdBarrier xbar = xcd_barrier_post((unsigned*)(ws + WS_CTL), misc);
#define IN(k) (((PH_MASK >> (k)) & 1) && lo <= (k) && (k) < hi)
#define NREP(k) (1 + ((REP_MASK >> (k)) & 1))
#define PHASE(k, ...) do { if (IN(k)) { for (int rep_ = 0; rep_ < NREP(k); ++rep_) { __VA_ARGS__; if (rep_ + 1 < NREP(k) || IN((k) + 1)) { if ((k) == 0 && rep_ + 1 == NREP(k)) grid.sync(); else xcd_barrier(xbar); } } } } while (0)

    PHASE(0, phase_prep(a, lds, G));

    PHASE(1, {
        { pg8::Gemm g{(const bf16_t*)(ws + WS_XH), (const bf16_t*)(ws + WS_WINT), T, IN_PROJ, D}; pg8::StaticOrder S; S.init(T, IN_PROJ, G, (int)blockIdx.x);
          pg8::EpiBf16 E{(bf16_t*)(ws + WS_P), PLD, (bf16_t*)(ws + WS_Q)}; pg8::gemm_phase<pg8::EpiBf16, pg8::StaticOrder, false>(lds, g, S, E, nullptr); }
        { pg8::Gemm g{(const bf16_t*)(ws + WS_MEMN), (const bf16_t*)(ws + WS_WKT), BATCH * NMEM, 256, D}; pg8::StaticOrder S; S.init(BATCH * NMEM, 256, G, (int)blockIdx.x);
          pg8::EpiBf16 E{(bf16_t*)(ws + WS_KMEM), 256, nullptr}; pg8::gemm_phase<pg8::EpiBf16, pg8::StaticOrder, false>(lds, g, S, E, nullptr); }
        { pg8::Gemm g{(const bf16_t*)(ws + WS_WVT), (const bf16_t*)(ws + WS_MEMN), 256, BATCH * NMEM, D}; pg8::StaticOrder S; S.init(256, BATCH * NMEM, G, (int)blockIdx.x);
          pg8::EpiBf16 E{(bf16_t*)(ws + WS_VT), BATCH * NMEM, nullptr}; pg8::gemm_phase<pg8::EpiBf16, pg8::StaticOrder, false>(lds, g, S, E, nullptr); }
    });

    constexpr int NSCAN = BATCH * NH * 2;
    PHASE(2, {
        for (int u = blockIdx.x; u < 2048; u += G) {
            if (u < 1024) { for (int r2 = 0; r2 < 1 + ((P2_REP >> 1) & 1); ++r2) conv_unit(a, lds, u); }
            else { for (int r2 = 0; r2 < 1 + ((P2_REP >> 2) & 1); ++r2) prep_unit(a, lds, u - 1024); }
        }
    });

    PHASE(3, {
        int bid = blockIdx.x; int Gp = G; asm volatile("" : "+s"(bid), "+s"(Gp));
        if (SCAN_MODE != 1) { for (int u = bid; u < NSCAN; u += Gp) scan_unit(a, lds, u); }
        if (SCAN_MODE == 1) { for (int u = bid; u < NSCAN; u += Gp) scan_chunked_unit<false>(a, lds, u); }
        if (SCAN_MODE == 2) { xcd_barrier(xbar); for (int u = bid; u < NSCAN; u += Gp) scan_chunked_unit<true>(a, lds, u); }
        if (rep_ == 0) {
            const int wv = __builtin_amdgcn_readfirstlane(threadIdx.x >> 6);
            if (Gp > NSCAN) { if (bid >= NSCAN) { for (int u = bid - NSCAN; u < 1024; u += Gp - NSCAN) for (int r2 = 0; r2 < 1 + (P2_REP & 1); ++r2) attn_unit(a, lds, u);
                                                 __syncthreads(); expert_prep_items(a, lds, (bid - NSCAN) * 8 + wv, (Gp - NSCAN) * 8, 2 * 8192, 3 * 8192); } }
            else { for (int u = bid; u < 1024; u += Gp) attn_unit(a, lds, u); __syncthreads(); expert_prep_items(a, lds, bid * 8 + wv, Gp * 8, 2 * 8192, 3 * 8192); }
        }
    });

    PHASE(4, phase_post(a, G));

    PHASE(5, {
        pg8::Gemm g{(const bf16_t*)(ws + WS_MIX), (const bf16_t*)(ws + WS_WOUTT), T, D, D}; pg8::StaticOrder S; S.init(T, D, G, (int)blockIdx.x);
        pg8::EpiResidSS E{a.in[I_X], (float*)(ws + WS_X1), (float*)(ws + WS_SS)}; pg8::gemm_phase<pg8::EpiResidSS, pg8::StaticOrder, false>(lds, g, S, E, nullptr);
    });

    PHASE(6, phase_router(a, lds, G));

    PHASE(7, { for (int u = blockIdx.x; u < BATCH * NE; u += G) topk_unit(a, lds, u); });

    PHASE(8, {
        pg8::Gemm g{(const bf16_t*)(ws + WS_H2), (const bf16_t*)(ws + WS_WGUT), NSLOT, 2048, D}; pg8::ExpertOrder S; S.init(32, 8, NE, G, (int)blockIdx.x);
        pg8::EpiSwiGLU E{(bf16_t*)(ws + WS_HID)}; pg8::gemm_phase<pg8::EpiSwiGLU, pg8::ExpertOrder, true>(lds, g, S, E, (const int*)(ws + WS_ROWTOK));
    });

    PHASE(9, {
        pg8::Gemm g{(const bf16_t*)(ws + WS_HID), (const bf16_t*)(ws + WS_WDT), NSLOT, D, FF}; pg8::ExpertOrder S; S.init(32, 4, NE, G, (int)blockIdx.x);
        pg8::EpiGateScale E{(bf16_t*)(ws + WS_YE), (const float*)(ws + WS_ROWGATE)}; pg8::gemm_phase<pg8::EpiGateScale, pg8::ExpertOrder, false>(lds, g, S, E, nullptr);
    });

    PHASE(10, phase_final(a, G));
#undef IN
#undef NREP
#undef PHASE
}

#ifndef MK_ONE_LAUNCH
#define MK_ONE_LAUNCH 1
#endif
extern "C" void kernel_launch(void* const* d_in, const int* in_sizes, int n_in, void* d_out, int out_size, void* d_ws, size_t ws_size, hipStream_t stream) {
    static int grid_blocks = 0;
    if (grid_blocks == 0) {
        if (n_in != 29 || out_size != T * D || ws_size < WS_END) { fprintf(stderr, "kernel_launch: unexpected problem: n_in %d out %d ws %zu (need %zu)\n", n_in, out_size, ws_size, (size_t)WS_END); grid_blocks = -1; return; }
        int dev = 0, cus = 0, per_cu = 0;
        if (hipGetDevice(&dev) != hipSuccess || hipDeviceGetAttribute(&cus, hipDeviceAttributeMultiprocessorCount, dev) != hipSuccess) { grid_blocks = -1; return; }
        if (hipFuncSetAttribute((const void*)mega, hipFuncAttributeMaxDynamicSharedMemorySize, LDS_BYTES) != hipSuccess) { fprintf(stderr, "kernel_launch: hipFuncSetAttribute failed\n"); grid_blocks = -1; return; }
        if (hipOccupancyMaxActiveBlocksPerMultiprocessor(&per_cu, (const void*)mega, NTHREADS, LDS_BYTES) != hipSuccess || per_cu < 1) { fprintf(stderr, "kernel_launch: occupancy query says %d blocks per CU\n", per_cu); grid_blocks = -1; return; }
        grid_blocks = cus;
    }
    if (grid_blocks < 0) return;
    if (hipMemsetAsync((char*)d_ws + WS_CTL, 0, CTL_BYTES, stream) != hipSuccess) { fprintf(stderr, "kernel_launch: memset failed\n"); return; }
    Args a{};
    for (int i = 0; i < 29; ++i) a.in[i] = (const float*)d_in[i];
    a.out = (float*)d_out; a.ws = (unsigned char*)d_ws;
#if MK_ONE_LAUNCH
    a.ph_lo = 0; a.ph_hi = NPHASE;
    { void* args[] = {&a}; hipError_t e = hipLaunchCooperativeKernel((const void*)mega, dim3(grid_blocks), dim3(NTHREADS), args, LDS_BYTES, stream);
      if (e != hipSuccess) fprintf(stderr, "cooperative launch failed: %s (grid %d)\n", hipGetErrorString(e), grid_blocks); }
#else
    for (int ph = 0; ph < NPHASE; ++ph) { a.ph_lo = ph; a.ph_hi = ph + 1; void* args[] = {&a};
        hipError_t e = hipLaunchCooperativeKernel((const void*)mega, dim3(grid_blocks), dim3(NTHREADS), args, LDS_BYTES, stream);
        if (e != hipSuccess) { fprintf(stderr, "cooperative launch %d failed: %s (grid %d)\n", ph, hipGetErrorString(e), grid_blocks); break; } }
#endif
}
```

```cpp
#include <hip/hip_runtime.h>
#include <hip/hip_cooperative_groups.h>
#include <cstdio>
#include <cstdint>
namespace cg = cooperative_groups;

#define LAS __attribute__((address_space(3)))
typedef unsigned short bf16_t;
typedef short bf16x8 __attribute__((ext_vector_type(8)));
typedef short s16x4 __attribute__((ext_vector_type(4)));
typedef float f32x2 __attribute__((ext_vector_type(2)));
typedef float f32x4 __attribute__((ext_vector_type(4)));
typedef float f32x16 __attribute__((ext_vector_type(16)));
typedef unsigned u32x2 __attribute__((ext_vector_type(2)));
typedef unsigned u32x4 __attribute__((ext_vector_type(4)));
typedef _Float16 f16x4 __attribute__((ext_vector_type(4)));
typedef __bf16 bf16v2 __attribute__((ext_vector_type(2)));

constexpr int D = 1024, BATCH = 16, SEQ = 4096, T = BATCH * SEQ, NMEM = 256;
constexpr int IN_PROJ = 2560, CW = 384, RW = 384, NH = 6, NE = 16, FF = 1024, CAP = 512;
constexpr int NSLOT = NE * BATCH * CAP;
constexpr int NTHREADS = 512;
constexpr int LDS_BYTES = 160 * 1024;
constexpr int NPHASE = 11;
#ifndef SCAN_MODE
#define SCAN_MODE 1
#endif

constexpr size_t MiB = 1u << 20;
constexpr size_t WS_WINT = 1 * MiB;
constexpr size_t WS_WOUTT = 6 * MiB;
constexpr size_t WS_WKT = 8 * MiB;
constexpr size_t WS_WVT = 8 * MiB + 512 * 1024;
constexpr size_t WS_SMALL = 9 * MiB;
constexpr size_t WS_WGUT = 10 * MiB;
constexpr size_t WS_WDT = 74 * MiB;
constexpr size_t WS_KMEM = 106 * MiB;
constexpr size_t WS_VT = 108 * MiB;
constexpr size_t WS_ROWTOK = 106 * MiB;
constexpr size_t WS_ROWGATE = 106 * MiB + 512 * 1024;
constexpr size_t WS_SS = 107 * MiB;
constexpr size_t WS_P = 112 * MiB;
constexpr size_t WS_YF = 112 * MiB;
constexpr size_t WS_YB = 208 * MiB;
constexpr size_t WS_X1 = 112 * MiB;
constexpr size_t WS_XH = 432 * MiB;
constexpr size_t WS_G = 432 * MiB;
constexpr size_t WS_BON = 480 * MiB;
constexpr size_t WS_Q = 400 * MiB;
constexpr int PLD = IN_PROJ - 256;
constexpr size_t WS_H2 = 432 * MiB;
constexpr size_t WS_MEMN = 560 * MiB;
constexpr size_t WS_MIX = 560 * MiB;
constexpr size_t WS_SCAN = 688 * MiB;
constexpr size_t SCAN_STRIDE = 48 * MiB;
constexpr size_t WS_SCAN7 = 496 * MiB;
constexpr size_t WS_PC = 484 * MiB;
__device__ __forceinline__ unsigned char* scan_arr(unsigned char* ws, int a) { return a < 7 ? ws + WS_SCAN + (size_t)a * SCAN_STRIDE : (a == 7 ? ws + WS_SCAN7 : ws + 560 * MiB + 640 * 2); }
__device__ __forceinline__ int scan_pitch(int a) { return a == 8 ? D : 384; }
constexpr size_t WS_AFF = 624 * MiB;
constexpr size_t WS_INV = 628 * MiB;
constexpr size_t WS_HID = 768 * MiB;
constexpr size_t WS_YE = 368 * MiB;
constexpr size_t WS_END = 1024 * MiB;

__device__ __forceinline__ unsigned pk_bf16(float lo, float hi) { f32x2 v = {lo, hi}; bf16v2 b = __builtin_convertvector(v, bf16v2); return __builtin_bit_cast(unsigned, b); }
__device__ __forceinline__ float bf_lo(unsigned u) { return __builtin_bit_cast(float, u << 16); }
__device__ __forceinline__ float bf_hi(unsigned u) { return __builtin_bit_cast(float, u & 0xffff0000u); }
__device__ __forceinline__ float wave_sum(float v) {
#pragma unroll
    for (int o = 1; o < 64; o <<= 1) v += __shfl_xor(v, o);
    return v;
}
__device__ __forceinline__ float sigmoidf_fast(float x) { return __builtin_amdgcn_rcpf(1.0f + __builtin_amdgcn_exp2f(-1.4426950408889634f * x)); }
template <int CTRL> __device__ __forceinline__ float dpp_f(float x) { return __builtin_bit_cast(float, __builtin_amdgcn_update_dpp(0, __builtin_bit_cast(int, x), CTRL, 0xF, 0xF, true)); }
__device__ __forceinline__ float sum8(float x) { x += dpp_f<0xB1>(x); x += dpp_f<0x4E>(x); x += dpp_f<0x141>(x); return x; }
__device__ __forceinline__ float sum16(float x) { x = sum8(x); x += dpp_f<0x140>(x); return x; }
__device__ __forceinline__ float max16(float x) { x = fmaxf(x, dpp_f<0xB1>(x)); x = fmaxf(x, dpp_f<0x4E>(x)); x = fmaxf(x, dpp_f<0x141>(x)); x = fmaxf(x, dpp_f<0x140>(x)); return x; }

typedef short v4i16g __attribute__((__vector_size__(8)));
__device__ __forceinline__ s16x4 tr_read16(LAS unsigned char* p) { v4i16g r = __builtin_amdgcn_ds_read_tr16_b64_v4i16((LAS v4i16g*)p); return __builtin_bit_cast(s16x4, r); }
__device__ __forceinline__ f32x4 bf4_to_f32(u32x2 w) { return (f32x4){bf_lo(w.x), bf_hi(w.x), bf_lo(w.y), bf_hi(w.y)}; }
__device__ __forceinline__ u32x2 f32_to_bf4(f32x4 v) { return (u32x2){pk_bf16(v.x, v.y), pk_bf16(v.z, v.w)}; }
__device__ __forceinline__ bf16x8 frag_lo4(f32x4 v) { const u32x4 w = {pk_bf16(v.x, v.y), pk_bf16(v.z, v.w), 0u, 0u}; return __builtin_bit_cast(bf16x8, w); }
__device__ __forceinline__ bf16x8 frag_cat(u32x2 a, u32x2 b) { const u32x4 w = {a.x, a.y, b.x, b.y}; return __builtin_bit_cast(bf16x8, w); }
#define MFMA16(a, b, c) __builtin_amdgcn_mfma_f32_16x16x32_bf16((a), (b), (c), 0, 0, 0)

namespace pg8 {
#define PG8_LAS __attribute__((address_space(3)))
constexpr int BM = 256, BK = 64, HALF = 128, HTB = HALF * BK * 2, STAGE_BYTES = 8 * HTB, NXCD = 8, WGM = 8;
__host__ __device__ __forceinline__ int lds_byte(int r, int c) { const int st = (r >> 4) * 2 + (c >> 5), rr = r & 15, cc = c & 31, ob = rr * 64 + cc * 2; return st * 1024 + (ob ^ (((ob >> 9) & 1) << 5)); }
__host__ __device__ __forceinline__ void stage_rc(int b, int& R, int& C) { const int st = b / 1024, sb = b % 1024, swz = sb ^ (((sb >> 9) & 1) << 5); R = (st >> 1) * 16 + swz / 64; C = (st & 1) * 32 + (swz % 64) / 2; }
__host__ __device__ __forceinline__ int perm32(int rho) { const int n = rho >> 4, i = rho & 15; return 8 * (i >> 2) + 4 * n + (i & 3); }

struct Unit { int pm, pn, gid; };
struct Gemm { const bf16_t* A; const bf16_t* Bt; int M, N, K; };

struct StaticOrder {
    int nM, nN, nwg, G, c;
    __device__ void init(int M, int N, int G_, int c_) { nM = M / BM; nN = N / BM; nwg = nM * nN; G = G_; c = c_; }
    __device__ bool next(int i, Unit& u) const {
        const long L = (long)i * G + c; if (L >= nwg) return false;
        int wgid = (int)L; { const int q = nwg / NXCD, r = nwg % NXCD, xcd = wgid % NXCD, off = wgid / NXCD; wgid = (xcd < r ? xcd * (q + 1) : r * (q + 1) + (xcd - r) * q) + off; }
        const int nig = WGM * nN, gid = wgid / nig, fm = gid * WGM, gsz = (nM - fm) < WGM ? (nM - fm) : WGM;
        u.pm = fm + ((wgid % nig) % gsz); u.pn = (wgid % nig) / gsz; u.gid = 0; return true;
    }
    __device__ __forceinline__ const char* aptr(const Gemm& g, const Unit& u, size_t tstep) const { return (const char*)g.A + (size_t)u.pm * tstep; }
    __device__ __forceinline__ const char* bptr(const Gemm& g, const Unit& u, size_t tstep) const { return (const char*)g.Bt + (size_t)u.pn * tstep; }
};
struct TripleOrder {
    StaticOrder S0; const bf16_t* A1; const bf16_t* B1; const bf16_t* A2; const bf16_t* B2; int n1, n2, G, c;
    __device__ bool next(int i, Unit& u) const {
        const long L = (long)i * G + c;
        if (L < n1) { u.pm = (int)L; u.pn = 0; u.gid = 1; return true; }
        if (L < n1 + n2) { u.pm = 0; u.pn = (int)(L - n1); u.gid = 2; return true; }
        const long L0 = L - n1 - n2; if (L0 >= S0.nwg) return false;
        StaticOrder T0 = S0; T0.c = (int)(L0 % G); return T0.next((int)(L0 / G), u);
    }
    __device__ __forceinline__ const char* aptr(const Gemm& g, const Unit& u, size_t tstep) const { return (const char*)(u.gid == 0 ? g.A : (u.gid == 1 ? A1 : A2)) + (size_t)u.pm * tstep; }
    __device__ __forceinline__ const char* bptr(const Gemm& g, const Unit& u, size_t tstep) const { return (const char*)(u.gid == 0 ? g.Bt : (u.gid == 1 ? B1 : B2)) + (size_t)u.pn * tstep; }
};
struct ExpertOrder {
    int nMe, nNe, per, total, G, c;
    __device__ void init(int nMe_, int nNe_, int nExp, int G_, int c_) { nMe = nMe_; nNe = nNe_; per = nMe * nNe; total = per * nExp; G = G_; c = c_; }
    __device__ bool next(int i, Unit& u) const {
        const long L = (long)i * G + c; if (L >= total) return false;
        const int e = (int)(L / per), w = (int)(L % per), xl = w % 8, j = w / 8, rpx = nMe / 8;
        u.pm = e * nMe + xl * rpx + (j % rpx); u.pn = e * nNe + j / rpx; u.gid = 0; return true;
    }
    __device__ __forceinline__ const char* aptr(const Gemm& g, const Unit& u, size_t tstep) const { return (const char*)g.A + (size_t)u.pm * tstep; }
    __device__ __forceinline__ const char* bptr(const Gemm& g, const Unit& u, size_t tstep) const { return (const char*)g.Bt + (size_t)u.pn * tstep; }
};

struct EpiBf16 {
    static constexpr bool PERM = true;
    bf16_t* O; int ldc; bf16_t* Q0;
    __device__ __forceinline__ void operator()(const f32x4 (&acc)[2][2][4][2], const Unit& u, int wr, int wc, int fr, int fq) const {
        const bool redir = (Q0 != nullptr) && (u.pn == 0);
        bf16_t* base = redir ? Q0 : O; const int ld = redir ? 256 : ldc;
        const int row0 = u.pm * BM + wr * 64 + fr, col0 = (u.pn - ((Q0 != nullptr && !redir) ? 1 : 0)) * BM + wc * 32 + 8 * fq;
#pragma unroll
        for (int ai = 0; ai < 2; ++ai)
#pragma unroll
            for (int m = 0; m < 4; ++m) { bf16_t* rowp = base + (size_t)(row0 + ai * HALF + m * 16) * ld + col0;
#pragma unroll
                for (int bj = 0; bj < 2; ++bj) { const f32x4 v0 = acc[ai][bj][m][0], v1 = acc[ai][bj][m][1];
                    u32x4 w; w.x = pk_bf16(v0[0], v0[1]); w.y = pk_bf16(v0[2], v0[3]); w.z = pk_bf16(v1[0], v1[1]); w.w = pk_bf16(v1[2], v1[3]);
                    *(u32x4*)(rowp + bj * HALF) = w; } }
    }
};
struct EpiBf16x3 {
    static constexpr bool PERM = true;
    EpiBf16 E0, E1, E2;
    __device__ __forceinline__ void operator()(const f32x4 (&acc)[2][2][4][2], const Unit& u, int wr, int wc, int fr, int fq) const {
        if (u.gid == 0) E0(acc, u, wr, wc, fr, fq); else if (u.gid == 1) E1(acc, u, wr, wc, fr, fq); else E2(acc, u, wr, wc, fr, fq); }
};
struct EpiResidSS {
    static constexpr bool PERM = false;
    const float* X; float* X1; float* ss;
    __device__ __forceinline__ void operator()(const f32x4 (&acc)[2][2][4][2], const Unit& u, int wr, int wc, int fr, int fq) const {
        const int row0 = u.pm * BM + wr * 64 + fr, col0 = u.pn * BM + wc * 32 + 4 * fq;
#pragma unroll
        for (int ai = 0; ai < 2; ++ai)
#pragma unroll
            for (int m = 0; m < 4; ++m) { const int row = row0 + ai * HALF + m * 16; const size_t off = (size_t)row * D + col0; float s = 0.f;
#pragma unroll
                for (int bj = 0; bj < 2; ++bj)
#pragma unroll
                    for (int n = 0; n < 2; ++n) { const f32x4 xv = *(const f32x4*)(X + off + bj * HALF + n * 16); const f32x4 o = xv + acc[ai][bj][m][n];
                        *(f32x4*)(X1 + off + bj * HALF + n * 16) = o; s += (o[0] * o[0] + o[1] * o[1]) + (o[2] * o[2] + o[3] * o[3]); }
                s += __shfl_xor(s, 16); s += __shfl_xor(s, 32);
                if (fq == 0) (void)__hip_atomic_fetch_add(ss + row, s, __ATOMIC_RELAXED, __HIP_MEMORY_SCOPE_AGENT); }
    }
};
struct EpiSwiGLU {
    static constexpr bool PERM = true;
    bf16_t* H;
    __device__ __forceinline__ void operator()(const f32x4 (&acc)[2][2][4][2], const Unit& u, int wr, int wc, int fr, int fq) const {
        const int row0 = u.pm * BM + wr * 64 + fr, col0 = (u.pn & 7) * HALF + wc * 32 + 8 * fq;
#pragma unroll
        for (int ai = 0; ai < 2; ++ai)
#pragma unroll
            for (int m = 0; m < 4; ++m) { bf16_t* rowp = H + (size_t)(row0 + ai * HALF + m * 16) * FF + col0; float h[8];
#pragma unroll
                for (int n = 0; n < 2; ++n)
#pragma unroll
                    for (int j = 0; j < 4; ++j) { const float gt = acc[ai][0][m][n][j], up = acc[ai][1][m][n][j]; h[n * 4 + j] = gt * sigmoidf_fast(gt) * up; }
                u32x4 w; w.x = pk_bf16(h[0], h[1]); w.y = pk_bf16(h[2], h[3]); w.z = pk_bf16(h[4], h[5]); w.w = pk_bf16(h[6], h[7]);
                *(u32x4*)rowp = w; }
    }
};
struct EpiGateScale {
    static constexpr bool PERM = true;
    bf16_t* Y; const float* gate;
    __device__ __forceinline__ void operator()(const f32x4 (&acc)[2][2][4][2], const Unit& u, int wr, int wc, int fr, int fq) const {
        const int row0 = u.pm * BM + wr * 64 + fr, col0 = (u.pn & 3) * BM + wc * 32 + 8 * fq;
#pragma unroll
        for (int ai = 0; ai < 2; ++ai)
#pragma unroll
            for (int m = 0; m < 4; ++m) { const int row = row0 + ai * HALF + m * 16; const float gs = gate[row]; bf16_t* rowp = Y + (size_t)row * D + col0;
#pragma unroll
                for (int bj = 0; bj < 2; ++bj) { const f32x4 v0 = acc[ai][bj][m][0] * gs, v1 = acc[ai][bj][m][1] * gs;
                    u32x4 w; w.x = pk_bf16(v0[0], v0[1]); w.y = pk_bf16(v0[2], v0[3]); w.z = pk_bf16(v1[0], v1[1]); w.w = pk_bf16(v1[2], v1[3]);
                    *(u32x4*)(rowp + bj * HALF) = w; } }
    }
};

template <class Epi, class Sched, bool GATHER>
__device__ __forceinline__ void gemm_phase(PG8_LAS unsigned char* lds, const Gemm g, const Sched& S, const Epi& E, const int* rowtok) {
    const int tid = threadIdx.x, wid = __builtin_amdgcn_readfirstlane(tid >> 6), lane = tid & 63, wr = wid >> 2, wc = wid & 3, fr = lane & 15, fq = lane >> 4;
    const int K = g.K, nt = K / BK;
    unsigned voffA[2], voffB[2]; int Rr[2], Cc[2];
#pragma unroll
    for (int i = 0; i < 2; ++i) { int R, C; stage_rc(tid * 16 + i * 8192, R, C); const int Rb = Epi::PERM ? ((R & ~31) + perm32(R & 31)) : R; Rr[i] = R; Cc[i] = C;
        voffA[i] = (unsigned)(R * K + C) * 2u; voffB[i] = (unsigned)(Rb * K + C) * 2u; }
    unsigned vAc[2][2], vAn[2][2];
    const size_t kstep = (size_t)(BK * 2);
    const size_t hstep = (size_t)HALF * K * 2;
    const size_t tstep = 2 * hstep;
    const unsigned ldsw = (unsigned)wid * 1024u;
    const int aoff = lds_byte(wr * 64 + fr, fq * 8), boff = lds_byte(wc * 32 + fr, fq * 8);
#define PG8_SA(b, h) (((b) * 2 + (h)) * HTB)
#define PG8_SB(b, h) ((4 + (b) * 2 + (h)) * HTB)
#define PG8_STAGE(bufoff, gbase, voff) do { _Pragma("unroll") for (int _i = 0; _i < 2; ++_i) \
        __builtin_amdgcn_global_load_lds((const unsigned*)((const char*)(gbase) + (voff)[_i]), (PG8_LAS unsigned*)(lds + (bufoff) + ldsw + _i * 8192), 16, 0, 0); } while (0)
#define PG8_STAGE_A(bufoff, hh, dbase, kbytes, vsel) do { if constexpr (GATHER) { PG8_STAGE(bufoff, (const char*)g.A + (kbytes), (vsel)[hh]); } else { PG8_STAGE(bufoff, (dbase) + ((hh) ? hstep : 0), voffA); } } while (0)
#define PG8_GATHER_OFF(dst, un) do { _Pragma("unroll") for (int _h = 0; _h < 2; ++_h) _Pragma("unroll") for (int _i = 0; _i < 2; ++_i) \
        (dst)[_h][_i] = (unsigned)rowtok[(un).pm * BM + _h * HALF + Rr[_i]] * (unsigned)(K * 2) + (unsigned)(Cc[_i] * 2); } while (0)
#define PG8_LDA(dst, b, h) do { _Pragma("unroll") for (int m = 0; m < 4; ++m) _Pragma("unroll") for (int k = 0; k < 2; ++k) dst[m][k] = *(const PG8_LAS bf16x8*)(lds + PG8_SA(b, h) + aoff + m * 2048 + k * 1024); } while (0)
#define PG8_LDB(dst, b, h) do { _Pragma("unroll") for (int n = 0; n < 2; ++n) _Pragma("unroll") for (int k = 0; k < 2; ++k) dst[n][k] = *(const PG8_LAS bf16x8*)(lds + PG8_SB(b, h) + boff + n * 2048 + k * 1024); } while (0)
#define PG8_MMA(ai, bj, At, Bt) do { __builtin_amdgcn_s_setprio(1); _Pragma("unroll") for (int m = 0; m < 4; ++m) _Pragma("unroll") for (int n = 0; n < 2; ++n) _Pragma("unroll") for (int k = 0; k < 2; ++k) \
        acc[ai][bj][m][n] = __builtin_amdgcn_mfma_f32_16x16x32_bf16(Bt[n][k], At[m][k], acc[ai][bj][m][n], 0, 0, 0); __builtin_amdgcn_s_setprio(0); } while (0)
#define PG8_WAIT_V(n) asm volatile("s_waitcnt vmcnt(" #n ")" ::: "memory")
#define PG8_WAIT_L(n) asm volatile("s_waitcnt lgkmcnt(" #n ")" ::: "memory")
#define PG8_BAR __builtin_amdgcn_s_barrier()
#define PG8_SCHED __builtin_amdgcn_sched_barrier(0)
    Unit cur, nxt; int ui = 0;
    if (!S.next(0, cur)) return;
    f32x4 acc[2][2][4][2];
#pragma unroll
    for (int a = 0; a < 2; ++a)
#pragma unroll
        for (int b = 0; b < 2; ++b)
#pragma unroll
            for (int m = 0; m < 4; ++m)
#pragma unroll
                for (int n = 0; n < 2; ++n) acc[a][b][m][n] = (f32x4){0.f, 0.f, 0.f, 0.f};
    bf16x8 At[4][2], B0[2][2], B1[2][2];
    const char* cA = GATHER ? (const char*)g.A : S.aptr(g, cur, tstep); const char* cB = S.bptr(g, cur, tstep);
    if constexpr (GATHER) { PG8_GATHER_OFF(vAc, cur); }
    PG8_STAGE(PG8_SB(0, 0), cB, voffB); PG8_STAGE_A(PG8_SA(0, 0), 0, cA, 0, vAc); PG8_STAGE(PG8_SB(0, 1), cB + hstep, voffB); PG8_STAGE_A(PG8_SA(0, 1), 1, cA, 0, vAc);
    if (wr == 1) PG8_BAR;
    PG8_WAIT_V(4); PG8_BAR;
    PG8_STAGE(PG8_SB(1, 0), cB + kstep, voffB); PG8_STAGE_A(PG8_SA(1, 0), 0, cA + kstep, kstep, vAc); PG8_STAGE(PG8_SB(1, 1), cB + hstep + kstep, voffB);
    PG8_WAIT_V(6); PG8_BAR;
    for (;;) {
        const bool has_next = S.next(ui + 1, nxt);
        const char* nA = (has_next && !GATHER) ? S.aptr(g, nxt, tstep) : cA; const char* nB = has_next ? S.bptr(g, nxt, tstep) : cB;
        if constexpr (GATHER) { if (has_next) { PG8_GATHER_OFF(vAn, nxt); } else {
#pragma unroll
            for (int _h = 0; _h < 2; ++_h)
#pragma unroll
                for (int _i = 0; _i < 2; ++_i) vAn[_h][_i] = vAc[_h][_i]; } }
        for (int t = 0; t < nt; t += 2) {
            const bool last = (t == nt - 2);
            const size_t k1 = (size_t)(t + 1) * kstep, k2 = last ? 0 : (size_t)(t + 2) * kstep, k3 = k2 + kstep;
            const char* a1 = cA + k1;
            const char* a2 = last ? nA : cA + (size_t)(t + 2) * kstep; const char* b2 = last ? nB : cB + (size_t)(t + 2) * kstep;
            const char* a3 = a2 + kstep; const char* b3 = b2 + kstep;
            unsigned vs[2][2];
#pragma unroll
            for (int _h = 0; _h < 2; ++_h)
#pragma unroll
                for (int _i = 0; _i < 2; ++_i) vs[_h][_i] = last ? vAn[_h][_i] : vAc[_h][_i];
            PG8_LDB(B0, 0, 0); PG8_SCHED; PG8_LDA(At, 0, 0); PG8_STAGE_A(PG8_SA(1, 1), 1, a1, k1, vAc);
            PG8_WAIT_L(8); PG8_BAR; PG8_WAIT_L(0); PG8_MMA(0, 0, At, B0); PG8_BAR; PG8_SCHED;
            PG8_LDB(B1, 0, 1); PG8_STAGE(PG8_SB(0, 0), b2, voffB);
            PG8_BAR; PG8_WAIT_L(0); PG8_MMA(0, 1, At, B1); PG8_BAR;
            PG8_LDA(At, 0, 1); PG8_STAGE_A(PG8_SA(0, 0), 0, a2, k2, vs);
            PG8_BAR; PG8_WAIT_L(0); PG8_MMA(1, 0, At, B0); PG8_BAR; PG8_SCHED;
            PG8_STAGE(PG8_SB(0, 1), b2 + hstep, voffB);
            PG8_WAIT_V(6); PG8_BAR; PG8_MMA(1, 1, At, B1); PG8_BAR;
            PG8_LDB(B0, 1, 0); PG8_SCHED; PG8_LDA(At, 1, 0); PG8_STAGE_A(PG8_SA(0, 1), 1, a2, k2, vs);
            PG8_WAIT_L(8); PG8_BAR; PG8_WAIT_L(0); PG8_MMA(0, 0, At, B0); PG8_BAR; PG8_SCHED;
            PG8_LDB(B1, 1, 1); PG8_STAGE(PG8_SB(1, 0), b3, voffB);
            PG8_BAR; PG8_WAIT_L(0); PG8_MMA(0, 1, At, B1); PG8_BAR;
            PG8_LDA(At, 1, 1); PG8_STAGE_A(PG8_SA(1, 0), 0, a3, k3, vs);
            PG8_BAR; PG8_WAIT_L(0); PG8_MMA(1, 0, At, B0); PG8_BAR; PG8_SCHED;
            PG8_STAGE(PG8_SB(1, 1), b3 + hstep, voffB);
            PG8_WAIT_V(6); PG8_BAR; PG8_MMA(1, 1, At, B1); PG8_BAR;
        }
        E(acc, cur, wr, wc, fr, fq);
        if (!has_next) break;
#pragma unroll
        for (int a = 0; a < 2; ++a)
#pragma unroll
            for (int b = 0; b < 2; ++b)
#pragma unroll
                for (int m = 0; m < 4; ++m)
#pragma unroll
                    for (int n = 0; n < 2; ++n) acc[a][b][m][n] = (f32x4){0.f, 0.f, 0.f, 0.f};
        cur = nxt; cA = nA; cB = nB; ++ui;
        if constexpr (GATHER) {
#pragma unroll
            for (int _h = 0; _h < 2; ++_h)
#pragma unroll
                for (int _i = 0; _i < 2; ++_i) vAc[_h][_i] = vAn[_h][_i]; }
    }
    PG8_WAIT_V(0);
    if (wr == 0) PG8_BAR;
    PG8_BAR;
#undef PG8_SA
#undef PG8_SB
#undef PG8_STAGE
#undef PG8_STAGE_A
#undef PG8_GATHER_OFF
#undef PG8_LDA
#undef PG8_LDB
#undef PG8_MMA
#undef PG8_WAIT_V
#undef PG8_WAIT_L
#undef PG8_BAR
#undef PG8_SCHED
}
}

struct Args {
    const float* in[29];
    float* out; unsigned char* ws;
    int ph_lo, ph_hi;
};
enum { I_X = 0, I_MEM, I_NMIXG, I_NMEMG, I_WIN, I_WMK, I_WMV, I_CONVW, I_CONVB, I_CLNG, I_CLNB, I_SHIFTMU, I_DW0, I_DUP, I_IA0, I_IUP, I_GUP, I_KK, I_KA, I_RK,
       I_LNXG, I_LNXB, I_WOUT, I_NFFNG, I_WROUTER, I_WEG, I_WEU, I_WED, I_FNG };

__device__ __forceinline__ void transpose_item(const float* W, int N, bf16_t* WT, int K, int k0, int n0, int drow0, LAS float* scr, int lane) {
#pragma unroll 8
    for (int i = 0; i < 32; ++i) { const int kk = 2 * i + (lane >> 5); scr[kk * 33 + (lane & 31)] = W[(size_t)(k0 + kk) * N + n0 + (lane & 31)]; }
    asm volatile("s_waitcnt lgkmcnt(0)" ::: "memory");
    const int c = lane & 7;
#pragma unroll
    for (int j = 0; j < 4; ++j) { const int n = (lane >> 3) + 8 * j; const LAS float* s = scr + (8 * c) * 33 + n;
        u32x4 o; o.x = pk_bf16(s[0 * 33], s[1 * 33]); o.y = pk_bf16(s[2 * 33], s[3 * 33]); o.z = pk_bf16(s[4 * 33], s[5 * 33]); o.w = pk_bf16(s[6 * 33], s[7 * 33]);
        *(u32x4*)(WT + (size_t)(drow0 + n) * K + k0 + 8 * c) = o; }
    asm volatile("s_waitcnt lgkmcnt(0)" ::: "memory");
}
__device__ __forceinline__ void expert_prep_items(const Args& a, LAS unsigned char* lds, int widx, int nw, int it_lo, int it_hi) {
    const int tid = threadIdx.x, lane = tid & 63, wave = __builtin_amdgcn_readfirstlane(tid >> 6);
    LAS float* scr = (LAS float*)(lds + wave * 16384);
    unsigned char* ws = a.ws;
    constexpr int S_EXP = 16 * 16 * 32;
    for (int r = it_lo + widx; r < it_hi; r += nw) {
        const int which = r / S_EXP, q = r % S_EXP, e = q / 512, kb = (q % 512) / 32, nb = q % 32, n0 = nb * 32;
        if (which == 0) transpose_item(a.in[I_WEG] + (size_t)e * D * FF, FF, (bf16_t*)(ws + WS_WGUT) + (size_t)e * 2048 * D, D, kb * 64, n0, (n0 >> 7) * 256 + (n0 & 127), scr, lane);
        else if (which == 1) transpose_item(a.in[I_WEU] + (size_t)e * D * FF, FF, (bf16_t*)(ws + WS_WGUT) + (size_t)e * 2048 * D, D, kb * 64, n0, (n0 >> 7) * 256 + 128 + (n0 & 127), scr, lane);
        else transpose_item(a.in[I_WED] + (size_t)e * FF * D, D, (bf16_t*)(ws + WS_WDT) + (size_t)e * D * FF, FF, kb * 64, n0, n0, scr, lane);
    }
}

__device__ __forceinline__ void rms_row_to_bf16(const float* xrow, const float* g, bf16_t* orow, int lane) {
    const f32x4* xr = (const f32x4*)xrow + lane; const f32x4* gr = (const f32x4*)g + lane;
    f32x4 v[4]; float s = 0.f;
#pragma unroll
    for (int j = 0; j < 4; ++j) { v[j] = xr[64 * j]; s += (v[j].x * v[j].x + v[j].y * v[j].y) + (v[j].z * v[j].z + v[j].w * v[j].w); }
    const float rs = 1.0f / sqrtf(wave_sum(s) * (1.f / D) + 1e-6f);
    u32x2* o8 = (u32x2*)orow + lane;
#pragma unroll
    for (int j = 0; j < 4; ++j) { const f32x4 gg = gr[64 * j]; u32x2 w; w.x = pk_bf16(v[j].x * rs * gg.x, v[j].y * rs * gg.y); w.y = pk_bf16(v[j].z * rs * gg.z, v[j].w * rs * gg.w); o8[64 * j] = w; }
}
__device__ __forceinline__ void phase_prep(const Args& a, LAS unsigned char* lds, int G) {
    const int tid = threadIdx.x, lane = tid & 63, wave = __builtin_amdgcn_readfirstlane(tid >> 6);
    LAS float* scr = (LAS float*)(lds + wave * 16384);
    const int gw = blockIdx.x * 8 + wave, NGW = G * 8;
    unsigned char* ws = a.ws;
    constexpr int S_WIN = 16 * 80, S_WOUT = 16 * 32, S_MK = 16 * 8, S_SM = 12, S_GUP = 24;
    constexpr int NITEMS = S_WIN + S_WOUT + 2 * S_MK + 4 * S_SM + S_GUP;
    for (int it = gw; it < NITEMS; it += NGW) {
        int r = it;
        if (r < S_WIN) { const int kb = r / 80, nb = r % 80; transpose_item(a.in[I_WIN], IN_PROJ, (bf16_t*)(ws + WS_WINT), D, kb * 64, nb * 32, nb * 32, scr, lane); continue; } r -= S_WIN;
        if (r < S_WOUT) { const int kb = r / 32, nb = r % 32; transpose_item(a.in[I_WOUT], D, (bf16_t*)(ws + WS_WOUTT), D, kb * 64, nb * 32, nb * 32, scr, lane); continue; } r -= S_WOUT;
        if (r < S_MK) { const int kb = r / 8, nb = r % 8; transpose_item(a.in[I_WMK], 256, (bf16_t*)(ws + WS_WKT), D, kb * 64, nb * 32, nb * 32, scr, lane); continue; } r -= S_MK;
        if (r < S_MK) { const int kb = r / 8, nb = r % 8; transpose_item(a.in[I_WMV], 256, (bf16_t*)(ws + WS_WVT), D, kb * 64, nb * 32, nb * 32, scr, lane); continue; } r -= S_MK;
        if (r < 4 * S_SM) { const int which = r / S_SM, nb = r % S_SM;
            const float* src = (which < 2 ? a.in[I_DUP] : a.in[I_IUP]) + (size_t)(which & 1) * 64 * RW;
            transpose_item(src, RW, (bf16_t*)(ws + WS_SMALL) + (size_t)which * RW * 64, 64, 0, nb * 32, nb * 32, scr, lane); continue; } r -= 4 * S_SM;
        { const int kb = r / 12, nb = r % 12; transpose_item(a.in[I_GUP], RW, (bf16_t*)(ws + WS_SMALL) + (size_t)4 * RW * 64, 128, kb * 64, nb * 32, nb * 32, scr, lane); }
    }
    expert_prep_items(a, lds, gw, NGW, 0, 3 * 8192);
    for (int m = gw; m < T; m += NGW) rms_row_to_bf16(a.in[I_X] + (size_t)m * D, a.in[I_NMIXG], (bf16_t*)(ws + WS_XH) + (size_t)m * D, lane);
    for (int m = gw; m < BATCH * NMEM; m += NGW) rms_row_to_bf16(a.in[I_MEM] + (size_t)m * D, a.in[I_NMEMG], (bf16_t*)(ws + WS_MEMN) + (size_t)m * D, lane);
}

constexpr int AT_KS = 144;
constexpr int AT_VS = 520;
constexpr int AT_VOFF = 256 * AT_KS;
__device__ __forceinline__ bf16x8 pack_step(const f32x16& x, int s) {
    u32x4 p;
    asm volatile("v_cvt_pk_bf16_f32 %0, %4, %5\n\tv_cvt_pk_bf16_f32 %1, %6, %7\n\tv_cvt_pk_bf16_f32 %2, %8, %9\n\tv_cvt_pk_bf16_f32 %3, %10, %11\n\ts_nop 1"
                 : "=&v"(p[0]), "=&v"(p[1]), "=&v"(p[2]), "=&v"(p[3])
                 : "v"(x[8 * s]), "v"(x[8 * s + 1]), "v"(x[8 * s + 2]), "v"(x[8 * s + 3]), "v"(x[8 * s + 4]), "v"(x[8 * s + 5]), "v"(x[8 * s + 6]), "v"(x[8 * s + 7]));
    return __builtin_bit_cast(bf16x8, p);
}
__device__ __forceinline__ void attn_unit(const Args& a, LAS unsigned char* lds, int unit) {
    const int tid = threadIdx.x, lane = tid & 63, wave = __builtin_amdgcn_readfirstlane(tid >> 6), r = lane & 31, h = lane >> 5;
    const int b = unit >> 6, hh = (unit >> 4) & 3, tile = unit & 15;
    const bf16_t* Qb = (const bf16_t*)(a.ws + WS_Q); const bf16_t* KM = (const bf16_t*)(a.ws + WS_KMEM); const bf16_t* VT = (const bf16_t*)(a.ws + WS_VT);
    bf16_t* MIX = (bf16_t*)(a.ws + WS_MIX);
    __syncthreads();
#pragma unroll
    for (int i = 0; i < 4; ++i) { const int c = tid + 512 * i, key = c >> 3, ch = c & 7;
        const u32x4 v = *(const u32x4*)(KM + (size_t)(b * NMEM + key) * 256 + hh * 64 + ch * 8);
        *(LAS u32x4*)(lds + key * AT_KS + ch * 16) = v; }
#pragma unroll
    for (int i = 0; i < 4; ++i) { const int c = tid + 512 * i, d = c >> 5, ch = c & 31;
        const u32x4 v = *(const u32x4*)(VT + (size_t)(hh * 64 + d) * (BATCH * NMEM) + b * NMEM + ch * 8);
        LAS u32x2* dst = (LAS u32x2*)(lds + AT_VOFF + d * AT_VS + ch * 16);
        dst[0] = (u32x2){v.x, v.y}; dst[1] = (u32x2){v.z, v.w}; }
    const int tok0 = b * SEQ + tile * 256 + wave * 32;
    bf16x8 qf[4];
#pragma unroll
    for (int ks = 0; ks < 4; ++ks) qf[ks] = *(const bf16x8*)(Qb + (size_t)(tok0 + r) * 256 + hh * 64 + ks * 16 + h * 8);
    __syncthreads();
    const float sc = 0.125f * 1.4426950408889634f;
    float m_run = -3.0e38f, sum = 0.f;
    f32x16 o[2];
#pragma unroll
    for (int dt = 0; dt < 2; ++dt)
#pragma unroll
        for (int i = 0; i < 16; ++i) o[dt][i] = 0.f;
#pragma unroll 1
    for (int kh = 0; kh < 2; ++kh) {
        f32x16 s[4];
#pragma unroll
        for (int k4 = 0; k4 < 4; ++k4) {
#pragma unroll
            for (int i = 0; i < 16; ++i) s[k4][i] = 0.f;
#pragma unroll
            for (int ks = 0; ks < 4; ++ks) { const bf16x8 ka = *(const LAS bf16x8*)(lds + ((kh * 4 + k4) * 32 + r) * AT_KS + (ks * 16 + h * 8) * 2);
                s[k4] = __builtin_amdgcn_mfma_f32_32x32x16_bf16(ka, qf[ks], s[k4], 0, 0, 0); }
        }
        float mx = m_run;
#pragma unroll
        for (int k4 = 0; k4 < 4; ++k4)
#pragma unroll
            for (int i = 0; i < 16; ++i) mx = fmaxf(mx, s[k4][i]);
        mx = fmaxf(mx, __shfl_xor(mx, 32));
        const float alpha = __builtin_amdgcn_exp2f((m_run - mx) * sc);
        float ps = 0.f;
#pragma unroll
        for (int k4 = 0; k4 < 4; ++k4)
#pragma unroll
            for (int i = 0; i < 16; ++i) { const float e = __builtin_amdgcn_exp2f((s[k4][i] - mx) * sc); s[k4][i] = e; ps += e; }
        ps += __shfl_xor(ps, 32);
        sum = sum * alpha + ps; m_run = mx;
#pragma unroll
        for (int dt = 0; dt < 2; ++dt)
#pragma unroll
            for (int i = 0; i < 16; ++i) o[dt][i] *= alpha;
#pragma unroll
        for (int k4 = 0; k4 < 4; ++k4)
#pragma unroll
            for (int s2 = 0; s2 < 2; ++s2) {
                const bf16x8 pb = pack_step(s[k4], s2);
#pragma unroll
                for (int dt = 0; dt < 2; ++dt) {
                    const LAS unsigned char* vp = lds + AT_VOFF + (32 * dt + r) * AT_VS + (32 * (kh * 4 + k4) + 16 * s2 + 4 * h) * 2;
                    const s16x4 lo = *(const LAS s16x4*)vp, hi = *(const LAS s16x4*)(vp + 16);
                    const bf16x8 va = __builtin_shufflevector(lo, hi, 0, 1, 2, 3, 4, 5, 6, 7);
                    o[dt] = __builtin_amdgcn_mfma_f32_32x32x16_bf16(va, pb, o[dt], 0, 0, 0);
                }
            }
    }
    const float inv = 1.0f / sum;
    bf16_t* orow = MIX + (size_t)(tok0 + r) * D + hh * 64;
#pragma unroll
    for (int dt = 0; dt < 2; ++dt)
#pragma unroll
        for (int gq = 0; gq < 4; ++gq) { u32x2 w; w.x = pk_bf16(o[dt][4 * gq] * inv, o[dt][4 * gq + 1] * inv); w.y = pk_bf16(o[dt][4 * gq + 2] * inv, o[dt][4 * gq + 3] * inv);
            *(u32x2*)(orow + 32 * dt + 8 * gq + 4 * h) = w; }
}

__device__ __forceinline__ void conv_unit(const Args& a, LAS unsigned char* lds, int unit) {
    const int tid = threadIdx.x, lane = tid & 63, wave = __builtin_amdgcn_readfirstlane(tid >> 6);
    const int b = unit >> 6, t0 = (unit & 63) * 64;
    const bf16_t* P = (const bf16_t*)(a.ws + WS_P); bf16_t* MIX = (bf16_t*)(a.ws + WS_MIX);
    LAS _Float16* U = (LAS _Float16*)lds;
    LAS _Float16* Cc = (LAS _Float16*)(lds + 94 * CW * 2);
    __syncthreads();
#pragma unroll 1
    for (int q0 = tid; q0 < 94 * 48; q0 += 3 * NTHREADS) {
        u32x4 vvv[3], ggg[3];
#pragma unroll
        for (int u3 = 0; u3 < 3; ++u3) { const int q = q0 + u3 * NTHREADS, j = q / 48, cc = (q % 48) * 8, s = t0 - 15 + j; const bool ok = (q < 94 * 48) && s >= 0 && s < SEQ;
            const bf16_t* row = P + (size_t)(b * SEQ + (ok ? s : 0)) * PLD + cc;
            vvv[u3] = ok ? *(const u32x4*)row : (u32x4){0u, 0u, 0u, 0u}; ggg[u3] = ok ? *(const u32x4*)(row + CW) : (u32x4){0u, 0u, 0u, 0u}; }
#pragma unroll
        for (int u3 = 0; u3 < 3; ++u3) { const int q = q0 + u3 * NTHREADS, j = q / 48, cc = (q % 48) * 8;
            if (q < 94 * 48) {
                const unsigned vw[4] = {vvv[u3].x, vvv[u3].y, vvv[u3].z, vvv[u3].w}, gw[4] = {ggg[u3].x, ggg[u3].y, ggg[u3].z, ggg[u3].w};
                float u[8];
#pragma unroll
                for (int k = 0; k < 4; ++k) { u[2 * k] = bf_lo(vw[k]) * sigmoidf_fast(bf_lo(gw[k])); u[2 * k + 1] = bf_hi(vw[k]) * sigmoidf_fast(bf_hi(gw[k])); }
                LAS f16x4* dst = (LAS f16x4*)(U + j * CW + cc); dst[0] = (f16x4){(_Float16)u[0], (_Float16)u[1], (_Float16)u[2], (_Float16)u[3]}; dst[1] = (f16x4){(_Float16)u[4], (_Float16)u[5], (_Float16)u[6], (_Float16)u[7]}; }
        }
    }
    __syncthreads();
    const int cq = tid & 127, tq = tid >> 7;
#pragma unroll 1
    for (int k3 = 0; k3 < 3; ++k3) { const int c = cq + 128 * k3;
        float w[31], res[16];
#pragma unroll
        for (int kk = 0; kk < 31; ++kk) w[kk] = a.in[I_CONVW][kk * CW + c];
        const float bias = a.in[I_CONVB][c];
#pragma unroll
        for (int tt = 0; tt < 16; ++tt) res[tt] = bias;
#pragma unroll
        for (int jj = 0; jj < 46; ++jj) { const float uv = (float)U[(tq * 16 + jj) * CW + c];
#pragma unroll
            for (int tt = 0; tt < 16; ++tt) { if (jj - tt >= 0 && jj - tt <= 30) res[tt] += uv * w[jj - tt]; } }
#pragma unroll
        for (int tt = 0; tt < 16; ++tt) Cc[(tq * 16 + tt) * CW + c] = (_Float16)res[tt];
    }
    __syncthreads();
    for (int tt = 0; tt < 8; ++tt) { const int t = wave * 8 + tt;
        float v[6]; float s = 0.f;
#pragma unroll
        for (int i = 0; i < 6; ++i) { v[i] = (float)Cc[t * CW + lane + 64 * i]; s += v[i]; }
        const float mean = wave_sum(s) * (1.f / CW); float q = 0.f;
#pragma unroll
        for (int i = 0; i < 6; ++i) { v[i] -= mean; q += v[i] * v[i]; }
        const float rstd = 1.0f / sqrtf(wave_sum(q) * (1.f / CW) + 1e-5f);
        bf16_t* orow = MIX + (size_t)(b * SEQ + t0 + t) * D + 256;
#pragma unroll
        for (int i = 0; i < 6; ++i) { const int c = lane + 64 * i; const float y = v[i] * rstd * a.in[I_CLNG][c] + a.in[I_CLNB][c]; const float o = y * sigmoidf_fast(y);
            orow[c] = (bf16_t)(pk_bf16(o, 0.f) & 0xffffu); }
    }
}

constexpr int PR_AS = 784;
constexpr int PR_RK = 64 * PR_AS;
constexpr int PR_RKS = 1536;
constexpr int PR_RN = PR_RK + 64 * PR_RKS;
constexpr int PR_CST = PR_RN + 2048;
static_assert(PR_CST + 7 * 384 * 4 <= LDS_BYTES - 64, "prep LDS map");
template <int CTRL> __device__ __forceinline__ f32x4 dpp4(f32x4 x) { return (f32x4){dpp_f<CTRL>(x.x), dpp_f<CTRL>(x.y), dpp_f<CTRL>(x.z), dpp_f<CTRL>(x.w)}; }
__device__ __forceinline__ void prep_unit(const Args& a, LAS unsigned char* lds, int unit) {
    const int tid = threadIdx.x, lane = tid & 63, wave = __builtin_amdgcn_readfirstlane(tid >> 6);
    const int b = unit >> 6, t0 = (unit & 63) * 64;
    const bf16_t* __restrict__ P = (const bf16_t*)(a.ws + WS_P);
    const float* __restrict__ mu = a.in[I_SHIFTMU];
    LAS float* RNs = (LAS float*)(lds + PR_RN); LAS float* CST = (LAS float*)(lds + PR_CST);
    __syncthreads();
    for (int i = tid; i < 7 * 384; i += NTHREADS) { const int w7 = i / 384, c7 = i % 384;
        CST[i] = (w7 == 0) ? a.in[I_KK][c7] : (w7 == 1) ? a.in[I_KA][c7] : (w7 == 2) ? a.in[I_RK][c7] : (w7 < 5) ? a.in[I_DW0][(w7 - 3) * RW + c7] : a.in[I_IA0][(w7 - 5) * RW + c7]; }
#ifndef PREP_REP1
#define PREP_REP1 1
#endif
#ifndef PREP_REP2
#define PREP_REP2 1
#endif
#pragma unroll 1
    for (int rp1 = 0; rp1 < PREP_REP1; ++rp1)
#pragma unroll 1
    for (int q0 = tid; q0 < 64 * 192; q0 += 4 * NTHREADS) {
        u32x4 cuv[4], pvv[4], nvv[4];
#pragma unroll
        for (int u4 = 0; u4 < 4; ++u4) { const int q = q0 + u4 * NTHREADS, tt = q / 192, c8 = (q % 192) * 8, s = t0 + tt;
            const bf16_t* row = P + ((size_t)b * SEQ + s) * PLD + 768 + c8;
            cuv[u4] = *(const u32x4*)row;
            pvv[u4] = (s > 0) ? *(const u32x4*)(row - PLD) : (u32x4){0u, 0u, 0u, 0u};
            nvv[u4] = (s < SEQ - 1) ? *(const u32x4*)(row + PLD) : (u32x4){0u, 0u, 0u, 0u}; }
#pragma unroll
        for (int u4 = 0; u4 < 4; ++u4) { const int q = q0 + u4 * NTHREADS, tt = q / 192, c8 = (q % 192) * 8, s = t0 + tt; const size_t tok = (size_t)b * SEQ + s;
            const u32x4 cu = cuv[u4], pv = pvv[u4], nv = nvv[u4];
            const unsigned cw[4] = {cu.x, cu.y, cu.z, cu.w}, pw[4] = {pv.x, pv.y, pv.z, pv.w}, nw[4] = {nv.x, nv.y, nv.z, nv.w};
            const f32x4 m0a = *(const f32x4*)(mu + c8), m0b = *(const f32x4*)(mu + c8 + 4), m1a = *(const f32x4*)(mu + 1536 + c8), m1b = *(const f32x4*)(mu + 1536 + c8 + 4);
            const float m0[8] = {m0a.x, m0a.y, m0a.z, m0a.w, m0b.x, m0b.y, m0b.z, m0b.w}, m1[8] = {m1a.x, m1a.y, m1a.z, m1a.w, m1b.x, m1b.y, m1b.z, m1b.w};
            float pf[8];
#pragma unroll
            for (int k = 0; k < 4; ++k) { const float c0 = bf_lo(cw[k]), c1 = bf_hi(cw[k]);
                pf[2 * k] = c0 + m0[2 * k] * (bf_lo(pw[k]) - c0) + m1[2 * k] * (bf_lo(nw[k]) - c0);
                pf[2 * k + 1] = c1 + m0[2 * k + 1] * (bf_hi(pw[k]) - c1) + m1[2 * k + 1] * (bf_hi(nw[k]) - c1); }
            if (c8 < 768) {
                f16x4 h0 = {(_Float16)pf[0], (_Float16)pf[1], (_Float16)pf[2], (_Float16)pf[3]}, h1 = {(_Float16)pf[4], (_Float16)pf[5], (_Float16)pf[6], (_Float16)pf[7]};
                LAS f16x4* dst = (LAS f16x4*)(lds + PR_RK + tt * PR_RKS + c8 * 2); dst[0] = h0; dst[1] = h1;
                if (c8 >= 384) { const f32x4 ka = *(const f32x4*)(a.in[I_KK] + c8 - 384), kb = *(const f32x4*)(a.in[I_KK] + c8 - 384 + 4);
                    float ssq = (pf[0] * ka.x) * (pf[0] * ka.x) + (pf[1] * ka.y) * (pf[1] * ka.y) + (pf[2] * ka.z) * (pf[2] * ka.z) + (pf[3] * ka.w) * (pf[3] * ka.w)
                              + (pf[4] * kb.x) * (pf[4] * kb.x) + (pf[5] * kb.y) * (pf[5] * kb.y) + (pf[6] * kb.z) * (pf[6] * kb.z) + (pf[7] * kb.w) * (pf[7] * kb.w);
                    ssq = sum8(ssq);
                    if ((lane & 7) == 0) RNs[tt * 8 + ((c8 - 384) >> 6)] = __builtin_amdgcn_rsqf(ssq + 1e-12f); }
            } else if (c8 < 1152) {
                u32x4 w; w.x = pk_bf16(pf[0], pf[1]); w.y = pk_bf16(pf[2], pf[3]); w.z = pk_bf16(pf[4], pf[5]); w.w = pk_bf16(pf[6], pf[7]);
                *(u32x4*)((bf16_t*)scan_arr(a.ws, 0) + tok * RW + (c8 - 768)) = w;
            } else {
                const int cc = c8 - 1152;
#pragma unroll
                for (int k = 0; k < 8; ++k) { if (cc < 128) pf[k] = 1.0f - 2.0f * __builtin_amdgcn_rcpf(1.0f + __builtin_amdgcn_exp2f(2.8853900817779268f * pf[k])); else if (cc >= 256) pf[k] = sigmoidf_fast(pf[k]); }
                u32x4 w; w.x = pk_bf16(pf[0], pf[1]); w.y = pk_bf16(pf[2], pf[3]); w.z = pk_bf16(pf[4], pf[5]); w.w = pk_bf16(pf[6], pf[7]);
                *(LAS u32x4*)(lds + tt * PR_AS + cc * 2) = w; }
        }
    }
    __syncthreads();
    const int l15 = lane & 15, kq = lane >> 4;
    const bf16_t* SM = (const bf16_t*)(a.ws + WS_SMALL);
    float* __restrict__ PCg = (float*)(a.ws + WS_PC); float* __restrict__ BON = (float*)(a.ws + WS_BON);
    bf16x8 Fc[16], Fn[16];
#define PREP_CH(nt_) (32 * ((nt_) >> 1) + 8 * (l15 >> 2) + 4 * ((nt_) & 1) + (l15 & 3))
#define PREP_LOADF(st_) do { const int it_ = wave + 8 * ((st_) / 3), kind_ = (st_) % 3, hd_ = it_ >> 2; \
        if (kind_ < 2) { const bf16_t* w0_ = SM + (size_t)kind_ * RW * 64; const bf16_t* w1_ = SM + (size_t)(2 + kind_) * RW * 64; \
            _Pragma("unroll") for (int f_ = 0; f_ < 16; ++f_) Fn[f_] = *(const bf16x8*)((((f_ >> 2) & 1) ? w1_ : w0_) + (size_t)(hd_ * 64 + PREP_CH(f_ & 3)) * 64 + (f_ >> 3) * 32 + kq * 8); } \
        else { const bf16_t* wg_ = SM + (size_t)4 * RW * 64; \
            _Pragma("unroll") for (int f_ = 0; f_ < 16; ++f_) Fn[f_] = *(const bf16x8*)(wg_ + (size_t)(hd_ * 64 + PREP_CH(f_ & 3)) * 128 + (f_ >> 2) * 32 + kq * 8); } } while (0)
    PREP_LOADF(0);
#pragma unroll 1
    for (int st = 0; st < 9; ++st) {
#pragma unroll
        for (int f = 0; f < 16; ++f) Fc[f] = Fn[f];
        const int it = wave + 8 * (st / 3), kind = st % 3, hd = it >> 2, mt = it & 3, tokl = mt * 16 + l15; const size_t tok = (size_t)b * SEQ + t0 + tokl;
        if (kind < 2) {
            const int d = kind;
            f32x4 accW[4], accA[4];
#pragma unroll
            for (int nt = 0; nt < 4; ++nt) { accW[nt] = (f32x4){0.f, 0.f, 0.f, 0.f}; accA[nt] = (f32x4){0.f, 0.f, 0.f, 0.f}; }
#pragma unroll
            for (int ks = 0; ks < 2; ++ks) {
                const bf16x8 aw = *(const LAS bf16x8*)(lds + tokl * PR_AS + (d * 64 + ks * 32 + kq * 8) * 2), aa = *(const LAS bf16x8*)(lds + tokl * PR_AS + ((2 + d) * 64 + ks * 32 + kq * 8) * 2);
#pragma unroll
                for (int nt = 0; nt < 4; ++nt) { accW[nt] = MFMA16(Fc[ks * 8 + nt], aw, accW[nt]); accA[nt] = MFMA16(Fc[ks * 8 + 4 + nt], aa, accA[nt]); }
            }
            if (st + 1 < 9) PREP_LOADF(st + 1);
            const float rn = RNs[tokl * 8 + hd];
            bf16_t* AHg = (bf16_t*)scan_arr(a.ws, 1 + 4 * d); bf16_t* RHg = (bf16_t*)scan_arr(a.ws, 2 + 4 * d); bf16_t* BHg = (bf16_t*)scan_arr(a.ws, 3 + 4 * d); bf16_t* KHg = (bf16_t*)scan_arr(a.ws, 4 + 4 * d);
            const int pitchK = scan_pitch(4 + 4 * d);
            float bsum = 0.f;
            u32x2 hA[2], hR[2], hB[2], hK[2];
#pragma unroll
            for (int nt = 0; nt < 4; ++nt) { const int ch = hd * 64 + 32 * (nt >> 1) + 8 * kq + 4 * (nt & 1);
                const f32x4 bW = *(const LAS f32x4*)(CST + (3 + d) * 384 + ch), bA = *(const LAS f32x4*)(CST + (5 + d) * 384 + ch);
                const f32x4 kkw = *(const LAS f32x4*)(CST + ch), kaw = *(const LAS f32x4*)(CST + 384 + ch), rkw = *(const LAS f32x4*)(CST + 768 + ch);
                const f32x4 zw = accW[nt] + bW, za = accA[nt] + bA;
                f32x4 lw, av;
#pragma unroll
                for (int e = 0; e < 4; ++e) { lw[e] = -0.606531f * 1.4426950408889634f * sigmoidf_fast(zw[e]); av[e] = sigmoidf_fast(za[e]); }
                f32x4 cum = lw;
                if (d == 0) { cum += dpp4<0x111>(cum); cum += dpp4<0x112>(cum); cum += dpp4<0x114>(cum); cum += dpp4<0x118>(cum); }
                else        { cum += dpp4<0x101>(cum); cum += dpp4<0x102>(cum); cum += dpp4<0x104>(cum); cum += dpp4<0x108>(cum); }
                f32x4 Pt, Pinv, Pprev;
#pragma unroll
                for (int e = 0; e < 4; ++e) { Pt[e] = __builtin_amdgcn_exp2f(cum[e]); Pinv[e] = __builtin_amdgcn_rcpf(Pt[e]); Pprev[e] = __builtin_amdgcn_exp2f(cum[e] - lw[e]); }
                const f32x4 r4 = __builtin_convertvector(*(const LAS f16x4*)(lds + PR_RK + tokl * PR_RKS + ch * 2), f32x4);
                const f32x4 k4 = __builtin_convertvector(*(const LAS f16x4*)(lds + PR_RK + tokl * PR_RKS + (384 + ch) * 2), f32x4);
                const f32x4 kk = k4 * kkw * rn, kd = k4 * (1.0f + (av - 1.0f) * kaw);
                hA[nt & 1] = f32_to_bf4(-kk * Pprev); hR[nt & 1] = f32_to_bf4(r4 * Pt); hB[nt & 1] = f32_to_bf4(kk * av * Pinv); hK[nt & 1] = f32_to_bf4(kd * Pinv);
                const f32x4 bt = r4 * kd * rkw; bsum += (bt.x + bt.y) + (bt.z + bt.w);
                if (l15 == (d ? 0 : 15)) *(f32x4*)(PCg + ((size_t)d * (T / 16) + (tok >> 4)) * RW + ch) = Pt;
                if (nt & 1) { const int c8 = ch - 4; const size_t eo = tok * RW + c8;
                    *(u32x4*)(AHg + eo) = (u32x4){hA[0].x, hA[0].y, hA[1].x, hA[1].y}; *(u32x4*)(RHg + eo) = (u32x4){hR[0].x, hR[0].y, hR[1].x, hR[1].y};
                    *(u32x4*)(BHg + eo) = (u32x4){hB[0].x, hB[0].y, hB[1].x, hB[1].y}; *(u32x4*)(KHg + tok * pitchK + c8) = (u32x4){hK[0].x, hK[0].y, hK[1].x, hK[1].y}; }
            }
            bsum += __shfl_xor(bsum, 16); bsum += __shfl_xor(bsum, 32);
            if (kq == 0) BON[(size_t)d * T * NH + tok * NH + hd] = bsum;
        } else {
            f32x4 acc[4];
#pragma unroll
            for (int nt = 0; nt < 4; ++nt) acc[nt] = (f32x4){0.f, 0.f, 0.f, 0.f};
#pragma unroll
            for (int ks = 0; ks < 4; ++ks) { const bf16x8 afr = *(const LAS bf16x8*)(lds + tokl * PR_AS + (256 + ks * 32 + kq * 8) * 2);
#pragma unroll
                for (int nt = 0; nt < 4; ++nt) acc[nt] = MFMA16(Fc[ks * 4 + nt], afr, acc[nt]); }
            if (st + 1 < 9) PREP_LOADF(st + 1);
#pragma unroll
            for (int pr = 0; pr < 2; ++pr) { const u32x2 g0 = f32_to_bf4(acc[2 * pr]), g1 = f32_to_bf4(acc[2 * pr + 1]);
                *(u32x4*)((bf16_t*)(a.ws + WS_G) + tok * RW + hd * 64 + 32 * pr + 8 * kq) = (u32x4){g0.x, g0.y, g1.x, g1.y}; }
        }
    }
#undef PREP_LOADF
#undef PREP_CH
}

constexpr int CK = 16, NCHUNK = SEQ / CK, CS_NS = 6;
constexpr int SL_ATIL = 0, SL_RTIL = 2048, SL_BH = 4096, SL_KH = 6144, SL_V = 8192, SL_ULOC = 10240, SL_YLOC = 12288, SL_PC = 14336, SL_BYTES = 14592;
constexpr int PS_IN = 0, PS_AH = 10240, PS_RH = 12288, PS_BYTES = 14336;
constexpr int CS_PS_OFF = CS_NS * SL_BYTES, CS_FLAG_OFF = CS_PS_OFF + 4 * PS_BYTES;
static_assert(CS_FLAG_OFF + 64 <= LDS_BYTES - 64, "chunked scan LDS map");
__device__ __forceinline__ int swz(int t, int j) { return t * 128 + ((((j >> 3) ^ (t & 7))) << 4) + ((j & 4) << 1); }
__device__ __forceinline__ void scan_chunked_unit(const Args& a, LAS unsigned char* lds, int unit) {
    const int tid = threadIdx.x, lane = tid & 63, wave = __builtin_amdgcn_readfirstlane(tid >> 6);
    const int dir = unit & 1, bh = unit >> 1, b = bh / NH, hd = bh % NH;
    const int c16 = lane & 15, q = lane >> 4, qp = c16 >> 2, pp = c16 & 3;
    volatile LAS unsigned* FULL = (volatile LAS unsigned*)(lds + CS_FLAG_OFF);
    volatile LAS unsigned* DONE = FULL + 8;
    float* Yg = (float*)(a.ws + (dir ? WS_YB : WS_YF));
    __syncthreads();
    if (tid < 16) FULL[tid] = 0u;
    __syncthreads();
    if (wave >= 4) {
        const int pw = wave - 4;
        LAS unsigned char* ps = lds + CS_PS_OFF + pw * PS_BYTES;
        const bf16_t* ARR[5] = {(const bf16_t*)scan_arr(a.ws, 1 + 4 * dir), (const bf16_t*)scan_arr(a.ws, 2 + 4 * dir), (const bf16_t*)scan_arr(a.ws, 3 + 4 * dir), (const bf16_t*)scan_arr(a.ws, 4 + 4 * dir), (const bf16_t*)scan_arr(a.ws, 0)};
        const int APITCH[5] = {scan_pitch(1 + 4 * dir), scan_pitch(2 + 4 * dir), scan_pitch(3 + 4 * dir), scan_pitch(4 + 4 * dir), 384};
        const float* PCg = (const float*)(a.ws + WS_PC) + (size_t)dir * (T / 16) * RW + hd * 64 + lane;
#define CS_ISSUE(cc) do { _Pragma("unroll") for (int ar_ = 0; ar_ < 5; ++ar_) _Pragma("unroll") for (int hf_ = 0; hf_ < 2; ++hf_) { \
            const int row_ = hf_ * 8 + (lane >> 3); const int st_ = (cc) * CK + row_; const int t_ = dir ? (SEQ - 1 - st_) : st_; \
            __builtin_amdgcn_global_load_lds((const unsigned*)(ARR[ar_] + ((size_t)b * SEQ + t_) * APITCH[ar_] + hd * 64 + 8 * ((lane & 7) ^ (row_ & 7))), (LAS unsigned*)(ps + PS_IN + ar_ * 2048 + hf_ * 1024), 16, 0, 0); } } while (0)
#define CS_PCLOAD(cc) PCg[(size_t)((size_t)b * (SEQ / CK) + (dir ? (NCHUNK - 1 - (cc)) : (cc))) * RW]
        CS_ISSUE(pw);
        float pcn = CS_PCLOAD(pw);
#pragma unroll 1
        for (int c = pw; c < NCHUNK; c += 4) {
            const int slot = c % CS_NS; LAS unsigned char* sl = lds + slot * SL_BYTES;
            const float pcv = pcn;
            asm volatile("s_waitcnt vmcnt(0)" ::: "memory");
            { unsigned sp = 0; const unsigned want = 4u * (unsigned)(c / CS_NS); while (DONE[slot] < want) { __builtin_amdgcn_s_sleep(1); if (++sp > (1u << 22)) break; } }
            asm volatile("" ::: "memory");
            { const u32x4 x0 = *(const LAS u32x4*)(ps + PS_IN + 0 * 2048 + lane * 16), x1 = *(const LAS u32x4*)(ps + PS_IN + 0 * 2048 + 1024 + lane * 16);
              const u32x4 x2 = *(const LAS u32x4*)(ps + PS_IN + 1 * 2048 + lane * 16), x3 = *(const LAS u32x4*)(ps + PS_IN + 1 * 2048 + 1024 + lane * 16);
              const u32x4 x4 = *(const LAS u32x4*)(ps + PS_IN + 2 * 2048 + lane * 16), x5 = *(const LAS u32x4*)(ps + PS_IN + 2 * 2048 + 1024 + lane * 16);
              const u32x4 x6 = *(const LAS u32x4*)(ps + PS_IN + 3 * 2048 + lane * 16), x7 = *(const LAS u32x4*)(ps + PS_IN + 3 * 2048 + 1024 + lane * 16);
              const u32x4 x8 = *(const LAS u32x4*)(ps + PS_IN + 4 * 2048 + lane * 16), x9 = *(const LAS u32x4*)(ps + PS_IN + 4 * 2048 + 1024 + lane * 16);
              *(LAS u32x4*)(ps + PS_AH + lane * 16) = x0; *(LAS u32x4*)(ps + PS_AH + 1024 + lane * 16) = x1;
              *(LAS u32x4*)(ps + PS_RH + lane * 16) = x2; *(LAS u32x4*)(ps + PS_RH + 1024 + lane * 16) = x3;
              *(LAS u32x4*)(sl + SL_BH + lane * 16) = x4; *(LAS u32x4*)(sl + SL_BH + 1024 + lane * 16) = x5;
              *(LAS u32x4*)(sl + SL_KH + lane * 16) = x6; *(LAS u32x4*)(sl + SL_KH + 1024 + lane * 16) = x7;
              *(LAS u32x4*)(sl + SL_V + lane * 16) = x8; *(LAS u32x4*)(sl + SL_V + 1024 + lane * 16) = x9;
              *(LAS float*)(sl + SL_PC + lane * 4) = pcv; }
            asm volatile("s_waitcnt lgkmcnt(0)" ::: "memory");
            if (c + 4 < NCHUNK) { CS_ISSUE(c + 4); pcn = CS_PCLOAD(c + 4); }
            bf16x8 AHf[2], BHf[2], KHf[2], RHf[2];
#pragma unroll
            for (int ks = 0; ks < 2; ++ks) { const int o = swz(c16, 32 * ks + 8 * q);
                AHf[ks] = *(const LAS bf16x8*)(ps + PS_AH + o); RHf[ks] = *(const LAS bf16x8*)(ps + PS_RH + o); BHf[ks] = *(const LAS bf16x8*)(sl + SL_BH + o); KHf[ks] = *(const LAS bf16x8*)(sl + SL_KH + o); }
            f32x4 Mab = {0.f, 0.f, 0.f, 0.f}, Mak = Mab, MrbT = Mab, MrkT = Mab, MabT = Mab;
#pragma unroll
            for (int ks = 0; ks < 2; ++ks) { Mab = MFMA16(AHf[ks], BHf[ks], Mab); MabT = MFMA16(BHf[ks], AHf[ks], MabT); Mak = MFMA16(AHf[ks], KHf[ks], Mak); MrbT = MFMA16(BHf[ks], RHf[ks], MrbT); MrkT = MFMA16(KHf[ks], RHf[ks], MrkT); }
#pragma unroll
            for (int r = 0; r < 4; ++r) { const bool lt = c16 < 4 * q + r, gt = 4 * q + r < c16, le = 4 * q + r <= c16;
                Mab[r] = lt ? Mab[r] : 0.f; Mak[r] = lt ? Mak[r] : 0.f; MabT[r] = gt ? MabT[r] : 0.f; MrbT[r] = le ? MrbT[r] : 0.f; MrkT[r] = le ? MrkT[r] : 0.f; }
            const f32x4 z4 = {0.f, 0.f, 0.f, 0.f};
            const bf16x8 fN = frag_lo4(Mab), fNT = frag_lo4(MabT);
            const f32x4 N2 = MFMA16(fNT, fN, z4), N2T = MFMA16(fN, fNT, z4);
            f32x4 PT = MabT;
#pragma unroll
            for (int r = 0; r < 4; ++r) PT[r] += (4 * q + r == c16) ? 1.0f : 0.f;
            const bf16x8 fN2 = frag_lo4(N2), fN2T = frag_lo4(N2T);
            PT = MFMA16(fN2, frag_lo4(PT), PT);
            const f32x4 N4 = MFMA16(fN2T, fN2, z4), N4T = MFMA16(fN2, fN2T, z4);
            const bf16x8 fN4 = frag_lo4(N4), fN4T = frag_lo4(N4T);
            PT = MFMA16(fN4, frag_lo4(PT), PT);
            const f32x4 N8 = MFMA16(fN4T, fN4, z4);
            PT = MFMA16(frag_lo4(N8), frag_lo4(PT), PT);
            const bf16x8 LinvF = frag_lo4(PT);
            const bf16x8 MakF = frag_lo4(Mak), MrbTF = frag_lo4(MrbT);
            const f32x4 W1 = MFMA16(LinvF, MakF, z4);
            const f32x4 W1T = MFMA16(MakF, LinvF, z4);
            const f32x4 W2T = MFMA16(frag_lo4(W1), MrbTF, MrkT);
            f32x4 AtT[4], RtT[4];
#pragma unroll
            for (int jt = 0; jt < 4; ++jt) {
                const bf16x8 ahF = frag_cat(__builtin_bit_cast(u32x2, tr_read16(ps + PS_AH + swz(4 * q + qp, 16 * jt + 4 * pp))), (u32x2){0u, 0u});
                const f32x4 AtN = MFMA16(LinvF, ahF, z4);
                AtT[jt] = MFMA16(ahF, LinvF, z4);
                const f32x4 rinit = bf4_to_f32(*(const LAS u32x2*)(ps + PS_RH + swz(c16, 16 * jt + 4 * q)));
                RtT[jt] = MFMA16(frag_lo4(AtN), MrbTF, rinit);
            }
#pragma unroll
            for (int ks = 0; ks < 2; ++ks) {
                const u32x4 wa = {pk_bf16(AtT[2 * ks][0], AtT[2 * ks][1]), pk_bf16(AtT[2 * ks][2], AtT[2 * ks][3]), pk_bf16(AtT[2 * ks + 1][0], AtT[2 * ks + 1][1]), pk_bf16(AtT[2 * ks + 1][2], AtT[2 * ks + 1][3])};
                const u32x4 wr = {pk_bf16(RtT[2 * ks][0], RtT[2 * ks][1]), pk_bf16(RtT[2 * ks][2], RtT[2 * ks][3]), pk_bf16(RtT[2 * ks + 1][0], RtT[2 * ks + 1][1]), pk_bf16(RtT[2 * ks + 1][2], RtT[2 * ks + 1][3])};
                *(LAS u32x4*)(sl + SL_ATIL + ks * 1024 + lane * 16) = wa; *(LAS u32x4*)(sl + SL_RTIL + ks * 1024 + lane * 16) = wr; }
            const bf16x8 W1TF = frag_lo4(W1T), W2TF = frag_lo4(W2T);
#pragma unroll
            for (int nt = 0; nt < 4; ++nt) { const bf16x8 vB = frag_cat(__builtin_bit_cast(u32x2, tr_read16(sl + SL_V + swz(4 * q + qp, 16 * nt + 4 * pp))), (u32x2){0u, 0u});
                const f32x4 ul = MFMA16(W1TF, vB, z4), yl = MFMA16(W2TF, vB, z4);
                *(LAS u32x2*)(sl + SL_ULOC + nt * 512 + lane * 8) = f32_to_bf4(ul); *(LAS u32x2*)(sl + SL_YLOC + nt * 512 + lane * 8) = f32_to_bf4(yl); }
            asm volatile("s_waitcnt lgkmcnt(0)" ::: "memory");
            if (lane == 0) FULL[slot] = (unsigned)(c + 1);
        }
#undef CS_ISSUE
#undef CS_PCLOAD
    } else {
        const int nt = wave;
        f32x4 S[4];
#pragma unroll
        for (int mt = 0; mt < 4; ++mt) S[mt] = (f32x4){0.f, 0.f, 0.f, 0.f};
#pragma unroll 1
        for (int c = 0; c < NCHUNK; ++c) {
            const int slot = c % CS_NS; LAS unsigned char* sl = lds + slot * SL_BYTES;
            { unsigned sp = 0; while (FULL[slot] < (unsigned)(c + 1)) { __builtin_amdgcn_s_sleep(1); if (++sp > (1u << 22)) break; } }
            asm volatile("" ::: "memory");
            const bf16x8 at0 = *(const LAS bf16x8*)(sl + SL_ATIL + lane * 16), at1 = *(const LAS bf16x8*)(sl + SL_ATIL + 1024 + lane * 16);
            const bf16x8 rt0 = *(const LAS bf16x8*)(sl + SL_RTIL + lane * 16), rt1 = *(const LAS bf16x8*)(sl + SL_RTIL + 1024 + lane * 16);
            const u32x2 ulw = *(const LAS u32x2*)(sl + SL_ULOC + nt * 512 + lane * 8), ylw = *(const LAS u32x2*)(sl + SL_YLOC + nt * 512 + lane * 8);
            const u32x2 vfw = __builtin_bit_cast(u32x2, tr_read16(sl + SL_V + swz(4 * q + qp, 16 * nt + 4 * pp)));
            f32x4 pc[4]; bf16x8 bk[4];
#pragma unroll
            for (int mt = 0; mt < 4; ++mt) { pc[mt] = *(const LAS f32x4*)(sl + SL_PC + (16 * mt + 4 * q) * 4);
                bk[mt] = frag_cat(__builtin_bit_cast(u32x2, tr_read16(sl + SL_BH + swz(4 * q + qp, 16 * mt + 4 * pp))), __builtin_bit_cast(u32x2, tr_read16(sl + SL_KH + swz(4 * q + qp, 16 * mt + 4 * pp)))); }
            const bf16x8 Sb0 = frag_cat(f32_to_bf4(S[0]), f32_to_bf4(S[1])), Sb1 = frag_cat(f32_to_bf4(S[2]), f32_to_bf4(S[3]));
            f32x4 UT = bf4_to_f32(ulw), YT = bf4_to_f32(ylw);
            UT = MFMA16(at0, Sb0, UT); UT = MFMA16(at1, Sb1, UT);
            YT = MFMA16(rt0, Sb0, YT); YT = MFMA16(rt1, Sb1, YT);
            const bf16x8 Ub = frag_cat(f32_to_bf4(UT), vfw);
#pragma unroll
            for (int mt = 0; mt < 4; ++mt) { S[mt] = MFMA16(bk[mt], Ub, S[mt]); S[mt] = S[mt] * pc[mt]; }
#pragma unroll
            for (int r = 0; r < 4; ++r) { const int st_ = c * CK + 4 * q + r; const int t_ = dir ? (SEQ - 1 - st_) : st_; Yg[((size_t)b * SEQ + t_) * RW + hd * 64 + 16 * nt + c16] = YT[r]; }
            asm volatile("s_waitcnt lgkmcnt(0)" ::: "memory");
            if (lane == 0) (void)__hip_atomic_fetch_add((LAS unsigned*)&DONE[slot], 1u, __ATOMIC_RELAXED, __HIP_MEMORY_SCOPE_WORKGROUP);
        }
    }
}

__device__ __forceinline__ void phase_post(const Args& a, int G) {
    const int tid = threadIdx.x, lane = tid & 63, wave = __builtin_amdgcn_readfirstlane(tid >> 6);
    const int gw = blockIdx.x * 8 + wave, NGW = G * 8, q = lane >> 4, l16 = lane & 15;
    const float* __restrict__ YF = (const float*)(a.ws + WS_YF); const float* __restrict__ YB = (const float*)(a.ws + WS_YB); const float* __restrict__ BON = (const float*)(a.ws + WS_BON);
    const bf16_t* __restrict__ Vg = (const bf16_t*)scan_arr(a.ws, 0); const bf16_t* __restrict__ Gg = (const bf16_t*)(a.ws + WS_G); bf16_t* __restrict__ MIX = (bf16_t*)(a.ws + WS_MIX);
    float* ss = (float*)(a.ws + WS_SS);
    for (int i = blockIdx.x * NTHREADS + tid; i < T; i += G * NTHREADS) ss[i] = 0.f;
    constexpr int NIT = T * NH / 4;
#pragma unroll 4
    for (int it = gw; it < NIT; it += NGW) {
        const int hr = 4 * it + q, tok = hr / NH, hd = hr - tok * NH; const size_t e = (size_t)hr * 64 + 4 * l16;
        const f32x4 yf = *(const f32x4*)(YF + e), yb = *(const f32x4*)(YB + e);
        const u32x2 vh = *(const u32x2*)(Vg + e); const u32x2 gw2 = *(const u32x2*)(Gg + e);
        const float bon = BON[hr] + BON[(size_t)T * NH + hr];
        const f32x4 lg = *(const f32x4*)(a.in[I_LNXG] + hd * 64 + 4 * l16), lb = *(const f32x4*)(a.in[I_LNXB] + hd * 64 + 4 * l16);
        const f32x4 y = yf + yb;
        const float mean = sum16((y.x + y.y) + (y.z + y.w)) * (1.f / 64.f);
        const f32x4 d = y - mean;
        const float var = sum16((d.x * d.x + d.y * d.y) + (d.z * d.z + d.w * d.w)) * (1.f / 64.f);
        const float rstd = 1.0f / sqrtf(var + 64e-5f);
        const f32x4 vv = bf4_to_f32(vh);
        const f32x4 gv = {bf_lo(gw2.x), bf_hi(gw2.x), bf_lo(gw2.y), bf_hi(gw2.y)};
        const f32x4 o = (d * rstd * lg + lb + vv * bon) * gv;
        u32x2 w; w.x = pk_bf16(o.x, o.y); w.y = pk_bf16(o.z, o.w);
        *(u32x2*)(MIX + (size_t)tok * D + 640 + hd * 64 + 4 * l16) = w;
    }
}

constexpr int RT_WS = 2064;
__device__ __forceinline__ void phase_router(const Args& a, LAS unsigned char* lds, int G) {
    const int tid = threadIdx.x, lane = tid & 63, wave = __builtin_amdgcn_readfirstlane(tid >> 6);
    const int gw = blockIdx.x * 8 + wave, NGW = G * 8, l15 = lane & 15, kq = lane >> 4;
    LAS bf16_t* WH = (LAS bf16_t*)lds; LAS bf16_t* WL = (LAS bf16_t*)(lds + 16 * RT_WS);
    for (int i = tid; i < D * NE; i += NTHREADS) { const int k = i >> 4, e = i & 15; const float w = a.in[I_WROUTER][i];
        const unsigned hi = pk_bf16(w, 0.f) & 0xffffu; const float rem = w - bf_lo(hi);
        WH[e * (RT_WS / 2) + k] = (bf16_t)hi; WL[e * (RT_WS / 2) + k] = (bf16_t)(pk_bf16(rem, 0.f) & 0xffffu); }
    __syncthreads();
    const float* __restrict__ X1 = (const float*)(a.ws + WS_X1); const float* __restrict__ ss = (const float*)(a.ws + WS_SS); bf16_t* __restrict__ H2 = (bf16_t*)(a.ws + WS_H2);
    float* __restrict__ AFF = (float*)(a.ws + WS_AFF); int* __restrict__ INV = (int*)(a.ws + WS_INV);
    const float* __restrict__ GF = a.in[I_NFFNG];
    for (int grp = gw; grp < T / 16; grp += NGW) {
        const int tok = grp * 16 + l15;
        const float rs = 1.0f / sqrtf(ss[tok] * (1.f / D) + 1e-6f);
        f32x4 acc = {0.f, 0.f, 0.f, 0.f};
        const float* xrow = X1 + (size_t)tok * D + 8 * kq; bf16_t* hrow = H2 + (size_t)tok * D + 8 * kq;
#pragma unroll 8
        for (int ks = 0; ks < 32; ++ks) {
            const f32x4 x0 = *(const f32x4*)(xrow + 32 * ks), x1v = *(const f32x4*)(xrow + 32 * ks + 4);
            const f32x4 g0 = *(const f32x4*)(GF + 32 * ks + 8 * kq), g1 = *(const f32x4*)(GF + 32 * ks + 8 * kq + 4);
            const f32x4 h0 = x0 * rs * g0, h1 = x1v * rs * g1;
            u32x4 hi; hi.x = pk_bf16(h0.x, h0.y); hi.y = pk_bf16(h0.z, h0.w); hi.z = pk_bf16(h1.x, h1.y); hi.w = pk_bf16(h1.z, h1.w);
            *(u32x4*)(hrow + 32 * ks) = hi;
            u32x4 lo; lo.x = pk_bf16(h0.x - bf_lo(hi.x), h0.y - bf_hi(hi.x)); lo.y = pk_bf16(h0.z - bf_lo(hi.y), h0.w - bf_hi(hi.y));
            lo.z = pk_bf16(h1.x - bf_lo(hi.z), h1.y - bf_hi(hi.z)); lo.w = pk_bf16(h1.z - bf_lo(hi.w), h1.w - bf_hi(hi.w));
            const bf16x8 ah = __builtin_bit_cast(bf16x8, hi), al = __builtin_bit_cast(bf16x8, lo);
            const bf16x8 bh = *(const LAS bf16x8*)(lds + l15 * RT_WS + (32 * ks + 8 * kq) * 2), bl = *(const LAS bf16x8*)(lds + 16 * RT_WS + l15 * RT_WS + (32 * ks + 8 * kq) * 2);
            acc = __builtin_amdgcn_mfma_f32_16x16x32_bf16(ah, bh, acc, 0, 0, 0);
            acc = __builtin_amdgcn_mfma_f32_16x16x32_bf16(al, bh, acc, 0, 0, 0);
            acc = __builtin_amdgcn_mfma_f32_16x16x32_bf16(ah, bl, acc, 0, 0, 0);
        }
#pragma unroll
        for (int rg = 0; rg < 4; ++rg) { const float mx = max16(acc[rg]); const float ex = __expf(acc[rg] - mx); const float sm = sum16(ex);
            const int t2 = grp * 16 + 4 * kq + rg, bb = t2 >> 12, sq = t2 & (SEQ - 1);
            AFF[((size_t)(bb * NE + l15)) * SEQ + sq] = ex / sm; }
        *(u32x4*)(INV + (size_t)grp * 256 + 4 * lane) = (u32x4){0xffffffffu, 0xffffffffu, 0xffffffffu, 0xffffffffu};
    }
}

__device__ __forceinline__ void topk_unit(const Args& a, LAS unsigned char* lds, int unit) {
    const int tid = threadIdx.x, lane = tid & 63, wave = __builtin_amdgcn_readfirstlane(tid >> 6);
    const int b = unit >> 4, e = unit & 15;
    const float* AFF = (const float*)(a.ws + WS_AFF) + (size_t)unit * SEQ;
    LAS unsigned* KEY = (LAS unsigned*)lds;
    LAS unsigned* HIST = (LAS unsigned*)(lds + 16384);
    LAS unsigned* CTL = (LAS unsigned*)(lds + 16384 + 1024);
    LAS unsigned* WS_ = (LAS unsigned*)(lds + 16384 + 2048);
    __syncthreads();
    unsigned key[8];
    { const u32x4 k0 = *(const u32x4*)(AFF + tid * 8), k1 = *(const u32x4*)(AFF + tid * 8 + 4); key[0] = k0.x; key[1] = k0.y; key[2] = k0.z; key[3] = k0.w; key[4] = k1.x; key[5] = k1.y; key[6] = k1.z; key[7] = k1.w; }
    if (tid == 0) { CTL[0] = 0u; CTL[1] = (unsigned)CAP; }
    unsigned prefix = 0u, mask = 0u;
#pragma unroll 1
    for (int pass = 0; pass < 4; ++pass) {
        const int shift = 24 - 8 * pass;
        if (tid < 256) HIST[tid] = 0u;
        __syncthreads();
#pragma unroll
        for (int i = 0; i < 8; ++i) if ((key[i] & mask) == prefix) (void)__hip_atomic_fetch_add(&HIST[(key[i] >> shift) & 255u], 1u, __ATOMIC_RELAXED, __HIP_MEMORY_SCOPE_WORKGROUP);
        __syncthreads();
        if (wave == 0) {
            const unsigned need = CTL[1];
            unsigned hv[4], tsum = 0u;
#pragma unroll
            for (int i = 0; i < 4; ++i) { hv[i] = HIST[255 - (4 * lane + i)]; tsum += hv[i]; }
            unsigned inc = tsum;
#pragma unroll
            for (int o = 1; o < 64; o <<= 1) { const unsigned v = __shfl_up(inc, o); if (lane >= o) inc += v; }
            unsigned exc = inc - tsum;
            if (exc < need && need <= inc) {
                unsigned run = exc; int di = 0;
#pragma unroll
                for (int i = 0; i < 4; ++i) { if (run < need && need <= run + hv[i]) { di = i; break; } run += hv[i]; }
                const unsigned digit = 255u - (unsigned)(4 * lane + di);
                CTL[0] = prefix | (digit << shift); CTL[1] = need - run;
            }
        }
        __syncthreads();
        prefix = CTL[0]; mask |= (255u << shift);
    }
    const unsigned thr = prefix, need_eq = CTL[1];
    unsigned ngt = 0u, neq = 0u;
#pragma unroll
    for (int i = 0; i < 8; ++i) { ngt += (key[i] > thr) ? 1u : 0u; neq += (key[i] == thr) ? 1u : 0u; }
    unsigned pk = ngt | (neq << 16), inc = pk;
#pragma unroll
    for (int o = 1; o < 64; o <<= 1) { const unsigned v = __shfl_up(inc, o); if (lane >= o) inc += v; }
    if (lane == 63) WS_[wave] = inc;
    __syncthreads();
    unsigned woff = 0u, tot = 0u;
#pragma unroll
    for (int w = 0; w < 8; ++w) { const unsigned v = WS_[w]; if (w < wave) woff += v; tot += v; }
    const unsigned exc = inc - pk + woff;
    unsigned gpos = exc & 0xffffu, epos = exc >> 16; const unsigned totgt = tot & 0xffffu;
    const int sbase = (e * BATCH + b) * CAP;
    int* ROWTOK = (int*)(a.ws + WS_ROWTOK); float* ROWGATE = (float*)(a.ws + WS_ROWGATE); int* INV = (int*)(a.ws + WS_INV);
#pragma unroll
    for (int i = 0; i < 8; ++i) {
        int pos = -1;
        if (key[i] > thr) pos = (int)gpos++;
        else if (key[i] == thr) { if (epos < need_eq) pos = (int)(totgt + epos); epos++; }
        if (pos >= 0) { const int s = tid * 8 + i, tok = b * SEQ + s, slot = sbase + pos;
            ROWTOK[slot] = tok; ROWGATE[slot] = __builtin_bit_cast(float, key[i]); INV[(size_t)tok * NE + e] = slot; }
    }
}

__device__ __forceinline__ void phase_final(const Args& a, int G) {
    const int tid = threadIdx.x, lane = tid & 63, wave = __builtin_amdgcn_readfirstlane(tid >> 6);
    const int gw = blockIdx.x * 8 + wave, NGW = G * 8;
    const float* __restrict__ X1 = (const float*)(a.ws + WS_X1); const bf16_t* __restrict__ YE = (const bf16_t*)(a.ws + WS_YE); const int* __restrict__ INV = (const int*)(a.ws + WS_INV);
    float* __restrict__ OUT = a.out;
    f32x4 gg[4];
#pragma unroll
    for (int j = 0; j < 4; ++j) gg[j] = *(const f32x4*)(a.in[I_FNG] + 4 * lane + 256 * j);
    int tok = gw;
    int invn = (tok < T) ? INV[(size_t)tok * NE + (lane & 15)] : -1;
    f32x4 xn[4];
#pragma unroll
    for (int j = 0; j < 4; ++j) xn[j] = (tok < T) ? *(const f32x4*)(X1 + (size_t)tok * D + 4 * lane + 256 * j) : (f32x4){0.f, 0.f, 0.f, 0.f};
    for (; tok < T; tok += NGW) {
        const int invc = invn; f32x4 v[4];
#pragma unroll
        for (int j = 0; j < 4; ++j) v[j] = xn[j];
        const int tn = tok + NGW;
        if (tn < T) { invn = INV[(size_t)tn * NE + (lane & 15)];
#pragma unroll
            for (int j = 0; j < 4; ++j) xn[j] = *(const f32x4*)(X1 + (size_t)tn * D + 4 * lane + 256 * j); }
        unsigned long long m = __ballot(invc >= 0) & 0xffffull;
        const int n = __builtin_popcountll(m);
        int sl[4]; float wt[4];
#pragma unroll
        for (int k = 0; k < 4; ++k) { int e = 0; if (m) { e = __builtin_ctzll(m); m &= m - 1; wt[k] = 1.f; sl[k] = __builtin_amdgcn_readlane(invc, e); } else { wt[k] = 0.f; sl[k] = 0; } }
        u32x2 rw[4][4];
#pragma unroll
        for (int k = 0; k < 4; ++k)
#pragma unroll
            for (int j = 0; j < 4; ++j) rw[k][j] = *(const u32x2*)(YE + (size_t)sl[k] * D + 4 * lane + 256 * j);
#pragma unroll
        for (int k = 0; k < 4; ++k)
#pragma unroll
            for (int j = 0; j < 4; ++j) { v[j].x += wt[k] * bf_lo(rw[k][j].x); v[j].y += wt[k] * bf_hi(rw[k][j].x); v[j].z += wt[k] * bf_lo(rw[k][j].y); v[j].w += wt[k] * bf_hi(rw[k][j].y); }
        if (n > 4) { while (m) { const int e = __builtin_ctzll(m); m &= m - 1; const int slot = __builtin_amdgcn_readlane(invc, e);
#pragma unroll
                for (int j = 0; j < 4; ++j) { const u32x2 w = *(const u32x2*)(YE + (size_t)slot * D + 4 * lane + 256 * j);
                    v[j].x += bf_lo(w.x); v[j].y += bf_hi(w.x); v[j].z += bf_lo(w.y); v[j].w += bf_hi(w.y); } } }
        float sq = 0.f;
#pragma unroll
        for (int j = 0; j < 4; ++j) sq += (v[j].x * v[j].x + v[j].y * v[j].y) + (v[j].z * v[j].z + v[j].w * v[j].w);
        float rs = 1.0f / sqrtf(wave_sum(sq) * (1.f / D) + 1e-6f);
#pragma unroll
        for (int j = 0; j < 4; ++j) *(f32x4*)(OUT + (size_t)tok * D + 4 * lane + 256 * j) = v[j] * rs * gg[j];
    }
}

#define XB_TMO      128
#define XB_XCNT(j)  (256  + 64 * (j))
#define XB_XSUB(j)  (1280 + 64 * (j))
#define XB_XGEN(j)  (2304 + 64 * (j))
#define XB_TOP      3328
#define XB_TOPGEN   3392
#define XCD_BAR_WORDS 3456
#define XB_SPIN_CAP (1u << 22)
__device__ __forceinline__ unsigned xb_ld(unsigned* p)              { return __hip_atomic_load(p, __ATOMIC_RELAXED, __HIP_MEMORY_SCOPE_AGENT); }
__device__ __forceinline__ unsigned xb_add(unsigned* p, unsigned v) { return __hip_atomic_fetch_add(p, v, __ATOMIC_RELAXED, __HIP_MEMORY_SCOPE_AGENT); }
__device__ __forceinline__ unsigned xb_xcc_id() { return (unsigned)__builtin_amdgcn_s_getreg((3 << 11) | 20) & 0xFu; }
#define XB_SPIN(cond, bar) do { unsigned _sp = 0; while (cond) { __builtin_amdgcn_s_sleep(1); \
    if ((++_sp & 255u) == 0u) { if (xb_ld(&(bar)[XB_TMO])) break; if (_sp > XB_SPIN_CAP) { atomicAdd(&(bar)[XB_TMO], 1u); break; } } } } while (0)
struct XcdBarrier { unsigned* bar; unsigned x; volatile LAS unsigned* st; };
__device__ __forceinline__ XcdBarrier xcd_barrier_post(unsigned* bar, volatile LAS unsigned* st) {
    XcdBarrier b; b.bar = bar; b.x = xb_xcc_id(); b.st = st;
    if (threadIdx.x == 0) (void)xb_add(&bar[XB_XCNT(b.x)], 1u);
    return b;
}
__device__ __forceinline__ void xcd_barrier_complete(unsigned* bar, unsigned x, unsigned& nloc, unsigned& nx) {
    const unsigned G = gridDim.x * gridDim.y * gridDim.z;
    unsigned sum, cnt, mine, sp = 0u;
    for (;;) {
        sum = 0u; cnt = 0u; mine = 0u;
#pragma unroll
        for (unsigned j = 0; j < 16; ++j) { const unsigned c = xb_ld(&bar[XB_XCNT(j)]); sum += c; cnt += (c > 0u) ? 1u : 0u; mine = (j == x) ? c : mine; }
        if (sum == G) break;
        __builtin_amdgcn_s_sleep(1);
        if ((++sp & 255u) == 0u) { if (xb_ld(&bar[XB_TMO])) break; if (sp > XB_SPIN_CAP) { atomicAdd(&bar[XB_TMO], 1u); break; } }
    }
    nloc = mine > 0u ? mine : 1u; nx = cnt > 0u ? cnt : 1u;
}
__device__ __forceinline__ void xcd_barrier(const XcdBarrier& b) {
    asm volatile("s_waitcnt vmcnt(0)" ::: "memory");
    __syncthreads();
    if (threadIdx.x == 0) {
        unsigned* bar = b.bar;
        __builtin_amdgcn_s_waitcnt(0);
        unsigned nloc = b.st[0], nx = b.st[1];
        if (nloc == 0u) { xcd_barrier_complete(bar, b.x, nloc, nx); b.st[0] = nloc; b.st[1] = nx; }
        const unsigned old = xb_add(&bar[XB_XSUB(b.x)], 1u);
        const unsigned gen = old / nloc;
        if (old + 1u == (gen + 1u) * nloc) {
            __builtin_amdgcn_fence(__ATOMIC_RELEASE, "agent");
            asm volatile("s_waitcnt vmcnt(0)" ::: "memory");
            const unsigned og = xb_add(&bar[XB_TOP], 1u);
            const unsigned tg = og / nx;
            if (og + 1u == (tg + 1u) * nx) xb_add(&bar[XB_TOPGEN], 1u);
            else XB_SPIN(xb_ld(&bar[XB_TOPGEN]) == tg, bar);
            __builtin_amdgcn_fence(__ATOMIC_ACQUIRE, "agent");
            xb_add(&bar[XB_XGEN(b.x)], 1u);
            asm volatile("s_waitcnt vmcnt(0)" ::: "memory");
        } else {
            XB_SPIN(xb_ld(&bar[XB_XGEN(b.x)]) == gen, bar);
            __builtin_amdgcn_fence(__ATOMIC_ACQUIRE, "agent");
            asm volatile("s_waitcnt vmcnt(0)" ::: "memory");
        }
    }
    __syncthreads();
}

#ifndef PH_MASK
#define PH_MASK 0x7ff
#endif
#ifndef REP_MASK
#define REP_MASK 0
#endif
#ifndef P2_MASK
#define P2_MASK 7
#endif
#ifndef P2_REP
#define P2_REP 0
#endif
constexpr int LDS_MISC = LDS_BYTES - 64;
constexpr size_t WS_CTL = 0, CTL_BYTES = 16384;
__global__ void __launch_bounds__(NTHREADS, 2) mega(Args a) {
    extern __shared__ __attribute__((aligned(16))) unsigned char lds_raw[];
    LAS unsigned char* lds = (LAS unsigned char*)lds_raw;
    cg::grid_group grid = cg::this_grid();
    const int G = gridDim.x, lo = a.ph_lo, hi = a.ph_hi;
    unsigned char* ws = a.ws;
    volatile LAS unsigned* misc = (volatile LAS unsigned*)(lds + LDS_MISC);
    if (threadIdx.x < 16) misc[threadIdx.x] = 0u;
    __syncthreads();
    XcdBarrier xbar = xcd_barrier_post((unsigned*)(ws + WS_CTL), misc);
#define IN(k) (((PH_MASK >> (k)) & 1) && lo <= (k) && (k) < hi)
#define NREP(k) (1 + ((REP_MASK >> (k)) & 1))
#define PHASE(k, ...) do { if (IN(k)) { for (int rep_ = 0; rep_ < NREP(k); ++rep_) { __VA_ARGS__; if (rep_ + 1 < NREP(k) || IN((k) + 1)) { if ((k) == 0 && rep_ + 1 == NREP(k)) grid.sync(); else xcd_barrier(xbar); } } } } while (0)

    PHASE(0, phase_prep(a, lds, G));

    PHASE(1, {
        pg8::Gemm g{(const bf16_t*)(ws + WS_XH), (const bf16_t*)(ws + WS_WINT), T, IN_PROJ, D};
        pg8::TripleOrder S; S.S0.init(T, IN_PROJ, G, 0); S.A1 = (const bf16_t*)(ws + WS_MEMN); S.B1 = (const bf16_t*)(ws + WS_WKT); S.A2 = (const bf16_t*)(ws + WS_WVT); S.B2 = (const bf16_t*)(ws + WS_MEMN);
        S.n1 = BATCH * NMEM / 256; S.n2 = BATCH * NMEM / 256; S.G = G; S.c = (int)blockIdx.x;
        pg8::EpiBf16x3 E{pg8::EpiBf16{(bf16_t*)(ws + WS_P), PLD, (bf16_t*)(ws + WS_Q)}, pg8::EpiBf16{(bf16_t*)(ws + WS_KMEM), 256, nullptr}, pg8::EpiBf16{(bf16_t*)(ws + WS_VT), BATCH * NMEM, nullptr}};
        pg8::gemm_phase<pg8::EpiBf16x3, pg8::TripleOrder, false>(lds, g, S, E, nullptr);
    });

    constexpr int NSCAN = BATCH * NH * 2;
    PHASE(2, {
        for (int u = blockIdx.x; u < 2048; u += G) {
            if (u < 1024) { for (int r2 = 0; r2 < 1 + ((P2_REP >> 1) & 1); ++r2) conv_unit(a, lds, u); }
            else { for (int r2 = 0; r2 < 1 + ((P2_REP >> 2) & 1); ++r2) prep_unit(a, lds, u - 1024); }
        }
    });

    PHASE(3, {
        int bid = blockIdx.x; int Gp = G; asm volatile("" : "+s"(bid), "+s"(Gp));
        for (int u = bid; u < NSCAN; u += Gp) scan_chunked_unit(a, lds, u);
        if (rep_ == 0) {
            if (Gp > NSCAN) { if (bid >= NSCAN) { for (int u = bid - NSCAN; u < 1024; u += Gp - NSCAN) for (int r2 = 0; r2 < 1 + (P2_REP & 1); ++r2) attn_unit(a, lds, u);
                                                 } }
            else { for (int u = bid; u < 1024; u += Gp) attn_unit(a, lds, u); }
        }
    });

    PHASE(4, phase_post(a, G));

    PHASE(5, {
        pg8::Gemm g{(const bf16_t*)(ws + WS_MIX), (const bf16_t*)(ws + WS_WOUTT), T, D, D}; pg8::StaticOrder S; S.init(T, D, G, (int)blockIdx.x);
        pg8::EpiResidSS E{a.in[I_X], (float*)(ws + WS_X1), (float*)(ws + WS_SS)}; pg8::gemm_phase<pg8::EpiResidSS, pg8::StaticOrder, false>(lds, g, S, E, nullptr);
    });

    PHASE(6, phase_router(a, lds, G));

    PHASE(7, { for (int u = blockIdx.x; u < BATCH * NE; u += G) topk_unit(a, lds, u); });

    PHASE(8, {
        pg8::Gemm g{(const bf16_t*)(ws + WS_H2), (const bf16_t*)(ws + WS_WGUT), NSLOT, 2048, D}; pg8::ExpertOrder S; S.init(32, 8, NE, G, (int)blockIdx.x);
        pg8::EpiSwiGLU E{(bf16_t*)(ws + WS_HID)}; pg8::gemm_phase<pg8::EpiSwiGLU, pg8::ExpertOrder, true>(lds, g, S, E, (const int*)(ws + WS_ROWTOK));
    });

    PHASE(9, {
        pg8::Gemm g{(const bf16_t*)(ws + WS_HID), (const bf16_t*)(ws + WS_WDT), NSLOT, D, FF}; pg8::ExpertOrder S; S.init(32, 4, NE, G, (int)blockIdx.x);
        pg8::EpiGateScale E{(bf16_t*)(ws + WS_YE), (const float*)(ws + WS_ROWGATE)}; pg8::gemm_phase<pg8::EpiGateScale, pg8::ExpertOrder, false>(lds, g, S, E, nullptr);
    });

    PHASE(10, phase_final(a, G));
#undef IN
#undef NREP
#undef PHASE
}

#ifndef MK_ONE_LAUNCH
#define MK_ONE_LAUNCH 1
#endif
extern "C" void kernel_launch(void* const* d_in, const int* in_sizes, int n_in, void* d_out, int out_size, void* d_ws, size_t ws_size, hipStream_t stream) {
    static int grid_blocks = 0;
    if (grid_blocks == 0) {
        if (n_in != 29 || out_size != T * D || ws_size < WS_END) { fprintf(stderr, "kernel_launch: unexpected problem: n_in %d out %d ws %zu (need %zu)\n", n_in, out_size, ws_size, (size_t)WS_END); grid_blocks = -1; return; }
        int dev = 0, cus = 0, per_cu = 0;
        if (hipGetDevice(&dev) != hipSuccess || hipDeviceGetAttribute(&cus, hipDeviceAttributeMultiprocessorCount, dev) != hipSuccess) { grid_blocks = -1; return; }
        if (hipFuncSetAttribute((const void*)mega, hipFuncAttributeMaxDynamicSharedMemorySize, LDS_BYTES) != hipSuccess) { fprintf(stderr, "kernel_launch: hipFuncSetAttribute failed\n"); grid_blocks = -1; return; }
        if (hipOccupancyMaxActiveBlocksPerMultiprocessor(&per_cu, (const void*)mega, NTHREADS, LDS_BYTES) != hipSuccess || per_cu < 1) { fprintf(stderr, "kernel_launch: occupancy query says %d blocks per CU\n", per_cu); grid_blocks = -1; return; }
        grid_blocks = cus;
    }
    if (grid_blocks < 0) return;
    if (hipMemsetAsync((char*)d_ws + WS_CTL, 0, CTL_BYTES, stream) != hipSuccess) { fprintf(stderr, "kernel_launch: memset failed\n"); return; }
    Args a{};
    for (int i = 0; i < 29; ++i) a.in[i] = (const float*)d_in[i];
    a.out = (float*)d_out; a.ws = (unsigned char*)d_ws;
#if MK_ONE_LAUNCH
    a.ph_lo = 0; a.ph_hi = NPHASE;
    { void* args[] = {&a}; hipError_t e = hipLaunchCooperativeKernel((const void*)mega, dim3(grid_blocks), dim3(NTHREADS), args, LDS_BYTES, stream);
      if (e != hipSuccess) fprintf(stderr, "cooperative launch failed: %s (grid %d)\n", hipGetErrorString(e), grid_blocks); }
#else
    for (int ph = 0; ph < NPHASE; ++ph) { a.ph_lo = ph; a.ph_hi = ph + 1; void* args[] = {&a};
        hipError_t e = hipLaunchCooperativeKernel((const void*)mega, dim3(grid_blocks), dim3(NTHREADS), args, LDS_BYTES, stream);
        if (e != hipSuccess) { fprintf(stderr, "cooperative launch %d failed: %s (grid %d)\n", ph, hipGetErrorString(e), grid_blocks); break; } }
#endif
}
```

```cpp
#include <hip/hip_runtime.h>
#include <hip/hip_cooperative_groups.h>
#include <cstdio>
#include <cstdint>
namespace cg = cooperative_groups;

#define LAS __attribute__((address_space(3)))
typedef unsigned short bf16_t;
typedef short bf16x8 __attribute__((ext_vector_type(8)));
typedef short s16x4 __attribute__((ext_vector_type(4)));
typedef float f32x2 __attribute__((ext_vector_type(2)));
typedef float f32x4 __attribute__((ext_vector_type(4)));
typedef float f32x16 __attribute__((ext_vector_type(16)));
typedef unsigned u32x2 __attribute__((ext_vector_type(2)));
typedef unsigned u32x4 __attribute__((ext_vector_type(4)));
typedef _Float16 f16x4 __attribute__((ext_vector_type(4)));
typedef __bf16 bf16v2 __attribute__((ext_vector_type(2)));

constexpr int D = 1024, BATCH = 16, SEQ = 4096, T = BATCH * SEQ, NMEM = 256;
constexpr int IN_PROJ = 2560, CW = 384, RW = 384, NH = 6, NE = 16, FF = 1024, CAP = 512;
constexpr int NSLOT = NE * BATCH * CAP;
constexpr int NTHREADS = 512;
constexpr int LDS_BYTES = 160 * 1024;
constexpr int NPHASE = 11;
#ifndef SCAN_MODE
#define SCAN_MODE 1
#endif

constexpr size_t MiB = 1u << 20;
constexpr size_t WS_WINT = 1 * MiB;
constexpr size_t WS_WOUTT = 6 * MiB;
constexpr size_t WS_WKT = 8 * MiB;
constexpr size_t WS_WVT = 8 * MiB + 512 * 1024;
constexpr size_t WS_SMALL = 9 * MiB;
constexpr size_t WS_WGUT = 10 * MiB;
constexpr size_t WS_WDT = 74 * MiB;
constexpr size_t WS_KMEM = 106 * MiB;
constexpr size_t WS_VT = 108 * MiB;
constexpr size_t WS_ROWTOK = 106 * MiB;
constexpr size_t WS_ROWGATE = 106 * MiB + 512 * 1024;
constexpr size_t WS_SS = 107 * MiB;
constexpr size_t WS_P = 112 * MiB;
constexpr size_t WS_YF = 112 * MiB;
constexpr size_t WS_YB = 208 * MiB;
constexpr size_t WS_X1 = 112 * MiB;
constexpr size_t WS_XH = 432 * MiB;
constexpr size_t WS_G = 432 * MiB;
constexpr size_t WS_BON = 480 * MiB;
constexpr size_t WS_Q = 400 * MiB;
constexpr int PLD = IN_PROJ - 256;
constexpr size_t WS_H2 = 432 * MiB;
constexpr size_t WS_MEMN = 560 * MiB;
constexpr size_t WS_MIX = 560 * MiB;
constexpr size_t WS_SCAN = 688 * MiB;
constexpr size_t SCAN_STRIDE = 48 * MiB;
constexpr size_t WS_SCAN7 = 496 * MiB;
constexpr size_t WS_PC = 484 * MiB;
__device__ __forceinline__ unsigned char* scan_arr(unsigned char* ws, int a) { return a < 7 ? ws + WS_SCAN + (size_t)a * SCAN_STRIDE : (a == 7 ? ws + WS_SCAN7 : ws + 560 * MiB + 640 * 2); }
__device__ __forceinline__ int scan_pitch(int a) { return a == 8 ? D : 384; }
__device__ __forceinline__ size_t hat_off(int a, size_t tok, int ch) { return a == 8 ? tok * D + ch : ((((tok >> 4) * NH + (ch >> 6)) << 10) + ((tok & 15) << 6) + (ch & 63)); }
constexpr size_t WS_AFF = 624 * MiB;
constexpr size_t WS_INV = 628 * MiB;
constexpr size_t WS_HID = 768 * MiB;
constexpr size_t WS_YE = 368 * MiB;
constexpr size_t WS_END = 1024 * MiB;

__device__ __forceinline__ unsigned pk_bf16(float lo, float hi) { f32x2 v = {lo, hi}; bf16v2 b = __builtin_convertvector(v, bf16v2); return __builtin_bit_cast(unsigned, b); }
__device__ __forceinline__ float bf_lo(unsigned u) { return __builtin_bit_cast(float, u << 16); }
__device__ __forceinline__ float bf_hi(unsigned u) { return __builtin_bit_cast(float, u & 0xffff0000u); }
__device__ __forceinline__ float wave_sum(float v) {
#pragma unroll
    for (int o = 1; o < 64; o <<= 1) v += __shfl_xor(v, o);
    return v;
}
__device__ __forceinline__ float sigmoidf_fast(float x) { return __builtin_amdgcn_rcpf(1.0f + __builtin_amdgcn_exp2f(-1.4426950408889634f * x)); }
template <int CTRL> __device__ __forceinline__ float dpp_f(float x) { return __builtin_bit_cast(float, __builtin_amdgcn_update_dpp(0, __builtin_bit_cast(int, x), CTRL, 0xF, 0xF, true)); }
__device__ __forceinline__ float sum8(float x) { x += dpp_f<0xB1>(x); x += dpp_f<0x4E>(x); x += dpp_f<0x141>(x); return x; }
__device__ __forceinline__ float sum16(float x) { x = sum8(x); x += dpp_f<0x140>(x); return x; }
__device__ __forceinline__ float max16(float x) { x = fmaxf(x, dpp_f<0xB1>(x)); x = fmaxf(x, dpp_f<0x4E>(x)); x = fmaxf(x, dpp_f<0x141>(x)); x = fmaxf(x, dpp_f<0x140>(x)); return x; }

typedef short v4i16g __attribute__((__vector_size__(8)));
__device__ __forceinline__ s16x4 tr_read16(LAS unsigned char* p) { v4i16g r = __builtin_amdgcn_ds_read_tr16_b64_v4i16((LAS v4i16g*)p); return __builtin_bit_cast(s16x4, r); }
__device__ __forceinline__ f32x4 bf4_to_f32(u32x2 w) { return (f32x4){bf_lo(w.x), bf_hi(w.x), bf_lo(w.y), bf_hi(w.y)}; }
__device__ __forceinline__ u32x2 f32_to_bf4(f32x4 v) { return (u32x2){pk_bf16(v.x, v.y), pk_bf16(v.z, v.w)}; }
__device__ __forceinline__ bf16x8 frag_lo4(f32x4 v) { const u32x4 w = {pk_bf16(v.x, v.y), pk_bf16(v.z, v.w), 0u, 0u}; return __builtin_bit_cast(bf16x8, w); }
__device__ __forceinline__ bf16x8 frag_cat(u32x2 a, u32x2 b) { const u32x4 w = {a.x, a.y, b.x, b.y}; return __builtin_bit_cast(bf16x8, w); }
#define MFMA16(a, b, c) __builtin_amdgcn_mfma_f32_16x16x32_bf16((a), (b), (c), 0, 0, 0)

namespace pg8 {
#define PG8_LAS __attribute__((address_space(3)))
constexpr int BM = 256, BK = 64, HALF = 128, HTB = HALF * BK * 2, STAGE_BYTES = 8 * HTB, NXCD = 8, WGM = 8;
__host__ __device__ __forceinline__ int lds_byte(int r, int c) { const int st = (r >> 4) * 2 + (c >> 5), rr = r & 15, cc = c & 31, ob = rr * 64 + cc * 2; return st * 1024 + (ob ^ (((ob >> 9) & 1) << 5)); }
__host__ __device__ __forceinline__ void stage_rc(int b, int& R, int& C) { const int st = b / 1024, sb = b % 1024, swz = sb ^ (((sb >> 9) & 1) << 5); R = (st >> 1) * 16 + swz / 64; C = (st & 1) * 32 + (swz % 64) / 2; }
__host__ __device__ __forceinline__ int perm32(int rho) { const int n = rho >> 4, i = rho & 15; return 8 * (i >> 2) + 4 * n + (i & 3); }

struct Unit { int pm, pn, gid; };
struct Gemm { const bf16_t* A; const bf16_t* Bt; int M, N, K; };

struct StaticOrder {
    int nM, nN, nwg, G, c;
    __device__ void init(int M, int N, int G_, int c_) { nM = M / BM; nN = N / BM; nwg = nM * nN; G = G_; c = c_; }
    __device__ bool next(int i, Unit& u) const {
        const long L = (long)i * G + c; if (L >= nwg) return false;
        int wgid = (int)L; { const int q = nwg / NXCD, r = nwg % NXCD, xcd = wgid % NXCD, off = wgid / NXCD; wgid = (xcd < r ? xcd * (q + 1) : r * (q + 1) + (xcd - r) * q) + off; }
        const int nig = WGM * nN, gid = wgid / nig, fm = gid * WGM, gsz = (nM - fm) < WGM ? (nM - fm) : WGM;
        u.pm = fm + ((wgid % nig) % gsz); u.pn = (wgid % nig) / gsz; u.gid = 0; return true;
    }
    __device__ __forceinline__ const char* aptr(const Gemm& g, const Unit& u, size_t tstep) const { return (const char*)g.A + (size_t)u.pm * tstep; }
    __device__ __forceinline__ const char* bptr(const Gemm& g, const Unit& u, size_t tstep) const { return (const char*)g.Bt + (size_t)u.pn * tstep; }
};
struct TripleOrder {
    StaticOrder S0; const bf16_t* A1; const bf16_t* B1; const bf16_t* A2; const bf16_t* B2; int n1, n2, G, c;
    __device__ bool next(int i, Unit& u) const {
        const long L = (long)i * G + c;
        if (L < n1) { u.pm = (int)L; u.pn = 0; u.gid = 1; return true; }
        if (L < n1 + n2) { u.pm = 0; u.pn = (int)(L - n1); u.gid = 2; return true; }
        const long L0 = L - n1 - n2; if (L0 >= S0.nwg) return false;
        StaticOrder T0 = S0; T0.c = (int)(L0 % G); return T0.next((int)(L0 / G), u);
    }
    __device__ __forceinline__ const char* aptr(const Gemm& g, const Unit& u, size_t tstep) const { return (const char*)(u.gid == 0 ? g.A : (u.gid == 1 ? A1 : A2)) + (size_t)u.pm * tstep; }
    __device__ __forceinline__ const char* bptr(const Gemm& g, const Unit& u, size_t tstep) const { return (const char*)(u.gid == 0 ? g.Bt : (u.gid == 1 ? B1 : B2)) + (size_t)u.pn * tstep; }
};
struct ExpertOrder {
    int nMe, nNe, per, total, G, c;
    __device__ void init(int nMe_, int nNe_, int nExp, int G_, int c_) { nMe = nMe_; nNe = nNe_; per = nMe * nNe; total = per * nExp; G = G_; c = c_; }
    __device__ bool next(int i, Unit& u) const {
        const long L = (long)i * G + c; if (L >= total) return false;
        const int e = (int)(L / per), w = (int)(L % per), xl = w % 8, j = w / 8, rpx = nMe / 8;
        u.pm = e * nMe + xl * rpx + (j % rpx); u.pn = e * nNe + j / rpx; u.gid = 0; return true;
    }
    __device__ __forceinline__ const char* aptr(const Gemm& g, const Unit& u, size_t tstep) const { return (const char*)g.A + (size_t)u.pm * tstep; }
    __device__ __forceinline__ const char* bptr(const Gemm& g, const Unit& u, size_t tstep) const { return (const char*)g.Bt + (size_t)u.pn * tstep; }
};

struct EpiBf16 {
    static constexpr bool PERM = true;
    bf16_t* O; int ldc; bf16_t* Q0;
    __device__ __forceinline__ void operator()(const f32x4 (&acc)[2][2][4][2], const Unit& u, int wr, int wc, int fr, int fq) const {
        const bool redir = (Q0 != nullptr) && (u.pn == 0);
        bf16_t* base = redir ? Q0 : O; const int ld = redir ? 256 : ldc;
        const int row0 = u.pm * BM + wr * 64 + fr, col0 = (u.pn - ((Q0 != nullptr && !redir) ? 1 : 0)) * BM + wc * 32 + 8 * fq;
#pragma unroll
        for (int ai = 0; ai < 2; ++ai)
#pragma unroll
            for (int m = 0; m < 4; ++m) { bf16_t* rowp = base + (size_t)(row0 + ai * HALF + m * 16) * ld + col0;
#pragma unroll
                for (int bj = 0; bj < 2; ++bj) { const f32x4 v0 = acc[ai][bj][m][0], v1 = acc[ai][bj][m][1];
                    u32x4 w; w.x = pk_bf16(v0[0], v0[1]); w.y = pk_bf16(v0[2], v0[3]); w.z = pk_bf16(v1[0], v1[1]); w.w = pk_bf16(v1[2], v1[3]);
                    *(u32x4*)(rowp + bj * HALF) = w; } }
    }
};
struct EpiBf16x3 {
    static constexpr bool PERM = true;
    EpiBf16 E0, E1, E2;
    __device__ __forceinline__ void operator()(const f32x4 (&acc)[2][2][4][2], const Unit& u, int wr, int wc, int fr, int fq) const {
        if (u.gid == 0) E0(acc, u, wr, wc, fr, fq); else if (u.gid == 1) E1(acc, u, wr, wc, fr, fq); else E2(acc, u, wr, wc, fr, fq); }
};
struct EpiResidSS {
    static constexpr bool PERM = false;
    const float* X; float* X1; float* ss;
    __device__ __forceinline__ void operator()(const f32x4 (&acc)[2][2][4][2], const Unit& u, int wr, int wc, int fr, int fq) const {
        const int row0 = u.pm * BM + wr * 64 + fr, col0 = u.pn * BM + wc * 32 + 4 * fq;
#pragma unroll
        for (int ai = 0; ai < 2; ++ai)
#pragma unroll
            for (int m = 0; m < 4; ++m) { const int row = row0 + ai * HALF + m * 16; const size_t off = (size_t)row * D + col0; float s = 0.f;
#pragma unroll
                for (int bj = 0; bj < 2; ++bj)
#pragma unroll
                    for (int n = 0; n < 2; ++n) { const f32x4 xv = *(const f32x4*)(X + off + bj * HALF + n * 16); const f32x4 o = xv + acc[ai][bj][m][n];
                        *(f32x4*)(X1 + off + bj * HALF + n * 16) = o; s += (o[0] * o[0] + o[1] * o[1]) + (o[2] * o[2] + o[3] * o[3]); }
                s += __shfl_xor(s, 16); s += __shfl_xor(s, 32);
                if (fq == 0) (void)__hip_atomic_fetch_add(ss + row, s, __ATOMIC_RELAXED, __HIP_MEMORY_SCOPE_AGENT); }
    }
};
struct EpiSwiGLU {
    static constexpr bool PERM = true;
    bf16_t* H;
    __device__ __forceinline__ void operator()(const f32x4 (&acc)[2][2][4][2], const Unit& u, int wr, int wc, int fr, int fq) const {
        const int row0 = u.pm * BM + wr * 64 + fr, col0 = (u.pn & 7) * HALF + wc * 32 + 8 * fq;
#pragma unroll
        for (int ai = 0; ai < 2; ++ai)
#pragma unroll
            for (int m = 0; m < 4; ++m) { bf16_t* rowp = H + (size_t)(row0 + ai * HALF + m * 16) * FF + col0; float h[8];
#pragma unroll
                for (int n = 0; n < 2; ++n)
#pragma unroll
                    for (int j = 0; j < 4; ++j) { const float gt = acc[ai][0][m][n][j], up = acc[ai][1][m][n][j]; h[n * 4 + j] = gt * sigmoidf_fast(gt) * up; }
                u32x4 w; w.x = pk_bf16(h[0], h[1]); w.y = pk_bf16(h[2], h[3]); w.z = pk_bf16(h[4], h[5]); w.w = pk_bf16(h[6], h[7]);
                *(u32x4*)rowp = w; }
    }
};
struct EpiGateScale {
    static constexpr bool PERM = true;
    bf16_t* Y; const float* gate;
    __device__ __forceinline__ void operator()(const f32x4 (&acc)[2][2][4][2], const Unit& u, int wr, int wc, int fr, int fq) const {
        const int row0 = u.pm * BM + wr * 64 + fr, col0 = (u.pn & 3) * BM + wc * 32 + 8 * fq;
#pragma unroll
        for (int ai = 0; ai < 2; ++ai)
#pragma unroll
            for (int m = 0; m < 4; ++m) { const int row = row0 + ai * HALF + m * 16; const float gs = gate[row]; bf16_t* rowp = Y + (size_t)row * D + col0;
#pragma unroll
                for (int bj = 0; bj < 2; ++bj) { const f32x4 v0 = acc[ai][bj][m][0] * gs, v1 = acc[ai][bj][m][1] * gs;
                    u32x4 w; w.x = pk_bf16(v0[0], v0[1]); w.y = pk_bf16(v0[2], v0[3]); w.z = pk_bf16(v1[0], v1[1]); w.w = pk_bf16(v1[2], v1[3]);
                    *(u32x4*)(rowp + bj * HALF) = w; } }
    }
};

template <class Epi, class Sched, bool GATHER>
__device__ __forceinline__ void gemm_phase(PG8_LAS unsigned char* lds, const Gemm g, const Sched& S, const Epi& E, const int* rowtok) {
    const int tid = threadIdx.x, wid = __builtin_amdgcn_readfirstlane(tid >> 6), lane = tid & 63, wr = wid >> 2, wc = wid & 3, fr = lane & 15, fq = lane >> 4;
    const int K = g.K, nt = K / BK;
    unsigned voffA[2], voffB[2]; int Rr[2], Cc[2];
#pragma unroll
    for (int i = 0; i < 2; ++i) { int R, C; stage_rc(tid * 16 + i * 8192, R, C); const int Rb = Epi::PERM ? ((R & ~31) + perm32(R & 31)) : R; Rr[i] = R; Cc[i] = C;
        voffA[i] = (unsigned)(R * K + C) * 2u; voffB[i] = (unsigned)(Rb * K + C) * 2u; }
    unsigned vAc[2][2], vAn[2][2];
    const size_t kstep = (size_t)(BK * 2);
    const size_t hstep = (size_t)HALF * K * 2;
    const size_t tstep = 2 * hstep;
    const unsigned ldsw = (unsigned)wid * 1024u;
    const int aoff = lds_byte(wr * 64 + fr, fq * 8), boff = lds_byte(wc * 32 + fr, fq * 8);
#define PG8_SA(b, h) (((b) * 2 + (h)) * HTB)
#define PG8_SB(b, h) ((4 + (b) * 2 + (h)) * HTB)
#define PG8_STAGE(bufoff, gbase, voff) do { _Pragma("unroll") for (int _i = 0; _i < 2; ++_i) \
        __builtin_amdgcn_global_load_lds((const unsigned*)((const char*)(gbase) + (voff)[_i]), (PG8_LAS unsigned*)(lds + (bufoff) + ldsw + _i * 8192), 16, 0, 0); } while (0)
#define PG8_STAGE_A(bufoff, hh, dbase, kbytes, vsel) do { if constexpr (GATHER) { PG8_STAGE(bufoff, (const char*)g.A + (kbytes), (vsel)[hh]); } else { PG8_STAGE(bufoff, (dbase) + ((hh) ? hstep : 0), voffA); } } while (0)
#define PG8_GATHER_OFF(dst, un) do { _Pragma("unroll") for (int _h = 0; _h < 2; ++_h) _Pragma("unroll") for (int _i = 0; _i < 2; ++_i) \
        (dst)[_h][_i] = (unsigned)rowtok[(un).pm * BM + _h * HALF + Rr[_i]] * (unsigned)(K * 2) + (unsigned)(Cc[_i] * 2); } while (0)
#define PG8_LDA(dst, b, h) do { _Pragma("unroll") for (int m = 0; m < 4; ++m) _Pragma("unroll") for (int k = 0; k < 2; ++k) dst[m][k] = *(const PG8_LAS bf16x8*)(lds + PG8_SA(b, h) + aoff + m * 2048 + k * 1024); } while (0)
#define PG8_LDB(dst, b, h) do { _Pragma("unroll") for (int n = 0; n < 2; ++n) _Pragma("unroll") for (int k = 0; k < 2; ++k) dst[n][k] = *(const PG8_LAS bf16x8*)(lds + PG8_SB(b, h) + boff + n * 2048 + k * 1024); } while (0)
#define PG8_MMA(ai, bj, At, Bt) do { __builtin_amdgcn_s_setprio(1); _Pragma("unroll") for (int m = 0; m < 4; ++m) _Pragma("unroll") for (int n = 0; n < 2; ++n) _Pragma("unroll") for (int k = 0; k < 2; ++k) \
        acc[ai][bj][m][n] = __builtin_amdgcn_mfma_f32_16x16x32_bf16(Bt[n][k], At[m][k], acc[ai][bj][m][n], 0, 0, 0); __builtin_amdgcn_s_setprio(0); } while (0)
#define PG8_WAIT_V(n) asm volatile("s_waitcnt vmcnt(" #n ")" ::: "memory")
#define PG8_WAIT_L(n) asm volatile("s_waitcnt lgkmcnt(" #n ")" ::: "memory")
#define PG8_BAR __builtin_amdgcn_s_barrier()
#define PG8_SCHED __builtin_amdgcn_sched_barrier(0)
    Unit cur, nxt; int ui = 0;
    if (!S.next(0, cur)) return;
    f32x4 acc[2][2][4][2];
#pragma unroll
    for (int a = 0; a < 2; ++a)
#pragma unroll
        for (int b = 0; b < 2; ++b)
#pragma unroll
            for (int m = 0; m < 4; ++m)
#pragma unroll
                for (int n = 0; n < 2; ++n) acc[a][b][m][n] = (f32x4){0.f, 0.f, 0.f, 0.f};
    bf16x8 At[4][2], B0[2][2], B1[2][2];
    const char* cA = GATHER ? (const char*)g.A : S.aptr(g, cur, tstep); const char* cB = S.bptr(g, cur, tstep);
    if constexpr (GATHER) { PG8_GATHER_OFF(vAc, cur); }
    PG8_STAGE(PG8_SB(0, 0), cB, voffB); PG8_STAGE_A(PG8_SA(0, 0), 0, cA, 0, vAc); PG8_STAGE(PG8_SB(0, 1), cB + hstep, voffB); PG8_STAGE_A(PG8_SA(0, 1), 1, cA, 0, vAc);
    if (wr == 1) PG8_BAR;
    PG8_WAIT_V(4); PG8_BAR;
    PG8_STAGE(PG8_SB(1, 0), cB + kstep, voffB); PG8_STAGE_A(PG8_SA(1, 0), 0, cA + kstep, kstep, vAc); PG8_STAGE(PG8_SB(1, 1), cB + hstep + kstep, voffB);
    PG8_WAIT_V(6); PG8_BAR;
    for (;;) {
        const bool has_next = S.next(ui + 1, nxt);
        const char* nA = (has_next && !GATHER) ? S.aptr(g, nxt, tstep) : cA; const char* nB = has_next ? S.bptr(g, nxt, tstep) : cB;
        if constexpr (GATHER) { if (has_next) { PG8_GATHER_OFF(vAn, nxt); } else {
#pragma unroll
            for (int _h = 0; _h < 2; ++_h)
#pragma unroll
                for (int _i = 0; _i < 2; ++_i) vAn[_h][_i] = vAc[_h][_i]; } }
        for (int t = 0; t < nt; t += 2) {
            const bool last = (t == nt - 2);
            const size_t k1 = (size_t)(t + 1) * kstep, k2 = last ? 0 : (size_t)(t + 2) * kstep, k3 = k2 + kstep;
            const char* a1 = cA + k1;
            const char* a2 = last ? nA : cA + (size_t)(t + 2) * kstep; const char* b2 = last ? nB : cB + (size_t)(t + 2) * kstep;
            const char* a3 = a2 + kstep; const char* b3 = b2 + kstep;
            unsigned vs[2][2];
#pragma unroll
            for (int _h = 0; _h < 2; ++_h)
#pragma unroll
                for (int _i = 0; _i < 2; ++_i) vs[_h][_i] = last ? vAn[_h][_i] : vAc[_h][_i];
            PG8_LDB(B0, 0, 0); PG8_SCHED; PG8_LDA(At, 0, 0); PG8_STAGE_A(PG8_SA(1, 1), 1, a1, k1, vAc);
            PG8_WAIT_L(8); PG8_BAR; PG8_WAIT_L(0); PG8_MMA(0, 0, At, B0); PG8_BAR; PG8_SCHED;
            PG8_LDB(B1, 0, 1); PG8_STAGE(PG8_SB(0, 0), b2, voffB);
            PG8_BAR; PG8_WAIT_L(0); PG8_MMA(0, 1, At, B1); PG8_BAR;
            PG8_LDA(At, 0, 1); PG8_STAGE_A(PG8_SA(0, 0), 0, a2, k2, vs);
            PG8_BAR; PG8_WAIT_L(0); PG8_MMA(1, 0, At, B0); PG8_BAR; PG8_SCHED;
            PG8_STAGE(PG8_SB(0, 1), b2 + hstep, voffB);
            PG8_WAIT_V(6); PG8_BAR; PG8_MMA(1, 1, At, B1); PG8_BAR;
            PG8_LDB(B0, 1, 0); PG8_SCHED; PG8_LDA(At, 1, 0); PG8_STAGE_A(PG8_SA(0, 1), 1, a2, k2, vs);
            PG8_WAIT_L(8); PG8_BAR; PG8_WAIT_L(0); PG8_MMA(0, 0, At, B0); PG8_BAR; PG8_SCHED;
            PG8_LDB(B1, 1, 1); PG8_STAGE(PG8_SB(1, 0), b3, voffB);
            PG8_BAR; PG8_WAIT_L(0); PG8_MMA(0, 1, At, B1); PG8_BAR;
            PG8_LDA(At, 1, 1); PG8_STAGE_A(PG8_SA(1, 0), 0, a3, k3, vs);
            PG8_BAR; PG8_WAIT_L(0); PG8_MMA(1, 0, At, B0); PG8_BAR; PG8_SCHED;
            PG8_STAGE(PG8_SB(1, 1), b3 + hstep, voffB);
            PG8_WAIT_V(6); PG8_BAR; PG8_MMA(1, 1, At, B1); PG8_BAR;
        }
        E(acc, cur, wr, wc, fr, fq);
        if (!has_next) break;
#pragma unroll
        for (int a = 0; a < 2; ++a)
#pragma unroll
            for (int b = 0; b < 2; ++b)
#pragma unroll
                for (int m = 0; m < 4; ++m)
#pragma unroll
                    for (int n = 0; n < 2; ++n) acc[a][b][m][n] = (f32x4){0.f, 0.f, 0.f, 0.f};
        cur = nxt; cA = nA; cB = nB; ++ui;
        if constexpr (GATHER) {
#pragma unroll
            for (int _h = 0; _h < 2; ++_h)
#pragma unroll
                for (int _i = 0; _i < 2; ++_i) vAc[_h][_i] = vAn[_h][_i]; }
    }
    PG8_WAIT_V(0);
    if (wr == 0) PG8_BAR;
    PG8_BAR;
#undef PG8_SA
#undef PG8_SB
#undef PG8_STAGE
#undef PG8_STAGE_A
#undef PG8_GATHER_OFF
#undef PG8_LDA
#undef PG8_LDB
#undef PG8_MMA
#undef PG8_WAIT_V
#undef PG8_WAIT_L
#undef PG8_BAR
#undef PG8_SCHED
}
}

struct Args {
    const float* in[29];
    float* out; unsigned char* ws;
    int ph_lo, ph_hi;
};
enum { I_X = 0, I_MEM, I_NMIXG, I_NMEMG, I_WIN, I_WMK, I_WMV, I_CONVW, I_CONVB, I_CLNG, I_CLNB, I_SHIFTMU, I_DW0, I_DUP, I_IA0, I_IUP, I_GUP, I_KK, I_KA, I_RK,
       I_LNXG, I_LNXB, I_WOUT, I_NFFNG, I_WROUTER, I_WEG, I_WEU, I_WED, I_FNG };

__device__ __forceinline__ void transpose_item(const float* W, int N, bf16_t* WT, int K, int k0, int n0, int drow0, LAS float* scr, int lane) {
    {
        f32x4 v[8];
#pragma unroll
        for (int i = 0; i < 8; ++i) v[i] = *(const f32x4*)(W + (size_t)(k0 + 8 * i + (lane >> 3)) * N + n0 + 4 * (lane & 7));
#pragma unroll
        for (int i = 0; i < 8; ++i) { LAS float* d = scr + (8 * i + (lane >> 3)) * 33 + 4 * (lane & 7); d[0] = v[i].x; d[1] = v[i].y; d[2] = v[i].z; d[3] = v[i].w; }
    }
    asm volatile("s_waitcnt lgkmcnt(0)" ::: "memory");
    const int c = lane & 7;
#pragma unroll
    for (int j = 0; j < 4; ++j) { const int n = (lane >> 3) + 8 * j; const LAS float* s = scr + (8 * c) * 33 + n;
        u32x4 o; o.x = pk_bf16(s[0 * 33], s[1 * 33]); o.y = pk_bf16(s[2 * 33], s[3 * 33]); o.z = pk_bf16(s[4 * 33], s[5 * 33]); o.w = pk_bf16(s[6 * 33], s[7 * 33]);
        *(u32x4*)(WT + (size_t)(drow0 + n) * K + k0 + 8 * c) = o; }
    asm volatile("s_waitcnt lgkmcnt(0)" ::: "memory");
}
__device__ __forceinline__ void expert_prep_items(const Args& a, LAS unsigned char* lds, int widx, int nw, int it_lo, int it_hi) {
    const int tid = threadIdx.x, lane = tid & 63, wave = __builtin_amdgcn_readfirstlane(tid >> 6);
    LAS float* scr = (LAS float*)(lds + wave * 16384);
    unsigned char* ws = a.ws;
    constexpr int S_EXP = 16 * 16 * 32;
    for (int r = it_lo + widx; r < it_hi; r += nw) {
        const int which = r / S_EXP, q = r % S_EXP, e = q / 512, kb = (q % 512) / 32, nb = q % 32, n0 = nb * 32;
        if (which == 0) transpose_item(a.in[I_WEG] + (size_t)e * D * FF, FF, (bf16_t*)(ws + WS_WGUT) + (size_t)e * 2048 * D, D, kb * 64, n0, (n0 >> 7) * 256 + (n0 & 127), scr, lane);
        else if (which == 1) transpose_item(a.in[I_WEU] + (size_t)e * D * FF, FF, (bf16_t*)(ws + WS_WGUT) + (size_t)e * 2048 * D, D, kb * 64, n0, (n0 >> 7) * 256 + 128 + (n0 & 127), scr, lane);
        else transpose_item(a.in[I_WED] + (size_t)e * FF * D, D, (bf16_t*)(ws + WS_WDT) + (size_t)e * D * FF, FF, kb * 64, n0, n0, scr, lane);
    }
}

__device__ __forceinline__ void rms_row_to_bf16(const float* xrow, const float* g, bf16_t* orow, int lane) {
    const f32x4* xr = (const f32x4*)xrow + lane; const f32x4* gr = (const f32x4*)g + lane;
    f32x4 v[4]; float s = 0.f;
#pragma unroll
    for (int j = 0; j < 4; ++j) { v[j] = xr[64 * j]; s += (v[j].x * v[j].x + v[j].y * v[j].y) + (v[j].z * v[j].z + v[j].w * v[j].w); }
    const float rs = 1.0f / sqrtf(wave_sum(s) * (1.f / D) + 1e-6f);
    u32x2* o8 = (u32x2*)orow + lane;
#pragma unroll
    for (int j = 0; j < 4; ++j) { const f32x4 gg = gr[64 * j]; u32x2 w; w.x = pk_bf16(v[j].x * rs * gg.x, v[j].y * rs * gg.y); w.y = pk_bf16(v[j].z * rs * gg.z, v[j].w * rs * gg.w); o8[64 * j] = w; }
}
__device__ __forceinline__ void phase_prep(const Args& a, LAS unsigned char* lds, int G) {
    const int tid = threadIdx.x, lane = tid & 63, wave = __builtin_amdgcn_readfirstlane(tid >> 6);
    LAS float* scr = (LAS float*)(lds + wave * 16384);
    const int gw = blockIdx.x * 8 + wave, NGW = G * 8;
    unsigned char* ws = a.ws;
    constexpr int S_WIN = 16 * 80, S_WOUT = 16 * 32, S_MK = 16 * 8, S_SM = 12, S_GUP = 24;
    constexpr int NITEMS = S_WIN + S_WOUT + 2 * S_MK + 4 * S_SM + S_GUP;
    for (int it = gw; it < NITEMS; it += NGW) {
        int r = it;
        if (r < S_WIN) { const int kb = r / 80, nb = r % 80; transpose_item(a.in[I_WIN], IN_PROJ, (bf16_t*)(ws + WS_WINT), D, kb * 64, nb * 32, nb * 32, scr, lane); continue; } r -= S_WIN;
        if (r < S_WOUT) { const int kb = r / 32, nb = r % 32; transpose_item(a.in[I_WOUT], D, (bf16_t*)(ws + WS_WOUTT), D, kb * 64, nb * 32, nb * 32, scr, lane); continue; } r -= S_WOUT;
        if (r < S_MK) { const int kb = r / 8, nb = r % 8; transpose_item(a.in[I_WMK], 256, (bf16_t*)(ws + WS_WKT), D, kb * 64, nb * 32, nb * 32, scr, lane); continue; } r -= S_MK;
        if (r < S_MK) { const int kb = r / 8, nb = r % 8; transpose_item(a.in[I_WMV], 256, (bf16_t*)(ws + WS_WVT), D, kb * 64, nb * 32, nb * 32, scr, lane); continue; } r -= S_MK;
        if (r < 4 * S_SM) { const int which = r / S_SM, nb = r % S_SM;
            const float* src = (which < 2 ? a.in[I_DUP] : a.in[I_IUP]) + (size_t)(which & 1) * 64 * RW;
            transpose_item(src, RW, (bf16_t*)(ws + WS_SMALL) + (size_t)which * RW * 64, 64, 0, nb * 32, nb * 32, scr, lane); continue; } r -= 4 * S_SM;
        { const int kb = r / 12, nb = r % 12; transpose_item(a.in[I_GUP], RW, (bf16_t*)(ws + WS_SMALL) + (size_t)4 * RW * 64, 128, kb * 64, nb * 32, nb * 32, scr, lane); }
    }
    expert_prep_items(a, lds, gw, NGW, 0, 3 * 8192);
    for (int m = gw; m < T; m += NGW) rms_row_to_bf16(a.in[I_X] + (size_t)m * D, a.in[I_NMIXG], (bf16_t*)(ws + WS_XH) + (size_t)m * D, lane);
    for (int m = gw; m < BATCH * NMEM; m += NGW) rms_row_to_bf16(a.in[I_MEM] + (size_t)m * D, a.in[I_NMEMG], (bf16_t*)(ws + WS_MEMN) + (size_t)m * D, lane);
}

constexpr int AT_KS = 144;
constexpr int AT_VS = 520;
constexpr int AT_VOFF = 256 * AT_KS;
__device__ __forceinline__ bf16x8 pack_step(const f32x16& x, int s) {
    u32x4 p;
    asm volatile("v_cvt_pk_bf16_f32 %0, %4, %5\n\tv_cvt_pk_bf16_f32 %1, %6, %7\n\tv_cvt_pk_bf16_f32 %2, %8, %9\n\tv_cvt_pk_bf16_f32 %3, %10, %11\n\ts_nop 1"
                 : "=&v"(p[0]), "=&v"(p[1]), "=&v"(p[2]), "=&v"(p[3])
                 : "v"(x[8 * s]), "v"(x[8 * s + 1]), "v"(x[8 * s + 2]), "v"(x[8 * s + 3]), "v"(x[8 * s + 4]), "v"(x[8 * s + 5]), "v"(x[8 * s + 6]), "v"(x[8 * s + 7]));
    return __builtin_bit_cast(bf16x8, p);
}
__device__ __forceinline__ void attn_unit(const Args& a, LAS unsigned char* lds, int unit) {
    const int tid = threadIdx.x, lane = tid & 63, wave = __builtin_amdgcn_readfirstlane(tid >> 6), r = lane & 31, h = lane >> 5;
    const int b = unit >> 2, hh = unit & 3;
    const bf16_t* Qb = (const bf16_t*)(a.ws + WS_Q); const bf16_t* KM = (const bf16_t*)(a.ws + WS_KMEM); const bf16_t* VT = (const bf16_t*)(a.ws + WS_VT);
    bf16_t* MIX = (bf16_t*)(a.ws + WS_MIX);
    __syncthreads();
#pragma unroll
    for (int i = 0; i < 4; ++i) { const int c = tid + 512 * i, key = c >> 3, ch = c & 7;
        const u32x4 v = *(const u32x4*)(KM + (size_t)(b * NMEM + key) * 256 + hh * 64 + ch * 8);
        *(LAS u32x4*)(lds + key * AT_KS + ch * 16) = v; }
#pragma unroll
    for (int i = 0; i < 4; ++i) { const int c = tid + 512 * i, d = c >> 5, ch = c & 31;
        const u32x4 v = *(const u32x4*)(VT + (size_t)(hh * 64 + d) * (BATCH * NMEM) + b * NMEM + ch * 8);
        LAS u32x2* dst = (LAS u32x2*)(lds + AT_VOFF + d * AT_VS + ch * 16);
        dst[0] = (u32x2){v.x, v.y}; dst[1] = (u32x2){v.z, v.w}; }
    __syncthreads();
#pragma unroll 1
    for (int tile = 0; tile < 16; ++tile) {
    const int tok0 = b * SEQ + tile * 256 + wave * 32;
    bf16x8 qf[4];
#pragma unroll
    for (int ks = 0; ks < 4; ++ks) qf[ks] = *(const bf16x8*)(Qb + (size_t)(tok0 + r) * 256 + hh * 64 + ks * 16 + h * 8);
    const float sc = 0.125f * 1.4426950408889634f;
    float m_run = -3.0e38f, sum = 0.f;
    f32x16 o[2];
#pragma unroll
    for (int dt = 0; dt < 2; ++dt)
#pragma unroll
        for (int i = 0; i < 16; ++i) o[dt][i] = 0.f;
#pragma unroll 1
    for (int kh = 0; kh < 2; ++kh) {
        f32x16 s[4];
#pragma unroll
        for (int k4 = 0; k4 < 4; ++k4) {
#pragma unroll
            for (int i = 0; i < 16; ++i) s[k4][i] = 0.f;
#pragma unroll
            for (int ks = 0; ks < 4; ++ks) { const bf16x8 ka = *(const LAS bf16x8*)(lds + ((kh * 4 + k4) * 32 + r) * AT_KS + (ks * 16 + h * 8) * 2);
                s[k4] = __builtin_amdgcn_mfma_f32_32x32x16_bf16(ka, qf[ks], s[k4], 0, 0, 0); }
        }
        float mx = m_run;
#pragma unroll
        for (int k4 = 0; k4 < 4; ++k4)
#pragma unroll
            for (int i = 0; i < 16; ++i) mx = fmaxf(mx, s[k4][i]);
        mx = fmaxf(mx, __shfl_xor(mx, 32));
        const float alpha = __builtin_amdgcn_exp2f((m_run - mx) * sc);
        float ps = 0.f;
#pragma unroll
        for (int k4 = 0; k4 < 4; ++k4)
#pragma unroll
            for (int i = 0; i < 16; ++i) { const float e = __builtin_amdgcn_exp2f((s[k4][i] - mx) * sc); s[k4][i] = e; ps += e; }
        ps += __shfl_xor(ps, 32);
        sum = sum * alpha + ps; m_run = mx;
#pragma unroll
        for (int dt = 0; dt < 2; ++dt)
#pragma unroll
            for (int i = 0; i < 16; ++i) o[dt][i] *= alpha;
#pragma unroll
        for (int k4 = 0; k4 < 4; ++k4)
#pragma unroll
            for (int s2 = 0; s2 < 2; ++s2) {
                const bf16x8 pb = pack_step(s[k4], s2);
#pragma unroll
                for (int dt = 0; dt < 2; ++dt) {
                    const LAS unsigned char* vp = lds + AT_VOFF + (32 * dt + r) * AT_VS + (32 * (kh * 4 + k4) + 16 * s2 + 4 * h) * 2;
                    const s16x4 lo = *(const LAS s16x4*)vp, hi = *(const LAS s16x4*)(vp + 16);
                    const bf16x8 va = __builtin_shufflevector(lo, hi, 0, 1, 2, 3, 4, 5, 6, 7);
                    o[dt] = __builtin_amdgcn_mfma_f32_32x32x16_bf16(va, pb, o[dt], 0, 0, 0);
                }
            }
    }
    const float inv = 1.0f / sum;
    bf16_t* orow = MIX + (size_t)(tok0 + r) * D + hh * 64;
#pragma unroll
    for (int dt = 0; dt < 2; ++dt)
#pragma unroll
        for (int gq = 0; gq < 4; ++gq) { u32x2 w; w.x = pk_bf16(o[dt][4 * gq] * inv, o[dt][4 * gq + 1] * inv); w.y = pk_bf16(o[dt][4 * gq + 2] * inv, o[dt][4 * gq + 3] * inv);
            *(u32x2*)(orow + 32 * dt + 8 * gq + 4 * h) = w; }
    }
}

__device__ __forceinline__ void conv_unit(const Args& a, LAS unsigned char* lds, int unit) {
    const int tid = threadIdx.x, lane = tid & 63, wave = __builtin_amdgcn_readfirstlane(tid >> 6);
    const int b = unit >> 6, t0 = (unit & 63) * 64;
    const bf16_t* P = (const bf16_t*)(a.ws + WS_P); bf16_t* MIX = (bf16_t*)(a.ws + WS_MIX);
    LAS _Float16* U = (LAS _Float16*)lds;
    LAS _Float16* Cc = (LAS _Float16*)(lds + 94 * CW * 2);
    __syncthreads();
#pragma unroll 1
    for (int q0 = tid; q0 < 94 * 48; q0 += 3 * NTHREADS) {
        u32x4 vvv[3], ggg[3];
#pragma unroll
        for (int u3 = 0; u3 < 3; ++u3) { const int q = q0 + u3 * NTHREADS, j = q / 48, cc = (q % 48) * 8, s = t0 - 15 + j; const bool ok = (q < 94 * 48) && s >= 0 && s < SEQ;
            const bf16_t* row = P + (size_t)(b * SEQ + (ok ? s : 0)) * PLD + cc;
            vvv[u3] = ok ? *(const u32x4*)row : (u32x4){0u, 0u, 0u, 0u}; ggg[u3] = ok ? *(const u32x4*)(row + CW) : (u32x4){0u, 0u, 0u, 0u}; }
#pragma unroll
        for (int u3 = 0; u3 < 3; ++u3) { const int q = q0 + u3 * NTHREADS, j = q / 48, cc = (q % 48) * 8;
            if (q < 94 * 48) {
                const unsigned vw[4] = {vvv[u3].x, vvv[u3].y, vvv[u3].z, vvv[u3].w}, gw[4] = {ggg[u3].x, ggg[u3].y, ggg[u3].z, ggg[u3].w};
                float u[8];
#pragma unroll
                for (int k = 0; k < 4; ++k) { u[2 * k] = bf_lo(vw[k]) * sigmoidf_fast(bf_lo(gw[k])); u[2 * k + 1] = bf_hi(vw[k]) * sigmoidf_fast(bf_hi(gw[k])); }
                LAS f16x4* dst = (LAS f16x4*)(U + j * CW + cc); dst[0] = (f16x4){(_Float16)u[0], (_Float16)u[1], (_Float16)u[2], (_Float16)u[3]}; dst[1] = (f16x4){(_Float16)u[4], (_Float16)u[5], (_Float16)u[6], (_Float16)u[7]}; }
        }
    }
    __syncthreads();
    const int cq = tid & 127, tq = tid >> 7;
#pragma unroll 1
    for (int k3 = 0; k3 < 3; ++k3) { const int c = cq + 128 * k3;
        float w[31], res[16];
#pragma unroll
        for (int kk = 0; kk < 31; ++kk) w[kk] = a.in[I_CONVW][kk * CW + c];
        const float bias = a.in[I_CONVB][c];
#pragma unroll
        for (int tt = 0; tt < 16; ++tt) res[tt] = bias;
#pragma unroll
        for (int jj = 0; jj < 46; ++jj) { const float uv = (float)U[(tq * 16 + jj) * CW + c];
#pragma unroll
            for (int tt = 0; tt < 16; ++tt) { if (jj - tt >= 0 && jj - tt <= 30) res[tt] += uv * w[jj - tt]; } }
#pragma unroll
        for (int tt = 0; tt < 16; ++tt) Cc[(tq * 16 + tt) * CW + c] = (_Float16)res[tt];
    }
    __syncthreads();
    for (int tt = 0; tt < 8; ++tt) { const int t = wave * 8 + tt;
        float v[6]; float s = 0.f;
#pragma unroll
        for (int i = 0; i < 6; ++i) { v[i] = (float)Cc[t * CW + lane + 64 * i]; s += v[i]; }
        const float mean = wave_sum(s) * (1.f / CW); float q = 0.f;
#pragma unroll
        for (int i = 0; i < 6; ++i) { v[i] -= mean; q += v[i] * v[i]; }
        const float rstd = 1.0f / sqrtf(wave_sum(q) * (1.f / CW) + 1e-5f);
        bf16_t* orow = MIX + (size_t)(b * SEQ + t0 + t) * D + 256;
#pragma unroll
        for (int i = 0; i < 6; ++i) { const int c = lane + 64 * i; const float y = v[i] * rstd * a.in[I_CLNG][c] + a.in[I_CLNB][c]; const float o = y * sigmoidf_fast(y);
            orow[c] = (bf16_t)(pk_bf16(o, 0.f) & 0xffffu); }
    }
}

constexpr int PR_AS = 784;
constexpr int PR_RK = 64 * PR_AS;
constexpr int PR_RKS = 1536;
constexpr int PR_RN = PR_RK + 64 * PR_RKS;
constexpr int PR_CST = PR_RN + 2048;
static_assert(PR_CST + 7 * 384 * 4 <= LDS_BYTES - 64, "prep LDS map");
template <int CTRL> __device__ __forceinline__ f32x4 dpp4(f32x4 x) { return (f32x4){dpp_f<CTRL>(x.x), dpp_f<CTRL>(x.y), dpp_f<CTRL>(x.z), dpp_f<CTRL>(x.w)}; }
__device__ __forceinline__ void prep_unit(const Args& a, LAS unsigned char* lds, int unit) {
    const int tid = threadIdx.x, lane = tid & 63, wave = __builtin_amdgcn_readfirstlane(tid >> 6);
    const int b = unit >> 6, t0 = (unit & 63) * 64;
    const bf16_t* __restrict__ P = (const bf16_t*)(a.ws + WS_P);
    const float* __restrict__ mu = a.in[I_SHIFTMU];
    LAS float* RNs = (LAS float*)(lds + PR_RN); LAS float* CST = (LAS float*)(lds + PR_CST);
    __syncthreads();
    for (int i = tid; i < 7 * 384; i += NTHREADS) { const int w7 = i / 384, c7 = i % 384;
        CST[i] = (w7 == 0) ? a.in[I_KK][c7] : (w7 == 1) ? a.in[I_KA][c7] : (w7 == 2) ? a.in[I_RK][c7] : (w7 < 5) ? a.in[I_DW0][(w7 - 3) * RW + c7] : a.in[I_IA0][(w7 - 5) * RW + c7]; }
#ifndef PREP_REP1
#define PREP_REP1 1
#endif
#ifndef PREP_REP2
#define PREP_REP2 1
#endif
#pragma unroll 1
    for (int rp1 = 0; rp1 < PREP_REP1; ++rp1)
#pragma unroll 1
    for (int q0 = tid; q0 < 64 * 192; q0 += 4 * NTHREADS) {
        u32x4 cuv[4], pvv[4], nvv[4];
#pragma unroll
        for (int u4 = 0; u4 < 4; ++u4) { const int q = q0 + u4 * NTHREADS, tt = q / 192, c8 = (q % 192) * 8, s = t0 + tt;
            const bf16_t* row = P + ((size_t)b * SEQ + s) * PLD + 768 + c8;
            cuv[u4] = *(const u32x4*)row;
            pvv[u4] = (s > 0) ? *(const u32x4*)(row - PLD) : (u32x4){0u, 0u, 0u, 0u};
            nvv[u4] = (s < SEQ - 1) ? *(const u32x4*)(row + PLD) : (u32x4){0u, 0u, 0u, 0u}; }
#pragma unroll
        for (int u4 = 0; u4 < 4; ++u4) { const int q = q0 + u4 * NTHREADS, tt = q / 192, c8 = (q % 192) * 8, s = t0 + tt; const size_t tok = (size_t)b * SEQ + s;
            const u32x4 cu = cuv[u4], pv = pvv[u4], nv = nvv[u4];
            const unsigned cw[4] = {cu.x, cu.y, cu.z, cu.w}, pw[4] = {pv.x, pv.y, pv.z, pv.w}, nw[4] = {nv.x, nv.y, nv.z, nv.w};
            const f32x4 m0a = *(const f32x4*)(mu + c8), m0b = *(const f32x4*)(mu + c8 + 4), m1a = *(const f32x4*)(mu + 1536 + c8), m1b = *(const f32x4*)(mu + 1536 + c8 + 4);
            const float m0[8] = {m0a.x, m0a.y, m0a.z, m0a.w, m0b.x, m0b.y, m0b.z, m0b.w}, m1[8] = {m1a.x, m1a.y, m1a.z, m1a.w, m1b.x, m1b.y, m1b.z, m1b.w};
            float pf[8];
#pragma unroll
            for (int k = 0; k < 4; ++k) { const float c0 = bf_lo(cw[k]), c1 = bf_hi(cw[k]);
                pf[2 * k] = c0 + m0[2 * k] * (bf_lo(pw[k]) - c0) + m1[2 * k] * (bf_lo(nw[k]) - c0);
                pf[2 * k + 1] = c1 + m0[2 * k + 1] * (bf_hi(pw[k]) - c1) + m1[2 * k + 1] * (bf_hi(nw[k]) - c1); }
            if (c8 < 768) {
                f16x4 h0 = {(_Float16)pf[0], (_Float16)pf[1], (_Float16)pf[2], (_Float16)pf[3]}, h1 = {(_Float16)pf[4], (_Float16)pf[5], (_Float16)pf[6], (_Float16)pf[7]};
                LAS f16x4* dst = (LAS f16x4*)(lds + PR_RK + tt * PR_RKS + c8 * 2); dst[0] = h0; dst[1] = h1;
                if (c8 >= 384) { const f32x4 ka = *(const f32x4*)(a.in[I_KK] + c8 - 384), kb = *(const f32x4*)(a.in[I_KK] + c8 - 384 + 4);
                    float ssq = (pf[0] * ka.x) * (pf[0] * ka.x) + (pf[1] * ka.y) * (pf[1] * ka.y) + (pf[2] * ka.z) * (pf[2] * ka.z) + (pf[3] * ka.w) * (pf[3] * ka.w)
                              + (pf[4] * kb.x) * (pf[4] * kb.x) + (pf[5] * kb.y) * (pf[5] * kb.y) + (pf[6] * kb.z) * (pf[6] * kb.z) + (pf[7] * kb.w) * (pf[7] * kb.w);
                    ssq = sum8(ssq);
                    if ((lane & 7) == 0) RNs[tt * 8 + ((c8 - 384) >> 6)] = __builtin_amdgcn_rsqf(ssq + 1e-12f); }
            } else if (c8 < 1152) {
                u32x4 w; w.x = pk_bf16(pf[0], pf[1]); w.y = pk_bf16(pf[2], pf[3]); w.z = pk_bf16(pf[4], pf[5]); w.w = pk_bf16(pf[6], pf[7]);
                *(u32x4*)((bf16_t*)scan_arr(a.ws, 0) + hat_off(0, tok, c8 - 768)) = w;
            } else {
                const int cc = c8 - 1152;
#pragma unroll
                for (int k = 0; k < 8; ++k) { if (cc < 128) pf[k] = 1.0f - 2.0f * __builtin_amdgcn_rcpf(1.0f + __builtin_amdgcn_exp2f(2.8853900817779268f * pf[k])); else if (cc >= 256) pf[k] = sigmoidf_fast(pf[k]); }
                u32x4 w; w.x = pk_bf16(pf[0], pf[1]); w.y = pk_bf16(pf[2], pf[3]); w.z = pk_bf16(pf[4], pf[5]); w.w = pk_bf16(pf[6], pf[7]);
                *(LAS u32x4*)(lds + tt * PR_AS + cc * 2) = w; }
        }
    }
    __syncthreads();
    const int l15 = lane & 15, kq = lane >> 4;
    const bf16_t* SM = (const bf16_t*)(a.ws + WS_SMALL);
    float* __restrict__ PCg = (float*)(a.ws + WS_PC); float* __restrict__ BON = (float*)(a.ws + WS_BON);
    bf16x8 Fc[16], Fn[16];
#define PREP_CH(nt_) (32 * ((nt_) >> 1) + 8 * (l15 >> 2) + 4 * ((nt_) & 1) + (l15 & 3))
#define PREP_LOADF(st_) do { const int it_ = wave + 8 * ((st_) / 3), kind_ = (st_) % 3, hd_ = it_ >> 2; \
        if (kind_ < 2) { const bf16_t* w0_ = SM + (size_t)kind_ * RW * 64; const bf16_t* w1_ = SM + (size_t)(2 + kind_) * RW * 64; \
            _Pragma("unroll") for (int f_ = 0; f_ < 16; ++f_) Fn[f_] = *(const bf16x8*)((((f_ >> 2) & 1) ? w1_ : w0_) + (size_t)(hd_ * 64 + PREP_CH(f_ & 3)) * 64 + (f_ >> 3) * 32 + kq * 8); } \
        else { const bf16_t* wg_ = SM + (size_t)4 * RW * 64; \
            _Pragma("unroll") for (int f_ = 0; f_ < 16; ++f_) Fn[f_] = *(const bf16x8*)(wg_ + (size_t)(hd_ * 64 + PREP_CH(f_ & 3)) * 128 + (f_ >> 2) * 32 + kq * 8); } } while (0)
    PREP_LOADF(0);
#pragma unroll 1
    for (int st = 0; st < 9; ++st) {
#pragma unroll
        for (int f = 0; f < 16; ++f) Fc[f] = Fn[f];
        const int it = wave + 8 * (st / 3), kind = st % 3, hd = it >> 2, mt = it & 3, tokl = mt * 16 + l15; const size_t tok = (size_t)b * SEQ + t0 + tokl;
        if (kind < 2) {
            const int d = kind;
            f32x4 accW[4], accA[4];
#pragma unroll
            for (int nt = 0; nt < 4; ++nt) { accW[nt] = (f32x4){0.f, 0.f, 0.f, 0.f}; accA[nt] = (f32x4){0.f, 0.f, 0.f, 0.f}; }
#pragma unroll
            for (int ks = 0; ks < 2; ++ks) {
                const bf16x8 aw = *(const LAS bf16x8*)(lds + tokl * PR_AS + (d * 64 + ks * 32 + kq * 8) * 2), aa = *(const LAS bf16x8*)(lds + tokl * PR_AS + ((2 + d) * 64 + ks * 32 + kq * 8) * 2);
#pragma unroll
                for (int nt = 0; nt < 4; ++nt) { accW[nt] = MFMA16(Fc[ks * 8 + nt], aw, accW[nt]); accA[nt] = MFMA16(Fc[ks * 8 + 4 + nt], aa, accA[nt]); }
            }
            if (st + 1 < 9) PREP_LOADF(st + 1);
            const float rn = RNs[tokl * 8 + hd];
            bf16_t* AHg = (bf16_t*)scan_arr(a.ws, 1 + 4 * d); bf16_t* RHg = (bf16_t*)scan_arr(a.ws, 2 + 4 * d); bf16_t* BHg = (bf16_t*)scan_arr(a.ws, 3 + 4 * d); bf16_t* KHg = (bf16_t*)scan_arr(a.ws, 4 + 4 * d);
            float bsum = 0.f;
            u32x2 hA[2], hR[2], hB[2], hK[2];
#pragma unroll
            for (int nt = 0; nt < 4; ++nt) { const int ch = hd * 64 + 32 * (nt >> 1) + 8 * kq + 4 * (nt & 1);
                const f32x4 bW = *(const LAS f32x4*)(CST + (3 + d) * 384 + ch), bA = *(const LAS f32x4*)(CST + (5 + d) * 384 + ch);
                const f32x4 kkw = *(const LAS f32x4*)(CST + ch), kaw = *(const LAS f32x4*)(CST + 384 + ch), rkw = *(const LAS f32x4*)(CST + 768 + ch);
                const f32x4 zw = accW[nt] + bW, za = accA[nt] + bA;
                f32x4 lw, av;
#pragma unroll
                for (int e = 0; e < 4; ++e) { lw[e] = -0.606531f * 1.4426950408889634f * sigmoidf_fast(zw[e]); av[e] = sigmoidf_fast(za[e]); }
                f32x4 cum = lw;
                if (d == 0) { cum += dpp4<0x111>(cum); cum += dpp4<0x112>(cum); cum += dpp4<0x114>(cum); cum += dpp4<0x118>(cum); }
                else        { cum += dpp4<0x101>(cum); cum += dpp4<0x102>(cum); cum += dpp4<0x104>(cum); cum += dpp4<0x108>(cum); }
                f32x4 Pt, Pinv, Pprev;
#pragma unroll
                for (int e = 0; e < 4; ++e) { Pt[e] = __builtin_amdgcn_exp2f(cum[e]); Pinv[e] = __builtin_amdgcn_rcpf(Pt[e]); Pprev[e] = __builtin_amdgcn_exp2f(cum[e] - lw[e]); }
                const f32x4 r4 = __builtin_convertvector(*(const LAS f16x4*)(lds + PR_RK + tokl * PR_RKS + ch * 2), f32x4);
                const f32x4 k4 = __builtin_convertvector(*(const LAS f16x4*)(lds + PR_RK + tokl * PR_RKS + (384 + ch) * 2), f32x4);
                const f32x4 kk = k4 * kkw * rn, kd = k4 * (1.0f + (av - 1.0f) * kaw);
                hA[nt & 1] = f32_to_bf4(-kk * Pprev); hR[nt & 1] = f32_to_bf4(r4 * Pt); hB[nt & 1] = f32_to_bf4(kk * av * Pinv); hK[nt & 1] = f32_to_bf4(kd * Pinv);
                const f32x4 bt = r4 * kd * rkw; bsum += (bt.x + bt.y) + (bt.z + bt.w);
                if (l15 == (d ? 0 : 15)) *(f32x4*)(PCg + ((size_t)d * (T / 16) + (tok >> 4)) * RW + ch) = Pt;
                if (nt & 1) { const int c8 = ch - 4; const size_t eo = hat_off(1, tok, c8);
                    *(u32x4*)(AHg + eo) = (u32x4){hA[0].x, hA[0].y, hA[1].x, hA[1].y}; *(u32x4*)(RHg + eo) = (u32x4){hR[0].x, hR[0].y, hR[1].x, hR[1].y};
                    *(u32x4*)(BHg + eo) = (u32x4){hB[0].x, hB[0].y, hB[1].x, hB[1].y}; *(u32x4*)(KHg + hat_off(4 + 4 * d, tok, c8)) = (u32x4){hK[0].x, hK[0].y, hK[1].x, hK[1].y}; }
            }
            bsum += __shfl_xor(bsum, 16); bsum += __shfl_xor(bsum, 32);
            if (kq == 0) BON[(size_t)d * T * NH + tok * NH + hd] = bsum;
        } else {
            f32x4 acc[4];
#pragma unroll
            for (int nt = 0; nt < 4; ++nt) acc[nt] = (f32x4){0.f, 0.f, 0.f, 0.f};
#pragma unroll
            for (int ks = 0; ks < 4; ++ks) { const bf16x8 afr = *(const LAS bf16x8*)(lds + tokl * PR_AS + (256 + ks * 32 + kq * 8) * 2);
#pragma unroll
                for (int nt = 0; nt < 4; ++nt) acc[nt] = MFMA16(Fc[ks * 4 + nt], afr, acc[nt]); }
            if (st + 1 < 9) PREP_LOADF(st + 1);
#pragma unroll
            for (int pr = 0; pr < 2; ++pr) { const u32x2 g0 = f32_to_bf4(acc[2 * pr]), g1 = f32_to_bf4(acc[2 * pr + 1]);
                *(u32x4*)((bf16_t*)(a.ws + WS_G) + tok * RW + hd * 64 + 32 * pr + 8 * kq) = (u32x4){g0.x, g0.y, g1.x, g1.y}; }
        }
    }
#undef PREP_LOADF
#undef PREP_CH
}

__device__ __forceinline__ void glds16_asm(const void* gptr, LAS unsigned char* ldst) {
    const unsigned la = __builtin_amdgcn_readfirstlane((unsigned)(size_t)ldst);
    asm volatile("s_mov_b32 m0, %1\n\ts_nop 0\n\tglobal_load_lds_dwordx4 %0, off" :: "v"(gptr), "s"(la) : "m0", "memory");
}
constexpr int CK = 16, NCHUNK = SEQ / CK, CS_NS = 8, CS_NPROD = 6, CS_NCONS = 2;
constexpr int SL_ATIL = 0, SL_RTIL = 2048, SL_BH = 4096, SL_KH = 6144, SL_V = 8192, SL_ULOC = 10240, SL_YLOC = 12288, SL_PC = 14336, SL_BYTES = 14592;
constexpr int PS_AH = 0, PS_RH = 2048, PS_BYTES = 4096;
constexpr int CS_PS_OFF = CS_NS * SL_BYTES, CS_FLAG_OFF = CS_PS_OFF + CS_NPROD * PS_BYTES;
static_assert(CS_FLAG_OFF + 64 <= LDS_BYTES - 64, "chunked scan LDS map");
__device__ __forceinline__ int swz(int t, int j) { return t * 128 + ((((j >> 3) ^ (t & 7))) << 4) + ((j & 4) << 1); }
__device__ __forceinline__ void scan_chunked_unit(const Args& a, LAS unsigned char* lds, int unit) {
    const int tid = threadIdx.x, lane = tid & 63, wave = __builtin_amdgcn_readfirstlane(tid >> 6);
    const int dir = unit & 1, bh = unit >> 1, b = bh / NH, hd = bh % NH;
    const int c16 = lane & 15, q = lane >> 4, qp = c16 >> 2, pp = c16 & 3;
    volatile LAS unsigned* FULL = (volatile LAS unsigned*)(lds + CS_FLAG_OFF);
    volatile LAS unsigned* DONE = FULL + 8;
    float* Yg = (float*)(a.ws + (dir ? WS_YB : WS_YF));
    __syncthreads();
    if (tid < 16) FULL[tid] = 0u;
    __syncthreads();
    if (wave >= CS_NCONS) {
        const int pw = wave - CS_NCONS;
        LAS unsigned char* ps = lds + CS_PS_OFF + pw * PS_BYTES;
        const bf16_t* ARR[5] = {(const bf16_t*)scan_arr(a.ws, 1 + 4 * dir), (const bf16_t*)scan_arr(a.ws, 2 + 4 * dir), (const bf16_t*)scan_arr(a.ws, 3 + 4 * dir), (const bf16_t*)scan_arr(a.ws, 4 + 4 * dir), (const bf16_t*)scan_arr(a.ws, 0)};
        const int AIDX[5] = {1 + 4 * dir, 2 + 4 * dir, 3 + 4 * dir, 4 + 4 * dir, 0};
        const float* PCg = (const float*)(a.ws + WS_PC) + (size_t)dir * (T / 16) * RW + hd * 64 + lane;
        u32x4 pf[10];
#define CS_ISSUE(cc) do { _Pragma("unroll") for (int ar_ = 0; ar_ < 5; ++ar_) _Pragma("unroll") for (int hf_ = 0; hf_ < 2; ++hf_) { \
            const int row_ = hf_ * 8 + (lane >> 3); const int st_ = (cc) * CK + row_; const int t_ = dir ? (SEQ - 1 - st_) : st_; \
            pf[ar_ * 2 + hf_] = *(const u32x4*)(ARR[ar_] + hat_off(AIDX[ar_], (size_t)b * SEQ + t_, hd * 64 + 8 * ((lane & 7) ^ (row_ & 7)))); } } while (0)
#define CS_PCLOAD(cc) PCg[(size_t)((size_t)b * (SEQ / CK) + (dir ? (NCHUNK - 1 - (cc)) : (cc))) * RW]
        CS_ISSUE(pw);
        float pcn = CS_PCLOAD(pw);
#pragma unroll 1
        for (int c = pw; c < NCHUNK; c += CS_NPROD) {
            const int slot = c % CS_NS; LAS unsigned char* sl = lds + slot * SL_BYTES;
            { unsigned sp = 0; const unsigned want = (unsigned)CS_NCONS * (unsigned)(c / CS_NS); while (DONE[slot] < want) { __builtin_amdgcn_s_sleep(1); if (++sp > (1u << 22)) break; } }
            asm volatile("" ::: "memory");
            *(LAS u32x4*)(ps + PS_AH + lane * 16) = pf[0]; *(LAS u32x4*)(ps + PS_AH + 1024 + lane * 16) = pf[1];
            *(LAS u32x4*)(ps + PS_RH + lane * 16) = pf[2]; *(LAS u32x4*)(ps + PS_RH + 1024 + lane * 16) = pf[3];
            *(LAS u32x4*)(sl + SL_BH + lane * 16) = pf[4]; *(LAS u32x4*)(sl + SL_BH + 1024 + lane * 16) = pf[5];
            *(LAS u32x4*)(sl + SL_KH + lane * 16) = pf[6]; *(LAS u32x4*)(sl + SL_KH + 1024 + lane * 16) = pf[7];
            *(LAS u32x4*)(sl + SL_V + lane * 16) = pf[8]; *(LAS u32x4*)(sl + SL_V + 1024 + lane * 16) = pf[9];
            *(LAS float*)(sl + SL_PC + lane * 4) = pcn;
            if (c + CS_NPROD < NCHUNK) { CS_ISSUE(c + CS_NPROD); pcn = CS_PCLOAD(c + CS_NPROD); }
            asm volatile("s_waitcnt lgkmcnt(0)" ::: "memory");
#ifndef PROD_REP
#define PROD_REP 1
#endif
#pragma unroll 1
            for (int rpp = 0; rpp < PROD_REP; ++rpp) {
            bf16x8 AHf[2], BHf[2], KHf[2], RHf[2];
#pragma unroll
            for (int ks = 0; ks < 2; ++ks) { const int o = swz(c16, 32 * ks + 8 * q);
                AHf[ks] = *(const LAS bf16x8*)(ps + PS_AH + o); RHf[ks] = *(const LAS bf16x8*)(ps + PS_RH + o); BHf[ks] = *(const LAS bf16x8*)(sl + SL_BH + o); KHf[ks] = *(const LAS bf16x8*)(sl + SL_KH + o); }
            f32x4 Mab = {0.f, 0.f, 0.f, 0.f}, Mak = Mab, MrbT = Mab, MrkT = Mab, MabT = Mab;
#pragma unroll
            for (int ks = 0; ks < 2; ++ks) { Mab = MFMA16(AHf[ks], BHf[ks], Mab); MabT = MFMA16(BHf[ks], AHf[ks], MabT); Mak = MFMA16(AHf[ks], KHf[ks], Mak); MrbT = MFMA16(BHf[ks], RHf[ks], MrbT); MrkT = MFMA16(KHf[ks], RHf[ks], MrkT); }
#pragma unroll
            for (int r = 0; r < 4; ++r) { const bool lt = c16 < 4 * q + r, gt = 4 * q + r < c16, le = 4 * q + r <= c16;
                Mab[r] = lt ? Mab[r] : 0.f; Mak[r] = lt ? Mak[r] : 0.f; MabT[r] = gt ? MabT[r] : 0.f; MrbT[r] = le ? MrbT[r] : 0.f; MrkT[r] = le ? MrkT[r] : 0.f; }
            const f32x4 z4 = {0.f, 0.f, 0.f, 0.f};
            const bf16x8 fN = frag_lo4(Mab), fNT = frag_lo4(MabT);
            const f32x4 N2 = MFMA16(fNT, fN, z4), N2T = MFMA16(fN, fNT, z4);
            f32x4 PT = MabT;
#pragma unroll
            for (int r = 0; r < 4; ++r) PT[r] += (4 * q + r == c16) ? 1.0f : 0.f;
            const bf16x8 fN2 = frag_lo4(N2), fN2T = frag_lo4(N2T);
            PT = MFMA16(fN2, frag_lo4(PT), PT);
            const f32x4 N4 = MFMA16(fN2T, fN2, z4), N4T = MFMA16(fN2, fN2T, z4);
            const bf16x8 fN4 = frag_lo4(N4), fN4T = frag_lo4(N4T);
            PT = MFMA16(fN4, frag_lo4(PT), PT);
            const f32x4 N8 = MFMA16(fN4T, fN4, z4);
            PT = MFMA16(frag_lo4(N8), frag_lo4(PT), PT);
            const bf16x8 LinvF = frag_lo4(PT);
            const bf16x8 MakF = frag_lo4(Mak), MrbTF = frag_lo4(MrbT);
            const f32x4 W1 = MFMA16(LinvF, MakF, z4);
            const f32x4 W1T = MFMA16(MakF, LinvF, z4);
            const f32x4 W2T = MFMA16(frag_lo4(W1), MrbTF, MrkT);
            f32x4 AtT[4], RtT[4];
#pragma unroll
            for (int jt = 0; jt < 4; ++jt) {
                const bf16x8 ahF = frag_cat(__builtin_bit_cast(u32x2, tr_read16(ps + PS_AH + swz(4 * q + qp, 16 * jt + 4 * pp))), (u32x2){0u, 0u});
                const f32x4 AtN = MFMA16(LinvF, ahF, z4);
                AtT[jt] = MFMA16(ahF, LinvF, z4);
                const f32x4 rinit = bf4_to_f32(*(const LAS u32x2*)(ps + PS_RH + swz(c16, 16 * jt + 4 * q)));
                RtT[jt] = MFMA16(frag_lo4(AtN), MrbTF, rinit);
            }
#pragma unroll
            for (int ks = 0; ks < 2; ++ks) {
                const u32x4 wa = {pk_bf16(AtT[2 * ks][0], AtT[2 * ks][1]), pk_bf16(AtT[2 * ks][2], AtT[2 * ks][3]), pk_bf16(AtT[2 * ks + 1][0], AtT[2 * ks + 1][1]), pk_bf16(AtT[2 * ks + 1][2], AtT[2 * ks + 1][3])};
                const u32x4 wr = {pk_bf16(RtT[2 * ks][0], RtT[2 * ks][1]), pk_bf16(RtT[2 * ks][2], RtT[2 * ks][3]), pk_bf16(RtT[2 * ks + 1][0], RtT[2 * ks + 1][1]), pk_bf16(RtT[2 * ks + 1][2], RtT[2 * ks + 1][3])};
                *(LAS u32x4*)(sl + SL_ATIL + ks * 1024 + lane * 16) = wa; *(LAS u32x4*)(sl + SL_RTIL + ks * 1024 + lane * 16) = wr; }
            *(LAS u32x2*)(sl + SL_ULOC + lane * 8) = f32_to_bf4(W1T); *(LAS u32x2*)(sl + SL_YLOC + lane * 8) = f32_to_bf4(W2T);
            }
            asm volatile("s_waitcnt lgkmcnt(0)" ::: "memory");
            if (lane == 0) FULL[slot] = (unsigned)(c + 1);
        }
#undef CS_ISSUE
#undef CS_PCLOAD
    } else {
        struct ConsOps { bf16x8 at0, at1, rt0, rt1, bk[4]; u32x2 w1w, w2w, vfw[2]; f32x4 pc[4]; };
        f32x4 S[2][4];
#pragma unroll
        for (int ti = 0; ti < 2; ++ti)
#pragma unroll
            for (int mt = 0; mt < 4; ++mt) S[ti][mt] = (f32x4){0.f, 0.f, 0.f, 0.f};
#define CONS_LOAD(X, cc) do { const int slot_ = (cc) % CS_NS; LAS unsigned char* sl_ = lds + slot_ * SL_BYTES; \
            { unsigned sp_ = 0; while (FULL[slot_] < (unsigned)((cc) + 1)) { __builtin_amdgcn_s_sleep(1); if (++sp_ > (1u << 22)) break; } } \
            asm volatile("" ::: "memory"); \
            X.at0 = *(const LAS bf16x8*)(sl_ + SL_ATIL + lane * 16); X.at1 = *(const LAS bf16x8*)(sl_ + SL_ATIL + 1024 + lane * 16); \
            X.rt0 = *(const LAS bf16x8*)(sl_ + SL_RTIL + lane * 16); X.rt1 = *(const LAS bf16x8*)(sl_ + SL_RTIL + 1024 + lane * 16); \
            X.w1w = *(const LAS u32x2*)(sl_ + SL_ULOC + lane * 8); X.w2w = *(const LAS u32x2*)(sl_ + SL_YLOC + lane * 8); \
            _Pragma("unroll") for (int mt_ = 0; mt_ < 4; ++mt_) { X.pc[mt_] = *(const LAS f32x4*)(sl_ + SL_PC + (16 * mt_ + 4 * q) * 4); \
                X.bk[mt_] = frag_cat(__builtin_bit_cast(u32x2, tr_read16(sl_ + SL_BH + swz(4 * q + qp, 16 * mt_ + 4 * pp))), __builtin_bit_cast(u32x2, tr_read16(sl_ + SL_KH + swz(4 * q + qp, 16 * mt_ + 4 * pp)))); } \
            _Pragma("unroll") for (int ti_ = 0; ti_ < 2; ++ti_) X.vfw[ti_] = __builtin_bit_cast(u32x2, tr_read16(sl_ + SL_V + swz(4 * q + qp, 16 * (2 * wave + ti_) + 4 * pp))); } while (0)
#define CONS_COMPUTE(X, cc) do { const f32x4 z4c_ = {0.f, 0.f, 0.f, 0.f}; const bf16x8 w1f_ = frag_cat(X.w1w, (u32x2){0u, 0u}), w2f_ = frag_cat(X.w2w, (u32x2){0u, 0u}); \
            _Pragma("unroll") for (int ti_ = 0; ti_ < 2; ++ti_) { const int nt_ = 2 * wave + ti_; \
                const bf16x8 vB_ = frag_cat(X.vfw[ti_], (u32x2){0u, 0u}); \
                const bf16x8 Sb0_ = frag_cat(f32_to_bf4(S[ti_][0]), f32_to_bf4(S[ti_][1])), Sb1_ = frag_cat(f32_to_bf4(S[ti_][2]), f32_to_bf4(S[ti_][3])); \
                const f32x4 U0_ = MFMA16(X.at0, Sb0_, MFMA16(w1f_, vB_, z4c_)), U1_ = MFMA16(X.at1, Sb1_, z4c_); \
                const f32x4 Y0_ = MFMA16(X.rt0, Sb0_, MFMA16(w2f_, vB_, z4c_)), Y1_ = MFMA16(X.rt1, Sb1_, z4c_); \
                const f32x4 UT_ = U0_ + U1_, YT_ = Y0_ + Y1_; \
                const bf16x8 Ub_ = frag_cat(f32_to_bf4(UT_), X.vfw[ti_]); \
                _Pragma("unroll") for (int mt_ = 0; mt_ < 4; ++mt_) { S[ti_][mt_] = MFMA16(X.bk[mt_], Ub_, S[ti_][mt_]); S[ti_][mt_] = S[ti_][mt_] * X.pc[mt_]; } \
                *(f32x4*)(Yg + ((((size_t)b * NCHUNK + (dir ? (NCHUNK - 1 - (cc)) : (cc))) * NH + hd) * 64 + 16 * nt_ + c16) * 16 + 4 * q) = YT_; } } while (0)
#define CONS_DONE(cc) do { asm volatile("s_waitcnt lgkmcnt(0)" ::: "memory"); if (lane == 0) (void)__hip_atomic_fetch_add((LAS unsigned*)&DONE[(cc) % CS_NS], 1u, __ATOMIC_RELAXED, __HIP_MEMORY_SCOPE_WORKGROUP); } while (0)
        ConsOps OA, OB;
        CONS_LOAD(OA, 0);
#pragma unroll 1
        for (int c = 0; c < NCHUNK; c += 2) {
            CONS_LOAD(OB, c + 1);
            CONS_COMPUTE(OA, c);
            CONS_DONE(c);
            if (c + 2 < NCHUNK) CONS_LOAD(OA, c + 2);
            CONS_COMPUTE(OB, c + 1);
            CONS_DONE(c + 1);
        }
#undef CONS_LOAD
#undef CONS_COMPUTE
#undef CONS_DONE
        unsigned tq0 = 0u, tq1 = 0u, tq2 = 0u, tq3 = 0u, tq4 = 0u, tq5 = 0u, tacc = 0u;
        (void)tq0; (void)tq1; (void)tq2; (void)tq3; (void)tq4; (void)tq5;
        (void)tacc;
    }
}

__device__ __forceinline__ void phase_post(const Args& a, int G) {
    const int tid = threadIdx.x, lane = tid & 63, wave = __builtin_amdgcn_readfirstlane(tid >> 6);
    const int gw = blockIdx.x * 8 + wave, NGW = G * 8, t = lane & 15, iq = lane >> 4;
    const float* __restrict__ YF = (const float*)(a.ws + WS_YF); const float* __restrict__ YB = (const float*)(a.ws + WS_YB); const float* __restrict__ BON = (const float*)(a.ws + WS_BON);
    const bf16_t* __restrict__ Vg = (const bf16_t*)scan_arr(a.ws, 0); const bf16_t* __restrict__ Gg = (const bf16_t*)(a.ws + WS_G); bf16_t* __restrict__ MIX = (bf16_t*)(a.ws + WS_MIX);
    float* ss = (float*)(a.ws + WS_SS);
    for (int i = blockIdx.x * NTHREADS + tid; i < T; i += G * NTHREADS) ss[i] = 0.f;
    constexpr int NIT = (T / 16) * NH;
#pragma unroll 1
    for (int it = gw; it < NIT; it += NGW) {
        const int tile = it / NH, hd = it - tile * NH, tok = tile * 16 + t;
        const float* yfp = YF + ((size_t)it * 64 + 16 * iq) * 16 + t; const float* ybp = YB + ((size_t)it * 64 + 16 * iq) * 16 + (15 - t);
        float y[16];
#pragma unroll
        for (int k = 0; k < 16; ++k) y[k] = yfp[k * 16] + ybp[k * 16];
        const u32x4 v0 = *(const u32x4*)(Vg + ((size_t)it * 16 + t) * 64 + 16 * iq), v1 = *(const u32x4*)(Vg + ((size_t)it * 16 + t) * 64 + 16 * iq + 8);
        const u32x4 g0 = *(const u32x4*)(Gg + (size_t)tok * RW + hd * 64 + 16 * iq), g1 = *(const u32x4*)(Gg + (size_t)tok * RW + hd * 64 + 16 * iq + 8);
        const float bon = BON[(size_t)tok * NH + hd] + BON[(size_t)T * NH + (size_t)tok * NH + hd];
        float sm = 0.f;
#pragma unroll
        for (int k = 0; k < 16; ++k) sm += y[k];
        sm += __shfl_xor(sm, 16); sm += __shfl_xor(sm, 32);
        const float mean = sm * (1.f / 64.f); float vs = 0.f;
#pragma unroll
        for (int k = 0; k < 16; ++k) { y[k] -= mean; vs += y[k] * y[k]; }
        vs += __shfl_xor(vs, 16); vs += __shfl_xor(vs, 32);
        const float rstd = 1.0f / sqrtf(vs * (1.f / 64.f) + 64e-5f);
        const unsigned vw[8] = {v0.x, v0.y, v0.z, v0.w, v1.x, v1.y, v1.z, v1.w}, gwd[8] = {g0.x, g0.y, g0.z, g0.w, g1.x, g1.y, g1.z, g1.w};
        unsigned ow[8];
#pragma unroll
        for (int k2 = 0; k2 < 8; ++k2) { const int ch = hd * 64 + 16 * iq + 2 * k2;
            const float o0 = (y[2 * k2] * rstd * a.in[I_LNXG][ch] + a.in[I_LNXB][ch] + bon * bf_lo(vw[k2])) * bf_lo(gwd[k2]);
            const float o1 = (y[2 * k2 + 1] * rstd * a.in[I_LNXG][ch + 1] + a.in[I_LNXB][ch + 1] + bon * bf_hi(vw[k2])) * bf_hi(gwd[k2]);
            ow[k2] = pk_bf16(o0, o1); }
        bf16_t* op = MIX + (size_t)tok * D + 640 + hd * 64 + 16 * iq;
        *(u32x4*)op = (u32x4){ow[0], ow[1], ow[2], ow[3]}; *(u32x4*)(op + 8) = (u32x4){ow[4], ow[5], ow[6], ow[7]};
    }
}

constexpr int RT_WS = 2064;
__device__ __forceinline__ void phase_router(const Args& a, LAS unsigned char* lds, int G) {
    const int tid = threadIdx.x, lane = tid & 63, wave = __builtin_amdgcn_readfirstlane(tid >> 6);
    const int gw = blockIdx.x * 8 + wave, NGW = G * 8, l15 = lane & 15, kq = lane >> 4;
    LAS bf16_t* WH = (LAS bf16_t*)lds; LAS bf16_t* WL = (LAS bf16_t*)(lds + 16 * RT_WS);
    for (int i = tid; i < D * NE; i += NTHREADS) { const int k = i >> 4, e = i & 15; const float w = a.in[I_WROUTER][i];
        const unsigned hi = pk_bf16(w, 0.f) & 0xffffu; const float rem = w - bf_lo(hi);
        WH[e * (RT_WS / 2) + k] = (bf16_t)hi; WL[e * (RT_WS / 2) + k] = (bf16_t)(pk_bf16(rem, 0.f) & 0xffffu); }
    __syncthreads();
    const float* __restrict__ X1 = (const float*)(a.ws + WS_X1); const float* __restrict__ ss = (const float*)(a.ws + WS_SS); bf16_t* __restrict__ H2 = (bf16_t*)(a.ws + WS_H2);
    float* __restrict__ AFF = (float*)(a.ws + WS_AFF); int* __restrict__ INV = (int*)(a.ws + WS_INV);
    const float* __restrict__ GF = a.in[I_NFFNG];
    for (int grp = gw; grp < T / 16; grp += NGW) {
        const int tok = grp * 16 + l15;
        const float rs = 1.0f / sqrtf(ss[tok] * (1.f / D) + 1e-6f);
        f32x4 acc = {0.f, 0.f, 0.f, 0.f};
        const float* xrow = X1 + (size_t)tok * D + 8 * kq; bf16_t* hrow = H2 + (size_t)tok * D + 8 * kq;
#pragma unroll 8
        for (int ks = 0; ks < 32; ++ks) {
            const f32x4 x0 = *(const f32x4*)(xrow + 32 * ks), x1v = *(const f32x4*)(xrow + 32 * ks + 4);
            const f32x4 g0 = *(const f32x4*)(GF + 32 * ks + 8 * kq), g1 = *(const f32x4*)(GF + 32 * ks + 8 * kq + 4);
            const f32x4 h0 = x0 * rs * g0, h1 = x1v * rs * g1;
            u32x4 hi; hi.x = pk_bf16(h0.x, h0.y); hi.y = pk_bf16(h0.z, h0.w); hi.z = pk_bf16(h1.x, h1.y); hi.w = pk_bf16(h1.z, h1.w);
            *(u32x4*)(hrow + 32 * ks) = hi;
            u32x4 lo; lo.x = pk_bf16(h0.x - bf_lo(hi.x), h0.y - bf_hi(hi.x)); lo.y = pk_bf16(h0.z - bf_lo(hi.y), h0.w - bf_hi(hi.y));
            lo.z = pk_bf16(h1.x - bf_lo(hi.z), h1.y - bf_hi(hi.z)); lo.w = pk_bf16(h1.z - bf_lo(hi.w), h1.w - bf_hi(hi.w));
            const bf16x8 ah = __builtin_bit_cast(bf16x8, hi), al = __builtin_bit_cast(bf16x8, lo);
            const bf16x8 bh = *(const LAS bf16x8*)(lds + l15 * RT_WS + (32 * ks + 8 * kq) * 2), bl = *(const LAS bf16x8*)(lds + 16 * RT_WS + l15 * RT_WS + (32 * ks + 8 * kq) * 2);
            acc = __builtin_amdgcn_mfma_f32_16x16x32_bf16(ah, bh, acc, 0, 0, 0);
            acc = __builtin_amdgcn_mfma_f32_16x16x32_bf16(al, bh, acc, 0, 0, 0);
            acc = __builtin_amdgcn_mfma_f32_16x16x32_bf16(ah, bl, acc, 0, 0, 0);
        }
#pragma unroll
        for (int rg = 0; rg < 4; ++rg) { const float mx = max16(acc[rg]); const float ex = __expf(acc[rg] - mx); const float sm = sum16(ex);
            const int t2 = grp * 16 + 4 * kq + rg, bb = t2 >> 12, sq = t2 & (SEQ - 1);
            AFF[((size_t)(bb * NE + l15)) * SEQ + sq] = ex / sm; }
        *(u32x4*)(INV + (size_t)grp * 256 + 4 * lane) = (u32x4){0xffffffffu, 0xffffffffu, 0xffffffffu, 0xffffffffu};
    }
}

__device__ __forceinline__ void topk_unit(const Args& a, LAS unsigned char* lds, int unit) {
    const int tid = threadIdx.x, lane = tid & 63, wave = __builtin_amdgcn_readfirstlane(tid >> 6);
    const int b = unit >> 4, e = unit & 15;
    const float* AFF = (const float*)(a.ws + WS_AFF) + (size_t)unit * SEQ;
    LAS unsigned* KEY = (LAS unsigned*)lds;
    LAS unsigned* HIST = (LAS unsigned*)(lds + 16384);
    LAS unsigned* CTL = (LAS unsigned*)(lds + 16384 + 1024);
    LAS unsigned* WS_ = (LAS unsigned*)(lds + 16384 + 2048);
    __syncthreads();
    unsigned key[8];
    { const u32x4 k0 = *(const u32x4*)(AFF + tid * 8), k1 = *(const u32x4*)(AFF + tid * 8 + 4); key[0] = k0.x; key[1] = k0.y; key[2] = k0.z; key[3] = k0.w; key[4] = k1.x; key[5] = k1.y; key[6] = k1.z; key[7] = k1.w; }
    if (tid == 0) { CTL[0] = 0u; CTL[1] = (unsigned)CAP; }
    unsigned prefix = 0u, mask = 0u;
#pragma unroll 1
    for (int pass = 0; pass < 4; ++pass) {
        const int shift = 24 - 8 * pass;
        if (tid < 256) HIST[tid] = 0u;
        __syncthreads();
#pragma unroll
        for (int i = 0; i < 8; ++i) if ((key[i] & mask) == prefix) (void)__hip_atomic_fetch_add(&HIST[(key[i] >> shift) & 255u], 1u, __ATOMIC_RELAXED, __HIP_MEMORY_SCOPE_WORKGROUP);
        __syncthreads();
        if (wave == 0) {
            const unsigned need = CTL[1];
            unsigned hv[4], tsum = 0u;
#pragma unroll
            for (int i = 0; i < 4; ++i) { hv[i] = HIST[255 - (4 * lane + i)]; tsum += hv[i]; }
            unsigned inc = tsum;
#pragma unroll
            for (int o = 1; o < 64; o <<= 1) { const unsigned v = __shfl_up(inc, o); if (lane >= o) inc += v; }
            unsigned exc = inc - tsum;
            if (exc < need && need <= inc) {
                unsigned run = exc; int di = 0;
#pragma unroll
                for (int i = 0; i < 4; ++i) { if (run < need && need <= run + hv[i]) { di = i; break; } run += hv[i]; }
                const unsigned digit = 255u - (unsigned)(4 * lane + di);
                CTL[0] = prefix | (digit << shift); CTL[1] = need - run;
            }
        }
        __syncthreads();
        prefix = CTL[0]; mask |= (255u << shift);
    }
    const unsigned thr = prefix, need_eq = CTL[1];
    unsigned ngt = 0u, neq = 0u;
#pragma unroll
    for (int i = 0; i < 8; ++i) { ngt += (key[i] > thr) ? 1u : 0u; neq += (key[i] == thr) ? 1u : 0u; }
    unsigned pk = ngt | (neq << 16), inc = pk;
#pragma unroll
    for (int o = 1; o < 64; o <<= 1) { const unsigned v = __shfl_up(inc, o); if (lane >= o) inc += v; }
    if (lane == 63) WS_[wave] = inc;
    __syncthreads();
    unsigned woff = 0u, tot = 0u;
#pragma unroll
    for (int w = 0; w < 8; ++w) { const unsigned v = WS_[w]; if (w < wave) woff += v; tot += v; }
    const unsigned exc = inc - pk + woff;
    unsigned gpos = exc & 0xffffu, epos = exc >> 16; const unsigned totgt = tot & 0xffffu;
    const int sbase = (e * BATCH + b) * CAP;
    int* ROWTOK = (int*)(a.ws + WS_ROWTOK); float* ROWGATE = (float*)(a.ws + WS_ROWGATE); int* INV = (int*)(a.ws + WS_INV);
#pragma unroll
    for (int i = 0; i < 8; ++i) {
        int pos = -1;
        if (key[i] > thr) pos = (int)gpos++;
        else if (key[i] == thr) { if (epos < need_eq) pos = (int)(totgt + epos); epos++; }
        if (pos >= 0) { const int s = tid * 8 + i, tok = b * SEQ + s, slot = sbase + pos;
            ROWTOK[slot] = tok; ROWGATE[slot] = __builtin_bit_cast(float, key[i]); INV[(size_t)tok * NE + e] = slot; }
    }
}

__device__ __forceinline__ void phase_final(const Args& a, int G) {
    const int tid = threadIdx.x, lane = tid & 63, wave = __builtin_amdgcn_readfirstlane(tid >> 6);
    const int gw = blockIdx.x * 8 + wave, NGW = G * 8;
    const float* __restrict__ X1 = (const float*)(a.ws + WS_X1); const bf16_t* __restrict__ YE = (const bf16_t*)(a.ws + WS_YE); const int* __restrict__ INV = (const int*)(a.ws + WS_INV);
    float* __restrict__ OUT = a.out;
    f32x4 gg[4];
#pragma unroll
    for (int j = 0; j < 4; ++j) gg[j] = *(const f32x4*)(a.in[I_FNG] + 4 * lane + 256 * j);
    int tok = gw;
    int invn = (tok < T) ? INV[(size_t)tok * NE + (lane & 15)] : -1;
    f32x4 xn[4];
#pragma unroll
    for (int j = 0; j < 4; ++j) xn[j] = (tok < T) ? *(const f32x4*)(X1 + (size_t)tok * D + 4 * lane + 256 * j) : (f32x4){0.f, 0.f, 0.f, 0.f};
    for (; tok < T; tok += NGW) {
        const int invc = invn; f32x4 v[4];
#pragma unroll
        for (int j = 0; j < 4; ++j) v[j] = xn[j];
        const int tn = tok + NGW;
        if (tn < T) { invn = INV[(size_t)tn * NE + (lane & 15)];
#pragma unroll
            for (int j = 0; j < 4; ++j) xn[j] = *(const f32x4*)(X1 + (size_t)tn * D + 4 * lane + 256 * j); }
        unsigned long long m = __ballot(invc >= 0) & 0xffffull;
        const int n = __builtin_popcountll(m);
        int sl[4]; float wt[4];
#pragma unroll
        for (int k = 0; k < 4; ++k) { int e = 0; if (m) { e = __builtin_ctzll(m); m &= m - 1; wt[k] = 1.f; sl[k] = __builtin_amdgcn_readlane(invc, e); } else { wt[k] = 0.f; sl[k] = 0; } }
        u32x2 rw[4][4];
#pragma unroll
        for (int k = 0; k < 4; ++k)
#pragma unroll
            for (int j = 0; j < 4; ++j) rw[k][j] = *(const u32x2*)(YE + (size_t)sl[k] * D + 4 * lane + 256 * j);
#pragma unroll
        for (int k = 0; k < 4; ++k)
#pragma unroll
            for (int j = 0; j < 4; ++j) { v[j].x += wt[k] * bf_lo(rw[k][j].x); v[j].y += wt[k] * bf_hi(rw[k][j].x); v[j].z += wt[k] * bf_lo(rw[k][j].y); v[j].w += wt[k] * bf_hi(rw[k][j].y); }
        if (n > 4) { while (m) { const int e = __builtin_ctzll(m); m &= m - 1; const int slot = __builtin_amdgcn_readlane(invc, e);
#pragma unroll
                for (int j = 0; j < 4; ++j) { const u32x2 w = *(const u32x2*)(YE + (size_t)slot * D + 4 * lane + 256 * j);
                    v[j].x += bf_lo(w.x); v[j].y += bf_hi(w.x); v[j].z += bf_lo(w.y); v[j].w += bf_hi(w.y); } } }
        float sq = 0.f;
#pragma unroll
        for (int j = 0; j < 4; ++j) sq += (v[j].x * v[j].x + v[j].y * v[j].y) + (v[j].z * v[j].z + v[j].w * v[j].w);
        float rs = 1.0f / sqrtf(wave_sum(sq) * (1.f / D) + 1e-6f);
#pragma unroll
        for (int j = 0; j < 4; ++j) *(f32x4*)(OUT + (size_t)tok * D + 4 * lane + 256 * j) = v[j] * rs * gg[j];
    }
}

#define XB_TMO      128
#define XB_XCNT(j)  (256  + 64 * (j))
#define XB_XSUB(j)  (1280 + 64 * (j))
#define XB_XGEN(j)  (2304 + 64 * (j))
#define XB_TOP      3328
#define XB_TOPGEN   3392
#define XCD_BAR_WORDS 3456
#define XB_SPIN_CAP (1u << 22)
__device__ __forceinline__ unsigned xb_ld(unsigned* p)              { return __hip_atomic_load(p, __ATOMIC_RELAXED, __HIP_MEMORY_SCOPE_AGENT); }
__device__ __forceinline__ unsigned xb_add(unsigned* p, unsigned v) { return __hip_atomic_fetch_add(p, v, __ATOMIC_RELAXED, __HIP_MEMORY_SCOPE_AGENT); }
__device__ __forceinline__ unsigned xb_xcc_id() { return (unsigned)__builtin_amdgcn_s_getreg((3 << 11) | 20) & 0xFu; }
#define XB_SPIN(cond, bar) do { unsigned _sp = 0; while (cond) { __builtin_amdgcn_s_sleep(1); \
    if ((++_sp & 255u) == 0u) { if (xb_ld(&(bar)[XB_TMO])) break; if (_sp > XB_SPIN_CAP) { atomicAdd(&(bar)[XB_TMO], 1u); break; } } } } while (0)
struct XcdBarrier { unsigned* bar; unsigned x; volatile LAS unsigned* st; };
__device__ __forceinline__ XcdBarrier xcd_barrier_post(unsigned* bar, volatile LAS unsigned* st) {
    XcdBarrier b; b.bar = bar; b.x = xb_xcc_id(); b.st = st;
    if (threadIdx.x == 0) (void)xb_add(&bar[XB_XCNT(b.x)], 1u);
    return b;
}
__device__ __forceinline__ void xcd_barrier_complete(unsigned* bar, unsigned x, unsigned& nloc, unsigned& nx) {
    const unsigned G = gridDim.x * gridDim.y * gridDim.z;
    unsigned sum, cnt, mine, sp = 0u;
    for (;;) {
        sum = 0u; cnt = 0u; mine = 0u;
#pragma unroll
        for (unsigned j = 0; j < 16; ++j) { const unsigned c = xb_ld(&bar[XB_XCNT(j)]); sum += c; cnt += (c > 0u) ? 1u : 0u; mine = (j == x) ? c : mine; }
        if (sum == G) break;
        __builtin_amdgcn_s_sleep(1);
        if ((++sp & 255u) == 0u) { if (xb_ld(&bar[XB_TMO])) break; if (sp > XB_SPIN_CAP) { atomicAdd(&bar[XB_TMO], 1u); break; } }
    }
    nloc = mine > 0u ? mine : 1u; nx = cnt > 0u ? cnt : 1u;
}
__device__ __forceinline__ void xcd_barrier(const XcdBarrier& b) {
    asm volatile("s_waitcnt vmcnt(0)" ::: "memory");
    __syncthreads();
    if (threadIdx.x == 0) {
        unsigned* bar = b.bar;
        __builtin_amdgcn_s_waitcnt(0);
        unsigned nloc = b.st[0], nx = b.st[1];
        if (nloc == 0u) { xcd_barrier_complete(bar, b.x, nloc, nx); b.st[0] = nloc; b.st[1] = nx; }
        const unsigned old = xb_add(&bar[XB_XSUB(b.x)], 1u);
        const unsigned gen = old / nloc;
        if (old + 1u == (gen + 1u) * nloc) {
            __builtin_amdgcn_fence(__ATOMIC_RELEASE, "agent");
            asm volatile("s_waitcnt vmcnt(0)" ::: "memory");
            const unsigned og = xb_add(&bar[XB_TOP], 1u);
            const unsigned tg = og / nx;
            if (og + 1u == (tg + 1u) * nx) xb_add(&bar[XB_TOPGEN], 1u);
            else XB_SPIN(xb_ld(&bar[XB_TOPGEN]) == tg, bar);
            __builtin_amdgcn_fence(__ATOMIC_ACQUIRE, "agent");
            xb_add(&bar[XB_XGEN(b.x)], 1u);
            asm volatile("s_waitcnt vmcnt(0)" ::: "memory");
        } else {
            XB_SPIN(xb_ld(&bar[XB_XGEN(b.x)]) == gen, bar);
            __builtin_amdgcn_fence(__ATOMIC_ACQUIRE, "agent");
            asm volatile("s_waitcnt vmcnt(0)" ::: "memory");
        }
    }
    __syncthreads();
}

#ifndef PH_MASK
#define PH_MASK 0x7ff
#endif
#ifndef REP_MASK
#define REP_MASK 0
#endif
#ifndef P2_MASK
#define P2_MASK 7
#endif
#ifndef P2_REP
#define P2_REP 0
#endif
constexpr int LDS_MISC = LDS_BYTES - 64;
constexpr size_t WS_CTL = 0, CTL_BYTES = 16384;
__global__ void __launch_bounds__(NTHREADS, 2) mega(Args a) {
    extern __shared__ __attribute__((aligned(16))) unsigned char lds_raw[];
    LAS unsigned char* lds = (LAS unsigned char*)lds_raw;
    cg::grid_group grid = cg::this_grid();
    const int G = gridDim.x, lo = a.ph_lo, hi = a.ph_hi;
    unsigned char* ws = a.ws;
    volatile LAS unsigned* misc = (volatile LAS unsigned*)(lds + LDS_MISC);
    if (threadIdx.x < 16) misc[threadIdx.x] = 0u;
    __syncthreads();
    XcdBarrier xbar = xcd_barrier_post((unsigned*)(ws + WS_CTL), misc);
#define IN(k) (((PH_MASK >> (k)) & 1) && lo <= (k) && (k) < hi)
#define NREP(k) (1 + ((REP_MASK >> (k)) & 1))
#define PHASE(k, ...) do { if (IN(k)) { for (int rep_ = 0; rep_ < NREP(k); ++rep_) { __VA_ARGS__; if (rep_ + 1 < NREP(k) || IN((k) + 1)) { if (lo < -1000) grid.sync();   xcd_barrier(xbar); } } } } while (0)

    PHASE(0, phase_prep(a, lds, G));

    PHASE(1, {
        pg8::Gemm g{(const bf16_t*)(ws + WS_XH), (const bf16_t*)(ws + WS_WINT), T, IN_PROJ, D};
        pg8::TripleOrder S; S.S0.init(T, IN_PROJ, G, 0); S.A1 = (const bf16_t*)(ws + WS_MEMN); S.B1 = (const bf16_t*)(ws + WS_WKT); S.A2 = (const bf16_t*)(ws + WS_WVT); S.B2 = (const bf16_t*)(ws + WS_MEMN);
        S.n1 = BATCH * NMEM / 256; S.n2 = BATCH * NMEM / 256; S.G = G; S.c = (int)blockIdx.x;
        pg8::EpiBf16x3 E{pg8::EpiBf16{(bf16_t*)(ws + WS_P), PLD, (bf16_t*)(ws + WS_Q)}, pg8::EpiBf16{(bf16_t*)(ws + WS_KMEM), 256, nullptr}, pg8::EpiBf16{(bf16_t*)(ws + WS_VT), BATCH * NMEM, nullptr}};
        pg8::gemm_phase<pg8::EpiBf16x3, pg8::TripleOrder, false>(lds, g, S, E, nullptr);
    });

    constexpr int NSCAN = BATCH * NH * 2;
    PHASE(2, {
        for (int u = blockIdx.x; u < 2048; u += G) {
            if (u < 1024) { for (int r2 = 0; r2 < 1 + ((P2_REP >> 1) & 1); ++r2) conv_unit(a, lds, u); }
            else { for (int r2 = 0; r2 < 1 + ((P2_REP >> 2) & 1); ++r2) prep_unit(a, lds, u - 1024); }
        }
    });

    PHASE(3, {
        int bid = blockIdx.x; int Gp = G; asm volatile("" : "+s"(bid), "+s"(Gp));
        for (int u = bid; u < NSCAN; u += Gp) scan_chunked_unit(a, lds, u);
        if (rep_ == 0) {
            if (Gp > NSCAN) { if (bid >= NSCAN) { for (int u = bid - NSCAN; u < 64; u += Gp - NSCAN) for (int r2 = 0; r2 < 1 + (P2_REP & 1); ++r2) attn_unit(a, lds, u);
                                                 } }
            else { for (int u = bid; u < 64; u += Gp) attn_unit(a, lds, u); }
        }
    });

    PHASE(4, phase_post(a, G));

    PHASE(5, {
        pg8::Gemm g{(const bf16_t*)(ws + WS_MIX), (const bf16_t*)(ws + WS_WOUTT), T, D, D}; pg8::StaticOrder S; S.init(T, D, G, (int)blockIdx.x);
        pg8::EpiResidSS E{a.in[I_X], (float*)(ws + WS_X1), (float*)(ws + WS_SS)}; pg8::gemm_phase<pg8::EpiResidSS, pg8::StaticOrder, false>(lds, g, S, E, nullptr);
    });

    PHASE(6, phase_router(a, lds, G));

    PHASE(7, { for (int u = blockIdx.x; u < BATCH * NE; u += G) topk_unit(a, lds, u); });

    PHASE(8, {
        pg8::Gemm g{(const bf16_t*)(ws + WS_H2), (const bf16_t*)(ws + WS_WGUT), NSLOT, 2048, D}; pg8::ExpertOrder S; S.init(32, 8, NE, G, (int)blockIdx.x);
        pg8::EpiSwiGLU E{(bf16_t*)(ws + WS_HID)}; pg8::gemm_phase<pg8::EpiSwiGLU, pg8::ExpertOrder, true>(lds, g, S, E, (const int*)(ws + WS_ROWTOK));
    });

    PHASE(9, {
        pg8::Gemm g{(const bf16_t*)(ws + WS_HID), (const bf16_t*)(ws + WS_WDT), NSLOT, D, FF}; pg8::ExpertOrder S; S.init(32, 4, NE, G, (int)blockIdx.x);
        pg8::EpiGateScale E{(bf16_t*)(ws + WS_YE), (const float*)(ws + WS_ROWGATE)}; pg8::gemm_phase<pg8::EpiGateScale, pg8::ExpertOrder, false>(lds, g, S, E, nullptr);
    });

    PHASE(10, phase_final(a, G));
#undef IN
#undef NREP
#undef PHASE
}

#ifndef MK_ONE_LAUNCH
#define MK_ONE_LAUNCH 1
#endif
extern "C" void kernel_launch(void* const* d_in, const int* in_sizes, int n_in, void* d_out, int out_size, void* d_ws, size_t ws_size, hipStream_t stream) {
    static int grid_blocks = 0;
    if (grid_blocks == 0) {
        if (n_in != 29 || out_size != T * D || ws_size < WS_END) { fprintf(stderr, "kernel_launch: unexpected problem: n_in %d out %d ws %zu (need %zu)\n", n_in, out_size, ws_size, (size_t)WS_END); grid_blocks = -1; return; }
        int dev = 0, cus = 0, per_cu = 0;
        if (hipGetDevice(&dev) != hipSuccess || hipDeviceGetAttribute(&cus, hipDeviceAttributeMultiprocessorCount, dev) != hipSuccess) { grid_blocks = -1; return; }
        if (hipFuncSetAttribute((const void*)mega, hipFuncAttributeMaxDynamicSharedMemorySize, LDS_BYTES) != hipSuccess) { fprintf(stderr, "kernel_launch: hipFuncSetAttribute failed\n"); grid_blocks = -1; return; }
        if (hipOccupancyMaxActiveBlocksPerMultiprocessor(&per_cu, (const void*)mega, NTHREADS, LDS_BYTES) != hipSuccess || per_cu < 1) { fprintf(stderr, "kernel_launch: occupancy query says %d blocks per CU\n", per_cu); grid_blocks = -1; return; }
        grid_blocks = cus;
    }
    if (grid_blocks < 0) return;
    if (hipMemsetAsync((char*)d_ws + WS_CTL, 0, CTL_BYTES, stream) != hipSuccess) { fprintf(stderr, "kernel_launch: memset failed\n"); return; }
    Args a{};
    for (int i = 0; i < 29; ++i) a.in[i] = (const float*)d_in[i];
    a.out = (float*)d_out; a.ws = (unsigned char*)d_ws;
#if MK_ONE_LAUNCH
    a.ph_lo = 0; a.ph_hi = NPHASE;
    { void* args[] = {&a}; hipError_t e = hipLaunchCooperativeKernel((const void*)mega, dim3(grid_blocks), dim3(NTHREADS), args, LDS_BYTES, stream);
      if (e != hipSuccess) fprintf(stderr, "cooperative launch failed: %s (grid %d)\n", hipGetErrorString(e), grid_blocks); }
#else
    for (int ph = 0; ph < NPHASE; ++ph) { a.ph_lo = ph; a.ph_hi = ph + 1; void* args[] = {&a};
        hipError_t e = hipLaunchCooperativeKernel((const void*)mega, dim3(grid_blocks), dim3(NTHREADS), args, LDS_BYTES, stream);
        if (e != hipSuccess) { fprintf(stderr, "cooperative launch %d failed: %s (grid %d)\n", ph, hipGetErrorString(e), grid_blocks); break; } }
#endif
}
```

```cpp
#include <hip/hip_runtime.h>
#include <hip/hip_cooperative_groups.h>
#include <cstdio>
#include <cstdint>
namespace cg = cooperative_groups;

#define LAS __attribute__((address_space(3)))
typedef unsigned short bf16_t;
typedef short bf16x8 __attribute__((ext_vector_type(8)));
typedef short s16x4 __attribute__((ext_vector_type(4)));
typedef float f32x2 __attribute__((ext_vector_type(2)));
typedef float f32x4 __attribute__((ext_vector_type(4)));
typedef float f32x16 __attribute__((ext_vector_type(16)));
typedef unsigned u32x2 __attribute__((ext_vector_type(2)));
typedef unsigned u32x4 __attribute__((ext_vector_type(4)));
typedef _Float16 f16x4 __attribute__((ext_vector_type(4)));
typedef __bf16 bf16v2 __attribute__((ext_vector_type(2)));

constexpr int D = 1024, BATCH = 16, SEQ = 4096, T = BATCH * SEQ, NMEM = 256;
constexpr int IN_PROJ = 2560, CW = 384, RW = 384, NH = 6, NE = 16, FF = 1024, CAP = 512;
constexpr int NSLOT = NE * BATCH * CAP;
constexpr int NTHREADS = 512;
constexpr int LDS_BYTES = 160 * 1024;
constexpr int NPHASE = 11;
#ifndef SCAN_MODE
#define SCAN_MODE 1
#endif

constexpr size_t MiB = 1u << 20;
constexpr size_t WS_WINT = 1 * MiB;
constexpr size_t WS_WOUTT = 6 * MiB;
constexpr size_t WS_WKT = 8 * MiB;
constexpr size_t WS_WVT = 8 * MiB + 512 * 1024;
constexpr size_t WS_SMALL = 9 * MiB;
constexpr size_t WS_WGUT = 10 * MiB;
constexpr size_t WS_WDT = 74 * MiB;
constexpr size_t WS_KMEM = 106 * MiB;
constexpr size_t WS_VT = 108 * MiB;
constexpr size_t WS_ROWTOK = 106 * MiB;
constexpr size_t WS_ROWGATE = 106 * MiB + 512 * 1024;
constexpr size_t WS_SS = 107 * MiB;
constexpr size_t WS_P = 112 * MiB;
constexpr size_t WS_YF = 112 * MiB;
constexpr size_t WS_YB = 208 * MiB;
constexpr size_t WS_X1 = 112 * MiB;
constexpr size_t WS_XH = 432 * MiB;
constexpr size_t WS_G = 432 * MiB;
constexpr size_t WS_BON = 480 * MiB;
constexpr size_t WS_Q = 400 * MiB;
constexpr int PLD = IN_PROJ - 256;
constexpr size_t WS_H2 = 432 * MiB;
constexpr size_t WS_MEMN = 560 * MiB;
constexpr size_t WS_MIX = 560 * MiB;
constexpr size_t WS_SCAN = 688 * MiB;
constexpr size_t SCAN_STRIDE = 48 * MiB;
constexpr size_t WS_SCAN7 = 496 * MiB;
constexpr size_t WS_PC = 484 * MiB;
__device__ __forceinline__ unsigned char* scan_arr(unsigned char* ws, int a) { return a < 7 ? ws + WS_SCAN + (size_t)a * SCAN_STRIDE : (a == 7 ? ws + WS_SCAN7 : ws + 560 * MiB + 640 * 2); }
__device__ __forceinline__ int scan_pitch(int a) { return a == 8 ? D : 384; }
__device__ __forceinline__ size_t hat_off(int a, size_t tok, int ch) { return a == 8 ? tok * D + ch : ((((tok >> 4) * NH + (ch >> 6)) << 10) + ((tok & 15) << 6) + (ch & 63)); }
constexpr size_t WS_AFF = 624 * MiB;
constexpr size_t WS_INV = 628 * MiB;
constexpr size_t WS_HID = 768 * MiB;
constexpr size_t WS_YE = 368 * MiB;
constexpr size_t WS_END = 1024 * MiB;

__device__ __forceinline__ unsigned pk_bf16(float lo, float hi) { f32x2 v = {lo, hi}; bf16v2 b = __builtin_convertvector(v, bf16v2); return __builtin_bit_cast(unsigned, b); }
__device__ __forceinline__ float bf_lo(unsigned u) { return __builtin_bit_cast(float, u << 16); }
__device__ __forceinline__ float bf_hi(unsigned u) { return __builtin_bit_cast(float, u & 0xffff0000u); }
__device__ __forceinline__ float wave_sum(float v) {
#pragma unroll
    for (int o = 1; o < 64; o <<= 1) v += __shfl_xor(v, o);
    return v;
}
__device__ __forceinline__ float sigmoidf_fast(float x) { return __builtin_amdgcn_rcpf(1.0f + __builtin_amdgcn_exp2f(-1.4426950408889634f * x)); }
template <int CTRL> __device__ __forceinline__ float dpp_f(float x) { return __builtin_bit_cast(float, __builtin_amdgcn_update_dpp(0, __builtin_bit_cast(int, x), CTRL, 0xF, 0xF, true)); }
__device__ __forceinline__ float sum8(float x) { x += dpp_f<0xB1>(x); x += dpp_f<0x4E>(x); x += dpp_f<0x141>(x); return x; }
__device__ __forceinline__ float sum16(float x) { x = sum8(x); x += dpp_f<0x140>(x); return x; }
__device__ __forceinline__ float max16(float x) { x = fmaxf(x, dpp_f<0xB1>(x)); x = fmaxf(x, dpp_f<0x4E>(x)); x = fmaxf(x, dpp_f<0x141>(x)); x = fmaxf(x, dpp_f<0x140>(x)); return x; }

typedef short v4i16g __attribute__((__vector_size__(8)));
__device__ __forceinline__ s16x4 tr_read16(LAS unsigned char* p) { v4i16g r = __builtin_amdgcn_ds_read_tr16_b64_v4i16((LAS v4i16g*)p); return __builtin_bit_cast(s16x4, r); }
__device__ __forceinline__ f32x4 bf4_to_f32(u32x2 w) { return (f32x4){bf_lo(w.x), bf_hi(w.x), bf_lo(w.y), bf_hi(w.y)}; }
__device__ __forceinline__ u32x2 f32_to_bf4(f32x4 v) { return (u32x2){pk_bf16(v.x, v.y), pk_bf16(v.z, v.w)}; }
__device__ __forceinline__ bf16x8 frag_lo4(f32x4 v) { const u32x4 w = {pk_bf16(v.x, v.y), pk_bf16(v.z, v.w), 0u, 0u}; return __builtin_bit_cast(bf16x8, w); }
__device__ __forceinline__ bf16x8 frag_cat(u32x2 a, u32x2 b) { const u32x4 w = {a.x, a.y, b.x, b.y}; return __builtin_bit_cast(bf16x8, w); }
#define MFMA16(a, b, c) __builtin_amdgcn_mfma_f32_16x16x32_bf16((a), (b), (c), 0, 0, 0)

namespace pg8 {
#define PG8_LAS __attribute__((address_space(3)))
constexpr int BM = 256, BK = 64, HALF = 128, HTB = HALF * BK * 2, STAGE_BYTES = 8 * HTB, NXCD = 8, WGM = 8;
__host__ __device__ __forceinline__ int lds_byte(int r, int c) { const int st = (r >> 4) * 2 + (c >> 5), rr = r & 15, cc = c & 31, ob = rr * 64 + cc * 2; return st * 1024 + (ob ^ (((ob >> 9) & 1) << 5)); }
__host__ __device__ __forceinline__ void stage_rc(int b, int& R, int& C) { const int st = b / 1024, sb = b % 1024, swz = sb ^ (((sb >> 9) & 1) << 5); R = (st >> 1) * 16 + swz / 64; C = (st & 1) * 32 + (swz % 64) / 2; }
__host__ __device__ __forceinline__ int perm32(int rho) { const int n = rho >> 4, i = rho & 15; return 8 * (i >> 2) + 4 * n + (i & 3); }

struct Unit { int pm, pn, gid; };
struct Gemm { const bf16_t* A; const bf16_t* Bt; int M, N, K; };

struct StaticOrder {
    int nM, nN, nwg, G, c;
    __device__ void init(int M, int N, int G_, int c_) { nM = M / BM; nN = N / BM; nwg = nM * nN; G = G_; c = c_; }
    __device__ bool next(int i, Unit& u) const {
        const long L = (long)i * G + c; if (L >= nwg) return false;
        int wgid = (int)L; { const int q = nwg / NXCD, r = nwg % NXCD, xcd = wgid % NXCD, off = wgid / NXCD; wgid = (xcd < r ? xcd * (q + 1) : r * (q + 1) + (xcd - r) * q) + off; }
        const int nig = WGM * nN, gid = wgid / nig, fm = gid * WGM, gsz = (nM - fm) < WGM ? (nM - fm) : WGM;
        u.pm = fm + ((wgid % nig) % gsz); u.pn = (wgid % nig) / gsz; u.gid = 0; return true;
    }
    __device__ __forceinline__ const char* aptr(const Gemm& g, const Unit& u, size_t tstep) const { return (const char*)g.A + (size_t)u.pm * tstep; }
    __device__ __forceinline__ const char* bptr(const Gemm& g, const Unit& u, size_t tstep) const { return (const char*)g.Bt + (size_t)u.pn * tstep; }
};
struct TripleOrder {
    StaticOrder S0; const bf16_t* A1; const bf16_t* B1; const bf16_t* A2; const bf16_t* B2; int n1, n2, G, c;
    __device__ bool next(int i, Unit& u) const {
        const long L = (long)i * G + c;
        if (L < n1) { u.pm = (int)L; u.pn = 0; u.gid = 1; return true; }
        if (L < n1 + n2) { u.pm = 0; u.pn = (int)(L - n1); u.gid = 2; return true; }
        const long L0 = L - n1 - n2; if (L0 >= S0.nwg) return false;
        StaticOrder T0 = S0; T0.c = (int)(L0 % G); return T0.next((int)(L0 / G), u);
    }
    __device__ __forceinline__ const char* aptr(const Gemm& g, const Unit& u, size_t tstep) const { return (const char*)(u.gid == 0 ? g.A : (u.gid == 1 ? A1 : A2)) + (size_t)u.pm * tstep; }
    __device__ __forceinline__ const char* bptr(const Gemm& g, const Unit& u, size_t tstep) const { return (const char*)(u.gid == 0 ? g.Bt : (u.gid == 1 ? B1 : B2)) + (size_t)u.pn * tstep; }
};
struct ExpertOrder {
    int nMe, nNe, per, total, G, c;
    __device__ void init(int nMe_, int nNe_, int nExp, int G_, int c_) { nMe = nMe_; nNe = nNe_; per = nMe * nNe; total = per * nExp; G = G_; c = c_; }
    __device__ bool next(int i, Unit& u) const {
        const long L = (long)i * G + c; if (L >= total) return false;
        const int e = (int)(L / per), w = (int)(L % per), xl = w % 8, j = w / 8, rpx = nMe / 8;
        u.pm = e * nMe + xl * rpx + (j % rpx); u.pn = e * nNe + j / rpx; u.gid = 0; return true;
    }
    __device__ __forceinline__ const char* aptr(const Gemm& g, const Unit& u, size_t tstep) const { return (const char*)g.A + (size_t)u.pm * tstep; }
    __device__ __forceinline__ const char* bptr(const Gemm& g, const Unit& u, size_t tstep) const { return (const char*)g.Bt + (size_t)u.pn * tstep; }
};

struct EpiBf16 {
    static constexpr bool PERM = true;
    bf16_t* O; int ldc; bf16_t* Q0;
    __device__ __forceinline__ void operator()(const f32x4 (&acc)[2][2][4][2], const Unit& u, int wr, int wc, int fr, int fq) const {
        const bool redir = (Q0 != nullptr) && (u.pn == 0);
        bf16_t* base = redir ? Q0 : O; const int ld = redir ? 256 : ldc;
        const int row0 = u.pm * BM + wr * 64 + fr, col0 = (u.pn - ((Q0 != nullptr && !redir) ? 1 : 0)) * BM + wc * 32 + 8 * fq;
#pragma unroll
        for (int ai = 0; ai < 2; ++ai)
#pragma unroll
            for (int m = 0; m < 4; ++m) { bf16_t* rowp = base + (size_t)(row0 + ai * HALF + m * 16) * ld + col0;
#pragma unroll
                for (int bj = 0; bj < 2; ++bj) { const f32x4 v0 = acc[ai][bj][m][0], v1 = acc[ai][bj][m][1];
                    u32x4 w; w.x = pk_bf16(v0[0], v0[1]); w.y = pk_bf16(v0[2], v0[3]); w.z = pk_bf16(v1[0], v1[1]); w.w = pk_bf16(v1[2], v1[3]);
                    *(u32x4*)(rowp + bj * HALF) = w; } }
    }
};
struct EpiBf16x3 {
    static constexpr bool PERM = true;
    EpiBf16 E0, E1, E2;
    __device__ __forceinline__ void operator()(const f32x4 (&acc)[2][2][4][2], const Unit& u, int wr, int wc, int fr, int fq) const {
        if (u.gid == 0) E0(acc, u, wr, wc, fr, fq); else if (u.gid == 1) E1(acc, u, wr, wc, fr, fq); else E2(acc, u, wr, wc, fr, fq); }
};
struct EpiResidSS {
    static constexpr bool PERM = false;
    const float* X; float* X1; float* ss;
    __device__ __forceinline__ void operator()(const f32x4 (&acc)[2][2][4][2], const Unit& u, int wr, int wc, int fr, int fq) const {
        const int row0 = u.pm * BM + wr * 64 + fr, col0 = u.pn * BM + wc * 32 + 4 * fq;
#pragma unroll
        for (int ai = 0; ai < 2; ++ai)
#pragma unroll
            for (int m = 0; m < 4; ++m) { const int row = row0 + ai * HALF + m * 16; const size_t off = (size_t)row * D + col0; float s = 0.f;
#pragma unroll
                for (int bj = 0; bj < 2; ++bj)
#pragma unroll
                    for (int n = 0; n < 2; ++n) { const f32x4 xv = *(const f32x4*)(X + off + bj * HALF + n * 16); const f32x4 o = xv + acc[ai][bj][m][n];
                        *(f32x4*)(X1 + off + bj * HALF + n * 16) = o; s += (o[0] * o[0] + o[1] * o[1]) + (o[2] * o[2] + o[3] * o[3]); }
                s += __shfl_xor(s, 16); s += __shfl_xor(s, 32);
                if (fq == 0) (void)__hip_atomic_fetch_add(ss + row, s, __ATOMIC_RELAXED, __HIP_MEMORY_SCOPE_AGENT); }
    }
};
struct EpiSwiGLU {
    static constexpr bool PERM = true;
    bf16_t* H;
    __device__ __forceinline__ void operator()(const f32x4 (&acc)[2][2][4][2], const Unit& u, int wr, int wc, int fr, int fq) const {
        const int row0 = u.pm * BM + wr * 64 + fr, col0 = (u.pn & 7) * HALF + wc * 32 + 8 * fq;
#pragma unroll
        for (int ai = 0; ai < 2; ++ai)
#pragma unroll
            for (int m = 0; m < 4; ++m) { const int row = row0 + ai * HALF + m * 16; bf16_t* rowp = H + ((((size_t)(row >> 8) * (FF / 64) + (col0 >> 6)) << 14) + ((row & 255) << 6) + (col0 & 63)); float h[8];
#pragma unroll
                for (int n = 0; n < 2; ++n)
#pragma unroll
                    for (int j = 0; j < 4; ++j) { const float gt = acc[ai][0][m][n][j], up = acc[ai][1][m][n][j]; h[n * 4 + j] = gt * sigmoidf_fast(gt) * up; }
                u32x4 w; w.x = pk_bf16(h[0], h[1]); w.y = pk_bf16(h[2], h[3]); w.z = pk_bf16(h[4], h[5]); w.w = pk_bf16(h[6], h[7]);
                *(u32x4*)rowp = w; }
    }
};
struct EpiGateScale {
    static constexpr bool PERM = true;
    bf16_t* Y; const float* gate;
    __device__ __forceinline__ void operator()(const f32x4 (&acc)[2][2][4][2], const Unit& u, int wr, int wc, int fr, int fq) const {
        const int row0 = u.pm * BM + wr * 64 + fr, col0 = (u.pn & 3) * BM + wc * 32 + 8 * fq;
#pragma unroll
        for (int ai = 0; ai < 2; ++ai)
#pragma unroll
            for (int m = 0; m < 4; ++m) { const int row = row0 + ai * HALF + m * 16; const float gs = gate[row]; bf16_t* rowp = Y + (size_t)row * D + col0;
#pragma unroll
                for (int bj = 0; bj < 2; ++bj) { const f32x4 v0 = acc[ai][bj][m][0] * gs, v1 = acc[ai][bj][m][1] * gs;
                    u32x4 w; w.x = pk_bf16(v0[0], v0[1]); w.y = pk_bf16(v0[2], v0[3]); w.z = pk_bf16(v1[0], v1[1]); w.w = pk_bf16(v1[2], v1[3]);
                    *(u32x4*)(rowp + bj * HALF) = w; } }
    }
};

template <class Epi, class Sched, bool GATHER, bool ATILED = false>
__device__ __forceinline__ void gemm_phase(PG8_LAS unsigned char* lds, const Gemm g, const Sched& S, const Epi& E, const int* rowtok) {
    const int tid = threadIdx.x, wid = __builtin_amdgcn_readfirstlane(tid >> 6), lane = tid & 63, wr = wid >> 2, wc = wid & 3, fr = lane & 15, fq = lane >> 4;
    const int K = g.K, nt = K / BK;
    unsigned voffA[2], voffB[2]; int Rr[2], Cc[2];
#pragma unroll
    for (int i = 0; i < 2; ++i) { int R, C; stage_rc(tid * 16 + i * 8192, R, C); const int Rb = Epi::PERM ? ((R & ~31) + perm32(R & 31)) : R; Rr[i] = R; Cc[i] = C;
        voffA[i] = ATILED ? (unsigned)(R * BK + C) * 2u : (unsigned)(R * K + C) * 2u; voffB[i] = (unsigned)(Rb * K + C) * 2u; }
    unsigned vAc[2][2], vAn[2][2];
    const size_t kstep = (size_t)(BK * 2);
    const size_t hstep = (size_t)HALF * K * 2;
    const size_t tstep = 2 * hstep;
    const size_t kstepA = ATILED ? (size_t)BM * BK * 2 : kstep, hstepA = ATILED ? (size_t)HALF * BK * 2 : hstep;
    const unsigned ldsw = (unsigned)wid * 1024u;
    const int aoff = lds_byte(wr * 64 + fr, fq * 8), boff = lds_byte(wc * 32 + fr, fq * 8);
#define PG8_SA(b, h) (((b) * 2 + (h)) * HTB)
#define PG8_SB(b, h) ((4 + (b) * 2 + (h)) * HTB)
#define PG8_STAGE(bufoff, gbase, voff) do { _Pragma("unroll") for (int _i = 0; _i < 2; ++_i) \
        __builtin_amdgcn_global_load_lds((const unsigned*)((const char*)(gbase) + (voff)[_i]), (PG8_LAS unsigned*)(lds + (bufoff) + ldsw + _i * 8192), 16, 0, 0); } while (0)
#define PG8_STAGE_A(bufoff, hh, dbase, kbytes, vsel) do { if constexpr (GATHER) { PG8_STAGE(bufoff, (const char*)g.A + (kbytes), (vsel)[hh]); } else { PG8_STAGE(bufoff, (dbase) + ((hh) ? hstepA : 0), voffA); } } while (0)
#define PG8_GATHER_OFF(dst, un) do { _Pragma("unroll") for (int _h = 0; _h < 2; ++_h) _Pragma("unroll") for (int _i = 0; _i < 2; ++_i) \
        (dst)[_h][_i] = (unsigned)rowtok[(un).pm * BM + _h * HALF + Rr[_i]] * (unsigned)(K * 2) + (unsigned)(Cc[_i] * 2); } while (0)
#define PG8_LDA(dst, b, h) do { _Pragma("unroll") for (int m = 0; m < 4; ++m) _Pragma("unroll") for (int k = 0; k < 2; ++k) dst[m][k] = *(const PG8_LAS bf16x8*)(lds + PG8_SA(b, h) + aoff + m * 2048 + k * 1024); } while (0)
#define PG8_LDB(dst, b, h) do { _Pragma("unroll") for (int n = 0; n < 2; ++n) _Pragma("unroll") for (int k = 0; k < 2; ++k) dst[n][k] = *(const PG8_LAS bf16x8*)(lds + PG8_SB(b, h) + boff + n * 2048 + k * 1024); } while (0)
#define PG8_MMA(ai, bj, At, Bt) do { __builtin_amdgcn_s_setprio(1); _Pragma("unroll") for (int m = 0; m < 4; ++m) _Pragma("unroll") for (int n = 0; n < 2; ++n) _Pragma("unroll") for (int k = 0; k < 2; ++k) \
        acc[ai][bj][m][n] = __builtin_amdgcn_mfma_f32_16x16x32_bf16(Bt[n][k], At[m][k], acc[ai][bj][m][n], 0, 0, 0); __builtin_amdgcn_s_setprio(0); } while (0)
#define PG8_WAIT_V(n) asm volatile("s_waitcnt vmcnt(" #n ")" ::: "memory")
#define PG8_WAIT_L(n) asm volatile("s_waitcnt lgkmcnt(" #n ")" ::: "memory")
#define PG8_BAR __builtin_amdgcn_s_barrier()
#define PG8_SCHED __builtin_amdgcn_sched_barrier(0)
    Unit cur, nxt; int ui = 0;
    if (!S.next(0, cur)) return;
    f32x4 acc[2][2][4][2];
#pragma unroll
    for (int a = 0; a < 2; ++a)
#pragma unroll
        for (int b = 0; b < 2; ++b)
#pragma unroll
            for (int m = 0; m < 4; ++m)
#pragma unroll
                for (int n = 0; n < 2; ++n) acc[a][b][m][n] = (f32x4){0.f, 0.f, 0.f, 0.f};
    bf16x8 At[4][2], B0[2][2], B1[2][2];
    const char* cA = GATHER ? (const char*)g.A : S.aptr(g, cur, tstep); const char* cB = S.bptr(g, cur, tstep);
    if constexpr (GATHER) { PG8_GATHER_OFF(vAc, cur); }
    PG8_STAGE(PG8_SB(0, 0), cB, voffB); PG8_STAGE_A(PG8_SA(0, 0), 0, cA, 0, vAc); PG8_STAGE(PG8_SB(0, 1), cB + hstep, voffB); PG8_STAGE_A(PG8_SA(0, 1), 1, cA, 0, vAc);
    if (wr == 1) PG8_BAR;
    PG8_WAIT_V(4); PG8_BAR;
    PG8_STAGE(PG8_SB(1, 0), cB + kstep, voffB); PG8_STAGE_A(PG8_SA(1, 0), 0, cA + kstepA, kstep, vAc); PG8_STAGE(PG8_SB(1, 1), cB + hstep + kstep, voffB);
    PG8_WAIT_V(6); PG8_BAR;
    for (;;) {
        const bool has_next = S.next(ui + 1, nxt);
        const char* nA = (has_next && !GATHER) ? S.aptr(g, nxt, tstep) : cA; const char* nB = has_next ? S.bptr(g, nxt, tstep) : cB;
        if constexpr (GATHER) { if (has_next) { PG8_GATHER_OFF(vAn, nxt); } else {
#pragma unroll
            for (int _h = 0; _h < 2; ++_h)
#pragma unroll
                for (int _i = 0; _i < 2; ++_i) vAn[_h][_i] = vAc[_h][_i]; } }
        for (int t = 0; t < nt; t += 2) {
            const bool last = (t == nt - 2);
            const size_t k1 = (size_t)(t + 1) * kstep, k2 = last ? 0 : (size_t)(t + 2) * kstep, k3 = k2 + kstep;
            const char* a1 = cA + (size_t)(t + 1) * kstepA;
            const char* a2 = last ? nA : cA + (size_t)(t + 2) * kstepA; const char* b2 = last ? nB : cB + (size_t)(t + 2) * kstep;
            const char* a3 = a2 + kstepA; const char* b3 = b2 + kstep;
            unsigned vs[2][2];
#pragma unroll
            for (int _h = 0; _h < 2; ++_h)
#pragma unroll
                for (int _i = 0; _i < 2; ++_i) vs[_h][_i] = last ? vAn[_h][_i] : vAc[_h][_i];
            PG8_LDB(B0, 0, 0); PG8_SCHED; PG8_LDA(At, 0, 0); PG8_STAGE_A(PG8_SA(1, 1), 1, a1, k1, vAc);
            PG8_WAIT_L(8); PG8_BAR; PG8_WAIT_L(0); PG8_MMA(0, 0, At, B0); PG8_BAR; PG8_SCHED;
            PG8_LDB(B1, 0, 1); PG8_STAGE(PG8_SB(0, 0), b2, voffB);
            PG8_BAR; PG8_WAIT_L(0); PG8_MMA(0, 1, At, B1); PG8_BAR;
            PG8_LDA(At, 0, 1); PG8_STAGE_A(PG8_SA(0, 0), 0, a2, k2, vs);
            PG8_BAR; PG8_WAIT_L(0); PG8_MMA(1, 0, At, B0); PG8_BAR; PG8_SCHED;
            PG8_STAGE(PG8_SB(0, 1), b2 + hstep, voffB);
            PG8_WAIT_V(6); PG8_BAR; PG8_MMA(1, 1, At, B1); PG8_BAR;
            PG8_LDB(B0, 1, 0); PG8_SCHED; PG8_LDA(At, 1, 0); PG8_STAGE_A(PG8_SA(0, 1), 1, a2, k2, vs);
            PG8_WAIT_L(8); PG8_BAR; PG8_WAIT_L(0); PG8_MMA(0, 0, At, B0); PG8_BAR; PG8_SCHED;
            PG8_LDB(B1, 1, 1); PG8_STAGE(PG8_SB(1, 0), b3, voffB);
            PG8_BAR; PG8_WAIT_L(0); PG8_MMA(0, 1, At, B1); PG8_BAR;
            PG8_LDA(At, 1, 1); PG8_STAGE_A(PG8_SA(1, 0), 0, a3, k3, vs);
            PG8_BAR; PG8_WAIT_L(0); PG8_MMA(1, 0, At, B0); PG8_BAR; PG8_SCHED;
            PG8_STAGE(PG8_SB(1, 1), b3 + hstep, voffB);
            PG8_WAIT_V(6); PG8_BAR; PG8_MMA(1, 1, At, B1); PG8_BAR;
        }
        E(acc, cur, wr, wc, fr, fq);
        if (!has_next) break;
#pragma unroll
        for (int a = 0; a < 2; ++a)
#pragma unroll
            for (int b = 0; b < 2; ++b)
#pragma unroll
                for (int m = 0; m < 4; ++m)
#pragma unroll
                    for (int n = 0; n < 2; ++n) acc[a][b][m][n] = (f32x4){0.f, 0.f, 0.f, 0.f};
        cur = nxt; cA = nA; cB = nB; ++ui;
        if constexpr (GATHER) {
#pragma unroll
            for (int _h = 0; _h < 2; ++_h)
#pragma unroll
                for (int _i = 0; _i < 2; ++_i) vAc[_h][_i] = vAn[_h][_i]; }
    }
    PG8_WAIT_V(0);
    if (wr == 0) PG8_BAR;
    PG8_BAR;
#undef PG8_SA
#undef PG8_SB
#undef PG8_STAGE
#undef PG8_STAGE_A
#undef PG8_GATHER_OFF
#undef PG8_LDA
#undef PG8_LDB
#undef PG8_MMA
#undef PG8_WAIT_V
#undef PG8_WAIT_L
#undef PG8_BAR
#undef PG8_SCHED
}
}

struct Args {
    const float* in[29];
    float* out; unsigned char* ws;
    int ph_lo, ph_hi;
};
enum { I_X = 0, I_MEM, I_NMIXG, I_NMEMG, I_WIN, I_WMK, I_WMV, I_CONVW, I_CONVB, I_CLNG, I_CLNB, I_SHIFTMU, I_DW0, I_DUP, I_IA0, I_IUP, I_GUP, I_KK, I_KA, I_RK,
       I_LNXG, I_LNXB, I_WOUT, I_NFFNG, I_WROUTER, I_WEG, I_WEU, I_WED, I_FNG };

__device__ __forceinline__ void transpose_item(const float* W, int N, bf16_t* WT, int K, int k0, int n0, int drow0, LAS float* scr, int lane) {
    {
        f32x4 v[8];
#pragma unroll
        for (int i = 0; i < 8; ++i) v[i] = *(const f32x4*)(W + (size_t)(k0 + 8 * i + (lane >> 3)) * N + n0 + 4 * (lane & 7));
#pragma unroll
        for (int i = 0; i < 8; ++i) { LAS float* d = scr + (8 * i + (lane >> 3)) * 33 + 4 * (lane & 7); d[0] = v[i].x; d[1] = v[i].y; d[2] = v[i].z; d[3] = v[i].w; }
    }
    asm volatile("s_waitcnt lgkmcnt(0)" ::: "memory");
    const int c = lane & 7;
#pragma unroll
    for (int j = 0; j < 4; ++j) { const int n = (lane >> 3) + 8 * j; const LAS float* s = scr + (8 * c) * 33 + n;
        u32x4 o; o.x = pk_bf16(s[0 * 33], s[1 * 33]); o.y = pk_bf16(s[2 * 33], s[3 * 33]); o.z = pk_bf16(s[4 * 33], s[5 * 33]); o.w = pk_bf16(s[6 * 33], s[7 * 33]);
        *(u32x4*)(WT + (size_t)(drow0 + n) * K + k0 + 8 * c) = o; }
    asm volatile("s_waitcnt lgkmcnt(0)" ::: "memory");
}
__device__ __forceinline__ void expert_prep_items(const Args& a, LAS unsigned char* lds, int widx, int nw, int it_lo, int it_hi) {
    const int tid = threadIdx.x, lane = tid & 63, wave = __builtin_amdgcn_readfirstlane(tid >> 6);
    LAS float* scr = (LAS float*)(lds + wave * 16384);
    unsigned char* ws = a.ws;
    constexpr int S_EXP = 16 * 16 * 32;
    for (int r = it_lo + widx; r < it_hi; r += nw) {
        const int which = r / S_EXP, q = r % S_EXP, e = q / 512, kb = (q % 512) / 32, nb = q % 32, n0 = nb * 32;
        if (which == 0) transpose_item(a.in[I_WEG] + (size_t)e * D * FF, FF, (bf16_t*)(ws + WS_WGUT) + (size_t)e * 2048 * D, D, kb * 64, n0, (n0 >> 7) * 256 + (n0 & 127), scr, lane);
        else if (which == 1) transpose_item(a.in[I_WEU] + (size_t)e * D * FF, FF, (bf16_t*)(ws + WS_WGUT) + (size_t)e * 2048 * D, D, kb * 64, n0, (n0 >> 7) * 256 + 128 + (n0 & 127), scr, lane);
        else transpose_item(a.in[I_WED] + (size_t)e * FF * D, D, (bf16_t*)(ws + WS_WDT) + (size_t)e * D * FF, FF, kb * 64, n0, n0, scr, lane);
    }
}

__device__ __forceinline__ void rms_row_to_bf16(const float* xrow, const float* g, bf16_t* orow, int lane) {
    const f32x4* xr = (const f32x4*)xrow + lane; const f32x4* gr = (const f32x4*)g + lane;
    f32x4 v[4]; float s = 0.f;
#pragma unroll
    for (int j = 0; j < 4; ++j) { v[j] = xr[64 * j]; s += (v[j].x * v[j].x + v[j].y * v[j].y) + (v[j].z * v[j].z + v[j].w * v[j].w); }
    const float rs = 1.0f / sqrtf(wave_sum(s) * (1.f / D) + 1e-6f);
    u32x2* o8 = (u32x2*)orow + lane;
#pragma unroll
    for (int j = 0; j < 4; ++j) { const f32x4 gg = gr[64 * j]; u32x2 w; w.x = pk_bf16(v[j].x * rs * gg.x, v[j].y * rs * gg.y); w.y = pk_bf16(v[j].z * rs * gg.z, v[j].w * rs * gg.w); o8[64 * j] = w; }
}
__device__ __forceinline__ void phase_prep(const Args& a, LAS unsigned char* lds, int G) {
    const int tid = threadIdx.x, lane = tid & 63, wave = __builtin_amdgcn_readfirstlane(tid >> 6);
    LAS float* scr = (LAS float*)(lds + wave * 16384);
    const int gw = blockIdx.x * 8 + wave, NGW = G * 8;
    unsigned char* ws = a.ws;
    constexpr int S_WIN = 16 * 80, S_WOUT = 16 * 32, S_MK = 16 * 8, S_SM = 12, S_GUP = 24;
    constexpr int NITEMS = S_WIN + S_WOUT + 2 * S_MK + 4 * S_SM + S_GUP;
    for (int it = gw; it < NITEMS; it += NGW) {
        int r = it;
        if (r < S_WIN) { const int kb = r / 80, nb = r % 80; transpose_item(a.in[I_WIN], IN_PROJ, (bf16_t*)(ws + WS_WINT), D, kb * 64, nb * 32, nb * 32, scr, lane); continue; } r -= S_WIN;
        if (r < S_WOUT) { const int kb = r / 32, nb = r % 32; transpose_item(a.in[I_WOUT], D, (bf16_t*)(ws + WS_WOUTT), D, kb * 64, nb * 32, nb * 32, scr, lane); continue; } r -= S_WOUT;
        if (r < S_MK) { const int kb = r / 8, nb = r % 8; transpose_item(a.in[I_WMK], 256, (bf16_t*)(ws + WS_WKT), D, kb * 64, nb * 32, nb * 32, scr, lane); continue; } r -= S_MK;
        if (r < S_MK) { const int kb = r / 8, nb = r % 8; transpose_item(a.in[I_WMV], 256, (bf16_t*)(ws + WS_WVT), D, kb * 64, nb * 32, nb * 32, scr, lane); continue; } r -= S_MK;
        if (r < 4 * S_SM) { const int which = r / S_SM, nb = r % S_SM;
            const float* src = (which < 2 ? a.in[I_DUP] : a.in[I_IUP]) + (size_t)(which & 1) * 64 * RW;
            transpose_item(src, RW, (bf16_t*)(ws + WS_SMALL) + (size_t)which * RW * 64, 64, 0, nb * 32, nb * 32, scr, lane); continue; } r -= 4 * S_SM;
        { const int kb = r / 12, nb = r % 12; transpose_item(a.in[I_GUP], RW, (bf16_t*)(ws + WS_SMALL) + (size_t)4 * RW * 64, 128, kb * 64, nb * 32, nb * 32, scr, lane); }
    }
    expert_prep_items(a, lds, gw, NGW, 0, 3 * 8192);
    for (int m = gw; m < T; m += NGW) rms_row_to_bf16(a.in[I_X] + (size_t)m * D, a.in[I_NMIXG], (bf16_t*)(ws + WS_XH) + (size_t)m * D, lane);
    for (int m = gw; m < BATCH * NMEM; m += NGW) rms_row_to_bf16(a.in[I_MEM] + (size_t)m * D, a.in[I_NMEMG], (bf16_t*)(ws + WS_MEMN) + (size_t)m * D, lane);
}

constexpr int AT_KS = 144;
constexpr int AT_VS = 520;
constexpr int AT_VOFF = 256 * AT_KS;
__device__ __forceinline__ bf16x8 pack_step(const f32x16& x, int s) {
    u32x4 p;
    asm volatile("v_cvt_pk_bf16_f32 %0, %4, %5\n\tv_cvt_pk_bf16_f32 %1, %6, %7\n\tv_cvt_pk_bf16_f32 %2, %8, %9\n\tv_cvt_pk_bf16_f32 %3, %10, %11\n\ts_nop 1"
                 : "=&v"(p[0]), "=&v"(p[1]), "=&v"(p[2]), "=&v"(p[3])
                 : "v"(x[8 * s]), "v"(x[8 * s + 1]), "v"(x[8 * s + 2]), "v"(x[8 * s + 3]), "v"(x[8 * s + 4]), "v"(x[8 * s + 5]), "v"(x[8 * s + 6]), "v"(x[8 * s + 7]));
    return __builtin_bit_cast(bf16x8, p);
}
__device__ __forceinline__ void attn_unit(const Args& a, LAS unsigned char* lds, int unit) {
    const int tid = threadIdx.x, lane = tid & 63, wave = __builtin_amdgcn_readfirstlane(tid >> 6), r = lane & 31, h = lane >> 5;
    const int b = unit >> 2, hh = unit & 3;
    const bf16_t* Qb = (const bf16_t*)(a.ws + WS_Q); const bf16_t* KM = (const bf16_t*)(a.ws + WS_KMEM); const bf16_t* VT = (const bf16_t*)(a.ws + WS_VT);
    bf16_t* MIX = (bf16_t*)(a.ws + WS_MIX);
    __syncthreads();
#pragma unroll
    for (int i = 0; i < 4; ++i) { const int c = tid + 512 * i, key = c >> 3, ch = c & 7;
        const u32x4 v = *(const u32x4*)(KM + (size_t)(b * NMEM + key) * 256 + hh * 64 + ch * 8);
        *(LAS u32x4*)(lds + key * AT_KS + ch * 16) = v; }
#pragma unroll
    for (int i = 0; i < 4; ++i) { const int c = tid + 512 * i, d = c >> 5, ch = c & 31;
        const u32x4 v = *(const u32x4*)(VT + (size_t)(hh * 64 + d) * (BATCH * NMEM) + b * NMEM + ch * 8);
        LAS u32x2* dst = (LAS u32x2*)(lds + AT_VOFF + d * AT_VS + ch * 16);
        dst[0] = (u32x2){v.x, v.y}; dst[1] = (u32x2){v.z, v.w}; }
    __syncthreads();
#pragma unroll 1
    for (int tile = 0; tile < 16; ++tile) {
    const int tok0 = b * SEQ + tile * 256 + wave * 32;
    bf16x8 qf[4];
#pragma unroll
    for (int ks = 0; ks < 4; ++ks) qf[ks] = *(const bf16x8*)(Qb + (size_t)(tok0 + r) * 256 + hh * 64 + ks * 16 + h * 8);
    const float sc = 0.125f * 1.4426950408889634f;
    float m_run = -3.0e38f, sum = 0.f;
    f32x16 o[2];
#pragma unroll
    for (int dt = 0; dt < 2; ++dt)
#pragma unroll
        for (int i = 0; i < 16; ++i) o[dt][i] = 0.f;
#pragma unroll 1
    for (int kh = 0; kh < 2; ++kh) {
        f32x16 s[4];
#pragma unroll
        for (int k4 = 0; k4 < 4; ++k4) {
#pragma unroll
            for (int i = 0; i < 16; ++i) s[k4][i] = 0.f;
#pragma unroll
            for (int ks = 0; ks < 4; ++ks) { const bf16x8 ka = *(const LAS bf16x8*)(lds + ((kh * 4 + k4) * 32 + r) * AT_KS + (ks * 16 + h * 8) * 2);
                s[k4] = __builtin_amdgcn_mfma_f32_32x32x16_bf16(ka, qf[ks], s[k4], 0, 0, 0); }
        }
        float mx = m_run;
#pragma unroll
        for (int k4 = 0; k4 < 4; ++k4)
#pragma unroll
            for (int i = 0; i < 16; ++i) mx = fmaxf(mx, s[k4][i]);
        mx = fmaxf(mx, __shfl_xor(mx, 32));
        const float alpha = __builtin_amdgcn_exp2f((m_run - mx) * sc);
        float ps = 0.f;
#pragma unroll
        for (int k4 = 0; k4 < 4; ++k4)
#pragma unroll
            for (int i = 0; i < 16; ++i) { const float e = __builtin_amdgcn_exp2f((s[k4][i] - mx) * sc); s[k4][i] = e; ps += e; }
        ps += __shfl_xor(ps, 32);
        sum = sum * alpha + ps; m_run = mx;
#pragma unroll
        for (int dt = 0; dt < 2; ++dt)
#pragma unroll
            for (int i = 0; i < 16; ++i) o[dt][i] *= alpha;
#pragma unroll
        for (int k4 = 0; k4 < 4; ++k4)
#pragma unroll
            for (int s2 = 0; s2 < 2; ++s2) {
                const bf16x8 pb = pack_step(s[k4], s2);
#pragma unroll
                for (int dt = 0; dt < 2; ++dt) {
                    const LAS unsigned char* vp = lds + AT_VOFF + (32 * dt + r) * AT_VS + (32 * (kh * 4 + k4) + 16 * s2 + 4 * h) * 2;
                    const s16x4 lo = *(const LAS s16x4*)vp, hi = *(const LAS s16x4*)(vp + 16);
                    const bf16x8 va = __builtin_shufflevector(lo, hi, 0, 1, 2, 3, 4, 5, 6, 7);
                    o[dt] = __builtin_amdgcn_mfma_f32_32x32x16_bf16(va, pb, o[dt], 0, 0, 0);
                }
            }
    }
    const float inv = 1.0f / sum;
    bf16_t* orow = MIX + (size_t)(tok0 + r) * D + hh * 64;
#pragma unroll
    for (int dt = 0; dt < 2; ++dt)
#pragma unroll
        for (int gq = 0; gq < 4; ++gq) { u32x2 w; w.x = pk_bf16(o[dt][4 * gq] * inv, o[dt][4 * gq + 1] * inv); w.y = pk_bf16(o[dt][4 * gq + 2] * inv, o[dt][4 * gq + 3] * inv);
            *(u32x2*)(orow + 32 * dt + 8 * gq + 4 * h) = w; }
    }
}

__device__ __forceinline__ void conv_unit(const Args& a, LAS unsigned char* lds, int unit) {
    const int tid = threadIdx.x, lane = tid & 63, wave = __builtin_amdgcn_readfirstlane(tid >> 6);
    const int b = unit >> 6, t0 = (unit & 63) * 64;
    const bf16_t* P = (const bf16_t*)(a.ws + WS_P); bf16_t* MIX = (bf16_t*)(a.ws + WS_MIX);
    LAS _Float16* U = (LAS _Float16*)lds;
    LAS _Float16* Cc = (LAS _Float16*)(lds + 94 * CW * 2);
    __syncthreads();
#pragma unroll 1
    for (int q0 = tid; q0 < 94 * 48; q0 += 3 * NTHREADS) {
        u32x4 vvv[3], ggg[3];
#pragma unroll
        for (int u3 = 0; u3 < 3; ++u3) { const int q = q0 + u3 * NTHREADS, j = q / 48, cc = (q % 48) * 8, s = t0 - 15 + j; const bool ok = (q < 94 * 48) && s >= 0 && s < SEQ;
            const bf16_t* row = P + (size_t)(b * SEQ + (ok ? s : 0)) * PLD + cc;
            vvv[u3] = ok ? *(const u32x4*)row : (u32x4){0u, 0u, 0u, 0u}; ggg[u3] = ok ? *(const u32x4*)(row + CW) : (u32x4){0u, 0u, 0u, 0u}; }
#pragma unroll
        for (int u3 = 0; u3 < 3; ++u3) { const int q = q0 + u3 * NTHREADS, j = q / 48, cc = (q % 48) * 8;
            if (q < 94 * 48) {
                const unsigned vw[4] = {vvv[u3].x, vvv[u3].y, vvv[u3].z, vvv[u3].w}, gw[4] = {ggg[u3].x, ggg[u3].y, ggg[u3].z, ggg[u3].w};
                float u[8];
#pragma unroll
                for (int k = 0; k < 4; ++k) { u[2 * k] = bf_lo(vw[k]) * sigmoidf_fast(bf_lo(gw[k])); u[2 * k + 1] = bf_hi(vw[k]) * sigmoidf_fast(bf_hi(gw[k])); }
                LAS f16x4* dst = (LAS f16x4*)(U + j * CW + cc); dst[0] = (f16x4){(_Float16)u[0], (_Float16)u[1], (_Float16)u[2], (_Float16)u[3]}; dst[1] = (f16x4){(_Float16)u[4], (_Float16)u[5], (_Float16)u[6], (_Float16)u[7]}; }
        }
    }
    __syncthreads();
    const int cq = tid & 127, tq = tid >> 7;
#pragma unroll 1
    for (int k3 = 0; k3 < 3; ++k3) { const int c = cq + 128 * k3;
        float w[31], res[16];
#pragma unroll
        for (int kk = 0; kk < 31; ++kk) w[kk] = a.in[I_CONVW][kk * CW + c];
        const float bias = a.in[I_CONVB][c];
#pragma unroll
        for (int tt = 0; tt < 16; ++tt) res[tt] = bias;
#pragma unroll
        for (int jj = 0; jj < 46; ++jj) { const float uv = (float)U[(tq * 16 + jj) * CW + c];
#pragma unroll
            for (int tt = 0; tt < 16; ++tt) { if (jj - tt >= 0 && jj - tt <= 30) res[tt] += uv * w[jj - tt]; } }
#pragma unroll
        for (int tt = 0; tt < 16; ++tt) Cc[(tq * 16 + tt) * CW + c] = (_Float16)res[tt];
    }
    __syncthreads();
    for (int tt = 0; tt < 8; ++tt) { const int t = wave * 8 + tt;
        float v[6]; float s = 0.f;
#pragma unroll
        for (int i = 0; i < 6; ++i) { v[i] = (float)Cc[t * CW + lane + 64 * i]; s += v[i]; }
        const float mean = wave_sum(s) * (1.f / CW); float q = 0.f;
#pragma unroll
        for (int i = 0; i < 6; ++i) { v[i] -= mean; q += v[i] * v[i]; }
        const float rstd = 1.0f / sqrtf(wave_sum(q) * (1.f / CW) + 1e-5f);
        bf16_t* orow = MIX + (size_t)(b * SEQ + t0 + t) * D + 256;
#pragma unroll
        for (int i = 0; i < 6; ++i) { const int c = lane + 64 * i; const float y = v[i] * rstd * a.in[I_CLNG][c] + a.in[I_CLNB][c]; const float o = y * sigmoidf_fast(y);
            orow[c] = (bf16_t)(pk_bf16(o, 0.f) & 0xffffu); }
    }
}

constexpr int PR_AS = 784;
constexpr int PR_RK = 64 * PR_AS;
constexpr int PR_RKS = 1536;
constexpr int PR_RN = PR_RK + 64 * PR_RKS;
constexpr int PR_CST = PR_RN + 2048;
static_assert(PR_CST + 7 * 384 * 4 <= LDS_BYTES - 64, "prep LDS map");
template <int CTRL> __device__ __forceinline__ f32x4 dpp4(f32x4 x) { return (f32x4){dpp_f<CTRL>(x.x), dpp_f<CTRL>(x.y), dpp_f<CTRL>(x.z), dpp_f<CTRL>(x.w)}; }
__device__ __forceinline__ void prep_unit(const Args& a, LAS unsigned char* lds, int unit) {
    const int tid = threadIdx.x, lane = tid & 63, wave = __builtin_amdgcn_readfirstlane(tid >> 6);
    const int b = unit >> 6, t0 = (unit & 63) * 64;
    const bf16_t* __restrict__ P = (const bf16_t*)(a.ws + WS_P);
    const float* __restrict__ mu = a.in[I_SHIFTMU];
    LAS float* RNs = (LAS float*)(lds + PR_RN); LAS float* CST = (LAS float*)(lds + PR_CST);
    __syncthreads();
    for (int i = tid; i < 7 * 384; i += NTHREADS) { const int w7 = i / 384, c7 = i % 384;
        CST[i] = (w7 == 0) ? a.in[I_KK][c7] : (w7 == 1) ? a.in[I_KA][c7] : (w7 == 2) ? a.in[I_RK][c7] : (w7 < 5) ? a.in[I_DW0][(w7 - 3) * RW + c7] : a.in[I_IA0][(w7 - 5) * RW + c7]; }
#ifndef PREP_REP1
#define PREP_REP1 1
#endif
#ifndef PREP_REP2
#define PREP_REP2 1
#endif
#pragma unroll 1
    for (int rp1 = 0; rp1 < PREP_REP1; ++rp1)
#pragma unroll 1
    for (int q0 = tid; q0 < 64 * 192; q0 += 4 * NTHREADS) {
        u32x4 cuv[4], pvv[4], nvv[4];
#pragma unroll
        for (int u4 = 0; u4 < 4; ++u4) { const int q = q0 + u4 * NTHREADS, tt = q / 192, c8 = (q % 192) * 8, s = t0 + tt;
            const bf16_t* row = P + ((size_t)b * SEQ + s) * PLD + 768 + c8;
            cuv[u4] = *(const u32x4*)row;
            pvv[u4] = (s > 0) ? *(const u32x4*)(row - PLD) : (u32x4){0u, 0u, 0u, 0u};
            nvv[u4] = (s < SEQ - 1) ? *(const u32x4*)(row + PLD) : (u32x4){0u, 0u, 0u, 0u}; }
#pragma unroll
        for (int u4 = 0; u4 < 4; ++u4) { const int q = q0 + u4 * NTHREADS, tt = q / 192, c8 = (q % 192) * 8, s = t0 + tt; const size_t tok = (size_t)b * SEQ + s;
            const u32x4 cu = cuv[u4], pv = pvv[u4], nv = nvv[u4];
            const unsigned cw[4] = {cu.x, cu.y, cu.z, cu.w}, pw[4] = {pv.x, pv.y, pv.z, pv.w}, nw[4] = {nv.x, nv.y, nv.z, nv.w};
            const f32x4 m0a = *(const f32x4*)(mu + c8), m0b = *(const f32x4*)(mu + c8 + 4), m1a = *(const f32x4*)(mu + 1536 + c8), m1b = *(const f32x4*)(mu + 1536 + c8 + 4);
            const float m0[8] = {m0a.x, m0a.y, m0a.z, m0a.w, m0b.x, m0b.y, m0b.z, m0b.w}, m1[8] = {m1a.x, m1a.y, m1a.z, m1a.w, m1b.x, m1b.y, m1b.z, m1b.w};
            float pf[8];
#pragma unroll
            for (int k = 0; k < 4; ++k) { const float c0 = bf_lo(cw[k]), c1 = bf_hi(cw[k]);
                pf[2 * k] = c0 + m0[2 * k] * (bf_lo(pw[k]) - c0) + m1[2 * k] * (bf_lo(nw[k]) - c0);
                pf[2 * k + 1] = c1 + m0[2 * k + 1] * (bf_hi(pw[k]) - c1) + m1[2 * k + 1] * (bf_hi(nw[k]) - c1); }
            if (c8 < 768) {
                f16x4 h0 = {(_Float16)pf[0], (_Float16)pf[1], (_Float16)pf[2], (_Float16)pf[3]}, h1 = {(_Float16)pf[4], (_Float16)pf[5], (_Float16)pf[6], (_Float16)pf[7]};
                LAS f16x4* dst = (LAS f16x4*)(lds + PR_RK + tt * PR_RKS + c8 * 2); dst[0] = h0; dst[1] = h1;
                if (c8 >= 384) { const f32x4 ka = *(const f32x4*)(a.in[I_KK] + c8 - 384), kb = *(const f32x4*)(a.in[I_KK] + c8 - 384 + 4);
                    float ssq = (pf[0] * ka.x) * (pf[0] * ka.x) + (pf[1] * ka.y) * (pf[1] * ka.y) + (pf[2] * ka.z) * (pf[2] * ka.z) + (pf[3] * ka.w) * (pf[3] * ka.w)
                              + (pf[4] * kb.x) * (pf[4] * kb.x) + (pf[5] * kb.y) * (pf[5] * kb.y) + (pf[6] * kb.z) * (pf[6] * kb.z) + (pf[7] * kb.w) * (pf[7] * kb.w);
                    ssq = sum8(ssq);
                    if ((lane & 7) == 0) RNs[tt * 8 + ((c8 - 384) >> 6)] = __builtin_amdgcn_rsqf(ssq + 1e-12f); }
            } else if (c8 < 1152) {
                u32x4 w; w.x = pk_bf16(pf[0], pf[1]); w.y = pk_bf16(pf[2], pf[3]); w.z = pk_bf16(pf[4], pf[5]); w.w = pk_bf16(pf[6], pf[7]);
                *(u32x4*)((bf16_t*)scan_arr(a.ws, 0) + hat_off(0, tok, c8 - 768)) = w;
            } else {
                const int cc = c8 - 1152;
#pragma unroll
                for (int k = 0; k < 8; ++k) { if (cc < 128) pf[k] = 1.0f - 2.0f * __builtin_amdgcn_rcpf(1.0f + __builtin_amdgcn_exp2f(2.8853900817779268f * pf[k])); else if (cc >= 256) pf[k] = sigmoidf_fast(pf[k]); }
                u32x4 w; w.x = pk_bf16(pf[0], pf[1]); w.y = pk_bf16(pf[2], pf[3]); w.z = pk_bf16(pf[4], pf[5]); w.w = pk_bf16(pf[6], pf[7]);
                *(LAS u32x4*)(lds + tt * PR_AS + cc * 2) = w; }
        }
    }
    __syncthreads();
    const int l15 = lane & 15, kq = lane >> 4;
    const bf16_t* SM = (const bf16_t*)(a.ws + WS_SMALL);
    float* __restrict__ PCg = (float*)(a.ws + WS_PC); float* __restrict__ BON = (float*)(a.ws + WS_BON);
    bf16x8 Fc[16], Fn[16];
#define PREP_CH(nt_) (32 * ((nt_) >> 1) + 8 * (l15 >> 2) + 4 * ((nt_) & 1) + (l15 & 3))
#define PREP_LOADF(st_) do { const int it_ = wave + 8 * ((st_) / 3), kind_ = (st_) % 3, hd_ = it_ >> 2; \
        if (kind_ < 2) { const bf16_t* w0_ = SM + (size_t)kind_ * RW * 64; const bf16_t* w1_ = SM + (size_t)(2 + kind_) * RW * 64; \
            _Pragma("unroll") for (int f_ = 0; f_ < 16; ++f_) Fn[f_] = *(const bf16x8*)((((f_ >> 2) & 1) ? w1_ : w0_) + (size_t)(hd_ * 64 + PREP_CH(f_ & 3)) * 64 + (f_ >> 3) * 32 + kq * 8); } \
        else { const bf16_t* wg_ = SM + (size_t)4 * RW * 64; \
            _Pragma("unroll") for (int f_ = 0; f_ < 16; ++f_) Fn[f_] = *(const bf16x8*)(wg_ + (size_t)(hd_ * 64 + PREP_CH(f_ & 3)) * 128 + (f_ >> 2) * 32 + kq * 8); } } while (0)
    PREP_LOADF(0);
#pragma unroll 1
    for (int st = 0; st < 9; ++st) {
#pragma unroll
        for (int f = 0; f < 16; ++f) Fc[f] = Fn[f];
        const int it = wave + 8 * (st / 3), kind = st % 3, hd = it >> 2, mt = it & 3, tokl = mt * 16 + l15; const size_t tok = (size_t)b * SEQ + t0 + tokl;
        if (kind < 2) {
            const int d = kind;
            f32x4 accW[4], accA[4];
#pragma unroll
            for (int nt = 0; nt < 4; ++nt) { accW[nt] = (f32x4){0.f, 0.f, 0.f, 0.f}; accA[nt] = (f32x4){0.f, 0.f, 0.f, 0.f}; }
#pragma unroll
            for (int ks = 0; ks < 2; ++ks) {
                const bf16x8 aw = *(const LAS bf16x8*)(lds + tokl * PR_AS + (d * 64 + ks * 32 + kq * 8) * 2), aa = *(const LAS bf16x8*)(lds + tokl * PR_AS + ((2 + d) * 64 + ks * 32 + kq * 8) * 2);
#pragma unroll
                for (int nt = 0; nt < 4; ++nt) { accW[nt] = MFMA16(Fc[ks * 8 + nt], aw, accW[nt]); accA[nt] = MFMA16(Fc[ks * 8 + 4 + nt], aa, accA[nt]); }
            }
            if (st + 1 < 9) PREP_LOADF(st + 1);
            const float rn = RNs[tokl * 8 + hd];
            bf16_t* AHg = (bf16_t*)scan_arr(a.ws, 1 + 4 * d); bf16_t* RHg = (bf16_t*)scan_arr(a.ws, 2 + 4 * d); bf16_t* BHg = (bf16_t*)scan_arr(a.ws, 3 + 4 * d); bf16_t* KHg = (bf16_t*)scan_arr(a.ws, 4 + 4 * d);
            float bsum = 0.f;
            u32x2 hA[2], hR[2], hB[2], hK[2];
#pragma unroll
            for (int nt = 0; nt < 4; ++nt) { const int ch = hd * 64 + 32 * (nt >> 1) + 8 * kq + 4 * (nt & 1);
                const f32x4 bW = *(const LAS f32x4*)(CST + (3 + d) * 384 + ch), bA = *(const LAS f32x4*)(CST + (5 + d) * 384 + ch);
                const f32x4 kkw = *(const LAS f32x4*)(CST + ch), kaw = *(const LAS f32x4*)(CST + 384 + ch), rkw = *(const LAS f32x4*)(CST + 768 + ch);
                const f32x4 zw = accW[nt] + bW, za = accA[nt] + bA;
                f32x4 lw, av;
#pragma unroll
                for (int e = 0; e < 4; ++e) { lw[e] = -0.606531f * 1.4426950408889634f * sigmoidf_fast(zw[e]); av[e] = sigmoidf_fast(za[e]); }
                f32x4 cum = lw;
                if (d == 0) { cum += dpp4<0x111>(cum); cum += dpp4<0x112>(cum); cum += dpp4<0x114>(cum); cum += dpp4<0x118>(cum); }
                else        { cum += dpp4<0x101>(cum); cum += dpp4<0x102>(cum); cum += dpp4<0x104>(cum); cum += dpp4<0x108>(cum); }
                f32x4 Pt, Pinv, Pprev;
#pragma unroll
                for (int e = 0; e < 4; ++e) { Pt[e] = __builtin_amdgcn_exp2f(cum[e]); Pinv[e] = __builtin_amdgcn_rcpf(Pt[e]); Pprev[e] = __builtin_amdgcn_exp2f(cum[e] - lw[e]); }
                const f32x4 r4 = __builtin_convertvector(*(const LAS f16x4*)(lds + PR_RK + tokl * PR_RKS + ch * 2), f32x4);
                const f32x4 k4 = __builtin_convertvector(*(const LAS f16x4*)(lds + PR_RK + tokl * PR_RKS + (384 + ch) * 2), f32x4);
                const f32x4 kk = k4 * kkw * rn, kd = k4 * (1.0f + (av - 1.0f) * kaw);
                hA[nt & 1] = f32_to_bf4(-kk * Pprev); hR[nt & 1] = f32_to_bf4(r4 * Pt); hB[nt & 1] = f32_to_bf4(kk * av * Pinv); hK[nt & 1] = f32_to_bf4(kd * Pinv);
                const f32x4 bt = r4 * kd * rkw; bsum += (bt.x + bt.y) + (bt.z + bt.w);
                if (l15 == (d ? 0 : 15)) *(f32x4*)(PCg + ((size_t)d * (T / 16) + (tok >> 4)) * RW + ch) = Pt;
                if (nt & 1) { const int c8 = ch - 4; const size_t eo = hat_off(1, tok, c8);
                    *(u32x4*)(AHg + eo) = (u32x4){hA[0].x, hA[0].y, hA[1].x, hA[1].y}; *(u32x4*)(RHg + eo) = (u32x4){hR[0].x, hR[0].y, hR[1].x, hR[1].y};
                    *(u32x4*)(BHg + eo) = (u32x4){hB[0].x, hB[0].y, hB[1].x, hB[1].y}; *(u32x4*)(KHg + hat_off(4 + 4 * d, tok, c8)) = (u32x4){hK[0].x, hK[0].y, hK[1].x, hK[1].y}; }
            }
            bsum += __shfl_xor(bsum, 16); bsum += __shfl_xor(bsum, 32);
            if (kq == 0) BON[(size_t)d * T * NH + tok * NH + hd] = bsum;
        } else {
            f32x4 acc[4];
#pragma unroll
            for (int nt = 0; nt < 4; ++nt) acc[nt] = (f32x4){0.f, 0.f, 0.f, 0.f};
#pragma unroll
            for (int ks = 0; ks < 4; ++ks) { const bf16x8 afr = *(const LAS bf16x8*)(lds + tokl * PR_AS + (256 + ks * 32 + kq * 8) * 2);
#pragma unroll
                for (int nt = 0; nt < 4; ++nt) acc[nt] = MFMA16(Fc[ks * 4 + nt], afr, acc[nt]); }
            if (st + 1 < 9) PREP_LOADF(st + 1);
#pragma unroll
            for (int pr = 0; pr < 2; ++pr) { const u32x2 g0 = f32_to_bf4(acc[2 * pr]), g1 = f32_to_bf4(acc[2 * pr + 1]);
                *(u32x4*)((bf16_t*)(a.ws + WS_G) + tok * RW + hd * 64 + 32 * pr + 8 * kq) = (u32x4){g0.x, g0.y, g1.x, g1.y}; }
        }
    }
#undef PREP_LOADF
#undef PREP_CH
}

__device__ __forceinline__ void glds16_asm(const void* gptr, LAS unsigned char* ldst) {
    const unsigned la = __builtin_amdgcn_readfirstlane((unsigned)(size_t)ldst);
    asm volatile("s_mov_b32 m0, %1\n\ts_nop 0\n\tglobal_load_lds_dwordx4 %0, off" :: "v"(gptr), "s"(la) : "m0", "memory");
}
constexpr int CK = 16, NCHUNK = SEQ / CK, CS_NS = 8, CS_NPROD = 6, CS_NCONS = 2;
constexpr int SL_ATIL = 0, SL_RTIL = 2048, SL_BH = 4096, SL_KH = 6144, SL_V = 8192, SL_ULOC = 10240, SL_YLOC = 12288, SL_PC = 14336, SL_BYTES = 14592;
constexpr int PS_AH = 0, PS_RH = 2048, PS_BYTES = 4096;
constexpr int CS_PS_OFF = CS_NS * SL_BYTES, CS_FLAG_OFF = CS_PS_OFF + CS_NPROD * PS_BYTES;
static_assert(CS_FLAG_OFF + 64 <= LDS_BYTES - 64, "chunked scan LDS map");
__device__ __forceinline__ int swz(int t, int j) { return t * 128 + ((((j >> 3) ^ (t & 7))) << 4) + ((j & 4) << 1); }
__device__ __forceinline__ void scan_chunked_unit(const Args& a, LAS unsigned char* lds, int unit) {
    const int tid = threadIdx.x, lane = tid & 63, wave = __builtin_amdgcn_readfirstlane(tid >> 6);
    const int dir = unit & 1, bh = unit >> 1, b = bh / NH, hd = bh % NH;
    const int c16 = lane & 15, q = lane >> 4, qp = c16 >> 2, pp = c16 & 3;
    volatile LAS unsigned* FULL = (volatile LAS unsigned*)(lds + CS_FLAG_OFF);
    volatile LAS unsigned* DONE = FULL + 8;
    float* Yg = (float*)(a.ws + (dir ? WS_YB : WS_YF));
    __syncthreads();
    if (tid < 16) FULL[tid] = 0u;
    __syncthreads();
    if (wave >= CS_NCONS) {
        const int pw = wave - CS_NCONS;
        LAS unsigned char* ps = lds + CS_PS_OFF + pw * PS_BYTES;
        const bf16_t* ARR[5] = {(const bf16_t*)scan_arr(a.ws, 1 + 4 * dir), (const bf16_t*)scan_arr(a.ws, 2 + 4 * dir), (const bf16_t*)scan_arr(a.ws, 3 + 4 * dir), (const bf16_t*)scan_arr(a.ws, 4 + 4 * dir), (const bf16_t*)scan_arr(a.ws, 0)};
        const int AIDX[5] = {1 + 4 * dir, 2 + 4 * dir, 3 + 4 * dir, 4 + 4 * dir, 0};
        const float* PCg = (const float*)(a.ws + WS_PC) + (size_t)dir * (T / 16) * RW + hd * 64 + lane;
        u32x4 pf[10];
#define CS_ISSUE(cc) do { _Pragma("unroll") for (int ar_ = 0; ar_ < 5; ++ar_) _Pragma("unroll") for (int hf_ = 0; hf_ < 2; ++hf_) { \
            const int row_ = hf_ * 8 + (lane >> 3); const int st_ = (cc) * CK + row_; const int t_ = dir ? (SEQ - 1 - st_) : st_; \
            pf[ar_ * 2 + hf_] = *(const u32x4*)(ARR[ar_] + hat_off(AIDX[ar_], (size_t)b * SEQ + t_, hd * 64 + 8 * ((lane & 7) ^ (row_ & 7)))); } } while (0)
#define CS_PCLOAD(cc) PCg[(size_t)((size_t)b * (SEQ / CK) + (dir ? (NCHUNK - 1 - (cc)) : (cc))) * RW]
        CS_ISSUE(pw);
        float pcn = CS_PCLOAD(pw);
#pragma unroll 1
        for (int c = pw; c < NCHUNK; c += CS_NPROD) {
            const int slot = c % CS_NS; LAS unsigned char* sl = lds + slot * SL_BYTES;
            { unsigned sp = 0; const unsigned want = (unsigned)CS_NCONS * (unsigned)(c / CS_NS); while (DONE[slot] < want) { __builtin_amdgcn_s_sleep(1); if (++sp > (1u << 22)) break; } }
            asm volatile("" ::: "memory");
            *(LAS u32x4*)(ps + PS_AH + lane * 16) = pf[0]; *(LAS u32x4*)(ps + PS_AH + 1024 + lane * 16) = pf[1];
            *(LAS u32x4*)(ps + PS_RH + lane * 16) = pf[2]; *(LAS u32x4*)(ps + PS_RH + 1024 + lane * 16) = pf[3];
            *(LAS u32x4*)(sl + SL_BH + lane * 16) = pf[4]; *(LAS u32x4*)(sl + SL_BH + 1024 + lane * 16) = pf[5];
            *(LAS u32x4*)(sl + SL_KH + lane * 16) = pf[6]; *(LAS u32x4*)(sl + SL_KH + 1024 + lane * 16) = pf[7];
            *(LAS u32x4*)(sl + SL_V + lane * 16) = pf[8]; *(LAS u32x4*)(sl + SL_V + 1024 + lane * 16) = pf[9];
            *(LAS float*)(sl + SL_PC + lane * 4) = pcn;
            if (c + CS_NPROD < NCHUNK) { CS_ISSUE(c + CS_NPROD); pcn = CS_PCLOAD(c + CS_NPROD); }
            asm volatile("s_waitcnt lgkmcnt(0)" ::: "memory");
#ifndef PROD_REP
#define PROD_REP 1
#endif
#pragma unroll 1
            for (int rpp = 0; rpp < PROD_REP; ++rpp) {
            bf16x8 AHf[2], BHf[2], KHf[2], RHf[2];
#pragma unroll
            for (int ks = 0; ks < 2; ++ks) { const int o = swz(c16, 32 * ks + 8 * q);
                AHf[ks] = *(const LAS bf16x8*)(ps + PS_AH + o); RHf[ks] = *(const LAS bf16x8*)(ps + PS_RH + o); BHf[ks] = *(const LAS bf16x8*)(sl + SL_BH + o); KHf[ks] = *(const LAS bf16x8*)(sl + SL_KH + o); }
            f32x4 Mab = {0.f, 0.f, 0.f, 0.f}, Mak = Mab, MrbT = Mab, MrkT = Mab, MabT = Mab;
#pragma unroll
            for (int ks = 0; ks < 2; ++ks) { Mab = MFMA16(AHf[ks], BHf[ks], Mab); MabT = MFMA16(BHf[ks], AHf[ks], MabT); Mak = MFMA16(AHf[ks], KHf[ks], Mak); MrbT = MFMA16(BHf[ks], RHf[ks], MrbT); MrkT = MFMA16(KHf[ks], RHf[ks], MrkT); }
#pragma unroll
            for (int r = 0; r < 4; ++r) { const bool lt = c16 < 4 * q + r, gt = 4 * q + r < c16, le = 4 * q + r <= c16;
                Mab[r] = lt ? Mab[r] : 0.f; Mak[r] = lt ? Mak[r] : 0.f; MabT[r] = gt ? MabT[r] : 0.f; MrbT[r] = le ? MrbT[r] : 0.f; MrkT[r] = le ? MrkT[r] : 0.f; }
            const f32x4 z4 = {0.f, 0.f, 0.f, 0.f};
            const bf16x8 fN = frag_lo4(Mab), fNT = frag_lo4(MabT);
            const f32x4 N2 = MFMA16(fNT, fN, z4), N2T = MFMA16(fN, fNT, z4);
            f32x4 PT = MabT;
#pragma unroll
            for (int r = 0; r < 4; ++r) PT[r] += (4 * q + r == c16) ? 1.0f : 0.f;
            const bf16x8 fN2 = frag_lo4(N2), fN2T = frag_lo4(N2T);
            PT = MFMA16(fN2, frag_lo4(PT), PT);
            const f32x4 N4 = MFMA16(fN2T, fN2, z4), N4T = MFMA16(fN2, fN2T, z4);
            const bf16x8 fN4 = frag_lo4(N4), fN4T = frag_lo4(N4T);
            PT = MFMA16(fN4, frag_lo4(PT), PT);
            const f32x4 N8 = MFMA16(fN4T, fN4, z4);
            PT = MFMA16(frag_lo4(N8), frag_lo4(PT), PT);
            const bf16x8 LinvF = frag_lo4(PT);
            const bf16x8 MakF = frag_lo4(Mak), MrbTF = frag_lo4(MrbT);
            const f32x4 W1 = MFMA16(LinvF, MakF, z4);
            const f32x4 W1T = MFMA16(MakF, LinvF, z4);
            const f32x4 W2T = MFMA16(frag_lo4(W1), MrbTF, MrkT);
            f32x4 AtT[4], RtT[4];
#pragma unroll
            for (int jt = 0; jt < 4; ++jt) {
                const bf16x8 ahF = frag_cat(__builtin_bit_cast(u32x2, tr_read16(ps + PS_AH + swz(4 * q + qp, 16 * jt + 4 * pp))), (u32x2){0u, 0u});
                const f32x4 AtN = MFMA16(LinvF, ahF, z4);
                AtT[jt] = MFMA16(ahF, LinvF, z4);
                const f32x4 rinit = bf4_to_f32(*(const LAS u32x2*)(ps + PS_RH + swz(c16, 16 * jt + 4 * q)));
                RtT[jt] = MFMA16(frag_lo4(AtN), MrbTF, rinit);
            }
#pragma unroll
            for (int ks = 0; ks < 2; ++ks) {
                const u32x4 wa = {pk_bf16(AtT[2 * ks][0], AtT[2 * ks][1]), pk_bf16(AtT[2 * ks][2], AtT[2 * ks][3]), pk_bf16(AtT[2 * ks + 1][0], AtT[2 * ks + 1][1]), pk_bf16(AtT[2 * ks + 1][2], AtT[2 * ks + 1][3])};
                const u32x4 wr = {pk_bf16(RtT[2 * ks][0], RtT[2 * ks][1]), pk_bf16(RtT[2 * ks][2], RtT[2 * ks][3]), pk_bf16(RtT[2 * ks + 1][0], RtT[2 * ks + 1][1]), pk_bf16(RtT[2 * ks + 1][2], RtT[2 * ks + 1][3])};
                *(LAS u32x4*)(sl + SL_ATIL + ks * 1024 + lane * 16) = wa; *(LAS u32x4*)(sl + SL_RTIL + ks * 1024 + lane * 16) = wr; }
            *(LAS u32x2*)(sl + SL_ULOC + lane * 8) = f32_to_bf4(W1T); *(LAS u32x2*)(sl + SL_YLOC + lane * 8) = f32_to_bf4(W2T);
            }
            asm volatile("s_waitcnt lgkmcnt(0)" ::: "memory");
            if (lane == 0) FULL[slot] = (unsigned)(c + 1);
        }
#undef CS_ISSUE
#undef CS_PCLOAD
    } else {
        struct ConsOps { bf16x8 at0, at1, rt0, rt1, bk[4]; u32x2 w1w, w2w, vfw[2]; f32x4 pc[4]; };
        f32x4 S[2][4];
#pragma unroll
        for (int ti = 0; ti < 2; ++ti)
#pragma unroll
            for (int mt = 0; mt < 4; ++mt) S[ti][mt] = (f32x4){0.f, 0.f, 0.f, 0.f};
#define CONS_LOAD(X, cc) do { const int slot_ = (cc) % CS_NS; LAS unsigned char* sl_ = lds + slot_ * SL_BYTES; \
            { unsigned sp_ = 0; while (FULL[slot_] < (unsigned)((cc) + 1)) { __builtin_amdgcn_s_sleep(1); if (++sp_ > (1u << 22)) break; } } \
            asm volatile("" ::: "memory"); \
            X.at0 = *(const LAS bf16x8*)(sl_ + SL_ATIL + lane * 16); X.at1 = *(const LAS bf16x8*)(sl_ + SL_ATIL + 1024 + lane * 16); \
            X.rt0 = *(const LAS bf16x8*)(sl_ + SL_RTIL + lane * 16); X.rt1 = *(const LAS bf16x8*)(sl_ + SL_RTIL + 1024 + lane * 16); \
            X.w1w = *(const LAS u32x2*)(sl_ + SL_ULOC + lane * 8); X.w2w = *(const LAS u32x2*)(sl_ + SL_YLOC + lane * 8); \
            _Pragma("unroll") for (int mt_ = 0; mt_ < 4; ++mt_) { X.pc[mt_] = *(const LAS f32x4*)(sl_ + SL_PC + (16 * mt_ + 4 * q) * 4); \
                X.bk[mt_] = frag_cat(__builtin_bit_cast(u32x2, tr_read16(sl_ + SL_BH + swz(4 * q + qp, 16 * mt_ + 4 * pp))), __builtin_bit_cast(u32x2, tr_read16(sl_ + SL_KH + swz(4 * q + qp, 16 * mt_ + 4 * pp)))); } \
            _Pragma("unroll") for (int ti_ = 0; ti_ < 2; ++ti_) X.vfw[ti_] = __builtin_bit_cast(u32x2, tr_read16(sl_ + SL_V + swz(4 * q + qp, 16 * (2 * wave + ti_) + 4 * pp))); } while (0)
#define CONS_COMPUTE(X, cc) do { const f32x4 z4c_ = {0.f, 0.f, 0.f, 0.f}; const bf16x8 w1f_ = frag_cat(X.w1w, (u32x2){0u, 0u}), w2f_ = frag_cat(X.w2w, (u32x2){0u, 0u}); \
            _Pragma("unroll") for (int ti_ = 0; ti_ < 2; ++ti_) { const int nt_ = 2 * wave + ti_; \
                const bf16x8 vB_ = frag_cat(X.vfw[ti_], (u32x2){0u, 0u}); \
                const bf16x8 Sb0_ = frag_cat(f32_to_bf4(S[ti_][0]), f32_to_bf4(S[ti_][1])), Sb1_ = frag_cat(f32_to_bf4(S[ti_][2]), f32_to_bf4(S[ti_][3])); \
                const f32x4 U0_ = MFMA16(X.at0, Sb0_, MFMA16(w1f_, vB_, z4c_)), U1_ = MFMA16(X.at1, Sb1_, z4c_); \
                const f32x4 Y0_ = MFMA16(X.rt0, Sb0_, MFMA16(w2f_, vB_, z4c_)), Y1_ = MFMA16(X.rt1, Sb1_, z4c_); \
                const f32x4 UT_ = U0_ + U1_, YT_ = Y0_ + Y1_; \
                const bf16x8 Ub_ = frag_cat(f32_to_bf4(UT_), X.vfw[ti_]); \
                _Pragma("unroll") for (int mt_ = 0; mt_ < 4; ++mt_) { S[ti_][mt_] = MFMA16(X.bk[mt_], Ub_, S[ti_][mt_]); S[ti_][mt_] = S[ti_][mt_] * X.pc[mt_]; } \
                *(f32x4*)(Yg + ((((size_t)b * NCHUNK + (dir ? (NCHUNK - 1 - (cc)) : (cc))) * NH + hd) * 64 + 16 * nt_ + c16) * 16 + 4 * q) = YT_; } } while (0)
#define CONS_DONE(cc) do { asm volatile("s_waitcnt lgkmcnt(0)" ::: "memory"); if (lane == 0) (void)__hip_atomic_fetch_add((LAS unsigned*)&DONE[(cc) % CS_NS], 1u, __ATOMIC_RELAXED, __HIP_MEMORY_SCOPE_WORKGROUP); } while (0)
        ConsOps OA, OB;
        CONS_LOAD(OA, 0);
#pragma unroll 1
        for (int c = 0; c < NCHUNK; c += 2) {
            CONS_LOAD(OB, c + 1);
            CONS_COMPUTE(OA, c);
            CONS_DONE(c);
            if (c + 2 < NCHUNK) CONS_LOAD(OA, c + 2);
            CONS_COMPUTE(OB, c + 1);
            CONS_DONE(c + 1);
        }
#undef CONS_LOAD
#undef CONS_COMPUTE
#undef CONS_DONE
        unsigned tq0 = 0u, tq1 = 0u, tq2 = 0u, tq3 = 0u, tq4 = 0u, tq5 = 0u, tacc = 0u;
        (void)tq0; (void)tq1; (void)tq2; (void)tq3; (void)tq4; (void)tq5;
        (void)tacc;
    }
}

__device__ __forceinline__ void phase_post(const Args& a, int G) {
    const int tid = threadIdx.x, lane = tid & 63, wave = __builtin_amdgcn_readfirstlane(tid >> 6);
    const int gw = blockIdx.x * 8 + wave, NGW = G * 8, t = lane & 15, iq = lane >> 4;
    const float* __restrict__ YF = (const float*)(a.ws + WS_YF); const float* __restrict__ YB = (const float*)(a.ws + WS_YB); const float* __restrict__ BON = (const float*)(a.ws + WS_BON);
    const bf16_t* __restrict__ Vg = (const bf16_t*)scan_arr(a.ws, 0); const bf16_t* __restrict__ Gg = (const bf16_t*)(a.ws + WS_G); bf16_t* __restrict__ MIX = (bf16_t*)(a.ws + WS_MIX);
    float* ss = (float*)(a.ws + WS_SS);
    for (int i = blockIdx.x * NTHREADS + tid; i < T; i += G * NTHREADS) ss[i] = 0.f;
    constexpr int NIT = (T / 16) * NH;
#pragma unroll 1
    for (int it = gw; it < NIT; it += NGW) {
        const int tile = it / NH, hd = it - tile * NH, tok = tile * 16 + t;
        const float* yfp = YF + ((size_t)it * 64 + 16 * iq) * 16 + t; const float* ybp = YB + ((size_t)it * 64 + 16 * iq) * 16 + (15 - t);
        float y[16];
#pragma unroll
        for (int k = 0; k < 16; ++k) y[k] = yfp[k * 16] + ybp[k * 16];
        const u32x4 v0 = *(const u32x4*)(Vg + ((size_t)it * 16 + t) * 64 + 16 * iq), v1 = *(const u32x4*)(Vg + ((size_t)it * 16 + t) * 64 + 16 * iq + 8);
        const u32x4 g0 = *(const u32x4*)(Gg + (size_t)tok * RW + hd * 64 + 16 * iq), g1 = *(const u32x4*)(Gg + (size_t)tok * RW + hd * 64 + 16 * iq + 8);
        const float bon = BON[(size_t)tok * NH + hd] + BON[(size_t)T * NH + (size_t)tok * NH + hd];
        float sm = 0.f;
#pragma unroll
        for (int k = 0; k < 16; ++k) sm += y[k];
        sm += __shfl_xor(sm, 16); sm += __shfl_xor(sm, 32);
        const float mean = sm * (1.f / 64.f); float vs = 0.f;
#pragma unroll
        for (int k = 0; k < 16; ++k) { y[k] -= mean; vs += y[k] * y[k]; }
        vs += __shfl_xor(vs, 16); vs += __shfl_xor(vs, 32);
        const float rstd = 1.0f / sqrtf(vs * (1.f / 64.f) + 64e-5f);
        const unsigned vw[8] = {v0.x, v0.y, v0.z, v0.w, v1.x, v1.y, v1.z, v1.w}, gwd[8] = {g0.x, g0.y, g0.z, g0.w, g1.x, g1.y, g1.z, g1.w};
        unsigned ow[8];
#pragma unroll
        for (int k2 = 0; k2 < 8; ++k2) { const int ch = hd * 64 + 16 * iq + 2 * k2;
            const float o0 = (y[2 * k2] * rstd * a.in[I_LNXG][ch] + a.in[I_LNXB][ch] + bon * bf_lo(vw[k2])) * bf_lo(gwd[k2]);
            const float o1 = (y[2 * k2 + 1] * rstd * a.in[I_LNXG][ch + 1] + a.in[I_LNXB][ch + 1] + bon * bf_hi(vw[k2])) * bf_hi(gwd[k2]);
            ow[k2] = pk_bf16(o0, o1); }
        bf16_t* op = MIX + (size_t)tok * D + 640 + hd * 64 + 16 * iq;
        *(u32x4*)op = (u32x4){ow[0], ow[1], ow[2], ow[3]}; *(u32x4*)(op + 8) = (u32x4){ow[4], ow[5], ow[6], ow[7]};
    }
}

constexpr int RT_WS = 2064;
__device__ __forceinline__ void phase_router(const Args& a, LAS unsigned char* lds, int G) {
    const int tid = threadIdx.x, lane = tid & 63, wave = __builtin_amdgcn_readfirstlane(tid >> 6);
    const int gw = blockIdx.x * 8 + wave, NGW = G * 8, l15 = lane & 15, kq = lane >> 4;
    LAS bf16_t* WH = (LAS bf16_t*)lds; LAS bf16_t* WL = (LAS bf16_t*)(lds + 16 * RT_WS);
    for (int i = tid; i < D * NE; i += NTHREADS) { const int k = i >> 4, e = i & 15; const float w = a.in[I_WROUTER][i];
        const unsigned hi = pk_bf16(w, 0.f) & 0xffffu; const float rem = w - bf_lo(hi);
        WH[e * (RT_WS / 2) + k] = (bf16_t)hi; WL[e * (RT_WS / 2) + k] = (bf16_t)(pk_bf16(rem, 0.f) & 0xffffu); }
    __syncthreads();
    const float* __restrict__ X1 = (const float*)(a.ws + WS_X1); const float* __restrict__ ss = (const float*)(a.ws + WS_SS); bf16_t* __restrict__ H2 = (bf16_t*)(a.ws + WS_H2);
    float* __restrict__ AFF = (float*)(a.ws + WS_AFF); int* __restrict__ INV = (int*)(a.ws + WS_INV);
    const float* __restrict__ GF = a.in[I_NFFNG];
    for (int grp = gw; grp < T / 16; grp += NGW) {
        const int tok = grp * 16 + l15;
        const float rs = 1.0f / sqrtf(ss[tok] * (1.f / D) + 1e-6f);
        f32x4 acc = {0.f, 0.f, 0.f, 0.f};
        const float* xrow = X1 + (size_t)tok * D + 8 * kq; bf16_t* hrow = H2 + (size_t)tok * D + 8 * kq;
#pragma unroll 8
        for (int ks = 0; ks < 32; ++ks) {
            const f32x4 x0 = *(const f32x4*)(xrow + 32 * ks), x1v = *(const f32x4*)(xrow + 32 * ks + 4);
            const f32x4 g0 = *(const f32x4*)(GF + 32 * ks + 8 * kq), g1 = *(const f32x4*)(GF + 32 * ks + 8 * kq + 4);
            const f32x4 h0 = x0 * rs * g0, h1 = x1v * rs * g1;
            u32x4 hi; hi.x = pk_bf16(h0.x, h0.y); hi.y = pk_bf16(h0.z, h0.w); hi.z = pk_bf16(h1.x, h1.y); hi.w = pk_bf16(h1.z, h1.w);
            *(u32x4*)(hrow + 32 * ks) = hi;
            u32x4 lo; lo.x = pk_bf16(h0.x - bf_lo(hi.x), h0.y - bf_hi(hi.x)); lo.y = pk_bf16(h0.z - bf_lo(hi.y), h0.w - bf_hi(hi.y));
            lo.z = pk_bf16(h1.x - bf_lo(hi.z), h1.y - bf_hi(hi.z)); lo.w = pk_bf16(h1.z - bf_lo(hi.w), h1.w - bf_hi(hi.w));
            const bf16x8 ah = __builtin_bit_cast(bf16x8, hi), al = __builtin_bit_cast(bf16x8, lo);
            const bf16x8 bh = *(const LAS bf16x8*)(lds + l15 * RT_WS + (32 * ks + 8 * kq) * 2), bl = *(const LAS bf16x8*)(lds + 16 * RT_WS + l15 * RT_WS + (32 * ks + 8 * kq) * 2);
            acc = __builtin_amdgcn_mfma_f32_16x16x32_bf16(ah, bh, acc, 0, 0, 0);
            acc = __builtin_amdgcn_mfma_f32_16x16x32_bf16(al, bh, acc, 0, 0, 0);
            acc = __builtin_amdgcn_mfma_f32_16x16x32_bf16(ah, bl, acc, 0, 0, 0);
        }
#pragma unroll
        for (int rg = 0; rg < 4; ++rg) { const float mx = max16(acc[rg]); const float ex = __expf(acc[rg] - mx); const float sm = sum16(ex);
            const int t2 = grp * 16 + 4 * kq + rg, bb = t2 >> 12, sq = t2 & (SEQ - 1);
            AFF[((size_t)(bb * NE + l15)) * SEQ + sq] = ex / sm; }
        *(u32x4*)(INV + (size_t)grp * 256 + 4 * lane) = (u32x4){0xffffffffu, 0xffffffffu, 0xffffffffu, 0xffffffffu};
    }
}

__device__ __forceinline__ void topk_unit(const Args& a, LAS unsigned char* lds, int unit) {
    const int tid = threadIdx.x, lane = tid & 63, wave = __builtin_amdgcn_readfirstlane(tid >> 6);
    const int b = unit >> 4, e = unit & 15;
    const float* AFF = (const float*)(a.ws + WS_AFF) + (size_t)unit * SEQ;
    LAS unsigned* KEY = (LAS unsigned*)lds;
    LAS unsigned* HIST = (LAS unsigned*)(lds + 16384);
    LAS unsigned* CTL = (LAS unsigned*)(lds + 16384 + 1024);
    LAS unsigned* WS_ = (LAS unsigned*)(lds + 16384 + 2048);
    __syncthreads();
    unsigned key[8];
    { const u32x4 k0 = *(const u32x4*)(AFF + tid * 8), k1 = *(const u32x4*)(AFF + tid * 8 + 4); key[0] = k0.x; key[1] = k0.y; key[2] = k0.z; key[3] = k0.w; key[4] = k1.x; key[5] = k1.y; key[6] = k1.z; key[7] = k1.w; }
    if (tid == 0) { CTL[0] = 0u; CTL[1] = (unsigned)CAP; }
    unsigned prefix = 0u, mask = 0u;
#pragma unroll 1
    for (int pass = 0; pass < 4; ++pass) {
        const int shift = 24 - 8 * pass;
        if (tid < 256) HIST[tid] = 0u;
        __syncthreads();
#pragma unroll
        for (int i = 0; i < 8; ++i) if ((key[i] & mask) == prefix) (void)__hip_atomic_fetch_add(&HIST[(key[i] >> shift) & 255u], 1u, __ATOMIC_RELAXED, __HIP_MEMORY_SCOPE_WORKGROUP);
        __syncthreads();
        if (wave == 0) {
            const unsigned need = CTL[1];
            unsigned hv[4], tsum = 0u;
#pragma unroll
            for (int i = 0; i < 4; ++i) { hv[i] = HIST[255 - (4 * lane + i)]; tsum += hv[i]; }
            unsigned inc = tsum;
#pragma unroll
            for (int o = 1; o < 64; o <<= 1) { const unsigned v = __shfl_up(inc, o); if (lane >= o) inc += v; }
            unsigned exc = inc - tsum;
            if (exc < need && need <= inc) {
                unsigned run = exc; int di = 0;
#pragma unroll
                for (int i = 0; i < 4; ++i) { if (run < need && need <= run + hv[i]) { di = i; break; } run += hv[i]; }
                const unsigned digit = 255u - (unsigned)(4 * lane + di);
                CTL[0] = prefix | (digit << shift); CTL[1] = need - run;
            }
        }
        __syncthreads();
        prefix = CTL[0]; mask |= (255u << shift);
    }
    const unsigned thr = prefix, need_eq = CTL[1];
    unsigned ngt = 0u, neq = 0u;
#pragma unroll
    for (int i = 0; i < 8; ++i) { ngt += (key[i] > thr) ? 1u : 0u; neq += (key[i] == thr) ? 1u : 0u; }
    unsigned pk = ngt | (neq << 16), inc = pk;
#pragma unroll
    for (int o = 1; o < 64; o <<= 1) { const unsigned v = __shfl_up(inc, o); if (lane >= o) inc += v; }
    if (lane == 63) WS_[wave] = inc;
    __syncthreads();
    unsigned woff = 0u, tot = 0u;
#pragma unroll
    for (int w = 0; w < 8; ++w) { const unsigned v = WS_[w]; if (w < wave) woff += v; tot += v; }
    const unsigned exc = inc - pk + woff;
    unsigned gpos = exc & 0xffffu, epos = exc >> 16; const unsigned totgt = tot & 0xffffu;
    const int sbase = (e * BATCH + b) * CAP;
    int* ROWTOK = (int*)(a.ws + WS_ROWTOK); float* ROWGATE = (float*)(a.ws + WS_ROWGATE); int* INV = (int*)(a.ws + WS_INV);
#pragma unroll
    for (int i = 0; i < 8; ++i) {
        int pos = -1;
        if (key[i] > thr) pos = (int)gpos++;
        else if (key[i] == thr) { if (epos < need_eq) pos = (int)(totgt + epos); epos++; }
        if (pos >= 0) { const int s = tid * 8 + i, tok = b * SEQ + s, slot = sbase + pos;
            ROWTOK[slot] = tok; ROWGATE[slot] = __builtin_bit_cast(float, key[i]); INV[(size_t)tok * NE + e] = slot; }
    }
}

__device__ __forceinline__ void phase_final(const Args& a, int G) {
    const int tid = threadIdx.x, lane = tid & 63, wave = __builtin_amdgcn_readfirstlane(tid >> 6);
    const int gw = blockIdx.x * 8 + wave, NGW = G * 8;
    const float* __restrict__ X1 = (const float*)(a.ws + WS_X1); const bf16_t* __restrict__ YE = (const bf16_t*)(a.ws + WS_YE); const int* __restrict__ INV = (const int*)(a.ws + WS_INV);
    float* __restrict__ OUT = a.out;
    f32x4 gg[4];
#pragma unroll
    for (int j = 0; j < 4; ++j) gg[j] = *(const f32x4*)(a.in[I_FNG] + 4 * lane + 256 * j);
    int tok = gw;
    int invn = (tok < T) ? INV[(size_t)tok * NE + (lane & 15)] : -1;
    f32x4 xn[4];
#pragma unroll
    for (int j = 0; j < 4; ++j) xn[j] = (tok < T) ? *(const f32x4*)(X1 + (size_t)tok * D + 4 * lane + 256 * j) : (f32x4){0.f, 0.f, 0.f, 0.f};
    for (; tok < T; tok += NGW) {
        const int invc = invn; f32x4 v[4];
#pragma unroll
        for (int j = 0; j < 4; ++j) v[j] = xn[j];
        const int tn = tok + NGW;
        if (tn < T) { invn = INV[(size_t)tn * NE + (lane & 15)];
#pragma unroll
            for (int j = 0; j < 4; ++j) xn[j] = *(const f32x4*)(X1 + (size_t)tn * D + 4 * lane + 256 * j); }
        unsigned long long m = __ballot(invc >= 0) & 0xffffull;
        const int n = __builtin_popcountll(m);
        int sl[4]; float wt[4];
#pragma unroll
        for (int k = 0; k < 4; ++k) { int e = 0; if (m) { e = __builtin_ctzll(m); m &= m - 1; wt[k] = 1.f; sl[k] = __builtin_amdgcn_readlane(invc, e); } else { wt[k] = 0.f; sl[k] = 0; } }
        u32x2 rw[4][4];
#pragma unroll
        for (int k = 0; k < 4; ++k)
#pragma unroll
            for (int j = 0; j < 4; ++j) rw[k][j] = *(const u32x2*)(YE + (size_t)sl[k] * D + 4 * lane + 256 * j);
#pragma unroll
        for (int k = 0; k < 4; ++k)
#pragma unroll
            for (int j = 0; j < 4; ++j) { v[j].x += wt[k] * bf_lo(rw[k][j].x); v[j].y += wt[k] * bf_hi(rw[k][j].x); v[j].z += wt[k] * bf_lo(rw[k][j].y); v[j].w += wt[k] * bf_hi(rw[k][j].y); }
        if (n > 4) { while (m) { const int e = __builtin_ctzll(m); m &= m - 1; const int slot = __builtin_amdgcn_readlane(invc, e);
#pragma unroll
                for (int j = 0; j < 4; ++j) { const u32x2 w = *(const u32x2*)(YE + (size_t)slot * D + 4 * lane + 256 * j);
                    v[j].x += bf_lo(w.x); v[j].y += bf_hi(w.x); v[j].z += bf_lo(w.y); v[j].w += bf_hi(w.y); } } }
        float sq = 0.f;
#pragma unroll
        for (int j = 0; j < 4; ++j) sq += (v[j].x * v[j].x + v[j].y * v[j].y) + (v[j].z * v[j].z + v[j].w * v[j].w);
        float rs = 1.0f / sqrtf(wave_sum(sq) * (1.f / D) + 1e-6f);
#pragma unroll
        for (int j = 0; j < 4; ++j) *(f32x4*)(OUT + (size_t)tok * D + 4 * lane + 256 * j) = v[j] * rs * gg[j];
    }
}

#define XB_TMO      128
#define XB_XCNT(j)  (256  + 64 * (j))
#define XB_XSUB(j)  (1280 + 64 * (j))
#define XB_XGEN(j)  (2304 + 64 * (j))
#define XB_TOP      3328
#define XB_TOPGEN   3392
#define XCD_BAR_WORDS 3456
#define XB_SPIN_CAP (1u << 22)
__device__ __forceinline__ unsigned xb_ld(unsigned* p)              { return __hip_atomic_load(p, __ATOMIC_RELAXED, __HIP_MEMORY_SCOPE_AGENT); }
__device__ __forceinline__ unsigned xb_add(unsigned* p, unsigned v) { return __hip_atomic_fetch_add(p, v, __ATOMIC_RELAXED, __HIP_MEMORY_SCOPE_AGENT); }
__device__ __forceinline__ unsigned xb_xcc_id() { return (unsigned)__builtin_amdgcn_s_getreg((3 << 11) | 20) & 0xFu; }
#define XB_SPIN(cond, bar) do { unsigned _sp = 0; while (cond) { __builtin_amdgcn_s_sleep(1); \
    if ((++_sp & 255u) == 0u) { if (xb_ld(&(bar)[XB_TMO])) break; if (_sp > XB_SPIN_CAP) { atomicAdd(&(bar)[XB_TMO], 1u); break; } } } } while (0)
struct XcdBarrier { unsigned* bar; unsigned x; volatile LAS unsigned* st; };
__device__ __forceinline__ XcdBarrier xcd_barrier_post(unsigned* bar, volatile LAS unsigned* st) {
    XcdBarrier b; b.bar = bar; b.x = xb_xcc_id(); b.st = st;
    if (threadIdx.x == 0) (void)xb_add(&bar[XB_XCNT(b.x)], 1u);
    return b;
}
__device__ __forceinline__ void xcd_barrier_complete(unsigned* bar, unsigned x, unsigned& nloc, unsigned& nx) {
    const unsigned G = gridDim.x * gridDim.y * gridDim.z;
    unsigned sum, cnt, mine, sp = 0u;
    for (;;) {
        sum = 0u; cnt = 0u; mine = 0u;
#pragma unroll
        for (unsigned j = 0; j < 16; ++j) { const unsigned c = xb_ld(&bar[XB_XCNT(j)]); sum += c; cnt += (c > 0u) ? 1u : 0u; mine = (j == x) ? c : mine; }
        if (sum == G) break;
        __builtin_amdgcn_s_sleep(1);
        if ((++sp & 255u) == 0u) { if (xb_ld(&bar[XB_TMO])) break; if (sp > XB_SPIN_CAP) { atomicAdd(&bar[XB_TMO], 1u); break; } }
    }
    nloc = mine > 0u ? mine : 1u; nx = cnt > 0u ? cnt : 1u;
}
__device__ __forceinline__ void xcd_barrier(const XcdBarrier& b) {
    asm volatile("s_waitcnt vmcnt(0)" ::: "memory");
    __syncthreads();
    if (threadIdx.x == 0) {
        unsigned* bar = b.bar;
        __builtin_amdgcn_s_waitcnt(0);
        unsigned nloc = b.st[0], nx = b.st[1];
        if (nloc == 0u) { xcd_barrier_complete(bar, b.x, nloc, nx); b.st[0] = nloc; b.st[1] = nx; }
        const unsigned old = xb_add(&bar[XB_XSUB(b.x)], 1u);
        const unsigned gen = old / nloc;
        if (old + 1u == (gen + 1u) * nloc) {
            __builtin_amdgcn_fence(__ATOMIC_RELEASE, "agent");
            asm volatile("s_waitcnt vmcnt(0)" ::: "memory");
            const unsigned og = xb_add(&bar[XB_TOP], 1u);
            const unsigned tg = og / nx;
            if (og + 1u == (tg + 1u) * nx) xb_add(&bar[XB_TOPGEN], 1u);
            else XB_SPIN(xb_ld(&bar[XB_TOPGEN]) == tg, bar);
            __builtin_amdgcn_fence(__ATOMIC_ACQUIRE, "agent");
            xb_add(&bar[XB_XGEN(b.x)], 1u);
            asm volatile("s_waitcnt vmcnt(0)" ::: "memory");
        } else {
            XB_SPIN(xb_ld(&bar[XB_XGEN(b.x)]) == gen, bar);
            __builtin_amdgcn_fence(__ATOMIC_ACQUIRE, "agent");
            asm volatile("s_waitcnt vmcnt(0)" ::: "memory");
        }
    }
    __syncthreads();
}

#ifndef PH_MASK
#define PH_MASK 0x7ff
#endif
#ifndef REP_MASK
#define REP_MASK 0
#endif
#ifndef P2_MASK
#define P2_MASK 7
#endif
#ifndef P2_REP
#define P2_REP 0
#endif
constexpr int LDS_MISC = LDS_BYTES - 64;
constexpr size_t WS_CTL = 0, CTL_BYTES = 16384;
__global__ void __launch_bounds__(NTHREADS, 2) mega(Args a) {
    extern __shared__ __attribute__((aligned(16))) unsigned char lds_raw[];
    LAS unsigned char* lds = (LAS unsigned char*)lds_raw;
    cg::grid_group grid = cg::this_grid();
    const int G = gridDim.x, lo = a.ph_lo, hi = a.ph_hi;
    unsigned char* ws = a.ws;
    volatile LAS unsigned* misc = (volatile LAS unsigned*)(lds + LDS_MISC);
    if (threadIdx.x < 16) misc[threadIdx.x] = 0u;
    __syncthreads();
    XcdBarrier xbar = xcd_barrier_post((unsigned*)(ws + WS_CTL), misc);
#define IN(k) (((PH_MASK >> (k)) & 1) && lo <= (k) && (k) < hi)
#define NREP(k) (1 + ((REP_MASK >> (k)) & 1))
#define PHASE(k, ...) do { if (IN(k)) { for (int rep_ = 0; rep_ < NREP(k); ++rep_) { __VA_ARGS__; if (rep_ + 1 < NREP(k) || IN((k) + 1)) { if (lo < -1000) grid.sync();   xcd_barrier(xbar); } } } } while (0)

    PHASE(0, phase_prep(a, lds, G));

    PHASE(1, {
        pg8::Gemm g{(const bf16_t*)(ws + WS_XH), (const bf16_t*)(ws + WS_WINT), T, IN_PROJ, D};
        pg8::TripleOrder S; S.S0.init(T, IN_PROJ, G, 0); S.A1 = (const bf16_t*)(ws + WS_MEMN); S.B1 = (const bf16_t*)(ws + WS_WKT); S.A2 = (const bf16_t*)(ws + WS_WVT); S.B2 = (const bf16_t*)(ws + WS_MEMN);
        S.n1 = BATCH * NMEM / 256; S.n2 = BATCH * NMEM / 256; S.G = G; S.c = (int)blockIdx.x;
        pg8::EpiBf16x3 E{pg8::EpiBf16{(bf16_t*)(ws + WS_P), PLD, (bf16_t*)(ws + WS_Q)}, pg8::EpiBf16{(bf16_t*)(ws + WS_KMEM), 256, nullptr}, pg8::EpiBf16{(bf16_t*)(ws + WS_VT), BATCH * NMEM, nullptr}};
        pg8::gemm_phase<pg8::EpiBf16x3, pg8::TripleOrder, false>(lds, g, S, E, nullptr);
    });

    constexpr int NSCAN = BATCH * NH * 2;
    PHASE(2, {
        for (int u = blockIdx.x; u < 2048; u += G) {
            if (u < 1024) { for (int r2 = 0; r2 < 1 + ((P2_REP >> 1) & 1); ++r2) conv_unit(a, lds, u); }
            else { for (int r2 = 0; r2 < 1 + ((P2_REP >> 2) & 1); ++r2) prep_unit(a, lds, u - 1024); }
        }
    });

    PHASE(3, {
        int bid = blockIdx.x; int Gp = G; asm volatile("" : "+s"(bid), "+s"(Gp));
        for (int u = bid; u < NSCAN; u += Gp) scan_chunked_unit(a, lds, u);
        if (rep_ == 0) {
            if (Gp > NSCAN) { if (bid >= NSCAN) { for (int u = bid - NSCAN; u < 64; u += Gp - NSCAN) for (int r2 = 0; r2 < 1 + (P2_REP & 1); ++r2) attn_unit(a, lds, u);
                                                 } }
            else { for (int u = bid; u < 64; u += Gp) attn_unit(a, lds, u); }
        }
    });

    PHASE(4, phase_post(a, G));

    PHASE(5, {
        pg8::Gemm g{(const bf16_t*)(ws + WS_MIX), (const bf16_t*)(ws + WS_WOUTT), T, D, D}; pg8::StaticOrder S; S.init(T, D, G, (int)blockIdx.x);
        pg8::EpiResidSS E{a.in[I_X], (float*)(ws + WS_X1), (float*)(ws + WS_SS)}; pg8::gemm_phase<pg8::EpiResidSS, pg8::StaticOrder, false>(lds, g, S, E, nullptr);
    });

    PHASE(6, phase_router(a, lds, G));

    PHASE(7, { for (int u = blockIdx.x; u < BATCH * NE; u += G) topk_unit(a, lds, u); });

    PHASE(8, {
        pg8::Gemm g{(const bf16_t*)(ws + WS_H2), (const bf16_t*)(ws + WS_WGUT), NSLOT, 2048, D}; pg8::ExpertOrder S; S.init(32, 8, NE, G, (int)blockIdx.x);
        pg8::EpiSwiGLU E{(bf16_t*)(ws + WS_HID)}; pg8::gemm_phase<pg8::EpiSwiGLU, pg8::ExpertOrder, true>(lds, g, S, E, (const int*)(ws + WS_ROWTOK));
    });

    PHASE(9, {
        pg8::Gemm g{(const bf16_t*)(ws + WS_HID), (const bf16_t*)(ws + WS_WDT), NSLOT, D, FF}; pg8::ExpertOrder S; S.init(32, 4, NE, G, (int)blockIdx.x);
        pg8::EpiGateScale E{(bf16_t*)(ws + WS_YE), (const float*)(ws + WS_ROWGATE)}; pg8::gemm_phase<pg8::EpiGateScale, pg8::ExpertOrder, false, true>(lds, g, S, E, nullptr);
    });

    PHASE(10, phase_final(a, G));
#undef IN
#undef NREP
#undef PHASE
}

#ifndef MK_ONE_LAUNCH
#define MK_ONE_LAUNCH 1
#endif
extern "C" void kernel_launch(void* const* d_in, const int* in_sizes, int n_in, void* d_out, int out_size, void* d_ws, size_t ws_size, hipStream_t stream) {
    static int grid_blocks = 0;
    if (grid_blocks == 0) {
        if (n_in != 29 || out_size != T * D || ws_size < WS_END) { fprintf(stderr, "kernel_launch: unexpected problem: n_in %d out %d ws %zu (need %zu)\n", n_in, out_size, ws_size, (size_t)WS_END); grid_blocks = -1; return; }
        int dev = 0, cus = 0, per_cu = 0;
        if (hipGetDevice(&dev) != hipSuccess || hipDeviceGetAttribute(&cus, hipDeviceAttributeMultiprocessorCount, dev) != hipSuccess) { grid_blocks = -1; return; }
        if (hipFuncSetAttribute((const void*)mega, hipFuncAttributeMaxDynamicSharedMemorySize, LDS_BYTES) != hipSuccess) { fprintf(stderr, "kernel_launch: hipFuncSetAttribute failed\n"); grid_blocks = -1; return; }
        if (hipOccupancyMaxActiveBlocksPerMultiprocessor(&per_cu, (const void*)mega, NTHREADS, LDS_BYTES) != hipSuccess || per_cu < 1) { fprintf(stderr, "kernel_launch: occupancy query says %d blocks per CU\n", per_cu); grid_blocks = -1; return; }
        grid_blocks = cus;
    }
    if (grid_blocks < 0) return;
    if (hipMemsetAsync((char*)d_ws + WS_CTL, 0, CTL_BYTES, stream) != hipSuccess) { fprintf(stderr, "kernel_launch: memset failed\n"); return; }
    Args a{};
    for (int i = 0; i < 29; ++i) a.in[i] = (const float*)d_in[i];
    a.out = (float*)d_out; a.ws = (unsigned char*)d_ws;
#if MK_ONE_LAUNCH
    a.ph_lo = 0; a.ph_hi = NPHASE;
    { void* args[] = {&a}; hipError_t e = hipLaunchCooperativeKernel((const void*)mega, dim3(grid_blocks), dim3(NTHREADS), args, LDS_BYTES, stream);
      if (e != hipSuccess) fprintf(stderr, "cooperative launch failed: %s (grid %d)\n", hipGetErrorString(e), grid_blocks); }
#else
    for (int ph = 0; ph < NPHASE; ++ph) { a.ph_lo = ph; a.ph_hi = ph + 1; void* args[] = {&a};
        hipError_t e = hipLaunchCooperativeKernel((const void*)mega, dim3(grid_blocks), dim3(NTHREADS), args, LDS_BYTES, stream);
        if (e != hipSuccess) { fprintf(stderr, "cooperative launch %d failed: %s (grid %d)\n", ph, hipGetErrorString(e), grid_blocks); break; } }
#endif
}
```

```cpp
#include <hip/hip_runtime.h>
#include <hip/hip_cooperative_groups.h>
#include <cstdio>
#include <cstdint>
namespace cg = cooperative_groups;

#define LAS __attribute__((address_space(3)))
typedef unsigned short bf16_t;
typedef short bf16x8 __attribute__((ext_vector_type(8)));
typedef short s16x4 __attribute__((ext_vector_type(4)));
typedef float f32x2 __attribute__((ext_vector_type(2)));
typedef float f32x4 __attribute__((ext_vector_type(4)));
typedef float f32x16 __attribute__((ext_vector_type(16)));
typedef unsigned u32x2 __attribute__((ext_vector_type(2)));
typedef unsigned u32x4 __attribute__((ext_vector_type(4)));
typedef _Float16 f16x4 __attribute__((ext_vector_type(4)));
typedef __bf16 bf16v2 __attribute__((ext_vector_type(2)));
typedef int v8i __attribute__((ext_vector_type(8)));
typedef int v4i __attribute__((ext_vector_type(4)));

constexpr int D = 1024, BATCH = 16, SEQ = 4096, T = BATCH * SEQ, NMEM = 256;
constexpr int IN_PROJ = 2560, CW = 384, RW = 384, NH = 6, NE = 16, FF = 1024, CAP = 512;
constexpr int NSLOT = NE * BATCH * CAP;
constexpr int NTHREADS = 512;
constexpr int LDS_BYTES = 160 * 1024;
constexpr int NPHASE = 11;
#ifndef SCAN_MODE
#define SCAN_MODE 1
#endif

constexpr size_t MiB = 1u << 20;
constexpr size_t WS_WINT = 1 * MiB;
constexpr size_t WS_WOUTT = 6 * MiB;
constexpr size_t WS_WKT = 8 * MiB;
constexpr size_t WS_WVT = 8 * MiB + 512 * 1024;
constexpr size_t WS_SMALL = 9 * MiB;
constexpr size_t WS_WGUT = 10 * MiB;
constexpr size_t WS_WDT = 74 * MiB;
constexpr size_t WS_KMEM = 106 * MiB;
constexpr size_t WS_VT = 108 * MiB;
constexpr size_t WS_ROWTOK = 106 * MiB;
constexpr size_t WS_ROWGATE = 106 * MiB + 512 * 1024;
constexpr size_t WS_SS = 107 * MiB;
constexpr size_t WS_P = 112 * MiB;
constexpr size_t WS_YF = 112 * MiB;
constexpr size_t WS_YB = 208 * MiB;
constexpr size_t WS_X1 = 112 * MiB;
constexpr size_t WS_XH = 432 * MiB;
constexpr size_t WS_G = 432 * MiB;
constexpr size_t WS_BON = 480 * MiB;
constexpr size_t WS_Q = 400 * MiB;
constexpr int PLD = IN_PROJ - 256;
constexpr size_t WS_H2 = 432 * MiB;
constexpr size_t WS_MEMN = 560 * MiB;
constexpr size_t WS_MIX = 560 * MiB;
constexpr size_t WS_SCAN = 688 * MiB;
constexpr size_t SCAN_STRIDE = 48 * MiB;
constexpr size_t WS_SCAN7 = 496 * MiB;
constexpr size_t WS_PC = 484 * MiB;
__device__ __forceinline__ unsigned char* scan_arr(unsigned char* ws, int a) { return a < 7 ? ws + WS_SCAN + (size_t)a * SCAN_STRIDE : (a == 7 ? ws + WS_SCAN7 : ws + 560 * MiB + 640 * 2); }
__device__ __forceinline__ int scan_pitch(int a) { return a == 8 ? D : 384; }
__device__ __forceinline__ size_t hat_off(int a, size_t tok, int ch) { return a == 8 ? tok * D + ch : ((((tok >> 4) * NH + (ch >> 6)) << 10) + ((tok & 15) << 6) + (ch & 63)); }
constexpr size_t WS_AFF = 624 * MiB;
constexpr size_t WS_INV = 628 * MiB;
constexpr size_t WS_HID = 768 * MiB;
constexpr size_t WS_YE = 368 * MiB;
constexpr size_t WS_END = 1024 * MiB;

__device__ __forceinline__ unsigned pk_bf16(float lo, float hi) { f32x2 v = {lo, hi}; bf16v2 b = __builtin_convertvector(v, bf16v2); return __builtin_bit_cast(unsigned, b); }
__device__ __forceinline__ unsigned pk_fp8x4(float a, float b, float c, float d) { int w = 0; w = __builtin_amdgcn_cvt_pk_fp8_f32(a, b, w, false); w = __builtin_amdgcn_cvt_pk_fp8_f32(c, d, w, true); return (unsigned)w; }
__device__ __forceinline__ float bf_lo(unsigned u) { return __builtin_bit_cast(float, u << 16); }
__device__ __forceinline__ float bf_hi(unsigned u) { return __builtin_bit_cast(float, u & 0xffff0000u); }
__device__ __forceinline__ float wave_sum(float v) {
#pragma unroll
    for (int o = 1; o < 64; o <<= 1) v += __shfl_xor(v, o);
    return v;
}
__device__ __forceinline__ float sigmoidf_fast(float x) { return __builtin_amdgcn_rcpf(1.0f + __builtin_amdgcn_exp2f(-1.4426950408889634f * x)); }
template <int CTRL> __device__ __forceinline__ float dpp_f(float x) { return __builtin_bit_cast(float, __builtin_amdgcn_update_dpp(0, __builtin_bit_cast(int, x), CTRL, 0xF, 0xF, true)); }
__device__ __forceinline__ float sum8(float x) { x += dpp_f<0xB1>(x); x += dpp_f<0x4E>(x); x += dpp_f<0x141>(x); return x; }
__device__ __forceinline__ float sum16(float x) { x = sum8(x); x += dpp_f<0x140>(x); return x; }
__device__ __forceinline__ float max16(float x) { x = fmaxf(x, dpp_f<0xB1>(x)); x = fmaxf(x, dpp_f<0x4E>(x)); x = fmaxf(x, dpp_f<0x141>(x)); x = fmaxf(x, dpp_f<0x140>(x)); return x; }

typedef short v4i16g __attribute__((__vector_size__(8)));
__device__ __forceinline__ s16x4 tr_read16(LAS unsigned char* p) { v4i16g r = __builtin_amdgcn_ds_read_tr16_b64_v4i16((LAS v4i16g*)p); return __builtin_bit_cast(s16x4, r); }
__device__ __forceinline__ f32x4 bf4_to_f32(u32x2 w) { return (f32x4){bf_lo(w.x), bf_hi(w.x), bf_lo(w.y), bf_hi(w.y)}; }
__device__ __forceinline__ u32x2 f32_to_bf4(f32x4 v) { return (u32x2){pk_bf16(v.x, v.y), pk_bf16(v.z, v.w)}; }
__device__ __forceinline__ bf16x8 frag_lo4(f32x4 v) { const u32x4 w = {pk_bf16(v.x, v.y), pk_bf16(v.z, v.w), 0u, 0u}; return __builtin_bit_cast(bf16x8, w); }
__device__ __forceinline__ bf16x8 frag_cat(u32x2 a, u32x2 b) { const u32x4 w = {a.x, a.y, b.x, b.y}; return __builtin_bit_cast(bf16x8, w); }
#define MFMA16(a, b, c) __builtin_amdgcn_mfma_f32_16x16x32_bf16((a), (b), (c), 0, 0, 0)

namespace pg8 {
#define PG8_LAS __attribute__((address_space(3)))
constexpr int BM = 256, BK = 64, HALF = 128, HTB = HALF * BK * 2, STAGE_BYTES = 8 * HTB, NXCD = 8, WGM = 8;
__host__ __device__ __forceinline__ int lds_byte(int r, int c) { const int st = (r >> 4) * 2 + (c >> 5), rr = r & 15, cc = c & 31, ob = rr * 64 + cc * 2; return st * 1024 + (ob ^ (((ob >> 9) & 1) << 5)); }
__host__ __device__ __forceinline__ void stage_rc(int b, int& R, int& C) { const int st = b / 1024, sb = b % 1024, swz = sb ^ (((sb >> 9) & 1) << 5); R = (st >> 1) * 16 + swz / 64; C = (st & 1) * 32 + (swz % 64) / 2; }
__host__ __device__ __forceinline__ int perm32(int rho) { const int n = rho >> 4, i = rho & 15; return 8 * (i >> 2) + 4 * n + (i & 3); }

struct Unit { int pm, pn, gid; };
struct Gemm { const bf16_t* A; const bf16_t* Bt; int M, N, K; int sw, sx; };

struct StaticOrder {
    int nM, nN, nwg, G, c;
    __device__ void init(int M, int N, int G_, int c_) { nM = M / BM; nN = N / BM; nwg = nM * nN; G = G_; c = c_; }
    __device__ bool next(int i, Unit& u) const {
        const long L = (long)i * G + c; if (L >= nwg) return false;
        int wgid = (int)L; { const int q = nwg / NXCD, r = nwg % NXCD, xcd = wgid % NXCD, off = wgid / NXCD; wgid = (xcd < r ? xcd * (q + 1) : r * (q + 1) + (xcd - r) * q) + off; }
        const int nig = WGM * nN, gid = wgid / nig, fm = gid * WGM, gsz = (nM - fm) < WGM ? (nM - fm) : WGM;
        u.pm = fm + ((wgid % nig) % gsz); u.pn = (wgid % nig) / gsz; u.gid = 0; return true;
    }
    __device__ __forceinline__ const char* aptr(const Gemm& g, const Unit& u, size_t tstep) const { return (const char*)g.A + (size_t)u.pm * tstep; }
    __device__ __forceinline__ const char* bptr(const Gemm& g, const Unit& u, size_t tstep) const { return (const char*)g.Bt + (size_t)u.pn * tstep; }
};
struct TripleOrder {
    StaticOrder S0; const bf16_t* A1; const bf16_t* B1; const bf16_t* A2; const bf16_t* B2; int n1, n2, G, c;
    __device__ bool next(int i, Unit& u) const {
        const long L = (long)i * G + c;
        if (L < n1) { u.pm = (int)L; u.pn = 0; u.gid = 1; return true; }
        if (L < n1 + n2) { u.pm = 0; u.pn = (int)(L - n1); u.gid = 2; return true; }
        const long L0 = L - n1 - n2; if (L0 >= S0.nwg) return false;
        StaticOrder T0 = S0; T0.c = (int)(L0 % G); return T0.next((int)(L0 / G), u);
    }
    __device__ __forceinline__ const char* aptr(const Gemm& g, const Unit& u, size_t tstep) const { return (const char*)(u.gid == 0 ? g.A : (u.gid == 1 ? A1 : A2)) + (size_t)u.pm * tstep; }
    __device__ __forceinline__ const char* bptr(const Gemm& g, const Unit& u, size_t tstep) const { return (const char*)(u.gid == 0 ? g.Bt : (u.gid == 1 ? B1 : B2)) + (size_t)u.pn * tstep; }
};
struct ExpertOrder {
    int nMe, nNe, per, total, G, c;
    __device__ void init(int nMe_, int nNe_, int nExp, int G_, int c_) { nMe = nMe_; nNe = nNe_; per = nMe * nNe; total = per * nExp; G = G_; c = c_; }
    __device__ bool next(int i, Unit& u) const {
        const long L = (long)i * G + c; if (L >= total) return false;
        const int e = (int)(L / per), w = (int)(L % per), xl = w % 8, j = w / 8, rpx = nMe / 8;
        u.pm = e * nMe + xl * rpx + (j % rpx); u.pn = e * nNe + j / rpx; u.gid = 0; return true;
    }
    __device__ __forceinline__ const char* aptr(const Gemm& g, const Unit& u, size_t tstep) const { return (const char*)g.A + (size_t)u.pm * tstep; }
    __device__ __forceinline__ const char* bptr(const Gemm& g, const Unit& u, size_t tstep) const { return (const char*)g.Bt + (size_t)u.pn * tstep; }
};

struct EpiBf16 {
    static constexpr bool PERM = true;
    bf16_t* O; int ldc; bf16_t* Q0;
    __device__ __forceinline__ void operator()(const f32x4 (&acc)[2][2][4][2], const Unit& u, int wr, int wc, int fr, int fq) const {
        const bool redir = (Q0 != nullptr) && (u.pn == 0);
        bf16_t* base = redir ? Q0 : O; const int ld = redir ? 256 : ldc;
        const int row0 = u.pm * BM + wr * 64 + fr, col0 = (u.pn - ((Q0 != nullptr && !redir) ? 1 : 0)) * BM + wc * 32 + 8 * fq;
#pragma unroll
        for (int ai = 0; ai < 2; ++ai)
#pragma unroll
            for (int m = 0; m < 4; ++m) { bf16_t* rowp = base + (size_t)(row0 + ai * HALF + m * 16) * ld + col0;
#pragma unroll
                for (int bj = 0; bj < 2; ++bj) { const f32x4 v0 = acc[ai][bj][m][0], v1 = acc[ai][bj][m][1];
                    u32x4 w; w.x = pk_bf16(v0[0], v0[1]); w.y = pk_bf16(v0[2], v0[3]); w.z = pk_bf16(v1[0], v1[1]); w.w = pk_bf16(v1[2], v1[3]);
                    *(u32x4*)(rowp + bj * HALF) = w; } }
    }
};
struct EpiBf16x3 {
    static constexpr bool PERM = true;
    EpiBf16 E0, E1, E2;
    __device__ __forceinline__ void operator()(const f32x4 (&acc)[2][2][4][2], const Unit& u, int wr, int wc, int fr, int fq) const {
        if (u.gid == 0) E0(acc, u, wr, wc, fr, fq); else if (u.gid == 1) E1(acc, u, wr, wc, fr, fq); else E2(acc, u, wr, wc, fr, fq); }
};
struct EpiResidSS {
    static constexpr bool PERM = false;
    const float* X; float* X1; float* ss;
    __device__ __forceinline__ void operator()(const f32x4 (&acc)[2][2][4][2], const Unit& u, int wr, int wc, int fr, int fq) const {
        const int row0 = u.pm * BM + wr * 64 + fr, col0 = u.pn * BM + wc * 32 + 4 * fq;
#pragma unroll
        for (int ai = 0; ai < 2; ++ai)
#pragma unroll
            for (int m = 0; m < 4; ++m) { const int row = row0 + ai * HALF + m * 16; const size_t off = (size_t)row * D + col0; float s = 0.f;
#pragma unroll
                for (int bj = 0; bj < 2; ++bj)
#pragma unroll
                    for (int n = 0; n < 2; ++n) { const f32x4 xv = *(const f32x4*)(X + off + bj * HALF + n * 16); const f32x4 o = xv + acc[ai][bj][m][n];
                        *(f32x4*)(X1 + off + bj * HALF + n * 16) = o; s += (o[0] * o[0] + o[1] * o[1]) + (o[2] * o[2] + o[3] * o[3]); }
                s += __shfl_xor(s, 16); s += __shfl_xor(s, 32);
                if (fq == 0) (void)__hip_atomic_fetch_add(ss + row, s, __ATOMIC_RELAXED, __HIP_MEMORY_SCOPE_AGENT); }
    }
};
struct EpiSwiGLU {
    static constexpr bool PERM = true;
    bf16_t* H;
    __device__ __forceinline__ void operator()(const f32x4 (&acc)[2][2][4][2], const Unit& u, int wr, int wc, int fr, int fq) const {
        const int row0 = u.pm * BM + wr * 64 + fr, col0 = (u.pn & 7) * HALF + wc * 32 + 8 * fq;
#pragma unroll
        for (int ai = 0; ai < 2; ++ai)
#pragma unroll
            for (int m = 0; m < 4; ++m) { const int row = row0 + ai * HALF + m * 16; float h[8];
                unsigned char* rowp = (unsigned char*)H + ((((size_t)(row >> 8) * (FF / 128) + (col0 >> 7)) << 15) + ((row & 255) << 7) + (col0 & 127));
#pragma unroll
                for (int n = 0; n < 2; ++n)
#pragma unroll
                    for (int j = 0; j < 4; ++j) { const float gt = acc[ai][0][m][n][j], up = acc[ai][1][m][n][j]; h[n * 4 + j] = 8.0f * gt * sigmoidf_fast(gt) * up; }
                *(u32x2*)rowp = (u32x2){pk_fp8x4(h[0], h[1], h[2], h[3]), pk_fp8x4(h[4], h[5], h[6], h[7])}; }
    }
};
struct EpiGateScale {
    static constexpr bool PERM = true;
    bf16_t* Y; const float* gate;
    __device__ __forceinline__ void operator()(const f32x4 (&acc)[2][2][4][2], const Unit& u, int wr, int wc, int fr, int fq) const {
        const int row0 = u.pm * BM + wr * 64 + fr, col0 = (u.pn & 3) * BM + wc * 32 + 8 * fq;
#pragma unroll
        for (int ai = 0; ai < 2; ++ai)
#pragma unroll
            for (int m = 0; m < 4; ++m) { const int row = row0 + ai * HALF + m * 16; const float gs = gate[row]; bf16_t* rowp = Y + (size_t)row * D + col0;
#pragma unroll
                for (int bj = 0; bj < 2; ++bj) { const f32x4 v0 = acc[ai][bj][m][0] * gs, v1 = acc[ai][bj][m][1] * gs;
                    u32x4 w; w.x = pk_bf16(v0[0], v0[1]); w.y = pk_bf16(v0[2], v0[3]); w.z = pk_bf16(v1[0], v1[1]); w.w = pk_bf16(v1[2], v1[3]);
                    *(u32x4*)(rowp + bj * HALF) = w; } }
    }
};

template <class Epi, class Sched, bool GATHER, bool ATILED = false, bool FP8 = false>
__device__ __forceinline__ void gemm_phase(PG8_LAS unsigned char* lds, const Gemm g, const Sched& S, const Epi& E, const int* rowtok) {
    int tid = threadIdx.x; asm volatile("" : "+v"(tid));
    const int wid = __builtin_amdgcn_readfirstlane(tid >> 6), lane = tid & 63, wr = wid >> 2, wc = wid & 3, fr = lane & 15, fq = lane >> 4;
    const int K = g.K, nt = K / BK;
    unsigned voffA0, voffB0;
    { int R, C; stage_rc(tid * 16, R, C); const int Rb = Epi::PERM ? ((R & ~31) + perm32(R & 31)) : R;
      voffA0 = ATILED ? (unsigned)(R * BK + C) * 2u : (unsigned)(R * K + C) * 2u; voffB0 = (unsigned)(Rb * K + C) * 2u; }
    const size_t dA = ATILED ? (size_t)64 * BK * 2 : (size_t)64 * K * 2, dB = (size_t)64 * K * 2;
    unsigned vAc[2][2], vAn[2][2];
    const size_t kstep = (size_t)(BK * 2);
    const size_t hstep = (size_t)HALF * K * 2;
    const size_t tstep = 2 * hstep;
    const size_t kstepA = ATILED ? (size_t)BM * BK * 2 : kstep, hstepA = ATILED ? (size_t)HALF * BK * 2 : hstep;
    const unsigned ldsw = (unsigned)wid * 1024u;
    const unsigned ldsbase = __builtin_amdgcn_readfirstlane((unsigned)(size_t)lds) + ldsw;
    const int aoff = lds_byte(wr * 64 + fr, fq * 8), boff = lds_byte(wc * 32 + fr, fq * 8);
#define PG8_SA(b, h) (((b) * 2 + (h)) * HTB)
#define PG8_SB(b, h) ((4 + (b) * 2 + (h)) * HTB)
#define PG8_GLDS(vo_, sb_, lo_) asm volatile("s_add_u32 m0, %2, %3\n\ts_nop 0\n\tglobal_load_lds_dwordx4 %0, %1" :: "v"(vo_), "s"((const void*)(sb_)), "s"(ldsbase), "n"(lo_) : "m0", "scc", "memory")
#define PG8_STAGE_D(bufoff, gbase, voff0, delta) do { PG8_GLDS(voff0, gbase, (bufoff)); PG8_GLDS(voff0, (const char*)(gbase) + (delta), (bufoff) + 8192); } while (0)
#define PG8_STAGE(bufoff, gbase, voff) do { PG8_GLDS((voff)[0], gbase, (bufoff)); PG8_GLDS((voff)[1], gbase, (bufoff) + 8192); } while (0)
#define PG8_STAGE_A(bufoff, hh, dbase, kbytes, vsel) do { if constexpr (GATHER) { PG8_STAGE(bufoff, (const char*)g.A + (kbytes), (vsel)[hh]); } else { PG8_STAGE_D(bufoff, (dbase) + ((hh) ? hstepA : 0), voffA0, dA); } } while (0)
#define PG8_GATHER_OFF(dst, un) do { int R_, C_; stage_rc(tid * 16, R_, C_); _Pragma("unroll") for (int _h = 0; _h < 2; ++_h) _Pragma("unroll") for (int _i = 0; _i < 2; ++_i) \
        (dst)[_h][_i] = (unsigned)rowtok[(un).pm * BM + _h * HALF + R_ + 64 * _i] * (unsigned)(K * 2) + (unsigned)(C_ * 2); } while (0)
#define PG8_LDA(dst, b, h) do { _Pragma("unroll") for (int m = 0; m < 4; ++m) _Pragma("unroll") for (int k = 0; k < 2; ++k) dst[m][k] = *(const PG8_LAS bf16x8*)(lds + PG8_SA(b, h) + aoff + m * 2048 + k * 1024); } while (0)
#define PG8_LDB(dst, b, h) do { _Pragma("unroll") for (int n = 0; n < 2; ++n) _Pragma("unroll") for (int k = 0; k < 2; ++k) dst[n][k] = *(const PG8_LAS bf16x8*)(lds + PG8_SB(b, h) + boff + n * 2048 + k * 1024); } while (0)
#define PG8_MMA(ai, bj, At, Bt) do { __builtin_amdgcn_s_setprio(1); _Pragma("unroll") for (int m = 0; m < 4; ++m) _Pragma("unroll") for (int n = 0; n < 2; ++n) _Pragma("unroll") for (int k = 0; k < 2; ++k) \
        acc[ai][bj][m][n] = __builtin_amdgcn_mfma_f32_16x16x32_bf16(Bt[n][k], At[m][k], acc[ai][bj][m][n], 0, 0, 0); __builtin_amdgcn_s_setprio(0); } while (0)
#define PG8_CAT8(lo_, hi_) __builtin_shufflevector(lo_, hi_, 0, 1, 2, 3, 4, 5, 6, 7)
#define PG8_LDA8(b, h) do { _Pragma("unroll") for (int m = 0; m < 4; ++m) { const v4i lo_ = *(const PG8_LAS v4i*)(lds + PG8_SA(b, h) + aoff + m * 2048), hi_ = *(const PG8_LAS v4i*)(lds + PG8_SA(b, h) + aoff + m * 2048 + 1024); A8[m] = PG8_CAT8(lo_, hi_); } } while (0)
#define PG8_LDB8(dst, b, h) do { _Pragma("unroll") for (int n = 0; n < 2; ++n) { const v4i lo_ = *(const PG8_LAS v4i*)(lds + PG8_SB(b, h) + boff + n * 2048), hi_ = *(const PG8_LAS v4i*)(lds + PG8_SB(b, h) + boff + n * 2048 + 1024); dst[n] = PG8_CAT8(lo_, hi_); } } while (0)
#define PG8_MMA8(ai, bj, Bt8) do { __builtin_amdgcn_s_setprio(1); _Pragma("unroll") for (int m = 0; m < 4; ++m) _Pragma("unroll") for (int n = 0; n < 2; ++n) \
        acc[ai][bj][m][n] = __builtin_amdgcn_mfma_scale_f32_16x16x128_f8f6f4(Bt8[n], A8[m], acc[ai][bj][m][n], 0, 0, 0, g.sw, 0, g.sx); __builtin_amdgcn_s_setprio(0); } while (0)
#define PG8_LDAX(b, h) do { if constexpr (FP8) { PG8_LDA8(b, h); } else { PG8_LDA(At, b, h); } } while (0)
#define PG8_LDBX(w, b, h) do { if constexpr (FP8) { if (w) { PG8_LDB8(B81, b, h); } else { PG8_LDB8(B80, b, h); } } else { if (w) { PG8_LDB(B1, b, h); } else { PG8_LDB(B0, b, h); } } } while (0)
#define PG8_MMX(ai, bj, w) do { if constexpr (FP8) { if (w) { PG8_MMA8(ai, bj, B81); } else { PG8_MMA8(ai, bj, B80); } } else { if (w) { PG8_MMA(ai, bj, At, B1); } else { PG8_MMA(ai, bj, At, B0); } } } while (0)
#define PG8_WAIT_V(n) asm volatile("s_waitcnt vmcnt(" #n ")" ::: "memory")
#define PG8_WAIT_L(n) asm volatile("s_waitcnt lgkmcnt(" #n ")" ::: "memory")
#define PG8_BAR __builtin_amdgcn_s_barrier()
#define PG8_SCHED __builtin_amdgcn_sched_barrier(0)
    Unit cur, nxt; int ui = 0;
    if (!S.next(0, cur)) return;
    f32x4 acc[2][2][4][2];
#pragma unroll
    for (int a = 0; a < 2; ++a)
#pragma unroll
        for (int b = 0; b < 2; ++b)
#pragma unroll
            for (int m = 0; m < 4; ++m)
#pragma unroll
                for (int n = 0; n < 2; ++n) acc[a][b][m][n] = (f32x4){0.f, 0.f, 0.f, 0.f};
    bf16x8 At[4][2], B0[2][2], B1[2][2]; v8i A8[4], B80[2], B81[2];
    const char* cA = GATHER ? (const char*)g.A : S.aptr(g, cur, tstep); const char* cB = S.bptr(g, cur, tstep);
    if constexpr (GATHER) { PG8_GATHER_OFF(vAc, cur); }
    PG8_STAGE_D(PG8_SB(0, 0), cB, voffB0, dB); PG8_STAGE_A(PG8_SA(0, 0), 0, cA, 0, vAc); PG8_STAGE_D(PG8_SB(0, 1), cB + hstep, voffB0, dB); PG8_STAGE_A(PG8_SA(0, 1), 1, cA, 0, vAc);
    if (wr == 1) PG8_BAR;
    PG8_WAIT_V(4); PG8_BAR;
    PG8_STAGE_D(PG8_SB(1, 0), cB + kstep, voffB0, dB); PG8_STAGE_A(PG8_SA(1, 0), 0, cA + kstepA, kstep, vAc); PG8_STAGE_D(PG8_SB(1, 1), cB + hstep + kstep, voffB0, dB);
    PG8_WAIT_V(6); PG8_BAR;
    for (;;) {
        const bool has_next = S.next(ui + 1, nxt);
        const char* nA = (has_next && !GATHER) ? S.aptr(g, nxt, tstep) : cA; const char* nB = has_next ? S.bptr(g, nxt, tstep) : cB;
        if constexpr (GATHER) { if (has_next) { PG8_GATHER_OFF(vAn, nxt); } else {
#pragma unroll
            for (int _h = 0; _h < 2; ++_h)
#pragma unroll
                for (int _i = 0; _i < 2; ++_i) vAn[_h][_i] = vAc[_h][_i]; } }
#pragma unroll 1
        for (int t = 0; t < nt; t += 2) {
            const bool last = (t == nt - 2);
            const size_t k1 = (size_t)(t + 1) * kstep, k2 = last ? 0 : (size_t)(t + 2) * kstep, k3 = k2 + kstep;
            const char* a1 = cA + (size_t)(t + 1) * kstepA;
            const char* a2 = last ? nA : cA + (size_t)(t + 2) * kstepA; const char* b2 = last ? nB : cB + (size_t)(t + 2) * kstep;
            const char* a3 = a2 + kstepA; const char* b3 = b2 + kstep;
            PG8_LDBX(0, 0, 0); PG8_SCHED; PG8_LDAX(0, 0); PG8_STAGE_A(PG8_SA(1, 1), 1, a1, k1, vAc);
            if constexpr (GATHER) { if (last) {
#pragma unroll
                for (int _h = 0; _h < 2; ++_h)
#pragma unroll
                    for (int _i = 0; _i < 2; ++_i) vAc[_h][_i] = vAn[_h][_i]; } }
            PG8_WAIT_L(8); PG8_BAR; PG8_WAIT_L(0); PG8_MMX(0, 0, 0); PG8_BAR; PG8_SCHED;
            PG8_LDBX(1, 0, 1); PG8_STAGE_D(PG8_SB(0, 0), b2, voffB0, dB);
            PG8_BAR; PG8_WAIT_L(0); PG8_MMX(0, 1, 1); PG8_BAR;
            PG8_LDAX(0, 1); PG8_STAGE_A(PG8_SA(0, 0), 0, a2, k2, vAc);
            PG8_BAR; PG8_WAIT_L(0); PG8_MMX(1, 0, 0); PG8_BAR; PG8_SCHED;
            PG8_STAGE_D(PG8_SB(0, 1), b2 + hstep, voffB0, dB);
            PG8_WAIT_V(6); PG8_BAR; PG8_MMX(1, 1, 1); PG8_BAR;
            PG8_LDBX(0, 1, 0); PG8_SCHED; PG8_LDAX(1, 0); PG8_STAGE_A(PG8_SA(0, 1), 1, a2, k2, vAc);
            PG8_WAIT_L(8); PG8_BAR; PG8_WAIT_L(0); PG8_MMX(0, 0, 0); PG8_BAR; PG8_SCHED;
            PG8_LDBX(1, 1, 1); PG8_STAGE_D(PG8_SB(1, 0), b3, voffB0, dB);
            PG8_BAR; PG8_WAIT_L(0); PG8_MMX(0, 1, 1); PG8_BAR;
            PG8_LDAX(1, 1); PG8_STAGE_A(PG8_SA(1, 0), 0, a3, k3, vAc);
            PG8_BAR; PG8_WAIT_L(0); PG8_MMX(1, 0, 0); PG8_BAR; PG8_SCHED;
            PG8_STAGE_D(PG8_SB(1, 1), b3 + hstep, voffB0, dB);
            PG8_WAIT_V(6); PG8_BAR; PG8_MMX(1, 1, 1); PG8_BAR;
        }
        E(acc, cur, wr, wc, fr, fq);
        if (!has_next) break;
#pragma unroll
        for (int a = 0; a < 2; ++a)
#pragma unroll
            for (int b = 0; b < 2; ++b)
#pragma unroll
                for (int m = 0; m < 4; ++m)
#pragma unroll
                    for (int n = 0; n < 2; ++n) acc[a][b][m][n] = (f32x4){0.f, 0.f, 0.f, 0.f};
        cur = nxt; cA = nA; cB = nB; ++ui;
        if constexpr (GATHER) {
#pragma unroll
            for (int _h = 0; _h < 2; ++_h)
#pragma unroll
                for (int _i = 0; _i < 2; ++_i) vAc[_h][_i] = vAn[_h][_i]; }
    }
    PG8_WAIT_V(0);
    if (wr == 0) PG8_BAR;
    PG8_BAR;
#undef PG8_SA
#undef PG8_SB
#undef PG8_STAGE
#undef PG8_STAGE_D
#undef PG8_GLDS
#undef PG8_STAGE_A
#undef PG8_GATHER_OFF
#undef PG8_LDA
#undef PG8_LDB
#undef PG8_MMA
#undef PG8_MMA8
#undef PG8_LDA8
#undef PG8_LDB8
#undef PG8_LDAX
#undef PG8_LDBX
#undef PG8_MMX
#undef PG8_CAT8
#undef PG8_WAIT_V
#undef PG8_WAIT_L
#undef PG8_BAR
#undef PG8_SCHED
}
}

struct Args {
    const float* in[29];
    float* out; unsigned char* ws;
    int ph_lo, ph_hi;
};
enum { I_X = 0, I_MEM, I_NMIXG, I_NMEMG, I_WIN, I_WMK, I_WMV, I_CONVW, I_CONVB, I_CLNG, I_CLNB, I_SHIFTMU, I_DW0, I_DUP, I_IA0, I_IUP, I_GUP, I_KK, I_KA, I_RK,
       I_LNXG, I_LNXB, I_WOUT, I_NFFNG, I_WROUTER, I_WEG, I_WEU, I_WED, I_FNG };

template <bool F8 = false>
__device__ __forceinline__ void transpose_item(const float* W, int N, bf16_t* WT, int K, int k0, int n0, int drow0, LAS float* scr, int lane) {
    {
        f32x4 v[8];
#pragma unroll
        for (int i = 0; i < 8; ++i) v[i] = *(const f32x4*)(W + (size_t)(k0 + 8 * i + (lane >> 3)) * N + n0 + 4 * (lane & 7));
#pragma unroll
        for (int i = 0; i < 8; ++i) { LAS float* d = scr + (8 * i + (lane >> 3)) * 33 + 4 * (lane & 7); d[0] = v[i].x; d[1] = v[i].y; d[2] = v[i].z; d[3] = v[i].w; }
    }
    asm volatile("s_waitcnt lgkmcnt(0)" ::: "memory");
    const int c = lane & 7;
#pragma unroll
    for (int j = 0; j < 4; ++j) { const int n = (lane >> 3) + 8 * j; const LAS float* s = scr + (8 * c) * 33 + n;
        if constexpr (F8) { *(u32x2*)((unsigned char*)WT + (size_t)(drow0 + n) * K + k0 + 8 * c) = (u32x2){pk_fp8x4(32.f * s[0 * 33], 32.f * s[1 * 33], 32.f * s[2 * 33], 32.f * s[3 * 33]), pk_fp8x4(32.f * s[4 * 33], 32.f * s[5 * 33], 32.f * s[6 * 33], 32.f * s[7 * 33])}; }
        else { u32x4 o; o.x = pk_bf16(s[0 * 33], s[1 * 33]); o.y = pk_bf16(s[2 * 33], s[3 * 33]); o.z = pk_bf16(s[4 * 33], s[5 * 33]); o.w = pk_bf16(s[6 * 33], s[7 * 33]);
            *(u32x4*)(WT + (size_t)(drow0 + n) * K + k0 + 8 * c) = o; } }
    asm volatile("s_waitcnt lgkmcnt(0)" ::: "memory");
}
__device__ __forceinline__ void expert_prep_items(const Args& a, LAS unsigned char* lds, int widx, int nw, int it_lo, int it_hi) {
    int tid = threadIdx.x; asm volatile("" : "+v"(tid)); const int lane = tid & 63, wave = __builtin_amdgcn_readfirstlane(tid >> 6);
    LAS float* scr = (LAS float*)(lds + wave * 16384);
    unsigned char* ws = a.ws;
    constexpr int S_EXP = 16 * 16 * 32;
    for (int r = it_lo + widx; r < it_hi; r += nw) {
        const int which = r / S_EXP, q = r % S_EXP, e = q / 512, kb = (q % 512) / 32, nb = q % 32, n0 = nb * 32;
        if (which == 0) transpose_item<true>(a.in[I_WEG] + (size_t)e * D * FF, FF, (bf16_t*)(ws + WS_WGUT + (size_t)e * 2048 * D), D, kb * 64, n0, (n0 >> 7) * 256 + (n0 & 127), scr, lane);
        else if (which == 1) transpose_item<true>(a.in[I_WEU] + (size_t)e * D * FF, FF, (bf16_t*)(ws + WS_WGUT + (size_t)e * 2048 * D), D, kb * 64, n0, (n0 >> 7) * 256 + 128 + (n0 & 127), scr, lane);
        else transpose_item<true>(a.in[I_WED] + (size_t)e * FF * D, D, (bf16_t*)(ws + WS_WDT + (size_t)e * D * FF), FF, kb * 64, n0, n0, scr, lane);
    }
}

__device__ __forceinline__ void rms_row_to_bf16(const float* xrow, const float* g, bf16_t* orow, int lane) {
    const f32x4* xr = (const f32x4*)xrow + lane; const f32x4* gr = (const f32x4*)g + lane;
    f32x4 v[4]; float s = 0.f;
#pragma unroll
    for (int j = 0; j < 4; ++j) { v[j] = xr[64 * j]; s += (v[j].x * v[j].x + v[j].y * v[j].y) + (v[j].z * v[j].z + v[j].w * v[j].w); }
    const float rs = 1.0f / sqrtf(wave_sum(s) * (1.f / D) + 1e-6f);
    u32x2* o8 = (u32x2*)orow + lane;
#pragma unroll
    for (int j = 0; j < 4; ++j) { const f32x4 gg = gr[64 * j]; u32x2 w; w.x = pk_bf16(v[j].x * rs * gg.x, v[j].y * rs * gg.y); w.y = pk_bf16(v[j].z * rs * gg.z, v[j].w * rs * gg.w); o8[64 * j] = w; }
}
__device__ __forceinline__ void phase_prep(const Args& a, LAS unsigned char* lds, int G) {
    int tid = threadIdx.x; asm volatile("" : "+v"(tid)); const int lane = tid & 63, wave = __builtin_amdgcn_readfirstlane(tid >> 6);
    LAS float* scr = (LAS float*)(lds + wave * 16384);
    const int gw = blockIdx.x * 8 + wave, NGW = G * 8;
    unsigned char* ws = a.ws;
    constexpr int S_WIN = 16 * 80, S_WOUT = 16 * 32, S_MK = 16 * 8, S_SM = 12, S_GUP = 24;
    constexpr int NITEMS = S_WIN + S_WOUT + 2 * S_MK + 4 * S_SM + S_GUP;
    for (int it = gw; it < NITEMS; it += NGW) {
        int r = it;
        if (r < S_WIN) { const int kb = r / 80, nb = r % 80; transpose_item(a.in[I_WIN], IN_PROJ, (bf16_t*)(ws + WS_WINT), D, kb * 64, nb * 32, nb * 32, scr, lane); continue; } r -= S_WIN;
        if (r < S_WOUT) { const int kb = r / 32, nb = r % 32; transpose_item(a.in[I_WOUT], D, (bf16_t*)(ws + WS_WOUTT), D, kb * 64, nb * 32, nb * 32, scr, lane); continue; } r -= S_WOUT;
        if (r < S_MK) { const int kb = r / 8, nb = r % 8; transpose_item(a.in[I_WMK], 256, (bf16_t*)(ws + WS_WKT), D, kb * 64, nb * 32, nb * 32, scr, lane); continue; } r -= S_MK;
        if (r < S_MK) { const int kb = r / 8, nb = r % 8; transpose_item(a.in[I_WMV], 256, (bf16_t*)(ws + WS_WVT), D, kb * 64, nb * 32, nb * 32, scr, lane); continue; } r -= S_MK;
        if (r < 4 * S_SM) { const int which = r / S_SM, nb = r % S_SM;
            const float* src = (which < 2 ? a.in[I_DUP] : a.in[I_IUP]) + (size_t)(which & 1) * 64 * RW;
            transpose_item(src, RW, (bf16_t*)(ws + WS_SMALL) + (size_t)which * RW * 64, 64, 0, nb * 32, nb * 32, scr, lane); continue; } r -= 4 * S_SM;
        { const int kb = r / 12, nb = r % 12; transpose_item(a.in[I_GUP], RW, (bf16_t*)(ws + WS_SMALL) + (size_t)4 * RW * 64, 128, kb * 64, nb * 32, nb * 32, scr, lane); }
    }
    expert_prep_items(a, lds, gw, NGW, 0, 3 * 8192);
    for (int m = gw; m < T; m += NGW) rms_row_to_bf16(a.in[I_X] + (size_t)m * D, a.in[I_NMIXG], (bf16_t*)(ws + WS_XH) + (size_t)m * D, lane);
    for (int m = gw; m < BATCH * NMEM; m += NGW) rms_row_to_bf16(a.in[I_MEM] + (size_t)m * D, a.in[I_NMEMG], (bf16_t*)(ws + WS_MEMN) + (size_t)m * D, lane);
}

constexpr int AT_KS = 144;
constexpr int AT_VS = 520;
constexpr int AT_VOFF = 256 * AT_KS;
__device__ __forceinline__ bf16x8 pack_step(const f32x16& x, int s) {
    u32x4 p;
    asm volatile("v_cvt_pk_bf16_f32 %0, %4, %5\n\tv_cvt_pk_bf16_f32 %1, %6, %7\n\tv_cvt_pk_bf16_f32 %2, %8, %9\n\tv_cvt_pk_bf16_f32 %3, %10, %11\n\ts_nop 1"
                 : "=&v"(p[0]), "=&v"(p[1]), "=&v"(p[2]), "=&v"(p[3])
                 : "v"(x[8 * s]), "v"(x[8 * s + 1]), "v"(x[8 * s + 2]), "v"(x[8 * s + 3]), "v"(x[8 * s + 4]), "v"(x[8 * s + 5]), "v"(x[8 * s + 6]), "v"(x[8 * s + 7]));
    return __builtin_bit_cast(bf16x8, p);
}
__device__ __forceinline__ void attn_unit(const Args& a, LAS unsigned char* lds, int unit) {
    int tid = threadIdx.x; asm volatile("" : "+v"(tid)); const int lane = tid & 63, wave = __builtin_amdgcn_readfirstlane(tid >> 6), r = lane & 31, h = lane >> 5;
    const int b = unit >> 2, hh = unit & 3;
    const bf16_t* Qb = (const bf16_t*)(a.ws + WS_Q); const bf16_t* KM = (const bf16_t*)(a.ws + WS_KMEM); const bf16_t* VT = (const bf16_t*)(a.ws + WS_VT);
    bf16_t* MIX = (bf16_t*)(a.ws + WS_MIX);
    __syncthreads();
#pragma unroll
    for (int i = 0; i < 4; ++i) { const int c = tid + 512 * i, key = c >> 3, ch = c & 7;
        const u32x4 v = *(const u32x4*)(KM + (size_t)(b * NMEM + key) * 256 + hh * 64 + ch * 8);
        *(LAS u32x4*)(lds + key * AT_KS + ch * 16) = v; }
#pragma unroll
    for (int i = 0; i < 4; ++i) { const int c = tid + 512 * i, d = c >> 5, ch = c & 31;
        const u32x4 v = *(const u32x4*)(VT + (size_t)(hh * 64 + d) * (BATCH * NMEM) + b * NMEM + ch * 8);
        LAS u32x2* dst = (LAS u32x2*)(lds + AT_VOFF + d * AT_VS + ch * 16);
        dst[0] = (u32x2){v.x, v.y}; dst[1] = (u32x2){v.z, v.w}; }
    __syncthreads();
#pragma unroll 1
    for (int tile = 0; tile < 16; ++tile) {
    const int tok0 = b * SEQ + tile * 256 + wave * 32;
    bf16x8 qf[4];
#pragma unroll
    for (int ks = 0; ks < 4; ++ks) qf[ks] = *(const bf16x8*)(Qb + (size_t)(tok0 + r) * 256 + hh * 64 + ks * 16 + h * 8);
    const float sc = 0.125f * 1.4426950408889634f;
    float m_run = -3.0e38f, sum = 0.f;
    f32x16 o[2];
#pragma unroll
    for (int dt = 0; dt < 2; ++dt)
#pragma unroll
        for (int i = 0; i < 16; ++i) o[dt][i] = 0.f;
#pragma unroll 1
    for (int kh = 0; kh < 2; ++kh) {
        f32x16 s[4];
#pragma unroll
        for (int k4 = 0; k4 < 4; ++k4) {
#pragma unroll
            for (int i = 0; i < 16; ++i) s[k4][i] = 0.f;
#pragma unroll
            for (int ks = 0; ks < 4; ++ks) { const bf16x8 ka = *(const LAS bf16x8*)(lds + ((kh * 4 + k4) * 32 + r) * AT_KS + (ks * 16 + h * 8) * 2);
                s[k4] = __builtin_amdgcn_mfma_f32_32x32x16_bf16(ka, qf[ks], s[k4], 0, 0, 0); }
        }
        float mx = m_run;
#pragma unroll
        for (int k4 = 0; k4 < 4; ++k4)
#pragma unroll
            for (int i = 0; i < 16; ++i) mx = fmaxf(mx, s[k4][i]);
        mx = fmaxf(mx, __shfl_xor(mx, 32));
        const float alpha = __builtin_amdgcn_exp2f((m_run - mx) * sc);
        float ps = 0.f;
#pragma unroll
        for (int k4 = 0; k4 < 4; ++k4)
#pragma unroll
            for (int i = 0; i < 16; ++i) { const float e = __builtin_amdgcn_exp2f((s[k4][i] - mx) * sc); s[k4][i] = e; ps += e; }
        ps += __shfl_xor(ps, 32);
        sum = sum * alpha + ps; m_run = mx;
#pragma unroll
        for (int dt = 0; dt < 2; ++dt)
#pragma unroll
            for (int i = 0; i < 16; ++i) o[dt][i] *= alpha;
#pragma unroll
        for (int k4 = 0; k4 < 4; ++k4)
#pragma unroll
            for (int s2 = 0; s2 < 2; ++s2) {
                const bf16x8 pb = pack_step(s[k4], s2);
#pragma unroll
                for (int dt = 0; dt < 2; ++dt) {
                    const LAS unsigned char* vp = lds + AT_VOFF + (32 * dt + r) * AT_VS + (32 * (kh * 4 + k4) + 16 * s2 + 4 * h) * 2;
                    const s16x4 lo = *(const LAS s16x4*)vp, hi = *(const LAS s16x4*)(vp + 16);
                    const bf16x8 va = __builtin_shufflevector(lo, hi, 0, 1, 2, 3, 4, 5, 6, 7);
                    o[dt] = __builtin_amdgcn_mfma_f32_32x32x16_bf16(va, pb, o[dt], 0, 0, 0);
                }
            }
    }
    const float inv = 1.0f / sum;
    bf16_t* orow = MIX + (size_t)(tok0 + r) * D + hh * 64;
#pragma unroll
    for (int dt = 0; dt < 2; ++dt)
#pragma unroll
        for (int gq = 0; gq < 4; ++gq) { u32x2 w; w.x = pk_bf16(o[dt][4 * gq] * inv, o[dt][4 * gq + 1] * inv); w.y = pk_bf16(o[dt][4 * gq + 2] * inv, o[dt][4 * gq + 3] * inv);
            *(u32x2*)(orow + 32 * dt + 8 * gq + 4 * h) = w; }
    }
}

__device__ __forceinline__ void conv_unit(const Args& a, LAS unsigned char* lds, int unit) {
    int tid = threadIdx.x; asm volatile("" : "+v"(tid)); const int lane = tid & 63, wave = __builtin_amdgcn_readfirstlane(tid >> 6);
    const int b = unit >> 6, t0 = (unit & 63) * 64;
    const bf16_t* P = (const bf16_t*)(a.ws + WS_P); bf16_t* MIX = (bf16_t*)(a.ws + WS_MIX);
    LAS _Float16* U = (LAS _Float16*)lds;
    LAS _Float16* Cc = (LAS _Float16*)(lds + 94 * CW * 2);
    __syncthreads();
#pragma unroll 1
    for (int q0 = tid; q0 < 94 * 48; q0 += 3 * NTHREADS) {
        u32x4 vvv[3], ggg[3];
#pragma unroll
        for (int u3 = 0; u3 < 3; ++u3) { const int q = q0 + u3 * NTHREADS, j = q / 48, cc = (q % 48) * 8, s = t0 - 15 + j; const bool ok = (q < 94 * 48) && s >= 0 && s < SEQ;
            const bf16_t* row = P + (size_t)(b * SEQ + (ok ? s : 0)) * PLD + cc;
            vvv[u3] = ok ? *(const u32x4*)row : (u32x4){0u, 0u, 0u, 0u}; ggg[u3] = ok ? *(const u32x4*)(row + CW) : (u32x4){0u, 0u, 0u, 0u}; }
#pragma unroll
        for (int u3 = 0; u3 < 3; ++u3) { const int q = q0 + u3 * NTHREADS, j = q / 48, cc = (q % 48) * 8;
            if (q < 94 * 48) {
                const unsigned vw[4] = {vvv[u3].x, vvv[u3].y, vvv[u3].z, vvv[u3].w}, gw[4] = {ggg[u3].x, ggg[u3].y, ggg[u3].z, ggg[u3].w};
                float u[8];
#pragma unroll
                for (int k = 0; k < 4; ++k) { u[2 * k] = bf_lo(vw[k]) * sigmoidf_fast(bf_lo(gw[k])); u[2 * k + 1] = bf_hi(vw[k]) * sigmoidf_fast(bf_hi(gw[k])); }
                LAS f16x4* dst = (LAS f16x4*)(U + j * CW + cc); dst[0] = (f16x4){(_Float16)u[0], (_Float16)u[1], (_Float16)u[2], (_Float16)u[3]}; dst[1] = (f16x4){(_Float16)u[4], (_Float16)u[5], (_Float16)u[6], (_Float16)u[7]}; }
        }
    }
    __syncthreads();
    const int cq = tid & 127, tq = tid >> 7;
#pragma unroll 1
    for (int k3 = 0; k3 < 3; ++k3) { const int c = cq + 128 * k3;
        float w[31], res[16];
#pragma unroll
        for (int kk = 0; kk < 31; ++kk) w[kk] = a.in[I_CONVW][kk * CW + c];
        const float bias = a.in[I_CONVB][c];
#pragma unroll
        for (int tt = 0; tt < 16; ++tt) res[tt] = bias;
#pragma unroll
        for (int jj = 0; jj < 46; ++jj) { const float uv = (float)U[(tq * 16 + jj) * CW + c];
#pragma unroll
            for (int tt = 0; tt < 16; ++tt) { if (jj - tt >= 0 && jj - tt <= 30) res[tt] += uv * w[jj - tt]; } }
#pragma unroll
        for (int tt = 0; tt < 16; ++tt) Cc[(tq * 16 + tt) * CW + c] = (_Float16)res[tt];
    }
    __syncthreads();
    for (int tt = 0; tt < 8; ++tt) { const int t = wave * 8 + tt;
        float v[6]; float s = 0.f;
#pragma unroll
        for (int i = 0; i < 6; ++i) { v[i] = (float)Cc[t * CW + lane + 64 * i]; s += v[i]; }
        const float mean = wave_sum(s) * (1.f / CW); float q = 0.f;
#pragma unroll
        for (int i = 0; i < 6; ++i) { v[i] -= mean; q += v[i] * v[i]; }
        const float rstd = 1.0f / sqrtf(wave_sum(q) * (1.f / CW) + 1e-5f);
        bf16_t* orow = MIX + (size_t)(b * SEQ + t0 + t) * D + 256;
#pragma unroll
        for (int i = 0; i < 6; ++i) { const int c = lane + 64 * i; const float y = v[i] * rstd * a.in[I_CLNG][c] + a.in[I_CLNB][c]; const float o = y * sigmoidf_fast(y);
            orow[c] = (bf16_t)(pk_bf16(o, 0.f) & 0xffffu); }
    }
}

constexpr int PR_AS = 784;
constexpr int PR_RK = 64 * PR_AS;
constexpr int PR_RKS = 1536;
constexpr int PR_RN = PR_RK + 64 * PR_RKS;
constexpr int PR_CST = PR_RN + 2048;
static_assert(PR_CST + 7 * 384 * 4 <= LDS_BYTES - 64, "prep LDS map");
template <int CTRL> __device__ __forceinline__ f32x4 dpp4(f32x4 x) { return (f32x4){dpp_f<CTRL>(x.x), dpp_f<CTRL>(x.y), dpp_f<CTRL>(x.z), dpp_f<CTRL>(x.w)}; }
__device__ __forceinline__ void prep_unit(const Args& a, LAS unsigned char* lds, int unit) {
    int tid = threadIdx.x; asm volatile("" : "+v"(tid)); const int lane = tid & 63, wave = __builtin_amdgcn_readfirstlane(tid >> 6);
    const int b = unit >> 6, t0 = (unit & 63) * 64;
    const bf16_t* __restrict__ P = (const bf16_t*)(a.ws + WS_P);
    const float* __restrict__ mu = a.in[I_SHIFTMU];
    LAS float* RNs = (LAS float*)(lds + PR_RN); LAS float* CST = (LAS float*)(lds + PR_CST);
    __syncthreads();
    for (int i = tid; i < 7 * 384; i += NTHREADS) { const int w7 = i / 384, c7 = i % 384;
        CST[i] = (w7 == 0) ? a.in[I_KK][c7] : (w7 == 1) ? a.in[I_KA][c7] : (w7 == 2) ? a.in[I_RK][c7] : (w7 < 5) ? a.in[I_DW0][(w7 - 3) * RW + c7] : a.in[I_IA0][(w7 - 5) * RW + c7]; }
#ifndef PREP_REP1
#define PREP_REP1 1
#endif
#ifndef PREP_REP2
#define PREP_REP2 1
#endif
#pragma unroll 1
    for (int rp1 = 0; rp1 < PREP_REP1; ++rp1)
#pragma unroll 1
    for (int q0 = tid; q0 < 64 * 192; q0 += 4 * NTHREADS) {
        u32x4 cuv[4], pvv[4], nvv[4];
#pragma unroll
        for (int u4 = 0; u4 < 4; ++u4) { const int q = q0 + u4 * NTHREADS, tt = q / 192, c8 = (q % 192) * 8, s = t0 + tt;
            const bf16_t* row = P + ((size_t)b * SEQ + s) * PLD + 768 + c8;
            cuv[u4] = *(const u32x4*)row;
            pvv[u4] = (s > 0) ? *(const u32x4*)(row - PLD) : (u32x4){0u, 0u, 0u, 0u};
            nvv[u4] = (s < SEQ - 1) ? *(const u32x4*)(row + PLD) : (u32x4){0u, 0u, 0u, 0u}; }
#pragma unroll
        for (int u4 = 0; u4 < 4; ++u4) { const int q = q0 + u4 * NTHREADS, tt = q / 192, c8 = (q % 192) * 8, s = t0 + tt; const size_t tok = (size_t)b * SEQ + s;
            const u32x4 cu = cuv[u4], pv = pvv[u4], nv = nvv[u4];
            const unsigned cw[4] = {cu.x, cu.y, cu.z, cu.w}, pw[4] = {pv.x, pv.y, pv.z, pv.w}, nw[4] = {nv.x, nv.y, nv.z, nv.w};
            const f32x4 m0a = *(const f32x4*)(mu + c8), m0b = *(const f32x4*)(mu + c8 + 4), m1a = *(const f32x4*)(mu + 1536 + c8), m1b = *(const f32x4*)(mu + 1536 + c8 + 4);
            const float m0[8] = {m0a.x, m0a.y, m0a.z, m0a.w, m0b.x, m0b.y, m0b.z, m0b.w}, m1[8] = {m1a.x, m1a.y, m1a.z, m1a.w, m1b.x, m1b.y, m1b.z, m1b.w};
            float pf[8];
#pragma unroll
            for (int k = 0; k < 4; ++k) { const float c0 = bf_lo(cw[k]), c1 = bf_hi(cw[k]);
                pf[2 * k] = c0 + m0[2 * k] * (bf_lo(pw[k]) - c0) + m1[2 * k] * (bf_lo(nw[k]) - c0);
                pf[2 * k + 1] = c1 + m0[2 * k + 1] * (bf_hi(pw[k]) - c1) + m1[2 * k + 1] * (bf_hi(nw[k]) - c1); }
            if (c8 < 768) {
                f16x4 h0 = {(_Float16)pf[0], (_Float16)pf[1], (_Float16)pf[2], (_Float16)pf[3]}, h1 = {(_Float16)pf[4], (_Float16)pf[5], (_Float16)pf[6], (_Float16)pf[7]};
                LAS f16x4* dst = (LAS f16x4*)(lds + PR_RK + tt * PR_RKS + c8 * 2); dst[0] = h0; dst[1] = h1;
                if (c8 >= 384) { const f32x4 ka = *(const f32x4*)(a.in[I_KK] + c8 - 384), kb = *(const f32x4*)(a.in[I_KK] + c8 - 384 + 4);
                    float ssq = (pf[0] * ka.x) * (pf[0] * ka.x) + (pf[1] * ka.y) * (pf[1] * ka.y) + (pf[2] * ka.z) * (pf[2] * ka.z) + (pf[3] * ka.w) * (pf[3] * ka.w)
                              + (pf[4] * kb.x) * (pf[4] * kb.x) + (pf[5] * kb.y) * (pf[5] * kb.y) + (pf[6] * kb.z) * (pf[6] * kb.z) + (pf[7] * kb.w) * (pf[7] * kb.w);
                    ssq = sum8(ssq);
                    if ((lane & 7) == 0) RNs[tt * 8 + ((c8 - 384) >> 6)] = __builtin_amdgcn_rsqf(ssq + 1e-12f); }
            } else if (c8 < 1152) {
                u32x4 w; w.x = pk_bf16(pf[0], pf[1]); w.y = pk_bf16(pf[2], pf[3]); w.z = pk_bf16(pf[4], pf[5]); w.w = pk_bf16(pf[6], pf[7]);
                *(u32x4*)((bf16_t*)scan_arr(a.ws, 0) + hat_off(0, tok, c8 - 768)) = w;
            } else {
                const int cc = c8 - 1152;
#pragma unroll
                for (int k = 0; k < 8; ++k) { if (cc < 128) pf[k] = 1.0f - 2.0f * __builtin_amdgcn_rcpf(1.0f + __builtin_amdgcn_exp2f(2.8853900817779268f * pf[k])); else if (cc >= 256) pf[k] = sigmoidf_fast(pf[k]); }
                u32x4 w; w.x = pk_bf16(pf[0], pf[1]); w.y = pk_bf16(pf[2], pf[3]); w.z = pk_bf16(pf[4], pf[5]); w.w = pk_bf16(pf[6], pf[7]);
                *(LAS u32x4*)(lds + tt * PR_AS + cc * 2) = w; }
        }
    }
    __syncthreads();
    const int l15 = lane & 15, kq = lane >> 4;
    const bf16_t* SM = (const bf16_t*)(a.ws + WS_SMALL);
    float* __restrict__ PCg = (float*)(a.ws + WS_PC); float* __restrict__ BON = (float*)(a.ws + WS_BON);
    bf16x8 Fc[16], Fn[16];
#define PREP_CH(nt_) (32 * ((nt_) >> 1) + 8 * (l15 >> 2) + 4 * ((nt_) & 1) + (l15 & 3))
#define PREP_LOADF(st_) do { const int it_ = wave + 8 * ((st_) / 3), kind_ = (st_) % 3, hd_ = it_ >> 2; \
        if (kind_ < 2) { const bf16_t* w0_ = SM + (size_t)kind_ * RW * 64; const bf16_t* w1_ = SM + (size_t)(2 + kind_) * RW * 64; \
            _Pragma("unroll") for (int f_ = 0; f_ < 16; ++f_) Fn[f_] = *(const bf16x8*)((((f_ >> 2) & 1) ? w1_ : w0_) + (size_t)(hd_ * 64 + PREP_CH(f_ & 3)) * 64 + (f_ >> 3) * 32 + kq * 8); } \
        else { const bf16_t* wg_ = SM + (size_t)4 * RW * 64; \
            _Pragma("unroll") for (int f_ = 0; f_ < 16; ++f_) Fn[f_] = *(const bf16x8*)(wg_ + (size_t)(hd_ * 64 + PREP_CH(f_ & 3)) * 128 + (f_ >> 2) * 32 + kq * 8); } } while (0)
    PREP_LOADF(0);
#pragma unroll 1
    for (int st = 0; st < 9; ++st) {
#pragma unroll
        for (int f = 0; f < 16; ++f) Fc[f] = Fn[f];
        const int it = wave + 8 * (st / 3), kind = st % 3, hd = it >> 2, mt = it & 3, tokl = mt * 16 + l15; const size_t tok = (size_t)b * SEQ + t0 + tokl;
        if (kind < 2) {
            const int d = kind;
            f32x4 accW[4], accA[4];
#pragma unroll
            for (int nt = 0; nt < 4; ++nt) { accW[nt] = (f32x4){0.f, 0.f, 0.f, 0.f}; accA[nt] = (f32x4){0.f, 0.f, 0.f, 0.f}; }
#pragma unroll
            for (int ks = 0; ks < 2; ++ks) {
                const bf16x8 aw = *(const LAS bf16x8*)(lds + tokl * PR_AS + (d * 64 + ks * 32 + kq * 8) * 2), aa = *(const LAS bf16x8*)(lds + tokl * PR_AS + ((2 + d) * 64 + ks * 32 + kq * 8) * 2);
#pragma unroll
                for (int nt = 0; nt < 4; ++nt) { accW[nt] = MFMA16(Fc[ks * 8 + nt], aw, accW[nt]); accA[nt] = MFMA16(Fc[ks * 8 + 4 + nt], aa, accA[nt]); }
            }
            if (st + 1 < 9) PREP_LOADF(st + 1);
            const float rn = RNs[tokl * 8 + hd];
            bf16_t* AHg = (bf16_t*)scan_arr(a.ws, 1 + 4 * d); bf16_t* RHg = (bf16_t*)scan_arr(a.ws, 2 + 4 * d); bf16_t* BHg = (bf16_t*)scan_arr(a.ws, 3 + 4 * d); bf16_t* KHg = (bf16_t*)scan_arr(a.ws, 4 + 4 * d);
            float bsum = 0.f;
            u32x2 hA[2], hR[2], hB[2], hK[2];
#pragma unroll
            for (int nt = 0; nt < 4; ++nt) { const int ch = hd * 64 + 32 * (nt >> 1) + 8 * kq + 4 * (nt & 1);
                const f32x4 bW = *(const LAS f32x4*)(CST + (3 + d) * 384 + ch), bA = *(const LAS f32x4*)(CST + (5 + d) * 384 + ch);
                const f32x4 kkw = *(const LAS f32x4*)(CST + ch), kaw = *(const LAS f32x4*)(CST + 384 + ch), rkw = *(const LAS f32x4*)(CST + 768 + ch);
                const f32x4 zw = accW[nt] + bW, za = accA[nt] + bA;
                f32x4 lw, av;
#pragma unroll
                for (int e = 0; e < 4; ++e) { lw[e] = -0.606531f * 1.4426950408889634f * sigmoidf_fast(zw[e]); av[e] = sigmoidf_fast(za[e]); }
                f32x4 cum = lw;
                if (d == 0) { cum += dpp4<0x111>(cum); cum += dpp4<0x112>(cum); cum += dpp4<0x114>(cum); cum += dpp4<0x118>(cum); }
                else        { cum += dpp4<0x101>(cum); cum += dpp4<0x102>(cum); cum += dpp4<0x104>(cum); cum += dpp4<0x108>(cum); }
                f32x4 Pt, Pinv, Pprev;
#pragma unroll
                for (int e = 0; e < 4; ++e) { Pt[e] = __builtin_amdgcn_exp2f(cum[e]); Pinv[e] = __builtin_amdgcn_rcpf(Pt[e]); Pprev[e] = __builtin_amdgcn_exp2f(cum[e] - lw[e]); }
                const f32x4 r4 = __builtin_convertvector(*(const LAS f16x4*)(lds + PR_RK + tokl * PR_RKS + ch * 2), f32x4);
                const f32x4 k4 = __builtin_convertvector(*(const LAS f16x4*)(lds + PR_RK + tokl * PR_RKS + (384 + ch) * 2), f32x4);
                const f32x4 kk = k4 * kkw * rn, kd = k4 * (1.0f + (av - 1.0f) * kaw);
                hA[nt & 1] = f32_to_bf4(-kk * Pprev); hR[nt & 1] = f32_to_bf4(r4 * Pt); hB[nt & 1] = f32_to_bf4(kk * av * Pinv); hK[nt & 1] = f32_to_bf4(kd * Pinv);
                const f32x4 bt = r4 * kd * rkw; bsum += (bt.x + bt.y) + (bt.z + bt.w);
                if (l15 == (d ? 0 : 15)) *(f32x4*)(PCg + ((size_t)d * (T / 16) + (tok >> 4)) * RW + ch) = Pt;
                if (nt & 1) { const int c8 = ch - 4; const size_t eo = hat_off(1, tok, c8);
                    *(u32x4*)(AHg + eo) = (u32x4){hA[0].x, hA[0].y, hA[1].x, hA[1].y}; *(u32x4*)(RHg + eo) = (u32x4){hR[0].x, hR[0].y, hR[1].x, hR[1].y};
                    *(u32x4*)(BHg + eo) = (u32x4){hB[0].x, hB[0].y, hB[1].x, hB[1].y}; *(u32x4*)(KHg + hat_off(4 + 4 * d, tok, c8)) = (u32x4){hK[0].x, hK[0].y, hK[1].x, hK[1].y}; }
            }
            bsum += __shfl_xor(bsum, 16); bsum += __shfl_xor(bsum, 32);
            if (kq == 0) BON[(size_t)d * T * NH + tok * NH + hd] = bsum;
        } else {
            f32x4 acc[4];
#pragma unroll
            for (int nt = 0; nt < 4; ++nt) acc[nt] = (f32x4){0.f, 0.f, 0.f, 0.f};
#pragma unroll
            for (int ks = 0; ks < 4; ++ks) { const bf16x8 afr = *(const LAS bf16x8*)(lds + tokl * PR_AS + (256 + ks * 32 + kq * 8) * 2);
#pragma unroll
                for (int nt = 0; nt < 4; ++nt) acc[nt] = MFMA16(Fc[ks * 4 + nt], afr, acc[nt]); }
            if (st + 1 < 9) PREP_LOADF(st + 1);
#pragma unroll
            for (int pr = 0; pr < 2; ++pr) { const u32x2 g0 = f32_to_bf4(acc[2 * pr]), g1 = f32_to_bf4(acc[2 * pr + 1]);
                *(u32x4*)((bf16_t*)(a.ws + WS_G) + tok * RW + hd * 64 + 32 * pr + 8 * kq) = (u32x4){g0.x, g0.y, g1.x, g1.y}; }
        }
    }
#undef PREP_LOADF
#undef PREP_CH
}

__device__ __forceinline__ void glds16_asm(const void* gptr, LAS unsigned char* ldst) {
    const unsigned la = __builtin_amdgcn_readfirstlane((unsigned)(size_t)ldst);
    asm volatile("s_mov_b32 m0, %1\n\ts_nop 0\n\tglobal_load_lds_dwordx4 %0, off" :: "v"(gptr), "s"(la) : "m0", "memory");
}
constexpr int CK = 16, NCHUNK = SEQ / CK, CS_NS = 8, CS_NPROD = 6, CS_NCONS = 2;
constexpr int SL_ATIL = 0, SL_RTIL = 2048, SL_BH = 4096, SL_KH = 6144, SL_V = 8192, SL_ULOC = 10240, SL_YLOC = 12288, SL_PC = 14336, SL_BYTES = 14592;
constexpr int PS_AH = 0, PS_RH = 2048, PS_BYTES = 4096;
constexpr int CS_PS_OFF = CS_NS * SL_BYTES, CS_FLAG_OFF = CS_PS_OFF + CS_NPROD * PS_BYTES;
static_assert(CS_FLAG_OFF + 64 <= LDS_BYTES - 64, "chunked scan LDS map");
__device__ __forceinline__ int swz(int t, int j) { return t * 128 + ((((j >> 3) ^ (t & 7))) << 4) + ((j & 4) << 1); }
__device__ __forceinline__ void scan_chunked_unit(const Args& a, LAS unsigned char* lds, int unit) {
    int tid = threadIdx.x; asm volatile("" : "+v"(tid)); const int lane = tid & 63, wave = __builtin_amdgcn_readfirstlane(tid >> 6);
    const int dir = unit & 1, bh = unit >> 1, b = bh / NH, hd = bh % NH;
    const int c16 = lane & 15, q = lane >> 4, qp = c16 >> 2, pp = c16 & 3;
    volatile LAS unsigned* FULL = (volatile LAS unsigned*)(lds + CS_FLAG_OFF);
    volatile LAS unsigned* DONE = FULL + 8;
    float* Yg = (float*)(a.ws + (dir ? WS_YB : WS_YF));
    __syncthreads();
    if (tid < 16) FULL[tid] = 0u;
    __syncthreads();
    if (wave >= CS_NCONS) {
        const int pw = wave - CS_NCONS;
        LAS unsigned char* ps = lds + CS_PS_OFF + pw * PS_BYTES;
        const bf16_t* ARR[5] = {(const bf16_t*)scan_arr(a.ws, 1 + 4 * dir), (const bf16_t*)scan_arr(a.ws, 2 + 4 * dir), (const bf16_t*)scan_arr(a.ws, 3 + 4 * dir), (const bf16_t*)scan_arr(a.ws, 4 + 4 * dir), (const bf16_t*)scan_arr(a.ws, 0)};
        const int AIDX[5] = {1 + 4 * dir, 2 + 4 * dir, 3 + 4 * dir, 4 + 4 * dir, 0};
        const float* PCg = (const float*)(a.ws + WS_PC) + (size_t)dir * (T / 16) * RW + hd * 64 + lane;
        u32x4 pf[10];
#define CS_ISSUE(cc) do { _Pragma("unroll") for (int ar_ = 0; ar_ < 5; ++ar_) _Pragma("unroll") for (int hf_ = 0; hf_ < 2; ++hf_) { \
            const int row_ = hf_ * 8 + (lane >> 3); const int st_ = (cc) * CK + row_; const int t_ = dir ? (SEQ - 1 - st_) : st_; \
            pf[ar_ * 2 + hf_] = *(const u32x4*)(ARR[ar_] + hat_off(AIDX[ar_], (size_t)b * SEQ + t_, hd * 64 + 8 * ((lane & 7) ^ (row_ & 7)))); } } while (0)
#define CS_PCLOAD(cc) PCg[(size_t)((size_t)b * (SEQ / CK) + (dir ? (NCHUNK - 1 - (cc)) : (cc))) * RW]
        CS_ISSUE(pw);
        float pcn = CS_PCLOAD(pw);
#pragma unroll 1
        for (int c = pw; c < NCHUNK; c += CS_NPROD) {
            const int slot = c % CS_NS; LAS unsigned char* sl = lds + slot * SL_BYTES;
            { unsigned sp = 0; const unsigned want = (unsigned)CS_NCONS * (unsigned)(c / CS_NS); while (DONE[slot] < want) { __builtin_amdgcn_s_sleep(1); if (++sp > (1u << 22)) break; } }
            asm volatile("" ::: "memory");
            *(LAS u32x4*)(ps + PS_AH + lane * 16) = pf[0]; *(LAS u32x4*)(ps + PS_AH + 1024 + lane * 16) = pf[1];
            *(LAS u32x4*)(ps + PS_RH + lane * 16) = pf[2]; *(LAS u32x4*)(ps + PS_RH + 1024 + lane * 16) = pf[3];
            *(LAS u32x4*)(sl + SL_BH + lane * 16) = pf[4]; *(LAS u32x4*)(sl + SL_BH + 1024 + lane * 16) = pf[5];
            *(LAS u32x4*)(sl + SL_KH + lane * 16) = pf[6]; *(LAS u32x4*)(sl + SL_KH + 1024 + lane * 16) = pf[7];
            *(LAS u32x4*)(sl + SL_V + lane * 16) = pf[8]; *(LAS u32x4*)(sl + SL_V + 1024 + lane * 16) = pf[9];
            *(LAS float*)(sl + SL_PC + lane * 4) = pcn;
            if (c + CS_NPROD < NCHUNK) { CS_ISSUE(c + CS_NPROD); pcn = CS_PCLOAD(c + CS_NPROD); }
            asm volatile("s_waitcnt lgkmcnt(0)" ::: "memory");
#ifndef PROD_REP
#define PROD_REP 1
#endif
#pragma unroll 1
            for (int rpp = 0; rpp < PROD_REP; ++rpp) {
            bf16x8 AHf[2], BHf[2], KHf[2], RHf[2];
#pragma unroll
            for (int ks = 0; ks < 2; ++ks) { const int o = swz(c16, 32 * ks + 8 * q);
                AHf[ks] = *(const LAS bf16x8*)(ps + PS_AH + o); RHf[ks] = *(const LAS bf16x8*)(ps + PS_RH + o); BHf[ks] = *(const LAS bf16x8*)(sl + SL_BH + o); KHf[ks] = *(const LAS bf16x8*)(sl + SL_KH + o); }
            f32x4 Mab = {0.f, 0.f, 0.f, 0.f}, Mak = Mab, MrbT = Mab, MrkT = Mab, MabT = Mab;
#pragma unroll
            for (int ks = 0; ks < 2; ++ks) { Mab = MFMA16(AHf[ks], BHf[ks], Mab); MabT = MFMA16(BHf[ks], AHf[ks], MabT); Mak = MFMA16(AHf[ks], KHf[ks], Mak); MrbT = MFMA16(BHf[ks], RHf[ks], MrbT); MrkT = MFMA16(KHf[ks], RHf[ks], MrkT); }
#pragma unroll
            for (int r = 0; r < 4; ++r) { const bool lt = c16 < 4 * q + r, gt = 4 * q + r < c16, le = 4 * q + r <= c16;
                Mab[r] = lt ? Mab[r] : 0.f; Mak[r] = lt ? Mak[r] : 0.f; MabT[r] = gt ? MabT[r] : 0.f; MrbT[r] = le ? MrbT[r] : 0.f; MrkT[r] = le ? MrkT[r] : 0.f; }
            const f32x4 z4 = {0.f, 0.f, 0.f, 0.f};
            const bf16x8 fN = frag_lo4(Mab), fNT = frag_lo4(MabT);
            const f32x4 N2 = MFMA16(fNT, fN, z4), N2T = MFMA16(fN, fNT, z4);
            f32x4 PT = MabT;
#pragma unroll
            for (int r = 0; r < 4; ++r) PT[r] += (4 * q + r == c16) ? 1.0f : 0.f;
            const bf16x8 fN2 = frag_lo4(N2), fN2T = frag_lo4(N2T);
            PT = MFMA16(fN2, frag_lo4(PT), PT);
            const f32x4 N4 = MFMA16(fN2T, fN2, z4), N4T = MFMA16(fN2, fN2T, z4);
            const bf16x8 fN4 = frag_lo4(N4), fN4T = frag_lo4(N4T);
            PT = MFMA16(fN4, frag_lo4(PT), PT);
            const f32x4 N8 = MFMA16(fN4T, fN4, z4);
            PT = MFMA16(frag_lo4(N8), frag_lo4(PT), PT);
            const bf16x8 LinvF = frag_lo4(PT);
            const bf16x8 MakF = frag_lo4(Mak), MrbTF = frag_lo4(MrbT);
            const f32x4 W1 = MFMA16(LinvF, MakF, z4);
            const f32x4 W1T = MFMA16(MakF, LinvF, z4);
            const f32x4 W2T = MFMA16(frag_lo4(W1), MrbTF, MrkT);
            f32x4 AtT[4], RtT[4];
#pragma unroll
            for (int jt = 0; jt < 4; ++jt) {
                const bf16x8 ahF = frag_cat(__builtin_bit_cast(u32x2, tr_read16(ps + PS_AH + swz(4 * q + qp, 16 * jt + 4 * pp))), (u32x2){0u, 0u});
                const f32x4 AtN = MFMA16(LinvF, ahF, z4);
                AtT[jt] = MFMA16(ahF, LinvF, z4);
                const f32x4 rinit = bf4_to_f32(*(const LAS u32x2*)(ps + PS_RH + swz(c16, 16 * jt + 4 * q)));
                RtT[jt] = MFMA16(frag_lo4(AtN), MrbTF, rinit);
            }
#pragma unroll
            for (int ks = 0; ks < 2; ++ks) {
                const u32x4 wa = {pk_bf16(AtT[2 * ks][0], AtT[2 * ks][1]), pk_bf16(AtT[2 * ks][2], AtT[2 * ks][3]), pk_bf16(AtT[2 * ks + 1][0], AtT[2 * ks + 1][1]), pk_bf16(AtT[2 * ks + 1][2], AtT[2 * ks + 1][3])};
                const u32x4 wr = {pk_bf16(RtT[2 * ks][0], RtT[2 * ks][1]), pk_bf16(RtT[2 * ks][2], RtT[2 * ks][3]), pk_bf16(RtT[2 * ks + 1][0], RtT[2 * ks + 1][1]), pk_bf16(RtT[2 * ks + 1][2], RtT[2 * ks + 1][3])};
                *(LAS u32x4*)(sl + SL_ATIL + ks * 1024 + lane * 16) = wa; *(LAS u32x4*)(sl + SL_RTIL + ks * 1024 + lane * 16) = wr; }
            *(LAS u32x2*)(sl + SL_ULOC + lane * 8) = f32_to_bf4(W1T); *(LAS u32x2*)(sl + SL_YLOC + lane * 8) = f32_to_bf4(W2T);
            }
            asm volatile("s_waitcnt lgkmcnt(0)" ::: "memory");
            if (lane == 0) FULL[slot] = (unsigned)(c + 1);
        }
#undef CS_ISSUE
#undef CS_PCLOAD
    } else {
        struct ConsOps { bf16x8 at0, at1, rt0, rt1, bk[4]; u32x2 w1w, w2w, vfw[2]; f32x4 pc[4]; };
        f32x4 S[2][4];
#pragma unroll
        for (int ti = 0; ti < 2; ++ti)
#pragma unroll
            for (int mt = 0; mt < 4; ++mt) S[ti][mt] = (f32x4){0.f, 0.f, 0.f, 0.f};
#define CONS_LOAD(X, cc) do { const int slot_ = (cc) % CS_NS; LAS unsigned char* sl_ = lds + slot_ * SL_BYTES; \
            { unsigned sp_ = 0; while (FULL[slot_] < (unsigned)((cc) + 1)) { __builtin_amdgcn_s_sleep(1); if (++sp_ > (1u << 22)) break; } } \
            asm volatile("" ::: "memory"); \
            X.at0 = *(const LAS bf16x8*)(sl_ + SL_ATIL + lane * 16); X.at1 = *(const LAS bf16x8*)(sl_ + SL_ATIL + 1024 + lane * 16); \
            X.rt0 = *(const LAS bf16x8*)(sl_ + SL_RTIL + lane * 16); X.rt1 = *(const LAS bf16x8*)(sl_ + SL_RTIL + 1024 + lane * 16); \
            X.w1w = *(const LAS u32x2*)(sl_ + SL_ULOC + lane * 8); X.w2w = *(const LAS u32x2*)(sl_ + SL_YLOC + lane * 8); \
            _Pragma("unroll") for (int mt_ = 0; mt_ < 4; ++mt_) { X.pc[mt_] = *(const LAS f32x4*)(sl_ + SL_PC + (16 * mt_ + 4 * q) * 4); \
                X.bk[mt_] = frag_cat(__builtin_bit_cast(u32x2, tr_read16(sl_ + SL_BH + swz(4 * q + qp, 16 * mt_ + 4 * pp))), __builtin_bit_cast(u32x2, tr_read16(sl_ + SL_KH + swz(4 * q + qp, 16 * mt_ + 4 * pp)))); } \
            _Pragma("unroll") for (int ti_ = 0; ti_ < 2; ++ti_) X.vfw[ti_] = __builtin_bit_cast(u32x2, tr_read16(sl_ + SL_V + swz(4 * q + qp, 16 * (2 * wave + ti_) + 4 * pp))); } while (0)
#define CONS_COMPUTE(X, cc) do { const f32x4 z4c_ = {0.f, 0.f, 0.f, 0.f}; const bf16x8 w1f_ = frag_cat(X.w1w, (u32x2){0u, 0u}), w2f_ = frag_cat(X.w2w, (u32x2){0u, 0u}); \
            _Pragma("unroll") for (int ti_ = 0; ti_ < 2; ++ti_) { const int nt_ = 2 * wave + ti_; \
                const bf16x8 vB_ = frag_cat(X.vfw[ti_], (u32x2){0u, 0u}); \
                const bf16x8 Sb0_ = frag_cat(f32_to_bf4(S[ti_][0]), f32_to_bf4(S[ti_][1])), Sb1_ = frag_cat(f32_to_bf4(S[ti_][2]), f32_to_bf4(S[ti_][3])); \
                const f32x4 U0_ = MFMA16(X.at0, Sb0_, MFMA16(w1f_, vB_, z4c_)), U1_ = MFMA16(X.at1, Sb1_, z4c_); \
                const f32x4 Y0_ = MFMA16(X.rt0, Sb0_, MFMA16(w2f_, vB_, z4c_)), Y1_ = MFMA16(X.rt1, Sb1_, z4c_); \
                const f32x4 UT_ = U0_ + U1_, YT_ = Y0_ + Y1_; \
                const bf16x8 Ub_ = frag_cat(f32_to_bf4(UT_), X.vfw[ti_]); \
                _Pragma("unroll") for (int mt_ = 0; mt_ < 4; ++mt_) { S[ti_][mt_] = MFMA16(X.bk[mt_], Ub_, S[ti_][mt_]); S[ti_][mt_] = S[ti_][mt_] * X.pc[mt_]; } \
                *(f32x4*)(Yg + ((((size_t)b * NCHUNK + (dir ? (NCHUNK - 1 - (cc)) : (cc))) * NH + hd) * 64 + 16 * nt_ + c16) * 16 + 4 * q) = YT_; } } while (0)
#define CONS_DONE(cc) do { asm volatile("s_waitcnt lgkmcnt(0)" ::: "memory"); if (lane == 0) (void)__hip_atomic_fetch_add((LAS unsigned*)&DONE[(cc) % CS_NS], 1u, __ATOMIC_RELAXED, __HIP_MEMORY_SCOPE_WORKGROUP); } while (0)
        ConsOps OA, OB;
        CONS_LOAD(OA, 0);
#pragma unroll 1
        for (int c = 0; c < NCHUNK; c += 2) {
            CONS_LOAD(OB, c + 1);
            CONS_COMPUTE(OA, c);
            CONS_DONE(c);
            if (c + 2 < NCHUNK) CONS_LOAD(OA, c + 2);
            CONS_COMPUTE(OB, c + 1);
            CONS_DONE(c + 1);
        }
#undef CONS_LOAD
#undef CONS_COMPUTE
#undef CONS_DONE
        unsigned tq0 = 0u, tq1 = 0u, tq2 = 0u, tq3 = 0u, tq4 = 0u, tq5 = 0u, tacc = 0u;
        (void)tq0; (void)tq1; (void)tq2; (void)tq3; (void)tq4; (void)tq5;
        (void)tacc;
    }
}

__device__ __forceinline__ void phase_post(const Args& a, int G) {
    int tid = threadIdx.x; asm volatile("" : "+v"(tid)); const int lane = tid & 63, wave = __builtin_amdgcn_readfirstlane(tid >> 6);
    const int gw = blockIdx.x * 8 + wave, NGW = G * 8, t = lane & 15, iq = lane >> 4;
    const float* __restrict__ YF = (const float*)(a.ws + WS_YF); const float* __restrict__ YB = (const float*)(a.ws + WS_YB); const float* __restrict__ BON = (const float*)(a.ws + WS_BON);
    const bf16_t* __restrict__ Vg = (const bf16_t*)scan_arr(a.ws, 0); const bf16_t* __restrict__ Gg = (const bf16_t*)(a.ws + WS_G); bf16_t* __restrict__ MIX = (bf16_t*)(a.ws + WS_MIX);
    float* ss = (float*)(a.ws + WS_SS);
    for (int i = blockIdx.x * NTHREADS + tid; i < T; i += G * NTHREADS) ss[i] = 0.f;
    constexpr int NIT = (T / 16) * NH;
#pragma unroll 1
    for (int it = gw; it < NIT; it += NGW) {
        const int tile = it / NH, hd = it - tile * NH, tok = tile * 16 + t;
        const float* yfp = YF + ((size_t)it * 64 + 16 * iq) * 16 + t; const float* ybp = YB + ((size_t)it * 64 + 16 * iq) * 16 + (15 - t);
        float y[16];
#pragma unroll
        for (int k = 0; k < 16; ++k) y[k] = yfp[k * 16] + ybp[k * 16];
        const u32x4 v0 = *(const u32x4*)(Vg + ((size_t)it * 16 + t) * 64 + 16 * iq), v1 = *(const u32x4*)(Vg + ((size_t)it * 16 + t) * 64 + 16 * iq + 8);
        const u32x4 g0 = *(const u32x4*)(Gg + (size_t)tok * RW + hd * 64 + 16 * iq), g1 = *(const u32x4*)(Gg + (size_t)tok * RW + hd * 64 + 16 * iq + 8);
        const float bon = BON[(size_t)tok * NH + hd] + BON[(size_t)T * NH + (size_t)tok * NH + hd];
        float sm = 0.f;
#pragma unroll
        for (int k = 0; k < 16; ++k) sm += y[k];
        sm += __shfl_xor(sm, 16); sm += __shfl_xor(sm, 32);
        const float mean = sm * (1.f / 64.f); float vs = 0.f;
#pragma unroll
        for (int k = 0; k < 16; ++k) { y[k] -= mean; vs += y[k] * y[k]; }
        vs += __shfl_xor(vs, 16); vs += __shfl_xor(vs, 32);
        const float rstd = 1.0f / sqrtf(vs * (1.f / 64.f) + 64e-5f);
        const unsigned vw[8] = {v0.x, v0.y, v0.z, v0.w, v1.x, v1.y, v1.z, v1.w}, gwd[8] = {g0.x, g0.y, g0.z, g0.w, g1.x, g1.y, g1.z, g1.w};
        unsigned ow[8];
#pragma unroll
        for (int k2 = 0; k2 < 8; ++k2) { const int ch = hd * 64 + 16 * iq + 2 * k2;
            const float o0 = (y[2 * k2] * rstd * a.in[I_LNXG][ch] + a.in[I_LNXB][ch] + bon * bf_lo(vw[k2])) * bf_lo(gwd[k2]);
            const float o1 = (y[2 * k2 + 1] * rstd * a.in[I_LNXG][ch + 1] + a.in[I_LNXB][ch + 1] + bon * bf_hi(vw[k2])) * bf_hi(gwd[k2]);
            ow[k2] = pk_bf16(o0, o1); }
        bf16_t* op = MIX + (size_t)tok * D + 640 + hd * 64 + 16 * iq;
        *(u32x4*)op = (u32x4){ow[0], ow[1], ow[2], ow[3]}; *(u32x4*)(op + 8) = (u32x4){ow[4], ow[5], ow[6], ow[7]};
    }
}

constexpr int RT_WS = 2064;
__device__ __forceinline__ void phase_router(const Args& a, LAS unsigned char* lds, int G) {
    int tid = threadIdx.x; asm volatile("" : "+v"(tid)); const int lane = tid & 63, wave = __builtin_amdgcn_readfirstlane(tid >> 6);
    const int gw = blockIdx.x * 8 + wave, NGW = G * 8, l15 = lane & 15, kq = lane >> 4;
    LAS bf16_t* WH = (LAS bf16_t*)lds; LAS bf16_t* WL = (LAS bf16_t*)(lds + 16 * RT_WS);
    for (int i = tid; i < D * NE; i += NTHREADS) { const int k = i >> 4, e = i & 15; const float w = a.in[I_WROUTER][i];
        const unsigned hi = pk_bf16(w, 0.f) & 0xffffu; const float rem = w - bf_lo(hi);
        WH[e * (RT_WS / 2) + k] = (bf16_t)hi; WL[e * (RT_WS / 2) + k] = (bf16_t)(pk_bf16(rem, 0.f) & 0xffffu); }
    __syncthreads();
    const float* __restrict__ X1 = (const float*)(a.ws + WS_X1); const float* __restrict__ ss = (const float*)(a.ws + WS_SS); bf16_t* __restrict__ H2 = (bf16_t*)(a.ws + WS_H2);
    float* __restrict__ AFF = (float*)(a.ws + WS_AFF); int* __restrict__ INV = (int*)(a.ws + WS_INV);
    const float* __restrict__ GF = a.in[I_NFFNG];
    for (int grp = gw; grp < T / 16; grp += NGW) {
        const int tok = grp * 16 + l15;
        const float rs = 1.0f / sqrtf(ss[tok] * (1.f / D) + 1e-6f);
        f32x4 acc = {0.f, 0.f, 0.f, 0.f};
        const float* xrow = X1 + (size_t)tok * D + 8 * kq; unsigned char* hrow8 = (unsigned char*)H2 + (size_t)tok * D + 8 * kq;
#pragma unroll 8
        for (int ks = 0; ks < 32; ++ks) {
            const f32x4 x0 = *(const f32x4*)(xrow + 32 * ks), x1v = *(const f32x4*)(xrow + 32 * ks + 4);
            const f32x4 g0 = *(const f32x4*)(GF + 32 * ks + 8 * kq), g1 = *(const f32x4*)(GF + 32 * ks + 8 * kq + 4);
            const f32x4 h0 = x0 * rs * g0, h1 = x1v * rs * g1;
            u32x4 hi; hi.x = pk_bf16(h0.x, h0.y); hi.y = pk_bf16(h0.z, h0.w); hi.z = pk_bf16(h1.x, h1.y); hi.w = pk_bf16(h1.z, h1.w);
            *(u32x2*)(hrow8 + 32 * ks) = (u32x2){pk_fp8x4(h0.x, h0.y, h0.z, h0.w), pk_fp8x4(h1.x, h1.y, h1.z, h1.w)};
            u32x4 lo; lo.x = pk_bf16(h0.x - bf_lo(hi.x), h0.y - bf_hi(hi.x)); lo.y = pk_bf16(h0.z - bf_lo(hi.y), h0.w - bf_hi(hi.y));
            lo.z = pk_bf16(h1.x - bf_lo(hi.z), h1.y - bf_hi(hi.z)); lo.w = pk_bf16(h1.z - bf_lo(hi.w), h1.w - bf_hi(hi.w));
            const bf16x8 ah = __builtin_bit_cast(bf16x8, hi), al = __builtin_bit_cast(bf16x8, lo);
            const bf16x8 bh = *(const LAS bf16x8*)(lds + l15 * RT_WS + (32 * ks + 8 * kq) * 2), bl = *(const LAS bf16x8*)(lds + 16 * RT_WS + l15 * RT_WS + (32 * ks + 8 * kq) * 2);
            acc = __builtin_amdgcn_mfma_f32_16x16x32_bf16(ah, bh, acc, 0, 0, 0);
            acc = __builtin_amdgcn_mfma_f32_16x16x32_bf16(al, bh, acc, 0, 0, 0);
            acc = __builtin_amdgcn_mfma_f32_16x16x32_bf16(ah, bl, acc, 0, 0, 0);
        }
#pragma unroll
        for (int rg = 0; rg < 4; ++rg) { const float mx = max16(acc[rg]); const float ex = __expf(acc[rg] - mx); const float sm = sum16(ex);
            const int t2 = grp * 16 + 4 * kq + rg, bb = t2 >> 12, sq = t2 & (SEQ - 1);
            AFF[((size_t)(bb * NE + l15)) * SEQ + sq] = ex / sm; }
        *(u32x4*)(INV + (size_t)grp * 256 + 4 * lane) = (u32x4){0xffffffffu, 0xffffffffu, 0xffffffffu, 0xffffffffu};
    }
}

__device__ __forceinline__ void topk_unit(const Args& a, LAS unsigned char* lds, int unit) {
    int tid = threadIdx.x; asm volatile("" : "+v"(tid)); const int lane = tid & 63, wave = __builtin_amdgcn_readfirstlane(tid >> 6);
    const int b = unit >> 4, e = unit & 15;
    const float* AFF = (const float*)(a.ws + WS_AFF) + (size_t)unit * SEQ;
    LAS unsigned* KEY = (LAS unsigned*)lds;
    LAS unsigned* HIST = (LAS unsigned*)(lds + 16384);
    LAS unsigned* CTL = (LAS unsigned*)(lds + 16384 + 1024);
    LAS unsigned* WS_ = (LAS unsigned*)(lds + 16384 + 2048);
    __syncthreads();
    unsigned key[8];
    { const u32x4 k0 = *(const u32x4*)(AFF + tid * 8), k1 = *(const u32x4*)(AFF + tid * 8 + 4); key[0] = k0.x; key[1] = k0.y; key[2] = k0.z; key[3] = k0.w; key[4] = k1.x; key[5] = k1.y; key[6] = k1.z; key[7] = k1.w; }
    if (tid == 0) { CTL[0] = 0u; CTL[1] = (unsigned)CAP; }
    unsigned prefix = 0u, mask = 0u;
#pragma unroll 1
    for (int pass = 0; pass < 4; ++pass) {
        const int shift = 24 - 8 * pass;
        if (tid < 256) HIST[tid] = 0u;
        __syncthreads();
#pragma unroll
        for (int i = 0; i < 8; ++i) if ((key[i] & mask) == prefix) (void)__hip_atomic_fetch_add(&HIST[(key[i] >> shift) & 255u], 1u, __ATOMIC_RELAXED, __HIP_MEMORY_SCOPE_WORKGROUP);
        __syncthreads();
        if (wave == 0) {
            const unsigned need = CTL[1];
            unsigned hv[4], tsum = 0u;
#pragma unroll
            for (int i = 0; i < 4; ++i) { hv[i] = HIST[255 - (4 * lane + i)]; tsum += hv[i]; }
            unsigned inc = tsum;
#pragma unroll
            for (int o = 1; o < 64; o <<= 1) { const unsigned v = __shfl_up(inc, o); if (lane >= o) inc += v; }
            unsigned exc = inc - tsum;
            if (exc < need && need <= inc) {
                unsigned run = exc; int di = 0;
#pragma unroll
                for (int i = 0; i < 4; ++i) { if (run < need && need <= run + hv[i]) { di = i; break; } run += hv[i]; }
                const unsigned digit = 255u - (unsigned)(4 * lane + di);
                CTL[0] = prefix | (digit << shift); CTL[1] = need - run;
            }
        }
        __syncthreads();
        prefix = CTL[0]; mask |= (255u << shift);
    }
    const unsigned thr = prefix, need_eq = CTL[1];
    unsigned ngt = 0u, neq = 0u;
#pragma unroll
    for (int i = 0; i < 8; ++i) { ngt += (key[i] > thr) ? 1u : 0u; neq += (key[i] == thr) ? 1u : 0u; }
    unsigned pk = ngt | (neq << 16), inc = pk;
#pragma unroll
    for (int o = 1; o < 64; o <<= 1) { const unsigned v = __shfl_up(inc, o); if (lane >= o) inc += v; }
    if (lane == 63) WS_[wave] = inc;
    __syncthreads();
    unsigned woff = 0u, tot = 0u;
#pragma unroll
    for (int w = 0; w < 8; ++w) { const unsigned v = WS_[w]; if (w < wave) woff += v; tot += v; }
    const unsigned exc = inc - pk + woff;
    unsigned gpos = exc & 0xffffu, epos = exc >> 16; const unsigned totgt = tot & 0xffffu;
    const int sbase = (e * BATCH + b) * CAP;
    int* ROWTOK = (int*)(a.ws + WS_ROWTOK); float* ROWGATE = (float*)(a.ws + WS_ROWGATE); int* INV = (int*)(a.ws + WS_INV);
#pragma unroll
    for (int i = 0; i < 8; ++i) {
        int pos = -1;
        if (key[i] > thr) pos = (int)gpos++;
        else if (key[i] == thr) { if (epos < need_eq) pos = (int)(totgt + epos); epos++; }
        if (pos >= 0) { const int s = tid * 8 + i, tok = b * SEQ + s, slot = sbase + pos;
            ROWTOK[slot] = tok; ROWGATE[slot] = __builtin_bit_cast(float, key[i]); INV[(size_t)tok * NE + e] = slot; }
    }
}

__device__ __forceinline__ void phase_final(const Args& a, int G) {
    int tid = threadIdx.x; asm volatile("" : "+v"(tid)); const int lane = tid & 63, wave = __builtin_amdgcn_readfirstlane(tid >> 6);
    const int gw = blockIdx.x * 8 + wave, NGW = G * 8;
    const float* __restrict__ X1 = (const float*)(a.ws + WS_X1); const bf16_t* __restrict__ YE = (const bf16_t*)(a.ws + WS_YE); const int* __restrict__ INV = (const int*)(a.ws + WS_INV);
    float* __restrict__ OUT = a.out;
    f32x4 gg[4];
#pragma unroll
    for (int j = 0; j < 4; ++j) gg[j] = *(const f32x4*)(a.in[I_FNG] + 4 * lane + 256 * j);
    int tok = gw;
    int invn = (tok < T) ? INV[(size_t)tok * NE + (lane & 15)] : -1;
    f32x4 xn[4];
#pragma unroll
    for (int j = 0; j < 4; ++j) xn[j] = (tok < T) ? *(const f32x4*)(X1 + (size_t)tok * D + 4 * lane + 256 * j) : (f32x4){0.f, 0.f, 0.f, 0.f};
    for (; tok < T; tok += NGW) {
        const int invc = invn; f32x4 v[4];
#pragma unroll
        for (int j = 0; j < 4; ++j) v[j] = xn[j];
        const int tn = tok + NGW;
        if (tn < T) { invn = INV[(size_t)tn * NE + (lane & 15)];
#pragma unroll
            for (int j = 0; j < 4; ++j) xn[j] = *(const f32x4*)(X1 + (size_t)tn * D + 4 * lane + 256 * j); }
        unsigned long long m = __ballot(invc >= 0) & 0xffffull;
        const int n = __builtin_popcountll(m);
        int sl[4]; float wt[4];
#pragma unroll
        for (int k = 0; k < 4; ++k) { int e = 0; if (m) { e = __builtin_ctzll(m); m &= m - 1; wt[k] = 1.f; sl[k] = __builtin_amdgcn_readlane(invc, e); } else { wt[k] = 0.f; sl[k] = 0; } }
        u32x2 rw[4][4];
#pragma unroll
        for (int k = 0; k < 4; ++k)
#pragma unroll
            for (int j = 0; j < 4; ++j) rw[k][j] = *(const u32x2*)(YE + (size_t)sl[k] * D + 4 * lane + 256 * j);
#pragma unroll
        for (int k = 0; k < 4; ++k)
#pragma unroll
            for (int j = 0; j < 4; ++j) { v[j].x += wt[k] * bf_lo(rw[k][j].x); v[j].y += wt[k] * bf_hi(rw[k][j].x); v[j].z += wt[k] * bf_lo(rw[k][j].y); v[j].w += wt[k] * bf_hi(rw[k][j].y); }
        if (n > 4) { while (m) { const int e = __builtin_ctzll(m); m &= m - 1; const int slot = __builtin_amdgcn_readlane(invc, e);
#pragma unroll
                for (int j = 0; j < 4; ++j) { const u32x2 w = *(const u32x2*)(YE + (size_t)slot * D + 4 * lane + 256 * j);
                    v[j].x += bf_lo(w.x); v[j].y += bf_hi(w.x); v[j].z += bf_lo(w.y); v[j].w += bf_hi(w.y); } } }
        float sq = 0.f;
#pragma unroll
        for (int j = 0; j < 4; ++j) sq += (v[j].x * v[j].x + v[j].y * v[j].y) + (v[j].z * v[j].z + v[j].w * v[j].w);
        float rs = 1.0f / sqrtf(wave_sum(sq) * (1.f / D) + 1e-6f);
#pragma unroll
        for (int j = 0; j < 4; ++j) *(f32x4*)(OUT + (size_t)tok * D + 4 * lane + 256 * j) = v[j] * rs * gg[j];
    }
}

#define XB_TMO      128
#define XB_XCNT(j)  (256  + 64 * (j))
#define XB_XSUB(j)  (1280 + 64 * (j))
#define XB_XGEN(j)  (2304 + 64 * (j))
#define XB_TOP      3328
#define XB_TOPGEN   3392
#define XCD_BAR_WORDS 3456
#define XB_SPIN_CAP (1u << 22)
__device__ __forceinline__ unsigned xb_ld(unsigned* p)              { return __hip_atomic_load(p, __ATOMIC_RELAXED, __HIP_MEMORY_SCOPE_AGENT); }
__device__ __forceinline__ unsigned xb_add(unsigned* p, unsigned v) { return __hip_atomic_fetch_add(p, v, __ATOMIC_RELAXED, __HIP_MEMORY_SCOPE_AGENT); }
__device__ __forceinline__ unsigned xb_xcc_id() { return (unsigned)__builtin_amdgcn_s_getreg((3 << 11) | 20) & 0xFu; }
#define XB_SPIN(cond, bar) do { unsigned _sp = 0; while (cond) { __builtin_amdgcn_s_sleep(1); \
    if ((++_sp & 255u) == 0u) { if (xb_ld(&(bar)[XB_TMO])) break; if (_sp > XB_SPIN_CAP) { atomicAdd(&(bar)[XB_TMO], 1u); break; } } } } while (0)
struct XcdBarrier { unsigned* bar; unsigned x; volatile LAS unsigned* st; };
__device__ __forceinline__ XcdBarrier xcd_barrier_post(unsigned* bar, volatile LAS unsigned* st) {
    XcdBarrier b; b.bar = bar; b.x = xb_xcc_id(); b.st = st;
    if (threadIdx.x == 0) (void)xb_add(&bar[XB_XCNT(b.x)], 1u);
    return b;
}
__device__ __forceinline__ void xcd_barrier_complete(unsigned* bar, unsigned x, unsigned& nloc, unsigned& nx) {
    const unsigned G = gridDim.x * gridDim.y * gridDim.z;
    unsigned sum, cnt, mine, sp = 0u;
    for (;;) {
        sum = 0u; cnt = 0u; mine = 0u;
#pragma unroll
        for (unsigned j = 0; j < 16; ++j) { const unsigned c = xb_ld(&bar[XB_XCNT(j)]); sum += c; cnt += (c > 0u) ? 1u : 0u; mine = (j == x) ? c : mine; }
        if (sum == G) break;
        __builtin_amdgcn_s_sleep(1);
        if ((++sp & 255u) == 0u) { if (xb_ld(&bar[XB_TMO])) break; if (sp > XB_SPIN_CAP) { atomicAdd(&bar[XB_TMO], 1u); break; } }
    }
    nloc = mine > 0u ? mine : 1u; nx = cnt > 0u ? cnt : 1u;
}
__device__ __forceinline__ void xcd_barrier(const XcdBarrier& b) {
    asm volatile("s_waitcnt vmcnt(0)" ::: "memory");
    __syncthreads();
    if (threadIdx.x == 0) {
        unsigned* bar = b.bar;
        __builtin_amdgcn_s_waitcnt(0);
        unsigned nloc = b.st[0], nx = b.st[1];
        if (nloc == 0u) { xcd_barrier_complete(bar, b.x, nloc, nx); b.st[0] = nloc; b.st[1] = nx; }
        const unsigned old = xb_add(&bar[XB_XSUB(b.x)], 1u);
        const unsigned gen = old / nloc;
        if (old + 1u == (gen + 1u) * nloc) {
            __builtin_amdgcn_fence(__ATOMIC_RELEASE, "agent");
            asm volatile("s_waitcnt vmcnt(0)" ::: "memory");
            const unsigned og = xb_add(&bar[XB_TOP], 1u);
            const unsigned tg = og / nx;
            if (og + 1u == (tg + 1u) * nx) xb_add(&bar[XB_TOPGEN], 1u);
            else XB_SPIN(xb_ld(&bar[XB_TOPGEN]) == tg, bar);
            __builtin_amdgcn_fence(__ATOMIC_ACQUIRE, "agent");
            xb_add(&bar[XB_XGEN(b.x)], 1u);
            asm volatile("s_waitcnt vmcnt(0)" ::: "memory");
        } else {
            XB_SPIN(xb_ld(&bar[XB_XGEN(b.x)]) == gen, bar);
            __builtin_amdgcn_fence(__ATOMIC_ACQUIRE, "agent");
            asm volatile("s_waitcnt vmcnt(0)" ::: "memory");
        }
    }
    __syncthreads();
}

#ifndef PH_MASK
#define PH_MASK 0x7ff
#endif
#ifndef REP_MASK
#define REP_MASK 0
#endif
#ifndef P2_MASK
#define P2_MASK 7
#endif
#ifndef P2_REP
#define P2_REP 0
#endif
constexpr int LDS_MISC = LDS_BYTES - 64;
constexpr int LDS_PTAB = LDS_BYTES - 512;
__device__ __forceinline__ Args load_args(LAS unsigned char* lds, int lo, int hi) {
    Args r; const LAS u32x2* t = (const LAS u32x2*)(lds + LDS_PTAB);
#pragma unroll
    for (int i = 0; i < 31; ++i) { const u32x2 v = t[i]; const unsigned long long p = ((unsigned long long)(unsigned)__builtin_amdgcn_readfirstlane((int)v.y) << 32) | (unsigned)__builtin_amdgcn_readfirstlane((int)v.x);
        if (i < 29) r.in[i] = (const float*)p; else if (i == 29) r.out = (float*)p; else r.ws = (unsigned char*)p; }
    r.ph_lo = lo; r.ph_hi = hi; return r;
}
constexpr size_t WS_CTL = 0, CTL_BYTES = 16384;
__global__ void __launch_bounds__(NTHREADS, 2) mega(Args a0) {
    extern __shared__ __attribute__((aligned(16))) unsigned char lds_raw[];
    LAS unsigned char* lds = (LAS unsigned char*)lds_raw;
    cg::grid_group grid = cg::this_grid();
    const int G = gridDim.x, lo = a0.ph_lo, hi = a0.ph_hi;
    volatile LAS unsigned* misc = (volatile LAS unsigned*)(lds + LDS_MISC);
    if (threadIdx.x < 16) misc[threadIdx.x] = 0u;
    if (threadIdx.x == 0) { LAS unsigned long long* t = (LAS unsigned long long*)(lds + LDS_PTAB);
#pragma unroll
        for (int i = 0; i < 29; ++i) t[i] = (unsigned long long)a0.in[i];
        t[29] = (unsigned long long)a0.out; t[30] = (unsigned long long)a0.ws; }
    __syncthreads();
    if (lo < -1000) grid.sync();
    XcdBarrier xbar = xcd_barrier_post((unsigned*)(a0.ws + WS_CTL), misc);
#define IN(k) (((PH_MASK >> (k)) & 1) && lo <= (k) && (k) < hi)
#define NREP(k) (1 + ((REP_MASK >> (k)) & 1))
#define PHASE(k, ...) do { if (IN(k)) { for (int rep_ = 0; rep_ < NREP(k); ++rep_) { { const Args a = load_args(lds, lo, hi); unsigned char* const ws = a.ws; (void)ws; __VA_ARGS__; } if (rep_ + 1 < NREP(k) || IN((k) + 1)) { xcd_barrier(xbar); } } } } while (0)

    PHASE(0, phase_prep(a, lds, G));

    PHASE(1, {
        pg8::Gemm g{(const bf16_t*)(ws + WS_XH), (const bf16_t*)(ws + WS_WINT), T, IN_PROJ, D, 0, 0};
        pg8::TripleOrder S; S.S0.init(T, IN_PROJ, G, 0); S.A1 = (const bf16_t*)(ws + WS_MEMN); S.B1 = (const bf16_t*)(ws + WS_WKT); S.A2 = (const bf16_t*)(ws + WS_WVT); S.B2 = (const bf16_t*)(ws + WS_MEMN);
        S.n1 = BATCH * NMEM / 256; S.n2 = BATCH * NMEM / 256; S.G = G; S.c = (int)blockIdx.x;
        pg8::EpiBf16x3 E{pg8::EpiBf16{(bf16_t*)(ws + WS_P), PLD, (bf16_t*)(ws + WS_Q)}, pg8::EpiBf16{(bf16_t*)(ws + WS_KMEM), 256, nullptr}, pg8::EpiBf16{(bf16_t*)(ws + WS_VT), BATCH * NMEM, nullptr}};
        pg8::gemm_phase<pg8::EpiBf16x3, pg8::TripleOrder, false>(lds, g, S, E, nullptr);
    });

    constexpr int NSCAN = BATCH * NH * 2;
    PHASE(2, {
        for (int u = blockIdx.x; u < 2048; u += G) {
            if (u < 1024) { for (int r2 = 0; r2 < 1 + ((P2_REP >> 1) & 1); ++r2) conv_unit(a, lds, u); }
            else { for (int r2 = 0; r2 < 1 + ((P2_REP >> 2) & 1); ++r2) prep_unit(a, lds, u - 1024); }
        }
    });

    PHASE(3, {
        int bid = blockIdx.x; int Gp = G; asm volatile("" : "+s"(bid), "+s"(Gp));
        for (int u = bid; u < NSCAN; u += Gp) scan_chunked_unit(a, lds, u);
        if (rep_ == 0) {
            if (Gp > NSCAN) { if (bid >= NSCAN) { for (int u = bid - NSCAN; u < 64; u += Gp - NSCAN) for (int r2 = 0; r2 < 1 + (P2_REP & 1); ++r2) attn_unit(a, lds, u);
                                                 } }
            else { for (int u = bid; u < 64; u += Gp) attn_unit(a, lds, u); }
        }
    });

    PHASE(4, phase_post(a, G));

    PHASE(5, {
        pg8::Gemm g{(const bf16_t*)(ws + WS_MIX), (const bf16_t*)(ws + WS_WOUTT), T, D, D, 0, 0}; pg8::StaticOrder S; S.init(T, D, G, (int)blockIdx.x);
        pg8::EpiResidSS E{a.in[I_X], (float*)(ws + WS_X1), (float*)(ws + WS_SS)}; pg8::gemm_phase<pg8::EpiResidSS, pg8::StaticOrder, false>(lds, g, S, E, nullptr);
    });

    PHASE(6, phase_router(a, lds, G));

    PHASE(7, { for (int u = blockIdx.x; u < BATCH * NE; u += G) topk_unit(a, lds, u); });

    PHASE(8, {
        pg8::Gemm g{(const bf16_t*)(ws + WS_H2), (const bf16_t*)(ws + WS_WGUT), NSLOT, 2048, D / 2, 0x7A7A7A7A, 0x7F7F7F7F};     pg8::ExpertOrder S; S.init(32, 8, NE, G, (int)blockIdx.x);
        pg8::EpiSwiGLU E{(bf16_t*)(ws + WS_HID)}; pg8::gemm_phase<pg8::EpiSwiGLU, pg8::ExpertOrder, true, false, true>(lds, g, S, E, (const int*)(ws + WS_ROWTOK));
    });

    PHASE(9, {
        pg8::Gemm g{(const bf16_t*)(ws + WS_HID), (const bf16_t*)(ws + WS_WDT), NSLOT, D, FF / 2, 0x7A7A7A7A, 0x7C7C7C7C};     pg8::ExpertOrder S; S.init(32, 4, NE, G, (int)blockIdx.x);
        pg8::EpiGateScale E{(bf16_t*)(ws + WS_YE), (const float*)(ws + WS_ROWGATE)}; pg8::gemm_phase<pg8::EpiGateScale, pg8::ExpertOrder, false, true, true>(lds, g, S, E, nullptr);
    });

    PHASE(10, phase_final(a, G));
#undef IN
#undef NREP
#undef PHASE
}

#ifndef MK_ONE_LAUNCH
#define MK_ONE_LAUNCH 1
#endif
extern "C" void kernel_launch(void* const* d_in, const int* in_sizes, int n_in, void* d_out, int out_size, void* d_ws, size_t ws_size, hipStream_t stream) {
    static int grid_blocks = 0;
    if (grid_blocks == 0) {
        if (n_in != 29 || out_size != T * D || ws_size < WS_END) { fprintf(stderr, "kernel_launch: unexpected problem: n_in %d out %d ws %zu (need %zu)\n", n_in, out_size, ws_size, (size_t)WS_END); grid_blocks = -1; return; }
        int dev = 0, cus = 0, per_cu = 0;
        if (hipGetDevice(&dev) != hipSuccess || hipDeviceGetAttribute(&cus, hipDeviceAttributeMultiprocessorCount, dev) != hipSuccess) { grid_blocks = -1; return; }
        if (hipFuncSetAttribute((const void*)mega, hipFuncAttributeMaxDynamicSharedMemorySize, LDS_BYTES) != hipSuccess) { fprintf(stderr, "kernel_launch: hipFuncSetAttribute failed\n"); grid_blocks = -1; return; }
        if (hipOccupancyMaxActiveBlocksPerMultiprocessor(&per_cu, (const void*)mega, NTHREADS, LDS_BYTES) != hipSuccess || per_cu < 1) { fprintf(stderr, "kernel_launch: occupancy query says %d blocks per CU\n", per_cu); grid_blocks = -1; return; }
        grid_blocks = cus;
    }
    if (grid_blocks < 0) return;
    if (hipMemsetAsync((char*)d_ws + WS_CTL, 0, CTL_BYTES, stream) != hipSuccess) { fprintf(stderr, "kernel_launch: memset failed\n"); return; }
    Args a{};
    for (int i = 0; i < 29; ++i) a.in[i] = (const float*)d_in[i];
    a.out = (float*)d_out; a.ws = (unsigned char*)d_ws;
#if MK_ONE_LAUNCH
    a.ph_lo = 0; a.ph_hi = NPHASE;
    { void* args[] = {&a}; hipError_t e = hipLaunchCooperativeKernel((const void*)mega, dim3(grid_blocks), dim3(NTHREADS), args, LDS_BYTES, stream);
      if (e != hipSuccess) fprintf(stderr, "cooperative launch failed: %s (grid %d)\n", hipGetErrorString(e), grid_blocks); }
#else
    for (int ph = 0; ph < NPHASE; ++ph) { a.ph_lo = ph; a.ph_hi = ph + 1; void* args[] = {&a};
        hipError_t e = hipLaunchCooperativeKernel((const void*)mega, dim3(grid_blocks), dim3(NTHREADS), args, LDS_BYTES, stream);
        if (e != hipSuccess) { fprintf(stderr, "cooperative launch %d failed: %s (grid %d)\n", ph, hipGetErrorString(e), grid_blocks); break; } }
#endif
}
```

```cpp
#include <hip/hip_runtime.h>
#include <hip/hip_cooperative_groups.h>
#include <cstdio>
#include <cstdint>
namespace cg = cooperative_groups;

#define LAS __attribute__((address_space(3)))
typedef unsigned short bf16_t;
typedef short bf16x8 __attribute__((ext_vector_type(8)));
typedef short s16x4 __attribute__((ext_vector_type(4)));
typedef float f32x2 __attribute__((ext_vector_type(2)));
typedef float f32x4 __attribute__((ext_vector_type(4)));
typedef float f32x16 __attribute__((ext_vector_type(16)));
typedef unsigned u32x2 __attribute__((ext_vector_type(2)));
typedef unsigned u32x4 __attribute__((ext_vector_type(4)));
typedef _Float16 f16x4 __attribute__((ext_vector_type(4)));
typedef __bf16 bf16v2 __attribute__((ext_vector_type(2)));
typedef int v8i __attribute__((ext_vector_type(8)));
typedef int v4i __attribute__((ext_vector_type(4)));

constexpr int D = 1024, BATCH = 16, SEQ = 4096, T = BATCH * SEQ, NMEM = 256;
constexpr int IN_PROJ = 2560, CW = 384, RW = 384, NH = 6, NE = 16, FF = 1024, CAP = 512;
constexpr int NSLOT = NE * BATCH * CAP;
constexpr int NTHREADS = 512;
constexpr int LDS_BYTES = 160 * 1024;
constexpr int NPHASE = 11;
#ifndef SCAN_MODE
#define SCAN_MODE 1
#endif

constexpr size_t MiB = 1u << 20;
constexpr size_t WS_WINT = 1 * MiB;
constexpr size_t WS_WOUTT = 6 * MiB;
constexpr size_t WS_WKT = 8 * MiB;
constexpr size_t WS_WVT = 8 * MiB + 512 * 1024;
constexpr size_t WS_SMALL = 9 * MiB;
constexpr size_t WS_WGUT = 10 * MiB;
constexpr size_t WS_WDT = 74 * MiB;
constexpr size_t WS_KMEM = 106 * MiB;
constexpr size_t WS_VT = 108 * MiB;
constexpr size_t WS_ROWTOK = 106 * MiB;
constexpr size_t WS_ROWGATE = 106 * MiB + 512 * 1024;
constexpr size_t WS_SS = 107 * MiB;
constexpr size_t WS_P = 112 * MiB;
constexpr size_t WS_YF = 112 * MiB;
constexpr size_t WS_YB = 208 * MiB;
constexpr size_t WS_X1 = 112 * MiB;
constexpr size_t WS_XH = 432 * MiB;
constexpr size_t WS_G = 432 * MiB;
constexpr size_t WS_BON = 480 * MiB;
constexpr size_t WS_Q = 400 * MiB;
constexpr int PLD = IN_PROJ - 256;
constexpr size_t WS_H2 = 432 * MiB;
constexpr size_t WS_MEMN = 560 * MiB;
constexpr size_t WS_MIX = 560 * MiB;
constexpr size_t WS_SCAN = 688 * MiB;
constexpr size_t SCAN_STRIDE = 48 * MiB;
constexpr size_t WS_SCAN7 = 496 * MiB;
constexpr size_t WS_PC = 484 * MiB;
__device__ __forceinline__ unsigned char* scan_arr(unsigned char* ws, int a) { return a < 7 ? ws + WS_SCAN + (size_t)a * SCAN_STRIDE : (a == 7 ? ws + WS_SCAN7 : ws + 560 * MiB + 640 * 2); }
__device__ __forceinline__ int scan_pitch(int a) { return a == 8 ? D : 384; }
__device__ __forceinline__ size_t hat_off(int a, size_t tok, int ch) { return a == 8 ? tok * D + ch : ((((tok >> 4) * NH + (ch >> 6)) << 10) + ((tok & 15) << 6) + (ch & 63)); }
constexpr size_t WS_AFF = 624 * MiB;
constexpr size_t WS_INV = 628 * MiB;
constexpr size_t WS_HID = 768 * MiB;
constexpr size_t WS_YE = 368 * MiB;
constexpr size_t WS_END = 1024 * MiB;

__device__ __forceinline__ unsigned pk_bf16(float lo, float hi) { f32x2 v = {lo, hi}; bf16v2 b = __builtin_convertvector(v, bf16v2); return __builtin_bit_cast(unsigned, b); }
__device__ __forceinline__ unsigned pk_fp8x4(float a, float b, float c, float d) { int w = 0; w = __builtin_amdgcn_cvt_pk_fp8_f32(a, b, w, false); w = __builtin_amdgcn_cvt_pk_fp8_f32(c, d, w, true); return (unsigned)w; }
__device__ __forceinline__ float bf_lo(unsigned u) { return __builtin_bit_cast(float, u << 16); }
__device__ __forceinline__ float bf_hi(unsigned u) { return __builtin_bit_cast(float, u & 0xffff0000u); }
__device__ __forceinline__ float wave_sum(float v) {
#pragma unroll
    for (int o = 1; o < 64; o <<= 1) v += __shfl_xor(v, o);
    return v;
}
__device__ __forceinline__ float sigmoidf_fast(float x) { return __builtin_amdgcn_rcpf(1.0f + __builtin_amdgcn_exp2f(-1.4426950408889634f * x)); }
template <int CTRL> __device__ __forceinline__ float dpp_f(float x) { return __builtin_bit_cast(float, __builtin_amdgcn_update_dpp(0, __builtin_bit_cast(int, x), CTRL, 0xF, 0xF, true)); }
__device__ __forceinline__ float sum8(float x) { x += dpp_f<0xB1>(x); x += dpp_f<0x4E>(x); x += dpp_f<0x141>(x); return x; }
__device__ __forceinline__ float sum16(float x) { x = sum8(x); x += dpp_f<0x140>(x); return x; }
__device__ __forceinline__ float max16(float x) { x = fmaxf(x, dpp_f<0xB1>(x)); x = fmaxf(x, dpp_f<0x4E>(x)); x = fmaxf(x, dpp_f<0x141>(x)); x = fmaxf(x, dpp_f<0x140>(x)); return x; }

typedef short v4i16g __attribute__((__vector_size__(8)));
__device__ __forceinline__ s16x4 tr_read16(LAS unsigned char* p) { v4i16g r = __builtin_amdgcn_ds_read_tr16_b64_v4i16((LAS v4i16g*)p); return __builtin_bit_cast(s16x4, r); }
__device__ __forceinline__ f32x4 bf4_to_f32(u32x2 w) { return (f32x4){bf_lo(w.x), bf_hi(w.x), bf_lo(w.y), bf_hi(w.y)}; }
__device__ __forceinline__ u32x2 f32_to_bf4(f32x4 v) { return (u32x2){pk_bf16(v.x, v.y), pk_bf16(v.z, v.w)}; }
__device__ __forceinline__ bf16x8 frag_lo4(f32x4 v) { const u32x4 w = {pk_bf16(v.x, v.y), pk_bf16(v.z, v.w), 0u, 0u}; return __builtin_bit_cast(bf16x8, w); }
__device__ __forceinline__ bf16x8 frag_cat(u32x2 a, u32x2 b) { const u32x4 w = {a.x, a.y, b.x, b.y}; return __builtin_bit_cast(bf16x8, w); }
#define MFMA16(a, b, c) __builtin_amdgcn_mfma_f32_16x16x32_bf16((a), (b), (c), 0, 0, 0)

__device__ __forceinline__ int tid_of(int wv) { int l; asm volatile("v_mbcnt_lo_u32_b32 %0, -1, 0\n\tv_mbcnt_hi_u32_b32 %0, -1, %0" : "=v"(l)); return (wv << 6) | l; }
namespace pg8 {
#define PG8_LAS __attribute__((address_space(3)))
constexpr int BM = 256, BK = 64, HALF = 128, HTB = HALF * BK * 2, STAGE_BYTES = 8 * HTB, NXCD = 8, WGM = 8;
__host__ __device__ __forceinline__ int lds_byte(int r, int c) { const int st = (r >> 4) * 2 + (c >> 5), rr = r & 15, cc = c & 31, ob = rr * 64 + cc * 2; return st * 1024 + (ob ^ (((ob >> 9) & 1) << 5)); }
__host__ __device__ __forceinline__ void stage_rc(int b, int& R, int& C) { const int st = b / 1024, sb = b % 1024, swz = sb ^ (((sb >> 9) & 1) << 5); R = (st >> 1) * 16 + swz / 64; C = (st & 1) * 32 + (swz % 64) / 2; }
__host__ __device__ __forceinline__ int perm32(int rho) { const int n = rho >> 4, i = rho & 15; return 8 * (i >> 2) + 4 * n + (i & 3); }

struct Unit { int pm, pn, gid; };
struct Gemm { const bf16_t* A; const bf16_t* Bt; int M, N, K; int sw, sx; };

struct StaticOrder {
    int nM, nN, nwg, G, c;
    __device__ void init(int M, int N, int G_, int c_) { nM = M / BM; nN = N / BM; nwg = nM * nN; G = G_; c = c_; }
    __device__ bool next(int i, Unit& u) const {
        const long L = (long)i * G + c; if (L >= nwg) return false;
        int wgid = (int)L; { const int q = nwg / NXCD, r = nwg % NXCD, xcd = wgid % NXCD, off = wgid / NXCD; wgid = (xcd < r ? xcd * (q + 1) : r * (q + 1) + (xcd - r) * q) + off; }
        const int nig = WGM * nN, gid = wgid / nig, fm = gid * WGM, gsz = (nM - fm) < WGM ? (nM - fm) : WGM;
        u.pm = fm + ((wgid % nig) % gsz); u.pn = (wgid % nig) / gsz; u.gid = 0; return true;
    }
    __device__ __forceinline__ const char* aptr(const Gemm& g, const Unit& u, size_t tstep) const { return (const char*)g.A + (size_t)u.pm * tstep; }
    __device__ __forceinline__ const char* bptr(const Gemm& g, const Unit& u, size_t tstep) const { return (const char*)g.Bt + (size_t)u.pn * tstep; }
};
struct TripleOrder {
    StaticOrder S0; const bf16_t* A1; const bf16_t* B1; const bf16_t* A2; const bf16_t* B2; int n1, n2, G, c;
    __device__ bool next(int i, Unit& u) const {
        const long L = (long)i * G + c;
        if (L < n1) { u.pm = (int)L; u.pn = 0; u.gid = 1; return true; }
        if (L < n1 + n2) { u.pm = 0; u.pn = (int)(L - n1); u.gid = 2; return true; }
        const long L0 = L - n1 - n2; if (L0 >= S0.nwg) return false;
        StaticOrder T0 = S0; T0.c = (int)(L0 % G); return T0.next((int)(L0 / G), u);
    }
    __device__ __forceinline__ const char* aptr(const Gemm& g, const Unit& u, size_t tstep) const { return (const char*)(u.gid == 0 ? g.A : (u.gid == 1 ? A1 : A2)) + (size_t)u.pm * tstep; }
    __device__ __forceinline__ const char* bptr(const Gemm& g, const Unit& u, size_t tstep) const { return (const char*)(u.gid == 0 ? g.Bt : (u.gid == 1 ? B1 : B2)) + (size_t)u.pn * tstep; }
};
struct ExpertOrder {
    int nMe, nNe, per, total, G, c;
    __device__ void init(int nMe_, int nNe_, int nExp, int G_, int c_) { nMe = nMe_; nNe = nNe_; per = nMe * nNe; total = per * nExp; G = G_; c = c_; }
    __device__ bool next(int i, Unit& u) const {
        const long L = (long)i * G + c; if (L >= total) return false;
        const int e = (int)(L / per), w = (int)(L % per), xl = w % 8, j = w / 8, rpx = nMe / 8;
        u.pm = e * nMe + xl * rpx + (j % rpx); u.pn = e * nNe + j / rpx; u.gid = 0; return true;
    }
    __device__ __forceinline__ const char* aptr(const Gemm& g, const Unit& u, size_t tstep) const { return (const char*)g.A + (size_t)u.pm * tstep; }
    __device__ __forceinline__ const char* bptr(const Gemm& g, const Unit& u, size_t tstep) const { return (const char*)g.Bt + (size_t)u.pn * tstep; }
};

struct EpiBf16 {
    static constexpr bool PERM = true;
    bf16_t* O; int ldc; bf16_t* Q0;
    __device__ __forceinline__ void operator()(const f32x4 (&acc)[2][2][4][2], const Unit& u, int wr, int wc, int fr, int fq) const {
        const bool redir = (Q0 != nullptr) && (u.pn == 0);
        bf16_t* base = redir ? Q0 : O; const int ld = redir ? 256 : ldc;
        const int row0 = u.pm * BM + wr * 64 + fr, col0 = (u.pn - ((Q0 != nullptr && !redir) ? 1 : 0)) * BM + wc * 32 + 8 * fq;
#pragma unroll
        for (int ai = 0; ai < 2; ++ai)
#pragma unroll
            for (int m = 0; m < 4; ++m) { bf16_t* rowp = base + (size_t)(row0 + ai * HALF + m * 16) * ld + col0;
#pragma unroll
                for (int bj = 0; bj < 2; ++bj) { const f32x4 v0 = acc[ai][bj][m][0], v1 = acc[ai][bj][m][1];
                    u32x4 w; w.x = pk_bf16(v0[0], v0[1]); w.y = pk_bf16(v0[2], v0[3]); w.z = pk_bf16(v1[0], v1[1]); w.w = pk_bf16(v1[2], v1[3]);
                    *(u32x4*)(rowp + bj * HALF) = w; } }
    }
};
struct EpiBf16x3 {
    static constexpr bool PERM = true;
    EpiBf16 E0, E1, E2;
    __device__ __forceinline__ void operator()(const f32x4 (&acc)[2][2][4][2], const Unit& u, int wr, int wc, int fr, int fq) const {
        if (u.gid == 0) E0(acc, u, wr, wc, fr, fq); else if (u.gid == 1) E1(acc, u, wr, wc, fr, fq); else E2(acc, u, wr, wc, fr, fq); }
};
struct EpiResidSS {
    static constexpr bool PERM = false;
    const float* X; float* X1; float* ss;
    __device__ __forceinline__ void operator()(const f32x4 (&acc)[2][2][4][2], const Unit& u, int wr, int wc, int fr, int fq) const {
        const int row0 = u.pm * BM + wr * 64 + fr, col0 = u.pn * BM + wc * 32 + 4 * fq;
#pragma unroll
        for (int ai = 0; ai < 2; ++ai)
#pragma unroll
            for (int m = 0; m < 4; ++m) { const int row = row0 + ai * HALF + m * 16; const size_t off = (size_t)row * D + col0; float s = 0.f;
#pragma unroll
                for (int bj = 0; bj < 2; ++bj)
#pragma unroll
                    for (int n = 0; n < 2; ++n) { const f32x4 xv = *(const f32x4*)(X + off + bj * HALF + n * 16); const f32x4 o = xv + acc[ai][bj][m][n];
                        *(f32x4*)(X1 + off + bj * HALF + n * 16) = o; s += (o[0] * o[0] + o[1] * o[1]) + (o[2] * o[2] + o[3] * o[3]); }
                s += __shfl_xor(s, 16); s += __shfl_xor(s, 32);
                if (fq == 0) (void)__hip_atomic_fetch_add(ss + row, s, __ATOMIC_RELAXED, __HIP_MEMORY_SCOPE_AGENT); }
    }
};
struct EpiSwiGLU {
    static constexpr bool PERM = true;
    bf16_t* H;
    __device__ __forceinline__ void operator()(const f32x4 (&acc)[2][2][4][2], const Unit& u, int wr, int wc, int fr, int fq) const {
        const int row0 = u.pm * BM + wr * 64 + fr, col0 = (u.pn & 7) * HALF + wc * 32 + 8 * fq;
#pragma unroll
        for (int ai = 0; ai < 2; ++ai)
#pragma unroll
            for (int m = 0; m < 4; ++m) { const int row = row0 + ai * HALF + m * 16; float h[8];
                unsigned char* rowp = (unsigned char*)H + ((((size_t)(row >> 8) * (FF / 128) + (col0 >> 7)) << 15) + ((row & 255) << 7) + (col0 & 127));
#pragma unroll
                for (int n = 0; n < 2; ++n)
#pragma unroll
                    for (int j = 0; j < 4; ++j) { const float gt = acc[ai][0][m][n][j], up = acc[ai][1][m][n][j]; h[n * 4 + j] = 8.0f * gt * sigmoidf_fast(gt) * up; }
                *(u32x2*)rowp = (u32x2){pk_fp8x4(h[0], h[1], h[2], h[3]), pk_fp8x4(h[4], h[5], h[6], h[7])}; }
    }
};
struct EpiGateScale {
    static constexpr bool PERM = true;
    bf16_t* Y; const float* gate;
    __device__ __forceinline__ void operator()(const f32x4 (&acc)[2][2][4][2], const Unit& u, int wr, int wc, int fr, int fq) const {
        const int row0 = u.pm * BM + wr * 64 + fr, col0 = (u.pn & 3) * BM + wc * 32 + 8 * fq;
#pragma unroll
        for (int ai = 0; ai < 2; ++ai)
#pragma unroll
            for (int m = 0; m < 4; ++m) { const int row = row0 + ai * HALF + m * 16; const float gs = gate[row]; bf16_t* rowp = Y + (size_t)row * D + col0;
#pragma unroll
                for (int bj = 0; bj < 2; ++bj) { const f32x4 v0 = acc[ai][bj][m][0] * gs, v1 = acc[ai][bj][m][1] * gs;
                    u32x4 w; w.x = pk_bf16(v0[0], v0[1]); w.y = pk_bf16(v0[2], v0[3]); w.z = pk_bf16(v1[0], v1[1]); w.w = pk_bf16(v1[2], v1[3]);
                    *(u32x4*)(rowp + bj * HALF) = w; } }
    }
};

template <class Epi, class Sched, bool GATHER, bool ATILED = false, bool FP8 = false>
__device__ __forceinline__ void gemm_phase(PG8_LAS unsigned char* lds, const Gemm g, const Sched& S, const Epi& E, const int* rowtok, const int wv) {
    int tid = tid_of(wv); asm volatile("" : "+v"(tid));
    const int wid = __builtin_amdgcn_readfirstlane(tid >> 6), lane = tid & 63, wr = wid >> 2, wc = wid & 3, fr = lane & 15, fq = lane >> 4;
    const int K = g.K, nt = K / BK;
    unsigned voffA0, voffB0;
    { int R, C; stage_rc(tid * 16, R, C); const int Rb = Epi::PERM ? ((R & ~31) + perm32(R & 31)) : R;
      voffA0 = ATILED ? (unsigned)(R * BK + C) * 2u : (unsigned)(R * K + C) * 2u; voffB0 = (unsigned)(Rb * K + C) * 2u; }
    const size_t dA = ATILED ? (size_t)64 * BK * 2 : (size_t)64 * K * 2, dB = (size_t)64 * K * 2;
    unsigned vAc[2][2], vAn[2][2];
    const size_t kstep = (size_t)(BK * 2);
    const size_t hstep = (size_t)HALF * K * 2;
    const size_t tstep = 2 * hstep;
    const size_t kstepA = ATILED ? (size_t)BM * BK * 2 : kstep, hstepA = ATILED ? (size_t)HALF * BK * 2 : hstep;
    const unsigned ldsw = (unsigned)wid * 1024u;
    const unsigned ldsbase = __builtin_amdgcn_readfirstlane((unsigned)(size_t)lds) + ldsw;
    const int aoff = lds_byte(wr * 64 + fr, fq * 8), boff = lds_byte(wc * 32 + fr, fq * 8);
#define PG8_SA(b, h) (((b) * 2 + (h)) * HTB)
#define PG8_SB(b, h) ((4 + (b) * 2 + (h)) * HTB)
#define PG8_GLDS(vo_, sb_, lo_) asm volatile("s_add_u32 m0, %2, %3\n\ts_nop 0\n\tglobal_load_lds_dwordx4 %0, %1" :: "v"(vo_), "s"((const void*)(sb_)), "s"(ldsbase), "n"(lo_) : "m0", "scc", "memory")
#define PG8_STAGE_D(bufoff, gbase, voff0, delta) do { PG8_GLDS(voff0, gbase, (bufoff)); PG8_GLDS(voff0, (const char*)(gbase) + (delta), (bufoff) + 8192); } while (0)
#define PG8_STAGE(bufoff, gbase, voff) do { PG8_GLDS((voff)[0], gbase, (bufoff)); PG8_GLDS((voff)[1], gbase, (bufoff) + 8192); } while (0)
#define PG8_STAGE_A(bufoff, hh, dbase, kbytes, vsel) do { if constexpr (GATHER) { PG8_STAGE(bufoff, (const char*)g.A + (kbytes), (vsel)[hh]); } else { PG8_STAGE_D(bufoff, (dbase) + ((hh) ? hstepA : 0), voffA0, dA); } } while (0)
#define PG8_GATHER_OFF(dst, un) do { int R_, C_; stage_rc(tid * 16, R_, C_); _Pragma("unroll") for (int _h = 0; _h < 2; ++_h) _Pragma("unroll") for (int _i = 0; _i < 2; ++_i) \
        (dst)[_h][_i] = (unsigned)rowtok[(un).pm * BM + _h * HALF + R_ + 64 * _i] * (unsigned)(K * 2) + (unsigned)(C_ * 2); } while (0)
#define PG8_LDA(dst, b, h) do { _Pragma("unroll") for (int m = 0; m < 4; ++m) _Pragma("unroll") for (int k = 0; k < 2; ++k) dst[m][k] = *(const PG8_LAS bf16x8*)(lds + PG8_SA(b, h) + aoff + m * 2048 + k * 1024); } while (0)
#define PG8_LDB(dst, b, h) do { _Pragma("unroll") for (int n = 0; n < 2; ++n) _Pragma("unroll") for (int k = 0; k < 2; ++k) dst[n][k] = *(const PG8_LAS bf16x8*)(lds + PG8_SB(b, h) + boff + n * 2048 + k * 1024); } while (0)
#define PG8_MMA(ai, bj, At, Bt) do { __builtin_amdgcn_s_setprio(1); _Pragma("unroll") for (int m = 0; m < 4; ++m) _Pragma("unroll") for (int n = 0; n < 2; ++n) _Pragma("unroll") for (int k = 0; k < 2; ++k) \
        acc[ai][bj][m][n] = __builtin_amdgcn_mfma_f32_16x16x32_bf16(Bt[n][k], At[m][k], acc[ai][bj][m][n], 0, 0, 0); __builtin_amdgcn_s_setprio(0); } while (0)
#define PG8_CAT8(lo_, hi_) __builtin_shufflevector(lo_, hi_, 0, 1, 2, 3, 4, 5, 6, 7)
#define PG8_LDA8(b, h) do { _Pragma("unroll") for (int m = 0; m < 4; ++m) { const v4i lo_ = *(const PG8_LAS v4i*)(lds + PG8_SA(b, h) + aoff + m * 2048), hi_ = *(const PG8_LAS v4i*)(lds + PG8_SA(b, h) + aoff + m * 2048 + 1024); A8[m] = PG8_CAT8(lo_, hi_); } } while (0)
#define PG8_LDB8(dst, b, h) do { _Pragma("unroll") for (int n = 0; n < 2; ++n) { const v4i lo_ = *(const PG8_LAS v4i*)(lds + PG8_SB(b, h) + boff + n * 2048), hi_ = *(const PG8_LAS v4i*)(lds + PG8_SB(b, h) + boff + n * 2048 + 1024); dst[n] = PG8_CAT8(lo_, hi_); } } while (0)
#define PG8_MMA8(ai, bj, Bt8) do { __builtin_amdgcn_s_setprio(1); _Pragma("unroll") for (int m = 0; m < 4; ++m) _Pragma("unroll") for (int n = 0; n < 2; ++n) \
        acc[ai][bj][m][n] = __builtin_amdgcn_mfma_scale_f32_16x16x128_f8f6f4(Bt8[n], A8[m], acc[ai][bj][m][n], 0, 0, 0, g.sw, 0, g.sx); __builtin_amdgcn_s_setprio(0); } while (0)
#define PG8_LDAX(b, h) do { if constexpr (FP8) { PG8_LDA8(b, h); } else { PG8_LDA(At, b, h); } } while (0)
#define PG8_LDBX(w, b, h) do { if constexpr (FP8) { if (w) { PG8_LDB8(B81, b, h); } else { PG8_LDB8(B80, b, h); } } else { if (w) { PG8_LDB(B1, b, h); } else { PG8_LDB(B0, b, h); } } } while (0)
#define PG8_MMX(ai, bj, w) do { if constexpr (FP8) { if (w) { PG8_MMA8(ai, bj, B81); } else { PG8_MMA8(ai, bj, B80); } } else { if (w) { PG8_MMA(ai, bj, At, B1); } else { PG8_MMA(ai, bj, At, B0); } } } while (0)
#define PG8_WAIT_V(n) asm volatile("s_waitcnt vmcnt(" #n ")" ::: "memory")
#define PG8_WAIT_L(n) asm volatile("s_waitcnt lgkmcnt(" #n ")" ::: "memory")
#define PG8_BAR __builtin_amdgcn_s_barrier()
#define PG8_SCHED __builtin_amdgcn_sched_barrier(0)
    Unit cur, nxt; int ui = 0;
    if (!S.next(0, cur)) return;
    f32x4 acc[2][2][4][2];
#pragma unroll
    for (int a = 0; a < 2; ++a)
#pragma unroll
        for (int b = 0; b < 2; ++b)
#pragma unroll
            for (int m = 0; m < 4; ++m)
#pragma unroll
                for (int n = 0; n < 2; ++n) acc[a][b][m][n] = (f32x4){0.f, 0.f, 0.f, 0.f};
    bf16x8 At[4][2], B0[2][2], B1[2][2]; v8i A8[4], B80[2], B81[2];
    const char* cA = GATHER ? (const char*)g.A : S.aptr(g, cur, tstep); const char* cB = S.bptr(g, cur, tstep);
    if constexpr (GATHER) { PG8_GATHER_OFF(vAc, cur); }
    PG8_STAGE_D(PG8_SB(0, 0), cB, voffB0, dB); PG8_STAGE_A(PG8_SA(0, 0), 0, cA, 0, vAc); PG8_STAGE_D(PG8_SB(0, 1), cB + hstep, voffB0, dB); PG8_STAGE_A(PG8_SA(0, 1), 1, cA, 0, vAc);
    if (wr == 1) PG8_BAR;
    PG8_WAIT_V(4); PG8_BAR;
    PG8_STAGE_D(PG8_SB(1, 0), cB + kstep, voffB0, dB); PG8_STAGE_A(PG8_SA(1, 0), 0, cA + kstepA, kstep, vAc); PG8_STAGE_D(PG8_SB(1, 1), cB + hstep + kstep, voffB0, dB);
    PG8_WAIT_V(6); PG8_BAR;
    for (;;) {
        const bool has_next = S.next(ui + 1, nxt);
        const char* nA = (has_next && !GATHER) ? S.aptr(g, nxt, tstep) : cA; const char* nB = has_next ? S.bptr(g, nxt, tstep) : cB;
        if constexpr (GATHER) { if (has_next) { PG8_GATHER_OFF(vAn, nxt); } else {
#pragma unroll
            for (int _h = 0; _h < 2; ++_h)
#pragma unroll
                for (int _i = 0; _i < 2; ++_i) vAn[_h][_i] = vAc[_h][_i]; } }
#pragma unroll 1
        for (int t = 0; t < nt; t += 2) {
            const bool last = (t == nt - 2);
            const size_t k1 = (size_t)(t + 1) * kstep, k2 = last ? 0 : (size_t)(t + 2) * kstep, k3 = k2 + kstep;
            const char* a1 = cA + (size_t)(t + 1) * kstepA;
            const char* a2 = last ? nA : cA + (size_t)(t + 2) * kstepA; const char* b2 = last ? nB : cB + (size_t)(t + 2) * kstep;
            const char* a3 = a2 + kstepA; const char* b3 = b2 + kstep;
            PG8_LDBX(0, 0, 0); PG8_SCHED; PG8_LDAX(0, 0); PG8_STAGE_A(PG8_SA(1, 1), 1, a1, k1, vAc);
            if constexpr (GATHER) { if (last) {
#pragma unroll
                for (int _h = 0; _h < 2; ++_h)
#pragma unroll
                    for (int _i = 0; _i < 2; ++_i) vAc[_h][_i] = vAn[_h][_i]; } }
            PG8_WAIT_L(8); PG8_BAR; PG8_WAIT_L(0); PG8_MMX(0, 0, 0); PG8_BAR; PG8_SCHED;
            PG8_LDBX(1, 0, 1); PG8_STAGE_D(PG8_SB(0, 0), b2, voffB0, dB);
            PG8_BAR; PG8_WAIT_L(0); PG8_MMX(0, 1, 1); PG8_BAR;
            PG8_LDAX(0, 1); PG8_STAGE_A(PG8_SA(0, 0), 0, a2, k2, vAc);
            PG8_BAR; PG8_WAIT_L(0); PG8_MMX(1, 0, 0); PG8_BAR; PG8_SCHED;
            PG8_STAGE_D(PG8_SB(0, 1), b2 + hstep, voffB0, dB);
            PG8_WAIT_V(6); PG8_BAR; PG8_MMX(1, 1, 1); PG8_BAR;
            PG8_LDBX(0, 1, 0); PG8_SCHED; PG8_LDAX(1, 0); PG8_STAGE_A(PG8_SA(0, 1), 1, a2, k2, vAc);
            PG8_WAIT_L(8); PG8_BAR; PG8_WAIT_L(0); PG8_MMX(0, 0, 0); PG8_BAR; PG8_SCHED;
            PG8_LDBX(1, 1, 1); PG8_STAGE_D(PG8_SB(1, 0), b3, voffB0, dB);
            PG8_BAR; PG8_WAIT_L(0); PG8_MMX(0, 1, 1); PG8_BAR;
            PG8_LDAX(1, 1); PG8_STAGE_A(PG8_SA(1, 0), 0, a3, k3, vAc);
            PG8_BAR; PG8_WAIT_L(0); PG8_MMX(1, 0, 0); PG8_BAR; PG8_SCHED;
            PG8_STAGE_D(PG8_SB(1, 1), b3 + hstep, voffB0, dB);
            PG8_WAIT_V(6); PG8_BAR; PG8_MMX(1, 1, 1); PG8_BAR;
        }
        E(acc, cur, wr, wc, fr, fq);
        if (!has_next) break;
#pragma unroll
        for (int a = 0; a < 2; ++a)
#pragma unroll
            for (int b = 0; b < 2; ++b)
#pragma unroll
                for (int m = 0; m < 4; ++m)
#pragma unroll
                    for (int n = 0; n < 2; ++n) acc[a][b][m][n] = (f32x4){0.f, 0.f, 0.f, 0.f};
        cur = nxt; cA = nA; cB = nB; ++ui;
        if constexpr (GATHER) {
#pragma unroll
            for (int _h = 0; _h < 2; ++_h)
#pragma unroll
                for (int _i = 0; _i < 2; ++_i) vAc[_h][_i] = vAn[_h][_i]; }
    }
    PG8_WAIT_V(0);
    if (wr == 0) PG8_BAR;
    PG8_BAR;
#undef PG8_SA
#undef PG8_SB
#undef PG8_STAGE
#undef PG8_STAGE_D
#undef PG8_GLDS
#undef PG8_STAGE_A
#undef PG8_GATHER_OFF
#undef PG8_LDA
#undef PG8_LDB
#undef PG8_MMA
#undef PG8_MMA8
#undef PG8_LDA8
#undef PG8_LDB8
#undef PG8_LDAX
#undef PG8_LDBX
#undef PG8_MMX
#undef PG8_CAT8
#undef PG8_WAIT_V
#undef PG8_WAIT_L
#undef PG8_BAR
#undef PG8_SCHED
}
}

struct Args {
    const float* in[29];
    float* out; unsigned char* ws;
    int ph_lo, ph_hi;
    int wv, zero_;
};
enum { I_X = 0, I_MEM, I_NMIXG, I_NMEMG, I_WIN, I_WMK, I_WMV, I_CONVW, I_CONVB, I_CLNG, I_CLNB, I_SHIFTMU, I_DW0, I_DUP, I_IA0, I_IUP, I_GUP, I_KK, I_KA, I_RK,
       I_LNXG, I_LNXB, I_WOUT, I_NFFNG, I_WROUTER, I_WEG, I_WEU, I_WED, I_FNG };

template <bool F8 = false>
__device__ __forceinline__ void transpose_item(const float* W, int N, bf16_t* WT, int K, int k0, int n0, int drow0, LAS float* scr, int lane) {
    {
        f32x4 v[8];
#pragma unroll
        for (int i = 0; i < 8; ++i) v[i] = *(const f32x4*)(W + (size_t)(k0 + 8 * i + (lane >> 3)) * N + n0 + 4 * (lane & 7));
#pragma unroll
        for (int i = 0; i < 8; ++i) { LAS float* d = scr + (8 * i + (lane >> 3)) * 33 + 4 * (lane & 7); d[0] = v[i].x; d[1] = v[i].y; d[2] = v[i].z; d[3] = v[i].w; }
    }
    asm volatile("s_waitcnt lgkmcnt(0)" ::: "memory");
    const int c = lane & 7;
#pragma unroll
    for (int j = 0; j < 4; ++j) { const int n = (lane >> 3) + 8 * j; const LAS float* s = scr + (8 * c) * 33 + n;
        if constexpr (F8) { *(u32x2*)((unsigned char*)WT + (size_t)(drow0 + n) * K + k0 + 8 * c) = (u32x2){pk_fp8x4(32.f * s[0 * 33], 32.f * s[1 * 33], 32.f * s[2 * 33], 32.f * s[3 * 33]), pk_fp8x4(32.f * s[4 * 33], 32.f * s[5 * 33], 32.f * s[6 * 33], 32.f * s[7 * 33])}; }
        else { u32x4 o; o.x = pk_bf16(s[0 * 33], s[1 * 33]); o.y = pk_bf16(s[2 * 33], s[3 * 33]); o.z = pk_bf16(s[4 * 33], s[5 * 33]); o.w = pk_bf16(s[6 * 33], s[7 * 33]);
            *(u32x4*)(WT + (size_t)(drow0 + n) * K + k0 + 8 * c) = o; } }
    asm volatile("s_waitcnt lgkmcnt(0)" ::: "memory");
}
__device__ __forceinline__ void expert_prep_items(const Args& a, LAS unsigned char* lds, int widx, int nw, int it_lo, int it_hi) {
    int tid = tid_of(a.wv); asm volatile("" : "+v"(tid)); const int lane = tid & 63, wave = __builtin_amdgcn_readfirstlane(tid >> 6);
    LAS float* scr = (LAS float*)(lds + wave * 16384);
    unsigned char* ws = a.ws;
    constexpr int S_EXP = 16 * 16 * 32;
    for (int r = it_lo + widx; r < it_hi; r += nw) {
        const int which = r / S_EXP, q = r % S_EXP, e = q / 512, kb = (q % 512) / 32, nb = q % 32, n0 = nb * 32;
        if (which == 0) transpose_item<true>(a.in[I_WEG] + (size_t)e * D * FF, FF, (bf16_t*)(ws + WS_WGUT + (size_t)e * 2048 * D), D, kb * 64, n0, (n0 >> 7) * 256 + (n0 & 127), scr, lane);
        else if (which == 1) transpose_item<true>(a.in[I_WEU] + (size_t)e * D * FF, FF, (bf16_t*)(ws + WS_WGUT + (size_t)e * 2048 * D), D, kb * 64, n0, (n0 >> 7) * 256 + 128 + (n0 & 127), scr, lane);
        else transpose_item<true>(a.in[I_WED] + (size_t)e * FF * D, D, (bf16_t*)(ws + WS_WDT + (size_t)e * D * FF), FF, kb * 64, n0, n0, scr, lane);
    }
}

__device__ __forceinline__ void rms_row_to_bf16(const float* xrow, const float* g, bf16_t* orow, int lane) {
    const f32x4* xr = (const f32x4*)xrow + lane; const f32x4* gr = (const f32x4*)g + lane;
    f32x4 v[4]; float s = 0.f;
#pragma unroll
    for (int j = 0; j < 4; ++j) { v[j] = xr[64 * j]; s += (v[j].x * v[j].x + v[j].y * v[j].y) + (v[j].z * v[j].z + v[j].w * v[j].w); }
    const float rs = 1.0f / sqrtf(wave_sum(s) * (1.f / D) + 1e-6f);
    u32x2* o8 = (u32x2*)orow + lane;
#pragma unroll
    for (int j = 0; j < 4; ++j) { const f32x4 gg = gr[64 * j]; u32x2 w; w.x = pk_bf16(v[j].x * rs * gg.x, v[j].y * rs * gg.y); w.y = pk_bf16(v[j].z * rs * gg.z, v[j].w * rs * gg.w); o8[64 * j] = w; }
}
__device__ __forceinline__ void phase_prep(const Args& a, LAS unsigned char* lds, int G) {
    int tid = tid_of(a.wv); asm volatile("" : "+v"(tid)); const int lane = tid & 63, wave = __builtin_amdgcn_readfirstlane(tid >> 6);
    LAS float* scr = (LAS float*)(lds + wave * 16384);
    const int gw = blockIdx.x * 8 + wave, NGW = G * 8;
    unsigned char* ws = a.ws;
    constexpr int S_WIN = 16 * 80, S_WOUT = 16 * 32, S_MK = 16 * 8, S_SM = 12, S_GUP = 24;
    constexpr int NITEMS = S_WIN + S_WOUT + 2 * S_MK + 4 * S_SM + S_GUP;
    for (int it = gw; it < NITEMS; it += NGW) {
        int r = it;
        if (r < S_WIN) { const int kb = r / 80, nb = r % 80; transpose_item(a.in[I_WIN], IN_PROJ, (bf16_t*)(ws + WS_WINT), D, kb * 64, nb * 32, nb * 32, scr, lane); continue; } r -= S_WIN;
        if (r < S_WOUT) { const int kb = r / 32, nb = r % 32; transpose_item(a.in[I_WOUT], D, (bf16_t*)(ws + WS_WOUTT), D, kb * 64, nb * 32, nb * 32, scr, lane); continue; } r -= S_WOUT;
        if (r < S_MK) { const int kb = r / 8, nb = r % 8; transpose_item(a.in[I_WMK], 256, (bf16_t*)(ws + WS_WKT), D, kb * 64, nb * 32, nb * 32, scr, lane); continue; } r -= S_MK;
        if (r < S_MK) { const int kb = r / 8, nb = r % 8; transpose_item(a.in[I_WMV], 256, (bf16_t*)(ws + WS_WVT), D, kb * 64, nb * 32, nb * 32, scr, lane); continue; } r -= S_MK;
        if (r < 4 * S_SM) { const int which = r / S_SM, nb = r % S_SM;
            const float* src = (which < 2 ? a.in[I_DUP] : a.in[I_IUP]) + (size_t)(which & 1) * 64 * RW;
            transpose_item(src, RW, (bf16_t*)(ws + WS_SMALL) + (size_t)which * RW * 64, 64, 0, nb * 32, nb * 32, scr, lane); continue; } r -= 4 * S_SM;
        { const int kb = r / 12, nb = r % 12; transpose_item(a.in[I_GUP], RW, (bf16_t*)(ws + WS_SMALL) + (size_t)4 * RW * 64, 128, kb * 64, nb * 32, nb * 32, scr, lane); }
    }
    expert_prep_items(a, lds, gw, NGW, 0, 3 * 8192);
    for (int m = gw; m < T; m += NGW) rms_row_to_bf16(a.in[I_X] + (size_t)m * D, a.in[I_NMIXG], (bf16_t*)(ws + WS_XH) + (size_t)m * D, lane);
    for (int m = gw; m < BATCH * NMEM; m += NGW) rms_row_to_bf16(a.in[I_MEM] + (size_t)m * D, a.in[I_NMEMG], (bf16_t*)(ws + WS_MEMN) + (size_t)m * D, lane);
}

constexpr int AT_KS = 144;
constexpr int AT_VS = 520;
constexpr int AT_VOFF = 256 * AT_KS;
__device__ __forceinline__ bf16x8 pack_step(const f32x16& x, int s) {
    u32x4 p;
    asm volatile("v_cvt_pk_bf16_f32 %0, %4, %5\n\tv_cvt_pk_bf16_f32 %1, %6, %7\n\tv_cvt_pk_bf16_f32 %2, %8, %9\n\tv_cvt_pk_bf16_f32 %3, %10, %11\n\ts_nop 1"
                 : "=&v"(p[0]), "=&v"(p[1]), "=&v"(p[2]), "=&v"(p[3])
                 : "v"(x[8 * s]), "v"(x[8 * s + 1]), "v"(x[8 * s + 2]), "v"(x[8 * s + 3]), "v"(x[8 * s + 4]), "v"(x[8 * s + 5]), "v"(x[8 * s + 6]), "v"(x[8 * s + 7]));
    return __builtin_bit_cast(bf16x8, p);
}
__device__ __forceinline__ void attn_unit(const Args& a, LAS unsigned char* lds, int unit) {
    int tid = tid_of(a.wv); asm volatile("" : "+v"(tid)); const int lane = tid & 63, wave = __builtin_amdgcn_readfirstlane(tid >> 6), r = lane & 31, h = lane >> 5;
    const int b = unit >> 2, hh = unit & 3;
    const bf16_t* Qb = (const bf16_t*)(a.ws + WS_Q); const bf16_t* KM = (const bf16_t*)(a.ws + WS_KMEM); const bf16_t* VT = (const bf16_t*)(a.ws + WS_VT);
    bf16_t* MIX = (bf16_t*)(a.ws + WS_MIX);
    __syncthreads();
#pragma unroll
    for (int i = 0; i < 4; ++i) { const int c = tid + 512 * i, key = c >> 3, ch = c & 7;
        const u32x4 v = *(const u32x4*)(KM + (size_t)(b * NMEM + key) * 256 + hh * 64 + ch * 8);
        *(LAS u32x4*)(lds + key * AT_KS + ch * 16) = v; }
#pragma unroll
    for (int i = 0; i < 4; ++i) { const int c = tid + 512 * i, d = c >> 5, ch = c & 31;
        const u32x4 v = *(const u32x4*)(VT + (size_t)(hh * 64 + d) * (BATCH * NMEM) + b * NMEM + ch * 8);
        LAS u32x2* dst = (LAS u32x2*)(lds + AT_VOFF + d * AT_VS + ch * 16);
        dst[0] = (u32x2){v.x, v.y}; dst[1] = (u32x2){v.z, v.w}; }
    __syncthreads();
#pragma unroll 1
    for (int tile = 0; tile < 16; ++tile) {
    const int tok0 = b * SEQ + tile * 256 + wave * 32;
    bf16x8 qf[4];
#pragma unroll
    for (int ks = 0; ks < 4; ++ks) qf[ks] = *(const bf16x8*)(Qb + (size_t)(tok0 + r) * 256 + hh * 64 + ks * 16 + h * 8);
    const float sc = 0.125f * 1.4426950408889634f;
    float m_run = -3.0e38f, sum = 0.f;
    f32x16 o[2];
#pragma unroll
    for (int dt = 0; dt < 2; ++dt)
#pragma unroll
        for (int i = 0; i < 16; ++i) o[dt][i] = 0.f;
#pragma unroll 1
    for (int kh = 0; kh < 2; ++kh) {
        f32x16 s[4];
#pragma unroll
        for (int k4 = 0; k4 < 4; ++k4) {
#pragma unroll
            for (int i = 0; i < 16; ++i) s[k4][i] = 0.f;
#pragma unroll
            for (int ks = 0; ks < 4; ++ks) { const bf16x8 ka = *(const LAS bf16x8*)(lds + ((kh * 4 + k4) * 32 + r) * AT_KS + (ks * 16 + h * 8) * 2);
                s[k4] = __builtin_amdgcn_mfma_f32_32x32x16_bf16(ka, qf[ks], s[k4], 0, 0, 0); }
        }
        float mx = m_run;
#pragma unroll
        for (int k4 = 0; k4 < 4; ++k4)
#pragma unroll
            for (int i = 0; i < 16; ++i) mx = fmaxf(mx, s[k4][i]);
        mx = fmaxf(mx, __shfl_xor(mx, 32));
        const float alpha = __builtin_amdgcn_exp2f((m_run - mx) * sc);
        float ps = 0.f;
#pragma unroll
        for (int k4 = 0; k4 < 4; ++k4)
#pragma unroll
            for (int i = 0; i < 16; ++i) { const float e = __builtin_amdgcn_exp2f((s[k4][i] - mx) * sc); s[k4][i] = e; ps += e; }
        ps += __shfl_xor(ps, 32);
        sum = sum * alpha + ps; m_run = mx;
#pragma unroll
        for (int dt = 0; dt < 2; ++dt)
#pragma unroll
            for (int i = 0; i < 16; ++i) o[dt][i] *= alpha;
#pragma unroll
        for (int k4 = 0; k4 < 4; ++k4)
#pragma unroll
            for (int s2 = 0; s2 < 2; ++s2) {
                const bf16x8 pb = pack_step(s[k4], s2);
#pragma unroll
                for (int dt = 0; dt < 2; ++dt) {
                    const LAS unsigned char* vp = lds + AT_VOFF + (32 * dt + r) * AT_VS + (32 * (kh * 4 + k4) + 16 * s2 + 4 * h) * 2;
                    const s16x4 lo = *(const LAS s16x4*)vp, hi = *(const LAS s16x4*)(vp + 16);
                    const bf16x8 va = __builtin_shufflevector(lo, hi, 0, 1, 2, 3, 4, 5, 6, 7);
                    o[dt] = __builtin_amdgcn_mfma_f32_32x32x16_bf16(va, pb, o[dt], 0, 0, 0);
                }
            }
    }
    const float inv = 1.0f / sum;
    bf16_t* orow = MIX + (size_t)(tok0 + r) * D + hh * 64;
#pragma unroll
    for (int dt = 0; dt < 2; ++dt)
#pragma unroll
        for (int gq = 0; gq < 4; ++gq) { u32x2 w; w.x = pk_bf16(o[dt][4 * gq] * inv, o[dt][4 * gq + 1] * inv); w.y = pk_bf16(o[dt][4 * gq + 2] * inv, o[dt][4 * gq + 3] * inv);
            *(u32x2*)(orow + 32 * dt + 8 * gq + 4 * h) = w; }
    }
}

__device__ __forceinline__ void conv_unit(const Args& a, LAS unsigned char* lds, int unit) {
    int tid = tid_of(a.wv); asm volatile("" : "+v"(tid)); const int lane = tid & 63, wave = __builtin_amdgcn_readfirstlane(tid >> 6);
    const int b = unit >> 6, t0 = (unit & 63) * 64;
    const bf16_t* P = (const bf16_t*)(a.ws + WS_P); bf16_t* MIX = (bf16_t*)(a.ws + WS_MIX);
    LAS _Float16* U = (LAS _Float16*)lds;
    LAS _Float16* Cc = (LAS _Float16*)(lds + 94 * CW * 2);
    __syncthreads();
#pragma unroll 1
    for (int q0 = tid; q0 < 94 * 48; q0 += 3 * NTHREADS) {
        u32x4 vvv[3], ggg[3];
#pragma unroll
        for (int u3 = 0; u3 < 3; ++u3) { const int q = q0 + u3 * NTHREADS, j = q / 48, cc = (q % 48) * 8, s = t0 - 15 + j; const bool ok = (q < 94 * 48) && s >= 0 && s < SEQ;
            const bf16_t* row = P + (size_t)(b * SEQ + (ok ? s : 0)) * PLD + cc;
            vvv[u3] = ok ? *(const u32x4*)row : (u32x4){0u, 0u, 0u, 0u}; ggg[u3] = ok ? *(const u32x4*)(row + CW) : (u32x4){0u, 0u, 0u, 0u}; }
#pragma unroll
        for (int u3 = 0; u3 < 3; ++u3) { const int q = q0 + u3 * NTHREADS, j = q / 48, cc = (q % 48) * 8;
            if (q < 94 * 48) {
                const unsigned vw[4] = {vvv[u3].x, vvv[u3].y, vvv[u3].z, vvv[u3].w}, gw[4] = {ggg[u3].x, ggg[u3].y, ggg[u3].z, ggg[u3].w};
                float u[8];
#pragma unroll
                for (int k = 0; k < 4; ++k) { u[2 * k] = bf_lo(vw[k]) * sigmoidf_fast(bf_lo(gw[k])); u[2 * k + 1] = bf_hi(vw[k]) * sigmoidf_fast(bf_hi(gw[k])); }
                LAS f16x4* dst = (LAS f16x4*)(U + j * CW + cc); dst[0] = (f16x4){(_Float16)u[0], (_Float16)u[1], (_Float16)u[2], (_Float16)u[3]}; dst[1] = (f16x4){(_Float16)u[4], (_Float16)u[5], (_Float16)u[6], (_Float16)u[7]}; }
        }
    }
    __syncthreads();
    const int cq = tid & 127, tq = tid >> 7;
#pragma unroll 1
    for (int k3 = 0; k3 < 3; ++k3) { const int c = cq + 128 * k3;
        float w[31], res[16];
#pragma unroll
        for (int kk = 0; kk < 31; ++kk) w[kk] = a.in[I_CONVW][kk * CW + c];
        const float bias = a.in[I_CONVB][c];
#pragma unroll
        for (int tt = 0; tt < 16; ++tt) res[tt] = bias;
#pragma unroll
        for (int jj = 0; jj < 46; ++jj) { const float uv = (float)U[(tq * 16 + jj) * CW + c];
#pragma unroll
            for (int tt = 0; tt < 16; ++tt) { if (jj - tt >= 0 && jj - tt <= 30) res[tt] += uv * w[jj - tt]; } }
#pragma unroll
        for (int tt = 0; tt < 16; ++tt) Cc[(tq * 16 + tt) * CW + c] = (_Float16)res[tt];
    }
    __syncthreads();
    for (int tt = 0; tt < 8; ++tt) { const int t = wave * 8 + tt;
        float v[6]; float s = 0.f;
#pragma unroll
        for (int i = 0; i < 6; ++i) { v[i] = (float)Cc[t * CW + lane + 64 * i]; s += v[i]; }
        const float mean = wave_sum(s) * (1.f / CW); float q = 0.f;
#pragma unroll
        for (int i = 0; i < 6; ++i) { v[i] -= mean; q += v[i] * v[i]; }
        const float rstd = 1.0f / sqrtf(wave_sum(q) * (1.f / CW) + 1e-5f);
        bf16_t* orow = MIX + (size_t)(b * SEQ + t0 + t) * D + 256;
#pragma unroll
        for (int i = 0; i < 6; ++i) { const int c = lane + 64 * i; const float y = v[i] * rstd * a.in[I_CLNG][c] + a.in[I_CLNB][c]; const float o = y * sigmoidf_fast(y);
            orow[c] = (bf16_t)(pk_bf16(o, 0.f) & 0xffffu); }
    }
}

constexpr int PR_AS = 784;
constexpr int PR_RK = 64 * PR_AS;
constexpr int PR_RKS = 1536;
constexpr int PR_RN = PR_RK + 64 * PR_RKS;
constexpr int PR_CST = PR_RN + 2048;
static_assert(PR_CST + 7 * 384 * 4 <= LDS_BYTES - 64, "prep LDS map");
template <int V> struct IC { static constexpr int value = V; };
template <int CTRL> __device__ __forceinline__ f32x4 dpp4(f32x4 x) { return (f32x4){dpp_f<CTRL>(x.x), dpp_f<CTRL>(x.y), dpp_f<CTRL>(x.z), dpp_f<CTRL>(x.w)}; }
__device__ __forceinline__ void prep_unit(const Args& a, LAS unsigned char* lds, int unit) {
    int tid = tid_of(a.wv); asm volatile("" : "+v"(tid)); const int lane = tid & 63, wave = __builtin_amdgcn_readfirstlane(tid >> 6);
    const int b = unit >> 6, t0 = (unit & 63) * 64;
    const bf16_t* __restrict__ P = (const bf16_t*)(a.ws + WS_P);
    const float* __restrict__ mu = a.in[I_SHIFTMU];
    LAS float* RNs = (LAS float*)(lds + PR_RN); LAS float* CST = (LAS float*)(lds + PR_CST);
    __syncthreads();
    for (int i = tid; i < 7 * 384; i += NTHREADS) { const int w7 = i / 384, c7 = i % 384;
        CST[i] = (w7 == 0) ? a.in[I_KK][c7] : (w7 == 1) ? a.in[I_KA][c7] : (w7 == 2) ? a.in[I_RK][c7] : (w7 < 5) ? a.in[I_DW0][(w7 - 3) * RW + c7] : a.in[I_IA0][(w7 - 5) * RW + c7]; }
#ifndef PREP_REP1
#define PREP_REP1 1
#endif
#ifndef PREP_REP2
#define PREP_REP2 1
#endif
#pragma unroll 1
    for (int rp1 = 0; rp1 < PREP_REP1; ++rp1)
#pragma unroll 1
    for (int q0 = tid; q0 < 64 * 192; q0 += 4 * NTHREADS) {
        u32x4 cuv[4], pvv[4], nvv[4];
#pragma unroll
        for (int u4 = 0; u4 < 4; ++u4) { const int q = q0 + u4 * NTHREADS, tt = q / 192, c8 = (q % 192) * 8, s = t0 + tt;
            const bf16_t* row = P + ((size_t)b * SEQ + s) * PLD + 768 + c8;
            cuv[u4] = *(const u32x4*)row;
            pvv[u4] = (s > 0) ? *(const u32x4*)(row - PLD) : (u32x4){0u, 0u, 0u, 0u};
            nvv[u4] = (s < SEQ - 1) ? *(const u32x4*)(row + PLD) : (u32x4){0u, 0u, 0u, 0u}; }
#pragma unroll
        for (int u4 = 0; u4 < 4; ++u4) { const int q = q0 + u4 * NTHREADS, tt = q / 192, c8 = (q % 192) * 8, s = t0 + tt; const size_t tok = (size_t)b * SEQ + s;
            const u32x4 cu = cuv[u4], pv = pvv[u4], nv = nvv[u4];
            const unsigned cw[4] = {cu.x, cu.y, cu.z, cu.w}, pw[4] = {pv.x, pv.y, pv.z, pv.w}, nw[4] = {nv.x, nv.y, nv.z, nv.w};
            const f32x4 m0a = *(const f32x4*)(mu + c8), m0b = *(const f32x4*)(mu + c8 + 4), m1a = *(const f32x4*)(mu + 1536 + c8), m1b = *(const f32x4*)(mu + 1536 + c8 + 4);
            const float m0[8] = {m0a.x, m0a.y, m0a.z, m0a.w, m0b.x, m0b.y, m0b.z, m0b.w}, m1[8] = {m1a.x, m1a.y, m1a.z, m1a.w, m1b.x, m1b.y, m1b.z, m1b.w};
            float pf[8];
#pragma unroll
            for (int k = 0; k < 4; ++k) { const float c0 = bf_lo(cw[k]), c1 = bf_hi(cw[k]);
                pf[2 * k] = c0 + m0[2 * k] * (bf_lo(pw[k]) - c0) + m1[2 * k] * (bf_lo(nw[k]) - c0);
                pf[2 * k + 1] = c1 + m0[2 * k + 1] * (bf_hi(pw[k]) - c1) + m1[2 * k + 1] * (bf_hi(nw[k]) - c1); }
            if (c8 < 768) {
                f16x4 h0 = {(_Float16)pf[0], (_Float16)pf[1], (_Float16)pf[2], (_Float16)pf[3]}, h1 = {(_Float16)pf[4], (_Float16)pf[5], (_Float16)pf[6], (_Float16)pf[7]};
                LAS f16x4* dst = (LAS f16x4*)(lds + PR_RK + tt * PR_RKS + c8 * 2); dst[0] = h0; dst[1] = h1;
                if (c8 >= 384) { const f32x4 ka = *(const f32x4*)(a.in[I_KK] + c8 - 384), kb = *(const f32x4*)(a.in[I_KK] + c8 - 384 + 4);
                    float ssq = (pf[0] * ka.x) * (pf[0] * ka.x) + (pf[1] * ka.y) * (pf[1] * ka.y) + (pf[2] * ka.z) * (pf[2] * ka.z) + (pf[3] * ka.w) * (pf[3] * ka.w)
                              + (pf[4] * kb.x) * (pf[4] * kb.x) + (pf[5] * kb.y) * (pf[5] * kb.y) + (pf[6] * kb.z) * (pf[6] * kb.z) + (pf[7] * kb.w) * (pf[7] * kb.w);
                    ssq = sum8(ssq);
                    if ((lane & 7) == 0) RNs[tt * 8 + ((c8 - 384) >> 6)] = __builtin_amdgcn_rsqf(ssq + 1e-12f); }
            } else if (c8 < 1152) {
                u32x4 w; w.x = pk_bf16(pf[0], pf[1]); w.y = pk_bf16(pf[2], pf[3]); w.z = pk_bf16(pf[4], pf[5]); w.w = pk_bf16(pf[6], pf[7]);
                *(u32x4*)((bf16_t*)scan_arr(a.ws, 0) + hat_off(0, tok, c8 - 768)) = w;
            } else {
                const int cc = c8 - 1152;
#pragma unroll
                for (int k = 0; k < 8; ++k) { if (cc < 128) pf[k] = 1.0f - 2.0f * __builtin_amdgcn_rcpf(1.0f + __builtin_amdgcn_exp2f(2.8853900817779268f * pf[k])); else if (cc >= 256) pf[k] = sigmoidf_fast(pf[k]); }
                u32x4 w; w.x = pk_bf16(pf[0], pf[1]); w.y = pk_bf16(pf[2], pf[3]); w.z = pk_bf16(pf[4], pf[5]); w.w = pk_bf16(pf[6], pf[7]);
                *(LAS u32x4*)(lds + tt * PR_AS + cc * 2) = w; }
        }
    }
    __syncthreads();
    const int l15 = lane & 15, kq = lane >> 4;
    float* __restrict__ PCg = (float*)(a.ws + WS_PC); float* __restrict__ BON = (float*)(a.ws + WS_BON);
    const char* SMb = (const char*)(a.ws + WS_SMALL);
    const unsigned wlo64 = (unsigned)(((8 * (l15 >> 2) + (l15 & 3)) * 64 + kq * 8) * 2), wlo128 = (unsigned)(((8 * (l15 >> 2) + (l15 & 3)) * 128 + kq * 8) * 2);
    const unsigned hlo = (unsigned)((l15 * 64 + 8 * kq) * 2), klo = (unsigned)((l15 * D + 8 * kq) * 2), glo = (unsigned)((l15 * RW + 8 * kq) * 2);
    bf16x8 Fc[16], Fn[16];
#define PREP_LOADW(hd_, kind_) do { \
        if ((kind_) < 2) { const char* w_ = SMb + ((size_t)(kind_) * RW * 64 + (size_t)(hd_) * 64 * 64) * 2; \
            _Pragma("unroll") for (int f_ = 0; f_ < 16; ++f_) Fn[f_] = *(const bf16x8*)(w_ + (size_t)(((f_ >> 2) & 1) * (2 * RW * 64 * 2) + (32 * ((f_ & 3) >> 1) + 4 * (f_ & 1)) * 128 + (f_ >> 3) * 64) + wlo64); } \
        else { const char* w_ = SMb + ((size_t)4 * RW * 64 + (size_t)(hd_) * 64 * 128) * 2; \
            _Pragma("unroll") for (int f_ = 0; f_ < 16; ++f_) Fn[f_] = *(const bf16x8*)(w_ + (size_t)((32 * ((f_ & 3) >> 1) + 4 * (f_ & 1)) * 256 + (f_ >> 2) * 64) + wlo128); } } while (0)
    auto dir_stage = [&](auto dc, const int it, const int nhd, const int nkind) {
        constexpr int d = decltype(dc)::value;
        const int hd = it >> 2, mt = it & 3, tokl = mt * 16 + l15; const size_t tb = (size_t)b * SEQ + t0 + mt * 16;
#pragma unroll
        for (int f = 0; f < 16; ++f) Fc[f] = Fn[f];
        f32x4 accW[4], accA[4];
#pragma unroll
        for (int nt = 0; nt < 4; ++nt) { accW[nt] = (f32x4){0.f, 0.f, 0.f, 0.f}; accA[nt] = (f32x4){0.f, 0.f, 0.f, 0.f}; }
#pragma unroll
        for (int ks = 0; ks < 2; ++ks) {
            const bf16x8 aw = *(const LAS bf16x8*)(lds + tokl * PR_AS + (d * 64 + ks * 32 + kq * 8) * 2), aa = *(const LAS bf16x8*)(lds + tokl * PR_AS + ((2 + d) * 64 + ks * 32 + kq * 8) * 2);
#pragma unroll
            for (int nt = 0; nt < 4; ++nt) { accW[nt] = MFMA16(Fc[ks * 8 + nt], aw, accW[nt]); accA[nt] = MFMA16(Fc[ks * 8 + 4 + nt], aa, accA[nt]); }
        }
        if (nkind >= 0) PREP_LOADW(nhd, nkind);
        const float rn = RNs[tokl * 8 + hd];
        const size_t tile_b = ((((tb >> 4) * NH + hd) << 10)) * 2;
        char* AHb = (char*)scan_arr(a.ws, 1 + 4 * d) + tile_b; char* RHb = (char*)scan_arr(a.ws, 2 + 4 * d) + tile_b; char* BHb = (char*)scan_arr(a.ws, 3 + 4 * d) + tile_b;
        char* KHb = d ? (char*)scan_arr(a.ws, 8) + (tb * D + hd * 64) * 2 : (char*)scan_arr(a.ws, 4) + tile_b; const unsigned khlo = d ? klo : hlo;
        char* PCb = (char*)(PCg + ((size_t)d * (T / 16) + (tb >> 4)) * RW + hd * 64); char* BOb = (char*)(BON + (size_t)d * T * NH + tb * NH + hd);
        float bsum = 0.f;
        u32x2 hA[2], hR[2], hB[2], hK[2]; f32x4 PtS[4];
#pragma unroll
        for (int nt = 0; nt < 4; ++nt) { const int ch = hd * 64 + 32 * (nt >> 1) + 8 * kq + 4 * (nt & 1);
            const f32x4 bW = *(const LAS f32x4*)(CST + (3 + d) * 384 + ch), bA = *(const LAS f32x4*)(CST + (5 + d) * 384 + ch);
            const f32x4 kkw = *(const LAS f32x4*)(CST + ch), kaw = *(const LAS f32x4*)(CST + 384 + ch), rkw = *(const LAS f32x4*)(CST + 768 + ch);
            const f32x4 zw = accW[nt] + bW, za = accA[nt] + bA;
            f32x4 lw, av;
#pragma unroll
            for (int e = 0; e < 4; ++e) { lw[e] = -0.606531f * 1.4426950408889634f * sigmoidf_fast(zw[e]); av[e] = sigmoidf_fast(za[e]); }
            f32x4 cum = lw;
            if (d == 0) { cum += dpp4<0x111>(cum); cum += dpp4<0x112>(cum); cum += dpp4<0x114>(cum); cum += dpp4<0x118>(cum); }
            else        { cum += dpp4<0x101>(cum); cum += dpp4<0x102>(cum); cum += dpp4<0x104>(cum); cum += dpp4<0x108>(cum); }
            f32x4 Pt, Pinv, Pprev;
#pragma unroll
            for (int e = 0; e < 4; ++e) { Pt[e] = __builtin_amdgcn_exp2f(cum[e]); Pinv[e] = __builtin_amdgcn_rcpf(Pt[e]);
                Pprev[e] = __builtin_amdgcn_exp2f(cum[e] - lw[e]); }
            PtS[nt] = Pt;
            const f32x4 r4 = __builtin_convertvector(*(const LAS f16x4*)(lds + PR_RK + tokl * PR_RKS + ch * 2), f32x4);
            const f32x4 k4 = __builtin_convertvector(*(const LAS f16x4*)(lds + PR_RK + tokl * PR_RKS + (384 + ch) * 2), f32x4);
            const f32x4 kk = k4 * kkw * rn, kd = k4 * (1.0f + (av - 1.0f) * kaw);
            hA[nt & 1] = f32_to_bf4(-kk * Pprev); hR[nt & 1] = f32_to_bf4(r4 * Pt); hB[nt & 1] = f32_to_bf4(kk * av * Pinv); hK[nt & 1] = f32_to_bf4(kd * Pinv);
            const f32x4 bt = r4 * kd * rkw; bsum += (bt.x + bt.y) + (bt.z + bt.w);
            if (nt & 1) { const int pr = nt >> 1;
                *(u32x4*)(AHb + (hlo + 64 * pr)) = (u32x4){hA[0].x, hA[0].y, hA[1].x, hA[1].y}; *(u32x4*)(RHb + (hlo + 64 * pr)) = (u32x4){hR[0].x, hR[0].y, hR[1].x, hR[1].y};
                *(u32x4*)(BHb + (hlo + 64 * pr)) = (u32x4){hB[0].x, hB[0].y, hB[1].x, hB[1].y}; *(u32x4*)(KHb + (khlo + 64 * pr)) = (u32x4){hK[0].x, hK[0].y, hK[1].x, hK[1].y}; }
        }
        if (l15 == (d ? 0 : 15)) {
#pragma unroll
            for (int nt = 0; nt < 4; ++nt) *(f32x4*)(PCb + (unsigned)(8 * kq * 4) + (32 * (nt >> 1) + 4 * (nt & 1)) * 4) = PtS[nt]; }
        bsum += __shfl_xor(bsum, 16); bsum += __shfl_xor(bsum, 32);
        if (kq == 0) *(float*)(BOb + (unsigned)(l15 * NH * 4)) = bsum;
    };
    auto gate_stage = [&](const int it, const int nhd, const int nkind) {
        const int hd = it >> 2, mt = it & 3, tokl = mt * 16 + l15; const size_t tb = (size_t)b * SEQ + t0 + mt * 16;
#pragma unroll
        for (int f = 0; f < 16; ++f) Fc[f] = Fn[f];
        f32x4 acc[4];
#pragma unroll
        for (int nt = 0; nt < 4; ++nt) acc[nt] = (f32x4){0.f, 0.f, 0.f, 0.f};
#pragma unroll
        for (int ks = 0; ks < 4; ++ks) { const bf16x8 afr = *(const LAS bf16x8*)(lds + tokl * PR_AS + (256 + ks * 32 + kq * 8) * 2);
#pragma unroll
            for (int nt = 0; nt < 4; ++nt) acc[nt] = MFMA16(Fc[ks * 4 + nt], afr, acc[nt]); }
        if (nkind >= 0) PREP_LOADW(nhd, nkind);
        char* Gb = (char*)((bf16_t*)(a.ws + WS_G) + tb * RW + hd * 64);
#pragma unroll
        for (int pr = 0; pr < 2; ++pr) { const u32x2 g0 = f32_to_bf4(acc[2 * pr]), g1 = f32_to_bf4(acc[2 * pr + 1]);
            *(u32x4*)(Gb + (glo + 64 * pr)) = (u32x4){g0.x, g0.y, g1.x, g1.y}; }
    };
    PREP_LOADW(wave >> 2, 0);
#pragma unroll 1
    for (int k3 = 0; k3 < 3; ++k3) { const int it = wave + 8 * k3, hd = it >> 2;
        dir_stage(IC<0>{}, it, hd, 1);
        dir_stage(IC<1>{}, it, hd, 2);
        gate_stage(it, (it + 8) >> 2, k3 < 2 ? 0 : -1);
    }
#undef PREP_LOADW
}

__device__ __forceinline__ void glds16_asm(const void* gptr, LAS unsigned char* ldst) {
    const unsigned la = __builtin_amdgcn_readfirstlane((unsigned)(size_t)ldst);
    asm volatile("s_mov_b32 m0, %1\n\ts_nop 0\n\tglobal_load_lds_dwordx4 %0, off" :: "v"(gptr), "s"(la) : "m0", "memory");
}
constexpr int CK = 16, NCHUNK = SEQ / CK, CS_NS = 8, CS_NPROD = 6, CS_NCONS = 2;
constexpr int SL_ATIL = 0, SL_RTIL = 2048, SL_BH = 4096, SL_KH = 6144, SL_V = 8192, SL_ULOC = 10240, SL_YLOC = 12288, SL_PC = 14336, SL_BYTES = 14592;
constexpr int PS_AH = 0, PS_RH = 2048, PS_BYTES = 4096;
constexpr int CS_PS_OFF = CS_NS * SL_BYTES, CS_FLAG_OFF = CS_PS_OFF + CS_NPROD * PS_BYTES;
static_assert(CS_FLAG_OFF + 64 <= LDS_BYTES - 64, "chunked scan LDS map");
__device__ __forceinline__ int swz(int t, int j) { return t * 128 + ((((j >> 3) ^ (t & 7))) << 4) + ((j & 4) << 1); }
__device__ __forceinline__ void scan_chunked_unit(const Args& a, LAS unsigned char* lds, int unit) {
    int tid = tid_of(a.wv); asm volatile("" : "+v"(tid)); const int lane = tid & 63, wave = __builtin_amdgcn_readfirstlane(tid >> 6);
    const int dir = unit & 1, bh = unit >> 1, b = bh / NH, hd = bh % NH;
    const int c16 = lane & 15, q = lane >> 4, qp = c16 >> 2, pp = c16 & 3;
    volatile LAS unsigned* FULL = (volatile LAS unsigned*)(lds + CS_FLAG_OFF);
    volatile LAS unsigned* DONE = FULL + 8;
    float* Yg = (float*)(a.ws + (dir ? WS_YB : WS_YF));
    __syncthreads();
    if (tid < 16) FULL[tid] = 0u;
    __syncthreads();
    if (wave >= CS_NCONS) {
        const int pw = wave - CS_NCONS;
        LAS unsigned char* ps = lds + CS_PS_OFF + pw * PS_BYTES;
        const bf16_t* ARR[5] = {(const bf16_t*)scan_arr(a.ws, 1 + 4 * dir), (const bf16_t*)scan_arr(a.ws, 2 + 4 * dir), (const bf16_t*)scan_arr(a.ws, 3 + 4 * dir), (const bf16_t*)scan_arr(a.ws, 4 + 4 * dir), (const bf16_t*)scan_arr(a.ws, 0)};
        const int AIDX[5] = {1 + 4 * dir, 2 + 4 * dir, 3 + 4 * dir, 4 + 4 * dir, 0};
        const float* PCg = (const float*)(a.ws + WS_PC) + (size_t)dir * (T / 16) * RW + hd * 64 + lane;
        u32x4 pf[10];
#define CS_ISSUE(cc) do { _Pragma("unroll") for (int ar_ = 0; ar_ < 5; ++ar_) _Pragma("unroll") for (int hf_ = 0; hf_ < 2; ++hf_) { \
            const int row_ = hf_ * 8 + (lane >> 3); const int st_ = (cc) * CK + row_; const int t_ = dir ? (SEQ - 1 - st_) : st_; \
            pf[ar_ * 2 + hf_] = *(const u32x4*)(ARR[ar_] + hat_off(AIDX[ar_], (size_t)b * SEQ + t_, hd * 64 + 8 * ((lane & 7) ^ (row_ & 7)))); } } while (0)
#define CS_PCLOAD(cc) PCg[(size_t)((size_t)b * (SEQ / CK) + (dir ? (NCHUNK - 1 - (cc)) : (cc))) * RW]
        CS_ISSUE(pw);
        float pcn = CS_PCLOAD(pw);
#pragma unroll 1
        for (int c = pw; c < NCHUNK; c += CS_NPROD) {
            const int slot = c % CS_NS; LAS unsigned char* sl = lds + slot * SL_BYTES;
            { unsigned sp = 0; const unsigned want = (unsigned)CS_NCONS * (unsigned)(c / CS_NS); while (DONE[slot] < want) { __builtin_amdgcn_s_sleep(1); if (++sp > (1u << 22)) break; } }
            asm volatile("" ::: "memory");
            *(LAS u32x4*)(ps + PS_AH + lane * 16) = pf[0]; *(LAS u32x4*)(ps + PS_AH + 1024 + lane * 16) = pf[1];
            *(LAS u32x4*)(ps + PS_RH + lane * 16) = pf[2]; *(LAS u32x4*)(ps + PS_RH + 1024 + lane * 16) = pf[3];
            *(LAS u32x4*)(sl + SL_BH + lane * 16) = pf[4]; *(LAS u32x4*)(sl + SL_BH + 1024 + lane * 16) = pf[5];
            *(LAS u32x4*)(sl + SL_KH + lane * 16) = pf[6]; *(LAS u32x4*)(sl + SL_KH + 1024 + lane * 16) = pf[7];
            *(LAS u32x4*)(sl + SL_V + lane * 16) = pf[8]; *(LAS u32x4*)(sl + SL_V + 1024 + lane * 16) = pf[9];
            *(LAS float*)(sl + SL_PC + lane * 4) = pcn;
            if (c + CS_NPROD < NCHUNK) { CS_ISSUE(c + CS_NPROD); pcn = CS_PCLOAD(c + CS_NPROD); }
            asm volatile("s_waitcnt lgkmcnt(0)" ::: "memory");
#ifndef PROD_REP
#define PROD_REP 1
#endif
#pragma unroll 1
            for (int rpp = 0; rpp < PROD_REP; ++rpp) {
            bf16x8 AHf[2], BHf[2], KHf[2], RHf[2];
#pragma unroll
            for (int ks = 0; ks < 2; ++ks) { const int o = swz(c16, 32 * ks + 8 * q);
                AHf[ks] = *(const LAS bf16x8*)(ps + PS_AH + o); RHf[ks] = *(const LAS bf16x8*)(ps + PS_RH + o); BHf[ks] = *(const LAS bf16x8*)(sl + SL_BH + o); KHf[ks] = *(const LAS bf16x8*)(sl + SL_KH + o); }
            f32x4 Mab = {0.f, 0.f, 0.f, 0.f}, Mak = Mab, MrbT = Mab, MrkT = Mab, MabT = Mab;
#pragma unroll
            for (int ks = 0; ks < 2; ++ks) { Mab = MFMA16(AHf[ks], BHf[ks], Mab); MabT = MFMA16(BHf[ks], AHf[ks], MabT); Mak = MFMA16(AHf[ks], KHf[ks], Mak); MrbT = MFMA16(BHf[ks], RHf[ks], MrbT); MrkT = MFMA16(KHf[ks], RHf[ks], MrkT); }
#pragma unroll
            for (int r = 0; r < 4; ++r) { const bool lt = c16 < 4 * q + r, gt = 4 * q + r < c16, le = 4 * q + r <= c16;
                Mab[r] = lt ? Mab[r] : 0.f; Mak[r] = lt ? Mak[r] : 0.f; MabT[r] = gt ? MabT[r] : 0.f; MrbT[r] = le ? MrbT[r] : 0.f; MrkT[r] = le ? MrkT[r] : 0.f; }
            const f32x4 z4 = {0.f, 0.f, 0.f, 0.f};
            const bf16x8 fN = frag_lo4(Mab), fNT = frag_lo4(MabT);
            const f32x4 N2 = MFMA16(fNT, fN, z4), N2T = MFMA16(fN, fNT, z4);
            f32x4 PT = MabT;
#pragma unroll
            for (int r = 0; r < 4; ++r) PT[r] += (4 * q + r == c16) ? 1.0f : 0.f;
            const bf16x8 fN2 = frag_lo4(N2), fN2T = frag_lo4(N2T);
            PT = MFMA16(fN2, frag_lo4(PT), PT);
            const f32x4 N4 = MFMA16(fN2T, fN2, z4), N4T = MFMA16(fN2, fN2T, z4);
            const bf16x8 fN4 = frag_lo4(N4), fN4T = frag_lo4(N4T);
            PT = MFMA16(fN4, frag_lo4(PT), PT);
            const f32x4 N8 = MFMA16(fN4T, fN4, z4);
            PT = MFMA16(frag_lo4(N8), frag_lo4(PT), PT);
            const bf16x8 LinvF = frag_lo4(PT);
            const bf16x8 MakF = frag_lo4(Mak), MrbTF = frag_lo4(MrbT);
            const f32x4 W1 = MFMA16(LinvF, MakF, z4);
            const f32x4 W1T = MFMA16(MakF, LinvF, z4);
            const f32x4 W2T = MFMA16(frag_lo4(W1), MrbTF, MrkT);
            f32x4 AtT[4], RtT[4];
#pragma unroll
            for (int jt = 0; jt < 4; ++jt) {
                const bf16x8 ahF = frag_cat(__builtin_bit_cast(u32x2, tr_read16(ps + PS_AH + swz(4 * q + qp, 16 * jt + 4 * pp))), (u32x2){0u, 0u});
                const f32x4 AtN = MFMA16(LinvF, ahF, z4);
                AtT[jt] = MFMA16(ahF, LinvF, z4);
                const f32x4 rinit = bf4_to_f32(*(const LAS u32x2*)(ps + PS_RH + swz(c16, 16 * jt + 4 * q)));
                RtT[jt] = MFMA16(frag_lo4(AtN), MrbTF, rinit);
            }
#pragma unroll
            for (int ks = 0; ks < 2; ++ks) {
                const u32x4 wa = {pk_bf16(AtT[2 * ks][0], AtT[2 * ks][1]), pk_bf16(AtT[2 * ks][2], AtT[2 * ks][3]), pk_bf16(AtT[2 * ks + 1][0], AtT[2 * ks + 1][1]), pk_bf16(AtT[2 * ks + 1][2], AtT[2 * ks + 1][3])};
                const u32x4 wr = {pk_bf16(RtT[2 * ks][0], RtT[2 * ks][1]), pk_bf16(RtT[2 * ks][2], RtT[2 * ks][3]), pk_bf16(RtT[2 * ks + 1][0], RtT[2 * ks + 1][1]), pk_bf16(RtT[2 * ks + 1][2], RtT[2 * ks + 1][3])};
                *(LAS u32x4*)(sl + SL_ATIL + ks * 1024 + lane * 16) = wa; *(LAS u32x4*)(sl + SL_RTIL + ks * 1024 + lane * 16) = wr; }
            *(LAS u32x2*)(sl + SL_ULOC + lane * 8) = f32_to_bf4(W1T); *(LAS u32x2*)(sl + SL_YLOC + lane * 8) = f32_to_bf4(W2T);
            }
            asm volatile("s_waitcnt lgkmcnt(0)" ::: "memory");
            if (lane == 0) FULL[slot] = (unsigned)(c + 1);
        }
#undef CS_ISSUE
#undef CS_PCLOAD
    } else {
        struct ConsOps { bf16x8 at0, at1, rt0, rt1, bk[4]; u32x2 w1w, w2w, vfw[2]; f32x4 pc[4]; };
        f32x4 S[2][4];
#pragma unroll
        for (int ti = 0; ti < 2; ++ti)
#pragma unroll
            for (int mt = 0; mt < 4; ++mt) S[ti][mt] = (f32x4){0.f, 0.f, 0.f, 0.f};
#define CONS_LOAD(X, cc) do { const int slot_ = (cc) % CS_NS; LAS unsigned char* sl_ = lds + slot_ * SL_BYTES; \
            { unsigned sp_ = 0; while (FULL[slot_] < (unsigned)((cc) + 1)) { __builtin_amdgcn_s_sleep(1); if (++sp_ > (1u << 22)) break; } } \
            asm volatile("" ::: "memory"); \
            X.at0 = *(const LAS bf16x8*)(sl_ + SL_ATIL + lane * 16); X.at1 = *(const LAS bf16x8*)(sl_ + SL_ATIL + 1024 + lane * 16); \
            X.rt0 = *(const LAS bf16x8*)(sl_ + SL_RTIL + lane * 16); X.rt1 = *(const LAS bf16x8*)(sl_ + SL_RTIL + 1024 + lane * 16); \
            X.w1w = *(const LAS u32x2*)(sl_ + SL_ULOC + lane * 8); X.w2w = *(const LAS u32x2*)(sl_ + SL_YLOC + lane * 8); \
            _Pragma("unroll") for (int mt_ = 0; mt_ < 4; ++mt_) { X.pc[mt_] = *(const LAS f32x4*)(sl_ + SL_PC + (16 * mt_ + 4 * q) * 4); \
                X.bk[mt_] = frag_cat(__builtin_bit_cast(u32x2, tr_read16(sl_ + SL_BH + swz(4 * q + qp, 16 * mt_ + 4 * pp))), __builtin_bit_cast(u32x2, tr_read16(sl_ + SL_KH + swz(4 * q + qp, 16 * mt_ + 4 * pp)))); } \
            _Pragma("unroll") for (int ti_ = 0; ti_ < 2; ++ti_) X.vfw[ti_] = __builtin_bit_cast(u32x2, tr_read16(sl_ + SL_V + swz(4 * q + qp, 16 * (2 * wave + ti_) + 4 * pp))); } while (0)
#define CONS_COMPUTE(X, cc) do { const f32x4 z4c_ = {0.f, 0.f, 0.f, 0.f}; const bf16x8 w1f_ = frag_cat(X.w1w, (u32x2){0u, 0u}), w2f_ = frag_cat(X.w2w, (u32x2){0u, 0u}); \
            _Pragma("unroll") for (int ti_ = 0; ti_ < 2; ++ti_) { const int nt_ = 2 * wave + ti_; \
                const bf16x8 vB_ = frag_cat(X.vfw[ti_], (u32x2){0u, 0u}); \
                const bf16x8 Sb0_ = frag_cat(f32_to_bf4(S[ti_][0]), f32_to_bf4(S[ti_][1])), Sb1_ = frag_cat(f32_to_bf4(S[ti_][2]), f32_to_bf4(S[ti_][3])); \
                const f32x4 U0_ = MFMA16(X.at0, Sb0_, MFMA16(w1f_, vB_, z4c_)), U1_ = MFMA16(X.at1, Sb1_, z4c_); \
                const f32x4 Y0_ = MFMA16(X.rt0, Sb0_, MFMA16(w2f_, vB_, z4c_)), Y1_ = MFMA16(X.rt1, Sb1_, z4c_); \
                const f32x4 UT_ = U0_ + U1_, YT_ = Y0_ + Y1_; \
                const bf16x8 Ub_ = frag_cat(f32_to_bf4(UT_), X.vfw[ti_]); \
                _Pragma("unroll") for (int mt_ = 0; mt_ < 4; ++mt_) { S[ti_][mt_] = MFMA16(X.bk[mt_], Ub_, S[ti_][mt_]); S[ti_][mt_] = S[ti_][mt_] * X.pc[mt_]; } \
                *(f32x4*)(Yg + ((((size_t)b * NCHUNK + (dir ? (NCHUNK - 1 - (cc)) : (cc))) * NH + hd) * 64 + 16 * nt_ + c16) * 16 + 4 * q) = YT_; } } while (0)
#define CONS_DONE(cc) do { asm volatile("s_waitcnt lgkmcnt(0)" ::: "memory"); if (lane == 0) (void)__hip_atomic_fetch_add((LAS unsigned*)&DONE[(cc) % CS_NS], 1u, __ATOMIC_RELAXED, __HIP_MEMORY_SCOPE_WORKGROUP); } while (0)
        ConsOps OA, OB;
        CONS_LOAD(OA, 0);
#pragma unroll 1
        for (int c = 0; c < NCHUNK; c += 2) {
            CONS_LOAD(OB, c + 1);
            CONS_COMPUTE(OA, c);
            CONS_DONE(c);
            if (c + 2 < NCHUNK) CONS_LOAD(OA, c + 2);
            CONS_COMPUTE(OB, c + 1);
            CONS_DONE(c + 1);
        }
#undef CONS_LOAD
#undef CONS_COMPUTE
#undef CONS_DONE
        unsigned tq0 = 0u, tq1 = 0u, tq2 = 0u, tq3 = 0u, tq4 = 0u, tq5 = 0u, tacc = 0u;
        (void)tq0; (void)tq1; (void)tq2; (void)tq3; (void)tq4; (void)tq5;
        (void)tacc;
    }
}

__device__ __forceinline__ void phase_post(const Args& a, int G) {
    int tid = tid_of(a.wv); asm volatile("" : "+v"(tid)); const int lane = tid & 63, wave = __builtin_amdgcn_readfirstlane(tid >> 6);
    const int gw = blockIdx.x * 8 + wave, NGW = G * 8, t = lane & 15, iq = lane >> 4;
    const float* __restrict__ YF = (const float*)(a.ws + WS_YF); const float* __restrict__ YB = (const float*)(a.ws + WS_YB); const float* __restrict__ BON = (const float*)(a.ws + WS_BON);
    const bf16_t* __restrict__ Vg = (const bf16_t*)scan_arr(a.ws, 0); const bf16_t* __restrict__ Gg = (const bf16_t*)(a.ws + WS_G); bf16_t* __restrict__ MIX = (bf16_t*)(a.ws + WS_MIX);
    float* ss = (float*)(a.ws + WS_SS);
    for (int i = blockIdx.x * NTHREADS + tid; i < T; i += G * NTHREADS) ss[i] = 0.f;
    constexpr int NIT = (T / 16) * NH;
#pragma unroll 1
    for (int it = gw; it < NIT; it += NGW) {
        const int tile = it / NH, hd = it - tile * NH, tok = tile * 16 + t;
        const float* yfp = YF + ((size_t)it * 64 + 16 * iq) * 16 + t; const float* ybp = YB + ((size_t)it * 64 + 16 * iq) * 16 + (15 - t);
        float y[16];
#pragma unroll
        for (int k = 0; k < 16; ++k) y[k] = yfp[k * 16] + ybp[k * 16];
        const u32x4 v0 = *(const u32x4*)(Vg + ((size_t)it * 16 + t) * 64 + 16 * iq), v1 = *(const u32x4*)(Vg + ((size_t)it * 16 + t) * 64 + 16 * iq + 8);
        const u32x4 g0 = *(const u32x4*)(Gg + (size_t)tok * RW + hd * 64 + 16 * iq), g1 = *(const u32x4*)(Gg + (size_t)tok * RW + hd * 64 + 16 * iq + 8);
        const float bon = BON[(size_t)tok * NH + hd] + BON[(size_t)T * NH + (size_t)tok * NH + hd];
        float sm = 0.f;
#pragma unroll
        for (int k = 0; k < 16; ++k) sm += y[k];
        sm += __shfl_xor(sm, 16); sm += __shfl_xor(sm, 32);
        const float mean = sm * (1.f / 64.f); float vs = 0.f;
#pragma unroll
        for (int k = 0; k < 16; ++k) { y[k] -= mean; vs += y[k] * y[k]; }
        vs += __shfl_xor(vs, 16); vs += __shfl_xor(vs, 32);
        const float rstd = 1.0f / sqrtf(vs * (1.f / 64.f) + 64e-5f);
        const unsigned vw[8] = {v0.x, v0.y, v0.z, v0.w, v1.x, v1.y, v1.z, v1.w}, gwd[8] = {g0.x, g0.y, g0.z, g0.w, g1.x, g1.y, g1.z, g1.w};
        unsigned ow[8];
#pragma unroll
        for (int k2 = 0; k2 < 8; ++k2) { const int ch = hd * 64 + 16 * iq + 2 * k2;
            const float o0 = (y[2 * k2] * rstd * a.in[I_LNXG][ch] + a.in[I_LNXB][ch] + bon * bf_lo(vw[k2])) * bf_lo(gwd[k2]);
            const float o1 = (y[2 * k2 + 1] * rstd * a.in[I_LNXG][ch + 1] + a.in[I_LNXB][ch + 1] + bon * bf_hi(vw[k2])) * bf_hi(gwd[k2]);
            ow[k2] = pk_bf16(o0, o1); }
        bf16_t* op = MIX + (size_t)tok * D + 640 + hd * 64 + 16 * iq;
        *(u32x4*)op = (u32x4){ow[0], ow[1], ow[2], ow[3]}; *(u32x4*)(op + 8) = (u32x4){ow[4], ow[5], ow[6], ow[7]};
    }
}

constexpr int RT_WS = 2064;
__device__ __forceinline__ void phase_router(const Args& a, LAS unsigned char* lds, int G) {
    int tid = tid_of(a.wv); asm volatile("" : "+v"(tid)); const int lane = tid & 63, wave = __builtin_amdgcn_readfirstlane(tid >> 6);
    const int gw = blockIdx.x * 8 + wave, NGW = G * 8, l15 = lane & 15, kq = lane >> 4;
    LAS bf16_t* WH = (LAS bf16_t*)lds; LAS bf16_t* WL = (LAS bf16_t*)(lds + 16 * RT_WS);
    for (int i = tid; i < D * NE; i += NTHREADS) { const int k = i >> 4, e = i & 15; const float w = a.in[I_WROUTER][i];
        const unsigned hi = pk_bf16(w, 0.f) & 0xffffu; const float rem = w - bf_lo(hi);
        WH[e * (RT_WS / 2) + k] = (bf16_t)hi; WL[e * (RT_WS / 2) + k] = (bf16_t)(pk_bf16(rem, 0.f) & 0xffffu); }
    __syncthreads();
    const float* __restrict__ X1 = (const float*)(a.ws + WS_X1); const float* __restrict__ ss = (const float*)(a.ws + WS_SS); bf16_t* __restrict__ H2 = (bf16_t*)(a.ws + WS_H2);
    float* __restrict__ AFF = (float*)(a.ws + WS_AFF); int* __restrict__ INV = (int*)(a.ws + WS_INV);
    const float* __restrict__ GF = a.in[I_NFFNG];
    for (int grp = gw; grp < T / 16; grp += NGW) {
        const int tok = grp * 16 + l15;
        const float rs = 1.0f / sqrtf(ss[tok] * (1.f / D) + 1e-6f);
        f32x4 acc = {0.f, 0.f, 0.f, 0.f};
        const float* xrow = X1 + (size_t)tok * D + 8 * kq; unsigned char* hrow8 = (unsigned char*)H2 + (size_t)tok * D + 8 * kq;
#pragma unroll 8
        for (int ks = 0; ks < 32; ++ks) {
            const f32x4 x0 = *(const f32x4*)(xrow + 32 * ks), x1v = *(const f32x4*)(xrow + 32 * ks + 4);
            const f32x4 g0 = *(const f32x4*)(GF + 32 * ks + 8 * kq), g1 = *(const f32x4*)(GF + 32 * ks + 8 * kq + 4);
            const f32x4 h0 = x0 * rs * g0, h1 = x1v * rs * g1;
            u32x4 hi; hi.x = pk_bf16(h0.x, h0.y); hi.y = pk_bf16(h0.z, h0.w); hi.z = pk_bf16(h1.x, h1.y); hi.w = pk_bf16(h1.z, h1.w);
            *(u32x2*)(hrow8 + 32 * ks) = (u32x2){pk_fp8x4(h0.x, h0.y, h0.z, h0.w), pk_fp8x4(h1.x, h1.y, h1.z, h1.w)};
            u32x4 lo; lo.x = pk_bf16(h0.x - bf_lo(hi.x), h0.y - bf_hi(hi.x)); lo.y = pk_bf16(h0.z - bf_lo(hi.y), h0.w - bf_hi(hi.y));
            lo.z = pk_bf16(h1.x - bf_lo(hi.z), h1.y - bf_hi(hi.z)); lo.w = pk_bf16(h1.z - bf_lo(hi.w), h1.w - bf_hi(hi.w));
            const bf16x8 ah = __builtin_bit_cast(bf16x8, hi), al = __builtin_bit_cast(bf16x8, lo);
            const bf16x8 bh = *(const LAS bf16x8*)(lds + l15 * RT_WS + (32 * ks + 8 * kq) * 2), bl = *(const LAS bf16x8*)(lds + 16 * RT_WS + l15 * RT_WS + (32 * ks + 8 * kq) * 2);
            acc = __builtin_amdgcn_mfma_f32_16x16x32_bf16(ah, bh, acc, 0, 0, 0);
            acc = __builtin_amdgcn_mfma_f32_16x16x32_bf16(al, bh, acc, 0, 0, 0);
            acc = __builtin_amdgcn_mfma_f32_16x16x32_bf16(ah, bl, acc, 0, 0, 0);
        }
#pragma unroll
        for (int rg = 0; rg < 4; ++rg) { const float mx = max16(acc[rg]); const float ex = __expf(acc[rg] - mx); const float sm = sum16(ex);
            const int t2 = grp * 16 + 4 * kq + rg, bb = t2 >> 12, sq = t2 & (SEQ - 1);
            AFF[((size_t)(bb * NE + l15)) * SEQ + sq] = ex / sm; }
        *(u32x4*)(INV + (size_t)grp * 256 + 4 * lane) = (u32x4){0xffffffffu, 0xffffffffu, 0xffffffffu, 0xffffffffu};
    }
}

__device__ __forceinline__ void topk_unit(const Args& a, LAS unsigned char* lds, int unit) {
    int tid = tid_of(a.wv); asm volatile("" : "+v"(tid)); const int lane = tid & 63, wave = __builtin_amdgcn_readfirstlane(tid >> 6);
    const int b = unit >> 4, e = unit & 15;
    const float* AFF = (const float*)(a.ws + WS_AFF) + (size_t)unit * SEQ;
    LAS unsigned* KEY = (LAS unsigned*)lds;
    LAS unsigned* HIST = (LAS unsigned*)(lds + 16384);
    LAS unsigned* CTL = (LAS unsigned*)(lds + 16384 + 1024);
    LAS unsigned* WS_ = (LAS unsigned*)(lds + 16384 + 2048);
    __syncthreads();
    unsigned key[8];
    { const u32x4 k0 = *(const u32x4*)(AFF + tid * 8), k1 = *(const u32x4*)(AFF + tid * 8 + 4); key[0] = k0.x; key[1] = k0.y; key[2] = k0.z; key[3] = k0.w; key[4] = k1.x; key[5] = k1.y; key[6] = k1.z; key[7] = k1.w; }
    if (tid == 0) { CTL[0] = 0u; CTL[1] = (unsigned)CAP; }
    unsigned prefix = 0u, mask = 0u;
#pragma unroll 1
    for (int pass = 0; pass < 4; ++pass) {
        const int shift = 24 - 8 * pass;
        if (tid < 256) HIST[tid] = 0u;
        __syncthreads();
#pragma unroll
        for (int i = 0; i < 8; ++i) if ((key[i] & mask) == prefix) (void)__hip_atomic_fetch_add(&HIST[(key[i] >> shift) & 255u], 1u, __ATOMIC_RELAXED, __HIP_MEMORY_SCOPE_WORKGROUP);
        __syncthreads();
        if (wave == 0) {
            const unsigned need = CTL[1];
            unsigned hv[4], tsum = 0u;
#pragma unroll
            for (int i = 0; i < 4; ++i) { hv[i] = HIST[255 - (4 * lane + i)]; tsum += hv[i]; }
            unsigned inc = tsum;
#pragma unroll
            for (int o = 1; o < 64; o <<= 1) { const unsigned v = __shfl_up(inc, o); if (lane >= o) inc += v; }
            unsigned exc = inc - tsum;
            if (exc < need && need <= inc) {
                unsigned run = exc; int di = 0;
#pragma unroll
                for (int i = 0; i < 4; ++i) { if (run < need && need <= run + hv[i]) { di = i; break; } run += hv[i]; }
                const unsigned digit = 255u - (unsigned)(4 * lane + di);
                CTL[0] = prefix | (digit << shift); CTL[1] = need - run;
            }
        }
        __syncthreads();
        prefix = CTL[0]; mask |= (255u << shift);
    }
    const unsigned thr = prefix, need_eq = CTL[1];
    unsigned ngt = 0u, neq = 0u;
#pragma unroll
    for (int i = 0; i < 8; ++i) { ngt += (key[i] > thr) ? 1u : 0u; neq += (key[i] == thr) ? 1u : 0u; }
    unsigned pk = ngt | (neq << 16), inc = pk;
#pragma unroll
    for (int o = 1; o < 64; o <<= 1) { const unsigned v = __shfl_up(inc, o); if (lane >= o) inc += v; }
    if (lane == 63) WS_[wave] = inc;
    __syncthreads();
    unsigned woff = 0u, tot = 0u;
#pragma unroll
    for (int w = 0; w < 8; ++w) { const unsigned v = WS_[w]; if (w < wave) woff += v; tot += v; }
    const unsigned exc = inc - pk + woff;
    unsigned gpos = exc & 0xffffu, epos = exc >> 16; const unsigned totgt = tot & 0xffffu;
    const int sbase = (e * BATCH + b) * CAP;
    int* ROWTOK = (int*)(a.ws + WS_ROWTOK); float* ROWGATE = (float*)(a.ws + WS_ROWGATE); int* INV = (int*)(a.ws + WS_INV);
#pragma unroll
    for (int i = 0; i < 8; ++i) {
        int pos = -1;
        if (key[i] > thr) pos = (int)gpos++;
        else if (key[i] == thr) { if (epos < need_eq) pos = (int)(totgt + epos); epos++; }
        if (pos >= 0) { const int s = tid * 8 + i, tok = b * SEQ + s, slot = sbase + pos;
            ROWTOK[slot] = tok; ROWGATE[slot] = __builtin_bit_cast(float, key[i]); INV[(size_t)tok * NE + e] = slot; }
    }
}

__device__ __forceinline__ void phase_final(const Args& a, int G) {
    int tid = tid_of(a.wv); asm volatile("" : "+v"(tid)); const int lane = tid & 63, wave = __builtin_amdgcn_readfirstlane(tid >> 6);
    const int gw = blockIdx.x * 8 + wave, NGW = G * 8;
    const float* __restrict__ X1 = (const float*)(a.ws + WS_X1); const bf16_t* __restrict__ YE = (const bf16_t*)(a.ws + WS_YE); const int* __restrict__ INV = (const int*)(a.ws + WS_INV);
    float* __restrict__ OUT = a.out;
    f32x4 gg[4];
#pragma unroll
    for (int j = 0; j < 4; ++j) gg[j] = *(const f32x4*)(a.in[I_FNG] + 4 * lane + 256 * j);
    int tok = gw;
    int invn = (tok < T) ? INV[(size_t)tok * NE + (lane & 15)] : -1;
    f32x4 xn[4];
#pragma unroll
    for (int j = 0; j < 4; ++j) xn[j] = (tok < T) ? *(const f32x4*)(X1 + (size_t)tok * D + 4 * lane + 256 * j) : (f32x4){0.f, 0.f, 0.f, 0.f};
    for (; tok < T; tok += NGW) {
        const int invc = invn; f32x4 v[4];
#pragma unroll
        for (int j = 0; j < 4; ++j) v[j] = xn[j];
        const int tn = tok + NGW;
        if (tn < T) { invn = INV[(size_t)tn * NE + (lane & 15)];
#pragma unroll
            for (int j = 0; j < 4; ++j) xn[j] = *(const f32x4*)(X1 + (size_t)tn * D + 4 * lane + 256 * j); }
        unsigned long long m = __ballot(invc >= 0) & 0xffffull;
        const int n = __builtin_popcountll(m);
        int sl[4]; float wt[4];
#pragma unroll
        for (int k = 0; k < 4; ++k) { int e = 0; if (m) { e = __builtin_ctzll(m); m &= m - 1; wt[k] = 1.f; sl[k] = __builtin_amdgcn_readlane(invc, e); } else { wt[k] = 0.f; sl[k] = 0; } }
        u32x2 rw[4][4];
#pragma unroll
        for (int k = 0; k < 4; ++k)
#pragma unroll
            for (int j = 0; j < 4; ++j) rw[k][j] = *(const u32x2*)(YE + (size_t)sl[k] * D + 4 * lane + 256 * j);
#pragma unroll
        for (int k = 0; k < 4; ++k)
#pragma unroll
            for (int j = 0; j < 4; ++j) { v[j].x += wt[k] * bf_lo(rw[k][j].x); v[j].y += wt[k] * bf_hi(rw[k][j].x); v[j].z += wt[k] * bf_lo(rw[k][j].y); v[j].w += wt[k] * bf_hi(rw[k][j].y); }
        if (n > 4) { while (m) { const int e = __builtin_ctzll(m); m &= m - 1; const int slot = __builtin_amdgcn_readlane(invc, e);
#pragma unroll
                for (int j = 0; j < 4; ++j) { const u32x2 w = *(const u32x2*)(YE + (size_t)slot * D + 4 * lane + 256 * j);
                    v[j].x += bf_lo(w.x); v[j].y += bf_hi(w.x); v[j].z += bf_lo(w.y); v[j].w += bf_hi(w.y); } } }
        float sq = 0.f;
#pragma unroll
        for (int j = 0; j < 4; ++j) sq += (v[j].x * v[j].x + v[j].y * v[j].y) + (v[j].z * v[j].z + v[j].w * v[j].w);
        float rs = 1.0f / sqrtf(wave_sum(sq) * (1.f / D) + 1e-6f);
#pragma unroll
        for (int j = 0; j < 4; ++j) *(f32x4*)(OUT + (size_t)tok * D + 4 * lane + 256 * j) = v[j] * rs * gg[j];
    }
}

#define XB_TMO      128
#define XB_XCNT(j)  (256  + 64 * (j))
#define XB_XSUB(j)  (1280 + 64 * (j))
#define XB_XGEN(j)  (2304 + 64 * (j))
#define XB_TOP      3328
#define XB_TOPGEN   3392
#define XCD_BAR_WORDS 3456
#define XB_SPIN_CAP (1u << 22)
__device__ __forceinline__ unsigned xb_ld(unsigned* p)              { return __hip_atomic_load(p, __ATOMIC_RELAXED, __HIP_MEMORY_SCOPE_AGENT); }
__device__ __forceinline__ unsigned xb_add(unsigned* p, unsigned v) { return __hip_atomic_fetch_add(p, v, __ATOMIC_RELAXED, __HIP_MEMORY_SCOPE_AGENT); }
__device__ __forceinline__ unsigned xb_xcc_id() { return (unsigned)__builtin_amdgcn_s_getreg((3 << 11) | 20) & 0xFu; }
#define XB_SPIN(cond, bar) do { unsigned _sp = 0; while (cond) { __builtin_amdgcn_s_sleep(1); \
    if ((++_sp & 255u) == 0u) { if (xb_ld(&(bar)[XB_TMO])) break; if (_sp > XB_SPIN_CAP) { atomicAdd(&(bar)[XB_TMO], 1u); break; } } } } while (0)
struct XcdBarrier { unsigned* bar; unsigned x; volatile LAS unsigned* st; int wv; };
__device__ __forceinline__ XcdBarrier xcd_barrier_post(unsigned* bar, volatile LAS unsigned* st, int wv) {
    XcdBarrier b; b.bar = bar; b.x = xb_xcc_id(); b.st = st; b.wv = wv;
    if (threadIdx.x == 0) (void)xb_add(&bar[XB_XCNT(b.x)], 1u);
    return b;
}
__device__ __forceinline__ void xcd_barrier_complete(unsigned* bar, unsigned x, unsigned& nloc, unsigned& nx) {
    const unsigned G = gridDim.x * gridDim.y * gridDim.z;
    unsigned sum, cnt, mine, sp = 0u;
    for (;;) {
        sum = 0u; cnt = 0u; mine = 0u;
#pragma unroll
        for (unsigned j = 0; j < 16; ++j) { const unsigned c = xb_ld(&bar[XB_XCNT(j)]); sum += c; cnt += (c > 0u) ? 1u : 0u; mine = (j == x) ? c : mine; }
        if (sum == G) break;
        __builtin_amdgcn_s_sleep(1);
        if ((++sp & 255u) == 0u) { if (xb_ld(&bar[XB_TMO])) break; if (sp > XB_SPIN_CAP) { atomicAdd(&bar[XB_TMO], 1u); break; } }
    }
    nloc = mine > 0u ? mine : 1u; nx = cnt > 0u ? cnt : 1u;
}
__device__ __forceinline__ void xcd_barrier(const XcdBarrier& b) {
    asm volatile("s_waitcnt vmcnt(0)" ::: "memory");
    __syncthreads();
    if (tid_of(b.wv) == 0) {
        unsigned* bar = b.bar;
        __builtin_amdgcn_s_waitcnt(0);
        unsigned nloc = b.st[0], nx = b.st[1];
        if (nloc == 0u) { xcd_barrier_complete(bar, b.x, nloc, nx); b.st[0] = nloc; b.st[1] = nx; }
        const unsigned old = xb_add(&bar[XB_XSUB(b.x)], 1u);
        const unsigned gen = old / nloc;
        if (old + 1u == (gen + 1u) * nloc) {
            __builtin_amdgcn_fence(__ATOMIC_RELEASE, "agent");
            asm volatile("s_waitcnt vmcnt(0)" ::: "memory");
            const unsigned og = xb_add(&bar[XB_TOP], 1u);
            const unsigned tg = og / nx;
            if (og + 1u == (tg + 1u) * nx) xb_add(&bar[XB_TOPGEN], 1u);
            else XB_SPIN(xb_ld(&bar[XB_TOPGEN]) == tg, bar);
            __builtin_amdgcn_fence(__ATOMIC_ACQUIRE, "agent");
            xb_add(&bar[XB_XGEN(b.x)], 1u);
            asm volatile("s_waitcnt vmcnt(0)" ::: "memory");
        } else {
            XB_SPIN(xb_ld(&bar[XB_XGEN(b.x)]) == gen, bar);
            __builtin_amdgcn_fence(__ATOMIC_ACQUIRE, "agent");
            asm volatile("s_waitcnt vmcnt(0)" ::: "memory");
        }
    }
    __syncthreads();
}

#ifndef PH_MASK
#define PH_MASK 0x7ff
#endif
#ifndef REP_MASK
#define REP_MASK 0
#endif
#ifndef P2_MASK
#define P2_MASK 7
#endif
#ifndef P2_REP
#define P2_REP 0
#define P9_REP 0
#endif
constexpr int LDS_MISC = LDS_BYTES - 64;
constexpr int LDS_PTAB = LDS_BYTES - 512;
__device__ __forceinline__ Args load_args(LAS unsigned char* lds, int lo, int hi, int wv) {
    Args r; const LAS u32x2* t = (const LAS u32x2*)(lds + LDS_PTAB);
#pragma unroll
    for (int i = 0; i < 31; ++i) { const u32x2 v = t[i]; const unsigned long long p = ((unsigned long long)(unsigned)__builtin_amdgcn_readfirstlane((int)v.y) << 32) | (unsigned)__builtin_amdgcn_readfirstlane((int)v.x);
        if (i < 29) r.in[i] = (const float*)p; else if (i == 29) r.out = (float*)p; else r.ws = (unsigned char*)p; }
    r.ph_lo = lo; r.ph_hi = hi; r.wv = wv; r.zero_ = 0; return r;
}
constexpr size_t WS_CTL = 0, CTL_BYTES = 16384;
__global__ void __launch_bounds__(NTHREADS, 2) mega(Args a0) {
    extern __shared__ __attribute__((aligned(16))) unsigned char lds_raw[];
    LAS unsigned char* lds = (LAS unsigned char*)lds_raw;
    cg::grid_group grid = cg::this_grid();
    const int G = gridDim.x, lo = a0.ph_lo, hi = a0.ph_hi, wv0 = __builtin_amdgcn_readfirstlane((int)threadIdx.x >> 6);
    volatile LAS unsigned* misc = (volatile LAS unsigned*)(lds + LDS_MISC);
    if (threadIdx.x < 16) misc[threadIdx.x] = 0u;
    if (threadIdx.x == 0) { LAS unsigned long long* t = (LAS unsigned long long*)(lds + LDS_PTAB);
#pragma unroll
        for (int i = 0; i < 29; ++i) t[i] = (unsigned long long)a0.in[i];
        t[29] = (unsigned long long)a0.out; t[30] = (unsigned long long)a0.ws; }
    __syncthreads();
    if (lo < -1000) grid.sync();
    XcdBarrier xbar = xcd_barrier_post((unsigned*)(a0.ws + WS_CTL), misc, wv0);
#define IN(k) (((PH_MASK >> (k)) & 1) && lo <= (k) && (k) < hi)
#define NREP(k) (1 + ((REP_MASK >> (k)) & 1))
#define PHASE(k, ...) do { if (IN(k)) { for (int rep_ = 0; rep_ < NREP(k); ++rep_) { { const Args a = load_args(lds, lo, hi, wv0); unsigned char* const ws = a.ws; (void)ws; __VA_ARGS__; } if (rep_ + 1 < NREP(k) || IN((k) + 1)) { xcd_barrier(xbar); } } } } while (0)

    PHASE(0, phase_prep(a, lds, G));

    PHASE(1, {
        pg8::Gemm g{(const bf16_t*)(ws + WS_XH), (const bf16_t*)(ws + WS_WINT), T, IN_PROJ, D, 0, 0};
        pg8::TripleOrder S; S.S0.init(T, IN_PROJ, G, 0); S.A1 = (const bf16_t*)(ws + WS_MEMN); S.B1 = (const bf16_t*)(ws + WS_WKT); S.A2 = (const bf16_t*)(ws + WS_WVT); S.B2 = (const bf16_t*)(ws + WS_MEMN);
        S.n1 = BATCH * NMEM / 256; S.n2 = BATCH * NMEM / 256; S.G = G; S.c = (int)blockIdx.x;
        pg8::EpiBf16x3 E{pg8::EpiBf16{(bf16_t*)(ws + WS_P), PLD, (bf16_t*)(ws + WS_Q)}, pg8::EpiBf16{(bf16_t*)(ws + WS_KMEM), 256, nullptr}, pg8::EpiBf16{(bf16_t*)(ws + WS_VT), BATCH * NMEM, nullptr}};
        pg8::gemm_phase<pg8::EpiBf16x3, pg8::TripleOrder, false>(lds, g, S, E, nullptr, a.wv);
    });

    constexpr int NSCAN = BATCH * NH * 2;
    PHASE(2, {
        for (int u = blockIdx.x; u < 2048; u += G) {
            if (u < 1024) { for (int r2 = 0; r2 < 1 + ((P2_REP >> 1) & 1); ++r2) conv_unit(a, lds, u); }
            else { for (int r2 = 0; r2 < 1 + ((P2_REP >> 2) & 1); ++r2) prep_unit(a, lds, u - 1024); }
        }
    });

    PHASE(3, {
        int bid = blockIdx.x; int Gp = G; asm volatile("" : "+s"(bid), "+s"(Gp));
        for (int u = bid; u < NSCAN; u += Gp) scan_chunked_unit(a, lds, u);
        if (rep_ == 0) {
            if (Gp > NSCAN) { if (bid >= NSCAN) { for (int u = bid - NSCAN; u < 64; u += Gp - NSCAN) for (int r2 = 0; r2 < 1 + (P2_REP & 1); ++r2) attn_unit(a, lds, u);
                                                 } }
            else { for (int u = bid; u < 64; u += Gp) attn_unit(a, lds, u); }
        }
    });

    PHASE(4, phase_post(a, G));

    PHASE(5, {
        pg8::Gemm g{(const bf16_t*)(ws + WS_MIX), (const bf16_t*)(ws + WS_WOUTT), T, D, D, 0, 0}; pg8::StaticOrder S; S.init(T, D, G, (int)blockIdx.x);
        pg8::EpiResidSS E{a.in[I_X], (float*)(ws + WS_X1), (float*)(ws + WS_SS)}; pg8::gemm_phase<pg8::EpiResidSS, pg8::StaticOrder, false>(lds, g, S, E, nullptr, a.wv);
    });

    PHASE(6, phase_router(a, lds, G));

    PHASE(7, { for (int u = blockIdx.x; u < BATCH * NE; u += G) topk_unit(a, lds, u); });

    PHASE(8, {
        pg8::Gemm g{(const bf16_t*)(ws + WS_H2), (const bf16_t*)(ws + WS_WGUT), NSLOT, 2048, D / 2, 0x7A7A7A7A, 0x7F7F7F7F};     pg8::ExpertOrder S; S.init(32, 8, NE, G, (int)blockIdx.x);
        pg8::EpiSwiGLU E{(bf16_t*)(ws + WS_HID)}; pg8::gemm_phase<pg8::EpiSwiGLU, pg8::ExpertOrder, true, false, true>(lds, g, S, E, (const int*)(ws + WS_ROWTOK), a.wv);
    });

    PHASE(9, {
        pg8::Gemm g{(const bf16_t*)(ws + WS_HID), (const bf16_t*)(ws + WS_WDT), NSLOT, D, FF / 2, 0x7A7A7A7A, 0x7C7C7C7C};     pg8::ExpertOrder S; S.init(32, 4, NE, G, (int)blockIdx.x);
        pg8::EpiGateScale E{(bf16_t*)(ws + WS_YE), (const float*)(ws + WS_ROWGATE)}; pg8::gemm_phase<pg8::EpiGateScale, pg8::ExpertOrder, false, true, true>(lds, g, S, E, nullptr, a.wv);
#if P9_REP
        __syncthreads(); pg8::gemm_phase<pg8::EpiGateScale, pg8::ExpertOrder, false, true, true>(lds, g, S, E, nullptr, a.wv);
#endif
    });

    PHASE(10, phase_final(a, G));
#undef IN
#undef NREP
#undef PHASE
}

#ifndef MK_ONE_LAUNCH
#define MK_ONE_LAUNCH 1
#endif
extern "C" void kernel_launch(void* const* d_in, const int* in_sizes, int n_in, void* d_out, int out_size, void* d_ws, size_t ws_size, hipStream_t stream) {
    static int grid_blocks = 0;
    if (grid_blocks == 0) {
        if (n_in != 29 || out_size != T * D || ws_size < WS_END) { fprintf(stderr, "kernel_launch: unexpected problem: n_in %d out %d ws %zu (need %zu)\n", n_in, out_size, ws_size, (size_t)WS_END); grid_blocks = -1; return; }
        int dev = 0, cus = 0, per_cu = 0;
        if (hipGetDevice(&dev) != hipSuccess || hipDeviceGetAttribute(&cus, hipDeviceAttributeMultiprocessorCount, dev) != hipSuccess) { grid_blocks = -1; return; }
        if (hipFuncSetAttribute((const void*)mega, hipFuncAttributeMaxDynamicSharedMemorySize, LDS_BYTES) != hipSuccess) { fprintf(stderr, "kernel_launch: hipFuncSetAttribute failed\n"); grid_blocks = -1; return; }
        if (hipOccupancyMaxActiveBlocksPerMultiprocessor(&per_cu, (const void*)mega, NTHREADS, LDS_BYTES) != hipSuccess || per_cu < 1) { fprintf(stderr, "kernel_launch: occupancy query says %d blocks per CU\n", per_cu); grid_blocks = -1; return; }
        grid_blocks = cus;
    }
    if (grid_blocks < 0) return;
    if (hipMemsetAsync((char*)d_ws + WS_CTL, 0, CTL_BYTES, stream) != hipSuccess) { fprintf(stderr, "kernel_launch: memset failed\n"); return; }
    Args a{};
    for (int i = 0; i < 29; ++i) a.in[i] = (const float*)d_in[i];
    a.out = (float*)d_out; a.ws = (unsigned char*)d_ws;
#if MK_ONE_LAUNCH
    a.ph_lo = 0; a.ph_hi = NPHASE;
    { void* args[] = {&a}; hipError_t e = hipLaunchCooperativeKernel((const void*)mega, dim3(grid_blocks), dim3(NTHREADS), args, LDS_BYTES, stream);
      if (e != hipSuccess) fprintf(stderr, "cooperative launch failed: %s (grid %d)\n", hipGetErrorString(e), grid_blocks); }
#else
    for (int ph = 0; ph < NPHASE; ++ph) { a.ph_lo = ph; a.ph_hi = ph + 1; void* args[] = {&a};
        hipError_t e = hipLaunchCooperativeKernel((const void*)mega, dim3(grid_blocks), dim3(NTHREADS), args, LDS_BYTES, stream);
        if (e != hipSuccess) { fprintf(stderr, "cooperative launch %d failed: %s (grid %d)\n", ph, hipGetErrorString(e), grid_blocks); break; } }
#endif
}
```

```cpp
#include <hip/hip_runtime.h>
#include <hip/hip_cooperative_groups.h>
#include <cstdio>
#include <cstdint>
namespace cg = cooperative_groups;

#define LAS __attribute__((address_space(3)))
typedef unsigned short bf16_t;
typedef short bf16x8 __attribute__((ext_vector_type(8)));
typedef short s16x4 __attribute__((ext_vector_type(4)));
typedef float f32x2 __attribute__((ext_vector_type(2)));
typedef float f32x4 __attribute__((ext_vector_type(4)));
typedef float f32x16 __attribute__((ext_vector_type(16)));
typedef unsigned u32x2 __attribute__((ext_vector_type(2)));
typedef unsigned u32x4 __attribute__((ext_vector_type(4)));
typedef _Float16 f16x4 __attribute__((ext_vector_type(4)));
typedef __bf16 bf16v2 __attribute__((ext_vector_type(2)));
typedef int v8i __attribute__((ext_vector_type(8)));
typedef int v4i __attribute__((ext_vector_type(4)));

constexpr int D = 1024, BATCH = 16, SEQ = 4096, T = BATCH * SEQ, NMEM = 256;
constexpr int IN_PROJ = 2560, CW = 384, RW = 384, NH = 6, NE = 16, FF = 1024, CAP = 512;
constexpr int NSLOT = NE * BATCH * CAP;
constexpr int NTHREADS = 512;
constexpr int LDS_BYTES = 160 * 1024;
constexpr int NPHASE = 11;
#ifndef SCAN_MODE
#define SCAN_MODE 1
#endif

constexpr size_t MiB = 1u << 20;
constexpr size_t WS_WINT = 1 * MiB;
constexpr size_t WS_WOUTT = 6 * MiB;
constexpr size_t WS_WKT = 8 * MiB;
constexpr size_t WS_WVT = 8 * MiB + 512 * 1024;
constexpr size_t WS_SMALL = 9 * MiB;
constexpr size_t WS_WGUT = 10 * MiB;
constexpr size_t WS_WDT = 74 * MiB;
constexpr size_t WS_KMEM = 106 * MiB;
constexpr size_t WS_VT = 108 * MiB;
constexpr size_t WS_ROWTOK = 106 * MiB;
constexpr size_t WS_ROWGATE = 106 * MiB + 512 * 1024;
constexpr size_t WS_SS = 107 * MiB;
constexpr size_t WS_P = 112 * MiB;
constexpr size_t WS_YF = 112 * MiB;
constexpr size_t WS_YB = 208 * MiB;
constexpr size_t WS_X1 = 112 * MiB;
constexpr size_t WS_XH = 432 * MiB;
constexpr size_t WS_G = 432 * MiB;
constexpr size_t WS_BON = 480 * MiB;
constexpr size_t WS_Q = 400 * MiB;
constexpr int PLD = IN_PROJ - 256;
constexpr size_t WS_H2 = 432 * MiB;
constexpr size_t WS_MEMN = 560 * MiB;
constexpr size_t WS_MIX = 560 * MiB;
constexpr size_t WS_SCAN = 688 * MiB;
constexpr size_t SCAN_STRIDE = 48 * MiB;
constexpr size_t WS_SCAN7 = 496 * MiB;
constexpr size_t WS_PC = 484 * MiB;
__device__ __forceinline__ unsigned char* scan_arr(unsigned char* ws, int a) { return a < 7 ? ws + WS_SCAN + (size_t)a * SCAN_STRIDE : (a == 7 ? ws + WS_SCAN7 : ws + 560 * MiB + 640 * 2); }
__device__ __forceinline__ int scan_pitch(int a) { return a == 8 ? D : 384; }
__device__ __forceinline__ size_t hat_off(int a, size_t tok, int ch) { return a == 8 ? tok * D + ch : ((((tok >> 4) * NH + (ch >> 6)) << 10) + ((tok & 15) << 6) + (ch & 63)); }
constexpr size_t WS_AFF = 624 * MiB;
constexpr size_t WS_INV = 628 * MiB;
constexpr size_t WS_HID = 768 * MiB;
constexpr size_t WS_YE = 368 * MiB;
constexpr size_t WS_END = 1024 * MiB;

__device__ __forceinline__ unsigned pk_bf16(float lo, float hi) { f32x2 v = {lo, hi}; bf16v2 b = __builtin_convertvector(v, bf16v2); return __builtin_bit_cast(unsigned, b); }
__device__ __forceinline__ unsigned pk_fp8x4(float a, float b, float c, float d) { int w = 0; w = __builtin_amdgcn_cvt_pk_fp8_f32(a, b, w, false); w = __builtin_amdgcn_cvt_pk_fp8_f32(c, d, w, true); return (unsigned)w; }
__device__ __forceinline__ float bf_lo(unsigned u) { return __builtin_bit_cast(float, u << 16); }
__device__ __forceinline__ float bf_hi(unsigned u) { return __builtin_bit_cast(float, u & 0xffff0000u); }
__device__ __forceinline__ float wave_sum(float v) {
#pragma unroll
    for (int o = 1; o < 64; o <<= 1) v += __shfl_xor(v, o);
    return v;
}
__device__ __forceinline__ float sigmoidf_fast(float x) { return __builtin_amdgcn_rcpf(1.0f + __builtin_amdgcn_exp2f(-1.4426950408889634f * x)); }
template <int CTRL> __device__ __forceinline__ float dpp_f(float x) { return __builtin_bit_cast(float, __builtin_amdgcn_update_dpp(0, __builtin_bit_cast(int, x), CTRL, 0xF, 0xF, true)); }
__device__ __forceinline__ float sum8(float x) { x += dpp_f<0xB1>(x); x += dpp_f<0x4E>(x); x += dpp_f<0x141>(x); return x; }
__device__ __forceinline__ float sum16(float x) { x = sum8(x); x += dpp_f<0x140>(x); return x; }
__device__ __forceinline__ float max16(float x) { x = fmaxf(x, dpp_f<0xB1>(x)); x = fmaxf(x, dpp_f<0x4E>(x)); x = fmaxf(x, dpp_f<0x141>(x)); x = fmaxf(x, dpp_f<0x140>(x)); return x; }

typedef short v4i16g __attribute__((__vector_size__(8)));
__device__ __forceinline__ s16x4 tr_read16(LAS unsigned char* p) { v4i16g r = __builtin_amdgcn_ds_read_tr16_b64_v4i16((LAS v4i16g*)p); return __builtin_bit_cast(s16x4, r); }
__device__ __forceinline__ f32x4 bf4_to_f32(u32x2 w) { return (f32x4){bf_lo(w.x), bf_hi(w.x), bf_lo(w.y), bf_hi(w.y)}; }
__device__ __forceinline__ u32x2 f32_to_bf4(f32x4 v) { return (u32x2){pk_bf16(v.x, v.y), pk_bf16(v.z, v.w)}; }
__device__ __forceinline__ bf16x8 frag_lo4(f32x4 v) { const u32x4 w = {pk_bf16(v.x, v.y), pk_bf16(v.z, v.w), 0u, 0u}; return __builtin_bit_cast(bf16x8, w); }
__device__ __forceinline__ bf16x8 frag_cat(u32x2 a, u32x2 b) { const u32x4 w = {a.x, a.y, b.x, b.y}; return __builtin_bit_cast(bf16x8, w); }
#define MFMA16(a, b, c) __builtin_amdgcn_mfma_f32_16x16x32_bf16((a), (b), (c), 0, 0, 0)

__device__ __forceinline__ int tid_of(int wv) { int l; asm volatile("v_mbcnt_lo_u32_b32 %0, -1, 0\n\tv_mbcnt_hi_u32_b32 %0, -1, %0" : "=v"(l)); return (wv << 6) | l; }
namespace pg8 {
#define PG8_LAS __attribute__((address_space(3)))
constexpr int BM = 256, BK = 64, HALF = 128, HTB = HALF * BK * 2, STAGE_BYTES = 8 * HTB, NXCD = 8, WGM = 8;
__host__ __device__ __forceinline__ int lds_byte(int r, int c) { const int st = (r >> 4) * 2 + (c >> 5), rr = r & 15, cc = c & 31, ob = rr * 64 + cc * 2; return st * 1024 + (ob ^ (((ob >> 9) & 1) << 5)); }
__host__ __device__ __forceinline__ void stage_rc(int b, int& R, int& C) { const int st = b / 1024, sb = b % 1024, swz = sb ^ (((sb >> 9) & 1) << 5); R = (st >> 1) * 16 + swz / 64; C = (st & 1) * 32 + (swz % 64) / 2; }
__host__ __device__ __forceinline__ int perm32(int rho) { const int n = rho >> 4, i = rho & 15; return 8 * (i >> 2) + 4 * n + (i & 3); }

struct Unit { int pm, pn, gid; };
struct Gemm { const bf16_t* A; const bf16_t* Bt; int M, N, K; int sw, sx; };

struct StaticOrder {
    int nM, nN, nwg, G, c;
    __device__ void init(int M, int N, int G_, int c_) { nM = M / BM; nN = N / BM; nwg = nM * nN; G = G_; c = c_; }
    __device__ bool next(int i, Unit& u) const {
        const long L = (long)i * G + c; if (L >= nwg) return false;
        int wgid = (int)L; { const int q = nwg / NXCD, r = nwg % NXCD, xcd = wgid % NXCD, off = wgid / NXCD; wgid = (xcd < r ? xcd * (q + 1) : r * (q + 1) + (xcd - r) * q) + off; }
        const int nig = WGM * nN, gid = wgid / nig, fm = gid * WGM, gsz = (nM - fm) < WGM ? (nM - fm) : WGM;
        u.pm = fm + ((wgid % nig) % gsz); u.pn = (wgid % nig) / gsz; u.gid = 0; return true;
    }
    __device__ __forceinline__ const char* aptr(const Gemm& g, const Unit& u, size_t tstep) const { return (const char*)g.A + (size_t)u.pm * tstep; }
    __device__ __forceinline__ const char* bptr(const Gemm& g, const Unit& u, size_t tstep) const { return (const char*)g.Bt + (size_t)u.pn * tstep; }
};
struct TripleOrder {
    StaticOrder S0; const bf16_t* A1; const bf16_t* B1; const bf16_t* A2; const bf16_t* B2; int n1, n2, G, c;
    __device__ bool next(int i, Unit& u) const {
        const long L = (long)i * G + c;
        if (L < n1) { u.pm = (int)L; u.pn = 0; u.gid = 1; return true; }
        if (L < n1 + n2) { u.pm = 0; u.pn = (int)(L - n1); u.gid = 2; return true; }
        const long L0 = L - n1 - n2; if (L0 >= S0.nwg) return false;
        StaticOrder T0 = S0; T0.c = (int)(L0 % G); return T0.next((int)(L0 / G), u);
    }
    __device__ __forceinline__ const char* aptr(const Gemm& g, const Unit& u, size_t tstep) const { return (const char*)(u.gid == 0 ? g.A : (u.gid == 1 ? A1 : A2)) + (size_t)u.pm * tstep; }
    __device__ __forceinline__ const char* bptr(const Gemm& g, const Unit& u, size_t tstep) const { return (const char*)(u.gid == 0 ? g.Bt : (u.gid == 1 ? B1 : B2)) + (size_t)u.pn * tstep; }
};
struct ExpertOrder {
    int nMe, nNe, per, total, G, c;
    __device__ void init(int nMe_, int nNe_, int nExp, int G_, int c_) { nMe = nMe_; nNe = nNe_; per = nMe * nNe; total = per * nExp; G = G_; c = c_; }
    __device__ bool next(int i, Unit& u) const {
        const long L = (long)i * G + c; if (L >= total) return false;
        const int e = (int)(L / per), w = (int)(L % per), xl = w % 8, j = w / 8, rpx = nMe / 8;
        u.pm = e * nMe + xl * rpx + (j % rpx); u.pn = e * nNe + j / rpx; u.gid = 0; return true;
    }
    __device__ __forceinline__ const char* aptr(const Gemm& g, const Unit& u, size_t tstep) const { return (const char*)g.A + (size_t)u.pm * tstep; }
    __device__ __forceinline__ const char* bptr(const Gemm& g, const Unit& u, size_t tstep) const { return (const char*)g.Bt + (size_t)u.pn * tstep; }
};

struct EpiBf16 {
    static constexpr bool PERM = true;
    bf16_t* O; int ldc; bf16_t* Q0;
    __device__ __forceinline__ void operator()(const f32x4 (&acc)[2][2][4][2], const Unit& u, int wr, int wc, int fr, int fq) const {
        const bool redir = (Q0 != nullptr) && (u.pn == 0);
        bf16_t* base = redir ? Q0 : O; const int ld = redir ? 256 : ldc;
        const int row0 = u.pm * BM + wr * 64 + fr, col0 = (u.pn - ((Q0 != nullptr && !redir) ? 1 : 0)) * BM + wc * 32 + 8 * fq;
#pragma unroll
        for (int ai = 0; ai < 2; ++ai)
#pragma unroll
            for (int m = 0; m < 4; ++m) { bf16_t* rowp = base + (size_t)(row0 + ai * HALF + m * 16) * ld + col0;
#pragma unroll
                for (int bj = 0; bj < 2; ++bj) { const f32x4 v0 = acc[ai][bj][m][0], v1 = acc[ai][bj][m][1];
                    u32x4 w; w.x = pk_bf16(v0[0], v0[1]); w.y = pk_bf16(v0[2], v0[3]); w.z = pk_bf16(v1[0], v1[1]); w.w = pk_bf16(v1[2], v1[3]);
                    *(u32x4*)(rowp + bj * HALF) = w; } }
    }
};
struct EpiBf16x3 {
    static constexpr bool PERM = true;
    EpiBf16 E0, E1, E2;
    __device__ __forceinline__ void operator()(const f32x4 (&acc)[2][2][4][2], const Unit& u, int wr, int wc, int fr, int fq) const {
        if (u.gid == 0) E0(acc, u, wr, wc, fr, fq); else if (u.gid == 1) E1(acc, u, wr, wc, fr, fq); else E2(acc, u, wr, wc, fr, fq); }
};
struct EpiResidSS {
    static constexpr bool PERM = false;
    const float* X; float* X1; float* ss;
    __device__ __forceinline__ void operator()(const f32x4 (&acc)[2][2][4][2], const Unit& u, int wr, int wc, int fr, int fq) const {
        const int row0 = u.pm * BM + wr * 64 + fr, col0 = u.pn * BM + wc * 32 + 4 * fq;
#pragma unroll
        for (int ai = 0; ai < 2; ++ai)
#pragma unroll
            for (int m = 0; m < 4; ++m) { const int row = row0 + ai * HALF + m * 16; const size_t off = (size_t)row * D + col0; float s = 0.f;
#pragma unroll
                for (int bj = 0; bj < 2; ++bj)
#pragma unroll
                    for (int n = 0; n < 2; ++n) { const f32x4 xv = *(const f32x4*)(X + off + bj * HALF + n * 16); const f32x4 o = xv + acc[ai][bj][m][n];
                        *(f32x4*)(X1 + off + bj * HALF + n * 16) = o; s += (o[0] * o[0] + o[1] * o[1]) + (o[2] * o[2] + o[3] * o[3]); }
                s += __shfl_xor(s, 16); s += __shfl_xor(s, 32);
                if (fq == 0) (void)__hip_atomic_fetch_add(ss + row, s, __ATOMIC_RELAXED, __HIP_MEMORY_SCOPE_AGENT); }
    }
};
struct EpiSwiGLU {
    static constexpr bool PERM = true;
    bf16_t* H;
    __device__ __forceinline__ void operator()(const f32x4 (&acc)[2][2][4][2], const Unit& u, int wr, int wc, int fr, int fq) const {
        const int row0 = u.pm * BM + wr * 64 + fr, col0 = (u.pn & 7) * HALF + wc * 32 + 8 * fq;
#pragma unroll
        for (int ai = 0; ai < 2; ++ai)
#pragma unroll
            for (int m = 0; m < 4; ++m) { const int row = row0 + ai * HALF + m * 16; float h[8];
                unsigned char* rowp = (unsigned char*)H + ((((size_t)(row >> 8) * (FF / 128) + (col0 >> 7)) << 15) + ((row & 255) << 7) + (col0 & 127));
#pragma unroll
                for (int n = 0; n < 2; ++n)
#pragma unroll
                    for (int j = 0; j < 4; ++j) { const float gt = acc[ai][0][m][n][j], up = acc[ai][1][m][n][j]; h[n * 4 + j] = 8.0f * gt * sigmoidf_fast(gt) * up; }
                *(u32x2*)rowp = (u32x2){pk_fp8x4(h[0], h[1], h[2], h[3]), pk_fp8x4(h[4], h[5], h[6], h[7])}; }
    }
};
struct EpiGateScale {
    static constexpr bool PERM = true;
    bf16_t* Y; const float* gate;
    __device__ __forceinline__ void operator()(const f32x4 (&acc)[2][2][4][2], const Unit& u, int wr, int wc, int fr, int fq) const {
        const int row0 = u.pm * BM + wr * 64 + fr, col0 = (u.pn & 3) * BM + wc * 32 + 8 * fq;
#pragma unroll
        for (int ai = 0; ai < 2; ++ai)
#pragma unroll
            for (int m = 0; m < 4; ++m) { const int row = row0 + ai * HALF + m * 16; const float gs = gate[row]; bf16_t* rowp = Y + (size_t)row * D + col0;
#pragma unroll
                for (int bj = 0; bj < 2; ++bj) { const f32x4 v0 = acc[ai][bj][m][0] * gs, v1 = acc[ai][bj][m][1] * gs;
                    u32x4 w; w.x = pk_bf16(v0[0], v0[1]); w.y = pk_bf16(v0[2], v0[3]); w.z = pk_bf16(v1[0], v1[1]); w.w = pk_bf16(v1[2], v1[3]);
                    *(u32x4*)(rowp + bj * HALF) = w; } }
    }
};

template <class Epi, class Sched, bool GATHER, bool ATILED = false, bool FP8 = false>
__device__ __forceinline__ void gemm_phase(PG8_LAS unsigned char* lds, const Gemm g, const Sched& S, const Epi& E, const int* rowtok, const int wv) {
    int tid = tid_of(wv); asm volatile("" : "+v"(tid));
    const int wid = __builtin_amdgcn_readfirstlane(tid >> 6), lane = tid & 63, wr = wid >> 2, wc = wid & 3, fr = lane & 15, fq = lane >> 4;
    const int K = g.K, nt = K / BK;
    unsigned voffA0, voffB0;
    { int R, C; stage_rc(tid * 16, R, C); const int Rb = Epi::PERM ? ((R & ~31) + perm32(R & 31)) : R;
      voffA0 = ATILED ? (unsigned)(R * BK + C) * 2u : (unsigned)(R * K + C) * 2u; voffB0 = (unsigned)(Rb * K + C) * 2u; }
    const size_t dA = ATILED ? (size_t)64 * BK * 2 : (size_t)64 * K * 2, dB = (size_t)64 * K * 2;
    unsigned vAc[2][2], vAn[2][2];
    const size_t kstep = (size_t)(BK * 2);
    const size_t hstep = (size_t)HALF * K * 2;
    const size_t tstep = 2 * hstep;
    const size_t kstepA = ATILED ? (size_t)BM * BK * 2 : kstep, hstepA = ATILED ? (size_t)HALF * BK * 2 : hstep;
    const unsigned ldsw = (unsigned)wid * 1024u;
    const unsigned ldsbase = __builtin_amdgcn_readfirstlane((unsigned)(size_t)lds) + ldsw;
    const int aoff = lds_byte(wr * 64 + fr, fq * 8), boff = lds_byte(wc * 32 + fr, fq * 8);
#define PG8_SA(b, h) (((b) * 2 + (h)) * HTB)
#define PG8_SB(b, h) ((4 + (b) * 2 + (h)) * HTB)
#define PG8_GLDS(vo_, sb_, lo_) asm volatile("s_add_u32 m0, %2, %3\n\ts_nop 0\n\tglobal_load_lds_dwordx4 %0, %1" :: "v"(vo_), "s"((const void*)(sb_)), "s"(ldsbase), "n"(lo_) : "m0", "scc", "memory")
#define PG8_STAGE_D(bufoff, gbase, voff0, delta) do { PG8_GLDS(voff0, gbase, (bufoff)); PG8_GLDS(voff0, (const char*)(gbase) + (delta), (bufoff) + 8192); } while (0)
#define PG8_STAGE(bufoff, gbase, voff) do { PG8_GLDS((voff)[0], gbase, (bufoff)); PG8_GLDS((voff)[1], gbase, (bufoff) + 8192); } while (0)
#define PG8_STAGE_A(bufoff, hh, dbase, kbytes, vsel) do { if constexpr (GATHER) { PG8_STAGE(bufoff, (const char*)g.A + (kbytes), (vsel)[hh]); } else { PG8_STAGE_D(bufoff, (dbase) + ((hh) ? hstepA : 0), voffA0, dA); } } while (0)
#define PG8_GATHER_OFF(dst, un) do { int R_, C_; stage_rc(tid * 16, R_, C_); _Pragma("unroll") for (int _h = 0; _h < 2; ++_h) _Pragma("unroll") for (int _i = 0; _i < 2; ++_i) \
        (dst)[_h][_i] = (unsigned)rowtok[(un).pm * BM + _h * HALF + R_ + 64 * _i] * (unsigned)(K * 2) + (unsigned)(C_ * 2); } while (0)
#define PG8_LDA(dst, b, h) do { _Pragma("unroll") for (int m = 0; m < 4; ++m) _Pragma("unroll") for (int k = 0; k < 2; ++k) dst[m][k] = *(const PG8_LAS bf16x8*)(lds + PG8_SA(b, h) + aoff + m * 2048 + k * 1024); } while (0)
#define PG8_LDB(dst, b, h) do { _Pragma("unroll") for (int n = 0; n < 2; ++n) _Pragma("unroll") for (int k = 0; k < 2; ++k) dst[n][k] = *(const PG8_LAS bf16x8*)(lds + PG8_SB(b, h) + boff + n * 2048 + k * 1024); } while (0)
#define PG8_MMA(ai, bj, At, Bt) do { __builtin_amdgcn_s_setprio(1); _Pragma("unroll") for (int m = 0; m < 4; ++m) _Pragma("unroll") for (int n = 0; n < 2; ++n) _Pragma("unroll") for (int k = 0; k < 2; ++k) \
        acc[ai][bj][m][n] = __builtin_amdgcn_mfma_f32_16x16x32_bf16(Bt[n][k], At[m][k], acc[ai][bj][m][n], 0, 0, 0); __builtin_amdgcn_s_setprio(0); } while (0)
#define PG8_CAT8(lo_, hi_) __builtin_shufflevector(lo_, hi_, 0, 1, 2, 3, 4, 5, 6, 7)
#define PG8_LDA8(b, h) do { _Pragma("unroll") for (int m = 0; m < 4; ++m) { const v4i lo_ = *(const PG8_LAS v4i*)(lds + PG8_SA(b, h) + aoff + m * 2048), hi_ = *(const PG8_LAS v4i*)(lds + PG8_SA(b, h) + aoff + m * 2048 + 1024); A8[m] = PG8_CAT8(lo_, hi_); } } while (0)
#define PG8_LDB8(dst, b, h) do { _Pragma("unroll") for (int n = 0; n < 2; ++n) { const v4i lo_ = *(const PG8_LAS v4i*)(lds + PG8_SB(b, h) + boff + n * 2048), hi_ = *(const PG8_LAS v4i*)(lds + PG8_SB(b, h) + boff + n * 2048 + 1024); dst[n] = PG8_CAT8(lo_, hi_); } } while (0)
#define PG8_MMA8(ai, bj, Bt8) do { __builtin_amdgcn_s_setprio(1); _Pragma("unroll") for (int m = 0; m < 4; ++m) _Pragma("unroll") for (int n = 0; n < 2; ++n) \
        acc[ai][bj][m][n] = __builtin_amdgcn_mfma_scale_f32_16x16x128_f8f6f4(Bt8[n], A8[m], acc[ai][bj][m][n], 0, 0, 0, g.sw, 0, g.sx); __builtin_amdgcn_s_setprio(0); } while (0)
#define PG8_LDAX(b, h) do { if constexpr (FP8) { PG8_LDA8(b, h); } else { PG8_LDA(At, b, h); } } while (0)
#define PG8_LDBX(w, b, h) do { if constexpr (FP8) { if (w) { PG8_LDB8(B81, b, h); } else { PG8_LDB8(B80, b, h); } } else { if (w) { PG8_LDB(B1, b, h); } else { PG8_LDB(B0, b, h); } } } while (0)
#define PG8_MMX(ai, bj, w) do { if constexpr (FP8) { if (w) { PG8_MMA8(ai, bj, B81); } else { PG8_MMA8(ai, bj, B80); } } else { if (w) { PG8_MMA(ai, bj, At, B1); } else { PG8_MMA(ai, bj, At, B0); } } } while (0)
#define PG8_WAIT_V(n) asm volatile("s_waitcnt vmcnt(" #n ")" ::: "memory")
#define PG8_WAIT_L(n) asm volatile("s_waitcnt lgkmcnt(" #n ")" ::: "memory")
#define PG8_BAR __builtin_amdgcn_s_barrier()
#define PG8_SCHED __builtin_amdgcn_sched_barrier(0)
    Unit cur, nxt; int ui = 0;
    if (!S.next(0, cur)) return;
    f32x4 acc[2][2][4][2];
#pragma unroll
    for (int a = 0; a < 2; ++a)
#pragma unroll
        for (int b = 0; b < 2; ++b)
#pragma unroll
            for (int m = 0; m < 4; ++m)
#pragma unroll
                for (int n = 0; n < 2; ++n) acc[a][b][m][n] = (f32x4){0.f, 0.f, 0.f, 0.f};
    bf16x8 At[4][2], B0[2][2], B1[2][2]; v8i A8[4], B80[2], B81[2];
    const char* cA = GATHER ? (const char*)g.A : S.aptr(g, cur, tstep); const char* cB = S.bptr(g, cur, tstep);
    if constexpr (GATHER) { PG8_GATHER_OFF(vAc, cur); }
    PG8_STAGE_D(PG8_SB(0, 0), cB, voffB0, dB); PG8_STAGE_A(PG8_SA(0, 0), 0, cA, 0, vAc); PG8_STAGE_D(PG8_SB(0, 1), cB + hstep, voffB0, dB); PG8_STAGE_A(PG8_SA(0, 1), 1, cA, 0, vAc);
    if (wr == 1) PG8_BAR;
    PG8_WAIT_V(4); PG8_BAR;
    PG8_STAGE_D(PG8_SB(1, 0), cB + kstep, voffB0, dB); PG8_STAGE_A(PG8_SA(1, 0), 0, cA + kstepA, kstep, vAc); PG8_STAGE_D(PG8_SB(1, 1), cB + hstep + kstep, voffB0, dB);
    PG8_WAIT_V(6); PG8_BAR;
    for (;;) {
        const bool has_next = S.next(ui + 1, nxt);
        const char* nA = (has_next && !GATHER) ? S.aptr(g, nxt, tstep) : cA; const char* nB = has_next ? S.bptr(g, nxt, tstep) : cB;
        if constexpr (GATHER) { if (has_next) { PG8_GATHER_OFF(vAn, nxt); } else {
#pragma unroll
            for (int _h = 0; _h < 2; ++_h)
#pragma unroll
                for (int _i = 0; _i < 2; ++_i) vAn[_h][_i] = vAc[_h][_i]; } }
#pragma unroll 1
        for (int t = 0; t < nt; t += 2) {
            const bool last = (t == nt - 2);
            const size_t k1 = (size_t)(t + 1) * kstep, k2 = last ? 0 : (size_t)(t + 2) * kstep, k3 = k2 + kstep;
            const char* a1 = cA + (size_t)(t + 1) * kstepA;
            const char* a2 = last ? nA : cA + (size_t)(t + 2) * kstepA; const char* b2 = last ? nB : cB + (size_t)(t + 2) * kstep;
            const char* a3 = a2 + kstepA; const char* b3 = b2 + kstep;
            PG8_LDBX(0, 0, 0); PG8_SCHED; PG8_LDAX(0, 0); PG8_STAGE_A(PG8_SA(1, 1), 1, a1, k1, vAc);
            if constexpr (GATHER) { if (last) {
#pragma unroll
                for (int _h = 0; _h < 2; ++_h)
#pragma unroll
                    for (int _i = 0; _i < 2; ++_i) vAc[_h][_i] = vAn[_h][_i]; } }
            PG8_WAIT_L(8); PG8_BAR; PG8_WAIT_L(0); PG8_MMX(0, 0, 0); PG8_BAR; PG8_SCHED;
            PG8_LDBX(1, 0, 1); PG8_STAGE_D(PG8_SB(0, 0), b2, voffB0, dB);
            PG8_BAR; PG8_WAIT_L(0); PG8_MMX(0, 1, 1); PG8_BAR;
            PG8_LDAX(0, 1); PG8_STAGE_A(PG8_SA(0, 0), 0, a2, k2, vAc);
            PG8_BAR; PG8_WAIT_L(0); PG8_MMX(1, 0, 0); PG8_BAR; PG8_SCHED;
            PG8_STAGE_D(PG8_SB(0, 1), b2 + hstep, voffB0, dB);
            PG8_WAIT_V(6); PG8_BAR; PG8_MMX(1, 1, 1); PG8_BAR;
            PG8_LDBX(0, 1, 0); PG8_SCHED; PG8_LDAX(1, 0); PG8_STAGE_A(PG8_SA(0, 1), 1, a2, k2, vAc);
            PG8_WAIT_L(8); PG8_BAR; PG8_WAIT_L(0); PG8_MMX(0, 0, 0); PG8_BAR; PG8_SCHED;
            PG8_LDBX(1, 1, 1); PG8_STAGE_D(PG8_SB(1, 0), b3, voffB0, dB);
            PG8_BAR; PG8_WAIT_L(0); PG8_MMX(0, 1, 1); PG8_BAR;
            PG8_LDAX(1, 1); PG8_STAGE_A(PG8_SA(1, 0), 0, a3, k3, vAc);
            PG8_BAR; PG8_WAIT_L(0); PG8_MMX(1, 0, 0); PG8_BAR; PG8_SCHED;
            PG8_STAGE_D(PG8_SB(1, 1), b3 + hstep, voffB0, dB);
            PG8_WAIT_V(6); PG8_BAR; PG8_MMX(1, 1, 1); PG8_BAR;
        }
        E(acc, cur, wr, wc, fr, fq);
        if (!has_next) break;
#pragma unroll
        for (int a = 0; a < 2; ++a)
#pragma unroll
            for (int b = 0; b < 2; ++b)
#pragma unroll
                for (int m = 0; m < 4; ++m)
#pragma unroll
                    for (int n = 0; n < 2; ++n) acc[a][b][m][n] = (f32x4){0.f, 0.f, 0.f, 0.f};
        cur = nxt; cA = nA; cB = nB; ++ui;
        if constexpr (GATHER) {
#pragma unroll
            for (int _h = 0; _h < 2; ++_h)
#pragma unroll
                for (int _i = 0; _i < 2; ++_i) vAc[_h][_i] = vAn[_h][_i]; }
    }
    PG8_WAIT_V(0);
    if (wr == 0) PG8_BAR;
    PG8_BAR;
#undef PG8_SA
#undef PG8_SB
#undef PG8_STAGE
#undef PG8_STAGE_D
#undef PG8_GLDS
#undef PG8_STAGE_A
#undef PG8_GATHER_OFF
#undef PG8_LDA
#undef PG8_LDB
#undef PG8_MMA
#undef PG8_MMA8
#undef PG8_LDA8
#undef PG8_LDB8
#undef PG8_LDAX
#undef PG8_LDBX
#undef PG8_MMX
#undef PG8_CAT8
#undef PG8_WAIT_V
#undef PG8_WAIT_L
#undef PG8_BAR
#undef PG8_SCHED
}
}

struct Args {
    const float* in[29];
    float* out; unsigned char* ws;
    int ph_lo, ph_hi;
    int wv, zero_;
};
enum { I_X = 0, I_MEM, I_NMIXG, I_NMEMG, I_WIN, I_WMK, I_WMV, I_CONVW, I_CONVB, I_CLNG, I_CLNB, I_SHIFTMU, I_DW0, I_DUP, I_IA0, I_IUP, I_GUP, I_KK, I_KA, I_RK,
       I_LNXG, I_LNXB, I_WOUT, I_NFFNG, I_WROUTER, I_WEG, I_WEU, I_WED, I_FNG };

template <bool F8 = false>
__device__ __forceinline__ void transpose_item(const float* W, int N, bf16_t* WT, int K, int k0, int n0, int drow0, LAS float* scr, int lane) {
    {
        f32x4 v[8];
#pragma unroll
        for (int i = 0; i < 8; ++i) v[i] = *(const f32x4*)(W + (size_t)(k0 + 8 * i + (lane >> 3)) * N + n0 + 4 * (lane & 7));
#pragma unroll
        for (int i = 0; i < 8; ++i) { LAS float* d = scr + (8 * i + (lane >> 3)) * 33 + 4 * (lane & 7); d[0] = v[i].x; d[1] = v[i].y; d[2] = v[i].z; d[3] = v[i].w; }
    }
    asm volatile("s_waitcnt lgkmcnt(0)" ::: "memory");
    const int c = lane & 7;
#pragma unroll
    for (int j = 0; j < 4; ++j) { const int n = (lane >> 3) + 8 * j; const LAS float* s = scr + (8 * c) * 33 + n;
        if constexpr (F8) { *(u32x2*)((unsigned char*)WT + (size_t)(drow0 + n) * K + k0 + 8 * c) = (u32x2){pk_fp8x4(32.f * s[0 * 33], 32.f * s[1 * 33], 32.f * s[2 * 33], 32.f * s[3 * 33]), pk_fp8x4(32.f * s[4 * 33], 32.f * s[5 * 33], 32.f * s[6 * 33], 32.f * s[7 * 33])}; }
        else { u32x4 o; o.x = pk_bf16(s[0 * 33], s[1 * 33]); o.y = pk_bf16(s[2 * 33], s[3 * 33]); o.z = pk_bf16(s[4 * 33], s[5 * 33]); o.w = pk_bf16(s[6 * 33], s[7 * 33]);
            *(u32x4*)(WT + (size_t)(drow0 + n) * K + k0 + 8 * c) = o; } }
    asm volatile("s_waitcnt lgkmcnt(0)" ::: "memory");
}
__device__ __forceinline__ void expert_prep_items(const Args& a, LAS unsigned char* lds, int widx, int nw, int it_lo, int it_hi) {
    int tid = tid_of(a.wv); asm volatile("" : "+v"(tid)); const int lane = tid & 63, wave = __builtin_amdgcn_readfirstlane(tid >> 6);
    LAS float* scr = (LAS float*)(lds + wave * 16384);
    unsigned char* ws = a.ws;
    constexpr int S_EXP = 16 * 16 * 32;
    for (int r = it_lo + widx; r < it_hi; r += nw) {
        const int which = r / S_EXP, q = r % S_EXP, e = q / 512, kb = (q % 512) / 32, nb = q % 32, n0 = nb * 32;
        if (which == 0) transpose_item<true>(a.in[I_WEG] + (size_t)e * D * FF, FF, (bf16_t*)(ws + WS_WGUT + (size_t)e * 2048 * D), D, kb * 64, n0, (n0 >> 7) * 256 + (n0 & 127), scr, lane);
        else if (which == 1) transpose_item<true>(a.in[I_WEU] + (size_t)e * D * FF, FF, (bf16_t*)(ws + WS_WGUT + (size_t)e * 2048 * D), D, kb * 64, n0, (n0 >> 7) * 256 + 128 + (n0 & 127), scr, lane);
        else transpose_item<true>(a.in[I_WED] + (size_t)e * FF * D, D, (bf16_t*)(ws + WS_WDT + (size_t)e * D * FF), FF, kb * 64, n0, n0, scr, lane);
    }
}

__device__ __forceinline__ void rms_row_to_bf16(const float* xrow, const float* g, bf16_t* orow, int lane) {
    const f32x4* xr = (const f32x4*)xrow + lane; const f32x4* gr = (const f32x4*)g + lane;
    f32x4 v[4]; float s = 0.f;
#pragma unroll
    for (int j = 0; j < 4; ++j) { v[j] = xr[64 * j]; s += (v[j].x * v[j].x + v[j].y * v[j].y) + (v[j].z * v[j].z + v[j].w * v[j].w); }
    const float rs = 1.0f / sqrtf(wave_sum(s) * (1.f / D) + 1e-6f);
    u32x2* o8 = (u32x2*)orow + lane;
#pragma unroll
    for (int j = 0; j < 4; ++j) { const f32x4 gg = gr[64 * j]; u32x2 w; w.x = pk_bf16(v[j].x * rs * gg.x, v[j].y * rs * gg.y); w.y = pk_bf16(v[j].z * rs * gg.z, v[j].w * rs * gg.w); o8[64 * j] = w; }
}
__device__ __forceinline__ void phase_prep(const Args& a, LAS unsigned char* lds, int G) {
    int tid = tid_of(a.wv); asm volatile("" : "+v"(tid)); const int lane = tid & 63, wave = __builtin_amdgcn_readfirstlane(tid >> 6);
    LAS float* scr = (LAS float*)(lds + wave * 16384);
    const int gw = blockIdx.x * 8 + wave, NGW = G * 8;
    unsigned char* ws = a.ws;
    constexpr int S_WIN = 16 * 80, S_WOUT = 16 * 32, S_MK = 16 * 8, S_SM = 12, S_GUP = 24;
    constexpr int NITEMS = S_WIN + S_WOUT + 2 * S_MK + 4 * S_SM + S_GUP;
    for (int it = gw; it < NITEMS; it += NGW) {
        int r = it;
        if (r < S_WIN) { const int kb = r / 80, nb = r % 80; transpose_item(a.in[I_WIN], IN_PROJ, (bf16_t*)(ws + WS_WINT), D, kb * 64, nb * 32, nb * 32, scr, lane); continue; } r -= S_WIN;
        if (r < S_WOUT) { const int kb = r / 32, nb = r % 32; transpose_item(a.in[I_WOUT], D, (bf16_t*)(ws + WS_WOUTT), D, kb * 64, nb * 32, nb * 32, scr, lane); continue; } r -= S_WOUT;
        if (r < S_MK) { const int kb = r / 8, nb = r % 8; transpose_item(a.in[I_WMK], 256, (bf16_t*)(ws + WS_WKT), D, kb * 64, nb * 32, nb * 32, scr, lane); continue; } r -= S_MK;
        if (r < S_MK) { const int kb = r / 8, nb = r % 8; transpose_item(a.in[I_WMV], 256, (bf16_t*)(ws + WS_WVT), D, kb * 64, nb * 32, nb * 32, scr, lane); continue; } r -= S_MK;
        if (r < 4 * S_SM) { const int which = r / S_SM, nb = r % S_SM;
            const float* src = (which < 2 ? a.in[I_DUP] : a.in[I_IUP]) + (size_t)(which & 1) * 64 * RW;
            transpose_item(src, RW, (bf16_t*)(ws + WS_SMALL) + (size_t)which * RW * 64, 64, 0, nb * 32, nb * 32, scr, lane); continue; } r -= 4 * S_SM;
        { const int kb = r / 12, nb = r % 12; transpose_item(a.in[I_GUP], RW, (bf16_t*)(ws + WS_SMALL) + (size_t)4 * RW * 64, 128, kb * 64, nb * 32, nb * 32, scr, lane); }
    }
    expert_prep_items(a, lds, gw, NGW, 0, 3 * 8192);
    for (int m = gw; m < T; m += NGW) rms_row_to_bf16(a.in[I_X] + (size_t)m * D, a.in[I_NMIXG], (bf16_t*)(ws + WS_XH) + (size_t)m * D, lane);
    for (int m = gw; m < BATCH * NMEM; m += NGW) rms_row_to_bf16(a.in[I_MEM] + (size_t)m * D, a.in[I_NMEMG], (bf16_t*)(ws + WS_MEMN) + (size_t)m * D, lane);
}

constexpr int AT_KS = 144;
constexpr int AT_VS = 520;
constexpr int AT_VOFF = 256 * AT_KS;
__device__ __forceinline__ bf16x8 pack_step(const f32x16& x, int s) {
    u32x4 p;
    asm volatile("v_cvt_pk_bf16_f32 %0, %4, %5\n\tv_cvt_pk_bf16_f32 %1, %6, %7\n\tv_cvt_pk_bf16_f32 %2, %8, %9\n\tv_cvt_pk_bf16_f32 %3, %10, %11\n\ts_nop 1"
                 : "=&v"(p[0]), "=&v"(p[1]), "=&v"(p[2]), "=&v"(p[3])
                 : "v"(x[8 * s]), "v"(x[8 * s + 1]), "v"(x[8 * s + 2]), "v"(x[8 * s + 3]), "v"(x[8 * s + 4]), "v"(x[8 * s + 5]), "v"(x[8 * s + 6]), "v"(x[8 * s + 7]));
    return __builtin_bit_cast(bf16x8, p);
}
__device__ __forceinline__ void attn_unit(const Args& a, LAS unsigned char* lds, int unit) {
    int tid = tid_of(a.wv); asm volatile("" : "+v"(tid)); const int lane = tid & 63, wave = __builtin_amdgcn_readfirstlane(tid >> 6), r = lane & 31, h = lane >> 5;
    const int b = unit >> 2, hh = unit & 3;
    const bf16_t* Qb = (const bf16_t*)(a.ws + WS_Q); const bf16_t* KM = (const bf16_t*)(a.ws + WS_KMEM); const bf16_t* VT = (const bf16_t*)(a.ws + WS_VT);
    bf16_t* MIX = (bf16_t*)(a.ws + WS_MIX);
    __syncthreads();
#pragma unroll
    for (int i = 0; i < 4; ++i) { const int c = tid + 512 * i, key = c >> 3, ch = c & 7;
        const u32x4 v = *(const u32x4*)(KM + (size_t)(b * NMEM + key) * 256 + hh * 64 + ch * 8);
        *(LAS u32x4*)(lds + key * AT_KS + ch * 16) = v; }
#pragma unroll
    for (int i = 0; i < 4; ++i) { const int c = tid + 512 * i, d = c >> 5, ch = c & 31;
        const u32x4 v = *(const u32x4*)(VT + (size_t)(hh * 64 + d) * (BATCH * NMEM) + b * NMEM + ch * 8);
        LAS u32x2* dst = (LAS u32x2*)(lds + AT_VOFF + d * AT_VS + ch * 16);
        dst[0] = (u32x2){v.x, v.y}; dst[1] = (u32x2){v.z, v.w}; }
    __syncthreads();
#pragma unroll 1
    for (int tile = 0; tile < 16; ++tile) {
    const int tok0 = b * SEQ + tile * 256 + wave * 32;
    bf16x8 qf[4];
#pragma unroll
    for (int ks = 0; ks < 4; ++ks) qf[ks] = *(const bf16x8*)(Qb + (size_t)(tok0 + r) * 256 + hh * 64 + ks * 16 + h * 8);
    const float sc = 0.125f * 1.4426950408889634f;
    float m_run = -3.0e38f, sum = 0.f;
    f32x16 o[2];
#pragma unroll
    for (int dt = 0; dt < 2; ++dt)
#pragma unroll
        for (int i = 0; i < 16; ++i) o[dt][i] = 0.f;
#pragma unroll 1
    for (int kh = 0; kh < 2; ++kh) {
        f32x16 s[4];
#pragma unroll
        for (int k4 = 0; k4 < 4; ++k4) {
#pragma unroll
            for (int i = 0; i < 16; ++i) s[k4][i] = 0.f;
#pragma unroll
            for (int ks = 0; ks < 4; ++ks) { const bf16x8 ka = *(const LAS bf16x8*)(lds + ((kh * 4 + k4) * 32 + r) * AT_KS + (ks * 16 + h * 8) * 2);
                s[k4] = __builtin_amdgcn_mfma_f32_32x32x16_bf16(ka, qf[ks], s[k4], 0, 0, 0); }
        }
        float mx = m_run;
#pragma unroll
        for (int k4 = 0; k4 < 4; ++k4)
#pragma unroll
            for (int i = 0; i < 16; ++i) mx = fmaxf(mx, s[k4][i]);
        mx = fmaxf(mx, __shfl_xor(mx, 32));
        const float alpha = __builtin_amdgcn_exp2f((m_run - mx) * sc);
        float ps = 0.f;
#pragma unroll
        for (int k4 = 0; k4 < 4; ++k4)
#pragma unroll
            for (int i = 0; i < 16; ++i) { const float e = __builtin_amdgcn_exp2f((s[k4][i] - mx) * sc); s[k4][i] = e; ps += e; }
        ps += __shfl_xor(ps, 32);
        sum = sum * alpha + ps; m_run = mx;
#pragma unroll
        for (int dt = 0; dt < 2; ++dt)
#pragma unroll
            for (int i = 0; i < 16; ++i) o[dt][i] *= alpha;
#pragma unroll
        for (int k4 = 0; k4 < 4; ++k4)
#pragma unroll
            for (int s2 = 0; s2 < 2; ++s2) {
                const bf16x8 pb = pack_step(s[k4], s2);
#pragma unroll
                for (int dt = 0; dt < 2; ++dt) {
                    const LAS unsigned char* vp = lds + AT_VOFF + (32 * dt + r) * AT_VS + (32 * (kh * 4 + k4) + 16 * s2 + 4 * h) * 2;
                    const s16x4 lo = *(const LAS s16x4*)vp, hi = *(const LAS s16x4*)(vp + 16);
                    const bf16x8 va = __builtin_shufflevector(lo, hi, 0, 1, 2, 3, 4, 5, 6, 7);
                    o[dt] = __builtin_amdgcn_mfma_f32_32x32x16_bf16(va, pb, o[dt], 0, 0, 0);
                }
            }
    }
    const float inv = 1.0f / sum;
    bf16_t* orow = MIX + (size_t)(tok0 + r) * D + hh * 64;
#pragma unroll
    for (int dt = 0; dt < 2; ++dt)
#pragma unroll
        for (int gq = 0; gq < 4; ++gq) { u32x2 w; w.x = pk_bf16(o[dt][4 * gq] * inv, o[dt][4 * gq + 1] * inv); w.y = pk_bf16(o[dt][4 * gq + 2] * inv, o[dt][4 * gq + 3] * inv);
            *(u32x2*)(orow + 32 * dt + 8 * gq + 4 * h) = w; }
    }
}

__device__ __forceinline__ void conv_unit(const Args& a, LAS unsigned char* lds, int unit) {
    int tid = tid_of(a.wv); asm volatile("" : "+v"(tid)); const int lane = tid & 63, wave = __builtin_amdgcn_readfirstlane(tid >> 6);
    const int b = unit >> 6, t0 = (unit & 63) * 64;
    const bf16_t* P = (const bf16_t*)(a.ws + WS_P); bf16_t* MIX = (bf16_t*)(a.ws + WS_MIX);
    LAS _Float16* U = (LAS _Float16*)lds;
    LAS _Float16* Cc = (LAS _Float16*)(lds + 94 * CW * 2);
    __syncthreads();
#pragma unroll 1
    for (int q0 = tid; q0 < 94 * 48; q0 += 3 * NTHREADS) {
        u32x4 vvv[3], ggg[3];
#pragma unroll
        for (int u3 = 0; u3 < 3; ++u3) { const int q = q0 + u3 * NTHREADS, j = q / 48, cc = (q % 48) * 8, s = t0 - 15 + j; const bool ok = (q < 94 * 48) && s >= 0 && s < SEQ;
            const bf16_t* row = P + (size_t)(b * SEQ + (ok ? s : 0)) * PLD + cc;
            vvv[u3] = ok ? *(const u32x4*)row : (u32x4){0u, 0u, 0u, 0u}; ggg[u3] = ok ? *(const u32x4*)(row + CW) : (u32x4){0u, 0u, 0u, 0u}; }
#pragma unroll
        for (int u3 = 0; u3 < 3; ++u3) { const int q = q0 + u3 * NTHREADS, j = q / 48, cc = (q % 48) * 8;
            if (q < 94 * 48) {
                const unsigned vw[4] = {vvv[u3].x, vvv[u3].y, vvv[u3].z, vvv[u3].w}, gw[4] = {ggg[u3].x, ggg[u3].y, ggg[u3].z, ggg[u3].w};
                float u[8];
#pragma unroll
                for (int k = 0; k < 4; ++k) { u[2 * k] = bf_lo(vw[k]) * sigmoidf_fast(bf_lo(gw[k])); u[2 * k + 1] = bf_hi(vw[k]) * sigmoidf_fast(bf_hi(gw[k])); }
                LAS f16x4* dst = (LAS f16x4*)(U + j * CW + cc); dst[0] = (f16x4){(_Float16)u[0], (_Float16)u[1], (_Float16)u[2], (_Float16)u[3]}; dst[1] = (f16x4){(_Float16)u[4], (_Float16)u[5], (_Float16)u[6], (_Float16)u[7]}; }
        }
    }
    __syncthreads();
    const int cq = tid & 127, tq = tid >> 7;
#pragma unroll 1
    for (int k3 = 0; k3 < 3; ++k3) { const int c = cq + 128 * k3;
        float w[31], res[16];
#pragma unroll
        for (int kk = 0; kk < 31; ++kk) w[kk] = a.in[I_CONVW][kk * CW + c];
        const float bias = a.in[I_CONVB][c];
#pragma unroll
        for (int tt = 0; tt < 16; ++tt) res[tt] = bias;
#pragma unroll
        for (int jj = 0; jj < 46; ++jj) { const float uv = (float)U[(tq * 16 + jj) * CW + c];
#pragma unroll
            for (int tt = 0; tt < 16; ++tt) { if (jj - tt >= 0 && jj - tt <= 30) res[tt] += uv * w[jj - tt]; } }
#pragma unroll
        for (int tt = 0; tt < 16; ++tt) Cc[(tq * 16 + tt) * CW + c] = (_Float16)res[tt];
    }
    __syncthreads();
    for (int tt = 0; tt < 8; ++tt) { const int t = wave * 8 + tt;
        float v[6]; float s = 0.f;
#pragma unroll
        for (int i = 0; i < 6; ++i) { v[i] = (float)Cc[t * CW + lane + 64 * i]; s += v[i]; }
        const float mean = wave_sum(s) * (1.f / CW); float q = 0.f;
#pragma unroll
        for (int i = 0; i < 6; ++i) { v[i] -= mean; q += v[i] * v[i]; }
        const float rstd = 1.0f / sqrtf(wave_sum(q) * (1.f / CW) + 1e-5f);
        bf16_t* orow = MIX + (size_t)(b * SEQ + t0 + t) * D + 256;
#pragma unroll
        for (int i = 0; i < 6; ++i) { const int c = lane + 64 * i; const float y = v[i] * rstd * a.in[I_CLNG][c] + a.in[I_CLNB][c]; const float o = y * sigmoidf_fast(y);
            orow[c] = (bf16_t)(pk_bf16(o, 0.f) & 0xffffu); }
    }
}

constexpr int PR_AS = 784;
constexpr int PR_RK = 64 * PR_AS;
constexpr int PR_RKS = 1536;
constexpr int PR_RN = PR_RK + 64 * PR_RKS;
constexpr int PR_CST = PR_RN + 2048;
static_assert(PR_CST + 7 * 384 * 4 <= LDS_BYTES - 64, "prep LDS map");
template <int V> struct IC { static constexpr int value = V; };
template <int CTRL> __device__ __forceinline__ f32x4 dpp4(f32x4 x) { return (f32x4){dpp_f<CTRL>(x.x), dpp_f<CTRL>(x.y), dpp_f<CTRL>(x.z), dpp_f<CTRL>(x.w)}; }
__device__ __forceinline__ void prep_unit(const Args& a, LAS unsigned char* lds, int unit) {
    int tid = tid_of(a.wv); asm volatile("" : "+v"(tid)); const int lane = tid & 63, wave = __builtin_amdgcn_readfirstlane(tid >> 6);
    const int b = unit >> 6, t0 = (unit & 63) * 64;
    const bf16_t* __restrict__ P = (const bf16_t*)(a.ws + WS_P);
    const float* __restrict__ mu = a.in[I_SHIFTMU];
    LAS float* RNs = (LAS float*)(lds + PR_RN); LAS float* CST = (LAS float*)(lds + PR_CST);
    __syncthreads();
    for (int i = tid; i < 7 * 384; i += NTHREADS) { const int w7 = i / 384, c7 = i % 384;
        CST[i] = (w7 == 0) ? a.in[I_KK][c7] : (w7 == 1) ? a.in[I_KA][c7] : (w7 == 2) ? a.in[I_RK][c7] : (w7 < 5) ? a.in[I_DW0][(w7 - 3) * RW + c7] : a.in[I_IA0][(w7 - 5) * RW + c7]; }
#ifndef PREP_REP1
#define PREP_REP1 1
#endif
#ifndef PREP_REP2
#define PREP_REP2 1
#endif
#pragma unroll 1
    for (int rp1 = 0; rp1 < PREP_REP1; ++rp1)
#pragma unroll 1
    for (int q0 = tid; q0 < 64 * 192; q0 += 4 * NTHREADS) {
        u32x4 cuv[4], pvv[4], nvv[4];
#pragma unroll
        for (int u4 = 0; u4 < 4; ++u4) { const int q = q0 + u4 * NTHREADS, tt = q / 192, c8 = (q % 192) * 8, s = t0 + tt;
            const bf16_t* row = P + ((size_t)b * SEQ + s) * PLD + 768 + c8;
            cuv[u4] = *(const u32x4*)row;
            pvv[u4] = (s > 0) ? *(const u32x4*)(row - PLD) : (u32x4){0u, 0u, 0u, 0u};
            nvv[u4] = (s < SEQ - 1) ? *(const u32x4*)(row + PLD) : (u32x4){0u, 0u, 0u, 0u}; }
#pragma unroll
        for (int u4 = 0; u4 < 4; ++u4) { const int q = q0 + u4 * NTHREADS, tt = q / 192, c8 = (q % 192) * 8, s = t0 + tt; const size_t tok = (size_t)b * SEQ + s;
            const u32x4 cu = cuv[u4], pv = pvv[u4], nv = nvv[u4];
            const unsigned cw[4] = {cu.x, cu.y, cu.z, cu.w}, pw[4] = {pv.x, pv.y, pv.z, pv.w}, nw[4] = {nv.x, nv.y, nv.z, nv.w};
            const f32x4 m0a = *(const f32x4*)(mu + c8), m0b = *(const f32x4*)(mu + c8 + 4), m1a = *(const f32x4*)(mu + 1536 + c8), m1b = *(const f32x4*)(mu + 1536 + c8 + 4);
            const float m0[8] = {m0a.x, m0a.y, m0a.z, m0a.w, m0b.x, m0b.y, m0b.z, m0b.w}, m1[8] = {m1a.x, m1a.y, m1a.z, m1a.w, m1b.x, m1b.y, m1b.z, m1b.w};
            float pf[8];
#pragma unroll
            for (int k = 0; k < 4; ++k) { const float c0 = bf_lo(cw[k]), c1 = bf_hi(cw[k]);
                pf[2 * k] = c0 + m0[2 * k] * (bf_lo(pw[k]) - c0) + m1[2 * k] * (bf_lo(nw[k]) - c0);
                pf[2 * k + 1] = c1 + m0[2 * k + 1] * (bf_hi(pw[k]) - c1) + m1[2 * k + 1] * (bf_hi(nw[k]) - c1); }
            if (c8 < 768) {
                f16x4 h0 = {(_Float16)pf[0], (_Float16)pf[1], (_Float16)pf[2], (_Float16)pf[3]}, h1 = {(_Float16)pf[4], (_Float16)pf[5], (_Float16)pf[6], (_Float16)pf[7]};
                LAS f16x4* dst = (LAS f16x4*)(lds + PR_RK + tt * PR_RKS + c8 * 2); dst[0] = h0; dst[1] = h1;
                if (c8 >= 384) { const f32x4 ka = *(const f32x4*)(a.in[I_KK] + c8 - 384), kb = *(const f32x4*)(a.in[I_KK] + c8 - 384 + 4);
                    float ssq = (pf[0] * ka.x) * (pf[0] * ka.x) + (pf[1] * ka.y) * (pf[1] * ka.y) + (pf[2] * ka.z) * (pf[2] * ka.z) + (pf[3] * ka.w) * (pf[3] * ka.w)
                              + (pf[4] * kb.x) * (pf[4] * kb.x) + (pf[5] * kb.y) * (pf[5] * kb.y) + (pf[6] * kb.z) * (pf[6] * kb.z) + (pf[7] * kb.w) * (pf[7] * kb.w);
                    ssq = sum8(ssq);
                    if ((lane & 7) == 0) RNs[tt * 8 + ((c8 - 384) >> 6)] = __builtin_amdgcn_rsqf(ssq + 1e-12f); }
            } else if (c8 < 1152) {
                u32x4 w; w.x = pk_bf16(pf[0], pf[1]); w.y = pk_bf16(pf[2], pf[3]); w.z = pk_bf16(pf[4], pf[5]); w.w = pk_bf16(pf[6], pf[7]);
                *(u32x4*)((bf16_t*)scan_arr(a.ws, 0) + hat_off(0, tok, c8 - 768)) = w;
            } else {
                const int cc = c8 - 1152;
#pragma unroll
                for (int k = 0; k < 8; ++k) { if (cc < 128) pf[k] = 1.0f - 2.0f * __builtin_amdgcn_rcpf(1.0f + __builtin_amdgcn_exp2f(2.8853900817779268f * pf[k])); else if (cc >= 256) pf[k] = sigmoidf_fast(pf[k]); }
                u32x4 w; w.x = pk_bf16(pf[0], pf[1]); w.y = pk_bf16(pf[2], pf[3]); w.z = pk_bf16(pf[4], pf[5]); w.w = pk_bf16(pf[6], pf[7]);
                *(LAS u32x4*)(lds + tt * PR_AS + cc * 2) = w; }
        }
    }
    __syncthreads();
    const int l15 = lane & 15, kq = lane >> 4;
    float* __restrict__ PCg = (float*)(a.ws + WS_PC); float* __restrict__ BON = (float*)(a.ws + WS_BON);
    const char* SMb = (const char*)(a.ws + WS_SMALL);
    const unsigned wlo64 = (unsigned)(((8 * (l15 >> 2) + (l15 & 3)) * 64 + kq * 8) * 2), wlo128 = (unsigned)(((8 * (l15 >> 2) + (l15 & 3)) * 128 + kq * 8) * 2);
    const unsigned hlo = (unsigned)((l15 * 64 + 8 * kq) * 2), klo = (unsigned)((l15 * D + 8 * kq) * 2), glo = (unsigned)((l15 * RW + 8 * kq) * 2);
    bf16x8 Fc[16], Fn[16];
#define PREP_LOADW(hd_, kind_) do { \
        if ((kind_) < 2) { const char* w_ = SMb + ((size_t)(kind_) * RW * 64 + (size_t)(hd_) * 64 * 64) * 2; \
            _Pragma("unroll") for (int f_ = 0; f_ < 16; ++f_) Fn[f_] = *(const bf16x8*)(w_ + (size_t)(((f_ >> 2) & 1) * (2 * RW * 64 * 2) + (32 * ((f_ & 3) >> 1) + 4 * (f_ & 1)) * 128 + (f_ >> 3) * 64) + wlo64); } \
        else { const char* w_ = SMb + ((size_t)4 * RW * 64 + (size_t)(hd_) * 64 * 128) * 2; \
            _Pragma("unroll") for (int f_ = 0; f_ < 16; ++f_) Fn[f_] = *(const bf16x8*)(w_ + (size_t)((32 * ((f_ & 3) >> 1) + 4 * (f_ & 1)) * 256 + (f_ >> 2) * 64) + wlo128); } } while (0)
    auto dir_stage = [&](auto dc, const int it, const int nhd, const int nkind) {
        constexpr int d = decltype(dc)::value;
        const int hd = it >> 2, mt = it & 3, tokl = mt * 16 + l15; const size_t tb = (size_t)b * SEQ + t0 + mt * 16;
#pragma unroll
        for (int f = 0; f < 16; ++f) Fc[f] = Fn[f];
        f32x4 accW[4], accA[4];
#pragma unroll
        for (int nt = 0; nt < 4; ++nt) { accW[nt] = (f32x4){0.f, 0.f, 0.f, 0.f}; accA[nt] = (f32x4){0.f, 0.f, 0.f, 0.f}; }
#pragma unroll
        for (int ks = 0; ks < 2; ++ks) {
            const bf16x8 aw = *(const LAS bf16x8*)(lds + tokl * PR_AS + (d * 64 + ks * 32 + kq * 8) * 2), aa = *(const LAS bf16x8*)(lds + tokl * PR_AS + ((2 + d) * 64 + ks * 32 + kq * 8) * 2);
#pragma unroll
            for (int nt = 0; nt < 4; ++nt) { accW[nt] = MFMA16(Fc[ks * 8 + nt], aw, accW[nt]); accA[nt] = MFMA16(Fc[ks * 8 + 4 + nt], aa, accA[nt]); }
        }
        if (nkind >= 0) PREP_LOADW(nhd, nkind);
        const float rn = RNs[tokl * 8 + hd];
        const size_t tile_b = ((((tb >> 4) * NH + hd) << 10)) * 2;
        char* AHb = (char*)scan_arr(a.ws, 1 + 4 * d) + tile_b; char* RHb = (char*)scan_arr(a.ws, 2 + 4 * d) + tile_b; char* BHb = (char*)scan_arr(a.ws, 3 + 4 * d) + tile_b;
        char* KHb = d ? (char*)scan_arr(a.ws, 8) + (tb * D + hd * 64) * 2 : (char*)scan_arr(a.ws, 4) + tile_b; const unsigned khlo = d ? klo : hlo;
        char* PCb = (char*)(PCg + ((size_t)d * (T / 16) + (tb >> 4)) * RW + hd * 64); char* BOb = (char*)(BON + (size_t)d * T * NH + tb * NH + hd);
        float bsum = 0.f;
        u32x2 hA[2], hR[2], hB[2], hK[2]; f32x4 PtS[4];
#pragma unroll
        for (int nt = 0; nt < 4; ++nt) { const int ch = hd * 64 + 32 * (nt >> 1) + 8 * kq + 4 * (nt & 1);
            const f32x4 bW = *(const LAS f32x4*)(CST + (3 + d) * 384 + ch), bA = *(const LAS f32x4*)(CST + (5 + d) * 384 + ch);
            const f32x4 kkw = *(const LAS f32x4*)(CST + ch), kaw = *(const LAS f32x4*)(CST + 384 + ch), rkw = *(const LAS f32x4*)(CST + 768 + ch);
            const f32x4 zw = accW[nt] + bW, za = accA[nt] + bA;
            f32x4 lw, av;
#pragma unroll
            for (int e = 0; e < 4; ++e) { lw[e] = -0.606531f * 1.4426950408889634f * sigmoidf_fast(zw[e]); av[e] = sigmoidf_fast(za[e]); }
            f32x4 cum = lw;
            if (d == 0) { cum += dpp4<0x111>(cum); cum += dpp4<0x112>(cum); cum += dpp4<0x114>(cum); cum += dpp4<0x118>(cum); }
            else        { cum += dpp4<0x101>(cum); cum += dpp4<0x102>(cum); cum += dpp4<0x104>(cum); cum += dpp4<0x108>(cum); }
            f32x4 Pt, Pinv, Pprev;
#pragma unroll
            for (int e = 0; e < 4; ++e) { Pt[e] = __builtin_amdgcn_exp2f(cum[e]); Pinv[e] = __builtin_amdgcn_rcpf(Pt[e]);
                Pprev[e] = __builtin_amdgcn_exp2f(cum[e] - lw[e]); }
            PtS[nt] = Pt;
            const f32x4 r4 = __builtin_convertvector(*(const LAS f16x4*)(lds + PR_RK + tokl * PR_RKS + ch * 2), f32x4);
            const f32x4 k4 = __builtin_convertvector(*(const LAS f16x4*)(lds + PR_RK + tokl * PR_RKS + (384 + ch) * 2), f32x4);
            const f32x4 kk = k4 * kkw * rn, kd = k4 * (1.0f + (av - 1.0f) * kaw);
            hA[nt & 1] = f32_to_bf4(-kk * Pprev); hR[nt & 1] = f32_to_bf4(r4 * Pt); hB[nt & 1] = f32_to_bf4(kk * av * Pinv); hK[nt & 1] = f32_to_bf4(kd * Pinv);
            const f32x4 bt = r4 * kd * rkw; bsum += (bt.x + bt.y) + (bt.z + bt.w);
            if (nt & 1) { const int pr = nt >> 1;
                *(u32x4*)(AHb + (hlo + 64 * pr)) = (u32x4){hA[0].x, hA[0].y, hA[1].x, hA[1].y}; *(u32x4*)(RHb + (hlo + 64 * pr)) = (u32x4){hR[0].x, hR[0].y, hR[1].x, hR[1].y};
                *(u32x4*)(BHb + (hlo + 64 * pr)) = (u32x4){hB[0].x, hB[0].y, hB[1].x, hB[1].y}; *(u32x4*)(KHb + (khlo + 64 * pr)) = (u32x4){hK[0].x, hK[0].y, hK[1].x, hK[1].y}; }
        }
        if (l15 == (d ? 0 : 15)) {
#pragma unroll
            for (int nt = 0; nt < 4; ++nt) *(f32x4*)(PCb + (unsigned)(8 * kq * 4) + (32 * (nt >> 1) + 4 * (nt & 1)) * 4) = PtS[nt]; }
        bsum += __shfl_xor(bsum, 16); bsum += __shfl_xor(bsum, 32);
        if (kq == 0) *(float*)(BOb + (unsigned)(l15 * NH * 4)) = bsum;
    };
    auto gate_stage = [&](const int it, const int nhd, const int nkind) {
        const int hd = it >> 2, mt = it & 3, tokl = mt * 16 + l15; const size_t tb = (size_t)b * SEQ + t0 + mt * 16;
#pragma unroll
        for (int f = 0; f < 16; ++f) Fc[f] = Fn[f];
        f32x4 acc[4];
#pragma unroll
        for (int nt = 0; nt < 4; ++nt) acc[nt] = (f32x4){0.f, 0.f, 0.f, 0.f};
#pragma unroll
        for (int ks = 0; ks < 4; ++ks) { const bf16x8 afr = *(const LAS bf16x8*)(lds + tokl * PR_AS + (256 + ks * 32 + kq * 8) * 2);
#pragma unroll
            for (int nt = 0; nt < 4; ++nt) acc[nt] = MFMA16(Fc[ks * 4 + nt], afr, acc[nt]); }
        if (nkind >= 0) PREP_LOADW(nhd, nkind);
        char* Gb = (char*)((bf16_t*)(a.ws + WS_G) + tb * RW + hd * 64);
#pragma unroll
        for (int pr = 0; pr < 2; ++pr) { const u32x2 g0 = f32_to_bf4(acc[2 * pr]), g1 = f32_to_bf4(acc[2 * pr + 1]);
            *(u32x4*)(Gb + (glo + 64 * pr)) = (u32x4){g0.x, g0.y, g1.x, g1.y}; }
    };
    PREP_LOADW(wave >> 2, 0);
#pragma unroll 1
    for (int k3 = 0; k3 < 3; ++k3) { const int it = wave + 8 * k3, hd = it >> 2;
        dir_stage(IC<0>{}, it, hd, 1);
        dir_stage(IC<1>{}, it, hd, 2);
        gate_stage(it, (it + 8) >> 2, k3 < 2 ? 0 : -1);
    }
#undef PREP_LOADW
}

__device__ __forceinline__ void glds16_asm(const void* gptr, LAS unsigned char* ldst) {
    const unsigned la = __builtin_amdgcn_readfirstlane((unsigned)(size_t)ldst);
    asm volatile("s_mov_b32 m0, %1\n\ts_nop 0\n\tglobal_load_lds_dwordx4 %0, off" :: "v"(gptr), "s"(la) : "m0", "memory");
}
constexpr int CK = 16, NCHUNK = SEQ / CK, CS_NS = 8, CS_NPROD = 6, CS_NCONS = 2;
constexpr int SL_ATIL = 0, SL_RTIL = 2048, SL_BH = 4096, SL_KH = 6144, SL_V = 8192, SL_ULOC = 10240, SL_YLOC = 12288, SL_PC = 14336, SL_BYTES = 14592;
constexpr int PS_AH = 0, PS_RH = 2048, PS_BYTES = 4096;
constexpr int CS_PS_OFF = CS_NS * SL_BYTES, CS_FLAG_OFF = CS_PS_OFF + CS_NPROD * PS_BYTES;
static_assert(CS_FLAG_OFF + 64 <= LDS_BYTES - 64, "chunked scan LDS map");
__device__ __forceinline__ int swz(int t, int j) { return t * 128 + ((((j >> 3) ^ (t & 7))) << 4) + ((j & 4) << 1); }
__device__ __forceinline__ void scan_chunked_unit(const Args& a, LAS unsigned char* lds, int unit) {
    int tid = tid_of(a.wv); asm volatile("" : "+v"(tid)); const int lane = tid & 63, wave = __builtin_amdgcn_readfirstlane(tid >> 6);
    const int dir = unit & 1, bh = unit >> 1, b = bh / NH, hd = bh % NH;
    const int c16 = lane & 15, q = lane >> 4, qp = c16 >> 2, pp = c16 & 3;
    volatile LAS unsigned* FULL = (volatile LAS unsigned*)(lds + CS_FLAG_OFF);
    volatile LAS unsigned* DONE = FULL + 8;
    float* Yg = (float*)(a.ws + (dir ? WS_YB : WS_YF));
    __syncthreads();
    if (tid < 16) FULL[tid] = 0u;
    __syncthreads();
    if (wave >= CS_NCONS) {
        const int pw = wave - CS_NCONS;
        LAS unsigned char* ps = lds + CS_PS_OFF + pw * PS_BYTES;
        const bf16_t* ARR[5] = {(const bf16_t*)scan_arr(a.ws, 1 + 4 * dir), (const bf16_t*)scan_arr(a.ws, 2 + 4 * dir), (const bf16_t*)scan_arr(a.ws, 3 + 4 * dir), (const bf16_t*)scan_arr(a.ws, 4 + 4 * dir), (const bf16_t*)scan_arr(a.ws, 0)};
        const int AIDX[5] = {1 + 4 * dir, 2 + 4 * dir, 3 + 4 * dir, 4 + 4 * dir, 0};
        const float* PCg = (const float*)(a.ws + WS_PC) + (size_t)dir * (T / 16) * RW + hd * 64 + lane;
        u32x4 pf[10];
#define CS_ISSUE(cc) do { _Pragma("unroll") for (int ar_ = 0; ar_ < 5; ++ar_) _Pragma("unroll") for (int hf_ = 0; hf_ < 2; ++hf_) { \
            const int row_ = hf_ * 8 + (lane >> 3); const int st_ = (cc) * CK + row_; const int t_ = dir ? (SEQ - 1 - st_) : st_; \
            pf[ar_ * 2 + hf_] = *(const u32x4*)(ARR[ar_] + hat_off(AIDX[ar_], (size_t)b * SEQ + t_, hd * 64 + 8 * ((lane & 7) ^ (row_ & 7)))); } } while (0)
#define CS_PCLOAD(cc) PCg[(size_t)((size_t)b * (SEQ / CK) + (dir ? (NCHUNK - 1 - (cc)) : (cc))) * RW]
        CS_ISSUE(pw);
        float pcn = CS_PCLOAD(pw);
#pragma unroll 1
        for (int c = pw; c < NCHUNK; c += CS_NPROD) {
            const int slot = c % CS_NS; LAS unsigned char* sl = lds + slot * SL_BYTES;
            { unsigned sp = 0; const unsigned want = (unsigned)CS_NCONS * (unsigned)(c / CS_NS); while (DONE[slot] < want) { __builtin_amdgcn_s_sleep(1); if (++sp > (1u << 22)) break; } }
            asm volatile("" ::: "memory");
            *(LAS u32x4*)(ps + PS_AH + lane * 16) = pf[0]; *(LAS u32x4*)(ps + PS_AH + 1024 + lane * 16) = pf[1];
            *(LAS u32x4*)(ps + PS_RH + lane * 16) = pf[2]; *(LAS u32x4*)(ps + PS_RH + 1024 + lane * 16) = pf[3];
            *(LAS u32x4*)(sl + SL_BH + lane * 16) = pf[4]; *(LAS u32x4*)(sl + SL_BH + 1024 + lane * 16) = pf[5];
            *(LAS u32x4*)(sl + SL_KH + lane * 16) = pf[6]; *(LAS u32x4*)(sl + SL_KH + 1024 + lane * 16) = pf[7];
            *(LAS u32x4*)(sl + SL_V + lane * 16) = pf[8]; *(LAS u32x4*)(sl + SL_V + 1024 + lane * 16) = pf[9];
            *(LAS float*)(sl + SL_PC + lane * 4) = pcn;
            if (c + CS_NPROD < NCHUNK) { CS_ISSUE(c + CS_NPROD); pcn = CS_PCLOAD(c + CS_NPROD); }
            asm volatile("s_waitcnt lgkmcnt(0)" ::: "memory");
#ifndef PROD_REP
#define PROD_REP 1
#endif
#pragma unroll 1
            for (int rpp = 0; rpp < PROD_REP; ++rpp) {
            bf16x8 AHf[2], BHf[2], KHf[2], RHf[2];
#pragma unroll
            for (int ks = 0; ks < 2; ++ks) { const int o = swz(c16, 32 * ks + 8 * q);
                AHf[ks] = *(const LAS bf16x8*)(ps + PS_AH + o); RHf[ks] = *(const LAS bf16x8*)(ps + PS_RH + o); BHf[ks] = *(const LAS bf16x8*)(sl + SL_BH + o); KHf[ks] = *(const LAS bf16x8*)(sl + SL_KH + o); }
            f32x4 Mab = {0.f, 0.f, 0.f, 0.f}, Mak = Mab, MrbT = Mab, MrkT = Mab, MabT = Mab;
#pragma unroll
            for (int ks = 0; ks < 2; ++ks) { Mab = MFMA16(AHf[ks], BHf[ks], Mab); MabT = MFMA16(BHf[ks], AHf[ks], MabT); Mak = MFMA16(AHf[ks], KHf[ks], Mak); MrbT = MFMA16(BHf[ks], RHf[ks], MrbT); MrkT = MFMA16(KHf[ks], RHf[ks], MrkT); }
#pragma unroll
            for (int r = 0; r < 4; ++r) { const bool lt = c16 < 4 * q + r, gt = 4 * q + r < c16, le = 4 * q + r <= c16;
                Mab[r] = lt ? Mab[r] : 0.f; Mak[r] = lt ? Mak[r] : 0.f; MabT[r] = gt ? MabT[r] : 0.f; MrbT[r] = le ? MrbT[r] : 0.f; MrkT[r] = le ? MrkT[r] : 0.f; }
            const f32x4 z4 = {0.f, 0.f, 0.f, 0.f};
            const bf16x8 fN = frag_lo4(Mab), fNT = frag_lo4(MabT);
            const f32x4 N2 = MFMA16(fNT, fN, z4), N2T = MFMA16(fN, fNT, z4);
            f32x4 PT = MabT;
#pragma unroll
            for (int r = 0; r < 4; ++r) PT[r] += (4 * q + r == c16) ? 1.0f : 0.f;
            const bf16x8 fN2 = frag_lo4(N2), fN2T = frag_lo4(N2T);
            PT = MFMA16(fN2, frag_lo4(PT), PT);
            const f32x4 N4 = MFMA16(fN2T, fN2, z4), N4T = MFMA16(fN2, fN2T, z4);
            const bf16x8 fN4 = frag_lo4(N4), fN4T = frag_lo4(N4T);
            PT = MFMA16(fN4, frag_lo4(PT), PT);
            const f32x4 N8 = MFMA16(fN4T, fN4, z4);
            PT = MFMA16(frag_lo4(N8), frag_lo4(PT), PT);
            const bf16x8 LinvF = frag_lo4(PT);
            const bf16x8 MakF = frag_lo4(Mak), MrbTF = frag_lo4(MrbT);
            const f32x4 W1 = MFMA16(LinvF, MakF, z4);
            const f32x4 W1T = MFMA16(MakF, LinvF, z4);
            const f32x4 W2T = MFMA16(frag_lo4(W1), MrbTF, MrkT);
            f32x4 AtT[4], RtT[4];
#pragma unroll
            for (int jt = 0; jt < 4; ++jt) {
                const bf16x8 ahF = frag_cat(__builtin_bit_cast(u32x2, tr_read16(ps + PS_AH + swz(4 * q + qp, 16 * jt + 4 * pp))), (u32x2){0u, 0u});
                const f32x4 AtN = MFMA16(LinvF, ahF, z4);
                AtT[jt] = MFMA16(ahF, LinvF, z4);
                const f32x4 rinit = bf4_to_f32(*(const LAS u32x2*)(ps + PS_RH + swz(c16, 16 * jt + 4 * q)));
                RtT[jt] = MFMA16(frag_lo4(AtN), MrbTF, rinit);
            }
#pragma unroll
            for (int ks = 0; ks < 2; ++ks) {
                const u32x4 wa = {pk_bf16(AtT[2 * ks][0], AtT[2 * ks][1]), pk_bf16(AtT[2 * ks][2], AtT[2 * ks][3]), pk_bf16(AtT[2 * ks + 1][0], AtT[2 * ks + 1][1]), pk_bf16(AtT[2 * ks + 1][2], AtT[2 * ks + 1][3])};
                const u32x4 wr = {pk_bf16(RtT[2 * ks][0], RtT[2 * ks][1]), pk_bf16(RtT[2 * ks][2], RtT[2 * ks][3]), pk_bf16(RtT[2 * ks + 1][0], RtT[2 * ks + 1][1]), pk_bf16(RtT[2 * ks + 1][2], RtT[2 * ks + 1][3])};
                *(LAS u32x4*)(sl + SL_ATIL + ks * 1024 + lane * 16) = wa; *(LAS u32x4*)(sl + SL_RTIL + ks * 1024 + lane * 16) = wr; }
            *(LAS u32x2*)(sl + SL_ULOC + lane * 8) = f32_to_bf4(W1T); *(LAS u32x2*)(sl + SL_YLOC + lane * 8) = f32_to_bf4(W2T);
            }
            asm volatile("s_waitcnt lgkmcnt(0)" ::: "memory");
            if (lane == 0) FULL[slot] = (unsigned)(c + 1);
        }
#undef CS_ISSUE
#undef CS_PCLOAD
    } else {
        struct ConsOps { bf16x8 at0, at1, rt0, rt1, bk[4]; u32x2 w1w, w2w, vfw[2]; f32x4 pc[4]; };
        f32x4 S[2][4];
#pragma unroll
        for (int ti = 0; ti < 2; ++ti)
#pragma unroll
            for (int mt = 0; mt < 4; ++mt) S[ti][mt] = (f32x4){0.f, 0.f, 0.f, 0.f};
#define CONS_LOAD(X, cc) do { const int slot_ = (cc) % CS_NS; LAS unsigned char* sl_ = lds + slot_ * SL_BYTES; \
            { unsigned sp_ = 0; while (FULL[slot_] < (unsigned)((cc) + 1)) { __builtin_amdgcn_s_sleep(1); if (++sp_ > (1u << 22)) break; } } \
            asm volatile("" ::: "memory"); \
            X.at0 = *(const LAS bf16x8*)(sl_ + SL_ATIL + lane * 16); X.at1 = *(const LAS bf16x8*)(sl_ + SL_ATIL + 1024 + lane * 16); \
            X.rt0 = *(const LAS bf16x8*)(sl_ + SL_RTIL + lane * 16); X.rt1 = *(const LAS bf16x8*)(sl_ + SL_RTIL + 1024 + lane * 16); \
            X.w1w = *(const LAS u32x2*)(sl_ + SL_ULOC + lane * 8); X.w2w = *(const LAS u32x2*)(sl_ + SL_YLOC + lane * 8); \
            _Pragma("unroll") for (int mt_ = 0; mt_ < 4; ++mt_) { X.pc[mt_] = *(const LAS f32x4*)(sl_ + SL_PC + (16 * mt_ + 4 * q) * 4); \
                X.bk[mt_] = frag_cat(__builtin_bit_cast(u32x2, tr_read16(sl_ + SL_BH + swz(4 * q + qp, 16 * mt_ + 4 * pp))), __builtin_bit_cast(u32x2, tr_read16(sl_ + SL_KH + swz(4 * q + qp, 16 * mt_ + 4 * pp)))); } \
            _Pragma("unroll") for (int ti_ = 0; ti_ < 2; ++ti_) X.vfw[ti_] = __builtin_bit_cast(u32x2, tr_read16(sl_ + SL_V + swz(4 * q + qp, 16 * (2 * wave + ti_) + 4 * pp))); } while (0)
#define CONS_COMPUTE(X, cc) do { const f32x4 z4c_ = {0.f, 0.f, 0.f, 0.f}; const bf16x8 w1f_ = frag_cat(X.w1w, (u32x2){0u, 0u}), w2f_ = frag_cat(X.w2w, (u32x2){0u, 0u}); \
            _Pragma("unroll") for (int ti_ = 0; ti_ < 2; ++ti_) { const int nt_ = 2 * wave + ti_; \
                const bf16x8 vB_ = frag_cat(X.vfw[ti_], (u32x2){0u, 0u}); \
                const bf16x8 Sb0_ = frag_cat(f32_to_bf4(S[ti_][0]), f32_to_bf4(S[ti_][1])), Sb1_ = frag_cat(f32_to_bf4(S[ti_][2]), f32_to_bf4(S[ti_][3])); \
                const f32x4 U0_ = MFMA16(X.at0, Sb0_, MFMA16(w1f_, vB_, z4c_)), U1_ = MFMA16(X.at1, Sb1_, z4c_); \
                const f32x4 Y0_ = MFMA16(X.rt0, Sb0_, MFMA16(w2f_, vB_, z4c_)), Y1_ = MFMA16(X.rt1, Sb1_, z4c_); \
                const f32x4 UT_ = U0_ + U1_, YT_ = Y0_ + Y1_; \
                const bf16x8 Ub_ = frag_cat(f32_to_bf4(UT_), X.vfw[ti_]); \
                _Pragma("unroll") for (int mt_ = 0; mt_ < 4; ++mt_) { S[ti_][mt_] = MFMA16(X.bk[mt_], Ub_, S[ti_][mt_]); S[ti_][mt_] = S[ti_][mt_] * X.pc[mt_]; } \
                *(f32x4*)(Yg + ((((size_t)b * NCHUNK + (dir ? (NCHUNK - 1 - (cc)) : (cc))) * NH + hd) * 64 + 16 * nt_ + c16) * 16 + 4 * q) = YT_; } } while (0)
#define CONS_DONE(cc) do { asm volatile("s_waitcnt lgkmcnt(0)" ::: "memory"); if (lane == 0) (void)__hip_atomic_fetch_add((LAS unsigned*)&DONE[(cc) % CS_NS], 1u, __ATOMIC_RELAXED, __HIP_MEMORY_SCOPE_WORKGROUP); } while (0)
        ConsOps OA, OB;
        CONS_LOAD(OA, 0);
#pragma unroll 1
        for (int c = 0; c < NCHUNK; c += 2) {
            CONS_LOAD(OB, c + 1);
            CONS_COMPUTE(OA, c);
            CONS_DONE(c);
            if (c + 2 < NCHUNK) CONS_LOAD(OA, c + 2);
            CONS_COMPUTE(OB, c + 1);
            CONS_DONE(c + 1);
        }
#undef CONS_LOAD
#undef CONS_COMPUTE
#undef CONS_DONE
        unsigned tq0 = 0u, tq1 = 0u, tq2 = 0u, tq3 = 0u, tq4 = 0u, tq5 = 0u, tacc = 0u;
        (void)tq0; (void)tq1; (void)tq2; (void)tq3; (void)tq4; (void)tq5;
        (void)tacc;
    }
}

__device__ __forceinline__ void phase_post(const Args& a, int G) {
    int tid = tid_of(a.wv); asm volatile("" : "+v"(tid)); const int lane = tid & 63, wave = __builtin_amdgcn_readfirstlane(tid >> 6);
    const int gw = blockIdx.x * 8 + wave, NGW = G * 8, t = lane & 15, iq = lane >> 4;
    const float* __restrict__ YF = (const float*)(a.ws + WS_YF); const float* __restrict__ YB = (const float*)(a.ws + WS_YB); const float* __restrict__ BON = (const float*)(a.ws + WS_BON);
    const bf16_t* __restrict__ Vg = (const bf16_t*)scan_arr(a.ws, 0); const bf16_t* __restrict__ Gg = (const bf16_t*)(a.ws + WS_G); bf16_t* __restrict__ MIX = (bf16_t*)(a.ws + WS_MIX);
    float* ss = (float*)(a.ws + WS_SS);
    for (int i = blockIdx.x * NTHREADS + tid; i < T; i += G * NTHREADS) ss[i] = 0.f;
    constexpr int NIT = (T / 16) * NH;
#pragma unroll 1
    for (int it = gw; it < NIT; it += NGW) {
        const int tile = it / NH, hd = it - tile * NH, tok = tile * 16 + t;
        const float* yfp = YF + ((size_t)it * 64 + 16 * iq) * 16 + t; const float* ybp = YB + ((size_t)it * 64 + 16 * iq) * 16 + (15 - t);
        float y[16];
#pragma unroll
        for (int k = 0; k < 16; ++k) y[k] = yfp[k * 16] + ybp[k * 16];
        const u32x4 v0 = *(const u32x4*)(Vg + ((size_t)it * 16 + t) * 64 + 16 * iq), v1 = *(const u32x4*)(Vg + ((size_t)it * 16 + t) * 64 + 16 * iq + 8);
        const u32x4 g0 = *(const u32x4*)(Gg + (size_t)tok * RW + hd * 64 + 16 * iq), g1 = *(const u32x4*)(Gg + (size_t)tok * RW + hd * 64 + 16 * iq + 8);
        const float bon = BON[(size_t)tok * NH + hd] + BON[(size_t)T * NH + (size_t)tok * NH + hd];
        float sm = 0.f;
#pragma unroll
        for (int k = 0; k < 16; ++k) sm += y[k];
        sm += __shfl_xor(sm, 16); sm += __shfl_xor(sm, 32);
        const float mean = sm * (1.f / 64.f); float vs = 0.f;
#pragma unroll
        for (int k = 0; k < 16; ++k) { y[k] -= mean; vs += y[k] * y[k]; }
        vs += __shfl_xor(vs, 16); vs += __shfl_xor(vs, 32);
        const float rstd = 1.0f / sqrtf(vs * (1.f / 64.f) + 64e-5f);
        const unsigned vw[8] = {v0.x, v0.y, v0.z, v0.w, v1.x, v1.y, v1.z, v1.w}, gwd[8] = {g0.x, g0.y, g0.z, g0.w, g1.x, g1.y, g1.z, g1.w};
        unsigned ow[8];
#pragma unroll
        for (int k2 = 0; k2 < 8; ++k2) { const int ch = hd * 64 + 16 * iq + 2 * k2;
            const float o0 = (y[2 * k2] * rstd * a.in[I_LNXG][ch] + a.in[I_LNXB][ch] + bon * bf_lo(vw[k2])) * bf_lo(gwd[k2]);
            const float o1 = (y[2 * k2 + 1] * rstd * a.in[I_LNXG][ch + 1] + a.in[I_LNXB][ch + 1] + bon * bf_hi(vw[k2])) * bf_hi(gwd[k2]);
            ow[k2] = pk_bf16(o0, o1); }
        bf16_t* op = MIX + (size_t)tok * D + 640 + hd * 64 + 16 * iq;
        *(u32x4*)op = (u32x4){ow[0], ow[1], ow[2], ow[3]}; *(u32x4*)(op + 8) = (u32x4){ow[4], ow[5], ow[6], ow[7]};
    }
}

constexpr int RT_WS = 2064;
__device__ __forceinline__ void phase_router(const Args& a, LAS unsigned char* lds, int G) {
    int tid = tid_of(a.wv); asm volatile("" : "+v"(tid)); const int lane = tid & 63, wave = __builtin_amdgcn_readfirstlane(tid >> 6);
    const int gw = blockIdx.x * 8 + wave, NGW = G * 8, l15 = lane & 15, kq = lane >> 4;
    LAS bf16_t* WH = (LAS bf16_t*)lds; LAS bf16_t* WL = (LAS bf16_t*)(lds + 16 * RT_WS);
    for (int i = tid; i < D * NE; i += NTHREADS) { const int k = i >> 4, e = i & 15; const float w = a.in[I_WROUTER][i];
        const unsigned hi = pk_bf16(w, 0.f) & 0xffffu; const float rem = w - bf_lo(hi);
        WH[e * (RT_WS / 2) + k] = (bf16_t)hi; WL[e * (RT_WS / 2) + k] = (bf16_t)(pk_bf16(rem, 0.f) & 0xffffu); }
    __syncthreads();
    const float* __restrict__ X1 = (const float*)(a.ws + WS_X1); const float* __restrict__ ss = (const float*)(a.ws + WS_SS); bf16_t* __restrict__ H2 = (bf16_t*)(a.ws + WS_H2);
    float* __restrict__ AFF = (float*)(a.ws + WS_AFF); int* __restrict__ INV = (int*)(a.ws + WS_INV);
    const float* __restrict__ GF = a.in[I_NFFNG];
    for (int grp = gw; grp < T / 16; grp += NGW) {
        const int tok = grp * 16 + l15;
        const float rs = 1.0f / sqrtf(ss[tok] * (1.f / D) + 1e-6f);
        f32x4 acc = {0.f, 0.f, 0.f, 0.f};
        const float* xrow = X1 + (size_t)tok * D + 8 * kq; unsigned char* hrow8 = (unsigned char*)H2 + (size_t)tok * D + 8 * kq;
#pragma unroll 8
        for (int ks = 0; ks < 32; ++ks) {
            const f32x4 x0 = *(const f32x4*)(xrow + 32 * ks), x1v = *(const f32x4*)(xrow + 32 * ks + 4);
            const f32x4 g0 = *(const f32x4*)(GF + 32 * ks + 8 * kq), g1 = *(const f32x4*)(GF + 32 * ks + 8 * kq + 4);
            const f32x4 h0 = x0 * rs * g0, h1 = x1v * rs * g1;
            u32x4 hi; hi.x = pk_bf16(h0.x, h0.y); hi.y = pk_bf16(h0.z, h0.w); hi.z = pk_bf16(h1.x, h1.y); hi.w = pk_bf16(h1.z, h1.w);
            *(u32x2*)(hrow8 + 32 * ks) = (u32x2){pk_fp8x4(h0.x, h0.y, h0.z, h0.w), pk_fp8x4(h1.x, h1.y, h1.z, h1.w)};
            u32x4 lo; lo.x = pk_bf16(h0.x - bf_lo(hi.x), h0.y - bf_hi(hi.x)); lo.y = pk_bf16(h0.z - bf_lo(hi.y), h0.w - bf_hi(hi.y));
            lo.z = pk_bf16(h1.x - bf_lo(hi.z), h1.y - bf_hi(hi.z)); lo.w = pk_bf16(h1.z - bf_lo(hi.w), h1.w - bf_hi(hi.w));
            const bf16x8 ah = __builtin_bit_cast(bf16x8, hi), al = __builtin_bit_cast(bf16x8, lo);
            const bf16x8 bh = *(const LAS bf16x8*)(lds + l15 * RT_WS + (32 * ks + 8 * kq) * 2), bl = *(const LAS bf16x8*)(lds + 16 * RT_WS + l15 * RT_WS + (32 * ks + 8 * kq) * 2);
            acc = __builtin_amdgcn_mfma_f32_16x16x32_bf16(ah, bh, acc, 0, 0, 0);
            acc = __builtin_amdgcn_mfma_f32_16x16x32_bf16(al, bh, acc, 0, 0, 0);
            acc = __builtin_amdgcn_mfma_f32_16x16x32_bf16(ah, bl, acc, 0, 0, 0);
        }
#pragma unroll
        for (int rg = 0; rg < 4; ++rg) { const float mx = max16(acc[rg]); const float ex = __expf(acc[rg] - mx); const float sm = sum16(ex);
            const int t2 = grp * 16 + 4 * kq + rg, bb = t2 >> 12, sq = t2 & (SEQ - 1);
            AFF[((size_t)(bb * NE + l15)) * SEQ + sq] = ex / sm; }
        *(u32x4*)(INV + (size_t)grp * 256 + 4 * lane) = (u32x4){0xffffffffu, 0xffffffffu, 0xffffffffu, 0xffffffffu};
    }
}

__device__ __forceinline__ void topk_unit(const Args& a, LAS unsigned char* lds, int unit) {
    int tid = tid_of(a.wv); asm volatile("" : "+v"(tid)); const int lane = tid & 63, wave = __builtin_amdgcn_readfirstlane(tid >> 6);
    const int b = unit >> 4, e = unit & 15;
    const float* AFF = (const float*)(a.ws + WS_AFF) + (size_t)unit * SEQ;
    LAS unsigned* KEY = (LAS unsigned*)lds;
    LAS unsigned* HIST = (LAS unsigned*)(lds + 16384);
    LAS unsigned* CTL = (LAS unsigned*)(lds + 16384 + 1024);
    LAS unsigned* WS_ = (LAS unsigned*)(lds + 16384 + 2048);
    __syncthreads();
    unsigned key[8];
    { const u32x4 k0 = *(const u32x4*)(AFF + tid * 8), k1 = *(const u32x4*)(AFF + tid * 8 + 4); key[0] = k0.x; key[1] = k0.y; key[2] = k0.z; key[3] = k0.w; key[4] = k1.x; key[5] = k1.y; key[6] = k1.z; key[7] = k1.w; }
    if (tid == 0) { CTL[0] = 0u; CTL[1] = (unsigned)CAP; }
    unsigned prefix = 0u, mask = 0u;
#pragma unroll 1
    for (int pass = 0; pass < 4; ++pass) {
        const int shift = 24 - 8 * pass;
        if (tid < 256) HIST[tid] = 0u;
        __syncthreads();
#pragma unroll
        for (int i = 0; i < 8; ++i) if ((key[i] & mask) == prefix) (void)__hip_atomic_fetch_add(&HIST[(key[i] >> shift) & 255u], 1u, __ATOMIC_RELAXED, __HIP_MEMORY_SCOPE_WORKGROUP);
        __syncthreads();
        if (wave == 0) {
            const unsigned need = CTL[1];
            unsigned hv[4], tsum = 0u;
#pragma unroll
            for (int i = 0; i < 4; ++i) { hv[i] = HIST[255 - (4 * lane + i)]; tsum += hv[i]; }
            unsigned inc = tsum;
#pragma unroll
            for (int o = 1; o < 64; o <<= 1) { const unsigned v = __shfl_up(inc, o); if (lane >= o) inc += v; }
            unsigned exc = inc - tsum;
            if (exc < need && need <= inc) {
                unsigned run = exc; int di = 0;
#pragma unroll
                for (int i = 0; i < 4; ++i) { if (run < need && need <= run + hv[i]) { di = i; break; } run += hv[i]; }
                const unsigned digit = 255u - (unsigned)(4 * lane + di);
                CTL[0] = prefix | (digit << shift); CTL[1] = need - run;
            }
        }
        __syncthreads();
        prefix = CTL[0]; mask |= (255u << shift);
    }
    const unsigned thr = prefix, need_eq = CTL[1];
    unsigned ngt = 0u, neq = 0u;
#pragma unroll
    for (int i = 0; i < 8; ++i) { ngt += (key[i] > thr) ? 1u : 0u; neq += (key[i] == thr) ? 1u : 0u; }
    unsigned pk = ngt | (neq << 16), inc = pk;
#pragma unroll
    for (int o = 1; o < 64; o <<= 1) { const unsigned v = __shfl_up(inc, o); if (lane >= o) inc += v; }
    if (lane == 63) WS_[wave] = inc;
    __syncthreads();
    unsigned woff = 0u, tot = 0u;
#pragma unroll
    for (int w = 0; w < 8; ++w) { const unsigned v = WS_[w]; if (w < wave) woff += v; tot += v; }
    const unsigned exc = inc - pk + woff;
    unsigned gpos = exc & 0xffffu, epos = exc >> 16; const unsigned totgt = tot & 0xffffu;
    const int sbase = (e * BATCH + b) * CAP;
    int* ROWTOK = (int*)(a.ws + WS_ROWTOK); float* ROWGATE = (float*)(a.ws + WS_ROWGATE); int* INV = (int*)(a.ws + WS_INV);
#pragma unroll
    for (int i = 0; i < 8; ++i) {
        int pos = -1;
        if (key[i] > thr) pos = (int)gpos++;
        else if (key[i] == thr) { if (epos < need_eq) pos = (int)(totgt + epos); epos++; }
        if (pos >= 0) { const int s = tid * 8 + i, tok = b * SEQ + s, slot = sbase + pos;
            ROWTOK[slot] = tok; ROWGATE[slot] = __builtin_bit_cast(float, key[i]); INV[(size_t)tok * NE + e] = slot; }
    }
}

__device__ __forceinline__ void phase_final(const Args& a, int G) {
    int tid = tid_of(a.wv); asm volatile("" : "+v"(tid)); const int lane = tid & 63, wave = __builtin_amdgcn_readfirstlane(tid >> 6);
    const int gw = blockIdx.x * 8 + wave, NGW = G * 8;
    const float* __restrict__ X1 = (const float*)(a.ws + WS_X1); const bf16_t* __restrict__ YE = (const bf16_t*)(a.ws + WS_YE); const int* __restrict__ INV = (const int*)(a.ws + WS_INV);
    float* __restrict__ OUT = a.out;
    f32x4 gg[4];
#pragma unroll
    for (int j = 0; j < 4; ++j) gg[j] = *(const f32x4*)(a.in[I_FNG] + 4 * lane + 256 * j);
    int tok = gw;
    int invn = (tok < T) ? INV[(size_t)tok * NE + (lane & 15)] : -1;
    f32x4 xn[4];
#pragma unroll
    for (int j = 0; j < 4; ++j) xn[j] = (tok < T) ? *(const f32x4*)(X1 + (size_t)tok * D + 4 * lane + 256 * j) : (f32x4){0.f, 0.f, 0.f, 0.f};
    for (; tok < T; tok += NGW) {
        const int invc = invn; f32x4 v[4];
#pragma unroll
        for (int j = 0; j < 4; ++j) v[j] = xn[j];
        const int tn = tok + NGW;
        if (tn < T) { invn = INV[(size_t)tn * NE + (lane & 15)];
#pragma unroll
            for (int j = 0; j < 4; ++j) xn[j] = *(const f32x4*)(X1 + (size_t)tn * D + 4 * lane + 256 * j); }
        unsigned long long m = __ballot(invc >= 0) & 0xffffull;
        const int n = __builtin_popcountll(m);
        int sl[4]; float wt[4];
#pragma unroll
        for (int k = 0; k < 4; ++k) { int e = 0; if (m) { e = __builtin_ctzll(m); m &= m - 1; wt[k] = 1.f; sl[k] = __builtin_amdgcn_readlane(invc, e); } else { wt[k] = 0.f; sl[k] = 0; } }
        u32x2 rw[4][4];
#pragma unroll
        for (int k = 0; k < 4; ++k)
#pragma unroll
            for (int j = 0; j < 4; ++j) rw[k][j] = *(const u32x2*)(YE + (size_t)sl[k] * D + 4 * lane + 256 * j);
#pragma unroll
        for (int k = 0; k < 4; ++k)
#pragma unroll
            for (int j = 0; j < 4; ++j) { v[j].x += wt[k] * bf_lo(rw[k][j].x); v[j].y += wt[k] * bf_hi(rw[k][j].x); v[j].z += wt[k] * bf_lo(rw[k][j].y); v[j].w += wt[k] * bf_hi(rw[k][j].y); }
        if (n > 4) { while (m) { const int e = __builtin_ctzll(m); m &= m - 1; const int slot = __builtin_amdgcn_readlane(invc, e);
#pragma unroll
                for (int j = 0; j < 4; ++j) { const u32x2 w = *(const u32x2*)(YE + (size_t)slot * D + 4 * lane + 256 * j);
                    v[j].x += bf_lo(w.x); v[j].y += bf_hi(w.x); v[j].z += bf_lo(w.y); v[j].w += bf_hi(w.y); } } }
        float sq = 0.f;
#pragma unroll
        for (int j = 0; j < 4; ++j) sq += (v[j].x * v[j].x + v[j].y * v[j].y) + (v[j].z * v[j].z + v[j].w * v[j].w);
        float rs = 1.0f / sqrtf(wave_sum(sq) * (1.f / D) + 1e-6f);
#pragma unroll
        for (int j = 0; j < 4; ++j) *(f32x4*)(OUT + (size_t)tok * D + 4 * lane + 256 * j) = v[j] * rs * gg[j];
    }
}

#define XB_TMO      128
#define XB_XCNT(j)  (256  + 64 * (j))
#define XB_XSUB(j)  (1280 + 64 * (j))
#define XB_XGEN(j)  (2304 + 64 * (j))
#define XB_TOP      3328
#define XB_TOPGEN   3392
#define XCD_BAR_WORDS 3456
#define XB_SPIN_CAP (1u << 22)
__device__ __forceinline__ unsigned xb_ld(unsigned* p)              { return __hip_atomic_load(p, __ATOMIC_RELAXED, __HIP_MEMORY_SCOPE_AGENT); }
__device__ __forceinline__ unsigned xb_add(unsigned* p, unsigned v) { return __hip_atomic_fetch_add(p, v, __ATOMIC_RELAXED, __HIP_MEMORY_SCOPE_AGENT); }
__device__ __forceinline__ unsigned xb_xcc_id() { return (unsigned)__builtin_amdgcn_s_getreg((3 << 11) | 20) & 0xFu; }
#define XB_SPIN(cond, bar) do { unsigned _sp = 0; while (cond) { __builtin_amdgcn_s_sleep(1); \
    if ((++_sp & 255u) == 0u) { if (xb_ld(&(bar)[XB_TMO])) break; if (_sp > XB_SPIN_CAP) { atomicAdd(&(bar)[XB_TMO], 1u); break; } } } } while (0)
struct XcdBarrier { unsigned* bar; unsigned x; volatile LAS unsigned* st; int wv; };
__device__ __forceinline__ XcdBarrier xcd_barrier_post(unsigned* bar, volatile LAS unsigned* st, int wv) {
    XcdBarrier b; b.bar = bar; b.x = xb_xcc_id(); b.st = st; b.wv = wv;
    if (threadIdx.x == 0) (void)xb_add(&bar[XB_XCNT(b.x)], 1u);
    return b;
}
__device__ __forceinline__ void xcd_barrier_complete(unsigned* bar, unsigned x, unsigned& nloc, unsigned& nx) {
    const unsigned G = gridDim.x * gridDim.y * gridDim.z;
    unsigned sum, cnt, mine, sp = 0u;
    for (;;) {
        sum = 0u; cnt = 0u; mine = 0u;
#pragma unroll
        for (unsigned j = 0; j < 16; ++j) { const unsigned c = xb_ld(&bar[XB_XCNT(j)]); sum += c; cnt += (c > 0u) ? 1u : 0u; mine = (j == x) ? c : mine; }
        if (sum == G) break;
        __builtin_amdgcn_s_sleep(1);
        if ((++sp & 255u) == 0u) { if (xb_ld(&bar[XB_TMO])) break; if (sp > XB_SPIN_CAP) { atomicAdd(&bar[XB_TMO], 1u); break; } }
    }
    nloc = mine > 0u ? mine : 1u; nx = cnt > 0u ? cnt : 1u;
}
__device__ __forceinline__ void xcd_barrier(const XcdBarrier& b) {
    asm volatile("s_waitcnt vmcnt(0)" ::: "memory");
    __syncthreads();
    if (tid_of(b.wv) == 0) {
        unsigned* bar = b.bar;
        __builtin_amdgcn_s_waitcnt(0);
        unsigned nloc = b.st[0], nx = b.st[1];
        if (nloc == 0u) { xcd_barrier_complete(bar, b.x, nloc, nx); b.st[0] = nloc; b.st[1] = nx; }
        const unsigned old = xb_add(&bar[XB_XSUB(b.x)], 1u);
        const unsigned gen = old / nloc;
        if (old + 1u == (gen + 1u) * nloc) {
            __builtin_amdgcn_fence(__ATOMIC_RELEASE, "agent");
            asm volatile("s_waitcnt vmcnt(0)" ::: "memory");
            const unsigned og = xb_add(&bar[XB_TOP], 1u);
            const unsigned tg = og / nx;
            if (og + 1u == (tg + 1u) * nx) xb_add(&bar[XB_TOPGEN], 1u);
            else XB_SPIN(xb_ld(&bar[XB_TOPGEN]) == tg, bar);
            __builtin_amdgcn_fence(__ATOMIC_ACQUIRE, "agent");
            xb_add(&bar[XB_XGEN(b.x)], 1u);
            asm volatile("s_waitcnt vmcnt(0)" ::: "memory");
        } else {
            XB_SPIN(xb_ld(&bar[XB_XGEN(b.x)]) == gen, bar);
            __builtin_amdgcn_fence(__ATOMIC_ACQUIRE, "agent");
            asm volatile("s_waitcnt vmcnt(0)" ::: "memory");
        }
    }
    __syncthreads();
}

#ifndef PH_MASK
#define PH_MASK 0x7ff
#endif
#ifndef REP_MASK
#define REP_MASK 0
#endif
#ifndef P2_MASK
#define P2_MASK 7
#endif
#ifndef P2_REP
#define P2_REP 0
#define P9_REP 0
#endif
constexpr int LDS_MISC = LDS_BYTES - 64;
constexpr int LDS_PTAB = LDS_BYTES - 512;
__device__ __forceinline__ Args load_args(LAS unsigned char* lds, int lo, int hi, int wv) {
    Args r; const LAS u32x2* t = (const LAS u32x2*)(lds + LDS_PTAB);
#pragma unroll
    for (int i = 0; i < 31; ++i) { const u32x2 v = t[i]; const unsigned long long p = ((unsigned long long)(unsigned)__builtin_amdgcn_readfirstlane((int)v.y) << 32) | (unsigned)__builtin_amdgcn_readfirstlane((int)v.x);
        if (i < 29) r.in[i] = (const float*)(const __attribute__((address_space(1))) float*)p; else if (i == 29) r.out = (float*)(__attribute__((address_space(1))) float*)p; else r.ws = (unsigned char*)(__attribute__((address_space(1))) unsigned char*)p; }
    r.ph_lo = lo; r.ph_hi = hi; r.wv = wv; r.zero_ = 0; return r;
}
constexpr size_t WS_CTL = 0, CTL_BYTES = 16384;
__global__ void __launch_bounds__(NTHREADS, 2) mega(Args a0) {
    extern __shared__ __attribute__((aligned(16))) unsigned char lds_raw[];
    LAS unsigned char* lds = (LAS unsigned char*)lds_raw;
    cg::grid_group grid = cg::this_grid();
    const int G = gridDim.x, lo = a0.ph_lo, hi = a0.ph_hi, wv0 = __builtin_amdgcn_readfirstlane((int)threadIdx.x >> 6);
    volatile LAS unsigned* misc = (volatile LAS unsigned*)(lds + LDS_MISC);
    if (threadIdx.x < 16) misc[threadIdx.x] = 0u;
    if (threadIdx.x == 0) { LAS unsigned long long* t = (LAS unsigned long long*)(lds + LDS_PTAB);
#pragma unroll
        for (int i = 0; i < 29; ++i) t[i] = (unsigned long long)a0.in[i];
        t[29] = (unsigned long long)a0.out; t[30] = (unsigned long long)a0.ws; }
    __syncthreads();
    if (lo < -1000) grid.sync();
    XcdBarrier xbar = xcd_barrier_post((unsigned*)(a0.ws + WS_CTL), misc, wv0);
#define IN(k) (((PH_MASK >> (k)) & 1) && lo <= (k) && (k) < hi)
#define NREP(k) (1 + ((REP_MASK >> (k)) & 1))
#define PHASE(k, ...) do { if (IN(k)) { for (int rep_ = 0; rep_ < NREP(k); ++rep_) { { const Args a = load_args(lds, lo, hi, wv0); unsigned char* const ws = a.ws; (void)ws; __VA_ARGS__; } if (rep_ + 1 < NREP(k) || IN((k) + 1)) { xcd_barrier(xbar); } } } } while (0)

    PHASE(0, phase_prep(a, lds, G));

    PHASE(1, {
        pg8::Gemm g{(const bf16_t*)(ws + WS_XH), (const bf16_t*)(ws + WS_WINT), T, IN_PROJ, D, 0, 0};
        pg8::TripleOrder S; S.S0.init(T, IN_PROJ, G, 0); S.A1 = (const bf16_t*)(ws + WS_MEMN); S.B1 = (const bf16_t*)(ws + WS_WKT); S.A2 = (const bf16_t*)(ws + WS_WVT); S.B2 = (const bf16_t*)(ws + WS_MEMN);
        S.n1 = BATCH * NMEM / 256; S.n2 = BATCH * NMEM / 256; S.G = G; S.c = (int)blockIdx.x;
        pg8::EpiBf16x3 E{pg8::EpiBf16{(bf16_t*)(ws + WS_P), PLD, (bf16_t*)(ws + WS_Q)}, pg8::EpiBf16{(bf16_t*)(ws + WS_KMEM), 256, nullptr}, pg8::EpiBf16{(bf16_t*)(ws + WS_VT), BATCH * NMEM, nullptr}};
        pg8::gemm_phase<pg8::EpiBf16x3, pg8::TripleOrder, false>(lds, g, S, E, nullptr, a.wv);
    });

    constexpr int NSCAN = BATCH * NH * 2;
    PHASE(2, {
        for (int u = blockIdx.x; u < 2048; u += G) {
            if (u < 1024) { for (int r2 = 0; r2 < 1 + ((P2_REP >> 1) & 1); ++r2) conv_unit(a, lds, u); }
            else { for (int r2 = 0; r2 < 1 + ((P2_REP >> 2) & 1); ++r2) prep_unit(a, lds, u - 1024); }
        }
    });

    PHASE(3, {
        int bid = blockIdx.x; int Gp = G; asm volatile("" : "+s"(bid), "+s"(Gp));
        for (int u = bid; u < NSCAN; u += Gp) scan_chunked_unit(a, lds, u);
        if (rep_ == 0) {
            if (Gp > NSCAN) { if (bid >= NSCAN) { for (int u = bid - NSCAN; u < 64; u += Gp - NSCAN) for (int r2 = 0; r2 < 1 + (P2_REP & 1); ++r2) attn_unit(a, lds, u);
                                                 } }
            else { for (int u = bid; u < 64; u += Gp) attn_unit(a, lds, u); }
        }
    });

    PHASE(4, phase_post(a, G));

    PHASE(5, {
        pg8::Gemm g{(const bf16_t*)(ws + WS_MIX), (const bf16_t*)(ws + WS_WOUTT), T, D, D, 0, 0}; pg8::StaticOrder S; S.init(T, D, G, (int)blockIdx.x);
        pg8::EpiResidSS E{a.in[I_X], (float*)(ws + WS_X1), (float*)(ws + WS_SS)}; pg8::gemm_phase<pg8::EpiResidSS, pg8::StaticOrder, false>(lds, g, S, E, nullptr, a.wv);
    });

    PHASE(6, phase_router(a, lds, G));

    PHASE(7, { for (int u = blockIdx.x; u < BATCH * NE; u += G) topk_unit(a, lds, u); });

    PHASE(8, {
        pg8::Gemm g{(const bf16_t*)(ws + WS_H2), (const bf16_t*)(ws + WS_WGUT), NSLOT, 2048, D / 2, 0x7A7A7A7A, 0x7F7F7F7F};     pg8::ExpertOrder S; S.init(32, 8, NE, G, (int)blockIdx.x);
        pg8::EpiSwiGLU E{(bf16_t*)(ws + WS_HID)}; pg8::gemm_phase<pg8::EpiSwiGLU, pg8::ExpertOrder, true, false, true>(lds, g, S, E, (const int*)(ws + WS_ROWTOK), a.wv);
    });

    PHASE(9, {
        pg8::Gemm g{(const bf16_t*)(ws + WS_HID), (const bf16_t*)(ws + WS_WDT), NSLOT, D, FF / 2, 0x7A7A7A7A, 0x7C7C7C7C};     pg8::ExpertOrder S; S.init(32, 4, NE, G, (int)blockIdx.x);
        pg8::EpiGateScale E{(bf16_t*)(ws + WS_YE), (const float*)(ws + WS_ROWGATE)}; pg8::gemm_phase<pg8::EpiGateScale, pg8::ExpertOrder, false, true, true>(lds, g, S, E, nullptr, a.wv);
#if P9_REP
        __syncthreads(); pg8::gemm_phase<pg8::EpiGateScale, pg8::ExpertOrder, false, true, true>(lds, g, S, E, nullptr, a.wv);
#endif
    });

    PHASE(10, phase_final(a, G));
#undef IN
#undef NREP
#undef PHASE
}

#ifndef MK_ONE_LAUNCH
#define MK_ONE_LAUNCH 1
#endif
extern "C" void kernel_launch(void* const* d_in, const int* in_sizes, int n_in, void* d_out, int out_size, void* d_ws, size_t ws_size, hipStream_t stream) {
    static int grid_blocks = 0;
    if (grid_blocks == 0) {
        if (n_in != 29 || out_size != T * D || ws_size < WS_END) { fprintf(stderr, "kernel_launch: unexpected problem: n_in %d out %d ws %zu (need %zu)\n", n_in, out_size, ws_size, (size_t)WS_END); grid_blocks = -1; return; }
        int dev = 0, cus = 0, per_cu = 0;
        if (hipGetDevice(&dev) != hipSuccess || hipDeviceGetAttribute(&cus, hipDeviceAttributeMultiprocessorCount, dev) != hipSuccess) { grid_blocks = -1; return; }
        if (hipFuncSetAttribute((const void*)mega, hipFuncAttributeMaxDynamicSharedMemorySize, LDS_BYTES) != hipSuccess) { fprintf(stderr, "kernel_launch: hipFuncSetAttribute failed\n"); grid_blocks = -1; return; }
        if (hipOccupancyMaxActiveBlocksPerMultiprocessor(&per_cu, (const void*)mega, NTHREADS, LDS_BYTES) != hipSuccess || per_cu < 1) { fprintf(stderr, "kernel_launch: occupancy query says %d blocks per CU\n", per_cu); grid_blocks = -1; return; }
        grid_blocks = cus;
    }
    if (grid_blocks < 0) return;
    if (hipMemsetAsync((char*)d_ws + WS_CTL, 0, CTL_BYTES, stream) != hipSuccess) { fprintf(stderr, "kernel_launch: memset failed\n"); return; }
    Args a{};
    for (int i = 0; i < 29; ++i) a.in[i] = (const float*)d_in[i];
    a.out = (float*)d_out; a.ws = (unsigned char*)d_ws;
#if MK_ONE_LAUNCH
    a.ph_lo = 0; a.ph_hi = NPHASE;
    { void* args[] = {&a}; hipError_t e = hipLaunchCooperativeKernel((const void*)mega, dim3(grid_blocks), dim3(NTHREADS), args, LDS_BYTES, stream);
      if (e != hipSuccess) fprintf(stderr, "cooperative launch failed: %s (grid %d)\n", hipGetErrorString(e), grid_blocks); }
#else
    for (int ph = 0; ph < NPHASE; ++ph) { a.ph_lo = ph; a.ph_hi = ph + 1; void* args[] = {&a};
        hipError_t e = hipLaunchCooperativeKernel((const void*)mega, dim3(grid_blocks), dim3(NTHREADS), args, LDS_BYTES, stream);
        if (e != hipSuccess) { fprintf(stderr, "cooperative launch %d failed: %s (grid %d)\n", ph, hipGetErrorString(e), grid_blocks); break; } }
#endif
}
```

```cpp
#include <hip/hip_runtime.h>
#include <hip/hip_cooperative_groups.h>
#include <cstdio>
#include <cstdint>
namespace cg = cooperative_groups;

#define LAS __attribute__((address_space(3)))
typedef unsigned short bf16_t;
typedef short bf16x8 __attribute__((ext_vector_type(8)));
typedef short s16x4 __attribute__((ext_vector_type(4)));
typedef float f32x2 __attribute__((ext_vector_type(2)));
typedef float f32x4 __attribute__((ext_vector_type(4)));
typedef float f32x16 __attribute__((ext_vector_type(16)));
typedef unsigned u32x2 __attribute__((ext_vector_type(2)));
typedef unsigned u32x4 __attribute__((ext_vector_type(4)));
typedef _Float16 f16x4 __attribute__((ext_vector_type(4)));
typedef __bf16 bf16v2 __attribute__((ext_vector_type(2)));
typedef int v8i __attribute__((ext_vector_type(8)));
typedef int v4i __attribute__((ext_vector_type(4)));

constexpr int D = 1024, BATCH = 16, SEQ = 4096, T = BATCH * SEQ, NMEM = 256;
constexpr int IN_PROJ = 2560, CW = 384, RW = 384, NH = 6, NE = 16, FF = 1024, CAP = 512;
constexpr int NSLOT = NE * BATCH * CAP;
constexpr int NTHREADS = 512;
constexpr int LDS_BYTES = 160 * 1024;
constexpr int NPHASE = 11;
#ifndef SCAN_MODE
#define SCAN_MODE 1
#endif

constexpr size_t MiB = 1u << 20;
constexpr size_t WS_WINT = 1 * MiB;
constexpr size_t WS_WOUTT = 6 * MiB;
constexpr size_t WS_WKT = 8 * MiB;
constexpr size_t WS_WVT = 8 * MiB + 512 * 1024;
constexpr size_t WS_SMALL = 9 * MiB;
constexpr size_t WS_WGUT = 10 * MiB;
constexpr size_t WS_WDT = 74 * MiB;
constexpr size_t WS_KMEM = 106 * MiB;
constexpr size_t WS_VT = 108 * MiB;
constexpr size_t WS_ROWTOK = 106 * MiB;
constexpr size_t WS_ROWGATE = 106 * MiB + 512 * 1024;
constexpr size_t WS_SS = 107 * MiB;
constexpr size_t WS_P = 112 * MiB;
constexpr size_t WS_YF = 112 * MiB;
constexpr size_t WS_YB = 208 * MiB;
constexpr size_t WS_X1 = 112 * MiB;
constexpr size_t WS_XH = 432 * MiB;
constexpr size_t WS_G = 432 * MiB;
constexpr size_t WS_BON = 480 * MiB;
constexpr size_t WS_Q = 400 * MiB;
constexpr int PLD = IN_PROJ - 256;
constexpr size_t WS_H2 = 432 * MiB;
constexpr size_t WS_MEMN = 560 * MiB;
constexpr size_t WS_MIX = 560 * MiB;
constexpr size_t WS_SCAN = 688 * MiB;
constexpr size_t SCAN_STRIDE = 48 * MiB;
constexpr size_t WS_SCAN7 = 496 * MiB;
constexpr size_t WS_PC = 484 * MiB;
__device__ __forceinline__ unsigned char* scan_arr(unsigned char* ws, int a) { return a < 7 ? ws + WS_SCAN + (size_t)a * SCAN_STRIDE : (a == 7 ? ws + WS_SCAN7 : ws + 560 * MiB + 640 * 2); }
__device__ __forceinline__ int scan_pitch(int a) { return a == 8 ? D : 384; }
__device__ __forceinline__ size_t hat_off(int a, size_t tok, int ch) { return a == 8 ? tok * D + ch : ((((tok >> 4) * NH + (ch >> 6)) << 10) + ((tok & 15) << 6) + (ch & 63)); }
constexpr size_t WS_AFF = 624 * MiB;
constexpr size_t WS_INV = 628 * MiB;
constexpr size_t WS_HID = 768 * MiB;
constexpr size_t WS_YE = 368 * MiB;
constexpr size_t WS_END = 1024 * MiB;

__device__ __forceinline__ unsigned pk_bf16(float lo, float hi) { f32x2 v = {lo, hi}; bf16v2 b = __builtin_convertvector(v, bf16v2); return __builtin_bit_cast(unsigned, b); }
__device__ __forceinline__ unsigned pk_fp8x4(float a, float b, float c, float d) { int w = 0; w = __builtin_amdgcn_cvt_pk_fp8_f32(a, b, w, false); w = __builtin_amdgcn_cvt_pk_fp8_f32(c, d, w, true); return (unsigned)w; }
__device__ __forceinline__ float bf_lo(unsigned u) { return __builtin_bit_cast(float, u << 16); }
__device__ __forceinline__ float bf_hi(unsigned u) { return __builtin_bit_cast(float, u & 0xffff0000u); }
__device__ __forceinline__ float wave_sum(float v) {
#pragma unroll
    for (int o = 1; o < 64; o <<= 1) v += __shfl_xor(v, o);
    return v;
}
__device__ __forceinline__ float sigmoidf_fast(float x) { return __builtin_amdgcn_rcpf(1.0f + __builtin_amdgcn_exp2f(-1.4426950408889634f * x)); }
template <int CTRL> __device__ __forceinline__ float dpp_f(float x) { return __builtin_bit_cast(float, __builtin_amdgcn_update_dpp(0, __builtin_bit_cast(int, x), CTRL, 0xF, 0xF, true)); }
__device__ __forceinline__ float sum8(float x) { x += dpp_f<0xB1>(x); x += dpp_f<0x4E>(x); x += dpp_f<0x141>(x); return x; }
__device__ __forceinline__ float sum16(float x) { x = sum8(x); x += dpp_f<0x140>(x); return x; }
__device__ __forceinline__ float max16(float x) { x = fmaxf(x, dpp_f<0xB1>(x)); x = fmaxf(x, dpp_f<0x4E>(x)); x = fmaxf(x, dpp_f<0x141>(x)); x = fmaxf(x, dpp_f<0x140>(x)); return x; }

typedef short v4i16g __attribute__((__vector_size__(8)));
__device__ __forceinline__ s16x4 tr_read16(LAS unsigned char* p) { v4i16g r = __builtin_amdgcn_ds_read_tr16_b64_v4i16((LAS v4i16g*)p); return __builtin_bit_cast(s16x4, r); }
__device__ __forceinline__ f32x4 bf4_to_f32(u32x2 w) { return (f32x4){bf_lo(w.x), bf_hi(w.x), bf_lo(w.y), bf_hi(w.y)}; }
__device__ __forceinline__ u32x2 f32_to_bf4(f32x4 v) { return (u32x2){pk_bf16(v.x, v.y), pk_bf16(v.z, v.w)}; }
__device__ __forceinline__ bf16x8 frag_lo4(f32x4 v) { const u32x4 w = {pk_bf16(v.x, v.y), pk_bf16(v.z, v.w), 0u, 0u}; return __builtin_bit_cast(bf16x8, w); }
__device__ __forceinline__ bf16x8 frag_cat(u32x2 a, u32x2 b) { const u32x4 w = {a.x, a.y, b.x, b.y}; return __builtin_bit_cast(bf16x8, w); }
#define MFMA16(a, b, c) __builtin_amdgcn_mfma_f32_16x16x32_bf16((a), (b), (c), 0, 0, 0)

__device__ __forceinline__ int tid_of(int wv) { int l; asm volatile("v_mbcnt_lo_u32_b32 %0, -1, 0\n\tv_mbcnt_hi_u32_b32 %0, -1, %0" : "=v"(l)); return (wv << 6) | l; }
namespace pg8 {
#define PG8_LAS __attribute__((address_space(3)))
constexpr int BM = 256, BK = 64, HALF = 128, HTB = HALF * BK * 2, STAGE_BYTES = 8 * HTB, NXCD = 8, WGM = 8;
__host__ __device__ __forceinline__ int lds_byte(int r, int c) { const int st = (r >> 4) * 2 + (c >> 5), rr = r & 15, cc = c & 31, ob = rr * 64 + cc * 2; return st * 1024 + (ob ^ (((ob >> 9) & 1) << 5)); }
__host__ __device__ __forceinline__ void stage_rc(int b, int& R, int& C) { const int st = b / 1024, sb = b % 1024, swz = sb ^ (((sb >> 9) & 1) << 5); R = (st >> 1) * 16 + swz / 64; C = (st & 1) * 32 + (swz % 64) / 2; }
__host__ __device__ __forceinline__ int perm32(int rho) { const int n = rho >> 4, i = rho & 15; return 8 * (i >> 2) + 4 * n + (i & 3); }

struct Unit { int pm, pn, gid; };
struct Gemm { const bf16_t* A; const bf16_t* Bt; int M, N, K; int sw, sx; };

struct StaticOrder {
    int nM, nN, nwg, G, c;
    __device__ void init(int M, int N, int G_, int c_) { nM = M / BM; nN = N / BM; nwg = nM * nN; G = G_; c = c_; }
    __device__ bool next(int i, Unit& u) const {
        const long L = (long)i * G + c; if (L >= nwg) return false;
        int wgid = (int)L; { const int q = nwg / NXCD, r = nwg % NXCD, xcd = wgid % NXCD, off = wgid / NXCD; wgid = (xcd < r ? xcd * (q + 1) : r * (q + 1) + (xcd - r) * q) + off; }
        const int nig = WGM * nN, gid = wgid / nig, fm = gid * WGM, gsz = (nM - fm) < WGM ? (nM - fm) : WGM;
        u.pm = fm + ((wgid % nig) % gsz); u.pn = (wgid % nig) / gsz; u.gid = 0; return true;
    }
    __device__ __forceinline__ const char* aptr(const Gemm& g, const Unit& u, size_t tstep) const { return (const char*)g.A + (size_t)u.pm * tstep; }
    __device__ __forceinline__ const char* bptr(const Gemm& g, const Unit& u, size_t tstep) const { return (const char*)g.Bt + (size_t)u.pn * tstep; }
};
struct TripleOrder {
    StaticOrder S0; const bf16_t* A1; const bf16_t* B1; const bf16_t* A2; const bf16_t* B2; int n1, n2, G, c;
    __device__ bool next(int i, Unit& u) const {
        const long L = (long)i * G + c;
        if (L < n1) { u.pm = (int)L; u.pn = 0; u.gid = 1; return true; }
        if (L < n1 + n2) { u.pm = 0; u.pn = (int)(L - n1); u.gid = 2; return true; }
        const long L0 = L - n1 - n2; if (L0 >= S0.nwg) return false;
        StaticOrder T0 = S0; T0.c = (int)(L0 % G); return T0.next((int)(L0 / G), u);
    }
    __device__ __forceinline__ const char* aptr(const Gemm& g, const Unit& u, size_t tstep) const { return (const char*)(u.gid == 0 ? g.A : (u.gid == 1 ? A1 : A2)) + (size_t)u.pm * tstep; }
    __device__ __forceinline__ const char* bptr(const Gemm& g, const Unit& u, size_t tstep) const { return (const char*)(u.gid == 0 ? g.Bt : (u.gid == 1 ? B1 : B2)) + (size_t)u.pn * tstep; }
};
struct ExpertOrder {
    int nMe, nNe, per, total, G, c;
    __device__ void init(int nMe_, int nNe_, int nExp, int G_, int c_) { nMe = nMe_; nNe = nNe_; per = nMe * nNe; total = per * nExp; G = G_; c = c_; }
    __device__ bool next(int i, Unit& u) const {
        const long L = (long)i * G + c; if (L >= total) return false;
        const int e = (int)(L / per), w = (int)(L % per), xl = w % 8, j = w / 8, rpx = nMe / 8;
        u.pm = e * nMe + xl * rpx + (j % rpx); u.pn = e * nNe + j / rpx; u.gid = 0; return true;
    }
    __device__ __forceinline__ const char* aptr(const Gemm& g, const Unit& u, size_t tstep) const { return (const char*)g.A + (size_t)u.pm * tstep; }
    __device__ __forceinline__ const char* bptr(const Gemm& g, const Unit& u, size_t tstep) const { return (const char*)g.Bt + (size_t)u.pn * tstep; }
};

struct EpiBf16 {
    static constexpr bool PERM = true;
    bf16_t* O; int ldc; bf16_t* Q0;
    __device__ __forceinline__ void operator()(const f32x4 (&acc)[2][2][4][2], const Unit& u, int wr, int wc, int fr, int fq) const {
        const bool redir = (Q0 != nullptr) && (u.pn == 0);
        bf16_t* base = redir ? Q0 : O; const int ld = redir ? 256 : ldc;
        const int row0 = u.pm * BM + wr * 64 + fr, col0 = (u.pn - ((Q0 != nullptr && !redir) ? 1 : 0)) * BM + wc * 32 + 8 * fq;
#pragma unroll
        for (int ai = 0; ai < 2; ++ai)
#pragma unroll
            for (int m = 0; m < 4; ++m) { bf16_t* rowp = base + (size_t)(row0 + ai * HALF + m * 16) * ld + col0;
#pragma unroll
                for (int bj = 0; bj < 2; ++bj) { const f32x4 v0 = acc[ai][bj][m][0], v1 = acc[ai][bj][m][1];
                    u32x4 w; w.x = pk_bf16(v0[0], v0[1]); w.y = pk_bf16(v0[2], v0[3]); w.z = pk_bf16(v1[0], v1[1]); w.w = pk_bf16(v1[2], v1[3]);
                    *(u32x4*)(rowp + bj * HALF) = w; } }
    }
};
struct EpiBf16x3 {
    static constexpr bool PERM = true;
    EpiBf16 E0, E1, E2;
    __device__ __forceinline__ void operator()(const f32x4 (&acc)[2][2][4][2], const Unit& u, int wr, int wc, int fr, int fq) const {
        if (u.gid == 0) E0(acc, u, wr, wc, fr, fq); else if (u.gid == 1) E1(acc, u, wr, wc, fr, fq); else E2(acc, u, wr, wc, fr, fq); }
};
struct EpiResidSS {
    static constexpr bool PERM = false;
    const float* X; bf16_t* X1; float* ss;
    __device__ __forceinline__ void operator()(const f32x4 (&acc)[2][2][4][2], const Unit& u, int wr, int wc, int fr, int fq) const {
        const int row0 = u.pm * BM + wr * 64 + fr, col0 = u.pn * BM + wc * 32 + 4 * fq;
#pragma unroll
        for (int ai = 0; ai < 2; ++ai)
#pragma unroll
            for (int m = 0; m < 4; ++m) { const int row = row0 + ai * HALF + m * 16; const size_t off = (size_t)row * D + col0; float s = 0.f;
#pragma unroll
                for (int bj = 0; bj < 2; ++bj)
#pragma unroll
                    for (int n = 0; n < 2; ++n) { const f32x4 xv = *(const f32x4*)(X + off + bj * HALF + n * 16); const f32x4 o = xv + acc[ai][bj][m][n];
                        *(u32x2*)(X1 + off + bj * HALF + n * 16) = f32_to_bf4(o); s += (o[0] * o[0] + o[1] * o[1]) + (o[2] * o[2] + o[3] * o[3]); }
                s += __shfl_xor(s, 16); s += __shfl_xor(s, 32);
                if (fq == 0) (void)__hip_atomic_fetch_add(ss + row, s, __ATOMIC_RELAXED, __HIP_MEMORY_SCOPE_AGENT); }
    }
};
struct EpiSwiGLU {
    static constexpr bool PERM = true;
    bf16_t* H;
    __device__ __forceinline__ void operator()(const f32x4 (&acc)[2][2][4][2], const Unit& u, int wr, int wc, int fr, int fq) const {
        const int row0 = u.pm * BM + wr * 64 + fr, col0 = (u.pn & 7) * HALF + wc * 32 + 8 * fq;
#pragma unroll
        for (int ai = 0; ai < 2; ++ai)
#pragma unroll
            for (int m = 0; m < 4; ++m) { const int row = row0 + ai * HALF + m * 16; float h[8];
                unsigned char* rowp = (unsigned char*)H + ((((size_t)(row >> 8) * (FF / 128) + (col0 >> 7)) << 15) + ((row & 255) << 7) + (col0 & 127));
#pragma unroll
                for (int n = 0; n < 2; ++n)
#pragma unroll
                    for (int j = 0; j < 4; ++j) { const float gt = acc[ai][0][m][n][j], up = acc[ai][1][m][n][j]; h[n * 4 + j] = 8.0f * gt * sigmoidf_fast(gt) * up; }
                *(u32x2*)rowp = (u32x2){pk_fp8x4(h[0], h[1], h[2], h[3]), pk_fp8x4(h[4], h[5], h[6], h[7])}; }
    }
};
struct EpiGateScale {
    static constexpr bool PERM = true;
    bf16_t* Y; const float* gate;
    __device__ __forceinline__ void operator()(const f32x4 (&acc)[2][2][4][2], const Unit& u, int wr, int wc, int fr, int fq) const {
        const int row0 = u.pm * BM + wr * 64 + fr, col0 = (u.pn & 3) * BM + wc * 32 + 8 * fq;
#pragma unroll
        for (int ai = 0; ai < 2; ++ai)
#pragma unroll
            for (int m = 0; m < 4; ++m) { const int row = row0 + ai * HALF + m * 16; const float gs = gate[row]; bf16_t* rowp = Y + (size_t)row * D + col0;
#pragma unroll
                for (int bj = 0; bj < 2; ++bj) { const f32x4 v0 = acc[ai][bj][m][0] * gs, v1 = acc[ai][bj][m][1] * gs;
                    u32x4 w; w.x = pk_bf16(v0[0], v0[1]); w.y = pk_bf16(v0[2], v0[3]); w.z = pk_bf16(v1[0], v1[1]); w.w = pk_bf16(v1[2], v1[3]);
                    *(u32x4*)(rowp + bj * HALF) = w; } }
    }
};

template <class Epi, class Sched, bool GATHER, bool ATILED = false, bool FP8 = false>
__device__ __forceinline__ void gemm_phase(PG8_LAS unsigned char* lds, const Gemm g, const Sched& S, const Epi& E, const int* rowtok, const int wv) {
    int tid = tid_of(wv); asm volatile("" : "+v"(tid));
    const int wid = __builtin_amdgcn_readfirstlane(tid >> 6), lane = tid & 63, wr = wid >> 2, wc = wid & 3, fr = lane & 15, fq = lane >> 4;
    const int K = g.K, nt = K / BK;
    unsigned voffA0, voffB0;
    { int R, C; stage_rc(tid * 16, R, C); const int Rb = Epi::PERM ? ((R & ~31) + perm32(R & 31)) : R;
      voffA0 = ATILED ? (unsigned)(R * BK + C) * 2u : (unsigned)(R * K + C) * 2u; voffB0 = (unsigned)(Rb * K + C) * 2u; }
    const size_t dA = ATILED ? (size_t)64 * BK * 2 : (size_t)64 * K * 2, dB = (size_t)64 * K * 2;
    unsigned vAc[2][2], vAn[2][2];
    const size_t kstep = (size_t)(BK * 2);
    const size_t hstep = (size_t)HALF * K * 2;
    const size_t tstep = 2 * hstep;
    const size_t kstepA = ATILED ? (size_t)BM * BK * 2 : kstep, hstepA = ATILED ? (size_t)HALF * BK * 2 : hstep;
    const unsigned ldsw = (unsigned)wid * 1024u;
    const unsigned ldsbase = __builtin_amdgcn_readfirstlane((unsigned)(size_t)lds) + ldsw;
    const int aoff = lds_byte(wr * 64 + fr, fq * 8), boff = lds_byte(wc * 32 + fr, fq * 8);
#define PG8_SA(b, h) (((b) * 2 + (h)) * HTB)
#define PG8_SB(b, h) ((4 + (b) * 2 + (h)) * HTB)
#define PG8_GLDS(vo_, sb_, lo_) asm volatile("s_add_u32 m0, %2, %3\n\ts_nop 0\n\tglobal_load_lds_dwordx4 %0, %1" :: "v"(vo_), "s"((const void*)(sb_)), "s"(ldsbase), "n"(lo_) : "m0", "scc", "memory")
#define PG8_STAGE_D(bufoff, gbase, voff0, delta) do { PG8_GLDS(voff0, gbase, (bufoff)); PG8_GLDS(voff0, (const char*)(gbase) + (delta), (bufoff) + 8192); } while (0)
#define PG8_STAGE(bufoff, gbase, voff) do { PG8_GLDS((voff)[0], gbase, (bufoff)); PG8_GLDS((voff)[1], gbase, (bufoff) + 8192); } while (0)
#define PG8_STAGE_A(bufoff, hh, dbase, kbytes, vsel) do { if constexpr (GATHER) { PG8_STAGE(bufoff, (const char*)g.A + (kbytes), (vsel)[hh]); } else { PG8_STAGE_D(bufoff, (dbase) + ((hh) ? hstepA : 0), voffA0, dA); } } while (0)
#define PG8_GATHER_OFF(dst, un) do { int R_, C_; stage_rc(tid * 16, R_, C_); _Pragma("unroll") for (int _h = 0; _h < 2; ++_h) _Pragma("unroll") for (int _i = 0; _i < 2; ++_i) \
        (dst)[_h][_i] = (unsigned)rowtok[(un).pm * BM + _h * HALF + R_ + 64 * _i] * (unsigned)(K * 2) + (unsigned)(C_ * 2); } while (0)
#define PG8_LDA(dst, b, h) do { _Pragma("unroll") for (int m = 0; m < 4; ++m) _Pragma("unroll") for (int k = 0; k < 2; ++k) dst[m][k] = *(const PG8_LAS bf16x8*)(lds + PG8_SA(b, h) + aoff + m * 2048 + k * 1024); } while (0)
#define PG8_LDB(dst, b, h) do { _Pragma("unroll") for (int n = 0; n < 2; ++n) _Pragma("unroll") for (int k = 0; k < 2; ++k) dst[n][k] = *(const PG8_LAS bf16x8*)(lds + PG8_SB(b, h) + boff + n * 2048 + k * 1024); } while (0)
#define PG8_MMA(ai, bj, At, Bt) do { __builtin_amdgcn_s_setprio(1); _Pragma("unroll") for (int m = 0; m < 4; ++m) _Pragma("unroll") for (int n = 0; n < 2; ++n) _Pragma("unroll") for (int k = 0; k < 2; ++k) \
        acc[ai][bj][m][n] = __builtin_amdgcn_mfma_f32_16x16x32_bf16(Bt[n][k], At[m][k], acc[ai][bj][m][n], 0, 0, 0); __builtin_amdgcn_s_setprio(0); } while (0)
#define PG8_CAT8(lo_, hi_) __builtin_shufflevector(lo_, hi_, 0, 1, 2, 3, 4, 5, 6, 7)
#define PG8_LDA8(b, h) do { _Pragma("unroll") for (int m = 0; m < 4; ++m) { const v4i lo_ = *(const PG8_LAS v4i*)(lds + PG8_SA(b, h) + aoff + m * 2048), hi_ = *(const PG8_LAS v4i*)(lds + PG8_SA(b, h) + aoff + m * 2048 + 1024); A8[m] = PG8_CAT8(lo_, hi_); } } while (0)
#define PG8_LDB8(dst, b, h) do { _Pragma("unroll") for (int n = 0; n < 2; ++n) { const v4i lo_ = *(const PG8_LAS v4i*)(lds + PG8_SB(b, h) + boff + n * 2048), hi_ = *(const PG8_LAS v4i*)(lds + PG8_SB(b, h) + boff + n * 2048 + 1024); dst[n] = PG8_CAT8(lo_, hi_); } } while (0)
#define PG8_MMA8(ai, bj, Bt8) do { __builtin_amdgcn_s_setprio(1); _Pragma("unroll") for (int m = 0; m < 4; ++m) _Pragma("unroll") for (int n = 0; n < 2; ++n) \
        acc[ai][bj][m][n] = __builtin_amdgcn_mfma_scale_f32_16x16x128_f8f6f4(Bt8[n], A8[m], acc[ai][bj][m][n], 0, 0, 0, g.sw, 0, g.sx); __builtin_amdgcn_s_setprio(0); } while (0)
#define PG8_LDAX(b, h) do { if constexpr (FP8) { PG8_LDA8(b, h); } else { PG8_LDA(At, b, h); } } while (0)
#define PG8_LDBX(w, b, h) do { if constexpr (FP8) { if (w) { PG8_LDB8(B81, b, h); } else { PG8_LDB8(B80, b, h); } } else { if (w) { PG8_LDB(B1, b, h); } else { PG8_LDB(B0, b, h); } } } while (0)
#define PG8_MMX(ai, bj, w) do { if constexpr (FP8) { if (w) { PG8_MMA8(ai, bj, B81); } else { PG8_MMA8(ai, bj, B80); } } else { if (w) { PG8_MMA(ai, bj, At, B1); } else { PG8_MMA(ai, bj, At, B0); } } } while (0)
#define PG8_WAIT_V(n) asm volatile("s_waitcnt vmcnt(" #n ")" ::: "memory")
#define PG8_WAIT_L(n) asm volatile("s_waitcnt lgkmcnt(" #n ")" ::: "memory")
#define PG8_BAR __builtin_amdgcn_s_barrier()
#define PG8_SCHED __builtin_amdgcn_sched_barrier(0)
    Unit cur, nxt; int ui = 0;
    if (!S.next(0, cur)) return;
    f32x4 acc[2][2][4][2];
#pragma unroll
    for (int a = 0; a < 2; ++a)
#pragma unroll
        for (int b = 0; b < 2; ++b)
#pragma unroll
            for (int m = 0; m < 4; ++m)
#pragma unroll
                for (int n = 0; n < 2; ++n) acc[a][b][m][n] = (f32x4){0.f, 0.f, 0.f, 0.f};
    bf16x8 At[4][2], B0[2][2], B1[2][2]; v8i A8[4], B80[2], B81[2];
    const char* cA = GATHER ? (const char*)g.A : S.aptr(g, cur, tstep); const char* cB = S.bptr(g, cur, tstep);
    if constexpr (GATHER) { PG8_GATHER_OFF(vAc, cur); }
    PG8_STAGE_D(PG8_SB(0, 0), cB, voffB0, dB); PG8_STAGE_A(PG8_SA(0, 0), 0, cA, 0, vAc); PG8_STAGE_D(PG8_SB(0, 1), cB + hstep, voffB0, dB); PG8_STAGE_A(PG8_SA(0, 1), 1, cA, 0, vAc);
    if (wr == 1) PG8_BAR;
    PG8_WAIT_V(4); PG8_BAR;
    PG8_STAGE_D(PG8_SB(1, 0), cB + kstep, voffB0, dB); PG8_STAGE_A(PG8_SA(1, 0), 0, cA + kstepA, kstep, vAc); PG8_STAGE_D(PG8_SB(1, 1), cB + hstep + kstep, voffB0, dB);
    PG8_WAIT_V(6); PG8_BAR;
    for (;;) {
        const bool has_next = S.next(ui + 1, nxt);
        const char* nA = (has_next && !GATHER) ? S.aptr(g, nxt, tstep) : cA; const char* nB = has_next ? S.bptr(g, nxt, tstep) : cB;
        if constexpr (GATHER) { if (has_next) { PG8_GATHER_OFF(vAn, nxt); } else {
#pragma unroll
            for (int _h = 0; _h < 2; ++_h)
#pragma unroll
                for (int _i = 0; _i < 2; ++_i) vAn[_h][_i] = vAc[_h][_i]; } }
#pragma unroll 1
        for (int t = 0; t < nt; t += 2) {
            const bool last = (t == nt - 2);
            const size_t k1 = (size_t)(t + 1) * kstep, k2 = last ? 0 : (size_t)(t + 2) * kstep, k3 = k2 + kstep;
            const char* a1 = cA + (size_t)(t + 1) * kstepA;
            const char* a2 = last ? nA : cA + (size_t)(t + 2) * kstepA; const char* b2 = last ? nB : cB + (size_t)(t + 2) * kstep;
            const char* a3 = a2 + kstepA; const char* b3 = b2 + kstep;
            PG8_LDBX(0, 0, 0); PG8_SCHED; PG8_LDAX(0, 0); PG8_STAGE_A(PG8_SA(1, 1), 1, a1, k1, vAc);
            if constexpr (GATHER) { if (last) {
#pragma unroll
                for (int _h = 0; _h < 2; ++_h)
#pragma unroll
                    for (int _i = 0; _i < 2; ++_i) vAc[_h][_i] = vAn[_h][_i]; } }
            PG8_WAIT_L(8); PG8_BAR; PG8_WAIT_L(0); PG8_MMX(0, 0, 0); PG8_BAR; PG8_SCHED;
            PG8_LDBX(1, 0, 1); PG8_STAGE_D(PG8_SB(0, 0), b2, voffB0, dB);
            PG8_BAR; PG8_WAIT_L(0); PG8_MMX(0, 1, 1); PG8_BAR;
            PG8_LDAX(0, 1); PG8_STAGE_A(PG8_SA(0, 0), 0, a2, k2, vAc);
            PG8_BAR; PG8_WAIT_L(0); PG8_MMX(1, 0, 0); PG8_BAR; PG8_SCHED;
            PG8_STAGE_D(PG8_SB(0, 1), b2 + hstep, voffB0, dB);
            PG8_WAIT_V(6); PG8_BAR; PG8_MMX(1, 1, 1); PG8_BAR;
            PG8_LDBX(0, 1, 0); PG8_SCHED; PG8_LDAX(1, 0); PG8_STAGE_A(PG8_SA(0, 1), 1, a2, k2, vAc);
            PG8_WAIT_L(8); PG8_BAR; PG8_WAIT_L(0); PG8_MMX(0, 0, 0); PG8_BAR; PG8_SCHED;
            PG8_LDBX(1, 1, 1); PG8_STAGE_D(PG8_SB(1, 0), b3, voffB0, dB);
            PG8_BAR; PG8_WAIT_L(0); PG8_MMX(0, 1, 1); PG8_BAR;
            PG8_LDAX(1, 1); PG8_STAGE_A(PG8_SA(1, 0), 0, a3, k3, vAc);
            PG8_BAR; PG8_WAIT_L(0); PG8_MMX(1, 0, 0); PG8_BAR; PG8_SCHED;
            PG8_STAGE_D(PG8_SB(1, 1), b3 + hstep, voffB0, dB);
            PG8_WAIT_V(6); PG8_BAR; PG8_MMX(1, 1, 1); PG8_BAR;
        }
        E(acc, cur, wr, wc, fr, fq);
        if (!has_next) break;
#pragma unroll
        for (int a = 0; a < 2; ++a)
#pragma unroll
            for (int b = 0; b < 2; ++b)
#pragma unroll
                for (int m = 0; m < 4; ++m)
#pragma unroll
                    for (int n = 0; n < 2; ++n) acc[a][b][m][n] = (f32x4){0.f, 0.f, 0.f, 0.f};
        cur = nxt; cA = nA; cB = nB; ++ui;
        if constexpr (GATHER) {
#pragma unroll
            for (int _h = 0; _h < 2; ++_h)
#pragma unroll
                for (int _i = 0; _i < 2; ++_i) vAc[_h][_i] = vAn[_h][_i]; }
    }
    PG8_WAIT_V(0);
    if (wr == 0) PG8_BAR;
    PG8_BAR;
#undef PG8_SA
#undef PG8_SB
#undef PG8_STAGE
#undef PG8_STAGE_D
#undef PG8_GLDS
#undef PG8_STAGE_A
#undef PG8_GATHER_OFF
#undef PG8_LDA
#undef PG8_LDB
#undef PG8_MMA
#undef PG8_MMA8
#undef PG8_LDA8
#undef PG8_LDB8
#undef PG8_LDAX
#undef PG8_LDBX
#undef PG8_MMX
#undef PG8_CAT8
#undef PG8_WAIT_V
#undef PG8_WAIT_L
#undef PG8_BAR
#undef PG8_SCHED
}
}

struct Args {
    const float* in[29];
    float* out; unsigned char* ws;
    int ph_lo, ph_hi;
    int wv, zero_;
};
enum { I_X = 0, I_MEM, I_NMIXG, I_NMEMG, I_WIN, I_WMK, I_WMV, I_CONVW, I_CONVB, I_CLNG, I_CLNB, I_SHIFTMU, I_DW0, I_DUP, I_IA0, I_IUP, I_GUP, I_KK, I_KA, I_RK,
       I_LNXG, I_LNXB, I_WOUT, I_NFFNG, I_WROUTER, I_WEG, I_WEU, I_WED, I_FNG };

template <bool F8 = false>
__device__ __forceinline__ void transpose_item(const float* W, int N, bf16_t* WT, int K, int k0, int n0, int drow0, LAS float* scr, int lane) {
    {
        f32x4 v[8];
#pragma unroll
        for (int i = 0; i < 8; ++i) v[i] = *(const f32x4*)(W + (size_t)(k0 + 8 * i + (lane >> 3)) * N + n0 + 4 * (lane & 7));
#pragma unroll
        for (int i = 0; i < 8; ++i) { LAS float* d = scr + (8 * i + (lane >> 3)) * 33 + 4 * (lane & 7); d[0] = v[i].x; d[1] = v[i].y; d[2] = v[i].z; d[3] = v[i].w; }
    }
    asm volatile("s_waitcnt lgkmcnt(0)" ::: "memory");
    const int c = lane & 7;
#pragma unroll
    for (int j = 0; j < 4; ++j) { const int n = (lane >> 3) + 8 * j; const LAS float* s = scr + (8 * c) * 33 + n;
        if constexpr (F8) { *(u32x2*)((unsigned char*)WT + (size_t)(drow0 + n) * K + k0 + 8 * c) = (u32x2){pk_fp8x4(32.f * s[0 * 33], 32.f * s[1 * 33], 32.f * s[2 * 33], 32.f * s[3 * 33]), pk_fp8x4(32.f * s[4 * 33], 32.f * s[5 * 33], 32.f * s[6 * 33], 32.f * s[7 * 33])}; }
        else { u32x4 o; o.x = pk_bf16(s[0 * 33], s[1 * 33]); o.y = pk_bf16(s[2 * 33], s[3 * 33]); o.z = pk_bf16(s[4 * 33], s[5 * 33]); o.w = pk_bf16(s[6 * 33], s[7 * 33]);
            *(u32x4*)(WT + (size_t)(drow0 + n) * K + k0 + 8 * c) = o; } }
    asm volatile("s_waitcnt lgkmcnt(0)" ::: "memory");
}
__device__ __forceinline__ void expert_prep_items(const Args& a, LAS unsigned char* lds, int widx, int nw, int it_lo, int it_hi) {
    int tid = tid_of(a.wv); asm volatile("" : "+v"(tid)); const int lane = tid & 63, wave = __builtin_amdgcn_readfirstlane(tid >> 6);
    LAS float* scr = (LAS float*)(lds + wave * 16384);
    unsigned char* ws = a.ws;
    constexpr int S_EXP = 16 * 16 * 32;
    for (int r = it_lo + widx; r < it_hi; r += nw) {
        const int which = r / S_EXP, q = r % S_EXP, e = q / 512, kb = (q % 512) / 32, nb = q % 32, n0 = nb * 32;
        if (which == 0) transpose_item<true>(a.in[I_WEG] + (size_t)e * D * FF, FF, (bf16_t*)(ws + WS_WGUT + (size_t)e * 2048 * D), D, kb * 64, n0, (n0 >> 7) * 256 + (n0 & 127), scr, lane);
        else if (which == 1) transpose_item<true>(a.in[I_WEU] + (size_t)e * D * FF, FF, (bf16_t*)(ws + WS_WGUT + (size_t)e * 2048 * D), D, kb * 64, n0, (n0 >> 7) * 256 + 128 + (n0 & 127), scr, lane);
        else transpose_item<true>(a.in[I_WED] + (size_t)e * FF * D, D, (bf16_t*)(ws + WS_WDT + (size_t)e * D * FF), FF, kb * 64, n0, n0, scr, lane);
    }
}

__device__ __forceinline__ void rms_row_to_bf16(const float* xrow, const float* g, bf16_t* orow, int lane) {
    const f32x4* xr = (const f32x4*)xrow + lane; const f32x4* gr = (const f32x4*)g + lane;
    f32x4 v[4]; float s = 0.f;
#pragma unroll
    for (int j = 0; j < 4; ++j) { v[j] = xr[64 * j]; s += (v[j].x * v[j].x + v[j].y * v[j].y) + (v[j].z * v[j].z + v[j].w * v[j].w); }
    const float rs = 1.0f / sqrtf(wave_sum(s) * (1.f / D) + 1e-6f);
    u32x2* o8 = (u32x2*)orow + lane;
#pragma unroll
    for (int j = 0; j < 4; ++j) { const f32x4 gg = gr[64 * j]; u32x2 w; w.x = pk_bf16(v[j].x * rs * gg.x, v[j].y * rs * gg.y); w.y = pk_bf16(v[j].z * rs * gg.z, v[j].w * rs * gg.w); o8[64 * j] = w; }
}
__device__ __forceinline__ void phase_prep(const Args& a, LAS unsigned char* lds, int G) {
    int tid = tid_of(a.wv); asm volatile("" : "+v"(tid)); const int lane = tid & 63, wave = __builtin_amdgcn_readfirstlane(tid >> 6);
    LAS float* scr = (LAS float*)(lds + wave * 16384);
    const int gw = blockIdx.x * 8 + wave, NGW = G * 8;
    unsigned char* ws = a.ws;
    constexpr int S_WIN = 16 * 80, S_WOUT = 16 * 32, S_MK = 16 * 8, S_SM = 12, S_GUP = 24;
    constexpr int NITEMS = S_WIN + S_WOUT + 2 * S_MK + 4 * S_SM + S_GUP;
    for (int it = gw; it < NITEMS; it += NGW) {
        int r = it;
        if (r < S_WIN) { const int kb = r / 80, nb = r % 80; transpose_item(a.in[I_WIN], IN_PROJ, (bf16_t*)(ws + WS_WINT), D, kb * 64, nb * 32, nb * 32, scr, lane); continue; } r -= S_WIN;
        if (r < S_WOUT) { const int kb = r / 32, nb = r % 32; transpose_item(a.in[I_WOUT], D, (bf16_t*)(ws + WS_WOUTT), D, kb * 64, nb * 32, nb * 32, scr, lane); continue; } r -= S_WOUT;
        if (r < S_MK) { const int kb = r / 8, nb = r % 8; transpose_item(a.in[I_WMK], 256, (bf16_t*)(ws + WS_WKT), D, kb * 64, nb * 32, nb * 32, scr, lane); continue; } r -= S_MK;
        if (r < S_MK) { const int kb = r / 8, nb = r % 8; transpose_item(a.in[I_WMV], 256, (bf16_t*)(ws + WS_WVT), D, kb * 64, nb * 32, nb * 32, scr, lane); continue; } r -= S_MK;
        if (r < 4 * S_SM) { const int which = r / S_SM, nb = r % S_SM;
            const float* src = (which < 2 ? a.in[I_DUP] : a.in[I_IUP]) + (size_t)(which & 1) * 64 * RW;
            transpose_item(src, RW, (bf16_t*)(ws + WS_SMALL) + (size_t)which * RW * 64, 64, 0, nb * 32, nb * 32, scr, lane); continue; } r -= 4 * S_SM;
        { const int kb = r / 12, nb = r % 12; transpose_item(a.in[I_GUP], RW, (bf16_t*)(ws + WS_SMALL) + (size_t)4 * RW * 64, 128, kb * 64, nb * 32, nb * 32, scr, lane); }
    }
    expert_prep_items(a, lds, gw, NGW, 0, 3 * 8192);
    for (int m = gw; m < T; m += NGW) rms_row_to_bf16(a.in[I_X] + (size_t)m * D, a.in[I_NMIXG], (bf16_t*)(ws + WS_XH) + (size_t)m * D, lane);
    for (int m = gw; m < BATCH * NMEM; m += NGW) rms_row_to_bf16(a.in[I_MEM] + (size_t)m * D, a.in[I_NMEMG], (bf16_t*)(ws + WS_MEMN) + (size_t)m * D, lane);
}

constexpr int AT_KS = 144;
constexpr int AT_VS = 520;
constexpr int AT_VOFF = 256 * AT_KS;
__device__ __forceinline__ bf16x8 pack_step(const f32x16& x, int s) {
    u32x4 p;
    asm volatile("v_cvt_pk_bf16_f32 %0, %4, %5\n\tv_cvt_pk_bf16_f32 %1, %6, %7\n\tv_cvt_pk_bf16_f32 %2, %8, %9\n\tv_cvt_pk_bf16_f32 %3, %10, %11\n\ts_nop 1"
                 : "=&v"(p[0]), "=&v"(p[1]), "=&v"(p[2]), "=&v"(p[3])
                 : "v"(x[8 * s]), "v"(x[8 * s + 1]), "v"(x[8 * s + 2]), "v"(x[8 * s + 3]), "v"(x[8 * s + 4]), "v"(x[8 * s + 5]), "v"(x[8 * s + 6]), "v"(x[8 * s + 7]));
    return __builtin_bit_cast(bf16x8, p);
}
__device__ __forceinline__ void attn_unit(const Args& a, LAS unsigned char* lds, int unit) {
    int tid = tid_of(a.wv); asm volatile("" : "+v"(tid)); const int lane = tid & 63, wave = __builtin_amdgcn_readfirstlane(tid >> 6), r = lane & 31, h = lane >> 5;
    const int b = unit >> 2, hh = unit & 3;
    const bf16_t* Qb = (const bf16_t*)(a.ws + WS_Q); const bf16_t* KM = (const bf16_t*)(a.ws + WS_KMEM); const bf16_t* VT = (const bf16_t*)(a.ws + WS_VT);
    bf16_t* MIX = (bf16_t*)(a.ws + WS_MIX);
    __syncthreads();
#pragma unroll
    for (int i = 0; i < 4; ++i) { const int c = tid + 512 * i, key = c >> 3, ch = c & 7;
        const u32x4 v = *(const u32x4*)(KM + (size_t)(b * NMEM + key) * 256 + hh * 64 + ch * 8);
        *(LAS u32x4*)(lds + key * AT_KS + ch * 16) = v; }
#pragma unroll
    for (int i = 0; i < 4; ++i) { const int c = tid + 512 * i, d = c >> 5, ch = c & 31;
        const u32x4 v = *(const u32x4*)(VT + (size_t)(hh * 64 + d) * (BATCH * NMEM) + b * NMEM + ch * 8);
        LAS u32x2* dst = (LAS u32x2*)(lds + AT_VOFF + d * AT_VS + ch * 16);
        dst[0] = (u32x2){v.x, v.y}; dst[1] = (u32x2){v.z, v.w}; }
    __syncthreads();
#pragma unroll 1
    for (int tile = 0; tile < 16; ++tile) {
    const int tok0 = b * SEQ + tile * 256 + wave * 32;
    bf16x8 qf[4];
#pragma unroll
    for (int ks = 0; ks < 4; ++ks) qf[ks] = *(const bf16x8*)(Qb + (size_t)(tok0 + r) * 256 + hh * 64 + ks * 16 + h * 8);
    const float sc = 0.125f * 1.4426950408889634f;
    float m_run = -3.0e38f, sum = 0.f;
    f32x16 o[2];
#pragma unroll
    for (int dt = 0; dt < 2; ++dt)
#pragma unroll
        for (int i = 0; i < 16; ++i) o[dt][i] = 0.f;
#pragma unroll 1
    for (int kh = 0; kh < 2; ++kh) {
        f32x16 s[4];
#pragma unroll
        for (int k4 = 0; k4 < 4; ++k4) {
#pragma unroll
            for (int i = 0; i < 16; ++i) s[k4][i] = 0.f;
#pragma unroll
            for (int ks = 0; ks < 4; ++ks) { const bf16x8 ka = *(const LAS bf16x8*)(lds + ((kh * 4 + k4) * 32 + r) * AT_KS + (ks * 16 + h * 8) * 2);
                s[k4] = __builtin_amdgcn_mfma_f32_32x32x16_bf16(ka, qf[ks], s[k4], 0, 0, 0); }
        }
        float mx = m_run;
#pragma unroll
        for (int k4 = 0; k4 < 4; ++k4)
#pragma unroll
            for (int i = 0; i < 16; ++i) mx = fmaxf(mx, s[k4][i]);
        mx = fmaxf(mx, __shfl_xor(mx, 32));
        const float alpha = __builtin_amdgcn_exp2f((m_run - mx) * sc);
        float ps = 0.f;
#pragma unroll
        for (int k4 = 0; k4 < 4; ++k4)
#pragma unroll
            for (int i = 0; i < 16; ++i) { const float e = __builtin_amdgcn_exp2f((s[k4][i] - mx) * sc); s[k4][i] = e; ps += e; }
        ps += __shfl_xor(ps, 32);
        sum = sum * alpha + ps; m_run = mx;
#pragma unroll
        for (int dt = 0; dt < 2; ++dt)
#pragma unroll
            for (int i = 0; i < 16; ++i) o[dt][i] *= alpha;
#pragma unroll
        for (int k4 = 0; k4 < 4; ++k4)
#pragma unroll
            for (int s2 = 0; s2 < 2; ++s2) {
                const bf16x8 pb = pack_step(s[k4], s2);
#pragma unroll
                for (int dt = 0; dt < 2; ++dt) {
                    const LAS unsigned char* vp = lds + AT_VOFF + (32 * dt + r) * AT_VS + (32 * (kh * 4 + k4) + 16 * s2 + 4 * h) * 2;
                    const s16x4 lo = *(const LAS s16x4*)vp, hi = *(const LAS s16x4*)(vp + 16);
                    const bf16x8 va = __builtin_shufflevector(lo, hi, 0, 1, 2, 3, 4, 5, 6, 7);
                    o[dt] = __builtin_amdgcn_mfma_f32_32x32x16_bf16(va, pb, o[dt], 0, 0, 0);
                }
            }
    }
    const float inv = 1.0f / sum;
    bf16_t* orow = MIX + (size_t)(tok0 + r) * D + hh * 64;
#pragma unroll
    for (int dt = 0; dt < 2; ++dt)
#pragma unroll
        for (int gq = 0; gq < 4; ++gq) { u32x2 w; w.x = pk_bf16(o[dt][4 * gq] * inv, o[dt][4 * gq + 1] * inv); w.y = pk_bf16(o[dt][4 * gq + 2] * inv, o[dt][4 * gq + 3] * inv);
            *(u32x2*)(orow + 32 * dt + 8 * gq + 4 * h) = w; }
    }
}

__device__ __forceinline__ void conv_unit(const Args& a, LAS unsigned char* lds, int unit) {
    int tid = tid_of(a.wv); asm volatile("" : "+v"(tid)); const int lane = tid & 63, wave = __builtin_amdgcn_readfirstlane(tid >> 6);
    const int b = unit >> 6, t0 = (unit & 63) * 64;
    const bf16_t* P = (const bf16_t*)(a.ws + WS_P); bf16_t* MIX = (bf16_t*)(a.ws + WS_MIX);
    LAS _Float16* U = (LAS _Float16*)lds;
    LAS _Float16* Cc = (LAS _Float16*)(lds + 94 * CW * 2);
    __syncthreads();
#pragma unroll 1
    for (int q0 = tid; q0 < 94 * 48; q0 += 3 * NTHREADS) {
        u32x4 vvv[3], ggg[3];
#pragma unroll
        for (int u3 = 0; u3 < 3; ++u3) { const int q = q0 + u3 * NTHREADS, j = q / 48, cc = (q % 48) * 8, s = t0 - 15 + j; const bool ok = (q < 94 * 48) && s >= 0 && s < SEQ;
            const bf16_t* row = P + (size_t)(b * SEQ + (ok ? s : 0)) * PLD + cc;
            vvv[u3] = ok ? *(const u32x4*)row : (u32x4){0u, 0u, 0u, 0u}; ggg[u3] = ok ? *(const u32x4*)(row + CW) : (u32x4){0u, 0u, 0u, 0u}; }
#pragma unroll
        for (int u3 = 0; u3 < 3; ++u3) { const int q = q0 + u3 * NTHREADS, j = q / 48, cc = (q % 48) * 8;
            if (q < 94 * 48) {
                const unsigned vw[4] = {vvv[u3].x, vvv[u3].y, vvv[u3].z, vvv[u3].w}, gw[4] = {ggg[u3].x, ggg[u3].y, ggg[u3].z, ggg[u3].w};
                float u[8];
#pragma unroll
                for (int k = 0; k < 4; ++k) { u[2 * k] = bf_lo(vw[k]) * sigmoidf_fast(bf_lo(gw[k])); u[2 * k + 1] = bf_hi(vw[k]) * sigmoidf_fast(bf_hi(gw[k])); }
                LAS f16x4* dst = (LAS f16x4*)(U + j * CW + cc); dst[0] = (f16x4){(_Float16)u[0], (_Float16)u[1], (_Float16)u[2], (_Float16)u[3]}; dst[1] = (f16x4){(_Float16)u[4], (_Float16)u[5], (_Float16)u[6], (_Float16)u[7]}; }
        }
    }
    __syncthreads();
    const int cq = tid & 127, tq = tid >> 7;
#pragma unroll 1
    for (int k3 = 0; k3 < 3; ++k3) { const int c = cq + 128 * k3;
        float w[31], res[16];
#pragma unroll
        for (int kk = 0; kk < 31; ++kk) w[kk] = a.in[I_CONVW][kk * CW + c];
        const float bias = a.in[I_CONVB][c];
#pragma unroll
        for (int tt = 0; tt < 16; ++tt) res[tt] = bias;
#pragma unroll
        for (int jj = 0; jj < 46; ++jj) { const float uv = (float)U[(tq * 16 + jj) * CW + c];
#pragma unroll
            for (int tt = 0; tt < 16; ++tt) { if (jj - tt >= 0 && jj - tt <= 30) res[tt] += uv * w[jj - tt]; } }
#pragma unroll
        for (int tt = 0; tt < 16; ++tt) Cc[(tq * 16 + tt) * CW + c] = (_Float16)res[tt];
    }
    __syncthreads();
    for (int tt = 0; tt < 8; ++tt) { const int t = wave * 8 + tt;
        float v[6]; float s = 0.f;
#pragma unroll
        for (int i = 0; i < 6; ++i) { v[i] = (float)Cc[t * CW + lane + 64 * i]; s += v[i]; }
        const float mean = wave_sum(s) * (1.f / CW); float q = 0.f;
#pragma unroll
        for (int i = 0; i < 6; ++i) { v[i] -= mean; q += v[i] * v[i]; }
        const float rstd = 1.0f / sqrtf(wave_sum(q) * (1.f / CW) + 1e-5f);
        bf16_t* orow = MIX + (size_t)(b * SEQ + t0 + t) * D + 256;
#pragma unroll
        for (int i = 0; i < 6; ++i) { const int c = lane + 64 * i; const float y = v[i] * rstd * a.in[I_CLNG][c] + a.in[I_CLNB][c]; const float o = y * sigmoidf_fast(y);
            orow[c] = (bf16_t)(pk_bf16(o, 0.f) & 0xffffu); }
    }
}

constexpr int PR_AS = 784;
constexpr int PR_RK = 64 * PR_AS;
constexpr int PR_RKS = 1536;
constexpr int PR_RN = PR_RK + 64 * PR_RKS;
constexpr int PR_CST = PR_RN + 2048;
static_assert(PR_CST + 7 * 384 * 4 <= LDS_BYTES - 64, "prep LDS map");
template <int V> struct IC { static constexpr int value = V; };
template <int CTRL> __device__ __forceinline__ f32x4 dpp4(f32x4 x) { return (f32x4){dpp_f<CTRL>(x.x), dpp_f<CTRL>(x.y), dpp_f<CTRL>(x.z), dpp_f<CTRL>(x.w)}; }
__device__ __forceinline__ void prep_unit(const Args& a, LAS unsigned char* lds, int unit) {
    int tid = tid_of(a.wv); asm volatile("" : "+v"(tid)); const int lane = tid & 63, wave = __builtin_amdgcn_readfirstlane(tid >> 6);
    const int b = unit >> 6, t0 = (unit & 63) * 64;
    const bf16_t* __restrict__ P = (const bf16_t*)(a.ws + WS_P);
    const float* __restrict__ mu = a.in[I_SHIFTMU];
    LAS float* RNs = (LAS float*)(lds + PR_RN); LAS float* CST = (LAS float*)(lds + PR_CST);
    __syncthreads();
    for (int i = tid; i < 7 * 384; i += NTHREADS) { const int w7 = i / 384, c7 = i % 384;
        CST[i] = (w7 == 0) ? a.in[I_KK][c7] : (w7 == 1) ? a.in[I_KA][c7] : (w7 == 2) ? a.in[I_RK][c7] : (w7 < 5) ? a.in[I_DW0][(w7 - 3) * RW + c7] : a.in[I_IA0][(w7 - 5) * RW + c7]; }
#ifndef PREP_REP1
#define PREP_REP1 1
#endif
#ifndef PREP_REP2
#define PREP_REP2 1
#endif
#pragma unroll 1
    for (int rp1 = 0; rp1 < PREP_REP1; ++rp1)
#pragma unroll 1
    for (int q0 = tid; q0 < 64 * 192; q0 += 4 * NTHREADS) {
        u32x4 cuv[4], pvv[4], nvv[4];
#pragma unroll
        for (int u4 = 0; u4 < 4; ++u4) { const int q = q0 + u4 * NTHREADS, tt = q / 192, c8 = (q % 192) * 8, s = t0 + tt;
            const bf16_t* row = P + ((size_t)b * SEQ + s) * PLD + 768 + c8;
            cuv[u4] = *(const u32x4*)row;
            pvv[u4] = (s > 0) ? *(const u32x4*)(row - PLD) : (u32x4){0u, 0u, 0u, 0u};
            nvv[u4] = (s < SEQ - 1) ? *(const u32x4*)(row + PLD) : (u32x4){0u, 0u, 0u, 0u}; }
#pragma unroll
        for (int u4 = 0; u4 < 4; ++u4) { const int q = q0 + u4 * NTHREADS, tt = q / 192, c8 = (q % 192) * 8, s = t0 + tt; const size_t tok = (size_t)b * SEQ + s;
            const u32x4 cu = cuv[u4], pv = pvv[u4], nv = nvv[u4];
            const unsigned cw[4] = {cu.x, cu.y, cu.z, cu.w}, pw[4] = {pv.x, pv.y, pv.z, pv.w}, nw[4] = {nv.x, nv.y, nv.z, nv.w};
            const f32x4 m0a = *(const f32x4*)(mu + c8), m0b = *(const f32x4*)(mu + c8 + 4), m1a = *(const f32x4*)(mu + 1536 + c8), m1b = *(const f32x4*)(mu + 1536 + c8 + 4);
            const float m0[8] = {m0a.x, m0a.y, m0a.z, m0a.w, m0b.x, m0b.y, m0b.z, m0b.w}, m1[8] = {m1a.x, m1a.y, m1a.z, m1a.w, m1b.x, m1b.y, m1b.z, m1b.w};
            float pf[8];
#pragma unroll
            for (int k = 0; k < 4; ++k) { const float c0 = bf_lo(cw[k]), c1 = bf_hi(cw[k]);
                pf[2 * k] = c0 + m0[2 * k] * (bf_lo(pw[k]) - c0) + m1[2 * k] * (bf_lo(nw[k]) - c0);
                pf[2 * k + 1] = c1 + m0[2 * k + 1] * (bf_hi(pw[k]) - c1) + m1[2 * k + 1] * (bf_hi(nw[k]) - c1); }
            if (c8 < 768) {
                f16x4 h0 = {(_Float16)pf[0], (_Float16)pf[1], (_Float16)pf[2], (_Float16)pf[3]}, h1 = {(_Float16)pf[4], (_Float16)pf[5], (_Float16)pf[6], (_Float16)pf[7]};
                LAS f16x4* dst = (LAS f16x4*)(lds + PR_RK + tt * PR_RKS + c8 * 2); dst[0] = h0; dst[1] = h1;
                if (c8 >= 384) { const f32x4 ka = *(const f32x4*)(a.in[I_KK] + c8 - 384), kb = *(const f32x4*)(a.in[I_KK] + c8 - 384 + 4);
                    float ssq = (pf[0] * ka.x) * (pf[0] * ka.x) + (pf[1] * ka.y) * (pf[1] * ka.y) + (pf[2] * ka.z) * (pf[2] * ka.z) + (pf[3] * ka.w) * (pf[3] * ka.w)
                              + (pf[4] * kb.x) * (pf[4] * kb.x) + (pf[5] * kb.y) * (pf[5] * kb.y) + (pf[6] * kb.z) * (pf[6] * kb.z) + (pf[7] * kb.w) * (pf[7] * kb.w);
                    ssq = sum8(ssq);
                    if ((lane & 7) == 0) RNs[tt * 8 + ((c8 - 384) >> 6)] = __builtin_amdgcn_rsqf(ssq + 1e-12f); }
            } else if (c8 < 1152) {
                u32x4 w; w.x = pk_bf16(pf[0], pf[1]); w.y = pk_bf16(pf[2], pf[3]); w.z = pk_bf16(pf[4], pf[5]); w.w = pk_bf16(pf[6], pf[7]);
                *(u32x4*)((bf16_t*)scan_arr(a.ws, 0) + hat_off(0, tok, c8 - 768)) = w;
            } else {
                const int cc = c8 - 1152;
#pragma unroll
                for (int k = 0; k < 8; ++k) { if (cc < 128) pf[k] = 1.0f - 2.0f * __builtin_amdgcn_rcpf(1.0f + __builtin_amdgcn_exp2f(2.8853900817779268f * pf[k])); else if (cc >= 256) pf[k] = sigmoidf_fast(pf[k]); }
                u32x4 w; w.x = pk_bf16(pf[0], pf[1]); w.y = pk_bf16(pf[2], pf[3]); w.z = pk_bf16(pf[4], pf[5]); w.w = pk_bf16(pf[6], pf[7]);
                *(LAS u32x4*)(lds + tt * PR_AS + cc * 2) = w; }
        }
    }
    __syncthreads();
    const int l15 = lane & 15, kq = lane >> 4;
    float* __restrict__ PCg = (float*)(a.ws + WS_PC); float* __restrict__ BON = (float*)(a.ws + WS_BON);
    const char* SMb = (const char*)(a.ws + WS_SMALL);
    const unsigned wlo64 = (unsigned)(((8 * (l15 >> 2) + (l15 & 3)) * 64 + kq * 8) * 2), wlo128 = (unsigned)(((8 * (l15 >> 2) + (l15 & 3)) * 128 + kq * 8) * 2);
    const unsigned hlo = (unsigned)((l15 * 64 + 8 * kq) * 2), klo = (unsigned)((l15 * D + 8 * kq) * 2), glo = (unsigned)((l15 * RW + 8 * kq) * 2);
    bf16x8 Fc[16], Fn[16];
#define PREP_LOADW(hd_, kind_) do { \
        if ((kind_) < 2) { const char* w_ = SMb + ((size_t)(kind_) * RW * 64 + (size_t)(hd_) * 64 * 64) * 2; \
            _Pragma("unroll") for (int f_ = 0; f_ < 16; ++f_) Fn[f_] = *(const bf16x8*)(w_ + (size_t)(((f_ >> 2) & 1) * (2 * RW * 64 * 2) + (32 * ((f_ & 3) >> 1) + 4 * (f_ & 1)) * 128 + (f_ >> 3) * 64) + wlo64); } \
        else { const char* w_ = SMb + ((size_t)4 * RW * 64 + (size_t)(hd_) * 64 * 128) * 2; \
            _Pragma("unroll") for (int f_ = 0; f_ < 16; ++f_) Fn[f_] = *(const bf16x8*)(w_ + (size_t)((32 * ((f_ & 3) >> 1) + 4 * (f_ & 1)) * 256 + (f_ >> 2) * 64) + wlo128); } } while (0)
    auto dir_stage = [&](auto dc, const int it, const int nhd, const int nkind) {
        constexpr int d = decltype(dc)::value;
        const int hd = it >> 2, mt = it & 3, tokl = mt * 16 + l15; const size_t tb = (size_t)b * SEQ + t0 + mt * 16;
#pragma unroll
        for (int f = 0; f < 16; ++f) Fc[f] = Fn[f];
        f32x4 accW[4], accA[4];
#pragma unroll
        for (int nt = 0; nt < 4; ++nt) { accW[nt] = (f32x4){0.f, 0.f, 0.f, 0.f}; accA[nt] = (f32x4){0.f, 0.f, 0.f, 0.f}; }
#pragma unroll
        for (int ks = 0; ks < 2; ++ks) {
            const bf16x8 aw = *(const LAS bf16x8*)(lds + tokl * PR_AS + (d * 64 + ks * 32 + kq * 8) * 2), aa = *(const LAS bf16x8*)(lds + tokl * PR_AS + ((2 + d) * 64 + ks * 32 + kq * 8) * 2);
#pragma unroll
            for (int nt = 0; nt < 4; ++nt) { accW[nt] = MFMA16(Fc[ks * 8 + nt], aw, accW[nt]); accA[nt] = MFMA16(Fc[ks * 8 + 4 + nt], aa, accA[nt]); }
        }
        if (nkind >= 0) PREP_LOADW(nhd, nkind);
        const float rn = RNs[tokl * 8 + hd];
        const size_t tile_b = ((((tb >> 4) * NH + hd) << 10)) * 2;
        char* AHb = (char*)scan_arr(a.ws, 1 + 4 * d) + tile_b; char* RHb = (char*)scan_arr(a.ws, 2 + 4 * d) + tile_b; char* BHb = (char*)scan_arr(a.ws, 3 + 4 * d) + tile_b;
        char* KHb = d ? (char*)scan_arr(a.ws, 8) + (tb * D + hd * 64) * 2 : (char*)scan_arr(a.ws, 4) + tile_b; const unsigned khlo = d ? klo : hlo;
        char* PCb = (char*)(PCg + ((size_t)d * (T / 16) + (tb >> 4)) * RW + hd * 64); char* BOb = (char*)(BON + (size_t)d * T * NH + tb * NH + hd);
        float bsum = 0.f;
        u32x2 hA[2], hR[2], hB[2], hK[2]; f32x4 PtS[4];
#pragma unroll
        for (int nt = 0; nt < 4; ++nt) { const int ch = hd * 64 + 32 * (nt >> 1) + 8 * kq + 4 * (nt & 1);
            const f32x4 bW = *(const LAS f32x4*)(CST + (3 + d) * 384 + ch), bA = *(const LAS f32x4*)(CST + (5 + d) * 384 + ch);
            const f32x4 kkw = *(const LAS f32x4*)(CST + ch), kaw = *(const LAS f32x4*)(CST + 384 + ch), rkw = *(const LAS f32x4*)(CST + 768 + ch);
            const f32x4 zw = accW[nt] + bW, za = accA[nt] + bA;
            f32x4 lw, av;
#pragma unroll
            for (int e = 0; e < 4; ++e) { lw[e] = -0.606531f * 1.4426950408889634f * sigmoidf_fast(zw[e]); av[e] = sigmoidf_fast(za[e]); }
            f32x4 cum = lw;
            if (d == 0) { cum += dpp4<0x111>(cum); cum += dpp4<0x112>(cum); cum += dpp4<0x114>(cum); cum += dpp4<0x118>(cum); }
            else        { cum += dpp4<0x101>(cum); cum += dpp4<0x102>(cum); cum += dpp4<0x104>(cum); cum += dpp4<0x108>(cum); }
            f32x4 Pt, Pinv, Pprev;
#pragma unroll
            for (int e = 0; e < 4; ++e) { Pt[e] = __builtin_amdgcn_exp2f(cum[e]); Pinv[e] = __builtin_amdgcn_rcpf(Pt[e]);
                Pprev[e] = __builtin_amdgcn_exp2f(cum[e] - lw[e]); }
            PtS[nt] = Pt;
            const f32x4 r4 = __builtin_convertvector(*(const LAS f16x4*)(lds + PR_RK + tokl * PR_RKS + ch * 2), f32x4);
            const f32x4 k4 = __builtin_convertvector(*(const LAS f16x4*)(lds + PR_RK + tokl * PR_RKS + (384 + ch) * 2), f32x4);
            const f32x4 kk = k4 * kkw * rn, kd = k4 * (1.0f + (av - 1.0f) * kaw);
            hA[nt & 1] = f32_to_bf4(-kk * Pprev); hR[nt & 1] = f32_to_bf4(r4 * Pt); hB[nt & 1] = f32_to_bf4(kk * av * Pinv); hK[nt & 1] = f32_to_bf4(kd * Pinv);
            const f32x4 bt = r4 * kd * rkw; bsum += (bt.x + bt.y) + (bt.z + bt.w);
            if (nt & 1) { const int pr = nt >> 1;
                *(u32x4*)(AHb + (hlo + 64 * pr)) = (u32x4){hA[0].x, hA[0].y, hA[1].x, hA[1].y}; *(u32x4*)(RHb + (hlo + 64 * pr)) = (u32x4){hR[0].x, hR[0].y, hR[1].x, hR[1].y};
                *(u32x4*)(BHb + (hlo + 64 * pr)) = (u32x4){hB[0].x, hB[0].y, hB[1].x, hB[1].y}; *(u32x4*)(KHb + (khlo + 64 * pr)) = (u32x4){hK[0].x, hK[0].y, hK[1].x, hK[1].y}; }
        }
        if (l15 == (d ? 0 : 15)) {
#pragma unroll
            for (int nt = 0; nt < 4; ++nt) *(f32x4*)(PCb + (unsigned)(8 * kq * 4) + (32 * (nt >> 1) + 4 * (nt & 1)) * 4) = PtS[nt]; }
        bsum += __shfl_xor(bsum, 16); bsum += __shfl_xor(bsum, 32);
        if (kq == 0) *(float*)(BOb + (unsigned)(l15 * NH * 4)) = bsum;
    };
    auto gate_stage = [&](const int it, const int nhd, const int nkind) {
        const int hd = it >> 2, mt = it & 3, tokl = mt * 16 + l15; const size_t tb = (size_t)b * SEQ + t0 + mt * 16;
#pragma unroll
        for (int f = 0; f < 16; ++f) Fc[f] = Fn[f];
        f32x4 acc[4];
#pragma unroll
        for (int nt = 0; nt < 4; ++nt) acc[nt] = (f32x4){0.f, 0.f, 0.f, 0.f};
#pragma unroll
        for (int ks = 0; ks < 4; ++ks) { const bf16x8 afr = *(const LAS bf16x8*)(lds + tokl * PR_AS + (256 + ks * 32 + kq * 8) * 2);
#pragma unroll
            for (int nt = 0; nt < 4; ++nt) acc[nt] = MFMA16(Fc[ks * 4 + nt], afr, acc[nt]); }
        if (nkind >= 0) PREP_LOADW(nhd, nkind);
        char* Gb = (char*)((bf16_t*)(a.ws + WS_G) + tb * RW + hd * 64);
#pragma unroll
        for (int pr = 0; pr < 2; ++pr) { const u32x2 g0 = f32_to_bf4(acc[2 * pr]), g1 = f32_to_bf4(acc[2 * pr + 1]);
            *(u32x4*)(Gb + (glo + 64 * pr)) = (u32x4){g0.x, g0.y, g1.x, g1.y}; }
    };
    PREP_LOADW(wave >> 2, 0);
#pragma unroll 1
    for (int k3 = 0; k3 < 3; ++k3) { const int it = wave + 8 * k3, hd = it >> 2;
        dir_stage(IC<0>{}, it, hd, 1);
        dir_stage(IC<1>{}, it, hd, 2);
        gate_stage(it, (it + 8) >> 2, k3 < 2 ? 0 : -1);
    }
#undef PREP_LOADW
}

__device__ __forceinline__ void glds16_asm(const void* gptr, LAS unsigned char* ldst) {
    const unsigned la = __builtin_amdgcn_readfirstlane((unsigned)(size_t)ldst);
    asm volatile("s_mov_b32 m0, %1\n\ts_nop 0\n\tglobal_load_lds_dwordx4 %0, off" :: "v"(gptr), "s"(la) : "m0", "memory");
}
constexpr int CK = 16, NCHUNK = SEQ / CK, CS_NS = 8, CS_NPROD = 6, CS_NCONS = 2;
constexpr int SL_ATIL = 0, SL_RTIL = 2048, SL_BH = 4096, SL_KH = 6144, SL_V = 8192, SL_ULOC = 10240, SL_YLOC = 12288, SL_PC = 14336, SL_BYTES = 14592;
constexpr int PS_AH = 0, PS_RH = 2048, PS_BYTES = 4096;
constexpr int CS_PS_OFF = CS_NS * SL_BYTES, CS_FLAG_OFF = CS_PS_OFF + CS_NPROD * PS_BYTES;
static_assert(CS_FLAG_OFF + 64 <= LDS_BYTES - 64, "chunked scan LDS map");
__device__ __forceinline__ int swz(int t, int j) { return t * 128 + ((((j >> 3) ^ (t & 7))) << 4) + ((j & 4) << 1); }
__device__ __forceinline__ void scan_chunked_unit(const Args& a, LAS unsigned char* lds, int unit) {
    int tid = tid_of(a.wv); asm volatile("" : "+v"(tid)); const int lane = tid & 63, wave = __builtin_amdgcn_readfirstlane(tid >> 6);
    const int dir = unit & 1, bh = unit >> 1, b = bh / NH, hd = bh % NH;
    const int c16 = lane & 15, q = lane >> 4, qp = c16 >> 2, pp = c16 & 3;
    volatile LAS unsigned* FULL = (volatile LAS unsigned*)(lds + CS_FLAG_OFF);
    volatile LAS unsigned* DONE = FULL + 8;
    float* Yg = (float*)(a.ws + (dir ? WS_YB : WS_YF));
    __syncthreads();
    if (tid < 16) FULL[tid] = 0u;
    __syncthreads();
    if (wave >= CS_NCONS) {
        const int pw = wave - CS_NCONS;
        LAS unsigned char* ps = lds + CS_PS_OFF + pw * PS_BYTES;
        const bf16_t* ARR[5] = {(const bf16_t*)scan_arr(a.ws, 1 + 4 * dir), (const bf16_t*)scan_arr(a.ws, 2 + 4 * dir), (const bf16_t*)scan_arr(a.ws, 3 + 4 * dir), (const bf16_t*)scan_arr(a.ws, 4 + 4 * dir), (const bf16_t*)scan_arr(a.ws, 0)};
        const int AIDX[5] = {1 + 4 * dir, 2 + 4 * dir, 3 + 4 * dir, 4 + 4 * dir, 0};
        const float* PCg = (const float*)(a.ws + WS_PC) + (size_t)dir * (T / 16) * RW + hd * 64 + lane;
        u32x4 pf[10];
#define CS_ISSUE(cc) do { _Pragma("unroll") for (int ar_ = 0; ar_ < 5; ++ar_) _Pragma("unroll") for (int hf_ = 0; hf_ < 2; ++hf_) { \
            const int row_ = hf_ * 8 + (lane >> 3); const int st_ = (cc) * CK + row_; const int t_ = dir ? (SEQ - 1 - st_) : st_; \
            pf[ar_ * 2 + hf_] = *(const u32x4*)(ARR[ar_] + hat_off(AIDX[ar_], (size_t)b * SEQ + t_, hd * 64 + 8 * ((lane & 7) ^ (row_ & 7)))); } } while (0)
#define CS_PCLOAD(cc) PCg[(size_t)((size_t)b * (SEQ / CK) + (dir ? (NCHUNK - 1 - (cc)) : (cc))) * RW]
        CS_ISSUE(pw);
        float pcn = CS_PCLOAD(pw);
#pragma unroll 1
        for (int c = pw; c < NCHUNK; c += CS_NPROD) {
            const int slot = c % CS_NS; LAS unsigned char* sl = lds + slot * SL_BYTES;
            { unsigned sp = 0; const unsigned want = (unsigned)CS_NCONS * (unsigned)(c / CS_NS); while (DONE[slot] < want) { __builtin_amdgcn_s_sleep(1); if (++sp > (1u << 22)) break; } }
            asm volatile("" ::: "memory");
            *(LAS u32x4*)(ps + PS_AH + lane * 16) = pf[0]; *(LAS u32x4*)(ps + PS_AH + 1024 + lane * 16) = pf[1];
            *(LAS u32x4*)(ps + PS_RH + lane * 16) = pf[2]; *(LAS u32x4*)(ps + PS_RH + 1024 + lane * 16) = pf[3];
            *(LAS u32x4*)(sl + SL_BH + lane * 16) = pf[4]; *(LAS u32x4*)(sl + SL_BH + 1024 + lane * 16) = pf[5];
            *(LAS u32x4*)(sl + SL_KH + lane * 16) = pf[6]; *(LAS u32x4*)(sl + SL_KH + 1024 + lane * 16) = pf[7];
            *(LAS u32x4*)(sl + SL_V + lane * 16) = pf[8]; *(LAS u32x4*)(sl + SL_V + 1024 + lane * 16) = pf[9];
            *(LAS float*)(sl + SL_PC + lane * 4) = pcn;
            if (c + CS_NPROD < NCHUNK) { CS_ISSUE(c + CS_NPROD); pcn = CS_PCLOAD(c + CS_NPROD); }
            asm volatile("s_waitcnt lgkmcnt(0)" ::: "memory");
#ifndef PROD_REP
#define PROD_REP 1
#endif
#pragma unroll 1
            for (int rpp = 0; rpp < PROD_REP; ++rpp) {
            bf16x8 AHf[2], BHf[2], KHf[2], RHf[2];
#pragma unroll
            for (int ks = 0; ks < 2; ++ks) { const int o = swz(c16, 32 * ks + 8 * q);
                AHf[ks] = *(const LAS bf16x8*)(ps + PS_AH + o); RHf[ks] = *(const LAS bf16x8*)(ps + PS_RH + o); BHf[ks] = *(const LAS bf16x8*)(sl + SL_BH + o); KHf[ks] = *(const LAS bf16x8*)(sl + SL_KH + o); }
            f32x4 Mab = {0.f, 0.f, 0.f, 0.f}, Mak = Mab, MrbT = Mab, MrkT = Mab, MabT = Mab;
#pragma unroll
            for (int ks = 0; ks < 2; ++ks) { Mab = MFMA16(AHf[ks], BHf[ks], Mab); MabT = MFMA16(BHf[ks], AHf[ks], MabT); Mak = MFMA16(AHf[ks], KHf[ks], Mak); MrbT = MFMA16(BHf[ks], RHf[ks], MrbT); MrkT = MFMA16(KHf[ks], RHf[ks], MrkT); }
#pragma unroll
            for (int r = 0; r < 4; ++r) { const bool lt = c16 < 4 * q + r, gt = 4 * q + r < c16, le = 4 * q + r <= c16;
                Mab[r] = lt ? Mab[r] : 0.f; Mak[r] = lt ? Mak[r] : 0.f; MabT[r] = gt ? MabT[r] : 0.f; MrbT[r] = le ? MrbT[r] : 0.f; MrkT[r] = le ? MrkT[r] : 0.f; }
            const f32x4 z4 = {0.f, 0.f, 0.f, 0.f};
            const bf16x8 fN = frag_lo4(Mab), fNT = frag_lo4(MabT);
            const f32x4 N2 = MFMA16(fNT, fN, z4), N2T = MFMA16(fN, fNT, z4);
            f32x4 PT = MabT;
#pragma unroll
            for (int r = 0; r < 4; ++r) PT[r] += (4 * q + r == c16) ? 1.0f : 0.f;
            const bf16x8 fN2 = frag_lo4(N2), fN2T = frag_lo4(N2T);
            PT = MFMA16(fN2, frag_lo4(PT), PT);
            const f32x4 N4 = MFMA16(fN2T, fN2, z4), N4T = MFMA16(fN2, fN2T, z4);
            const bf16x8 fN4 = frag_lo4(N4), fN4T = frag_lo4(N4T);
            PT = MFMA16(fN4, frag_lo4(PT), PT);
            const f32x4 N8 = MFMA16(fN4T, fN4, z4);
            PT = MFMA16(frag_lo4(N8), frag_lo4(PT), PT);
            const bf16x8 LinvF = frag_lo4(PT);
            const bf16x8 MakF = frag_lo4(Mak), MrbTF = frag_lo4(MrbT);
            const f32x4 W1 = MFMA16(LinvF, MakF, z4);
            const f32x4 W1T = MFMA16(MakF, LinvF, z4);
            const f32x4 W2T = MFMA16(frag_lo4(W1), MrbTF, MrkT);
            f32x4 AtT[4], RtT[4];
#pragma unroll
            for (int jt = 0; jt < 4; ++jt) {
                const bf16x8 ahF = frag_cat(__builtin_bit_cast(u32x2, tr_read16(ps + PS_AH + swz(4 * q + qp, 16 * jt + 4 * pp))), (u32x2){0u, 0u});
                const f32x4 AtN = MFMA16(LinvF, ahF, z4);
                AtT[jt] = MFMA16(ahF, LinvF, z4);
                const f32x4 rinit = bf4_to_f32(*(const LAS u32x2*)(ps + PS_RH + swz(c16, 16 * jt + 4 * q)));
                RtT[jt] = MFMA16(frag_lo4(AtN), MrbTF, rinit);
            }
#pragma unroll
            for (int ks = 0; ks < 2; ++ks) {
                const u32x4 wa = {pk_bf16(AtT[2 * ks][0], AtT[2 * ks][1]), pk_bf16(AtT[2 * ks][2], AtT[2 * ks][3]), pk_bf16(AtT[2 * ks + 1][0], AtT[2 * ks + 1][1]), pk_bf16(AtT[2 * ks + 1][2], AtT[2 * ks + 1][3])};
                const u32x4 wr = {pk_bf16(RtT[2 * ks][0], RtT[2 * ks][1]), pk_bf16(RtT[2 * ks][2], RtT[2 * ks][3]), pk_bf16(RtT[2 * ks + 1][0], RtT[2 * ks + 1][1]), pk_bf16(RtT[2 * ks + 1][2], RtT[2 * ks + 1][3])};
                *(LAS u32x4*)(sl + SL_ATIL + ks * 1024 + lane * 16) = wa; *(LAS u32x4*)(sl + SL_RTIL + ks * 1024 + lane * 16) = wr; }
            *(LAS u32x2*)(sl + SL_ULOC + lane * 8) = f32_to_bf4(W1T); *(LAS u32x2*)(sl + SL_YLOC + lane * 8) = f32_to_bf4(W2T);
            }
            asm volatile("s_waitcnt lgkmcnt(0)" ::: "memory");
            if (lane == 0) FULL[slot] = (unsigned)(c + 1);
        }
#undef CS_ISSUE
#undef CS_PCLOAD
    } else {
        struct ConsOps { bf16x8 at0, at1, rt0, rt1, bk[4]; u32x2 w1w, w2w, vfw[2]; f32x4 pc[4]; };
        f32x4 S[2][4];
#pragma unroll
        for (int ti = 0; ti < 2; ++ti)
#pragma unroll
            for (int mt = 0; mt < 4; ++mt) S[ti][mt] = (f32x4){0.f, 0.f, 0.f, 0.f};
#define CONS_LOAD(X, cc) do { const int slot_ = (cc) % CS_NS; LAS unsigned char* sl_ = lds + slot_ * SL_BYTES; \
            { unsigned sp_ = 0; while (FULL[slot_] < (unsigned)((cc) + 1)) { __builtin_amdgcn_s_sleep(1); if (++sp_ > (1u << 22)) break; } } \
            asm volatile("" ::: "memory"); \
            X.at0 = *(const LAS bf16x8*)(sl_ + SL_ATIL + lane * 16); X.at1 = *(const LAS bf16x8*)(sl_ + SL_ATIL + 1024 + lane * 16); \
            X.rt0 = *(const LAS bf16x8*)(sl_ + SL_RTIL + lane * 16); X.rt1 = *(const LAS bf16x8*)(sl_ + SL_RTIL + 1024 + lane * 16); \
            X.w1w = *(const LAS u32x2*)(sl_ + SL_ULOC + lane * 8); X.w2w = *(const LAS u32x2*)(sl_ + SL_YLOC + lane * 8); \
            _Pragma("unroll") for (int mt_ = 0; mt_ < 4; ++mt_) { X.pc[mt_] = *(const LAS f32x4*)(sl_ + SL_PC + (16 * mt_ + 4 * q) * 4); \
                X.bk[mt_] = frag_cat(__builtin_bit_cast(u32x2, tr_read16(sl_ + SL_BH + swz(4 * q + qp, 16 * mt_ + 4 * pp))), __builtin_bit_cast(u32x2, tr_read16(sl_ + SL_KH + swz(4 * q + qp, 16 * mt_ + 4 * pp)))); } \
            _Pragma("unroll") for (int ti_ = 0; ti_ < 2; ++ti_) X.vfw[ti_] = __builtin_bit_cast(u32x2, tr_read16(sl_ + SL_V + swz(4 * q + qp, 16 * (2 * wave + ti_) + 4 * pp))); } while (0)
#define CONS_COMPUTE(X, cc) do { const f32x4 z4c_ = {0.f, 0.f, 0.f, 0.f}; const bf16x8 w1f_ = frag_cat(X.w1w, (u32x2){0u, 0u}), w2f_ = frag_cat(X.w2w, (u32x2){0u, 0u}); \
            _Pragma("unroll") for (int ti_ = 0; ti_ < 2; ++ti_) { const int nt_ = 2 * wave + ti_; \
                const bf16x8 vB_ = frag_cat(X.vfw[ti_], (u32x2){0u, 0u}); \
                const bf16x8 Sb0_ = frag_cat(f32_to_bf4(S[ti_][0]), f32_to_bf4(S[ti_][1])), Sb1_ = frag_cat(f32_to_bf4(S[ti_][2]), f32_to_bf4(S[ti_][3])); \
                const f32x4 U0_ = MFMA16(X.at0, Sb0_, MFMA16(w1f_, vB_, z4c_)), U1_ = MFMA16(X.at1, Sb1_, z4c_); \
                const f32x4 Y0_ = MFMA16(X.rt0, Sb0_, MFMA16(w2f_, vB_, z4c_)), Y1_ = MFMA16(X.rt1, Sb1_, z4c_); \
                const f32x4 UT_ = U0_ + U1_, YT_ = Y0_ + Y1_; \
                const bf16x8 Ub_ = frag_cat(f32_to_bf4(UT_), X.vfw[ti_]); \
                _Pragma("unroll") for (int mt_ = 0; mt_ < 4; ++mt_) { S[ti_][mt_] = MFMA16(X.bk[mt_], Ub_, S[ti_][mt_]); S[ti_][mt_] = S[ti_][mt_] * X.pc[mt_]; } \
                *(f32x4*)(Yg + ((((size_t)b * NCHUNK + (dir ? (NCHUNK - 1 - (cc)) : (cc))) * NH + hd) * 64 + 16 * nt_ + c16) * 16 + 4 * q) = YT_; } } while (0)
#define CONS_DONE(cc) do { asm volatile("s_waitcnt lgkmcnt(0)" ::: "memory"); if (lane == 0) (void)__hip_atomic_fetch_add((LAS unsigned*)&DONE[(cc) % CS_NS], 1u, __ATOMIC_RELAXED, __HIP_MEMORY_SCOPE_WORKGROUP); } while (0)
        ConsOps OA, OB;
        CONS_LOAD(OA, 0);
#pragma unroll 1
        for (int c = 0; c < NCHUNK; c += 2) {
            CONS_LOAD(OB, c + 1);
            CONS_COMPUTE(OA, c);
            CONS_DONE(c);
            if (c + 2 < NCHUNK) CONS_LOAD(OA, c + 2);
            CONS_COMPUTE(OB, c + 1);
            CONS_DONE(c + 1);
        }
#undef CONS_LOAD
#undef CONS_COMPUTE
#undef CONS_DONE
        unsigned tq0 = 0u, tq1 = 0u, tq2 = 0u, tq3 = 0u, tq4 = 0u, tq5 = 0u, tacc = 0u;
        (void)tq0; (void)tq1; (void)tq2; (void)tq3; (void)tq4; (void)tq5;
        (void)tacc;
    }
}

__device__ __forceinline__ void phase_post(const Args& a, int G) {
    int tid = tid_of(a.wv); asm volatile("" : "+v"(tid)); const int lane = tid & 63, wave = __builtin_amdgcn_readfirstlane(tid >> 6);
    const int gw = blockIdx.x * 8 + wave, NGW = G * 8, t = lane & 15, iq = lane >> 4;
    const float* __restrict__ YF = (const float*)(a.ws + WS_YF); const float* __restrict__ YB = (const float*)(a.ws + WS_YB); const float* __restrict__ BON = (const float*)(a.ws + WS_BON);
    const bf16_t* __restrict__ Vg = (const bf16_t*)scan_arr(a.ws, 0); const bf16_t* __restrict__ Gg = (const bf16_t*)(a.ws + WS_G); bf16_t* __restrict__ MIX = (bf16_t*)(a.ws + WS_MIX);
    float* ss = (float*)(a.ws + WS_SS);
    for (int i = blockIdx.x * NTHREADS + tid; i < T; i += G * NTHREADS) ss[i] = 0.f;
    constexpr int NIT = (T / 16) * NH;
#pragma unroll 1
    for (int it = gw; it < NIT; it += NGW) {
        const int tile = it / NH, hd = it - tile * NH, tok = tile * 16 + t;
        const float* yfp = YF + ((size_t)it * 64 + 16 * iq) * 16 + t; const float* ybp = YB + ((size_t)it * 64 + 16 * iq) * 16 + (15 - t);
        float y[16];
#pragma unroll
        for (int k = 0; k < 16; ++k) y[k] = yfp[k * 16] + ybp[k * 16];
        const u32x4 v0 = *(const u32x4*)(Vg + ((size_t)it * 16 + t) * 64 + 16 * iq), v1 = *(const u32x4*)(Vg + ((size_t)it * 16 + t) * 64 + 16 * iq + 8);
        const u32x4 g0 = *(const u32x4*)(Gg + (size_t)tok * RW + hd * 64 + 16 * iq), g1 = *(const u32x4*)(Gg + (size_t)tok * RW + hd * 64 + 16 * iq + 8);
        const float bon = BON[(size_t)tok * NH + hd] + BON[(size_t)T * NH + (size_t)tok * NH + hd];
        float sm = 0.f;
#pragma unroll
        for (int k = 0; k < 16; ++k) sm += y[k];
        sm += __shfl_xor(sm, 16); sm += __shfl_xor(sm, 32);
        const float mean = sm * (1.f / 64.f); float vs = 0.f;
#pragma unroll
        for (int k = 0; k < 16; ++k) { y[k] -= mean; vs += y[k] * y[k]; }
        vs += __shfl_xor(vs, 16); vs += __shfl_xor(vs, 32);
        const float rstd = 1.0f / sqrtf(vs * (1.f / 64.f) + 64e-5f);
        const unsigned vw[8] = {v0.x, v0.y, v0.z, v0.w, v1.x, v1.y, v1.z, v1.w}, gwd[8] = {g0.x, g0.y, g0.z, g0.w, g1.x, g1.y, g1.z, g1.w};
        unsigned ow[8];
#pragma unroll
        for (int k2 = 0; k2 < 8; ++k2) { const int ch = hd * 64 + 16 * iq + 2 * k2;
            const float o0 = (y[2 * k2] * rstd * a.in[I_LNXG][ch] + a.in[I_LNXB][ch] + bon * bf_lo(vw[k2])) * bf_lo(gwd[k2]);
            const float o1 = (y[2 * k2 + 1] * rstd * a.in[I_LNXG][ch + 1] + a.in[I_LNXB][ch + 1] + bon * bf_hi(vw[k2])) * bf_hi(gwd[k2]);
            ow[k2] = pk_bf16(o0, o1); }
        bf16_t* op = MIX + (size_t)tok * D + 640 + hd * 64 + 16 * iq;
        *(u32x4*)op = (u32x4){ow[0], ow[1], ow[2], ow[3]}; *(u32x4*)(op + 8) = (u32x4){ow[4], ow[5], ow[6], ow[7]};
    }
}

constexpr int RT_WS = 2064;
__device__ __forceinline__ void phase_router(const Args& a, LAS unsigned char* lds, int G) {
    int tid = tid_of(a.wv); asm volatile("" : "+v"(tid)); const int lane = tid & 63, wave = __builtin_amdgcn_readfirstlane(tid >> 6);
    const int gw = blockIdx.x * 8 + wave, NGW = G * 8, l15 = lane & 15, kq = lane >> 4;
    LAS bf16_t* WH = (LAS bf16_t*)lds; LAS bf16_t* WL = (LAS bf16_t*)(lds + 16 * RT_WS);
    for (int i = tid; i < D * NE; i += NTHREADS) { const int k = i >> 4, e = i & 15; const float w = a.in[I_WROUTER][i];
        const unsigned hi = pk_bf16(w, 0.f) & 0xffffu; const float rem = w - bf_lo(hi);
        WH[e * (RT_WS / 2) + k] = (bf16_t)hi; WL[e * (RT_WS / 2) + k] = (bf16_t)(pk_bf16(rem, 0.f) & 0xffffu); }
    __syncthreads();
    const bf16_t* __restrict__ X1 = (const bf16_t*)(a.ws + WS_X1); const float* __restrict__ ss = (const float*)(a.ws + WS_SS); bf16_t* __restrict__ H2 = (bf16_t*)(a.ws + WS_H2);
    float* __restrict__ AFF = (float*)(a.ws + WS_AFF); int* __restrict__ INV = (int*)(a.ws + WS_INV);
    const float* __restrict__ GF = a.in[I_NFFNG];
    for (int grp = gw; grp < T / 16; grp += NGW) {
        const int tok = grp * 16 + l15;
        const float rs = 1.0f / sqrtf(ss[tok] * (1.f / D) + 1e-6f);
        f32x4 acc = {0.f, 0.f, 0.f, 0.f};
        const bf16_t* xrow = X1 + (size_t)tok * D + 8 * kq; unsigned char* hrow8 = (unsigned char*)H2 + (size_t)tok * D + 8 * kq;
#pragma unroll 8
        for (int ks = 0; ks < 32; ++ks) {
            const u32x4 xw = *(const u32x4*)(xrow + 32 * ks); const f32x4 x0 = {bf_lo(xw.x), bf_hi(xw.x), bf_lo(xw.y), bf_hi(xw.y)}, x1v = {bf_lo(xw.z), bf_hi(xw.z), bf_lo(xw.w), bf_hi(xw.w)};
            const f32x4 g0 = *(const f32x4*)(GF + 32 * ks + 8 * kq), g1 = *(const f32x4*)(GF + 32 * ks + 8 * kq + 4);
            const f32x4 h0 = x0 * rs * g0, h1 = x1v * rs * g1;
            u32x4 hi; hi.x = pk_bf16(h0.x, h0.y); hi.y = pk_bf16(h0.z, h0.w); hi.z = pk_bf16(h1.x, h1.y); hi.w = pk_bf16(h1.z, h1.w);
            *(u32x2*)(hrow8 + 32 * ks) = (u32x2){pk_fp8x4(h0.x, h0.y, h0.z, h0.w), pk_fp8x4(h1.x, h1.y, h1.z, h1.w)};
            u32x4 lo; lo.x = pk_bf16(h0.x - bf_lo(hi.x), h0.y - bf_hi(hi.x)); lo.y = pk_bf16(h0.z - bf_lo(hi.y), h0.w - bf_hi(hi.y));
            lo.z = pk_bf16(h1.x - bf_lo(hi.z), h1.y - bf_hi(hi.z)); lo.w = pk_bf16(h1.z - bf_lo(hi.w), h1.w - bf_hi(hi.w));
            const bf16x8 ah = __builtin_bit_cast(bf16x8, hi), al = __builtin_bit_cast(bf16x8, lo);
            const bf16x8 bh = *(const LAS bf16x8*)(lds + l15 * RT_WS + (32 * ks + 8 * kq) * 2), bl = *(const LAS bf16x8*)(lds + 16 * RT_WS + l15 * RT_WS + (32 * ks + 8 * kq) * 2);
            acc = __builtin_amdgcn_mfma_f32_16x16x32_bf16(ah, bh, acc, 0, 0, 0);
            acc = __builtin_amdgcn_mfma_f32_16x16x32_bf16(al, bh, acc, 0, 0, 0);
            acc = __builtin_amdgcn_mfma_f32_16x16x32_bf16(ah, bl, acc, 0, 0, 0);
        }
#pragma unroll
        for (int rg = 0; rg < 4; ++rg) { const float mx = max16(acc[rg]); const float ex = __expf(acc[rg] - mx); const float sm = sum16(ex);
            const int t2 = grp * 16 + 4 * kq + rg, bb = t2 >> 12, sq = t2 & (SEQ - 1);
            AFF[((size_t)(bb * NE + l15)) * SEQ + sq] = ex / sm; }
        *(u32x4*)(INV + (size_t)grp * 256 + 4 * lane) = (u32x4){0xffffffffu, 0xffffffffu, 0xffffffffu, 0xffffffffu};
    }
}

__device__ __forceinline__ void topk_unit(const Args& a, LAS unsigned char* lds, int unit) {
    int tid = tid_of(a.wv); asm volatile("" : "+v"(tid)); const int lane = tid & 63, wave = __builtin_amdgcn_readfirstlane(tid >> 6);
    const int b = unit >> 4, e = unit & 15;
    const float* AFF = (const float*)(a.ws + WS_AFF) + (size_t)unit * SEQ;
    LAS unsigned* KEY = (LAS unsigned*)lds;
    LAS unsigned* HIST = (LAS unsigned*)(lds + 16384);
    LAS unsigned* CTL = (LAS unsigned*)(lds + 16384 + 1024);
    LAS unsigned* WS_ = (LAS unsigned*)(lds + 16384 + 2048);
    __syncthreads();
    unsigned key[8];
    { const u32x4 k0 = *(const u32x4*)(AFF + tid * 8), k1 = *(const u32x4*)(AFF + tid * 8 + 4); key[0] = k0.x; key[1] = k0.y; key[2] = k0.z; key[3] = k0.w; key[4] = k1.x; key[5] = k1.y; key[6] = k1.z; key[7] = k1.w; }
    if (tid == 0) { CTL[0] = 0u; CTL[1] = (unsigned)CAP; }
    unsigned prefix = 0u, mask = 0u;
#pragma unroll 1
    for (int pass = 0; pass < 4; ++pass) {
        const int shift = 24 - 8 * pass;
        if (tid < 256) HIST[tid] = 0u;
        __syncthreads();
#pragma unroll
        for (int i = 0; i < 8; ++i) if ((key[i] & mask) == prefix) (void)__hip_atomic_fetch_add(&HIST[(key[i] >> shift) & 255u], 1u, __ATOMIC_RELAXED, __HIP_MEMORY_SCOPE_WORKGROUP);
        __syncthreads();
        if (wave == 0) {
            const unsigned need = CTL[1];
            unsigned hv[4], tsum = 0u;
#pragma unroll
            for (int i = 0; i < 4; ++i) { hv[i] = HIST[255 - (4 * lane + i)]; tsum += hv[i]; }
            unsigned inc = tsum;
#pragma unroll
            for (int o = 1; o < 64; o <<= 1) { const unsigned v = __shfl_up(inc, o); if (lane >= o) inc += v; }
            unsigned exc = inc - tsum;
            if (exc < need && need <= inc) {
                unsigned run = exc; int di = 0;
#pragma unroll
                for (int i = 0; i < 4; ++i) { if (run < need && need <= run + hv[i]) { di = i; break; } run += hv[i]; }
                const unsigned digit = 255u - (unsigned)(4 * lane + di);
                CTL[0] = prefix | (digit << shift); CTL[1] = need - run;
            }
        }
        __syncthreads();
        prefix = CTL[0]; mask |= (255u << shift);
    }
    const unsigned thr = prefix, need_eq = CTL[1];
    unsigned ngt = 0u, neq = 0u;
#pragma unroll
    for (int i = 0; i < 8; ++i) { ngt += (key[i] > thr) ? 1u : 0u; neq += (key[i] == thr) ? 1u : 0u; }
    unsigned pk = ngt | (neq << 16), inc = pk;
#pragma unroll
    for (int o = 1; o < 64; o <<= 1) { const unsigned v = __shfl_up(inc, o); if (lane >= o) inc += v; }
    if (lane == 63) WS_[wave] = inc;
    __syncthreads();
    unsigned woff = 0u, tot = 0u;
#pragma unroll
    for (int w = 0; w < 8; ++w) { const unsigned v = WS_[w]; if (w < wave) woff += v; tot += v; }
    const unsigned exc = inc - pk + woff;
    unsigned gpos = exc & 0xffffu, epos = exc >> 16; const unsigned totgt = tot & 0xffffu;
    const int sbase = (e * BATCH + b) * CAP;
    int* ROWTOK = (int*)(a.ws + WS_ROWTOK); float* ROWGATE = (float*)(a.ws + WS_ROWGATE); int* INV = (int*)(a.ws + WS_INV);
#pragma unroll
    for (int i = 0; i < 8; ++i) {
        int pos = -1;
        if (key[i] > thr) pos = (int)gpos++;
        else if (key[i] == thr) { if (epos < need_eq) pos = (int)(totgt + epos); epos++; }
        if (pos >= 0) { const int s = tid * 8 + i, tok = b * SEQ + s, slot = sbase + pos;
            ROWTOK[slot] = tok; ROWGATE[slot] = __builtin_bit_cast(float, key[i]); INV[(size_t)tok * NE + e] = slot; }
    }
}

__device__ __forceinline__ void phase_final(const Args& a, int G) {
    int tid = tid_of(a.wv); asm volatile("" : "+v"(tid)); const int lane = tid & 63, wave = __builtin_amdgcn_readfirstlane(tid >> 6);
    const int gw = blockIdx.x * 8 + wave, NGW = G * 8;
    const bf16_t* __restrict__ X1 = (const bf16_t*)(a.ws + WS_X1); const bf16_t* __restrict__ YE = (const bf16_t*)(a.ws + WS_YE); const int* __restrict__ INV = (const int*)(a.ws + WS_INV);
    float* __restrict__ OUT = a.out;
    f32x4 gg[4];
#pragma unroll
    for (int j = 0; j < 4; ++j) gg[j] = *(const f32x4*)(a.in[I_FNG] + 4 * lane + 256 * j);
#define PF_SLOTS(inv_, n_, m_, sl_) do { m_ = __ballot((inv_) >= 0) & 0xffffull; n_ = __builtin_popcountll(m_); unsigned long long mm_ = m_; \
        _Pragma("unroll") for (int k_ = 0; k_ < 4; ++k_) { if (mm_) { const int e_ = __builtin_ctzll(mm_); mm_ &= mm_ - 1; sl_[k_] = __builtin_amdgcn_readlane((inv_), e_); } else sl_[k_] = 0; } m_ = mm_; } while (0)
#define PF_ROWS(rw_, xr_, tk_, n_, sl_) do { \
        _Pragma("unroll") for (int k_ = 0; k_ < 4; ++k_) { if (k_ < (n_)) { _Pragma("unroll") for (int j_ = 0; j_ < 4; ++j_) rw_[k_][j_] = *(const u32x2*)(YE + (size_t)sl_[k_] * D + 4 * lane + 256 * j_); } \
            else { _Pragma("unroll") for (int j_ = 0; j_ < 4; ++j_) rw_[k_][j_] = (u32x2){0u, 0u}; } } \
        _Pragma("unroll") for (int j_ = 0; j_ < 4; ++j_) xr_[j_] = *(const u32x2*)(X1 + (size_t)(tk_) * D + 4 * lane + 256 * j_); } while (0)
    int tok = gw;
    if (tok >= T) return;
    int inv0 = INV[(size_t)tok * NE + (lane & 15)];
    int inv1 = (tok + NGW < T) ? INV[(size_t)(tok + NGW) * NE + (lane & 15)] : -1;
    unsigned long long mc; int nc, slc[4]; u32x2 rwc[4][4], xc[4];
    PF_SLOTS(inv0, nc, mc, slc);
    PF_ROWS(rwc, xc, tok, nc, slc);
    for (; tok < T; tok += NGW) {
        const int t1 = tok + NGW, t2 = tok + 2 * NGW;
        const int inv2 = (t2 < T) ? INV[(size_t)t2 * NE + (lane & 15)] : -1;
        unsigned long long mn = 0ull; int nn = 0, sln[4] = {0, 0, 0, 0}; u32x2 rwn[4][4], xn[4];
        if (t1 < T) { PF_SLOTS(inv1, nn, mn, sln); PF_ROWS(rwn, xn, t1, nn, sln); }
        else {
#pragma unroll
            for (int k = 0; k < 4; ++k)
#pragma unroll
                for (int j = 0; j < 4; ++j) rwn[k][j] = (u32x2){0u, 0u};
#pragma unroll
            for (int j = 0; j < 4; ++j) xn[j] = (u32x2){0u, 0u}; }
        f32x4 v[4];
#pragma unroll
        for (int j = 0; j < 4; ++j) v[j] = (f32x4){bf_lo(xc[j].x), bf_hi(xc[j].x), bf_lo(xc[j].y), bf_hi(xc[j].y)};
#pragma unroll
        for (int k = 0; k < 4; ++k)
#pragma unroll
            for (int j = 0; j < 4; ++j) { v[j].x += bf_lo(rwc[k][j].x); v[j].y += bf_hi(rwc[k][j].x); v[j].z += bf_lo(rwc[k][j].y); v[j].w += bf_hi(rwc[k][j].y); }
        if (nc > 4) { unsigned long long m = mc; while (m) { const int e = __builtin_ctzll(m); m &= m - 1; const int slot = __builtin_amdgcn_readlane(inv0, e);
#pragma unroll
                for (int j = 0; j < 4; ++j) { const u32x2 w = *(const u32x2*)(YE + (size_t)slot * D + 4 * lane + 256 * j);
                    v[j].x += bf_lo(w.x); v[j].y += bf_hi(w.x); v[j].z += bf_lo(w.y); v[j].w += bf_hi(w.y); } } }
        float sq = 0.f;
#pragma unroll
        for (int j = 0; j < 4; ++j) sq += (v[j].x * v[j].x + v[j].y * v[j].y) + (v[j].z * v[j].z + v[j].w * v[j].w);
        float rs = 1.0f / sqrtf(wave_sum(sq) * (1.f / D) + 1e-6f);
#pragma unroll
        for (int j = 0; j < 4; ++j) *(f32x4*)(OUT + (size_t)tok * D + 4 * lane + 256 * j) = v[j] * rs * gg[j];
        inv0 = inv1; inv1 = inv2; mc = mn; nc = nn;
#pragma unroll
        for (int k = 0; k < 4; ++k) { slc[k] = sln[k];
#pragma unroll
            for (int j = 0; j < 4; ++j) rwc[k][j] = rwn[k][j]; }
#pragma unroll
        for (int j = 0; j < 4; ++j) xc[j] = xn[j];
    }
#undef PF_SLOTS
#undef PF_ROWS
}

#define XB_TMO      128
#define XB_XCNT(j)  (256  + 64 * (j))
#define XB_XSUB(j)  (1280 + 64 * (j))
#define XB_XGEN(j)  (2304 + 64 * (j))
#define XB_TOP      3328
#define XB_TOPGEN   3392
#define XCD_BAR_WORDS 3456
#define XB_SPIN_CAP (1u << 22)
__device__ __forceinline__ unsigned xb_ld(unsigned* p)              { return __hip_atomic_load(p, __ATOMIC_RELAXED, __HIP_MEMORY_SCOPE_AGENT); }
__device__ __forceinline__ unsigned xb_add(unsigned* p, unsigned v) { return __hip_atomic_fetch_add(p, v, __ATOMIC_RELAXED, __HIP_MEMORY_SCOPE_AGENT); }
__device__ __forceinline__ unsigned xb_xcc_id() { return (unsigned)__builtin_amdgcn_s_getreg((3 << 11) | 20) & 0xFu; }
#define XB_SPIN(cond, bar) do { unsigned _sp = 0; while (cond) { __builtin_amdgcn_s_sleep(1); \
    if ((++_sp & 255u) == 0u) { if (xb_ld(&(bar)[XB_TMO])) break; if (_sp > XB_SPIN_CAP) { atomicAdd(&(bar)[XB_TMO], 1u); break; } } } } while (0)
struct XcdBarrier { unsigned* bar; unsigned x; volatile LAS unsigned* st; int wv; };
__device__ __forceinline__ XcdBarrier xcd_barrier_post(unsigned* bar, volatile LAS unsigned* st, int wv) {
    XcdBarrier b; b.bar = bar; b.x = xb_xcc_id(); b.st = st; b.wv = wv;
    if (threadIdx.x == 0) (void)xb_add(&bar[XB_XCNT(b.x)], 1u);
    return b;
}
__device__ __forceinline__ void xcd_barrier_complete(unsigned* bar, unsigned x, unsigned& nloc, unsigned& nx) {
    const unsigned G = gridDim.x * gridDim.y * gridDim.z;
    unsigned sum, cnt, mine, sp = 0u;
    for (;;) {
        sum = 0u; cnt = 0u; mine = 0u;
#pragma unroll
        for (unsigned j = 0; j < 16; ++j) { const unsigned c = xb_ld(&bar[XB_XCNT(j)]); sum += c; cnt += (c > 0u) ? 1u : 0u; mine = (j == x) ? c : mine; }
        if (sum == G) break;
        __builtin_amdgcn_s_sleep(1);
        if ((++sp & 255u) == 0u) { if (xb_ld(&bar[XB_TMO])) break; if (sp > XB_SPIN_CAP) { atomicAdd(&bar[XB_TMO], 1u); break; } }
    }
    nloc = mine > 0u ? mine : 1u; nx = cnt > 0u ? cnt : 1u;
}
__device__ __forceinline__ void xcd_barrier(const XcdBarrier& b) {
    asm volatile("s_waitcnt vmcnt(0)" ::: "memory");
    __syncthreads();
    if (tid_of(b.wv) == 0) {
        unsigned* bar = b.bar;
        __builtin_amdgcn_s_waitcnt(0);
        unsigned nloc = b.st[0], nx = b.st[1];
        if (nloc == 0u) { xcd_barrier_complete(bar, b.x, nloc, nx); b.st[0] = nloc; b.st[1] = nx; }
        const unsigned old = xb_add(&bar[XB_XSUB(b.x)], 1u);
        const unsigned gen = old / nloc;
        if (old + 1u == (gen + 1u) * nloc) {
            __builtin_amdgcn_fence(__ATOMIC_RELEASE, "agent");
            asm volatile("s_waitcnt vmcnt(0)" ::: "memory");
            const unsigned og = xb_add(&bar[XB_TOP], 1u);
            const unsigned tg = og / nx;
            if (og + 1u == (tg + 1u) * nx) xb_add(&bar[XB_TOPGEN], 1u);
            else XB_SPIN(xb_ld(&bar[XB_TOPGEN]) == tg, bar);
            __builtin_amdgcn_fence(__ATOMIC_ACQUIRE, "agent");
            xb_add(&bar[XB_XGEN(b.x)], 1u);
            asm volatile("s_waitcnt vmcnt(0)" ::: "memory");
        } else {
            XB_SPIN(xb_ld(&bar[XB_XGEN(b.x)]) == gen, bar);
            __builtin_amdgcn_fence(__ATOMIC_ACQUIRE, "agent");
            asm volatile("s_waitcnt vmcnt(0)" ::: "memory");
        }
    }
    __syncthreads();
}

#ifndef PH_MASK
#define PH_MASK 0x7ff
#endif
#ifndef REP_MASK
#define REP_MASK 0
#endif
#ifndef P2_MASK
#define P2_MASK 7
#endif
#ifndef P2_REP
#define P2_REP 0
#define P9_REP 0
#endif
constexpr int LDS_MISC = LDS_BYTES - 64;
constexpr int LDS_PTAB = LDS_BYTES - 512;
__device__ __forceinline__ Args load_args(LAS unsigned char* lds, int lo, int hi, int wv) {
    Args r; const LAS u32x2* t = (const LAS u32x2*)(lds + LDS_PTAB);
#pragma unroll
    for (int i = 0; i < 31; ++i) { const u32x2 v = t[i]; const unsigned long long p = ((unsigned long long)(unsigned)__builtin_amdgcn_readfirstlane((int)v.y) << 32) | (unsigned)__builtin_amdgcn_readfirstlane((int)v.x);
        if (i < 29) r.in[i] = (const float*)(const __attribute__((address_space(1))) float*)p; else if (i == 29) r.out = (float*)(__attribute__((address_space(1))) float*)p; else r.ws = (unsigned char*)(__attribute__((address_space(1))) unsigned char*)p; }
    r.ph_lo = lo; r.ph_hi = hi; r.wv = wv; r.zero_ = 0; return r;
}
constexpr size_t WS_CTL = 0, CTL_BYTES = 16384;
__global__ void __launch_bounds__(NTHREADS, 2) mega(Args a0) {
    extern __shared__ __attribute__((aligned(16))) unsigned char lds_raw[];
    LAS unsigned char* lds = (LAS unsigned char*)lds_raw;
    cg::grid_group grid = cg::this_grid();
    const int G = gridDim.x, lo = a0.ph_lo, hi = a0.ph_hi, wv0 = __builtin_amdgcn_readfirstlane((int)threadIdx.x >> 6);
    volatile LAS unsigned* misc = (volatile LAS unsigned*)(lds + LDS_MISC);
    if (threadIdx.x < 16) misc[threadIdx.x] = 0u;
    if (threadIdx.x == 0) { LAS unsigned long long* t = (LAS unsigned long long*)(lds + LDS_PTAB);
#pragma unroll
        for (int i = 0; i < 29; ++i) t[i] = (unsigned long long)a0.in[i];
        t[29] = (unsigned long long)a0.out; t[30] = (unsigned long long)a0.ws; }
    __syncthreads();
    if (lo < -1000) grid.sync();
    XcdBarrier xbar = xcd_barrier_post((unsigned*)(a0.ws + WS_CTL), misc, wv0);
#define IN(k) (((PH_MASK >> (k)) & 1) && lo <= (k) && (k) < hi)
#define NREP(k) (1 + ((REP_MASK >> (k)) & 1))
#define PHASE(k, ...) do { if (IN(k)) { for (int rep_ = 0; rep_ < NREP(k); ++rep_) { { const Args a = load_args(lds, lo, hi, wv0); unsigned char* const ws = a.ws; (void)ws; __VA_ARGS__; } if (rep_ + 1 < NREP(k) || IN((k) + 1)) { xcd_barrier(xbar); } } } } while (0)

    PHASE(0, phase_prep(a, lds, G));

    PHASE(1, {
        pg8::Gemm g{(const bf16_t*)(ws + WS_XH), (const bf16_t*)(ws + WS_WINT), T, IN_PROJ, D, 0, 0};
        pg8::TripleOrder S; S.S0.init(T, IN_PROJ, G, 0); S.A1 = (const bf16_t*)(ws + WS_MEMN); S.B1 = (const bf16_t*)(ws + WS_WKT); S.A2 = (const bf16_t*)(ws + WS_WVT); S.B2 = (const bf16_t*)(ws + WS_MEMN);
        S.n1 = BATCH * NMEM / 256; S.n2 = BATCH * NMEM / 256; S.G = G; S.c = (int)blockIdx.x;
        pg8::EpiBf16x3 E{pg8::EpiBf16{(bf16_t*)(ws + WS_P), PLD, (bf16_t*)(ws + WS_Q)}, pg8::EpiBf16{(bf16_t*)(ws + WS_KMEM), 256, nullptr}, pg8::EpiBf16{(bf16_t*)(ws + WS_VT), BATCH * NMEM, nullptr}};
        pg8::gemm_phase<pg8::EpiBf16x3, pg8::TripleOrder, false>(lds, g, S, E, nullptr, a.wv);
    });

    constexpr int NSCAN = BATCH * NH * 2;
    PHASE(2, {
        for (int u = blockIdx.x; u < 2048; u += G) {
            if (u < 1024) { for (int r2 = 0; r2 < 1 + ((P2_REP >> 1) & 1); ++r2) conv_unit(a, lds, u); }
            else { for (int r2 = 0; r2 < 1 + ((P2_REP >> 2) & 1); ++r2) prep_unit(a, lds, u - 1024); }
        }
    });

    PHASE(3, {
        int bid = blockIdx.x; int Gp = G; asm volatile("" : "+s"(bid), "+s"(Gp));
        for (int u = bid; u < NSCAN; u += Gp) scan_chunked_unit(a, lds, u);
        if (rep_ == 0) {
            if (Gp > NSCAN) { if (bid >= NSCAN) { for (int u = bid - NSCAN; u < 64; u += Gp - NSCAN) for (int r2 = 0; r2 < 1 + (P2_REP & 1); ++r2) attn_unit(a, lds, u);
                                                 } }
            else { for (int u = bid; u < 64; u += Gp) attn_unit(a, lds, u); }
        }
    });

    PHASE(4, phase_post(a, G));

    PHASE(5, {
        pg8::Gemm g{(const bf16_t*)(ws + WS_MIX), (const bf16_t*)(ws + WS_WOUTT), T, D, D, 0, 0}; pg8::StaticOrder S; S.init(T, D, G, (int)blockIdx.x);
        pg8::EpiResidSS E{a.in[I_X], (bf16_t*)(ws + WS_X1), (float*)(ws + WS_SS)}; pg8::gemm_phase<pg8::EpiResidSS, pg8::StaticOrder, false>(lds, g, S, E, nullptr, a.wv);
    });

    PHASE(6, phase_router(a, lds, G));

    PHASE(7, { for (int u = blockIdx.x; u < BATCH * NE; u += G) topk_unit(a, lds, u); });

    PHASE(8, {
        pg8::Gemm g{(const bf16_t*)(ws + WS_H2), (const bf16_t*)(ws + WS_WGUT), NSLOT, 2048, D / 2, 0x7A7A7A7A, 0x7F7F7F7F};     pg8::ExpertOrder S; S.init(32, 8, NE, G, (int)blockIdx.x);
        pg8::EpiSwiGLU E{(bf16_t*)(ws + WS_HID)}; pg8::gemm_phase<pg8::EpiSwiGLU, pg8::ExpertOrder, true, false, true>(lds, g, S, E, (const int*)(ws + WS_ROWTOK), a.wv);
    });

    PHASE(9, {
        pg8::Gemm g{(const bf16_t*)(ws + WS_HID), (const bf16_t*)(ws + WS_WDT), NSLOT, D, FF / 2, 0x7A7A7A7A, 0x7C7C7C7C};     pg8::ExpertOrder S; S.init(32, 4, NE, G, (int)blockIdx.x);
        pg8::EpiGateScale E{(bf16_t*)(ws + WS_YE), (const float*)(ws + WS_ROWGATE)}; pg8::gemm_phase<pg8::EpiGateScale, pg8::ExpertOrder, false, true, true>(lds, g, S, E, nullptr, a.wv);
#if P9_REP
        __syncthreads(); pg8::gemm_phase<pg8::EpiGateScale, pg8::ExpertOrder, false, true, true>(lds, g, S, E, nullptr, a.wv);
#endif
    });

    PHASE(10, phase_final(a, G));
#undef IN
#undef NREP
#undef PHASE
}

#ifndef MK_ONE_LAUNCH
#define MK_ONE_LAUNCH 1
#endif
extern "C" void kernel_launch(void* const* d_in, const int* in_sizes, int n_in, void* d_out, int out_size, void* d_ws, size_t ws_size, hipStream_t stream) {
    static int grid_blocks = 0;
    if (grid_blocks == 0) {
        if (n_in != 29 || out_size != T * D || ws_size < WS_END) { fprintf(stderr, "kernel_launch: unexpected problem: n_in %d out %d ws %zu (need %zu)\n", n_in, out_size, ws_size, (size_t)WS_END); grid_blocks = -1; return; }
        int dev = 0, cus = 0, per_cu = 0;
        if (hipGetDevice(&dev) != hipSuccess || hipDeviceGetAttribute(&cus, hipDeviceAttributeMultiprocessorCount, dev) != hipSuccess) { grid_blocks = -1; return; }
        if (hipFuncSetAttribute((const void*)mega, hipFuncAttributeMaxDynamicSharedMemorySize, LDS_BYTES) != hipSuccess) { fprintf(stderr, "kernel_launch: hipFuncSetAttribute failed\n"); grid_blocks = -1; return; }
        if (hipOccupancyMaxActiveBlocksPerMultiprocessor(&per_cu, (const void*)mega, NTHREADS, LDS_BYTES) != hipSuccess || per_cu < 1) { fprintf(stderr, "kernel_launch: occupancy query says %d blocks per CU\n", per_cu); grid_blocks = -1; return; }
        grid_blocks = cus;
    }
    if (grid_blocks < 0) return;
    if (hipMemsetAsync((char*)d_ws + WS_CTL, 0, CTL_BYTES, stream) != hipSuccess) { fprintf(stderr, "kernel_launch: memset failed\n"); return; }
    Args a{};
    for (int i = 0; i < 29; ++i) a.in[i] = (const float*)d_in[i];
    a.out = (float*)d_out; a.ws = (unsigned char*)d_ws;
#if MK_ONE_LAUNCH
    a.ph_lo = 0; a.ph_hi = NPHASE;
    { void* args[] = {&a}; hipError_t e = hipLaunchCooperativeKernel((const void*)mega, dim3(grid_blocks), dim3(NTHREADS), args, LDS_BYTES, stream);
      if (e != hipSuccess) fprintf(stderr, "cooperative launch failed: %s (grid %d)\n", hipGetErrorString(e), grid_blocks); }
#else
    for (int ph = 0; ph < NPHASE; ++ph) { a.ph_lo = ph; a.ph_hi = ph + 1; void* args[] = {&a};
        hipError_t e = hipLaunchCooperativeKernel((const void*)mega, dim3(grid_blocks), dim3(NTHREADS), args, LDS_BYTES, stream);
        if (e != hipSuccess) { fprintf(stderr, "cooperative launch %d failed: %s (grid %d)\n", ph, hipGetErrorString(e), grid_blocks); break; } }
#endif
}
```

```cpp
#include <hip/hip_runtime.h>
#include <hip/hip_cooperative_groups.h>
#include <cstdio>
#include <cstdint>
namespace cg = cooperative_groups;

#define LAS __attribute__((address_space(3)))
typedef unsigned short bf16_t;
typedef short bf16x8 __attribute__((ext_vector_type(8)));
typedef short s16x4 __attribute__((ext_vector_type(4)));
typedef float f32x2 __attribute__((ext_vector_type(2)));
typedef float f32x4 __attribute__((ext_vector_type(4)));
typedef float f32x16 __attribute__((ext_vector_type(16)));
typedef unsigned u32x2 __attribute__((ext_vector_type(2)));
typedef unsigned u32x4 __attribute__((ext_vector_type(4)));
typedef _Float16 f16x4 __attribute__((ext_vector_type(4)));
typedef __bf16 bf16v2 __attribute__((ext_vector_type(2)));
typedef int v8i __attribute__((ext_vector_type(8)));
typedef int v4i __attribute__((ext_vector_type(4)));

constexpr int D = 1024, BATCH = 16, SEQ = 4096, T = BATCH * SEQ, NMEM = 256;
constexpr int IN_PROJ = 2560, CW = 384, RW = 384, NH = 6, NE = 16, FF = 1024, CAP = 512;
constexpr int NSLOT = NE * BATCH * CAP;
constexpr int NTHREADS = 512;
constexpr int LDS_BYTES = 160 * 1024;
constexpr int NPHASE = 11;
#ifndef SCAN_MODE
#define SCAN_MODE 1
#endif

constexpr size_t MiB = 1u << 20;
constexpr size_t WS_WINT = 1 * MiB;
constexpr size_t WS_WOUTT = 6 * MiB;
constexpr size_t WS_WKT = 8 * MiB;
constexpr size_t WS_WVT = 8 * MiB + 512 * 1024;
constexpr size_t WS_SMALL = 9 * MiB;
constexpr size_t WS_WGUT = 10 * MiB;
constexpr size_t WS_WDT = 74 * MiB;
constexpr size_t WS_KMEM = 106 * MiB;
constexpr size_t WS_VT = 108 * MiB;
constexpr size_t WS_ROWTOK = 106 * MiB;
constexpr size_t WS_ROWGATE = 106 * MiB + 512 * 1024;
constexpr size_t WS_SS = 107 * MiB;
constexpr size_t WS_P = 112 * MiB;
constexpr size_t WS_YF = 112 * MiB;
constexpr size_t WS_YB = 208 * MiB;
constexpr size_t WS_X1 = 112 * MiB;
constexpr size_t WS_XH = 432 * MiB;
constexpr size_t WS_G = 432 * MiB;
constexpr size_t WS_BON = 480 * MiB;
constexpr size_t WS_Q = 400 * MiB;
constexpr int PLD = IN_PROJ - 256;
constexpr size_t WS_H2 = 432 * MiB;
constexpr size_t WS_MEMN = 560 * MiB;
constexpr size_t WS_MIX = 560 * MiB;
constexpr size_t WS_SCAN = 688 * MiB;
constexpr size_t SCAN_STRIDE = 48 * MiB;
constexpr size_t WS_SCAN7 = 496 * MiB;
constexpr size_t WS_PC = 484 * MiB;
__device__ __forceinline__ unsigned char* scan_arr(unsigned char* ws, int a) { return a < 7 ? ws + WS_SCAN + (size_t)a * SCAN_STRIDE : (a == 7 ? ws + WS_SCAN7 : ws + 560 * MiB + 640 * 2); }
__device__ __forceinline__ int scan_pitch(int a) { return a == 8 ? D : 384; }
__device__ __forceinline__ size_t hat_off(int a, size_t tok, int ch) { return a == 8 ? tok * D + ch : ((((tok >> 4) * NH + (ch >> 6)) << 10) + ((tok & 15) << 6) + (ch & 63)); }
constexpr size_t WS_AFF = 624 * MiB;
constexpr size_t WS_INV = 628 * MiB;
constexpr size_t WS_HID = 768 * MiB;
constexpr size_t WS_YE = 368 * MiB;
constexpr size_t WS_END = 1024 * MiB;

__device__ __forceinline__ unsigned pk_bf16(float lo, float hi) { f32x2 v = {lo, hi}; bf16v2 b = __builtin_convertvector(v, bf16v2); return __builtin_bit_cast(unsigned, b); }
__device__ __forceinline__ unsigned pk_fp8x4(float a, float b, float c, float d) { int w = 0; w = __builtin_amdgcn_cvt_pk_fp8_f32(a, b, w, false); w = __builtin_amdgcn_cvt_pk_fp8_f32(c, d, w, true); return (unsigned)w; }
__device__ __forceinline__ float bf_lo(unsigned u) { return __builtin_bit_cast(float, u << 16); }
__device__ __forceinline__ float bf_hi(unsigned u) { return __builtin_bit_cast(float, u & 0xffff0000u); }
__device__ __forceinline__ float wave_sum(float v) {
#pragma unroll
    for (int o = 1; o < 64; o <<= 1) v += __shfl_xor(v, o);
    return v;
}
__device__ __forceinline__ float sigmoidf_fast(float x) { return __builtin_amdgcn_rcpf(1.0f + __builtin_amdgcn_exp2f(-1.4426950408889634f * x)); }
template <int CTRL> __device__ __forceinline__ float dpp_f(float x) { return __builtin_bit_cast(float, __builtin_amdgcn_update_dpp(0, __builtin_bit_cast(int, x), CTRL, 0xF, 0xF, true)); }
__device__ __forceinline__ float sum8(float x) { x += dpp_f<0xB1>(x); x += dpp_f<0x4E>(x); x += dpp_f<0x141>(x); return x; }
__device__ __forceinline__ float sum16(float x) { x = sum8(x); x += dpp_f<0x140>(x); return x; }
__device__ __forceinline__ float max16(float x) { x = fmaxf(x, dpp_f<0xB1>(x)); x = fmaxf(x, dpp_f<0x4E>(x)); x = fmaxf(x, dpp_f<0x141>(x)); x = fmaxf(x, dpp_f<0x140>(x)); return x; }

typedef short v4i16g __attribute__((__vector_size__(8)));
__device__ __forceinline__ s16x4 tr_read16(LAS unsigned char* p) { v4i16g r = __builtin_amdgcn_ds_read_tr16_b64_v4i16((LAS v4i16g*)p); return __builtin_bit_cast(s16x4, r); }
__device__ __forceinline__ f32x4 bf4_to_f32(u32x2 w) { return (f32x4){bf_lo(w.x), bf_hi(w.x), bf_lo(w.y), bf_hi(w.y)}; }
__device__ __forceinline__ u32x2 f32_to_bf4(f32x4 v) { return (u32x2){pk_bf16(v.x, v.y), pk_bf16(v.z, v.w)}; }
__device__ __forceinline__ bf16x8 frag_lo4(f32x4 v) { const u32x4 w = {pk_bf16(v.x, v.y), pk_bf16(v.z, v.w), 0u, 0u}; return __builtin_bit_cast(bf16x8, w); }
__device__ __forceinline__ bf16x8 frag_cat(u32x2 a, u32x2 b) { const u32x4 w = {a.x, a.y, b.x, b.y}; return __builtin_bit_cast(bf16x8, w); }
#define MFMA16(a, b, c) __builtin_amdgcn_mfma_f32_16x16x32_bf16((a), (b), (c), 0, 0, 0)

__device__ __forceinline__ int tid_of(int wv) { int l; asm volatile("v_mbcnt_lo_u32_b32 %0, -1, 0\n\tv_mbcnt_hi_u32_b32 %0, -1, %0" : "=v"(l)); return (wv << 6) | l; }
namespace pg8 {
#define PG8_LAS __attribute__((address_space(3)))
constexpr int BM = 256, BK = 64, HALF = 128, HTB = HALF * BK * 2, STAGE_BYTES = 8 * HTB, NXCD = 8, WGM = 8;
__host__ __device__ __forceinline__ int lds_byte(int r, int c) { const int st = (r >> 4) * 2 + (c >> 5), rr = r & 15, cc = c & 31, ob = rr * 64 + cc * 2; return st * 1024 + (ob ^ (((ob >> 9) & 1) << 5)); }
__host__ __device__ __forceinline__ void stage_rc(int b, int& R, int& C) { const int st = b / 1024, sb = b % 1024, swz = sb ^ (((sb >> 9) & 1) << 5); R = (st >> 1) * 16 + swz / 64; C = (st & 1) * 32 + (swz % 64) / 2; }
__host__ __device__ __forceinline__ int perm32(int rho) { const int n = rho >> 4, i = rho & 15; return 8 * (i >> 2) + 4 * n + (i & 3); }

struct Unit { int pm, pn, gid; };
struct Gemm { const bf16_t* A; const bf16_t* Bt; int M, N, K; int sw, sx; };

struct StaticOrder {
    int nM, nN, nwg, G, c;
    __device__ void init(int M, int N, int G_, int c_) { nM = M / BM; nN = N / BM; nwg = nM * nN; G = G_; c = c_; }
    __device__ bool next(int i, Unit& u) const {
        const long L = (long)i * G + c; if (L >= nwg) return false;
        int wgid = (int)L; { const int q = nwg / NXCD, r = nwg % NXCD, xcd = wgid % NXCD, off = wgid / NXCD; wgid = (xcd < r ? xcd * (q + 1) : r * (q + 1) + (xcd - r) * q) + off; }
        const int nig = WGM * nN, gid = wgid / nig, fm = gid * WGM, gsz = (nM - fm) < WGM ? (nM - fm) : WGM;
        u.pm = fm + ((wgid % nig) % gsz); u.pn = (wgid % nig) / gsz; u.gid = 0; return true;
    }
    __device__ __forceinline__ const char* aptr(const Gemm& g, const Unit& u, size_t tstep) const { return (const char*)g.A + (size_t)u.pm * tstep; }
    __device__ __forceinline__ const char* bptr(const Gemm& g, const Unit& u, size_t tstep) const { return (const char*)g.Bt + (size_t)u.pn * tstep; }
};
struct TripleOrder {
    StaticOrder S0; const bf16_t* A1; const bf16_t* B1; const bf16_t* A2; const bf16_t* B2; int n1, n2, G, c;
    __device__ bool next(int i, Unit& u) const {
        const long L = (long)i * G + c;
        if (L < n1) { u.pm = (int)L; u.pn = 0; u.gid = 1; return true; }
        if (L < n1 + n2) { u.pm = 0; u.pn = (int)(L - n1); u.gid = 2; return true; }
        const long L0 = L - n1 - n2; if (L0 >= S0.nwg) return false;
        StaticOrder T0 = S0; T0.c = (int)(L0 % G); return T0.next((int)(L0 / G), u);
    }
    __device__ __forceinline__ const char* aptr(const Gemm& g, const Unit& u, size_t tstep) const { return (const char*)(u.gid == 0 ? g.A : (u.gid == 1 ? A1 : A2)) + (size_t)u.pm * tstep; }
    __device__ __forceinline__ const char* bptr(const Gemm& g, const Unit& u, size_t tstep) const { return (const char*)(u.gid == 0 ? g.Bt : (u.gid == 1 ? B1 : B2)) + (size_t)u.pn * tstep; }
};
struct ExpertOrder {
    int nMe, nNe, per, total, G, c;
    __device__ void init(int nMe_, int nNe_, int nExp, int G_, int c_) { nMe = nMe_; nNe = nNe_; per = nMe * nNe; total = per * nExp; G = G_; c = c_; }
    __device__ bool next(int i, Unit& u) const {
        const long L = (long)i * G + c; if (L >= total) return false;
        const int e = (int)(L / per), w = (int)(L % per), xl = w % 8, j = w / 8, rpx = nMe / 8;
        u.pm = e * nMe + xl * rpx + (j % rpx); u.pn = e * nNe + j / rpx; u.gid = 0; return true;
    }
    __device__ __forceinline__ const char* aptr(const Gemm& g, const Unit& u, size_t tstep) const { return (const char*)g.A + (size_t)u.pm * tstep; }
    __device__ __forceinline__ const char* bptr(const Gemm& g, const Unit& u, size_t tstep) const { return (const char*)g.Bt + (size_t)u.pn * tstep; }
};

struct EpiBf16 {
    static constexpr bool PERM = true;
    bf16_t* O; int ldc; bf16_t* Q0;
    __device__ __forceinline__ void operator()(const f32x4 (&acc)[2][2][4][2], const Unit& u, int wr, int wc, int fr, int fq) const {
        const bool redir = (Q0 != nullptr) && (u.pn == 0);
        bf16_t* base = redir ? Q0 : O; const int ld = redir ? 256 : ldc;
        const int row0 = u.pm * BM + wr * 64 + fr, col0 = (u.pn - ((Q0 != nullptr && !redir) ? 1 : 0)) * BM + wc * 32 + 8 * fq;
#pragma unroll
        for (int ai = 0; ai < 2; ++ai)
#pragma unroll
            for (int m = 0; m < 4; ++m) { bf16_t* rowp = base + (size_t)(row0 + ai * HALF + m * 16) * ld + col0;
#pragma unroll
                for (int bj = 0; bj < 2; ++bj) { const f32x4 v0 = acc[ai][bj][m][0], v1 = acc[ai][bj][m][1];
                    u32x4 w; w.x = pk_bf16(v0[0], v0[1]); w.y = pk_bf16(v0[2], v0[3]); w.z = pk_bf16(v1[0], v1[1]); w.w = pk_bf16(v1[2], v1[3]);
                    *(u32x4*)(rowp + bj * HALF) = w; } }
    }
};
struct EpiBf16x3 {
    static constexpr bool PERM = true;
    EpiBf16 E0, E1, E2;
    __device__ __forceinline__ void operator()(const f32x4 (&acc)[2][2][4][2], const Unit& u, int wr, int wc, int fr, int fq) const {
        if (u.gid == 0) E0(acc, u, wr, wc, fr, fq); else if (u.gid == 1) E1(acc, u, wr, wc, fr, fq); else E2(acc, u, wr, wc, fr, fq); }
};
struct EpiResidSS {
    static constexpr bool PERM = false;
    const float* X; bf16_t* X1; float* ss;
    __device__ __forceinline__ void operator()(const f32x4 (&acc)[2][2][4][2], const Unit& u, int wr, int wc, int fr, int fq) const {
        const int row0 = u.pm * BM + wr * 64 + fr, col0 = u.pn * BM + wc * 32 + 4 * fq;
#pragma unroll
        for (int ai = 0; ai < 2; ++ai)
#pragma unroll
            for (int m = 0; m < 4; ++m) { const int row = row0 + ai * HALF + m * 16; const size_t off = (size_t)row * D + col0; float s = 0.f;
#pragma unroll
                for (int bj = 0; bj < 2; ++bj)
#pragma unroll
                    for (int n = 0; n < 2; ++n) { const f32x4 xv = *(const f32x4*)(X + off + bj * HALF + n * 16); const f32x4 o = xv + acc[ai][bj][m][n];
                        *(u32x2*)(X1 + off + bj * HALF + n * 16) = f32_to_bf4(o); s += (o[0] * o[0] + o[1] * o[1]) + (o[2] * o[2] + o[3] * o[3]); }
                s += __shfl_xor(s, 16); s += __shfl_xor(s, 32);
                if (fq == 0) (void)__hip_atomic_fetch_add(ss + row, s, __ATOMIC_RELAXED, __HIP_MEMORY_SCOPE_AGENT); }
    }
};
struct EpiSwiGLU {
    static constexpr bool PERM = true;
    bf16_t* H;
    __device__ __forceinline__ void operator()(const f32x4 (&acc)[2][2][4][2], const Unit& u, int wr, int wc, int fr, int fq) const {
        const int row0 = u.pm * BM + wr * 64 + fr, col0 = (u.pn & 7) * HALF + wc * 32 + 8 * fq;
#pragma unroll
        for (int ai = 0; ai < 2; ++ai)
#pragma unroll
            for (int m = 0; m < 4; ++m) { const int row = row0 + ai * HALF + m * 16; float h[8];
                unsigned char* rowp = (unsigned char*)H + ((((size_t)(row >> 8) * (FF / 128) + (col0 >> 7)) << 15) + ((row & 255) << 7) + (col0 & 127));
#pragma unroll
                for (int n = 0; n < 2; ++n)
#pragma unroll
                    for (int j = 0; j < 4; ++j) { const float gt = acc[ai][0][m][n][j], up = acc[ai][1][m][n][j]; h[n * 4 + j] = 8.0f * gt * sigmoidf_fast(gt) * up; }
                *(u32x2*)rowp = (u32x2){pk_fp8x4(h[0], h[1], h[2], h[3]), pk_fp8x4(h[4], h[5], h[6], h[7])}; }
    }
};
struct EpiGateScale {
    static constexpr bool PERM = true;
    bf16_t* Y; const float* gate;
    __device__ __forceinline__ void operator()(const f32x4 (&acc)[2][2][4][2], const Unit& u, int wr, int wc, int fr, int fq) const {
        const int row0 = u.pm * BM + wr * 64 + fr, col0 = (u.pn & 3) * BM + wc * 32 + 8 * fq;
#pragma unroll
        for (int ai = 0; ai < 2; ++ai)
#pragma unroll
            for (int m = 0; m < 4; ++m) { const int row = row0 + ai * HALF + m * 16; const float gs = gate[row]; bf16_t* rowp = Y + (size_t)row * D + col0;
#pragma unroll
                for (int bj = 0; bj < 2; ++bj) { const f32x4 v0 = acc[ai][bj][m][0] * gs, v1 = acc[ai][bj][m][1] * gs;
                    u32x4 w; w.x = pk_bf16(v0[0], v0[1]); w.y = pk_bf16(v0[2], v0[3]); w.z = pk_bf16(v1[0], v1[1]); w.w = pk_bf16(v1[2], v1[3]);
                    *(u32x4*)(rowp + bj * HALF) = w; } }
    }
};

template <class Epi, class Sched, bool GATHER, bool ATILED = false, bool FP8 = false>
__device__ __forceinline__ void gemm_phase(PG8_LAS unsigned char* lds, const Gemm g, const Sched& S, const Epi& E, const int* rowtok, const int wv) {
    int tid = tid_of(wv); asm volatile("" : "+v"(tid));
    const int wid = __builtin_amdgcn_readfirstlane(tid >> 6), lane = tid & 63, wr = wid >> 2, wc = wid & 3, fr = lane & 15, fq = lane >> 4;
    const int K = g.K, nt = K / BK;
    unsigned voffA0, voffB0;
    { int R, C; stage_rc(tid * 16, R, C); const int Rb = Epi::PERM ? ((R & ~31) + perm32(R & 31)) : R;
      voffA0 = ATILED ? (unsigned)(R * BK + C) * 2u : (unsigned)(R * K + C) * 2u; voffB0 = (unsigned)(Rb * K + C) * 2u; }
    const size_t dA = ATILED ? (size_t)64 * BK * 2 : (size_t)64 * K * 2, dB = (size_t)64 * K * 2;
    unsigned vAc[2][2], vAn[2][2];
    const size_t kstep = (size_t)(BK * 2);
    const size_t hstep = (size_t)HALF * K * 2;
    const size_t tstep = 2 * hstep;
    const size_t kstepA = ATILED ? (size_t)BM * BK * 2 : kstep, hstepA = ATILED ? (size_t)HALF * BK * 2 : hstep;
    const unsigned ldsw = (unsigned)wid * 1024u;
    const unsigned ldsbase = __builtin_amdgcn_readfirstlane((unsigned)(size_t)lds) + ldsw;
    const int aoff = lds_byte(wr * 64 + fr, fq * 8), boff = lds_byte(wc * 32 + fr, fq * 8);
#define PG8_SA(b, h) (((b) * 2 + (h)) * HTB)
#define PG8_SB(b, h) ((4 + (b) * 2 + (h)) * HTB)
#define PG8_GLDS(vo_, sb_, lo_) asm volatile("s_add_u32 m0, %2, %3\n\ts_nop 0\n\tglobal_load_lds_dwordx4 %0, %1" :: "v"(vo_), "s"((const void*)(sb_)), "s"(ldsbase), "n"(lo_) : "m0", "scc", "memory")
#define PG8_STAGE_D(bufoff, gbase, voff0, delta) do { PG8_GLDS(voff0, gbase, (bufoff)); PG8_GLDS(voff0, (const char*)(gbase) + (delta), (bufoff) + 8192); } while (0)
#define PG8_STAGE(bufoff, gbase, voff) do { PG8_GLDS((voff)[0], gbase, (bufoff)); PG8_GLDS((voff)[1], gbase, (bufoff) + 8192); } while (0)
#define PG8_STAGE_A(bufoff, hh, dbase, kbytes, vsel) do { if constexpr (GATHER) { PG8_STAGE(bufoff, (const char*)g.A + (kbytes), (vsel)[hh]); } else { PG8_STAGE_D(bufoff, (dbase) + ((hh) ? hstepA : 0), voffA0, dA); } } while (0)
#define PG8_GATHER_OFF(dst, un) do { int R_, C_; stage_rc(tid * 16, R_, C_); _Pragma("unroll") for (int _h = 0; _h < 2; ++_h) _Pragma("unroll") for (int _i = 0; _i < 2; ++_i) \
        (dst)[_h][_i] = (unsigned)rowtok[(un).pm * BM + _h * HALF + R_ + 64 * _i] * (unsigned)(K * 2) + (unsigned)(C_ * 2); } while (0)
#define PG8_LDA(dst, b, h) do { _Pragma("unroll") for (int m = 0; m < 4; ++m) _Pragma("unroll") for (int k = 0; k < 2; ++k) dst[m][k] = *(const PG8_LAS bf16x8*)(lds + PG8_SA(b, h) + aoff + m * 2048 + k * 1024); } while (0)
#define PG8_LDB(dst, b, h) do { _Pragma("unroll") for (int n = 0; n < 2; ++n) _Pragma("unroll") for (int k = 0; k < 2; ++k) dst[n][k] = *(const PG8_LAS bf16x8*)(lds + PG8_SB(b, h) + boff + n * 2048 + k * 1024); } while (0)
#define PG8_MMA(ai, bj, At, Bt) do { __builtin_amdgcn_s_setprio(1); _Pragma("unroll") for (int m = 0; m < 4; ++m) _Pragma("unroll") for (int n = 0; n < 2; ++n) _Pragma("unroll") for (int k = 0; k < 2; ++k) \
        acc[ai][bj][m][n] = __builtin_amdgcn_mfma_f32_16x16x32_bf16(Bt[n][k], At[m][k], acc[ai][bj][m][n], 0, 0, 0); __builtin_amdgcn_s_setprio(0); } while (0)
#define PG8_CAT8(lo_, hi_) __builtin_shufflevector(lo_, hi_, 0, 1, 2, 3, 4, 5, 6, 7)
#define PG8_LDA8(b, h) do { _Pragma("unroll") for (int m = 0; m < 4; ++m) { const v4i lo_ = *(const PG8_LAS v4i*)(lds + PG8_SA(b, h) + aoff + m * 2048), hi_ = *(const PG8_LAS v4i*)(lds + PG8_SA(b, h) + aoff + m * 2048 + 1024); A8[m] = PG8_CAT8(lo_, hi_); } } while (0)
#define PG8_LDB8(dst, b, h) do { _Pragma("unroll") for (int n = 0; n < 2; ++n) { const v4i lo_ = *(const PG8_LAS v4i*)(lds + PG8_SB(b, h) + boff + n * 2048), hi_ = *(const PG8_LAS v4i*)(lds + PG8_SB(b, h) + boff + n * 2048 + 1024); dst[n] = PG8_CAT8(lo_, hi_); } } while (0)
#define PG8_MMA8(ai, bj, Bt8) do { __builtin_amdgcn_s_setprio(1); _Pragma("unroll") for (int m = 0; m < 4; ++m) _Pragma("unroll") for (int n = 0; n < 2; ++n) \
        acc[ai][bj][m][n] = __builtin_amdgcn_mfma_scale_f32_16x16x128_f8f6f4(Bt8[n], A8[m], acc[ai][bj][m][n], 0, 0, 0, g.sw, 0, g.sx); __builtin_amdgcn_s_setprio(0); } while (0)
#define PG8_LDAX(b, h) do { if constexpr (FP8) { PG8_LDA8(b, h); } else { PG8_LDA(At, b, h); } } while (0)
#define PG8_LDBX(w, b, h) do { if constexpr (FP8) { if (w) { PG8_LDB8(B81, b, h); } else { PG8_LDB8(B80, b, h); } } else { if (w) { PG8_LDB(B1, b, h); } else { PG8_LDB(B0, b, h); } } } while (0)
#define PG8_MMX(ai, bj, w) do { if constexpr (FP8) { if (w) { PG8_MMA8(ai, bj, B81); } else { PG8_MMA8(ai, bj, B80); } } else { if (w) { PG8_MMA(ai, bj, At, B1); } else { PG8_MMA(ai, bj, At, B0); } } } while (0)
#define PG8_WAIT_V(n) asm volatile("s_waitcnt vmcnt(" #n ")" ::: "memory")
#define PG8_WAIT_L(n) asm volatile("s_waitcnt lgkmcnt(" #n ")" ::: "memory")
#define PG8_BAR __builtin_amdgcn_s_barrier()
#define PG8_SCHED __builtin_amdgcn_sched_barrier(0)
    Unit cur, nxt; int ui = 0;
    if (!S.next(0, cur)) return;
    f32x4 acc[2][2][4][2];
#pragma unroll
    for (int a = 0; a < 2; ++a)
#pragma unroll
        for (int b = 0; b < 2; ++b)
#pragma unroll
            for (int m = 0; m < 4; ++m)
#pragma unroll
                for (int n = 0; n < 2; ++n) acc[a][b][m][n] = (f32x4){0.f, 0.f, 0.f, 0.f};
    bf16x8 At[4][2], B0[2][2], B1[2][2]; v8i A8[4], B80[2], B81[2];
    const char* cA = GATHER ? (const char*)g.A : S.aptr(g, cur, tstep); const char* cB = S.bptr(g, cur, tstep);
    if constexpr (GATHER) { PG8_GATHER_OFF(vAc, cur); }
    PG8_STAGE_D(PG8_SB(0, 0), cB, voffB0, dB); PG8_STAGE_A(PG8_SA(0, 0), 0, cA, 0, vAc); PG8_STAGE_D(PG8_SB(0, 1), cB + hstep, voffB0, dB); PG8_STAGE_A(PG8_SA(0, 1), 1, cA, 0, vAc);
    if (wr == 1) PG8_BAR;
    PG8_WAIT_V(4); PG8_BAR;
    PG8_STAGE_D(PG8_SB(1, 0), cB + kstep, voffB0, dB); PG8_STAGE_A(PG8_SA(1, 0), 0, cA + kstepA, kstep, vAc); PG8_STAGE_D(PG8_SB(1, 1), cB + hstep + kstep, voffB0, dB);
    PG8_WAIT_V(6); PG8_BAR;
    for (;;) {
        const bool has_next = S.next(ui + 1, nxt);
        const char* nA = (has_next && !GATHER) ? S.aptr(g, nxt, tstep) : cA; const char* nB = has_next ? S.bptr(g, nxt, tstep) : cB;
        if constexpr (GATHER) { if (has_next) { PG8_GATHER_OFF(vAn, nxt); } else {
#pragma unroll
            for (int _h = 0; _h < 2; ++_h)
#pragma unroll
                for (int _i = 0; _i < 2; ++_i) vAn[_h][_i] = vAc[_h][_i]; } }
#pragma unroll 1
        for (int t = 0; t < nt; t += 2) {
            const bool last = (t == nt - 2);
            const size_t k1 = (size_t)(t + 1) * kstep, k2 = last ? 0 : (size_t)(t + 2) * kstep, k3 = k2 + kstep;
            const char* a1 = cA + (size_t)(t + 1) * kstepA;
            const char* a2 = last ? nA : cA + (size_t)(t + 2) * kstepA; const char* b2 = last ? nB : cB + (size_t)(t + 2) * kstep;
            const char* a3 = a2 + kstepA; const char* b3 = b2 + kstep;
            PG8_LDBX(0, 0, 0); PG8_SCHED; PG8_LDAX(0, 0); PG8_STAGE_A(PG8_SA(1, 1), 1, a1, k1, vAc);
            if constexpr (GATHER) { if (last) {
#pragma unroll
                for (int _h = 0; _h < 2; ++_h)
#pragma unroll
                    for (int _i = 0; _i < 2; ++_i) vAc[_h][_i] = vAn[_h][_i]; } }
            PG8_WAIT_L(8); PG8_BAR; PG8_WAIT_L(0); PG8_MMX(0, 0, 0); PG8_BAR; PG8_SCHED;
            PG8_LDBX(1, 0, 1); PG8_STAGE_D(PG8_SB(0, 0), b2, voffB0, dB);
            PG8_BAR; PG8_WAIT_L(0); PG8_MMX(0, 1, 1); PG8_BAR;
            PG8_LDAX(0, 1); PG8_STAGE_A(PG8_SA(0, 0), 0, a2, k2, vAc);
            PG8_BAR; PG8_WAIT_L(0); PG8_MMX(1, 0, 0); PG8_BAR; PG8_SCHED;
            PG8_STAGE_D(PG8_SB(0, 1), b2 + hstep, voffB0, dB);
            PG8_WAIT_V(6); PG8_BAR; PG8_MMX(1, 1, 1); PG8_BAR;
            PG8_LDBX(0, 1, 0); PG8_SCHED; PG8_LDAX(1, 0); PG8_STAGE_A(PG8_SA(0, 1), 1, a2, k2, vAc);
            PG8_WAIT_L(8); PG8_BAR; PG8_WAIT_L(0); PG8_MMX(0, 0, 0); PG8_BAR; PG8_SCHED;
            PG8_LDBX(1, 1, 1); PG8_STAGE_D(PG8_SB(1, 0), b3, voffB0, dB);
            PG8_BAR; PG8_WAIT_L(0); PG8_MMX(0, 1, 1); PG8_BAR;
            PG8_LDAX(1, 1); PG8_STAGE_A(PG8_SA(1, 0), 0, a3, k3, vAc);
            PG8_BAR; PG8_WAIT_L(0); PG8_MMX(1, 0, 0); PG8_BAR; PG8_SCHED;
            PG8_STAGE_D(PG8_SB(1, 1), b3 + hstep, voffB0, dB);
            PG8_WAIT_V(6); PG8_BAR; PG8_MMX(1, 1, 1); PG8_BAR;
        }
        E(acc, cur, wr, wc, fr, fq);
        if (!has_next) break;
#pragma unroll
        for (int a = 0; a < 2; ++a)
#pragma unroll
            for (int b = 0; b < 2; ++b)
#pragma unroll
                for (int m = 0; m < 4; ++m)
#pragma unroll
                    for (int n = 0; n < 2; ++n) acc[a][b][m][n] = (f32x4){0.f, 0.f, 0.f, 0.f};
        cur = nxt; cA = nA; cB = nB; ++ui;
        if constexpr (GATHER) {
#pragma unroll
            for (int _h = 0; _h < 2; ++_h)
#pragma unroll
                for (int _i = 0; _i < 2; ++_i) vAc[_h][_i] = vAn[_h][_i]; }
    }
    PG8_WAIT_V(0);
    if (wr == 0) PG8_BAR;
    PG8_BAR;
#undef PG8_SA
#undef PG8_SB
#undef PG8_STAGE
#undef PG8_STAGE_D
#undef PG8_GLDS
#undef PG8_STAGE_A
#undef PG8_GATHER_OFF
#undef PG8_LDA
#undef PG8_LDB
#undef PG8_MMA
#undef PG8_MMA8
#undef PG8_LDA8
#undef PG8_LDB8
#undef PG8_LDAX
#undef PG8_LDBX
#undef PG8_MMX
#undef PG8_CAT8
#undef PG8_WAIT_V
#undef PG8_WAIT_L
#undef PG8_BAR
#undef PG8_SCHED
}
}

struct Args {
    const float* in[29];
    float* out; unsigned char* ws;
    int ph_lo, ph_hi;
    int wv, zero_;
};
enum { I_X = 0, I_MEM, I_NMIXG, I_NMEMG, I_WIN, I_WMK, I_WMV, I_CONVW, I_CONVB, I_CLNG, I_CLNB, I_SHIFTMU, I_DW0, I_DUP, I_IA0, I_IUP, I_GUP, I_KK, I_KA, I_RK,
       I_LNXG, I_LNXB, I_WOUT, I_NFFNG, I_WROUTER, I_WEG, I_WEU, I_WED, I_FNG };

template <bool F8 = false>
__device__ __forceinline__ void transpose_item(const float* W, int N, bf16_t* WT, int K, int k0, int n0, int drow0, LAS float* scr, int lane) {
    {
        f32x4 v[8];
#pragma unroll
        for (int i = 0; i < 8; ++i) v[i] = *(const f32x4*)(W + (size_t)(k0 + 8 * i + (lane >> 3)) * N + n0 + 4 * (lane & 7));
#pragma unroll
        for (int i = 0; i < 8; ++i) { LAS float* d = scr + (8 * i + (lane >> 3)) * 33 + 4 * (lane & 7); d[0] = v[i].x; d[1] = v[i].y; d[2] = v[i].z; d[3] = v[i].w; }
    }
    asm volatile("s_waitcnt lgkmcnt(0)" ::: "memory");
    const int c = lane & 7;
#pragma unroll
    for (int j = 0; j < 4; ++j) { const int n = (lane >> 3) + 8 * j; const LAS float* s = scr + (8 * c) * 33 + n;
        if constexpr (F8) { *(u32x2*)((unsigned char*)WT + (size_t)(drow0 + n) * K + k0 + 8 * c) = (u32x2){pk_fp8x4(32.f * s[0 * 33], 32.f * s[1 * 33], 32.f * s[2 * 33], 32.f * s[3 * 33]), pk_fp8x4(32.f * s[4 * 33], 32.f * s[5 * 33], 32.f * s[6 * 33], 32.f * s[7 * 33])}; }
        else { u32x4 o; o.x = pk_bf16(s[0 * 33], s[1 * 33]); o.y = pk_bf16(s[2 * 33], s[3 * 33]); o.z = pk_bf16(s[4 * 33], s[5 * 33]); o.w = pk_bf16(s[6 * 33], s[7 * 33]);
            *(u32x4*)(WT + (size_t)(drow0 + n) * K + k0 + 8 * c) = o; } }
    asm volatile("s_waitcnt lgkmcnt(0)" ::: "memory");
}
__device__ __forceinline__ void expert_prep_items(const Args& a, LAS unsigned char* lds, int widx, int nw, int it_lo, int it_hi) {
    int tid = tid_of(a.wv); asm volatile("" : "+v"(tid)); const int lane = tid & 63, wave = __builtin_amdgcn_readfirstlane(tid >> 6);
    LAS float* scr = (LAS float*)(lds + wave * 16384);
    unsigned char* ws = a.ws;
    constexpr int S_EXP = 16 * 16 * 32;
    for (int r = it_lo + widx; r < it_hi; r += nw) {
        const int which = r / S_EXP, q = r % S_EXP, e = q / 512, kb = (q % 512) / 32, nb = q % 32, n0 = nb * 32;
        if (which == 0) transpose_item<true>(a.in[I_WEG] + (size_t)e * D * FF, FF, (bf16_t*)(ws + WS_WGUT + (size_t)e * 2048 * D), D, kb * 64, n0, (n0 >> 7) * 256 + (n0 & 127), scr, lane);
        else if (which == 1) transpose_item<true>(a.in[I_WEU] + (size_t)e * D * FF, FF, (bf16_t*)(ws + WS_WGUT + (size_t)e * 2048 * D), D, kb * 64, n0, (n0 >> 7) * 256 + 128 + (n0 & 127), scr, lane);
        else transpose_item<true>(a.in[I_WED] + (size_t)e * FF * D, D, (bf16_t*)(ws + WS_WDT + (size_t)e * D * FF), FF, kb * 64, n0, n0, scr, lane);
    }
}

__device__ __forceinline__ void rms_row_to_bf16(const float* xrow, const float* g, bf16_t* orow, int lane) {
    const f32x4* xr = (const f32x4*)xrow + lane; const f32x4* gr = (const f32x4*)g + lane;
    f32x4 v[4]; float s = 0.f;
#pragma unroll
    for (int j = 0; j < 4; ++j) { v[j] = xr[64 * j]; s += (v[j].x * v[j].x + v[j].y * v[j].y) + (v[j].z * v[j].z + v[j].w * v[j].w); }
    const float rs = 1.0f / sqrtf(wave_sum(s) * (1.f / D) + 1e-6f);
    u32x2* o8 = (u32x2*)orow + lane;
#pragma unroll
    for (int j = 0; j < 4; ++j) { const f32x4 gg = gr[64 * j]; u32x2 w; w.x = pk_bf16(v[j].x * rs * gg.x, v[j].y * rs * gg.y); w.y = pk_bf16(v[j].z * rs * gg.z, v[j].w * rs * gg.w); o8[64 * j] = w; }
}
__device__ __forceinline__ void phase_prep(const Args& a, LAS unsigned char* lds, int G) {
    int tid = tid_of(a.wv); asm volatile("" : "+v"(tid)); const int lane = tid & 63, wave = __builtin_amdgcn_readfirstlane(tid >> 6);
    LAS float* scr = (LAS float*)(lds + wave * 16384);
    const int gw = blockIdx.x * 8 + wave, NGW = G * 8;
    unsigned char* ws = a.ws;
    constexpr int S_WIN = 16 * 80, S_WOUT = 16 * 32, S_MK = 16 * 8, S_SM = 12, S_GUP = 24;
    constexpr int NITEMS = S_WIN + S_WOUT + 2 * S_MK + 4 * S_SM + S_GUP;
    for (int it = gw; it < NITEMS; it += NGW) {
        int r = it;
        if (r < S_WIN) { const int kb = r / 80, nb = r % 80; transpose_item(a.in[I_WIN], IN_PROJ, (bf16_t*)(ws + WS_WINT), D, kb * 64, nb * 32, nb * 32, scr, lane); continue; } r -= S_WIN;
        if (r < S_WOUT) { const int kb = r / 32, nb = r % 32; transpose_item(a.in[I_WOUT], D, (bf16_t*)(ws + WS_WOUTT), D, kb * 64, nb * 32, nb * 32, scr, lane); continue; } r -= S_WOUT;
        if (r < S_MK) { const int kb = r / 8, nb = r % 8; transpose_item(a.in[I_WMK], 256, (bf16_t*)(ws + WS_WKT), D, kb * 64, nb * 32, nb * 32, scr, lane); continue; } r -= S_MK;
        if (r < S_MK) { const int kb = r / 8, nb = r % 8; transpose_item(a.in[I_WMV], 256, (bf16_t*)(ws + WS_WVT), D, kb * 64, nb * 32, nb * 32, scr, lane); continue; } r -= S_MK;
        if (r < 4 * S_SM) { const int which = r / S_SM, nb = r % S_SM;
            const float* src = (which < 2 ? a.in[I_DUP] : a.in[I_IUP]) + (size_t)(which & 1) * 64 * RW;
            transpose_item(src, RW, (bf16_t*)(ws + WS_SMALL) + (size_t)which * RW * 64, 64, 0, nb * 32, nb * 32, scr, lane); continue; } r -= 4 * S_SM;
        { const int kb = r / 12, nb = r % 12; transpose_item(a.in[I_GUP], RW, (bf16_t*)(ws + WS_SMALL) + (size_t)4 * RW * 64, 128, kb * 64, nb * 32, nb * 32, scr, lane); }
    }
    expert_prep_items(a, lds, gw, NGW, 0, 3 * 8192);
    for (int m = gw; m < T; m += NGW) rms_row_to_bf16(a.in[I_X] + (size_t)m * D, a.in[I_NMIXG], (bf16_t*)(ws + WS_XH) + (size_t)m * D, lane);
    for (int m = gw; m < BATCH * NMEM; m += NGW) rms_row_to_bf16(a.in[I_MEM] + (size_t)m * D, a.in[I_NMEMG], (bf16_t*)(ws + WS_MEMN) + (size_t)m * D, lane);
}

constexpr int AT_KS = 144;
constexpr int AT_VS = 520;
constexpr int AT_VOFF = 256 * AT_KS;
__device__ __forceinline__ bf16x8 pack_step(const f32x16& x, int s) {
    u32x4 p;
    asm volatile("v_cvt_pk_bf16_f32 %0, %4, %5\n\tv_cvt_pk_bf16_f32 %1, %6, %7\n\tv_cvt_pk_bf16_f32 %2, %8, %9\n\tv_cvt_pk_bf16_f32 %3, %10, %11\n\ts_nop 1"
                 : "=&v"(p[0]), "=&v"(p[1]), "=&v"(p[2]), "=&v"(p[3])
                 : "v"(x[8 * s]), "v"(x[8 * s + 1]), "v"(x[8 * s + 2]), "v"(x[8 * s + 3]), "v"(x[8 * s + 4]), "v"(x[8 * s + 5]), "v"(x[8 * s + 6]), "v"(x[8 * s + 7]));
    return __builtin_bit_cast(bf16x8, p);
}
__device__ __forceinline__ void attn_unit(const Args& a, LAS unsigned char* lds, int unit) {
    int tid = tid_of(a.wv); asm volatile("" : "+v"(tid)); const int lane = tid & 63, wave = __builtin_amdgcn_readfirstlane(tid >> 6), r = lane & 31, h = lane >> 5;
    const int b = unit >> 2, hh = unit & 3;
    const bf16_t* Qb = (const bf16_t*)(a.ws + WS_Q); const bf16_t* KM = (const bf16_t*)(a.ws + WS_KMEM); const bf16_t* VT = (const bf16_t*)(a.ws + WS_VT);
    bf16_t* MIX = (bf16_t*)(a.ws + WS_MIX);
    __syncthreads();
#pragma unroll
    for (int i = 0; i < 4; ++i) { const int c = tid + 512 * i, key = c >> 3, ch = c & 7;
        const u32x4 v = *(const u32x4*)(KM + (size_t)(b * NMEM + key) * 256 + hh * 64 + ch * 8);
        *(LAS u32x4*)(lds + key * AT_KS + ch * 16) = v; }
#pragma unroll
    for (int i = 0; i < 4; ++i) { const int c = tid + 512 * i, d = c >> 5, ch = c & 31;
        const u32x4 v = *(const u32x4*)(VT + (size_t)(hh * 64 + d) * (BATCH * NMEM) + b * NMEM + ch * 8);
        LAS u32x2* dst = (LAS u32x2*)(lds + AT_VOFF + d * AT_VS + ch * 16);
        dst[0] = (u32x2){v.x, v.y}; dst[1] = (u32x2){v.z, v.w}; }
    __syncthreads();
#pragma unroll 1
    for (int tile = 0; tile < 16; ++tile) {
    const int tok0 = b * SEQ + tile * 256 + wave * 32;
    bf16x8 qf[4];
#pragma unroll
    for (int ks = 0; ks < 4; ++ks) qf[ks] = *(const bf16x8*)(Qb + (size_t)(tok0 + r) * 256 + hh * 64 + ks * 16 + h * 8);
    const float sc = 0.125f * 1.4426950408889634f;
    float m_run = -3.0e38f, sum = 0.f;
    f32x16 o[2];
#pragma unroll
    for (int dt = 0; dt < 2; ++dt)
#pragma unroll
        for (int i = 0; i < 16; ++i) o[dt][i] = 0.f;
#pragma unroll 1
    for (int kh = 0; kh < 2; ++kh) {
        f32x16 s[4];
#pragma unroll
        for (int k4 = 0; k4 < 4; ++k4) {
#pragma unroll
            for (int i = 0; i < 16; ++i) s[k4][i] = 0.f;
#pragma unroll
            for (int ks = 0; ks < 4; ++ks) { const bf16x8 ka = *(const LAS bf16x8*)(lds + ((kh * 4 + k4) * 32 + r) * AT_KS + (ks * 16 + h * 8) * 2);
                s[k4] = __builtin_amdgcn_mfma_f32_32x32x16_bf16(ka, qf[ks], s[k4], 0, 0, 0); }
        }
        float mx = m_run;
#pragma unroll
        for (int k4 = 0; k4 < 4; ++k4)
#pragma unroll
            for (int i = 0; i < 16; ++i) mx = fmaxf(mx, s[k4][i]);
        mx = fmaxf(mx, __shfl_xor(mx, 32));
        const float alpha = __builtin_amdgcn_exp2f((m_run - mx) * sc);
        float ps = 0.f;
#pragma unroll
        for (int k4 = 0; k4 < 4; ++k4)
#pragma unroll
            for (int i = 0; i < 16; ++i) { const float e = __builtin_amdgcn_exp2f((s[k4][i] - mx) * sc); s[k4][i] = e; ps += e; }
        ps += __shfl_xor(ps, 32);
        sum = sum * alpha + ps; m_run = mx;
#pragma unroll
        for (int dt = 0; dt < 2; ++dt)
#pragma unroll
            for (int i = 0; i < 16; ++i) o[dt][i] *= alpha;
#pragma unroll
        for (int k4 = 0; k4 < 4; ++k4)
#pragma unroll
            for (int s2 = 0; s2 < 2; ++s2) {
                const bf16x8 pb = pack_step(s[k4], s2);
#pragma unroll
                for (int dt = 0; dt < 2; ++dt) {
                    const LAS unsigned char* vp = lds + AT_VOFF + (32 * dt + r) * AT_VS + (32 * (kh * 4 + k4) + 16 * s2 + 4 * h) * 2;
                    const s16x4 lo = *(const LAS s16x4*)vp, hi = *(const LAS s16x4*)(vp + 16);
                    const bf16x8 va = __builtin_shufflevector(lo, hi, 0, 1, 2, 3, 4, 5, 6, 7);
                    o[dt] = __builtin_amdgcn_mfma_f32_32x32x16_bf16(va, pb, o[dt], 0, 0, 0);
                }
            }
    }
    const float inv = 1.0f / sum;
    bf16_t* orow = MIX + (size_t)(tok0 + r) * D + hh * 64;
#pragma unroll
    for (int dt = 0; dt < 2; ++dt)
#pragma unroll
        for (int gq = 0; gq < 4; ++gq) { u32x2 w; w.x = pk_bf16(o[dt][4 * gq] * inv, o[dt][4 * gq + 1] * inv); w.y = pk_bf16(o[dt][4 * gq + 2] * inv, o[dt][4 * gq + 3] * inv);
            *(u32x2*)(orow + 32 * dt + 8 * gq + 4 * h) = w; }
    }
}

__device__ __forceinline__ void conv_unit(const Args& a, LAS unsigned char* lds, int unit) {
    int tid = tid_of(a.wv); asm volatile("" : "+v"(tid)); const int lane = tid & 63, wave = __builtin_amdgcn_readfirstlane(tid >> 6);
    const int b = unit >> 6, t0 = (unit & 63) * 64;
    const bf16_t* P = (const bf16_t*)(a.ws + WS_P); bf16_t* MIX = (bf16_t*)(a.ws + WS_MIX);
    LAS _Float16* U = (LAS _Float16*)lds;
    LAS _Float16* Cc = (LAS _Float16*)(lds + 94 * CW * 2);
    __syncthreads();
#pragma unroll 1
    for (int q0 = tid; q0 < 94 * 48; q0 += 3 * NTHREADS) {
        u32x4 vvv[3], ggg[3];
#pragma unroll
        for (int u3 = 0; u3 < 3; ++u3) { const int q = q0 + u3 * NTHREADS, j = q / 48, cc = (q % 48) * 8, s = t0 - 15 + j; const bool ok = (q < 94 * 48) && s >= 0 && s < SEQ;
            const bf16_t* row = P + (size_t)(b * SEQ + (ok ? s : 0)) * PLD + cc;
            vvv[u3] = ok ? *(const u32x4*)row : (u32x4){0u, 0u, 0u, 0u}; ggg[u3] = ok ? *(const u32x4*)(row + CW) : (u32x4){0u, 0u, 0u, 0u}; }
#pragma unroll
        for (int u3 = 0; u3 < 3; ++u3) { const int q = q0 + u3 * NTHREADS, j = q / 48, cc = (q % 48) * 8;
            if (q < 94 * 48) {
                const unsigned vw[4] = {vvv[u3].x, vvv[u3].y, vvv[u3].z, vvv[u3].w}, gw[4] = {ggg[u3].x, ggg[u3].y, ggg[u3].z, ggg[u3].w};
                float u[8];
#pragma unroll
                for (int k = 0; k < 4; ++k) { u[2 * k] = bf_lo(vw[k]) * sigmoidf_fast(bf_lo(gw[k])); u[2 * k + 1] = bf_hi(vw[k]) * sigmoidf_fast(bf_hi(gw[k])); }
                LAS f16x4* dst = (LAS f16x4*)(U + j * CW + cc); dst[0] = (f16x4){(_Float16)u[0], (_Float16)u[1], (_Float16)u[2], (_Float16)u[3]}; dst[1] = (f16x4){(_Float16)u[4], (_Float16)u[5], (_Float16)u[6], (_Float16)u[7]}; }
        }
    }
    __syncthreads();
    const int cq = tid & 127, tq = tid >> 7;
#pragma unroll 1
    for (int k3 = 0; k3 < 3; ++k3) { const int c = cq + 128 * k3;
        float w[31], res[16];
#pragma unroll
        for (int kk = 0; kk < 31; ++kk) w[kk] = a.in[I_CONVW][kk * CW + c];
        const float bias = a.in[I_CONVB][c];
#pragma unroll
        for (int tt = 0; tt < 16; ++tt) res[tt] = bias;
#pragma unroll
        for (int jj = 0; jj < 46; ++jj) { const float uv = (float)U[(tq * 16 + jj) * CW + c];
#pragma unroll
            for (int tt = 0; tt < 16; ++tt) { if (jj - tt >= 0 && jj - tt <= 30) res[tt] += uv * w[jj - tt]; } }
#pragma unroll
        for (int tt = 0; tt < 16; ++tt) Cc[(tq * 16 + tt) * CW + c] = (_Float16)res[tt];
    }
    __syncthreads();
    for (int tt = 0; tt < 8; ++tt) { const int t = wave * 8 + tt;
        float v[6]; float s = 0.f;
#pragma unroll
        for (int i = 0; i < 6; ++i) { v[i] = (float)Cc[t * CW + lane + 64 * i]; s += v[i]; }
        const float mean = wave_sum(s) * (1.f / CW); float q = 0.f;
#pragma unroll
        for (int i = 0; i < 6; ++i) { v[i] -= mean; q += v[i] * v[i]; }
        const float rstd = 1.0f / sqrtf(wave_sum(q) * (1.f / CW) + 1e-5f);
        bf16_t* orow = MIX + (size_t)(b * SEQ + t0 + t) * D + 256;
#pragma unroll
        for (int i = 0; i < 6; ++i) { const int c = lane + 64 * i; const float y = v[i] * rstd * a.in[I_CLNG][c] + a.in[I_CLNB][c]; const float o = y * sigmoidf_fast(y);
            orow[c] = (bf16_t)(pk_bf16(o, 0.f) & 0xffffu); }
    }
}

constexpr int PR_AS = 784;
constexpr int PR_RK = 64 * PR_AS;
constexpr int PR_RKS = 1536;
constexpr int PR_RN = PR_RK + 64 * PR_RKS;
constexpr int PR_CST = PR_RN + 2048;
static_assert(PR_CST + 7 * 384 * 4 <= LDS_BYTES - 64, "prep LDS map");
template <int V> struct IC { static constexpr int value = V; };
template <int CTRL> __device__ __forceinline__ f32x4 dpp4(f32x4 x) { return (f32x4){dpp_f<CTRL>(x.x), dpp_f<CTRL>(x.y), dpp_f<CTRL>(x.z), dpp_f<CTRL>(x.w)}; }
__device__ __forceinline__ void prep_unit(const Args& a, LAS unsigned char* lds, int unit) {
    int tid = tid_of(a.wv); asm volatile("" : "+v"(tid)); const int lane = tid & 63, wave = __builtin_amdgcn_readfirstlane(tid >> 6);
    const int b = unit >> 6, t0 = (unit & 63) * 64;
    const bf16_t* __restrict__ P = (const bf16_t*)(a.ws + WS_P);
    const float* __restrict__ mu = a.in[I_SHIFTMU];
    LAS float* RNs = (LAS float*)(lds + PR_RN); LAS float* CST = (LAS float*)(lds + PR_CST);
    __syncthreads();
    for (int i = tid; i < 7 * 384; i += NTHREADS) { const int w7 = i / 384, c7 = i % 384;
        CST[i] = (w7 == 0) ? a.in[I_KK][c7] : (w7 == 1) ? a.in[I_KA][c7] : (w7 == 2) ? a.in[I_RK][c7] : (w7 < 5) ? a.in[I_DW0][(w7 - 3) * RW + c7] : a.in[I_IA0][(w7 - 5) * RW + c7]; }
#ifndef PREP_REP1
#define PREP_REP1 1
#endif
    auto s1_batch = [&](auto tyc) {
        constexpr int ty = decltype(tyc)::value;
        u32x4 cuv[6], pvv[6], nvv[6]; int ttv[6], c8v[6];
#pragma unroll
        for (int u = 0; u < 6; ++u) { int tt, c8;
            if (ty < 3) { const int q = tid + u * NTHREADS; tt = q / 48; c8 = ty * 384 + (q % 48) * 8; }
            else { const int q = tid + (u & 1) * NTHREADS; tt = q >> 4; c8 = 1152 + (u >> 1) * 128 + (q & 15) * 8; }
            ttv[u] = tt; c8v[u] = c8; const int sq = t0 + tt;
            const bf16_t* row = P + ((size_t)b * SEQ + sq) * PLD + 768 + c8;
            cuv[u] = *(const u32x4*)row;
            pvv[u] = (sq > 0) ? *(const u32x4*)(row - PLD) : (u32x4){0u, 0u, 0u, 0u};
            nvv[u] = (sq < SEQ - 1) ? *(const u32x4*)(row + PLD) : (u32x4){0u, 0u, 0u, 0u}; }
#pragma unroll
        for (int u = 0; u < 6; ++u) { const int tt = ttv[u], c8 = c8v[u]; const size_t tok = (size_t)b * SEQ + t0 + tt;
            const u32x4 cu = cuv[u], pv = pvv[u], nv = nvv[u];
            const unsigned cw[4] = {cu.x, cu.y, cu.z, cu.w}, pw[4] = {pv.x, pv.y, pv.z, pv.w}, nw[4] = {nv.x, nv.y, nv.z, nv.w};
            const f32x4 m0a = *(const f32x4*)(mu + c8), m0b = *(const f32x4*)(mu + c8 + 4), m1a = *(const f32x4*)(mu + 1536 + c8), m1b = *(const f32x4*)(mu + 1536 + c8 + 4);
            const float m0[8] = {m0a.x, m0a.y, m0a.z, m0a.w, m0b.x, m0b.y, m0b.z, m0b.w}, m1[8] = {m1a.x, m1a.y, m1a.z, m1a.w, m1b.x, m1b.y, m1b.z, m1b.w};
            float pf[8];
#pragma unroll
            for (int k = 0; k < 4; ++k) { const float c0 = bf_lo(cw[k]), c1 = bf_hi(cw[k]);
                pf[2 * k] = c0 + m0[2 * k] * (bf_lo(pw[k]) - c0) + m1[2 * k] * (bf_lo(nw[k]) - c0);
                pf[2 * k + 1] = c1 + m0[2 * k + 1] * (bf_hi(pw[k]) - c1) + m1[2 * k + 1] * (bf_hi(nw[k]) - c1); }
            if (ty < 2) {
                f16x4 h0 = {(_Float16)pf[0], (_Float16)pf[1], (_Float16)pf[2], (_Float16)pf[3]}, h1 = {(_Float16)pf[4], (_Float16)pf[5], (_Float16)pf[6], (_Float16)pf[7]};
                LAS f16x4* dst = (LAS f16x4*)(lds + PR_RK + tt * PR_RKS + c8 * 2); dst[0] = h0; dst[1] = h1;
                if (ty == 1) { const f32x4 ka = *(const f32x4*)(a.in[I_KK] + c8 - 384), kb = *(const f32x4*)(a.in[I_KK] + c8 - 384 + 4);
                    float ssq = (pf[0] * ka.x) * (pf[0] * ka.x) + (pf[1] * ka.y) * (pf[1] * ka.y) + (pf[2] * ka.z) * (pf[2] * ka.z) + (pf[3] * ka.w) * (pf[3] * ka.w)
                              + (pf[4] * kb.x) * (pf[4] * kb.x) + (pf[5] * kb.y) * (pf[5] * kb.y) + (pf[6] * kb.z) * (pf[6] * kb.z) + (pf[7] * kb.w) * (pf[7] * kb.w);
                    ssq = sum8(ssq);
                    if ((lane & 7) == 0) RNs[tt * 8 + ((c8 - 384) >> 6)] = __builtin_amdgcn_rsqf(ssq + 1e-12f); }
            } else if (ty == 2) {
                u32x4 w; w.x = pk_bf16(pf[0], pf[1]); w.y = pk_bf16(pf[2], pf[3]); w.z = pk_bf16(pf[4], pf[5]); w.w = pk_bf16(pf[6], pf[7]);
                *(u32x4*)((bf16_t*)scan_arr(a.ws, 0) + hat_off(0, tok, c8 - 768)) = w;
            } else {
                const int cc = c8 - 1152;
#pragma unroll
                for (int k = 0; k < 8; ++k) { if ((u >> 1) == 0) pf[k] = 1.0f - 2.0f * __builtin_amdgcn_rcpf(1.0f + __builtin_amdgcn_exp2f(2.8853900817779268f * pf[k])); else if ((u >> 1) == 2) pf[k] = sigmoidf_fast(pf[k]); }
                u32x4 w; w.x = pk_bf16(pf[0], pf[1]); w.y = pk_bf16(pf[2], pf[3]); w.z = pk_bf16(pf[4], pf[5]); w.w = pk_bf16(pf[6], pf[7]);
                *(LAS u32x4*)(lds + tt * PR_AS + cc * 2) = w; }
        }
    };
#pragma unroll 1
    for (int rp1 = 0; rp1 < PREP_REP1; ++rp1) { s1_batch(IC<0>{}); s1_batch(IC<1>{}); s1_batch(IC<2>{}); s1_batch(IC<3>{}); }
    __syncthreads();
    const int l15 = lane & 15, kq = lane >> 4;
    float* __restrict__ PCg = (float*)(a.ws + WS_PC); float* __restrict__ BON = (float*)(a.ws + WS_BON);
    const char* SMb = (const char*)(a.ws + WS_SMALL);
    const unsigned wlo64 = (unsigned)(((8 * (l15 >> 2) + (l15 & 3)) * 64 + kq * 8) * 2), wlo128 = (unsigned)(((8 * (l15 >> 2) + (l15 & 3)) * 128 + kq * 8) * 2);
    const unsigned hlo = (unsigned)((l15 * 64 + 8 * kq) * 2), klo = (unsigned)((l15 * D + 8 * kq) * 2), glo = (unsigned)((l15 * RW + 8 * kq) * 2);
    bf16x8 Fc[16], Fn[16];
#define PREP_LOADW(hd_, kind_) do { \
        if ((kind_) < 2) { const char* w_ = SMb + ((size_t)(kind_) * RW * 64 + (size_t)(hd_) * 64 * 64) * 2; \
            _Pragma("unroll") for (int f_ = 0; f_ < 16; ++f_) Fn[f_] = *(const bf16x8*)(w_ + (size_t)(((f_ >> 2) & 1) * (2 * RW * 64 * 2) + (32 * ((f_ & 3) >> 1) + 4 * (f_ & 1)) * 128 + (f_ >> 3) * 64) + wlo64); } \
        else { const char* w_ = SMb + ((size_t)4 * RW * 64 + (size_t)(hd_) * 64 * 128) * 2; \
            _Pragma("unroll") for (int f_ = 0; f_ < 16; ++f_) Fn[f_] = *(const bf16x8*)(w_ + (size_t)((32 * ((f_ & 3) >> 1) + 4 * (f_ & 1)) * 256 + (f_ >> 2) * 64) + wlo128); } } while (0)
    auto dir_stage = [&](auto dc, const int it, const int nhd, const int nkind) {
        constexpr int d = decltype(dc)::value;
        const int hd = it >> 2, mt = it & 3, tokl = mt * 16 + l15; const size_t tb = (size_t)b * SEQ + t0 + mt * 16;
#pragma unroll
        for (int f = 0; f < 16; ++f) Fc[f] = Fn[f];
        f32x4 accW[4], accA[4];
#pragma unroll
        for (int nt = 0; nt < 4; ++nt) { accW[nt] = (f32x4){0.f, 0.f, 0.f, 0.f}; accA[nt] = (f32x4){0.f, 0.f, 0.f, 0.f}; }
#pragma unroll
        for (int ks = 0; ks < 2; ++ks) {
            const bf16x8 aw = *(const LAS bf16x8*)(lds + tokl * PR_AS + (d * 64 + ks * 32 + kq * 8) * 2), aa = *(const LAS bf16x8*)(lds + tokl * PR_AS + ((2 + d) * 64 + ks * 32 + kq * 8) * 2);
#pragma unroll
            for (int nt = 0; nt < 4; ++nt) { accW[nt] = MFMA16(Fc[ks * 8 + nt], aw, accW[nt]); accA[nt] = MFMA16(Fc[ks * 8 + 4 + nt], aa, accA[nt]); }
        }
        if (nkind >= 0) PREP_LOADW(nhd, nkind);
        const float rn = RNs[tokl * 8 + hd];
        const size_t tile_b = ((((tb >> 4) * NH + hd) << 10)) * 2;
        char* AHb = (char*)scan_arr(a.ws, 1 + 4 * d) + tile_b; char* RHb = (char*)scan_arr(a.ws, 2 + 4 * d) + tile_b; char* BHb = (char*)scan_arr(a.ws, 3 + 4 * d) + tile_b;
        char* KHb = d ? (char*)scan_arr(a.ws, 8) + (tb * D + hd * 64) * 2 : (char*)scan_arr(a.ws, 4) + tile_b; const unsigned khlo = d ? klo : hlo;
        char* PCb = (char*)(PCg + ((size_t)d * (T / 16) + (tb >> 4)) * RW + hd * 64); char* BOb = (char*)(BON + (size_t)d * T * NH + tb * NH + hd);
        float bsum = 0.f;
        u32x2 hA[2], hR[2], hB[2], hK[2]; f32x4 PtS[4];
#pragma unroll
        for (int nt = 0; nt < 4; ++nt) { const int ch = hd * 64 + 32 * (nt >> 1) + 8 * kq + 4 * (nt & 1);
            const f32x4 bW = *(const LAS f32x4*)(CST + (3 + d) * 384 + ch), bA = *(const LAS f32x4*)(CST + (5 + d) * 384 + ch);
            const f32x4 kkw = *(const LAS f32x4*)(CST + ch), kaw = *(const LAS f32x4*)(CST + 384 + ch), rkw = *(const LAS f32x4*)(CST + 768 + ch);
            const f32x4 zw = accW[nt] + bW, za = accA[nt] + bA;
            f32x4 lw, av;
#pragma unroll
            for (int e = 0; e < 4; ++e) { lw[e] = -0.606531f * 1.4426950408889634f * sigmoidf_fast(zw[e]); av[e] = sigmoidf_fast(za[e]); }
            f32x4 cum = lw;
            if (d == 0) { cum += dpp4<0x111>(cum); cum += dpp4<0x112>(cum); cum += dpp4<0x114>(cum); cum += dpp4<0x118>(cum); }
            else        { cum += dpp4<0x101>(cum); cum += dpp4<0x102>(cum); cum += dpp4<0x104>(cum); cum += dpp4<0x108>(cum); }
            f32x4 Pt, Pinv, Pprev;
#pragma unroll
            for (int e = 0; e < 4; ++e) { Pt[e] = __builtin_amdgcn_exp2f(cum[e]); Pinv[e] = __builtin_amdgcn_rcpf(Pt[e]);
                Pprev[e] = __builtin_amdgcn_exp2f(cum[e] - lw[e]); }
            PtS[nt] = Pt;
            const f32x4 r4 = __builtin_convertvector(*(const LAS f16x4*)(lds + PR_RK + tokl * PR_RKS + ch * 2), f32x4);
            const f32x4 k4 = __builtin_convertvector(*(const LAS f16x4*)(lds + PR_RK + tokl * PR_RKS + (384 + ch) * 2), f32x4);
            const f32x4 kk = k4 * kkw * rn, kd = k4 * (1.0f + (av - 1.0f) * kaw);
            hA[nt & 1] = f32_to_bf4(-kk * Pprev); hR[nt & 1] = f32_to_bf4(r4 * Pt); hB[nt & 1] = f32_to_bf4(kk * av * Pinv); hK[nt & 1] = f32_to_bf4(kd * Pinv);
            const f32x4 bt = r4 * kd * rkw; bsum += (bt.x + bt.y) + (bt.z + bt.w);
            if (nt & 1) { const int pr = nt >> 1;
                *(u32x4*)(AHb + (hlo + 64 * pr)) = (u32x4){hA[0].x, hA[0].y, hA[1].x, hA[1].y}; *(u32x4*)(RHb + (hlo + 64 * pr)) = (u32x4){hR[0].x, hR[0].y, hR[1].x, hR[1].y};
                *(u32x4*)(BHb + (hlo + 64 * pr)) = (u32x4){hB[0].x, hB[0].y, hB[1].x, hB[1].y}; *(u32x4*)(KHb + (khlo + 64 * pr)) = (u32x4){hK[0].x, hK[0].y, hK[1].x, hK[1].y}; }
        }
        if (l15 == (d ? 0 : 15)) {
#pragma unroll
            for (int nt = 0; nt < 4; ++nt) *(f32x4*)(PCb + (unsigned)(8 * kq * 4) + (32 * (nt >> 1) + 4 * (nt & 1)) * 4) = PtS[nt]; }
        bsum += __shfl_xor(bsum, 16); bsum += __shfl_xor(bsum, 32);
        if (kq == 0) *(float*)(BOb + (unsigned)(l15 * NH * 4)) = bsum;
    };
    auto gate_stage = [&](const int it, const int nhd, const int nkind) {
        const int hd = it >> 2, mt = it & 3, tokl = mt * 16 + l15; const size_t tb = (size_t)b * SEQ + t0 + mt * 16;
#pragma unroll
        for (int f = 0; f < 16; ++f) Fc[f] = Fn[f];
        f32x4 acc[4];
#pragma unroll
        for (int nt = 0; nt < 4; ++nt) acc[nt] = (f32x4){0.f, 0.f, 0.f, 0.f};
#pragma unroll
        for (int ks = 0; ks < 4; ++ks) { const bf16x8 afr = *(const LAS bf16x8*)(lds + tokl * PR_AS + (256 + ks * 32 + kq * 8) * 2);
#pragma unroll
            for (int nt = 0; nt < 4; ++nt) acc[nt] = MFMA16(Fc[ks * 4 + nt], afr, acc[nt]); }
        if (nkind >= 0) PREP_LOADW(nhd, nkind);
        char* Gb = (char*)((bf16_t*)(a.ws + WS_G) + tb * RW + hd * 64);
#pragma unroll
        for (int pr = 0; pr < 2; ++pr) { const u32x2 g0 = f32_to_bf4(acc[2 * pr]), g1 = f32_to_bf4(acc[2 * pr + 1]);
            *(u32x4*)(Gb + (glo + 64 * pr)) = (u32x4){g0.x, g0.y, g1.x, g1.y}; }
    };
    PREP_LOADW(wave >> 2, 0);
#pragma unroll 1
    for (int k3 = 0; k3 < 3; ++k3) { const int it = wave + 8 * k3, hd = it >> 2;
        dir_stage(IC<0>{}, it, hd, 1);
        dir_stage(IC<1>{}, it, hd, 2);
        gate_stage(it, (it + 8) >> 2, k3 < 2 ? 0 : -1);
    }
#undef PREP_LOADW
}

__device__ __forceinline__ void glds16_asm(const void* gptr, LAS unsigned char* ldst) {
    const unsigned la = __builtin_amdgcn_readfirstlane((unsigned)(size_t)ldst);
    asm volatile("s_mov_b32 m0, %1\n\ts_nop 0\n\tglobal_load_lds_dwordx4 %0, off" :: "v"(gptr), "s"(la) : "m0", "memory");
}
constexpr int CK = 16, NCHUNK = SEQ / CK, CS_NS = 8, CS_NPROD = 6, CS_NCONS = 2;
constexpr int SL_ATIL = 0, SL_RTIL = 2048, SL_BH = 4096, SL_KH = 6144, SL_V = 8192, SL_ULOC = 10240, SL_YLOC = 12288, SL_PC = 14336, SL_BYTES = 14592;
constexpr int PS_AH = 0, PS_RH = 2048, PS_BYTES = 4096;
constexpr int CS_PS_OFF = CS_NS * SL_BYTES, CS_FLAG_OFF = CS_PS_OFF + CS_NPROD * PS_BYTES;
static_assert(CS_FLAG_OFF + 64 <= LDS_BYTES - 64, "chunked scan LDS map");
__device__ __forceinline__ int swz(int t, int j) { return t * 128 + ((((j >> 3) ^ (t & 7))) << 4) + ((j & 4) << 1); }
__device__ __forceinline__ void scan_chunked_unit(const Args& a, LAS unsigned char* lds, int unit) {
    int tid = tid_of(a.wv); asm volatile("" : "+v"(tid)); const int lane = tid & 63, wave = __builtin_amdgcn_readfirstlane(tid >> 6);
    const int dir = unit & 1, bh = unit >> 1, b = bh / NH, hd = bh % NH;
    const int c16 = lane & 15, q = lane >> 4, qp = c16 >> 2, pp = c16 & 3;
    volatile LAS unsigned* FULL = (volatile LAS unsigned*)(lds + CS_FLAG_OFF);
    volatile LAS unsigned* DONE = FULL + 8;
    float* Yg = (float*)(a.ws + (dir ? WS_YB : WS_YF));
    __syncthreads();
    if (tid < 16) FULL[tid] = 0u;
    __syncthreads();
    if (wave >= CS_NCONS) {
        const int pw = wave - CS_NCONS;
        LAS unsigned char* ps = lds + CS_PS_OFF + pw * PS_BYTES;
        const bf16_t* ARR[5] = {(const bf16_t*)scan_arr(a.ws, 1 + 4 * dir), (const bf16_t*)scan_arr(a.ws, 2 + 4 * dir), (const bf16_t*)scan_arr(a.ws, 3 + 4 * dir), (const bf16_t*)scan_arr(a.ws, 4 + 4 * dir), (const bf16_t*)scan_arr(a.ws, 0)};
        const int AIDX[5] = {1 + 4 * dir, 2 + 4 * dir, 3 + 4 * dir, 4 + 4 * dir, 0};
        const float* PCg = (const float*)(a.ws + WS_PC) + (size_t)dir * (T / 16) * RW + hd * 64 + lane;
        u32x4 pf[10];
#define CS_ISSUE(cc) do { _Pragma("unroll") for (int ar_ = 0; ar_ < 5; ++ar_) _Pragma("unroll") for (int hf_ = 0; hf_ < 2; ++hf_) { \
            const int row_ = hf_ * 8 + (lane >> 3); const int st_ = (cc) * CK + row_; const int t_ = dir ? (SEQ - 1 - st_) : st_; \
            pf[ar_ * 2 + hf_] = *(const u32x4*)(ARR[ar_] + hat_off(AIDX[ar_], (size_t)b * SEQ + t_, hd * 64 + 8 * ((lane & 7) ^ (row_ & 7)))); } } while (0)
#define CS_PCLOAD(cc) PCg[(size_t)((size_t)b * (SEQ / CK) + (dir ? (NCHUNK - 1 - (cc)) : (cc))) * RW]
        CS_ISSUE(pw);
        float pcn = CS_PCLOAD(pw);
#pragma unroll 1
        for (int c = pw; c < NCHUNK; c += CS_NPROD) {
            const int slot = c % CS_NS; LAS unsigned char* sl = lds + slot * SL_BYTES;
            { unsigned sp = 0; const unsigned want = (unsigned)CS_NCONS * (unsigned)(c / CS_NS); while (DONE[slot] < want) { __builtin_amdgcn_s_sleep(1); if (++sp > (1u << 22)) break; } }
            asm volatile("" ::: "memory");
            *(LAS u32x4*)(ps + PS_AH + lane * 16) = pf[0]; *(LAS u32x4*)(ps + PS_AH + 1024 + lane * 16) = pf[1];
            *(LAS u32x4*)(ps + PS_RH + lane * 16) = pf[2]; *(LAS u32x4*)(ps + PS_RH + 1024 + lane * 16) = pf[3];
            *(LAS u32x4*)(sl + SL_BH + lane * 16) = pf[4]; *(LAS u32x4*)(sl + SL_BH + 1024 + lane * 16) = pf[5];
            *(LAS u32x4*)(sl + SL_KH + lane * 16) = pf[6]; *(LAS u32x4*)(sl + SL_KH + 1024 + lane * 16) = pf[7];
            *(LAS u32x4*)(sl + SL_V + lane * 16) = pf[8]; *(LAS u32x4*)(sl + SL_V + 1024 + lane * 16) = pf[9];
            *(LAS float*)(sl + SL_PC + lane * 4) = pcn;
            if (c + CS_NPROD < NCHUNK) { CS_ISSUE(c + CS_NPROD); pcn = CS_PCLOAD(c + CS_NPROD); }
            asm volatile("s_waitcnt lgkmcnt(0)" ::: "memory");
#ifndef PROD_REP
#define PROD_REP 1
#endif
#pragma unroll 1
            for (int rpp = 0; rpp < PROD_REP; ++rpp) {
            bf16x8 AHf[2], BHf[2], KHf[2], RHf[2];
#pragma unroll
            for (int ks = 0; ks < 2; ++ks) { const int o = swz(c16, 32 * ks + 8 * q);
                AHf[ks] = *(const LAS bf16x8*)(ps + PS_AH + o); RHf[ks] = *(const LAS bf16x8*)(ps + PS_RH + o); BHf[ks] = *(const LAS bf16x8*)(sl + SL_BH + o); KHf[ks] = *(const LAS bf16x8*)(sl + SL_KH + o); }
            f32x4 Mab = {0.f, 0.f, 0.f, 0.f}, Mak = Mab, MrbT = Mab, MrkT = Mab, MabT = Mab;
#pragma unroll
            for (int ks = 0; ks < 2; ++ks) { Mab = MFMA16(AHf[ks], BHf[ks], Mab); MabT = MFMA16(BHf[ks], AHf[ks], MabT); Mak = MFMA16(AHf[ks], KHf[ks], Mak); MrbT = MFMA16(BHf[ks], RHf[ks], MrbT); MrkT = MFMA16(KHf[ks], RHf[ks], MrkT); }
#pragma unroll
            for (int r = 0; r < 4; ++r) { const bool lt = c16 < 4 * q + r, gt = 4 * q + r < c16, le = 4 * q + r <= c16;
                Mab[r] = lt ? Mab[r] : 0.f; Mak[r] = lt ? Mak[r] : 0.f; MabT[r] = gt ? MabT[r] : 0.f; MrbT[r] = le ? MrbT[r] : 0.f; MrkT[r] = le ? MrkT[r] : 0.f; }
            const f32x4 z4 = {0.f, 0.f, 0.f, 0.f};
            const bf16x8 fN = frag_lo4(Mab), fNT = frag_lo4(MabT);
            const f32x4 N2 = MFMA16(fNT, fN, z4), N2T = MFMA16(fN, fNT, z4);
            f32x4 PT = MabT;
#pragma unroll
            for (int r = 0; r < 4; ++r) PT[r] += (4 * q + r == c16) ? 1.0f : 0.f;
            const bf16x8 fN2 = frag_lo4(N2), fN2T = frag_lo4(N2T);
            PT = MFMA16(fN2, frag_lo4(PT), PT);
            const f32x4 N4 = MFMA16(fN2T, fN2, z4), N4T = MFMA16(fN2, fN2T, z4);
            const bf16x8 fN4 = frag_lo4(N4), fN4T = frag_lo4(N4T);
            PT = MFMA16(fN4, frag_lo4(PT), PT);
            const f32x4 N8 = MFMA16(fN4T, fN4, z4);
            PT = MFMA16(frag_lo4(N8), frag_lo4(PT), PT);
            const bf16x8 LinvF = frag_lo4(PT);
            const bf16x8 MakF = frag_lo4(Mak), MrbTF = frag_lo4(MrbT);
            const f32x4 W1 = MFMA16(LinvF, MakF, z4);
            const f32x4 W1T = MFMA16(MakF, LinvF, z4);
            const f32x4 W2T = MFMA16(frag_lo4(W1), MrbTF, MrkT);
            f32x4 AtT[4], RtT[4];
#pragma unroll
            for (int jt = 0; jt < 4; ++jt) {
                const bf16x8 ahF = frag_cat(__builtin_bit_cast(u32x2, tr_read16(ps + PS_AH + swz(4 * q + qp, 16 * jt + 4 * pp))), (u32x2){0u, 0u});
                const f32x4 AtN = MFMA16(LinvF, ahF, z4);
                AtT[jt] = MFMA16(ahF, LinvF, z4);
                const f32x4 rinit = bf4_to_f32(*(const LAS u32x2*)(ps + PS_RH + swz(c16, 16 * jt + 4 * q)));
                RtT[jt] = MFMA16(frag_lo4(AtN), MrbTF, rinit);
            }
#pragma unroll
            for (int ks = 0; ks < 2; ++ks) {
                const u32x4 wa = {pk_bf16(AtT[2 * ks][0], AtT[2 * ks][1]), pk_bf16(AtT[2 * ks][2], AtT[2 * ks][3]), pk_bf16(AtT[2 * ks + 1][0], AtT[2 * ks + 1][1]), pk_bf16(AtT[2 * ks + 1][2], AtT[2 * ks + 1][3])};
                const u32x4 wr = {pk_bf16(RtT[2 * ks][0], RtT[2 * ks][1]), pk_bf16(RtT[2 * ks][2], RtT[2 * ks][3]), pk_bf16(RtT[2 * ks + 1][0], RtT[2 * ks + 1][1]), pk_bf16(RtT[2 * ks + 1][2], RtT[2 * ks + 1][3])};
                *(LAS u32x4*)(sl + SL_ATIL + ks * 1024 + lane * 16) = wa; *(LAS u32x4*)(sl + SL_RTIL + ks * 1024 + lane * 16) = wr; }
            *(LAS u32x2*)(sl + SL_ULOC + lane * 8) = f32_to_bf4(W1T); *(LAS u32x2*)(sl + SL_YLOC + lane * 8) = f32_to_bf4(W2T);
            }
            asm volatile("s_waitcnt lgkmcnt(0)" ::: "memory");
            if (lane == 0) FULL[slot] = (unsigned)(c + 1);
        }
#undef CS_ISSUE
#undef CS_PCLOAD
    } else {
        struct ConsOps { bf16x8 at0, at1, rt0, rt1, bk[4]; u32x2 w1w, w2w, vfw[2]; f32x4 pc[4]; };
        f32x4 S[2][4];
#pragma unroll
        for (int ti = 0; ti < 2; ++ti)
#pragma unroll
            for (int mt = 0; mt < 4; ++mt) S[ti][mt] = (f32x4){0.f, 0.f, 0.f, 0.f};
#define CONS_LOAD(X, cc) do { const int slot_ = (cc) % CS_NS; LAS unsigned char* sl_ = lds + slot_ * SL_BYTES; \
            { unsigned sp_ = 0; while (FULL[slot_] < (unsigned)((cc) + 1)) { __builtin_amdgcn_s_sleep(1); if (++sp_ > (1u << 22)) break; } } \
            asm volatile("" ::: "memory"); \
            X.at0 = *(const LAS bf16x8*)(sl_ + SL_ATIL + lane * 16); X.at1 = *(const LAS bf16x8*)(sl_ + SL_ATIL + 1024 + lane * 16); \
            X.rt0 = *(const LAS bf16x8*)(sl_ + SL_RTIL + lane * 16); X.rt1 = *(const LAS bf16x8*)(sl_ + SL_RTIL + 1024 + lane * 16); \
            X.w1w = *(const LAS u32x2*)(sl_ + SL_ULOC + lane * 8); X.w2w = *(const LAS u32x2*)(sl_ + SL_YLOC + lane * 8); \
            _Pragma("unroll") for (int mt_ = 0; mt_ < 4; ++mt_) { X.pc[mt_] = *(const LAS f32x4*)(sl_ + SL_PC + (16 * mt_ + 4 * q) * 4); \
                X.bk[mt_] = frag_cat(__builtin_bit_cast(u32x2, tr_read16(sl_ + SL_BH + swz(4 * q + qp, 16 * mt_ + 4 * pp))), __builtin_bit_cast(u32x2, tr_read16(sl_ + SL_KH + swz(4 * q + qp, 16 * mt_ + 4 * pp)))); } \
            _Pragma("unroll") for (int ti_ = 0; ti_ < 2; ++ti_) X.vfw[ti_] = __builtin_bit_cast(u32x2, tr_read16(sl_ + SL_V + swz(4 * q + qp, 16 * (2 * wave + ti_) + 4 * pp))); } while (0)
#define CONS_COMPUTE(X, cc) do { const f32x4 z4c_ = {0.f, 0.f, 0.f, 0.f}; const bf16x8 w1f_ = frag_cat(X.w1w, (u32x2){0u, 0u}), w2f_ = frag_cat(X.w2w, (u32x2){0u, 0u}); \
            _Pragma("unroll") for (int ti_ = 0; ti_ < 2; ++ti_) { const int nt_ = 2 * wave + ti_; \
                const bf16x8 vB_ = frag_cat(X.vfw[ti_], (u32x2){0u, 0u}); \
                const bf16x8 Sb0_ = frag_cat(f32_to_bf4(S[ti_][0]), f32_to_bf4(S[ti_][1])), Sb1_ = frag_cat(f32_to_bf4(S[ti_][2]), f32_to_bf4(S[ti_][3])); \
                const f32x4 U0_ = MFMA16(X.at0, Sb0_, MFMA16(w1f_, vB_, z4c_)), U1_ = MFMA16(X.at1, Sb1_, z4c_); \
                const f32x4 Y0_ = MFMA16(X.rt0, Sb0_, MFMA16(w2f_, vB_, z4c_)), Y1_ = MFMA16(X.rt1, Sb1_, z4c_); \
                const f32x4 UT_ = U0_ + U1_, YT_ = Y0_ + Y1_; \
                const bf16x8 Ub_ = frag_cat(f32_to_bf4(UT_), X.vfw[ti_]); \
                _Pragma("unroll") for (int mt_ = 0; mt_ < 4; ++mt_) { S[ti_][mt_] = MFMA16(X.bk[mt_], Ub_, S[ti_][mt_]); S[ti_][mt_] = S[ti_][mt_] * X.pc[mt_]; } \
                *(f32x4*)(Yg + ((((size_t)b * NCHUNK + (dir ? (NCHUNK - 1 - (cc)) : (cc))) * NH + hd) * 64 + 16 * nt_ + c16) * 16 + 4 * q) = YT_; } } while (0)
#define CONS_DONE(cc) do { asm volatile("s_waitcnt lgkmcnt(0)" ::: "memory"); if (lane == 0) (void)__hip_atomic_fetch_add((LAS unsigned*)&DONE[(cc) % CS_NS], 1u, __ATOMIC_RELAXED, __HIP_MEMORY_SCOPE_WORKGROUP); } while (0)
        ConsOps OA, OB;
        CONS_LOAD(OA, 0);
#pragma unroll 1
        for (int c = 0; c < NCHUNK; c += 2) {
            CONS_LOAD(OB, c + 1);
            CONS_COMPUTE(OA, c);
            CONS_DONE(c);
            if (c + 2 < NCHUNK) CONS_LOAD(OA, c + 2);
            CONS_COMPUTE(OB, c + 1);
            CONS_DONE(c + 1);
        }
#undef CONS_LOAD
#undef CONS_COMPUTE
#undef CONS_DONE
        unsigned tq0 = 0u, tq1 = 0u, tq2 = 0u, tq3 = 0u, tq4 = 0u, tq5 = 0u, tacc = 0u;
        (void)tq0; (void)tq1; (void)tq2; (void)tq3; (void)tq4; (void)tq5;
        (void)tacc;
    }
}

__device__ __forceinline__ void phase_post(const Args& a, int G) {
    int tid = tid_of(a.wv); asm volatile("" : "+v"(tid)); const int lane = tid & 63, wave = __builtin_amdgcn_readfirstlane(tid >> 6);
    const int gw = blockIdx.x * 8 + wave, NGW = G * 8, t = lane & 15, iq = lane >> 4;
    const float* __restrict__ YF = (const float*)(a.ws + WS_YF); const float* __restrict__ YB = (const float*)(a.ws + WS_YB); const float* __restrict__ BON = (const float*)(a.ws + WS_BON);
    const bf16_t* __restrict__ Vg = (const bf16_t*)scan_arr(a.ws, 0); const bf16_t* __restrict__ Gg = (const bf16_t*)(a.ws + WS_G); bf16_t* __restrict__ MIX = (bf16_t*)(a.ws + WS_MIX);
    float* ss = (float*)(a.ws + WS_SS);
    for (int i = blockIdx.x * NTHREADS + tid; i < T; i += G * NTHREADS) ss[i] = 0.f;
    constexpr int NIT = (T / 16) * NH;
#pragma unroll 1
    for (int it = gw; it < NIT; it += NGW) {
        const int tile = it / NH, hd = it - tile * NH, tok = tile * 16 + t;
        const float* yfp = YF + ((size_t)it * 64 + 16 * iq) * 16 + t; const float* ybp = YB + ((size_t)it * 64 + 16 * iq) * 16 + (15 - t);
        float y[16];
#pragma unroll
        for (int k = 0; k < 16; ++k) y[k] = yfp[k * 16] + ybp[k * 16];
        const u32x4 v0 = *(const u32x4*)(Vg + ((size_t)it * 16 + t) * 64 + 16 * iq), v1 = *(const u32x4*)(Vg + ((size_t)it * 16 + t) * 64 + 16 * iq + 8);
        const u32x4 g0 = *(const u32x4*)(Gg + (size_t)tok * RW + hd * 64 + 16 * iq), g1 = *(const u32x4*)(Gg + (size_t)tok * RW + hd * 64 + 16 * iq + 8);
        const float bon = BON[(size_t)tok * NH + hd] + BON[(size_t)T * NH + (size_t)tok * NH + hd];
        float sm = 0.f;
#pragma unroll
        for (int k = 0; k < 16; ++k) sm += y[k];
        sm += __shfl_xor(sm, 16); sm += __shfl_xor(sm, 32);
        const float mean = sm * (1.f / 64.f); float vs = 0.f;
#pragma unroll
        for (int k = 0; k < 16; ++k) { y[k] -= mean; vs += y[k] * y[k]; }
        vs += __shfl_xor(vs, 16); vs += __shfl_xor(vs, 32);
        const float rstd = 1.0f / sqrtf(vs * (1.f / 64.f) + 64e-5f);
        const unsigned vw[8] = {v0.x, v0.y, v0.z, v0.w, v1.x, v1.y, v1.z, v1.w}, gwd[8] = {g0.x, g0.y, g0.z, g0.w, g1.x, g1.y, g1.z, g1.w};
        unsigned ow[8];
#pragma unroll
        for (int k2 = 0; k2 < 8; ++k2) { const int ch = hd * 64 + 16 * iq + 2 * k2;
            const float o0 = (y[2 * k2] * rstd * a.in[I_LNXG][ch] + a.in[I_LNXB][ch] + bon * bf_lo(vw[k2])) * bf_lo(gwd[k2]);
            const float o1 = (y[2 * k2 + 1] * rstd * a.in[I_LNXG][ch + 1] + a.in[I_LNXB][ch + 1] + bon * bf_hi(vw[k2])) * bf_hi(gwd[k2]);
            ow[k2] = pk_bf16(o0, o1); }
        bf16_t* op = MIX + (size_t)tok * D + 640 + hd * 64 + 16 * iq;
        *(u32x4*)op = (u32x4){ow[0], ow[1], ow[2], ow[3]}; *(u32x4*)(op + 8) = (u32x4){ow[4], ow[5], ow[6], ow[7]};
    }
}

constexpr int RT_WS = 2064;
__device__ __forceinline__ void phase_router(const Args& a, LAS unsigned char* lds, int G) {
    int tid = tid_of(a.wv); asm volatile("" : "+v"(tid)); const int lane = tid & 63, wave = __builtin_amdgcn_readfirstlane(tid >> 6);
    const int gw = blockIdx.x * 8 + wave, NGW = G * 8, l15 = lane & 15, kq = lane >> 4;
    LAS bf16_t* WH = (LAS bf16_t*)lds; LAS bf16_t* WL = (LAS bf16_t*)(lds + 16 * RT_WS);
    for (int i = tid; i < D * NE; i += NTHREADS) { const int k = i >> 4, e = i & 15; const float w = a.in[I_WROUTER][i];
        const unsigned hi = pk_bf16(w, 0.f) & 0xffffu; const float rem = w - bf_lo(hi);
        WH[e * (RT_WS / 2) + k] = (bf16_t)hi; WL[e * (RT_WS / 2) + k] = (bf16_t)(pk_bf16(rem, 0.f) & 0xffffu); }
    __syncthreads();
    const bf16_t* __restrict__ X1 = (const bf16_t*)(a.ws + WS_X1); const float* __restrict__ ss = (const float*)(a.ws + WS_SS); bf16_t* __restrict__ H2 = (bf16_t*)(a.ws + WS_H2);
    float* __restrict__ AFF = (float*)(a.ws + WS_AFF); int* __restrict__ INV = (int*)(a.ws + WS_INV);
    const float* __restrict__ GF = a.in[I_NFFNG];
    for (int grp = gw; grp < T / 16; grp += NGW) {
        const int tok = grp * 16 + l15;
        const float rs = 1.0f / sqrtf(ss[tok] * (1.f / D) + 1e-6f);
        f32x4 acc = {0.f, 0.f, 0.f, 0.f};
        const bf16_t* xrow = X1 + (size_t)tok * D + 8 * kq; unsigned char* hrow8 = (unsigned char*)H2 + (size_t)tok * D + 8 * kq;
#pragma unroll 8
        for (int ks = 0; ks < 32; ++ks) {
            const u32x4 xw = *(const u32x4*)(xrow + 32 * ks); const f32x4 x0 = {bf_lo(xw.x), bf_hi(xw.x), bf_lo(xw.y), bf_hi(xw.y)}, x1v = {bf_lo(xw.z), bf_hi(xw.z), bf_lo(xw.w), bf_hi(xw.w)};
            const f32x4 g0 = *(const f32x4*)(GF + 32 * ks + 8 * kq), g1 = *(const f32x4*)(GF + 32 * ks + 8 * kq + 4);
            const f32x4 h0 = x0 * rs * g0, h1 = x1v * rs * g1;
            u32x4 hi; hi.x = pk_bf16(h0.x, h0.y); hi.y = pk_bf16(h0.z, h0.w); hi.z = pk_bf16(h1.x, h1.y); hi.w = pk_bf16(h1.z, h1.w);
            *(u32x2*)(hrow8 + 32 * ks) = (u32x2){pk_fp8x4(h0.x, h0.y, h0.z, h0.w), pk_fp8x4(h1.x, h1.y, h1.z, h1.w)};
            u32x4 lo; lo.x = pk_bf16(h0.x - bf_lo(hi.x), h0.y - bf_hi(hi.x)); lo.y = pk_bf16(h0.z - bf_lo(hi.y), h0.w - bf_hi(hi.y));
            lo.z = pk_bf16(h1.x - bf_lo(hi.z), h1.y - bf_hi(hi.z)); lo.w = pk_bf16(h1.z - bf_lo(hi.w), h1.w - bf_hi(hi.w));
            const bf16x8 ah = __builtin_bit_cast(bf16x8, hi), al = __builtin_bit_cast(bf16x8, lo);
            const bf16x8 bh = *(const LAS bf16x8*)(lds + l15 * RT_WS + (32 * ks + 8 * kq) * 2), bl = *(const LAS bf16x8*)(lds + 16 * RT_WS + l15 * RT_WS + (32 * ks + 8 * kq) * 2);
            acc = __builtin_amdgcn_mfma_f32_16x16x32_bf16(ah, bh, acc, 0, 0, 0);
            acc = __builtin_amdgcn_mfma_f32_16x16x32_bf16(al, bh, acc, 0, 0, 0);
            acc = __builtin_amdgcn_mfma_f32_16x16x32_bf16(ah, bl, acc, 0, 0, 0);
        }
#pragma unroll
        for (int rg = 0; rg < 4; ++rg) { const float mx = max16(acc[rg]); const float ex = __expf(acc[rg] - mx); const float sm = sum16(ex);
            const int t2 = grp * 16 + 4 * kq + rg, bb = t2 >> 12, sq = t2 & (SEQ - 1);
            AFF[((size_t)(bb * NE + l15)) * SEQ + sq] = ex / sm; }
        *(u32x4*)(INV + (size_t)grp * 256 + 4 * lane) = (u32x4){0xffffffffu, 0xffffffffu, 0xffffffffu, 0xffffffffu};
    }
}

__device__ __forceinline__ void topk_unit(const Args& a, LAS unsigned char* lds, int unit) {
    int tid = tid_of(a.wv); asm volatile("" : "+v"(tid)); const int lane = tid & 63, wave = __builtin_amdgcn_readfirstlane(tid >> 6);
    const int b = unit >> 4, e = unit & 15;
    const float* AFF = (const float*)(a.ws + WS_AFF) + (size_t)unit * SEQ;
    LAS unsigned* KEY = (LAS unsigned*)lds;
    LAS unsigned* HIST = (LAS unsigned*)(lds + 16384);
    LAS unsigned* CTL = (LAS unsigned*)(lds + 16384 + 1024);
    LAS unsigned* WS_ = (LAS unsigned*)(lds + 16384 + 2048);
    __syncthreads();
    unsigned key[8];
    { const u32x4 k0 = *(const u32x4*)(AFF + tid * 8), k1 = *(const u32x4*)(AFF + tid * 8 + 4); key[0] = k0.x; key[1] = k0.y; key[2] = k0.z; key[3] = k0.w; key[4] = k1.x; key[5] = k1.y; key[6] = k1.z; key[7] = k1.w; }
    if (tid == 0) { CTL[0] = 0u; CTL[1] = (unsigned)CAP; }
    unsigned prefix = 0u, mask = 0u;
#pragma unroll 1
    for (int pass = 0; pass < 4; ++pass) {
        const int shift = 24 - 8 * pass;
        if (tid < 256) HIST[tid] = 0u;
        __syncthreads();
#pragma unroll
        for (int i = 0; i < 8; ++i) if ((key[i] & mask) == prefix) (void)__hip_atomic_fetch_add(&HIST[(key[i] >> shift) & 255u], 1u, __ATOMIC_RELAXED, __HIP_MEMORY_SCOPE_WORKGROUP);
        __syncthreads();
        if (wave == 0) {
            const unsigned need = CTL[1];
            unsigned hv[4], tsum = 0u;
#pragma unroll
            for (int i = 0; i < 4; ++i) { hv[i] = HIST[255 - (4 * lane + i)]; tsum += hv[i]; }
            unsigned inc = tsum;
#pragma unroll
            for (int o = 1; o < 64; o <<= 1) { const unsigned v = __shfl_up(inc, o); if (lane >= o) inc += v; }
            unsigned exc = inc - tsum;
            if (exc < need && need <= inc) {
                unsigned run = exc; int di = 0;
#pragma unroll
                for (int i = 0; i < 4; ++i) { if (run < need && need <= run + hv[i]) { di = i; break; } run += hv[i]; }
                const unsigned digit = 255u - (unsigned)(4 * lane + di);
                CTL[0] = prefix | (digit << shift); CTL[1] = need - run;
            }
        }
        __syncthreads();
        prefix = CTL[0]; mask |= (255u << shift);
    }
    const unsigned thr = prefix, need_eq = CTL[1];
    unsigned ngt = 0u, neq = 0u;
#pragma unroll
    for (int i = 0; i < 8; ++i) { ngt += (key[i] > thr) ? 1u : 0u; neq += (key[i] == thr) ? 1u : 0u; }
    unsigned pk = ngt | (neq << 16), inc = pk;
#pragma unroll
    for (int o = 1; o < 64; o <<= 1) { const unsigned v = __shfl_up(inc, o); if (lane >= o) inc += v; }
    if (lane == 63) WS_[wave] = inc;
    __syncthreads();
    unsigned woff = 0u, tot = 0u;
#pragma unroll
    for (int w = 0; w < 8; ++w) { const unsigned v = WS_[w]; if (w < wave) woff += v; tot += v; }
    const unsigned exc = inc - pk + woff;
    unsigned gpos = exc & 0xffffu, epos = exc >> 16; const unsigned totgt = tot & 0xffffu;
    const int sbase = (e * BATCH + b) * CAP;
    int* ROWTOK = (int*)(a.ws + WS_ROWTOK); float* ROWGATE = (float*)(a.ws + WS_ROWGATE); int* INV = (int*)(a.ws + WS_INV);
#pragma unroll
    for (int i = 0; i < 8; ++i) {
        int pos = -1;
        if (key[i] > thr) pos = (int)gpos++;
        else if (key[i] == thr) { if (epos < need_eq) pos = (int)(totgt + epos); epos++; }
        if (pos >= 0) { const int s = tid * 8 + i, tok = b * SEQ + s, slot = sbase + pos;
            ROWTOK[slot] = tok; ROWGATE[slot] = __builtin_bit_cast(float, key[i]); INV[(size_t)tok * NE + e] = slot; }
    }
}

__device__ __forceinline__ void phase_final(const Args& a, int G) {
    int tid = tid_of(a.wv); asm volatile("" : "+v"(tid)); const int lane = tid & 63, wave = __builtin_amdgcn_readfirstlane(tid >> 6);
    const int gw = blockIdx.x * 8 + wave, NGW = G * 8;
    const bf16_t* __restrict__ X1 = (const bf16_t*)(a.ws + WS_X1); const bf16_t* __restrict__ YE = (const bf16_t*)(a.ws + WS_YE); const int* __restrict__ INV = (const int*)(a.ws + WS_INV);
    float* __restrict__ OUT = a.out;
    f32x4 gg[4];
#pragma unroll
    for (int j = 0; j < 4; ++j) gg[j] = *(const f32x4*)(a.in[I_FNG] + 4 * lane + 256 * j);
#define PF_SLOTS(inv_, n_, m_, sl_) do { m_ = __ballot((inv_) >= 0) & 0xffffull; n_ = __builtin_popcountll(m_); unsigned long long mm_ = m_; \
        _Pragma("unroll") for (int k_ = 0; k_ < 4; ++k_) { if (mm_) { const int e_ = __builtin_ctzll(mm_); mm_ &= mm_ - 1; sl_[k_] = __builtin_amdgcn_readlane((inv_), e_); } else sl_[k_] = 0; } m_ = mm_; } while (0)
#define PF_ROWS(rw_, xr_, tk_, n_, sl_) do { \
        _Pragma("unroll") for (int k_ = 0; k_ < 4; ++k_) { if (k_ < (n_)) { _Pragma("unroll") for (int j_ = 0; j_ < 4; ++j_) rw_[k_][j_] = *(const u32x2*)(YE + (size_t)sl_[k_] * D + 4 * lane + 256 * j_); } \
            else { _Pragma("unroll") for (int j_ = 0; j_ < 4; ++j_) rw_[k_][j_] = (u32x2){0u, 0u}; } } \
        _Pragma("unroll") for (int j_ = 0; j_ < 4; ++j_) xr_[j_] = *(const u32x2*)(X1 + (size_t)(tk_) * D + 4 * lane + 256 * j_); } while (0)
    int tok = gw;
    if (tok >= T) return;
    int inv0 = INV[(size_t)tok * NE + (lane & 15)];
    int inv1 = (tok + NGW < T) ? INV[(size_t)(tok + NGW) * NE + (lane & 15)] : -1;
    unsigned long long mc; int nc, slc[4]; u32x2 rwc[4][4], xc[4];
    PF_SLOTS(inv0, nc, mc, slc);
    PF_ROWS(rwc, xc, tok, nc, slc);
    for (; tok < T; tok += NGW) {
        const int t1 = tok + NGW, t2 = tok + 2 * NGW;
        const int inv2 = (t2 < T) ? INV[(size_t)t2 * NE + (lane & 15)] : -1;
        unsigned long long mn = 0ull; int nn = 0, sln[4] = {0, 0, 0, 0}; u32x2 rwn[4][4], xn[4];
        if (t1 < T) { PF_SLOTS(inv1, nn, mn, sln); PF_ROWS(rwn, xn, t1, nn, sln); }
        else {
#pragma unroll
            for (int k = 0; k < 4; ++k)
#pragma unroll
                for (int j = 0; j < 4; ++j) rwn[k][j] = (u32x2){0u, 0u};
#pragma unroll
            for (int j = 0; j < 4; ++j) xn[j] = (u32x2){0u, 0u}; }
        f32x4 v[4];
#pragma unroll
        for (int j = 0; j < 4; ++j) v[j] = (f32x4){bf_lo(xc[j].x), bf_hi(xc[j].x), bf_lo(xc[j].y), bf_hi(xc[j].y)};
#pragma unroll
        for (int k = 0; k < 4; ++k)
#pragma unroll
            for (int j = 0; j < 4; ++j) { v[j].x += bf_lo(rwc[k][j].x); v[j].y += bf_hi(rwc[k][j].x); v[j].z += bf_lo(rwc[k][j].y); v[j].w += bf_hi(rwc[k][j].y); }
        if (nc > 4) { unsigned long long m = mc; while (m) { const int e = __builtin_ctzll(m); m &= m - 1; const int slot = __builtin_amdgcn_readlane(inv0, e);
#pragma unroll
                for (int j = 0; j < 4; ++j) { const u32x2 w = *(const u32x2*)(YE + (size_t)slot * D + 4 * lane + 256 * j);
                    v[j].x += bf_lo(w.x); v[j].y += bf_hi(w.x); v[j].z += bf_lo(w.y); v[j].w += bf_hi(w.y); } } }
        float sq = 0.f;
#pragma unroll
        for (int j = 0; j < 4; ++j) sq += (v[j].x * v[j].x + v[j].y * v[j].y) + (v[j].z * v[j].z + v[j].w * v[j].w);
        float rs = 1.0f / sqrtf(wave_sum(sq) * (1.f / D) + 1e-6f);
#pragma unroll
        for (int j = 0; j < 4; ++j) *(f32x4*)(OUT + (size_t)tok * D + 4 * lane + 256 * j) = v[j] * rs * gg[j];
        inv0 = inv1; inv1 = inv2; mc = mn; nc = nn;
#pragma unroll
        for (int k = 0; k < 4; ++k) { slc[k] = sln[k];
#pragma unroll
            for (int j = 0; j < 4; ++j) rwc[k][j] = rwn[k][j]; }
#pragma unroll
        for (int j = 0; j < 4; ++j) xc[j] = xn[j];
    }
#undef PF_SLOTS
#undef PF_ROWS
}

#define XB_TMO      128
#define XB_XCNT(j)  (256  + 64 * (j))
#define XB_XSUB(j)  (1280 + 64 * (j))
#define XB_XGEN(j)  (2304 + 64 * (j))
#define XB_TOP      3328
#define XB_TOPGEN   3392
#define XCD_BAR_WORDS 3456
#define XB_SPIN_CAP (1u << 22)
__device__ __forceinline__ unsigned xb_ld(unsigned* p)              { return __hip_atomic_load(p, __ATOMIC_RELAXED, __HIP_MEMORY_SCOPE_AGENT); }
__device__ __forceinline__ unsigned xb_add(unsigned* p, unsigned v) { return __hip_atomic_fetch_add(p, v, __ATOMIC_RELAXED, __HIP_MEMORY_SCOPE_AGENT); }
__device__ __forceinline__ unsigned xb_xcc_id() { return (unsigned)__builtin_amdgcn_s_getreg((3 << 11) | 20) & 0xFu; }
#define XB_SPIN(cond, bar) do { unsigned _sp = 0; while (cond) { __builtin_amdgcn_s_sleep(1); \
    if ((++_sp & 255u) == 0u) { if (xb_ld(&(bar)[XB_TMO])) break; if (_sp > XB_SPIN_CAP) { atomicAdd(&(bar)[XB_TMO], 1u); break; } } } } while (0)
struct XcdBarrier { unsigned* bar; unsigned x; volatile LAS unsigned* st; int wv; };
__device__ __forceinline__ XcdBarrier xcd_barrier_post(unsigned* bar, volatile LAS unsigned* st, int wv) {
    XcdBarrier b; b.bar = bar; b.x = xb_xcc_id(); b.st = st; b.wv = wv;
    if (threadIdx.x == 0) (void)xb_add(&bar[XB_XCNT(b.x)], 1u);
    return b;
}
__device__ __forceinline__ void xcd_barrier_complete(unsigned* bar, unsigned x, unsigned& nloc, unsigned& nx) {
    const unsigned G = gridDim.x * gridDim.y * gridDim.z;
    unsigned sum, cnt, mine, sp = 0u;
    for (;;) {
        sum = 0u; cnt = 0u; mine = 0u;
#pragma unroll
        for (unsigned j = 0; j < 16; ++j) { const unsigned c = xb_ld(&bar[XB_XCNT(j)]); sum += c; cnt += (c > 0u) ? 1u : 0u; mine = (j == x) ? c : mine; }
        if (sum == G) break;
        __builtin_amdgcn_s_sleep(1);
        if ((++sp & 255u) == 0u) { if (xb_ld(&bar[XB_TMO])) break; if (sp > XB_SPIN_CAP) { atomicAdd(&bar[XB_TMO], 1u); break; } }
    }
    nloc = mine > 0u ? mine : 1u; nx = cnt > 0u ? cnt : 1u;
}
__device__ __forceinline__ void xcd_barrier(const XcdBarrier& b) {
    asm volatile("s_waitcnt vmcnt(0)" ::: "memory");
    __syncthreads();
    if (tid_of(b.wv) == 0) {
        unsigned* bar = b.bar;
        __builtin_amdgcn_s_waitcnt(0);
        unsigned nloc = b.st[0], nx = b.st[1];
        if (nloc == 0u) { xcd_barrier_complete(bar, b.x, nloc, nx); b.st[0] = nloc; b.st[1] = nx; }
        const unsigned old = xb_add(&bar[XB_XSUB(b.x)], 1u);
        const unsigned gen = old / nloc;
        if (old + 1u == (gen + 1u) * nloc) {
            __builtin_amdgcn_fence(__ATOMIC_RELEASE, "agent");
            asm volatile("s_waitcnt vmcnt(0)" ::: "memory");
            const unsigned og = xb_add(&bar[XB_TOP], 1u);
            const unsigned tg = og / nx;
            if (og + 1u == (tg + 1u) * nx) xb_add(&bar[XB_TOPGEN], 1u);
            else XB_SPIN(xb_ld(&bar[XB_TOPGEN]) == tg, bar);
            __builtin_amdgcn_fence(__ATOMIC_ACQUIRE, "agent");
            xb_add(&bar[XB_XGEN(b.x)], 1u);
            asm volatile("s_waitcnt vmcnt(0)" ::: "memory");
        } else {
            XB_SPIN(xb_ld(&bar[XB_XGEN(b.x)]) == gen, bar);
            __builtin_amdgcn_fence(__ATOMIC_ACQUIRE, "agent");
            asm volatile("s_waitcnt vmcnt(0)" ::: "memory");
        }
    }
    __syncthreads();
}

#ifndef PH_MASK
#define PH_MASK 0x7ff
#endif
#ifndef REP_MASK
#define REP_MASK 0
#endif
#ifndef P2_MASK
#define P2_MASK 7
#endif
#ifndef P2_REP
#define P2_REP 0
#define P9_REP 0
#endif
constexpr int LDS_MISC = LDS_BYTES - 64;
constexpr int LDS_PTAB = LDS_BYTES - 512;
__device__ __forceinline__ Args load_args(LAS unsigned char* lds, int lo, int hi, int wv) {
    Args r; const LAS u32x2* t = (const LAS u32x2*)(lds + LDS_PTAB);
#pragma unroll
    for (int i = 0; i < 31; ++i) { const u32x2 v = t[i]; const unsigned long long p = ((unsigned long long)(unsigned)__builtin_amdgcn_readfirstlane((int)v.y) << 32) | (unsigned)__builtin_amdgcn_readfirstlane((int)v.x);
        if (i < 29) r.in[i] = (const float*)(const __attribute__((address_space(1))) float*)p; else if (i == 29) r.out = (float*)(__attribute__((address_space(1))) float*)p; else r.ws = (unsigned char*)(__attribute__((address_space(1))) unsigned char*)p; }
    r.ph_lo = lo; r.ph_hi = hi; r.wv = wv; r.zero_ = 0; return r;
}
constexpr size_t WS_CTL = 0, CTL_BYTES = 16384;
__global__ void __launch_bounds__(NTHREADS, 2) mega(Args a0) {
    extern __shared__ __attribute__((aligned(16))) unsigned char lds_raw[];
    LAS unsigned char* lds = (LAS unsigned char*)lds_raw;
    cg::grid_group grid = cg::this_grid();
    const int G = gridDim.x, lo = a0.ph_lo, hi = a0.ph_hi, wv0 = __builtin_amdgcn_readfirstlane((int)threadIdx.x >> 6);
    volatile LAS unsigned* misc = (volatile LAS unsigned*)(lds + LDS_MISC);
    if (threadIdx.x < 16) misc[threadIdx.x] = 0u;
    if (threadIdx.x == 0) { LAS unsigned long long* t = (LAS unsigned long long*)(lds + LDS_PTAB);
#pragma unroll
        for (int i = 0; i < 29; ++i) t[i] = (unsigned long long)a0.in[i];
        t[29] = (unsigned long long)a0.out; t[30] = (unsigned long long)a0.ws; }
    __syncthreads();
    if (lo < -1000) grid.sync();
    XcdBarrier xbar = xcd_barrier_post((unsigned*)(a0.ws + WS_CTL), misc, wv0);
#define IN(k) (((PH_MASK >> (k)) & 1) && lo <= (k) && (k) < hi)
#define NREP(k) (1 + ((REP_MASK >> (k)) & 1))
#define PHASE(k, ...) do { if (IN(k)) { for (int rep_ = 0; rep_ < NREP(k); ++rep_) { { const Args a = load_args(lds, lo, hi, wv0); unsigned char* const ws = a.ws; (void)ws; __VA_ARGS__; } if (rep_ + 1 < NREP(k) || IN((k) + 1)) { xcd_barrier(xbar); } } } } while (0)

    PHASE(0, phase_prep(a, lds, G));

    PHASE(1, {
        pg8::Gemm g{(const bf16_t*)(ws + WS_XH), (const bf16_t*)(ws + WS_WINT), T, IN_PROJ, D, 0, 0};
        pg8::TripleOrder S; S.S0.init(T, IN_PROJ, G, 0); S.A1 = (const bf16_t*)(ws + WS_MEMN); S.B1 = (const bf16_t*)(ws + WS_WKT); S.A2 = (const bf16_t*)(ws + WS_WVT); S.B2 = (const bf16_t*)(ws + WS_MEMN);
        S.n1 = BATCH * NMEM / 256; S.n2 = BATCH * NMEM / 256; S.G = G; S.c = (int)blockIdx.x;
        pg8::EpiBf16x3 E{pg8::EpiBf16{(bf16_t*)(ws + WS_P), PLD, (bf16_t*)(ws + WS_Q)}, pg8::EpiBf16{(bf16_t*)(ws + WS_KMEM), 256, nullptr}, pg8::EpiBf16{(bf16_t*)(ws + WS_VT), BATCH * NMEM, nullptr}};
        pg8::gemm_phase<pg8::EpiBf16x3, pg8::TripleOrder, false>(lds, g, S, E, nullptr, a.wv);
    });

    constexpr int NSCAN = BATCH * NH * 2;
    PHASE(2, {
        for (int u = blockIdx.x; u < 2048; u += G) {
            if (u < 1024) { for (int r2 = 0; r2 < 1 + ((P2_REP >> 1) & 1); ++r2) conv_unit(a, lds, u); }
            else { for (int r2 = 0; r2 < 1 + ((P2_REP >> 2) & 1); ++r2) prep_unit(a, lds, u - 1024); }
        }
    });

    PHASE(3, {
        int bid = blockIdx.x; int Gp = G; asm volatile("" : "+s"(bid), "+s"(Gp));
        for (int u = bid; u < NSCAN; u += Gp) scan_chunked_unit(a, lds, u);
        if (rep_ == 0) {
            if (Gp > NSCAN) { if (bid >= NSCAN) { for (int u = bid - NSCAN; u < 64; u += Gp - NSCAN) for (int r2 = 0; r2 < 1 + (P2_REP & 1); ++r2) attn_unit(a, lds, u);
                                                 } }
            else { for (int u = bid; u < 64; u += Gp) attn_unit(a, lds, u); }
        }
    });

    PHASE(4, phase_post(a, G));

    PHASE(5, {
        pg8::Gemm g{(const bf16_t*)(ws + WS_MIX), (const bf16_t*)(ws + WS_WOUTT), T, D, D, 0, 0}; pg8::StaticOrder S; S.init(T, D, G, (int)blockIdx.x);
        pg8::EpiResidSS E{a.in[I_X], (bf16_t*)(ws + WS_X1), (float*)(ws + WS_SS)}; pg8::gemm_phase<pg8::EpiResidSS, pg8::StaticOrder, false>(lds, g, S, E, nullptr, a.wv);
    });

    PHASE(6, phase_router(a, lds, G));

    PHASE(7, { for (int u = blockIdx.x; u < BATCH * NE; u += G) topk_unit(a, lds, u); });

    PHASE(8, {
        pg8::Gemm g{(const bf16_t*)(ws + WS_H2), (const bf16_t*)(ws + WS_WGUT), NSLOT, 2048, D / 2, 0x7A7A7A7A, 0x7F7F7F7F};     pg8::ExpertOrder S; S.init(32, 8, NE, G, (int)blockIdx.x);
        pg8::EpiSwiGLU E{(bf16_t*)(ws + WS_HID)}; pg8::gemm_phase<pg8::EpiSwiGLU, pg8::ExpertOrder, true, false, true>(lds, g, S, E, (const int*)(ws + WS_ROWTOK), a.wv);
    });

    PHASE(9, {
        pg8::Gemm g{(const bf16_t*)(ws + WS_HID), (const bf16_t*)(ws + WS_WDT), NSLOT, D, FF / 2, 0x7A7A7A7A, 0x7C7C7C7C};     pg8::ExpertOrder S; S.init(32, 4, NE, G, (int)blockIdx.x);
        pg8::EpiGateScale E{(bf16_t*)(ws + WS_YE), (const float*)(ws + WS_ROWGATE)}; pg8::gemm_phase<pg8::EpiGateScale, pg8::ExpertOrder, false, true, true>(lds, g, S, E, nullptr, a.wv);
#if P9_REP
        __syncthreads(); pg8::gemm_phase<pg8::EpiGateScale, pg8::ExpertOrder, false, true, true>(lds, g, S, E, nullptr, a.wv);
#endif
    });

    PHASE(10, phase_final(a, G));
#undef IN
#undef NREP
#undef PHASE
}

#ifndef MK_ONE_LAUNCH
#define MK_ONE_LAUNCH 1
#endif
extern "C" void kernel_launch(void* const* d_in, const int* in_sizes, int n_in, void* d_out, int out_size, void* d_ws, size_t ws_size, hipStream_t stream) {
    static int grid_blocks = 0;
    if (grid_blocks == 0) {
        if (n_in != 29 || out_size != T * D || ws_size < WS_END) { fprintf(stderr, "kernel_launch: unexpected problem: n_in %d out %d ws %zu (need %zu)\n", n_in, out_size, ws_size, (size_t)WS_END); grid_blocks = -1; return; }
        int dev = 0, cus = 0, per_cu = 0;
        if (hipGetDevice(&dev) != hipSuccess || hipDeviceGetAttribute(&cus, hipDeviceAttributeMultiprocessorCount, dev) != hipSuccess) { grid_blocks = -1; return; }
        if (hipFuncSetAttribute((const void*)mega, hipFuncAttributeMaxDynamicSharedMemorySize, LDS_BYTES) != hipSuccess) { fprintf(stderr, "kernel_launch: hipFuncSetAttribute failed\n"); grid_blocks = -1; return; }
        if (hipOccupancyMaxActiveBlocksPerMultiprocessor(&per_cu, (const void*)mega, NTHREADS, LDS_BYTES) != hipSuccess || per_cu < 1) { fprintf(stderr, "kernel_launch: occupancy query says %d blocks per CU\n", per_cu); grid_blocks = -1; return; }
        grid_blocks = cus;
    }
    if (grid_blocks < 0) return;
    if (hipMemsetAsync((char*)d_ws + WS_CTL, 0, CTL_BYTES, stream) != hipSuccess) { fprintf(stderr, "kernel_launch: memset failed\n"); return; }
    Args a{};
    for (int i = 0; i < 29; ++i) a.in[i] = (const float*)d_in[i];
    a.out = (float*)d_out; a.ws = (unsigned char*)d_ws;
#if MK_ONE_LAUNCH
    a.ph_lo = 0; a.ph_hi = NPHASE;
    { void* args[] = {&a}; hipError_t e = hipLaunchCooperativeKernel((const void*)mega, dim3(grid_blocks), dim3(NTHREADS), args, LDS_BYTES, stream);
      if (e != hipSuccess) fprintf(stderr, "cooperative launch failed: %s (grid %d)\n", hipGetErrorString(e), grid_blocks); }
#else
    for (int ph = 0; ph < NPHASE; ++ph) { a.ph_lo = ph; a.ph_hi = ph + 1; void* args[] = {&a};
        hipError_t e = hipLaunchCooperativeKernel((const void*)mega, dim3(grid_blocks), dim3(NTHREADS), args, LDS_BYTES, stream);
        if (e != hipSuccess) { fprintf(stderr, "cooperative launch %d failed: %s (grid %d)\n", ph, hipGetErrorString(e), grid_blocks); break; } }
#endif
}
```

```cpp
#include <hip/hip_runtime.h>
#include <hip/hip_cooperative_groups.h>
#include <cstdio>
#include <cstdint>
namespace cg = cooperative_groups;

#define LAS __attribute__((address_space(3)))
typedef unsigned short bf16_t;
typedef short bf16x8 __attribute__((ext_vector_type(8)));
typedef short s16x4 __attribute__((ext_vector_type(4)));
typedef float f32x2 __attribute__((ext_vector_type(2)));
typedef float f32x4 __attribute__((ext_vector_type(4)));
typedef float f32x16 __attribute__((ext_vector_type(16)));
typedef unsigned u32x2 __attribute__((ext_vector_type(2)));
typedef unsigned u32x4 __attribute__((ext_vector_type(4)));
typedef _Float16 f16x4 __attribute__((ext_vector_type(4)));
typedef __bf16 bf16v2 __attribute__((ext_vector_type(2)));
typedef int v8i __attribute__((ext_vector_type(8)));
typedef int v4i __attribute__((ext_vector_type(4)));

constexpr int D = 1024, BATCH = 16, SEQ = 4096, T = BATCH * SEQ, NMEM = 256;
constexpr int IN_PROJ = 2560, CW = 384, RW = 384, NH = 6, NE = 16, FF = 1024, CAP = 512;
constexpr int NSLOT = NE * BATCH * CAP;
constexpr int NTHREADS = 512;
constexpr int LDS_BYTES = 160 * 1024;
constexpr int NPHASE = 11;
#ifndef SCAN_MODE
#define SCAN_MODE 1
#endif

constexpr size_t MiB = 1u << 20;
constexpr size_t WS_WINT = 1 * MiB;
constexpr size_t WS_WOUTT = 6 * MiB;
constexpr size_t WS_WKT = 8 * MiB;
constexpr size_t WS_WVT = 8 * MiB + 512 * 1024;
constexpr size_t WS_SMALL = 9 * MiB;
constexpr size_t WS_WGUT = 10 * MiB;
constexpr size_t WS_WDT = 74 * MiB;
constexpr size_t WS_KMEM = 106 * MiB;
constexpr size_t WS_VT = 108 * MiB;
constexpr size_t WS_ROWTOK = 106 * MiB;
constexpr size_t WS_ROWGATE = 106 * MiB + 512 * 1024;
constexpr size_t WS_SS = 107 * MiB;
constexpr size_t WS_P = 112 * MiB;
constexpr size_t WS_YF = 112 * MiB;
constexpr size_t WS_YB = 208 * MiB;
constexpr size_t WS_X1 = 112 * MiB;
constexpr size_t WS_XH = 432 * MiB;
constexpr size_t WS_G = 432 * MiB;
constexpr size_t WS_BON = 480 * MiB;
constexpr size_t WS_Q = 400 * MiB;
constexpr int PLD = IN_PROJ - 256;
constexpr size_t WS_H2 = 432 * MiB;
constexpr size_t WS_MEMN = 560 * MiB;
constexpr size_t WS_MIX = 560 * MiB;
constexpr size_t WS_SCAN = 688 * MiB;
constexpr size_t SCAN_STRIDE = 48 * MiB;
constexpr size_t WS_SCAN7 = 496 * MiB;
constexpr size_t WS_PC = 484 * MiB;
__device__ __forceinline__ unsigned char* scan_arr(unsigned char* ws, int a) { return a < 7 ? ws + WS_SCAN + (size_t)a * SCAN_STRIDE : (a == 7 ? ws + WS_SCAN7 : ws + 560 * MiB + 640 * 2); }
__device__ __forceinline__ int scan_pitch(int a) { return a == 8 ? D : 384; }
__device__ __forceinline__ size_t hat_off(int a, size_t tok, int ch) { return a == 8 ? tok * D + ch : ((((tok >> 4) * NH + (ch >> 6)) << 10) + ((tok & 15) << 6) + (ch & 63)); }
constexpr size_t WS_AFF = 624 * MiB;
constexpr size_t WS_INV = 628 * MiB;
constexpr size_t WS_HID = 768 * MiB;
constexpr size_t WS_YE = 368 * MiB;
constexpr size_t WS_END = 1024 * MiB;

__device__ __forceinline__ unsigned pk_bf16(float lo, float hi) { f32x2 v = {lo, hi}; bf16v2 b = __builtin_convertvector(v, bf16v2); return __builtin_bit_cast(unsigned, b); }
__device__ __forceinline__ unsigned pk_fp8x4(float a, float b, float c, float d) { int w = 0; w = __builtin_amdgcn_cvt_pk_fp8_f32(a, b, w, false); w = __builtin_amdgcn_cvt_pk_fp8_f32(c, d, w, true); return (unsigned)w; }
__device__ __forceinline__ float bf_lo(unsigned u) { return __builtin_bit_cast(float, u << 16); }
__device__ __forceinline__ float bf_hi(unsigned u) { return __builtin_bit_cast(float, u & 0xffff0000u); }
__device__ __forceinline__ float wave_sum(float v) {
#pragma unroll
    for (int o = 1; o < 64; o <<= 1) v += __shfl_xor(v, o);
    return v;
}
__device__ __forceinline__ float sigmoidf_fast(float x) { return __builtin_amdgcn_rcpf(1.0f + __builtin_amdgcn_exp2f(-1.4426950408889634f * x)); }
template <int CTRL> __device__ __forceinline__ float dpp_f(float x) { return __builtin_bit_cast(float, __builtin_amdgcn_update_dpp(0, __builtin_bit_cast(int, x), CTRL, 0xF, 0xF, true)); }
__device__ __forceinline__ float sum8(float x) { x += dpp_f<0xB1>(x); x += dpp_f<0x4E>(x); x += dpp_f<0x141>(x); return x; }
__device__ __forceinline__ float sum16(float x) { x = sum8(x); x += dpp_f<0x140>(x); return x; }
__device__ __forceinline__ float max16(float x) { x = fmaxf(x, dpp_f<0xB1>(x)); x = fmaxf(x, dpp_f<0x4E>(x)); x = fmaxf(x, dpp_f<0x141>(x)); x = fmaxf(x, dpp_f<0x140>(x)); return x; }

typedef short v4i16g __attribute__((__vector_size__(8)));
__device__ __forceinline__ s16x4 tr_read16(LAS unsigned char* p) { v4i16g r = __builtin_amdgcn_ds_read_tr16_b64_v4i16((LAS v4i16g*)p); return __builtin_bit_cast(s16x4, r); }
__device__ __forceinline__ f32x4 bf4_to_f32(u32x2 w) { return (f32x4){bf_lo(w.x), bf_hi(w.x), bf_lo(w.y), bf_hi(w.y)}; }
__device__ __forceinline__ u32x2 f32_to_bf4(f32x4 v) { return (u32x2){pk_bf16(v.x, v.y), pk_bf16(v.z, v.w)}; }
__device__ __forceinline__ bf16x8 frag_lo4(f32x4 v) { const u32x4 w = {pk_bf16(v.x, v.y), pk_bf16(v.z, v.w), 0u, 0u}; return __builtin_bit_cast(bf16x8, w); }
__device__ __forceinline__ bf16x8 frag_cat(u32x2 a, u32x2 b) { const u32x4 w = {a.x, a.y, b.x, b.y}; return __builtin_bit_cast(bf16x8, w); }
#define MFMA16(a, b, c) __builtin_amdgcn_mfma_f32_16x16x32_bf16((a), (b), (c), 0, 0, 0)

__device__ __forceinline__ int tid_of(int wv) { int l; asm volatile("v_mbcnt_lo_u32_b32 %0, -1, 0\n\tv_mbcnt_hi_u32_b32 %0, -1, %0" : "=v"(l)); return (wv << 6) | l; }
namespace pg8 {
#define PG8_LAS __attribute__((address_space(3)))
constexpr int BM = 256, BK = 64, HALF = 128, HTB = HALF * BK * 2, STAGE_BYTES = 8 * HTB, NXCD = 8, WGM = 8;
__host__ __device__ __forceinline__ int lds_byte(int r, int c) { const int st = (r >> 4) * 2 + (c >> 5), rr = r & 15, cc = c & 31, ob = rr * 64 + cc * 2; return st * 1024 + (ob ^ (((ob >> 9) & 1) << 5)); }
__host__ __device__ __forceinline__ void stage_rc(int b, int& R, int& C) { const int st = b / 1024, sb = b % 1024, swz = sb ^ (((sb >> 9) & 1) << 5); R = (st >> 1) * 16 + swz / 64; C = (st & 1) * 32 + (swz % 64) / 2; }
__host__ __device__ __forceinline__ int perm32(int rho) { const int n = rho >> 4, i = rho & 15; return 8 * (i >> 2) + 4 * n + (i & 3); }

struct Unit { int pm, pn, gid; };
struct Gemm { const bf16_t* A; const bf16_t* Bt; int M, N, K; int sw, sx; };

struct StaticOrder {
    int nM, nN, nwg, G, c;
    __device__ void init(int M, int N, int G_, int c_) { nM = M / BM; nN = N / BM; nwg = nM * nN; G = G_; c = c_; }
    __device__ bool next(int i, Unit& u) const {
        const long L = (long)i * G + c; if (L >= nwg) return false;
        int wgid = (int)L; { const int q = nwg / NXCD, r = nwg % NXCD, xcd = wgid % NXCD, off = wgid / NXCD; wgid = (xcd < r ? xcd * (q + 1) : r * (q + 1) + (xcd - r) * q) + off; }
        const int nig = WGM * nN, gid = wgid / nig, fm = gid * WGM, gsz = (nM - fm) < WGM ? (nM - fm) : WGM;
        u.pm = fm + ((wgid % nig) % gsz); u.pn = (wgid % nig) / gsz; u.gid = 0; return true;
    }
    __device__ __forceinline__ const char* aptr(const Gemm& g, const Unit& u, size_t tstep) const { return (const char*)g.A + (size_t)u.pm * tstep; }
    __device__ __forceinline__ const char* bptr(const Gemm& g, const Unit& u, size_t tstep) const { return (const char*)g.Bt + (size_t)u.pn * tstep; }
};
struct TripleOrder {
    StaticOrder S0; const bf16_t* A1; const bf16_t* B1; const bf16_t* A2; const bf16_t* B2; int n1, n2, G, c;
    __device__ bool next(int i, Unit& u) const {
        const long L = (long)i * G + c;
        if (L < n1) { u.pm = (int)L; u.pn = 0; u.gid = 1; return true; }
        if (L < n1 + n2) { u.pm = 0; u.pn = (int)(L - n1); u.gid = 2; return true; }
        const long L0 = L - n1 - n2; if (L0 >= S0.nwg) return false;
        StaticOrder T0 = S0; T0.c = (int)(L0 % G); return T0.next((int)(L0 / G), u);
    }
    __device__ __forceinline__ const char* aptr(const Gemm& g, const Unit& u, size_t tstep) const { return (const char*)(u.gid == 0 ? g.A : (u.gid == 1 ? A1 : A2)) + (size_t)u.pm * tstep; }
    __device__ __forceinline__ const char* bptr(const Gemm& g, const Unit& u, size_t tstep) const { return (const char*)(u.gid == 0 ? g.Bt : (u.gid == 1 ? B1 : B2)) + (size_t)u.pn * tstep; }
};
struct ExpertOrder {
    int nMe, nNe, per, total, G, c;
    __device__ void init(int nMe_, int nNe_, int nExp, int G_, int c_) { nMe = nMe_; nNe = nNe_; per = nMe * nNe; total = per * nExp; G = G_; c = c_; }
    __device__ bool next(int i, Unit& u) const {
        const long L = (long)i * G + c; if (L >= total) return false;
        const int e = (int)(L / per), w = (int)(L % per), xl = w % 8, j = w / 8, rpx = nMe / 8;
        u.pm = e * nMe + xl * rpx + (j % rpx); u.pn = e * nNe + j / rpx; u.gid = 0; return true;
    }
    __device__ __forceinline__ const char* aptr(const Gemm& g, const Unit& u, size_t tstep) const { return (const char*)g.A + (size_t)u.pm * tstep; }
    __device__ __forceinline__ const char* bptr(const Gemm& g, const Unit& u, size_t tstep) const { return (const char*)g.Bt + (size_t)u.pn * tstep; }
};

struct EpiBf16 {
    static constexpr bool PERM = true;
    bf16_t* O; int ldc; bf16_t* Q0;
    __device__ __forceinline__ void operator()(const f32x4 (&acc)[2][2][4][2], const Unit& u, int wr, int wc, int fr, int fq) const {
        const bool redir = (Q0 != nullptr) && (u.pn == 0);
        bf16_t* base = redir ? Q0 : O; const int ld = redir ? 256 : ldc;
        const int row0 = u.pm * BM + wr * 64 + fr, col0 = (u.pn - ((Q0 != nullptr && !redir) ? 1 : 0)) * BM + wc * 32 + 8 * fq;
#pragma unroll
        for (int ai = 0; ai < 2; ++ai)
#pragma unroll
            for (int m = 0; m < 4; ++m) { bf16_t* rowp = base + (size_t)(row0 + ai * HALF + m * 16) * ld + col0;
#pragma unroll
                for (int bj = 0; bj < 2; ++bj) { const f32x4 v0 = acc[ai][bj][m][0], v1 = acc[ai][bj][m][1];
                    u32x4 w; w.x = pk_bf16(v0[0], v0[1]); w.y = pk_bf16(v0[2], v0[3]); w.z = pk_bf16(v1[0], v1[1]); w.w = pk_bf16(v1[2], v1[3]);
                    *(u32x4*)(rowp + bj * HALF) = w; } }
    }
};
struct EpiBf16x3 {
    static constexpr bool PERM = true;
    EpiBf16 E0, E1, E2;
    __device__ __forceinline__ void operator()(const f32x4 (&acc)[2][2][4][2], const Unit& u, int wr, int wc, int fr, int fq) const {
        if (u.gid == 0) E0(acc, u, wr, wc, fr, fq); else if (u.gid == 1) E1(acc, u, wr, wc, fr, fq); else E2(acc, u, wr, wc, fr, fq); }
};
struct EpiResidSS {
    static constexpr bool PERM = false;
    const float* X; bf16_t* X1; float* ss;
    __device__ __forceinline__ void operator()(const f32x4 (&acc)[2][2][4][2], const Unit& u, int wr, int wc, int fr, int fq) const {
        const int row0 = u.pm * BM + wr * 64 + fr, col0 = u.pn * BM + wc * 32 + 4 * fq;
#pragma unroll
        for (int ai = 0; ai < 2; ++ai)
#pragma unroll
            for (int m = 0; m < 4; ++m) { const int row = row0 + ai * HALF + m * 16; const size_t off = (size_t)row * D + col0; float s = 0.f;
#pragma unroll
                for (int bj = 0; bj < 2; ++bj)
#pragma unroll
                    for (int n = 0; n < 2; ++n) { const f32x4 xv = *(const f32x4*)(X + off + bj * HALF + n * 16); const f32x4 o = xv + acc[ai][bj][m][n];
                        *(u32x2*)(X1 + off + bj * HALF + n * 16) = f32_to_bf4(o); s += (o[0] * o[0] + o[1] * o[1]) + (o[2] * o[2] + o[3] * o[3]); }
                s += __shfl_xor(s, 16); s += __shfl_xor(s, 32);
                if (fq == 0) (void)__hip_atomic_fetch_add(ss + row, s, __ATOMIC_RELAXED, __HIP_MEMORY_SCOPE_AGENT); }
    }
};
struct EpiSwiGLU {
    static constexpr bool PERM = true;
    bf16_t* H;
    __device__ __forceinline__ void operator()(const f32x4 (&acc)[2][2][4][2], const Unit& u, int wr, int wc, int fr, int fq) const {
        const int row0 = u.pm * BM + wr * 64 + fr, col0 = (u.pn & 7) * HALF + wc * 32 + 8 * fq;
#pragma unroll
        for (int ai = 0; ai < 2; ++ai)
#pragma unroll
            for (int m = 0; m < 4; ++m) { const int row = row0 + ai * HALF + m * 16; float h[8];
                unsigned char* rowp = (unsigned char*)H + ((((size_t)(row >> 8) * (FF / 128) + (col0 >> 7)) << 15) + ((row & 255) << 7) + (col0 & 127));
#pragma unroll
                for (int n = 0; n < 2; ++n)
#pragma unroll
                    for (int j = 0; j < 4; ++j) { const float gt = acc[ai][0][m][n][j], up = acc[ai][1][m][n][j]; h[n * 4 + j] = 8.0f * gt * sigmoidf_fast(gt) * up; }
                *(u32x2*)rowp = (u32x2){pk_fp8x4(h[0], h[1], h[2], h[3]), pk_fp8x4(h[4], h[5], h[6], h[7])}; }
    }
};
struct EpiGateScale {
    static constexpr bool PERM = true;
    bf16_t* Y; const float* gate;
    __device__ __forceinline__ void operator()(const f32x4 (&acc)[2][2][4][2], const Unit& u, int wr, int wc, int fr, int fq) const {
        const int row0 = u.pm * BM + wr * 64 + fr, col0 = (u.pn & 3) * BM + wc * 32 + 8 * fq;
#pragma unroll
        for (int ai = 0; ai < 2; ++ai)
#pragma unroll
            for (int m = 0; m < 4; ++m) { const int row = row0 + ai * HALF + m * 16; const float gs = gate[row]; bf16_t* rowp = Y + (size_t)row * D + col0;
#pragma unroll
                for (int bj = 0; bj < 2; ++bj) { const f32x4 v0 = acc[ai][bj][m][0] * gs, v1 = acc[ai][bj][m][1] * gs;
                    u32x4 w; w.x = pk_bf16(v0[0], v0[1]); w.y = pk_bf16(v0[2], v0[3]); w.z = pk_bf16(v1[0], v1[1]); w.w = pk_bf16(v1[2], v1[3]);
                    *(u32x4*)(rowp + bj * HALF) = w; } }
    }
};

template <class Epi, class Sched, bool GATHER, bool ATILED = false, bool FP8 = false>
__device__ __forceinline__ void gemm_phase(PG8_LAS unsigned char* lds, const Gemm g, const Sched& S, const Epi& E, const int* rowtok, const int wv) {
    int tid = tid_of(wv); asm volatile("" : "+v"(tid));
    const int wid = __builtin_amdgcn_readfirstlane(tid >> 6), lane = tid & 63, wr = wid >> 2, wc = wid & 3, fr = lane & 15, fq = lane >> 4;
    const int K = g.K, nt = K / BK;
    unsigned voffA0, voffB0;
    { int R, C; stage_rc(tid * 16, R, C); const int Rb = Epi::PERM ? ((R & ~31) + perm32(R & 31)) : R;
      voffA0 = ATILED ? (unsigned)(R * BK + C) * 2u : (unsigned)(R * K + C) * 2u; voffB0 = (unsigned)(Rb * K + C) * 2u; }
    const size_t dA = ATILED ? (size_t)64 * BK * 2 : (size_t)64 * K * 2, dB = (size_t)64 * K * 2;
    unsigned vAc[2][2], vAn[2][2];
    const size_t kstep = (size_t)(BK * 2);
    const size_t hstep = (size_t)HALF * K * 2;
    const size_t tstep = 2 * hstep;
    const size_t kstepA = ATILED ? (size_t)BM * BK * 2 : kstep, hstepA = ATILED ? (size_t)HALF * BK * 2 : hstep;
    const unsigned ldsw = (unsigned)wid * 1024u;
    const unsigned ldsbase = __builtin_amdgcn_readfirstlane((unsigned)(size_t)lds) + ldsw;
    const int aoff = lds_byte(wr * 64 + fr, fq * 8), boff = lds_byte(wc * 32 + fr, fq * 8);
#define PG8_SA(b, h) (((b) * 2 + (h)) * HTB)
#define PG8_SB(b, h) ((4 + (b) * 2 + (h)) * HTB)
#define PG8_GLDS(vo_, sb_, lo_) asm volatile("s_add_u32 m0, %2, %3\n\ts_nop 0\n\tglobal_load_lds_dwordx4 %0, %1" :: "v"(vo_), "s"((const void*)(sb_)), "s"(ldsbase), "n"(lo_) : "m0", "scc", "memory")
#define PG8_STAGE_D(bufoff, gbase, voff0, delta) do { PG8_GLDS(voff0, gbase, (bufoff)); PG8_GLDS(voff0, (const char*)(gbase) + (delta), (bufoff) + 8192); } while (0)
#define PG8_STAGE(bufoff, gbase, voff) do { PG8_GLDS((voff)[0], gbase, (bufoff)); PG8_GLDS((voff)[1], gbase, (bufoff) + 8192); } while (0)
#define PG8_STAGE_A(bufoff, hh, dbase, kbytes, vsel) do { if constexpr (GATHER) { PG8_STAGE(bufoff, (const char*)g.A + (kbytes), (vsel)[hh]); } else { PG8_STAGE_D(bufoff, (dbase) + ((hh) ? hstepA : 0), voffA0, dA); } } while (0)
#define PG8_GATHER_OFF(dst, un) do { int R_, C_; stage_rc(tid * 16, R_, C_); _Pragma("unroll") for (int _h = 0; _h < 2; ++_h) _Pragma("unroll") for (int _i = 0; _i < 2; ++_i) \
        (dst)[_h][_i] = (unsigned)rowtok[(un).pm * BM + _h * HALF + R_ + 64 * _i] * (unsigned)(K * 2) + (unsigned)(C_ * 2); } while (0)
#define PG8_LDA(dst, b, h) do { _Pragma("unroll") for (int m = 0; m < 4; ++m) _Pragma("unroll") for (int k = 0; k < 2; ++k) dst[m][k] = *(const PG8_LAS bf16x8*)(lds + PG8_SA(b, h) + aoff + m * 2048 + k * 1024); } while (0)
#define PG8_LDB(dst, b, h) do { _Pragma("unroll") for (int n = 0; n < 2; ++n) _Pragma("unroll") for (int k = 0; k < 2; ++k) dst[n][k] = *(const PG8_LAS bf16x8*)(lds + PG8_SB(b, h) + boff + n * 2048 + k * 1024); } while (0)
#define PG8_MMA(ai, bj, At, Bt) do { __builtin_amdgcn_s_setprio(1); _Pragma("unroll") for (int m = 0; m < 4; ++m) _Pragma("unroll") for (int n = 0; n < 2; ++n) _Pragma("unroll") for (int k = 0; k < 2; ++k) \
        acc[ai][bj][m][n] = __builtin_amdgcn_mfma_f32_16x16x32_bf16(Bt[n][k], At[m][k], acc[ai][bj][m][n], 0, 0, 0); __builtin_amdgcn_s_setprio(0); } while (0)
#define PG8_CAT8(lo_, hi_) __builtin_shufflevector(lo_, hi_, 0, 1, 2, 3, 4, 5, 6, 7)
#define PG8_LDA8(b, h) do { _Pragma("unroll") for (int m = 0; m < 4; ++m) { const v4i lo_ = *(const PG8_LAS v4i*)(lds + PG8_SA(b, h) + aoff + m * 2048), hi_ = *(const PG8_LAS v4i*)(lds + PG8_SA(b, h) + aoff + m * 2048 + 1024); A8[m] = PG8_CAT8(lo_, hi_); } } while (0)
#define PG8_LDB8(dst, b, h) do { _Pragma("unroll") for (int n = 0; n < 2; ++n) { const v4i lo_ = *(const PG8_LAS v4i*)(lds + PG8_SB(b, h) + boff + n * 2048), hi_ = *(const PG8_LAS v4i*)(lds + PG8_SB(b, h) + boff + n * 2048 + 1024); dst[n] = PG8_CAT8(lo_, hi_); } } while (0)
#define PG8_MMA8(ai, bj, Bt8) do { __builtin_amdgcn_s_setprio(1); _Pragma("unroll") for (int m = 0; m < 4; ++m) _Pragma("unroll") for (int n = 0; n < 2; ++n) \
        acc[ai][bj][m][n] = __builtin_amdgcn_mfma_scale_f32_16x16x128_f8f6f4(Bt8[n], A8[m], acc[ai][bj][m][n], 0, 0, 0, g.sw, 0, g.sx); __builtin_amdgcn_s_setprio(0); } while (0)
#define PG8_LDAX(b, h) do { if constexpr (FP8) { PG8_LDA8(b, h); } else { PG8_LDA(At, b, h); } } while (0)
#define PG8_LDBX(w, b, h) do { if constexpr (FP8) { if (w) { PG8_LDB8(B81, b, h); } else { PG8_LDB8(B80, b, h); } } else { if (w) { PG8_LDB(B1, b, h); } else { PG8_LDB(B0, b, h); } } } while (0)
#define PG8_MMX(ai, bj, w) do { if constexpr (FP8) { if (w) { PG8_MMA8(ai, bj, B81); } else { PG8_MMA8(ai, bj, B80); } } else { if (w) { PG8_MMA(ai, bj, At, B1); } else { PG8_MMA(ai, bj, At, B0); } } } while (0)
#define PG8_WAIT_V(n) asm volatile("s_waitcnt vmcnt(" #n ")" ::: "memory")
#define PG8_WAIT_L(n) asm volatile("s_waitcnt lgkmcnt(" #n ")" ::: "memory")
#define PG8_BAR __builtin_amdgcn_s_barrier()
#define PG8_SCHED __builtin_amdgcn_sched_barrier(0)
    Unit cur, nxt; int ui = 0;
    if (!S.next(0, cur)) return;
    f32x4 acc[2][2][4][2];
#pragma unroll
    for (int a = 0; a < 2; ++a)
#pragma unroll
        for (int b = 0; b < 2; ++b)
#pragma unroll
            for (int m = 0; m < 4; ++m)
#pragma unroll
                for (int n = 0; n < 2; ++n) acc[a][b][m][n] = (f32x4){0.f, 0.f, 0.f, 0.f};
    bf16x8 At[4][2], B0[2][2], B1[2][2]; v8i A8[4], B80[2], B81[2];
    const char* cA = GATHER ? (const char*)g.A : S.aptr(g, cur, tstep); const char* cB = S.bptr(g, cur, tstep);
    if constexpr (GATHER) { PG8_GATHER_OFF(vAc, cur); }
    PG8_STAGE_D(PG8_SB(0, 0), cB, voffB0, dB); PG8_STAGE_A(PG8_SA(0, 0), 0, cA, 0, vAc); PG8_STAGE_D(PG8_SB(0, 1), cB + hstep, voffB0, dB); PG8_STAGE_A(PG8_SA(0, 1), 1, cA, 0, vAc);
    if (wr == 1) PG8_BAR;
    PG8_WAIT_V(4); PG8_BAR;
    PG8_STAGE_D(PG8_SB(1, 0), cB + kstep, voffB0, dB); PG8_STAGE_A(PG8_SA(1, 0), 0, cA + kstepA, kstep, vAc); PG8_STAGE_D(PG8_SB(1, 1), cB + hstep + kstep, voffB0, dB);
    PG8_WAIT_V(6); PG8_BAR;
    for (;;) {
        const bool has_next = S.next(ui + 1, nxt);
        const char* nA = (has_next && !GATHER) ? S.aptr(g, nxt, tstep) : cA; const char* nB = has_next ? S.bptr(g, nxt, tstep) : cB;
        if constexpr (GATHER) { if (has_next) { PG8_GATHER_OFF(vAn, nxt); } else {
#pragma unroll
            for (int _h = 0; _h < 2; ++_h)
#pragma unroll
                for (int _i = 0; _i < 2; ++_i) vAn[_h][_i] = vAc[_h][_i]; } }
#pragma unroll 1
        for (int t = 0; t < nt; t += 2) {
            const bool last = (t == nt - 2);
            const size_t k1 = (size_t)(t + 1) * kstep, k2 = last ? 0 : (size_t)(t + 2) * kstep, k3 = k2 + kstep;
            const char* a1 = cA + (size_t)(t + 1) * kstepA;
            const char* a2 = last ? nA : cA + (size_t)(t + 2) * kstepA; const char* b2 = last ? nB : cB + (size_t)(t + 2) * kstep;
            const char* a3 = a2 + kstepA; const char* b3 = b2 + kstep;
            PG8_LDBX(0, 0, 0); PG8_SCHED; PG8_LDAX(0, 0); PG8_STAGE_A(PG8_SA(1, 1), 1, a1, k1, vAc);
            if constexpr (GATHER) { if (last) {
#pragma unroll
                for (int _h = 0; _h < 2; ++_h)
#pragma unroll
                    for (int _i = 0; _i < 2; ++_i) vAc[_h][_i] = vAn[_h][_i]; } }
            PG8_WAIT_L(8); PG8_BAR; PG8_WAIT_L(0); PG8_MMX(0, 0, 0); PG8_BAR; PG8_SCHED;
            PG8_LDBX(1, 0, 1); PG8_STAGE_D(PG8_SB(0, 0), b2, voffB0, dB);
            PG8_BAR; PG8_WAIT_L(0); PG8_MMX(0, 1, 1); PG8_BAR;
            PG8_LDAX(0, 1); PG8_STAGE_A(PG8_SA(0, 0), 0, a2, k2, vAc);
            PG8_BAR; PG8_WAIT_L(0); PG8_MMX(1, 0, 0); PG8_BAR; PG8_SCHED;
            PG8_STAGE_D(PG8_SB(0, 1), b2 + hstep, voffB0, dB);
            PG8_WAIT_V(6); PG8_BAR; PG8_MMX(1, 1, 1); PG8_BAR;
            PG8_LDBX(0, 1, 0); PG8_SCHED; PG8_LDAX(1, 0); PG8_STAGE_A(PG8_SA(0, 1), 1, a2, k2, vAc);
            PG8_WAIT_L(8); PG8_BAR; PG8_WAIT_L(0); PG8_MMX(0, 0, 0); PG8_BAR; PG8_SCHED;
            PG8_LDBX(1, 1, 1); PG8_STAGE_D(PG8_SB(1, 0), b3, voffB0, dB);
            PG8_BAR; PG8_WAIT_L(0); PG8_MMX(0, 1, 1); PG8_BAR;
            PG8_LDAX(1, 1); PG8_STAGE_A(PG8_SA(1, 0), 0, a3, k3, vAc);
            PG8_BAR; PG8_WAIT_L(0); PG8_MMX(1, 0, 0); PG8_BAR; PG8_SCHED;
            PG8_STAGE_D(PG8_SB(1, 1), b3 + hstep, voffB0, dB);
            PG8_WAIT_V(6); PG8_BAR; PG8_MMX(1, 1, 1); PG8_BAR;
        }
        E(acc, cur, wr, wc, fr, fq);
        if (!has_next) break;
#pragma unroll
        for (int a = 0; a < 2; ++a)
#pragma unroll
            for (int b = 0; b < 2; ++b)
#pragma unroll
                for (int m = 0; m < 4; ++m)
#pragma unroll
                    for (int n = 0; n < 2; ++n) acc[a][b][m][n] = (f32x4){0.f, 0.f, 0.f, 0.f};
        cur = nxt; cA = nA; cB = nB; ++ui;
        if constexpr (GATHER) {
#pragma unroll
            for (int _h = 0; _h < 2; ++_h)
#pragma unroll
                for (int _i = 0; _i < 2; ++_i) vAc[_h][_i] = vAn[_h][_i]; }
    }
    PG8_WAIT_V(0);
    if (wr == 0) PG8_BAR;
    PG8_BAR;
#undef PG8_SA
#undef PG8_SB
#undef PG8_STAGE
#undef PG8_STAGE_D
#undef PG8_GLDS
#undef PG8_STAGE_A
#undef PG8_GATHER_OFF
#undef PG8_LDA
#undef PG8_LDB
#undef PG8_MMA
#undef PG8_MMA8
#undef PG8_LDA8
#undef PG8_LDB8
#undef PG8_LDAX
#undef PG8_LDBX
#undef PG8_MMX
#undef PG8_CAT8
#undef PG8_WAIT_V
#undef PG8_WAIT_L
#undef PG8_BAR
#undef PG8_SCHED
}
}

struct Args {
    const float* in[29];
    float* out; unsigned char* ws;
    int ph_lo, ph_hi;
    int wv, zero_;
};
enum { I_X = 0, I_MEM, I_NMIXG, I_NMEMG, I_WIN, I_WMK, I_WMV, I_CONVW, I_CONVB, I_CLNG, I_CLNB, I_SHIFTMU, I_DW0, I_DUP, I_IA0, I_IUP, I_GUP, I_KK, I_KA, I_RK,
       I_LNXG, I_LNXB, I_WOUT, I_NFFNG, I_WROUTER, I_WEG, I_WEU, I_WED, I_FNG };

template <bool F8 = false>
__device__ __forceinline__ void transpose_item(const float* W, int N, bf16_t* WT, int K, int k0, int n0, int drow0, LAS float* scr, int lane) {
    {
        f32x4 v[8];
#pragma unroll
        for (int i = 0; i < 8; ++i) v[i] = *(const f32x4*)(W + (size_t)(k0 + 8 * i + (lane >> 3)) * N + n0 + 4 * (lane & 7));
#pragma unroll
        for (int i = 0; i < 8; ++i) { LAS float* d = scr + (8 * i + (lane >> 3)) * 33 + 4 * (lane & 7); d[0] = v[i].x; d[1] = v[i].y; d[2] = v[i].z; d[3] = v[i].w; }
    }
    asm volatile("s_waitcnt lgkmcnt(0)" ::: "memory");
    const int c = lane & 7;
#pragma unroll
    for (int j = 0; j < 4; ++j) { const int n = (lane >> 3) + 8 * j; const LAS float* s = scr + (8 * c) * 33 + n;
        if constexpr (F8) { *(u32x2*)((unsigned char*)WT + (size_t)(drow0 + n) * K + k0 + 8 * c) = (u32x2){pk_fp8x4(32.f * s[0 * 33], 32.f * s[1 * 33], 32.f * s[2 * 33], 32.f * s[3 * 33]), pk_fp8x4(32.f * s[4 * 33], 32.f * s[5 * 33], 32.f * s[6 * 33], 32.f * s[7 * 33])}; }
        else { u32x4 o; o.x = pk_bf16(s[0 * 33], s[1 * 33]); o.y = pk_bf16(s[2 * 33], s[3 * 33]); o.z = pk_bf16(s[4 * 33], s[5 * 33]); o.w = pk_bf16(s[6 * 33], s[7 * 33]);
            *(u32x4*)(WT + (size_t)(drow0 + n) * K + k0 + 8 * c) = o; } }
    asm volatile("s_waitcnt lgkmcnt(0)" ::: "memory");
}
__device__ __forceinline__ void expert_prep_items(const Args& a, LAS unsigned char* lds, int widx, int nw, int it_lo, int it_hi) {
    int tid = tid_of(a.wv); asm volatile("" : "+v"(tid)); const int lane = tid & 63, wave = __builtin_amdgcn_readfirstlane(tid >> 6);
    LAS float* scr = (LAS float*)(lds + wave * 16384);
    unsigned char* ws = a.ws;
    constexpr int S_EXP = 16 * 16 * 32;
    for (int r = it_lo + widx; r < it_hi; r += nw) {
        const int which = r / S_EXP, q = r % S_EXP, e = q / 512, kb = (q % 512) / 32, nb = q % 32, n0 = nb * 32;
        if (which == 0) transpose_item<true>(a.in[I_WEG] + (size_t)e * D * FF, FF, (bf16_t*)(ws + WS_WGUT + (size_t)e * 2048 * D), D, kb * 64, n0, (n0 >> 7) * 256 + (n0 & 127), scr, lane);
        else if (which == 1) transpose_item<true>(a.in[I_WEU] + (size_t)e * D * FF, FF, (bf16_t*)(ws + WS_WGUT + (size_t)e * 2048 * D), D, kb * 64, n0, (n0 >> 7) * 256 + 128 + (n0 & 127), scr, lane);
        else transpose_item<true>(a.in[I_WED] + (size_t)e * FF * D, D, (bf16_t*)(ws + WS_WDT + (size_t)e * D * FF), FF, kb * 64, n0, n0, scr, lane);
    }
}

__device__ __forceinline__ void rms_row_to_bf16(const float* xrow, const float* g, bf16_t* orow, int lane) {
    const f32x4* xr = (const f32x4*)xrow + lane; const f32x4* gr = (const f32x4*)g + lane;
    f32x4 v[4]; float s = 0.f;
#pragma unroll
    for (int j = 0; j < 4; ++j) { v[j] = xr[64 * j]; s += (v[j].x * v[j].x + v[j].y * v[j].y) + (v[j].z * v[j].z + v[j].w * v[j].w); }
    const float rs = 1.0f / sqrtf(wave_sum(s) * (1.f / D) + 1e-6f);
    u32x2* o8 = (u32x2*)orow + lane;
#pragma unroll
    for (int j = 0; j < 4; ++j) { const f32x4 gg = gr[64 * j]; u32x2 w; w.x = pk_bf16(v[j].x * rs * gg.x, v[j].y * rs * gg.y); w.y = pk_bf16(v[j].z * rs * gg.z, v[j].w * rs * gg.w); o8[64 * j] = w; }
}
__device__ __forceinline__ void phase_prep(const Args& a, LAS unsigned char* lds, int G) {
    int tid = tid_of(a.wv); asm volatile("" : "+v"(tid)); const int lane = tid & 63, wave = __builtin_amdgcn_readfirstlane(tid >> 6);
    LAS float* scr = (LAS float*)(lds + wave * 16384);
    const int gw = blockIdx.x * 8 + wave, NGW = G * 8;
    unsigned char* ws = a.ws;
    constexpr int S_WIN = 16 * 80, S_WOUT = 16 * 32, S_MK = 16 * 8, S_SM = 12, S_GUP = 24;
    constexpr int NITEMS = S_WIN + S_WOUT + 2 * S_MK + 4 * S_SM + S_GUP;
    for (int it = gw; it < NITEMS; it += NGW) {
        int r = it;
        if (r < S_WIN) { const int kb = r / 80, nb = r % 80; transpose_item(a.in[I_WIN], IN_PROJ, (bf16_t*)(ws + WS_WINT), D, kb * 64, nb * 32, nb * 32, scr, lane); continue; } r -= S_WIN;
        if (r < S_WOUT) { const int kb = r / 32, nb = r % 32; transpose_item(a.in[I_WOUT], D, (bf16_t*)(ws + WS_WOUTT), D, kb * 64, nb * 32, nb * 32, scr, lane); continue; } r -= S_WOUT;
        if (r < S_MK) { const int kb = r / 8, nb = r % 8; transpose_item(a.in[I_WMK], 256, (bf16_t*)(ws + WS_WKT), D, kb * 64, nb * 32, nb * 32, scr, lane); continue; } r -= S_MK;
        if (r < S_MK) { const int kb = r / 8, nb = r % 8; transpose_item(a.in[I_WMV], 256, (bf16_t*)(ws + WS_WVT), D, kb * 64, nb * 32, nb * 32, scr, lane); continue; } r -= S_MK;
        if (r < 4 * S_SM) { const int which = r / S_SM, nb = r % S_SM;
            const float* src = (which < 2 ? a.in[I_DUP] : a.in[I_IUP]) + (size_t)(which & 1) * 64 * RW;
            transpose_item(src, RW, (bf16_t*)(ws + WS_SMALL) + (size_t)which * RW * 64, 64, 0, nb * 32, nb * 32, scr, lane); continue; } r -= 4 * S_SM;
        { const int kb = r / 12, nb = r % 12; transpose_item(a.in[I_GUP], RW, (bf16_t*)(ws + WS_SMALL) + (size_t)4 * RW * 64, 128, kb * 64, nb * 32, nb * 32, scr, lane); }
    }
    for (int m = gw; m < T; m += NGW) rms_row_to_bf16(a.in[I_X] + (size_t)m * D, a.in[I_NMIXG], (bf16_t*)(ws + WS_XH) + (size_t)m * D, lane);
    for (int m = gw; m < BATCH * NMEM; m += NGW) rms_row_to_bf16(a.in[I_MEM] + (size_t)m * D, a.in[I_NMEMG], (bf16_t*)(ws + WS_MEMN) + (size_t)m * D, lane);
}

constexpr int AT_KS = 144;
constexpr int AT_VS = 520;
constexpr int AT_VOFF = 256 * AT_KS;
__device__ __forceinline__ bf16x8 pack_step(const f32x16& x, int s) {
    u32x4 p;
    asm volatile("v_cvt_pk_bf16_f32 %0, %4, %5\n\tv_cvt_pk_bf16_f32 %1, %6, %7\n\tv_cvt_pk_bf16_f32 %2, %8, %9\n\tv_cvt_pk_bf16_f32 %3, %10, %11\n\ts_nop 1"
                 : "=&v"(p[0]), "=&v"(p[1]), "=&v"(p[2]), "=&v"(p[3])
                 : "v"(x[8 * s]), "v"(x[8 * s + 1]), "v"(x[8 * s + 2]), "v"(x[8 * s + 3]), "v"(x[8 * s + 4]), "v"(x[8 * s + 5]), "v"(x[8 * s + 6]), "v"(x[8 * s + 7]));
    return __builtin_bit_cast(bf16x8, p);
}
__device__ __forceinline__ void attn_unit(const Args& a, LAS unsigned char* lds, int unit) {
    int tid = tid_of(a.wv); asm volatile("" : "+v"(tid)); const int lane = tid & 63, wave = __builtin_amdgcn_readfirstlane(tid >> 6), r = lane & 31, h = lane >> 5;
    const int b = unit >> 2, hh = unit & 3;
    const bf16_t* Qb = (const bf16_t*)(a.ws + WS_Q); const bf16_t* KM = (const bf16_t*)(a.ws + WS_KMEM); const bf16_t* VT = (const bf16_t*)(a.ws + WS_VT);
    bf16_t* MIX = (bf16_t*)(a.ws + WS_MIX);
    __syncthreads();
#pragma unroll
    for (int i = 0; i < 4; ++i) { const int c = tid + 512 * i, key = c >> 3, ch = c & 7;
        const u32x4 v = *(const u32x4*)(KM + (size_t)(b * NMEM + key) * 256 + hh * 64 + ch * 8);
        *(LAS u32x4*)(lds + key * AT_KS + ch * 16) = v; }
#pragma unroll
    for (int i = 0; i < 4; ++i) { const int c = tid + 512 * i, d = c >> 5, ch = c & 31;
        const u32x4 v = *(const u32x4*)(VT + (size_t)(hh * 64 + d) * (BATCH * NMEM) + b * NMEM + ch * 8);
        LAS u32x2* dst = (LAS u32x2*)(lds + AT_VOFF + d * AT_VS + ch * 16);
        dst[0] = (u32x2){v.x, v.y}; dst[1] = (u32x2){v.z, v.w}; }
    __syncthreads();
#pragma unroll 1
    for (int tile = 0; tile < 16; ++tile) {
    const int tok0 = b * SEQ + tile * 256 + wave * 32;
    bf16x8 qf[4];
#pragma unroll
    for (int ks = 0; ks < 4; ++ks) qf[ks] = *(const bf16x8*)(Qb + (size_t)(tok0 + r) * 256 + hh * 64 + ks * 16 + h * 8);
    const float sc = 0.125f * 1.4426950408889634f;
    float m_run = -3.0e38f, sum = 0.f;
    f32x16 o[2];
#pragma unroll
    for (int dt = 0; dt < 2; ++dt)
#pragma unroll
        for (int i = 0; i < 16; ++i) o[dt][i] = 0.f;
#pragma unroll 1
    for (int kh = 0; kh < 2; ++kh) {
        f32x16 s[4];
#pragma unroll
        for (int k4 = 0; k4 < 4; ++k4) {
#pragma unroll
            for (int i = 0; i < 16; ++i) s[k4][i] = 0.f;
#pragma unroll
            for (int ks = 0; ks < 4; ++ks) { const bf16x8 ka = *(const LAS bf16x8*)(lds + ((kh * 4 + k4) * 32 + r) * AT_KS + (ks * 16 + h * 8) * 2);
                s[k4] = __builtin_amdgcn_mfma_f32_32x32x16_bf16(ka, qf[ks], s[k4], 0, 0, 0); }
        }
        float mx = m_run;
#pragma unroll
        for (int k4 = 0; k4 < 4; ++k4)
#pragma unroll
            for (int i = 0; i < 16; ++i) mx = fmaxf(mx, s[k4][i]);
        mx = fmaxf(mx, __shfl_xor(mx, 32));
        const float alpha = __builtin_amdgcn_exp2f((m_run - mx) * sc);
        float ps = 0.f;
#pragma unroll
        for (int k4 = 0; k4 < 4; ++k4)
#pragma unroll
            for (int i = 0; i < 16; ++i) { const float e = __builtin_amdgcn_exp2f((s[k4][i] - mx) * sc); s[k4][i] = e; ps += e; }
        ps += __shfl_xor(ps, 32);
        sum = sum * alpha + ps; m_run = mx;
#pragma unroll
        for (int dt = 0; dt < 2; ++dt)
#pragma unroll
            for (int i = 0; i < 16; ++i) o[dt][i] *= alpha;
#pragma unroll
        for (int k4 = 0; k4 < 4; ++k4)
#pragma unroll
            for (int s2 = 0; s2 < 2; ++s2) {
                const bf16x8 pb = pack_step(s[k4], s2);
#pragma unroll
                for (int dt = 0; dt < 2; ++dt) {
                    const LAS unsigned char* vp = lds + AT_VOFF + (32 * dt + r) * AT_VS + (32 * (kh * 4 + k4) + 16 * s2 + 4 * h) * 2;
                    const s16x4 lo = *(const LAS s16x4*)vp, hi = *(const LAS s16x4*)(vp + 16);
                    const bf16x8 va = __builtin_shufflevector(lo, hi, 0, 1, 2, 3, 4, 5, 6, 7);
                    o[dt] = __builtin_amdgcn_mfma_f32_32x32x16_bf16(va, pb, o[dt], 0, 0, 0);
                }
            }
    }
    const float inv = 1.0f / sum;
    bf16_t* orow = MIX + (size_t)(tok0 + r) * D + hh * 64;
#pragma unroll
    for (int dt = 0; dt < 2; ++dt)
#pragma unroll
        for (int gq = 0; gq < 4; ++gq) { u32x2 w; w.x = pk_bf16(o[dt][4 * gq] * inv, o[dt][4 * gq + 1] * inv); w.y = pk_bf16(o[dt][4 * gq + 2] * inv, o[dt][4 * gq + 3] * inv);
            *(u32x2*)(orow + 32 * dt + 8 * gq + 4 * h) = w; }
    }
}

__device__ __forceinline__ void conv_unit(const Args& a, LAS unsigned char* lds, int unit) {
    int tid = tid_of(a.wv); asm volatile("" : "+v"(tid)); const int lane = tid & 63, wave = __builtin_amdgcn_readfirstlane(tid >> 6);
    const int b = unit >> 6, t0 = (unit & 63) * 64;
    const bf16_t* P = (const bf16_t*)(a.ws + WS_P); bf16_t* MIX = (bf16_t*)(a.ws + WS_MIX);
    LAS _Float16* U = (LAS _Float16*)lds;
    LAS _Float16* Cc = (LAS _Float16*)(lds + 94 * CW * 2);
    __syncthreads();
#pragma unroll 1
    for (int q0 = tid; q0 < 94 * 48; q0 += 3 * NTHREADS) {
        u32x4 vvv[3], ggg[3];
#pragma unroll
        for (int u3 = 0; u3 < 3; ++u3) { const int q = q0 + u3 * NTHREADS, j = q / 48, cc = (q % 48) * 8, s = t0 - 15 + j; const bool ok = (q < 94 * 48) && s >= 0 && s < SEQ;
            const bf16_t* row = P + (size_t)(b * SEQ + (ok ? s : 0)) * PLD + cc;
            vvv[u3] = ok ? *(const u32x4*)row : (u32x4){0u, 0u, 0u, 0u}; ggg[u3] = ok ? *(const u32x4*)(row + CW) : (u32x4){0u, 0u, 0u, 0u}; }
#pragma unroll
        for (int u3 = 0; u3 < 3; ++u3) { const int q = q0 + u3 * NTHREADS, j = q / 48, cc = (q % 48) * 8;
            if (q < 94 * 48) {
                const unsigned vw[4] = {vvv[u3].x, vvv[u3].y, vvv[u3].z, vvv[u3].w}, gw[4] = {ggg[u3].x, ggg[u3].y, ggg[u3].z, ggg[u3].w};
                float u[8];
#pragma unroll
                for (int k = 0; k < 4; ++k) { u[2 * k] = bf_lo(vw[k]) * sigmoidf_fast(bf_lo(gw[k])); u[2 * k + 1] = bf_hi(vw[k]) * sigmoidf_fast(bf_hi(gw[k])); }
                LAS f16x4* dst = (LAS f16x4*)(U + j * CW + cc); dst[0] = (f16x4){(_Float16)u[0], (_Float16)u[1], (_Float16)u[2], (_Float16)u[3]}; dst[1] = (f16x4){(_Float16)u[4], (_Float16)u[5], (_Float16)u[6], (_Float16)u[7]}; }
        }
    }
    __syncthreads();
    const int cq = tid & 127, tq = tid >> 7;
#pragma unroll 1
    for (int k3 = 0; k3 < 3; ++k3) { const int c = cq + 128 * k3;
        float w[31], res[16];
#pragma unroll
        for (int kk = 0; kk < 31; ++kk) w[kk] = a.in[I_CONVW][kk * CW + c];
        const float bias = a.in[I_CONVB][c];
#pragma unroll
        for (int tt = 0; tt < 16; ++tt) res[tt] = bias;
#pragma unroll
        for (int jj = 0; jj < 46; ++jj) { const float uv = (float)U[(tq * 16 + jj) * CW + c];
#pragma unroll
            for (int tt = 0; tt < 16; ++tt) { if (jj - tt >= 0 && jj - tt <= 30) res[tt] += uv * w[jj - tt]; } }
#pragma unroll
        for (int tt = 0; tt < 16; ++tt) Cc[(tq * 16 + tt) * CW + c] = (_Float16)res[tt];
    }
    __syncthreads();
    for (int tt = 0; tt < 8; ++tt) { const int t = wave * 8 + tt;
        float v[6]; float s = 0.f;
#pragma unroll
        for (int i = 0; i < 6; ++i) { v[i] = (float)Cc[t * CW + lane + 64 * i]; s += v[i]; }
        const float mean = wave_sum(s) * (1.f / CW); float q = 0.f;
#pragma unroll
        for (int i = 0; i < 6; ++i) { v[i] -= mean; q += v[i] * v[i]; }
        const float rstd = 1.0f / sqrtf(wave_sum(q) * (1.f / CW) + 1e-5f);
        bf16_t* orow = MIX + (size_t)(b * SEQ + t0 + t) * D + 256;
#pragma unroll
        for (int i = 0; i < 6; ++i) { const int c = lane + 64 * i; const float y = v[i] * rstd * a.in[I_CLNG][c] + a.in[I_CLNB][c]; const float o = y * sigmoidf_fast(y);
            orow[c] = (bf16_t)(pk_bf16(o, 0.f) & 0xffffu); }
    }
}

constexpr int PR_AS = 784;
constexpr int PR_RK = 64 * PR_AS;
constexpr int PR_RKS = 1536;
constexpr int PR_RN = PR_RK + 64 * PR_RKS;
constexpr int PR_CST = PR_RN + 2048;
static_assert(PR_CST + 7 * 384 * 4 <= LDS_BYTES - 64, "prep LDS map");
template <int V> struct IC { static constexpr int value = V; };
template <int CTRL> __device__ __forceinline__ f32x4 dpp4(f32x4 x) { return (f32x4){dpp_f<CTRL>(x.x), dpp_f<CTRL>(x.y), dpp_f<CTRL>(x.z), dpp_f<CTRL>(x.w)}; }
__device__ __forceinline__ void prep_unit(const Args& a, LAS unsigned char* lds, int unit) {
    int tid = tid_of(a.wv); asm volatile("" : "+v"(tid)); const int lane = tid & 63, wave = __builtin_amdgcn_readfirstlane(tid >> 6);
    const int b = unit >> 6, t0 = (unit & 63) * 64;
    const bf16_t* __restrict__ P = (const bf16_t*)(a.ws + WS_P);
    const float* __restrict__ mu = a.in[I_SHIFTMU];
    LAS float* RNs = (LAS float*)(lds + PR_RN); LAS float* CST = (LAS float*)(lds + PR_CST);
    __syncthreads();
    for (int i = tid; i < 7 * 384; i += NTHREADS) { const int w7 = i / 384, c7 = i % 384;
        CST[i] = (w7 == 0) ? a.in[I_KK][c7] : (w7 == 1) ? a.in[I_KA][c7] : (w7 == 2) ? a.in[I_RK][c7] : (w7 < 5) ? a.in[I_DW0][(w7 - 3) * RW + c7] : a.in[I_IA0][(w7 - 5) * RW + c7]; }
#ifndef PREP_REP1
#define PREP_REP1 1
#endif
    auto s1_batch = [&](auto tyc) {
        constexpr int ty = decltype(tyc)::value;
        u32x4 cuv[6], pvv[6], nvv[6]; int ttv[6], c8v[6];
#pragma unroll
        for (int u = 0; u < 6; ++u) { int tt, c8;
            if (ty < 3) { const int q = tid + u * NTHREADS; tt = q / 48; c8 = ty * 384 + (q % 48) * 8; }
            else { const int q = tid + (u & 1) * NTHREADS; tt = q >> 4; c8 = 1152 + (u >> 1) * 128 + (q & 15) * 8; }
            ttv[u] = tt; c8v[u] = c8; const int sq = t0 + tt;
            const bf16_t* row = P + ((size_t)b * SEQ + sq) * PLD + 768 + c8;
            cuv[u] = *(const u32x4*)row;
            pvv[u] = (sq > 0) ? *(const u32x4*)(row - PLD) : (u32x4){0u, 0u, 0u, 0u};
            nvv[u] = (sq < SEQ - 1) ? *(const u32x4*)(row + PLD) : (u32x4){0u, 0u, 0u, 0u}; }
#pragma unroll
        for (int u = 0; u < 6; ++u) { const int tt = ttv[u], c8 = c8v[u]; const size_t tok = (size_t)b * SEQ + t0 + tt;
            const u32x4 cu = cuv[u], pv = pvv[u], nv = nvv[u];
            const unsigned cw[4] = {cu.x, cu.y, cu.z, cu.w}, pw[4] = {pv.x, pv.y, pv.z, pv.w}, nw[4] = {nv.x, nv.y, nv.z, nv.w};
            const f32x4 m0a = *(const f32x4*)(mu + c8), m0b = *(const f32x4*)(mu + c8 + 4), m1a = *(const f32x4*)(mu + 1536 + c8), m1b = *(const f32x4*)(mu + 1536 + c8 + 4);
            const float m0[8] = {m0a.x, m0a.y, m0a.z, m0a.w, m0b.x, m0b.y, m0b.z, m0b.w}, m1[8] = {m1a.x, m1a.y, m1a.z, m1a.w, m1b.x, m1b.y, m1b.z, m1b.w};
            float pf[8];
#pragma unroll
            for (int k = 0; k < 4; ++k) { const float c0 = bf_lo(cw[k]), c1 = bf_hi(cw[k]);
                pf[2 * k] = c0 + m0[2 * k] * (bf_lo(pw[k]) - c0) + m1[2 * k] * (bf_lo(nw[k]) - c0);
                pf[2 * k + 1] = c1 + m0[2 * k + 1] * (bf_hi(pw[k]) - c1) + m1[2 * k + 1] * (bf_hi(nw[k]) - c1); }
            if (ty < 2) {
                f16x4 h0 = {(_Float16)pf[0], (_Float16)pf[1], (_Float16)pf[2], (_Float16)pf[3]}, h1 = {(_Float16)pf[4], (_Float16)pf[5], (_Float16)pf[6], (_Float16)pf[7]};
                LAS f16x4* dst = (LAS f16x4*)(lds + PR_RK + tt * PR_RKS + c8 * 2); dst[0] = h0; dst[1] = h1;
                if (ty == 1) { const f32x4 ka = *(const f32x4*)(a.in[I_KK] + c8 - 384), kb = *(const f32x4*)(a.in[I_KK] + c8 - 384 + 4);
                    float ssq = (pf[0] * ka.x) * (pf[0] * ka.x) + (pf[1] * ka.y) * (pf[1] * ka.y) + (pf[2] * ka.z) * (pf[2] * ka.z) + (pf[3] * ka.w) * (pf[3] * ka.w)
                              + (pf[4] * kb.x) * (pf[4] * kb.x) + (pf[5] * kb.y) * (pf[5] * kb.y) + (pf[6] * kb.z) * (pf[6] * kb.z) + (pf[7] * kb.w) * (pf[7] * kb.w);
                    ssq = sum8(ssq);
                    if ((lane & 7) == 0) RNs[tt * 8 + ((c8 - 384) >> 6)] = __builtin_amdgcn_rsqf(ssq + 1e-12f); }
            } else if (ty == 2) {
                u32x4 w; w.x = pk_bf16(pf[0], pf[1]); w.y = pk_bf16(pf[2], pf[3]); w.z = pk_bf16(pf[4], pf[5]); w.w = pk_bf16(pf[6], pf[7]);
                *(u32x4*)((bf16_t*)scan_arr(a.ws, 0) + hat_off(0, tok, c8 - 768)) = w;
            } else {
                const int cc = c8 - 1152;
#pragma unroll
                for (int k = 0; k < 8; ++k) { if ((u >> 1) == 0) pf[k] = 1.0f - 2.0f * __builtin_amdgcn_rcpf(1.0f + __builtin_amdgcn_exp2f(2.8853900817779268f * pf[k])); else if ((u >> 1) == 2) pf[k] = sigmoidf_fast(pf[k]); }
                u32x4 w; w.x = pk_bf16(pf[0], pf[1]); w.y = pk_bf16(pf[2], pf[3]); w.z = pk_bf16(pf[4], pf[5]); w.w = pk_bf16(pf[6], pf[7]);
                *(LAS u32x4*)(lds + tt * PR_AS + cc * 2) = w; }
        }
    };
#pragma unroll 1
    for (int rp1 = 0; rp1 < PREP_REP1; ++rp1) { s1_batch(IC<0>{}); s1_batch(IC<1>{}); s1_batch(IC<2>{}); s1_batch(IC<3>{}); }
    __syncthreads();
    const int l15 = lane & 15, kq = lane >> 4;
    float* __restrict__ PCg = (float*)(a.ws + WS_PC); float* __restrict__ BON = (float*)(a.ws + WS_BON);
    const char* SMb = (const char*)(a.ws + WS_SMALL);
    const unsigned wlo64 = (unsigned)(((8 * (l15 >> 2) + (l15 & 3)) * 64 + kq * 8) * 2), wlo128 = (unsigned)(((8 * (l15 >> 2) + (l15 & 3)) * 128 + kq * 8) * 2);
    const unsigned hlo = (unsigned)((l15 * 64 + 8 * kq) * 2), klo = (unsigned)((l15 * D + 8 * kq) * 2), glo = (unsigned)((l15 * RW + 8 * kq) * 2);
    bf16x8 Fc[16], Fn[16];
#define PREP_LOADW(hd_, kind_) do { \
        if ((kind_) < 2) { const char* w_ = SMb + ((size_t)(kind_) * RW * 64 + (size_t)(hd_) * 64 * 64) * 2; \
            _Pragma("unroll") for (int f_ = 0; f_ < 16; ++f_) Fn[f_] = *(const bf16x8*)(w_ + (size_t)(((f_ >> 2) & 1) * (2 * RW * 64 * 2) + (32 * ((f_ & 3) >> 1) + 4 * (f_ & 1)) * 128 + (f_ >> 3) * 64) + wlo64); } \
        else { const char* w_ = SMb + ((size_t)4 * RW * 64 + (size_t)(hd_) * 64 * 128) * 2; \
            _Pragma("unroll") for (int f_ = 0; f_ < 16; ++f_) Fn[f_] = *(const bf16x8*)(w_ + (size_t)((32 * ((f_ & 3) >> 1) + 4 * (f_ & 1)) * 256 + (f_ >> 2) * 64) + wlo128); } } while (0)
    auto dir_stage = [&](auto dc, const int it, const int nhd, const int nkind) {
        constexpr int d = decltype(dc)::value;
        const int hd = it >> 2, mt = it & 3, tokl = mt * 16 + l15; const size_t tb = (size_t)b * SEQ + t0 + mt * 16;
#pragma unroll
        for (int f = 0; f < 16; ++f) Fc[f] = Fn[f];
        f32x4 accW[4], accA[4];
#pragma unroll
        for (int nt = 0; nt < 4; ++nt) { accW[nt] = (f32x4){0.f, 0.f, 0.f, 0.f}; accA[nt] = (f32x4){0.f, 0.f, 0.f, 0.f}; }
#pragma unroll
        for (int ks = 0; ks < 2; ++ks) {
            const bf16x8 aw = *(const LAS bf16x8*)(lds + tokl * PR_AS + (d * 64 + ks * 32 + kq * 8) * 2), aa = *(const LAS bf16x8*)(lds + tokl * PR_AS + ((2 + d) * 64 + ks * 32 + kq * 8) * 2);
#pragma unroll
            for (int nt = 0; nt < 4; ++nt) { accW[nt] = MFMA16(Fc[ks * 8 + nt], aw, accW[nt]); accA[nt] = MFMA16(Fc[ks * 8 + 4 + nt], aa, accA[nt]); }
        }
        if (nkind >= 0) PREP_LOADW(nhd, nkind);
        const float rn = RNs[tokl * 8 + hd];
        const size_t tile_b = ((((tb >> 4) * NH + hd) << 10)) * 2;
        char* AHb = (char*)scan_arr(a.ws, 1 + 4 * d) + tile_b; char* RHb = (char*)scan_arr(a.ws, 2 + 4 * d) + tile_b; char* BHb = (char*)scan_arr(a.ws, 3 + 4 * d) + tile_b;
        char* KHb = d ? (char*)scan_arr(a.ws, 8) + (tb * D + hd * 64) * 2 : (char*)scan_arr(a.ws, 4) + tile_b; const unsigned khlo = d ? klo : hlo;
        char* PCb = (char*)(PCg + ((size_t)d * (T / 16) + (tb >> 4)) * RW + hd * 64); char* BOb = (char*)(BON + (size_t)d * T * NH + tb * NH + hd);
        float bsum = 0.f;
        u32x2 hA[2], hR[2], hB[2], hK[2]; f32x4 PtS[4];
#pragma unroll
        for (int nt = 0; nt < 4; ++nt) { const int ch = hd * 64 + 32 * (nt >> 1) + 8 * kq + 4 * (nt & 1);
            const f32x4 bW = *(const LAS f32x4*)(CST + (3 + d) * 384 + ch), bA = *(const LAS f32x4*)(CST + (5 + d) * 384 + ch);
            const f32x4 kkw = *(const LAS f32x4*)(CST + ch), kaw = *(const LAS f32x4*)(CST + 384 + ch), rkw = *(const LAS f32x4*)(CST + 768 + ch);
            const f32x4 zw = accW[nt] + bW, za = accA[nt] + bA;
            f32x4 lw, av;
#pragma unroll
            for (int e = 0; e < 4; ++e) { lw[e] = -0.606531f * 1.4426950408889634f * sigmoidf_fast(zw[e]); av[e] = sigmoidf_fast(za[e]); }
            f32x4 cum = lw;
            if (d == 0) { cum += dpp4<0x111>(cum); cum += dpp4<0x112>(cum); cum += dpp4<0x114>(cum); cum += dpp4<0x118>(cum); }
            else        { cum += dpp4<0x101>(cum); cum += dpp4<0x102>(cum); cum += dpp4<0x104>(cum); cum += dpp4<0x108>(cum); }
            f32x4 Pt, Pinv, Pprev;
#pragma unroll
            for (int e = 0; e < 4; ++e) { Pt[e] = __builtin_amdgcn_exp2f(cum[e]); Pinv[e] = __builtin_amdgcn_rcpf(Pt[e]);
                Pprev[e] = __builtin_amdgcn_exp2f(cum[e] - lw[e]); }
            PtS[nt] = Pt;
            const f32x4 r4 = __builtin_convertvector(*(const LAS f16x4*)(lds + PR_RK + tokl * PR_RKS + ch * 2), f32x4);
            const f32x4 k4 = __builtin_convertvector(*(const LAS f16x4*)(lds + PR_RK + tokl * PR_RKS + (384 + ch) * 2), f32x4);
            const f32x4 kk = k4 * kkw * rn, kd = k4 * (1.0f + (av - 1.0f) * kaw);
            hA[nt & 1] = f32_to_bf4(-kk * Pprev); hR[nt & 1] = f32_to_bf4(r4 * Pt); hB[nt & 1] = f32_to_bf4(kk * av * Pinv); hK[nt & 1] = f32_to_bf4(kd * Pinv);
            const f32x4 bt = r4 * kd * rkw; bsum += (bt.x + bt.y) + (bt.z + bt.w);
            if (nt & 1) { const int pr = nt >> 1;
                *(u32x4*)(AHb + (hlo + 64 * pr)) = (u32x4){hA[0].x, hA[0].y, hA[1].x, hA[1].y}; *(u32x4*)(RHb + (hlo + 64 * pr)) = (u32x4){hR[0].x, hR[0].y, hR[1].x, hR[1].y};
                *(u32x4*)(BHb + (hlo + 64 * pr)) = (u32x4){hB[0].x, hB[0].y, hB[1].x, hB[1].y}; *(u32x4*)(KHb + (khlo + 64 * pr)) = (u32x4){hK[0].x, hK[0].y, hK[1].x, hK[1].y}; }
        }
        if (l15 == (d ? 0 : 15)) {
#pragma unroll
            for (int nt = 0; nt < 4; ++nt) *(f32x4*)(PCb + (unsigned)(8 * kq * 4) + (32 * (nt >> 1) + 4 * (nt & 1)) * 4) = PtS[nt]; }
        bsum += __shfl_xor(bsum, 16); bsum += __shfl_xor(bsum, 32);
        if (kq == 0) *(float*)(BOb + (unsigned)(l15 * NH * 4)) = bsum;
    };
    auto gate_stage = [&](const int it, const int nhd, const int nkind) {
        const int hd = it >> 2, mt = it & 3, tokl = mt * 16 + l15; const size_t tb = (size_t)b * SEQ + t0 + mt * 16;
#pragma unroll
        for (int f = 0; f < 16; ++f) Fc[f] = Fn[f];
        f32x4 acc[4];
#pragma unroll
        for (int nt = 0; nt < 4; ++nt) acc[nt] = (f32x4){0.f, 0.f, 0.f, 0.f};
#pragma unroll
        for (int ks = 0; ks < 4; ++ks) { const bf16x8 afr = *(const LAS bf16x8*)(lds + tokl * PR_AS + (256 + ks * 32 + kq * 8) * 2);
#pragma unroll
            for (int nt = 0; nt < 4; ++nt) acc[nt] = MFMA16(Fc[ks * 4 + nt], afr, acc[nt]); }
        if (nkind >= 0) PREP_LOADW(nhd, nkind);
        char* Gb = (char*)((bf16_t*)(a.ws + WS_G) + tb * RW + hd * 64);
#pragma unroll
        for (int pr = 0; pr < 2; ++pr) { const u32x2 g0 = f32_to_bf4(acc[2 * pr]), g1 = f32_to_bf4(acc[2 * pr + 1]);
            *(u32x4*)(Gb + (glo + 64 * pr)) = (u32x4){g0.x, g0.y, g1.x, g1.y}; }
    };
    PREP_LOADW(wave >> 2, 0);
#pragma unroll 1
    for (int k3 = 0; k3 < 3; ++k3) { const int it = wave + 8 * k3, hd = it >> 2;
        dir_stage(IC<0>{}, it, hd, 1);
        dir_stage(IC<1>{}, it, hd, 2);
        gate_stage(it, (it + 8) >> 2, k3 < 2 ? 0 : -1);
    }
#undef PREP_LOADW
}

__device__ __forceinline__ void glds16_asm(const void* gptr, LAS unsigned char* ldst) {
    const unsigned la = __builtin_amdgcn_readfirstlane((unsigned)(size_t)ldst);
    asm volatile("s_mov_b32 m0, %1\n\ts_nop 0\n\tglobal_load_lds_dwordx4 %0, off" :: "v"(gptr), "s"(la) : "m0", "memory");
}
constexpr int CK = 16, NCHUNK = SEQ / CK, CS_NS = 8, CS_NPROD = 6, CS_NCONS = 2;
constexpr int SL_ATIL = 0, SL_RTIL = 2048, SL_BH = 4096, SL_KH = 6144, SL_V = 8192, SL_ULOC = 10240, SL_YLOC = 12288, SL_PC = 14336, SL_BYTES = 14592;
constexpr int PS_AH = 0, PS_RH = 2048, PS_BYTES = 4096;
constexpr int CS_PS_OFF = CS_NS * SL_BYTES, CS_FLAG_OFF = CS_PS_OFF + CS_NPROD * PS_BYTES;
static_assert(CS_FLAG_OFF + 64 <= LDS_BYTES - 64, "chunked scan LDS map");
__device__ __forceinline__ int swz(int t, int j) { return t * 128 + ((((j >> 3) ^ (t & 7))) << 4) + ((j & 4) << 1); }
__device__ __forceinline__ void scan_chunked_unit(const Args& a, LAS unsigned char* lds, int unit) {
    int tid = tid_of(a.wv); asm volatile("" : "+v"(tid)); const int lane = tid & 63, wave = __builtin_amdgcn_readfirstlane(tid >> 6);
    const int dir = unit & 1, bh = unit >> 1, b = bh / NH, hd = bh % NH;
    const int c16 = lane & 15, q = lane >> 4, qp = c16 >> 2, pp = c16 & 3;
    volatile LAS unsigned* FULL = (volatile LAS unsigned*)(lds + CS_FLAG_OFF);
    volatile LAS unsigned* DONE = FULL + 8;
    float* Yg = (float*)(a.ws + (dir ? WS_YB : WS_YF));
    __syncthreads();
    if (tid < 16) FULL[tid] = 0u;
    __syncthreads();
    if (wave >= CS_NCONS) {
        const int pw = wave - CS_NCONS;
        LAS unsigned char* ps = lds + CS_PS_OFF + pw * PS_BYTES;
        const bf16_t* ARR[5] = {(const bf16_t*)scan_arr(a.ws, 1 + 4 * dir), (const bf16_t*)scan_arr(a.ws, 2 + 4 * dir), (const bf16_t*)scan_arr(a.ws, 3 + 4 * dir), (const bf16_t*)scan_arr(a.ws, 4 + 4 * dir), (const bf16_t*)scan_arr(a.ws, 0)};
        const int AIDX[5] = {1 + 4 * dir, 2 + 4 * dir, 3 + 4 * dir, 4 + 4 * dir, 0};
        const float* PCg = (const float*)(a.ws + WS_PC) + (size_t)dir * (T / 16) * RW + hd * 64 + lane;
        u32x4 pf[10];
#define CS_ISSUE(cc) do { _Pragma("unroll") for (int ar_ = 0; ar_ < 5; ++ar_) _Pragma("unroll") for (int hf_ = 0; hf_ < 2; ++hf_) { \
            const int row_ = hf_ * 8 + (lane >> 3); const int st_ = (cc) * CK + row_; const int t_ = dir ? (SEQ - 1 - st_) : st_; \
            pf[ar_ * 2 + hf_] = *(const u32x4*)(ARR[ar_] + hat_off(AIDX[ar_], (size_t)b * SEQ + t_, hd * 64 + 8 * ((lane & 7) ^ (row_ & 7)))); } } while (0)
#define CS_PCLOAD(cc) PCg[(size_t)((size_t)b * (SEQ / CK) + (dir ? (NCHUNK - 1 - (cc)) : (cc))) * RW]
        CS_ISSUE(pw);
        float pcn = CS_PCLOAD(pw);
#pragma unroll 1
        for (int c = pw; c < NCHUNK; c += CS_NPROD) {
            const int slot = c % CS_NS; LAS unsigned char* sl = lds + slot * SL_BYTES;
            { unsigned sp = 0; const unsigned want = (unsigned)CS_NCONS * (unsigned)(c / CS_NS); while (DONE[slot] < want) { __builtin_amdgcn_s_sleep(1); if (++sp > (1u << 22)) break; } }
            asm volatile("" ::: "memory");
            *(LAS u32x4*)(ps + PS_AH + lane * 16) = pf[0]; *(LAS u32x4*)(ps + PS_AH + 1024 + lane * 16) = pf[1];
            *(LAS u32x4*)(ps + PS_RH + lane * 16) = pf[2]; *(LAS u32x4*)(ps + PS_RH + 1024 + lane * 16) = pf[3];
            *(LAS u32x4*)(sl + SL_BH + lane * 16) = pf[4]; *(LAS u32x4*)(sl + SL_BH + 1024 + lane * 16) = pf[5];
            *(LAS u32x4*)(sl + SL_KH + lane * 16) = pf[6]; *(LAS u32x4*)(sl + SL_KH + 1024 + lane * 16) = pf[7];
            *(LAS u32x4*)(sl + SL_V + lane * 16) = pf[8]; *(LAS u32x4*)(sl + SL_V + 1024 + lane * 16) = pf[9];
            *(LAS float*)(sl + SL_PC + lane * 4) = pcn;
            if (c + CS_NPROD < NCHUNK) { CS_ISSUE(c + CS_NPROD); pcn = CS_PCLOAD(c + CS_NPROD); }
            asm volatile("s_waitcnt lgkmcnt(0)" ::: "memory");
#ifndef PROD_REP
#define PROD_REP 1
#endif
#pragma unroll 1
            for (int rpp = 0; rpp < PROD_REP; ++rpp) {
            bf16x8 AHf[2], BHf[2], KHf[2], RHf[2];
#pragma unroll
            for (int ks = 0; ks < 2; ++ks) { const int o = swz(c16, 32 * ks + 8 * q);
                AHf[ks] = *(const LAS bf16x8*)(ps + PS_AH + o); RHf[ks] = *(const LAS bf16x8*)(ps + PS_RH + o); BHf[ks] = *(const LAS bf16x8*)(sl + SL_BH + o); KHf[ks] = *(const LAS bf16x8*)(sl + SL_KH + o); }
            f32x4 Mab = {0.f, 0.f, 0.f, 0.f}, Mak = Mab, MrbT = Mab, MrkT = Mab, MabT = Mab;
#pragma unroll
            for (int ks = 0; ks < 2; ++ks) { Mab = MFMA16(AHf[ks], BHf[ks], Mab); MabT = MFMA16(BHf[ks], AHf[ks], MabT); Mak = MFMA16(AHf[ks], KHf[ks], Mak); MrbT = MFMA16(BHf[ks], RHf[ks], MrbT); MrkT = MFMA16(KHf[ks], RHf[ks], MrkT); }
#pragma unroll
            for (int r = 0; r < 4; ++r) { const bool lt = c16 < 4 * q + r, gt = 4 * q + r < c16, le = 4 * q + r <= c16;
                Mab[r] = lt ? Mab[r] : 0.f; Mak[r] = lt ? Mak[r] : 0.f; MabT[r] = gt ? MabT[r] : 0.f; MrbT[r] = le ? MrbT[r] : 0.f; MrkT[r] = le ? MrkT[r] : 0.f; }
            const f32x4 z4 = {0.f, 0.f, 0.f, 0.f};
            const bf16x8 fN = frag_lo4(Mab), fNT = frag_lo4(MabT);
            const f32x4 N2 = MFMA16(fNT, fN, z4), N2T = MFMA16(fN, fNT, z4);
            f32x4 PT = MabT;
#pragma unroll
            for (int r = 0; r < 4; ++r) PT[r] += (4 * q + r == c16) ? 1.0f : 0.f;
            const bf16x8 fN2 = frag_lo4(N2), fN2T = frag_lo4(N2T);
            PT = MFMA16(fN2, frag_lo4(PT), PT);
            const f32x4 N4 = MFMA16(fN2T, fN2, z4), N4T = MFMA16(fN2, fN2T, z4);
            const bf16x8 fN4 = frag_lo4(N4), fN4T = frag_lo4(N4T);
            PT = MFMA16(fN4, frag_lo4(PT), PT);
            const f32x4 N8 = MFMA16(fN4T, fN4, z4);
            PT = MFMA16(frag_lo4(N8), frag_lo4(PT), PT);
            const bf16x8 LinvF = frag_lo4(PT);
            const bf16x8 MakF = frag_lo4(Mak), MrbTF = frag_lo4(MrbT);
            const f32x4 W1 = MFMA16(LinvF, MakF, z4);
            const f32x4 W1T = MFMA16(MakF, LinvF, z4);
            const f32x4 W2T = MFMA16(frag_lo4(W1), MrbTF, MrkT);
            f32x4 AtT[4], RtT[4];
#pragma unroll
            for (int jt = 0; jt < 4; ++jt) {
                const bf16x8 ahF = frag_cat(__builtin_bit_cast(u32x2, tr_read16(ps + PS_AH + swz(4 * q + qp, 16 * jt + 4 * pp))), (u32x2){0u, 0u});
                const f32x4 AtN = MFMA16(LinvF, ahF, z4);
                AtT[jt] = MFMA16(ahF, LinvF, z4);
                const f32x4 rinit = bf4_to_f32(*(const LAS u32x2*)(ps + PS_RH + swz(c16, 16 * jt + 4 * q)));
                RtT[jt] = MFMA16(frag_lo4(AtN), MrbTF, rinit);
            }
#pragma unroll
            for (int ks = 0; ks < 2; ++ks) {
                const u32x4 wa = {pk_bf16(AtT[2 * ks][0], AtT[2 * ks][1]), pk_bf16(AtT[2 * ks][2], AtT[2 * ks][3]), pk_bf16(AtT[2 * ks + 1][0], AtT[2 * ks + 1][1]), pk_bf16(AtT[2 * ks + 1][2], AtT[2 * ks + 1][3])};
                const u32x4 wr = {pk_bf16(RtT[2 * ks][0], RtT[2 * ks][1]), pk_bf16(RtT[2 * ks][2], RtT[2 * ks][3]), pk_bf16(RtT[2 * ks + 1][0], RtT[2 * ks + 1][1]), pk_bf16(RtT[2 * ks + 1][2], RtT[2 * ks + 1][3])};
                *(LAS u32x4*)(sl + SL_ATIL + ks * 1024 + lane * 16) = wa; *(LAS u32x4*)(sl + SL_RTIL + ks * 1024 + lane * 16) = wr; }
            *(LAS u32x2*)(sl + SL_ULOC + lane * 8) = f32_to_bf4(W1T); *(LAS u32x2*)(sl + SL_YLOC + lane * 8) = f32_to_bf4(W2T);
            }
            asm volatile("s_waitcnt lgkmcnt(0)" ::: "memory");
            if (lane == 0) FULL[slot] = (unsigned)(c + 1);
        }
#undef CS_ISSUE
#undef CS_PCLOAD
    } else {
        struct ConsOps { bf16x8 at0, at1, rt0, rt1, bk[4]; u32x2 w1w, w2w, vfw[2]; f32x4 pc[4]; };
        f32x4 S[2][4];
#pragma unroll
        for (int ti = 0; ti < 2; ++ti)
#pragma unroll
            for (int mt = 0; mt < 4; ++mt) S[ti][mt] = (f32x4){0.f, 0.f, 0.f, 0.f};
#define CONS_LOAD(X, cc) do { const int slot_ = (cc) % CS_NS; LAS unsigned char* sl_ = lds + slot_ * SL_BYTES; \
            { unsigned sp_ = 0; while (FULL[slot_] < (unsigned)((cc) + 1)) { __builtin_amdgcn_s_sleep(1); if (++sp_ > (1u << 22)) break; } } \
            asm volatile("" ::: "memory"); \
            X.at0 = *(const LAS bf16x8*)(sl_ + SL_ATIL + lane * 16); X.at1 = *(const LAS bf16x8*)(sl_ + SL_ATIL + 1024 + lane * 16); \
            X.rt0 = *(const LAS bf16x8*)(sl_ + SL_RTIL + lane * 16); X.rt1 = *(const LAS bf16x8*)(sl_ + SL_RTIL + 1024 + lane * 16); \
            X.w1w = *(const LAS u32x2*)(sl_ + SL_ULOC + lane * 8); X.w2w = *(const LAS u32x2*)(sl_ + SL_YLOC + lane * 8); \
            _Pragma("unroll") for (int mt_ = 0; mt_ < 4; ++mt_) { X.pc[mt_] = *(const LAS f32x4*)(sl_ + SL_PC + (16 * mt_ + 4 * q) * 4); \
                X.bk[mt_] = frag_cat(__builtin_bit_cast(u32x2, tr_read16(sl_ + SL_BH + swz(4 * q + qp, 16 * mt_ + 4 * pp))), __builtin_bit_cast(u32x2, tr_read16(sl_ + SL_KH + swz(4 * q + qp, 16 * mt_ + 4 * pp)))); } \
            _Pragma("unroll") for (int ti_ = 0; ti_ < 2; ++ti_) X.vfw[ti_] = __builtin_bit_cast(u32x2, tr_read16(sl_ + SL_V + swz(4 * q + qp, 16 * (2 * wave + ti_) + 4 * pp))); } while (0)
#define CONS_COMPUTE(X, cc) do { const f32x4 z4c_ = {0.f, 0.f, 0.f, 0.f}; const bf16x8 w1f_ = frag_cat(X.w1w, (u32x2){0u, 0u}), w2f_ = frag_cat(X.w2w, (u32x2){0u, 0u}); \
            _Pragma("unroll") for (int ti_ = 0; ti_ < 2; ++ti_) { const int nt_ = 2 * wave + ti_; \
                const bf16x8 vB_ = frag_cat(X.vfw[ti_], (u32x2){0u, 0u}); \
                const bf16x8 Sb0_ = frag_cat(f32_to_bf4(S[ti_][0]), f32_to_bf4(S[ti_][1])), Sb1_ = frag_cat(f32_to_bf4(S[ti_][2]), f32_to_bf4(S[ti_][3])); \
                const f32x4 U0_ = MFMA16(X.at0, Sb0_, MFMA16(w1f_, vB_, z4c_)), U1_ = MFMA16(X.at1, Sb1_, z4c_); \
                const f32x4 Y0_ = MFMA16(X.rt0, Sb0_, MFMA16(w2f_, vB_, z4c_)), Y1_ = MFMA16(X.rt1, Sb1_, z4c_); \
                const f32x4 UT_ = U0_ + U1_, YT_ = Y0_ + Y1_; \
                const bf16x8 Ub_ = frag_cat(f32_to_bf4(UT_), X.vfw[ti_]); \
                _Pragma("unroll") for (int mt_ = 0; mt_ < 4; ++mt_) { S[ti_][mt_] = MFMA16(X.bk[mt_], Ub_, S[ti_][mt_]); S[ti_][mt_] = S[ti_][mt_] * X.pc[mt_]; } \
                *(f32x4*)(Yg + ((((size_t)b * NCHUNK + (dir ? (NCHUNK - 1 - (cc)) : (cc))) * NH + hd) * 64 + 16 * nt_ + c16) * 16 + 4 * q) = YT_; } } while (0)
#define CONS_DONE(cc) do { asm volatile("s_waitcnt lgkmcnt(0)" ::: "memory"); if (lane == 0) (void)__hip_atomic_fetch_add((LAS unsigned*)&DONE[(cc) % CS_NS], 1u, __ATOMIC_RELAXED, __HIP_MEMORY_SCOPE_WORKGROUP); } while (0)
        ConsOps OA, OB;
        CONS_LOAD(OA, 0);
#pragma unroll 1
        for (int c = 0; c < NCHUNK; c += 2) {
            CONS_LOAD(OB, c + 1);
            CONS_COMPUTE(OA, c);
            CONS_DONE(c);
            if (c + 2 < NCHUNK) CONS_LOAD(OA, c + 2);
            CONS_COMPUTE(OB, c + 1);
            CONS_DONE(c + 1);
        }
#undef CONS_LOAD
#undef CONS_COMPUTE
#undef CONS_DONE
        unsigned tq0 = 0u, tq1 = 0u, tq2 = 0u, tq3 = 0u, tq4 = 0u, tq5 = 0u, tacc = 0u;
        (void)tq0; (void)tq1; (void)tq2; (void)tq3; (void)tq4; (void)tq5;
        (void)tacc;
    }
}

__device__ __forceinline__ void phase_post(const Args& a, int G) {
    int tid = tid_of(a.wv); asm volatile("" : "+v"(tid)); const int lane = tid & 63, wave = __builtin_amdgcn_readfirstlane(tid >> 6);
    const int gw = blockIdx.x * 8 + wave, NGW = G * 8, t = lane & 15, iq = lane >> 4;
    const float* __restrict__ YF = (const float*)(a.ws + WS_YF); const float* __restrict__ YB = (const float*)(a.ws + WS_YB); const float* __restrict__ BON = (const float*)(a.ws + WS_BON);
    const bf16_t* __restrict__ Vg = (const bf16_t*)scan_arr(a.ws, 0); const bf16_t* __restrict__ Gg = (const bf16_t*)(a.ws + WS_G); bf16_t* __restrict__ MIX = (bf16_t*)(a.ws + WS_MIX);
    float* ss = (float*)(a.ws + WS_SS);
    for (int i = blockIdx.x * NTHREADS + tid; i < T; i += G * NTHREADS) ss[i] = 0.f;
    constexpr int NIT = (T / 16) * NH;
#pragma unroll 1
    for (int it = gw; it < NIT; it += NGW) {
        const int tile = it / NH, hd = it - tile * NH, tok = tile * 16 + t;
        const float* yfp = YF + ((size_t)it * 64 + 16 * iq) * 16 + t; const float* ybp = YB + ((size_t)it * 64 + 16 * iq) * 16 + (15 - t);
        float y[16];
#pragma unroll
        for (int k = 0; k < 16; ++k) y[k] = yfp[k * 16] + ybp[k * 16];
        const u32x4 v0 = *(const u32x4*)(Vg + ((size_t)it * 16 + t) * 64 + 16 * iq), v1 = *(const u32x4*)(Vg + ((size_t)it * 16 + t) * 64 + 16 * iq + 8);
        const u32x4 g0 = *(const u32x4*)(Gg + (size_t)tok * RW + hd * 64 + 16 * iq), g1 = *(const u32x4*)(Gg + (size_t)tok * RW + hd * 64 + 16 * iq + 8);
        const float bon = BON[(size_t)tok * NH + hd] + BON[(size_t)T * NH + (size_t)tok * NH + hd];
        float sm = 0.f;
#pragma unroll
        for (int k = 0; k < 16; ++k) sm += y[k];
        sm += __shfl_xor(sm, 16); sm += __shfl_xor(sm, 32);
        const float mean = sm * (1.f / 64.f); float vs = 0.f;
#pragma unroll
        for (int k = 0; k < 16; ++k) { y[k] -= mean; vs += y[k] * y[k]; }
        vs += __shfl_xor(vs, 16); vs += __shfl_xor(vs, 32);
        const float rstd = 1.0f / sqrtf(vs * (1.f / 64.f) + 64e-5f);
        const unsigned vw[8] = {v0.x, v0.y, v0.z, v0.w, v1.x, v1.y, v1.z, v1.w}, gwd[8] = {g0.x, g0.y, g0.z, g0.w, g1.x, g1.y, g1.z, g1.w};
        unsigned ow[8];
#pragma unroll
        for (int k2 = 0; k2 < 8; ++k2) { const int ch = hd * 64 + 16 * iq + 2 * k2;
            const float o0 = (y[2 * k2] * rstd * a.in[I_LNXG][ch] + a.in[I_LNXB][ch] + bon * bf_lo(vw[k2])) * bf_lo(gwd[k2]);
            const float o1 = (y[2 * k2 + 1] * rstd * a.in[I_LNXG][ch + 1] + a.in[I_LNXB][ch + 1] + bon * bf_hi(vw[k2])) * bf_hi(gwd[k2]);
            ow[k2] = pk_bf16(o0, o1); }
        bf16_t* op = MIX + (size_t)tok * D + 640 + hd * 64 + 16 * iq;
        *(u32x4*)op = (u32x4){ow[0], ow[1], ow[2], ow[3]}; *(u32x4*)(op + 8) = (u32x4){ow[4], ow[5], ow[6], ow[7]};
    }
}

constexpr int RT_WS = 2064;
__device__ __forceinline__ void phase_router(const Args& a, LAS unsigned char* lds, int G) {
    int tid = tid_of(a.wv); asm volatile("" : "+v"(tid)); const int lane = tid & 63, wave = __builtin_amdgcn_readfirstlane(tid >> 6);
    const int gw = blockIdx.x * 8 + wave, NGW = G * 8, l15 = lane & 15, kq = lane >> 4;
    LAS bf16_t* WH = (LAS bf16_t*)lds; LAS bf16_t* WL = (LAS bf16_t*)(lds + 16 * RT_WS);
    for (int i = tid; i < D * NE; i += NTHREADS) { const int k = i >> 4, e = i & 15; const float w = a.in[I_WROUTER][i];
        const unsigned hi = pk_bf16(w, 0.f) & 0xffffu; const float rem = w - bf_lo(hi);
        WH[e * (RT_WS / 2) + k] = (bf16_t)hi; WL[e * (RT_WS / 2) + k] = (bf16_t)(pk_bf16(rem, 0.f) & 0xffffu); }
    __syncthreads();
    const bf16_t* __restrict__ X1 = (const bf16_t*)(a.ws + WS_X1); const float* __restrict__ ss = (const float*)(a.ws + WS_SS); bf16_t* __restrict__ H2 = (bf16_t*)(a.ws + WS_H2);
    float* __restrict__ AFF = (float*)(a.ws + WS_AFF); int* __restrict__ INV = (int*)(a.ws + WS_INV);
    const float* __restrict__ GF = a.in[I_NFFNG];
    for (int grp = gw; grp < T / 16; grp += NGW) {
        const int tok = grp * 16 + l15;
        const float rs = 1.0f / sqrtf(ss[tok] * (1.f / D) + 1e-6f);
        f32x4 acc = {0.f, 0.f, 0.f, 0.f};
        const bf16_t* xrow = X1 + (size_t)tok * D + 8 * kq; unsigned char* hrow8 = (unsigned char*)H2 + (size_t)tok * D + 8 * kq;
#pragma unroll 8
        for (int ks = 0; ks < 32; ++ks) {
            const u32x4 xw = *(const u32x4*)(xrow + 32 * ks); const f32x4 x0 = {bf_lo(xw.x), bf_hi(xw.x), bf_lo(xw.y), bf_hi(xw.y)}, x1v = {bf_lo(xw.z), bf_hi(xw.z), bf_lo(xw.w), bf_hi(xw.w)};
            const f32x4 g0 = *(const f32x4*)(GF + 32 * ks + 8 * kq), g1 = *(const f32x4*)(GF + 32 * ks + 8 * kq + 4);
            const f32x4 h0 = x0 * rs * g0, h1 = x1v * rs * g1;
            u32x4 hi; hi.x = pk_bf16(h0.x, h0.y); hi.y = pk_bf16(h0.z, h0.w); hi.z = pk_bf16(h1.x, h1.y); hi.w = pk_bf16(h1.z, h1.w);
            *(u32x2*)(hrow8 + 32 * ks) = (u32x2){pk_fp8x4(h0.x, h0.y, h0.z, h0.w), pk_fp8x4(h1.x, h1.y, h1.z, h1.w)};
            u32x4 lo; lo.x = pk_bf16(h0.x - bf_lo(hi.x), h0.y - bf_hi(hi.x)); lo.y = pk_bf16(h0.z - bf_lo(hi.y), h0.w - bf_hi(hi.y));
            lo.z = pk_bf16(h1.x - bf_lo(hi.z), h1.y - bf_hi(hi.z)); lo.w = pk_bf16(h1.z - bf_lo(hi.w), h1.w - bf_hi(hi.w));
            const bf16x8 ah = __builtin_bit_cast(bf16x8, hi), al = __builtin_bit_cast(bf16x8, lo);
            const bf16x8 bh = *(const LAS bf16x8*)(lds + l15 * RT_WS + (32 * ks + 8 * kq) * 2), bl = *(const LAS bf16x8*)(lds + 16 * RT_WS + l15 * RT_WS + (32 * ks + 8 * kq) * 2);
            acc = __builtin_amdgcn_mfma_f32_16x16x32_bf16(ah, bh, acc, 0, 0, 0);
            acc = __builtin_amdgcn_mfma_f32_16x16x32_bf16(al, bh, acc, 0, 0, 0);
            acc = __builtin_amdgcn_mfma_f32_16x16x32_bf16(ah, bl, acc, 0, 0, 0);
        }
#pragma unroll
        for (int rg = 0; rg < 4; ++rg) { const float mx = max16(acc[rg]); const float ex = __expf(acc[rg] - mx); const float sm = sum16(ex);
            const int t2 = grp * 16 + 4 * kq + rg, bb = t2 >> 12, sq = t2 & (SEQ - 1);
            AFF[((size_t)(bb * NE + l15)) * SEQ + sq] = ex / sm; }
        *(u32x4*)(INV + (size_t)grp * 256 + 4 * lane) = (u32x4){0xffffffffu, 0xffffffffu, 0xffffffffu, 0xffffffffu};
    }
}

__device__ __forceinline__ void topk_unit(const Args& a, LAS unsigned char* lds, int unit) {
    int tid = tid_of(a.wv); asm volatile("" : "+v"(tid)); const int lane = tid & 63, wave = __builtin_amdgcn_readfirstlane(tid >> 6);
    const int b = unit >> 4, e = unit & 15;
    const float* AFF = (const float*)(a.ws + WS_AFF) + (size_t)unit * SEQ;
    LAS unsigned* KEY = (LAS unsigned*)lds;
    LAS unsigned* HIST = (LAS unsigned*)(lds + 16384);
    LAS unsigned* CTL = (LAS unsigned*)(lds + 16384 + 1024);
    LAS unsigned* WS_ = (LAS unsigned*)(lds + 16384 + 2048);
    __syncthreads();
    unsigned key[8];
    { const u32x4 k0 = *(const u32x4*)(AFF + tid * 8), k1 = *(const u32x4*)(AFF + tid * 8 + 4); key[0] = k0.x; key[1] = k0.y; key[2] = k0.z; key[3] = k0.w; key[4] = k1.x; key[5] = k1.y; key[6] = k1.z; key[7] = k1.w; }
    if (tid == 0) { CTL[0] = 0u; CTL[1] = (unsigned)CAP; }
    unsigned prefix = 0u, mask = 0u;
#pragma unroll 1
    for (int pass = 0; pass < 4; ++pass) {
        const int shift = 24 - 8 * pass;
        if (tid < 256) HIST[tid] = 0u;
        __syncthreads();
#pragma unroll
        for (int i = 0; i < 8; ++i) if ((key[i] & mask) == prefix) (void)__hip_atomic_fetch_add(&HIST[(key[i] >> shift) & 255u], 1u, __ATOMIC_RELAXED, __HIP_MEMORY_SCOPE_WORKGROUP);
        __syncthreads();
        if (wave == 0) {
            const unsigned need = CTL[1];
            unsigned hv[4], tsum = 0u;
#pragma unroll
            for (int i = 0; i < 4; ++i) { hv[i] = HIST[255 - (4 * lane + i)]; tsum += hv[i]; }
            unsigned inc = tsum;
#pragma unroll
            for (int o = 1; o < 64; o <<= 1) { const unsigned v = __shfl_up(inc, o); if (lane >= o) inc += v; }
            unsigned exc = inc - tsum;
            if (exc < need && need <= inc) {
                unsigned run = exc; int di = 0;
#pragma unroll
                for (int i = 0; i < 4; ++i) { if (run < need && need <= run + hv[i]) { di = i; break; } run += hv[i]; }
                const unsigned digit = 255u - (unsigned)(4 * lane + di);
                CTL[0] = prefix | (digit << shift); CTL[1] = need - run;
            }
        }
        __syncthreads();
        prefix = CTL[0]; mask |= (255u << shift);
    }
    const unsigned thr = prefix, need_eq = CTL[1];
    unsigned ngt = 0u, neq = 0u;
#pragma unroll
    for (int i = 0; i < 8; ++i) { ngt += (key[i] > thr) ? 1u : 0u; neq += (key[i] == thr) ? 1u : 0u; }
    unsigned pk = ngt | (neq << 16), inc = pk;
#pragma unroll
    for (int o = 1; o < 64; o <<= 1) { const unsigned v = __shfl_up(inc, o); if (lane >= o) inc += v; }
    if (lane == 63) WS_[wave] = inc;
    __syncthreads();
    unsigned woff = 0u, tot = 0u;
#pragma unroll
    for (int w = 0; w < 8; ++w) { const unsigned v = WS_[w]; if (w < wave) woff += v; tot += v; }
    const unsigned exc = inc - pk + woff;
    unsigned gpos = exc & 0xffffu, epos = exc >> 16; const unsigned totgt = tot & 0xffffu;
    const int sbase = (e * BATCH + b) * CAP;
    int* ROWTOK = (int*)(a.ws + WS_ROWTOK); float* ROWGATE = (float*)(a.ws + WS_ROWGATE); int* INV = (int*)(a.ws + WS_INV);
#pragma unroll
    for (int i = 0; i < 8; ++i) {
        int pos = -1;
        if (key[i] > thr) pos = (int)gpos++;
        else if (key[i] == thr) { if (epos < need_eq) pos = (int)(totgt + epos); epos++; }
        if (pos >= 0) { const int s = tid * 8 + i, tok = b * SEQ + s, slot = sbase + pos;
            ROWTOK[slot] = tok; ROWGATE[slot] = __builtin_bit_cast(float, key[i]); INV[(size_t)tok * NE + e] = slot; }
    }
}

__device__ __forceinline__ void phase_final(const Args& a, int G) {
    int tid = tid_of(a.wv); asm volatile("" : "+v"(tid)); const int lane = tid & 63, wave = __builtin_amdgcn_readfirstlane(tid >> 6);
    const int gw = blockIdx.x * 8 + wave, NGW = G * 8;
    const bf16_t* __restrict__ X1 = (const bf16_t*)(a.ws + WS_X1); const bf16_t* __restrict__ YE = (const bf16_t*)(a.ws + WS_YE); const int* __restrict__ INV = (const int*)(a.ws + WS_INV);
    float* __restrict__ OUT = a.out;
    f32x4 gg[4];
#pragma unroll
    for (int j = 0; j < 4; ++j) gg[j] = *(const f32x4*)(a.in[I_FNG] + 4 * lane + 256 * j);
#define PF_SLOTS(inv_, n_, m_, sl_) do { m_ = __ballot((inv_) >= 0) & 0xffffull; n_ = __builtin_popcountll(m_); unsigned long long mm_ = m_; \
        _Pragma("unroll") for (int k_ = 0; k_ < 4; ++k_) { if (mm_) { const int e_ = __builtin_ctzll(mm_); mm_ &= mm_ - 1; sl_[k_] = __builtin_amdgcn_readlane((inv_), e_); } else sl_[k_] = 0; } m_ = mm_; } while (0)
#define PF_ROWS(rw_, xr_, tk_, n_, sl_) do { \
        _Pragma("unroll") for (int k_ = 0; k_ < 4; ++k_) { if (k_ < (n_)) { _Pragma("unroll") for (int j_ = 0; j_ < 4; ++j_) rw_[k_][j_] = *(const u32x2*)(YE + (size_t)sl_[k_] * D + 4 * lane + 256 * j_); } \
            else { _Pragma("unroll") for (int j_ = 0; j_ < 4; ++j_) rw_[k_][j_] = (u32x2){0u, 0u}; } } \
        _Pragma("unroll") for (int j_ = 0; j_ < 4; ++j_) xr_[j_] = *(const u32x2*)(X1 + (size_t)(tk_) * D + 4 * lane + 256 * j_); } while (0)
    int tok = gw;
    if (tok >= T) return;
    int inv0 = INV[(size_t)tok * NE + (lane & 15)];
    int inv1 = (tok + NGW < T) ? INV[(size_t)(tok + NGW) * NE + (lane & 15)] : -1;
    unsigned long long mc; int nc, slc[4]; u32x2 rwc[4][4], xc[4];
    PF_SLOTS(inv0, nc, mc, slc);
    PF_ROWS(rwc, xc, tok, nc, slc);
    for (; tok < T; tok += NGW) {
        const int t1 = tok + NGW, t2 = tok + 2 * NGW;
        const int inv2 = (t2 < T) ? INV[(size_t)t2 * NE + (lane & 15)] : -1;
        unsigned long long mn = 0ull; int nn = 0, sln[4] = {0, 0, 0, 0}; u32x2 rwn[4][4], xn[4];
        if (t1 < T) { PF_SLOTS(inv1, nn, mn, sln); PF_ROWS(rwn, xn, t1, nn, sln); }
        else {
#pragma unroll
            for (int k = 0; k < 4; ++k)
#pragma unroll
                for (int j = 0; j < 4; ++j) rwn[k][j] = (u32x2){0u, 0u};
#pragma unroll
            for (int j = 0; j < 4; ++j) xn[j] = (u32x2){0u, 0u}; }
        f32x4 v[4];
#pragma unroll
        for (int j = 0; j < 4; ++j) v[j] = (f32x4){bf_lo(xc[j].x), bf_hi(xc[j].x), bf_lo(xc[j].y), bf_hi(xc[j].y)};
#pragma unroll
        for (int k = 0; k < 4; ++k)
#pragma unroll
            for (int j = 0; j < 4; ++j) { v[j].x += bf_lo(rwc[k][j].x); v[j].y += bf_hi(rwc[k][j].x); v[j].z += bf_lo(rwc[k][j].y); v[j].w += bf_hi(rwc[k][j].y); }
        if (nc > 4) { unsigned long long m = mc; while (m) { const int e = __builtin_ctzll(m); m &= m - 1; const int slot = __builtin_amdgcn_readlane(inv0, e);
#pragma unroll
                for (int j = 0; j < 4; ++j) { const u32x2 w = *(const u32x2*)(YE + (size_t)slot * D + 4 * lane + 256 * j);
                    v[j].x += bf_lo(w.x); v[j].y += bf_hi(w.x); v[j].z += bf_lo(w.y); v[j].w += bf_hi(w.y); } } }
        float sq = 0.f;
#pragma unroll
        for (int j = 0; j < 4; ++j) sq += (v[j].x * v[j].x + v[j].y * v[j].y) + (v[j].z * v[j].z + v[j].w * v[j].w);
        float rs = 1.0f / sqrtf(wave_sum(sq) * (1.f / D) + 1e-6f);
#pragma unroll
        for (int j = 0; j < 4; ++j) *(f32x4*)(OUT + (size_t)tok * D + 4 * lane + 256 * j) = v[j] * rs * gg[j];
        inv0 = inv1; inv1 = inv2; mc = mn; nc = nn;
#pragma unroll
        for (int k = 0; k < 4; ++k) { slc[k] = sln[k];
#pragma unroll
            for (int j = 0; j < 4; ++j) rwc[k][j] = rwn[k][j]; }
#pragma unroll
        for (int j = 0; j < 4; ++j) xc[j] = xn[j];
    }
#undef PF_SLOTS
#undef PF_ROWS
}

#define XB_TMO      128
#define XB_XCNT(j)  (256  + 64 * (j))
#define XB_XSUB(j)  (1280 + 64 * (j))
#define XB_XGEN(j)  (2304 + 64 * (j))
#define XB_TOP      3328
#define XB_TOPGEN   3392
#define XCD_BAR_WORDS 3456
#define XB_SPIN_CAP (1u << 22)
__device__ __forceinline__ unsigned xb_ld(unsigned* p)              { return __hip_atomic_load(p, __ATOMIC_RELAXED, __HIP_MEMORY_SCOPE_AGENT); }
__device__ __forceinline__ unsigned xb_add(unsigned* p, unsigned v) { return __hip_atomic_fetch_add(p, v, __ATOMIC_RELAXED, __HIP_MEMORY_SCOPE_AGENT); }
__device__ __forceinline__ unsigned xb_xcc_id() { return (unsigned)__builtin_amdgcn_s_getreg((3 << 11) | 20) & 0xFu; }
#define XB_SPIN(cond, bar) do { unsigned _sp = 0; while (cond) { __builtin_amdgcn_s_sleep(1); \
    if ((++_sp & 255u) == 0u) { if (xb_ld(&(bar)[XB_TMO])) break; if (_sp > XB_SPIN_CAP) { atomicAdd(&(bar)[XB_TMO], 1u); break; } } } } while (0)
struct XcdBarrier { unsigned* bar; unsigned x; volatile LAS unsigned* st; int wv; };
__device__ __forceinline__ XcdBarrier xcd_barrier_post(unsigned* bar, volatile LAS unsigned* st, int wv) {
    XcdBarrier b; b.bar = bar; b.x = xb_xcc_id(); b.st = st; b.wv = wv;
    if (threadIdx.x == 0) (void)xb_add(&bar[XB_XCNT(b.x)], 1u);
    return b;
}
__device__ __forceinline__ void xcd_barrier_complete(unsigned* bar, unsigned x, unsigned& nloc, unsigned& nx) {
    const unsigned G = gridDim.x * gridDim.y * gridDim.z;
    unsigned sum, cnt, mine, sp = 0u;
    for (;;) {
        sum = 0u; cnt = 0u; mine = 0u;
#pragma unroll
        for (unsigned j = 0; j < 16; ++j) { const unsigned c = xb_ld(&bar[XB_XCNT(j)]); sum += c; cnt += (c > 0u) ? 1u : 0u; mine = (j == x) ? c : mine; }
        if (sum == G) break;
        __builtin_amdgcn_s_sleep(1);
        if ((++sp & 255u) == 0u) { if (xb_ld(&bar[XB_TMO])) break; if (sp > XB_SPIN_CAP) { atomicAdd(&bar[XB_TMO], 1u); break; } }
    }
    nloc = mine > 0u ? mine : 1u; nx = cnt > 0u ? cnt : 1u;
}
__device__ __forceinline__ void xcd_barrier(const XcdBarrier& b) {
    asm volatile("s_waitcnt vmcnt(0)" ::: "memory");
    __syncthreads();
    if (tid_of(b.wv) == 0) {
        unsigned* bar = b.bar;
        __builtin_amdgcn_s_waitcnt(0);
        unsigned nloc = b.st[0], nx = b.st[1];
        if (nloc == 0u) { xcd_barrier_complete(bar, b.x, nloc, nx); b.st[0] = nloc; b.st[1] = nx; }
        const unsigned old = xb_add(&bar[XB_XSUB(b.x)], 1u);
        const unsigned gen = old / nloc;
        if (old + 1u == (gen + 1u) * nloc) {
            __builtin_amdgcn_fence(__ATOMIC_RELEASE, "agent");
            asm volatile("s_waitcnt vmcnt(0)" ::: "memory");
            const unsigned og = xb_add(&bar[XB_TOP], 1u);
            const unsigned tg = og / nx;
            if (og + 1u == (tg + 1u) * nx) xb_add(&bar[XB_TOPGEN], 1u);
            else XB_SPIN(xb_ld(&bar[XB_TOPGEN]) == tg, bar);
            __builtin_amdgcn_fence(__ATOMIC_ACQUIRE, "agent");
            xb_add(&bar[XB_XGEN(b.x)], 1u);
            asm volatile("s_waitcnt vmcnt(0)" ::: "memory");
        } else {
            XB_SPIN(xb_ld(&bar[XB_XGEN(b.x)]) == gen, bar);
            __builtin_amdgcn_fence(__ATOMIC_ACQUIRE, "agent");
            asm volatile("s_waitcnt vmcnt(0)" ::: "memory");
        }
    }
    __syncthreads();
}

#ifndef PH_MASK
#define PH_MASK 0x7ff
#endif
#ifndef REP_MASK
#define REP_MASK 0
#endif
#ifndef P2_MASK
#define P2_MASK 7
#endif
#ifndef P2_REP
#define P2_REP 0
#define P9_REP 0
#endif
constexpr int LDS_MISC = LDS_BYTES - 64;
constexpr int LDS_PTAB = LDS_BYTES - 512;
__device__ __forceinline__ Args load_args(LAS unsigned char* lds, int lo, int hi, int wv) {
    Args r; const LAS u32x2* t = (const LAS u32x2*)(lds + LDS_PTAB);
#pragma unroll
    for (int i = 0; i < 31; ++i) { const u32x2 v = t[i]; const unsigned long long p = ((unsigned long long)(unsigned)__builtin_amdgcn_readfirstlane((int)v.y) << 32) | (unsigned)__builtin_amdgcn_readfirstlane((int)v.x);
        if (i < 29) r.in[i] = (const float*)(const __attribute__((address_space(1))) float*)p; else if (i == 29) r.out = (float*)(__attribute__((address_space(1))) float*)p; else r.ws = (unsigned char*)(__attribute__((address_space(1))) unsigned char*)p; }
    r.ph_lo = lo; r.ph_hi = hi; r.wv = wv; r.zero_ = 0; return r;
}
constexpr size_t WS_CTL = 0, CTL_BYTES = 16384;
__global__ void __launch_bounds__(NTHREADS, 2) mega(Args a0) {
    extern __shared__ __attribute__((aligned(16))) unsigned char lds_raw[];
    LAS unsigned char* lds = (LAS unsigned char*)lds_raw;
    cg::grid_group grid = cg::this_grid();
    const int G = gridDim.x, lo = a0.ph_lo, hi = a0.ph_hi, wv0 = __builtin_amdgcn_readfirstlane((int)threadIdx.x >> 6);
    volatile LAS unsigned* misc = (volatile LAS unsigned*)(lds + LDS_MISC);
    if (threadIdx.x < 16) misc[threadIdx.x] = 0u;
    if (threadIdx.x == 0) { LAS unsigned long long* t = (LAS unsigned long long*)(lds + LDS_PTAB);
#pragma unroll
        for (int i = 0; i < 29; ++i) t[i] = (unsigned long long)a0.in[i];
        t[29] = (unsigned long long)a0.out; t[30] = (unsigned long long)a0.ws; }
    __syncthreads();
    if (lo < -1000) grid.sync();
    XcdBarrier xbar = xcd_barrier_post((unsigned*)(a0.ws + WS_CTL), misc, wv0);
#define IN(k) (((PH_MASK >> (k)) & 1) && lo <= (k) && (k) < hi)
#define NREP(k) (1 + ((REP_MASK >> (k)) & 1))
#define PHASE(k, ...) do { if (IN(k)) { for (int rep_ = 0; rep_ < NREP(k); ++rep_) { { const Args a = load_args(lds, lo, hi, wv0); unsigned char* const ws = a.ws; (void)ws; __VA_ARGS__; } if (rep_ + 1 < NREP(k) || IN((k) + 1)) { xcd_barrier(xbar); } } } } while (0)

    PHASE(0, phase_prep(a, lds, G));

    PHASE(1, {
        pg8::Gemm g{(const bf16_t*)(ws + WS_XH), (const bf16_t*)(ws + WS_WINT), T, IN_PROJ, D, 0, 0};
        pg8::TripleOrder S; S.S0.init(T, IN_PROJ, G, 0); S.A1 = (const bf16_t*)(ws + WS_MEMN); S.B1 = (const bf16_t*)(ws + WS_WKT); S.A2 = (const bf16_t*)(ws + WS_WVT); S.B2 = (const bf16_t*)(ws + WS_MEMN);
        S.n1 = BATCH * NMEM / 256; S.n2 = BATCH * NMEM / 256; S.G = G; S.c = (int)blockIdx.x;
        pg8::EpiBf16x3 E{pg8::EpiBf16{(bf16_t*)(ws + WS_P), PLD, (bf16_t*)(ws + WS_Q)}, pg8::EpiBf16{(bf16_t*)(ws + WS_KMEM), 256, nullptr}, pg8::EpiBf16{(bf16_t*)(ws + WS_VT), BATCH * NMEM, nullptr}};
        const int total = S.n1 + S.n2 + S.S0.nwg, rem = total % G, c = (int)blockIdx.x;
        const bool cv = rem ? (c >= rem) : true; const int ncv = rem ? G - rem : G, rank = rem ? c - rem : c;
        if (cv && !(rank & 1)) { expert_prep_items(a, lds, rank * 8 + a.wv, ncv * 8, 0, 3 * 8192); __syncthreads(); }
        pg8::gemm_phase<pg8::EpiBf16x3, pg8::TripleOrder, false>(lds, g, S, E, nullptr, a.wv);
        if (cv && (rank & 1)) { __syncthreads(); expert_prep_items(a, lds, rank * 8 + a.wv, ncv * 8, 0, 3 * 8192); }
    });

    constexpr int NSCAN = BATCH * NH * 2;
    PHASE(2, {
        for (int u = blockIdx.x; u < 2048; u += G) {
            if (u < 1024) { for (int r2 = 0; r2 < 1 + ((P2_REP >> 1) & 1); ++r2) conv_unit(a, lds, u); }
            else { for (int r2 = 0; r2 < 1 + ((P2_REP >> 2) & 1); ++r2) prep_unit(a, lds, u - 1024); }
        }
    });

    PHASE(3, {
        int bid = blockIdx.x; int Gp = G; asm volatile("" : "+s"(bid), "+s"(Gp));
        for (int u = bid; u < NSCAN; u += Gp) scan_chunked_unit(a, lds, u);
        if (rep_ == 0) {
            if (Gp > NSCAN) { if (bid >= NSCAN) { for (int u = bid - NSCAN; u < 64; u += Gp - NSCAN) for (int r2 = 0; r2 < 1 + (P2_REP & 1); ++r2) attn_unit(a, lds, u);
                                                 } }
            else { for (int u = bid; u < 64; u += Gp) attn_unit(a, lds, u); }
        }
    });

    PHASE(4, phase_post(a, G));

    PHASE(5, {
        pg8::Gemm g{(const bf16_t*)(ws + WS_MIX), (const bf16_t*)(ws + WS_WOUTT), T, D, D, 0, 0}; pg8::StaticOrder S; S.init(T, D, G, (int)blockIdx.x);
        pg8::EpiResidSS E{a.in[I_X], (bf16_t*)(ws + WS_X1), (float*)(ws + WS_SS)}; pg8::gemm_phase<pg8::EpiResidSS, pg8::StaticOrder, false>(lds, g, S, E, nullptr, a.wv);
    });

    PHASE(6, phase_router(a, lds, G));

    PHASE(7, { for (int u = blockIdx.x; u < BATCH * NE; u += G) topk_unit(a, lds, u); });

    PHASE(8, {
        pg8::Gemm g{(const bf16_t*)(ws + WS_H2), (const bf16_t*)(ws + WS_WGUT), NSLOT, 2048, D / 2, 0x7A7A7A7A, 0x7F7F7F7F};     pg8::ExpertOrder S; S.init(32, 8, NE, G, (int)blockIdx.x);
        pg8::EpiSwiGLU E{(bf16_t*)(ws + WS_HID)}; pg8::gemm_phase<pg8::EpiSwiGLU, pg8::ExpertOrder, true, false, true>(lds, g, S, E, (const int*)(ws + WS_ROWTOK), a.wv);
    });

    PHASE(9, {
        pg8::Gemm g{(const bf16_t*)(ws + WS_HID), (const bf16_t*)(ws + WS_WDT), NSLOT, D, FF / 2, 0x7A7A7A7A, 0x7C7C7C7C};     pg8::ExpertOrder S; S.init(32, 4, NE, G, (int)blockIdx.x);
        pg8::EpiGateScale E{(bf16_t*)(ws + WS_YE), (const float*)(ws + WS_ROWGATE)}; pg8::gemm_phase<pg8::EpiGateScale, pg8::ExpertOrder, false, true, true>(lds, g, S, E, nullptr, a.wv);
#if P9_REP
        __syncthreads(); pg8::gemm_phase<pg8::EpiGateScale, pg8::ExpertOrder, false, true, true>(lds, g, S, E, nullptr, a.wv);
#endif
    });

    PHASE(10, phase_final(a, G));
#undef IN
#undef NREP
#undef PHASE
}

#ifndef MK_ONE_LAUNCH
#define MK_ONE_LAUNCH 1
#endif
extern "C" void kernel_launch(void* const* d_in, const int* in_sizes, int n_in, void* d_out, int out_size, void* d_ws, size_t ws_size, hipStream_t stream) {
    static int grid_blocks = 0;
    if (grid_blocks == 0) {
        if (n_in != 29 || out_size != T * D || ws_size < WS_END) { fprintf(stderr, "kernel_launch: unexpected problem: n_in %d out %d ws %zu (need %zu)\n", n_in, out_size, ws_size, (size_t)WS_END); grid_blocks = -1; return; }
        int dev = 0, cus = 0, per_cu = 0;
        if (hipGetDevice(&dev) != hipSuccess || hipDeviceGetAttribute(&cus, hipDeviceAttributeMultiprocessorCount, dev) != hipSuccess) { grid_blocks = -1; return; }
        if (hipFuncSetAttribute((const void*)mega, hipFuncAttributeMaxDynamicSharedMemorySize, LDS_BYTES) != hipSuccess) { fprintf(stderr, "kernel_launch: hipFuncSetAttribute failed\n"); grid_blocks = -1; return; }
        if (hipOccupancyMaxActiveBlocksPerMultiprocessor(&per_cu, (const void*)mega, NTHREADS, LDS_BYTES) != hipSuccess || per_cu < 1) { fprintf(stderr, "kernel_launch: occupancy query says %d blocks per CU\n", per_cu); grid_blocks = -1; return; }
        grid_blocks = cus;
    }
    if (grid_blocks < 0) return;
    if (hipMemsetAsync((char*)d_ws + WS_CTL, 0, CTL_BYTES, stream) != hipSuccess) { fprintf(stderr, "kernel_launch: memset failed\n"); return; }
    Args a{};
    for (int i = 0; i < 29; ++i) a.in[i] = (const float*)d_in[i];
    a.out = (float*)d_out; a.ws = (unsigned char*)d_ws;
#if MK_ONE_LAUNCH
    a.ph_lo = 0; a.ph_hi = NPHASE;
    { void* args[] = {&a}; hipError_t e = hipLaunchCooperativeKernel((const void*)mega, dim3(grid_blocks), dim3(NTHREADS), args, LDS_BYTES, stream);
      if (e != hipSuccess) fprintf(stderr, "cooperative launch failed: %s (grid %d)\n", hipGetErrorString(e), grid_blocks); }
#else
    for (int ph = 0; ph < NPHASE; ++ph) { a.ph_lo = ph; a.ph_hi = ph + 1; void* args[] = {&a};
        hipError_t e = hipLaunchCooperativeKernel((const void*)mega, dim3(grid_blocks), dim3(NTHREADS), args, LDS_BYTES, stream);
        if (e != hipSuccess) { fprintf(stderr, "cooperative launch %d failed: %s (grid %d)\n", ph, hipGetErrorString(e), grid_blocks); break; } }
#endif
}
```

```cpp
#include <hip/hip_runtime.h>
#include <hip/hip_cooperative_groups.h>
#include <cstdio>
#include <cstdint>
namespace cg = cooperative_groups;

#define LAS __attribute__((address_space(3)))
typedef unsigned short bf16_t;
typedef short bf16x8 __attribute__((ext_vector_type(8)));
typedef short s16x4 __attribute__((ext_vector_type(4)));
typedef float f32x2 __attribute__((ext_vector_type(2)));
typedef float f32x4 __attribute__((ext_vector_type(4)));
typedef float f32x16 __attribute__((ext_vector_type(16)));
typedef unsigned u32x2 __attribute__((ext_vector_type(2)));
typedef unsigned u32x4 __attribute__((ext_vector_type(4)));
typedef _Float16 f16x4 __attribute__((ext_vector_type(4)));
typedef __bf16 bf16v2 __attribute__((ext_vector_type(2)));
typedef int v8i __attribute__((ext_vector_type(8)));
typedef int v4i __attribute__((ext_vector_type(4)));

constexpr int D = 1024, BATCH = 16, SEQ = 4096, T = BATCH * SEQ, NMEM = 256;
constexpr int IN_PROJ = 2560, CW = 384, RW = 384, NH = 6, NE = 16, FF = 1024, CAP = 512;
constexpr int NSLOT = NE * BATCH * CAP;
constexpr int NTHREADS = 512;
constexpr int LDS_BYTES = 160 * 1024;
constexpr int NPHASE = 11;
#ifndef SCAN_MODE
#define SCAN_MODE 1
#endif

constexpr size_t MiB = 1u << 20;
constexpr size_t WS_WINT = 1 * MiB;
constexpr size_t WS_WOUTT = 6 * MiB;
constexpr size_t WS_WKT = 8 * MiB;
constexpr size_t WS_WVT = 8 * MiB + 512 * 1024;
constexpr size_t WS_SMALL = 9 * MiB;
constexpr size_t WS_WGUT = 10 * MiB;
constexpr size_t WS_WDT = 74 * MiB;
constexpr size_t WS_KMEM = 106 * MiB;
constexpr size_t WS_VT = 108 * MiB;
constexpr size_t WS_ROWTOK = 106 * MiB;
constexpr size_t WS_ROWGATE = 106 * MiB + 512 * 1024;
constexpr size_t WS_SS = 107 * MiB;
constexpr size_t WS_P = 112 * MiB;
constexpr size_t WS_YF = 112 * MiB;
constexpr size_t WS_YB = 208 * MiB;
constexpr size_t WS_X1 = 112 * MiB;
constexpr size_t WS_XH = 432 * MiB;
constexpr size_t WS_G = 432 * MiB;
constexpr size_t WS_BON = 480 * MiB;
constexpr size_t WS_Q = 400 * MiB;
constexpr int PLD = IN_PROJ - 256;
constexpr size_t WS_H2 = 432 * MiB;
constexpr size_t WS_MEMN = 560 * MiB;
constexpr size_t WS_MIX = 560 * MiB;
constexpr size_t WS_SCAN = 688 * MiB;
constexpr size_t SCAN_STRIDE = 48 * MiB;
constexpr size_t WS_SCAN7 = 496 * MiB;
constexpr size_t WS_PC = 484 * MiB;
__device__ __forceinline__ unsigned char* scan_arr(unsigned char* ws, int a) { return a < 7 ? ws + WS_SCAN + (size_t)a * SCAN_STRIDE : (a == 7 ? ws + WS_SCAN7 : ws + 560 * MiB + 640 * 2); }
__device__ __forceinline__ int scan_pitch(int a) { return a == 8 ? D : 384; }
__device__ __forceinline__ size_t hat_off(int a, size_t tok, int ch) { return a == 8 ? tok * D + ch : ((((tok >> 4) * NH + (ch >> 6)) << 10) + ((tok & 15) << 6) + (ch & 63)); }
constexpr size_t WS_AFF = 624 * MiB;
constexpr size_t WS_INV = 628 * MiB;
constexpr size_t WS_HID = 768 * MiB;
constexpr size_t WS_YE = 368 * MiB;
constexpr size_t WS_END = 1024 * MiB;

__device__ __forceinline__ unsigned pk_bf16(float lo, float hi) { f32x2 v = {lo, hi}; bf16v2 b = __builtin_convertvector(v, bf16v2); return __builtin_bit_cast(unsigned, b); }
__device__ __forceinline__ unsigned pk_fp8x4(float a, float b, float c, float d) { int w = 0; w = __builtin_amdgcn_cvt_pk_fp8_f32(a, b, w, false); w = __builtin_amdgcn_cvt_pk_fp8_f32(c, d, w, true); return (unsigned)w; }
__device__ __forceinline__ float bf_lo(unsigned u) { return __builtin_bit_cast(float, u << 16); }
__device__ __forceinline__ float bf_hi(unsigned u) { return __builtin_bit_cast(float, u & 0xffff0000u); }
__device__ __forceinline__ float wave_sum(float v) {
#pragma unroll
    for (int o = 1; o < 64; o <<= 1) v += __shfl_xor(v, o);
    return v;
}
__device__ __forceinline__ float sigmoidf_fast(float x) { return __builtin_amdgcn_rcpf(1.0f + __builtin_amdgcn_exp2f(-1.4426950408889634f * x)); }
template <int CTRL> __device__ __forceinline__ float dpp_f(float x) { return __builtin_bit_cast(float, __builtin_amdgcn_update_dpp(0, __builtin_bit_cast(int, x), CTRL, 0xF, 0xF, true)); }
__device__ __forceinline__ float sum8(float x) { x += dpp_f<0xB1>(x); x += dpp_f<0x4E>(x); x += dpp_f<0x141>(x); return x; }
__device__ __forceinline__ float sum16(float x) { x = sum8(x); x += dpp_f<0x140>(x); return x; }
__device__ __forceinline__ float max16(float x) { x = fmaxf(x, dpp_f<0xB1>(x)); x = fmaxf(x, dpp_f<0x4E>(x)); x = fmaxf(x, dpp_f<0x141>(x)); x = fmaxf(x, dpp_f<0x140>(x)); return x; }

typedef short v4i16g __attribute__((__vector_size__(8)));
__device__ __forceinline__ s16x4 tr_read16(LAS unsigned char* p) { v4i16g r = __builtin_amdgcn_ds_read_tr16_b64_v4i16((LAS v4i16g*)p); return __builtin_bit_cast(s16x4, r); }
__device__ __forceinline__ f32x4 bf4_to_f32(u32x2 w) { return (f32x4){bf_lo(w.x), bf_hi(w.x), bf_lo(w.y), bf_hi(w.y)}; }
__device__ __forceinline__ u32x2 f32_to_bf4(f32x4 v) { return (u32x2){pk_bf16(v.x, v.y), pk_bf16(v.z, v.w)}; }
__device__ __forceinline__ bf16x8 frag_lo4(f32x4 v) { const u32x4 w = {pk_bf16(v.x, v.y), pk_bf16(v.z, v.w), 0u, 0u}; return __builtin_bit_cast(bf16x8, w); }
__device__ __forceinline__ bf16x8 frag_cat(u32x2 a, u32x2 b) { const u32x4 w = {a.x, a.y, b.x, b.y}; return __builtin_bit_cast(bf16x8, w); }
#define MFMA16(a, b, c) __builtin_amdgcn_mfma_f32_16x16x32_bf16((a), (b), (c), 0, 0, 0)

__device__ __forceinline__ int tid_of(int wv) { int l; asm volatile("v_mbcnt_lo_u32_b32 %0, -1, 0\n\tv_mbcnt_hi_u32_b32 %0, -1, %0" : "=v"(l)); return (wv << 6) | l; }
namespace pg8 {
#define PG8_LAS __attribute__((address_space(3)))
constexpr int BM = 256, BK = 64, HALF = 128, HTB = HALF * BK * 2, STAGE_BYTES = 8 * HTB, NXCD = 8, WGM = 8;
__host__ __device__ __forceinline__ int lds_byte(int r, int c) { const int st = (r >> 4) * 2 + (c >> 5), rr = r & 15, cc = c & 31, ob = rr * 64 + cc * 2; return st * 1024 + (ob ^ (((ob >> 9) & 1) << 5)); }
__host__ __device__ __forceinline__ void stage_rc(int b, int& R, int& C) { const int st = b / 1024, sb = b % 1024, swz = sb ^ (((sb >> 9) & 1) << 5); R = (st >> 1) * 16 + swz / 64; C = (st & 1) * 32 + (swz % 64) / 2; }
__host__ __device__ __forceinline__ int perm32(int rho) { const int n = rho >> 4, i = rho & 15; return 8 * (i >> 2) + 4 * n + (i & 3); }

struct Unit { int pm, pn, gid; };
struct Gemm { const bf16_t* A; const bf16_t* Bt; int M, N, K; int sw, sx; };

struct StaticOrder {
    int nM, nN, nwg, G, c;
    __device__ void init(int M, int N, int G_, int c_) { nM = M / BM; nN = N / BM; nwg = nM * nN; G = G_; c = c_; }
    __device__ bool next(int i, Unit& u) const {
        const long L = (long)i * G + c; if (L >= nwg) return false;
        int wgid = (int)L; { const int q = nwg / NXCD, r = nwg % NXCD, xcd = wgid % NXCD, off = wgid / NXCD; wgid = (xcd < r ? xcd * (q + 1) : r * (q + 1) + (xcd - r) * q) + off; }
        const int nig = WGM * nN, gid = wgid / nig, fm = gid * WGM, gsz = (nM - fm) < WGM ? (nM - fm) : WGM;
        u.pm = fm + ((wgid % nig) % gsz); u.pn = (wgid % nig) / gsz; u.gid = 0; return true;
    }
    __device__ __forceinline__ const char* aptr(const Gemm& g, const Unit& u, size_t tstep) const { return (const char*)g.A + (size_t)u.pm * tstep; }
    __device__ __forceinline__ const char* bptr(const Gemm& g, const Unit& u, size_t tstep) const { return (const char*)g.Bt + (size_t)u.pn * tstep; }
};
struct TripleOrder {
    StaticOrder S0; const bf16_t* A1; const bf16_t* B1; const bf16_t* A2; const bf16_t* B2; int n1, n2, G, c;
    __device__ bool next(int i, Unit& u) const {
        const long L = (long)i * G + c;
        if (L < n1) { u.pm = (int)L; u.pn = 0; u.gid = 1; return true; }
        if (L < n1 + n2) { u.pm = 0; u.pn = (int)(L - n1); u.gid = 2; return true; }
        const long L0 = L - n1 - n2; if (L0 >= S0.nwg) return false;
        StaticOrder T0 = S0; T0.c = (int)(L0 % G); return T0.next((int)(L0 / G), u);
    }
    __device__ __forceinline__ const char* aptr(const Gemm& g, const Unit& u, size_t tstep) const { return (const char*)(u.gid == 0 ? g.A : (u.gid == 1 ? A1 : A2)) + (size_t)u.pm * tstep; }
    __device__ __forceinline__ const char* bptr(const Gemm& g, const Unit& u, size_t tstep) const { return (const char*)(u.gid == 0 ? g.Bt : (u.gid == 1 ? B1 : B2)) + (size_t)u.pn * tstep; }
};
struct ExpertOrder {
    int nMe, nNe, per, total, G, c;
    __device__ void init(int nMe_, int nNe_, int nExp, int G_, int c_) { nMe = nMe_; nNe = nNe_; per = nMe * nNe; total = per * nExp; G = G_; c = c_; }
    __device__ bool next(int i, Unit& u) const {
        const long L = (long)i * G + c; if (L >= total) return false;
        const int e = (int)(L / per), w = (int)(L % per), xl = w % 8, j = w / 8, rpx = nMe / 8;
        u.pm = e * nMe + xl * rpx + (j % rpx); u.pn = e * nNe + j / rpx; u.gid = 0; return true;
    }
    __device__ __forceinline__ const char* aptr(const Gemm& g, const Unit& u, size_t tstep) const { return (const char*)g.A + (size_t)u.pm * tstep; }
    __device__ __forceinline__ const char* bptr(const Gemm& g, const Unit& u, size_t tstep) const { return (const char*)g.Bt + (size_t)u.pn * tstep; }
};

struct EpiBf16 {
    static constexpr bool PERM = true;
    bf16_t* O; int ldc; bf16_t* Q0;
    __device__ __forceinline__ void operator()(const f32x4 (&acc)[2][2][4][2], const Unit& u, int wr, int wc, int fr, int fq) const {
        const bool redir = (Q0 != nullptr) && (u.pn == 0);
        bf16_t* base = redir ? Q0 : O; const int ld = redir ? 256 : ldc;
        const int row0 = u.pm * BM + wr * 64 + fr, col0 = (u.pn - ((Q0 != nullptr && !redir) ? 1 : 0)) * BM + wc * 32 + 8 * fq;
#pragma unroll
        for (int ai = 0; ai < 2; ++ai)
#pragma unroll
            for (int m = 0; m < 4; ++m) { bf16_t* rowp = base + (size_t)(row0 + ai * HALF + m * 16) * ld + col0;
#pragma unroll
                for (int bj = 0; bj < 2; ++bj) { const f32x4 v0 = acc[ai][bj][m][0], v1 = acc[ai][bj][m][1];
                    u32x4 w; w.x = pk_bf16(v0[0], v0[1]); w.y = pk_bf16(v0[2], v0[3]); w.z = pk_bf16(v1[0], v1[1]); w.w = pk_bf16(v1[2], v1[3]);
                    *(u32x4*)(rowp + bj * HALF) = w; } }
    }
};
struct EpiBf16x3 {
    static constexpr bool PERM = true;
    EpiBf16 E0, E1, E2;
    __device__ __forceinline__ void operator()(const f32x4 (&acc)[2][2][4][2], const Unit& u, int wr, int wc, int fr, int fq) const {
        if (u.gid == 0) E0(acc, u, wr, wc, fr, fq); else if (u.gid == 1) E1(acc, u, wr, wc, fr, fq); else E2(acc, u, wr, wc, fr, fq); }
};
struct EpiResidSS {
    static constexpr bool PERM = false;
    const float* X; bf16_t* X1; float* ss;
    __device__ __forceinline__ void operator()(const f32x4 (&acc)[2][2][4][2], const Unit& u, int wr, int wc, int fr, int fq) const {
        const int row0 = u.pm * BM + wr * 64 + fr, col0 = u.pn * BM + wc * 32 + 4 * fq;
#pragma unroll
        for (int ai = 0; ai < 2; ++ai)
#pragma unroll
            for (int m = 0; m < 4; ++m) { const int row = row0 + ai * HALF + m * 16; const size_t off = (size_t)row * D + col0; float s = 0.f;
#pragma unroll
                for (int bj = 0; bj < 2; ++bj)
#pragma unroll
                    for (int n = 0; n < 2; ++n) { const f32x4 xv = *(const f32x4*)(X + off + bj * HALF + n * 16); const f32x4 o = xv + acc[ai][bj][m][n];
                        *(u32x2*)(X1 + off + bj * HALF + n * 16) = f32_to_bf4(o); s += (o[0] * o[0] + o[1] * o[1]) + (o[2] * o[2] + o[3] * o[3]); }
                s += __shfl_xor(s, 16); s += __shfl_xor(s, 32);
                if (fq == 0) (void)__hip_atomic_fetch_add(ss + row, s, __ATOMIC_RELAXED, __HIP_MEMORY_SCOPE_AGENT); }
    }
};
struct EpiSwiGLU {
    static constexpr bool PERM = true;
    bf16_t* H;
    __device__ __forceinline__ void operator()(const f32x4 (&acc)[2][2][4][2], const Unit& u, int wr, int wc, int fr, int fq) const {
        const int row0 = u.pm * BM + wr * 64 + fr, col0 = (u.pn & 7) * HALF + wc * 32 + 8 * fq;
#pragma unroll
        for (int ai = 0; ai < 2; ++ai)
#pragma unroll
            for (int m = 0; m < 4; ++m) { const int row = row0 + ai * HALF + m * 16; float h[8];
                unsigned char* rowp = (unsigned char*)H + ((((size_t)(row >> 8) * (FF / 128) + (col0 >> 7)) << 15) + ((row & 255) << 7) + (col0 & 127));
#pragma unroll
                for (int n = 0; n < 2; ++n)
#pragma unroll
                    for (int j = 0; j < 4; ++j) { const float gt = acc[ai][0][m][n][j], up = acc[ai][1][m][n][j]; h[n * 4 + j] = 8.0f * gt * sigmoidf_fast(gt) * up; }
                *(u32x2*)rowp = (u32x2){pk_fp8x4(h[0], h[1], h[2], h[3]), pk_fp8x4(h[4], h[5], h[6], h[7])}; }
    }
};
struct EpiGateScale {
    static constexpr bool PERM = true;
    bf16_t* Y; const float* gate;
    __device__ __forceinline__ void operator()(const f32x4 (&acc)[2][2][4][2], const Unit& u, int wr, int wc, int fr, int fq) const {
        const int row0 = u.pm * BM + wr * 64 + fr, col0 = (u.pn & 3) * BM + wc * 32 + 8 * fq;
#pragma unroll
        for (int ai = 0; ai < 2; ++ai)
#pragma unroll
            for (int m = 0; m < 4; ++m) { const int row = row0 + ai * HALF + m * 16; const float gs = gate[row]; bf16_t* rowp = Y + (size_t)row * D + col0;
#pragma unroll
                for (int bj = 0; bj < 2; ++bj) { const f32x4 v0 = acc[ai][bj][m][0] * gs, v1 = acc[ai][bj][m][1] * gs;
                    u32x4 w; w.x = pk_bf16(v0[0], v0[1]); w.y = pk_bf16(v0[2], v0[3]); w.z = pk_bf16(v1[0], v1[1]); w.w = pk_bf16(v1[2], v1[3]);
                    *(u32x4*)(rowp + bj * HALF) = w; } }
    }
};

template <class Epi, class Sched, bool GATHER, bool ATILED = false, bool FP8 = false>
__device__ __forceinline__ void gemm_phase(PG8_LAS unsigned char* lds, const Gemm g, const Sched& S, const Epi& E, const int* rowtok, const int wv) {
    int tid = tid_of(wv); asm volatile("" : "+v"(tid));
    const int wid = __builtin_amdgcn_readfirstlane(tid >> 6), lane = tid & 63, wr = wid >> 2, wc = wid & 3, fr = lane & 15, fq = lane >> 4;
    const int K = g.K, nt = K / BK;
    unsigned voffA0, voffB0;
    { int R, C; stage_rc(tid * 16, R, C); const int Rb = Epi::PERM ? ((R & ~31) + perm32(R & 31)) : R;
      voffA0 = ATILED ? (unsigned)(R * BK + C) * 2u : (unsigned)(R * K + C) * 2u; voffB0 = (unsigned)(Rb * K + C) * 2u; }
    const size_t dA = ATILED ? (size_t)64 * BK * 2 : (size_t)64 * K * 2, dB = (size_t)64 * K * 2;
    unsigned vAc[2][2], vAn[2][2];
    const size_t kstep = (size_t)(BK * 2);
    const size_t hstep = (size_t)HALF * K * 2;
    const size_t tstep = 2 * hstep;
    const size_t kstepA = ATILED ? (size_t)BM * BK * 2 : kstep, hstepA = ATILED ? (size_t)HALF * BK * 2 : hstep;
    const unsigned ldsw = (unsigned)wid * 1024u;
    const unsigned ldsbase = __builtin_amdgcn_readfirstlane((unsigned)(size_t)lds) + ldsw;
    const int aoff = lds_byte(wr * 64 + fr, fq * 8), boff = lds_byte(wc * 32 + fr, fq * 8);
#define PG8_SA(b, h) (((b) * 2 + (h)) * HTB)
#define PG8_SB(b, h) ((4 + (b) * 2 + (h)) * HTB)
#define PG8_GLDS(vo_, sb_, lo_) asm volatile("s_add_u32 m0, %2, %3\n\ts_nop 0\n\tglobal_load_lds_dwordx4 %0, %1" :: "v"(vo_), "s"((const void*)(sb_)), "s"(ldsbase), "n"(lo_) : "m0", "scc", "memory")
#define PG8_STAGE_D(bufoff, gbase, voff0, delta) do { PG8_GLDS(voff0, gbase, (bufoff)); PG8_GLDS(voff0, (const char*)(gbase) + (delta), (bufoff) + 8192); } while (0)
#define PG8_STAGE(bufoff, gbase, voff) do { PG8_GLDS((voff)[0], gbase, (bufoff)); PG8_GLDS((voff)[1], gbase, (bufoff) + 8192); } while (0)
#define PG8_STAGE_A(bufoff, hh, dbase, kbytes, vsel) do { if constexpr (GATHER) { PG8_STAGE(bufoff, (const char*)g.A + (kbytes), (vsel)[hh]); } else { PG8_STAGE_D(bufoff, (dbase) + ((hh) ? hstepA : 0), voffA0, dA); } } while (0)
#define PG8_GATHER_OFF(dst, un) do { int R_, C_; stage_rc(tid * 16, R_, C_); _Pragma("unroll") for (int _h = 0; _h < 2; ++_h) _Pragma("unroll") for (int _i = 0; _i < 2; ++_i) \
        (dst)[_h][_i] = (unsigned)rowtok[(un).pm * BM + _h * HALF + R_ + 64 * _i] * (unsigned)(K * 2) + (unsigned)(C_ * 2); } while (0)
#define PG8_LDA(dst, b, h) do { _Pragma("unroll") for (int m = 0; m < 4; ++m) _Pragma("unroll") for (int k = 0; k < 2; ++k) dst[m][k] = *(const PG8_LAS bf16x8*)(lds + PG8_SA(b, h) + aoff + m * 2048 + k * 1024); } while (0)
#define PG8_LDB(dst, b, h) do { _Pragma("unroll") for (int n = 0; n < 2; ++n) _Pragma("unroll") for (int k = 0; k < 2; ++k) dst[n][k] = *(const PG8_LAS bf16x8*)(lds + PG8_SB(b, h) + boff + n * 2048 + k * 1024); } while (0)
#define PG8_MMA(ai, bj, At, Bt) do { __builtin_amdgcn_s_setprio(1); _Pragma("unroll") for (int m = 0; m < 4; ++m) _Pragma("unroll") for (int n = 0; n < 2; ++n) _Pragma("unroll") for (int k = 0; k < 2; ++k) \
        acc[ai][bj][m][n] = __builtin_amdgcn_mfma_f32_16x16x32_bf16(Bt[n][k], At[m][k], acc[ai][bj][m][n], 0, 0, 0); __builtin_amdgcn_s_setprio(0); } while (0)
#define PG8_CAT8(lo_, hi_) __builtin_shufflevector(lo_, hi_, 0, 1, 2, 3, 4, 5, 6, 7)
#define PG8_LDA8(b, h) do { _Pragma("unroll") for (int m = 0; m < 4; ++m) { const v4i lo_ = *(const PG8_LAS v4i*)(lds + PG8_SA(b, h) + aoff + m * 2048), hi_ = *(const PG8_LAS v4i*)(lds + PG8_SA(b, h) + aoff + m * 2048 + 1024); A8[m] = PG8_CAT8(lo_, hi_); } } while (0)
#define PG8_LDB8(dst, b, h) do { _Pragma("unroll") for (int n = 0; n < 2; ++n) { const v4i lo_ = *(const PG8_LAS v4i*)(lds + PG8_SB(b, h) + boff + n * 2048), hi_ = *(const PG8_LAS v4i*)(lds + PG8_SB(b, h) + boff + n * 2048 + 1024); dst[n] = PG8_CAT8(lo_, hi_); } } while (0)
#define PG8_MMA8(ai, bj, Bt8) do { __builtin_amdgcn_s_setprio(1); _Pragma("unroll") for (int m = 0; m < 4; ++m) _Pragma("unroll") for (int n = 0; n < 2; ++n) \
        acc[ai][bj][m][n] = __builtin_amdgcn_mfma_scale_f32_16x16x128_f8f6f4(Bt8[n], A8[m], acc[ai][bj][m][n], 0, 0, 0, g.sw, 0, g.sx); __builtin_amdgcn_s_setprio(0); } while (0)
#define PG8_LDAX(b, h) do { if constexpr (FP8) { PG8_LDA8(b, h); } else { PG8_LDA(At, b, h); } } while (0)
#define PG8_LDBX(w, b, h) do { if constexpr (FP8) { if (w) { PG8_LDB8(B81, b, h); } else { PG8_LDB8(B80, b, h); } } else { if (w) { PG8_LDB(B1, b, h); } else { PG8_LDB(B0, b, h); } } } while (0)
#define PG8_MMX(ai, bj, w) do { if constexpr (FP8) { if (w) { PG8_MMA8(ai, bj, B81); } else { PG8_MMA8(ai, bj, B80); } } else { if (w) { PG8_MMA(ai, bj, At, B1); } else { PG8_MMA(ai, bj, At, B0); } } } while (0)
#define PG8_WAIT_V(n) asm volatile("s_waitcnt vmcnt(" #n ")" ::: "memory")
#define PG8_WAIT_L(n) asm volatile("s_waitcnt lgkmcnt(" #n ")" ::: "memory")
#define PG8_BAR __builtin_amdgcn_s_barrier()
#define PG8_SCHED __builtin_amdgcn_sched_barrier(0)
    Unit cur, nxt; int ui = 0;
    if (!S.next(0, cur)) return;
    f32x4 acc[2][2][4][2];
#pragma unroll
    for (int a = 0; a < 2; ++a)
#pragma unroll
        for (int b = 0; b < 2; ++b)
#pragma unroll
            for (int m = 0; m < 4; ++m)
#pragma unroll
                for (int n = 0; n < 2; ++n) acc[a][b][m][n] = (f32x4){0.f, 0.f, 0.f, 0.f};
    bf16x8 At[4][2], B0[2][2], B1[2][2]; v8i A8[4], B80[2], B81[2];
    const char* cA = GATHER ? (const char*)g.A : S.aptr(g, cur, tstep); const char* cB = S.bptr(g, cur, tstep);
    if constexpr (GATHER) { PG8_GATHER_OFF(vAc, cur); }
    PG8_STAGE_D(PG8_SB(0, 0), cB, voffB0, dB); PG8_STAGE_A(PG8_SA(0, 0), 0, cA, 0, vAc); PG8_STAGE_D(PG8_SB(0, 1), cB + hstep, voffB0, dB); PG8_STAGE_A(PG8_SA(0, 1), 1, cA, 0, vAc);
    if (wr == 1) PG8_BAR;
    PG8_WAIT_V(4); PG8_BAR;
    PG8_STAGE_D(PG8_SB(1, 0), cB + kstep, voffB0, dB); PG8_STAGE_A(PG8_SA(1, 0), 0, cA + kstepA, kstep, vAc); PG8_STAGE_D(PG8_SB(1, 1), cB + hstep + kstep, voffB0, dB);
    PG8_WAIT_V(6); PG8_BAR;
    for (;;) {
        const bool has_next = S.next(ui + 1, nxt);
        const char* nA = (has_next && !GATHER) ? S.aptr(g, nxt, tstep) : cA; const char* nB = has_next ? S.bptr(g, nxt, tstep) : cB;
        if constexpr (GATHER) { if (has_next) { PG8_GATHER_OFF(vAn, nxt); } else {
#pragma unroll
            for (int _h = 0; _h < 2; ++_h)
#pragma unroll
                for (int _i = 0; _i < 2; ++_i) vAn[_h][_i] = vAc[_h][_i]; } }
#pragma unroll 1
        for (int t = 0; t < nt; t += 2) {
            const bool last = (t == nt - 2);
            const size_t k1 = (size_t)(t + 1) * kstep, k2 = last ? 0 : (size_t)(t + 2) * kstep, k3 = k2 + kstep;
            const char* a1 = cA + (size_t)(t + 1) * kstepA;
            const char* a2 = last ? nA : cA + (size_t)(t + 2) * kstepA; const char* b2 = last ? nB : cB + (size_t)(t + 2) * kstep;
            const char* a3 = a2 + kstepA; const char* b3 = b2 + kstep;
            PG8_LDBX(0, 0, 0); PG8_SCHED; PG8_LDAX(0, 0); PG8_STAGE_A(PG8_SA(1, 1), 1, a1, k1, vAc);
            if constexpr (GATHER) { if (last) {
#pragma unroll
                for (int _h = 0; _h < 2; ++_h)
#pragma unroll
                    for (int _i = 0; _i < 2; ++_i) vAc[_h][_i] = vAn[_h][_i]; } }
            PG8_WAIT_L(8); PG8_BAR; PG8_WAIT_L(0); PG8_MMX(0, 0, 0); PG8_BAR; PG8_SCHED;
            PG8_LDBX(1, 0, 1); PG8_STAGE_D(PG8_SB(0, 0), b2, voffB0, dB);
            PG8_BAR; PG8_WAIT_L(0); PG8_MMX(0, 1, 1); PG8_BAR;
            PG8_LDAX(0, 1); PG8_STAGE_A(PG8_SA(0, 0), 0, a2, k2, vAc);
            PG8_BAR; PG8_WAIT_L(0); PG8_MMX(1, 0, 0); PG8_BAR; PG8_SCHED;
            PG8_STAGE_D(PG8_SB(0, 1), b2 + hstep, voffB0, dB);
            PG8_WAIT_V(6); PG8_BAR; PG8_MMX(1, 1, 1); PG8_BAR;
            PG8_LDBX(0, 1, 0); PG8_SCHED; PG8_LDAX(1, 0); PG8_STAGE_A(PG8_SA(0, 1), 1, a2, k2, vAc);
            PG8_WAIT_L(8); PG8_BAR; PG8_WAIT_L(0); PG8_MMX(0, 0, 0); PG8_BAR; PG8_SCHED;
            PG8_LDBX(1, 1, 1); PG8_STAGE_D(PG8_SB(1, 0), b3, voffB0, dB);
            PG8_BAR; PG8_WAIT_L(0); PG8_MMX(0, 1, 1); PG8_BAR;
            PG8_LDAX(1, 1); PG8_STAGE_A(PG8_SA(1, 0), 0, a3, k3, vAc);
            PG8_BAR; PG8_WAIT_L(0); PG8_MMX(1, 0, 0); PG8_BAR; PG8_SCHED;
            PG8_STAGE_D(PG8_SB(1, 1), b3 + hstep, voffB0, dB);
            PG8_WAIT_V(6); PG8_BAR; PG8_MMX(1, 1, 1); PG8_BAR;
        }
        E(acc, cur, wr, wc, fr, fq);
        if (!has_next) break;
#pragma unroll
        for (int a = 0; a < 2; ++a)
#pragma unroll
            for (int b = 0; b < 2; ++b)
#pragma unroll
                for (int m = 0; m < 4; ++m)
#pragma unroll
                    for (int n = 0; n < 2; ++n) acc[a][b][m][n] = (f32x4){0.f, 0.f, 0.f, 0.f};
        cur = nxt; cA = nA; cB = nB; ++ui;
        if constexpr (GATHER) {
#pragma unroll
            for (int _h = 0; _h < 2; ++_h)
#pragma unroll
                for (int _i = 0; _i < 2; ++_i) vAc[_h][_i] = vAn[_h][_i]; }
    }
    PG8_WAIT_V(0);
    if (wr == 0) PG8_BAR;
    PG8_BAR;
#undef PG8_SA
#undef PG8_SB
#undef PG8_STAGE
#undef PG8_STAGE_D
#undef PG8_GLDS
#undef PG8_STAGE_A
#undef PG8_GATHER_OFF
#undef PG8_LDA
#undef PG8_LDB
#undef PG8_MMA
#undef PG8_MMA8
#undef PG8_LDA8
#undef PG8_LDB8
#undef PG8_LDAX
#undef PG8_LDBX
#undef PG8_MMX
#undef PG8_CAT8
#undef PG8_WAIT_V
#undef PG8_WAIT_L
#undef PG8_BAR
#undef PG8_SCHED
}
}

struct Args {
    const float* in[29];
    float* out; unsigned char* ws;
    int ph_lo, ph_hi;
    int wv, zero_;
};
enum { I_X = 0, I_MEM, I_NMIXG, I_NMEMG, I_WIN, I_WMK, I_WMV, I_CONVW, I_CONVB, I_CLNG, I_CLNB, I_SHIFTMU, I_DW0, I_DUP, I_IA0, I_IUP, I_GUP, I_KK, I_KA, I_RK,
       I_LNXG, I_LNXB, I_WOUT, I_NFFNG, I_WROUTER, I_WEG, I_WEU, I_WED, I_FNG };

template <bool F8 = false>
__device__ __forceinline__ void transpose_item(const float* W, int N, bf16_t* WT, int K, int k0, int n0, int drow0, LAS float* scr, int lane) {
    {
        f32x4 v[8];
#pragma unroll
        for (int i = 0; i < 8; ++i) v[i] = *(const f32x4*)(W + (size_t)(k0 + 8 * i + (lane >> 3)) * N + n0 + 4 * (lane & 7));
#pragma unroll
        for (int i = 0; i < 8; ++i) { LAS float* d = scr + (8 * i + (lane >> 3)) * 33 + 4 * (lane & 7); d[0] = v[i].x; d[1] = v[i].y; d[2] = v[i].z; d[3] = v[i].w; }
    }
    asm volatile("s_waitcnt lgkmcnt(0)" ::: "memory");
    const int c = lane & 7;
#pragma unroll
    for (int j = 0; j < 4; ++j) { const int n = (lane >> 3) + 8 * j; const LAS float* s = scr + (8 * c) * 33 + n;
        if constexpr (F8) { *(u32x2*)((unsigned char*)WT + (size_t)(drow0 + n) * K + k0 + 8 * c) = (u32x2){pk_fp8x4(32.f * s[0 * 33], 32.f * s[1 * 33], 32.f * s[2 * 33], 32.f * s[3 * 33]), pk_fp8x4(32.f * s[4 * 33], 32.f * s[5 * 33], 32.f * s[6 * 33], 32.f * s[7 * 33])}; }
        else { u32x4 o; o.x = pk_bf16(s[0 * 33], s[1 * 33]); o.y = pk_bf16(s[2 * 33], s[3 * 33]); o.z = pk_bf16(s[4 * 33], s[5 * 33]); o.w = pk_bf16(s[6 * 33], s[7 * 33]);
            *(u32x4*)(WT + (size_t)(drow0 + n) * K + k0 + 8 * c) = o; } }
    asm volatile("s_waitcnt lgkmcnt(0)" ::: "memory");
}
__device__ __forceinline__ void expert_prep_items(const Args& a, LAS unsigned char* lds, int widx, int nw, int it_lo, int it_hi) {
    int tid = tid_of(a.wv); asm volatile("" : "+v"(tid)); const int lane = tid & 63, wave = __builtin_amdgcn_readfirstlane(tid >> 6);
    LAS float* scr = (LAS float*)(lds + wave * 16384);
    unsigned char* ws = a.ws;
    constexpr int S_EXP = 16 * 16 * 32;
    for (int r = it_lo + widx; r < it_hi; r += nw) {
        const int which = r / S_EXP, q = r % S_EXP, e = q / 512, kb = (q % 512) / 32, nb = q % 32, n0 = nb * 32;
        if (which == 0) transpose_item<true>(a.in[I_WEG] + (size_t)e * D * FF, FF, (bf16_t*)(ws + WS_WGUT + (size_t)e * 2048 * D), D, kb * 64, n0, (n0 >> 7) * 256 + (n0 & 127), scr, lane);
        else if (which == 1) transpose_item<true>(a.in[I_WEU] + (size_t)e * D * FF, FF, (bf16_t*)(ws + WS_WGUT + (size_t)e * 2048 * D), D, kb * 64, n0, (n0 >> 7) * 256 + 128 + (n0 & 127), scr, lane);
        else transpose_item<true>(a.in[I_WED] + (size_t)e * FF * D, D, (bf16_t*)(ws + WS_WDT + (size_t)e * D * FF), FF, kb * 64, n0, n0, scr, lane);
    }
}

__device__ __forceinline__ void rms_row_to_bf16(const float* xrow, const float* g, bf16_t* orow, int lane) {
    const f32x4* xr = (const f32x4*)xrow + lane; const f32x4* gr = (const f32x4*)g + lane;
    f32x4 v[4]; float s = 0.f;
#pragma unroll
    for (int j = 0; j < 4; ++j) { v[j] = xr[64 * j]; s += (v[j].x * v[j].x + v[j].y * v[j].y) + (v[j].z * v[j].z + v[j].w * v[j].w); }
    const float rs = 1.0f / sqrtf(wave_sum(s) * (1.f / D) + 1e-6f);
    u32x2* o8 = (u32x2*)orow + lane;
#pragma unroll
    for (int j = 0; j < 4; ++j) { const f32x4 gg = gr[64 * j]; u32x2 w; w.x = pk_bf16(v[j].x * rs * gg.x, v[j].y * rs * gg.y); w.y = pk_bf16(v[j].z * rs * gg.z, v[j].w * rs * gg.w); o8[64 * j] = w; }
}
__device__ __forceinline__ void phase_prep(const Args& a, LAS unsigned char* lds, int G) {
    int tid = tid_of(a.wv); asm volatile("" : "+v"(tid)); const int lane = tid & 63, wave = __builtin_amdgcn_readfirstlane(tid >> 6);
    LAS float* scr = (LAS float*)(lds + wave * 16384);
    const int gw = blockIdx.x * 8 + wave, NGW = G * 8;
    unsigned char* ws = a.ws;
    constexpr int S_WIN = 16 * 80, S_WOUT = 16 * 32, S_MK = 16 * 8, S_SM = 12, S_GUP = 24;
    constexpr int NITEMS = S_WIN + S_WOUT + 2 * S_MK + 4 * S_SM + S_GUP;
    for (int it = gw; it < NITEMS; it += NGW) {
        int r = it;
        if (r < S_WIN) { const int kb = r / 80, nb = r % 80; transpose_item(a.in[I_WIN], IN_PROJ, (bf16_t*)(ws + WS_WINT), D, kb * 64, nb * 32, nb * 32, scr, lane); continue; } r -= S_WIN;
        if (r < S_WOUT) { const int kb = r / 32, nb = r % 32; transpose_item(a.in[I_WOUT], D, (bf16_t*)(ws + WS_WOUTT), D, kb * 64, nb * 32, nb * 32, scr, lane); continue; } r -= S_WOUT;
        if (r < S_MK) { const int kb = r / 8, nb = r % 8; transpose_item(a.in[I_WMK], 256, (bf16_t*)(ws + WS_WKT), D, kb * 64, nb * 32, nb * 32, scr, lane); continue; } r -= S_MK;
        if (r < S_MK) { const int kb = r / 8, nb = r % 8; transpose_item(a.in[I_WMV], 256, (bf16_t*)(ws + WS_WVT), D, kb * 64, nb * 32, nb * 32, scr, lane); continue; } r -= S_MK;
        if (r < 4 * S_SM) { const int which = r / S_SM, nb = r % S_SM;
            const float* src = (which < 2 ? a.in[I_DUP] : a.in[I_IUP]) + (size_t)(which & 1) * 64 * RW;
            transpose_item(src, RW, (bf16_t*)(ws + WS_SMALL) + (size_t)which * RW * 64, 64, 0, nb * 32, nb * 32, scr, lane); continue; } r -= 4 * S_SM;
        { const int kb = r / 12, nb = r % 12; transpose_item(a.in[I_GUP], RW, (bf16_t*)(ws + WS_SMALL) + (size_t)4 * RW * 64, 128, kb * 64, nb * 32, nb * 32, scr, lane); }
    }
    for (int m = gw; m < T; m += NGW) rms_row_to_bf16(a.in[I_X] + (size_t)m * D, a.in[I_NMIXG], (bf16_t*)(ws + WS_XH) + (size_t)m * D, lane);
    for (int m = gw; m < BATCH * NMEM; m += NGW) rms_row_to_bf16(a.in[I_MEM] + (size_t)m * D, a.in[I_NMEMG], (bf16_t*)(ws + WS_MEMN) + (size_t)m * D, lane);
}

constexpr int AT_KS = 144;
constexpr int AT_VS = 520;
constexpr int AT_VOFF = 256 * AT_KS;
__device__ __forceinline__ bf16x8 pack_step(const f32x16& x, int s) {
    u32x4 p;
    asm volatile("v_cvt_pk_bf16_f32 %0, %4, %5\n\tv_cvt_pk_bf16_f32 %1, %6, %7\n\tv_cvt_pk_bf16_f32 %2, %8, %9\n\tv_cvt_pk_bf16_f32 %3, %10, %11\n\ts_nop 1"
                 : "=&v"(p[0]), "=&v"(p[1]), "=&v"(p[2]), "=&v"(p[3])
                 : "v"(x[8 * s]), "v"(x[8 * s + 1]), "v"(x[8 * s + 2]), "v"(x[8 * s + 3]), "v"(x[8 * s + 4]), "v"(x[8 * s + 5]), "v"(x[8 * s + 6]), "v"(x[8 * s + 7]));
    return __builtin_bit_cast(bf16x8, p);
}
__device__ __forceinline__ void attn_unit(const Args& a, LAS unsigned char* lds, int unit) {
    int tid = tid_of(a.wv); asm volatile("" : "+v"(tid)); const int lane = tid & 63, wave = __builtin_amdgcn_readfirstlane(tid >> 6), r = lane & 31, h = lane >> 5;
    const int b = unit >> 2, hh = unit & 3;
    const bf16_t* Qb = (const bf16_t*)(a.ws + WS_Q); const bf16_t* KM = (const bf16_t*)(a.ws + WS_KMEM); const bf16_t* VT = (const bf16_t*)(a.ws + WS_VT);
    bf16_t* MIX = (bf16_t*)(a.ws + WS_MIX);
    __syncthreads();
#pragma unroll
    for (int i = 0; i < 4; ++i) { const int c = tid + 512 * i, key = c >> 3, ch = c & 7;
        const u32x4 v = *(const u32x4*)(KM + (size_t)(b * NMEM + key) * 256 + hh * 64 + ch * 8);
        *(LAS u32x4*)(lds + key * AT_KS + ch * 16) = v; }
#pragma unroll
    for (int i = 0; i < 4; ++i) { const int c = tid + 512 * i, d = c >> 5, ch = c & 31;
        const u32x4 v = *(const u32x4*)(VT + (size_t)(hh * 64 + d) * (BATCH * NMEM) + b * NMEM + ch * 8);
        LAS u32x2* dst = (LAS u32x2*)(lds + AT_VOFF + d * AT_VS + ch * 16);
        dst[0] = (u32x2){v.x, v.y}; dst[1] = (u32x2){v.z, v.w}; }
    __syncthreads();
#pragma unroll 1
    for (int tile = 0; tile < 16; ++tile) {
    const int tok0 = b * SEQ + tile * 256 + wave * 32;
    bf16x8 qf[4];
#pragma unroll
    for (int ks = 0; ks < 4; ++ks) qf[ks] = *(const bf16x8*)(Qb + (size_t)(tok0 + r) * 256 + hh * 64 + ks * 16 + h * 8);
    const float sc = 0.125f * 1.4426950408889634f;
    float m_run = -3.0e38f, sum = 0.f;
    f32x16 o[2];
#pragma unroll
    for (int dt = 0; dt < 2; ++dt)
#pragma unroll
        for (int i = 0; i < 16; ++i) o[dt][i] = 0.f;
#pragma unroll 1
    for (int kh = 0; kh < 2; ++kh) {
        f32x16 s[4];
#pragma unroll
        for (int k4 = 0; k4 < 4; ++k4) {
#pragma unroll
            for (int i = 0; i < 16; ++i) s[k4][i] = 0.f;
#pragma unroll
            for (int ks = 0; ks < 4; ++ks) { const bf16x8 ka = *(const LAS bf16x8*)(lds + ((kh * 4 + k4) * 32 + r) * AT_KS + (ks * 16 + h * 8) * 2);
                s[k4] = __builtin_amdgcn_mfma_f32_32x32x16_bf16(ka, qf[ks], s[k4], 0, 0, 0); }
        }
        float mx = m_run;
#pragma unroll
        for (int k4 = 0; k4 < 4; ++k4)
#pragma unroll
            for (int i = 0; i < 16; ++i) mx = fmaxf(mx, s[k4][i]);
        mx = fmaxf(mx, __shfl_xor(mx, 32));
        const float alpha = __builtin_amdgcn_exp2f((m_run - mx) * sc);
        float ps = 0.f;
#pragma unroll
        for (int k4 = 0; k4 < 4; ++k4)
#pragma unroll
            for (int i = 0; i < 16; ++i) { const float e = __builtin_amdgcn_exp2f((s[k4][i] - mx) * sc); s[k4][i] = e; ps += e; }
        ps += __shfl_xor(ps, 32);
        sum = sum * alpha + ps; m_run = mx;
#pragma unroll
        for (int dt = 0; dt < 2; ++dt)
#pragma unroll
            for (int i = 0; i < 16; ++i) o[dt][i] *= alpha;
#pragma unroll
        for (int k4 = 0; k4 < 4; ++k4)
#pragma unroll
            for (int s2 = 0; s2 < 2; ++s2) {
                const bf16x8 pb = pack_step(s[k4], s2);
#pragma unroll
                for (int dt = 0; dt < 2; ++dt) {
                    const LAS unsigned char* vp = lds + AT_VOFF + (32 * dt + r) * AT_VS + (32 * (kh * 4 + k4) + 16 * s2 + 4 * h) * 2;
                    const s16x4 lo = *(const LAS s16x4*)vp, hi = *(const LAS s16x4*)(vp + 16);
                    const bf16x8 va = __builtin_shufflevector(lo, hi, 0, 1, 2, 3, 4, 5, 6, 7);
                    o[dt] = __builtin_amdgcn_mfma_f32_32x32x16_bf16(va, pb, o[dt], 0, 0, 0);
                }
            }
    }
    const float inv = 1.0f / sum;
    bf16_t* orow = MIX + (size_t)(tok0 + r) * D + hh * 64;
#pragma unroll
    for (int dt = 0; dt < 2; ++dt)
#pragma unroll
        for (int gq = 0; gq < 4; ++gq) { u32x2 w; w.x = pk_bf16(o[dt][4 * gq] * inv, o[dt][4 * gq + 1] * inv); w.y = pk_bf16(o[dt][4 * gq + 2] * inv, o[dt][4 * gq + 3] * inv);
            *(u32x2*)(orow + 32 * dt + 8 * gq + 4 * h) = w; }
    }
}

__device__ __forceinline__ void conv_unit(const Args& a, LAS unsigned char* lds, int unit) {
    int tid = tid_of(a.wv); asm volatile("" : "+v"(tid)); const int lane = tid & 63, wave = __builtin_amdgcn_readfirstlane(tid >> 6);
    const int b = unit >> 6, t0 = (unit & 63) * 64;
    const bf16_t* P = (const bf16_t*)(a.ws + WS_P); bf16_t* MIX = (bf16_t*)(a.ws + WS_MIX);
    LAS _Float16* U = (LAS _Float16*)lds;
    LAS _Float16* Cc = (LAS _Float16*)(lds + 94 * CW * 2);
    __syncthreads();
#pragma unroll 1
    for (int q0 = tid; q0 < 94 * 48; q0 += 3 * NTHREADS) {
        u32x4 vvv[3], ggg[3];
#pragma unroll
        for (int u3 = 0; u3 < 3; ++u3) { const int q = q0 + u3 * NTHREADS, j = q / 48, cc = (q % 48) * 8, s = t0 - 15 + j; const bool ok = (q < 94 * 48) && s >= 0 && s < SEQ;
            const bf16_t* row = P + (size_t)(b * SEQ + (ok ? s : 0)) * PLD + cc;
            vvv[u3] = ok ? *(const u32x4*)row : (u32x4){0u, 0u, 0u, 0u}; ggg[u3] = ok ? *(const u32x4*)(row + CW) : (u32x4){0u, 0u, 0u, 0u}; }
#pragma unroll
        for (int u3 = 0; u3 < 3; ++u3) { const int q = q0 + u3 * NTHREADS, j = q / 48, cc = (q % 48) * 8;
            if (q < 94 * 48) {
                const unsigned vw[4] = {vvv[u3].x, vvv[u3].y, vvv[u3].z, vvv[u3].w}, gw[4] = {ggg[u3].x, ggg[u3].y, ggg[u3].z, ggg[u3].w};
                float u[8];
#pragma unroll
                for (int k = 0; k < 4; ++k) { u[2 * k] = bf_lo(vw[k]) * sigmoidf_fast(bf_lo(gw[k])); u[2 * k + 1] = bf_hi(vw[k]) * sigmoidf_fast(bf_hi(gw[k])); }
                LAS f16x4* dst = (LAS f16x4*)(U + j * CW + cc); dst[0] = (f16x4){(_Float16)u[0], (_Float16)u[1], (_Float16)u[2], (_Float16)u[3]}; dst[1] = (f16x4){(_Float16)u[4], (_Float16)u[5], (_Float16)u[6], (_Float16)u[7]}; }
        }
    }
    __syncthreads();
    const int cq = tid & 127, tq = tid >> 7;
#pragma unroll 1
    for (int k3 = 0; k3 < 3; ++k3) { const int c = cq + 128 * k3;
        float w[31], res[16];
#pragma unroll
        for (int kk = 0; kk < 31; ++kk) w[kk] = a.in[I_CONVW][kk * CW + c];
        const float bias = a.in[I_CONVB][c];
#pragma unroll
        for (int tt = 0; tt < 16; ++tt) res[tt] = bias;
#pragma unroll
        for (int jj = 0; jj < 46; ++jj) { const float uv = (float)U[(tq * 16 + jj) * CW + c];
#pragma unroll
            for (int tt = 0; tt < 16; ++tt) { if (jj - tt >= 0 && jj - tt <= 30) res[tt] += uv * w[jj - tt]; } }
#pragma unroll
        for (int tt = 0; tt < 16; ++tt) Cc[(tq * 16 + tt) * CW + c] = (_Float16)res[tt];
    }
    __syncthreads();
    for (int tt = 0; tt < 8; ++tt) { const int t = wave * 8 + tt;
        float v[6]; float s = 0.f;
#pragma unroll
        for (int i = 0; i < 6; ++i) { v[i] = (float)Cc[t * CW + lane + 64 * i]; s += v[i]; }
        const float mean = wave_sum(s) * (1.f / CW); float q = 0.f;
#pragma unroll
        for (int i = 0; i < 6; ++i) { v[i] -= mean; q += v[i] * v[i]; }
        const float rstd = 1.0f / sqrtf(wave_sum(q) * (1.f / CW) + 1e-5f);
        bf16_t* orow = MIX + (size_t)(b * SEQ + t0 + t) * D + 256;
#pragma unroll
        for (int i = 0; i < 6; ++i) { const int c = lane + 64 * i; const float y = v[i] * rstd * a.in[I_CLNG][c] + a.in[I_CLNB][c]; const float o = y * sigmoidf_fast(y);
            orow[c] = (bf16_t)(pk_bf16(o, 0.f) & 0xffffu); }
    }
}

constexpr int PR_AS = 784;
constexpr int PR_RK = 64 * PR_AS;
constexpr int PR_RKS = 1536;
constexpr int PR_RN = PR_RK + 64 * PR_RKS;
constexpr int PR_CST = PR_RN + 2048;
static_assert(PR_CST + 7 * 384 * 4 <= LDS_BYTES - 64, "prep LDS map");
template <int V> struct IC { static constexpr int value = V; };
template <int CTRL> __device__ __forceinline__ f32x4 dpp4(f32x4 x) { return (f32x4){dpp_f<CTRL>(x.x), dpp_f<CTRL>(x.y), dpp_f<CTRL>(x.z), dpp_f<CTRL>(x.w)}; }
__device__ __forceinline__ void prep_unit(const Args& a, LAS unsigned char* lds, int unit) {
    int tid = tid_of(a.wv); asm volatile("" : "+v"(tid)); const int lane = tid & 63, wave = __builtin_amdgcn_readfirstlane(tid >> 6);
    const int b = unit >> 6, t0 = (unit & 63) * 64;
    const bf16_t* __restrict__ P = (const bf16_t*)(a.ws + WS_P);
    const float* __restrict__ mu = a.in[I_SHIFTMU];
    LAS float* RNs = (LAS float*)(lds + PR_RN); LAS float* CST = (LAS float*)(lds + PR_CST);
    __syncthreads();
    for (int i = tid; i < 7 * 384; i += NTHREADS) { const int w7 = i / 384, c7 = i % 384;
        CST[i] = (w7 == 0) ? a.in[I_KK][c7] : (w7 == 1) ? a.in[I_KA][c7] : (w7 == 2) ? a.in[I_RK][c7] : (w7 < 5) ? a.in[I_DW0][(w7 - 3) * RW + c7] : a.in[I_IA0][(w7 - 5) * RW + c7]; }
#ifndef PREP_REP1
#define PREP_REP1 1
#endif
    struct S1Buf { u32x4 cu[2], pv[2], nv[2]; f32x4 m0a, m0b, m1a, m1b, ka, kb; };
    const int s1row = 8 * wave + (lane >> 4), s1c = lane & 15;
    auto s1_issue = [&](auto sc, S1Buf& B) {
        constexpr int sb = decltype(sc)::value, ty = (sb / 3 == 0) ? 2 : (sb / 3 == 1) ? 0 : (sb / 3 == 2) ? 1 : 3, cg = sb % 3;
        const int c8 = ty * 384 + (cg * 16 + s1c) * 8;
#pragma unroll
        for (int th = 0; th < 2; ++th) { const int sq = t0 + s1row + 4 * th;
            const bf16_t* row = P + ((size_t)b * SEQ + sq) * PLD + 768 + c8;
            B.cu[th] = *(const u32x4*)row;
            B.pv[th] = (sq > 0) ? *(const u32x4*)(row - PLD) : (u32x4){0u, 0u, 0u, 0u};
            B.nv[th] = (sq < SEQ - 1) ? *(const u32x4*)(row + PLD) : (u32x4){0u, 0u, 0u, 0u}; }
        B.m0a = *(const f32x4*)(mu + c8); B.m0b = *(const f32x4*)(mu + c8 + 4); B.m1a = *(const f32x4*)(mu + 1536 + c8); B.m1b = *(const f32x4*)(mu + 1536 + c8 + 4);
        if (ty == 1) { B.ka = *(const f32x4*)(a.in[I_KK] + c8 - 384); B.kb = *(const f32x4*)(a.in[I_KK] + c8 - 384 + 4); }
    };
    auto s1_compute = [&](auto sc, const S1Buf& B) {
        constexpr int sb = decltype(sc)::value, ty = (sb / 3 == 0) ? 2 : (sb / 3 == 1) ? 0 : (sb / 3 == 2) ? 1 : 3, cg = sb % 3;
        const int c8 = ty * 384 + (cg * 16 + s1c) * 8;
        const float m0[8] = {B.m0a.x, B.m0a.y, B.m0a.z, B.m0a.w, B.m0b.x, B.m0b.y, B.m0b.z, B.m0b.w}, m1[8] = {B.m1a.x, B.m1a.y, B.m1a.z, B.m1a.w, B.m1b.x, B.m1b.y, B.m1b.z, B.m1b.w};
#pragma unroll
        for (int th = 0; th < 2; ++th) { const int tt = s1row + 4 * th; const size_t tok = (size_t)b * SEQ + t0 + tt;
            const u32x4 cu = B.cu[th], pv = B.pv[th], nv = B.nv[th];
            const unsigned cw[4] = {cu.x, cu.y, cu.z, cu.w}, pw[4] = {pv.x, pv.y, pv.z, pv.w}, nw[4] = {nv.x, nv.y, nv.z, nv.w};
            float pf[8];
#pragma unroll
            for (int k = 0; k < 4; ++k) { const float c0 = bf_lo(cw[k]), c1 = bf_hi(cw[k]);
                pf[2 * k] = c0 + m0[2 * k] * (bf_lo(pw[k]) - c0) + m1[2 * k] * (bf_lo(nw[k]) - c0);
                pf[2 * k + 1] = c1 + m0[2 * k + 1] * (bf_hi(pw[k]) - c1) + m1[2 * k + 1] * (bf_hi(nw[k]) - c1); }
            if (ty < 2) {
                f16x4 h0 = {(_Float16)pf[0], (_Float16)pf[1], (_Float16)pf[2], (_Float16)pf[3]}, h1 = {(_Float16)pf[4], (_Float16)pf[5], (_Float16)pf[6], (_Float16)pf[7]};
                LAS f16x4* dst = (LAS f16x4*)(lds + PR_RK + tt * PR_RKS + c8 * 2); dst[0] = h0; dst[1] = h1;
                if (ty == 1) { const f32x4 ka = B.ka, kb = B.kb;
                    float ssq = (pf[0] * ka.x) * (pf[0] * ka.x) + (pf[1] * ka.y) * (pf[1] * ka.y) + (pf[2] * ka.z) * (pf[2] * ka.z) + (pf[3] * ka.w) * (pf[3] * ka.w)
                              + (pf[4] * kb.x) * (pf[4] * kb.x) + (pf[5] * kb.y) * (pf[5] * kb.y) + (pf[6] * kb.z) * (pf[6] * kb.z) + (pf[7] * kb.w) * (pf[7] * kb.w);
                    ssq = sum8(ssq);
                    if ((lane & 7) == 0) RNs[tt * 8 + ((c8 - 384) >> 6)] = __builtin_amdgcn_rsqf(ssq + 1e-12f); }
            } else if (ty == 2) {
                u32x4 w; w.x = pk_bf16(pf[0], pf[1]); w.y = pk_bf16(pf[2], pf[3]); w.z = pk_bf16(pf[4], pf[5]); w.w = pk_bf16(pf[6], pf[7]);
                *(u32x4*)((bf16_t*)scan_arr(a.ws, 0) + hat_off(0, tok, c8 - 768)) = w;
            } else {
                const int cc = c8 - 1152;
#pragma unroll
                for (int k = 0; k < 8; ++k) { if (cg == 0) pf[k] = 1.0f - 2.0f * __builtin_amdgcn_rcpf(1.0f + __builtin_amdgcn_exp2f(2.8853900817779268f * pf[k])); else if (cg == 2) pf[k] = sigmoidf_fast(pf[k]); }
                u32x4 w; w.x = pk_bf16(pf[0], pf[1]); w.y = pk_bf16(pf[2], pf[3]); w.z = pk_bf16(pf[4], pf[5]); w.w = pk_bf16(pf[6], pf[7]);
                *(LAS u32x4*)(lds + tt * PR_AS + cc * 2) = w; }
        }
    };
#pragma unroll 1
    for (int rp1 = 0; rp1 < PREP_REP1; ++rp1) {
        S1Buf B0, B1, B2;
        s1_issue(IC<0>{}, B0); s1_issue(IC<1>{}, B1);
        s1_issue(IC<2>{}, B2); s1_compute(IC<0>{}, B0);
        s1_issue(IC<3>{}, B0); s1_compute(IC<1>{}, B1);
        s1_issue(IC<4>{}, B1); s1_compute(IC<2>{}, B2);
        s1_issue(IC<5>{}, B2); s1_compute(IC<3>{}, B0);
        s1_issue(IC<6>{}, B0); s1_compute(IC<4>{}, B1);
        s1_issue(IC<7>{}, B1); s1_compute(IC<5>{}, B2);
        s1_issue(IC<8>{}, B2); s1_compute(IC<6>{}, B0);
        s1_issue(IC<9>{}, B0); s1_compute(IC<7>{}, B1);
        s1_issue(IC<10>{}, B1); s1_compute(IC<8>{}, B2);
        s1_issue(IC<11>{}, B2); s1_compute(IC<9>{}, B0);
        s1_compute(IC<10>{}, B1); s1_compute(IC<11>{}, B2);
    }
    __syncthreads();
    const int l15 = lane & 15, kq = lane >> 4;
    float* __restrict__ PCg = (float*)(a.ws + WS_PC); float* __restrict__ BON = (float*)(a.ws + WS_BON);
    const char* SMb = (const char*)(a.ws + WS_SMALL);
    const unsigned wlo64 = (unsigned)(((8 * (l15 >> 2) + (l15 & 3)) * 64 + kq * 8) * 2), wlo128 = (unsigned)(((8 * (l15 >> 2) + (l15 & 3)) * 128 + kq * 8) * 2);
    const unsigned hlo = (unsigned)((l15 * 64 + 8 * kq) * 2), klo = (unsigned)((l15 * D + 8 * kq) * 2), glo = (unsigned)((l15 * RW + 8 * kq) * 2);
    bf16x8 Fc[16], Fn[16];
#define PREP_LOADW(hd_, kind_) do { \
        if ((kind_) < 2) { const char* w_ = SMb + ((size_t)(kind_) * RW * 64 + (size_t)(hd_) * 64 * 64) * 2; \
            _Pragma("unroll") for (int f_ = 0; f_ < 16; ++f_) Fn[f_] = *(const bf16x8*)(w_ + (size_t)(((f_ >> 2) & 1) * (2 * RW * 64 * 2) + (32 * ((f_ & 3) >> 1) + 4 * (f_ & 1)) * 128 + (f_ >> 3) * 64) + wlo64); } \
        else { const char* w_ = SMb + ((size_t)4 * RW * 64 + (size_t)(hd_) * 64 * 128) * 2; \
            _Pragma("unroll") for (int f_ = 0; f_ < 16; ++f_) Fn[f_] = *(const bf16x8*)(w_ + (size_t)((32 * ((f_ & 3) >> 1) + 4 * (f_ & 1)) * 256 + (f_ >> 2) * 64) + wlo128); } } while (0)
    auto dir_stage = [&](auto dc, const int it, const int nhd, const int nkind) {
        constexpr int d = decltype(dc)::value;
        const int hd = it >> 2, mt = it & 3, tokl = mt * 16 + l15; const size_t tb = (size_t)b * SEQ + t0 + mt * 16;
#pragma unroll
        for (int f = 0; f < 16; ++f) Fc[f] = Fn[f];
        f32x4 accW[4], accA[4];
#pragma unroll
        for (int nt = 0; nt < 4; ++nt) { accW[nt] = (f32x4){0.f, 0.f, 0.f, 0.f}; accA[nt] = (f32x4){0.f, 0.f, 0.f, 0.f}; }
#pragma unroll
        for (int ks = 0; ks < 2; ++ks) {
            const bf16x8 aw = *(const LAS bf16x8*)(lds + tokl * PR_AS + (d * 64 + ks * 32 + kq * 8) * 2), aa = *(const LAS bf16x8*)(lds + tokl * PR_AS + ((2 + d) * 64 + ks * 32 + kq * 8) * 2);
#pragma unroll
            for (int nt = 0; nt < 4; ++nt) { accW[nt] = MFMA16(Fc[ks * 8 + nt], aw, accW[nt]); accA[nt] = MFMA16(Fc[ks * 8 + 4 + nt], aa, accA[nt]); }
        }
        if (nkind >= 0) PREP_LOADW(nhd, nkind);
        const float rn = RNs[tokl * 8 + hd];
        const size_t tile_b = ((((tb >> 4) * NH + hd) << 10)) * 2;
        char* AHb = (char*)scan_arr(a.ws, 1 + 4 * d) + tile_b; char* RHb = (char*)scan_arr(a.ws, 2 + 4 * d) + tile_b; char* BHb = (char*)scan_arr(a.ws, 3 + 4 * d) + tile_b;
        char* KHb = d ? (char*)scan_arr(a.ws, 8) + (tb * D + hd * 64) * 2 : (char*)scan_arr(a.ws, 4) + tile_b; const unsigned khlo = d ? klo : hlo;
        char* PCb = (char*)(PCg + ((size_t)d * (T / 16) + (tb >> 4)) * RW + hd * 64); char* BOb = (char*)(BON + (size_t)d * T * NH + tb * NH + hd);
        float bsum = 0.f;
        u32x2 hA[2], hR[2], hB[2], hK[2]; f32x4 PtS[4];
#pragma unroll
        for (int nt = 0; nt < 4; ++nt) { const int ch = hd * 64 + 32 * (nt >> 1) + 8 * kq + 4 * (nt & 1);
            const f32x4 bW = *(const LAS f32x4*)(CST + (3 + d) * 384 + ch), bA = *(const LAS f32x4*)(CST + (5 + d) * 384 + ch);
            const f32x4 kkw = *(const LAS f32x4*)(CST + ch), kaw = *(const LAS f32x4*)(CST + 384 + ch), rkw = *(const LAS f32x4*)(CST + 768 + ch);
            const f32x4 zw = accW[nt] + bW, za = accA[nt] + bA;
            f32x4 lw, av;
#pragma unroll
            for (int e = 0; e < 4; ++e) { lw[e] = -0.606531f * 1.4426950408889634f * sigmoidf_fast(zw[e]); av[e] = sigmoidf_fast(za[e]); }
            f32x4 cum = lw;
            if (d == 0) { cum += dpp4<0x111>(cum); cum += dpp4<0x112>(cum); cum += dpp4<0x114>(cum); cum += dpp4<0x118>(cum); }
            else        { cum += dpp4<0x101>(cum); cum += dpp4<0x102>(cum); cum += dpp4<0x104>(cum); cum += dpp4<0x108>(cum); }
            f32x4 Pt, Pinv, Pprev;
#pragma unroll
            for (int e = 0; e < 4; ++e) { Pt[e] = __builtin_amdgcn_exp2f(cum[e]); Pinv[e] = __builtin_amdgcn_rcpf(Pt[e]);
                Pprev[e] = __builtin_amdgcn_exp2f(cum[e] - lw[e]); }
            PtS[nt] = Pt;
            const f32x4 r4 = __builtin_convertvector(*(const LAS f16x4*)(lds + PR_RK + tokl * PR_RKS + ch * 2), f32x4);
            const f32x4 k4 = __builtin_convertvector(*(const LAS f16x4*)(lds + PR_RK + tokl * PR_RKS + (384 + ch) * 2), f32x4);
            const f32x4 kk = k4 * kkw * rn, kd = k4 * (1.0f + (av - 1.0f) * kaw);
            hA[nt & 1] = f32_to_bf4(-kk * Pprev); hR[nt & 1] = f32_to_bf4(r4 * Pt); hB[nt & 1] = f32_to_bf4(kk * av * Pinv); hK[nt & 1] = f32_to_bf4(kd * Pinv);
            const f32x4 bt = r4 * kd * rkw; bsum += (bt.x + bt.y) + (bt.z + bt.w);
            if (nt & 1) { const int pr = nt >> 1;
                *(u32x4*)(AHb + (hlo + 64 * pr)) = (u32x4){hA[0].x, hA[0].y, hA[1].x, hA[1].y}; *(u32x4*)(RHb + (hlo + 64 * pr)) = (u32x4){hR[0].x, hR[0].y, hR[1].x, hR[1].y};
                *(u32x4*)(BHb + (hlo + 64 * pr)) = (u32x4){hB[0].x, hB[0].y, hB[1].x, hB[1].y}; *(u32x4*)(KHb + (khlo + 64 * pr)) = (u32x4){hK[0].x, hK[0].y, hK[1].x, hK[1].y}; }
        }
        if (l15 == (d ? 0 : 15)) {
#pragma unroll
            for (int nt = 0; nt < 4; ++nt) *(f32x4*)(PCb + (unsigned)(8 * kq * 4) + (32 * (nt >> 1) + 4 * (nt & 1)) * 4) = PtS[nt]; }
        bsum += __shfl_xor(bsum, 16); bsum += __shfl_xor(bsum, 32);
        if (kq == 0) *(float*)(BOb + (unsigned)(l15 * NH * 4)) = bsum;
    };
    auto gate_stage = [&](const int it, const int nhd, const int nkind) {
        const int hd = it >> 2, mt = it & 3, tokl = mt * 16 + l15; const size_t tb = (size_t)b * SEQ + t0 + mt * 16;
#pragma unroll
        for (int f = 0; f < 16; ++f) Fc[f] = Fn[f];
        f32x4 acc[4];
#pragma unroll
        for (int nt = 0; nt < 4; ++nt) acc[nt] = (f32x4){0.f, 0.f, 0.f, 0.f};
#pragma unroll
        for (int ks = 0; ks < 4; ++ks) { const bf16x8 afr = *(const LAS bf16x8*)(lds + tokl * PR_AS + (256 + ks * 32 + kq * 8) * 2);
#pragma unroll
            for (int nt = 0; nt < 4; ++nt) acc[nt] = MFMA16(Fc[ks * 4 + nt], afr, acc[nt]); }
        if (nkind >= 0) PREP_LOADW(nhd, nkind);
        char* Gb = (char*)((bf16_t*)(a.ws + WS_G) + tb * RW + hd * 64);
#pragma unroll
        for (int pr = 0; pr < 2; ++pr) { const u32x2 g0 = f32_to_bf4(acc[2 * pr]), g1 = f32_to_bf4(acc[2 * pr + 1]);
            *(u32x4*)(Gb + (glo + 64 * pr)) = (u32x4){g0.x, g0.y, g1.x, g1.y}; }
    };
    PREP_LOADW(wave >> 2, 0);
#pragma unroll 1
    for (int k3 = 0; k3 < 3; ++k3) { const int it = wave + 8 * k3, hd = it >> 2;
        dir_stage(IC<0>{}, it, hd, 1);
        dir_stage(IC<1>{}, it, hd, 2);
        gate_stage(it, (it + 8) >> 2, k3 < 2 ? 0 : -1);
    }
#undef PREP_LOADW
}

__device__ __forceinline__ void glds16_asm(const void* gptr, LAS unsigned char* ldst) {
    const unsigned la = __builtin_amdgcn_readfirstlane((unsigned)(size_t)ldst);
    asm volatile("s_mov_b32 m0, %1\n\ts_nop 0\n\tglobal_load_lds_dwordx4 %0, off" :: "v"(gptr), "s"(la) : "m0", "memory");
}
constexpr int CK = 16, NCHUNK = SEQ / CK, CS_NS = 8, CS_NPROD = 6, CS_NCONS = 2;
constexpr int SL_ATIL = 0, SL_RTIL = 2048, SL_BH = 4096, SL_KH = 6144, SL_V = 8192, SL_ULOC = 10240, SL_YLOC = 12288, SL_PC = 14336, SL_BYTES = 14592;
constexpr int PS_AH = 0, PS_RH = 2048, PS_BYTES = 4096;
constexpr int CS_PS_OFF = CS_NS * SL_BYTES, CS_FLAG_OFF = CS_PS_OFF + CS_NPROD * PS_BYTES;
static_assert(CS_FLAG_OFF + 64 <= LDS_BYTES - 64, "chunked scan LDS map");
__device__ __forceinline__ int swz(int t, int j) { return t * 128 + ((((j >> 3) ^ (t & 7))) << 4) + ((j & 4) << 1); }
__device__ __forceinline__ void scan_chunked_unit(const Args& a, LAS unsigned char* lds, int unit) {
    int tid = tid_of(a.wv); asm volatile("" : "+v"(tid)); const int lane = tid & 63, wave = __builtin_amdgcn_readfirstlane(tid >> 6);
    const int dir = unit & 1, bh = unit >> 1, b = bh / NH, hd = bh % NH;
    const int c16 = lane & 15, q = lane >> 4, qp = c16 >> 2, pp = c16 & 3;
    volatile LAS unsigned* FULL = (volatile LAS unsigned*)(lds + CS_FLAG_OFF);
    volatile LAS unsigned* DONE = FULL + 8;
    float* Yg = (float*)(a.ws + (dir ? WS_YB : WS_YF));
    __syncthreads();
    if (tid < 16) FULL[tid] = 0u;
    __syncthreads();
    if (wave >= CS_NCONS) {
        const int pw = wave - CS_NCONS;
        LAS unsigned char* ps = lds + CS_PS_OFF + pw * PS_BYTES;
        const bf16_t* ARR[5] = {(const bf16_t*)scan_arr(a.ws, 1 + 4 * dir), (const bf16_t*)scan_arr(a.ws, 2 + 4 * dir), (const bf16_t*)scan_arr(a.ws, 3 + 4 * dir), (const bf16_t*)scan_arr(a.ws, 4 + 4 * dir), (const bf16_t*)scan_arr(a.ws, 0)};
        const int AIDX[5] = {1 + 4 * dir, 2 + 4 * dir, 3 + 4 * dir, 4 + 4 * dir, 0};
        const float* PCg = (const float*)(a.ws + WS_PC) + (size_t)dir * (T / 16) * RW + hd * 64 + lane;
        u32x4 pf[10];
#define CS_ISSUE(cc) do { _Pragma("unroll") for (int ar_ = 0; ar_ < 5; ++ar_) _Pragma("unroll") for (int hf_ = 0; hf_ < 2; ++hf_) { \
            const int row_ = hf_ * 8 + (lane >> 3); const int st_ = (cc) * CK + row_; const int t_ = dir ? (SEQ - 1 - st_) : st_; \
            pf[ar_ * 2 + hf_] = *(const u32x4*)(ARR[ar_] + hat_off(AIDX[ar_], (size_t)b * SEQ + t_, hd * 64 + 8 * ((lane & 7) ^ (row_ & 7)))); } } while (0)
#define CS_PCLOAD(cc) PCg[(size_t)((size_t)b * (SEQ / CK) + (dir ? (NCHUNK - 1 - (cc)) : (cc))) * RW]
        CS_ISSUE(pw);
        float pcn = CS_PCLOAD(pw);
#pragma unroll 1
        for (int c = pw; c < NCHUNK; c += CS_NPROD) {
            const int slot = c % CS_NS; LAS unsigned char* sl = lds + slot * SL_BYTES;
            { unsigned sp = 0; const unsigned want = (unsigned)CS_NCONS * (unsigned)(c / CS_NS); while (DONE[slot] < want) { __builtin_amdgcn_s_sleep(1); if (++sp > (1u << 22)) break; } }
            asm volatile("" ::: "memory");
            *(LAS u32x4*)(ps + PS_AH + lane * 16) = pf[0]; *(LAS u32x4*)(ps + PS_AH + 1024 + lane * 16) = pf[1];
            *(LAS u32x4*)(ps + PS_RH + lane * 16) = pf[2]; *(LAS u32x4*)(ps + PS_RH + 1024 + lane * 16) = pf[3];
            *(LAS u32x4*)(sl + SL_BH + lane * 16) = pf[4]; *(LAS u32x4*)(sl + SL_BH + 1024 + lane * 16) = pf[5];
            *(LAS u32x4*)(sl + SL_KH + lane * 16) = pf[6]; *(LAS u32x4*)(sl + SL_KH + 1024 + lane * 16) = pf[7];
            *(LAS u32x4*)(sl + SL_V + lane * 16) = pf[8]; *(LAS u32x4*)(sl + SL_V + 1024 + lane * 16) = pf[9];
            *(LAS float*)(sl + SL_PC + lane * 4) = pcn;
            if (c + CS_NPROD < NCHUNK) { CS_ISSUE(c + CS_NPROD); pcn = CS_PCLOAD(c + CS_NPROD); }
            asm volatile("s_waitcnt lgkmcnt(0)" ::: "memory");
#ifndef PROD_REP
#define PROD_REP 1
#endif
#pragma unroll 1
            for (int rpp = 0; rpp < PROD_REP; ++rpp) {
            bf16x8 AHf[2], BHf[2], KHf[2], RHf[2];
#pragma unroll
            for (int ks = 0; ks < 2; ++ks) { const int o = swz(c16, 32 * ks + 8 * q);
                AHf[ks] = *(const LAS bf16x8*)(ps + PS_AH + o); RHf[ks] = *(const LAS bf16x8*)(ps + PS_RH + o); BHf[ks] = *(const LAS bf16x8*)(sl + SL_BH + o); KHf[ks] = *(const LAS bf16x8*)(sl + SL_KH + o); }
            f32x4 Mab = {0.f, 0.f, 0.f, 0.f}, Mak = Mab, MrbT = Mab, MrkT = Mab, MabT = Mab;
#pragma unroll
            for (int ks = 0; ks < 2; ++ks) { Mab = MFMA16(AHf[ks], BHf[ks], Mab); MabT = MFMA16(BHf[ks], AHf[ks], MabT); Mak = MFMA16(AHf[ks], KHf[ks], Mak); MrbT = MFMA16(BHf[ks], RHf[ks], MrbT); MrkT = MFMA16(KHf[ks], RHf[ks], MrkT); }
#pragma unroll
            for (int r = 0; r < 4; ++r) { const bool lt = c16 < 4 * q + r, gt = 4 * q + r < c16, le = 4 * q + r <= c16;
                Mab[r] = lt ? Mab[r] : 0.f; Mak[r] = lt ? Mak[r] : 0.f; MabT[r] = gt ? MabT[r] : 0.f; MrbT[r] = le ? MrbT[r] : 0.f; MrkT[r] = le ? MrkT[r] : 0.f; }
            const f32x4 z4 = {0.f, 0.f, 0.f, 0.f};
            const bf16x8 fN = frag_lo4(Mab), fNT = frag_lo4(MabT);
            const f32x4 N2 = MFMA16(fNT, fN, z4), N2T = MFMA16(fN, fNT, z4);
            f32x4 PT = MabT;
#pragma unroll
            for (int r = 0; r < 4; ++r) PT[r] += (4 * q + r == c16) ? 1.0f : 0.f;
            const bf16x8 fN2 = frag_lo4(N2), fN2T = frag_lo4(N2T);
            PT = MFMA16(fN2, frag_lo4(PT), PT);
            const f32x4 N4 = MFMA16(fN2T, fN2, z4), N4T = MFMA16(fN2, fN2T, z4);
            const bf16x8 fN4 = frag_lo4(N4), fN4T = frag_lo4(N4T);
            PT = MFMA16(fN4, frag_lo4(PT), PT);
            const f32x4 N8 = MFMA16(fN4T, fN4, z4);
            PT = MFMA16(frag_lo4(N8), frag_lo4(PT), PT);
            const bf16x8 LinvF = frag_lo4(PT);
            const bf16x8 MakF = frag_lo4(Mak), MrbTF = frag_lo4(MrbT);
            const f32x4 W1 = MFMA16(LinvF, MakF, z4);
            const f32x4 W1T = MFMA16(MakF, LinvF, z4);
            const f32x4 W2T = MFMA16(frag_lo4(W1), MrbTF, MrkT);
            f32x4 AtT[4], RtT[4];
#pragma unroll
            for (int jt = 0; jt < 4; ++jt) {
                const bf16x8 ahF = frag_cat(__builtin_bit_cast(u32x2, tr_read16(ps + PS_AH + swz(4 * q + qp, 16 * jt + 4 * pp))), (u32x2){0u, 0u});
                const f32x4 AtN = MFMA16(LinvF, ahF, z4);
                AtT[jt] = MFMA16(ahF, LinvF, z4);
                const f32x4 rinit = bf4_to_f32(*(const LAS u32x2*)(ps + PS_RH + swz(c16, 16 * jt + 4 * q)));
                RtT[jt] = MFMA16(frag_lo4(AtN), MrbTF, rinit);
            }
#pragma unroll
            for (int ks = 0; ks < 2; ++ks) {
                const u32x4 wa = {pk_bf16(AtT[2 * ks][0], AtT[2 * ks][1]), pk_bf16(AtT[2 * ks][2], AtT[2 * ks][3]), pk_bf16(AtT[2 * ks + 1][0], AtT[2 * ks + 1][1]), pk_bf16(AtT[2 * ks + 1][2], AtT[2 * ks + 1][3])};
                const u32x4 wr = {pk_bf16(RtT[2 * ks][0], RtT[2 * ks][1]), pk_bf16(RtT[2 * ks][2], RtT[2 * ks][3]), pk_bf16(RtT[2 * ks + 1][0], RtT[2 * ks + 1][1]), pk_bf16(RtT[2 * ks + 1][2], RtT[2 * ks + 1][3])};
                *(LAS u32x4*)(sl + SL_ATIL + ks * 1024 + lane * 16) = wa; *(LAS u32x4*)(sl + SL_RTIL + ks * 1024 + lane * 16) = wr; }
            *(LAS u32x2*)(sl + SL_ULOC + lane * 8) = f32_to_bf4(W1T); *(LAS u32x2*)(sl + SL_YLOC + lane * 8) = f32_to_bf4(W2T);
            }
            asm volatile("s_waitcnt lgkmcnt(0)" ::: "memory");
            if (lane == 0) FULL[slot] = (unsigned)(c + 1);
        }
#undef CS_ISSUE
#undef CS_PCLOAD
    } else {
        struct ConsOps { bf16x8 at0, at1, rt0, rt1, bk[4]; u32x2 w1w, w2w, vfw[2]; f32x4 pc[4]; };
        f32x4 S[2][4];
#pragma unroll
        for (int ti = 0; ti < 2; ++ti)
#pragma unroll
            for (int mt = 0; mt < 4; ++mt) S[ti][mt] = (f32x4){0.f, 0.f, 0.f, 0.f};
#define CONS_LOAD(X, cc) do { const int slot_ = (cc) % CS_NS; LAS unsigned char* sl_ = lds + slot_ * SL_BYTES; \
            { unsigned sp_ = 0; while (FULL[slot_] < (unsigned)((cc) + 1)) { __builtin_amdgcn_s_sleep(1); if (++sp_ > (1u << 22)) break; } } \
            asm volatile("" ::: "memory"); \
            X.at0 = *(const LAS bf16x8*)(sl_ + SL_ATIL + lane * 16); X.at1 = *(const LAS bf16x8*)(sl_ + SL_ATIL + 1024 + lane * 16); \
            X.rt0 = *(const LAS bf16x8*)(sl_ + SL_RTIL + lane * 16); X.rt1 = *(const LAS bf16x8*)(sl_ + SL_RTIL + 1024 + lane * 16); \
            X.w1w = *(const LAS u32x2*)(sl_ + SL_ULOC + lane * 8); X.w2w = *(const LAS u32x2*)(sl_ + SL_YLOC + lane * 8); \
            _Pragma("unroll") for (int mt_ = 0; mt_ < 4; ++mt_) { X.pc[mt_] = *(const LAS f32x4*)(sl_ + SL_PC + (16 * mt_ + 4 * q) * 4); \
                X.bk[mt_] = frag_cat(__builtin_bit_cast(u32x2, tr_read16(sl_ + SL_BH + swz(4 * q + qp, 16 * mt_ + 4 * pp))), __builtin_bit_cast(u32x2, tr_read16(sl_ + SL_KH + swz(4 * q + qp, 16 * mt_ + 4 * pp)))); } \
            _Pragma("unroll") for (int ti_ = 0; ti_ < 2; ++ti_) X.vfw[ti_] = __builtin_bit_cast(u32x2, tr_read16(sl_ + SL_V + swz(4 * q + qp, 16 * (2 * wave + ti_) + 4 * pp))); } while (0)
#define CONS_COMPUTE(X, cc) do { const f32x4 z4c_ = {0.f, 0.f, 0.f, 0.f}; const bf16x8 w1f_ = frag_cat(X.w1w, (u32x2){0u, 0u}), w2f_ = frag_cat(X.w2w, (u32x2){0u, 0u}); \
            _Pragma("unroll") for (int ti_ = 0; ti_ < 2; ++ti_) { const int nt_ = 2 * wave + ti_; \
                const bf16x8 vB_ = frag_cat(X.vfw[ti_], (u32x2){0u, 0u}); \
                const bf16x8 Sb0_ = frag_cat(f32_to_bf4(S[ti_][0]), f32_to_bf4(S[ti_][1])), Sb1_ = frag_cat(f32_to_bf4(S[ti_][2]), f32_to_bf4(S[ti_][3])); \
                const f32x4 U0_ = MFMA16(X.at0, Sb0_, MFMA16(w1f_, vB_, z4c_)), U1_ = MFMA16(X.at1, Sb1_, z4c_); \
                const f32x4 Y0_ = MFMA16(X.rt0, Sb0_, MFMA16(w2f_, vB_, z4c_)), Y1_ = MFMA16(X.rt1, Sb1_, z4c_); \
                const f32x4 UT_ = U0_ + U1_, YT_ = Y0_ + Y1_; \
                const bf16x8 Ub_ = frag_cat(f32_to_bf4(UT_), X.vfw[ti_]); \
                _Pragma("unroll") for (int mt_ = 0; mt_ < 4; ++mt_) { S[ti_][mt_] = MFMA16(X.bk[mt_], Ub_, S[ti_][mt_]); S[ti_][mt_] = S[ti_][mt_] * X.pc[mt_]; } \
                *(f32x4*)(Yg + ((((size_t)b * NCHUNK + (dir ? (NCHUNK - 1 - (cc)) : (cc))) * NH + hd) * 64 + 16 * nt_ + c16) * 16 + 4 * q) = YT_; } } while (0)
#define CONS_DONE(cc) do { asm volatile("s_waitcnt lgkmcnt(0)" ::: "memory"); if (lane == 0) (void)__hip_atomic_fetch_add((LAS unsigned*)&DONE[(cc) % CS_NS], 1u, __ATOMIC_RELAXED, __HIP_MEMORY_SCOPE_WORKGROUP); } while (0)
        ConsOps OA, OB;
        CONS_LOAD(OA, 0);
#pragma unroll 1
        for (int c = 0; c < NCHUNK; c += 2) {
            CONS_LOAD(OB, c + 1);
            CONS_COMPUTE(OA, c);
            CONS_DONE(c);
            if (c + 2 < NCHUNK) CONS_LOAD(OA, c + 2);
            CONS_COMPUTE(OB, c + 1);
            CONS_DONE(c + 1);
        }
#undef CONS_LOAD
#undef CONS_COMPUTE
#undef CONS_DONE
        unsigned tq0 = 0u, tq1 = 0u, tq2 = 0u, tq3 = 0u, tq4 = 0u, tq5 = 0u, tacc = 0u;
        (void)tq0; (void)tq1; (void)tq2; (void)tq3; (void)tq4; (void)tq5;
        (void)tacc;
    }
}

__device__ __forceinline__ void phase_post(const Args& a, int G) {
    int tid = tid_of(a.wv); asm volatile("" : "+v"(tid)); const int lane = tid & 63, wave = __builtin_amdgcn_readfirstlane(tid >> 6);
    const int gw = blockIdx.x * 8 + wave, NGW = G * 8, t = lane & 15, iq = lane >> 4;
    const float* __restrict__ YF = (const float*)(a.ws + WS_YF); const float* __restrict__ YB = (const float*)(a.ws + WS_YB); const float* __restrict__ BON = (const float*)(a.ws + WS_BON);
    const bf16_t* __restrict__ Vg = (const bf16_t*)scan_arr(a.ws, 0); const bf16_t* __restrict__ Gg = (const bf16_t*)(a.ws + WS_G); bf16_t* __restrict__ MIX = (bf16_t*)(a.ws + WS_MIX);
    float* ss = (float*)(a.ws + WS_SS);
    for (int i = blockIdx.x * NTHREADS + tid; i < T; i += G * NTHREADS) ss[i] = 0.f;
    constexpr int NIT = (T / 16) * NH;
#pragma unroll 1
    for (int it = gw; it < NIT; it += NGW) {
        const int tile = it / NH, hd = it - tile * NH, tok = tile * 16 + t;
        const float* yfp = YF + ((size_t)it * 64 + 16 * iq) * 16 + t; const float* ybp = YB + ((size_t)it * 64 + 16 * iq) * 16 + (15 - t);
        float y[16];
#pragma unroll
        for (int k = 0; k < 16; ++k) y[k] = yfp[k * 16] + ybp[k * 16];
        const u32x4 v0 = *(const u32x4*)(Vg + ((size_t)it * 16 + t) * 64 + 16 * iq), v1 = *(const u32x4*)(Vg + ((size_t)it * 16 + t) * 64 + 16 * iq + 8);
        const u32x4 g0 = *(const u32x4*)(Gg + (size_t)tok * RW + hd * 64 + 16 * iq), g1 = *(const u32x4*)(Gg + (size_t)tok * RW + hd * 64 + 16 * iq + 8);
        const float bon = BON[(size_t)tok * NH + hd] + BON[(size_t)T * NH + (size_t)tok * NH + hd];
        float sm = 0.f;
#pragma unroll
        for (int k = 0; k < 16; ++k) sm += y[k];
        sm += __shfl_xor(sm, 16); sm += __shfl_xor(sm, 32);
        const float mean = sm * (1.f / 64.f); float vs = 0.f;
#pragma unroll
        for (int k = 0; k < 16; ++k) { y[k] -= mean; vs += y[k] * y[k]; }
        vs += __shfl_xor(vs, 16); vs += __shfl_xor(vs, 32);
        const float rstd = 1.0f / sqrtf(vs * (1.f / 64.f) + 64e-5f);
        const unsigned vw[8] = {v0.x, v0.y, v0.z, v0.w, v1.x, v1.y, v1.z, v1.w}, gwd[8] = {g0.x, g0.y, g0.z, g0.w, g1.x, g1.y, g1.z, g1.w};
        unsigned ow[8];
#pragma unroll
        for (int k2 = 0; k2 < 8; ++k2) { const int ch = hd * 64 + 16 * iq + 2 * k2;
            const float o0 = (y[2 * k2] * rstd * a.in[I_LNXG][ch] + a.in[I_LNXB][ch] + bon * bf_lo(vw[k2])) * bf_lo(gwd[k2]);
            const float o1 = (y[2 * k2 + 1] * rstd * a.in[I_LNXG][ch + 1] + a.in[I_LNXB][ch + 1] + bon * bf_hi(vw[k2])) * bf_hi(gwd[k2]);
            ow[k2] = pk_bf16(o0, o1); }
        bf16_t* op = MIX + (size_t)tok * D + 640 + hd * 64 + 16 * iq;
        *(u32x4*)op = (u32x4){ow[0], ow[1], ow[2], ow[3]}; *(u32x4*)(op + 8) = (u32x4){ow[4], ow[5], ow[6], ow[7]};
    }
}

constexpr int RT_WS = 2064;
__device__ __forceinline__ void phase_router(const Args& a, LAS unsigned char* lds, int G) {
    int tid = tid_of(a.wv); asm volatile("" : "+v"(tid)); const int lane = tid & 63, wave = __builtin_amdgcn_readfirstlane(tid >> 6);
    const int gw = blockIdx.x * 8 + wave, NGW = G * 8, l15 = lane & 15, kq = lane >> 4;
    LAS bf16_t* WH = (LAS bf16_t*)lds; LAS bf16_t* WL = (LAS bf16_t*)(lds + 16 * RT_WS);
    for (int i = tid; i < D * NE; i += NTHREADS) { const int k = i >> 4, e = i & 15; const float w = a.in[I_WROUTER][i];
        const unsigned hi = pk_bf16(w, 0.f) & 0xffffu; const float rem = w - bf_lo(hi);
        WH[e * (RT_WS / 2) + k] = (bf16_t)hi; WL[e * (RT_WS / 2) + k] = (bf16_t)(pk_bf16(rem, 0.f) & 0xffffu); }
    __syncthreads();
    const bf16_t* __restrict__ X1 = (const bf16_t*)(a.ws + WS_X1); const float* __restrict__ ss = (const float*)(a.ws + WS_SS); bf16_t* __restrict__ H2 = (bf16_t*)(a.ws + WS_H2);
    float* __restrict__ AFF = (float*)(a.ws + WS_AFF); int* __restrict__ INV = (int*)(a.ws + WS_INV);
    const float* __restrict__ GF = a.in[I_NFFNG];
    for (int grp = gw; grp < T / 16; grp += NGW) {
        const int tok = grp * 16 + l15;
        const float rs = 1.0f / sqrtf(ss[tok] * (1.f / D) + 1e-6f);
        f32x4 acc = {0.f, 0.f, 0.f, 0.f};
        const bf16_t* xrow = X1 + (size_t)tok * D + 8 * kq; unsigned char* hrow8 = (unsigned char*)H2 + (size_t)tok * D + 8 * kq;
#pragma unroll 8
        for (int ks = 0; ks < 32; ++ks) {
            const u32x4 xw = *(const u32x4*)(xrow + 32 * ks); const f32x4 x0 = {bf_lo(xw.x), bf_hi(xw.x), bf_lo(xw.y), bf_hi(xw.y)}, x1v = {bf_lo(xw.z), bf_hi(xw.z), bf_lo(xw.w), bf_hi(xw.w)};
            const f32x4 g0 = *(const f32x4*)(GF + 32 * ks + 8 * kq), g1 = *(const f32x4*)(GF + 32 * ks + 8 * kq + 4);
            const f32x4 h0 = x0 * rs * g0, h1 = x1v * rs * g1;
            u32x4 hi; hi.x = pk_bf16(h0.x, h0.y); hi.y = pk_bf16(h0.z, h0.w); hi.z = pk_bf16(h1.x, h1.y); hi.w = pk_bf16(h1.z, h1.w);
            *(u32x2*)(hrow8 + 32 * ks) = (u32x2){pk_fp8x4(h0.x, h0.y, h0.z, h0.w), pk_fp8x4(h1.x, h1.y, h1.z, h1.w)};
            u32x4 lo; lo.x = pk_bf16(h0.x - bf_lo(hi.x), h0.y - bf_hi(hi.x)); lo.y = pk_bf16(h0.z - bf_lo(hi.y), h0.w - bf_hi(hi.y));
            lo.z = pk_bf16(h1.x - bf_lo(hi.z), h1.y - bf_hi(hi.z)); lo.w = pk_bf16(h1.z - bf_lo(hi.w), h1.w - bf_hi(hi.w));
            const bf16x8 ah = __builtin_bit_cast(bf16x8, hi), al = __builtin_bit_cast(bf16x8, lo);
            const bf16x8 bh = *(const LAS bf16x8*)(lds + l15 * RT_WS + (32 * ks + 8 * kq) * 2), bl = *(const LAS bf16x8*)(lds + 16 * RT_WS + l15 * RT_WS + (32 * ks + 8 * kq) * 2);
            acc = __builtin_amdgcn_mfma_f32_16x16x32_bf16(ah, bh, acc, 0, 0, 0);
            acc = __builtin_amdgcn_mfma_f32_16x16x32_bf16(al, bh, acc, 0, 0, 0);
            acc = __builtin_amdgcn_mfma_f32_16x16x32_bf16(ah, bl, acc, 0, 0, 0);
        }
#pragma unroll
        for (int rg = 0; rg < 4; ++rg) { const float mx = max16(acc[rg]); const float ex = __expf(acc[rg] - mx); const float sm = sum16(ex);
            const int t2 = grp * 16 + 4 * kq + rg, bb = t2 >> 12, sq = t2 & (SEQ - 1);
            AFF[((size_t)(bb * NE + l15)) * SEQ + sq] = ex / sm; }
        *(u32x4*)(INV + (size_t)grp * 256 + 4 * lane) = (u32x4){0xffffffffu, 0xffffffffu, 0xffffffffu, 0xffffffffu};
    }
}

__device__ __forceinline__ void topk_unit(const Args& a, LAS unsigned char* lds, int unit) {
    int tid = tid_of(a.wv); asm volatile("" : "+v"(tid)); const int lane = tid & 63, wave = __builtin_amdgcn_readfirstlane(tid >> 6);
    const int b = unit >> 4, e = unit & 15;
    const float* AFF = (const float*)(a.ws + WS_AFF) + (size_t)unit * SEQ;
    LAS unsigned* KEY = (LAS unsigned*)lds;
    LAS unsigned* HIST = (LAS unsigned*)(lds + 16384);
    LAS unsigned* CTL = (LAS unsigned*)(lds + 16384 + 1024);
    LAS unsigned* WS_ = (LAS unsigned*)(lds + 16384 + 2048);
    __syncthreads();
    unsigned key[8];
    { const u32x4 k0 = *(const u32x4*)(AFF + tid * 8), k1 = *(const u32x4*)(AFF + tid * 8 + 4); key[0] = k0.x; key[1] = k0.y; key[2] = k0.z; key[3] = k0.w; key[4] = k1.x; key[5] = k1.y; key[6] = k1.z; key[7] = k1.w; }
    if (tid == 0) { CTL[0] = 0u; CTL[1] = (unsigned)CAP; }
    unsigned prefix = 0u, mask = 0u;
#pragma unroll 1
    for (int pass = 0; pass < 4; ++pass) {
        const int shift = 24 - 8 * pass;
        if (tid < 256) HIST[tid] = 0u;
        __syncthreads();
#pragma unroll
        for (int i = 0; i < 8; ++i) if ((key[i] & mask) == prefix) (void)__hip_atomic_fetch_add(&HIST[(key[i] >> shift) & 255u], 1u, __ATOMIC_RELAXED, __HIP_MEMORY_SCOPE_WORKGROUP);
        __syncthreads();
        if (wave == 0) {
            const unsigned need = CTL[1];
            unsigned hv[4], tsum = 0u;
#pragma unroll
            for (int i = 0; i < 4; ++i) { hv[i] = HIST[255 - (4 * lane + i)]; tsum += hv[i]; }
            unsigned inc = tsum;
#pragma unroll
            for (int o = 1; o < 64; o <<= 1) { const unsigned v = __shfl_up(inc, o); if (lane >= o) inc += v; }
            unsigned exc = inc - tsum;
            if (exc < need && need <= inc) {
                unsigned run = exc; int di = 0;
#pragma unroll
                for (int i = 0; i < 4; ++i) { if (run < need && need <= run + hv[i]) { di = i; break; } run += hv[i]; }
                const unsigned digit = 255u - (unsigned)(4 * lane + di);
                CTL[0] = prefix | (digit << shift); CTL[1] = need - run;
            }
        }
        __syncthreads();
        prefix = CTL[0]; mask |= (255u << shift);
    }
    const unsigned thr = prefix, need_eq = CTL[1];
    unsigned ngt = 0u, neq = 0u;
#pragma unroll
    for (int i = 0; i < 8; ++i) { ngt += (key[i] > thr) ? 1u : 0u; neq += (key[i] == thr) ? 1u : 0u; }
    unsigned pk = ngt | (neq << 16), inc = pk;
#pragma unroll
    for (int o = 1; o < 64; o <<= 1) { const unsigned v = __shfl_up(inc, o); if (lane >= o) inc += v; }
    if (lane == 63) WS_[wave] = inc;
    __syncthreads();
    unsigned woff = 0u, tot = 0u;
#pragma unroll
    for (int w = 0; w < 8; ++w) { const unsigned v = WS_[w]; if (w < wave) woff += v; tot += v; }
    const unsigned exc = inc - pk + woff;
    unsigned gpos = exc & 0xffffu, epos = exc >> 16; const unsigned totgt = tot & 0xffffu;
    const int sbase = (e * BATCH + b) * CAP;
    int* ROWTOK = (int*)(a.ws + WS_ROWTOK); float* ROWGATE = (float*)(a.ws + WS_ROWGATE); int* INV = (int*)(a.ws + WS_INV);
#pragma unroll
    for (int i = 0; i < 8; ++i) {
        int pos = -1;
        if (key[i] > thr) pos = (int)gpos++;
        else if (key[i] == thr) { if (epos < need_eq) pos = (int)(totgt + epos); epos++; }
        if (pos >= 0) { const int s = tid * 8 + i, tok = b * SEQ + s, slot = sbase + pos;
            ROWTOK[slot] = tok; ROWGATE[slot] = __builtin_bit_cast(float, key[i]); INV[(size_t)tok * NE + e] = slot; }
    }
}

__device__ __forceinline__ void phase_final(const Args& a, int G) {
    int tid = tid_of(a.wv); asm volatile("" : "+v"(tid)); const int lane = tid & 63, wave = __builtin_amdgcn_readfirstlane(tid >> 6);
    const int gw = blockIdx.x * 8 + wave, NGW = G * 8;
    const bf16_t* __restrict__ X1 = (const bf16_t*)(a.ws + WS_X1); const bf16_t* __restrict__ YE = (const bf16_t*)(a.ws + WS_YE); const int* __restrict__ INV = (const int*)(a.ws + WS_INV);
    float* __restrict__ OUT = a.out;
    f32x4 gg[4];
#pragma unroll
    for (int j = 0; j < 4; ++j) gg[j] = *(const f32x4*)(a.in[I_FNG] + 4 * lane + 256 * j);
#define PF_SLOTS(inv_, n_, m_, sl_) do { m_ = __ballot((inv_) >= 0) & 0xffffull; n_ = __builtin_popcountll(m_); unsigned long long mm_ = m_; \
        _Pragma("unroll") for (int k_ = 0; k_ < 4; ++k_) { if (mm_) { const int e_ = __builtin_ctzll(mm_); mm_ &= mm_ - 1; sl_[k_] = __builtin_amdgcn_readlane((inv_), e_); } else sl_[k_] = 0; } m_ = mm_; } while (0)
#define PF_ROWS(rw_, xr_, tk_, n_, sl_) do { \
        _Pragma("unroll") for (int k_ = 0; k_ < 4; ++k_) { if (k_ < (n_)) { _Pragma("unroll") for (int j_ = 0; j_ < 4; ++j_) rw_[k_][j_] = *(const u32x2*)(YE + (size_t)sl_[k_] * D + 4 * lane + 256 * j_); } \
            else { _Pragma("unroll") for (int j_ = 0; j_ < 4; ++j_) rw_[k_][j_] = (u32x2){0u, 0u}; } } \
        _Pragma("unroll") for (int j_ = 0; j_ < 4; ++j_) xr_[j_] = *(const u32x2*)(X1 + (size_t)(tk_) * D + 4 * lane + 256 * j_); } while (0)
    int tok = gw;
    if (tok >= T) return;
    int inv0 = INV[(size_t)tok * NE + (lane & 15)];
    int inv1 = (tok + NGW < T) ? INV[(size_t)(tok + NGW) * NE + (lane & 15)] : -1;
    unsigned long long mc; int nc, slc[4]; u32x2 rwc[4][4], xc[4];
    PF_SLOTS(inv0, nc, mc, slc);
    PF_ROWS(rwc, xc, tok, nc, slc);
    for (; tok < T; tok += NGW) {
        const int t1 = tok + NGW, t2 = tok + 2 * NGW;
        const int inv2 = (t2 < T) ? INV[(size_t)t2 * NE + (lane & 15)] : -1;
        unsigned long long mn = 0ull; int nn = 0, sln[4] = {0, 0, 0, 0}; u32x2 rwn[4][4], xn[4];
        if (t1 < T) { PF_SLOTS(inv1, nn, mn, sln); PF_ROWS(rwn, xn, t1, nn, sln); }
        else {
#pragma unroll
            for (int k = 0; k < 4; ++k)
#pragma unroll
                for (int j = 0; j < 4; ++j) rwn[k][j] = (u32x2){0u, 0u};
#pragma unroll
            for (int j = 0; j < 4; ++j) xn[j] = (u32x2){0u, 0u}; }
        f32x4 v[4];
#pragma unroll
        for (int j = 0; j < 4; ++j) v[j] = (f32x4){bf_lo(xc[j].x), bf_hi(xc[j].x), bf_lo(xc[j].y), bf_hi(xc[j].y)};
#pragma unroll
        for (int k = 0; k < 4; ++k)
#pragma unroll
            for (int j = 0; j < 4; ++j) { v[j].x += bf_lo(rwc[k][j].x); v[j].y += bf_hi(rwc[k][j].x); v[j].z += bf_lo(rwc[k][j].y); v[j].w += bf_hi(rwc[k][j].y); }
        if (nc > 4) { unsigned long long m = mc; while (m) { const int e = __builtin_ctzll(m); m &= m - 1; const int slot = __builtin_amdgcn_readlane(inv0, e);
#pragma unroll
                for (int j = 0; j < 4; ++j) { const u32x2 w = *(const u32x2*)(YE + (size_t)slot * D + 4 * lane + 256 * j);
                    v[j].x += bf_lo(w.x); v[j].y += bf_hi(w.x); v[j].z += bf_lo(w.y); v[j].w += bf_hi(w.y); } } }
        float sq = 0.f;
#pragma unroll
        for (int j = 0; j < 4; ++j) sq += (v[j].x * v[j].x + v[j].y * v[j].y) + (v[j].z * v[j].z + v[j].w * v[j].w);
        float rs = 1.0f / sqrtf(wave_sum(sq) * (1.f / D) + 1e-6f);
#pragma unroll
        for (int j = 0; j < 4; ++j) *(f32x4*)(OUT + (size_t)tok * D + 4 * lane + 256 * j) = v[j] * rs * gg[j];
        inv0 = inv1; inv1 = inv2; mc = mn; nc = nn;
#pragma unroll
        for (int k = 0; k < 4; ++k) { slc[k] = sln[k];
#pragma unroll
            for (int j = 0; j < 4; ++j) rwc[k][j] = rwn[k][j]; }
#pragma unroll
        for (int j = 0; j < 4; ++j) xc[j] = xn[j];
    }
#undef PF_SLOTS
#undef PF_ROWS
}

#define XB_TMO      128
#define XB_XCNT(j)  (256  + 64 * (j))
#define XB_XSUB(j)  (1280 + 64 * (j))
#define XB_XGEN(j)  (2304 + 64 * (j))
#define XB_TOP      3328
#define XB_TOPGEN   3392
#define XCD_BAR_WORDS 3456
#define XB_SPIN_CAP (1u << 22)
__device__ __forceinline__ unsigned xb_ld(unsigned* p)              { return __hip_atomic_load(p, __ATOMIC_RELAXED, __HIP_MEMORY_SCOPE_AGENT); }
__device__ __forceinline__ unsigned xb_add(unsigned* p, unsigned v) { return __hip_atomic_fetch_add(p, v, __ATOMIC_RELAXED, __HIP_MEMORY_SCOPE_AGENT); }
__device__ __forceinline__ unsigned xb_xcc_id() { return (unsigned)__builtin_amdgcn_s_getreg((3 << 11) | 20) & 0xFu; }
#define XB_SPIN(cond, bar) do { unsigned _sp = 0; while (cond) { __builtin_amdgcn_s_sleep(1); \
    if ((++_sp & 255u) == 0u) { if (xb_ld(&(bar)[XB_TMO])) break; if (_sp > XB_SPIN_CAP) { atomicAdd(&(bar)[XB_TMO], 1u); break; } } } } while (0)
struct XcdBarrier { unsigned* bar; unsigned x; volatile LAS unsigned* st; int wv; };
__device__ __forceinline__ XcdBarrier xcd_barrier_post(unsigned* bar, volatile LAS unsigned* st, int wv) {
    XcdBarrier b; b.bar = bar; b.x = xb_xcc_id(); b.st = st; b.wv = wv;
    if (threadIdx.x == 0) (void)xb_add(&bar[XB_XCNT(b.x)], 1u);
    return b;
}
__device__ __forceinline__ void xcd_barrier_complete(unsigned* bar, unsigned x, unsigned& nloc, unsigned& nx) {
    const unsigned G = gridDim.x * gridDim.y * gridDim.z;
    unsigned sum, cnt, mine, sp = 0u;
    for (;;) {
        sum = 0u; cnt = 0u; mine = 0u;
#pragma unroll
        for (unsigned j = 0; j < 16; ++j) { const unsigned c = xb_ld(&bar[XB_XCNT(j)]); sum += c; cnt += (c > 0u) ? 1u : 0u; mine = (j == x) ? c : mine; }
        if (sum == G) break;
        __builtin_amdgcn_s_sleep(1);
        if ((++sp & 255u) == 0u) { if (xb_ld(&bar[XB_TMO])) break; if (sp > XB_SPIN_CAP) { atomicAdd(&bar[XB_TMO], 1u); break; } }
    }
    nloc = mine > 0u ? mine : 1u; nx = cnt > 0u ? cnt : 1u;
}
__device__ __forceinline__ void xcd_barrier(const XcdBarrier& b) {
    asm volatile("s_waitcnt vmcnt(0)" ::: "memory");
    __syncthreads();
    if (tid_of(b.wv) == 0) {
        unsigned* bar = b.bar;
        __builtin_amdgcn_s_waitcnt(0);
        unsigned nloc = b.st[0], nx = b.st[1];
        if (nloc == 0u) { xcd_barrier_complete(bar, b.x, nloc, nx); b.st[0] = nloc; b.st[1] = nx; }
        const unsigned old = xb_add(&bar[XB_XSUB(b.x)], 1u);
        const unsigned gen = old / nloc;
        if (old + 1u == (gen + 1u) * nloc) {
            __builtin_amdgcn_fence(__ATOMIC_RELEASE, "agent");
            asm volatile("s_waitcnt vmcnt(0)" ::: "memory");
            const unsigned og = xb_add(&bar[XB_TOP], 1u);
            const unsigned tg = og / nx;
            if (og + 1u == (tg + 1u) * nx) xb_add(&bar[XB_TOPGEN], 1u);
            else XB_SPIN(xb_ld(&bar[XB_TOPGEN]) == tg, bar);
            __builtin_amdgcn_fence(__ATOMIC_ACQUIRE, "agent");
            xb_add(&bar[XB_XGEN(b.x)], 1u);
            asm volatile("s_waitcnt vmcnt(0)" ::: "memory");
        } else {
            XB_SPIN(xb_ld(&bar[XB_XGEN(b.x)]) == gen, bar);
            __builtin_amdgcn_fence(__ATOMIC_ACQUIRE, "agent");
            asm volatile("s_waitcnt vmcnt(0)" ::: "memory");
        }
    }
    __syncthreads();
}

#ifndef PH_MASK
#define PH_MASK 0x7ff
#endif
#ifndef REP_MASK
#define REP_MASK 0
#endif
#ifndef P2_MASK
#define P2_MASK 7
#endif
#ifndef P2_REP
#define P2_REP 0
#define P9_REP 0
#endif
constexpr int LDS_MISC = LDS_BYTES - 64;
constexpr int LDS_PTAB = LDS_BYTES - 512;
__device__ __forceinline__ Args load_args(LAS unsigned char* lds, int lo, int hi, int wv) {
    Args r; const LAS u32x2* t = (const LAS u32x2*)(lds + LDS_PTAB);
#pragma unroll
    for (int i = 0; i < 31; ++i) { const u32x2 v = t[i]; const unsigned long long p = ((unsigned long long)(unsigned)__builtin_amdgcn_readfirstlane((int)v.y) << 32) | (unsigned)__builtin_amdgcn_readfirstlane((int)v.x);
        if (i < 29) r.in[i] = (const float*)(const __attribute__((address_space(1))) float*)p; else if (i == 29) r.out = (float*)(__attribute__((address_space(1))) float*)p; else r.ws = (unsigned char*)(__attribute__((address_space(1))) unsigned char*)p; }
    r.ph_lo = lo; r.ph_hi = hi; r.wv = wv; r.zero_ = 0; return r;
}
constexpr size_t WS_CTL = 0, CTL_BYTES = 16384;
__global__ void __launch_bounds__(NTHREADS, 2) mega(Args a0) {
    extern __shared__ __attribute__((aligned(16))) unsigned char lds_raw[];
    LAS unsigned char* lds = (LAS unsigned char*)lds_raw;
    cg::grid_group grid = cg::this_grid();
    const int G = gridDim.x, lo = a0.ph_lo, hi = a0.ph_hi, wv0 = __builtin_amdgcn_readfirstlane((int)threadIdx.x >> 6);
    volatile LAS unsigned* misc = (volatile LAS unsigned*)(lds + LDS_MISC);
    if (threadIdx.x < 16) misc[threadIdx.x] = 0u;
    if (threadIdx.x == 0) { LAS unsigned long long* t = (LAS unsigned long long*)(lds + LDS_PTAB);
#pragma unroll
        for (int i = 0; i < 29; ++i) t[i] = (unsigned long long)a0.in[i];
        t[29] = (unsigned long long)a0.out; t[30] = (unsigned long long)a0.ws; }
    __syncthreads();
    if (lo < -1000) grid.sync();
    XcdBarrier xbar = xcd_barrier_post((unsigned*)(a0.ws + WS_CTL), misc, wv0);
#define IN(k) (((PH_MASK >> (k)) & 1) && lo <= (k) && (k) < hi)
#define NREP(k) (1 + ((REP_MASK >> (k)) & 1))
#define PHASE(k, ...) do { if (IN(k)) { for (int rep_ = 0; rep_ < NREP(k); ++rep_) { { const Args a = load_args(lds, lo, hi, wv0); unsigned char* const ws = a.ws; (void)ws; __VA_ARGS__; } if (rep_ + 1 < NREP(k) || IN((k) + 1)) { xcd_barrier(xbar); } } } } while (0)

    PHASE(0, phase_prep(a, lds, G));

    PHASE(1, {
        pg8::Gemm g{(const bf16_t*)(ws + WS_XH), (const bf16_t*)(ws + WS_WINT), T, IN_PROJ, D, 0, 0};
        pg8::TripleOrder S; S.S0.init(T, IN_PROJ, G, 0); S.A1 = (const bf16_t*)(ws + WS_MEMN); S.B1 = (const bf16_t*)(ws + WS_WKT); S.A2 = (const bf16_t*)(ws + WS_WVT); S.B2 = (const bf16_t*)(ws + WS_MEMN);
        S.n1 = BATCH * NMEM / 256; S.n2 = BATCH * NMEM / 256; S.G = G; S.c = (int)blockIdx.x;
        pg8::EpiBf16x3 E{pg8::EpiBf16{(bf16_t*)(ws + WS_P), PLD, (bf16_t*)(ws + WS_Q)}, pg8::EpiBf16{(bf16_t*)(ws + WS_KMEM), 256, nullptr}, pg8::EpiBf16{(bf16_t*)(ws + WS_VT), BATCH * NMEM, nullptr}};
        const int total = S.n1 + S.n2 + S.S0.nwg, rem = total % G, c = (int)blockIdx.x;
        const bool cv = rem ? (c >= rem) : true; const int ncv = rem ? G - rem : G, rank = rem ? c - rem : c;
        if (cv && !(rank & 1)) { expert_prep_items(a, lds, rank * 8 + a.wv, ncv * 8, 0, 3 * 8192); __syncthreads(); }
        pg8::gemm_phase<pg8::EpiBf16x3, pg8::TripleOrder, false>(lds, g, S, E, nullptr, a.wv);
        if (cv && (rank & 1)) { __syncthreads(); expert_prep_items(a, lds, rank * 8 + a.wv, ncv * 8, 0, 3 * 8192); }
    });

    constexpr int NSCAN = BATCH * NH * 2;
    PHASE(2, {
        for (int u = blockIdx.x; u < 2048; u += G) {
            if (u < 1024) { for (int r2 = 0; r2 < 1 + ((P2_REP >> 1) & 1); ++r2) conv_unit(a, lds, u); }
            else { for (int r2 = 0; r2 < 1 + ((P2_REP >> 2) & 1); ++r2) prep_unit(a, lds, u - 1024); }
        }
    });

    PHASE(3, {
        int bid = blockIdx.x; int Gp = G; asm volatile("" : "+s"(bid), "+s"(Gp));
        for (int u = bid; u < NSCAN; u += Gp) scan_chunked_unit(a, lds, u);
        if (rep_ == 0) {
            if (Gp > NSCAN) { if (bid >= NSCAN) { for (int u = bid - NSCAN; u < 64; u += Gp - NSCAN) for (int r2 = 0; r2 < 1 + (P2_REP & 1); ++r2) attn_unit(a, lds, u);
                                                 } }
            else { for (int u = bid; u < 64; u += Gp) attn_unit(a, lds, u); }
        }
    });

    PHASE(4, phase_post(a, G));

    PHASE(5, {
        pg8::Gemm g{(const bf16_t*)(ws + WS_MIX), (const bf16_t*)(ws + WS_WOUTT), T, D, D, 0, 0}; pg8::StaticOrder S; S.init(T, D, G, (int)blockIdx.x);
        pg8::EpiResidSS E{a.in[I_X], (bf16_t*)(ws + WS_X1), (float*)(ws + WS_SS)}; pg8::gemm_phase<pg8::EpiResidSS, pg8::StaticOrder, false>(lds, g, S, E, nullptr, a.wv);
    });

    PHASE(6, phase_router(a, lds, G));

    PHASE(7, { for (int u = blockIdx.x; u < BATCH * NE; u += G) topk_unit(a, lds, u); });

    PHASE(8, {
        pg8::Gemm g{(const bf16_t*)(ws + WS_H2), (const bf16_t*)(ws + WS_WGUT), NSLOT, 2048, D / 2, 0x7A7A7A7A, 0x7F7F7F7F};     pg8::ExpertOrder S; S.init(32, 8, NE, G, (int)blockIdx.x);
        pg8::EpiSwiGLU E{(bf16_t*)(ws + WS_HID)}; pg8::gemm_phase<pg8::EpiSwiGLU, pg8::ExpertOrder, true, false, true>(lds, g, S, E, (const int*)(ws + WS_ROWTOK), a.wv);
    });

    PHASE(9, {
        pg8::Gemm g{(const bf16_t*)(ws + WS_HID), (const bf16_t*)(ws + WS_WDT), NSLOT, D, FF / 2, 0x7A7A7A7A, 0x7C7C7C7C};     pg8::ExpertOrder S; S.init(32, 4, NE, G, (int)blockIdx.x);
        pg8::EpiGateScale E{(bf16_t*)(ws + WS_YE), (const float*)(ws + WS_ROWGATE)}; pg8::gemm_phase<pg8::EpiGateScale, pg8::ExpertOrder, false, true, true>(lds, g, S, E, nullptr, a.wv);
#if P9_REP
        __syncthreads(); pg8::gemm_phase<pg8::EpiGateScale, pg8::ExpertOrder, false, true, true>(lds, g, S, E, nullptr, a.wv);
#endif
    });

    PHASE(10, phase_final(a, G));
#undef IN
#undef NREP
#undef PHASE
}

#ifndef MK_ONE_LAUNCH
#define MK_ONE_LAUNCH 1
#endif
extern "C" void kernel_launch(void* const* d_in, const int* in_sizes, int n_in, void* d_out, int out_size, void* d_ws, size_t ws_size, hipStream_t stream) {
    static int grid_blocks = 0;
    if (grid_blocks == 0) {
        if (n_in != 29 || out_size != T * D || ws_size < WS_END) { fprintf(stderr, "kernel_launch: unexpected problem: n_in %d out %d ws %zu (need %zu)\n", n_in, out_size, ws_size, (size_t)WS_END); grid_blocks = -1; return; }
        int dev = 0, cus = 0, per_cu = 0;
        if (hipGetDevice(&dev) != hipSuccess || hipDeviceGetAttribute(&cus, hipDeviceAttributeMultiprocessorCount, dev) != hipSuccess) { grid_blocks = -1; return; }
        if (hipFuncSetAttribute((const void*)mega, hipFuncAttributeMaxDynamicSharedMemorySize, LDS_BYTES) != hipSuccess) { fprintf(stderr, "kernel_launch: hipFuncSetAttribute failed\n"); grid_blocks = -1; return; }
        if (hipOccupancyMaxActiveBlocksPerMultiprocessor(&per_cu, (const void*)mega, NTHREADS, LDS_BYTES) != hipSuccess || per_cu < 1) { fprintf(stderr, "kernel_launch: occupancy query says %d blocks per CU\n", per_cu); grid_blocks = -1; return; }
        grid_blocks = cus;
    }
    if (grid_blocks < 0) return;
    if (hipMemsetAsync((char*)d_ws + WS_CTL, 0, CTL_BYTES, stream) != hipSuccess) { fprintf(stderr, "kernel_launch: memset failed\n"); return; }
    Args a{};
    for (int i = 0; i < 29; ++i) a.in[i] = (const float*)d_in[i];
    a.out = (float*)d_out; a.ws = (unsigned char*)d_ws;
#if MK_ONE_LAUNCH
    a.ph_lo = 0; a.ph_hi = NPHASE;
    { void* args[] = {&a}; hipError_t e = hipLaunchCooperativeKernel((const void*)mega, dim3(grid_blocks), dim3(NTHREADS), args, LDS_BYTES, stream);
      if (e != hipSuccess) fprintf(stderr, "cooperative launch failed: %s (grid %d)\n", hipGetErrorString(e), grid_blocks); }
#else
    for (int ph = 0; ph < NPHASE; ++ph) { a.ph_lo = ph; a.ph_hi = ph + 1; void* args[] = {&a};
        hipError_t e = hipLaunchCooperativeKernel((const void*)mega, dim3(grid_blocks), dim3(NTHREADS), args, LDS_BYTES, stream);
        if (e != hipSuccess) { fprintf(stderr, "cooperative launch %d failed: %s (grid %d)\n", ph, hipGetErrorString(e), grid_blocks); break; } }
#endif
}
```

```cpp
#include <hip/hip_runtime.h>
#include <hip/hip_cooperative_groups.h>
#include <cstdio>
#include <cstdint>
namespace cg = cooperative_groups;

#define LAS __attribute__((address_space(3)))
typedef unsigned short bf16_t;
typedef short bf16x8 __attribute__((ext_vector_type(8)));
typedef short s16x4 __attribute__((ext_vector_type(4)));
typedef float f32x2 __attribute__((ext_vector_type(2)));
typedef float f32x4 __attribute__((ext_vector_type(4)));
typedef float f32x16 __attribute__((ext_vector_type(16)));
typedef unsigned u32x2 __attribute__((ext_vector_type(2)));
typedef unsigned u32x4 __attribute__((ext_vector_type(4)));
typedef _Float16 f16x4 __attribute__((ext_vector_type(4)));
typedef __bf16 bf16v2 __attribute__((ext_vector_type(2)));
typedef int v8i __attribute__((ext_vector_type(8)));
typedef int v4i __attribute__((ext_vector_type(4)));

constexpr int D = 1024, BATCH = 16, SEQ = 4096, T = BATCH * SEQ, NMEM = 256;
constexpr int IN_PROJ = 2560, CW = 384, RW = 384, NH = 6, NE = 16, FF = 1024, CAP = 512;
constexpr int NSLOT = NE * BATCH * CAP;
constexpr int NTHREADS = 512;
constexpr int LDS_BYTES = 160 * 1024;
constexpr int NPHASE = 11;
#ifndef SCAN_MODE
#define SCAN_MODE 1
#endif

constexpr size_t MiB = 1u << 20;
constexpr size_t WS_WINT = 1 * MiB;
constexpr size_t WS_WOUTT = 6 * MiB;
constexpr size_t WS_WKT = 8 * MiB;
constexpr size_t WS_WVT = 8 * MiB + 512 * 1024;
constexpr size_t WS_SMALL = 9 * MiB;
constexpr size_t WS_WGUT = 10 * MiB;
constexpr size_t WS_WDT = 74 * MiB;
constexpr size_t WS_KMEM = 106 * MiB;
constexpr size_t WS_VT = 108 * MiB;
constexpr size_t WS_ROWTOK = 106 * MiB;
constexpr size_t WS_ROWGATE = 106 * MiB + 512 * 1024;
constexpr size_t WS_SS = 107 * MiB;
constexpr size_t WS_P = 112 * MiB;
constexpr size_t WS_YF = 112 * MiB;
constexpr size_t WS_YB = 208 * MiB;
constexpr size_t WS_X1 = 112 * MiB;
constexpr size_t WS_XH = 432 * MiB;
constexpr size_t WS_G = 432 * MiB;
constexpr size_t WS_BON = 480 * MiB;
constexpr size_t WS_Q = 400 * MiB;
constexpr int PLD = IN_PROJ - 256;
constexpr size_t WS_H2 = 432 * MiB;
constexpr size_t WS_MEMN = 560 * MiB;
constexpr size_t WS_MIX = 560 * MiB;
constexpr size_t WS_SCAN = 688 * MiB;
constexpr size_t SCAN_STRIDE = 48 * MiB;
constexpr size_t WS_SCAN7 = 496 * MiB;
constexpr size_t WS_PC = 484 * MiB;
__device__ __forceinline__ unsigned char* scan_arr(unsigned char* ws, int a) { return a < 7 ? ws + WS_SCAN + (size_t)a * SCAN_STRIDE : (a == 7 ? ws + WS_SCAN7 : ws + 560 * MiB + 640 * 2); }
__device__ __forceinline__ int scan_pitch(int a) { return a == 8 ? D : 384; }
__device__ __forceinline__ size_t hat_off(int a, size_t tok, int ch) { return a == 8 ? tok * D + ch : ((((tok >> 4) * NH + (ch >> 6)) << 10) + ((tok & 15) << 6) + (ch & 63)); }
constexpr size_t WS_AFF = 624 * MiB;
constexpr size_t WS_INV = 628 * MiB;
constexpr size_t WS_HID = 768 * MiB;
constexpr size_t WS_YE = 368 * MiB;
constexpr size_t WS_END = 1024 * MiB;

__device__ __forceinline__ unsigned pk_bf16(float lo, float hi) { f32x2 v = {lo, hi}; bf16v2 b = __builtin_convertvector(v, bf16v2); return __builtin_bit_cast(unsigned, b); }
__device__ __forceinline__ unsigned pk_fp8x4(float a, float b, float c, float d) { int w = 0; w = __builtin_amdgcn_cvt_pk_fp8_f32(a, b, w, false); w = __builtin_amdgcn_cvt_pk_fp8_f32(c, d, w, true); return (unsigned)w; }
__device__ __forceinline__ float bf_lo(unsigned u) { return __builtin_bit_cast(float, u << 16); }
__device__ __forceinline__ float bf_hi(unsigned u) { return __builtin_bit_cast(float, u & 0xffff0000u); }
__device__ __forceinline__ float wave_sum(float v) {
#pragma unroll
    for (int o = 1; o < 64; o <<= 1) v += __shfl_xor(v, o);
    return v;
}
__device__ __forceinline__ float sigmoidf_fast(float x) { return __builtin_amdgcn_rcpf(1.0f + __builtin_amdgcn_exp2f(-1.4426950408889634f * x)); }
template <int CTRL> __device__ __forceinline__ float dpp_f(float x) { return __builtin_bit_cast(float, __builtin_amdgcn_update_dpp(0, __builtin_bit_cast(int, x), CTRL, 0xF, 0xF, true)); }
__device__ __forceinline__ float sum8(float x) { x += dpp_f<0xB1>(x); x += dpp_f<0x4E>(x); x += dpp_f<0x141>(x); return x; }
__device__ __forceinline__ float sum16(float x) { x = sum8(x); x += dpp_f<0x140>(x); return x; }
__device__ __forceinline__ float max16(float x) { x = fmaxf(x, dpp_f<0xB1>(x)); x = fmaxf(x, dpp_f<0x4E>(x)); x = fmaxf(x, dpp_f<0x141>(x)); x = fmaxf(x, dpp_f<0x140>(x)); return x; }

typedef short v4i16g __attribute__((__vector_size__(8)));
__device__ __forceinline__ s16x4 tr_read16(LAS unsigned char* p) { v4i16g r = __builtin_amdgcn_ds_read_tr16_b64_v4i16((LAS v4i16g*)p); return __builtin_bit_cast(s16x4, r); }
__device__ __forceinline__ f32x4 bf4_to_f32(u32x2 w) { return (f32x4){bf_lo(w.x), bf_hi(w.x), bf_lo(w.y), bf_hi(w.y)}; }
__device__ __forceinline__ u32x2 f32_to_bf4(f32x4 v) { return (u32x2){pk_bf16(v.x, v.y), pk_bf16(v.z, v.w)}; }
__device__ __forceinline__ bf16x8 frag_lo4(f32x4 v) { const u32x4 w = {pk_bf16(v.x, v.y), pk_bf16(v.z, v.w), 0u, 0u}; return __builtin_bit_cast(bf16x8, w); }
__device__ __forceinline__ bf16x8 frag_cat(u32x2 a, u32x2 b) { const u32x4 w = {a.x, a.y, b.x, b.y}; return __builtin_bit_cast(bf16x8, w); }
#define MFMA16(a, b, c) __builtin_amdgcn_mfma_f32_16x16x32_bf16((a), (b), (c), 0, 0, 0)

__device__ __forceinline__ int tid_of(int wv) { int l; asm volatile("v_mbcnt_lo_u32_b32 %0, -1, 0\n\tv_mbcnt_hi_u32_b32 %0, -1, %0" : "=v"(l)); return (wv << 6) | l; }
namespace pg8 {
#define PG8_LAS __attribute__((address_space(3)))
constexpr int BM = 256, BK = 64, HALF = 128, HTB = HALF * BK * 2, STAGE_BYTES = 8 * HTB, NXCD = 8, WGM = 8;
__host__ __device__ __forceinline__ int lds_byte(int r, int c) { const int st = (r >> 4) * 2 + (c >> 5), rr = r & 15, cc = c & 31, ob = rr * 64 + cc * 2; return st * 1024 + (ob ^ (((ob >> 9) & 1) << 5)); }
__host__ __device__ __forceinline__ void stage_rc(int b, int& R, int& C) { const int st = b / 1024, sb = b % 1024, swz = sb ^ (((sb >> 9) & 1) << 5); R = (st >> 1) * 16 + swz / 64; C = (st & 1) * 32 + (swz % 64) / 2; }
__host__ __device__ __forceinline__ int perm32(int rho) { const int n = rho >> 4, i = rho & 15; return 8 * (i >> 2) + 4 * n + (i & 3); }

struct Unit { int pm, pn, gid; };
struct Gemm { const bf16_t* A; const bf16_t* Bt; int M, N, K; int sw, sx; };

struct StaticOrder {
    int nM, nN, nwg, G, c;
    __device__ void init(int M, int N, int G_, int c_) { nM = M / BM; nN = N / BM; nwg = nM * nN; G = G_; c = c_; }
    __device__ bool next(int i, Unit& u) const {
        const long L = (long)i * G + c; if (L >= nwg) return false;
        int wgid = (int)L; { const int q = nwg / NXCD, r = nwg % NXCD, xcd = wgid % NXCD, off = wgid / NXCD; wgid = (xcd < r ? xcd * (q + 1) : r * (q + 1) + (xcd - r) * q) + off; }
        const int nig = WGM * nN, gid = wgid / nig, fm = gid * WGM, gsz = (nM - fm) < WGM ? (nM - fm) : WGM;
        u.pm = fm + ((wgid % nig) % gsz); u.pn = (wgid % nig) / gsz; u.gid = 0; return true;
    }
    __device__ __forceinline__ const char* aptr(const Gemm& g, const Unit& u, size_t tstep) const { return (const char*)g.A + (size_t)u.pm * tstep; }
    __device__ __forceinline__ const char* bptr(const Gemm& g, const Unit& u, size_t tstep) const { return (const char*)g.Bt + (size_t)u.pn * tstep; }
};
struct TripleOrder {
    StaticOrder S0; const bf16_t* A1; const bf16_t* B1; const bf16_t* A2; const bf16_t* B2; int n1, n2, G, c;
    __device__ bool next(int i, Unit& u) const {
        const long L = (long)i * G + c;
        if (L < n1) { u.pm = (int)L; u.pn = 0; u.gid = 1; return true; }
        if (L < n1 + n2) { u.pm = 0; u.pn = (int)(L - n1); u.gid = 2; return true; }
        const long L0 = L - n1 - n2; if (L0 >= S0.nwg) return false;
        StaticOrder T0 = S0; T0.c = (int)(L0 % G); return T0.next((int)(L0 / G), u);
    }
    __device__ __forceinline__ const char* aptr(const Gemm& g, const Unit& u, size_t tstep) const { return (const char*)(u.gid == 0 ? g.A : (u.gid == 1 ? A1 : A2)) + (size_t)u.pm * tstep; }
    __device__ __forceinline__ const char* bptr(const Gemm& g, const Unit& u, size_t tstep) const { return (const char*)(u.gid == 0 ? g.Bt : (u.gid == 1 ? B1 : B2)) + (size_t)u.pn * tstep; }
};
struct ExpertOrder {
    int nMe, nNe, per, total, G, c;
    __device__ void init(int nMe_, int nNe_, int nExp, int G_, int c_) { nMe = nMe_; nNe = nNe_; per = nMe * nNe; total = per * nExp; G = G_; c = c_; }
    __device__ bool next(int i, Unit& u) const {
        const long L = (long)i * G + c; if (L >= total) return false;
        const int e = (int)(L / per), w = (int)(L % per), xl = w % 8, j = w / 8, rpx = nMe / 8;
        u.pm = e * nMe + xl * rpx + (j % rpx); u.pn = e * nNe + j / rpx; u.gid = 0; return true;
    }
    __device__ __forceinline__ const char* aptr(const Gemm& g, const Unit& u, size_t tstep) const { return (const char*)g.A + (size_t)u.pm * tstep; }
    __device__ __forceinline__ const char* bptr(const Gemm& g, const Unit& u, size_t tstep) const { return (const char*)g.Bt + (size_t)u.pn * tstep; }
};

struct EpiBf16 {
    static constexpr bool PERM = true;
    bf16_t* O; int ldc; bf16_t* Q0;
    __device__ __forceinline__ void operator()(const f32x4 (&acc)[2][2][4][2], const Unit& u, int wr, int wc, int fr, int fq) const {
        const bool redir = (Q0 != nullptr) && (u.pn == 0);
        bf16_t* base = redir ? Q0 : O; const int ld = redir ? 256 : ldc;
        const int row0 = u.pm * BM + wr * 64 + fr, col0 = (u.pn - ((Q0 != nullptr && !redir) ? 1 : 0)) * BM + wc * 32 + 8 * fq;
#pragma unroll
        for (int ai = 0; ai < 2; ++ai)
#pragma unroll
            for (int m = 0; m < 4; ++m) { bf16_t* rowp = base + (size_t)(row0 + ai * HALF + m * 16) * ld + col0;
#pragma unroll
                for (int bj = 0; bj < 2; ++bj) { const f32x4 v0 = acc[ai][bj][m][0], v1 = acc[ai][bj][m][1];
                    u32x4 w; w.x = pk_bf16(v0[0], v0[1]); w.y = pk_bf16(v0[2], v0[3]); w.z = pk_bf16(v1[0], v1[1]); w.w = pk_bf16(v1[2], v1[3]);
                    *(u32x4*)(rowp + bj * HALF) = w; } }
    }
};
struct EpiBf16x3 {
    static constexpr bool PERM = true;
    EpiBf16 E0, E1, E2;
    __device__ __forceinline__ void operator()(const f32x4 (&acc)[2][2][4][2], const Unit& u, int wr, int wc, int fr, int fq) const {
        if (u.gid == 0) E0(acc, u, wr, wc, fr, fq); else if (u.gid == 1) E1(acc, u, wr, wc, fr, fq); else E2(acc, u, wr, wc, fr, fq); }
};
struct EpiResidSS {
    static constexpr bool PERM = false;
    const float* X; bf16_t* X1; float* ss;
    __device__ __forceinline__ void operator()(const f32x4 (&acc)[2][2][4][2], const Unit& u, int wr, int wc, int fr, int fq) const {
        const int row0 = u.pm * BM + wr * 64 + fr, col0 = u.pn * BM + wc * 32 + 4 * fq;
#pragma unroll
        for (int ai = 0; ai < 2; ++ai)
#pragma unroll
            for (int m = 0; m < 4; ++m) { const int row = row0 + ai * HALF + m * 16; const size_t off = (size_t)row * D + col0; float s = 0.f;
#pragma unroll
                for (int bj = 0; bj < 2; ++bj)
#pragma unroll
                    for (int n = 0; n < 2; ++n) { const f32x4 xv = *(const f32x4*)(X + off + bj * HALF + n * 16); const f32x4 o = xv + acc[ai][bj][m][n];
                        *(u32x2*)(X1 + off + bj * HALF + n * 16) = f32_to_bf4(o); s += (o[0] * o[0] + o[1] * o[1]) + (o[2] * o[2] + o[3] * o[3]); }
                s += __shfl_xor(s, 16); s += __shfl_xor(s, 32);
                if (fq == 0) (void)__hip_atomic_fetch_add(ss + row, s, __ATOMIC_RELAXED, __HIP_MEMORY_SCOPE_AGENT); }
    }
};
struct EpiSwiGLU {
    static constexpr bool PERM = true;
    bf16_t* H;
    __device__ __forceinline__ void operator()(const f32x4 (&acc)[2][2][4][2], const Unit& u, int wr, int wc, int fr, int fq) const {
        const int row0 = u.pm * BM + wr * 64 + fr, col0 = (u.pn & 7) * HALF + wc * 32 + 8 * fq;
#pragma unroll
        for (int ai = 0; ai < 2; ++ai)
#pragma unroll
            for (int m = 0; m < 4; ++m) { const int row = row0 + ai * HALF + m * 16; float h[8];
                unsigned char* rowp = (unsigned char*)H + ((((size_t)(row >> 8) * (FF / 128) + (col0 >> 7)) << 15) + ((row & 255) << 7) + (col0 & 127));
#pragma unroll
                for (int n = 0; n < 2; ++n)
#pragma unroll
                    for (int j = 0; j < 4; ++j) { const float gt = acc[ai][0][m][n][j], up = acc[ai][1][m][n][j]; h[n * 4 + j] = 8.0f * gt * sigmoidf_fast(gt) * up; }
                *(u32x2*)rowp = (u32x2){pk_fp8x4(h[0], h[1], h[2], h[3]), pk_fp8x4(h[4], h[5], h[6], h[7])}; }
    }
};
struct EpiGateScale {
    static constexpr bool PERM = true;
    bf16_t* Y; const float* gate;
    __device__ __forceinline__ void operator()(const f32x4 (&acc)[2][2][4][2], const Unit& u, int wr, int wc, int fr, int fq) const {
        const int row0 = u.pm * BM + wr * 64 + fr, col0 = (u.pn & 3) * BM + wc * 32 + 8 * fq;
#pragma unroll
        for (int ai = 0; ai < 2; ++ai)
#pragma unroll
            for (int m = 0; m < 4; ++m) { const int row = row0 + ai * HALF + m * 16; const float gs = gate[row]; bf16_t* rowp = Y + (size_t)row * D + col0;
#pragma unroll
                for (int bj = 0; bj < 2; ++bj) { const f32x4 v0 = acc[ai][bj][m][0] * gs, v1 = acc[ai][bj][m][1] * gs;
                    u32x4 w; w.x = pk_bf16(v0[0], v0[1]); w.y = pk_bf16(v0[2], v0[3]); w.z = pk_bf16(v1[0], v1[1]); w.w = pk_bf16(v1[2], v1[3]);
                    *(u32x4*)(rowp + bj * HALF) = w; } }
    }
};

template <class Epi, class Sched, bool GATHER, bool ATILED = false, bool FP8 = false>
__device__ __forceinline__ void gemm_phase(PG8_LAS unsigned char* lds, const Gemm g, const Sched& S, const Epi& E, const int* rowtok, const int wv) {
    int tid = tid_of(wv); asm volatile("" : "+v"(tid));
    const int wid = __builtin_amdgcn_readfirstlane(tid >> 6), lane = tid & 63, wr = wid >> 2, wc = wid & 3, fr = lane & 15, fq = lane >> 4;
    const int K = g.K, nt = K / BK;
    unsigned voffA0, voffB0;
    { int R, C; stage_rc(tid * 16, R, C); const int Rb = Epi::PERM ? ((R & ~31) + perm32(R & 31)) : R;
      voffA0 = ATILED ? (unsigned)(R * BK + C) * 2u : (unsigned)(R * K + C) * 2u; voffB0 = (unsigned)(Rb * K + C) * 2u; }
    const size_t dA = ATILED ? (size_t)64 * BK * 2 : (size_t)64 * K * 2, dB = (size_t)64 * K * 2;
    unsigned vAc[2][2], vAn[2][2];
    const size_t kstep = (size_t)(BK * 2);
    const size_t hstep = (size_t)HALF * K * 2;
    const size_t tstep = 2 * hstep;
    const size_t kstepA = ATILED ? (size_t)BM * BK * 2 : kstep, hstepA = ATILED ? (size_t)HALF * BK * 2 : hstep;
    const unsigned ldsw = (unsigned)wid * 1024u;
    const unsigned ldsbase = __builtin_amdgcn_readfirstlane((unsigned)(size_t)lds) + ldsw;
    const int aoff = lds_byte(wr * 64 + fr, fq * 8), boff = lds_byte(wc * 32 + fr, fq * 8);
#define PG8_SA(b, h) (((b) * 2 + (h)) * HTB)
#define PG8_SB(b, h) ((4 + (b) * 2 + (h)) * HTB)
#define PG8_GLDS(vo_, sb_, lo_) asm volatile("s_add_u32 m0, %2, %3\n\ts_nop 0\n\tglobal_load_lds_dwordx4 %0, %1" :: "v"(vo_), "s"((const void*)(sb_)), "s"(ldsbase), "n"(lo_) : "m0", "scc", "memory")
#define PG8_STAGE_D(bufoff, gbase, voff0, delta) do { PG8_GLDS(voff0, gbase, (bufoff)); PG8_GLDS(voff0, (const char*)(gbase) + (delta), (bufoff) + 8192); } while (0)
#define PG8_STAGE(bufoff, gbase, voff) do { PG8_GLDS((voff)[0], gbase, (bufoff)); PG8_GLDS((voff)[1], gbase, (bufoff) + 8192); } while (0)
#define PG8_STAGE_A(bufoff, hh, dbase, kbytes, vsel) do { if constexpr (GATHER) { PG8_STAGE(bufoff, (const char*)g.A + (kbytes), (vsel)[hh]); } else { PG8_STAGE_D(bufoff, (dbase) + ((hh) ? hstepA : 0), voffA0, dA); } } while (0)
#define PG8_GATHER_OFF(dst, un) do { int R_, C_; stage_rc(tid * 16, R_, C_); _Pragma("unroll") for (int _h = 0; _h < 2; ++_h) _Pragma("unroll") for (int _i = 0; _i < 2; ++_i) \
        (dst)[_h][_i] = (unsigned)rowtok[(un).pm * BM + _h * HALF + R_ + 64 * _i] * (unsigned)(K * 2) + (unsigned)(C_ * 2); } while (0)
#define PG8_LDA(dst, b, h) do { _Pragma("unroll") for (int m = 0; m < 4; ++m) _Pragma("unroll") for (int k = 0; k < 2; ++k) dst[m][k] = *(const PG8_LAS bf16x8*)(lds + PG8_SA(b, h) + aoff + m * 2048 + k * 1024); } while (0)
#define PG8_LDB(dst, b, h) do { _Pragma("unroll") for (int n = 0; n < 2; ++n) _Pragma("unroll") for (int k = 0; k < 2; ++k) dst[n][k] = *(const PG8_LAS bf16x8*)(lds + PG8_SB(b, h) + boff + n * 2048 + k * 1024); } while (0)
#define PG8_MMA(ai, bj, At, Bt) do { __builtin_amdgcn_s_setprio(1); _Pragma("unroll") for (int m = 0; m < 4; ++m) _Pragma("unroll") for (int n = 0; n < 2; ++n) _Pragma("unroll") for (int k = 0; k < 2; ++k) \
        acc[ai][bj][m][n] = __builtin_amdgcn_mfma_f32_16x16x32_bf16(Bt[n][k], At[m][k], acc[ai][bj][m][n], 0, 0, 0); __builtin_amdgcn_s_setprio(0); } while (0)
#define PG8_CAT8(lo_, hi_) __builtin_shufflevector(lo_, hi_, 0, 1, 2, 3, 4, 5, 6, 7)
#define PG8_LDA8(b, h) do { _Pragma("unroll") for (int m = 0; m < 4; ++m) { const v4i lo_ = *(const PG8_LAS v4i*)(lds + PG8_SA(b, h) + aoff + m * 2048), hi_ = *(const PG8_LAS v4i*)(lds + PG8_SA(b, h) + aoff + m * 2048 + 1024); A8[m] = PG8_CAT8(lo_, hi_); } } while (0)
#define PG8_LDB8(dst, b, h) do { _Pragma("unroll") for (int n = 0; n < 2; ++n) { const v4i lo_ = *(const PG8_LAS v4i*)(lds + PG8_SB(b, h) + boff + n * 2048), hi_ = *(const PG8_LAS v4i*)(lds + PG8_SB(b, h) + boff + n * 2048 + 1024); dst[n] = PG8_CAT8(lo_, hi_); } } while (0)
#define PG8_MMA8(ai, bj, Bt8) do { __builtin_amdgcn_s_setprio(1); _Pragma("unroll") for (int m = 0; m < 4; ++m) _Pragma("unroll") for (int n = 0; n < 2; ++n) \
        acc[ai][bj][m][n] = __builtin_amdgcn_mfma_scale_f32_16x16x128_f8f6f4(Bt8[n], A8[m], acc[ai][bj][m][n], 0, 0, 0, g.sw, 0, g.sx); __builtin_amdgcn_s_setprio(0); } while (0)
#define PG8_LDAX(b, h) do { if constexpr (FP8) { PG8_LDA8(b, h); } else { PG8_LDA(At, b, h); } } while (0)
#define PG8_LDBX(w, b, h) do { if constexpr (FP8) { if (w) { PG8_LDB8(B81, b, h); } else { PG8_LDB8(B80, b, h); } } else { if (w) { PG8_LDB(B1, b, h); } else { PG8_LDB(B0, b, h); } } } while (0)
#define PG8_MMX(ai, bj, w) do { if constexpr (FP8) { if (w) { PG8_MMA8(ai, bj, B81); } else { PG8_MMA8(ai, bj, B80); } } else { if (w) { PG8_MMA(ai, bj, At, B1); } else { PG8_MMA(ai, bj, At, B0); } } } while (0)
#define PG8_WAIT_V(n) asm volatile("s_waitcnt vmcnt(" #n ")" ::: "memory")
#define PG8_WAIT_L(n) asm volatile("s_waitcnt lgkmcnt(" #n ")" ::: "memory")
#define PG8_BAR __builtin_amdgcn_s_barrier()
#define PG8_SCHED __builtin_amdgcn_sched_barrier(0)
    Unit cur, nxt; int ui = 0;
    if (!S.next(0, cur)) return;
    f32x4 acc[2][2][4][2];
#pragma unroll
    for (int a = 0; a < 2; ++a)
#pragma unroll
        for (int b = 0; b < 2; ++b)
#pragma unroll
            for (int m = 0; m < 4; ++m)
#pragma unroll
                for (int n = 0; n < 2; ++n) acc[a][b][m][n] = (f32x4){0.f, 0.f, 0.f, 0.f};
    bf16x8 At[4][2], B0[2][2], B1[2][2]; v8i A8[4], B80[2], B81[2];
    const char* cA = GATHER ? (const char*)g.A : S.aptr(g, cur, tstep); const char* cB = S.bptr(g, cur, tstep);
    if constexpr (GATHER) { PG8_GATHER_OFF(vAc, cur); }
    PG8_STAGE_D(PG8_SB(0, 0), cB, voffB0, dB); PG8_STAGE_A(PG8_SA(0, 0), 0, cA, 0, vAc); PG8_STAGE_D(PG8_SB(0, 1), cB + hstep, voffB0, dB); PG8_STAGE_A(PG8_SA(0, 1), 1, cA, 0, vAc);
    if (wr == 1) PG8_BAR;
    PG8_WAIT_V(4); PG8_BAR;
    PG8_STAGE_D(PG8_SB(1, 0), cB + kstep, voffB0, dB); PG8_STAGE_A(PG8_SA(1, 0), 0, cA + kstepA, kstep, vAc); PG8_STAGE_D(PG8_SB(1, 1), cB + hstep + kstep, voffB0, dB);
    PG8_WAIT_V(6); PG8_BAR;
    for (;;) {
        const bool has_next = S.next(ui + 1, nxt);
        const char* nA = (has_next && !GATHER) ? S.aptr(g, nxt, tstep) : cA; const char* nB = has_next ? S.bptr(g, nxt, tstep) : cB;
        if constexpr (GATHER) { if (has_next) { PG8_GATHER_OFF(vAn, nxt); } else {
#pragma unroll
            for (int _h = 0; _h < 2; ++_h)
#pragma unroll
                for (int _i = 0; _i < 2; ++_i) vAn[_h][_i] = vAc[_h][_i]; } }
#pragma unroll 1
        for (int t = 0; t < nt; t += 2) {
            const bool last = (t == nt - 2);
            const size_t k1 = (size_t)(t + 1) * kstep, k2 = last ? 0 : (size_t)(t + 2) * kstep, k3 = k2 + kstep;
            const char* a1 = cA + (size_t)(t + 1) * kstepA;
            const char* a2 = last ? nA : cA + (size_t)(t + 2) * kstepA; const char* b2 = last ? nB : cB + (size_t)(t + 2) * kstep;
            const char* a3 = a2 + kstepA; const char* b3 = b2 + kstep;
            PG8_LDBX(0, 0, 0); PG8_SCHED; PG8_LDAX(0, 0); PG8_STAGE_A(PG8_SA(1, 1), 1, a1, k1, vAc);
            if constexpr (GATHER) { if (last) {
#pragma unroll
                for (int _h = 0; _h < 2; ++_h)
#pragma unroll
                    for (int _i = 0; _i < 2; ++_i) vAc[_h][_i] = vAn[_h][_i]; } }
            PG8_WAIT_L(8); PG8_BAR; PG8_WAIT_L(0); PG8_MMX(0, 0, 0); PG8_BAR; PG8_SCHED;
            PG8_LDBX(1, 0, 1); PG8_STAGE_D(PG8_SB(0, 0), b2, voffB0, dB);
            PG8_BAR; PG8_WAIT_L(0); PG8_MMX(0, 1, 1); PG8_BAR;
            PG8_LDAX(0, 1); PG8_STAGE_A(PG8_SA(0, 0), 0, a2, k2, vAc);
            PG8_BAR; PG8_WAIT_L(0); PG8_MMX(1, 0, 0); PG8_BAR; PG8_SCHED;
            PG8_STAGE_D(PG8_SB(0, 1), b2 + hstep, voffB0, dB);
            PG8_WAIT_V(6); PG8_BAR; PG8_MMX(1, 1, 1); PG8_BAR;
            PG8_LDBX(0, 1, 0); PG8_SCHED; PG8_LDAX(1, 0); PG8_STAGE_A(PG8_SA(0, 1), 1, a2, k2, vAc);
            PG8_WAIT_L(8); PG8_BAR; PG8_WAIT_L(0); PG8_MMX(0, 0, 0); PG8_BAR; PG8_SCHED;
            PG8_LDBX(1, 1, 1); PG8_STAGE_D(PG8_SB(1, 0), b3, voffB0, dB);
            PG8_BAR; PG8_WAIT_L(0); PG8_MMX(0, 1, 1); PG8_BAR;
            PG8_LDAX(1, 1); PG8_STAGE_A(PG8_SA(1, 0), 0, a3, k3, vAc);
            PG8_BAR; PG8_WAIT_L(0); PG8_MMX(1, 0, 0); PG8_BAR; PG8_SCHED;
            PG8_STAGE_D(PG8_SB(1, 1), b3 + hstep, voffB0, dB);
            PG8_WAIT_V(6); PG8_BAR; PG8_MMX(1, 1, 1); PG8_BAR;
        }
        E(acc, cur, wr, wc, fr, fq);
        if (!has_next) break;
#pragma unroll
        for (int a = 0; a < 2; ++a)
#pragma unroll
            for (int b = 0; b < 2; ++b)
#pragma unroll
                for (int m = 0; m < 4; ++m)
#pragma unroll
                    for (int n = 0; n < 2; ++n) acc[a][b][m][n] = (f32x4){0.f, 0.f, 0.f, 0.f};
        cur = nxt; cA = nA; cB = nB; ++ui;
        if constexpr (GATHER) {
#pragma unroll
            for (int _h = 0; _h < 2; ++_h)
#pragma unroll
                for (int _i = 0; _i < 2; ++_i) vAc[_h][_i] = vAn[_h][_i]; }
    }
    PG8_WAIT_V(0);
    if (wr == 0) PG8_BAR;
    PG8_BAR;
#undef PG8_SA
#undef PG8_SB
#undef PG8_STAGE
#undef PG8_STAGE_D
#undef PG8_GLDS
#undef PG8_STAGE_A
#undef PG8_GATHER_OFF
#undef PG8_LDA
#undef PG8_LDB
#undef PG8_MMA
#undef PG8_MMA8
#undef PG8_LDA8
#undef PG8_LDB8
#undef PG8_LDAX
#undef PG8_LDBX
#undef PG8_MMX
#undef PG8_CAT8
#undef PG8_WAIT_V
#undef PG8_WAIT_L
#undef PG8_BAR
#undef PG8_SCHED
}
}

struct Args {
    const float* in[29];
    float* out; unsigned char* ws;
    int ph_lo, ph_hi;
    int wv, zero_;
};
enum { I_X = 0, I_MEM, I_NMIXG, I_NMEMG, I_WIN, I_WMK, I_WMV, I_CONVW, I_CONVB, I_CLNG, I_CLNB, I_SHIFTMU, I_DW0, I_DUP, I_IA0, I_IUP, I_GUP, I_KK, I_KA, I_RK,
       I_LNXG, I_LNXB, I_WOUT, I_NFFNG, I_WROUTER, I_WEG, I_WEU, I_WED, I_FNG };

template <bool F8 = false>
__device__ __forceinline__ void transpose_item(const float* W, int N, bf16_t* WT, int K, int k0, int n0, int drow0, LAS float* scr, int lane) {
    {
        f32x4 v[8];
#pragma unroll
        for (int i = 0; i < 8; ++i) v[i] = *(const f32x4*)(W + (size_t)(k0 + 8 * i + (lane >> 3)) * N + n0 + 4 * (lane & 7));
#pragma unroll
        for (int i = 0; i < 8; ++i) { LAS float* d = scr + (8 * i + (lane >> 3)) * 33 + 4 * (lane & 7); d[0] = v[i].x; d[1] = v[i].y; d[2] = v[i].z; d[3] = v[i].w; }
    }
    asm volatile("s_waitcnt lgkmcnt(0)" ::: "memory");
    const int c = lane & 7;
#pragma unroll
    for (int j = 0; j < 4; ++j) { const int n = (lane >> 3) + 8 * j; const LAS float* s = scr + (8 * c) * 33 + n;
        if constexpr (F8) { *(u32x2*)((unsigned char*)WT + (size_t)(drow0 + n) * K + k0 + 8 * c) = (u32x2){pk_fp8x4(32.f * s[0 * 33], 32.f * s[1 * 33], 32.f * s[2 * 33], 32.f * s[3 * 33]), pk_fp8x4(32.f * s[4 * 33], 32.f * s[5 * 33], 32.f * s[6 * 33], 32.f * s[7 * 33])}; }
        else { u32x4 o; o.x = pk_bf16(s[0 * 33], s[1 * 33]); o.y = pk_bf16(s[2 * 33], s[3 * 33]); o.z = pk_bf16(s[4 * 33], s[5 * 33]); o.w = pk_bf16(s[6 * 33], s[7 * 33]);
            *(u32x4*)(WT + (size_t)(drow0 + n) * K + k0 + 8 * c) = o; } }
    asm volatile("s_waitcnt lgkmcnt(0)" ::: "memory");
}
__device__ __forceinline__ void expert_prep_items(const Args& a, LAS unsigned char* lds, int widx, int nw, int it_lo, int it_hi) {
    int tid = tid_of(a.wv); asm volatile("" : "+v"(tid)); const int lane = tid & 63, wave = __builtin_amdgcn_readfirstlane(tid >> 6);
    LAS float* scr = (LAS float*)(lds + wave * 16384);
    unsigned char* ws = a.ws;
    constexpr int S_EXP = 16 * 16 * 32;
    for (int r = it_lo + widx; r < it_hi; r += nw) {
        const int which = r / S_EXP, q = r % S_EXP, e = q / 512, kb = (q % 512) / 32, nb = q % 32, n0 = nb * 32;
        if (which == 0) transpose_item<true>(a.in[I_WEG] + (size_t)e * D * FF, FF, (bf16_t*)(ws + WS_WGUT + (size_t)e * 2048 * D), D, kb * 64, n0, (n0 >> 7) * 256 + (n0 & 127), scr, lane);
        else if (which == 1) transpose_item<true>(a.in[I_WEU] + (size_t)e * D * FF, FF, (bf16_t*)(ws + WS_WGUT + (size_t)e * 2048 * D), D, kb * 64, n0, (n0 >> 7) * 256 + 128 + (n0 & 127), scr, lane);
        else transpose_item<true>(a.in[I_WED] + (size_t)e * FF * D, D, (bf16_t*)(ws + WS_WDT + (size_t)e * D * FF), FF, kb * 64, n0, n0, scr, lane);
    }
}

__device__ __forceinline__ void rms_row_to_bf16(const float* xrow, const float* g, bf16_t* orow, int lane) {
    const f32x4* xr = (const f32x4*)xrow + lane; const f32x4* gr = (const f32x4*)g + lane;
    f32x4 v[4]; float s = 0.f;
#pragma unroll
    for (int j = 0; j < 4; ++j) { v[j] = xr[64 * j]; s += (v[j].x * v[j].x + v[j].y * v[j].y) + (v[j].z * v[j].z + v[j].w * v[j].w); }
    const float rs = 1.0f / sqrtf(wave_sum(s) * (1.f / D) + 1e-6f);
    u32x2* o8 = (u32x2*)orow + lane;
#pragma unroll
    for (int j = 0; j < 4; ++j) { const f32x4 gg = gr[64 * j]; u32x2 w; w.x = pk_bf16(v[j].x * rs * gg.x, v[j].y * rs * gg.y); w.y = pk_bf16(v[j].z * rs * gg.z, v[j].w * rs * gg.w); o8[64 * j] = w; }
}
__device__ __forceinline__ void phase_prep(const Args& a, LAS unsigned char* lds, int G) {
    int tid = tid_of(a.wv); asm volatile("" : "+v"(tid)); const int lane = tid & 63, wave = __builtin_amdgcn_readfirstlane(tid >> 6);
    LAS float* scr = (LAS float*)(lds + wave * 16384);
    const int gw = blockIdx.x * 8 + wave, NGW = G * 8;
    unsigned char* ws = a.ws;
    constexpr int S_WIN = 16 * 80, S_WOUT = 16 * 32, S_MK = 16 * 8, S_SM = 12, S_GUP = 24;
    constexpr int NITEMS = S_WIN + S_WOUT + 2 * S_MK + 4 * S_SM + S_GUP;
    for (int it = gw; it < NITEMS; it += NGW) {
        int r = it;
        if (r < S_WIN) { const int kb = r / 80, nb = r % 80; transpose_item(a.in[I_WIN], IN_PROJ, (bf16_t*)(ws + WS_WINT), D, kb * 64, nb * 32, nb * 32, scr, lane); continue; } r -= S_WIN;
        if (r < S_WOUT) { const int kb = r / 32, nb = r % 32; transpose_item(a.in[I_WOUT], D, (bf16_t*)(ws + WS_WOUTT), D, kb * 64, nb * 32, nb * 32, scr, lane); continue; } r -= S_WOUT;
        if (r < S_MK) { const int kb = r / 8, nb = r % 8; transpose_item(a.in[I_WMK], 256, (bf16_t*)(ws + WS_WKT), D, kb * 64, nb * 32, nb * 32, scr, lane); continue; } r -= S_MK;
        if (r < S_MK) { const int kb = r / 8, nb = r % 8; transpose_item(a.in[I_WMV], 256, (bf16_t*)(ws + WS_WVT), D, kb * 64, nb * 32, nb * 32, scr, lane); continue; } r -= S_MK;
        if (r < 4 * S_SM) { const int which = r / S_SM, nb = r % S_SM;
            const float* src = (which < 2 ? a.in[I_DUP] : a.in[I_IUP]) + (size_t)(which & 1) * 64 * RW;
            transpose_item(src, RW, (bf16_t*)(ws + WS_SMALL) + (size_t)which * RW * 64, 64, 0, nb * 32, nb * 32, scr, lane); continue; } r -= 4 * S_SM;
        { const int kb = r / 12, nb = r % 12; transpose_item(a.in[I_GUP], RW, (bf16_t*)(ws + WS_SMALL) + (size_t)4 * RW * 64, 128, kb * 64, nb * 32, nb * 32, scr, lane); }
    }
    for (int m = gw; m < T; m += NGW) rms_row_to_bf16(a.in[I_X] + (size_t)m * D, a.in[I_NMIXG], (bf16_t*)(ws + WS_XH) + (size_t)m * D, lane);
    for (int m = gw; m < BATCH * NMEM; m += NGW) rms_row_to_bf16(a.in[I_MEM] + (size_t)m * D, a.in[I_NMEMG], (bf16_t*)(ws + WS_MEMN) + (size_t)m * D, lane);
}

constexpr int AT_KS = 144;
constexpr int AT_VS = 520;
constexpr int AT_VOFF = 256 * AT_KS;
__device__ __forceinline__ bf16x8 pack_step(const f32x16& x, int s) {
    u32x4 p;
    asm volatile("v_cvt_pk_bf16_f32 %0, %4, %5\n\tv_cvt_pk_bf16_f32 %1, %6, %7\n\tv_cvt_pk_bf16_f32 %2, %8, %9\n\tv_cvt_pk_bf16_f32 %3, %10, %11\n\ts_nop 1"
                 : "=&v"(p[0]), "=&v"(p[1]), "=&v"(p[2]), "=&v"(p[3])
                 : "v"(x[8 * s]), "v"(x[8 * s + 1]), "v"(x[8 * s + 2]), "v"(x[8 * s + 3]), "v"(x[8 * s + 4]), "v"(x[8 * s + 5]), "v"(x[8 * s + 6]), "v"(x[8 * s + 7]));
    return __builtin_bit_cast(bf16x8, p);
}
__device__ __forceinline__ void attn_unit(const Args& a, LAS unsigned char* lds, int unit) {
    int tid = tid_of(a.wv); asm volatile("" : "+v"(tid)); const int lane = tid & 63, wave = __builtin_amdgcn_readfirstlane(tid >> 6), r = lane & 31, h = lane >> 5;
    const int b = unit >> 2, hh = unit & 3;
    const bf16_t* Qb = (const bf16_t*)(a.ws + WS_Q); const bf16_t* KM = (const bf16_t*)(a.ws + WS_KMEM); const bf16_t* VT = (const bf16_t*)(a.ws + WS_VT);
    bf16_t* MIX = (bf16_t*)(a.ws + WS_MIX);
    __syncthreads();
#pragma unroll
    for (int i = 0; i < 4; ++i) { const int c = tid + 512 * i, key = c >> 3, ch = c & 7;
        const u32x4 v = *(const u32x4*)(KM + (size_t)(b * NMEM + key) * 256 + hh * 64 + ch * 8);
        *(LAS u32x4*)(lds + key * AT_KS + ch * 16) = v; }
#pragma unroll
    for (int i = 0; i < 4; ++i) { const int c = tid + 512 * i, d = c >> 5, ch = c & 31;
        const u32x4 v = *(const u32x4*)(VT + (size_t)(hh * 64 + d) * (BATCH * NMEM) + b * NMEM + ch * 8);
        LAS u32x2* dst = (LAS u32x2*)(lds + AT_VOFF + d * AT_VS + ch * 16);
        dst[0] = (u32x2){v.x, v.y}; dst[1] = (u32x2){v.z, v.w}; }
    __syncthreads();
#pragma unroll 1
    for (int tile = 0; tile < 16; ++tile) {
    const int tok0 = b * SEQ + tile * 256 + wave * 32;
    bf16x8 qf[4];
#pragma unroll
    for (int ks = 0; ks < 4; ++ks) qf[ks] = *(const bf16x8*)(Qb + (size_t)(tok0 + r) * 256 + hh * 64 + ks * 16 + h * 8);
    const float sc = 0.125f * 1.4426950408889634f;
    float m_run = -3.0e38f, sum = 0.f;
    f32x16 o[2];
#pragma unroll
    for (int dt = 0; dt < 2; ++dt)
#pragma unroll
        for (int i = 0; i < 16; ++i) o[dt][i] = 0.f;
#pragma unroll 1
    for (int kh = 0; kh < 2; ++kh) {
        f32x16 s[4];
#pragma unroll
        for (int k4 = 0; k4 < 4; ++k4) {
#pragma unroll
            for (int i = 0; i < 16; ++i) s[k4][i] = 0.f;
#pragma unroll
            for (int ks = 0; ks < 4; ++ks) { const bf16x8 ka = *(const LAS bf16x8*)(lds + ((kh * 4 + k4) * 32 + r) * AT_KS + (ks * 16 + h * 8) * 2);
                s[k4] = __builtin_amdgcn_mfma_f32_32x32x16_bf16(ka, qf[ks], s[k4], 0, 0, 0); }
        }
        float mx = m_run;
#pragma unroll
        for (int k4 = 0; k4 < 4; ++k4)
#pragma unroll
            for (int i = 0; i < 16; ++i) mx = fmaxf(mx, s[k4][i]);
        mx = fmaxf(mx, __shfl_xor(mx, 32));
        const float alpha = __builtin_amdgcn_exp2f((m_run - mx) * sc);
        float ps = 0.f;
#pragma unroll
        for (int k4 = 0; k4 < 4; ++k4)
#pragma unroll
            for (int i = 0; i < 16; ++i) { const float e = __builtin_amdgcn_exp2f((s[k4][i] - mx) * sc); s[k4][i] = e; ps += e; }
        ps += __shfl_xor(ps, 32);
        sum = sum * alpha + ps; m_run = mx;
#pragma unroll
        for (int dt = 0; dt < 2; ++dt)
#pragma unroll
            for (int i = 0; i < 16; ++i) o[dt][i] *= alpha;
#pragma unroll
        for (int k4 = 0; k4 < 4; ++k4)
#pragma unroll
            for (int s2 = 0; s2 < 2; ++s2) {
                const bf16x8 pb = pack_step(s[k4], s2);
#pragma unroll
                for (int dt = 0; dt < 2; ++dt) {
                    const LAS unsigned char* vp = lds + AT_VOFF + (32 * dt + r) * AT_VS + (32 * (kh * 4 + k4) + 16 * s2 + 4 * h) * 2;
                    const s16x4 lo = *(const LAS s16x4*)vp, hi = *(const LAS s16x4*)(vp + 16);
                    const bf16x8 va = __builtin_shufflevector(lo, hi, 0, 1, 2, 3, 4, 5, 6, 7);
                    o[dt] = __builtin_amdgcn_mfma_f32_32x32x16_bf16(va, pb, o[dt], 0, 0, 0);
                }
            }
    }
    const float inv = 1.0f / sum;
    bf16_t* orow = MIX + (size_t)(tok0 + r) * D + hh * 64;
#pragma unroll
    for (int dt = 0; dt < 2; ++dt)
#pragma unroll
        for (int gq = 0; gq < 4; ++gq) { u32x2 w; w.x = pk_bf16(o[dt][4 * gq] * inv, o[dt][4 * gq + 1] * inv); w.y = pk_bf16(o[dt][4 * gq + 2] * inv, o[dt][4 * gq + 3] * inv);
            *(u32x2*)(orow + 32 * dt + 8 * gq + 4 * h) = w; }
    }
}

constexpr int CV_U = 0, CV_C = 94 * 384 * 2, CV_W = CV_C + 64 * 384 * 2, CV_PRM = CV_W + 31 * 384 * 2;
static_assert(CV_PRM + 3 * 384 * 4 <= LDS_BYTES - 512, "conv LDS map");
__device__ __forceinline__ void conv_stream(const Args& a, LAS unsigned char* lds, int u0, int G) {
    int tid = tid_of(a.wv); asm volatile("" : "+v"(tid)); const int lane = tid & 63, wave = __builtin_amdgcn_readfirstlane(tid >> 6);
    if (u0 >= 1024) return;
    const bf16_t* P = (const bf16_t*)(a.ws + WS_P); bf16_t* MIX = (bf16_t*)(a.ws + WS_MIX);
    LAS _Float16* U = (LAS _Float16*)(lds + CV_U);
    LAS _Float16* Cc = (LAS _Float16*)(lds + CV_C);
    LAS _Float16* W16 = (LAS _Float16*)(lds + CV_W); LAS float* PRM = (LAS float*)(lds + CV_PRM);
    __syncthreads();
    for (int i = tid; i < 31 * CW; i += NTHREADS) W16[i] = (_Float16)a.in[I_CONVW][i];
    for (int i = tid; i < 3 * CW; i += NTHREADS) PRM[i] = (i < CW) ? a.in[I_CONVB][i] : (i < 2 * CW) ? a.in[I_CLNG][i - CW] : a.in[I_CLNB][i - 2 * CW];
    u32x4 vvv[9], ggg[9];
#define CONV_LOAD(un_) do { const int b_ = (un_) >> 6, t0_ = ((un_) & 63) * 64; \
        _Pragma("unroll") for (int u9 = 0; u9 < 9; ++u9) { const int q = tid + u9 * NTHREADS, j = q / 48, cc = (q % 48) * 8, sq = t0_ - 15 + j; const bool ok = (q < 94 * 48) && sq >= 0 && sq < SEQ; \
            const bf16_t* row = P + (size_t)(b_ * SEQ + (ok ? sq : 0)) * PLD + cc; \
            vvv[u9] = ok ? *(const u32x4*)row : (u32x4){0u, 0u, 0u, 0u}; ggg[u9] = ok ? *(const u32x4*)(row + CW) : (u32x4){0u, 0u, 0u, 0u}; } } while (0)
    CONV_LOAD(u0);
#pragma unroll 1
    for (int unit = u0; unit < 1024; unit += G) {
        const int b = unit >> 6, t0 = (unit & 63) * 64;
        __syncthreads();
#pragma unroll
        for (int u9 = 0; u9 < 9; ++u9) { const int q = tid + u9 * NTHREADS, j = q / 48, cc = (q % 48) * 8;
            if (q < 94 * 48) {
                const unsigned vw[4] = {vvv[u9].x, vvv[u9].y, vvv[u9].z, vvv[u9].w}, gw[4] = {ggg[u9].x, ggg[u9].y, ggg[u9].z, ggg[u9].w};
                float u[8];
#pragma unroll
                for (int k = 0; k < 4; ++k) { u[2 * k] = bf_lo(vw[k]) * sigmoidf_fast(bf_lo(gw[k])); u[2 * k + 1] = bf_hi(vw[k]) * sigmoidf_fast(bf_hi(gw[k])); }
                LAS f16x4* dst = (LAS f16x4*)(U + j * CW + cc); dst[0] = (f16x4){(_Float16)u[0], (_Float16)u[1], (_Float16)u[2], (_Float16)u[3]}; dst[1] = (f16x4){(_Float16)u[4], (_Float16)u[5], (_Float16)u[6], (_Float16)u[7]}; }
        }
        if (unit + G < 1024) CONV_LOAD(unit + G);
        __syncthreads();
        const int cq = tid & 127, tq = tid >> 7;
#pragma unroll 1
        for (int k3 = 0; k3 < 3; ++k3) { const int c = cq + 128 * k3;
            float w[31], res[16];
#pragma unroll
            for (int kk = 0; kk < 31; ++kk) w[kk] = (float)W16[kk * CW + c];
            const float bias = PRM[c];
#pragma unroll
            for (int tt = 0; tt < 16; ++tt) res[tt] = bias;
#pragma unroll
            for (int jj = 0; jj < 46; ++jj) { const float uv = (float)U[(tq * 16 + jj) * CW + c];
#pragma unroll
                for (int tt = 0; tt < 16; ++tt) { if (jj - tt >= 0 && jj - tt <= 30) res[tt] += uv * w[jj - tt]; } }
#pragma unroll
            for (int tt = 0; tt < 16; ++tt) Cc[(tq * 16 + tt) * CW + c] = (_Float16)res[tt];
        }
        __syncthreads();
        for (int tt = 0; tt < 8; ++tt) { const int t = wave * 8 + tt;
            float v[6]; float sm = 0.f;
#pragma unroll
            for (int i = 0; i < 6; ++i) { v[i] = (float)Cc[t * CW + lane + 64 * i]; sm += v[i]; }
            const float mean = wave_sum(sm) * (1.f / CW); float q = 0.f;
#pragma unroll
            for (int i = 0; i < 6; ++i) { v[i] -= mean; q += v[i] * v[i]; }
            const float rstd = 1.0f / sqrtf(wave_sum(q) * (1.f / CW) + 1e-5f);
            bf16_t* orow = MIX + (size_t)(b * SEQ + t0 + t) * D + 256;
#pragma unroll
            for (int i = 0; i < 6; ++i) { const int c = lane + 64 * i; const float y = v[i] * rstd * PRM[CW + c] + PRM[2 * CW + c]; const float o = y * sigmoidf_fast(y);
                orow[c] = (bf16_t)(pk_bf16(o, 0.f) & 0xffffu); }
        }
    }
#undef CONV_LOAD
}

constexpr int PR_AS = 784;
constexpr int PR_RK = 64 * PR_AS;
constexpr int PR_RKS = 1536;
constexpr int PR_RN = PR_RK + 64 * PR_RKS;
constexpr int PR_CST = PR_RN + 2048;
static_assert(PR_CST + 7 * 384 * 4 <= LDS_BYTES - 64, "prep LDS map");
template <int V> struct IC { static constexpr int value = V; };
template <int CTRL> __device__ __forceinline__ f32x4 dpp4(f32x4 x) { return (f32x4){dpp_f<CTRL>(x.x), dpp_f<CTRL>(x.y), dpp_f<CTRL>(x.z), dpp_f<CTRL>(x.w)}; }
__device__ __forceinline__ void prep_unit(const Args& a, LAS unsigned char* lds, int unit) {
    int tid = tid_of(a.wv); asm volatile("" : "+v"(tid)); const int lane = tid & 63, wave = __builtin_amdgcn_readfirstlane(tid >> 6);
    const int b = unit >> 6, t0 = (unit & 63) * 64;
    const bf16_t* __restrict__ P = (const bf16_t*)(a.ws + WS_P);
    const float* __restrict__ mu = a.in[I_SHIFTMU];
    LAS float* RNs = (LAS float*)(lds + PR_RN); LAS float* CST = (LAS float*)(lds + PR_CST);
    __syncthreads();
    for (int i = tid; i < 7 * 384; i += NTHREADS) { const int w7 = i / 384, c7 = i % 384;
        CST[i] = (w7 == 0) ? a.in[I_KK][c7] : (w7 == 1) ? a.in[I_KA][c7] : (w7 == 2) ? a.in[I_RK][c7] : (w7 < 5) ? a.in[I_DW0][(w7 - 3) * RW + c7] : a.in[I_IA0][(w7 - 5) * RW + c7]; }
#ifndef PREP_REP1
#define PREP_REP1 1
#endif
    struct S1Buf { u32x4 cu[2], pv[2], nv[2]; f32x4 m0a, m0b, m1a, m1b, ka, kb; };
    const int s1row = 8 * wave + (lane >> 4), s1c = lane & 15;
    auto s1_issue = [&](auto sc, S1Buf& B) {
        constexpr int sb = decltype(sc)::value, ty = (sb / 3 == 0) ? 2 : (sb / 3 == 1) ? 0 : (sb / 3 == 2) ? 1 : 3, cg = sb % 3;
        const int c8 = ty * 384 + (cg * 16 + s1c) * 8;
#pragma unroll
        for (int th = 0; th < 2; ++th) { const int sq = t0 + s1row + 4 * th;
            const bf16_t* row = P + ((size_t)b * SEQ + sq) * PLD + 768 + c8;
            B.cu[th] = *(const u32x4*)row;
            B.pv[th] = (sq > 0) ? *(const u32x4*)(row - PLD) : (u32x4){0u, 0u, 0u, 0u};
            B.nv[th] = (sq < SEQ - 1) ? *(const u32x4*)(row + PLD) : (u32x4){0u, 0u, 0u, 0u}; }
        B.m0a = *(const f32x4*)(mu + c8); B.m0b = *(const f32x4*)(mu + c8 + 4); B.m1a = *(const f32x4*)(mu + 1536 + c8); B.m1b = *(const f32x4*)(mu + 1536 + c8 + 4);
        if (ty == 1) { B.ka = *(const f32x4*)(a.in[I_KK] + c8 - 384); B.kb = *(const f32x4*)(a.in[I_KK] + c8 - 384 + 4); }
    };
    auto s1_compute = [&](auto sc, const S1Buf& B) {
        constexpr int sb = decltype(sc)::value, ty = (sb / 3 == 0) ? 2 : (sb / 3 == 1) ? 0 : (sb / 3 == 2) ? 1 : 3, cg = sb % 3;
        const int c8 = ty * 384 + (cg * 16 + s1c) * 8;
        const float m0[8] = {B.m0a.x, B.m0a.y, B.m0a.z, B.m0a.w, B.m0b.x, B.m0b.y, B.m0b.z, B.m0b.w}, m1[8] = {B.m1a.x, B.m1a.y, B.m1a.z, B.m1a.w, B.m1b.x, B.m1b.y, B.m1b.z, B.m1b.w};
#pragma unroll
        for (int th = 0; th < 2; ++th) { const int tt = s1row + 4 * th; const size_t tok = (size_t)b * SEQ + t0 + tt;
            const u32x4 cu = B.cu[th], pv = B.pv[th], nv = B.nv[th];
            const unsigned cw[4] = {cu.x, cu.y, cu.z, cu.w}, pw[4] = {pv.x, pv.y, pv.z, pv.w}, nw[4] = {nv.x, nv.y, nv.z, nv.w};
            float pf[8];
#pragma unroll
            for (int k = 0; k < 4; ++k) { const float c0 = bf_lo(cw[k]), c1 = bf_hi(cw[k]);
                pf[2 * k] = c0 + m0[2 * k] * (bf_lo(pw[k]) - c0) + m1[2 * k] * (bf_lo(nw[k]) - c0);
                pf[2 * k + 1] = c1 + m0[2 * k + 1] * (bf_hi(pw[k]) - c1) + m1[2 * k + 1] * (bf_hi(nw[k]) - c1); }
            if (ty < 2) {
                f16x4 h0 = {(_Float16)pf[0], (_Float16)pf[1], (_Float16)pf[2], (_Float16)pf[3]}, h1 = {(_Float16)pf[4], (_Float16)pf[5], (_Float16)pf[6], (_Float16)pf[7]};
                LAS f16x4* dst = (LAS f16x4*)(lds + PR_RK + tt * PR_RKS + c8 * 2); dst[0] = h0; dst[1] = h1;
                if (ty == 1) { const f32x4 ka = B.ka, kb = B.kb;
                    float ssq = (pf[0] * ka.x) * (pf[0] * ka.x) + (pf[1] * ka.y) * (pf[1] * ka.y) + (pf[2] * ka.z) * (pf[2] * ka.z) + (pf[3] * ka.w) * (pf[3] * ka.w)
                              + (pf[4] * kb.x) * (pf[4] * kb.x) + (pf[5] * kb.y) * (pf[5] * kb.y) + (pf[6] * kb.z) * (pf[6] * kb.z) + (pf[7] * kb.w) * (pf[7] * kb.w);
                    ssq = sum8(ssq);
                    if ((lane & 7) == 0) RNs[tt * 8 + ((c8 - 384) >> 6)] = __builtin_amdgcn_rsqf(ssq + 1e-12f); }
            } else if (ty == 2) {
                u32x4 w; w.x = pk_bf16(pf[0], pf[1]); w.y = pk_bf16(pf[2], pf[3]); w.z = pk_bf16(pf[4], pf[5]); w.w = pk_bf16(pf[6], pf[7]);
                *(u32x4*)((bf16_t*)scan_arr(a.ws, 0) + hat_off(0, tok, c8 - 768)) = w;
            } else {
                const int cc = c8 - 1152;
#pragma unroll
                for (int k = 0; k < 8; ++k) { if (cg == 0) pf[k] = 1.0f - 2.0f * __builtin_amdgcn_rcpf(1.0f + __builtin_amdgcn_exp2f(2.8853900817779268f * pf[k])); else if (cg == 2) pf[k] = sigmoidf_fast(pf[k]); }
                u32x4 w; w.x = pk_bf16(pf[0], pf[1]); w.y = pk_bf16(pf[2], pf[3]); w.z = pk_bf16(pf[4], pf[5]); w.w = pk_bf16(pf[6], pf[7]);
                *(LAS u32x4*)(lds + tt * PR_AS + cc * 2) = w; }
        }
    };
#pragma unroll 1
    for (int rp1 = 0; rp1 < PREP_REP1; ++rp1) {
        S1Buf B0, B1, B2;
        s1_issue(IC<0>{}, B0); s1_issue(IC<1>{}, B1);
        s1_issue(IC<2>{}, B2); s1_compute(IC<0>{}, B0);
        s1_issue(IC<3>{}, B0); s1_compute(IC<1>{}, B1);
        s1_issue(IC<4>{}, B1); s1_compute(IC<2>{}, B2);
        s1_issue(IC<5>{}, B2); s1_compute(IC<3>{}, B0);
        s1_issue(IC<6>{}, B0); s1_compute(IC<4>{}, B1);
        s1_issue(IC<7>{}, B1); s1_compute(IC<5>{}, B2);
        s1_issue(IC<8>{}, B2); s1_compute(IC<6>{}, B0);
        s1_issue(IC<9>{}, B0); s1_compute(IC<7>{}, B1);
        s1_issue(IC<10>{}, B1); s1_compute(IC<8>{}, B2);
        s1_issue(IC<11>{}, B2); s1_compute(IC<9>{}, B0);
        s1_compute(IC<10>{}, B1); s1_compute(IC<11>{}, B2);
    }
    __syncthreads();
    const int l15 = lane & 15, kq = lane >> 4;
    float* __restrict__ PCg = (float*)(a.ws + WS_PC); float* __restrict__ BON = (float*)(a.ws + WS_BON);
    const char* SMb = (const char*)(a.ws + WS_SMALL);
    const unsigned wlo64 = (unsigned)(((8 * (l15 >> 2) + (l15 & 3)) * 64 + kq * 8) * 2), wlo128 = (unsigned)(((8 * (l15 >> 2) + (l15 & 3)) * 128 + kq * 8) * 2);
    const unsigned hlo = (unsigned)((l15 * 64 + 8 * kq) * 2), klo = (unsigned)((l15 * D + 8 * kq) * 2), glo = (unsigned)((l15 * RW + 8 * kq) * 2);
    bf16x8 Fc[16], Fn[16];
#define PREP_LOADW(hd_, kind_) do { \
        if ((kind_) < 2) { const char* w_ = SMb + ((size_t)(kind_) * RW * 64 + (size_t)(hd_) * 64 * 64) * 2; \
            _Pragma("unroll") for (int f_ = 0; f_ < 16; ++f_) Fn[f_] = *(const bf16x8*)(w_ + (size_t)(((f_ >> 2) & 1) * (2 * RW * 64 * 2) + (32 * ((f_ & 3) >> 1) + 4 * (f_ & 1)) * 128 + (f_ >> 3) * 64) + wlo64); } \
        else { const char* w_ = SMb + ((size_t)4 * RW * 64 + (size_t)(hd_) * 64 * 128) * 2; \
            _Pragma("unroll") for (int f_ = 0; f_ < 16; ++f_) Fn[f_] = *(const bf16x8*)(w_ + (size_t)((32 * ((f_ & 3) >> 1) + 4 * (f_ & 1)) * 256 + (f_ >> 2) * 64) + wlo128); } } while (0)
    auto dir_stage = [&](auto dc, const int it, const int nhd, const int nkind) {
        constexpr int d = decltype(dc)::value;
        const int hd = it >> 2, mt = it & 3, tokl = mt * 16 + l15; const size_t tb = (size_t)b * SEQ + t0 + mt * 16;
#pragma unroll
        for (int f = 0; f < 16; ++f) Fc[f] = Fn[f];
        f32x4 accW[4], accA[4];
#pragma unroll
        for (int nt = 0; nt < 4; ++nt) { accW[nt] = (f32x4){0.f, 0.f, 0.f, 0.f}; accA[nt] = (f32x4){0.f, 0.f, 0.f, 0.f}; }
#pragma unroll
        for (int ks = 0; ks < 2; ++ks) {
            const bf16x8 aw = *(const LAS bf16x8*)(lds + tokl * PR_AS + (d * 64 + ks * 32 + kq * 8) * 2), aa = *(const LAS bf16x8*)(lds + tokl * PR_AS + ((2 + d) * 64 + ks * 32 + kq * 8) * 2);
#pragma unroll
            for (int nt = 0; nt < 4; ++nt) { accW[nt] = MFMA16(Fc[ks * 8 + nt], aw, accW[nt]); accA[nt] = MFMA16(Fc[ks * 8 + 4 + nt], aa, accA[nt]); }
        }
        if (nkind >= 0) PREP_LOADW(nhd, nkind);
        const float rn = RNs[tokl * 8 + hd];
        const size_t tile_b = ((((tb >> 4) * NH + hd) << 10)) * 2;
        char* AHb = (char*)scan_arr(a.ws, 1 + 4 * d) + tile_b; char* RHb = (char*)scan_arr(a.ws, 2 + 4 * d) + tile_b; char* BHb = (char*)scan_arr(a.ws, 3 + 4 * d) + tile_b;
        char* KHb = d ? (char*)scan_arr(a.ws, 8) + (tb * D + hd * 64) * 2 : (char*)scan_arr(a.ws, 4) + tile_b; const unsigned khlo = d ? klo : hlo;
        char* PCb = (char*)(PCg + ((size_t)d * (T / 16) + (tb >> 4)) * RW + hd * 64); char* BOb = (char*)(BON + (size_t)d * T * NH + tb * NH + hd);
        float bsum = 0.f; const float first1 = (l15 == (d ? 15 : 0)) ? 1.f : 0.f;
        u32x2 hA[2], hR[2], hB[2], hK[2]; f32x4 PtS[4];
#pragma unroll
        for (int nt = 0; nt < 4; ++nt) { const int ch = hd * 64 + 32 * (nt >> 1) + 8 * kq + 4 * (nt & 1);
            const f32x4 bW = *(const LAS f32x4*)(CST + (3 + d) * 384 + ch), bA = *(const LAS f32x4*)(CST + (5 + d) * 384 + ch);
            const f32x4 kkw = *(const LAS f32x4*)(CST + ch), kaw = *(const LAS f32x4*)(CST + 384 + ch), rkw = *(const LAS f32x4*)(CST + 768 + ch);
            const f32x4 zw = accW[nt] + bW, za = accA[nt] + bA;
            f32x4 lw, av;
#pragma unroll
            for (int e = 0; e < 4; ++e) { lw[e] = -0.606531f * 1.4426950408889634f * sigmoidf_fast(zw[e]); av[e] = sigmoidf_fast(za[e]); }
            f32x4 cum = lw;
#define PREP_CUM4(SH) "v_add_f32_dpp %0, %0, %0 " SH " row_mask:0xf bank_mask:0xf bound_ctrl:1\n\tv_add_f32_dpp %1, %1, %1 " SH " row_mask:0xf bank_mask:0xf bound_ctrl:1\n\t" \
                      "v_add_f32_dpp %2, %2, %2 " SH " row_mask:0xf bank_mask:0xf bound_ctrl:1\n\tv_add_f32_dpp %3, %3, %3 " SH " row_mask:0xf bank_mask:0xf bound_ctrl:1\n\t"
            if (d == 0) asm volatile("s_nop 1\n\t" PREP_CUM4("row_shr:1") PREP_CUM4("row_shr:2") PREP_CUM4("row_shr:4") PREP_CUM4("row_shr:8") : "+v"(cum.x), "+v"(cum.y), "+v"(cum.z), "+v"(cum.w));
            else        asm volatile("s_nop 1\n\t" PREP_CUM4("row_shl:1") PREP_CUM4("row_shl:2") PREP_CUM4("row_shl:4") PREP_CUM4("row_shl:8") : "+v"(cum.x), "+v"(cum.y), "+v"(cum.z), "+v"(cum.w));
#undef PREP_CUM4
            f32x4 Pt, Pinv, Pprev;
#pragma unroll
            for (int e = 0; e < 4; ++e) { Pt[e] = __builtin_amdgcn_exp2f(cum[e]); Pinv[e] = __builtin_amdgcn_rcpf(Pt[e]);
                Pprev[e] = dpp_f<d ? 0x101 : 0x111>(Pt[e]) + first1; }
            PtS[nt] = Pt;
            const f32x4 r4 = __builtin_convertvector(*(const LAS f16x4*)(lds + PR_RK + tokl * PR_RKS + ch * 2), f32x4);
            const f32x4 k4 = __builtin_convertvector(*(const LAS f16x4*)(lds + PR_RK + tokl * PR_RKS + (384 + ch) * 2), f32x4);
            const f32x4 kk = k4 * kkw * rn, kd = k4 * (1.0f + (av - 1.0f) * kaw);
            hA[nt & 1] = f32_to_bf4(-kk * Pprev); hR[nt & 1] = f32_to_bf4(r4 * Pt); hB[nt & 1] = f32_to_bf4(kk * av * Pinv); hK[nt & 1] = f32_to_bf4(kd * Pinv);
            const f32x4 bt = r4 * kd * rkw; bsum += (bt.x + bt.y) + (bt.z + bt.w);
            if (nt & 1) { const int pr = nt >> 1;
                *(u32x4*)(AHb + (hlo + 64 * pr)) = (u32x4){hA[0].x, hA[0].y, hA[1].x, hA[1].y}; *(u32x4*)(RHb + (hlo + 64 * pr)) = (u32x4){hR[0].x, hR[0].y, hR[1].x, hR[1].y};
                *(u32x4*)(BHb + (hlo + 64 * pr)) = (u32x4){hB[0].x, hB[0].y, hB[1].x, hB[1].y}; *(u32x4*)(KHb + (khlo + 64 * pr)) = (u32x4){hK[0].x, hK[0].y, hK[1].x, hK[1].y}; }
        }
        if (l15 == (d ? 0 : 15)) {
#pragma unroll
            for (int nt = 0; nt < 4; ++nt) *(f32x4*)(PCb + (unsigned)(8 * kq * 4) + (32 * (nt >> 1) + 4 * (nt & 1)) * 4) = PtS[nt]; }
        bsum += __shfl_xor(bsum, 16); bsum += __shfl_xor(bsum, 32);
        if (kq == 0) *(float*)(BOb + (unsigned)(l15 * NH * 4)) = bsum;
    };
    auto gate_stage = [&](const int it, const int nhd, const int nkind) {
        const int hd = it >> 2, mt = it & 3, tokl = mt * 16 + l15; const size_t tb = (size_t)b * SEQ + t0 + mt * 16;
#pragma unroll
        for (int f = 0; f < 16; ++f) Fc[f] = Fn[f];
        f32x4 acc[4];
#pragma unroll
        for (int nt = 0; nt < 4; ++nt) acc[nt] = (f32x4){0.f, 0.f, 0.f, 0.f};
#pragma unroll
        for (int ks = 0; ks < 4; ++ks) { const bf16x8 afr = *(const LAS bf16x8*)(lds + tokl * PR_AS + (256 + ks * 32 + kq * 8) * 2);
#pragma unroll
            for (int nt = 0; nt < 4; ++nt) acc[nt] = MFMA16(Fc[ks * 4 + nt], afr, acc[nt]); }
        if (nkind >= 0) PREP_LOADW(nhd, nkind);
        char* Gb = (char*)((bf16_t*)(a.ws + WS_G) + tb * RW + hd * 64);
#pragma unroll
        for (int pr = 0; pr < 2; ++pr) { const u32x2 g0 = f32_to_bf4(acc[2 * pr]), g1 = f32_to_bf4(acc[2 * pr + 1]);
            *(u32x4*)(Gb + (glo + 64 * pr)) = (u32x4){g0.x, g0.y, g1.x, g1.y}; }
    };
    PREP_LOADW(wave >> 2, 0);
#pragma unroll 1
    for (int k3 = 0; k3 < 3; ++k3) { const int it = wave + 8 * k3, hd = it >> 2;
        dir_stage(IC<0>{}, it, hd, 1);
        dir_stage(IC<1>{}, it, hd, 2);
        gate_stage(it, (it + 8) >> 2, k3 < 2 ? 0 : -1);
    }
#undef PREP_LOADW
}

__device__ __forceinline__ void glds16_asm(const void* gptr, LAS unsigned char* ldst) {
    const unsigned la = __builtin_amdgcn_readfirstlane((unsigned)(size_t)ldst);
    asm volatile("s_mov_b32 m0, %1\n\ts_nop 0\n\tglobal_load_lds_dwordx4 %0, off" :: "v"(gptr), "s"(la) : "m0", "memory");
}
constexpr int CK = 16, NCHUNK = SEQ / CK, CS_NS = 8, CS_NPROD = 6, CS_NCONS = 2;
constexpr int SL_ATIL = 0, SL_RTIL = 2048, SL_BH = 4096, SL_KH = 6144, SL_V = 8192, SL_ULOC = 10240, SL_YLOC = 12288, SL_PC = 14336, SL_BYTES = 14592;
constexpr int PS_AH = 0, PS_RH = 2048, PS_BYTES = 4096;
constexpr int CS_PS_OFF = CS_NS * SL_BYTES, CS_FLAG_OFF = CS_PS_OFF + CS_NPROD * PS_BYTES;
static_assert(CS_FLAG_OFF + 64 <= LDS_BYTES - 64, "chunked scan LDS map");
__device__ __forceinline__ int swz(int t, int j) { return t * 128 + ((((j >> 3) ^ (t & 7))) << 4) + ((j & 4) << 1); }
__device__ __forceinline__ void scan_chunked_unit(const Args& a, LAS unsigned char* lds, int unit) {
    int tid = tid_of(a.wv); asm volatile("" : "+v"(tid)); const int lane = tid & 63, wave = __builtin_amdgcn_readfirstlane(tid >> 6);
    const int dir = unit & 1, bh = unit >> 1, b = bh / NH, hd = bh % NH;
    const int c16 = lane & 15, q = lane >> 4, qp = c16 >> 2, pp = c16 & 3;
    volatile LAS unsigned* FULL = (volatile LAS unsigned*)(lds + CS_FLAG_OFF);
    volatile LAS unsigned* DONE = FULL + 8;
    float* Yg = (float*)(a.ws + (dir ? WS_YB : WS_YF));
    __syncthreads();
    if (tid < 16) FULL[tid] = 0u;
    __syncthreads();
    if (wave >= CS_NCONS) {
        const int pw = wave - CS_NCONS;
        LAS unsigned char* ps = lds + CS_PS_OFF + pw * PS_BYTES;
        const bf16_t* ARR[5] = {(const bf16_t*)scan_arr(a.ws, 1 + 4 * dir), (const bf16_t*)scan_arr(a.ws, 2 + 4 * dir), (const bf16_t*)scan_arr(a.ws, 3 + 4 * dir), (const bf16_t*)scan_arr(a.ws, 4 + 4 * dir), (const bf16_t*)scan_arr(a.ws, 0)};
        const int AIDX[5] = {1 + 4 * dir, 2 + 4 * dir, 3 + 4 * dir, 4 + 4 * dir, 0};
        const float* PCg = (const float*)(a.ws + WS_PC) + (size_t)dir * (T / 16) * RW + hd * 64 + lane;
        u32x4 pf[10];
#define CS_ISSUE(cc) do { _Pragma("unroll") for (int ar_ = 0; ar_ < 5; ++ar_) _Pragma("unroll") for (int hf_ = 0; hf_ < 2; ++hf_) { \
            const int row_ = hf_ * 8 + (lane >> 3); const int st_ = (cc) * CK + row_; const int t_ = dir ? (SEQ - 1 - st_) : st_; \
            pf[ar_ * 2 + hf_] = *(const u32x4*)(ARR[ar_] + hat_off(AIDX[ar_], (size_t)b * SEQ + t_, hd * 64 + 8 * ((lane & 7) ^ (row_ & 7)))); } } while (0)
#define CS_PCLOAD(cc) PCg[(size_t)((size_t)b * (SEQ / CK) + (dir ? (NCHUNK - 1 - (cc)) : (cc))) * RW]
        CS_ISSUE(pw);
        float pcn = CS_PCLOAD(pw);
#pragma unroll 1
        for (int c = pw; c < NCHUNK; c += CS_NPROD) {
            const int slot = c % CS_NS; LAS unsigned char* sl = lds + slot * SL_BYTES;
            { unsigned sp = 0; const unsigned want = (unsigned)CS_NCONS * (unsigned)(c / CS_NS); while (DONE[slot] < want) { __builtin_amdgcn_s_sleep(1); if (++sp > (1u << 22)) break; } }
            asm volatile("" ::: "memory");
            *(LAS u32x4*)(ps + PS_AH + lane * 16) = pf[0]; *(LAS u32x4*)(ps + PS_AH + 1024 + lane * 16) = pf[1];
            *(LAS u32x4*)(ps + PS_RH + lane * 16) = pf[2]; *(LAS u32x4*)(ps + PS_RH + 1024 + lane * 16) = pf[3];
            *(LAS u32x4*)(sl + SL_BH + lane * 16) = pf[4]; *(LAS u32x4*)(sl + SL_BH + 1024 + lane * 16) = pf[5];
            *(LAS u32x4*)(sl + SL_KH + lane * 16) = pf[6]; *(LAS u32x4*)(sl + SL_KH + 1024 + lane * 16) = pf[7];
            *(LAS u32x4*)(sl + SL_V + lane * 16) = pf[8]; *(LAS u32x4*)(sl + SL_V + 1024 + lane * 16) = pf[9];
            *(LAS float*)(sl + SL_PC + lane * 4) = pcn;
            if (c + CS_NPROD < NCHUNK) { CS_ISSUE(c + CS_NPROD); pcn = CS_PCLOAD(c + CS_NPROD); }
            asm volatile("s_waitcnt lgkmcnt(0)" ::: "memory");
#ifndef PROD_REP
#define PROD_REP 1
#endif
#pragma unroll 1
            for (int rpp = 0; rpp < PROD_REP; ++rpp) {
            bf16x8 AHf[2], BHf[2], KHf[2], RHf[2];
#pragma unroll
            for (int ks = 0; ks < 2; ++ks) { const int o = swz(c16, 32 * ks + 8 * q);
                AHf[ks] = *(const LAS bf16x8*)(ps + PS_AH + o); RHf[ks] = *(const LAS bf16x8*)(ps + PS_RH + o); BHf[ks] = *(const LAS bf16x8*)(sl + SL_BH + o); KHf[ks] = *(const LAS bf16x8*)(sl + SL_KH + o); }
            f32x4 Mab = {0.f, 0.f, 0.f, 0.f}, Mak = Mab, MrbT = Mab, MrkT = Mab, MabT = Mab;
#pragma unroll
            for (int ks = 0; ks < 2; ++ks) { Mab = MFMA16(AHf[ks], BHf[ks], Mab); MabT = MFMA16(BHf[ks], AHf[ks], MabT); Mak = MFMA16(AHf[ks], KHf[ks], Mak); MrbT = MFMA16(BHf[ks], RHf[ks], MrbT); MrkT = MFMA16(KHf[ks], RHf[ks], MrkT); }
#pragma unroll
            for (int r = 0; r < 4; ++r) { const bool lt = c16 < 4 * q + r, gt = 4 * q + r < c16, le = 4 * q + r <= c16;
                Mab[r] = lt ? Mab[r] : 0.f; Mak[r] = lt ? Mak[r] : 0.f; MabT[r] = gt ? MabT[r] : 0.f; MrbT[r] = le ? MrbT[r] : 0.f; MrkT[r] = le ? MrkT[r] : 0.f; }
            const f32x4 z4 = {0.f, 0.f, 0.f, 0.f};
            const bf16x8 fN = frag_lo4(Mab), fNT = frag_lo4(MabT);
            const f32x4 N2 = MFMA16(fNT, fN, z4), N2T = MFMA16(fN, fNT, z4);
            f32x4 PT = MabT;
#pragma unroll
            for (int r = 0; r < 4; ++r) PT[r] += (4 * q + r == c16) ? 1.0f : 0.f;
            const bf16x8 fN2 = frag_lo4(N2), fN2T = frag_lo4(N2T);
            PT = MFMA16(fN2, frag_lo4(PT), PT);
            const f32x4 N4 = MFMA16(fN2T, fN2, z4), N4T = MFMA16(fN2, fN2T, z4);
            const bf16x8 fN4 = frag_lo4(N4), fN4T = frag_lo4(N4T);
            PT = MFMA16(fN4, frag_lo4(PT), PT);
            const f32x4 N8 = MFMA16(fN4T, fN4, z4);
            PT = MFMA16(frag_lo4(N8), frag_lo4(PT), PT);
            const bf16x8 LinvF = frag_lo4(PT);
            const bf16x8 MakF = frag_lo4(Mak), MrbTF = frag_lo4(MrbT);
            const f32x4 W1 = MFMA16(LinvF, MakF, z4);
            const f32x4 W1T = MFMA16(MakF, LinvF, z4);
            const f32x4 W2T = MFMA16(frag_lo4(W1), MrbTF, MrkT);
            f32x4 AtT[4], RtT[4];
#pragma unroll
            for (int jt = 0; jt < 4; ++jt) {
                const bf16x8 ahF = frag_cat(__builtin_bit_cast(u32x2, tr_read16(ps + PS_AH + swz(4 * q + qp, 16 * jt + 4 * pp))), (u32x2){0u, 0u});
                const f32x4 AtN = MFMA16(LinvF, ahF, z4);
                AtT[jt] = MFMA16(ahF, LinvF, z4);
                const f32x4 rinit = bf4_to_f32(*(const LAS u32x2*)(ps + PS_RH + swz(c16, 16 * jt + 4 * q)));
                RtT[jt] = MFMA16(frag_lo4(AtN), MrbTF, rinit);
            }
#pragma unroll
            for (int ks = 0; ks < 2; ++ks) {
                const u32x4 wa = {pk_bf16(AtT[2 * ks][0], AtT[2 * ks][1]), pk_bf16(AtT[2 * ks][2], AtT[2 * ks][3]), pk_bf16(AtT[2 * ks + 1][0], AtT[2 * ks + 1][1]), pk_bf16(AtT[2 * ks + 1][2], AtT[2 * ks + 1][3])};
                const u32x4 wr = {pk_bf16(RtT[2 * ks][0], RtT[2 * ks][1]), pk_bf16(RtT[2 * ks][2], RtT[2 * ks][3]), pk_bf16(RtT[2 * ks + 1][0], RtT[2 * ks + 1][1]), pk_bf16(RtT[2 * ks + 1][2], RtT[2 * ks + 1][3])};
                *(LAS u32x4*)(sl + SL_ATIL + ks * 1024 + lane * 16) = wa; *(LAS u32x4*)(sl + SL_RTIL + ks * 1024 + lane * 16) = wr; }
            *(LAS u32x2*)(sl + SL_ULOC + lane * 8) = f32_to_bf4(W1T); *(LAS u32x2*)(sl + SL_YLOC + lane * 8) = f32_to_bf4(W2T);
            }
            asm volatile("s_waitcnt lgkmcnt(0)" ::: "memory");
            if (lane == 0) FULL[slot] = (unsigned)(c + 1);
        }
#undef CS_ISSUE
#undef CS_PCLOAD
    } else {
        struct ConsOps { bf16x8 at0, at1, rt0, rt1, bk[4]; u32x2 w1w, w2w, vfw[2]; f32x4 pc[4]; };
        f32x4 S[2][4];
#pragma unroll
        for (int ti = 0; ti < 2; ++ti)
#pragma unroll
            for (int mt = 0; mt < 4; ++mt) S[ti][mt] = (f32x4){0.f, 0.f, 0.f, 0.f};
#define CONS_LOAD(X, cc) do { const int slot_ = (cc) % CS_NS; LAS unsigned char* sl_ = lds + slot_ * SL_BYTES; \
            { unsigned sp_ = 0; while (FULL[slot_] < (unsigned)((cc) + 1)) { __builtin_amdgcn_s_sleep(1); if (++sp_ > (1u << 22)) break; } } \
            asm volatile("" ::: "memory"); \
            X.at0 = *(const LAS bf16x8*)(sl_ + SL_ATIL + lane * 16); X.at1 = *(const LAS bf16x8*)(sl_ + SL_ATIL + 1024 + lane * 16); \
            X.rt0 = *(const LAS bf16x8*)(sl_ + SL_RTIL + lane * 16); X.rt1 = *(const LAS bf16x8*)(sl_ + SL_RTIL + 1024 + lane * 16); \
            X.w1w = *(const LAS u32x2*)(sl_ + SL_ULOC + lane * 8); X.w2w = *(const LAS u32x2*)(sl_ + SL_YLOC + lane * 8); \
            _Pragma("unroll") for (int mt_ = 0; mt_ < 4; ++mt_) { X.pc[mt_] = *(const LAS f32x4*)(sl_ + SL_PC + (16 * mt_ + 4 * q) * 4); \
                X.bk[mt_] = frag_cat(__builtin_bit_cast(u32x2, tr_read16(sl_ + SL_BH + swz(4 * q + qp, 16 * mt_ + 4 * pp))), __builtin_bit_cast(u32x2, tr_read16(sl_ + SL_KH + swz(4 * q + qp, 16 * mt_ + 4 * pp)))); } \
            _Pragma("unroll") for (int ti_ = 0; ti_ < 2; ++ti_) X.vfw[ti_] = __builtin_bit_cast(u32x2, tr_read16(sl_ + SL_V + swz(4 * q + qp, 16 * (2 * wave + ti_) + 4 * pp))); } while (0)
#define CONS_COMPUTE(X, cc) do { const f32x4 z4c_ = {0.f, 0.f, 0.f, 0.f}; const bf16x8 w1f_ = frag_cat(X.w1w, (u32x2){0u, 0u}), w2f_ = frag_cat(X.w2w, (u32x2){0u, 0u}); \
            _Pragma("unroll") for (int ti_ = 0; ti_ < 2; ++ti_) { const int nt_ = 2 * wave + ti_; \
                const bf16x8 vB_ = frag_cat(X.vfw[ti_], (u32x2){0u, 0u}); \
                const bf16x8 Sb0_ = frag_cat(f32_to_bf4(S[ti_][0]), f32_to_bf4(S[ti_][1])), Sb1_ = frag_cat(f32_to_bf4(S[ti_][2]), f32_to_bf4(S[ti_][3])); \
                const f32x4 U0_ = MFMA16(X.at0, Sb0_, MFMA16(w1f_, vB_, z4c_)), U1_ = MFMA16(X.at1, Sb1_, z4c_); \
                const f32x4 Y0_ = MFMA16(X.rt0, Sb0_, MFMA16(w2f_, vB_, z4c_)), Y1_ = MFMA16(X.rt1, Sb1_, z4c_); \
                const f32x4 UT_ = U0_ + U1_, YT_ = Y0_ + Y1_; \
                const bf16x8 Ub_ = frag_cat(f32_to_bf4(UT_), X.vfw[ti_]); \
                _Pragma("unroll") for (int mt_ = 0; mt_ < 4; ++mt_) { S[ti_][mt_] = MFMA16(X.bk[mt_], Ub_, S[ti_][mt_]); S[ti_][mt_] = S[ti_][mt_] * X.pc[mt_]; } \
                *(f32x4*)(Yg + ((((size_t)b * NCHUNK + (dir ? (NCHUNK - 1 - (cc)) : (cc))) * NH + hd) * 64 + 16 * nt_ + c16) * 16 + 4 * q) = YT_; } } while (0)
#define CONS_DONE(cc) do { asm volatile("s_waitcnt lgkmcnt(0)" ::: "memory"); if (lane == 0) (void)__hip_atomic_fetch_add((LAS unsigned*)&DONE[(cc) % CS_NS], 1u, __ATOMIC_RELAXED, __HIP_MEMORY_SCOPE_WORKGROUP); } while (0)
        ConsOps OA, OB;
        CONS_LOAD(OA, 0);
#pragma unroll 1
        for (int c = 0; c < NCHUNK; c += 2) {
            CONS_LOAD(OB, c + 1);
            CONS_COMPUTE(OA, c);
            CONS_DONE(c);
            if (c + 2 < NCHUNK) CONS_LOAD(OA, c + 2);
            CONS_COMPUTE(OB, c + 1);
            CONS_DONE(c + 1);
        }
#undef CONS_LOAD
#undef CONS_COMPUTE
#undef CONS_DONE
        unsigned tq0 = 0u, tq1 = 0u, tq2 = 0u, tq3 = 0u, tq4 = 0u, tq5 = 0u, tacc = 0u;
        (void)tq0; (void)tq1; (void)tq2; (void)tq3; (void)tq4; (void)tq5;
        (void)tacc;
    }
}

__device__ __forceinline__ void phase_post(const Args& a, int G) {
    int tid = tid_of(a.wv); asm volatile("" : "+v"(tid)); const int lane = tid & 63, wave = __builtin_amdgcn_readfirstlane(tid >> 6);
    const int gw = blockIdx.x * 8 + wave, NGW = G * 8, t = lane & 15, iq = lane >> 4;
    const float* __restrict__ YF = (const float*)(a.ws + WS_YF); const float* __restrict__ YB = (const float*)(a.ws + WS_YB); const float* __restrict__ BON = (const float*)(a.ws + WS_BON);
    const bf16_t* __restrict__ Vg = (const bf16_t*)scan_arr(a.ws, 0); const bf16_t* __restrict__ Gg = (const bf16_t*)(a.ws + WS_G); bf16_t* __restrict__ MIX = (bf16_t*)(a.ws + WS_MIX);
    float* ss = (float*)(a.ws + WS_SS);
    for (int i = blockIdx.x * NTHREADS + tid; i < T; i += G * NTHREADS) ss[i] = 0.f;
    constexpr int NIT = (T / 16) * NH;
#pragma unroll 1
    for (int it = gw; it < NIT; it += NGW) {
        const int tile = it / NH, hd = it - tile * NH, tok = tile * 16 + t;
        const float* yfp = YF + ((size_t)it * 64 + 16 * iq) * 16 + t; const float* ybp = YB + ((size_t)it * 64 + 16 * iq) * 16 + (15 - t);
        float y[16];
#pragma unroll
        for (int k = 0; k < 16; ++k) y[k] = yfp[k * 16] + ybp[k * 16];
        const u32x4 v0 = *(const u32x4*)(Vg + ((size_t)it * 16 + t) * 64 + 16 * iq), v1 = *(const u32x4*)(Vg + ((size_t)it * 16 + t) * 64 + 16 * iq + 8);
        const u32x4 g0 = *(const u32x4*)(Gg + (size_t)tok * RW + hd * 64 + 16 * iq), g1 = *(const u32x4*)(Gg + (size_t)tok * RW + hd * 64 + 16 * iq + 8);
        const float bon = BON[(size_t)tok * NH + hd] + BON[(size_t)T * NH + (size_t)tok * NH + hd];
        float sm = 0.f;
#pragma unroll
        for (int k = 0; k < 16; ++k) sm += y[k];
        sm += __shfl_xor(sm, 16); sm += __shfl_xor(sm, 32);
        const float mean = sm * (1.f / 64.f); float vs = 0.f;
#pragma unroll
        for (int k = 0; k < 16; ++k) { y[k] -= mean; vs += y[k] * y[k]; }
        vs += __shfl_xor(vs, 16); vs += __shfl_xor(vs, 32);
        const float rstd = 1.0f / sqrtf(vs * (1.f / 64.f) + 64e-5f);
        const unsigned vw[8] = {v0.x, v0.y, v0.z, v0.w, v1.x, v1.y, v1.z, v1.w}, gwd[8] = {g0.x, g0.y, g0.z, g0.w, g1.x, g1.y, g1.z, g1.w};
        unsigned ow[8];
#pragma unroll
        for (int k2 = 0; k2 < 8; ++k2) { const int ch = hd * 64 + 16 * iq + 2 * k2;
            const float o0 = (y[2 * k2] * rstd * a.in[I_LNXG][ch] + a.in[I_LNXB][ch] + bon * bf_lo(vw[k2])) * bf_lo(gwd[k2]);
            const float o1 = (y[2 * k2 + 1] * rstd * a.in[I_LNXG][ch + 1] + a.in[I_LNXB][ch + 1] + bon * bf_hi(vw[k2])) * bf_hi(gwd[k2]);
            ow[k2] = pk_bf16(o0, o1); }
        bf16_t* op = MIX + (size_t)tok * D + 640 + hd * 64 + 16 * iq;
        *(u32x4*)op = (u32x4){ow[0], ow[1], ow[2], ow[3]}; *(u32x4*)(op + 8) = (u32x4){ow[4], ow[5], ow[6], ow[7]};
    }
}

constexpr int RT_WS = 2064;
__device__ __forceinline__ void phase_router(const Args& a, LAS unsigned char* lds, int G) {
    int tid = tid_of(a.wv); asm volatile("" : "+v"(tid)); const int lane = tid & 63, wave = __builtin_amdgcn_readfirstlane(tid >> 6);
    const int gw = blockIdx.x * 8 + wave, NGW = G * 8, l15 = lane & 15, kq = lane >> 4;
    LAS bf16_t* WH = (LAS bf16_t*)lds; LAS bf16_t* WL = (LAS bf16_t*)(lds + 16 * RT_WS);
    for (int i = tid; i < D * NE; i += NTHREADS) { const int k = i >> 4, e = i & 15; const float w = a.in[I_WROUTER][i];
        const unsigned hi = pk_bf16(w, 0.f) & 0xffffu; const float rem = w - bf_lo(hi);
        WH[e * (RT_WS / 2) + k] = (bf16_t)hi; WL[e * (RT_WS / 2) + k] = (bf16_t)(pk_bf16(rem, 0.f) & 0xffffu); }
    __syncthreads();
    const bf16_t* __restrict__ X1 = (const bf16_t*)(a.ws + WS_X1); const float* __restrict__ ss = (const float*)(a.ws + WS_SS); bf16_t* __restrict__ H2 = (bf16_t*)(a.ws + WS_H2);
    float* __restrict__ AFF = (float*)(a.ws + WS_AFF); int* __restrict__ INV = (int*)(a.ws + WS_INV);
    const float* __restrict__ GF = a.in[I_NFFNG];
    for (int grp = gw; grp < T / 16; grp += NGW) {
        const int tok = grp * 16 + l15;
        const float rs = 1.0f / sqrtf(ss[tok] * (1.f / D) + 1e-6f);
        f32x4 acc = {0.f, 0.f, 0.f, 0.f};
        const bf16_t* xrow = X1 + (size_t)tok * D + 8 * kq; unsigned char* hrow8 = (unsigned char*)H2 + (size_t)tok * D + 8 * kq;
#pragma unroll 8
        for (int ks = 0; ks < 32; ++ks) {
            const u32x4 xw = *(const u32x4*)(xrow + 32 * ks); const f32x4 x0 = {bf_lo(xw.x), bf_hi(xw.x), bf_lo(xw.y), bf_hi(xw.y)}, x1v = {bf_lo(xw.z), bf_hi(xw.z), bf_lo(xw.w), bf_hi(xw.w)};
            const f32x4 g0 = *(const f32x4*)(GF + 32 * ks + 8 * kq), g1 = *(const f32x4*)(GF + 32 * ks + 8 * kq + 4);
            const f32x4 h0 = x0 * rs * g0, h1 = x1v * rs * g1;
            u32x4 hi; hi.x = pk_bf16(h0.x, h0.y); hi.y = pk_bf16(h0.z, h0.w); hi.z = pk_bf16(h1.x, h1.y); hi.w = pk_bf16(h1.z, h1.w);
            *(u32x2*)(hrow8 + 32 * ks) = (u32x2){pk_fp8x4(h0.x, h0.y, h0.z, h0.w), pk_fp8x4(h1.x, h1.y, h1.z, h1.w)};
            u32x4 lo; lo.x = pk_bf16(h0.x - bf_lo(hi.x), h0.y - bf_hi(hi.x)); lo.y = pk_bf16(h0.z - bf_lo(hi.y), h0.w - bf_hi(hi.y));
            lo.z = pk_bf16(h1.x - bf_lo(hi.z), h1.y - bf_hi(hi.z)); lo.w = pk_bf16(h1.z - bf_lo(hi.w), h1.w - bf_hi(hi.w));
            const bf16x8 ah = __builtin_bit_cast(bf16x8, hi), al = __builtin_bit_cast(bf16x8, lo);
            const bf16x8 bh = *(const LAS bf16x8*)(lds + l15 * RT_WS + (32 * ks + 8 * kq) * 2), bl = *(const LAS bf16x8*)(lds + 16 * RT_WS + l15 * RT_WS + (32 * ks + 8 * kq) * 2);
            acc = __builtin_amdgcn_mfma_f32_16x16x32_bf16(ah, bh, acc, 0, 0, 0);
            acc = __builtin_amdgcn_mfma_f32_16x16x32_bf16(al, bh, acc, 0, 0, 0);
            acc = __builtin_amdgcn_mfma_f32_16x16x32_bf16(ah, bl, acc, 0, 0, 0);
        }
#pragma unroll
        for (int rg = 0; rg < 4; ++rg) { const float mx = max16(acc[rg]); const float ex = __expf(acc[rg] - mx); const float sm = sum16(ex);
            const int t2 = grp * 16 + 4 * kq + rg, bb = t2 >> 12, sq = t2 & (SEQ - 1);
            AFF[((size_t)(bb * NE + l15)) * SEQ + sq] = ex / sm; }
        *(u32x4*)(INV + (size_t)grp * 256 + 4 * lane) = (u32x4){0xffffffffu, 0xffffffffu, 0xffffffffu, 0xffffffffu};
    }
}

__device__ __forceinline__ void topk_unit(const Args& a, LAS unsigned char* lds, int unit) {
    int tid = tid_of(a.wv); asm volatile("" : "+v"(tid)); const int lane = tid & 63, wave = __builtin_amdgcn_readfirstlane(tid >> 6);
    const int b = unit >> 4, e = unit & 15;
    const float* AFF = (const float*)(a.ws + WS_AFF) + (size_t)unit * SEQ;
    LAS unsigned* KEY = (LAS unsigned*)lds;
    LAS unsigned* HIST = (LAS unsigned*)(lds + 16384);
    LAS unsigned* CTL = (LAS unsigned*)(lds + 16384 + 1024);
    LAS unsigned* WS_ = (LAS unsigned*)(lds + 16384 + 2048);
    __syncthreads();
    unsigned key[8];
    { const u32x4 k0 = *(const u32x4*)(AFF + tid * 8), k1 = *(const u32x4*)(AFF + tid * 8 + 4); key[0] = k0.x; key[1] = k0.y; key[2] = k0.z; key[3] = k0.w; key[4] = k1.x; key[5] = k1.y; key[6] = k1.z; key[7] = k1.w; }
    if (tid == 0) { CTL[0] = 0u; CTL[1] = (unsigned)CAP; }
    unsigned prefix = 0u, mask = 0u;
#pragma unroll 1
    for (int pass = 0; pass < 4; ++pass) {
        const int shift = 24 - 8 * pass;
        if (tid < 256) HIST[tid] = 0u;
        __syncthreads();
#pragma unroll
        for (int i = 0; i < 8; ++i) if ((key[i] & mask) == prefix) (void)__hip_atomic_fetch_add(&HIST[(key[i] >> shift) & 255u], 1u, __ATOMIC_RELAXED, __HIP_MEMORY_SCOPE_WORKGROUP);
        __syncthreads();
        if (wave == 0) {
            const unsigned need = CTL[1];
            unsigned hv[4], tsum = 0u;
#pragma unroll
            for (int i = 0; i < 4; ++i) { hv[i] = HIST[255 - (4 * lane + i)]; tsum += hv[i]; }
            unsigned inc = tsum;
#pragma unroll
            for (int o = 1; o < 64; o <<= 1) { const unsigned v = __shfl_up(inc, o); if (lane >= o) inc += v; }
            unsigned exc = inc - tsum;
            if (exc < need && need <= inc) {
                unsigned run = exc; int di = 0;
#pragma unroll
                for (int i = 0; i < 4; ++i) { if (run < need && need <= run + hv[i]) { di = i; break; } run += hv[i]; }
                const unsigned digit = 255u - (unsigned)(4 * lane + di);
                CTL[0] = prefix | (digit << shift); CTL[1] = need - run;
            }
        }
        __syncthreads();
        prefix = CTL[0]; mask |= (255u << shift);
    }
    const unsigned thr = prefix, need_eq = CTL[1];
    unsigned ngt = 0u, neq = 0u;
#pragma unroll
    for (int i = 0; i < 8; ++i) { ngt += (key[i] > thr) ? 1u : 0u; neq += (key[i] == thr) ? 1u : 0u; }
    unsigned pk = ngt | (neq << 16), inc = pk;
#pragma unroll
    for (int o = 1; o < 64; o <<= 1) { const unsigned v = __shfl_up(inc, o); if (lane >= o) inc += v; }
    if (lane == 63) WS_[wave] = inc;
    __syncthreads();
    unsigned woff = 0u, tot = 0u;
#pragma unroll
    for (int w = 0; w < 8; ++w) { const unsigned v = WS_[w]; if (w < wave) woff += v; tot += v; }
    const unsigned exc = inc - pk + woff;
    unsigned gpos = exc & 0xffffu, epos = exc >> 16; const unsigned totgt = tot & 0xffffu;
    const int sbase = (e * BATCH + b) * CAP;
    int* ROWTOK = (int*)(a.ws + WS_ROWTOK); float* ROWGATE = (float*)(a.ws + WS_ROWGATE); int* INV = (int*)(a.ws + WS_INV);
#pragma unroll
    for (int i = 0; i < 8; ++i) {
        int pos = -1;
        if (key[i] > thr) pos = (int)gpos++;
        else if (key[i] == thr) { if (epos < need_eq) pos = (int)(totgt + epos); epos++; }
        if (pos >= 0) { const int s = tid * 8 + i, tok = b * SEQ + s, slot = sbase + pos;
            ROWTOK[slot] = tok; ROWGATE[slot] = __builtin_bit_cast(float, key[i]); INV[(size_t)tok * NE + e] = slot; }
    }
}

__device__ __forceinline__ void phase_final(const Args& a, int G) {
    int tid = tid_of(a.wv); asm volatile("" : "+v"(tid)); const int lane = tid & 63, wave = __builtin_amdgcn_readfirstlane(tid >> 6);
    const int gw = blockIdx.x * 8 + wave, NGW = G * 8;
    const bf16_t* __restrict__ X1 = (const bf16_t*)(a.ws + WS_X1); const bf16_t* __restrict__ YE = (const bf16_t*)(a.ws + WS_YE); const int* __restrict__ INV = (const int*)(a.ws + WS_INV);
    float* __restrict__ OUT = a.out;
    f32x4 gg[4];
#pragma unroll
    for (int j = 0; j < 4; ++j) gg[j] = *(const f32x4*)(a.in[I_FNG] + 4 * lane + 256 * j);
#define PF_SLOTS(inv_, n_, m_, sl_) do { m_ = __ballot((inv_) >= 0) & 0xffffull; n_ = __builtin_popcountll(m_); unsigned long long mm_ = m_; \
        _Pragma("unroll") for (int k_ = 0; k_ < 4; ++k_) { if (mm_) { const int e_ = __builtin_ctzll(mm_); mm_ &= mm_ - 1; sl_[k_] = __builtin_amdgcn_readlane((inv_), e_); } else sl_[k_] = 0; } m_ = mm_; } while (0)
#define PF_ROWS(rw_, xr_, tk_, n_, sl_) do { \
        _Pragma("unroll") for (int k_ = 0; k_ < 4; ++k_) { if (k_ < (n_)) { _Pragma("unroll") for (int j_ = 0; j_ < 4; ++j_) rw_[k_][j_] = *(const u32x2*)(YE + (size_t)sl_[k_] * D + 4 * lane + 256 * j_); } \
            else { _Pragma("unroll") for (int j_ = 0; j_ < 4; ++j_) rw_[k_][j_] = (u32x2){0u, 0u}; } } \
        _Pragma("unroll") for (int j_ = 0; j_ < 4; ++j_) xr_[j_] = *(const u32x2*)(X1 + (size_t)(tk_) * D + 4 * lane + 256 * j_); } while (0)
    int tok = gw;
    if (tok >= T) return;
    int inv0 = INV[(size_t)tok * NE + (lane & 15)];
    int inv1 = (tok + NGW < T) ? INV[(size_t)(tok + NGW) * NE + (lane & 15)] : -1;
    unsigned long long mc; int nc, slc[4]; u32x2 rwc[4][4], xc[4];
    PF_SLOTS(inv0, nc, mc, slc);
    PF_ROWS(rwc, xc, tok, nc, slc);
    for (; tok < T; tok += NGW) {
        const int t1 = tok + NGW, t2 = tok + 2 * NGW;
        const int inv2 = (t2 < T) ? INV[(size_t)t2 * NE + (lane & 15)] : -1;
        unsigned long long mn = 0ull; int nn = 0, sln[4] = {0, 0, 0, 0}; u32x2 rwn[4][4], xn[4];
        if (t1 < T) { PF_SLOTS(inv1, nn, mn, sln); PF_ROWS(rwn, xn, t1, nn, sln); }
        else {
#pragma unroll
            for (int k = 0; k < 4; ++k)
#pragma unroll
                for (int j = 0; j < 4; ++j) rwn[k][j] = (u32x2){0u, 0u};
#pragma unroll
            for (int j = 0; j < 4; ++j) xn[j] = (u32x2){0u, 0u}; }
        f32x4 v[4];
#pragma unroll
        for (int j = 0; j < 4; ++j) v[j] = (f32x4){bf_lo(xc[j].x), bf_hi(xc[j].x), bf_lo(xc[j].y), bf_hi(xc[j].y)};
#pragma unroll
        for (int k = 0; k < 4; ++k)
#pragma unroll
            for (int j = 0; j < 4; ++j) { v[j].x += bf_lo(rwc[k][j].x); v[j].y += bf_hi(rwc[k][j].x); v[j].z += bf_lo(rwc[k][j].y); v[j].w += bf_hi(rwc[k][j].y); }
        if (nc > 4) { unsigned long long m = mc; while (m) { const int e = __builtin_ctzll(m); m &= m - 1; const int slot = __builtin_amdgcn_readlane(inv0, e);
#pragma unroll
                for (int j = 0; j < 4; ++j) { const u32x2 w = *(const u32x2*)(YE + (size_t)slot * D + 4 * lane + 256 * j);
                    v[j].x += bf_lo(w.x); v[j].y += bf_hi(w.x); v[j].z += bf_lo(w.y); v[j].w += bf_hi(w.y); } } }
        float sq = 0.f;
#pragma unroll
        for (int j = 0; j < 4; ++j) sq += (v[j].x * v[j].x + v[j].y * v[j].y) + (v[j].z * v[j].z + v[j].w * v[j].w);
        float rs = 1.0f / sqrtf(wave_sum(sq) * (1.f / D) + 1e-6f);
#pragma unroll
        for (int j = 0; j < 4; ++j) *(f32x4*)(OUT + (size_t)tok * D + 4 * lane + 256 * j) = v[j] * rs * gg[j];
        inv0 = inv1; inv1 = inv2; mc = mn; nc = nn;
#pragma unroll
        for (int k = 0; k < 4; ++k) { slc[k] = sln[k];
#pragma unroll
            for (int j = 0; j < 4; ++j) rwc[k][j] = rwn[k][j]; }
#pragma unroll
        for (int j = 0; j < 4; ++j) xc[j] = xn[j];
    }
#undef PF_SLOTS
#undef PF_ROWS
}

#define XB_TMO      128
#define XB_XCNT(j)  (256  + 64 * (j))
#define XB_XSUB(j)  (1280 + 64 * (j))
#define XB_XGEN(j)  (2304 + 64 * (j))
#define XB_TOP      3328
#define XB_TOPGEN   3392
#define XCD_BAR_WORDS 3456
#define XB_SPIN_CAP (1u << 22)
__device__ __forceinline__ unsigned xb_ld(unsigned* p)              { return __hip_atomic_load(p, __ATOMIC_RELAXED, __HIP_MEMORY_SCOPE_AGENT); }
__device__ __forceinline__ unsigned xb_add(unsigned* p, unsigned v) { return __hip_atomic_fetch_add(p, v, __ATOMIC_RELAXED, __HIP_MEMORY_SCOPE_AGENT); }
__device__ __forceinline__ unsigned xb_xcc_id() { return (unsigned)__builtin_amdgcn_s_getreg((3 << 11) | 20) & 0xFu; }
#define XB_SPIN(cond, bar) do { unsigned _sp = 0; while (cond) { __builtin_amdgcn_s_sleep(1); \
    if ((++_sp & 255u) == 0u) { if (xb_ld(&(bar)[XB_TMO])) break; if (_sp > XB_SPIN_CAP) { atomicAdd(&(bar)[XB_TMO], 1u); break; } } } } while (0)
struct XcdBarrier { unsigned* bar; unsigned x; volatile LAS unsigned* st; int wv; };
__device__ __forceinline__ XcdBarrier xcd_barrier_post(unsigned* bar, volatile LAS unsigned* st, int wv) {
    XcdBarrier b; b.bar = bar; b.x = xb_xcc_id(); b.st = st; b.wv = wv;
    if (threadIdx.x == 0) (void)xb_add(&bar[XB_XCNT(b.x)], 1u);
    return b;
}
__device__ __forceinline__ void xcd_barrier_complete(unsigned* bar, unsigned x, unsigned& nloc, unsigned& nx) {
    const unsigned G = gridDim.x * gridDim.y * gridDim.z;
    unsigned sum, cnt, mine, sp = 0u;
    for (;;) {
        sum = 0u; cnt = 0u; mine = 0u;
#pragma unroll
        for (unsigned j = 0; j < 16; ++j) { const unsigned c = xb_ld(&bar[XB_XCNT(j)]); sum += c; cnt += (c > 0u) ? 1u : 0u; mine = (j == x) ? c : mine; }
        if (sum == G) break;
        __builtin_amdgcn_s_sleep(1);
        if ((++sp & 255u) == 0u) { if (xb_ld(&bar[XB_TMO])) break; if (sp > XB_SPIN_CAP) { atomicAdd(&bar[XB_TMO], 1u); break; } }
    }
    nloc = mine > 0u ? mine : 1u; nx = cnt > 0u ? cnt : 1u;
}
__device__ __forceinline__ void xcd_barrier(const XcdBarrier& b) {
    asm volatile("s_waitcnt vmcnt(0)" ::: "memory");
    __syncthreads();
    if (tid_of(b.wv) == 0) {
        unsigned* bar = b.bar;
        __builtin_amdgcn_s_waitcnt(0);
        unsigned nloc = b.st[0], nx = b.st[1];
        if (nloc == 0u) { xcd_barrier_complete(bar, b.x, nloc, nx); b.st[0] = nloc; b.st[1] = nx; }
        const unsigned old = xb_add(&bar[XB_XSUB(b.x)], 1u);
        const unsigned gen = old / nloc;
        if (old + 1u == (gen + 1u) * nloc) {
            __builtin_amdgcn_fence(__ATOMIC_RELEASE, "agent");
            asm volatile("s_waitcnt vmcnt(0)" ::: "memory");
            const unsigned og = xb_add(&bar[XB_TOP], 1u);
            const unsigned tg = og / nx;
            if (og + 1u == (tg + 1u) * nx) xb_add(&bar[XB_TOPGEN], 1u);
            else XB_SPIN(xb_ld(&bar[XB_TOPGEN]) == tg, bar);
            __builtin_amdgcn_fence(__ATOMIC_ACQUIRE, "agent");
            xb_add(&bar[XB_XGEN(b.x)], 1u);
            asm volatile("s_waitcnt vmcnt(0)" ::: "memory");
        } else {
            XB_SPIN(xb_ld(&bar[XB_XGEN(b.x)]) == gen, bar);
            __builtin_amdgcn_fence(__ATOMIC_ACQUIRE, "agent");
            asm volatile("s_waitcnt vmcnt(0)" ::: "memory");
        }
    }
    __syncthreads();
}

#ifndef PH_MASK
#define PH_MASK 0x7ff
#endif
#ifndef REP_MASK
#define REP_MASK 0
#endif
#ifndef P2_MASK
#define P2_MASK 7
#endif
#ifndef P2_REP
#define P2_REP 0
#define P9_REP 0
#endif
constexpr int LDS_MISC = LDS_BYTES - 64;
constexpr int LDS_PTAB = LDS_BYTES - 512;
__device__ __forceinline__ Args load_args(LAS unsigned char* lds, int lo, int hi, int wv) {
    Args r; const LAS u32x2* t = (const LAS u32x2*)(lds + LDS_PTAB);
#pragma unroll
    for (int i = 0; i < 31; ++i) { const u32x2 v = t[i]; const unsigned long long p = ((unsigned long long)(unsigned)__builtin_amdgcn_readfirstlane((int)v.y) << 32) | (unsigned)__builtin_amdgcn_readfirstlane((int)v.x);
        if (i < 29) r.in[i] = (const float*)(const __attribute__((address_space(1))) float*)p; else if (i == 29) r.out = (float*)(__attribute__((address_space(1))) float*)p; else r.ws = (unsigned char*)(__attribute__((address_space(1))) unsigned char*)p; }
    r.ph_lo = lo; r.ph_hi = hi; r.wv = wv; r.zero_ = 0; return r;
}
constexpr size_t WS_CTL = 0, CTL_BYTES = 16384;
__global__ void __launch_bounds__(NTHREADS, 2) mega(Args a0) {
    extern __shared__ __attribute__((aligned(16))) unsigned char lds_raw[];
    LAS unsigned char* lds = (LAS unsigned char*)lds_raw;
    cg::grid_group grid = cg::this_grid();
    const int G = gridDim.x, lo = a0.ph_lo, hi = a0.ph_hi, wv0 = __builtin_amdgcn_readfirstlane((int)threadIdx.x >> 6);
    volatile LAS unsigned* misc = (volatile LAS unsigned*)(lds + LDS_MISC);
    if (threadIdx.x < 16) misc[threadIdx.x] = 0u;
    if (threadIdx.x == 0) { LAS unsigned long long* t = (LAS unsigned long long*)(lds + LDS_PTAB);
#pragma unroll
        for (int i = 0; i < 29; ++i) t[i] = (unsigned long long)a0.in[i];
        t[29] = (unsigned long long)a0.out; t[30] = (unsigned long long)a0.ws; }
    __syncthreads();
    if (lo < -1000) grid.sync();
    XcdBarrier xbar = xcd_barrier_post((unsigned*)(a0.ws + WS_CTL), misc, wv0);
#define IN(k) (((PH_MASK >> (k)) & 1) && lo <= (k) && (k) < hi)
#define NREP(k) (1 + ((REP_MASK >> (k)) & 1))
#define PHASE(k, ...) do { if (IN(k)) { for (int rep_ = 0; rep_ < NREP(k); ++rep_) { { const Args a = load_args(lds, lo, hi, wv0); unsigned char* const ws = a.ws; (void)ws; __VA_ARGS__; } if (rep_ + 1 < NREP(k) || IN((k) + 1)) { xcd_barrier(xbar); } } } } while (0)

    PHASE(0, phase_prep(a, lds, G));

    PHASE(1, {
        pg8::Gemm g{(const bf16_t*)(ws + WS_XH), (const bf16_t*)(ws + WS_WINT), T, IN_PROJ, D, 0, 0};
        pg8::TripleOrder S; S.S0.init(T, IN_PROJ, G, 0); S.A1 = (const bf16_t*)(ws + WS_MEMN); S.B1 = (const bf16_t*)(ws + WS_WKT); S.A2 = (const bf16_t*)(ws + WS_WVT); S.B2 = (const bf16_t*)(ws + WS_MEMN);
        S.n1 = BATCH * NMEM / 256; S.n2 = BATCH * NMEM / 256; S.G = G; S.c = (int)blockIdx.x;
        pg8::EpiBf16x3 E{pg8::EpiBf16{(bf16_t*)(ws + WS_P), PLD, (bf16_t*)(ws + WS_Q)}, pg8::EpiBf16{(bf16_t*)(ws + WS_KMEM), 256, nullptr}, pg8::EpiBf16{(bf16_t*)(ws + WS_VT), BATCH * NMEM, nullptr}};
        const int total = S.n1 + S.n2 + S.S0.nwg, rem = total % G, c = (int)blockIdx.x;
        const bool cv = rem ? (c >= rem) : true; const int ncv = rem ? G - rem : G, rank = rem ? c - rem : c;
        if (cv && !(rank & 1)) { expert_prep_items(a, lds, rank * 8 + a.wv, ncv * 8, 0, 3 * 8192); __syncthreads(); }
        pg8::gemm_phase<pg8::EpiBf16x3, pg8::TripleOrder, false>(lds, g, S, E, nullptr, a.wv);
        if (cv && (rank & 1)) { __syncthreads(); expert_prep_items(a, lds, rank * 8 + a.wv, ncv * 8, 0, 3 * 8192); }
    });

    constexpr int NSCAN = BATCH * NH * 2;
    PHASE(2, {
        for (int r2 = 0; r2 < 1 + ((P2_REP >> 1) & 1); ++r2) conv_stream(a, lds, (int)blockIdx.x, G);
        for (int u = blockIdx.x; u < 2048; u += G) {
            if (u >= 1024) { for (int r2 = 0; r2 < 1 + ((P2_REP >> 2) & 1); ++r2) prep_unit(a, lds, u - 1024); }
        }
    });

    PHASE(3, {
        int bid = blockIdx.x; int Gp = G; asm volatile("" : "+s"(bid), "+s"(Gp));
        for (int u = bid; u < NSCAN; u += Gp) scan_chunked_unit(a, lds, u);
        if (rep_ == 0) {
            if (Gp > NSCAN) { if (bid >= NSCAN) { for (int u = bid - NSCAN; u < 64; u += Gp - NSCAN) for (int r2 = 0; r2 < 1 + (P2_REP & 1); ++r2) attn_unit(a, lds, u);
                                                 } }
            else { for (int u = bid; u < 64; u += Gp) attn_unit(a, lds, u); }
        }
    });

    PHASE(4, phase_post(a, G));

    PHASE(5, {
        pg8::Gemm g{(const bf16_t*)(ws + WS_MIX), (const bf16_t*)(ws + WS_WOUTT), T, D, D, 0, 0}; pg8::StaticOrder S; S.init(T, D, G, (int)blockIdx.x);
        pg8::EpiResidSS E{a.in[I_X], (bf16_t*)(ws + WS_X1), (float*)(ws + WS_SS)}; pg8::gemm_phase<pg8::EpiResidSS, pg8::StaticOrder, false>(lds, g, S, E, nullptr, a.wv);
    });

    PHASE(6, phase_router(a, lds, G));

    PHASE(7, { for (int u = blockIdx.x; u < BATCH * NE; u += G) topk_unit(a, lds, u); });

    PHASE(8, {
        pg8::Gemm g{(const bf16_t*)(ws + WS_H2), (const bf16_t*)(ws + WS_WGUT), NSLOT, 2048, D / 2, 0x7A7A7A7A, 0x7F7F7F7F};     pg8::ExpertOrder S; S.init(32, 8, NE, G, (int)blockIdx.x);
        pg8::EpiSwiGLU E{(bf16_t*)(ws + WS_HID)}; pg8::gemm_phase<pg8::EpiSwiGLU, pg8::ExpertOrder, true, false, true>(lds, g, S, E, (const int*)(ws + WS_ROWTOK), a.wv);
    });

    PHASE(9, {
        pg8::Gemm g{(const bf16_t*)(ws + WS_HID), (const bf16_t*)(ws + WS_WDT), NSLOT, D, FF / 2, 0x7A7A7A7A, 0x7C7C7C7C};     pg8::ExpertOrder S; S.init(32, 4, NE, G, (int)blockIdx.x);
        pg8::EpiGateScale E{(bf16_t*)(ws + WS_YE), (const float*)(ws + WS_ROWGATE)}; pg8::gemm_phase<pg8::EpiGateScale, pg8::ExpertOrder, false, true, true>(lds, g, S, E, nullptr, a.wv);
#if P9_REP
        __syncthreads(); pg8::gemm_phase<pg8::EpiGateScale, pg8::ExpertOrder, false, true, true>(lds, g, S, E, nullptr, a.wv);
#endif
    });

    PHASE(10, phase_final(a, G));
#undef IN
#undef NREP
#undef PHASE
}

#ifndef MK_ONE_LAUNCH
#define MK_ONE_LAUNCH 1
#endif
extern "C" void kernel_launch(void* const* d_in, const int* in_sizes, int n_in, void* d_out, int out_size, void* d_ws, size_t ws_size, hipStream_t stream) {
    static int grid_blocks = 0;
    if (grid_blocks == 0) {
        if (n_in != 29 || out_size != T * D || ws_size < WS_END) { fprintf(stderr, "kernel_launch: unexpected problem: n_in %d out %d ws %zu (need %zu)\n", n_in, out_size, ws_size, (size_t)WS_END); grid_blocks = -1; return; }
        int dev = 0, cus = 0, per_cu = 0;
        if (hipGetDevice(&dev) != hipSuccess || hipDeviceGetAttribute(&cus, hipDeviceAttributeMultiprocessorCount, dev) != hipSuccess) { grid_blocks = -1; return; }
        if (hipFuncSetAttribute((const void*)mega, hipFuncAttributeMaxDynamicSharedMemorySize, LDS_BYTES) != hipSuccess) { fprintf(stderr, "kernel_launch: hipFuncSetAttribute failed\n"); grid_blocks = -1; return; }
        if (hipOccupancyMaxActiveBlocksPerMultiprocessor(&per_cu, (const void*)mega, NTHREADS, LDS_BYTES) != hipSuccess || per_cu < 1) { fprintf(stderr, "kernel_launch: occupancy query says %d blocks per CU\n", per_cu); grid_blocks = -1; return; }
        grid_blocks = cus;
    }
    if (grid_blocks < 0) return;
    if (hipMemsetAsync((char*)d_ws + WS_CTL, 0, CTL_BYTES, stream) != hipSuccess) { fprintf(stderr, "kernel_launch: memset failed\n"); return; }
    Args a{};
    for (int i = 0; i < 29; ++i) a.in[i] = (const float*)d_in[i];
    a.out = (float*)d_out; a.ws = (unsigned char*)d_ws;
#if MK_ONE_LAUNCH
    a.ph_lo = 0; a.ph_hi = NPHASE;
    { void* args[] = {&a}; hipError_t e = hipLaunchCooperativeKernel((const void*)mega, dim3(grid_blocks), dim3(NTHREADS), args, LDS_BYTES, stream);
      if (e != hipSuccess) fprintf(stderr, "cooperative launch failed: %s (grid %d)\n", hipGetErrorString(e), grid_blocks); }
#else
    for (int ph = 0; ph < NPHASE; ++ph) { a.ph_lo = ph; a.ph_hi = ph + 1; void* args[] = {&a};
        hipError_t e = hipLaunchCooperativeKernel((const void*)mega, dim3(grid_blocks), dim3(NTHREADS), args, LDS_BYTES, stream);
        if (e != hipSuccess) { fprintf(stderr, "cooperative launch %d failed: %s (grid %d)\n", ph, hipGetErrorString(e), grid_blocks); break; } }
#endif
}
```

```cpp
#include <hip/hip_runtime.h>
#include <hip/hip_cooperative_groups.h>
#include <cstdio>
#include <cstdint>
namespace cg = cooperative_groups;

#define LAS __attribute__((address_space(3)))
typedef unsigned short bf16_t;
typedef short bf16x8 __attribute__((ext_vector_type(8)));
typedef short s16x4 __attribute__((ext_vector_type(4)));
typedef float f32x2 __attribute__((ext_vector_type(2)));
typedef float f32x4 __attribute__((ext_vector_type(4)));
typedef float f32x16 __attribute__((ext_vector_type(16)));
typedef unsigned u32x2 __attribute__((ext_vector_type(2)));
typedef unsigned u32x4 __attribute__((ext_vector_type(4)));
typedef _Float16 f16x4 __attribute__((ext_vector_type(4)));
typedef _Float16 f16x2 __attribute__((ext_vector_type(2)));
typedef __bf16 bf16v2 __attribute__((ext_vector_type(2)));
typedef int v8i __attribute__((ext_vector_type(8)));
typedef int v4i __attribute__((ext_vector_type(4)));

constexpr int D = 1024, BATCH = 16, SEQ = 4096, T = BATCH * SEQ, NMEM = 256;
constexpr int IN_PROJ = 2560, CW = 384, RW = 384, NH = 6, NE = 16, FF = 1024, CAP = 512;
constexpr int NSLOT = NE * BATCH * CAP;
constexpr int NTHREADS = 512;
constexpr int LDS_BYTES = 160 * 1024;
constexpr int NPHASE = 11;
#ifndef SCAN_MODE
#define SCAN_MODE 1
#endif

constexpr size_t MiB = 1u << 20;
constexpr size_t WS_WINT = 1 * MiB;
constexpr size_t WS_WOUTT = 6 * MiB;
constexpr size_t WS_WKT = 8 * MiB;
constexpr size_t WS_WVT = 8 * MiB + 512 * 1024;
constexpr size_t WS_SMALL = 9 * MiB;
constexpr size_t WS_WGUT = 10 * MiB;
constexpr size_t WS_WDT = 74 * MiB;
constexpr size_t WS_KMEM = 106 * MiB;
constexpr size_t WS_VT = 108 * MiB;
constexpr size_t WS_ROWTOK = 106 * MiB;
constexpr size_t WS_ROWGATE = 106 * MiB + 512 * 1024;
constexpr size_t WS_SS = 107 * MiB;
constexpr size_t WS_P = 112 * MiB;
constexpr size_t WS_YF = 112 * MiB;
constexpr size_t WS_YB = 208 * MiB;
constexpr size_t WS_X1 = 112 * MiB;
constexpr size_t WS_XH = 432 * MiB;
constexpr size_t WS_G = 432 * MiB;
constexpr size_t WS_BON = 480 * MiB;
constexpr size_t WS_Q = 400 * MiB;
constexpr int PLD = IN_PROJ - 256;
constexpr size_t WS_H2 = 432 * MiB;
constexpr size_t WS_MEMN = 560 * MiB;
constexpr size_t WS_MIX = 560 * MiB;
constexpr size_t WS_SCAN = 688 * MiB;
constexpr size_t SCAN_STRIDE = 48 * MiB;
constexpr size_t WS_SCAN7 = 496 * MiB;
constexpr size_t WS_PC = 484 * MiB;
__device__ __forceinline__ unsigned char* scan_arr(unsigned char* ws, int a) { return a < 7 ? ws + WS_SCAN + (size_t)a * SCAN_STRIDE : (a == 7 ? ws + WS_SCAN7 : ws + 560 * MiB + 640 * 2); }
__device__ __forceinline__ int scan_pitch(int a) { return a == 8 ? D : 384; }
__device__ __forceinline__ size_t hat_off(int a, size_t tok, int ch) { return a == 8 ? tok * D + ch : ((((tok >> 4) * NH + (ch >> 6)) << 10) + ((tok & 15) << 6) + (ch & 63)); }
constexpr size_t WS_AFF = 624 * MiB;
constexpr size_t WS_INV = 628 * MiB;
constexpr size_t WS_HID = 768 * MiB;
constexpr size_t WS_YE = 368 * MiB;
constexpr size_t WS_END = 1024 * MiB;

__device__ __forceinline__ unsigned pk_bf16(float lo, float hi) { f32x2 v = {lo, hi}; bf16v2 b = __builtin_convertvector(v, bf16v2); return __builtin_bit_cast(unsigned, b); }
__device__ __forceinline__ unsigned pk_fp8x4(float a, float b, float c, float d) { int w = 0; w = __builtin_amdgcn_cvt_pk_fp8_f32(a, b, w, false); w = __builtin_amdgcn_cvt_pk_fp8_f32(c, d, w, true); return (unsigned)w; }
__device__ __forceinline__ float bf_lo(unsigned u) { return __builtin_bit_cast(float, u << 16); }
__device__ __forceinline__ float bf_hi(unsigned u) { return __builtin_bit_cast(float, u & 0xffff0000u); }
__device__ __forceinline__ float wave_sum(float v) {
#pragma unroll
    for (int o = 1; o < 64; o <<= 1) v += __shfl_xor(v, o);
    return v;
}
__device__ __forceinline__ float sigmoidf_fast(float x) { return __builtin_amdgcn_rcpf(1.0f + __builtin_amdgcn_exp2f(-1.4426950408889634f * x)); }
template <int CTRL> __device__ __forceinline__ float dpp_f(float x) { return __builtin_bit_cast(float, __builtin_amdgcn_update_dpp(0, __builtin_bit_cast(int, x), CTRL, 0xF, 0xF, true)); }
__device__ __forceinline__ float sum8(float x) { x += dpp_f<0xB1>(x); x += dpp_f<0x4E>(x); x += dpp_f<0x141>(x); return x; }
__device__ __forceinline__ float sum16(float x) { x = sum8(x); x += dpp_f<0x140>(x); return x; }
__device__ __forceinline__ float max16(float x) { x = fmaxf(x, dpp_f<0xB1>(x)); x = fmaxf(x, dpp_f<0x4E>(x)); x = fmaxf(x, dpp_f<0x141>(x)); x = fmaxf(x, dpp_f<0x140>(x)); return x; }

typedef short v4i16g __attribute__((__vector_size__(8)));
__device__ __forceinline__ s16x4 tr_read16(LAS unsigned char* p) { v4i16g r = __builtin_amdgcn_ds_read_tr16_b64_v4i16((LAS v4i16g*)p); return __builtin_bit_cast(s16x4, r); }
__device__ __forceinline__ f32x4 bf4_to_f32(u32x2 w) { return (f32x4){bf_lo(w.x), bf_hi(w.x), bf_lo(w.y), bf_hi(w.y)}; }
__device__ __forceinline__ u32x2 f32_to_bf4(f32x4 v) { return (u32x2){pk_bf16(v.x, v.y), pk_bf16(v.z, v.w)}; }
__device__ __forceinline__ bf16x8 frag_lo4(f32x4 v) { const u32x4 w = {pk_bf16(v.x, v.y), pk_bf16(v.z, v.w), 0u, 0u}; return __builtin_bit_cast(bf16x8, w); }
__device__ __forceinline__ bf16x8 frag_cat(u32x2 a, u32x2 b) { const u32x4 w = {a.x, a.y, b.x, b.y}; return __builtin_bit_cast(bf16x8, w); }
#define MFMA16(a, b, c) __builtin_amdgcn_mfma_f32_16x16x32_bf16((a), (b), (c), 0, 0, 0)

__device__ __forceinline__ int tid_of(int wv) { int l; asm volatile("v_mbcnt_lo_u32_b32 %0, -1, 0\n\tv_mbcnt_hi_u32_b32 %0, -1, %0" : "=v"(l)); return (wv << 6) | l; }
namespace pg8 {
#define PG8_LAS __attribute__((address_space(3)))
constexpr int BM = 256, BK = 64, HALF = 128, HTB = HALF * BK * 2, STAGE_BYTES = 8 * HTB, NXCD = 8, WGM = 8;
__host__ __device__ __forceinline__ int lds_byte(int r, int c) { const int st = (r >> 4) * 2 + (c >> 5), rr = r & 15, cc = c & 31, ob = rr * 64 + cc * 2; return st * 1024 + (ob ^ (((ob >> 9) & 1) << 5)); }
__host__ __device__ __forceinline__ void stage_rc(int b, int& R, int& C) { const int st = b / 1024, sb = b % 1024, swz = sb ^ (((sb >> 9) & 1) << 5); R = (st >> 1) * 16 + swz / 64; C = (st & 1) * 32 + (swz % 64) / 2; }
__host__ __device__ __forceinline__ int perm32(int rho) { const int n = rho >> 4, i = rho & 15; return 8 * (i >> 2) + 4 * n + (i & 3); }

struct Unit { int pm, pn, gid; };
struct Gemm { const bf16_t* A; const bf16_t* Bt; int M, N, K; int sw, sx; };

struct StaticOrder {
    int nM, nN, nwg, G, c;
    __device__ void init(int M, int N, int G_, int c_) { nM = M / BM; nN = N / BM; nwg = nM * nN; G = G_; c = c_; }
    __device__ bool next(int i, Unit& u) const {
        const long L = (long)i * G + c; if (L >= nwg) return false;
        int wgid = (int)L; { const int q = nwg / NXCD, r = nwg % NXCD, xcd = wgid % NXCD, off = wgid / NXCD; wgid = (xcd < r ? xcd * (q + 1) : r * (q + 1) + (xcd - r) * q) + off; }
        const int nig = WGM * nN, gid = wgid / nig, fm = gid * WGM, gsz = (nM - fm) < WGM ? (nM - fm) : WGM;
        u.pm = fm + ((wgid % nig) % gsz); u.pn = (wgid % nig) / gsz; u.gid = 0; return true;
    }
    __device__ __forceinline__ const char* aptr(const Gemm& g, const Unit& u, size_t tstep) const { return (const char*)g.A + (size_t)u.pm * tstep; }
    __device__ __forceinline__ const char* bptr(const Gemm& g, const Unit& u, size_t tstep) const { return (const char*)g.Bt + (size_t)u.pn * tstep; }
};
struct TripleOrder {
    StaticOrder S0; const bf16_t* A1; const bf16_t* B1; const bf16_t* A2; const bf16_t* B2; int n1, n2, G, c;
    __device__ bool next(int i, Unit& u) const {
        const long L = (long)i * G + c;
        if (L < n1) { u.pm = (int)L; u.pn = 0; u.gid = 1; return true; }
        if (L < n1 + n2) { u.pm = 0; u.pn = (int)(L - n1); u.gid = 2; return true; }
        const long L0 = L - n1 - n2; if (L0 >= S0.nwg) return false;
        StaticOrder T0 = S0; T0.c = (int)(L0 % G); return T0.next((int)(L0 / G), u);
    }
    __device__ __forceinline__ const char* aptr(const Gemm& g, const Unit& u, size_t tstep) const { return (const char*)(u.gid == 0 ? g.A : (u.gid == 1 ? A1 : A2)) + (size_t)u.pm * tstep; }
    __device__ __forceinline__ const char* bptr(const Gemm& g, const Unit& u, size_t tstep) const { return (const char*)(u.gid == 0 ? g.Bt : (u.gid == 1 ? B1 : B2)) + (size_t)u.pn * tstep; }
};
struct ExpertOrder {
    int nMe, nNe, per, total, G, c;
    __device__ void init(int nMe_, int nNe_, int nExp, int G_, int c_) { nMe = nMe_; nNe = nNe_; per = nMe * nNe; total = per * nExp; G = G_; c = c_; }
    __device__ bool next(int i, Unit& u) const {
        const long L = (long)i * G + c; if (L >= total) return false;
        const int e = (int)(L / per), w = (int)(L % per), xl = w % 8, j = w / 8, rpx = nMe / 8;
        u.pm = e * nMe + xl * rpx + (j % rpx); u.pn = e * nNe + j / rpx; u.gid = 0; return true;
    }
    __device__ __forceinline__ const char* aptr(const Gemm& g, const Unit& u, size_t tstep) const { return (const char*)g.A + (size_t)u.pm * tstep; }
    __device__ __forceinline__ const char* bptr(const Gemm& g, const Unit& u, size_t tstep) const { return (const char*)g.Bt + (size_t)u.pn * tstep; }
};

struct EpiBf16 {
    static constexpr bool PERM = true;
    bf16_t* O; int ldc; bf16_t* Q0;
    __device__ __forceinline__ void operator()(const f32x4 (&acc)[2][2][4][2], const Unit& u, int wr, int wc, int fr, int fq) const {
        const bool redir = (Q0 != nullptr) && (u.pn == 0);
        bf16_t* base = redir ? Q0 : O; const int ld = redir ? 256 : ldc;
        const int row0 = u.pm * BM + wr * 64 + fr, col0 = (u.pn - ((Q0 != nullptr && !redir) ? 1 : 0)) * BM + wc * 32 + 8 * fq;
#pragma unroll
        for (int ai = 0; ai < 2; ++ai)
#pragma unroll
            for (int m = 0; m < 4; ++m) { bf16_t* rowp = base + (size_t)(row0 + ai * HALF + m * 16) * ld + col0;
#pragma unroll
                for (int bj = 0; bj < 2; ++bj) { const f32x4 v0 = acc[ai][bj][m][0], v1 = acc[ai][bj][m][1];
                    u32x4 w; w.x = pk_bf16(v0[0], v0[1]); w.y = pk_bf16(v0[2], v0[3]); w.z = pk_bf16(v1[0], v1[1]); w.w = pk_bf16(v1[2], v1[3]);
                    *(u32x4*)(rowp + bj * HALF) = w; } }
    }
};
struct EpiBf16x3 {
    static constexpr bool PERM = true;
    EpiBf16 E0, E1, E2;
    __device__ __forceinline__ void operator()(const f32x4 (&acc)[2][2][4][2], const Unit& u, int wr, int wc, int fr, int fq) const {
        if (u.gid == 0) E0(acc, u, wr, wc, fr, fq); else if (u.gid == 1) E1(acc, u, wr, wc, fr, fq); else E2(acc, u, wr, wc, fr, fq); }
};
struct EpiResidSS {
    static constexpr bool PERM = false;
    const float* X; bf16_t* X1; float* ss;
    __device__ __forceinline__ void operator()(const f32x4 (&acc)[2][2][4][2], const Unit& u, int wr, int wc, int fr, int fq) const {
        const int row0 = u.pm * BM + wr * 64 + fr, col0 = u.pn * BM + wc * 32 + 4 * fq;
#pragma unroll
        for (int ai = 0; ai < 2; ++ai)
#pragma unroll
            for (int m = 0; m < 4; ++m) { const int row = row0 + ai * HALF + m * 16; const size_t off = (size_t)row * D + col0; float s = 0.f;
#pragma unroll
                for (int bj = 0; bj < 2; ++bj)
#pragma unroll
                    for (int n = 0; n < 2; ++n) { const f32x4 xv = *(const f32x4*)(X + off + bj * HALF + n * 16); const f32x4 o = xv + acc[ai][bj][m][n];
                        *(u32x2*)(X1 + off + bj * HALF + n * 16) = f32_to_bf4(o); s += (o[0] * o[0] + o[1] * o[1]) + (o[2] * o[2] + o[3] * o[3]); }
                s += __shfl_xor(s, 16); s += __shfl_xor(s, 32);
                if (fq == 0) (void)__hip_atomic_fetch_add(ss + row, s, __ATOMIC_RELAXED, __HIP_MEMORY_SCOPE_AGENT); }
    }
};
struct EpiSwiGLU {
    static constexpr bool PERM = true;
    bf16_t* H;
    __device__ __forceinline__ void operator()(const f32x4 (&acc)[2][2][4][2], const Unit& u, int wr, int wc, int fr, int fq) const {
        const int row0 = u.pm * BM + wr * 64 + fr, col0 = (u.pn & 7) * HALF + wc * 32 + 8 * fq;
#pragma unroll
        for (int ai = 0; ai < 2; ++ai)
#pragma unroll
            for (int m = 0; m < 4; ++m) { const int row = row0 + ai * HALF + m * 16; float h[8];
                unsigned char* rowp = (unsigned char*)H + ((((size_t)(row >> 8) * (FF / 128) + (col0 >> 7)) << 15) + ((row & 255) << 7) + (col0 & 127));
#pragma unroll
                for (int n = 0; n < 2; ++n)
#pragma unroll
                    for (int j = 0; j < 4; ++j) { const float gt = acc[ai][0][m][n][j], up = acc[ai][1][m][n][j]; h[n * 4 + j] = 8.0f * gt * sigmoidf_fast(gt) * up; }
                *(u32x2*)rowp = (u32x2){pk_fp8x4(h[0], h[1], h[2], h[3]), pk_fp8x4(h[4], h[5], h[6], h[7])}; }
    }
};
struct EpiGateScale {
    static constexpr bool PERM = true;
    bf16_t* Y; const float* gate;
    __device__ __forceinline__ void operator()(const f32x4 (&acc)[2][2][4][2], const Unit& u, int wr, int wc, int fr, int fq) const {
        const int row0 = u.pm * BM + wr * 64 + fr, col0 = (u.pn & 3) * BM + wc * 32 + 8 * fq;
#pragma unroll
        for (int ai = 0; ai < 2; ++ai)
#pragma unroll
            for (int m = 0; m < 4; ++m) { const int row = row0 + ai * HALF + m * 16; const float gs = gate[row]; bf16_t* rowp = Y + (size_t)row * D + col0;
#pragma unroll
                for (int bj = 0; bj < 2; ++bj) { const f32x4 v0 = acc[ai][bj][m][0] * gs, v1 = acc[ai][bj][m][1] * gs;
                    u32x4 w; w.x = pk_bf16(v0[0], v0[1]); w.y = pk_bf16(v0[2], v0[3]); w.z = pk_bf16(v1[0], v1[1]); w.w = pk_bf16(v1[2], v1[3]);
                    *(u32x4*)(rowp + bj * HALF) = w; } }
    }
};

template <class Epi, class Sched, bool GATHER, bool ATILED = false, bool FP8 = false>
__device__ __forceinline__ void gemm_phase(PG8_LAS unsigned char* lds, const Gemm g, const Sched& S, const Epi& E, const int* rowtok, const int wv) {
    int tid = tid_of(wv); asm volatile("" : "+v"(tid));
    const int wid = __builtin_amdgcn_readfirstlane(tid >> 6), lane = tid & 63, wr = wid >> 2, wc = wid & 3, fr = lane & 15, fq = lane >> 4;
    const int K = g.K, nt = K / BK;
    unsigned voffA0, voffB0;
    { int R, C; stage_rc(tid * 16, R, C); const int Rb = Epi::PERM ? ((R & ~31) + perm32(R & 31)) : R;
      voffA0 = ATILED ? (unsigned)(R * BK + C) * 2u : (unsigned)(R * K + C) * 2u; voffB0 = (unsigned)(Rb * K + C) * 2u; }
    const size_t dA = ATILED ? (size_t)64 * BK * 2 : (size_t)64 * K * 2, dB = (size_t)64 * K * 2;
    unsigned vAc[2][2], vAn[2][2];
    const size_t kstep = (size_t)(BK * 2);
    const size_t hstep = (size_t)HALF * K * 2;
    const size_t tstep = 2 * hstep;
    const size_t kstepA = ATILED ? (size_t)BM * BK * 2 : kstep, hstepA = ATILED ? (size_t)HALF * BK * 2 : hstep;
    const unsigned ldsw = (unsigned)wid * 1024u;
    const unsigned ldsbase = __builtin_amdgcn_readfirstlane((unsigned)(size_t)lds) + ldsw;
    const int aoff = lds_byte(wr * 64 + fr, fq * 8), boff = lds_byte(wc * 32 + fr, fq * 8);
#define PG8_SA(b, h) (((b) * 2 + (h)) * HTB)
#define PG8_SB(b, h) ((4 + (b) * 2 + (h)) * HTB)
#define PG8_GLDS(vo_, sb_, lo_) asm volatile("s_add_u32 m0, %2, %3\n\ts_nop 0\n\tglobal_load_lds_dwordx4 %0, %1" :: "v"(vo_), "s"((const void*)(sb_)), "s"(ldsbase), "n"(lo_) : "m0", "scc", "memory")
#define PG8_STAGE_D(bufoff, gbase, voff0, delta) do { PG8_GLDS(voff0, gbase, (bufoff)); PG8_GLDS(voff0, (const char*)(gbase) + (delta), (bufoff) + 8192); } while (0)
#define PG8_STAGE(bufoff, gbase, voff) do { PG8_GLDS((voff)[0], gbase, (bufoff)); PG8_GLDS((voff)[1], gbase, (bufoff) + 8192); } while (0)
#define PG8_STAGE_A(bufoff, hh, dbase, kbytes, vsel) do { if constexpr (GATHER) { PG8_STAGE(bufoff, (const char*)g.A + (kbytes), (vsel)[hh]); } else { PG8_STAGE_D(bufoff, (dbase) + ((hh) ? hstepA : 0), voffA0, dA); } } while (0)
#define PG8_GATHER_OFF(dst, un) do { int R_, C_; stage_rc(tid * 16, R_, C_); _Pragma("unroll") for (int _h = 0; _h < 2; ++_h) _Pragma("unroll") for (int _i = 0; _i < 2; ++_i) \
        (dst)[_h][_i] = (unsigned)rowtok[(un).pm * BM + _h * HALF + R_ + 64 * _i] * (unsigned)(K * 2) + (unsigned)(C_ * 2); } while (0)
#define PG8_LDA(dst, b, h) do { _Pragma("unroll") for (int m = 0; m < 4; ++m) _Pragma("unroll") for (int k = 0; k < 2; ++k) dst[m][k] = *(const PG8_LAS bf16x8*)(lds + PG8_SA(b, h) + aoff + m * 2048 + k * 1024); } while (0)
#define PG8_LDB(dst, b, h) do { _Pragma("unroll") for (int n = 0; n < 2; ++n) _Pragma("unroll") for (int k = 0; k < 2; ++k) dst[n][k] = *(const PG8_LAS bf16x8*)(lds + PG8_SB(b, h) + boff + n * 2048 + k * 1024); } while (0)
#define PG8_MMA(ai, bj, At, Bt) do { __builtin_amdgcn_s_setprio(1); _Pragma("unroll") for (int m = 0; m < 4; ++m) _Pragma("unroll") for (int n = 0; n < 2; ++n) _Pragma("unroll") for (int k = 0; k < 2; ++k) \
        acc[ai][bj][m][n] = __builtin_amdgcn_mfma_f32_16x16x32_bf16(Bt[n][k], At[m][k], acc[ai][bj][m][n], 0, 0, 0); __builtin_amdgcn_s_setprio(0); } while (0)
#define PG8_CAT8(lo_, hi_) __builtin_shufflevector(lo_, hi_, 0, 1, 2, 3, 4, 5, 6, 7)
#define PG8_LDA8(b, h) do { _Pragma("unroll") for (int m = 0; m < 4; ++m) { const v4i lo_ = *(const PG8_LAS v4i*)(lds + PG8_SA(b, h) + aoff + m * 2048), hi_ = *(const PG8_LAS v4i*)(lds + PG8_SA(b, h) + aoff + m * 2048 + 1024); A8[m] = PG8_CAT8(lo_, hi_); } } while (0)
#define PG8_LDB8(dst, b, h) do { _Pragma("unroll") for (int n = 0; n < 2; ++n) { const v4i lo_ = *(const PG8_LAS v4i*)(lds + PG8_SB(b, h) + boff + n * 2048), hi_ = *(const PG8_LAS v4i*)(lds + PG8_SB(b, h) + boff + n * 2048 + 1024); dst[n] = PG8_CAT8(lo_, hi_); } } while (0)
#define PG8_MMA8(ai, bj, Bt8) do { __builtin_amdgcn_s_setprio(1); _Pragma("unroll") for (int m = 0; m < 4; ++m) _Pragma("unroll") for (int n = 0; n < 2; ++n) \
        acc[ai][bj][m][n] = __builtin_amdgcn_mfma_scale_f32_16x16x128_f8f6f4(Bt8[n], A8[m], acc[ai][bj][m][n], 0, 0, 0, g.sw, 0, g.sx); __builtin_amdgcn_s_setprio(0); } while (0)
#define PG8_LDAX(b, h) do { if constexpr (FP8) { PG8_LDA8(b, h); } else { PG8_LDA(At, b, h); } } while (0)
#define PG8_LDBX(w, b, h) do { if constexpr (FP8) { if (w) { PG8_LDB8(B81, b, h); } else { PG8_LDB8(B80, b, h); } } else { if (w) { PG8_LDB(B1, b, h); } else { PG8_LDB(B0, b, h); } } } while (0)
#define PG8_MMX(ai, bj, w) do { if constexpr (FP8) { if (w) { PG8_MMA8(ai, bj, B81); } else { PG8_MMA8(ai, bj, B80); } } else { if (w) { PG8_MMA(ai, bj, At, B1); } else { PG8_MMA(ai, bj, At, B0); } } } while (0)
#define PG8_WAIT_V(n) asm volatile("s_waitcnt vmcnt(" #n ")" ::: "memory")
#define PG8_WAIT_L(n) asm volatile("s_waitcnt lgkmcnt(" #n ")" ::: "memory")
#define PG8_BAR __builtin_amdgcn_s_barrier()
#define PG8_SCHED __builtin_amdgcn_sched_barrier(0)
    Unit cur, nxt; int ui = 0;
    if (!S.next(0, cur)) return;
    f32x4 acc[2][2][4][2];
#pragma unroll
    for (int a = 0; a < 2; ++a)
#pragma unroll
        for (int b = 0; b < 2; ++b)
#pragma unroll
            for (int m = 0; m < 4; ++m)
#pragma unroll
                for (int n = 0; n < 2; ++n) acc[a][b][m][n] = (f32x4){0.f, 0.f, 0.f, 0.f};
    bf16x8 At[4][2], B0[2][2], B1[2][2]; v8i A8[4], B80[2], B81[2];
    const char* cA = GATHER ? (const char*)g.A : S.aptr(g, cur, tstep); const char* cB = S.bptr(g, cur, tstep);
    if constexpr (GATHER) { PG8_GATHER_OFF(vAc, cur); }
    PG8_STAGE_D(PG8_SB(0, 0), cB, voffB0, dB); PG8_STAGE_A(PG8_SA(0, 0), 0, cA, 0, vAc); PG8_STAGE_D(PG8_SB(0, 1), cB + hstep, voffB0, dB); PG8_STAGE_A(PG8_SA(0, 1), 1, cA, 0, vAc);
    if (wr == 1) PG8_BAR;
    PG8_WAIT_V(4); PG8_BAR;
    PG8_STAGE_D(PG8_SB(1, 0), cB + kstep, voffB0, dB); PG8_STAGE_A(PG8_SA(1, 0), 0, cA + kstepA, kstep, vAc); PG8_STAGE_D(PG8_SB(1, 1), cB + hstep + kstep, voffB0, dB);
    PG8_WAIT_V(6); PG8_BAR;
    for (;;) {
        const bool has_next = S.next(ui + 1, nxt);
        const char* nA = (has_next && !GATHER) ? S.aptr(g, nxt, tstep) : cA; const char* nB = has_next ? S.bptr(g, nxt, tstep) : cB;
        if constexpr (GATHER) { if (has_next) { PG8_GATHER_OFF(vAn, nxt); } else {
#pragma unroll
            for (int _h = 0; _h < 2; ++_h)
#pragma unroll
                for (int _i = 0; _i < 2; ++_i) vAn[_h][_i] = vAc[_h][_i]; } }
#pragma unroll 1
        for (int t = 0; t < nt; t += 2) {
            const bool last = (t == nt - 2);
            const size_t k1 = (size_t)(t + 1) * kstep, k2 = last ? 0 : (size_t)(t + 2) * kstep, k3 = k2 + kstep;
            const char* a1 = cA + (size_t)(t + 1) * kstepA;
            const char* a2 = last ? nA : cA + (size_t)(t + 2) * kstepA; const char* b2 = last ? nB : cB + (size_t)(t + 2) * kstep;
            const char* a3 = a2 + kstepA; const char* b3 = b2 + kstep;
            PG8_LDBX(0, 0, 0); PG8_SCHED; PG8_LDAX(0, 0); PG8_STAGE_A(PG8_SA(1, 1), 1, a1, k1, vAc);
            if constexpr (GATHER) { if (last) {
#pragma unroll
                for (int _h = 0; _h < 2; ++_h)
#pragma unroll
                    for (int _i = 0; _i < 2; ++_i) vAc[_h][_i] = vAn[_h][_i]; } }
            PG8_WAIT_L(8); PG8_BAR; PG8_WAIT_L(0); PG8_MMX(0, 0, 0); PG8_BAR; PG8_SCHED;
            PG8_LDBX(1, 0, 1); PG8_STAGE_D(PG8_SB(0, 0), b2, voffB0, dB);
            PG8_BAR; PG8_WAIT_L(0); PG8_MMX(0, 1, 1); PG8_BAR;
            PG8_LDAX(0, 1); PG8_STAGE_A(PG8_SA(0, 0), 0, a2, k2, vAc);
            PG8_BAR; PG8_WAIT_L(0); PG8_MMX(1, 0, 0); PG8_BAR; PG8_SCHED;
            PG8_STAGE_D(PG8_SB(0, 1), b2 + hstep, voffB0, dB);
            PG8_WAIT_V(6); PG8_BAR; PG8_MMX(1, 1, 1); PG8_BAR;
            PG8_LDBX(0, 1, 0); PG8_SCHED; PG8_LDAX(1, 0); PG8_STAGE_A(PG8_SA(0, 1), 1, a2, k2, vAc);
            PG8_WAIT_L(8); PG8_BAR; PG8_WAIT_L(0); PG8_MMX(0, 0, 0); PG8_BAR; PG8_SCHED;
            PG8_LDBX(1, 1, 1); PG8_STAGE_D(PG8_SB(1, 0), b3, voffB0, dB);
            PG8_BAR; PG8_WAIT_L(0); PG8_MMX(0, 1, 1); PG8_BAR;
            PG8_LDAX(1, 1); PG8_STAGE_A(PG8_SA(1, 0), 0, a3, k3, vAc);
            PG8_BAR; PG8_WAIT_L(0); PG8_MMX(1, 0, 0); PG8_BAR; PG8_SCHED;
            PG8_STAGE_D(PG8_SB(1, 1), b3 + hstep, voffB0, dB);
            PG8_WAIT_V(6); PG8_BAR; PG8_MMX(1, 1, 1); PG8_BAR;
        }
        E(acc, cur, wr, wc, fr, fq);
        if (!has_next) break;
#pragma unroll
        for (int a = 0; a < 2; ++a)
#pragma unroll
            for (int b = 0; b < 2; ++b)
#pragma unroll
                for (int m = 0; m < 4; ++m)
#pragma unroll
                    for (int n = 0; n < 2; ++n) acc[a][b][m][n] = (f32x4){0.f, 0.f, 0.f, 0.f};
        cur = nxt; cA = nA; cB = nB; ++ui;
        if constexpr (GATHER) {
#pragma unroll
            for (int _h = 0; _h < 2; ++_h)
#pragma unroll
                for (int _i = 0; _i < 2; ++_i) vAc[_h][_i] = vAn[_h][_i]; }
    }
    PG8_WAIT_V(0);
    if (wr == 0) PG8_BAR;
    PG8_BAR;
#undef PG8_SA
#undef PG8_SB
#undef PG8_STAGE
#undef PG8_STAGE_D
#undef PG8_GLDS
#undef PG8_STAGE_A
#undef PG8_GATHER_OFF
#undef PG8_LDA
#undef PG8_LDB
#undef PG8_MMA
#undef PG8_MMA8
#undef PG8_LDA8
#undef PG8_LDB8
#undef PG8_LDAX
#undef PG8_LDBX
#undef PG8_MMX
#undef PG8_CAT8
#undef PG8_WAIT_V
#undef PG8_WAIT_L
#undef PG8_BAR
#undef PG8_SCHED
}
}

struct Args {
    const float* in[29];
    float* out; unsigned char* ws;
    int ph_lo, ph_hi;
    int wv, zero_;
};
enum { I_X = 0, I_MEM, I_NMIXG, I_NMEMG, I_WIN, I_WMK, I_WMV, I_CONVW, I_CONVB, I_CLNG, I_CLNB, I_SHIFTMU, I_DW0, I_DUP, I_IA0, I_IUP, I_GUP, I_KK, I_KA, I_RK,
       I_LNXG, I_LNXB, I_WOUT, I_NFFNG, I_WROUTER, I_WEG, I_WEU, I_WED, I_FNG };

template <bool F8 = false>
__device__ __forceinline__ void transpose_item(const float* W, int N, bf16_t* WT, int K, int k0, int n0, int drow0, LAS float* scr, int lane) {
    {
        f32x4 v[8];
#pragma unroll
        for (int i = 0; i < 8; ++i) v[i] = *(const f32x4*)(W + (size_t)(k0 + 8 * i + (lane >> 3)) * N + n0 + 4 * (lane & 7));
#pragma unroll
        for (int i = 0; i < 8; ++i) { LAS float* d = scr + (8 * i + (lane >> 3)) * 33 + 4 * (lane & 7); d[0] = v[i].x; d[1] = v[i].y; d[2] = v[i].z; d[3] = v[i].w; }
    }
    asm volatile("s_waitcnt lgkmcnt(0)" ::: "memory");
    const int c = lane & 7;
#pragma unroll
    for (int j = 0; j < 4; ++j) { const int n = (lane >> 3) + 8 * j; const LAS float* s = scr + (8 * c) * 33 + n;
        if constexpr (F8) { *(u32x2*)((unsigned char*)WT + (size_t)(drow0 + n) * K + k0 + 8 * c) = (u32x2){pk_fp8x4(32.f * s[0 * 33], 32.f * s[1 * 33], 32.f * s[2 * 33], 32.f * s[3 * 33]), pk_fp8x4(32.f * s[4 * 33], 32.f * s[5 * 33], 32.f * s[6 * 33], 32.f * s[7 * 33])}; }
        else { u32x4 o; o.x = pk_bf16(s[0 * 33], s[1 * 33]); o.y = pk_bf16(s[2 * 33], s[3 * 33]); o.z = pk_bf16(s[4 * 33], s[5 * 33]); o.w = pk_bf16(s[6 * 33], s[7 * 33]);
            *(u32x4*)(WT + (size_t)(drow0 + n) * K + k0 + 8 * c) = o; } }
    asm volatile("s_waitcnt lgkmcnt(0)" ::: "memory");
}
__device__ __forceinline__ void expert_prep_items(const Args& a, LAS unsigned char* lds, int widx, int nw, int it_lo, int it_hi) {
    int tid = tid_of(a.wv); asm volatile("" : "+v"(tid)); const int lane = tid & 63, wave = __builtin_amdgcn_readfirstlane(tid >> 6);
    LAS float* scr = (LAS float*)(lds + wave * 16384);
    unsigned char* ws = a.ws;
    constexpr int S_EXP = 16 * 16 * 32;
    for (int r = it_lo + widx; r < it_hi; r += nw) {
        const int which = r / S_EXP, q = r % S_EXP, e = q / 512, kb = (q % 512) / 32, nb = q % 32, n0 = nb * 32;
        if (which == 0) transpose_item<true>(a.in[I_WEG] + (size_t)e * D * FF, FF, (bf16_t*)(ws + WS_WGUT + (size_t)e * 2048 * D), D, kb * 64, n0, (n0 >> 7) * 256 + (n0 & 127), scr, lane);
        else if (which == 1) transpose_item<true>(a.in[I_WEU] + (size_t)e * D * FF, FF, (bf16_t*)(ws + WS_WGUT + (size_t)e * 2048 * D), D, kb * 64, n0, (n0 >> 7) * 256 + 128 + (n0 & 127), scr, lane);
        else transpose_item<true>(a.in[I_WED] + (size_t)e * FF * D, D, (bf16_t*)(ws + WS_WDT + (size_t)e * D * FF), FF, kb * 64, n0, n0, scr, lane);
    }
}

__device__ __forceinline__ void rms_row_to_bf16(const float* xrow, const float* g, bf16_t* orow, int lane) {
    const f32x4* xr = (const f32x4*)xrow + lane; const f32x4* gr = (const f32x4*)g + lane;
    f32x4 v[4]; float s = 0.f;
#pragma unroll
    for (int j = 0; j < 4; ++j) { v[j] = xr[64 * j]; s += (v[j].x * v[j].x + v[j].y * v[j].y) + (v[j].z * v[j].z + v[j].w * v[j].w); }
    const float rs = 1.0f / sqrtf(wave_sum(s) * (1.f / D) + 1e-6f);
    u32x2* o8 = (u32x2*)orow + lane;
#pragma unroll
    for (int j = 0; j < 4; ++j) { const f32x4 gg = gr[64 * j]; u32x2 w; w.x = pk_bf16(v[j].x * rs * gg.x, v[j].y * rs * gg.y); w.y = pk_bf16(v[j].z * rs * gg.z, v[j].w * rs * gg.w); o8[64 * j] = w; }
}
__device__ __forceinline__ void phase_prep(const Args& a, LAS unsigned char* lds, int G) {
    int tid = tid_of(a.wv); asm volatile("" : "+v"(tid)); const int lane = tid & 63, wave = __builtin_amdgcn_readfirstlane(tid >> 6);
    LAS float* scr = (LAS float*)(lds + wave * 16384);
    const int gw = blockIdx.x * 8 + wave, NGW = G * 8;
    unsigned char* ws = a.ws;
    constexpr int S_WIN = 16 * 80, S_WOUT = 16 * 32, S_MK = 16 * 8, S_SM = 12, S_GUP = 24;
    constexpr int NITEMS = S_WIN + S_WOUT + 2 * S_MK + 4 * S_SM + S_GUP;
    for (int it = gw; it < NITEMS; it += NGW) {
        int r = it;
        if (r < S_WIN) { const int kb = r / 80, nb = r % 80; transpose_item(a.in[I_WIN], IN_PROJ, (bf16_t*)(ws + WS_WINT), D, kb * 64, nb * 32, nb * 32, scr, lane); continue; } r -= S_WIN;
        if (r < S_WOUT) { const int kb = r / 32, nb = r % 32; transpose_item(a.in[I_WOUT], D, (bf16_t*)(ws + WS_WOUTT), D, kb * 64, nb * 32, nb * 32, scr, lane); continue; } r -= S_WOUT;
        if (r < S_MK) { const int kb = r / 8, nb = r % 8; transpose_item(a.in[I_WMK], 256, (bf16_t*)(ws + WS_WKT), D, kb * 64, nb * 32, nb * 32, scr, lane); continue; } r -= S_MK;
        if (r < S_MK) { const int kb = r / 8, nb = r % 8; transpose_item(a.in[I_WMV], 256, (bf16_t*)(ws + WS_WVT), D, kb * 64, nb * 32, nb * 32, scr, lane); continue; } r -= S_MK;
        if (r < 4 * S_SM) { const int which = r / S_SM, nb = r % S_SM;
            const float* src = (which < 2 ? a.in[I_DUP] : a.in[I_IUP]) + (size_t)(which & 1) * 64 * RW;
            transpose_item(src, RW, (bf16_t*)(ws + WS_SMALL) + (size_t)which * RW * 64, 64, 0, nb * 32, nb * 32, scr, lane); continue; } r -= 4 * S_SM;
        { const int kb = r / 12, nb = r % 12; transpose_item(a.in[I_GUP], RW, (bf16_t*)(ws + WS_SMALL) + (size_t)4 * RW * 64, 128, kb * 64, nb * 32, nb * 32, scr, lane); }
    }
    for (int m = gw; m < T; m += NGW) rms_row_to_bf16(a.in[I_X] + (size_t)m * D, a.in[I_NMIXG], (bf16_t*)(ws + WS_XH) + (size_t)m * D, lane);
    for (int m = gw; m < BATCH * NMEM; m += NGW) rms_row_to_bf16(a.in[I_MEM] + (size_t)m * D, a.in[I_NMEMG], (bf16_t*)(ws + WS_MEMN) + (size_t)m * D, lane);
}

constexpr int AT_KS = 144;
constexpr int AT_VS = 520;
constexpr int AT_VOFF = 256 * AT_KS;
__device__ __forceinline__ bf16x8 pack_step(const f32x16& x, int s) {
    u32x4 p;
    asm volatile("v_cvt_pk_bf16_f32 %0, %4, %5\n\tv_cvt_pk_bf16_f32 %1, %6, %7\n\tv_cvt_pk_bf16_f32 %2, %8, %9\n\tv_cvt_pk_bf16_f32 %3, %10, %11\n\ts_nop 1"
                 : "=&v"(p[0]), "=&v"(p[1]), "=&v"(p[2]), "=&v"(p[3])
                 : "v"(x[8 * s]), "v"(x[8 * s + 1]), "v"(x[8 * s + 2]), "v"(x[8 * s + 3]), "v"(x[8 * s + 4]), "v"(x[8 * s + 5]), "v"(x[8 * s + 6]), "v"(x[8 * s + 7]));
    return __builtin_bit_cast(bf16x8, p);
}
__device__ __forceinline__ void attn_unit(const Args& a, LAS unsigned char* lds, int unit) {
    int tid = tid_of(a.wv); asm volatile("" : "+v"(tid)); const int lane = tid & 63, wave = __builtin_amdgcn_readfirstlane(tid >> 6), r = lane & 31, h = lane >> 5;
    const int b = unit >> 2, hh = unit & 3;
    const bf16_t* Qb = (const bf16_t*)(a.ws + WS_Q); const bf16_t* KM = (const bf16_t*)(a.ws + WS_KMEM); const bf16_t* VT = (const bf16_t*)(a.ws + WS_VT);
    bf16_t* MIX = (bf16_t*)(a.ws + WS_MIX);
    __syncthreads();
#pragma unroll
    for (int i = 0; i < 4; ++i) { const int c = tid + 512 * i, key = c >> 3, ch = c & 7;
        const u32x4 v = *(const u32x4*)(KM + (size_t)(b * NMEM + key) * 256 + hh * 64 + ch * 8);
        *(LAS u32x4*)(lds + key * AT_KS + ch * 16) = v; }
#pragma unroll
    for (int i = 0; i < 4; ++i) { const int c = tid + 512 * i, d = c >> 5, ch = c & 31;
        const u32x4 v = *(const u32x4*)(VT + (size_t)(hh * 64 + d) * (BATCH * NMEM) + b * NMEM + ch * 8);
        LAS u32x2* dst = (LAS u32x2*)(lds + AT_VOFF + d * AT_VS + ch * 16);
        dst[0] = (u32x2){v.x, v.y}; dst[1] = (u32x2){v.z, v.w}; }
    __syncthreads();
#pragma unroll 1
    for (int tile = 0; tile < 16; ++tile) {
    const int tok0 = b * SEQ + tile * 256 + wave * 32;
    bf16x8 qf[4];
#pragma unroll
    for (int ks = 0; ks < 4; ++ks) qf[ks] = *(const bf16x8*)(Qb + (size_t)(tok0 + r) * 256 + hh * 64 + ks * 16 + h * 8);
    const float sc = 0.125f * 1.4426950408889634f;
    float m_run = -3.0e38f, sum = 0.f;
    f32x16 o[2];
#pragma unroll
    for (int dt = 0; dt < 2; ++dt)
#pragma unroll
        for (int i = 0; i < 16; ++i) o[dt][i] = 0.f;
#pragma unroll 1
    for (int kh = 0; kh < 2; ++kh) {
        f32x16 s[4];
#pragma unroll
        for (int k4 = 0; k4 < 4; ++k4) {
#pragma unroll
            for (int i = 0; i < 16; ++i) s[k4][i] = 0.f;
#pragma unroll
            for (int ks = 0; ks < 4; ++ks) { const bf16x8 ka = *(const LAS bf16x8*)(lds + ((kh * 4 + k4) * 32 + r) * AT_KS + (ks * 16 + h * 8) * 2);
                s[k4] = __builtin_amdgcn_mfma_f32_32x32x16_bf16(ka, qf[ks], s[k4], 0, 0, 0); }
        }
        float mx = m_run;
#pragma unroll
        for (int k4 = 0; k4 < 4; ++k4)
#pragma unroll
            for (int i = 0; i < 16; ++i) mx = fmaxf(mx, s[k4][i]);
        mx = fmaxf(mx, __shfl_xor(mx, 32));
        const float alpha = __builtin_amdgcn_exp2f((m_run - mx) * sc);
        float ps = 0.f;
#pragma unroll
        for (int k4 = 0; k4 < 4; ++k4)
#pragma unroll
            for (int i = 0; i < 16; ++i) { const float e = __builtin_amdgcn_exp2f((s[k4][i] - mx) * sc); s[k4][i] = e; ps += e; }
        ps += __shfl_xor(ps, 32);
        sum = sum * alpha + ps; m_run = mx;
#pragma unroll
        for (int dt = 0; dt < 2; ++dt)
#pragma unroll
            for (int i = 0; i < 16; ++i) o[dt][i] *= alpha;
#pragma unroll
        for (int k4 = 0; k4 < 4; ++k4)
#pragma unroll
            for (int s2 = 0; s2 < 2; ++s2) {
                const bf16x8 pb = pack_step(s[k4], s2);
#pragma unroll
                for (int dt = 0; dt < 2; ++dt) {
                    const LAS unsigned char* vp = lds + AT_VOFF + (32 * dt + r) * AT_VS + (32 * (kh * 4 + k4) + 16 * s2 + 4 * h) * 2;
                    const s16x4 lo = *(const LAS s16x4*)vp, hi = *(const LAS s16x4*)(vp + 16);
                    const bf16x8 va = __builtin_shufflevector(lo, hi, 0, 1, 2, 3, 4, 5, 6, 7);
                    o[dt] = __builtin_amdgcn_mfma_f32_32x32x16_bf16(va, pb, o[dt], 0, 0, 0);
                }
            }
    }
    const float inv = 1.0f / sum;
    bf16_t* orow = MIX + (size_t)(tok0 + r) * D + hh * 64;
#pragma unroll
    for (int dt = 0; dt < 2; ++dt)
#pragma unroll
        for (int gq = 0; gq < 4; ++gq) { u32x2 w; w.x = pk_bf16(o[dt][4 * gq] * inv, o[dt][4 * gq + 1] * inv); w.y = pk_bf16(o[dt][4 * gq + 2] * inv, o[dt][4 * gq + 3] * inv);
            *(u32x2*)(orow + 32 * dt + 8 * gq + 4 * h) = w; }
    }
}

constexpr int CV_U = 0, CV_C = 94 * 384 * 2, CV_W = CV_C + 64 * 384 * 2, CV_PRM = CV_W + 31 * 384 * 2;
static_assert(CV_PRM + 3 * 384 * 4 <= LDS_BYTES - 512, "conv LDS map");
__device__ __forceinline__ void conv_stream(const Args& a, LAS unsigned char* lds, int u0, int G) {
    int tid = tid_of(a.wv); asm volatile("" : "+v"(tid)); const int lane = tid & 63, wave = __builtin_amdgcn_readfirstlane(tid >> 6);
    if (u0 >= 1024) return;
    const bf16_t* P = (const bf16_t*)(a.ws + WS_P); bf16_t* MIX = (bf16_t*)(a.ws + WS_MIX);
    LAS _Float16* U = (LAS _Float16*)(lds + CV_U);
    LAS _Float16* Cc = (LAS _Float16*)(lds + CV_C);
    LAS _Float16* W16 = (LAS _Float16*)(lds + CV_W); LAS float* PRM = (LAS float*)(lds + CV_PRM);
    __syncthreads();
    for (int i = tid; i < 31 * CW; i += NTHREADS) W16[i] = (_Float16)a.in[I_CONVW][i];
    for (int i = tid; i < 3 * CW; i += NTHREADS) PRM[i] = (i < CW) ? a.in[I_CONVB][i] : (i < 2 * CW) ? a.in[I_CLNG][i - CW] : a.in[I_CLNB][i - 2 * CW];
    u32x4 vvv[9], ggg[9];
#define CONV_LOAD(un_) do { const int b_ = (un_) >> 6, t0_ = ((un_) & 63) * 64; \
        _Pragma("unroll") for (int u9 = 0; u9 < 9; ++u9) { const int q = tid + u9 * NTHREADS, j = q / 48, cc = (q % 48) * 8, sq = t0_ - 15 + j; const bool ok = (q < 94 * 48) && sq >= 0 && sq < SEQ; \
            const bf16_t* row = P + (size_t)(b_ * SEQ + (ok ? sq : 0)) * PLD + cc; \
            vvv[u9] = ok ? *(const u32x4*)row : (u32x4){0u, 0u, 0u, 0u}; ggg[u9] = ok ? *(const u32x4*)(row + CW) : (u32x4){0u, 0u, 0u, 0u}; } } while (0)
    CONV_LOAD(u0);
#pragma unroll 1
    for (int unit = u0; unit < 1024; unit += G) {
        const int b = unit >> 6, t0 = (unit & 63) * 64;
        __syncthreads();
#pragma unroll
        for (int u9 = 0; u9 < 9; ++u9) { const int q = tid + u9 * NTHREADS, j = q / 48, cc = (q % 48) * 8;
            if (q < 94 * 48) {
                const unsigned vw[4] = {vvv[u9].x, vvv[u9].y, vvv[u9].z, vvv[u9].w}, gw[4] = {ggg[u9].x, ggg[u9].y, ggg[u9].z, ggg[u9].w};
                float u[8];
#pragma unroll
                for (int k = 0; k < 4; ++k) { u[2 * k] = bf_lo(vw[k]) * sigmoidf_fast(bf_lo(gw[k])); u[2 * k + 1] = bf_hi(vw[k]) * sigmoidf_fast(bf_hi(gw[k])); }
                LAS f16x4* dst = (LAS f16x4*)(U + j * CW + cc); dst[0] = (f16x4){(_Float16)u[0], (_Float16)u[1], (_Float16)u[2], (_Float16)u[3]}; dst[1] = (f16x4){(_Float16)u[4], (_Float16)u[5], (_Float16)u[6], (_Float16)u[7]}; }
        }
        if (unit + G < 1024) CONV_LOAD(unit + G);
        __syncthreads();
#pragma unroll 1
        for (int k3 = 0; k3 < 3; ++k3) { const int it = tid + k3 * NTHREADS, c = 2 * (it % 192), g8 = (it / 192) * 8;
            f16x2 w2[31], res[8];
#pragma unroll
            for (int kk = 0; kk < 31; ++kk) w2[kk] = *(const LAS f16x2*)(W16 + kk * CW + c);
            const f16x2 bias2 = {(_Float16)PRM[c], (_Float16)PRM[c + 1]};
#pragma unroll
            for (int tt = 0; tt < 8; ++tt) res[tt] = bias2;
#pragma unroll
            for (int jj = 0; jj < 38; ++jj) { const f16x2 uv = *(const LAS f16x2*)(U + (g8 + jj) * CW + c);
#pragma unroll
                for (int tt = 0; tt < 8; ++tt) { if (jj - tt >= 0 && jj - tt <= 30) res[tt] += uv * w2[jj - tt]; } }
#pragma unroll
            for (int tt = 0; tt < 8; ++tt) *(LAS f16x2*)(Cc + (g8 + tt) * CW + c) = res[tt];
        }
        __syncthreads();
        for (int tt = 0; tt < 8; ++tt) { const int t = wave * 8 + tt;
            float v[6]; float sm = 0.f;
#pragma unroll
            for (int i = 0; i < 6; ++i) { v[i] = (float)Cc[t * CW + lane + 64 * i]; sm += v[i]; }
            const float mean = wave_sum(sm) * (1.f / CW); float q = 0.f;
#pragma unroll
            for (int i = 0; i < 6; ++i) { v[i] -= mean; q += v[i] * v[i]; }
            const float rstd = 1.0f / sqrtf(wave_sum(q) * (1.f / CW) + 1e-5f);
            bf16_t* orow = MIX + (size_t)(b * SEQ + t0 + t) * D + 256;
#pragma unroll
            for (int i = 0; i < 6; ++i) { const int c = lane + 64 * i; const float y = v[i] * rstd * PRM[CW + c] + PRM[2 * CW + c]; const float o = y * sigmoidf_fast(y);
                orow[c] = (bf16_t)(pk_bf16(o, 0.f) & 0xffffu); }
        }
    }
#undef CONV_LOAD
}

constexpr int PR_AS = 784;
constexpr int PR_RK = 64 * PR_AS;
constexpr int PR_RKS = 1536;
constexpr int PR_RN = PR_RK + 64 * PR_RKS;
constexpr int PR_CST = PR_RN + 2048;
static_assert(PR_CST + 7 * 384 * 4 <= LDS_BYTES - 64, "prep LDS map");
template <int V> struct IC { static constexpr int value = V; };
template <int CTRL> __device__ __forceinline__ f32x4 dpp4(f32x4 x) { return (f32x4){dpp_f<CTRL>(x.x), dpp_f<CTRL>(x.y), dpp_f<CTRL>(x.z), dpp_f<CTRL>(x.w)}; }
__device__ __forceinline__ void prep_unit(const Args& a, LAS unsigned char* lds, int unit) {
    int tid = tid_of(a.wv); asm volatile("" : "+v"(tid)); const int lane = tid & 63, wave = __builtin_amdgcn_readfirstlane(tid >> 6);
    const int b = unit >> 6, t0 = (unit & 63) * 64;
    const bf16_t* __restrict__ P = (const bf16_t*)(a.ws + WS_P);
    const float* __restrict__ mu = a.in[I_SHIFTMU];
    LAS float* RNs = (LAS float*)(lds + PR_RN); LAS float* CST = (LAS float*)(lds + PR_CST);
    __syncthreads();
    for (int i = tid; i < 7 * 384; i += NTHREADS) { const int w7 = i / 384, c7 = i % 384;
        CST[i] = (w7 == 0) ? a.in[I_KK][c7] : (w7 == 1) ? a.in[I_KA][c7] : (w7 == 2) ? a.in[I_RK][c7] : (w7 < 5) ? a.in[I_DW0][(w7 - 3) * RW + c7] : a.in[I_IA0][(w7 - 5) * RW + c7]; }
#ifndef PREP_REP1
#define PREP_REP1 1
#endif
    struct S1Buf { u32x4 cu[2], pv[2], nv[2]; f32x4 m0a, m0b, m1a, m1b, ka, kb; };
    const int s1row = 8 * wave + (lane >> 4), s1c = lane & 15;
    auto s1_issue = [&](auto sc, S1Buf& B) {
        constexpr int sb = decltype(sc)::value, ty = (sb / 3 == 0) ? 2 : (sb / 3 == 1) ? 0 : (sb / 3 == 2) ? 1 : 3, cg = sb % 3;
        const int c8 = ty * 384 + (cg * 16 + s1c) * 8;
#pragma unroll
        for (int th = 0; th < 2; ++th) { const int sq = t0 + s1row + 4 * th;
            const bf16_t* row = P + ((size_t)b * SEQ + sq) * PLD + 768 + c8;
            B.cu[th] = *(const u32x4*)row;
            B.pv[th] = (sq > 0) ? *(const u32x4*)(row - PLD) : (u32x4){0u, 0u, 0u, 0u};
            B.nv[th] = (sq < SEQ - 1) ? *(const u32x4*)(row + PLD) : (u32x4){0u, 0u, 0u, 0u}; }
        B.m0a = *(const f32x4*)(mu + c8); B.m0b = *(const f32x4*)(mu + c8 + 4); B.m1a = *(const f32x4*)(mu + 1536 + c8); B.m1b = *(const f32x4*)(mu + 1536 + c8 + 4);
        if (ty == 1) { B.ka = *(const f32x4*)(a.in[I_KK] + c8 - 384); B.kb = *(const f32x4*)(a.in[I_KK] + c8 - 384 + 4); }
    };
    auto s1_compute = [&](auto sc, const S1Buf& B) {
        constexpr int sb = decltype(sc)::value, ty = (sb / 3 == 0) ? 2 : (sb / 3 == 1) ? 0 : (sb / 3 == 2) ? 1 : 3, cg = sb % 3;
        const int c8 = ty * 384 + (cg * 16 + s1c) * 8;
        const float m0[8] = {B.m0a.x, B.m0a.y, B.m0a.z, B.m0a.w, B.m0b.x, B.m0b.y, B.m0b.z, B.m0b.w}, m1[8] = {B.m1a.x, B.m1a.y, B.m1a.z, B.m1a.w, B.m1b.x, B.m1b.y, B.m1b.z, B.m1b.w};
#pragma unroll
        for (int th = 0; th < 2; ++th) { const int tt = s1row + 4 * th; const size_t tok = (size_t)b * SEQ + t0 + tt;
            const u32x4 cu = B.cu[th], pv = B.pv[th], nv = B.nv[th];
            const unsigned cw[4] = {cu.x, cu.y, cu.z, cu.w}, pw[4] = {pv.x, pv.y, pv.z, pv.w}, nw[4] = {nv.x, nv.y, nv.z, nv.w};
            float pf[8];
#pragma unroll
            for (int k = 0; k < 4; ++k) { const float c0 = bf_lo(cw[k]), c1 = bf_hi(cw[k]);
                pf[2 * k] = c0 + m0[2 * k] * (bf_lo(pw[k]) - c0) + m1[2 * k] * (bf_lo(nw[k]) - c0);
                pf[2 * k + 1] = c1 + m0[2 * k + 1] * (bf_hi(pw[k]) - c1) + m1[2 * k + 1] * (bf_hi(nw[k]) - c1); }
            if (ty < 2) {
                f16x4 h0 = {(_Float16)pf[0], (_Float16)pf[1], (_Float16)pf[2], (_Float16)pf[3]}, h1 = {(_Float16)pf[4], (_Float16)pf[5], (_Float16)pf[6], (_Float16)pf[7]};
                LAS f16x4* dst = (LAS f16x4*)(lds + PR_RK + tt * PR_RKS + c8 * 2); dst[0] = h0; dst[1] = h1;
                if (ty == 1) { const f32x4 ka = B.ka, kb = B.kb;
                    float ssq = (pf[0] * ka.x) * (pf[0] * ka.x) + (pf[1] * ka.y) * (pf[1] * ka.y) + (pf[2] * ka.z) * (pf[2] * ka.z) + (pf[3] * ka.w) * (pf[3] * ka.w)
                              + (pf[4] * kb.x) * (pf[4] * kb.x) + (pf[5] * kb.y) * (pf[5] * kb.y) + (pf[6] * kb.z) * (pf[6] * kb.z) + (pf[7] * kb.w) * (pf[7] * kb.w);
                    ssq = sum8(ssq);
                    if ((lane & 7) == 0) RNs[tt * 8 + ((c8 - 384) >> 6)] = __builtin_amdgcn_rsqf(ssq + 1e-12f); }
            } else if (ty == 2) {
                u32x4 w; w.x = pk_bf16(pf[0], pf[1]); w.y = pk_bf16(pf[2], pf[3]); w.z = pk_bf16(pf[4], pf[5]); w.w = pk_bf16(pf[6], pf[7]);
                *(u32x4*)((bf16_t*)scan_arr(a.ws, 0) + hat_off(0, tok, c8 - 768)) = w;
            } else {
                const int cc = c8 - 1152;
#pragma unroll
                for (int k = 0; k < 8; ++k) { if (cg == 0) pf[k] = 1.0f - 2.0f * __builtin_amdgcn_rcpf(1.0f + __builtin_amdgcn_exp2f(2.8853900817779268f * pf[k])); else if (cg == 2) pf[k] = sigmoidf_fast(pf[k]); }
                u32x4 w; w.x = pk_bf16(pf[0], pf[1]); w.y = pk_bf16(pf[2], pf[3]); w.z = pk_bf16(pf[4], pf[5]); w.w = pk_bf16(pf[6], pf[7]);
                *(LAS u32x4*)(lds + tt * PR_AS + cc * 2) = w; }
        }
    };
#pragma unroll 1
    for (int rp1 = 0; rp1 < PREP_REP1; ++rp1) {
        S1Buf B0, B1, B2;
        s1_issue(IC<0>{}, B0); s1_issue(IC<1>{}, B1);
        s1_issue(IC<2>{}, B2); s1_compute(IC<0>{}, B0);
        s1_issue(IC<3>{}, B0); s1_compute(IC<1>{}, B1);
        s1_issue(IC<4>{}, B1); s1_compute(IC<2>{}, B2);
        s1_issue(IC<5>{}, B2); s1_compute(IC<3>{}, B0);
        s1_issue(IC<6>{}, B0); s1_compute(IC<4>{}, B1);
        s1_issue(IC<7>{}, B1); s1_compute(IC<5>{}, B2);
        s1_issue(IC<8>{}, B2); s1_compute(IC<6>{}, B0);
        s1_issue(IC<9>{}, B0); s1_compute(IC<7>{}, B1);
        s1_issue(IC<10>{}, B1); s1_compute(IC<8>{}, B2);
        s1_issue(IC<11>{}, B2); s1_compute(IC<9>{}, B0);
        s1_compute(IC<10>{}, B1); s1_compute(IC<11>{}, B2);
    }
    __syncthreads();
    const int l15 = lane & 15, kq = lane >> 4;
    float* __restrict__ PCg = (float*)(a.ws + WS_PC); float* __restrict__ BON = (float*)(a.ws + WS_BON);
    const char* SMb = (const char*)(a.ws + WS_SMALL);
    const unsigned wlo64 = (unsigned)(((8 * (l15 >> 2) + (l15 & 3)) * 64 + kq * 8) * 2), wlo128 = (unsigned)(((8 * (l15 >> 2) + (l15 & 3)) * 128 + kq * 8) * 2);
    const unsigned hlo = (unsigned)((l15 * 64 + 8 * kq) * 2), klo = (unsigned)((l15 * D + 8 * kq) * 2), glo = (unsigned)((l15 * RW + 8 * kq) * 2);
    bf16x8 Fc[16], Fn[16];
#define PREP_LOADW(hd_, kind_) do { \
        if ((kind_) < 2) { const char* w_ = SMb + ((size_t)(kind_) * RW * 64 + (size_t)(hd_) * 64 * 64) * 2; \
            _Pragma("unroll") for (int f_ = 0; f_ < 16; ++f_) Fn[f_] = *(const bf16x8*)(w_ + (size_t)(((f_ >> 2) & 1) * (2 * RW * 64 * 2) + (32 * ((f_ & 3) >> 1) + 4 * (f_ & 1)) * 128 + (f_ >> 3) * 64) + wlo64); } \
        else { const char* w_ = SMb + ((size_t)4 * RW * 64 + (size_t)(hd_) * 64 * 128) * 2; \
            _Pragma("unroll") for (int f_ = 0; f_ < 16; ++f_) Fn[f_] = *(const bf16x8*)(w_ + (size_t)((32 * ((f_ & 3) >> 1) + 4 * (f_ & 1)) * 256 + (f_ >> 2) * 64) + wlo128); } } while (0)
    auto dir_stage = [&](auto dc, const int it, const int nhd, const int nkind) {
        constexpr int d = decltype(dc)::value;
        const int hd = it >> 2, mt = it & 3, tokl = mt * 16 + l15; const size_t tb = (size_t)b * SEQ + t0 + mt * 16;
#pragma unroll
        for (int f = 0; f < 16; ++f) Fc[f] = Fn[f];
        f32x4 accW[4], accA[4];
#pragma unroll
        for (int nt = 0; nt < 4; ++nt) { accW[nt] = (f32x4){0.f, 0.f, 0.f, 0.f}; accA[nt] = (f32x4){0.f, 0.f, 0.f, 0.f}; }
#pragma unroll
        for (int ks = 0; ks < 2; ++ks) {
            const bf16x8 aw = *(const LAS bf16x8*)(lds + tokl * PR_AS + (d * 64 + ks * 32 + kq * 8) * 2), aa = *(const LAS bf16x8*)(lds + tokl * PR_AS + ((2 + d) * 64 + ks * 32 + kq * 8) * 2);
#pragma unroll
            for (int nt = 0; nt < 4; ++nt) { accW[nt] = MFMA16(Fc[ks * 8 + nt], aw, accW[nt]); accA[nt] = MFMA16(Fc[ks * 8 + 4 + nt], aa, accA[nt]); }
        }
        if (nkind >= 0) PREP_LOADW(nhd, nkind);
        const float rn = RNs[tokl * 8 + hd];
        const size_t tile_b = ((((tb >> 4) * NH + hd) << 10)) * 2;
        char* AHb = (char*)scan_arr(a.ws, 1 + 4 * d) + tile_b; char* RHb = (char*)scan_arr(a.ws, 2 + 4 * d) + tile_b; char* BHb = (char*)scan_arr(a.ws, 3 + 4 * d) + tile_b;
        char* KHb = d ? (char*)scan_arr(a.ws, 8) + (tb * D + hd * 64) * 2 : (char*)scan_arr(a.ws, 4) + tile_b; const unsigned khlo = d ? klo : hlo;
        char* PCb = (char*)(PCg + ((size_t)d * (T / 16) + (tb >> 4)) * RW + hd * 64); char* BOb = (char*)(BON + (size_t)d * T * NH + tb * NH + hd);
        float bsum = 0.f; const float first1 = (l15 == (d ? 15 : 0)) ? 1.f : 0.f;
        u32x2 hA[2], hR[2], hB[2], hK[2]; f32x4 PtS[4];
#pragma unroll
        for (int nt = 0; nt < 4; ++nt) { const int ch = hd * 64 + 32 * (nt >> 1) + 8 * kq + 4 * (nt & 1);
            const f32x4 bW = *(const LAS f32x4*)(CST + (3 + d) * 384 + ch), bA = *(const LAS f32x4*)(CST + (5 + d) * 384 + ch);
            const f32x4 kkw = *(const LAS f32x4*)(CST + ch), kaw = *(const LAS f32x4*)(CST + 384 + ch), rkw = *(const LAS f32x4*)(CST + 768 + ch);
            const f32x4 zw = accW[nt] + bW, za = accA[nt] + bA;
            f32x4 lw, av;
#pragma unroll
            for (int e = 0; e < 4; ++e) { lw[e] = -0.606531f * 1.4426950408889634f * sigmoidf_fast(zw[e]); av[e] = sigmoidf_fast(za[e]); }
            f32x4 cum = lw;
#define PREP_CUM4(SH) "v_add_f32_dpp %0, %0, %0 " SH " row_mask:0xf bank_mask:0xf bound_ctrl:1\n\tv_add_f32_dpp %1, %1, %1 " SH " row_mask:0xf bank_mask:0xf bound_ctrl:1\n\t" \
                      "v_add_f32_dpp %2, %2, %2 " SH " row_mask:0xf bank_mask:0xf bound_ctrl:1\n\tv_add_f32_dpp %3, %3, %3 " SH " row_mask:0xf bank_mask:0xf bound_ctrl:1\n\t"
            if (d == 0) asm volatile("s_nop 1\n\t" PREP_CUM4("row_shr:1") PREP_CUM4("row_shr:2") PREP_CUM4("row_shr:4") PREP_CUM4("row_shr:8") : "+v"(cum.x), "+v"(cum.y), "+v"(cum.z), "+v"(cum.w));
            else        asm volatile("s_nop 1\n\t" PREP_CUM4("row_shl:1") PREP_CUM4("row_shl:2") PREP_CUM4("row_shl:4") PREP_CUM4("row_shl:8") : "+v"(cum.x), "+v"(cum.y), "+v"(cum.z), "+v"(cum.w));
#undef PREP_CUM4
            f32x4 Pt, Pinv, Pprev;
#pragma unroll
            for (int e = 0; e < 4; ++e) { Pt[e] = __builtin_amdgcn_exp2f(cum[e]); Pinv[e] = __builtin_amdgcn_rcpf(Pt[e]);
                Pprev[e] = dpp_f<d ? 0x101 : 0x111>(Pt[e]) + first1; }
            PtS[nt] = Pt;
            const f32x4 r4 = __builtin_convertvector(*(const LAS f16x4*)(lds + PR_RK + tokl * PR_RKS + ch * 2), f32x4);
            const f32x4 k4 = __builtin_convertvector(*(const LAS f16x4*)(lds + PR_RK + tokl * PR_RKS + (384 + ch) * 2), f32x4);
            const f32x4 kk = k4 * kkw * rn, kd = k4 * (1.0f + (av - 1.0f) * kaw);
            hA[nt & 1] = f32_to_bf4(-kk * Pprev); hR[nt & 1] = f32_to_bf4(r4 * Pt); hB[nt & 1] = f32_to_bf4(kk * av * Pinv); hK[nt & 1] = f32_to_bf4(kd * Pinv);
            const f32x4 bt = r4 * kd * rkw; bsum += (bt.x + bt.y) + (bt.z + bt.w);
            if (nt & 1) { const int pr = nt >> 1;
                *(u32x4*)(AHb + (hlo + 64 * pr)) = (u32x4){hA[0].x, hA[0].y, hA[1].x, hA[1].y}; *(u32x4*)(RHb + (hlo + 64 * pr)) = (u32x4){hR[0].x, hR[0].y, hR[1].x, hR[1].y};
                *(u32x4*)(BHb + (hlo + 64 * pr)) = (u32x4){hB[0].x, hB[0].y, hB[1].x, hB[1].y}; *(u32x4*)(KHb + (khlo + 64 * pr)) = (u32x4){hK[0].x, hK[0].y, hK[1].x, hK[1].y}; }
        }
        if (l15 == (d ? 0 : 15)) {
#pragma unroll
            for (int nt = 0; nt < 4; ++nt) *(f32x4*)(PCb + (unsigned)(8 * kq * 4) + (32 * (nt >> 1) + 4 * (nt & 1)) * 4) = PtS[nt]; }
        bsum += __shfl_xor(bsum, 16); bsum += __shfl_xor(bsum, 32);
        if (kq == 0) *(float*)(BOb + (unsigned)(l15 * NH * 4)) = bsum;
    };
    auto gate_stage = [&](const int it, const int nhd, const int nkind) {
        const int hd = it >> 2, mt = it & 3, tokl = mt * 16 + l15; const size_t tb = (size_t)b * SEQ + t0 + mt * 16;
#pragma unroll
        for (int f = 0; f < 16; ++f) Fc[f] = Fn[f];
        f32x4 acc[4];
#pragma unroll
        for (int nt = 0; nt < 4; ++nt) acc[nt] = (f32x4){0.f, 0.f, 0.f, 0.f};
#pragma unroll
        for (int ks = 0; ks < 4; ++ks) { const bf16x8 afr = *(const LAS bf16x8*)(lds + tokl * PR_AS + (256 + ks * 32 + kq * 8) * 2);
#pragma unroll
            for (int nt = 0; nt < 4; ++nt) acc[nt] = MFMA16(Fc[ks * 4 + nt], afr, acc[nt]); }
        if (nkind >= 0) PREP_LOADW(nhd, nkind);
        char* Gb = (char*)((bf16_t*)(a.ws + WS_G) + tb * RW + hd * 64);
#pragma unroll
        for (int pr = 0; pr < 2; ++pr) { const u32x2 g0 = f32_to_bf4(acc[2 * pr]), g1 = f32_to_bf4(acc[2 * pr + 1]);
            *(u32x4*)(Gb + (glo + 64 * pr)) = (u32x4){g0.x, g0.y, g1.x, g1.y}; }
    };
    PREP_LOADW(wave >> 2, 0);
#pragma unroll 1
    for (int k3 = 0; k3 < 3; ++k3) { const int it = wave + 8 * k3, hd = it >> 2;
        dir_stage(IC<0>{}, it, hd, 1);
        dir_stage(IC<1>{}, it, hd, 2);
        gate_stage(it, (it + 8) >> 2, k3 < 2 ? 0 : -1);
    }
#undef PREP_LOADW
}

__device__ __forceinline__ void glds16_asm(const void* gptr, LAS unsigned char* ldst) {
    const unsigned la = __builtin_amdgcn_readfirstlane((unsigned)(size_t)ldst);
    asm volatile("s_mov_b32 m0, %1\n\ts_nop 0\n\tglobal_load_lds_dwordx4 %0, off" :: "v"(gptr), "s"(la) : "m0", "memory");
}
constexpr int CK = 16, NCHUNK = SEQ / CK, CS_NS = 8, CS_NPROD = 6, CS_NCONS = 2;
constexpr int SL_ATIL = 0, SL_RTIL = 2048, SL_BH = 4096, SL_KH = 6144, SL_V = 8192, SL_ULOC = 10240, SL_YLOC = 12288, SL_PC = 14336, SL_BYTES = 14592;
constexpr int PS_AH = 0, PS_RH = 2048, PS_BYTES = 4096;
constexpr int CS_PS_OFF = CS_NS * SL_BYTES, CS_FLAG_OFF = CS_PS_OFF + CS_NPROD * PS_BYTES;
static_assert(CS_FLAG_OFF + 64 <= LDS_BYTES - 64, "chunked scan LDS map");
__device__ __forceinline__ int swz(int t, int j) { return t * 128 + ((((j >> 3) ^ (t & 7))) << 4) + ((j & 4) << 1); }
__device__ __forceinline__ void scan_chunked_unit(const Args& a, LAS unsigned char* lds, int unit) {
    int tid = tid_of(a.wv); asm volatile("" : "+v"(tid)); const int lane = tid & 63, wave = __builtin_amdgcn_readfirstlane(tid >> 6);
    const int dir = unit & 1, bh = unit >> 1, b = bh / NH, hd = bh % NH;
    const int c16 = lane & 15, q = lane >> 4, qp = c16 >> 2, pp = c16 & 3;
    volatile LAS unsigned* FULL = (volatile LAS unsigned*)(lds + CS_FLAG_OFF);
    volatile LAS unsigned* DONE = FULL + 8;
    float* Yg = (float*)(a.ws + (dir ? WS_YB : WS_YF));
    __syncthreads();
    if (tid < 16) FULL[tid] = 0u;
    __syncthreads();
    if (wave >= CS_NCONS) {
        const int pw = wave - CS_NCONS;
        LAS unsigned char* ps = lds + CS_PS_OFF + pw * PS_BYTES;
        const bf16_t* ARR[5] = {(const bf16_t*)scan_arr(a.ws, 1 + 4 * dir), (const bf16_t*)scan_arr(a.ws, 2 + 4 * dir), (const bf16_t*)scan_arr(a.ws, 3 + 4 * dir), (const bf16_t*)scan_arr(a.ws, 4 + 4 * dir), (const bf16_t*)scan_arr(a.ws, 0)};
        const int AIDX[5] = {1 + 4 * dir, 2 + 4 * dir, 3 + 4 * dir, 4 + 4 * dir, 0};
        const float* PCg = (const float*)(a.ws + WS_PC) + (size_t)dir * (T / 16) * RW + hd * 64 + lane;
        u32x4 pf[10];
#define CS_ISSUE(cc) do { _Pragma("unroll") for (int ar_ = 0; ar_ < 5; ++ar_) _Pragma("unroll") for (int hf_ = 0; hf_ < 2; ++hf_) { \
            const int row_ = hf_ * 8 + (lane >> 3); const int st_ = (cc) * CK + row_; const int t_ = dir ? (SEQ - 1 - st_) : st_; \
            pf[ar_ * 2 + hf_] = *(const u32x4*)(ARR[ar_] + hat_off(AIDX[ar_], (size_t)b * SEQ + t_, hd * 64 + 8 * ((lane & 7) ^ (row_ & 7)))); } } while (0)
#define CS_PCLOAD(cc) PCg[(size_t)((size_t)b * (SEQ / CK) + (dir ? (NCHUNK - 1 - (cc)) : (cc))) * RW]
        CS_ISSUE(pw);
        float pcn = CS_PCLOAD(pw);
#pragma unroll 1
        for (int c = pw; c < NCHUNK; c += CS_NPROD) {
            const int slot = c % CS_NS; LAS unsigned char* sl = lds + slot * SL_BYTES;
            { unsigned sp = 0; const unsigned want = (unsigned)CS_NCONS * (unsigned)(c / CS_NS); while (DONE[slot] < want) { __builtin_amdgcn_s_sleep(1); if (++sp > (1u << 22)) break; } }
            asm volatile("" ::: "memory");
            *(LAS u32x4*)(ps + PS_AH + lane * 16) = pf[0]; *(LAS u32x4*)(ps + PS_AH + 1024 + lane * 16) = pf[1];
            *(LAS u32x4*)(ps + PS_RH + lane * 16) = pf[2]; *(LAS u32x4*)(ps + PS_RH + 1024 + lane * 16) = pf[3];
            *(LAS u32x4*)(sl + SL_BH + lane * 16) = pf[4]; *(LAS u32x4*)(sl + SL_BH + 1024 + lane * 16) = pf[5];
            *(LAS u32x4*)(sl + SL_KH + lane * 16) = pf[6]; *(LAS u32x4*)(sl + SL_KH + 1024 + lane * 16) = pf[7];
            *(LAS u32x4*)(sl + SL_V + lane * 16) = pf[8]; *(LAS u32x4*)(sl + SL_V + 1024 + lane * 16) = pf[9];
            *(LAS float*)(sl + SL_PC + lane * 4) = pcn;
            if (c + CS_NPROD < NCHUNK) { CS_ISSUE(c + CS_NPROD); pcn = CS_PCLOAD(c + CS_NPROD); }
            asm volatile("s_waitcnt lgkmcnt(0)" ::: "memory");
#ifndef PROD_REP
#define PROD_REP 1
#endif
#pragma unroll 1
            for (int rpp = 0; rpp < PROD_REP; ++rpp) {
            bf16x8 AHf[2], BHf[2], KHf[2], RHf[2];
#pragma unroll
            for (int ks = 0; ks < 2; ++ks) { const int o = swz(c16, 32 * ks + 8 * q);
                AHf[ks] = *(const LAS bf16x8*)(ps + PS_AH + o); RHf[ks] = *(const LAS bf16x8*)(ps + PS_RH + o); BHf[ks] = *(const LAS bf16x8*)(sl + SL_BH + o); KHf[ks] = *(const LAS bf16x8*)(sl + SL_KH + o); }
            f32x4 Mab = {0.f, 0.f, 0.f, 0.f}, Mak = Mab, MrbT = Mab, MrkT = Mab, MabT = Mab;
#pragma unroll
            for (int ks = 0; ks < 2; ++ks) { Mab = MFMA16(AHf[ks], BHf[ks], Mab); MabT = MFMA16(BHf[ks], AHf[ks], MabT); Mak = MFMA16(AHf[ks], KHf[ks], Mak); MrbT = MFMA16(BHf[ks], RHf[ks], MrbT); MrkT = MFMA16(KHf[ks], RHf[ks], MrkT); }
#pragma unroll
            for (int r = 0; r < 4; ++r) { const bool lt = c16 < 4 * q + r, gt = 4 * q + r < c16, le = 4 * q + r <= c16;
                Mab[r] = lt ? Mab[r] : 0.f; Mak[r] = lt ? Mak[r] : 0.f; MabT[r] = gt ? MabT[r] : 0.f; MrbT[r] = le ? MrbT[r] : 0.f; MrkT[r] = le ? MrkT[r] : 0.f; }
            const f32x4 z4 = {0.f, 0.f, 0.f, 0.f};
            const bf16x8 fN = frag_lo4(Mab), fNT = frag_lo4(MabT);
            const f32x4 N2 = MFMA16(fNT, fN, z4), N2T = MFMA16(fN, fNT, z4);
            f32x4 PT = MabT;
#pragma unroll
            for (int r = 0; r < 4; ++r) PT[r] += (4 * q + r == c16) ? 1.0f : 0.f;
            const bf16x8 fN2 = frag_lo4(N2), fN2T = frag_lo4(N2T);
            PT = MFMA16(fN2, frag_lo4(PT), PT);
            const f32x4 N4 = MFMA16(fN2T, fN2, z4), N4T = MFMA16(fN2, fN2T, z4);
            const bf16x8 fN4 = frag_lo4(N4), fN4T = frag_lo4(N4T);
            PT = MFMA16(fN4, frag_lo4(PT), PT);
            const f32x4 N8 = MFMA16(fN4T, fN4, z4);
            PT = MFMA16(frag_lo4(N8), frag_lo4(PT), PT);
            const bf16x8 LinvF = frag_lo4(PT);
            const bf16x8 MakF = frag_lo4(Mak), MrbTF = frag_lo4(MrbT);
            const f32x4 W1 = MFMA16(LinvF, MakF, z4);
            const f32x4 W1T = MFMA16(MakF, LinvF, z4);
            const f32x4 W2T = MFMA16(frag_lo4(W1), MrbTF, MrkT);
            f32x4 AtT[4], RtT[4];
#pragma unroll
            for (int jt = 0; jt < 4; ++jt) {
                const bf16x8 ahF = frag_cat(__builtin_bit_cast(u32x2, tr_read16(ps + PS_AH + swz(4 * q + qp, 16 * jt + 4 * pp))), (u32x2){0u, 0u});
                const f32x4 AtN = MFMA16(LinvF, ahF, z4);
                AtT[jt] = MFMA16(ahF, LinvF, z4);
                const f32x4 rinit = bf4_to_f32(*(const LAS u32x2*)(ps + PS_RH + swz(c16, 16 * jt + 4 * q)));
                RtT[jt] = MFMA16(frag_lo4(AtN), MrbTF, rinit);
            }
#pragma unroll
            for (int ks = 0; ks < 2; ++ks) {
                const u32x4 wa = {pk_bf16(AtT[2 * ks][0], AtT[2 * ks][1]), pk_bf16(AtT[2 * ks][2], AtT[2 * ks][3]), pk_bf16(AtT[2 * ks + 1][0], AtT[2 * ks + 1][1]), pk_bf16(AtT[2 * ks + 1][2], AtT[2 * ks + 1][3])};
                const u32x4 wr = {pk_bf16(RtT[2 * ks][0], RtT[2 * ks][1]), pk_bf16(RtT[2 * ks][2], RtT[2 * ks][3]), pk_bf16(RtT[2 * ks + 1][0], RtT[2 * ks + 1][1]), pk_bf16(RtT[2 * ks + 1][2], RtT[2 * ks + 1][3])};
                *(LAS u32x4*)(sl + SL_ATIL + ks * 1024 + lane * 16) = wa; *(LAS u32x4*)(sl + SL_RTIL + ks * 1024 + lane * 16) = wr; }
            *(LAS u32x2*)(sl + SL_ULOC + lane * 8) = f32_to_bf4(W1T); *(LAS u32x2*)(sl + SL_YLOC + lane * 8) = f32_to_bf4(W2T);
            }
            asm volatile("s_waitcnt lgkmcnt(0)" ::: "memory");
            if (lane == 0) FULL[slot] = (unsigned)(c + 1);
        }
#undef CS_ISSUE
#undef CS_PCLOAD
    } else {
        struct ConsOps { bf16x8 at0, at1, rt0, rt1, bk[4]; u32x2 w1w, w2w, vfw[2]; f32x4 pc[4]; };
        f32x4 S[2][4];
#pragma unroll
        for (int ti = 0; ti < 2; ++ti)
#pragma unroll
            for (int mt = 0; mt < 4; ++mt) S[ti][mt] = (f32x4){0.f, 0.f, 0.f, 0.f};
#define CONS_LOAD(X, cc) do { const int slot_ = (cc) % CS_NS; LAS unsigned char* sl_ = lds + slot_ * SL_BYTES; \
            { unsigned sp_ = 0; while (FULL[slot_] < (unsigned)((cc) + 1)) { __builtin_amdgcn_s_sleep(1); if (++sp_ > (1u << 22)) break; } } \
            asm volatile("" ::: "memory"); \
            X.at0 = *(const LAS bf16x8*)(sl_ + SL_ATIL + lane * 16); X.at1 = *(const LAS bf16x8*)(sl_ + SL_ATIL + 1024 + lane * 16); \
            X.rt0 = *(const LAS bf16x8*)(sl_ + SL_RTIL + lane * 16); X.rt1 = *(const LAS bf16x8*)(sl_ + SL_RTIL + 1024 + lane * 16); \
            X.w1w = *(const LAS u32x2*)(sl_ + SL_ULOC + lane * 8); X.w2w = *(const LAS u32x2*)(sl_ + SL_YLOC + lane * 8); \
            _Pragma("unroll") for (int mt_ = 0; mt_ < 4; ++mt_) { X.pc[mt_] = *(const LAS f32x4*)(sl_ + SL_PC + (16 * mt_ + 4 * q) * 4); \
                X.bk[mt_] = frag_cat(__builtin_bit_cast(u32x2, tr_read16(sl_ + SL_BH + swz(4 * q + qp, 16 * mt_ + 4 * pp))), __builtin_bit_cast(u32x2, tr_read16(sl_ + SL_KH + swz(4 * q + qp, 16 * mt_ + 4 * pp)))); } \
            _Pragma("unroll") for (int ti_ = 0; ti_ < 2; ++ti_) X.vfw[ti_] = __builtin_bit_cast(u32x2, tr_read16(sl_ + SL_V + swz(4 * q + qp, 16 * (2 * wave + ti_) + 4 * pp))); } while (0)
#define CONS_COMPUTE(X, cc) do { const f32x4 z4c_ = {0.f, 0.f, 0.f, 0.f}; const bf16x8 w1f_ = frag_cat(X.w1w, (u32x2){0u, 0u}), w2f_ = frag_cat(X.w2w, (u32x2){0u, 0u}); \
            _Pragma("unroll") for (int ti_ = 0; ti_ < 2; ++ti_) { const int nt_ = 2 * wave + ti_; \
                const bf16x8 vB_ = frag_cat(X.vfw[ti_], (u32x2){0u, 0u}); \
                const bf16x8 Sb0_ = frag_cat(f32_to_bf4(S[ti_][0]), f32_to_bf4(S[ti_][1])), Sb1_ = frag_cat(f32_to_bf4(S[ti_][2]), f32_to_bf4(S[ti_][3])); \
                const f32x4 U0_ = MFMA16(X.at0, Sb0_, MFMA16(w1f_, vB_, z4c_)), U1_ = MFMA16(X.at1, Sb1_, z4c_); \
                const f32x4 Y0_ = MFMA16(X.rt0, Sb0_, MFMA16(w2f_, vB_, z4c_)), Y1_ = MFMA16(X.rt1, Sb1_, z4c_); \
                const f32x4 UT_ = U0_ + U1_, YT_ = Y0_ + Y1_; \
                const bf16x8 Ub_ = frag_cat(f32_to_bf4(UT_), X.vfw[ti_]); \
                _Pragma("unroll") for (int mt_ = 0; mt_ < 4; ++mt_) { S[ti_][mt_] = MFMA16(X.bk[mt_], Ub_, S[ti_][mt_]); S[ti_][mt_] = S[ti_][mt_] * X.pc[mt_]; } \
                *(f32x4*)(Yg + ((((size_t)b * NCHUNK + (dir ? (NCHUNK - 1 - (cc)) : (cc))) * NH + hd) * 64 + 16 * nt_ + c16) * 16 + 4 * q) = YT_; } } while (0)
#define CONS_DONE(cc) do { asm volatile("s_waitcnt lgkmcnt(0)" ::: "memory"); if (lane == 0) (void)__hip_atomic_fetch_add((LAS unsigned*)&DONE[(cc) % CS_NS], 1u, __ATOMIC_RELAXED, __HIP_MEMORY_SCOPE_WORKGROUP); } while (0)
        ConsOps OA, OB;
        CONS_LOAD(OA, 0);
#pragma unroll 1
        for (int c = 0; c < NCHUNK; c += 2) {
            CONS_LOAD(OB, c + 1);
            CONS_COMPUTE(OA, c);
            CONS_DONE(c);
            if (c + 2 < NCHUNK) CONS_LOAD(OA, c + 2);
            CONS_COMPUTE(OB, c + 1);
            CONS_DONE(c + 1);
        }
#undef CONS_LOAD
#undef CONS_COMPUTE
#undef CONS_DONE
        unsigned tq0 = 0u, tq1 = 0u, tq2 = 0u, tq3 = 0u, tq4 = 0u, tq5 = 0u, tacc = 0u;
        (void)tq0; (void)tq1; (void)tq2; (void)tq3; (void)tq4; (void)tq5;
        (void)tacc;
    }
}

__device__ __forceinline__ void phase_post(const Args& a, int G) {
    int tid = tid_of(a.wv); asm volatile("" : "+v"(tid)); const int lane = tid & 63, wave = __builtin_amdgcn_readfirstlane(tid >> 6);
    const int gw = blockIdx.x * 8 + wave, NGW = G * 8, t = lane & 15, iq = lane >> 4;
    const float* __restrict__ YF = (const float*)(a.ws + WS_YF); const float* __restrict__ YB = (const float*)(a.ws + WS_YB); const float* __restrict__ BON = (const float*)(a.ws + WS_BON);
    const bf16_t* __restrict__ Vg = (const bf16_t*)scan_arr(a.ws, 0); const bf16_t* __restrict__ Gg = (const bf16_t*)(a.ws + WS_G); bf16_t* __restrict__ MIX = (bf16_t*)(a.ws + WS_MIX);
    float* ss = (float*)(a.ws + WS_SS);
    for (int i = blockIdx.x * NTHREADS + tid; i < T; i += G * NTHREADS) ss[i] = 0.f;
    constexpr int NIT = (T / 16) * NH;
#pragma unroll 1
    for (int it = gw; it < NIT; it += NGW) {
        const int tile = it / NH, hd = it - tile * NH, tok = tile * 16 + t;
        const float* yfp = YF + ((size_t)it * 64 + 16 * iq) * 16 + t; const float* ybp = YB + ((size_t)it * 64 + 16 * iq) * 16 + (15 - t);
        float y[16];
#pragma unroll
        for (int k = 0; k < 16; ++k) y[k] = yfp[k * 16] + ybp[k * 16];
        const u32x4 v0 = *(const u32x4*)(Vg + ((size_t)it * 16 + t) * 64 + 16 * iq), v1 = *(const u32x4*)(Vg + ((size_t)it * 16 + t) * 64 + 16 * iq + 8);
        const u32x4 g0 = *(const u32x4*)(Gg + (size_t)tok * RW + hd * 64 + 16 * iq), g1 = *(const u32x4*)(Gg + (size_t)tok * RW + hd * 64 + 16 * iq + 8);
        const float bon = BON[(size_t)tok * NH + hd] + BON[(size_t)T * NH + (size_t)tok * NH + hd];
        float sm = 0.f;
#pragma unroll
        for (int k = 0; k < 16; ++k) sm += y[k];
        sm += __shfl_xor(sm, 16); sm += __shfl_xor(sm, 32);
        const float mean = sm * (1.f / 64.f); float vs = 0.f;
#pragma unroll
        for (int k = 0; k < 16; ++k) { y[k] -= mean; vs += y[k] * y[k]; }
        vs += __shfl_xor(vs, 16); vs += __shfl_xor(vs, 32);
        const float rstd = 1.0f / sqrtf(vs * (1.f / 64.f) + 64e-5f);
        const unsigned vw[8] = {v0.x, v0.y, v0.z, v0.w, v1.x, v1.y, v1.z, v1.w}, gwd[8] = {g0.x, g0.y, g0.z, g0.w, g1.x, g1.y, g1.z, g1.w};
        unsigned ow[8];
#pragma unroll
        for (int k2 = 0; k2 < 8; ++k2) { const int ch = hd * 64 + 16 * iq + 2 * k2;
            const float o0 = (y[2 * k2] * rstd * a.in[I_LNXG][ch] + a.in[I_LNXB][ch] + bon * bf_lo(vw[k2])) * bf_lo(gwd[k2]);
            const float o1 = (y[2 * k2 + 1] * rstd * a.in[I_LNXG][ch + 1] + a.in[I_LNXB][ch + 1] + bon * bf_hi(vw[k2])) * bf_hi(gwd[k2]);
            ow[k2] = pk_bf16(o0, o1); }
        bf16_t* op = MIX + (size_t)tok * D + 640 + hd * 64 + 16 * iq;
        *(u32x4*)op = (u32x4){ow[0], ow[1], ow[2], ow[3]}; *(u32x4*)(op + 8) = (u32x4){ow[4], ow[5], ow[6], ow[7]};
    }
}

constexpr int RT_WS = 2064;
__device__ __forceinline__ void phase_router(const Args& a, LAS unsigned char* lds, int G) {
    int tid = tid_of(a.wv); asm volatile("" : "+v"(tid)); const int lane = tid & 63, wave = __builtin_amdgcn_readfirstlane(tid >> 6);
    const int gw = blockIdx.x * 8 + wave, NGW = G * 8, l15 = lane & 15, kq = lane >> 4;
    LAS bf16_t* WH = (LAS bf16_t*)lds; LAS bf16_t* WL = (LAS bf16_t*)(lds + 16 * RT_WS);
    for (int i = tid; i < D * NE; i += NTHREADS) { const int k = i >> 4, e = i & 15; const float w = a.in[I_WROUTER][i];
        const unsigned hi = pk_bf16(w, 0.f) & 0xffffu; const float rem = w - bf_lo(hi);
        WH[e * (RT_WS / 2) + k] = (bf16_t)hi; WL[e * (RT_WS / 2) + k] = (bf16_t)(pk_bf16(rem, 0.f) & 0xffffu); }
    __syncthreads();
    const bf16_t* __restrict__ X1 = (const bf16_t*)(a.ws + WS_X1); const float* __restrict__ ss = (const float*)(a.ws + WS_SS); bf16_t* __restrict__ H2 = (bf16_t*)(a.ws + WS_H2);
    float* __restrict__ AFF = (float*)(a.ws + WS_AFF); int* __restrict__ INV = (int*)(a.ws + WS_INV);
    const float* __restrict__ GF = a.in[I_NFFNG];
    for (int grp = gw; grp < T / 16; grp += NGW) {
        const int tok = grp * 16 + l15;
        const float rs = 1.0f / sqrtf(ss[tok] * (1.f / D) + 1e-6f);
        f32x4 acc = {0.f, 0.f, 0.f, 0.f};
        const bf16_t* xrow = X1 + (size_t)tok * D + 8 * kq; unsigned char* hrow8 = (unsigned char*)H2 + (size_t)tok * D + 8 * kq;
#pragma unroll 8
        for (int ks = 0; ks < 32; ++ks) {
            const u32x4 xw = *(const u32x4*)(xrow + 32 * ks); const f32x4 x0 = {bf_lo(xw.x), bf_hi(xw.x), bf_lo(xw.y), bf_hi(xw.y)}, x1v = {bf_lo(xw.z), bf_hi(xw.z), bf_lo(xw.w), bf_hi(xw.w)};
            const f32x4 g0 = *(const f32x4*)(GF + 32 * ks + 8 * kq), g1 = *(const f32x4*)(GF + 32 * ks + 8 * kq + 4);
            const f32x4 h0 = x0 * rs * g0, h1 = x1v * rs * g1;
            u32x4 hi; hi.x = pk_bf16(h0.x, h0.y); hi.y = pk_bf16(h0.z, h0.w); hi.z = pk_bf16(h1.x, h1.y); hi.w = pk_bf16(h1.z, h1.w);
            *(u32x2*)(hrow8 + 32 * ks) = (u32x2){pk_fp8x4(h0.x, h0.y, h0.z, h0.w), pk_fp8x4(h1.x, h1.y, h1.z, h1.w)};
            u32x4 lo; lo.x = pk_bf16(h0.x - bf_lo(hi.x), h0.y - bf_hi(hi.x)); lo.y = pk_bf16(h0.z - bf_lo(hi.y), h0.w - bf_hi(hi.y));
            lo.z = pk_bf16(h1.x - bf_lo(hi.z), h1.y - bf_hi(hi.z)); lo.w = pk_bf16(h1.z - bf_lo(hi.w), h1.w - bf_hi(hi.w));
            const bf16x8 ah = __builtin_bit_cast(bf16x8, hi), al = __builtin_bit_cast(bf16x8, lo);
            const bf16x8 bh = *(const LAS bf16x8*)(lds + l15 * RT_WS + (32 * ks + 8 * kq) * 2), bl = *(const LAS bf16x8*)(lds + 16 * RT_WS + l15 * RT_WS + (32 * ks + 8 * kq) * 2);
            acc = __builtin_amdgcn_mfma_f32_16x16x32_bf16(ah, bh, acc, 0, 0, 0);
            acc = __builtin_amdgcn_mfma_f32_16x16x32_bf16(al, bh, acc, 0, 0, 0);
            acc = __builtin_amdgcn_mfma_f32_16x16x32_bf16(ah, bl, acc, 0, 0, 0);
        }
#pragma unroll
        for (int rg = 0; rg < 4; ++rg) { const float mx = max16(acc[rg]); const float ex = __expf(acc[rg] - mx); const float sm = sum16(ex);
            const int t2 = grp * 16 + 4 * kq + rg, bb = t2 >> 12, sq = t2 & (SEQ - 1);
            AFF[((size_t)(bb * NE + l15)) * SEQ + sq] = ex / sm; }
        *(u32x4*)(INV + (size_t)grp * 256 + 4 * lane) = (u32x4){0xffffffffu, 0xffffffffu, 0xffffffffu, 0xffffffffu};
    }
}

__device__ __forceinline__ void topk_unit(const Args& a, LAS unsigned char* lds, int unit) {
    int tid = tid_of(a.wv); asm volatile("" : "+v"(tid)); const int lane = tid & 63, wave = __builtin_amdgcn_readfirstlane(tid >> 6);
    const int b = unit >> 4, e = unit & 15;
    const float* AFF = (const float*)(a.ws + WS_AFF) + (size_t)unit * SEQ;
    LAS unsigned* KEY = (LAS unsigned*)lds;
    LAS unsigned* HIST = (LAS unsigned*)(lds + 16384);
    LAS unsigned* CTL = (LAS unsigned*)(lds + 16384 + 1024);
    LAS unsigned* WS_ = (LAS unsigned*)(lds + 16384 + 2048);
    __syncthreads();
    unsigned key[8];
    { const u32x4 k0 = *(const u32x4*)(AFF + tid * 8), k1 = *(const u32x4*)(AFF + tid * 8 + 4); key[0] = k0.x; key[1] = k0.y; key[2] = k0.z; key[3] = k0.w; key[4] = k1.x; key[5] = k1.y; key[6] = k1.z; key[7] = k1.w; }
    if (tid == 0) { CTL[0] = 0u; CTL[1] = (unsigned)CAP; }
    unsigned prefix = 0u, mask = 0u;
#pragma unroll 1
    for (int pass = 0; pass < 4; ++pass) {
        const int shift = 24 - 8 * pass;
        if (tid < 256) HIST[tid] = 0u;
        __syncthreads();
#pragma unroll
        for (int i = 0; i < 8; ++i) if ((key[i] & mask) == prefix) (void)__hip_atomic_fetch_add(&HIST[(key[i] >> shift) & 255u], 1u, __ATOMIC_RELAXED, __HIP_MEMORY_SCOPE_WORKGROUP);
        __syncthreads();
        if (wave == 0) {
            const unsigned need = CTL[1];
            unsigned hv[4], tsum = 0u;
#pragma unroll
            for (int i = 0; i < 4; ++i) { hv[i] = HIST[255 - (4 * lane + i)]; tsum += hv[i]; }
            unsigned inc = tsum;
#pragma unroll
            for (int o = 1; o < 64; o <<= 1) { const unsigned v = __shfl_up(inc, o); if (lane >= o) inc += v; }
            unsigned exc = inc - tsum;
            if (exc < need && need <= inc) {
                unsigned run = exc; int di = 0;
#pragma unroll
                for (int i = 0; i < 4; ++i) { if (run < need && need <= run + hv[i]) { di = i; break; } run += hv[i]; }
                const unsigned digit = 255u - (unsigned)(4 * lane + di);
                CTL[0] = prefix | (digit << shift); CTL[1] = need - run;
            }
        }
        __syncthreads();
        prefix = CTL[0]; mask |= (255u << shift);
    }
    const unsigned thr = prefix, need_eq = CTL[1];
    unsigned ngt = 0u, neq = 0u;
#pragma unroll
    for (int i = 0; i < 8; ++i) { ngt += (key[i] > thr) ? 1u : 0u; neq += (key[i] == thr) ? 1u : 0u; }
    unsigned pk = ngt | (neq << 16), inc = pk;
#pragma unroll
    for (int o = 1; o < 64; o <<= 1) { const unsigned v = __shfl_up(inc, o); if (lane >= o) inc += v; }
    if (lane == 63) WS_[wave] = inc;
    __syncthreads();
    unsigned woff = 0u, tot = 0u;
#pragma unroll
    for (int w = 0; w < 8; ++w) { const unsigned v = WS_[w]; if (w < wave) woff += v; tot += v; }
    const unsigned exc = inc - pk + woff;
    unsigned gpos = exc & 0xffffu, epos = exc >> 16; const unsigned totgt = tot & 0xffffu;
    const int sbase = (e * BATCH + b) * CAP;
    int* ROWTOK = (int*)(a.ws + WS_ROWTOK); float* ROWGATE = (float*)(a.ws + WS_ROWGATE); int* INV = (int*)(a.ws + WS_INV);
#pragma unroll
    for (int i = 0; i < 8; ++i) {
        int pos = -1;
        if (key[i] > thr) pos = (int)gpos++;
        else if (key[i] == thr) { if (epos < need_eq) pos = (int)(totgt + epos); epos++; }
        if (pos >= 0) { const int s = tid * 8 + i, tok = b * SEQ + s, slot = sbase + pos;
            ROWTOK[slot] = tok; ROWGATE[slot] = __builtin_bit_cast(float, key[i]); INV[(size_t)tok * NE + e] = slot; }
    }
}

__device__ __forceinline__ void phase_final(const Args& a, int G) {
    int tid = tid_of(a.wv); asm volatile("" : "+v"(tid)); const int lane = tid & 63, wave = __builtin_amdgcn_readfirstlane(tid >> 6);
    const int gw = blockIdx.x * 8 + wave, NGW = G * 8;
    const bf16_t* __restrict__ X1 = (const bf16_t*)(a.ws + WS_X1); const bf16_t* __restrict__ YE = (const bf16_t*)(a.ws + WS_YE); const int* __restrict__ INV = (const int*)(a.ws + WS_INV);
    float* __restrict__ OUT = a.out;
    f32x4 gg[4];
#pragma unroll
    for (int j = 0; j < 4; ++j) gg[j] = *(const f32x4*)(a.in[I_FNG] + 4 * lane + 256 * j);
#define PF_SLOTS(inv_, n_, m_, sl_) do { m_ = __ballot((inv_) >= 0) & 0xffffull; n_ = __builtin_popcountll(m_); unsigned long long mm_ = m_; \
        _Pragma("unroll") for (int k_ = 0; k_ < 4; ++k_) { if (mm_) { const int e_ = __builtin_ctzll(mm_); mm_ &= mm_ - 1; sl_[k_] = __builtin_amdgcn_readlane((inv_), e_); } else sl_[k_] = 0; } m_ = mm_; } while (0)
#define PF_ROWS(rw_, xr_, tk_, n_, sl_) do { \
        _Pragma("unroll") for (int k_ = 0; k_ < 4; ++k_) { if (k_ < (n_)) { _Pragma("unroll") for (int j_ = 0; j_ < 4; ++j_) rw_[k_][j_] = *(const u32x2*)(YE + (size_t)sl_[k_] * D + 4 * lane + 256 * j_); } \
            else { _Pragma("unroll") for (int j_ = 0; j_ < 4; ++j_) rw_[k_][j_] = (u32x2){0u, 0u}; } } \
        _Pragma("unroll") for (int j_ = 0; j_ < 4; ++j_) xr_[j_] = *(const u32x2*)(X1 + (size_t)(tk_) * D + 4 * lane + 256 * j_); } while (0)
    int tok = gw;
    if (tok >= T) return;
    int inv0 = INV[(size_t)tok * NE + (lane & 15)];
    int inv1 = (tok + NGW < T) ? INV[(size_t)(tok + NGW) * NE + (lane & 15)] : -1;
    unsigned long long mc; int nc, slc[4]; u32x2 rwc[4][4], xc[4];
    PF_SLOTS(inv0, nc, mc, slc);
    PF_ROWS(rwc, xc, tok, nc, slc);
    for (; tok < T; tok += NGW) {
        const int t1 = tok + NGW, t2 = tok + 2 * NGW;
        const int inv2 = (t2 < T) ? INV[(size_t)t2 * NE + (lane & 15)] : -1;
        unsigned long long mn = 0ull; int nn = 0, sln[4] = {0, 0, 0, 0}; u32x2 rwn[4][4], xn[4];
        if (t1 < T) { PF_SLOTS(inv1, nn, mn, sln); PF_ROWS(rwn, xn, t1, nn, sln); }
        else {
#pragma unroll
            for (int k = 0; k < 4; ++k)
#pragma unroll
                for (int j = 0; j < 4; ++j) rwn[k][j] = (u32x2){0u, 0u};
#pragma unroll
            for (int j = 0; j < 4; ++j) xn[j] = (u32x2){0u, 0u}; }
        f32x4 v[4];
#pragma unroll
        for (int j = 0; j < 4; ++j) v[j] = (f32x4){bf_lo(xc[j].x), bf_hi(xc[j].x), bf_lo(xc[j].y), bf_hi(xc[j].y)};
#pragma unroll
        for (int k = 0; k < 4; ++k)
#pragma unroll
            for (int j = 0; j < 4; ++j) { v[j].x += bf_lo(rwc[k][j].x); v[j].y += bf_hi(rwc[k][j].x); v[j].z += bf_lo(rwc[k][j].y); v[j].w += bf_hi(rwc[k][j].y); }
        if (nc > 4) { unsigned long long m = mc; while (m) { const int e = __builtin_ctzll(m); m &= m - 1; const int slot = __builtin_amdgcn_readlane(inv0, e);
#pragma unroll
                for (int j = 0; j < 4; ++j) { const u32x2 w = *(const u32x2*)(YE + (size_t)slot * D + 4 * lane + 256 * j);
                    v[j].x += bf_lo(w.x); v[j].y += bf_hi(w.x); v[j].z += bf_lo(w.y); v[j].w += bf_hi(w.y); } } }
        float sq = 0.f;
#pragma unroll
        for (int j = 0; j < 4; ++j) sq += (v[j].x * v[j].x + v[j].y * v[j].y) + (v[j].z * v[j].z + v[j].w * v[j].w);
        float rs = 1.0f / sqrtf(wave_sum(sq) * (1.f / D) + 1e-6f);
#pragma unroll
        for (int j = 0; j < 4; ++j) *(f32x4*)(OUT + (size_t)tok * D + 4 * lane + 256 * j) = v[j] * rs * gg[j];
        inv0 = inv1; inv1 = inv2; mc = mn; nc = nn;
#pragma unroll
        for (int k = 0; k < 4; ++k) { slc[k] = sln[k];
#pragma unroll
            for (int j = 0; j < 4; ++j) rwc[k][j] = rwn[k][j]; }
#pragma unroll
        for (int j = 0; j < 4; ++j) xc[j] = xn[j];
    }
#undef PF_SLOTS
#undef PF_ROWS
}

#define XB_TMO      128
#define XB_XCNT(j)  (256  + 64 * (j))
#define XB_XSUB(j)  (1280 + 64 * (j))
#define XB_XGEN(j)  (2304 + 64 * (j))
#define XB_TOP      3328
#define XB_TOPGEN   3392
#define XCD_BAR_WORDS 3456
#define XB_SPIN_CAP (1u << 22)
__device__ __forceinline__ unsigned xb_ld(unsigned* p)              { return __hip_atomic_load(p, __ATOMIC_RELAXED, __HIP_MEMORY_SCOPE_AGENT); }
__device__ __forceinline__ unsigned xb_add(unsigned* p, unsigned v) { return __hip_atomic_fetch_add(p, v, __ATOMIC_RELAXED, __HIP_MEMORY_SCOPE_AGENT); }
__device__ __forceinline__ unsigned xb_xcc_id() { return (unsigned)__builtin_amdgcn_s_getreg((3 << 11) | 20) & 0xFu; }
#define XB_SPIN(cond, bar) do { unsigned _sp = 0; while (cond) { __builtin_amdgcn_s_sleep(1); \
    if ((++_sp & 255u) == 0u) { if (xb_ld(&(bar)[XB_TMO])) break; if (_sp > XB_SPIN_CAP) { atomicAdd(&(bar)[XB_TMO], 1u); break; } } } } while (0)
struct XcdBarrier { unsigned* bar; unsigned x; volatile LAS unsigned* st; int wv; };
__device__ __forceinline__ XcdBarrier xcd_barrier_post(unsigned* bar, volatile LAS unsigned* st, int wv) {
    XcdBarrier b; b.bar = bar; b.x = xb_xcc_id(); b.st = st; b.wv = wv;
    if (threadIdx.x == 0) (void)xb_add(&bar[XB_XCNT(b.x)], 1u);
    return b;
}
__device__ __forceinline__ void xcd_barrier_complete(unsigned* bar, unsigned x, unsigned& nloc, unsigned& nx) {
    const unsigned G = gridDim.x * gridDim.y * gridDim.z;
    unsigned sum, cnt, mine, sp = 0u;
    for (;;) {
        sum = 0u; cnt = 0u; mine = 0u;
#pragma unroll
        for (unsigned j = 0; j < 16; ++j) { const unsigned c = xb_ld(&bar[XB_XCNT(j)]); sum += c; cnt += (c > 0u) ? 1u : 0u; mine = (j == x) ? c : mine; }
        if (sum == G) break;
        __builtin_amdgcn_s_sleep(1);
        if ((++sp & 255u) == 0u) { if (xb_ld(&bar[XB_TMO])) break; if (sp > XB_SPIN_CAP) { atomicAdd(&bar[XB_TMO], 1u); break; } }
    }
    nloc = mine > 0u ? mine : 1u; nx = cnt > 0u ? cnt : 1u;
}
__device__ __forceinline__ void xcd_barrier(const XcdBarrier& b) {
    asm volatile("s_waitcnt vmcnt(0)" ::: "memory");
    __syncthreads();
    if (tid_of(b.wv) == 0) {
        unsigned* bar = b.bar;
        __builtin_amdgcn_s_waitcnt(0);
        unsigned nloc = b.st[0], nx = b.st[1];
        if (nloc == 0u) { xcd_barrier_complete(bar, b.x, nloc, nx); b.st[0] = nloc; b.st[1] = nx; }
        const unsigned old = xb_add(&bar[XB_XSUB(b.x)], 1u);
        const unsigned gen = old / nloc;
        if (old + 1u == (gen + 1u) * nloc) {
            __builtin_amdgcn_fence(__ATOMIC_RELEASE, "agent");
            asm volatile("s_waitcnt vmcnt(0)" ::: "memory");
            const unsigned og = xb_add(&bar[XB_TOP], 1u);
            const unsigned tg = og / nx;
            if (og + 1u == (tg + 1u) * nx) xb_add(&bar[XB_TOPGEN], 1u);
            else XB_SPIN(xb_ld(&bar[XB_TOPGEN]) == tg, bar);
            __builtin_amdgcn_fence(__ATOMIC_ACQUIRE, "agent");
            xb_add(&bar[XB_XGEN(b.x)], 1u);
            asm volatile("s_waitcnt vmcnt(0)" ::: "memory");
        } else {
            XB_SPIN(xb_ld(&bar[XB_XGEN(b.x)]) == gen, bar);
            __builtin_amdgcn_fence(__ATOMIC_ACQUIRE, "agent");
            asm volatile("s_waitcnt vmcnt(0)" ::: "memory");
        }
    }
    __syncthreads();
}

#ifndef PH_MASK
#define PH_MASK 0x7ff
#endif
#ifndef REP_MASK
#define REP_MASK 0
#endif
#ifndef P2_MASK
#define P2_MASK 7
#endif
#ifndef P2_REP
#define P2_REP 0
#define P9_REP 0
#endif
constexpr int LDS_MISC = LDS_BYTES - 64;
constexpr int LDS_PTAB = LDS_BYTES - 512;
__device__ __forceinline__ Args load_args(LAS unsigned char* lds, int lo, int hi, int wv) {
    Args r; const LAS u32x2* t = (const LAS u32x2*)(lds + LDS_PTAB);
#pragma unroll
    for (int i = 0; i < 31; ++i) { const u32x2 v = t[i]; const unsigned long long p = ((unsigned long long)(unsigned)__builtin_amdgcn_readfirstlane((int)v.y) << 32) | (unsigned)__builtin_amdgcn_readfirstlane((int)v.x);
        if (i < 29) r.in[i] = (const float*)(const __attribute__((address_space(1))) float*)p; else if (i == 29) r.out = (float*)(__attribute__((address_space(1))) float*)p; else r.ws = (unsigned char*)(__attribute__((address_space(1))) unsigned char*)p; }
    r.ph_lo = lo; r.ph_hi = hi; r.wv = wv; r.zero_ = 0; return r;
}
constexpr size_t WS_CTL = 0, CTL_BYTES = 16384;
__global__ void __launch_bounds__(NTHREADS, 2) mega(Args a0) {
    extern __shared__ __attribute__((aligned(16))) unsigned char lds_raw[];
    LAS unsigned char* lds = (LAS unsigned char*)lds_raw;
    cg::grid_group grid = cg::this_grid();
    const int G = gridDim.x, lo = a0.ph_lo, hi = a0.ph_hi, wv0 = __builtin_amdgcn_readfirstlane((int)threadIdx.x >> 6);
    volatile LAS unsigned* misc = (volatile LAS unsigned*)(lds + LDS_MISC);
    if (threadIdx.x < 16) misc[threadIdx.x] = 0u;
    if (threadIdx.x == 0) { LAS unsigned long long* t = (LAS unsigned long long*)(lds + LDS_PTAB);
#pragma unroll
        for (int i = 0; i < 29; ++i) t[i] = (unsigned long long)a0.in[i];
        t[29] = (unsigned long long)a0.out; t[30] = (unsigned long long)a0.ws; }
    __syncthreads();
    if (lo < -1000) grid.sync();
    XcdBarrier xbar = xcd_barrier_post((unsigned*)(a0.ws + WS_CTL), misc, wv0);
#define IN(k) (((PH_MASK >> (k)) & 1) && lo <= (k) && (k) < hi)
#define NREP(k) (1 + ((REP_MASK >> (k)) & 1))
#define PHASE(k, ...) do { if (IN(k)) { for (int rep_ = 0; rep_ < NREP(k); ++rep_) { { const Args a = load_args(lds, lo, hi, wv0); unsigned char* const ws = a.ws; (void)ws; __VA_ARGS__; } if (rep_ + 1 < NREP(k) || IN((k) + 1)) { xcd_barrier(xbar); } } } } while (0)

    PHASE(0, phase_prep(a, lds, G));

    PHASE(1, {
        pg8::Gemm g{(const bf16_t*)(ws + WS_XH), (const bf16_t*)(ws + WS_WINT), T, IN_PROJ, D, 0, 0};
        pg8::TripleOrder S; S.S0.init(T, IN_PROJ, G, 0); S.A1 = (const bf16_t*)(ws + WS_MEMN); S.B1 = (const bf16_t*)(ws + WS_WKT); S.A2 = (const bf16_t*)(ws + WS_WVT); S.B2 = (const bf16_t*)(ws + WS_MEMN);
        S.n1 = BATCH * NMEM / 256; S.n2 = BATCH * NMEM / 256; S.G = G; S.c = (int)blockIdx.x;
        pg8::EpiBf16x3 E{pg8::EpiBf16{(bf16_t*)(ws + WS_P), PLD, (bf16_t*)(ws + WS_Q)}, pg8::EpiBf16{(bf16_t*)(ws + WS_KMEM), 256, nullptr}, pg8::EpiBf16{(bf16_t*)(ws + WS_VT), BATCH * NMEM, nullptr}};
        const int total = S.n1 + S.n2 + S.S0.nwg, rem = total % G, c = (int)blockIdx.x;
        const bool cv = rem ? (c >= rem) : true; const int ncv = rem ? G - rem : G, rank = rem ? c - rem : c;
        if (cv && !(rank & 1)) { expert_prep_items(a, lds, rank * 8 + a.wv, ncv * 8, 0, 3 * 8192); __syncthreads(); }
        pg8::gemm_phase<pg8::EpiBf16x3, pg8::TripleOrder, false>(lds, g, S, E, nullptr, a.wv);
        if (cv && (rank & 1)) { __syncthreads(); expert_prep_items(a, lds, rank * 8 + a.wv, ncv * 8, 0, 3 * 8192); }
    });

    constexpr int NSCAN = BATCH * NH * 2;
    PHASE(2, {
        for (int r2 = 0; r2 < 1 + ((P2_REP >> 1) & 1); ++r2) conv_stream(a, lds, (int)blockIdx.x, G);
        for (int u = blockIdx.x; u < 2048; u += G) {
            if (u >= 1024) { for (int r2 = 0; r2 < 1 + ((P2_REP >> 2) & 1); ++r2) prep_unit(a, lds, u - 1024); }
        }
    });

    PHASE(3, {
        int bid = blockIdx.x; int Gp = G; asm volatile("" : "+s"(bid), "+s"(Gp));
        for (int u = bid; u < NSCAN; u += Gp) scan_chunked_unit(a, lds, u);
        if (rep_ == 0) {
            if (Gp > NSCAN) { if (bid >= NSCAN) { for (int u = bid - NSCAN; u < 64; u += Gp - NSCAN) for (int r2 = 0; r2 < 1 + (P2_REP & 1); ++r2) attn_unit(a, lds, u);
                                                 } }
            else { for (int u = bid; u < 64; u += Gp) attn_unit(a, lds, u); }
        }
    });

    PHASE(4, phase_post(a, G));

    PHASE(5, {
        pg8::Gemm g{(const bf16_t*)(ws + WS_MIX), (const bf16_t*)(ws + WS_WOUTT), T, D, D, 0, 0}; pg8::StaticOrder S; S.init(T, D, G, (int)blockIdx.x);
        pg8::EpiResidSS E{a.in[I_X], (bf16_t*)(ws + WS_X1), (float*)(ws + WS_SS)}; pg8::gemm_phase<pg8::EpiResidSS, pg8::StaticOrder, false>(lds, g, S, E, nullptr, a.wv);
    });

    PHASE(6, phase_router(a, lds, G));

    PHASE(7, { for (int u = blockIdx.x; u < BATCH * NE; u += G) topk_unit(a, lds, u); });

    PHASE(8, {
        pg8::Gemm g{(const bf16_t*)(ws + WS_H2), (const bf16_t*)(ws + WS_WGUT), NSLOT, 2048, D / 2, 0x7A7A7A7A, 0x7F7F7F7F};     pg8::ExpertOrder S; S.init(32, 8, NE, G, (int)blockIdx.x);
        pg8::EpiSwiGLU E{(bf16_t*)(ws + WS_HID)}; pg8::gemm_phase<pg8::EpiSwiGLU, pg8::ExpertOrder, true, false, true>(lds, g, S, E, (const int*)(ws + WS_ROWTOK), a.wv);
    });

    PHASE(9, {
        pg8::Gemm g{(const bf16_t*)(ws + WS_HID), (const bf16_t*)(ws + WS_WDT), NSLOT, D, FF / 2, 0x7A7A7A7A, 0x7C7C7C7C};     pg8::ExpertOrder S; S.init(32, 4, NE, G, (int)blockIdx.x);
        pg8::EpiGateScale E{(bf16_t*)(ws + WS_YE), (const float*)(ws + WS_ROWGATE)}; pg8::gemm_phase<pg8::EpiGateScale, pg8::ExpertOrder, false, true, true>(lds, g, S, E, nullptr, a.wv);
#if P9_REP
        __syncthreads(); pg8::gemm_phase<pg8::EpiGateScale, pg8::ExpertOrder, false, true, true>(lds, g, S, E, nullptr, a.wv);
#endif
    });

    PHASE(10, phase_final(a, G));
#undef IN
#undef NREP
#undef PHASE
}

#ifndef MK_ONE_LAUNCH
#define MK_ONE_LAUNCH 1
#endif
extern "C" void kernel_launch(void* const* d_in, const int* in_sizes, int n_in, void* d_out, int out_size, void* d_ws, size_t ws_size, hipStream_t stream) {
    static int grid_blocks = 0;
    if (grid_blocks == 0) {
        if (n_in != 29 || out_size != T * D || ws_size < WS_END) { fprintf(stderr, "kernel_launch: unexpected problem: n_in %d out %d ws %zu (need %zu)\n", n_in, out_size, ws_size, (size_t)WS_END); grid_blocks = -1; return; }
        int dev = 0, cus = 0, per_cu = 0;
        if (hipGetDevice(&dev) != hipSuccess || hipDeviceGetAttribute(&cus, hipDeviceAttributeMultiprocessorCount, dev) != hipSuccess) { grid_blocks = -1; return; }
        if (hipFuncSetAttribute((const void*)mega, hipFuncAttributeMaxDynamicSharedMemorySize, LDS_BYTES) != hipSuccess) { fprintf(stderr, "kernel_launch: hipFuncSetAttribute failed\n"); grid_blocks = -1; return; }
        if (hipOccupancyMaxActiveBlocksPerMultiprocessor(&per_cu, (const void*)mega, NTHREADS, LDS_BYTES) != hipSuccess || per_cu < 1) { fprintf(stderr, "kernel_launch: occupancy query says %d blocks per CU\n", per_cu); grid_blocks = -1; return; }
        grid_blocks = cus;
    }
    if (grid_blocks < 0) return;
    if (hipMemsetAsync((char*)d_ws + WS_CTL, 0, CTL_BYTES, stream) != hipSuccess) { fprintf(stderr, "kernel_launch: memset failed\n"); return; }
    Args a{};
    for (int i = 0; i < 29; ++i) a.in[i] = (const float*)d_in[i];
    a.out = (float*)d_out; a.ws = (unsigned char*)d_ws;
#if MK_ONE_LAUNCH
    a.ph_lo = 0; a.ph_hi = NPHASE;
    { void* args[] = {&a}; hipError_t e = hipLaunchCooperativeKernel((const void*)mega, dim3(grid_blocks), dim3(NTHREADS), args, LDS_BYTES, stream);
      if (e != hipSuccess) fprintf(stderr, "cooperative launch failed: %s (grid %d)\n", hipGetErrorString(e), grid_blocks); }
#else
    for (int ph = 0; ph < NPHASE; ++ph) { a.ph_lo = ph; a.ph_hi = ph + 1; void* args[] = {&a};
        hipError_t e = hipLaunchCooperativeKernel((const void*)mega, dim3(grid_blocks), dim3(NTHREADS), args, LDS_BYTES, stream);
        if (e != hipSuccess) { fprintf(stderr, "cooperative launch %d failed: %s (grid %d)\n", ph, hipGetErrorString(e), grid_blocks); break; } }
#endif
}
```

```cpp
#include <hip/hip_runtime.h>
#include <hip/hip_cooperative_groups.h>
#include <cstdio>
#include <cstdint>
namespace cg = cooperative_groups;

#define LAS __attribute__((address_space(3)))
typedef unsigned short bf16_t;
typedef short bf16x8 __attribute__((ext_vector_type(8)));
typedef short s16x4 __attribute__((ext_vector_type(4)));
typedef float f32x2 __attribute__((ext_vector_type(2)));
typedef float f32x4 __attribute__((ext_vector_type(4)));
typedef float f32x16 __attribute__((ext_vector_type(16)));
typedef unsigned u32x2 __attribute__((ext_vector_type(2)));
typedef unsigned u32x4 __attribute__((ext_vector_type(4)));
typedef _Float16 f16x4 __attribute__((ext_vector_type(4)));
typedef _Float16 f16x2 __attribute__((ext_vector_type(2)));
typedef __bf16 bf16v2 __attribute__((ext_vector_type(2)));
typedef int v8i __attribute__((ext_vector_type(8)));
typedef int v4i __attribute__((ext_vector_type(4)));

constexpr int D = 1024, BATCH = 16, SEQ = 4096, T = BATCH * SEQ, NMEM = 256;
constexpr int IN_PROJ = 2560, CW = 384, RW = 384, NH = 6, NE = 16, FF = 1024, CAP = 512;
constexpr int NSLOT = NE * BATCH * CAP;
constexpr int NTHREADS = 512;
constexpr int LDS_BYTES = 160 * 1024;
constexpr int NPHASE = 11;
#ifndef SCAN_MODE
#define SCAN_MODE 1
#endif

constexpr size_t MiB = 1u << 20;
constexpr size_t WS_WINT = 1 * MiB;
constexpr size_t WS_WOUTT = 6 * MiB;
constexpr size_t WS_WKT = 8 * MiB;
constexpr size_t WS_WVT = 8 * MiB + 512 * 1024;
constexpr size_t WS_SMALL = 9 * MiB;
constexpr size_t WS_WGUT = 10 * MiB;
constexpr size_t WS_WDT = 74 * MiB;
constexpr size_t WS_KMEM = 106 * MiB;
constexpr size_t WS_VT = 108 * MiB;
constexpr size_t WS_ROWTOK = 106 * MiB;
constexpr size_t WS_ROWGATE = 106 * MiB + 512 * 1024;
constexpr size_t WS_SS = 107 * MiB;
constexpr size_t WS_P = 112 * MiB;
constexpr size_t WS_YF = 112 * MiB;
constexpr size_t WS_YB = 208 * MiB;
constexpr size_t WS_X1 = 112 * MiB;
constexpr size_t WS_XH = 432 * MiB;
constexpr size_t WS_G = 432 * MiB;
constexpr size_t WS_BON = 480 * MiB;
constexpr size_t WS_Q = 400 * MiB;
constexpr int PLD = IN_PROJ - 256;
constexpr size_t WS_H2 = 432 * MiB;
constexpr size_t WS_MEMN = 560 * MiB;
constexpr size_t WS_MIX = 560 * MiB;
constexpr size_t WS_SCAN = 688 * MiB;
constexpr size_t SCAN_STRIDE = 48 * MiB;
constexpr size_t WS_SCAN7 = 496 * MiB;
constexpr size_t WS_PC = 484 * MiB;
__device__ __forceinline__ unsigned char* scan_arr(unsigned char* ws, int a) { return a < 7 ? ws + WS_SCAN + (size_t)a * SCAN_STRIDE : (a == 7 ? ws + WS_SCAN7 : ws + 560 * MiB + 640 * 2); }
__device__ __forceinline__ int scan_pitch(int a) { return a == 8 ? D : 384; }
__device__ __forceinline__ size_t hat_off(int a, size_t tok, int ch) { return a == 8 ? tok * D + ch : ((((tok >> 4) * NH + (ch >> 6)) << 10) + ((tok & 15) << 6) + (ch & 63)); }
constexpr size_t WS_AFF = 624 * MiB;
constexpr size_t WS_INV = 628 * MiB;
constexpr size_t WS_HID = 768 * MiB;
constexpr size_t WS_YE = 368 * MiB;
constexpr size_t WS_END = 1024 * MiB;

__device__ __forceinline__ unsigned pk_bf16(float lo, float hi) { f32x2 v = {lo, hi}; bf16v2 b = __builtin_convertvector(v, bf16v2); return __builtin_bit_cast(unsigned, b); }
__device__ __forceinline__ unsigned pk_fp8x4(float a, float b, float c, float d) { int w = 0; w = __builtin_amdgcn_cvt_pk_fp8_f32(a, b, w, false); w = __builtin_amdgcn_cvt_pk_fp8_f32(c, d, w, true); return (unsigned)w; }
__device__ __forceinline__ float bf_lo(unsigned u) { return __builtin_bit_cast(float, u << 16); }
__device__ __forceinline__ float bf_hi(unsigned u) { return __builtin_bit_cast(float, u & 0xffff0000u); }
__device__ __forceinline__ float wave_sum(float v) {
#pragma unroll
    for (int o = 1; o < 64; o <<= 1) v += __shfl_xor(v, o);
    return v;
}
__device__ __forceinline__ float sigmoidf_fast(float x) { return __builtin_amdgcn_rcpf(1.0f + __builtin_amdgcn_exp2f(-1.4426950408889634f * x)); }
template <int CTRL> __device__ __forceinline__ float dpp_f(float x) { return __builtin_bit_cast(float, __builtin_amdgcn_update_dpp(0, __builtin_bit_cast(int, x), CTRL, 0xF, 0xF, true)); }
__device__ __forceinline__ float sum8(float x) { x += dpp_f<0xB1>(x); x += dpp_f<0x4E>(x); x += dpp_f<0x141>(x); return x; }
__device__ __forceinline__ float sum16(float x) { x = sum8(x); x += dpp_f<0x140>(x); return x; }
__device__ __forceinline__ float max16(float x) { x = fmaxf(x, dpp_f<0xB1>(x)); x = fmaxf(x, dpp_f<0x4E>(x)); x = fmaxf(x, dpp_f<0x141>(x)); x = fmaxf(x, dpp_f<0x140>(x)); return x; }

typedef short v4i16g __attribute__((__vector_size__(8)));
__device__ __forceinline__ s16x4 tr_read16(LAS unsigned char* p) { v4i16g r = __builtin_amdgcn_ds_read_tr16_b64_v4i16((LAS v4i16g*)p); return __builtin_bit_cast(s16x4, r); }
__device__ __forceinline__ f32x4 bf4_to_f32(u32x2 w) { return (f32x4){bf_lo(w.x), bf_hi(w.x), bf_lo(w.y), bf_hi(w.y)}; }
__device__ __forceinline__ u32x2 f32_to_bf4(f32x4 v) { return (u32x2){pk_bf16(v.x, v.y), pk_bf16(v.z, v.w)}; }
__device__ __forceinline__ bf16x8 frag_lo4(f32x4 v) { const u32x4 w = {pk_bf16(v.x, v.y), pk_bf16(v.z, v.w), 0u, 0u}; return __builtin_bit_cast(bf16x8, w); }
__device__ __forceinline__ bf16x8 frag_cat(u32x2 a, u32x2 b) { const u32x4 w = {a.x, a.y, b.x, b.y}; return __builtin_bit_cast(bf16x8, w); }
#define MFMA16(a, b, c) __builtin_amdgcn_mfma_f32_16x16x32_bf16((a), (b), (c), 0, 0, 0)

__device__ __forceinline__ int tid_of(int wv) { int l; asm volatile("v_mbcnt_lo_u32_b32 %0, -1, 0\n\tv_mbcnt_hi_u32_b32 %0, -1, %0" : "=v"(l)); return (wv << 6) | l; }
namespace pg8 {
#define PG8_LAS __attribute__((address_space(3)))
constexpr int BM = 256, BK = 64, HALF = 128, HTB = HALF * BK * 2, STAGE_BYTES = 8 * HTB, NXCD = 8, WGM = 8;
__host__ __device__ __forceinline__ int lds_byte(int r, int c) { const int st = (r >> 4) * 2 + (c >> 5), rr = r & 15, cc = c & 31, ob = rr * 64 + cc * 2; return st * 1024 + (ob ^ (((ob >> 9) & 1) << 5)); }
__host__ __device__ __forceinline__ void stage_rc(int b, int& R, int& C) { const int st = b / 1024, sb = b % 1024, swz = sb ^ (((sb >> 9) & 1) << 5); R = (st >> 1) * 16 + swz / 64; C = (st & 1) * 32 + (swz % 64) / 2; }
__host__ __device__ __forceinline__ int perm32(int rho) { const int n = rho >> 4, i = rho & 15; return 8 * (i >> 2) + 4 * n + (i & 3); }

struct Unit { int pm, pn, gid; };
struct Gemm { const bf16_t* A; const bf16_t* Bt; int M, N, K; int sw, sx; };

struct StaticOrder {
    int nM, nN, nwg, G, c;
    __device__ void init(int M, int N, int G_, int c_) { nM = M / BM; nN = N / BM; nwg = nM * nN; G = G_; c = c_; }
    __device__ bool next(int i, Unit& u) const {
        const long L = (long)i * G + c; if (L >= nwg) return false;
        int wgid = (int)L; { const int q = nwg / NXCD, r = nwg % NXCD, xcd = wgid % NXCD, off = wgid / NXCD; wgid = (xcd < r ? xcd * (q + 1) : r * (q + 1) + (xcd - r) * q) + off; }
        const int nig = WGM * nN, gid = wgid / nig, fm = gid * WGM, gsz = (nM - fm) < WGM ? (nM - fm) : WGM;
        u.pm = fm + ((wgid % nig) % gsz); u.pn = (wgid % nig) / gsz; u.gid = 0; return true;
    }
    __device__ __forceinline__ const char* aptr(const Gemm& g, const Unit& u, size_t tstep) const { return (const char*)g.A + (size_t)u.pm * tstep; }
    __device__ __forceinline__ const char* bptr(const Gemm& g, const Unit& u, size_t tstep) const { return (const char*)g.Bt + (size_t)u.pn * tstep; }
};
struct TripleOrder {
    StaticOrder S0; const bf16_t* A1; const bf16_t* B1; const bf16_t* A2; const bf16_t* B2; int n1, n2, G, c;
    __device__ bool next(int i, Unit& u) const {
        const long L = (long)i * G + c;
        if (L < n1) { u.pm = (int)L; u.pn = 0; u.gid = 1; return true; }
        if (L < n1 + n2) { u.pm = 0; u.pn = (int)(L - n1); u.gid = 2; return true; }
        const long L0 = L - n1 - n2; if (L0 >= S0.nwg) return false;
        StaticOrder T0 = S0; T0.c = (int)(L0 % G); return T0.next((int)(L0 / G), u);
    }
    __device__ __forceinline__ const char* aptr(const Gemm& g, const Unit& u, size_t tstep) const { return (const char*)(u.gid == 0 ? g.A : (u.gid == 1 ? A1 : A2)) + (size_t)u.pm * tstep; }
    __device__ __forceinline__ const char* bptr(const Gemm& g, const Unit& u, size_t tstep) const { return (const char*)(u.gid == 0 ? g.Bt : (u.gid == 1 ? B1 : B2)) + (size_t)u.pn * tstep; }
};
struct ExpertOrder {
    int nMe, nNe, per, total, G, c;
    __device__ void init(int nMe_, int nNe_, int nExp, int G_, int c_) { nMe = nMe_; nNe = nNe_; per = nMe * nNe; total = per * nExp; G = G_; c = c_; }
    __device__ bool next(int i, Unit& u) const {
        const long L = (long)i * G + c; if (L >= total) return false;
        const int e = (int)(L / per), w = (int)(L % per), xl = w % 8, j = w / 8, rpx = nMe / 8;
        u.pm = e * nMe + xl * rpx + (j % rpx); u.pn = e * nNe + j / rpx; u.gid = 0; return true;
    }
    __device__ __forceinline__ const char* aptr(const Gemm& g, const Unit& u, size_t tstep) const { return (const char*)g.A + (size_t)u.pm * tstep; }
    __device__ __forceinline__ const char* bptr(const Gemm& g, const Unit& u, size_t tstep) const { return (const char*)g.Bt + (size_t)u.pn * tstep; }
};

struct EpiBf16 {
    static constexpr bool PERM = true;
    bf16_t* O; int ldc; bf16_t* Q0;
    __device__ __forceinline__ void operator()(const f32x4 (&acc)[2][2][4][2], const Unit& u, int wr, int wc, int fr, int fq) const {
        const bool redir = (Q0 != nullptr) && (u.pn == 0);
        bf16_t* base = redir ? Q0 : O; const int ld = redir ? 256 : ldc;
        const int row0 = u.pm * BM + wr * 64 + fr, col0 = (u.pn - ((Q0 != nullptr && !redir) ? 1 : 0)) * BM + wc * 32 + 8 * fq;
#pragma unroll
        for (int ai = 0; ai < 2; ++ai)
#pragma unroll
            for (int m = 0; m < 4; ++m) { bf16_t* rowp = base + (size_t)(row0 + ai * HALF + m * 16) * ld + col0;
#pragma unroll
                for (int bj = 0; bj < 2; ++bj) { const f32x4 v0 = acc[ai][bj][m][0], v1 = acc[ai][bj][m][1];
                    u32x4 w; w.x = pk_bf16(v0[0], v0[1]); w.y = pk_bf16(v0[2], v0[3]); w.z = pk_bf16(v1[0], v1[1]); w.w = pk_bf16(v1[2], v1[3]);
                    *(u32x4*)(rowp + bj * HALF) = w; } }
    }
};
struct EpiBf16x3 {
    static constexpr bool PERM = true;
    EpiBf16 E0, E1, E2;
    __device__ __forceinline__ void operator()(const f32x4 (&acc)[2][2][4][2], const Unit& u, int wr, int wc, int fr, int fq) const {
        if (u.gid == 0) E0(acc, u, wr, wc, fr, fq); else if (u.gid == 1) E1(acc, u, wr, wc, fr, fq); else E2(acc, u, wr, wc, fr, fq); }
};
struct EpiResidSS {
    static constexpr bool PERM = false;
    const float* X; bf16_t* X1; float* ss;
    __device__ __forceinline__ void operator()(const f32x4 (&acc)[2][2][4][2], const Unit& u, int wr, int wc, int fr, int fq) const {
        const int row0 = u.pm * BM + wr * 64 + fr, col0 = u.pn * BM + wc * 32 + 4 * fq;
#pragma unroll
        for (int ai = 0; ai < 2; ++ai)
#pragma unroll
            for (int m = 0; m < 4; ++m) { const int row = row0 + ai * HALF + m * 16; const size_t off = (size_t)row * D + col0; float s = 0.f;
#pragma unroll
                for (int bj = 0; bj < 2; ++bj)
#pragma unroll
                    for (int n = 0; n < 2; ++n) { const f32x4 xv = *(const f32x4*)(X + off + bj * HALF + n * 16); const f32x4 o = xv + acc[ai][bj][m][n];
                        *(u32x2*)(X1 + off + bj * HALF + n * 16) = f32_to_bf4(o); s += (o[0] * o[0] + o[1] * o[1]) + (o[2] * o[2] + o[3] * o[3]); }
                s += __shfl_xor(s, 16); s += __shfl_xor(s, 32);
                if (fq == 0) (void)__hip_atomic_fetch_add(ss + row, s, __ATOMIC_RELAXED, __HIP_MEMORY_SCOPE_AGENT); }
    }
};
struct EpiSwiGLU {
    static constexpr bool PERM = true;
    bf16_t* H;
    __device__ __forceinline__ void operator()(const f32x4 (&acc)[2][2][4][2], const Unit& u, int wr, int wc, int fr, int fq) const {
        const int row0 = u.pm * BM + wr * 64 + fr, col0 = (u.pn & 7) * HALF + wc * 32 + 8 * fq;
#pragma unroll
        for (int ai = 0; ai < 2; ++ai)
#pragma unroll
            for (int m = 0; m < 4; ++m) { const int row = row0 + ai * HALF + m * 16; float h[8];
                unsigned char* rowp = (unsigned char*)H + ((((size_t)(row >> 8) * (FF / 128) + (col0 >> 7)) << 15) + ((row & 255) << 7) + (col0 & 127));
#pragma unroll
                for (int n = 0; n < 2; ++n)
#pragma unroll
                    for (int j = 0; j < 4; ++j) { const float gt = acc[ai][0][m][n][j], up = acc[ai][1][m][n][j]; h[n * 4 + j] = 8.0f * gt * sigmoidf_fast(gt) * up; }
                *(u32x2*)rowp = (u32x2){pk_fp8x4(h[0], h[1], h[2], h[3]), pk_fp8x4(h[4], h[5], h[6], h[7])}; }
    }
};
struct EpiGateScale {
    static constexpr bool PERM = true;
    unsigned char* Y; const float* gate;
    __device__ __forceinline__ void operator()(const f32x4 (&acc)[2][2][4][2], const Unit& u, int wr, int wc, int fr, int fq) const {
        const int row0 = u.pm * BM + wr * 64 + fr, col0 = (u.pn & 3) * BM + wc * 32 + 8 * fq;
#pragma unroll
        for (int ai = 0; ai < 2; ++ai)
#pragma unroll
            for (int m = 0; m < 4; ++m) { const int row = row0 + ai * HALF + m * 16; unsigned char* rowp = Y + (size_t)row * D + col0;
#pragma unroll
                for (int bj = 0; bj < 2; ++bj) { f32x4 v0 = acc[ai][bj][m][0] * 16.0f, v1 = acc[ai][bj][m][1] * 16.0f;
#pragma unroll
                    for (int e = 0; e < 4; ++e) { v0[e] = __builtin_amdgcn_fmed3f(v0[e], -448.0f, 448.0f); v1[e] = __builtin_amdgcn_fmed3f(v1[e], -448.0f, 448.0f); }
                    *(u32x2*)(rowp + bj * HALF) = (u32x2){pk_fp8x4(v0[0], v0[1], v0[2], v0[3]), pk_fp8x4(v1[0], v1[1], v1[2], v1[3])}; } }
    }
};

template <class Epi, class Sched, bool GATHER, bool ATILED = false, bool FP8 = false>
__device__ __forceinline__ void gemm_phase(PG8_LAS unsigned char* lds, const Gemm g, const Sched& S, const Epi& E, const int* rowtok, const int wv) {
    int tid = tid_of(wv); asm volatile("" : "+v"(tid));
    const int wid = __builtin_amdgcn_readfirstlane(tid >> 6), lane = tid & 63, wr = wid >> 2, wc = wid & 3, fr = lane & 15, fq = lane >> 4;
    const int K = g.K, nt = K / BK;
    unsigned voffA0, voffB0;
    { int R, C; stage_rc(tid * 16, R, C); const int Rb = Epi::PERM ? ((R & ~31) + perm32(R & 31)) : R;
      voffA0 = ATILED ? (unsigned)(R * BK + C) * 2u : (unsigned)(R * K + C) * 2u; voffB0 = (unsigned)(Rb * K + C) * 2u; }
    const size_t dA = ATILED ? (size_t)64 * BK * 2 : (size_t)64 * K * 2, dB = (size_t)64 * K * 2;
    unsigned vAc[2][2], vAn[2][2];
    const size_t kstep = (size_t)(BK * 2);
    const size_t hstep = (size_t)HALF * K * 2;
    const size_t tstep = 2 * hstep;
    const size_t kstepA = ATILED ? (size_t)BM * BK * 2 : kstep, hstepA = ATILED ? (size_t)HALF * BK * 2 : hstep;
    const unsigned ldsw = (unsigned)wid * 1024u;
    const unsigned ldsbase = __builtin_amdgcn_readfirstlane((unsigned)(size_t)lds) + ldsw;
    const int aoff = lds_byte(wr * 64 + fr, fq * 8), boff = lds_byte(wc * 32 + fr, fq * 8);
#define PG8_SA(b, h) (((b) * 2 + (h)) * HTB)
#define PG8_SB(b, h) ((4 + (b) * 2 + (h)) * HTB)
#define PG8_GLDS(vo_, sb_, lo_) asm volatile("s_add_u32 m0, %2, %3\n\ts_nop 0\n\tglobal_load_lds_dwordx4 %0, %1" :: "v"(vo_), "s"((const void*)(sb_)), "s"(ldsbase), "n"(lo_) : "m0", "scc", "memory")
#define PG8_STAGE_D(bufoff, gbase, voff0, delta) do { PG8_GLDS(voff0, gbase, (bufoff)); PG8_GLDS(voff0, (const char*)(gbase) + (delta), (bufoff) + 8192); } while (0)
#define PG8_STAGE(bufoff, gbase, voff) do { PG8_GLDS((voff)[0], gbase, (bufoff)); PG8_GLDS((voff)[1], gbase, (bufoff) + 8192); } while (0)
#define PG8_STAGE_A(bufoff, hh, dbase, kbytes, vsel) do { if constexpr (GATHER) { PG8_STAGE(bufoff, (const char*)g.A + (kbytes), (vsel)[hh]); } else { PG8_STAGE_D(bufoff, (dbase) + ((hh) ? hstepA : 0), voffA0, dA); } } while (0)
#define PG8_GATHER_OFF(dst, un) do { int R_, C_; stage_rc(tid * 16, R_, C_); _Pragma("unroll") for (int _h = 0; _h < 2; ++_h) _Pragma("unroll") for (int _i = 0; _i < 2; ++_i) \
        (dst)[_h][_i] = (unsigned)rowtok[(un).pm * BM + _h * HALF + R_ + 64 * _i] * (unsigned)(K * 2) + (unsigned)(C_ * 2); } while (0)
#define PG8_LDA(dst, b, h) do { _Pragma("unroll") for (int m = 0; m < 4; ++m) _Pragma("unroll") for (int k = 0; k < 2; ++k) dst[m][k] = *(const PG8_LAS bf16x8*)(lds + PG8_SA(b, h) + aoff + m * 2048 + k * 1024); } while (0)
#define PG8_LDB(dst, b, h) do { _Pragma("unroll") for (int n = 0; n < 2; ++n) _Pragma("unroll") for (int k = 0; k < 2; ++k) dst[n][k] = *(const PG8_LAS bf16x8*)(lds + PG8_SB(b, h) + boff + n * 2048 + k * 1024); } while (0)
#define PG8_MMA(ai, bj, At, Bt) do { __builtin_amdgcn_s_setprio(1); _Pragma("unroll") for (int m = 0; m < 4; ++m) _Pragma("unroll") for (int n = 0; n < 2; ++n) _Pragma("unroll") for (int k = 0; k < 2; ++k) \
        acc[ai][bj][m][n] = __builtin_amdgcn_mfma_f32_16x16x32_bf16(Bt[n][k], At[m][k], acc[ai][bj][m][n], 0, 0, 0); __builtin_amdgcn_s_setprio(0); } while (0)
#define PG8_CAT8(lo_, hi_) __builtin_shufflevector(lo_, hi_, 0, 1, 2, 3, 4, 5, 6, 7)
#define PG8_LDA8(b, h) do { _Pragma("unroll") for (int m = 0; m < 4; ++m) { const v4i lo_ = *(const PG8_LAS v4i*)(lds + PG8_SA(b, h) + aoff + m * 2048), hi_ = *(const PG8_LAS v4i*)(lds + PG8_SA(b, h) + aoff + m * 2048 + 1024); A8[m] = PG8_CAT8(lo_, hi_); } } while (0)
#define PG8_LDB8(dst, b, h) do { _Pragma("unroll") for (int n = 0; n < 2; ++n) { const v4i lo_ = *(const PG8_LAS v4i*)(lds + PG8_SB(b, h) + boff + n * 2048), hi_ = *(const PG8_LAS v4i*)(lds + PG8_SB(b, h) + boff + n * 2048 + 1024); dst[n] = PG8_CAT8(lo_, hi_); } } while (0)
#define PG8_MMA8(ai, bj, Bt8) do { __builtin_amdgcn_s_setprio(1); _Pragma("unroll") for (int m = 0; m < 4; ++m) _Pragma("unroll") for (int n = 0; n < 2; ++n) \
        acc[ai][bj][m][n] = __builtin_amdgcn_mfma_scale_f32_16x16x128_f8f6f4(Bt8[n], A8[m], acc[ai][bj][m][n], 0, 0, 0, g.sw, 0, g.sx); __builtin_amdgcn_s_setprio(0); } while (0)
#define PG8_LDAX(b, h) do { if constexpr (FP8) { PG8_LDA8(b, h); } else { PG8_LDA(At, b, h); } } while (0)
#define PG8_LDBX(w, b, h) do { if constexpr (FP8) { if (w) { PG8_LDB8(B81, b, h); } else { PG8_LDB8(B80, b, h); } } else { if (w) { PG8_LDB(B1, b, h); } else { PG8_LDB(B0, b, h); } } } while (0)
#define PG8_MMX(ai, bj, w) do { if constexpr (FP8) { if (w) { PG8_MMA8(ai, bj, B81); } else { PG8_MMA8(ai, bj, B80); } } else { if (w) { PG8_MMA(ai, bj, At, B1); } else { PG8_MMA(ai, bj, At, B0); } } } while (0)
#define PG8_WAIT_V(n) asm volatile("s_waitcnt vmcnt(" #n ")" ::: "memory")
#define PG8_WAIT_L(n) asm volatile("s_waitcnt lgkmcnt(" #n ")" ::: "memory")
#define PG8_BAR __builtin_amdgcn_s_barrier()
#define PG8_SCHED __builtin_amdgcn_sched_barrier(0)
    Unit cur, nxt; int ui = 0;
    if (!S.next(0, cur)) return;
    f32x4 acc[2][2][4][2];
#pragma unroll
    for (int a = 0; a < 2; ++a)
#pragma unroll
        for (int b = 0; b < 2; ++b)
#pragma unroll
            for (int m = 0; m < 4; ++m)
#pragma unroll
                for (int n = 0; n < 2; ++n) acc[a][b][m][n] = (f32x4){0.f, 0.f, 0.f, 0.f};
    bf16x8 At[4][2], B0[2][2], B1[2][2]; v8i A8[4], B80[2], B81[2];
    const char* cA = GATHER ? (const char*)g.A : S.aptr(g, cur, tstep); const char* cB = S.bptr(g, cur, tstep);
    if constexpr (GATHER) { PG8_GATHER_OFF(vAc, cur); }
    PG8_STAGE_D(PG8_SB(0, 0), cB, voffB0, dB); PG8_STAGE_A(PG8_SA(0, 0), 0, cA, 0, vAc); PG8_STAGE_D(PG8_SB(0, 1), cB + hstep, voffB0, dB); PG8_STAGE_A(PG8_SA(0, 1), 1, cA, 0, vAc);
    if (wr == 1) PG8_BAR;
    PG8_WAIT_V(4); PG8_BAR;
    PG8_STAGE_D(PG8_SB(1, 0), cB + kstep, voffB0, dB); PG8_STAGE_A(PG8_SA(1, 0), 0, cA + kstepA, kstep, vAc); PG8_STAGE_D(PG8_SB(1, 1), cB + hstep + kstep, voffB0, dB);
    PG8_WAIT_V(6); PG8_BAR;
    for (;;) {
        const bool has_next = S.next(ui + 1, nxt);
        const char* nA = (has_next && !GATHER) ? S.aptr(g, nxt, tstep) : cA; const char* nB = has_next ? S.bptr(g, nxt, tstep) : cB;
        if constexpr (GATHER) { if (has_next) { PG8_GATHER_OFF(vAn, nxt); } else {
#pragma unroll
            for (int _h = 0; _h < 2; ++_h)
#pragma unroll
                for (int _i = 0; _i < 2; ++_i) vAn[_h][_i] = vAc[_h][_i]; } }
#pragma unroll 1
        for (int t = 0; t < nt; t += 2) {
            const bool last = (t == nt - 2);
            const size_t k1 = (size_t)(t + 1) * kstep, k2 = last ? 0 : (size_t)(t + 2) * kstep, k3 = k2 + kstep;
            const char* a1 = cA + (size_t)(t + 1) * kstepA;
            const char* a2 = last ? nA : cA + (size_t)(t + 2) * kstepA; const char* b2 = last ? nB : cB + (size_t)(t + 2) * kstep;
            const char* a3 = a2 + kstepA; const char* b3 = b2 + kstep;
            PG8_LDBX(0, 0, 0); PG8_SCHED; PG8_LDAX(0, 0); PG8_STAGE_A(PG8_SA(1, 1), 1, a1, k1, vAc);
            if constexpr (GATHER) { if (last) {
#pragma unroll
                for (int _h = 0; _h < 2; ++_h)
#pragma unroll
                    for (int _i = 0; _i < 2; ++_i) vAc[_h][_i] = vAn[_h][_i]; } }
            PG8_WAIT_L(8); PG8_BAR; PG8_WAIT_L(0); PG8_MMX(0, 0, 0); PG8_BAR; PG8_SCHED;
            PG8_LDBX(1, 0, 1); PG8_STAGE_D(PG8_SB(0, 0), b2, voffB0, dB);
            PG8_BAR; PG8_WAIT_L(0); PG8_MMX(0, 1, 1); PG8_BAR;
            PG8_LDAX(0, 1); PG8_STAGE_A(PG8_SA(0, 0), 0, a2, k2, vAc);
            PG8_BAR; PG8_WAIT_L(0); PG8_MMX(1, 0, 0); PG8_BAR; PG8_SCHED;
            PG8_STAGE_D(PG8_SB(0, 1), b2 + hstep, voffB0, dB);
            PG8_WAIT_V(6); PG8_BAR; PG8_MMX(1, 1, 1); PG8_BAR;
            PG8_LDBX(0, 1, 0); PG8_SCHED; PG8_LDAX(1, 0); PG8_STAGE_A(PG8_SA(0, 1), 1, a2, k2, vAc);
            PG8_WAIT_L(8); PG8_BAR; PG8_WAIT_L(0); PG8_MMX(0, 0, 0); PG8_BAR; PG8_SCHED;
            PG8_LDBX(1, 1, 1); PG8_STAGE_D(PG8_SB(1, 0), b3, voffB0, dB);
            PG8_BAR; PG8_WAIT_L(0); PG8_MMX(0, 1, 1); PG8_BAR;
            PG8_LDAX(1, 1); PG8_STAGE_A(PG8_SA(1, 0), 0, a3, k3, vAc);
            PG8_BAR; PG8_WAIT_L(0); PG8_MMX(1, 0, 0); PG8_BAR; PG8_SCHED;
            PG8_STAGE_D(PG8_SB(1, 1), b3 + hstep, voffB0, dB);
            PG8_WAIT_V(6); PG8_BAR; PG8_MMX(1, 1, 1); PG8_BAR;
        }
        E(acc, cur, wr, wc, fr, fq);
        if (!has_next) break;
#pragma unroll
        for (int a = 0; a < 2; ++a)
#pragma unroll
            for (int b = 0; b < 2; ++b)
#pragma unroll
                for (int m = 0; m < 4; ++m)
#pragma unroll
                    for (int n = 0; n < 2; ++n) acc[a][b][m][n] = (f32x4){0.f, 0.f, 0.f, 0.f};
        cur = nxt; cA = nA; cB = nB; ++ui;
        if constexpr (GATHER) {
#pragma unroll
            for (int _h = 0; _h < 2; ++_h)
#pragma unroll
                for (int _i = 0; _i < 2; ++_i) vAc[_h][_i] = vAn[_h][_i]; }
    }
    PG8_WAIT_V(0);
    if (wr == 0) PG8_BAR;
    PG8_BAR;
#undef PG8_SA
#undef PG8_SB
#undef PG8_STAGE
#undef PG8_STAGE_D
#undef PG8_GLDS
#undef PG8_STAGE_A
#undef PG8_GATHER_OFF
#undef PG8_LDA
#undef PG8_LDB
#undef PG8_MMA
#undef PG8_MMA8
#undef PG8_LDA8
#undef PG8_LDB8
#undef PG8_LDAX
#undef PG8_LDBX
#undef PG8_MMX
#undef PG8_CAT8
#undef PG8_WAIT_V
#undef PG8_WAIT_L
#undef PG8_BAR
#undef PG8_SCHED
}
}

struct Args {
    const float* in[29];
    float* out; unsigned char* ws;
    int ph_lo, ph_hi;
    int wv, zero_;
};
enum { I_X = 0, I_MEM, I_NMIXG, I_NMEMG, I_WIN, I_WMK, I_WMV, I_CONVW, I_CONVB, I_CLNG, I_CLNB, I_SHIFTMU, I_DW0, I_DUP, I_IA0, I_IUP, I_GUP, I_KK, I_KA, I_RK,
       I_LNXG, I_LNXB, I_WOUT, I_NFFNG, I_WROUTER, I_WEG, I_WEU, I_WED, I_FNG };

template <bool F8 = false>
__device__ __forceinline__ void transpose_item(const float* W, int N, bf16_t* WT, int K, int k0, int n0, int drow0, LAS float* scr, int lane) {
    {
        f32x4 v[8];
#pragma unroll
        for (int i = 0; i < 8; ++i) v[i] = *(const f32x4*)(W + (size_t)(k0 + 8 * i + (lane >> 3)) * N + n0 + 4 * (lane & 7));
#pragma unroll
        for (int i = 0; i < 8; ++i) { LAS float* d = scr + (8 * i + (lane >> 3)) * 33 + 4 * (lane & 7); d[0] = v[i].x; d[1] = v[i].y; d[2] = v[i].z; d[3] = v[i].w; }
    }
    asm volatile("s_waitcnt lgkmcnt(0)" ::: "memory");
    const int c = lane & 7;
#pragma unroll
    for (int j = 0; j < 4; ++j) { const int n = (lane >> 3) + 8 * j; const LAS float* s = scr + (8 * c) * 33 + n;
        if constexpr (F8) { *(u32x2*)((unsigned char*)WT + (size_t)(drow0 + n) * K + k0 + 8 * c) = (u32x2){pk_fp8x4(32.f * s[0 * 33], 32.f * s[1 * 33], 32.f * s[2 * 33], 32.f * s[3 * 33]), pk_fp8x4(32.f * s[4 * 33], 32.f * s[5 * 33], 32.f * s[6 * 33], 32.f * s[7 * 33])}; }
        else { u32x4 o; o.x = pk_bf16(s[0 * 33], s[1 * 33]); o.y = pk_bf16(s[2 * 33], s[3 * 33]); o.z = pk_bf16(s[4 * 33], s[5 * 33]); o.w = pk_bf16(s[6 * 33], s[7 * 33]);
            *(u32x4*)(WT + (size_t)(drow0 + n) * K + k0 + 8 * c) = o; } }
    asm volatile("s_waitcnt lgkmcnt(0)" ::: "memory");
}
__device__ __forceinline__ void expert_prep_items(const Args& a, LAS unsigned char* lds, int widx, int nw, int it_lo, int it_hi) {
    int tid = tid_of(a.wv); asm volatile("" : "+v"(tid)); const int lane = tid & 63, wave = __builtin_amdgcn_readfirstlane(tid >> 6);
    LAS float* scr = (LAS float*)(lds + wave * 16384);
    unsigned char* ws = a.ws;
    constexpr int S_EXP = 16 * 16 * 32;
    for (int r = it_lo + widx; r < it_hi; r += nw) {
        const int which = r / S_EXP, q = r % S_EXP, e = q / 512, kb = (q % 512) / 32, nb = q % 32, n0 = nb * 32;
        if (which == 0) transpose_item<true>(a.in[I_WEG] + (size_t)e * D * FF, FF, (bf16_t*)(ws + WS_WGUT + (size_t)e * 2048 * D), D, kb * 64, n0, (n0 >> 7) * 256 + (n0 & 127), scr, lane);
        else if (which == 1) transpose_item<true>(a.in[I_WEU] + (size_t)e * D * FF, FF, (bf16_t*)(ws + WS_WGUT + (size_t)e * 2048 * D), D, kb * 64, n0, (n0 >> 7) * 256 + 128 + (n0 & 127), scr, lane);
        else transpose_item<true>(a.in[I_WED] + (size_t)e * FF * D, D, (bf16_t*)(ws + WS_WDT + (size_t)e * D * FF), FF, kb * 64, n0, n0, scr, lane);
    }
}

__device__ __forceinline__ void rms_row_to_bf16(const float* xrow, const float* g, bf16_t* orow, int lane) {
    const f32x4* xr = (const f32x4*)xrow + lane; const f32x4* gr = (const f32x4*)g + lane;
    f32x4 v[4]; float s = 0.f;
#pragma unroll
    for (int j = 0; j < 4; ++j) { v[j] = xr[64 * j]; s += (v[j].x * v[j].x + v[j].y * v[j].y) + (v[j].z * v[j].z + v[j].w * v[j].w); }
    const float rs = 1.0f / sqrtf(wave_sum(s) * (1.f / D) + 1e-6f);
    u32x2* o8 = (u32x2*)orow + lane;
#pragma unroll
    for (int j = 0; j < 4; ++j) { const f32x4 gg = gr[64 * j]; u32x2 w; w.x = pk_bf16(v[j].x * rs * gg.x, v[j].y * rs * gg.y); w.y = pk_bf16(v[j].z * rs * gg.z, v[j].w * rs * gg.w); o8[64 * j] = w; }
}
__device__ __forceinline__ void phase_prep(const Args& a, LAS unsigned char* lds, int G) {
    int tid = tid_of(a.wv); asm volatile("" : "+v"(tid)); const int lane = tid & 63, wave = __builtin_amdgcn_readfirstlane(tid >> 6);
    LAS float* scr = (LAS float*)(lds + wave * 16384);
    const int gw = blockIdx.x * 8 + wave, NGW = G * 8;
    unsigned char* ws = a.ws;
    constexpr int S_WIN = 16 * 80, S_WOUT = 16 * 32, S_MK = 16 * 8, S_SM = 12, S_GUP = 24;
    constexpr int NITEMS = S_WIN + S_WOUT + 2 * S_MK + 4 * S_SM + S_GUP;
    for (int it = gw; it < NITEMS; it += NGW) {
        int r = it;
        if (r < S_WIN) { const int kb = r / 80, nb = r % 80; transpose_item(a.in[I_WIN], IN_PROJ, (bf16_t*)(ws + WS_WINT), D, kb * 64, nb * 32, nb * 32, scr, lane); continue; } r -= S_WIN;
        if (r < S_WOUT) { const int kb = r / 32, nb = r % 32; transpose_item(a.in[I_WOUT], D, (bf16_t*)(ws + WS_WOUTT), D, kb * 64, nb * 32, nb * 32, scr, lane); continue; } r -= S_WOUT;
        if (r < S_MK) { const int kb = r / 8, nb = r % 8; transpose_item(a.in[I_WMK], 256, (bf16_t*)(ws + WS_WKT), D, kb * 64, nb * 32, nb * 32, scr, lane); continue; } r -= S_MK;
        if (r < S_MK) { const int kb = r / 8, nb = r % 8; transpose_item(a.in[I_WMV], 256, (bf16_t*)(ws + WS_WVT), D, kb * 64, nb * 32, nb * 32, scr, lane); continue; } r -= S_MK;
        if (r < 4 * S_SM) { const int which = r / S_SM, nb = r % S_SM;
            const float* src = (which < 2 ? a.in[I_DUP] : a.in[I_IUP]) + (size_t)(which & 1) * 64 * RW;
            transpose_item(src, RW, (bf16_t*)(ws + WS_SMALL) + (size_t)which * RW * 64, 64, 0, nb * 32, nb * 32, scr, lane); continue; } r -= 4 * S_SM;
        { const int kb = r / 12, nb = r % 12; transpose_item(a.in[I_GUP], RW, (bf16_t*)(ws + WS_SMALL) + (size_t)4 * RW * 64, 128, kb * 64, nb * 32, nb * 32, scr, lane); }
    }
    for (int m = gw; m < T; m += NGW) rms_row_to_bf16(a.in[I_X] + (size_t)m * D, a.in[I_NMIXG], (bf16_t*)(ws + WS_XH) + (size_t)m * D, lane);
    for (int m = gw; m < BATCH * NMEM; m += NGW) rms_row_to_bf16(a.in[I_MEM] + (size_t)m * D, a.in[I_NMEMG], (bf16_t*)(ws + WS_MEMN) + (size_t)m * D, lane);
}

constexpr int AT_KS = 144;
constexpr int AT_VS = 520;
constexpr int AT_VOFF = 256 * AT_KS;
__device__ __forceinline__ bf16x8 pack_step(const f32x16& x, int s) {
    u32x4 p;
    asm volatile("v_cvt_pk_bf16_f32 %0, %4, %5\n\tv_cvt_pk_bf16_f32 %1, %6, %7\n\tv_cvt_pk_bf16_f32 %2, %8, %9\n\tv_cvt_pk_bf16_f32 %3, %10, %11\n\ts_nop 1"
                 : "=&v"(p[0]), "=&v"(p[1]), "=&v"(p[2]), "=&v"(p[3])
                 : "v"(x[8 * s]), "v"(x[8 * s + 1]), "v"(x[8 * s + 2]), "v"(x[8 * s + 3]), "v"(x[8 * s + 4]), "v"(x[8 * s + 5]), "v"(x[8 * s + 6]), "v"(x[8 * s + 7]));
    return __builtin_bit_cast(bf16x8, p);
}
__device__ __forceinline__ void attn_unit(const Args& a, LAS unsigned char* lds, int unit) {
    int tid = tid_of(a.wv); asm volatile("" : "+v"(tid)); const int lane = tid & 63, wave = __builtin_amdgcn_readfirstlane(tid >> 6), r = lane & 31, h = lane >> 5;
    const int b = unit >> 2, hh = unit & 3;
    const bf16_t* Qb = (const bf16_t*)(a.ws + WS_Q); const bf16_t* KM = (const bf16_t*)(a.ws + WS_KMEM); const bf16_t* VT = (const bf16_t*)(a.ws + WS_VT);
    bf16_t* MIX = (bf16_t*)(a.ws + WS_MIX);
    __syncthreads();
#pragma unroll
    for (int i = 0; i < 4; ++i) { const int c = tid + 512 * i, key = c >> 3, ch = c & 7;
        const u32x4 v = *(const u32x4*)(KM + (size_t)(b * NMEM + key) * 256 + hh * 64 + ch * 8);
        *(LAS u32x4*)(lds + key * AT_KS + ch * 16) = v; }
#pragma unroll
    for (int i = 0; i < 4; ++i) { const int c = tid + 512 * i, d = c >> 5, ch = c & 31;
        const u32x4 v = *(const u32x4*)(VT + (size_t)(hh * 64 + d) * (BATCH * NMEM) + b * NMEM + ch * 8);
        LAS u32x2* dst = (LAS u32x2*)(lds + AT_VOFF + d * AT_VS + ch * 16);
        dst[0] = (u32x2){v.x, v.y}; dst[1] = (u32x2){v.z, v.w}; }
    __syncthreads();
#pragma unroll 1
    for (int tile = 0; tile < 16; ++tile) {
    const int tok0 = b * SEQ + tile * 256 + wave * 32;
    bf16x8 qf[4];
#pragma unroll
    for (int ks = 0; ks < 4; ++ks) qf[ks] = *(const bf16x8*)(Qb + (size_t)(tok0 + r) * 256 + hh * 64 + ks * 16 + h * 8);
    const float sc = 0.125f * 1.4426950408889634f;
    float m_run = -3.0e38f, sum = 0.f;
    f32x16 o[2];
#pragma unroll
    for (int dt = 0; dt < 2; ++dt)
#pragma unroll
        for (int i = 0; i < 16; ++i) o[dt][i] = 0.f;
#pragma unroll 1
    for (int kh = 0; kh < 2; ++kh) {
        f32x16 s[4];
#pragma unroll
        for (int k4 = 0; k4 < 4; ++k4) {
#pragma unroll
            for (int i = 0; i < 16; ++i) s[k4][i] = 0.f;
#pragma unroll
            for (int ks = 0; ks < 4; ++ks) { const bf16x8 ka = *(const LAS bf16x8*)(lds + ((kh * 4 + k4) * 32 + r) * AT_KS + (ks * 16 + h * 8) * 2);
                s[k4] = __builtin_amdgcn_mfma_f32_32x32x16_bf16(ka, qf[ks], s[k4], 0, 0, 0); }
        }
        float mx = m_run;
#pragma unroll
        for (int k4 = 0; k4 < 4; ++k4)
#pragma unroll
            for (int i = 0; i < 16; ++i) mx = fmaxf(mx, s[k4][i]);
        mx = fmaxf(mx, __shfl_xor(mx, 32));
        const float alpha = __builtin_amdgcn_exp2f((m_run - mx) * sc);
        float ps = 0.f;
#pragma unroll
        for (int k4 = 0; k4 < 4; ++k4)
#pragma unroll
            for (int i = 0; i < 16; ++i) { const float e = __builtin_amdgcn_exp2f((s[k4][i] - mx) * sc); s[k4][i] = e; ps += e; }
        ps += __shfl_xor(ps, 32);
        sum = sum * alpha + ps; m_run = mx;
#pragma unroll
        for (int dt = 0; dt < 2; ++dt)
#pragma unroll
            for (int i = 0; i < 16; ++i) o[dt][i] *= alpha;
#pragma unroll
        for (int k4 = 0; k4 < 4; ++k4)
#pragma unroll
            for (int s2 = 0; s2 < 2; ++s2) {
                const bf16x8 pb = pack_step(s[k4], s2);
#pragma unroll
                for (int dt = 0; dt < 2; ++dt) {
                    const LAS unsigned char* vp = lds + AT_VOFF + (32 * dt + r) * AT_VS + (32 * (kh * 4 + k4) + 16 * s2 + 4 * h) * 2;
                    const s16x4 lo = *(const LAS s16x4*)vp, hi = *(const LAS s16x4*)(vp + 16);
                    const bf16x8 va = __builtin_shufflevector(lo, hi, 0, 1, 2, 3, 4, 5, 6, 7);
                    o[dt] = __builtin_amdgcn_mfma_f32_32x32x16_bf16(va, pb, o[dt], 0, 0, 0);
                }
            }
    }
    const float inv = 1.0f / sum;
    bf16_t* orow = MIX + (size_t)(tok0 + r) * D + hh * 64;
#pragma unroll
    for (int dt = 0; dt < 2; ++dt)
#pragma unroll
        for (int gq = 0; gq < 4; ++gq) { u32x2 w; w.x = pk_bf16(o[dt][4 * gq] * inv, o[dt][4 * gq + 1] * inv); w.y = pk_bf16(o[dt][4 * gq + 2] * inv, o[dt][4 * gq + 3] * inv);
            *(u32x2*)(orow + 32 * dt + 8 * gq + 4 * h) = w; }
    }
}

constexpr int CV_U = 0, CV_C = 94 * 384 * 2, CV_W = CV_C + 64 * 384 * 2, CV_PRM = CV_W + 31 * 384 * 2;
static_assert(CV_PRM + 3 * 384 * 4 <= LDS_BYTES - 512, "conv LDS map");
__device__ __forceinline__ void conv_stream(const Args& a, LAS unsigned char* lds, int u0, int G) {
    int tid = tid_of(a.wv); asm volatile("" : "+v"(tid)); const int lane = tid & 63, wave = __builtin_amdgcn_readfirstlane(tid >> 6);
    if (u0 >= 1024) return;
    const bf16_t* P = (const bf16_t*)(a.ws + WS_P); bf16_t* MIX = (bf16_t*)(a.ws + WS_MIX);
    LAS _Float16* U = (LAS _Float16*)(lds + CV_U);
    LAS _Float16* Cc = (LAS _Float16*)(lds + CV_C);
    LAS _Float16* W16 = (LAS _Float16*)(lds + CV_W); LAS float* PRM = (LAS float*)(lds + CV_PRM);
    __syncthreads();
    for (int i = tid; i < 31 * CW; i += NTHREADS) W16[i] = (_Float16)a.in[I_CONVW][i];
    for (int i = tid; i < 3 * CW; i += NTHREADS) PRM[i] = (i < CW) ? a.in[I_CONVB][i] : (i < 2 * CW) ? a.in[I_CLNG][i - CW] : a.in[I_CLNB][i - 2 * CW];
    u32x4 vvv[9], ggg[9];
#define CONV_LOAD(un_) do { const int b_ = (un_) >> 6, t0_ = ((un_) & 63) * 64; \
        _Pragma("unroll") for (int u9 = 0; u9 < 9; ++u9) { const int q = tid + u9 * NTHREADS, j = q / 48, cc = (q % 48) * 8, sq = t0_ - 15 + j; const bool ok = (q < 94 * 48) && sq >= 0 && sq < SEQ; \
            const bf16_t* row = P + (size_t)(b_ * SEQ + (ok ? sq : 0)) * PLD + cc; \
            vvv[u9] = ok ? *(const u32x4*)row : (u32x4){0u, 0u, 0u, 0u}; ggg[u9] = ok ? *(const u32x4*)(row + CW) : (u32x4){0u, 0u, 0u, 0u}; } } while (0)
    CONV_LOAD(u0);
#pragma unroll 1
    for (int unit = u0; unit < 1024; unit += G) {
        const int b = unit >> 6, t0 = (unit & 63) * 64;
        __syncthreads();
#pragma unroll
        for (int u9 = 0; u9 < 9; ++u9) { const int q = tid + u9 * NTHREADS, j = q / 48, cc = (q % 48) * 8;
            if (q < 94 * 48) {
                const unsigned vw[4] = {vvv[u9].x, vvv[u9].y, vvv[u9].z, vvv[u9].w}, gw[4] = {ggg[u9].x, ggg[u9].y, ggg[u9].z, ggg[u9].w};
                float u[8];
#pragma unroll
                for (int k = 0; k < 4; ++k) { u[2 * k] = bf_lo(vw[k]) * sigmoidf_fast(bf_lo(gw[k])); u[2 * k + 1] = bf_hi(vw[k]) * sigmoidf_fast(bf_hi(gw[k])); }
                LAS f16x4* dst = (LAS f16x4*)(U + j * CW + cc); dst[0] = (f16x4){(_Float16)u[0], (_Float16)u[1], (_Float16)u[2], (_Float16)u[3]}; dst[1] = (f16x4){(_Float16)u[4], (_Float16)u[5], (_Float16)u[6], (_Float16)u[7]}; }
        }
        if (unit + G < 1024) CONV_LOAD(unit + G);
        __syncthreads();
#pragma unroll 1
        for (int k3 = 0; k3 < 3; ++k3) { const int it = tid + k3 * NTHREADS, c = 2 * (it % 192), g8 = (it / 192) * 8;
            f16x2 w2[31], res[8];
#pragma unroll
            for (int kk = 0; kk < 31; ++kk) w2[kk] = *(const LAS f16x2*)(W16 + kk * CW + c);
            const f16x2 bias2 = {(_Float16)PRM[c], (_Float16)PRM[c + 1]};
#pragma unroll
            for (int tt = 0; tt < 8; ++tt) res[tt] = bias2;
#pragma unroll
            for (int jj = 0; jj < 38; ++jj) { const f16x2 uv = *(const LAS f16x2*)(U + (g8 + jj) * CW + c);
#pragma unroll
                for (int tt = 0; tt < 8; ++tt) { if (jj - tt >= 0 && jj - tt <= 30) res[tt] += uv * w2[jj - tt]; } }
#pragma unroll
            for (int tt = 0; tt < 8; ++tt) *(LAS f16x2*)(Cc + (g8 + tt) * CW + c) = res[tt];
        }
        __syncthreads();
        for (int tt = 0; tt < 8; ++tt) { const int t = wave * 8 + tt;
            float v[6]; float sm = 0.f;
#pragma unroll
            for (int i = 0; i < 6; ++i) { v[i] = (float)Cc[t * CW + lane + 64 * i]; sm += v[i]; }
            const float mean = wave_sum(sm) * (1.f / CW); float q = 0.f;
#pragma unroll
            for (int i = 0; i < 6; ++i) { v[i] -= mean; q += v[i] * v[i]; }
            const float rstd = 1.0f / sqrtf(wave_sum(q) * (1.f / CW) + 1e-5f);
            bf16_t* orow = MIX + (size_t)(b * SEQ + t0 + t) * D + 256;
#pragma unroll
            for (int i = 0; i < 6; ++i) { const int c = lane + 64 * i; const float y = v[i] * rstd * PRM[CW + c] + PRM[2 * CW + c]; const float o = y * sigmoidf_fast(y);
                orow[c] = (bf16_t)(pk_bf16(o, 0.f) & 0xffffu); }
        }
    }
#undef CONV_LOAD
}

constexpr int PR_AS = 784;
constexpr int PR_RK = 64 * PR_AS;
constexpr int PR_RKS = 1536;
constexpr int PR_RN = PR_RK + 64 * PR_RKS;
constexpr int PR_CST = PR_RN + 2048;
static_assert(PR_CST + 7 * 384 * 4 <= LDS_BYTES - 64, "prep LDS map");
template <int V> struct IC { static constexpr int value = V; };
template <int CTRL> __device__ __forceinline__ f32x4 dpp4(f32x4 x) { return (f32x4){dpp_f<CTRL>(x.x), dpp_f<CTRL>(x.y), dpp_f<CTRL>(x.z), dpp_f<CTRL>(x.w)}; }
__device__ __forceinline__ void prep_unit(const Args& a, LAS unsigned char* lds, int unit) {
    int tid = tid_of(a.wv); asm volatile("" : "+v"(tid)); const int lane = tid & 63, wave = __builtin_amdgcn_readfirstlane(tid >> 6);
    const int b = unit >> 6, t0 = (unit & 63) * 64;
    const bf16_t* __restrict__ P = (const bf16_t*)(a.ws + WS_P);
    const float* __restrict__ mu = a.in[I_SHIFTMU];
    LAS float* RNs = (LAS float*)(lds + PR_RN); LAS float* CST = (LAS float*)(lds + PR_CST);
    __syncthreads();
    for (int i = tid; i < 7 * 384; i += NTHREADS) { const int w7 = i / 384, c7 = i % 384;
        CST[i] = (w7 == 0) ? a.in[I_KK][c7] : (w7 == 1) ? a.in[I_KA][c7] : (w7 == 2) ? a.in[I_RK][c7] : (w7 < 5) ? a.in[I_DW0][(w7 - 3) * RW + c7] : a.in[I_IA0][(w7 - 5) * RW + c7]; }
#ifndef PREP_REP1
#define PREP_REP1 1
#endif
    struct S1Buf { u32x4 cu[2], pv[2], nv[2]; f32x4 m0a, m0b, m1a, m1b, ka, kb; };
    const int s1row = 8 * wave + (lane >> 4), s1c = lane & 15;
    auto s1_issue = [&](auto sc, S1Buf& B) {
        constexpr int sb = decltype(sc)::value, ty = (sb / 3 == 0) ? 2 : (sb / 3 == 1) ? 0 : (sb / 3 == 2) ? 1 : 3, cg = sb % 3;
        const int c8 = ty * 384 + (cg * 16 + s1c) * 8;
#pragma unroll
        for (int th = 0; th < 2; ++th) { const int sq = t0 + s1row + 4 * th;
            const bf16_t* row = P + ((size_t)b * SEQ + sq) * PLD + 768 + c8;
            B.cu[th] = *(const u32x4*)row;
            B.pv[th] = (sq > 0) ? *(const u32x4*)(row - PLD) : (u32x4){0u, 0u, 0u, 0u};
            B.nv[th] = (sq < SEQ - 1) ? *(const u32x4*)(row + PLD) : (u32x4){0u, 0u, 0u, 0u}; }
        B.m0a = *(const f32x4*)(mu + c8); B.m0b = *(const f32x4*)(mu + c8 + 4); B.m1a = *(const f32x4*)(mu + 1536 + c8); B.m1b = *(const f32x4*)(mu + 1536 + c8 + 4);
        if (ty == 1) { B.ka = *(const f32x4*)(a.in[I_KK] + c8 - 384); B.kb = *(const f32x4*)(a.in[I_KK] + c8 - 384 + 4); }
    };
    auto s1_compute = [&](auto sc, const S1Buf& B) {
        constexpr int sb = decltype(sc)::value, ty = (sb / 3 == 0) ? 2 : (sb / 3 == 1) ? 0 : (sb / 3 == 2) ? 1 : 3, cg = sb % 3;
        const int c8 = ty * 384 + (cg * 16 + s1c) * 8;
        const float m0[8] = {B.m0a.x, B.m0a.y, B.m0a.z, B.m0a.w, B.m0b.x, B.m0b.y, B.m0b.z, B.m0b.w}, m1[8] = {B.m1a.x, B.m1a.y, B.m1a.z, B.m1a.w, B.m1b.x, B.m1b.y, B.m1b.z, B.m1b.w};
#pragma unroll
        for (int th = 0; th < 2; ++th) { const int tt = s1row + 4 * th; const size_t tok = (size_t)b * SEQ + t0 + tt;
            const u32x4 cu = B.cu[th], pv = B.pv[th], nv = B.nv[th];
            const unsigned cw[4] = {cu.x, cu.y, cu.z, cu.w}, pw[4] = {pv.x, pv.y, pv.z, pv.w}, nw[4] = {nv.x, nv.y, nv.z, nv.w};
            float pf[8];
#pragma unroll
            for (int k = 0; k < 4; ++k) { const float c0 = bf_lo(cw[k]), c1 = bf_hi(cw[k]);
                pf[2 * k] = c0 + m0[2 * k] * (bf_lo(pw[k]) - c0) + m1[2 * k] * (bf_lo(nw[k]) - c0);
                pf[2 * k + 1] = c1 + m0[2 * k + 1] * (bf_hi(pw[k]) - c1) + m1[2 * k + 1] * (bf_hi(nw[k]) - c1); }
            if (ty < 2) {
                f16x4 h0 = {(_Float16)pf[0], (_Float16)pf[1], (_Float16)pf[2], (_Float16)pf[3]}, h1 = {(_Float16)pf[4], (_Float16)pf[5], (_Float16)pf[6], (_Float16)pf[7]};
                LAS f16x4* dst = (LAS f16x4*)(lds + PR_RK + tt * PR_RKS + c8 * 2); dst[0] = h0; dst[1] = h1;
                if (ty == 1) { const f32x4 ka = B.ka, kb = B.kb;
                    float ssq = (pf[0] * ka.x) * (pf[0] * ka.x) + (pf[1] * ka.y) * (pf[1] * ka.y) + (pf[2] * ka.z) * (pf[2] * ka.z) + (pf[3] * ka.w) * (pf[3] * ka.w)
                              + (pf[4] * kb.x) * (pf[4] * kb.x) + (pf[5] * kb.y) * (pf[5] * kb.y) + (pf[6] * kb.z) * (pf[6] * kb.z) + (pf[7] * kb.w) * (pf[7] * kb.w);
                    ssq = sum8(ssq);
                    if ((lane & 7) == 0) RNs[tt * 8 + ((c8 - 384) >> 6)] = __builtin_amdgcn_rsqf(ssq + 1e-12f); }
            } else if (ty == 2) {
                u32x4 w; w.x = pk_bf16(pf[0], pf[1]); w.y = pk_bf16(pf[2], pf[3]); w.z = pk_bf16(pf[4], pf[5]); w.w = pk_bf16(pf[6], pf[7]);
                *(u32x4*)((bf16_t*)scan_arr(a.ws, 0) + hat_off(0, tok, c8 - 768)) = w;
            } else {
                const int cc = c8 - 1152;
#pragma unroll
                for (int k = 0; k < 8; ++k) { if (cg == 0) pf[k] = 1.0f - 2.0f * __builtin_amdgcn_rcpf(1.0f + __builtin_amdgcn_exp2f(2.8853900817779268f * pf[k])); else if (cg == 2) pf[k] = sigmoidf_fast(pf[k]); }
                u32x4 w; w.x = pk_bf16(pf[0], pf[1]); w.y = pk_bf16(pf[2], pf[3]); w.z = pk_bf16(pf[4], pf[5]); w.w = pk_bf16(pf[6], pf[7]);
                *(LAS u32x4*)(lds + tt * PR_AS + cc * 2) = w; }
        }
    };
#pragma unroll 1
    for (int rp1 = 0; rp1 < PREP_REP1; ++rp1) {
        S1Buf B0, B1, B2;
        s1_issue(IC<0>{}, B0); s1_issue(IC<1>{}, B1);
        s1_issue(IC<2>{}, B2); s1_compute(IC<0>{}, B0);
        s1_issue(IC<3>{}, B0); s1_compute(IC<1>{}, B1);
        s1_issue(IC<4>{}, B1); s1_compute(IC<2>{}, B2);
        s1_issue(IC<5>{}, B2); s1_compute(IC<3>{}, B0);
        s1_issue(IC<6>{}, B0); s1_compute(IC<4>{}, B1);
        s1_issue(IC<7>{}, B1); s1_compute(IC<5>{}, B2);
        s1_issue(IC<8>{}, B2); s1_compute(IC<6>{}, B0);
        s1_issue(IC<9>{}, B0); s1_compute(IC<7>{}, B1);
        s1_issue(IC<10>{}, B1); s1_compute(IC<8>{}, B2);
        s1_issue(IC<11>{}, B2); s1_compute(IC<9>{}, B0);
        s1_compute(IC<10>{}, B1); s1_compute(IC<11>{}, B2);
    }
    __syncthreads();
    const int l15 = lane & 15, kq = lane >> 4;
    float* __restrict__ PCg = (float*)(a.ws + WS_PC); float* __restrict__ BON = (float*)(a.ws + WS_BON);
    const char* SMb = (const char*)(a.ws + WS_SMALL);
    const unsigned wlo64 = (unsigned)(((8 * (l15 >> 2) + (l15 & 3)) * 64 + kq * 8) * 2), wlo128 = (unsigned)(((8 * (l15 >> 2) + (l15 & 3)) * 128 + kq * 8) * 2);
    const unsigned hlo = (unsigned)((l15 * 64 + 8 * kq) * 2), klo = (unsigned)((l15 * D + 8 * kq) * 2), glo = (unsigned)((l15 * RW + 8 * kq) * 2);
    bf16x8 Fc[16], Fn[16];
#define PREP_LOADW(hd_, kind_) do { \
        if ((kind_) < 2) { const char* w_ = SMb + ((size_t)(kind_) * RW * 64 + (size_t)(hd_) * 64 * 64) * 2; \
            _Pragma("unroll") for (int f_ = 0; f_ < 16; ++f_) Fn[f_] = *(const bf16x8*)(w_ + (size_t)(((f_ >> 2) & 1) * (2 * RW * 64 * 2) + (32 * ((f_ & 3) >> 1) + 4 * (f_ & 1)) * 128 + (f_ >> 3) * 64) + wlo64); } \
        else { const char* w_ = SMb + ((size_t)4 * RW * 64 + (size_t)(hd_) * 64 * 128) * 2; \
            _Pragma("unroll") for (int f_ = 0; f_ < 16; ++f_) Fn[f_] = *(const bf16x8*)(w_ + (size_t)((32 * ((f_ & 3) >> 1) + 4 * (f_ & 1)) * 256 + (f_ >> 2) * 64) + wlo128); } } while (0)
    auto dir_stage = [&](auto dc, const int it, const int nhd, const int nkind) {
        constexpr int d = decltype(dc)::value;
        const int hd = it >> 2, mt = it & 3, tokl = mt * 16 + l15; const size_t tb = (size_t)b * SEQ + t0 + mt * 16;
#pragma unroll
        for (int f = 0; f < 16; ++f) Fc[f] = Fn[f];
        f32x4 accW[4], accA[4];
#pragma unroll
        for (int nt = 0; nt < 4; ++nt) { accW[nt] = (f32x4){0.f, 0.f, 0.f, 0.f}; accA[nt] = (f32x4){0.f, 0.f, 0.f, 0.f}; }
#pragma unroll
        for (int ks = 0; ks < 2; ++ks) {
            const bf16x8 aw = *(const LAS bf16x8*)(lds + tokl * PR_AS + (d * 64 + ks * 32 + kq * 8) * 2), aa = *(const LAS bf16x8*)(lds + tokl * PR_AS + ((2 + d) * 64 + ks * 32 + kq * 8) * 2);
#pragma unroll
            for (int nt = 0; nt < 4; ++nt) { accW[nt] = MFMA16(Fc[ks * 8 + nt], aw, accW[nt]); accA[nt] = MFMA16(Fc[ks * 8 + 4 + nt], aa, accA[nt]); }
        }
        if (nkind >= 0) PREP_LOADW(nhd, nkind);
        const float rn = RNs[tokl * 8 + hd];
        const size_t tile_b = ((((tb >> 4) * NH + hd) << 10)) * 2;
        char* AHb = (char*)scan_arr(a.ws, 1 + 4 * d) + tile_b; char* RHb = (char*)scan_arr(a.ws, 2 + 4 * d) + tile_b; char* BHb = (char*)scan_arr(a.ws, 3 + 4 * d) + tile_b;
        char* KHb = d ? (char*)scan_arr(a.ws, 8) + (tb * D + hd * 64) * 2 : (char*)scan_arr(a.ws, 4) + tile_b; const unsigned khlo = d ? klo : hlo;
        char* PCb = (char*)(PCg + ((size_t)d * (T / 16) + (tb >> 4)) * RW + hd * 64); char* BOb = (char*)(BON + (size_t)d * T * NH + tb * NH + hd);
        float bsum = 0.f; const float first1 = (l15 == (d ? 15 : 0)) ? 1.f : 0.f;
        u32x2 hA[2], hR[2], hB[2], hK[2]; f32x4 PtS[4];
#pragma unroll
        for (int nt = 0; nt < 4; ++nt) { const int ch = hd * 64 + 32 * (nt >> 1) + 8 * kq + 4 * (nt & 1);
            const f32x4 bW = *(const LAS f32x4*)(CST + (3 + d) * 384 + ch), bA = *(const LAS f32x4*)(CST + (5 + d) * 384 + ch);
            const f32x4 kkw = *(const LAS f32x4*)(CST + ch), kaw = *(const LAS f32x4*)(CST + 384 + ch), rkw = *(const LAS f32x4*)(CST + 768 + ch);
            const f32x4 zw = accW[nt] + bW, za = accA[nt] + bA;
            f32x4 lw, av;
#pragma unroll
            for (int e = 0; e < 4; ++e) { lw[e] = -0.606531f * 1.4426950408889634f * sigmoidf_fast(zw[e]); av[e] = sigmoidf_fast(za[e]); }
            f32x4 cum = lw;
#define PREP_CUM4(SH) "v_add_f32_dpp %0, %0, %0 " SH " row_mask:0xf bank_mask:0xf bound_ctrl:1\n\tv_add_f32_dpp %1, %1, %1 " SH " row_mask:0xf bank_mask:0xf bound_ctrl:1\n\t" \
                      "v_add_f32_dpp %2, %2, %2 " SH " row_mask:0xf bank_mask:0xf bound_ctrl:1\n\tv_add_f32_dpp %3, %3, %3 " SH " row_mask:0xf bank_mask:0xf bound_ctrl:1\n\t"
            if (d == 0) asm volatile("s_nop 1\n\t" PREP_CUM4("row_shr:1") PREP_CUM4("row_shr:2") PREP_CUM4("row_shr:4") PREP_CUM4("row_shr:8") : "+v"(cum.x), "+v"(cum.y), "+v"(cum.z), "+v"(cum.w));
            else        asm volatile("s_nop 1\n\t" PREP_CUM4("row_shl:1") PREP_CUM4("row_shl:2") PREP_CUM4("row_shl:4") PREP_CUM4("row_shl:8") : "+v"(cum.x), "+v"(cum.y), "+v"(cum.z), "+v"(cum.w));
#undef PREP_CUM4
            f32x4 Pt, Pinv, Pprev;
#pragma unroll
            for (int e = 0; e < 4; ++e) { Pt[e] = __builtin_amdgcn_exp2f(cum[e]); Pinv[e] = __builtin_amdgcn_rcpf(Pt[e]);
                Pprev[e] = dpp_f<d ? 0x101 : 0x111>(Pt[e]) + first1; }
            PtS[nt] = Pt;
            const f32x4 r4 = __builtin_convertvector(*(const LAS f16x4*)(lds + PR_RK + tokl * PR_RKS + ch * 2), f32x4);
            const f32x4 k4 = __builtin_convertvector(*(const LAS f16x4*)(lds + PR_RK + tokl * PR_RKS + (384 + ch) * 2), f32x4);
            const f32x4 kk = k4 * kkw * rn, kd = k4 * (1.0f + (av - 1.0f) * kaw);
            hA[nt & 1] = f32_to_bf4(-kk * Pprev); hR[nt & 1] = f32_to_bf4(r4 * Pt); hB[nt & 1] = f32_to_bf4(kk * av * Pinv); hK[nt & 1] = f32_to_bf4(kd * Pinv);
            const f32x4 bt = r4 * kd * rkw; bsum += (bt.x + bt.y) + (bt.z + bt.w);
            if (nt & 1) { const int pr = nt >> 1;
                *(u32x4*)(AHb + (hlo + 64 * pr)) = (u32x4){hA[0].x, hA[0].y, hA[1].x, hA[1].y}; *(u32x4*)(RHb + (hlo + 64 * pr)) = (u32x4){hR[0].x, hR[0].y, hR[1].x, hR[1].y};
                *(u32x4*)(BHb + (hlo + 64 * pr)) = (u32x4){hB[0].x, hB[0].y, hB[1].x, hB[1].y}; *(u32x4*)(KHb + (khlo + 64 * pr)) = (u32x4){hK[0].x, hK[0].y, hK[1].x, hK[1].y}; }
        }
        if (l15 == (d ? 0 : 15)) {
#pragma unroll
            for (int nt = 0; nt < 4; ++nt) *(f32x4*)(PCb + (unsigned)(8 * kq * 4) + (32 * (nt >> 1) + 4 * (nt & 1)) * 4) = PtS[nt]; }
        bsum += __shfl_xor(bsum, 16); bsum += __shfl_xor(bsum, 32);
        if (kq == 0) *(float*)(BOb + (unsigned)(l15 * NH * 4)) = bsum;
    };
    auto gate_stage = [&](const int it, const int nhd, const int nkind) {
        const int hd = it >> 2, mt = it & 3, tokl = mt * 16 + l15; const size_t tb = (size_t)b * SEQ + t0 + mt * 16;
#pragma unroll
        for (int f = 0; f < 16; ++f) Fc[f] = Fn[f];
        f32x4 acc[4];
#pragma unroll
        for (int nt = 0; nt < 4; ++nt) acc[nt] = (f32x4){0.f, 0.f, 0.f, 0.f};
#pragma unroll
        for (int ks = 0; ks < 4; ++ks) { const bf16x8 afr = *(const LAS bf16x8*)(lds + tokl * PR_AS + (256 + ks * 32 + kq * 8) * 2);
#pragma unroll
            for (int nt = 0; nt < 4; ++nt) acc[nt] = MFMA16(Fc[ks * 4 + nt], afr, acc[nt]); }
        if (nkind >= 0) PREP_LOADW(nhd, nkind);
        char* Gb = (char*)((bf16_t*)(a.ws + WS_G) + tb * RW + hd * 64);
#pragma unroll
        for (int pr = 0; pr < 2; ++pr) { const u32x2 g0 = f32_to_bf4(acc[2 * pr]), g1 = f32_to_bf4(acc[2 * pr + 1]);
            *(u32x4*)(Gb + (glo + 64 * pr)) = (u32x4){g0.x, g0.y, g1.x, g1.y}; }
    };
    PREP_LOADW(wave >> 2, 0);
#pragma unroll 1
    for (int k3 = 0; k3 < 3; ++k3) { const int it = wave + 8 * k3, hd = it >> 2;
        dir_stage(IC<0>{}, it, hd, 1);
        dir_stage(IC<1>{}, it, hd, 2);
        gate_stage(it, (it + 8) >> 2, k3 < 2 ? 0 : -1);
    }
#undef PREP_LOADW
}

__device__ __forceinline__ void glds16_asm(const void* gptr, LAS unsigned char* ldst) {
    const unsigned la = __builtin_amdgcn_readfirstlane((unsigned)(size_t)ldst);
    asm volatile("s_mov_b32 m0, %1\n\ts_nop 0\n\tglobal_load_lds_dwordx4 %0, off" :: "v"(gptr), "s"(la) : "m0", "memory");
}
constexpr int CK = 16, NCHUNK = SEQ / CK, CS_NS = 8, CS_NPROD = 6, CS_NCONS = 2;
constexpr int SL_ATIL = 0, SL_RTIL = 2048, SL_BH = 4096, SL_KH = 6144, SL_V = 8192, SL_ULOC = 10240, SL_YLOC = 12288, SL_PC = 14336, SL_BYTES = 14592;
constexpr int PS_AH = 0, PS_RH = 2048, PS_BYTES = 4096;
constexpr int CS_PS_OFF = CS_NS * SL_BYTES, CS_FLAG_OFF = CS_PS_OFF + CS_NPROD * PS_BYTES;
static_assert(CS_FLAG_OFF + 64 <= LDS_BYTES - 64, "chunked scan LDS map");
__device__ __forceinline__ int swz(int t, int j) { return t * 128 + ((((j >> 3) ^ (t & 7))) << 4) + ((j & 4) << 1); }
__device__ __forceinline__ void scan_chunked_unit(const Args& a, LAS unsigned char* lds, int unit) {
    int tid = tid_of(a.wv); asm volatile("" : "+v"(tid)); const int lane = tid & 63, wave = __builtin_amdgcn_readfirstlane(tid >> 6);
    const int dir = unit & 1, bh = unit >> 1, b = bh / NH, hd = bh % NH;
    const int c16 = lane & 15, q = lane >> 4, qp = c16 >> 2, pp = c16 & 3;
    volatile LAS unsigned* FULL = (volatile LAS unsigned*)(lds + CS_FLAG_OFF);
    volatile LAS unsigned* DONE = FULL + 8;
    float* Yg = (float*)(a.ws + (dir ? WS_YB : WS_YF));
    __syncthreads();
    if (tid < 16) FULL[tid] = 0u;
    __syncthreads();
    if (wave >= CS_NCONS) {
        const int pw = wave - CS_NCONS;
        LAS unsigned char* ps = lds + CS_PS_OFF + pw * PS_BYTES;
        const bf16_t* ARR[5] = {(const bf16_t*)scan_arr(a.ws, 1 + 4 * dir), (const bf16_t*)scan_arr(a.ws, 2 + 4 * dir), (const bf16_t*)scan_arr(a.ws, 3 + 4 * dir), (const bf16_t*)scan_arr(a.ws, 4 + 4 * dir), (const bf16_t*)scan_arr(a.ws, 0)};
        const int AIDX[5] = {1 + 4 * dir, 2 + 4 * dir, 3 + 4 * dir, 4 + 4 * dir, 0};
        const float* PCg = (const float*)(a.ws + WS_PC) + (size_t)dir * (T / 16) * RW + hd * 64 + lane;
        u32x4 pf[10];
#define CS_ISSUE(cc) do { _Pragma("unroll") for (int ar_ = 0; ar_ < 5; ++ar_) _Pragma("unroll") for (int hf_ = 0; hf_ < 2; ++hf_) { \
            const int row_ = hf_ * 8 + (lane >> 3); const int st_ = (cc) * CK + row_; const int t_ = dir ? (SEQ - 1 - st_) : st_; \
            pf[ar_ * 2 + hf_] = *(const u32x4*)(ARR[ar_] + hat_off(AIDX[ar_], (size_t)b * SEQ + t_, hd * 64 + 8 * ((lane & 7) ^ (row_ & 7)))); } } while (0)
#define CS_PCLOAD(cc) PCg[(size_t)((size_t)b * (SEQ / CK) + (dir ? (NCHUNK - 1 - (cc)) : (cc))) * RW]
        CS_ISSUE(pw);
        float pcn = CS_PCLOAD(pw);
#pragma unroll 1
        for (int c = pw; c < NCHUNK; c += CS_NPROD) {
            const int slot = c % CS_NS; LAS unsigned char* sl = lds + slot * SL_BYTES;
            { unsigned sp = 0; const unsigned want = (unsigned)CS_NCONS * (unsigned)(c / CS_NS); while (DONE[slot] < want) { __builtin_amdgcn_s_sleep(1); if (++sp > (1u << 22)) break; } }
            asm volatile("" ::: "memory");
            *(LAS u32x4*)(ps + PS_AH + lane * 16) = pf[0]; *(LAS u32x4*)(ps + PS_AH + 1024 + lane * 16) = pf[1];
            *(LAS u32x4*)(ps + PS_RH + lane * 16) = pf[2]; *(LAS u32x4*)(ps + PS_RH + 1024 + lane * 16) = pf[3];
            *(LAS u32x4*)(sl + SL_BH + lane * 16) = pf[4]; *(LAS u32x4*)(sl + SL_BH + 1024 + lane * 16) = pf[5];
            *(LAS u32x4*)(sl + SL_KH + lane * 16) = pf[6]; *(LAS u32x4*)(sl + SL_KH + 1024 + lane * 16) = pf[7];
            *(LAS u32x4*)(sl + SL_V + lane * 16) = pf[8]; *(LAS u32x4*)(sl + SL_V + 1024 + lane * 16) = pf[9];
            *(LAS float*)(sl + SL_PC + lane * 4) = pcn;
            if (c + CS_NPROD < NCHUNK) { CS_ISSUE(c + CS_NPROD); pcn = CS_PCLOAD(c + CS_NPROD); }
            asm volatile("s_waitcnt lgkmcnt(0)" ::: "memory");
#ifndef PROD_REP
#define PROD_REP 1
#endif
#pragma unroll 1
            for (int rpp = 0; rpp < PROD_REP; ++rpp) {
            bf16x8 AHf[2], BHf[2], KHf[2], RHf[2];
#pragma unroll
            for (int ks = 0; ks < 2; ++ks) { const int o = swz(c16, 32 * ks + 8 * q);
                AHf[ks] = *(const LAS bf16x8*)(ps + PS_AH + o); RHf[ks] = *(const LAS bf16x8*)(ps + PS_RH + o); BHf[ks] = *(const LAS bf16x8*)(sl + SL_BH + o); KHf[ks] = *(const LAS bf16x8*)(sl + SL_KH + o); }
            f32x4 Mab = {0.f, 0.f, 0.f, 0.f}, Mak = Mab, MrbT = Mab, MrkT = Mab, MabT = Mab;
#pragma unroll
            for (int ks = 0; ks < 2; ++ks) { Mab = MFMA16(AHf[ks], BHf[ks], Mab); MabT = MFMA16(BHf[ks], AHf[ks], MabT); Mak = MFMA16(AHf[ks], KHf[ks], Mak); MrbT = MFMA16(BHf[ks], RHf[ks], MrbT); MrkT = MFMA16(KHf[ks], RHf[ks], MrkT); }
#pragma unroll
            for (int r = 0; r < 4; ++r) { const bool lt = c16 < 4 * q + r, gt = 4 * q + r < c16, le = 4 * q + r <= c16;
                Mab[r] = lt ? Mab[r] : 0.f; Mak[r] = lt ? Mak[r] : 0.f; MabT[r] = gt ? MabT[r] : 0.f; MrbT[r] = le ? MrbT[r] : 0.f; MrkT[r] = le ? MrkT[r] : 0.f; }
            const f32x4 z4 = {0.f, 0.f, 0.f, 0.f};
            const bf16x8 fN = frag_lo4(Mab), fNT = frag_lo4(MabT);
            const f32x4 N2 = MFMA16(fNT, fN, z4), N2T = MFMA16(fN, fNT, z4);
            f32x4 PT = MabT;
#pragma unroll
            for (int r = 0; r < 4; ++r) PT[r] += (4 * q + r == c16) ? 1.0f : 0.f;
            const bf16x8 fN2 = frag_lo4(N2), fN2T = frag_lo4(N2T);
            PT = MFMA16(fN2, frag_lo4(PT), PT);
            const f32x4 N4 = MFMA16(fN2T, fN2, z4), N4T = MFMA16(fN2, fN2T, z4);
            const bf16x8 fN4 = frag_lo4(N4), fN4T = frag_lo4(N4T);
            PT = MFMA16(fN4, frag_lo4(PT), PT);
            const f32x4 N8 = MFMA16(fN4T, fN4, z4);
            PT = MFMA16(frag_lo4(N8), frag_lo4(PT), PT);
            const bf16x8 LinvF = frag_lo4(PT);
            const bf16x8 MakF = frag_lo4(Mak), MrbTF = frag_lo4(MrbT);
            const f32x4 W1 = MFMA16(LinvF, MakF, z4);
            const f32x4 W1T = MFMA16(MakF, LinvF, z4);
            const f32x4 W2T = MFMA16(frag_lo4(W1), MrbTF, MrkT);
            f32x4 AtT[4], RtT[4];
#pragma unroll
            for (int jt = 0; jt < 4; ++jt) {
                const bf16x8 ahF = frag_cat(__builtin_bit_cast(u32x2, tr_read16(ps + PS_AH + swz(4 * q + qp, 16 * jt + 4 * pp))), (u32x2){0u, 0u});
                const f32x4 AtN = MFMA16(LinvF, ahF, z4);
                AtT[jt] = MFMA16(ahF, LinvF, z4);
                const f32x4 rinit = bf4_to_f32(*(const LAS u32x2*)(ps + PS_RH + swz(c16, 16 * jt + 4 * q)));
                RtT[jt] = MFMA16(frag_lo4(AtN), MrbTF, rinit);
            }
#pragma unroll
            for (int ks = 0; ks < 2; ++ks) {
                const u32x4 wa = {pk_bf16(AtT[2 * ks][0], AtT[2 * ks][1]), pk_bf16(AtT[2 * ks][2], AtT[2 * ks][3]), pk_bf16(AtT[2 * ks + 1][0], AtT[2 * ks + 1][1]), pk_bf16(AtT[2 * ks + 1][2], AtT[2 * ks + 1][3])};
                const u32x4 wr = {pk_bf16(RtT[2 * ks][0], RtT[2 * ks][1]), pk_bf16(RtT[2 * ks][2], RtT[2 * ks][3]), pk_bf16(RtT[2 * ks + 1][0], RtT[2 * ks + 1][1]), pk_bf16(RtT[2 * ks + 1][2], RtT[2 * ks + 1][3])};
                *(LAS u32x4*)(sl + SL_ATIL + ks * 1024 + lane * 16) = wa; *(LAS u32x4*)(sl + SL_RTIL + ks * 1024 + lane * 16) = wr; }
            *(LAS u32x2*)(sl + SL_ULOC + lane * 8) = f32_to_bf4(W1T); *(LAS u32x2*)(sl + SL_YLOC + lane * 8) = f32_to_bf4(W2T);
            }
            asm volatile("s_waitcnt lgkmcnt(0)" ::: "memory");
            if (lane == 0) FULL[slot] = (unsigned)(c + 1);
        }
#undef CS_ISSUE
#undef CS_PCLOAD
    } else {
        struct ConsOps { bf16x8 at0, at1, rt0, rt1, bk[4]; u32x2 w1w, w2w, vfw[2]; f32x4 pc[4]; };
        f32x4 S[2][4];
#pragma unroll
        for (int ti = 0; ti < 2; ++ti)
#pragma unroll
            for (int mt = 0; mt < 4; ++mt) S[ti][mt] = (f32x4){0.f, 0.f, 0.f, 0.f};
#define CONS_LOAD(X, cc) do { const int slot_ = (cc) % CS_NS; LAS unsigned char* sl_ = lds + slot_ * SL_BYTES; \
            { unsigned sp_ = 0; while (FULL[slot_] < (unsigned)((cc) + 1)) { __builtin_amdgcn_s_sleep(1); if (++sp_ > (1u << 22)) break; } } \
            asm volatile("" ::: "memory"); \
            X.at0 = *(const LAS bf16x8*)(sl_ + SL_ATIL + lane * 16); X.at1 = *(const LAS bf16x8*)(sl_ + SL_ATIL + 1024 + lane * 16); \
            X.rt0 = *(const LAS bf16x8*)(sl_ + SL_RTIL + lane * 16); X.rt1 = *(const LAS bf16x8*)(sl_ + SL_RTIL + 1024 + lane * 16); \
            X.w1w = *(const LAS u32x2*)(sl_ + SL_ULOC + lane * 8); X.w2w = *(const LAS u32x2*)(sl_ + SL_YLOC + lane * 8); \
            _Pragma("unroll") for (int mt_ = 0; mt_ < 4; ++mt_) { X.pc[mt_] = *(const LAS f32x4*)(sl_ + SL_PC + (16 * mt_ + 4 * q) * 4); \
                X.bk[mt_] = frag_cat(__builtin_bit_cast(u32x2, tr_read16(sl_ + SL_BH + swz(4 * q + qp, 16 * mt_ + 4 * pp))), __builtin_bit_cast(u32x2, tr_read16(sl_ + SL_KH + swz(4 * q + qp, 16 * mt_ + 4 * pp)))); } \
            _Pragma("unroll") for (int ti_ = 0; ti_ < 2; ++ti_) X.vfw[ti_] = __builtin_bit_cast(u32x2, tr_read16(sl_ + SL_V + swz(4 * q + qp, 16 * (2 * wave + ti_) + 4 * pp))); } while (0)
#define CONS_COMPUTE(X, cc) do { const f32x4 z4c_ = {0.f, 0.f, 0.f, 0.f}; const bf16x8 w1f_ = frag_cat(X.w1w, (u32x2){0u, 0u}), w2f_ = frag_cat(X.w2w, (u32x2){0u, 0u}); \
            _Pragma("unroll") for (int ti_ = 0; ti_ < 2; ++ti_) { const int nt_ = 2 * wave + ti_; \
                const bf16x8 vB_ = frag_cat(X.vfw[ti_], (u32x2){0u, 0u}); \
                const bf16x8 Sb0_ = frag_cat(f32_to_bf4(S[ti_][0]), f32_to_bf4(S[ti_][1])), Sb1_ = frag_cat(f32_to_bf4(S[ti_][2]), f32_to_bf4(S[ti_][3])); \
                const f32x4 U0_ = MFMA16(X.at0, Sb0_, MFMA16(w1f_, vB_, z4c_)), U1_ = MFMA16(X.at1, Sb1_, z4c_); \
                const f32x4 Y0_ = MFMA16(X.rt0, Sb0_, MFMA16(w2f_, vB_, z4c_)), Y1_ = MFMA16(X.rt1, Sb1_, z4c_); \
                const f32x4 UT_ = U0_ + U1_, YT_ = Y0_ + Y1_; \
                const bf16x8 Ub_ = frag_cat(f32_to_bf4(UT_), X.vfw[ti_]); \
                _Pragma("unroll") for (int mt_ = 0; mt_ < 4; ++mt_) { S[ti_][mt_] = MFMA16(X.bk[mt_], Ub_, S[ti_][mt_]); S[ti_][mt_] = S[ti_][mt_] * X.pc[mt_]; } \
                *(f32x4*)(Yg + ((((size_t)b * NCHUNK + (dir ? (NCHUNK - 1 - (cc)) : (cc))) * NH + hd) * 64 + 16 * nt_ + c16) * 16 + 4 * q) = YT_; } } while (0)
#define CONS_DONE(cc) do { asm volatile("s_waitcnt lgkmcnt(0)" ::: "memory"); if (lane == 0) (void)__hip_atomic_fetch_add((LAS unsigned*)&DONE[(cc) % CS_NS], 1u, __ATOMIC_RELAXED, __HIP_MEMORY_SCOPE_WORKGROUP); } while (0)
        ConsOps OA, OB;
        CONS_LOAD(OA, 0);
#pragma unroll 1
        for (int c = 0; c < NCHUNK; c += 2) {
            CONS_LOAD(OB, c + 1);
            CONS_COMPUTE(OA, c);
            CONS_DONE(c);
            if (c + 2 < NCHUNK) CONS_LOAD(OA, c + 2);
            CONS_COMPUTE(OB, c + 1);
            CONS_DONE(c + 1);
        }
#undef CONS_LOAD
#undef CONS_COMPUTE
#undef CONS_DONE
        unsigned tq0 = 0u, tq1 = 0u, tq2 = 0u, tq3 = 0u, tq4 = 0u, tq5 = 0u, tacc = 0u;
        (void)tq0; (void)tq1; (void)tq2; (void)tq3; (void)tq4; (void)tq5;
        (void)tacc;
    }
}

__device__ __forceinline__ void phase_post(const Args& a, int G) {
    int tid = tid_of(a.wv); asm volatile("" : "+v"(tid)); const int lane = tid & 63, wave = __builtin_amdgcn_readfirstlane(tid >> 6);
    const int gw = blockIdx.x * 8 + wave, NGW = G * 8, t = lane & 15, iq = lane >> 4;
    const float* __restrict__ YF = (const float*)(a.ws + WS_YF); const float* __restrict__ YB = (const float*)(a.ws + WS_YB); const float* __restrict__ BON = (const float*)(a.ws + WS_BON);
    const bf16_t* __restrict__ Vg = (const bf16_t*)scan_arr(a.ws, 0); const bf16_t* __restrict__ Gg = (const bf16_t*)(a.ws + WS_G); bf16_t* __restrict__ MIX = (bf16_t*)(a.ws + WS_MIX);
    float* ss = (float*)(a.ws + WS_SS);
    for (int i = blockIdx.x * NTHREADS + tid; i < T; i += G * NTHREADS) ss[i] = 0.f;
    constexpr int NIT = (T / 16) * NH;
#pragma unroll 1
    for (int it = gw; it < NIT; it += NGW) {
        const int tile = it / NH, hd = it - tile * NH, tok = tile * 16 + t;
        const float* yfp = YF + ((size_t)it * 64 + 16 * iq) * 16 + t; const float* ybp = YB + ((size_t)it * 64 + 16 * iq) * 16 + (15 - t);
        float y[16];
#pragma unroll
        for (int k = 0; k < 16; ++k) y[k] = yfp[k * 16] + ybp[k * 16];
        const u32x4 v0 = *(const u32x4*)(Vg + ((size_t)it * 16 + t) * 64 + 16 * iq), v1 = *(const u32x4*)(Vg + ((size_t)it * 16 + t) * 64 + 16 * iq + 8);
        const u32x4 g0 = *(const u32x4*)(Gg + (size_t)tok * RW + hd * 64 + 16 * iq), g1 = *(const u32x4*)(Gg + (size_t)tok * RW + hd * 64 + 16 * iq + 8);
        const float bon = BON[(size_t)tok * NH + hd] + BON[(size_t)T * NH + (size_t)tok * NH + hd];
        float sm = 0.f;
#pragma unroll
        for (int k = 0; k < 16; ++k) sm += y[k];
        sm += __shfl_xor(sm, 16); sm += __shfl_xor(sm, 32);
        const float mean = sm * (1.f / 64.f); float vs = 0.f;
#pragma unroll
        for (int k = 0; k < 16; ++k) { y[k] -= mean; vs += y[k] * y[k]; }
        vs += __shfl_xor(vs, 16); vs += __shfl_xor(vs, 32);
        const float rstd = 1.0f / sqrtf(vs * (1.f / 64.f) + 64e-5f);
        const unsigned vw[8] = {v0.x, v0.y, v0.z, v0.w, v1.x, v1.y, v1.z, v1.w}, gwd[8] = {g0.x, g0.y, g0.z, g0.w, g1.x, g1.y, g1.z, g1.w};
        unsigned ow[8];
#pragma unroll
        for (int k2 = 0; k2 < 8; ++k2) { const int ch = hd * 64 + 16 * iq + 2 * k2;
            const float o0 = (y[2 * k2] * rstd * a.in[I_LNXG][ch] + a.in[I_LNXB][ch] + bon * bf_lo(vw[k2])) * bf_lo(gwd[k2]);
            const float o1 = (y[2 * k2 + 1] * rstd * a.in[I_LNXG][ch + 1] + a.in[I_LNXB][ch + 1] + bon * bf_hi(vw[k2])) * bf_hi(gwd[k2]);
            ow[k2] = pk_bf16(o0, o1); }
        bf16_t* op = MIX + (size_t)tok * D + 640 + hd * 64 + 16 * iq;
        *(u32x4*)op = (u32x4){ow[0], ow[1], ow[2], ow[3]}; *(u32x4*)(op + 8) = (u32x4){ow[4], ow[5], ow[6], ow[7]};
    }
}

constexpr int RT_WS = 2064;
__device__ __forceinline__ void phase_router(const Args& a, LAS unsigned char* lds, int G) {
    int tid = tid_of(a.wv); asm volatile("" : "+v"(tid)); const int lane = tid & 63, wave = __builtin_amdgcn_readfirstlane(tid >> 6);
    const int gw = blockIdx.x * 8 + wave, NGW = G * 8, l15 = lane & 15, kq = lane >> 4;
    LAS bf16_t* WH = (LAS bf16_t*)lds; LAS bf16_t* WL = (LAS bf16_t*)(lds + 16 * RT_WS);
    for (int i = tid; i < D * NE; i += NTHREADS) { const int k = i >> 4, e = i & 15; const float w = a.in[I_WROUTER][i];
        const unsigned hi = pk_bf16(w, 0.f) & 0xffffu; const float rem = w - bf_lo(hi);
        WH[e * (RT_WS / 2) + k] = (bf16_t)hi; WL[e * (RT_WS / 2) + k] = (bf16_t)(pk_bf16(rem, 0.f) & 0xffffu); }
    __syncthreads();
    const bf16_t* __restrict__ X1 = (const bf16_t*)(a.ws + WS_X1); const float* __restrict__ ss = (const float*)(a.ws + WS_SS); bf16_t* __restrict__ H2 = (bf16_t*)(a.ws + WS_H2);
    float* __restrict__ AFF = (float*)(a.ws + WS_AFF); int* __restrict__ INV = (int*)(a.ws + WS_INV);
    const float* __restrict__ GF = a.in[I_NFFNG];
    for (int grp = gw; grp < T / 16; grp += NGW) {
        const int tok = grp * 16 + l15;
        const float rs = 1.0f / sqrtf(ss[tok] * (1.f / D) + 1e-6f);
        f32x4 acc = {0.f, 0.f, 0.f, 0.f};
        const bf16_t* xrow = X1 + (size_t)tok * D + 8 * kq; unsigned char* hrow8 = (unsigned char*)H2 + (size_t)tok * D + 8 * kq;
#pragma unroll 8
        for (int ks = 0; ks < 32; ++ks) {
            const u32x4 xw = *(const u32x4*)(xrow + 32 * ks); const f32x4 x0 = {bf_lo(xw.x), bf_hi(xw.x), bf_lo(xw.y), bf_hi(xw.y)}, x1v = {bf_lo(xw.z), bf_hi(xw.z), bf_lo(xw.w), bf_hi(xw.w)};
            const f32x4 g0 = *(const f32x4*)(GF + 32 * ks + 8 * kq), g1 = *(const f32x4*)(GF + 32 * ks + 8 * kq + 4);
            const f32x4 h0 = x0 * rs * g0, h1 = x1v * rs * g1;
            u32x4 hi; hi.x = pk_bf16(h0.x, h0.y); hi.y = pk_bf16(h0.z, h0.w); hi.z = pk_bf16(h1.x, h1.y); hi.w = pk_bf16(h1.z, h1.w);
            *(u32x2*)(hrow8 + 32 * ks) = (u32x2){pk_fp8x4(h0.x, h0.y, h0.z, h0.w), pk_fp8x4(h1.x, h1.y, h1.z, h1.w)};
            u32x4 lo; lo.x = pk_bf16(h0.x - bf_lo(hi.x), h0.y - bf_hi(hi.x)); lo.y = pk_bf16(h0.z - bf_lo(hi.y), h0.w - bf_hi(hi.y));
            lo.z = pk_bf16(h1.x - bf_lo(hi.z), h1.y - bf_hi(hi.z)); lo.w = pk_bf16(h1.z - bf_lo(hi.w), h1.w - bf_hi(hi.w));
            const bf16x8 ah = __builtin_bit_cast(bf16x8, hi), al = __builtin_bit_cast(bf16x8, lo);
            const bf16x8 bh = *(const LAS bf16x8*)(lds + l15 * RT_WS + (32 * ks + 8 * kq) * 2), bl = *(const LAS bf16x8*)(lds + 16 * RT_WS + l15 * RT_WS + (32 * ks + 8 * kq) * 2);
            acc = __builtin_amdgcn_mfma_f32_16x16x32_bf16(ah, bh, acc, 0, 0, 0);
            acc = __builtin_amdgcn_mfma_f32_16x16x32_bf16(al, bh, acc, 0, 0, 0);
            acc = __builtin_amdgcn_mfma_f32_16x16x32_bf16(ah, bl, acc, 0, 0, 0);
        }
#pragma unroll
        for (int rg = 0; rg < 4; ++rg) { const float mx = max16(acc[rg]); const float ex = __expf(acc[rg] - mx); const float sm = sum16(ex);
            const int t2 = grp * 16 + 4 * kq + rg, bb = t2 >> 12, sq = t2 & (SEQ - 1);
            AFF[((size_t)(bb * NE + l15)) * SEQ + sq] = ex / sm; }
        *(u32x4*)(INV + (size_t)grp * 256 + 4 * lane) = (u32x4){0xffffffffu, 0xffffffffu, 0xffffffffu, 0xffffffffu};
    }
}

__device__ __forceinline__ void topk_unit(const Args& a, LAS unsigned char* lds, int unit) {
    int tid = tid_of(a.wv); asm volatile("" : "+v"(tid)); const int lane = tid & 63, wave = __builtin_amdgcn_readfirstlane(tid >> 6);
    const int b = unit >> 4, e = unit & 15;
    const float* AFF = (const float*)(a.ws + WS_AFF) + (size_t)unit * SEQ;
    LAS unsigned* KEY = (LAS unsigned*)lds;
    LAS unsigned* HIST = (LAS unsigned*)(lds + 16384);
    LAS unsigned* CTL = (LAS unsigned*)(lds + 16384 + 1024);
    LAS unsigned* WS_ = (LAS unsigned*)(lds + 16384 + 2048);
    __syncthreads();
    unsigned key[8];
    { const u32x4 k0 = *(const u32x4*)(AFF + tid * 8), k1 = *(const u32x4*)(AFF + tid * 8 + 4); key[0] = k0.x; key[1] = k0.y; key[2] = k0.z; key[3] = k0.w; key[4] = k1.x; key[5] = k1.y; key[6] = k1.z; key[7] = k1.w; }
    if (tid == 0) { CTL[0] = 0u; CTL[1] = (unsigned)CAP; }
    unsigned prefix = 0u, mask = 0u;
#pragma unroll 1
    for (int pass = 0; pass < 4; ++pass) {
        const int shift = 24 - 8 * pass;
        if (tid < 256) HIST[tid] = 0u;
        __syncthreads();
#pragma unroll
        for (int i = 0; i < 8; ++i) if ((key[i] & mask) == prefix) (void)__hip_atomic_fetch_add(&HIST[(key[i] >> shift) & 255u], 1u, __ATOMIC_RELAXED, __HIP_MEMORY_SCOPE_WORKGROUP);
        __syncthreads();
        if (wave == 0) {
            const unsigned need = CTL[1];
            unsigned hv[4], tsum = 0u;
#pragma unroll
            for (int i = 0; i < 4; ++i) { hv[i] = HIST[255 - (4 * lane + i)]; tsum += hv[i]; }
            unsigned inc = tsum;
#pragma unroll
            for (int o = 1; o < 64; o <<= 1) { const unsigned v = __shfl_up(inc, o); if (lane >= o) inc += v; }
            unsigned exc = inc - tsum;
            if (exc < need && need <= inc) {
                unsigned run = exc; int di = 0;
#pragma unroll
                for (int i = 0; i < 4; ++i) { if (run < need && need <= run + hv[i]) { di = i; break; } run += hv[i]; }
                const unsigned digit = 255u - (unsigned)(4 * lane + di);
                CTL[0] = prefix | (digit << shift); CTL[1] = need - run;
            }
        }
        __syncthreads();
        prefix = CTL[0]; mask |= (255u << shift);
    }
    const unsigned thr = prefix, need_eq = CTL[1];
    unsigned ngt = 0u, neq = 0u;
#pragma unroll
    for (int i = 0; i < 8; ++i) { ngt += (key[i] > thr) ? 1u : 0u; neq += (key[i] == thr) ? 1u : 0u; }
    unsigned pk = ngt | (neq << 16), inc = pk;
#pragma unroll
    for (int o = 1; o < 64; o <<= 1) { const unsigned v = __shfl_up(inc, o); if (lane >= o) inc += v; }
    if (lane == 63) WS_[wave] = inc;
    __syncthreads();
    unsigned woff = 0u, tot = 0u;
#pragma unroll
    for (int w = 0; w < 8; ++w) { const unsigned v = WS_[w]; if (w < wave) woff += v; tot += v; }
    const unsigned exc = inc - pk + woff;
    unsigned gpos = exc & 0xffffu, epos = exc >> 16; const unsigned totgt = tot & 0xffffu;
    const int sbase = (e * BATCH + b) * CAP;
    int* ROWTOK = (int*)(a.ws + WS_ROWTOK); float* ROWGATE = (float*)(a.ws + WS_ROWGATE); int* INV = (int*)(a.ws + WS_INV);
#pragma unroll
    for (int i = 0; i < 8; ++i) {
        int pos = -1;
        if (key[i] > thr) pos = (int)gpos++;
        else if (key[i] == thr) { if (epos < need_eq) pos = (int)(totgt + epos); epos++; }
        if (pos >= 0) { const int s = tid * 8 + i, tok = b * SEQ + s, slot = sbase + pos;
            ROWTOK[slot] = tok; ROWGATE[slot] = __builtin_bit_cast(float, key[i]); INV[(size_t)tok * NE + e] = slot; }
    }
}

__device__ __forceinline__ void phase_final(const Args& a, int G) {
    int tid = tid_of(a.wv); asm volatile("" : "+v"(tid)); const int lane = tid & 63, wave = __builtin_amdgcn_readfirstlane(tid >> 6);
    const int gw = blockIdx.x * 8 + wave, NGW = G * 8;
    const bf16_t* __restrict__ X1 = (const bf16_t*)(a.ws + WS_X1); const unsigned char* __restrict__ YE = (const unsigned char*)(a.ws + WS_YE); const int* __restrict__ INV = (const int*)(a.ws + WS_INV);
    float* __restrict__ OUT = a.out;
    const float* __restrict__ RG = (const float*)(a.ws + WS_ROWGATE);
    f32x4 gg[2][2];
#pragma unroll
    for (int j = 0; j < 2; ++j) { gg[j][0] = *(const f32x4*)(a.in[I_FNG] + 8 * lane + 512 * j); gg[j][1] = *(const f32x4*)(a.in[I_FNG] + 8 * lane + 512 * j + 4); }
#define PF_SLOTS(inv_, n_, m_, sl_) do { m_ = __ballot((inv_) >= 0) & 0xffffull; n_ = __builtin_popcountll(m_); unsigned long long mm_ = m_; \
        _Pragma("unroll") for (int k_ = 0; k_ < 4; ++k_) { if (mm_) { const int e_ = __builtin_ctzll(mm_); mm_ &= mm_ - 1; sl_[k_] = __builtin_amdgcn_readlane((inv_), e_); } else sl_[k_] = 0; } m_ = mm_; } while (0)
#define PF_GATES(gt_, n_, sl_) do { _Pragma("unroll") for (int k_ = 0; k_ < 4; ++k_) gt_[k_] = (k_ < (n_)) ? RG[sl_[k_]] * 0.0625f : 0.f; } while (0)
#define PF_ROWS(rw_, xr_, tk_, n_, sl_) do { \
        _Pragma("unroll") for (int k_ = 0; k_ < 4; ++k_) { if (k_ < (n_)) { _Pragma("unroll") for (int j_ = 0; j_ < 2; ++j_) rw_[k_][j_] = *(const u32x2*)(YE + (size_t)sl_[k_] * D + 8 * lane + 512 * j_); } \
            else { _Pragma("unroll") for (int j_ = 0; j_ < 2; ++j_) rw_[k_][j_] = (u32x2){0u, 0u}; } } \
        _Pragma("unroll") for (int j_ = 0; j_ < 2; ++j_) xr_[j_] = *(const u32x4*)(X1 + (size_t)(tk_) * D + 8 * lane + 512 * j_); } while (0)
#define PF_ACC(v_, w_, g_) do { const f32x2 p0_ = __builtin_amdgcn_cvt_pk_f32_fp8((int)(w_).x, false), p1_ = __builtin_amdgcn_cvt_pk_f32_fp8((int)(w_).x, true), p2_ = __builtin_amdgcn_cvt_pk_f32_fp8((int)(w_).y, false), p3_ = __builtin_amdgcn_cvt_pk_f32_fp8((int)(w_).y, true); \
        v_[0] += (g_) * p0_.x; v_[1] += (g_) * p0_.y; v_[2] += (g_) * p1_.x; v_[3] += (g_) * p1_.y; v_[4] += (g_) * p2_.x; v_[5] += (g_) * p2_.y; v_[6] += (g_) * p3_.x; v_[7] += (g_) * p3_.y; } while (0)
    int tok = gw;
    if (tok >= T) return;
    int inv0 = INV[(size_t)tok * NE + (lane & 15)];
    int inv1 = (tok + NGW < T) ? INV[(size_t)(tok + NGW) * NE + (lane & 15)] : -1;
    unsigned long long mc; int nc, slc[4]; u32x2 rwc[4][2]; u32x4 xc[2]; float gtc[4];
    PF_SLOTS(inv0, nc, mc, slc);
    PF_GATES(gtc, nc, slc);
    PF_ROWS(rwc, xc, tok, nc, slc);
    for (; tok < T; tok += NGW) {
        const int t1 = tok + NGW, t2 = tok + 2 * NGW;
        const int inv2 = (t2 < T) ? INV[(size_t)t2 * NE + (lane & 15)] : -1;
        unsigned long long mn = 0ull; int nn = 0, sln[4] = {0, 0, 0, 0}; u32x2 rwn[4][2]; u32x4 xn[2]; float gtn[4] = {0.f, 0.f, 0.f, 0.f};
        if (t1 < T) { PF_SLOTS(inv1, nn, mn, sln); PF_GATES(gtn, nn, sln); PF_ROWS(rwn, xn, t1, nn, sln); }
        else {
#pragma unroll
            for (int k = 0; k < 4; ++k)
#pragma unroll
                for (int j = 0; j < 2; ++j) rwn[k][j] = (u32x2){0u, 0u};
#pragma unroll
            for (int j = 0; j < 2; ++j) xn[j] = (u32x4){0u, 0u, 0u, 0u}; }
        float v[2][8];
#pragma unroll
        for (int j = 0; j < 2; ++j) { v[j][0] = bf_lo(xc[j].x); v[j][1] = bf_hi(xc[j].x); v[j][2] = bf_lo(xc[j].y); v[j][3] = bf_hi(xc[j].y); v[j][4] = bf_lo(xc[j].z); v[j][5] = bf_hi(xc[j].z); v[j][6] = bf_lo(xc[j].w); v[j][7] = bf_hi(xc[j].w); }
#pragma unroll
        for (int k = 0; k < 4; ++k)
#pragma unroll
            for (int j = 0; j < 2; ++j) PF_ACC(v[j], rwc[k][j], gtc[k]);
        if (nc > 4) { unsigned long long m = mc; while (m) { const int e = __builtin_ctzll(m); m &= m - 1; const int slot = __builtin_amdgcn_readlane(inv0, e); const float gs = RG[slot] * 0.0625f;
#pragma unroll
                for (int j = 0; j < 2; ++j) { const u32x2 w = *(const u32x2*)(YE + (size_t)slot * D + 8 * lane + 512 * j); PF_ACC(v[j], w, gs); } } }
        float sq = 0.f;
#pragma unroll
        for (int j = 0; j < 2; ++j)
#pragma unroll
            for (int e = 0; e < 8; ++e) sq += v[j][e] * v[j][e];
        float rs = 1.0f / sqrtf(wave_sum(sq) * (1.f / D) + 1e-6f);
#pragma unroll
        for (int j = 0; j < 2; ++j) { float* o = OUT + (size_t)tok * D + 8 * lane + 512 * j;
            *(f32x4*)o = (f32x4){v[j][0], v[j][1], v[j][2], v[j][3]} * rs * gg[j][0]; *(f32x4*)(o + 4) = (f32x4){v[j][4], v[j][5], v[j][6], v[j][7]} * rs * gg[j][1]; }
        inv0 = inv1; inv1 = inv2; mc = mn; nc = nn;
#pragma unroll
        for (int k = 0; k < 4; ++k) { slc[k] = sln[k]; gtc[k] = gtn[k];
#pragma unroll
            for (int j = 0; j < 2; ++j) rwc[k][j] = rwn[k][j]; }
#pragma unroll
        for (int j = 0; j < 2; ++j) xc[j] = xn[j];
    }
#undef PF_SLOTS
#undef PF_GATES
#undef PF_ROWS
#undef PF_ACC
}

#define XB_TMO      128
#define XB_XCNT(j)  (256  + 64 * (j))
#define XB_XSUB(j)  (1280 + 64 * (j))
#define XB_XGEN(j)  (2304 + 64 * (j))
#define XB_TOP      3328
#define XB_TOPGEN   3392
#define XCD_BAR_WORDS 3456
#define XB_SPIN_CAP (1u << 22)
__device__ __forceinline__ unsigned xb_ld(unsigned* p)              { return __hip_atomic_load(p, __ATOMIC_RELAXED, __HIP_MEMORY_SCOPE_AGENT); }
__device__ __forceinline__ unsigned xb_add(unsigned* p, unsigned v) { return __hip_atomic_fetch_add(p, v, __ATOMIC_RELAXED, __HIP_MEMORY_SCOPE_AGENT); }
__device__ __forceinline__ unsigned xb_xcc_id() { return (unsigned)__builtin_amdgcn_s_getreg((3 << 11) | 20) & 0xFu; }
#define XB_SPIN(cond, bar) do { unsigned _sp = 0; while (cond) { __builtin_amdgcn_s_sleep(1); \
    if ((++_sp & 255u) == 0u) { if (xb_ld(&(bar)[XB_TMO])) break; if (_sp > XB_SPIN_CAP) { atomicAdd(&(bar)[XB_TMO], 1u); break; } } } } while (0)
struct XcdBarrier { unsigned* bar; unsigned x; volatile LAS unsigned* st; int wv; };
__device__ __forceinline__ XcdBarrier xcd_barrier_post(unsigned* bar, volatile LAS unsigned* st, int wv) {
    XcdBarrier b; b.bar = bar; b.x = xb_xcc_id(); b.st = st; b.wv = wv;
    if (threadIdx.x == 0) (void)xb_add(&bar[XB_XCNT(b.x)], 1u);
    return b;
}
__device__ __forceinline__ void xcd_barrier_complete(unsigned* bar, unsigned x, unsigned& nloc, unsigned& nx) {
    const unsigned G = gridDim.x * gridDim.y * gridDim.z;
    unsigned sum, cnt, mine, sp = 0u;
    for (;;) {
        sum = 0u; cnt = 0u; mine = 0u;
#pragma unroll
        for (unsigned j = 0; j < 16; ++j) { const unsigned c = xb_ld(&bar[XB_XCNT(j)]); sum += c; cnt += (c > 0u) ? 1u : 0u; mine = (j == x) ? c : mine; }
        if (sum == G) break;
        __builtin_amdgcn_s_sleep(1);
        if ((++sp & 255u) == 0u) { if (xb_ld(&bar[XB_TMO])) break; if (sp > XB_SPIN_CAP) { atomicAdd(&bar[XB_TMO], 1u); break; } }
    }
    nloc = mine > 0u ? mine : 1u; nx = cnt > 0u ? cnt : 1u;
}
__device__ __forceinline__ void xcd_barrier(const XcdBarrier& b) {
    asm volatile("s_waitcnt vmcnt(0)" ::: "memory");
    __syncthreads();
    if (tid_of(b.wv) == 0) {
        unsigned* bar = b.bar;
        __builtin_amdgcn_s_waitcnt(0);
        unsigned nloc = b.st[0], nx = b.st[1];
        if (nloc == 0u) { xcd_barrier_complete(bar, b.x, nloc, nx); b.st[0] = nloc; b.st[1] = nx; }
        const unsigned old = xb_add(&bar[XB_XSUB(b.x)], 1u);
        const unsigned gen = old / nloc;
        if (old + 1u == (gen + 1u) * nloc) {
            __builtin_amdgcn_fence(__ATOMIC_RELEASE, "agent");
            asm volatile("s_waitcnt vmcnt(0)" ::: "memory");
            const unsigned og = xb_add(&bar[XB_TOP], 1u);
            const unsigned tg = og / nx;
            if (og + 1u == (tg + 1u) * nx) xb_add(&bar[XB_TOPGEN], 1u);
            else XB_SPIN(xb_ld(&bar[XB_TOPGEN]) == tg, bar);
            __builtin_amdgcn_fence(__ATOMIC_ACQUIRE, "agent");
            xb_add(&bar[XB_XGEN(b.x)], 1u);
            asm volatile("s_waitcnt vmcnt(0)" ::: "memory");
        } else {
            XB_SPIN(xb_ld(&bar[XB_XGEN(b.x)]) == gen, bar);
            __builtin_amdgcn_fence(__ATOMIC_ACQUIRE, "agent");
            asm volatile("s_waitcnt vmcnt(0)" ::: "memory");
        }
    }
    __syncthreads();
}

#ifndef PH_MASK
#define PH_MASK 0x7ff
#endif
#ifndef REP_MASK
#define REP_MASK 0
#endif
#ifndef P2_MASK
#define P2_MASK 7
#endif
#ifndef P2_REP
#define P2_REP 0
#define P9_REP 0
#endif
constexpr int LDS_MISC = LDS_BYTES - 64;
constexpr int LDS_PTAB = LDS_BYTES - 512;
__device__ __forceinline__ Args load_args(LAS unsigned char* lds, int lo, int hi, int wv) {
    Args r; const LAS u32x2* t = (const LAS u32x2*)(lds + LDS_PTAB);
#pragma unroll
    for (int i = 0; i < 31; ++i) { const u32x2 v = t[i]; const unsigned long long p = ((unsigned long long)(unsigned)__builtin_amdgcn_readfirstlane((int)v.y) << 32) | (unsigned)__builtin_amdgcn_readfirstlane((int)v.x);
        if (i < 29) r.in[i] = (const float*)(const __attribute__((address_space(1))) float*)p; else if (i == 29) r.out = (float*)(__attribute__((address_space(1))) float*)p; else r.ws = (unsigned char*)(__attribute__((address_space(1))) unsigned char*)p; }
    r.ph_lo = lo; r.ph_hi = hi; r.wv = wv; r.zero_ = 0; return r;
}
constexpr size_t WS_CTL = 0, CTL_BYTES = 16384;
__global__ void __launch_bounds__(NTHREADS, 2) mega(Args a0) {
    extern __shared__ __attribute__((aligned(16))) unsigned char lds_raw[];
    LAS unsigned char* lds = (LAS unsigned char*)lds_raw;
    cg::grid_group grid = cg::this_grid();
    const int G = gridDim.x, lo = a0.ph_lo, hi = a0.ph_hi, wv0 = __builtin_amdgcn_readfirstlane((int)threadIdx.x >> 6);
    volatile LAS unsigned* misc = (volatile LAS unsigned*)(lds + LDS_MISC);
    if (threadIdx.x < 16) misc[threadIdx.x] = 0u;
    if (threadIdx.x == 0) { LAS unsigned long long* t = (LAS unsigned long long*)(lds + LDS_PTAB);
#pragma unroll
        for (int i = 0; i < 29; ++i) t[i] = (unsigned long long)a0.in[i];
        t[29] = (unsigned long long)a0.out; t[30] = (unsigned long long)a0.ws; }
    __syncthreads();
    if (lo < -1000) grid.sync();
    XcdBarrier xbar = xcd_barrier_post((unsigned*)(a0.ws + WS_CTL), misc, wv0);
#define IN(k) (((PH_MASK >> (k)) & 1) && lo <= (k) && (k) < hi)
#define NREP(k) (1 + ((REP_MASK >> (k)) & 1))
#define PHASE(k, ...) do { if (IN(k)) { for (int rep_ = 0; rep_ < NREP(k); ++rep_) { { const Args a = load_args(lds, lo, hi, wv0); unsigned char* const ws = a.ws; (void)ws; __VA_ARGS__; } if (rep_ + 1 < NREP(k) || IN((k) + 1)) { xcd_barrier(xbar); } } } } while (0)

    PHASE(0, phase_prep(a, lds, G));

    PHASE(1, {
        pg8::Gemm g{(const bf16_t*)(ws + WS_XH), (const bf16_t*)(ws + WS_WINT), T, IN_PROJ, D, 0, 0};
        pg8::TripleOrder S; S.S0.init(T, IN_PROJ, G, 0); S.A1 = (const bf16_t*)(ws + WS_MEMN); S.B1 = (const bf16_t*)(ws + WS_WKT); S.A2 = (const bf16_t*)(ws + WS_WVT); S.B2 = (const bf16_t*)(ws + WS_MEMN);
        S.n1 = BATCH * NMEM / 256; S.n2 = BATCH * NMEM / 256; S.G = G; S.c = (int)blockIdx.x;
        pg8::EpiBf16x3 E{pg8::EpiBf16{(bf16_t*)(ws + WS_P), PLD, (bf16_t*)(ws + WS_Q)}, pg8::EpiBf16{(bf16_t*)(ws + WS_KMEM), 256, nullptr}, pg8::EpiBf16{(bf16_t*)(ws + WS_VT), BATCH * NMEM, nullptr}};
        const int total = S.n1 + S.n2 + S.S0.nwg, rem = total % G, c = (int)blockIdx.x;
        const bool cv = rem ? (c >= rem) : true; const int ncv = rem ? G - rem : G, rank = rem ? c - rem : c;
        if (cv && !(rank & 1)) { expert_prep_items(a, lds, rank * 8 + a.wv, ncv * 8, 0, 3 * 8192); __syncthreads(); }
        pg8::gemm_phase<pg8::EpiBf16x3, pg8::TripleOrder, false>(lds, g, S, E, nullptr, a.wv);
        if (cv && (rank & 1)) { __syncthreads(); expert_prep_items(a, lds, rank * 8 + a.wv, ncv * 8, 0, 3 * 8192); }
    });

    constexpr int NSCAN = BATCH * NH * 2;
    PHASE(2, {
        for (int r2 = 0; r2 < 1 + ((P2_REP >> 1) & 1); ++r2) conv_stream(a, lds, (int)blockIdx.x, G);
        for (int u = blockIdx.x; u < 2048; u += G) {
            if (u >= 1024) { for (int r2 = 0; r2 < 1 + ((P2_REP >> 2) & 1); ++r2) prep_unit(a, lds, u - 1024); }
        }
    });

    PHASE(3, {
        int bid = blockIdx.x; int Gp = G; asm volatile("" : "+s"(bid), "+s"(Gp));
        for (int u = bid; u < NSCAN; u += Gp) scan_chunked_unit(a, lds, u);
        if (rep_ == 0) {
            if (Gp > NSCAN) { if (bid >= NSCAN) { for (int u = bid - NSCAN; u < 64; u += Gp - NSCAN) for (int r2 = 0; r2 < 1 + (P2_REP & 1); ++r2) attn_unit(a, lds, u);
                                                 } }
            else { for (int u = bid; u < 64; u += Gp) attn_unit(a, lds, u); }
        }
    });

    PHASE(4, phase_post(a, G));

    PHASE(5, {
        pg8::Gemm g{(const bf16_t*)(ws + WS_MIX), (const bf16_t*)(ws + WS_WOUTT), T, D, D, 0, 0}; pg8::StaticOrder S; S.init(T, D, G, (int)blockIdx.x);
        pg8::EpiResidSS E{a.in[I_X], (bf16_t*)(ws + WS_X1), (float*)(ws + WS_SS)}; pg8::gemm_phase<pg8::EpiResidSS, pg8::StaticOrder, false>(lds, g, S, E, nullptr, a.wv);
    });

    PHASE(6, phase_router(a, lds, G));

    PHASE(7, { for (int u = blockIdx.x; u < BATCH * NE; u += G) topk_unit(a, lds, u); });

    PHASE(8, {
        pg8::Gemm g{(const bf16_t*)(ws + WS_H2), (const bf16_t*)(ws + WS_WGUT), NSLOT, 2048, D / 2, 0x7A7A7A7A, 0x7F7F7F7F};     pg8::ExpertOrder S; S.init(32, 8, NE, G, (int)blockIdx.x);
        pg8::EpiSwiGLU E{(bf16_t*)(ws + WS_HID)}; pg8::gemm_phase<pg8::EpiSwiGLU, pg8::ExpertOrder, true, false, true>(lds, g, S, E, (const int*)(ws + WS_ROWTOK), a.wv);
    });

    PHASE(9, {
        pg8::Gemm g{(const bf16_t*)(ws + WS_HID), (const bf16_t*)(ws + WS_WDT), NSLOT, D, FF / 2, 0x7A7A7A7A, 0x7C7C7C7C};     pg8::ExpertOrder S; S.init(32, 4, NE, G, (int)blockIdx.x);
        pg8::EpiGateScale E{(unsigned char*)(ws + WS_YE), (const float*)(ws + WS_ROWGATE)}; pg8::gemm_phase<pg8::EpiGateScale, pg8::ExpertOrder, false, true, true>(lds, g, S, E, nullptr, a.wv);
#if P9_REP
        __syncthreads(); pg8::gemm_phase<pg8::EpiGateScale, pg8::ExpertOrder, false, true, true>(lds, g, S, E, nullptr, a.wv);
#endif
    });

    PHASE(10, phase_final(a, G));
#undef IN
#undef NREP
#undef PHASE
}

#ifndef MK_ONE_LAUNCH
#define MK_ONE_LAUNCH 1
#endif
extern "C" void kernel_launch(void* const* d_in, const int* in_sizes, int n_in, void* d_out, int out_size, void* d_ws, size_t ws_size, hipStream_t stream) {
    static int grid_blocks = 0;
    if (grid_blocks == 0) {
        if (n_in != 29 || out_size != T * D || ws_size < WS_END) { fprintf(stderr, "kernel_launch: unexpected problem: n_in %d out %d ws %zu (need %zu)\n", n_in, out_size, ws_size, (size_t)WS_END); grid_blocks = -1; return; }
        int dev = 0, cus = 0, per_cu = 0;
        if (hipGetDevice(&dev) != hipSuccess || hipDeviceGetAttribute(&cus, hipDeviceAttributeMultiprocessorCount, dev) != hipSuccess) { grid_blocks = -1; return; }
        if (hipFuncSetAttribute((const void*)mega, hipFuncAttributeMaxDynamicSharedMemorySize, LDS_BYTES) != hipSuccess) { fprintf(stderr, "kernel_launch: hipFuncSetAttribute failed\n"); grid_blocks = -1; return; }
        if (hipOccupancyMaxActiveBlocksPerMultiprocessor(&per_cu, (const void*)mega, NTHREADS, LDS_BYTES) != hipSuccess || per_cu < 1) { fprintf(stderr, "kernel_launch: occupancy query says %d blocks per CU\n", per_cu); grid_blocks = -1; return; }
        grid_blocks = cus;
    }
    if (grid_blocks < 0) return;
    if (hipMemsetAsync((char*)d_ws + WS_CTL, 0, CTL_BYTES, stream) != hipSuccess) { fprintf(stderr, "kernel_launch: memset failed\n"); return; }
    Args a{};
    for (int i = 0; i < 29; ++i) a.in[i] = (const float*)d_in[i];
    a.out = (float*)d_out; a.ws = (unsigned char*)d_ws;
#if MK_ONE_LAUNCH
    a.ph_lo = 0; a.ph_hi = NPHASE;
    { void* args[] = {&a}; hipError_t e = hipLaunchCooperativeKernel((const void*)mega, dim3(grid_blocks), dim3(NTHREADS), args, LDS_BYTES, stream);
      if (e != hipSuccess) fprintf(stderr, "cooperative launch failed: %s (grid %d)\n", hipGetErrorString(e), grid_blocks); }
#else
    for (int ph = 0; ph < NPHASE; ++ph) { a.ph_lo = ph; a.ph_hi = ph + 1; void* args[] = {&a};
        hipError_t e = hipLaunchCooperativeKernel((const void*)mega, dim3(grid_blocks), dim3(NTHREADS), args, LDS_BYTES, stream);
        if (e != hipSuccess) { fprintf(stderr, "cooperative launch %d failed: %s (grid %d)\n", ph, hipGetErrorString(e), grid_blocks); break; } }
#endif
}
```

```cpp
#include <hip/hip_runtime.h>
#include <hip/hip_cooperative_groups.h>
#include <cstdio>
#include <cstdint>
namespace cg = cooperative_groups;
#define SCAN_CPRIO 1

#define LAS __attribute__((address_space(3)))
typedef unsigned short bf16_t;
typedef short bf16x8 __attribute__((ext_vector_type(8)));
typedef short s16x4 __attribute__((ext_vector_type(4)));
typedef float f32x2 __attribute__((ext_vector_type(2)));
typedef float f32x4 __attribute__((ext_vector_type(4)));
typedef float f32x16 __attribute__((ext_vector_type(16)));
typedef unsigned u32x2 __attribute__((ext_vector_type(2)));
typedef unsigned u32x4 __attribute__((ext_vector_type(4)));
typedef _Float16 f16x4 __attribute__((ext_vector_type(4)));
typedef _Float16 f16x2 __attribute__((ext_vector_type(2)));
typedef __bf16 bf16v2 __attribute__((ext_vector_type(2)));
typedef int v8i __attribute__((ext_vector_type(8)));
typedef int v4i __attribute__((ext_vector_type(4)));

constexpr int D = 1024, BATCH = 16, SEQ = 4096, T = BATCH * SEQ, NMEM = 256;
constexpr int IN_PROJ = 2560, CW = 384, RW = 384, NH = 6, NE = 16, FF = 1024, CAP = 512;
constexpr int NSLOT = NE * BATCH * CAP;
constexpr int NTHREADS = 512;
constexpr int LDS_BYTES = 160 * 1024;
constexpr int NPHASE = 11;
#ifndef SCAN_MODE
#define SCAN_MODE 1
#endif

constexpr size_t MiB = 1u << 20;
constexpr size_t WS_WINT = 1 * MiB;
constexpr size_t WS_WOUTT = 6 * MiB;
constexpr size_t WS_WKT = 8 * MiB;
constexpr size_t WS_WVT = 8 * MiB + 512 * 1024;
constexpr size_t WS_SMALL = 9 * MiB;
constexpr size_t WS_WGUT = 10 * MiB;
constexpr size_t WS_WDT = 74 * MiB;
constexpr size_t WS_KMEM = 106 * MiB;
constexpr size_t WS_VT = 108 * MiB;
constexpr size_t WS_ROWTOK = 106 * MiB;
constexpr size_t WS_ROWGATE = 106 * MiB + 512 * 1024;
constexpr size_t WS_SS = 107 * MiB;
constexpr size_t WS_P = 112 * MiB;
constexpr size_t WS_YF = 112 * MiB;
constexpr size_t WS_YB = 208 * MiB;
constexpr size_t WS_X1 = 112 * MiB;
constexpr size_t WS_XH = 432 * MiB;
constexpr size_t WS_G = 432 * MiB;
constexpr size_t WS_BON = 480 * MiB;
constexpr size_t WS_Q = 400 * MiB;
constexpr int PLD = IN_PROJ - 256;
constexpr size_t WS_H2 = 432 * MiB;
constexpr size_t WS_MEMN = 560 * MiB;
constexpr size_t WS_MIX = 560 * MiB;
constexpr size_t WS_SCAN = 688 * MiB;
constexpr size_t SCAN_STRIDE = 48 * MiB;
constexpr size_t WS_SCAN7 = 496 * MiB;
constexpr size_t WS_PC = 484 * MiB;
__device__ __forceinline__ size_t mix_off(size_t tok, int col) { return (((tok >> 8) * (size_t)(D / 64) + (size_t)(col >> 6)) << 14) + ((tok & 255) << 6) + (size_t)(col & 63); }
__device__ __forceinline__ unsigned char* scan_arr(unsigned char* ws, int a) { return a < 7 ? ws + WS_SCAN + (size_t)a * SCAN_STRIDE : (a == 7 ? ws + WS_SCAN7 : ws + 560 * MiB); }
__device__ __forceinline__ int scan_pitch(int a) { return a == 8 ? D : 384; }
__device__ __forceinline__ size_t hat_off(int a, size_t tok, int ch) { return a == 8 ? mix_off(tok, 640 + ch) : ((((tok >> 4) * NH + (ch >> 6)) << 10) + ((tok & 15) << 6) + (ch & 63)); }
constexpr size_t WS_AFF = 624 * MiB;
constexpr size_t WS_INV = 628 * MiB;
constexpr size_t WS_PR = 160 * MiB;
constexpr size_t WS_HID = 768 * MiB;
constexpr size_t WS_YE = 368 * MiB;
constexpr size_t WS_END = 1024 * MiB;

__device__ __forceinline__ unsigned pk_bf16(float lo, float hi) { f32x2 v = {lo, hi}; bf16v2 b = __builtin_convertvector(v, bf16v2); return __builtin_bit_cast(unsigned, b); }
__device__ __forceinline__ unsigned pk_fp8x4(float a, float b, float c, float d) { int w = 0; w = __builtin_amdgcn_cvt_pk_fp8_f32(a, b, w, false); w = __builtin_amdgcn_cvt_pk_fp8_f32(c, d, w, true); return (unsigned)w; }
__device__ __forceinline__ float bf_lo(unsigned u) { return __builtin_bit_cast(float, u << 16); }
__device__ __forceinline__ float bf_hi(unsigned u) { return __builtin_bit_cast(float, u & 0xffff0000u); }
__device__ __forceinline__ float wave_sum(float v) {
#pragma unroll
    for (int o = 1; o < 64; o <<= 1) v += __shfl_xor(v, o);
    return v;
}
__device__ __forceinline__ float sigmoidf_fast(float x) { return __builtin_amdgcn_rcpf(1.0f + __builtin_amdgcn_exp2f(-1.4426950408889634f * x)); }
template <int CTRL> __device__ __forceinline__ float dpp_f(float x) { return __builtin_bit_cast(float, __builtin_amdgcn_update_dpp(0, __builtin_bit_cast(int, x), CTRL, 0xF, 0xF, true)); }
__device__ __forceinline__ float sum8(float x) { x += dpp_f<0xB1>(x); x += dpp_f<0x4E>(x); x += dpp_f<0x141>(x); return x; }
__device__ __forceinline__ float sum16(float x) { x = sum8(x); x += dpp_f<0x140>(x); return x; }
__device__ __forceinline__ float max16(float x) { x = fmaxf(x, dpp_f<0xB1>(x)); x = fmaxf(x, dpp_f<0x4E>(x)); x = fmaxf(x, dpp_f<0x141>(x)); x = fmaxf(x, dpp_f<0x140>(x)); return x; }

typedef short v4i16g __attribute__((__vector_size__(8)));
__device__ __forceinline__ s16x4 tr_read16(LAS unsigned char* p) { v4i16g r = __builtin_amdgcn_ds_read_tr16_b64_v4i16((LAS v4i16g*)p); return __builtin_bit_cast(s16x4, r); }
__device__ __forceinline__ f32x4 bf4_to_f32(u32x2 w) { return (f32x4){bf_lo(w.x), bf_hi(w.x), bf_lo(w.y), bf_hi(w.y)}; }
__device__ __forceinline__ u32x2 f32_to_bf4(f32x4 v) { return (u32x2){pk_bf16(v.x, v.y), pk_bf16(v.z, v.w)}; }
__device__ __forceinline__ bf16x8 frag_lo4(f32x4 v) { const u32x4 w = {pk_bf16(v.x, v.y), pk_bf16(v.z, v.w), 0u, 0u}; return __builtin_bit_cast(bf16x8, w); }
__device__ __forceinline__ bf16x8 frag_cat(u32x2 a, u32x2 b) { const u32x4 w = {a.x, a.y, b.x, b.y}; return __builtin_bit_cast(bf16x8, w); }
#define MFMA16(a, b, c) __builtin_amdgcn_mfma_f32_16x16x32_bf16((a), (b), (c), 0, 0, 0)

__device__ __forceinline__ int tid_of(int wv) { int l; asm volatile("v_mbcnt_lo_u32_b32 %0, -1, 0\n\tv_mbcnt_hi_u32_b32 %0, -1, %0" : "=v"(l)); return (wv << 6) | l; }
namespace pg8 {
#define PG8_LAS __attribute__((address_space(3)))
constexpr int T_ROWS = 65536;
constexpr int BM = 256, BK = 64, HALF = 128, HTB = HALF * BK * 2, STAGE_BYTES = 8 * HTB, NXCD = 8, WGM = 8;
__host__ __device__ __forceinline__ int lds_byte(int r, int c) { const int st = (r >> 4) * 2 + (c >> 5), rr = r & 15, cc = c & 31, ob = rr * 64 + cc * 2; return st * 1024 + (ob ^ (((ob >> 9) & 1) << 5)); }
__host__ __device__ __forceinline__ void stage_rc(int b, int& R, int& C) { const int st = b / 1024, sb = b % 1024, swz = sb ^ (((sb >> 9) & 1) << 5); R = (st >> 1) * 16 + swz / 64; C = (st & 1) * 32 + (swz % 64) / 2; }
__host__ __device__ __forceinline__ int perm32(int rho) { const int n = rho >> 4, i = rho & 15; return 8 * (i >> 2) + 4 * n + (i & 3); }

struct Unit { int pm, pn, gid; };
struct Gemm { const bf16_t* A; const bf16_t* Bt; int M, N, K; int sw, sx; };

struct StaticOrder {
    int nM, nN, nwg, G, c, rev;
    __device__ void init(int M, int N, int G_, int c_, int rev_ = 0) { nM = M / BM; nN = N / BM; nwg = nM * nN; G = G_; c = c_; rev = rev_; }
    __device__ bool next(int i, Unit& u) const {
        const long L = (long)i * G + c; if (L >= nwg) return false;
        int wgid = (int)L; { const int q = nwg / NXCD, r = nwg % NXCD, xcd = wgid % NXCD, off = wgid / NXCD; wgid = (xcd < r ? xcd * (q + 1) : r * (q + 1) + (xcd - r) * q) + off; }
        const int nig = WGM * nN, gid = wgid / nig, fm = gid * WGM, gsz = (nM - fm) < WGM ? (nM - fm) : WGM;
        u.pm = fm + ((wgid % nig) % gsz); if (rev) u.pm = nM - 1 - u.pm; u.pn = (wgid % nig) / gsz; u.gid = 0; return true;
    }
    __device__ __forceinline__ const char* aptr(const Gemm& g, const Unit& u, size_t tstep) const { return (const char*)g.A + (size_t)u.pm * tstep; }
    __device__ __forceinline__ const char* bptr(const Gemm& g, const Unit& u, size_t tstep) const { return (const char*)g.Bt + (size_t)u.pn * tstep; }
};
struct TripleOrder {
    StaticOrder S0; const bf16_t* A1; const bf16_t* B1; const bf16_t* A2; const bf16_t* B2; int n1, n2, G, c;
    __device__ bool next(int i, Unit& u) const {
        const long L = (long)i * G + c;
        if (L < n1) { u.pm = (int)L; u.pn = 0; u.gid = 1; return true; }
        if (L < n1 + n2) { u.pm = 0; u.pn = (int)(L - n1); u.gid = 2; return true; }
        const long L0 = L - n1 - n2; if (L0 >= S0.nwg) return false;
        StaticOrder T0 = S0; T0.c = (int)(L0 % G); return T0.next((int)(L0 / G), u);
    }
    __device__ __forceinline__ const char* aptr(const Gemm& g, const Unit& u, size_t tstep) const { return (const char*)(u.gid == 0 ? g.A : (u.gid == 1 ? A1 : A2)) + (size_t)u.pm * tstep; }
    __device__ __forceinline__ const char* bptr(const Gemm& g, const Unit& u, size_t tstep) const { return (const char*)(u.gid == 0 ? g.Bt : (u.gid == 1 ? B1 : B2)) + (size_t)u.pn * tstep; }
};
struct ExpertOrder {
    int nMe, nNe, per, total, G, c;
    __device__ void init(int nMe_, int nNe_, int nExp, int G_, int c_) { nMe = nMe_; nNe = nNe_; per = nMe * nNe; total = per * nExp; G = G_; c = c_; }
    __device__ bool next(int i, Unit& u) const {
        const long L = (long)i * G + c; if (L >= total) return false;
        const int e = (int)(L / per), w = (int)(L % per), xl = w % 8, j = w / 8, rpx = nMe / 8;
        u.pm = e * nMe + xl * rpx + (j % rpx); u.pn = e * nNe + j / rpx; u.gid = 0; return true;
    }
    __device__ __forceinline__ const char* aptr(const Gemm& g, const Unit& u, size_t tstep) const { return (const char*)g.A + (size_t)u.pm * tstep; }
    __device__ __forceinline__ const char* bptr(const Gemm& g, const Unit& u, size_t tstep) const { return (const char*)g.Bt + (size_t)u.pn * tstep; }
};

struct EpiBf16 {
    static constexpr bool PERM = true;
    bf16_t* O; int ldc; bf16_t* Q0; bf16_t* PR = nullptr;
    __device__ __forceinline__ void operator()(const f32x4 (&acc)[2][2][4][2], const Unit& u, int wr, int wc, int fr, int fq) const {
        const bool redir = (Q0 != nullptr) && (u.pn == 0);
        bf16_t* base = redir ? Q0 : O; const int ld = redir ? 256 : ldc;
        const int row0 = u.pm * BM + wr * 64 + fr, col0 = (u.pn - ((Q0 != nullptr && !redir) ? 1 : 0)) * BM + wc * 32 + 8 * fq;
#pragma unroll
        for (int ai = 0; ai < 2; ++ai)
#pragma unroll
            for (int m = 0; m < 4; ++m) { bf16_t* rowp = base + (size_t)(row0 + ai * HALF + m * 16) * ld + col0;
#pragma unroll
                for (int bj = 0; bj < 2; ++bj) { const f32x4 v0 = acc[ai][bj][m][0], v1 = acc[ai][bj][m][1];
                    u32x4 w; w.x = pk_bf16(v0[0], v0[1]); w.y = pk_bf16(v0[2], v0[3]); w.z = pk_bf16(v1[0], v1[1]); w.w = pk_bf16(v1[2], v1[3]);
                    *(u32x4*)(rowp + bj * HALF) = w; } }
    }
};
struct EpiBf16x3 {
    static constexpr bool PERM = true;
    EpiBf16 E0, E1, E2;
    __device__ __forceinline__ void deferred(const f32x4 (&acc)[2][2][4][2], const Unit& u, int wr, int wc, int fr, int fq, u32x4 (&pend)[8], char*& pptr, unsigned& pstep, unsigned& phalf) const {
        if (u.gid == 0) { if (u.pn >= 1 && u.pn <= 3) deferred_glu(E0.O, E0.ldc, acc, u, wr, wc, fr, fq, pend, pptr, pstep, phalf); else deferred1((E0.PR != nullptr && u.pn >= 4) ? E0.PR + (size_t)(u.pn - 4) * T_ROWS * 256 : E0.O, (E0.PR != nullptr && u.pn >= 4) ? nullptr : E0.Q0, (E0.PR != nullptr && u.pn >= 4) ? 256 : E0.ldc, acc, u, wr, wc, fr, fq, pend, pptr, pstep, phalf, (E0.PR != nullptr && u.pn >= 4)); }
        else if (u.gid == 1) deferred1(E1.O, E1.Q0, E1.ldc, acc, u, wr, wc, fr, fq, pend, pptr, pstep, phalf, false);
        else deferred1(E2.O, E2.Q0, E2.ldc, acc, u, wr, wc, fr, fq, pend, pptr, pstep, phalf, false); }
    __device__ __forceinline__ void deferred1(bf16_t* const eO, bf16_t* const eQ, const int eld, const f32x4 (&acc)[2][2][4][2], const Unit& u, int wr, int wc, int fr, int fq, u32x4 (&pend)[8], char*& pptr, unsigned& pstep, unsigned& phalf, const bool panel) const {
        const bool redir = (eQ != nullptr) && (u.pn == 0);
        bf16_t* base = redir ? eQ : eO; const int ld = redir ? 256 : eld;
        const int row0 = u.pm * BM + wr * 64 + fr, col0 = (panel ? 0 : (u.pn - ((eQ != nullptr && !redir) ? 1 : 0)) * BM) + wc * 32 + 8 * fq;
#pragma unroll
        for (int m = 0; m < 4; ++m) { bf16_t* rowp = base + (size_t)(row0 + m * 16) * ld + col0;
#pragma unroll
            for (int bj = 0; bj < 2; ++bj) { const f32x4 v0 = acc[0][bj][m][0], v1 = acc[0][bj][m][1];
                u32x4 w; w.x = pk_bf16(v0[0], v0[1]); w.y = pk_bf16(v0[2], v0[3]); w.z = pk_bf16(v1[0], v1[1]); w.w = pk_bf16(v1[2], v1[3]);
                *(u32x4*)(rowp + bj * HALF) = w; } }
#pragma unroll
        for (int m = 0; m < 4; ++m)
#pragma unroll
            for (int bj = 0; bj < 2; ++bj) { const f32x4 v0 = acc[1][bj][m][0], v1 = acc[1][bj][m][1];
                pend[2 * m + bj] = (u32x4){pk_bf16(v0[0], v0[1]), pk_bf16(v0[2], v0[3]), pk_bf16(v1[0], v1[1]), pk_bf16(v1[2], v1[3])}; }
        pptr = (char*)(base + (size_t)(row0 + HALF) * ld + col0); pstep = (unsigned)(16 * ld * 2); phalf = (unsigned)(HALF * 2);
    }
    __device__ __forceinline__ void deferred_glu(bf16_t* const eO, const int ld, const f32x4 (&acc)[2][2][4][2], const Unit& u, int wr, int wc, int fr, int fq, u32x4 (&pend)[8], char*& pptr, unsigned& pstep, unsigned& phalf) const {
        const int row0 = u.pm * BM + wr * 64 + fr, col0 = (u.pn - 1) * HALF + wc * 32 + 8 * fq;
#pragma unroll
        for (int ai = 0; ai < 2; ++ai)
#pragma unroll
            for (int m = 0; m < 4; ++m) { float uo[8];
#pragma unroll
                for (int n = 0; n < 2; ++n)
#pragma unroll
                    for (int j = 0; j < 4; ++j) uo[4 * n + j] = acc[ai][0][m][n][j] * sigmoidf_fast(acc[ai][1][m][n][j]);
                const u32x4 w = {pk_bf16(uo[0], uo[1]), pk_bf16(uo[2], uo[3]), pk_bf16(uo[4], uo[5]), pk_bf16(uo[6], uo[7])};
                if (ai == 0) *(u32x4*)(eO + (size_t)(row0 + m * 16) * ld + col0) = w; else { pend[2 * m] = w; pend[2 * m + 1] = w; } }
        pptr = (char*)(eO + (size_t)(row0 + HALF) * ld + col0); pstep = (unsigned)(16 * ld * 2); phalf = 0u;
    }
    __device__ __forceinline__ void operator()(const f32x4 (&acc)[2][2][4][2], const Unit& u, int wr, int wc, int fr, int fq) const {
        if (u.gid == 0) E0(acc, u, wr, wc, fr, fq); else if (u.gid == 1) E1(acc, u, wr, wc, fr, fq); else E2(acc, u, wr, wc, fr, fq); }
};
struct EpiResidSS {
    static constexpr bool PERM = false;
    const float* X; bf16_t* X1; float* ss;
    __device__ __forceinline__ void operator()(const f32x4 (&acc)[2][2][4][2], const Unit& u, int wr, int wc, int fr, int fq) const {
        const int row0 = u.pm * BM + wr * 64 + fr, col0 = u.pn * BM + wc * 32 + 4 * fq;
        const float* __restrict__ Xr = X; bf16_t* __restrict__ Yr = X1;
        f32x4 xa[2][2][2], xb[2][2][2];
#define RS_LOAD(dst, p_) do { _Pragma("unroll") for (int mm = 0; mm < 2; ++mm) { const size_t off_ = (size_t)(row0 + ((p_) >> 1) * HALF + (2 * ((p_) & 1) + mm) * 16) * D + col0; \
            _Pragma("unroll") for (int bj = 0; bj < 2; ++bj) _Pragma("unroll") for (int n = 0; n < 2; ++n) dst[mm][bj][n] = __builtin_nontemporal_load((const f32x4*)(Xr + off_ + bj * HALF + n * 16)); } } while (0)
#define RS_DO(src, p_) do { _Pragma("unroll") for (int mm = 0; mm < 2; ++mm) { const int ai = (p_) >> 1, m = 2 * ((p_) & 1) + mm, row = row0 + ai * HALF + m * 16; const size_t off_ = (size_t)row * D + col0; float s_ = 0.f; \
            _Pragma("unroll") for (int bj = 0; bj < 2; ++bj) _Pragma("unroll") for (int n = 0; n < 2; ++n) { const f32x4 o = src[mm][bj][n] + acc[ai][bj][m][n]; \
                *(u32x2*)(Yr + off_ + bj * HALF + n * 16) = f32_to_bf4(o); s_ += (o[0] * o[0] + o[1] * o[1]) + (o[2] * o[2] + o[3] * o[3]); } \
            s_ += __shfl_xor(s_, 16); s_ += __shfl_xor(s_, 32); \
            if (fq == 0) (void)__hip_atomic_fetch_add(ss + row, s_, __ATOMIC_RELAXED, __HIP_MEMORY_SCOPE_AGENT); } } while (0)
        RS_LOAD(xa, 0); RS_LOAD(xb, 1);
        RS_DO(xa, 0); RS_LOAD(xa, 2);
        RS_DO(xb, 1); RS_LOAD(xb, 3);
        RS_DO(xa, 2); RS_DO(xb, 3);
#undef RS_LOAD
#undef RS_DO
    }
};
struct EpiSwiGLU {
    static constexpr bool PERM = true;
    bf16_t* H;
    __device__ __forceinline__ void operator()(const f32x4 (&acc)[2][2][4][2], const Unit& u, int wr, int wc, int fr, int fq) const {
        const int row0 = u.pm * BM + wr * 64 + fr, col0 = (u.pn & 7) * HALF + wc * 32 + 8 * fq;
#pragma unroll
        for (int ai = 0; ai < 2; ++ai)
#pragma unroll
            for (int m = 0; m < 4; ++m) { const int row = row0 + ai * HALF + m * 16; float h[8];
                unsigned char* rowp = (unsigned char*)H + ((((size_t)(row >> 8) * (FF / 128) + (col0 >> 7)) << 15) + ((row & 255) << 7) + (col0 & 127));
#pragma unroll
                for (int n = 0; n < 2; ++n)
#pragma unroll
                    for (int j = 0; j < 4; ++j) { const float gt = acc[ai][0][m][n][j], up = acc[ai][1][m][n][j]; h[n * 4 + j] = __builtin_amdgcn_fmed3f((gt * up) * __builtin_amdgcn_rcpf(1.0f + __builtin_amdgcn_exp2f(-gt)), -448.0f, 448.0f); }
                *(u32x2*)rowp = (u32x2){pk_fp8x4(h[0], h[1], h[2], h[3]), pk_fp8x4(h[4], h[5], h[6], h[7])}; }
    }
};
struct EpiGateScale {
    static constexpr bool PERM = true;
    unsigned char* Y; const float* gate;
    __device__ __forceinline__ void operator()(const f32x4 (&acc)[2][2][4][2], const Unit& u, int wr, int wc, int fr, int fq) const {
        const int row0 = u.pm * BM + wr * 64 + fr, col0 = (u.pn & 3) * BM + wc * 32 + 8 * fq;
#pragma unroll
        for (int ai = 0; ai < 2; ++ai)
#pragma unroll
            for (int m = 0; m < 4; ++m) { const int row = row0 + ai * HALF + m * 16; unsigned char* rowp = Y + (size_t)row * D + col0;
#pragma unroll
                for (int bj = 0; bj < 2; ++bj) { f32x4 v0 = acc[ai][bj][m][0] * 16.0f, v1 = acc[ai][bj][m][1] * 16.0f;
#pragma unroll
                    for (int e = 0; e < 4; ++e) { v0[e] = __builtin_amdgcn_fmed3f(v0[e], -448.0f, 448.0f); v1[e] = __builtin_amdgcn_fmed3f(v1[e], -448.0f, 448.0f); }
                    *(u32x2*)(rowp + bj * HALF) = (u32x2){pk_fp8x4(v0[0], v0[1], v0[2], v0[3]), pk_fp8x4(v1[0], v1[1], v1[2], v1[3])}; } }
    }
};

template <class Epi, class Sched, bool GATHER, bool ATILED = false, bool FP8 = false, bool DEFER = false>
__device__ __forceinline__ void gemm_phase(PG8_LAS unsigned char* lds, const Gemm g, const Sched& S, const Epi& E, const int* rowtok, const int wv) {
    int tid = tid_of(wv); asm volatile("" : "+v"(tid));
    const int wid = __builtin_amdgcn_readfirstlane(tid >> 6), lane = tid & 63, wr = wid >> 2, wc = wid & 3, fr = lane & 15, fq = lane >> 4;
    const int K = g.K, nt = K / BK;
    unsigned voffA0, voffB0;
    { int R, C; stage_rc(tid * 16, R, C); const int Rb = Epi::PERM ? ((R & ~31) + perm32(R & 31)) : R;
      voffA0 = ATILED ? (unsigned)(R * BK + C) * 2u : (unsigned)(R * K + C) * 2u; voffB0 = (unsigned)(Rb * K + C) * 2u; }
    const size_t dA = ATILED ? (size_t)64 * BK * 2 : (size_t)64 * K * 2, dB = (size_t)64 * K * 2;
    unsigned vAc[2][2], vAn[2][2];
    const size_t kstep = (size_t)(BK * 2);
    const size_t hstep = (size_t)HALF * K * 2;
    const size_t tstep = 2 * hstep;
    const size_t kstepA = ATILED ? (size_t)BM * BK * 2 : kstep, hstepA = ATILED ? (size_t)HALF * BK * 2 : hstep;
    const unsigned ldsw = (unsigned)wid * 1024u;
    const unsigned ldsbase = __builtin_amdgcn_readfirstlane((unsigned)(size_t)lds) + ldsw;
    const int aoff = lds_byte(wr * 64 + fr, fq * 8), boff = lds_byte(wc * 32 + fr, fq * 8);
#define PG8_SA(b, h) (((b) * 2 + (h)) * HTB)
#define PG8_SB(b, h) ((4 + (b) * 2 + (h)) * HTB)
#define PG8_GLDS(vo_, sb_, lo_) asm volatile("s_add_u32 m0, %2, %3\n\ts_nop 0\n\tglobal_load_lds_dwordx4 %0, %1" :: "v"(vo_), "s"((const void*)(sb_)), "s"(ldsbase), "n"(lo_) : "m0", "scc", "memory")
#define PG8_STAGE_D(bufoff, gbase, voff0, delta) do { PG8_GLDS(voff0, gbase, (bufoff)); PG8_GLDS(voff0, (const char*)(gbase) + (delta), (bufoff) + 8192); } while (0)
#define PG8_STAGE(bufoff, gbase, voff) do { PG8_GLDS((voff)[0], gbase, (bufoff)); PG8_GLDS((voff)[1], gbase, (bufoff) + 8192); } while (0)
#define PG8_STAGE_A(bufoff, hh, dbase, kbytes, vsel) do { if constexpr (GATHER) { PG8_STAGE(bufoff, (const char*)g.A + (kbytes), (vsel)[hh]); } else { PG8_STAGE_D(bufoff, (dbase) + ((hh) ? hstepA : 0), voffA0, dA); } } while (0)
#define PG8_GATHER_OFF(dst, un) do { int R_, C_; stage_rc(tid * 16, R_, C_); _Pragma("unroll") for (int _h = 0; _h < 2; ++_h) _Pragma("unroll") for (int _i = 0; _i < 2; ++_i) \
        (dst)[_h][_i] = (unsigned)rowtok[(un).pm * BM + _h * HALF + R_ + 64 * _i] * (unsigned)(K * 2) + (unsigned)(C_ * 2); } while (0)
#define PG8_LDA(dst, b, h) do { _Pragma("unroll") for (int m = 0; m < 4; ++m) _Pragma("unroll") for (int k = 0; k < 2; ++k) dst[m][k] = *(const PG8_LAS bf16x8*)(lds + PG8_SA(b, h) + aoff + m * 2048 + k * 1024); } while (0)
#define PG8_LDB(dst, b, h) do { _Pragma("unroll") for (int n = 0; n < 2; ++n) _Pragma("unroll") for (int k = 0; k < 2; ++k) dst[n][k] = *(const PG8_LAS bf16x8*)(lds + PG8_SB(b, h) + boff + n * 2048 + k * 1024); } while (0)
#define PG8_MMA(ai, bj, At, Bt) do { __builtin_amdgcn_s_setprio(1); _Pragma("unroll") for (int m = 0; m < 4; ++m) _Pragma("unroll") for (int n = 0; n < 2; ++n) _Pragma("unroll") for (int k = 0; k < 2; ++k) \
        acc[ai][bj][m][n] = __builtin_amdgcn_mfma_f32_16x16x32_bf16(Bt[n][k], At[m][k], acc[ai][bj][m][n], 0, 0, 0); __builtin_amdgcn_s_setprio(0); } while (0)
#define PG8_CAT8(lo_, hi_) __builtin_shufflevector(lo_, hi_, 0, 1, 2, 3, 4, 5, 6, 7)
#define PG8_LDA8(b, h) do { _Pragma("unroll") for (int m = 0; m < 4; ++m) { const v4i lo_ = *(const PG8_LAS v4i*)(lds + PG8_SA(b, h) + aoff + m * 2048), hi_ = *(const PG8_LAS v4i*)(lds + PG8_SA(b, h) + aoff + m * 2048 + 1024); A8[m] = PG8_CAT8(lo_, hi_); } } while (0)
#define PG8_LDB8(dst, b, h) do { _Pragma("unroll") for (int n = 0; n < 2; ++n) { const v4i lo_ = *(const PG8_LAS v4i*)(lds + PG8_SB(b, h) + boff + n * 2048), hi_ = *(const PG8_LAS v4i*)(lds + PG8_SB(b, h) + boff + n * 2048 + 1024); dst[n] = PG8_CAT8(lo_, hi_); } } while (0)
#define PG8_MMA8(ai, bj, Bt8) do { __builtin_amdgcn_s_setprio(1); _Pragma("unroll") for (int m = 0; m < 4; ++m) _Pragma("unroll") for (int n = 0; n < 2; ++n) \
        acc[ai][bj][m][n] = __builtin_amdgcn_mfma_scale_f32_16x16x128_f8f6f4(Bt8[n], A8[m], acc[ai][bj][m][n], 0, 0, 0, g.sw, 0, g.sx); __builtin_amdgcn_s_setprio(0); } while (0)
#define PG8_LDAX(b, h) do { if constexpr (FP8) { PG8_LDA8(b, h); } else { PG8_LDA(At, b, h); } } while (0)
#define PG8_LDBX(w, b, h) do { if constexpr (FP8) { if (w) { PG8_LDB8(B81, b, h); } else { PG8_LDB8(B80, b, h); } } else { if (w) { PG8_LDB(B1, b, h); } else { PG8_LDB(B0, b, h); } } } while (0)
#define PG8_MMX(ai, bj, w) do { if constexpr (FP8) { if (w) { PG8_MMA8(ai, bj, B81); } else { PG8_MMA8(ai, bj, B80); } } else { if (w) { PG8_MMA(ai, bj, At, B1); } else { PG8_MMA(ai, bj, At, B0); } } } while (0)
#define PG8_WAIT_V(n) asm volatile("s_waitcnt vmcnt(" #n ")" ::: "memory")
#define PG8_WAIT_L(n) asm volatile("s_waitcnt lgkmcnt(" #n ")" ::: "memory")
#define PG8_BAR __builtin_amdgcn_s_barrier()
#define PG8_SCHED __builtin_amdgcn_sched_barrier(0)
    Unit cur, nxt; int ui = 0;
    if (!S.next(0, cur)) return;
    u32x4 pend[8]; char* pptr = nullptr; unsigned pstep = 0u, phalf = 0u; bool pv = false;
#define PG8_DEFER(k_) do { if constexpr (DEFER) { if (pv && t == 0) *(u32x4*)(pptr + (size_t)((k_) >> 1) * pstep + ((k_) & 1) * phalf) = pend[k_]; } } while (0)
    f32x4 acc[2][2][4][2];
#pragma unroll
    for (int a = 0; a < 2; ++a)
#pragma unroll
        for (int b = 0; b < 2; ++b)
#pragma unroll
            for (int m = 0; m < 4; ++m)
#pragma unroll
                for (int n = 0; n < 2; ++n) acc[a][b][m][n] = (f32x4){0.f, 0.f, 0.f, 0.f};
    bf16x8 At[4][2], B0[2][2], B1[2][2]; v8i A8[4], B80[2], B81[2];
    const char* cA = GATHER ? (const char*)g.A : S.aptr(g, cur, tstep); const char* cB = S.bptr(g, cur, tstep);
    if constexpr (GATHER) { PG8_GATHER_OFF(vAc, cur); }
    PG8_STAGE_D(PG8_SB(0, 0), cB, voffB0, dB); PG8_STAGE_A(PG8_SA(0, 0), 0, cA, 0, vAc); PG8_STAGE_D(PG8_SB(0, 1), cB + hstep, voffB0, dB); PG8_STAGE_A(PG8_SA(0, 1), 1, cA, 0, vAc);
    if (wr == 1) PG8_BAR;
    PG8_WAIT_V(4); PG8_BAR;
    PG8_STAGE_D(PG8_SB(1, 0), cB + kstep, voffB0, dB); PG8_STAGE_A(PG8_SA(1, 0), 0, cA + kstepA, kstep, vAc); PG8_STAGE_D(PG8_SB(1, 1), cB + hstep + kstep, voffB0, dB);
    PG8_WAIT_V(6); PG8_BAR;
    for (;;) {
        const bool has_next = S.next(ui + 1, nxt);
        const char* nA = (has_next && !GATHER) ? S.aptr(g, nxt, tstep) : cA; const char* nB = has_next ? S.bptr(g, nxt, tstep) : cB;
        if constexpr (GATHER) { if (has_next) { PG8_GATHER_OFF(vAn, nxt); } else {
#pragma unroll
            for (int _h = 0; _h < 2; ++_h)
#pragma unroll
                for (int _i = 0; _i < 2; ++_i) vAn[_h][_i] = vAc[_h][_i]; } }
#pragma unroll 1
        for (int t = 0; t < nt; t += 2) {
            const bool last = (t == nt - 2);
            const size_t k1 = (size_t)(t + 1) * kstep, k2 = last ? 0 : (size_t)(t + 2) * kstep, k3 = k2 + kstep;
            const char* a1 = cA + (size_t)(t + 1) * kstepA;
            const char* a2 = last ? nA : cA + (size_t)(t + 2) * kstepA; const char* b2 = last ? nB : cB + (size_t)(t + 2) * kstep;
            const char* a3 = a2 + kstepA; const char* b3 = b2 + kstep;
            PG8_LDBX(0, 0, 0); PG8_SCHED; PG8_LDAX(0, 0); PG8_STAGE_A(PG8_SA(1, 1), 1, a1, k1, vAc); PG8_DEFER(0);
            if constexpr (GATHER) { if (last) {
#pragma unroll
                for (int _h = 0; _h < 2; ++_h)
#pragma unroll
                    for (int _i = 0; _i < 2; ++_i) vAc[_h][_i] = vAn[_h][_i]; } }
            PG8_WAIT_L(8); PG8_BAR; PG8_WAIT_L(0); PG8_MMX(0, 0, 0); PG8_BAR; PG8_SCHED;
            PG8_LDBX(1, 0, 1); PG8_STAGE_D(PG8_SB(0, 0), b2, voffB0, dB); PG8_DEFER(1);
            PG8_BAR; PG8_WAIT_L(0); PG8_MMX(0, 1, 1); PG8_BAR;
            PG8_LDAX(0, 1); PG8_STAGE_A(PG8_SA(0, 0), 0, a2, k2, vAc); PG8_DEFER(2);
            PG8_BAR; PG8_WAIT_L(0); PG8_MMX(1, 0, 0); PG8_BAR; PG8_SCHED;
            PG8_STAGE_D(PG8_SB(0, 1), b2 + hstep, voffB0, dB); PG8_DEFER(3);
            PG8_WAIT_V(6); PG8_BAR; PG8_MMX(1, 1, 1); PG8_BAR;
            PG8_LDBX(0, 1, 0); PG8_SCHED; PG8_LDAX(1, 0); PG8_STAGE_A(PG8_SA(0, 1), 1, a2, k2, vAc); PG8_DEFER(4);
            PG8_WAIT_L(8); PG8_BAR; PG8_WAIT_L(0); PG8_MMX(0, 0, 0); PG8_BAR; PG8_SCHED;
            PG8_LDBX(1, 1, 1); PG8_STAGE_D(PG8_SB(1, 0), b3, voffB0, dB); PG8_DEFER(5);
            PG8_BAR; PG8_WAIT_L(0); PG8_MMX(0, 1, 1); PG8_BAR;
            PG8_LDAX(1, 1); PG8_STAGE_A(PG8_SA(1, 0), 0, a3, k3, vAc); PG8_DEFER(6);
            PG8_BAR; PG8_WAIT_L(0); PG8_MMX(1, 0, 0); PG8_BAR; PG8_SCHED;
            PG8_STAGE_D(PG8_SB(1, 1), b3 + hstep, voffB0, dB); PG8_DEFER(7);
            PG8_WAIT_V(6); PG8_BAR; PG8_MMX(1, 1, 1); PG8_BAR;
        }
        if constexpr (DEFER) { E.deferred(acc, cur, wr, wc, fr, fq, pend, pptr, pstep, phalf); pv = true; } else E(acc, cur, wr, wc, fr, fq);
        if (!has_next) break;
#pragma unroll
        for (int a = 0; a < 2; ++a)
#pragma unroll
            for (int b = 0; b < 2; ++b)
#pragma unroll
                for (int m = 0; m < 4; ++m)
#pragma unroll
                    for (int n = 0; n < 2; ++n) acc[a][b][m][n] = (f32x4){0.f, 0.f, 0.f, 0.f};
        cur = nxt; cA = nA; cB = nB; ++ui;
        if constexpr (GATHER) {
#pragma unroll
            for (int _h = 0; _h < 2; ++_h)
#pragma unroll
                for (int _i = 0; _i < 2; ++_i) vAc[_h][_i] = vAn[_h][_i]; }
    }
    if constexpr (DEFER) { if (pv) {
#pragma unroll
        for (int k = 0; k < 8; ++k) *(u32x4*)(pptr + (size_t)(k >> 1) * pstep + (k & 1) * phalf) = pend[k]; } }
    PG8_WAIT_V(0);
    if (wr == 0) PG8_BAR;
    PG8_BAR;
#undef PG8_DEFER
#undef PG8_SA
#undef PG8_SB
#undef PG8_STAGE
#undef PG8_STAGE_D
#undef PG8_GLDS
#undef PG8_STAGE_A
#undef PG8_GATHER_OFF
#undef PG8_LDA
#undef PG8_LDB
#undef PG8_MMA
#undef PG8_MMA8
#undef PG8_LDA8
#undef PG8_LDB8
#undef PG8_LDAX
#undef PG8_LDBX
#undef PG8_MMX
#undef PG8_CAT8
#undef PG8_WAIT_V
#undef PG8_WAIT_L
#undef PG8_BAR
#undef PG8_SCHED
}
}

struct Args {
    const float* in[29];
    float* out; unsigned char* ws;
    int ph_lo, ph_hi;
    int wv, zero_;
};
enum { I_X = 0, I_MEM, I_NMIXG, I_NMEMG, I_WIN, I_WMK, I_WMV, I_CONVW, I_CONVB, I_CLNG, I_CLNB, I_SHIFTMU, I_DW0, I_DUP, I_IA0, I_IUP, I_GUP, I_KK, I_KA, I_RK,
       I_LNXG, I_LNXB, I_WOUT, I_NFFNG, I_WROUTER, I_WEG, I_WEU, I_WED, I_FNG };

template <bool F8 = false>
__device__ __forceinline__ void transpose_item(const float* W, int N, bf16_t* WT, int K, int k0, int n0, int drow0, LAS float* scr, int lane, const float sc = 32.f) {
    {
        f32x4 v[8];
#pragma unroll
        for (int i = 0; i < 8; ++i) v[i] = __builtin_nontemporal_load((const f32x4*)(W + (size_t)(k0 + 8 * i + (lane >> 3)) * N + n0 + 4 * (lane & 7)));
#pragma unroll
        for (int i = 0; i < 8; ++i) { LAS float* d = scr + (8 * i + (lane >> 3)) * 33 + 4 * (lane & 7); d[0] = v[i].x; d[1] = v[i].y; d[2] = v[i].z; d[3] = v[i].w; }
    }
    asm volatile("s_waitcnt lgkmcnt(0)" ::: "memory");
    const int c = lane & 7;
#pragma unroll
    for (int j = 0; j < 4; ++j) { const int n = (lane >> 3) + 8 * j; const LAS float* s = scr + (8 * c) * 33 + n;
        if constexpr (F8) { *(u32x2*)((unsigned char*)WT + (size_t)(drow0 + n) * K + k0 + 8 * c) = (u32x2){pk_fp8x4(sc * s[0 * 33], sc * s[1 * 33], sc * s[2 * 33], sc * s[3 * 33]), pk_fp8x4(sc * s[4 * 33], sc * s[5 * 33], sc * s[6 * 33], sc * s[7 * 33])}; }
        else { u32x4 o; o.x = pk_bf16(s[0 * 33], s[1 * 33]); o.y = pk_bf16(s[2 * 33], s[3 * 33]); o.z = pk_bf16(s[4 * 33], s[5 * 33]); o.w = pk_bf16(s[6 * 33], s[7 * 33]);
            *(u32x4*)(WT + (size_t)(drow0 + n) * K + k0 + 8 * c) = o; } }
    asm volatile("s_waitcnt lgkmcnt(0)" ::: "memory");
}
__device__ __forceinline__ void expert_prep_items(const Args& a, LAS unsigned char* lds, int widx, int nw, int it_lo, int it_hi) {
    int tid = tid_of(a.wv); asm volatile("" : "+v"(tid)); const int lane = tid & 63, wave = __builtin_amdgcn_readfirstlane(tid >> 6);
    LAS float* scr = (LAS float*)(lds + wave * 16384);
    unsigned char* ws = a.ws;
    constexpr int S_EXP = 16 * 16 * 32;
    for (int r = it_lo + widx; r < it_hi; r += nw) {
        const int which = r / S_EXP, q = r % S_EXP, e = q / 512, kb = (q % 512) / 32, nb = q % 32, n0 = nb * 32;
        if (which == 0) transpose_item<true>(a.in[I_WEG] + (size_t)e * D * FF, FF, (bf16_t*)(ws + WS_WGUT + (size_t)e * 2048 * D), D, kb * 64, n0, (n0 >> 7) * 256 + (n0 & 127), scr, lane, 32.f * 1.4426950408889634f);
        else if (which == 1) transpose_item<true>(a.in[I_WEU] + (size_t)e * D * FF, FF, (bf16_t*)(ws + WS_WGUT + (size_t)e * 2048 * D), D, kb * 64, n0, (n0 >> 7) * 256 + 128 + (n0 & 127), scr, lane, 32.f * 8.0f / 1.4426950408889634f);
        else transpose_item<true>(a.in[I_WED] + (size_t)e * FF * D, D, (bf16_t*)(ws + WS_WDT + (size_t)e * D * FF), FF, kb * 64, n0, n0, scr, lane);
    }
}

__device__ __forceinline__ void rms_row_to_bf16(const float* xrow, const float* g, bf16_t* orow, int lane) {
    const f32x4* xr = (const f32x4*)xrow + lane; const f32x4* gr = (const f32x4*)g + lane;
    f32x4 v[4]; float s = 0.f;
#pragma unroll
    for (int j = 0; j < 4; ++j) { v[j] = xr[64 * j]; s += (v[j].x * v[j].x + v[j].y * v[j].y) + (v[j].z * v[j].z + v[j].w * v[j].w); }
    const float rs = 1.0f / sqrtf(wave_sum(s) * (1.f / D) + 1e-6f);
    u32x2* o8 = (u32x2*)orow + lane;
#pragma unroll
    for (int j = 0; j < 4; ++j) { const f32x4 gg = gr[64 * j]; u32x2 w; w.x = pk_bf16(v[j].x * rs * gg.x, v[j].y * rs * gg.y); w.y = pk_bf16(v[j].z * rs * gg.z, v[j].w * rs * gg.w); o8[64 * j] = w; }
}
__device__ __forceinline__ void phase_prep(const Args& a, LAS unsigned char* lds, int G) {
    int tid = tid_of(a.wv); asm volatile("" : "+v"(tid)); const int lane = tid & 63, wave = __builtin_amdgcn_readfirstlane(tid >> 6);
    LAS float* scr = (LAS float*)(lds + wave * 16384);
    const int gw = blockIdx.x * 8 + wave, NGW = G * 8;
    unsigned char* ws = a.ws;
    constexpr int S_WIN = 16 * 80, S_WOUT = 16 * 32, S_MK = 16 * 8, S_SM = 12, S_GUP = 24;
    constexpr int NITEMS = S_WIN + S_WOUT + 2 * S_MK + 4 * S_SM + S_GUP;
    for (int it = gw; it < NITEMS; it += NGW) {
        int r = it;
        if (r < S_WIN) { const int kb = r / 80, nb = r % 80, n0 = nb * 32;
            const int drow = (n0 < 256 || n0 >= 1024) ? n0 : (n0 < 640 ? 256 + ((n0 - 256) >> 7) * 256 + ((n0 - 256) & 127) : 256 + ((n0 - 640) >> 7) * 256 + 128 + ((n0 - 640) & 127));
            transpose_item(a.in[I_WIN], IN_PROJ, (bf16_t*)(ws + WS_WINT), D, kb * 64, n0, drow, scr, lane); continue; } r -= S_WIN;
        if (r < S_WOUT) { const int kb = r / 32, nb = r % 32; transpose_item(a.in[I_WOUT], D, (bf16_t*)(ws + WS_WOUTT), D, kb * 64, nb * 32, nb * 32, scr, lane); continue; } r -= S_WOUT;
        if (r < S_MK) { const int kb = r / 8, nb = r % 8; transpose_item(a.in[I_WMK], 256, (bf16_t*)(ws + WS_WKT), D, kb * 64, nb * 32, nb * 32, scr, lane); continue; } r -= S_MK;
        if (r < S_MK) { const int kb = r / 8, nb = r % 8; transpose_item(a.in[I_WMV], 256, (bf16_t*)(ws + WS_WVT), D, kb * 64, nb * 32, nb * 32, scr, lane); continue; } r -= S_MK;
        if (r < 4 * S_SM) { const int which = r / S_SM, nb = r % S_SM;
            const float* src = (which < 2 ? a.in[I_DUP] : a.in[I_IUP]) + (size_t)(which & 1) * 64 * RW;
            transpose_item(src, RW, (bf16_t*)(ws + WS_SMALL) + (size_t)which * RW * 64, 64, 0, nb * 32, nb * 32, scr, lane); continue; } r -= 4 * S_SM;
        { const int kb = r / 12, nb = r % 12; transpose_item(a.in[I_GUP], RW, (bf16_t*)(ws + WS_SMALL) + (size_t)4 * RW * 64, 128, kb * 64, nb * 32, nb * 32, scr, lane); }
    }
    {
        const float* __restrict__ X = a.in[I_X]; bf16_t* __restrict__ XH = (bf16_t*)(ws + WS_XH);
        f32x4 gg[4];
#pragma unroll
        for (int j = 0; j < 4; ++j) gg[j] = ((const f32x4*)a.in[I_NMIXG])[lane + 64 * j];
        f32x4 r0[4], r1[4], r2[4];
#define P0_LOADROW(r_, m_) do { if ((m_) < T) { const f32x4* xr_ = (const f32x4*)(X + (size_t)(m_) * D) + lane; _Pragma("unroll") for (int j_ = 0; j_ < 4; ++j_) r_[j_] = __builtin_nontemporal_load(xr_ + 64 * j_); } } while (0)
#define P0_DOROW(r_, m_) do { if ((m_) < T) { float s_ = 0.f; _Pragma("unroll") for (int j_ = 0; j_ < 4; ++j_) s_ += (r_[j_].x * r_[j_].x + r_[j_].y * r_[j_].y) + (r_[j_].z * r_[j_].z + r_[j_].w * r_[j_].w); \
            const float rs_ = 1.0f / sqrtf(wave_sum(s_) * (1.f / D) + 1e-6f); u32x2* o8_ = (u32x2*)(XH + (size_t)(m_) * D) + lane; \
            _Pragma("unroll") for (int j_ = 0; j_ < 4; ++j_) { u32x2 w_; w_.x = pk_bf16(r_[j_].x * rs_ * gg[j_].x, r_[j_].y * rs_ * gg[j_].y); w_.y = pk_bf16(r_[j_].z * rs_ * gg[j_].z, r_[j_].w * rs_ * gg[j_].w); o8_[64 * j_] = w_; } } } while (0)
        P0_LOADROW(r0, gw); P0_LOADROW(r1, gw + NGW);
#pragma unroll 1
        for (int m = gw; m < T; m += 3 * NGW) {
            P0_LOADROW(r2, m + 2 * NGW); P0_DOROW(r0, m);
            P0_LOADROW(r0, m + 3 * NGW); P0_DOROW(r1, m + NGW);
            P0_LOADROW(r1, m + 4 * NGW); P0_DOROW(r2, m + 2 * NGW);
        }
#undef P0_LOADROW
#undef P0_DOROW
    }
    for (int m = gw; m < BATCH * NMEM; m += NGW) rms_row_to_bf16(a.in[I_MEM] + (size_t)m * D, a.in[I_NMEMG], (bf16_t*)(ws + WS_MEMN) + (size_t)m * D, lane);
}

constexpr int AT_KS = 144;
constexpr int AT_VS = 520;
constexpr int AT_VOFF = 256 * AT_KS;
__device__ __forceinline__ bf16x8 pack_step(const f32x16& x, int s) {
    u32x4 p;
    asm volatile("v_cvt_pk_bf16_f32 %0, %4, %5\n\tv_cvt_pk_bf16_f32 %1, %6, %7\n\tv_cvt_pk_bf16_f32 %2, %8, %9\n\tv_cvt_pk_bf16_f32 %3, %10, %11\n\ts_nop 1"
                 : "=&v"(p[0]), "=&v"(p[1]), "=&v"(p[2]), "=&v"(p[3])
                 : "v"(x[8 * s]), "v"(x[8 * s + 1]), "v"(x[8 * s + 2]), "v"(x[8 * s + 3]), "v"(x[8 * s + 4]), "v"(x[8 * s + 5]), "v"(x[8 * s + 6]), "v"(x[8 * s + 7]));
    return __builtin_bit_cast(bf16x8, p);
}
__device__ __forceinline__ void attn_unit(const Args& a, LAS unsigned char* lds, int unit) {
    int tid = tid_of(a.wv); asm volatile("" : "+v"(tid)); const int lane = tid & 63, wave = __builtin_amdgcn_readfirstlane(tid >> 6), r = lane & 31, h = lane >> 5;
    const int b = unit >> 2, hh = unit & 3;
    const bf16_t* Qb = (const bf16_t*)(a.ws + WS_Q); const bf16_t* KM = (const bf16_t*)(a.ws + WS_KMEM); const bf16_t* VT = (const bf16_t*)(a.ws + WS_VT);
    bf16_t* MIX = (bf16_t*)(a.ws + WS_MIX);
    __syncthreads();
#pragma unroll
    for (int i = 0; i < 4; ++i) { const int c = tid + 512 * i, key = c >> 3, ch = c & 7;
        const u32x4 v = *(const u32x4*)(KM + (size_t)(b * NMEM + key) * 256 + hh * 64 + ch * 8);
        *(LAS u32x4*)(lds + key * AT_KS + ch * 16) = v; }
#pragma unroll
    for (int i = 0; i < 4; ++i) { const int c = tid + 512 * i, d = c >> 5, ch = c & 31;
        const u32x4 v = *(const u32x4*)(VT + (size_t)(hh * 64 + d) * (BATCH * NMEM) + b * NMEM + ch * 8);
        LAS u32x2* dst = (LAS u32x2*)(lds + AT_VOFF + d * AT_VS + ch * 16);
        dst[0] = (u32x2){v.x, v.y}; dst[1] = (u32x2){v.z, v.w}; }
    __syncthreads();
#pragma unroll 1
    for (int tile = 0; tile < 16; ++tile) {
    const int tok0 = b * SEQ + tile * 256 + wave * 32;
    bf16x8 qf[4];
#pragma unroll
    for (int ks = 0; ks < 4; ++ks) qf[ks] = __builtin_nontemporal_load((const bf16x8*)(Qb + (size_t)(tok0 + r) * 256 + hh * 64 + ks * 16 + h * 8));
    const float sc = 0.125f * 1.4426950408889634f;
    float m_run = -3.0e38f, sum = 0.f;
    f32x16 o[2];
#pragma unroll
    for (int dt = 0; dt < 2; ++dt)
#pragma unroll
        for (int i = 0; i < 16; ++i) o[dt][i] = 0.f;
#pragma unroll 1
    for (int kh = 0; kh < 2; ++kh) {
        f32x16 s[4];
#pragma unroll
        for (int k4 = 0; k4 < 4; ++k4) {
#pragma unroll
            for (int i = 0; i < 16; ++i) s[k4][i] = 0.f;
#pragma unroll
            for (int ks = 0; ks < 4; ++ks) { const bf16x8 ka = *(const LAS bf16x8*)(lds + ((kh * 4 + k4) * 32 + r) * AT_KS + (ks * 16 + h * 8) * 2);
                s[k4] = __builtin_amdgcn_mfma_f32_32x32x16_bf16(ka, qf[ks], s[k4], 0, 0, 0); }
        }
        float mx = m_run;
#pragma unroll
        for (int k4 = 0; k4 < 4; ++k4)
#pragma unroll
            for (int i = 0; i < 16; ++i) mx = fmaxf(mx, s[k4][i]);
        mx = fmaxf(mx, __shfl_xor(mx, 32));
        const float alpha = __builtin_amdgcn_exp2f((m_run - mx) * sc);
        float ps = 0.f;
#pragma unroll
        for (int k4 = 0; k4 < 4; ++k4)
#pragma unroll
            for (int i = 0; i < 16; ++i) { const float e = __builtin_amdgcn_exp2f((s[k4][i] - mx) * sc); s[k4][i] = e; ps += e; }
        ps += __shfl_xor(ps, 32);
        sum = sum * alpha + ps; m_run = mx;
#pragma unroll
        for (int dt = 0; dt < 2; ++dt)
#pragma unroll
            for (int i = 0; i < 16; ++i) o[dt][i] *= alpha;
#pragma unroll
        for (int k4 = 0; k4 < 4; ++k4)
#pragma unroll
            for (int s2 = 0; s2 < 2; ++s2) {
                const bf16x8 pb = pack_step(s[k4], s2);
#pragma unroll
                for (int dt = 0; dt < 2; ++dt) {
                    const LAS unsigned char* vp = lds + AT_VOFF + (32 * dt + r) * AT_VS + (32 * (kh * 4 + k4) + 16 * s2 + 4 * h) * 2;
                    const s16x4 lo = *(const LAS s16x4*)vp, hi = *(const LAS s16x4*)(vp + 16);
                    const bf16x8 va = __builtin_shufflevector(lo, hi, 0, 1, 2, 3, 4, 5, 6, 7);
                    o[dt] = __builtin_amdgcn_mfma_f32_32x32x16_bf16(va, pb, o[dt], 0, 0, 0);
                }
            }
    }
    const float inv = 1.0f / sum;
    bf16_t* orow = MIX + mix_off((size_t)(tok0 + r), hh * 64);
#pragma unroll
    for (int dt = 0; dt < 2; ++dt)
#pragma unroll
        for (int gq = 0; gq < 4; ++gq) { u32x2 w; w.x = pk_bf16(o[dt][4 * gq] * inv, o[dt][4 * gq + 1] * inv); w.y = pk_bf16(o[dt][4 * gq + 2] * inv, o[dt][4 * gq + 3] * inv);
            *(u32x2*)(orow + 32 * dt + 8 * gq + 4 * h) = w; }
    }
}

__device__ __forceinline__ int p2_unit(int u, int G) { if (G != 256) return u; const int k = u >> 8, j = u & 255, x = j >> 5, r = j & 31; return 4 * (32 * x + 8 * k + (r >> 2)) + (r & 3); }
constexpr int CV_U = 0, CV_C = 94 * 384 * 2, CV_W = CV_C + 64 * 384 * 2, CV_PRM = CV_W + 31 * 384 * 2;
static_assert(CV_PRM + 3 * 384 * 4 <= LDS_BYTES - 512, "conv LDS map");
__device__ __forceinline__ void conv_prestage(const Args& a, LAS unsigned char* lds) {
    int tid = tid_of(a.wv); asm volatile("" : "+v"(tid));
    LAS _Float16* W16 = (LAS _Float16*)(lds + CV_W); LAS float* PRM = (LAS float*)(lds + CV_PRM);
    for (int i = tid; i < 31 * CW; i += NTHREADS) W16[i] = (_Float16)a.in[I_CONVW][i];
    for (int i = tid; i < 3 * CW; i += NTHREADS) PRM[i] = (i < CW) ? a.in[I_CONVB][i] : (i < 2 * CW) ? a.in[I_CLNG][i - CW] : a.in[I_CLNB][i - 2 * CW];
}
__device__ __forceinline__ void conv_stream(const Args& a, LAS unsigned char* lds, int u0, int G, bool pre) {
    int tid = tid_of(a.wv); asm volatile("" : "+v"(tid)); const int lane = tid & 63, wave = __builtin_amdgcn_readfirstlane(tid >> 6);
    if (u0 >= 1024) return;
    const bf16_t* P = (const bf16_t*)(a.ws + WS_P); bf16_t* MIX = (bf16_t*)(a.ws + WS_MIX);
    LAS _Float16* U = (LAS _Float16*)(lds + CV_U);
    LAS _Float16* Cc = (LAS _Float16*)(lds + CV_C);
    LAS _Float16* W16 = (LAS _Float16*)(lds + CV_W); LAS float* PRM = (LAS float*)(lds + CV_PRM);
    if (!pre) { __syncthreads(); conv_prestage(a, lds); }
    u32x4 vvv[9];
#define CONV_LOAD(un_) do { const int b_ = (un_) >> 6, t0_ = ((un_) & 63) * 64; \
        _Pragma("unroll") for (int u9 = 0; u9 < 9; ++u9) { const int q = tid + u9 * NTHREADS, j = q / 48, cc = (q % 48) * 8, sq = t0_ - 15 + j; const bool ok = (q < 94 * 48) && sq >= 0 && sq < SEQ; \
            const bf16_t* row = P + (size_t)(b_ * SEQ + (ok ? sq : 0)) * CW + cc; \
            vvv[u9] = ok ? __builtin_nontemporal_load((const u32x4*)row) : (u32x4){0u, 0u, 0u, 0u}; } } while (0)
    CONV_LOAD(p2_unit(u0, G));
#pragma unroll 1
    for (int uu = u0; uu < 1024; uu += G) { const int unit = p2_unit(uu, G);
        const int b = unit >> 6, t0 = (unit & 63) * 64;
        __syncthreads();
#pragma unroll
        for (int u9 = 0; u9 < 9; ++u9) { const int q = tid + u9 * NTHREADS, j = q / 48, cc = (q % 48) * 8;
            if (q < 94 * 48) {
                const unsigned vw[4] = {vvv[u9].x, vvv[u9].y, vvv[u9].z, vvv[u9].w};
                float u[8];
#pragma unroll
                for (int k = 0; k < 4; ++k) { u[2 * k] = bf_lo(vw[k]); u[2 * k + 1] = bf_hi(vw[k]); }
                LAS f16x4* dst = (LAS f16x4*)(U + j * CW + cc); dst[0] = (f16x4){(_Float16)u[0], (_Float16)u[1], (_Float16)u[2], (_Float16)u[3]}; dst[1] = (f16x4){(_Float16)u[4], (_Float16)u[5], (_Float16)u[6], (_Float16)u[7]}; }
        }
        if (uu + G < 1024) CONV_LOAD(p2_unit(uu + G, G));
        __syncthreads();
#pragma unroll 1
        for (int k3 = 0; k3 < 3; ++k3) { const int it = tid + k3 * NTHREADS, c = 2 * (it % 192), g8 = (it / 192) * 8;
            f16x2 w2[31], res[8];
#pragma unroll
            for (int kk = 0; kk < 31; ++kk) w2[kk] = *(const LAS f16x2*)(W16 + kk * CW + c);
            const f16x2 bias2 = {(_Float16)PRM[c], (_Float16)PRM[c + 1]};
#pragma unroll
            for (int tt = 0; tt < 8; ++tt) res[tt] = bias2;
#pragma unroll
            for (int jj = 0; jj < 38; ++jj) { const f16x2 uv = *(const LAS f16x2*)(U + (g8 + jj) * CW + c);
#pragma unroll
                for (int tt = 0; tt < 8; ++tt) { if (jj - tt >= 0 && jj - tt <= 30) res[tt] += uv * w2[jj - tt]; } }
#pragma unroll
            for (int tt = 0; tt < 8; ++tt) *(LAS f16x2*)(Cc + (g8 + tt) * CW + c) = res[tt];
        }
        __syncthreads();
        for (int tt = 0; tt < 8; ++tt) { const int t = wave * 8 + tt;
            float v[6]; float sm = 0.f;
#pragma unroll
            for (int i = 0; i < 3; ++i) { const f16x2 h2v = *(const LAS f16x2*)(Cc + t * CW + 2 * lane + 128 * i); v[2 * i] = (float)h2v.x; v[2 * i + 1] = (float)h2v.y; sm += v[2 * i] + v[2 * i + 1]; }
            const float mean = wave_sum(sm) * (1.f / CW); float q = 0.f;
#pragma unroll
            for (int i = 0; i < 6; ++i) { v[i] -= mean; q += v[i] * v[i]; }
            const float rstd = 1.0f / sqrtf(wave_sum(q) * (1.f / CW) + 1e-5f);
            const size_t otok = (size_t)(b * SEQ + t0 + t);
#pragma unroll
            for (int i = 0; i < 3; ++i) { const int c = 2 * lane + 128 * i; float o2[2];
#pragma unroll
                for (int e = 0; e < 2; ++e) { const float y = v[2 * i + e] * rstd * PRM[CW + c + e] + PRM[2 * CW + c + e]; o2[e] = y * sigmoidf_fast(y); }
                *(unsigned*)(MIX + mix_off(otok, 256 + c)) = pk_bf16(o2[0], o2[1]); }
        }
    }
#undef CONV_LOAD
}

constexpr int PR_AS = 784;
constexpr int PR_RK = 64 * PR_AS;
constexpr int PR_RKS = 1552;
constexpr int PR_RN = PR_RK + 64 * PR_RKS;
constexpr int PR_CST = PR_RN + 2048;
static_assert(PR_CST + 7 * 384 * 4 <= LDS_BYTES - 64, "prep LDS map");
template <int V> struct IC { static constexpr int value = V; };
template <int CTRL> __device__ __forceinline__ f32x4 dpp4(f32x4 x) { return (f32x4){dpp_f<CTRL>(x.x), dpp_f<CTRL>(x.y), dpp_f<CTRL>(x.z), dpp_f<CTRL>(x.w)}; }
__device__ __forceinline__ void prep_unit(const Args& a, LAS unsigned char* lds, int unit) {
    int tid = tid_of(a.wv); asm volatile("" : "+v"(tid)); const int lane = tid & 63, wave = __builtin_amdgcn_readfirstlane(tid >> 6);
    const int b = unit >> 6, t0 = (unit & 63) * 64;
    const bf16_t* __restrict__ PRp = (const bf16_t*)(a.ws + WS_PR);
    const float* __restrict__ mu = a.in[I_SHIFTMU];
    LAS float* RNs = (LAS float*)(lds + PR_RN); LAS float* CST = (LAS float*)(lds + PR_CST);
    __syncthreads();
    for (int i = tid; i < 7 * 384; i += NTHREADS) { const int w7 = i / 384, c7 = i % 384;
        CST[i] = (w7 == 0) ? a.in[I_KK][c7] : (w7 == 1) ? a.in[I_KA][c7] : (w7 == 2) ? a.in[I_RK][c7] : (w7 < 5) ? a.in[I_DW0][(w7 - 3) * RW + c7] : a.in[I_IA0][(w7 - 5) * RW + c7]; }
#ifndef PREP_REP1
#define PREP_REP1 1
#endif
    struct S1Buf { u32x4 cu[2], pv[2], nv[2]; f32x4 m0a, m0b, m1a, m1b, ka, kb; };
    const int s1row = 8 * wave + (lane >> 4), s1c = lane & 15;
    auto s1_issue = [&](auto sc, S1Buf& B) {
        constexpr int sb = decltype(sc)::value, ty = sb < 3 ? 2 : sb == 3 ? 3 : sb < 7 ? 0 : sb < 10 ? 1 : 3, cg = sb < 3 ? sb : sb == 3 ? 2 : sb < 7 ? sb - 4 : sb < 10 ? sb - 7 : sb - 10;
        const int c8 = ty * 384 + (cg * 16 + s1c) * 8;
#pragma unroll
        for (int th = 0; th < 2; ++th) { const int sq = t0 + s1row + 4 * th;
            const bf16_t* row = PRp + (size_t)(c8 >> 8) * ((size_t)T * 256) + ((size_t)b * SEQ + sq) * 256 + (c8 & 255);
            B.cu[th] = *(const u32x4*)row;
            B.pv[th] = (sq > 0) ? *(const u32x4*)(row - 256) : (u32x4){0u, 0u, 0u, 0u};
            B.nv[th] = (sq < SEQ - 1) ? *(const u32x4*)(row + 256) : (u32x4){0u, 0u, 0u, 0u}; }
        B.m0a = *(const f32x4*)(mu + c8); B.m0b = *(const f32x4*)(mu + c8 + 4); B.m1a = *(const f32x4*)(mu + 1536 + c8); B.m1b = *(const f32x4*)(mu + 1536 + c8 + 4);
        if (ty == 1) { B.ka = *(const f32x4*)(a.in[I_KK] + c8 - 384); B.kb = *(const f32x4*)(a.in[I_KK] + c8 - 384 + 4); }
    };
    auto s1_compute = [&](auto sc, const S1Buf& B) {
        constexpr int sb = decltype(sc)::value, ty = sb < 3 ? 2 : sb == 3 ? 3 : sb < 7 ? 0 : sb < 10 ? 1 : 3, cg = sb < 3 ? sb : sb == 3 ? 2 : sb < 7 ? sb - 4 : sb < 10 ? sb - 7 : sb - 10;
        const int c8 = ty * 384 + (cg * 16 + s1c) * 8;
        const float m0[8] = {B.m0a.x, B.m0a.y, B.m0a.z, B.m0a.w, B.m0b.x, B.m0b.y, B.m0b.z, B.m0b.w}, m1[8] = {B.m1a.x, B.m1a.y, B.m1a.z, B.m1a.w, B.m1b.x, B.m1b.y, B.m1b.z, B.m1b.w};
#pragma unroll
        for (int th = 0; th < 2; ++th) { const int tt = s1row + 4 * th; const size_t tok = (size_t)b * SEQ + t0 + tt;
            const u32x4 cu = B.cu[th], pv = B.pv[th], nv = B.nv[th];
            const unsigned cw[4] = {cu.x, cu.y, cu.z, cu.w}, pw[4] = {pv.x, pv.y, pv.z, pv.w}, nw[4] = {nv.x, nv.y, nv.z, nv.w};
            float pf[8];
#pragma unroll
            for (int k = 0; k < 4; ++k) { const float c0 = bf_lo(cw[k]), c1 = bf_hi(cw[k]);
                pf[2 * k] = c0 + m0[2 * k] * (bf_lo(pw[k]) - c0) + m1[2 * k] * (bf_lo(nw[k]) - c0);
                pf[2 * k + 1] = c1 + m0[2 * k + 1] * (bf_hi(pw[k]) - c1) + m1[2 * k + 1] * (bf_hi(nw[k]) - c1); }
            if (ty < 2) {
                f16x4 h0 = {(_Float16)pf[0], (_Float16)pf[1], (_Float16)pf[2], (_Float16)pf[3]}, h1 = {(_Float16)pf[4], (_Float16)pf[5], (_Float16)pf[6], (_Float16)pf[7]};
                LAS f16x4* dst = (LAS f16x4*)(lds + PR_RK + tt * PR_RKS + c8 * 2); dst[0] = h0; dst[1] = h1;
                if (ty == 1) { const f32x4 ka = B.ka, kb = B.kb;
                    float ssq = (pf[0] * ka.x) * (pf[0] * ka.x) + (pf[1] * ka.y) * (pf[1] * ka.y) + (pf[2] * ka.z) * (pf[2] * ka.z) + (pf[3] * ka.w) * (pf[3] * ka.w)
                              + (pf[4] * kb.x) * (pf[4] * kb.x) + (pf[5] * kb.y) * (pf[5] * kb.y) + (pf[6] * kb.z) * (pf[6] * kb.z) + (pf[7] * kb.w) * (pf[7] * kb.w);
                    ssq = sum8(ssq);
                    if ((lane & 7) == 0) RNs[tt * 8 + ((c8 - 384) >> 6)] = __builtin_amdgcn_rsqf(ssq + 1e-12f); }
            } else if (ty == 2) {
                u32x4 w; w.x = pk_bf16(pf[0], pf[1]); w.y = pk_bf16(pf[2], pf[3]); w.z = pk_bf16(pf[4], pf[5]); w.w = pk_bf16(pf[6], pf[7]);
                *(u32x4*)((bf16_t*)scan_arr(a.ws, 0) + hat_off(0, tok, c8 - 768)) = w;
            } else {
                const int cc = c8 - 1152;
#pragma unroll
                for (int k = 0; k < 8; ++k) { if (cg == 0) pf[k] = 1.0f - 2.0f * __builtin_amdgcn_rcpf(1.0f + __builtin_amdgcn_exp2f(2.8853900817779268f * pf[k])); else if (cg == 2) pf[k] = sigmoidf_fast(pf[k]); }
                u32x4 w; w.x = pk_bf16(pf[0], pf[1]); w.y = pk_bf16(pf[2], pf[3]); w.z = pk_bf16(pf[4], pf[5]); w.w = pk_bf16(pf[6], pf[7]);
                if (cg < 2) *(LAS u32x4*)(lds + tt * PR_AS + cc * 2) = w;
                else *(u32x4*)((bf16_t*)(a.ws + WS_G) + tok * 128 + (cc - 256)) = w; }
        }
    };
#pragma unroll 1
    for (int rp1 = 0; rp1 < PREP_REP1; ++rp1) {
        S1Buf B0, B1, B2;
        s1_issue(IC<0>{}, B0); s1_issue(IC<1>{}, B1);
        s1_issue(IC<2>{}, B2); s1_compute(IC<0>{}, B0);
        s1_issue(IC<3>{}, B0); s1_compute(IC<1>{}, B1);
        s1_issue(IC<4>{}, B1); s1_compute(IC<2>{}, B2);
        s1_issue(IC<5>{}, B2); s1_compute(IC<3>{}, B0);
        s1_issue(IC<6>{}, B0); s1_compute(IC<4>{}, B1);
        s1_issue(IC<7>{}, B1); s1_compute(IC<5>{}, B2);
        s1_issue(IC<8>{}, B2); s1_compute(IC<6>{}, B0);
        s1_issue(IC<9>{}, B0); s1_compute(IC<7>{}, B1);
        s1_issue(IC<10>{}, B1); s1_compute(IC<8>{}, B2);
        s1_issue(IC<11>{}, B2); s1_compute(IC<9>{}, B0);
        s1_compute(IC<10>{}, B1); s1_compute(IC<11>{}, B2);
    }
    __syncthreads();
    const int l15 = lane & 15, kq = lane >> 4;
    float* __restrict__ PCg = (float*)(a.ws + WS_PC); float* __restrict__ BON = (float*)(a.ws + WS_BON);
    const char* SMb = (const char*)(a.ws + WS_SMALL);
    const unsigned wlo64 = (unsigned)(((8 * (l15 >> 2) + (l15 & 3)) * 64 + kq * 8) * 2), wlo128 = (unsigned)(((8 * (l15 >> 2) + (l15 & 3)) * 128 + kq * 8) * 2);
    const unsigned hlo = (unsigned)((l15 * 64 + 8 * kq) * 2), klo = (unsigned)((l15 * D + 8 * kq) * 2), glo = (unsigned)((l15 * RW + 8 * kq) * 2);
    bf16x8 Fc[16], Fn[16];
#define PREP_LOADW(hd_, kind_) do { \
        if ((kind_) < 2) { const char* w_ = SMb + ((size_t)(kind_) * RW * 64 + (size_t)(hd_) * 64 * 64) * 2; \
            _Pragma("unroll") for (int f_ = 0; f_ < 16; ++f_) Fn[f_] = *(const bf16x8*)(w_ + (size_t)(((f_ >> 2) & 1) * (2 * RW * 64 * 2) + (32 * ((f_ & 3) >> 1) + 4 * (f_ & 1)) * 128 + (f_ >> 3) * 64) + wlo64); } \
        else { const char* w_ = SMb + ((size_t)4 * RW * 64 + (size_t)(hd_) * 64 * 128) * 2; \
            _Pragma("unroll") for (int f_ = 0; f_ < 16; ++f_) Fn[f_] = *(const bf16x8*)(w_ + (size_t)((32 * ((f_ & 3) >> 1) + 4 * (f_ & 1)) * 256 + (f_ >> 2) * 64) + wlo128); } } while (0)
    auto dir_stage = [&](auto dc, const int it, const int nhd, const int nkind) {
        constexpr int d = decltype(dc)::value;
        const int hd = it >> 2, mt = it & 3, tokl = mt * 16 + l15; const size_t tb = (size_t)b * SEQ + t0 + mt * 16;
#pragma unroll
        for (int f = 0; f < 16; ++f) Fc[f] = Fn[f];
        f32x4 accW[4], accA[4];
#pragma unroll
        for (int nt = 0; nt < 4; ++nt) { accW[nt] = (f32x4){0.f, 0.f, 0.f, 0.f}; accA[nt] = (f32x4){0.f, 0.f, 0.f, 0.f}; }
#pragma unroll
        for (int ks = 0; ks < 2; ++ks) {
            const bf16x8 aw = *(const LAS bf16x8*)(lds + tokl * PR_AS + (d * 64 + ks * 32 + kq * 8) * 2), aa = *(const LAS bf16x8*)(lds + tokl * PR_AS + ((2 + d) * 64 + ks * 32 + kq * 8) * 2);
#pragma unroll
            for (int nt = 0; nt < 4; ++nt) { accW[nt] = MFMA16(Fc[ks * 8 + nt], aw, accW[nt]); accA[nt] = MFMA16(Fc[ks * 8 + 4 + nt], aa, accA[nt]); }
        }
        if (nkind >= 0) PREP_LOADW(nhd, nkind);
        const float rn = RNs[tokl * 8 + hd];
        const size_t tile_b = ((((tb >> 4) * NH + hd) << 10)) * 2;
        char* AHb = (char*)scan_arr(a.ws, 1 + 4 * d) + tile_b; char* RHb = (char*)scan_arr(a.ws, 2 + 4 * d) + tile_b; char* BHb = (char*)scan_arr(a.ws, 3 + 4 * d) + tile_b;
        char* KHb = d ? (char*)scan_arr(a.ws, 8) + mix_off(tb, 640 + hd * 64) * 2 : (char*)scan_arr(a.ws, 4) + tile_b; const unsigned khlo = hlo; (void)klo;
        char* PCb = (char*)(PCg + ((size_t)d * (T / 16) + (tb >> 4)) * RW + hd * 64); char* BOb = (char*)(BON + (size_t)d * T * NH + tb * NH + hd);
        float bsum = 0.f; const float first1 = (l15 == (d ? 15 : 0)) ? 1.f : 0.f;
        u32x2 hA[2], hR[2], hB[2], hK[2]; f32x4 PtS[4];
#pragma unroll
        for (int nt = 0; nt < 4; ++nt) { const int ch = hd * 64 + 32 * (nt >> 1) + 8 * kq + 4 * (nt & 1);
            const f32x4 bW = *(const LAS f32x4*)(CST + (3 + d) * 384 + ch), bA = *(const LAS f32x4*)(CST + (5 + d) * 384 + ch);
            const f32x4 kkw = *(const LAS f32x4*)(CST + ch), kaw = *(const LAS f32x4*)(CST + 384 + ch), rkw = *(const LAS f32x4*)(CST + 768 + ch);
            const f32x4 zw = accW[nt] + bW, za = accA[nt] + bA;
            f32x4 lw, av;
#pragma unroll
            for (int e = 0; e < 4; ++e) { lw[e] = -0.606531f * 1.4426950408889634f * sigmoidf_fast(zw[e]); av[e] = sigmoidf_fast(za[e]); }
            f32x4 cum = lw;
#define PREP_CUM4(SH) "v_add_f32_dpp %0, %0, %0 " SH " row_mask:0xf bank_mask:0xf bound_ctrl:1\n\tv_add_f32_dpp %1, %1, %1 " SH " row_mask:0xf bank_mask:0xf bound_ctrl:1\n\t" \
                      "v_add_f32_dpp %2, %2, %2 " SH " row_mask:0xf bank_mask:0xf bound_ctrl:1\n\tv_add_f32_dpp %3, %3, %3 " SH " row_mask:0xf bank_mask:0xf bound_ctrl:1\n\t"
            if (d == 0) asm volatile("s_nop 1\n\t" PREP_CUM4("row_shr:1") PREP_CUM4("row_shr:2") PREP_CUM4("row_shr:4") PREP_CUM4("row_shr:8") : "+v"(cum.x), "+v"(cum.y), "+v"(cum.z), "+v"(cum.w));
            else        asm volatile("s_nop 1\n\t" PREP_CUM4("row_shl:1") PREP_CUM4("row_shl:2") PREP_CUM4("row_shl:4") PREP_CUM4("row_shl:8") : "+v"(cum.x), "+v"(cum.y), "+v"(cum.z), "+v"(cum.w));
#undef PREP_CUM4
            f32x4 Pt, Pinv, Pprev;
#pragma unroll
            for (int e = 0; e < 4; ++e) { Pt[e] = __builtin_amdgcn_exp2f(cum[e]); Pinv[e] = __builtin_amdgcn_rcpf(Pt[e]);
                Pprev[e] = dpp_f<d ? 0x101 : 0x111>(Pt[e]) + first1; }
            PtS[nt] = Pt;
            const f32x4 r4 = __builtin_convertvector(*(const LAS f16x4*)(lds + PR_RK + tokl * PR_RKS + ch * 2), f32x4);
            const f32x4 k4 = __builtin_convertvector(*(const LAS f16x4*)(lds + PR_RK + tokl * PR_RKS + (384 + ch) * 2), f32x4);
            const f32x4 kk = k4 * kkw * rn, kd = k4 * (1.0f + (av - 1.0f) * kaw);
            hA[nt & 1] = f32_to_bf4(-kk * Pprev); hR[nt & 1] = f32_to_bf4(r4 * Pt); hB[nt & 1] = f32_to_bf4(kk * av * Pinv); hK[nt & 1] = f32_to_bf4(kd * Pinv);
            const f32x4 bt = r4 * kd * rkw; bsum += (bt.x + bt.y) + (bt.z + bt.w);
            if (nt & 1) { const int pr = nt >> 1;
                *(u32x4*)(AHb + (hlo + 64 * pr)) = (u32x4){hA[0].x, hA[0].y, hA[1].x, hA[1].y}; *(u32x4*)(RHb + (hlo + 64 * pr)) = (u32x4){hR[0].x, hR[0].y, hR[1].x, hR[1].y};
                *(u32x4*)(BHb + (hlo + 64 * pr)) = (u32x4){hB[0].x, hB[0].y, hB[1].x, hB[1].y}; *(u32x4*)(KHb + (khlo + 64 * pr)) = (u32x4){hK[0].x, hK[0].y, hK[1].x, hK[1].y}; }
        }
        if (l15 == (d ? 0 : 15)) {
#pragma unroll
            for (int nt = 0; nt < 4; ++nt) *(f32x4*)(PCb + (unsigned)(8 * kq * 4) + (32 * (nt >> 1) + 4 * (nt & 1)) * 4) = PtS[nt]; }
        bsum += __shfl_xor(bsum, 16); bsum += __shfl_xor(bsum, 32);
        if (kq == 0) *(float*)(BOb + (unsigned)(l15 * NH * 4)) = bsum;
    };
    PREP_LOADW(wave >> 2, 0);
#pragma unroll 1
    for (int k3 = 0; k3 < 3; ++k3) { const int it = wave + 8 * k3, hd = it >> 2;
        dir_stage(IC<0>{}, it, hd, 1);
        dir_stage(IC<1>{}, it, (it + 8) >> 2, k3 < 2 ? 0 : -1);
    }
#undef PREP_LOADW
}

__device__ __forceinline__ void glds16_asm(const void* gptr, LAS unsigned char* ldst) {
    const unsigned la = __builtin_amdgcn_readfirstlane((unsigned)(size_t)ldst);
    asm volatile("s_mov_b32 m0, %1\n\ts_nop 0\n\tglobal_load_lds_dwordx4 %0, off" :: "v"(gptr), "s"(la) : "m0", "memory");
}
constexpr int CK = 16, NCHUNK = SEQ / CK, CS_NS = 8, CS_NPROD = 4, CS_NCONS = 4, CS_TPC = 4 / CS_NCONS;
constexpr int SL_ATIL = 0, SL_RTIL = 2048, SL_BH = 4096, SL_KH = 6144, SL_V = 8192, SL_ULOC = 10240, SL_YLOC = 12288, SL_PC = 14336, SL_BYTES = 14592;
constexpr int PS_AH = 0, PS_RH = 2048, PS_BYTES = 4096;
constexpr int CS_PS_OFF = CS_NS * SL_BYTES, CS_FLAG_OFF = CS_PS_OFF + CS_NPROD * PS_BYTES;
static_assert(CS_FLAG_OFF + 4 * (8 + 8 * CS_NCONS) <= LDS_BYTES - 512, "chunked scan LDS map");
__device__ __forceinline__ int swz(int t, int j) { return t * 128 + ((((j >> 3) ^ (t & 7))) << 4) + ((j & 4) << 1); }
__device__ __forceinline__ void scan_chunked_unit(const Args& a, LAS unsigned char* lds, int unit) {
    int tid = tid_of(a.wv); asm volatile("" : "+v"(tid)); const int lane = tid & 63, wave = __builtin_amdgcn_readfirstlane(tid >> 6);
    const int dir = unit & 1, bh = unit >> 1, b = bh / NH, hd = bh % NH;
    const int c16 = lane & 15, q = lane >> 4, qp = c16 >> 2, pp = c16 & 3;
    volatile LAS unsigned* FULL = (volatile LAS unsigned*)(lds + CS_FLAG_OFF);
    volatile LAS unsigned* DONE = FULL + 8;
    bf16_t* Yg = (bf16_t*)(a.ws + (dir ? WS_YB : WS_YF));
    __syncthreads();
    if (tid < 8 + 8 * CS_NCONS) FULL[tid] = 0u;
    __syncthreads();
    if (wave >= CS_NCONS) {
        const int pw = wave - CS_NCONS;
        LAS unsigned char* ps = lds + CS_PS_OFF + pw * PS_BYTES;
        const bf16_t* ARR[5] = {(const bf16_t*)scan_arr(a.ws, 1 + 4 * dir), (const bf16_t*)scan_arr(a.ws, 2 + 4 * dir), (const bf16_t*)scan_arr(a.ws, 3 + 4 * dir), (const bf16_t*)scan_arr(a.ws, 4 + 4 * dir), (const bf16_t*)scan_arr(a.ws, 0)};
        const int AIDX[5] = {1 + 4 * dir, 2 + 4 * dir, 3 + 4 * dir, 4 + 4 * dir, 0};
        const float* PCg = (const float*)(a.ws + WS_PC) + (size_t)dir * (T / 16) * RW + hd * 64 + lane;
        u32x4 pfA[10], pfB[10];
#define CS_ISSUE(cc) do { _Pragma("unroll") for (int ar_ = 0; ar_ < 5; ++ar_) _Pragma("unroll") for (int hf_ = 0; hf_ < 2; ++hf_) { \
            const int row_ = hf_ * 8 + (lane >> 3); const int st_ = (cc) * CK + row_; const int t_ = dir ? (SEQ - 1 - st_) : st_; \
            pf[ar_ * 2 + hf_] = __builtin_nontemporal_load((const u32x4*)(ARR[ar_] + hat_off(AIDX[ar_], (size_t)b * SEQ + t_, hd * 64 + 8 * ((lane & 7) ^ (row_ & 7))))); } } while (0)
#define CS_PCLOAD(cc) PCg[(size_t)((size_t)b * (SEQ / CK) + (dir ? (NCHUNK - 1 - (cc)) : (cc))) * RW]
        auto prod_body = [&](u32x4 (&pf)[10], float& pcn, const int c, const int cnext) {
            const int slot = c % CS_NS; LAS unsigned char* sl = lds + slot * SL_BYTES;
            { unsigned sp = 0; const unsigned want = (unsigned)(c / CS_NS); for (;;) { bool ok = true;
#pragma unroll
                for (int cw = 0; cw < CS_NCONS; ++cw) ok = ok && (DONE[slot * CS_NCONS + cw] >= want);
                if (ok) break; __builtin_amdgcn_s_sleep(1); if (++sp > (1u << 22)) break; } }
            asm volatile("" ::: "memory");
            *(LAS u32x4*)(ps + PS_AH + lane * 16) = pf[0]; *(LAS u32x4*)(ps + PS_AH + 1024 + lane * 16) = pf[1];
            *(LAS u32x4*)(ps + PS_RH + lane * 16) = pf[2]; *(LAS u32x4*)(ps + PS_RH + 1024 + lane * 16) = pf[3];
            *(LAS u32x4*)(sl + SL_BH + lane * 16) = pf[4]; *(LAS u32x4*)(sl + SL_BH + 1024 + lane * 16) = pf[5];
            *(LAS u32x4*)(sl + SL_KH + lane * 16) = pf[6]; *(LAS u32x4*)(sl + SL_KH + 1024 + lane * 16) = pf[7];
            *(LAS u32x4*)(sl + SL_V + lane * 16) = pf[8]; *(LAS u32x4*)(sl + SL_V + 1024 + lane * 16) = pf[9];
            *(LAS float*)(sl + SL_PC + lane * 4) = pcn;
            if (cnext < NCHUNK) { CS_ISSUE(cnext); pcn = CS_PCLOAD(cnext); }
            asm volatile("s_waitcnt lgkmcnt(0)" ::: "memory");
#ifndef PROD_REP
#define PROD_REP 1
#endif
#pragma unroll 1
            for (int rpp = 0; rpp < PROD_REP; ++rpp) {
            bf16x8 AHf[2], BHf[2], KHf[2], RHf[2];
#pragma unroll
            for (int ks = 0; ks < 2; ++ks) { const int o = swz(c16, 32 * ks + 8 * q);
                AHf[ks] = *(const LAS bf16x8*)(ps + PS_AH + o); RHf[ks] = *(const LAS bf16x8*)(ps + PS_RH + o); BHf[ks] = *(const LAS bf16x8*)(sl + SL_BH + o); KHf[ks] = *(const LAS bf16x8*)(sl + SL_KH + o); }
            f32x4 Mab = {0.f, 0.f, 0.f, 0.f}, Mak = Mab, MrbT = Mab, MrkT = Mab, MabT = Mab;
#pragma unroll
            for (int ks = 0; ks < 2; ++ks) { Mab = MFMA16(AHf[ks], BHf[ks], Mab); MabT = MFMA16(BHf[ks], AHf[ks], MabT); Mak = MFMA16(AHf[ks], KHf[ks], Mak); MrbT = MFMA16(BHf[ks], RHf[ks], MrbT); MrkT = MFMA16(KHf[ks], RHf[ks], MrkT); }
#pragma unroll
            for (int r = 0; r < 4; ++r) { const bool lt = c16 < 4 * q + r, gt = 4 * q + r < c16, le = 4 * q + r <= c16;
                Mab[r] = lt ? Mab[r] : 0.f; Mak[r] = lt ? Mak[r] : 0.f; MabT[r] = gt ? MabT[r] : 0.f; MrbT[r] = le ? MrbT[r] : 0.f; MrkT[r] = le ? MrkT[r] : 0.f; }
            const f32x4 z4 = {0.f, 0.f, 0.f, 0.f};
            const bf16x8 fN = frag_lo4(Mab), fNT = frag_lo4(MabT);
            const f32x4 N2 = MFMA16(fNT, fN, z4), N2T = MFMA16(fN, fNT, z4);
            f32x4 PT = MabT;
#pragma unroll
            for (int r = 0; r < 4; ++r) PT[r] += (4 * q + r == c16) ? 1.0f : 0.f;
            const bf16x8 fN2 = frag_lo4(N2), fN2T = frag_lo4(N2T);
            PT = MFMA16(fN2, frag_lo4(PT), PT);
            const f32x4 N4 = MFMA16(fN2T, fN2, z4), N4T = MFMA16(fN2, fN2T, z4);
            const bf16x8 fN4 = frag_lo4(N4), fN4T = frag_lo4(N4T);
            PT = MFMA16(fN4, frag_lo4(PT), PT);
            const f32x4 N8 = MFMA16(fN4T, fN4, z4);
            PT = MFMA16(frag_lo4(N8), frag_lo4(PT), PT);
            const bf16x8 LinvF = frag_lo4(PT);
            const bf16x8 MakF = frag_lo4(Mak), MrbTF = frag_lo4(MrbT);
            const f32x4 W1 = MFMA16(LinvF, MakF, z4);
            const f32x4 W1T = MFMA16(MakF, LinvF, z4);
            const f32x4 W2T = MFMA16(frag_lo4(W1), MrbTF, MrkT);
            f32x4 AtT[4], RtT[4];
#pragma unroll
            for (int jt = 0; jt < 4; ++jt) {
                const bf16x8 ahF = frag_cat(__builtin_bit_cast(u32x2, tr_read16(ps + PS_AH + swz(4 * q + qp, 16 * jt + 4 * pp))), (u32x2){0u, 0u});
                const f32x4 AtN = MFMA16(LinvF, ahF, z4);
                AtT[jt] = MFMA16(ahF, LinvF, z4);
                const f32x4 rinit = bf4_to_f32(*(const LAS u32x2*)(ps + PS_RH + swz(c16, 16 * jt + 4 * q)));
                RtT[jt] = MFMA16(frag_lo4(AtN), MrbTF, rinit);
            }
#pragma unroll
            for (int ks = 0; ks < 2; ++ks) {
                const u32x4 wa = {pk_bf16(AtT[2 * ks][0], AtT[2 * ks][1]), pk_bf16(AtT[2 * ks][2], AtT[2 * ks][3]), pk_bf16(AtT[2 * ks + 1][0], AtT[2 * ks + 1][1]), pk_bf16(AtT[2 * ks + 1][2], AtT[2 * ks + 1][3])};
                const u32x4 wr = {pk_bf16(RtT[2 * ks][0], RtT[2 * ks][1]), pk_bf16(RtT[2 * ks][2], RtT[2 * ks][3]), pk_bf16(RtT[2 * ks + 1][0], RtT[2 * ks + 1][1]), pk_bf16(RtT[2 * ks + 1][2], RtT[2 * ks + 1][3])};
                *(LAS u32x4*)(sl + SL_ATIL + ks * 1024 + lane * 16) = wa; *(LAS u32x4*)(sl + SL_RTIL + ks * 1024 + lane * 16) = wr; }
            *(LAS u32x2*)(sl + SL_ULOC + lane * 8) = f32_to_bf4(W1T); *(LAS u32x2*)(sl + SL_YLOC + lane * 8) = f32_to_bf4(W2T);
            }
            asm volatile("s_waitcnt lgkmcnt(0)" ::: "memory");
            if (lane == 0) FULL[slot] = (unsigned)(c + 1);
        };
        float pcA, pcB = 0.f;
        { u32x4 (&pf)[10] = pfA; CS_ISSUE(pw); pcA = CS_PCLOAD(pw); }
        if (pw + CS_NPROD < NCHUNK) { u32x4 (&pf)[10] = pfB; CS_ISSUE(pw + CS_NPROD); pcB = CS_PCLOAD(pw + CS_NPROD); }
#pragma unroll 1
        for (int c = pw; c < NCHUNK; c += 2 * CS_NPROD) {
            prod_body(pfA, pcA, c, c + 2 * CS_NPROD);
            if (c + CS_NPROD < NCHUNK) prod_body(pfB, pcB, c + CS_NPROD, c + 3 * CS_NPROD);
        }
#undef CS_ISSUE
#undef CS_PCLOAD
    } else {
        __builtin_amdgcn_s_setprio(SCAN_CPRIO);
        struct ConsOps { bf16x8 at0, at1, rt0, rt1, bk[4]; u32x2 w1w, w2w, vfw[CS_TPC]; f32x4 pc[4]; };
        f32x4 S[CS_TPC][4];
#pragma unroll
        for (int ti = 0; ti < CS_TPC; ++ti)
#pragma unroll
            for (int mt = 0; mt < 4; ++mt) S[ti][mt] = (f32x4){0.f, 0.f, 0.f, 0.f};
#define CONS_LOAD(X, cc) do { const int slot_ = (cc) % CS_NS; LAS unsigned char* sl_ = lds + slot_ * SL_BYTES; \
            if (flpre < (unsigned)((cc) + 1)) { unsigned sp_ = 0; while (FULL[slot_] < (unsigned)((cc) + 1)) { __builtin_amdgcn_s_sleep(1); if (++sp_ > (1u << 22)) break; } }     \
            asm volatile("" ::: "memory"); \
            X.at0 = *(const LAS bf16x8*)(sl_ + SL_ATIL + lane * 16); X.at1 = *(const LAS bf16x8*)(sl_ + SL_ATIL + 1024 + lane * 16); \
            X.rt0 = *(const LAS bf16x8*)(sl_ + SL_RTIL + lane * 16); X.rt1 = *(const LAS bf16x8*)(sl_ + SL_RTIL + 1024 + lane * 16); \
            X.w1w = *(const LAS u32x2*)(sl_ + SL_ULOC + lane * 8); X.w2w = *(const LAS u32x2*)(sl_ + SL_YLOC + lane * 8); \
            _Pragma("unroll") for (int mt_ = 0; mt_ < 4; ++mt_) { X.pc[mt_] = *(const LAS f32x4*)(sl_ + SL_PC + (16 * mt_ + 4 * q) * 4); \
                X.bk[mt_] = frag_cat(__builtin_bit_cast(u32x2, tr_read16(sl_ + SL_BH + swz(4 * q + qp, 16 * mt_ + 4 * pp))), __builtin_bit_cast(u32x2, tr_read16(sl_ + SL_KH + swz(4 * q + qp, 16 * mt_ + 4 * pp)))); } \
            _Pragma("unroll") for (int ti_ = 0; ti_ < CS_TPC; ++ti_) X.vfw[ti_] = __builtin_bit_cast(u32x2, tr_read16(sl_ + SL_V + swz(4 * q + qp, 16 * (CS_TPC * wave + ti_) + 4 * pp))); \
            flpre = FULL[((cc) + 1) % CS_NS]; } while (0)
#define CONS_COMPUTE(X, cc) do { const f32x4 z4c_ = {0.f, 0.f, 0.f, 0.f}; const bf16x8 w1f_ = frag_cat(X.w1w, (u32x2){0u, 0u}), w2f_ = frag_cat(X.w2w, (u32x2){0u, 0u}); \
            _Pragma("unroll") for (int ti_ = 0; ti_ < CS_TPC; ++ti_) { const int nt_ = CS_TPC * wave + ti_; \
                const bf16x8 vB_ = frag_cat(X.vfw[ti_], (u32x2){0u, 0u}); \
                const bf16x8 Sb0_ = frag_cat(f32_to_bf4(S[ti_][0]), f32_to_bf4(S[ti_][1])), Sb1_ = frag_cat(f32_to_bf4(S[ti_][2]), f32_to_bf4(S[ti_][3])); \
                const f32x4 U0_ = MFMA16(X.at0, Sb0_, MFMA16(w1f_, vB_, z4c_)), U1_ = MFMA16(X.at1, Sb1_, z4c_); \
                const f32x4 Y0_ = MFMA16(X.rt0, Sb0_, MFMA16(w2f_, vB_, z4c_)), Y1_ = MFMA16(X.rt1, Sb1_, z4c_); \
                const f32x4 UT_ = U0_ + U1_, YT_ = Y0_ + Y1_; \
                const bf16x8 Ub_ = frag_cat(f32_to_bf4(UT_), X.vfw[ti_]); \
                _Pragma("unroll") for (int mt_ = 0; mt_ < 4; ++mt_) { S[ti_][mt_] = MFMA16(X.bk[mt_], Ub_, S[ti_][mt_]); S[ti_][mt_] = S[ti_][mt_] * X.pc[mt_]; } \
                *(u32x2*)(yp + ti_ * 256) = f32_to_bf4(YT_); } yp += ystep; } while (0)
#define CONS_DONE(cc) do { asm volatile("s_waitcnt lgkmcnt(0)" ::: "memory"); if (lane == 0) DONE[((cc) % CS_NS) * CS_NCONS + wave] = (unsigned)((cc) / CS_NS + 1); } while (0)
        ConsOps OA, OB; unsigned flpre = 0u;
        bf16_t* yp = Yg + ((((size_t)b * NCHUNK + (dir ? (NCHUNK - 1) : 0)) * NH + hd) * 64 + 16 * (CS_TPC * wave) + c16) * 16 + 4 * q; const long ystep = dir ? -(long)(NH * 64 * 16) : (long)(NH * 64 * 16);
        CONS_LOAD(OA, 0);
#pragma unroll 1
        for (int c = 0; c < NCHUNK; c += 2) {
            CONS_LOAD(OB, c + 1);
            CONS_COMPUTE(OA, c);
            CONS_DONE(c);
            if (c + 2 < NCHUNK) CONS_LOAD(OA, c + 2);
            CONS_COMPUTE(OB, c + 1);
            CONS_DONE(c + 1);
        }
#undef CONS_LOAD
#undef CONS_COMPUTE
#undef CONS_DONE
        __builtin_amdgcn_s_setprio(0);
        unsigned tq0 = 0u, tq1 = 0u, tq2 = 0u, tq3 = 0u, tq4 = 0u, tq5 = 0u, tacc = 0u;
        (void)tq0; (void)tq1; (void)tq2; (void)tq3; (void)tq4; (void)tq5;
        (void)tacc;
    }
}

constexpr int PO_WS = 272;
constexpr int PO_LNP = 384 * PO_WS;
static_assert(PO_LNP + 2 * 384 * 4 <= LDS_BYTES - 512, "post LDS map");
__device__ __forceinline__ void post_prestage(const Args& a, LAS unsigned char* lds) {
    int tid = tid_of(a.wv); asm volatile("" : "+v"(tid));
    LAS float* LNP = (LAS float*)(lds + PO_LNP);
    { const bf16_t* WG = (const bf16_t*)(a.ws + WS_SMALL) + (size_t)4 * RW * 64;
      for (int i = tid; i < RW * 16; i += NTHREADS) { const int row = i >> 4, c16 = i & 15; *(LAS u32x4*)(lds + row * PO_WS + c16 * 16) = *(const u32x4*)(WG + (size_t)row * 128 + c16 * 8); } }
    for (int i = tid; i < 2 * RW; i += NTHREADS) LNP[i] = (i < RW) ? a.in[I_LNXG][i] : a.in[I_LNXB][i - RW];
}
__device__ __forceinline__ void phase_post(const Args& a, LAS unsigned char* lds, int G, bool pre) {
    int tid = tid_of(a.wv); asm volatile("" : "+v"(tid)); const int lane = tid & 63, wave = __builtin_amdgcn_readfirstlane(tid >> 6);
    const int gw = blockIdx.x * 8 + wave, NGW = G * 8, t = lane & 15, kq = lane >> 4;
    const bf16_t* __restrict__ YF = (const bf16_t*)(a.ws + WS_YF); const bf16_t* __restrict__ YB = (const bf16_t*)(a.ws + WS_YB); const float* __restrict__ BON = (const float*)(a.ws + WS_BON);
    const bf16_t* __restrict__ Vg = (const bf16_t*)scan_arr(a.ws, 0); const bf16_t* __restrict__ SG = (const bf16_t*)(a.ws + WS_G); bf16_t* __restrict__ MIX = (bf16_t*)(a.ws + WS_MIX);
    float* ss = (float*)(a.ws + WS_SS);
    LAS float* LNP = (LAS float*)(lds + PO_LNP);
    if (!pre) { __syncthreads(); post_prestage(a, lds); }
    for (int i = blockIdx.x * NTHREADS + tid; i < T; i += G * NTHREADS) ss[i] = 0.f;
    __syncthreads();
    constexpr int NIT = (T / 16) * NH;
    struct PItem { unsigned short yf[16], yb[16]; u32x4 v0, v1, sg[4]; float b0, b1; };
#define PO_CH(k_) (32 * ((k_) >> 3) + 8 * kq + ((k_) & 7))
    auto load_item = [&](int it, PItem& I) {
        const int tile = it / NH, hd = it - tile * NH, tok = tile * 16 + t;
        const bf16_t* yfp = YF + ((size_t)it * 64 + 8 * kq) * 16 + t; const bf16_t* ybp = YB + ((size_t)it * 64 + 8 * kq) * 16 + (15 - t);
#pragma unroll
        for (int k = 0; k < 16; ++k) { I.yf[k] = __builtin_nontemporal_load(yfp + (32 * (k >> 3) + (k & 7)) * 16); I.yb[k] = __builtin_nontemporal_load(ybp + (32 * (k >> 3) + (k & 7)) * 16); }
        I.v0 = __builtin_nontemporal_load((const u32x4*)(Vg + ((size_t)it * 16 + t) * 64 + 8 * kq)); I.v1 = __builtin_nontemporal_load((const u32x4*)(Vg + ((size_t)it * 16 + t) * 64 + 32 + 8 * kq));
#pragma unroll
        for (int ks = 0; ks < 4; ++ks) I.sg[ks] = __builtin_nontemporal_load((const u32x4*)(SG + (size_t)tok * 128 + ks * 32 + kq * 8));
        I.b0 = BON[(size_t)tok * NH + hd]; I.b1 = BON[(size_t)T * NH + (size_t)tok * NH + hd];
    };
    auto do_item = [&](int it, const PItem& I) {
        const int tile = it / NH, hd = it - tile * NH, tok = tile * 16 + t;
        f32x4 gacc[4];
#pragma unroll
        for (int nt = 0; nt < 4; ++nt) gacc[nt] = (f32x4){0.f, 0.f, 0.f, 0.f};
#pragma unroll
        for (int ks = 0; ks < 4; ++ks) { const bf16x8 bfr = __builtin_bit_cast(bf16x8, I.sg[ks]);
#pragma unroll
            for (int nt = 0; nt < 4; ++nt) { const int wrow = hd * 64 + 32 * (nt >> 1) + 8 * (t >> 2) + 4 * (nt & 1) + (t & 3);
                const bf16x8 wfr = *(const LAS bf16x8*)(lds + wrow * PO_WS + (ks * 32 + kq * 8) * 2);
                gacc[nt] = MFMA16(wfr, bfr, gacc[nt]); } }
        float y[16];
#pragma unroll
        for (int k = 0; k < 16; ++k) y[k] = bf_lo((unsigned)I.yf[k]) + bf_lo((unsigned)I.yb[k]);
        const float bon = I.b0 + I.b1;
        float sm = 0.f;
#pragma unroll
        for (int k = 0; k < 16; ++k) sm += y[k];
        sm += __shfl_xor(sm, 16); sm += __shfl_xor(sm, 32);
        const float mean = sm * (1.f / 64.f); float vs = 0.f;
#pragma unroll
        for (int k = 0; k < 16; ++k) { y[k] -= mean; vs += y[k] * y[k]; }
        vs += __shfl_xor(vs, 16); vs += __shfl_xor(vs, 32);
        const float rstd = 1.0f / sqrtf(vs * (1.f / 64.f) + 64e-5f);
        const unsigned vw[8] = {I.v0.x, I.v0.y, I.v0.z, I.v0.w, I.v1.x, I.v1.y, I.v1.z, I.v1.w};
        unsigned ow[8];
#pragma unroll
        for (int k2 = 0; k2 < 8; ++k2) { const int k = 2 * k2, ch = hd * 64 + PO_CH(k);
            const float o0 = (y[k] * rstd * LNP[ch] + LNP[RW + ch] + bon * bf_lo(vw[k2])) * gacc[k >> 2][k & 3];
            const float o1 = (y[k + 1] * rstd * LNP[ch + 1] + LNP[RW + ch + 1] + bon * bf_hi(vw[k2])) * gacc[(k + 1) >> 2][(k + 1) & 3];
            ow[k2] = pk_bf16(o0, o1); }
        bf16_t* op = MIX + mix_off((size_t)tok, 640 + hd * 64) + 8 * kq;
        *(u32x4*)op = (u32x4){ow[0], ow[1], ow[2], ow[3]}; *(u32x4*)(op + 32) = (u32x4){ow[4], ow[5], ow[6], ow[7]};
    };
    PItem A, B;
    if (gw < NIT) load_item(gw, A);
#pragma unroll 1
    for (int it = gw; it < NIT; it += 2 * NGW) {
        if (it + NGW < NIT) load_item(it + NGW, B);
        do_item(it, A);
        if (it + 2 * NGW < NIT) load_item(it + 2 * NGW, A);
        if (it + NGW < NIT) do_item(it + NGW, B);
    }
#undef PO_CH
}

constexpr int RT_WS = 2064;
__device__ __forceinline__ void router_prestage(const Args& a, LAS unsigned char* lds) {
    int tid = tid_of(a.wv); asm volatile("" : "+v"(tid));
    LAS bf16_t* WH = (LAS bf16_t*)lds; LAS bf16_t* WL = (LAS bf16_t*)(lds + 16 * RT_WS);
    for (int i = tid; i < D * NE; i += NTHREADS) { const int k = i >> 4, e = i & 15; const float w = a.in[I_WROUTER][i];
        const unsigned hi = pk_bf16(w, 0.f) & 0xffffu; const float rem = w - bf_lo(hi);
        WH[e * (RT_WS / 2) + k] = (bf16_t)hi; WL[e * (RT_WS / 2) + k] = (bf16_t)(pk_bf16(rem, 0.f) & 0xffffu); }
}
__device__ __forceinline__ void phase_router(const Args& a, LAS unsigned char* lds, int G, bool pre) {
    int tid = tid_of(a.wv); asm volatile("" : "+v"(tid)); const int lane = tid & 63, wave = __builtin_amdgcn_readfirstlane(tid >> 6);
    const int gw = blockIdx.x * 8 + wave, NGW = G * 8, l15 = lane & 15, kq = lane >> 4;
    if (!pre) router_prestage(a, lds);
    __syncthreads();
    const bf16_t* __restrict__ X1 = (const bf16_t*)(a.ws + WS_X1); const float* __restrict__ ss = (const float*)(a.ws + WS_SS); bf16_t* __restrict__ H2 = (bf16_t*)(a.ws + WS_H2);
    float* __restrict__ AFF = (float*)(a.ws + WS_AFF); int* __restrict__ INV = (int*)(a.ws + WS_INV);
    const float* __restrict__ GF = a.in[I_NFFNG];
    for (int grp = gw; grp < T / 16; grp += NGW) {
        const int tok = grp * 16 + l15;
        const float rs = 1.0f / sqrtf(ss[tok] * (1.f / D) + 1e-6f);
        f32x4 acc = {0.f, 0.f, 0.f, 0.f};
        const bf16_t* xrow = X1 + (size_t)tok * D + 8 * kq; unsigned char* hrow8 = (unsigned char*)H2 + (size_t)tok * D + 8 * kq;
#pragma unroll 8
        for (int ks = 0; ks < 32; ++ks) {
            const u32x4 xw = __builtin_nontemporal_load((const u32x4*)(xrow + 32 * ks)); const f32x4 x0 = {bf_lo(xw.x), bf_hi(xw.x), bf_lo(xw.y), bf_hi(xw.y)}, x1v = {bf_lo(xw.z), bf_hi(xw.z), bf_lo(xw.w), bf_hi(xw.w)};
            const f32x4 g0 = *(const f32x4*)(GF + 32 * ks + 8 * kq), g1 = *(const f32x4*)(GF + 32 * ks + 8 * kq + 4);
            const f32x4 h0 = x0 * rs * g0, h1 = x1v * rs * g1;
            u32x4 hi; hi.x = pk_bf16(h0.x, h0.y); hi.y = pk_bf16(h0.z, h0.w); hi.z = pk_bf16(h1.x, h1.y); hi.w = pk_bf16(h1.z, h1.w);
            { f32x4 c0 = h0, c1 = h1;
#pragma unroll
              for (int e = 0; e < 4; ++e) { c0[e] = __builtin_amdgcn_fmed3f(c0[e], -448.0f, 448.0f); c1[e] = __builtin_amdgcn_fmed3f(c1[e], -448.0f, 448.0f); }
              *(u32x2*)(hrow8 + 32 * ks) = (u32x2){pk_fp8x4(c0.x, c0.y, c0.z, c0.w), pk_fp8x4(c1.x, c1.y, c1.z, c1.w)}; }
            u32x4 lo; lo.x = pk_bf16(h0.x - bf_lo(hi.x), h0.y - bf_hi(hi.x)); lo.y = pk_bf16(h0.z - bf_lo(hi.y), h0.w - bf_hi(hi.y));
            lo.z = pk_bf16(h1.x - bf_lo(hi.z), h1.y - bf_hi(hi.z)); lo.w = pk_bf16(h1.z - bf_lo(hi.w), h1.w - bf_hi(hi.w));
            const bf16x8 ah = __builtin_bit_cast(bf16x8, hi), al = __builtin_bit_cast(bf16x8, lo);
            const bf16x8 bh = *(const LAS bf16x8*)(lds + l15 * RT_WS + (32 * ks + 8 * kq) * 2), bl = *(const LAS bf16x8*)(lds + 16 * RT_WS + l15 * RT_WS + (32 * ks + 8 * kq) * 2);
            acc = __builtin_amdgcn_mfma_f32_16x16x32_bf16(ah, bh, acc, 0, 0, 0);
            acc = __builtin_amdgcn_mfma_f32_16x16x32_bf16(al, bh, acc, 0, 0, 0);
            acc = __builtin_amdgcn_mfma_f32_16x16x32_bf16(ah, bl, acc, 0, 0, 0);
        }
        { f32x4 pr;
#pragma unroll
          for (int rg = 0; rg < 4; ++rg) { const float mx = max16(acc[rg]); const float ex = __expf(acc[rg] - mx); const float sm = sum16(ex); pr[rg] = ex / sm; }
          const int t2 = grp * 16 + 4 * kq, bb = t2 >> 12, sq = t2 & (SEQ - 1);
          *(f32x4*)(AFF + ((size_t)(bb * NE + l15)) * SEQ + sq) = pr; }
        *(u32x4*)(INV + (size_t)grp * 256 + 4 * lane) = (u32x4){0xffffffffu, 0xffffffffu, 0xffffffffu, 0xffffffffu};
    }
}

__device__ __forceinline__ void topk_unit(const Args& a, LAS unsigned char* lds, int unit) {
    int tid = tid_of(a.wv); asm volatile("" : "+v"(tid)); const int lane = tid & 63, wave = __builtin_amdgcn_readfirstlane(tid >> 6);
    const int b = unit >> 4, e = unit & 15;
    const float* AFF = (const float*)(a.ws + WS_AFF) + (size_t)unit * SEQ;
    LAS unsigned* KEY = (LAS unsigned*)lds;
    LAS unsigned* HIST = (LAS unsigned*)(lds + 16384);
    LAS unsigned* CTL = (LAS unsigned*)(lds + 16384 + 1024);
    LAS unsigned* WS_ = (LAS unsigned*)(lds + 16384 + 2048);
    __syncthreads();
    unsigned key[8];
    { const u32x4 k0 = *(const u32x4*)(AFF + tid * 8), k1 = *(const u32x4*)(AFF + tid * 8 + 4); key[0] = k0.x; key[1] = k0.y; key[2] = k0.z; key[3] = k0.w; key[4] = k1.x; key[5] = k1.y; key[6] = k1.z; key[7] = k1.w; }
    if (tid == 0) { CTL[0] = 0u; CTL[1] = (unsigned)CAP; }
    unsigned prefix = 0u, mask = 0u;
#pragma unroll 1
    for (int pass = 0; pass < 4; ++pass) {
        const int shift = 24 - 8 * pass;
        if (tid < 256) HIST[tid] = 0u;
        __syncthreads();
#pragma unroll
        for (int i = 0; i < 8; ++i) if ((key[i] & mask) == prefix) (void)__hip_atomic_fetch_add(&HIST[(key[i] >> shift) & 255u], 1u, __ATOMIC_RELAXED, __HIP_MEMORY_SCOPE_WORKGROUP);
        __syncthreads();
        if (wave == 0) {
            const unsigned need = CTL[1];
            unsigned hv[4], tsum = 0u;
#pragma unroll
            for (int i = 0; i < 4; ++i) { hv[i] = HIST[255 - (4 * lane + i)]; tsum += hv[i]; }
            unsigned inc = tsum;
#pragma unroll
            for (int o = 1; o < 64; o <<= 1) { const unsigned v = __shfl_up(inc, o); if (lane >= o) inc += v; }
            unsigned exc = inc - tsum;
            if (exc < need && need <= inc) {
                unsigned run = exc; int di = 0;
#pragma unroll
                for (int i = 0; i < 4; ++i) { if (run < need && need <= run + hv[i]) { di = i; break; } run += hv[i]; }
                const unsigned digit = 255u - (unsigned)(4 * lane + di);
                CTL[0] = prefix | (digit << shift); CTL[1] = need - run;
            }
        }
        __syncthreads();
        prefix = CTL[0]; mask |= (255u << shift);
    }
    const unsigned thr = prefix, need_eq = CTL[1];
    unsigned ngt = 0u, neq = 0u;
#pragma unroll
    for (int i = 0; i < 8; ++i) { ngt += (key[i] > thr) ? 1u : 0u; neq += (key[i] == thr) ? 1u : 0u; }
    unsigned pk = ngt | (neq << 16), inc = pk;
#pragma unroll
    for (int o = 1; o < 64; o <<= 1) { const unsigned v = __shfl_up(inc, o); if (lane >= o) inc += v; }
    if (lane == 63) WS_[wave] = inc;
    __syncthreads();
    unsigned woff = 0u, tot = 0u;
#pragma unroll
    for (int w = 0; w < 8; ++w) { const unsigned v = WS_[w]; if (w < wave) woff += v; tot += v; }
    const unsigned exc = inc - pk + woff;
    unsigned gpos = exc & 0xffffu, epos = exc >> 16; const unsigned totgt = tot & 0xffffu;
    const int sbase = (e * BATCH + b) * CAP;
    int* ROWTOK = (int*)(a.ws + WS_ROWTOK); float* ROWGATE = (float*)(a.ws + WS_ROWGATE); int* INV = (int*)(a.ws + WS_INV);
#pragma unroll
    for (int i = 0; i < 8; ++i) {
        int pos = -1;
        if (key[i] > thr) pos = (int)gpos++;
        else if (key[i] == thr) { if (epos < need_eq) pos = (int)(totgt + epos); epos++; }
        if (pos >= 0) { const int s = tid * 8 + i, tok = b * SEQ + s, slot = sbase + pos;
            ROWTOK[slot] = tok; ROWGATE[slot] = __builtin_bit_cast(float, key[i]); INV[(size_t)tok * NE + e] = slot; }
    }
}

__device__ __forceinline__ void phase_final(const Args& a, int G) {
    int tid = tid_of(a.wv); asm volatile("" : "+v"(tid)); const int lane = tid & 63, wave = __builtin_amdgcn_readfirstlane(tid >> 6);
    const int gw = blockIdx.x * 8 + wave, NGW = G * 8;
    const bf16_t* __restrict__ X1 = (const bf16_t*)(a.ws + WS_X1); const unsigned char* __restrict__ YE = (const unsigned char*)(a.ws + WS_YE); const int* __restrict__ INV = (const int*)(a.ws + WS_INV);
    float* __restrict__ OUT = a.out;
    const float* __restrict__ RG = (const float*)(a.ws + WS_ROWGATE);
    f32x4 gg[2][2];
#pragma unroll
    for (int j = 0; j < 2; ++j) { gg[j][0] = *(const f32x4*)(a.in[I_FNG] + 8 * lane + 512 * j); gg[j][1] = *(const f32x4*)(a.in[I_FNG] + 8 * lane + 512 * j + 4); }
#define PF_SLOTS(inv_, n_, m_, sl_) do { m_ = __ballot((inv_) >= 0) & 0xffffull; n_ = __builtin_popcountll(m_); unsigned long long mm_ = m_; \
        _Pragma("unroll") for (int k_ = 0; k_ < 4; ++k_) { if (mm_) { const int e_ = __builtin_ctzll(mm_); mm_ &= mm_ - 1; sl_[k_] = __builtin_amdgcn_readlane((inv_), e_); } else sl_[k_] = 0; } m_ = mm_; } while (0)
#define PF_GATES(gt_, n_, sl_) do { _Pragma("unroll") for (int k_ = 0; k_ < 4; ++k_) gt_[k_] = (k_ < (n_)) ? RG[sl_[k_]] * 0.0625f : 0.f; } while (0)
#define PF_ROWS(rw_, xr_, tk_, n_, sl_) do { \
        _Pragma("unroll") for (int k_ = 0; k_ < 4; ++k_) { if (k_ < (n_)) { _Pragma("unroll") for (int j_ = 0; j_ < 2; ++j_) rw_[k_][j_] = __builtin_nontemporal_load((const u32x2*)(YE + (size_t)sl_[k_] * D + 8 * lane + 512 * j_)); } \
            else { _Pragma("unroll") for (int j_ = 0; j_ < 2; ++j_) rw_[k_][j_] = (u32x2){0u, 0u}; } } \
        _Pragma("unroll") for (int j_ = 0; j_ < 2; ++j_) xr_[j_] = __builtin_nontemporal_load((const u32x4*)(X1 + (size_t)(tk_) * D + 8 * lane + 512 * j_)); } while (0)
#define PF_ACC(v_, w_, g_) do { const f32x2 p0_ = __builtin_amdgcn_cvt_pk_f32_fp8((int)(w_).x, false), p1_ = __builtin_amdgcn_cvt_pk_f32_fp8((int)(w_).x, true), p2_ = __builtin_amdgcn_cvt_pk_f32_fp8((int)(w_).y, false), p3_ = __builtin_amdgcn_cvt_pk_f32_fp8((int)(w_).y, true); \
        v_[0] += (g_) * p0_.x; v_[1] += (g_) * p0_.y; v_[2] += (g_) * p1_.x; v_[3] += (g_) * p1_.y; v_[4] += (g_) * p2_.x; v_[5] += (g_) * p2_.y; v_[6] += (g_) * p3_.x; v_[7] += (g_) * p3_.y; } while (0)
    int tok = gw;
    if (tok >= T) return;
    int inv0 = INV[(size_t)tok * NE + (lane & 15)];
    int inv1 = (tok + NGW < T) ? INV[(size_t)(tok + NGW) * NE + (lane & 15)] : -1;
    unsigned long long mc; int nc, slc[4]; u32x2 rwc[4][2]; u32x4 xc[2]; float gtc[4];
    PF_SLOTS(inv0, nc, mc, slc);
    PF_GATES(gtc, nc, slc);
    PF_ROWS(rwc, xc, tok, nc, slc);
    for (; tok < T; tok += NGW) {
        const int t1 = tok + NGW, t2 = tok + 2 * NGW;
        const int inv2 = (t2 < T) ? INV[(size_t)t2 * NE + (lane & 15)] : -1;
        unsigned long long mn = 0ull; int nn = 0, sln[4] = {0, 0, 0, 0}; u32x2 rwn[4][2]; u32x4 xn[2]; float gtn[4] = {0.f, 0.f, 0.f, 0.f};
        if (t1 < T) { PF_SLOTS(inv1, nn, mn, sln); PF_GATES(gtn, nn, sln); PF_ROWS(rwn, xn, t1, nn, sln); }
        else {
#pragma unroll
            for (int k = 0; k < 4; ++k)
#pragma unroll
                for (int j = 0; j < 2; ++j) rwn[k][j] = (u32x2){0u, 0u};
#pragma unroll
            for (int j = 0; j < 2; ++j) xn[j] = (u32x4){0u, 0u, 0u, 0u}; }
        float v[2][8];
#pragma unroll
        for (int j = 0; j < 2; ++j) { v[j][0] = bf_lo(xc[j].x); v[j][1] = bf_hi(xc[j].x); v[j][2] = bf_lo(xc[j].y); v[j][3] = bf_hi(xc[j].y); v[j][4] = bf_lo(xc[j].z); v[j][5] = bf_hi(xc[j].z); v[j][6] = bf_lo(xc[j].w); v[j][7] = bf_hi(xc[j].w); }
#pragma unroll
        for (int k = 0; k < 4; ++k)
#pragma unroll
            for (int j = 0; j < 2; ++j) PF_ACC(v[j], rwc[k][j], gtc[k]);
        if (nc > 4) { unsigned long long m = mc; while (m) { const int e = __builtin_ctzll(m); m &= m - 1; const int slot = __builtin_amdgcn_readlane(inv0, e); const float gs = RG[slot] * 0.0625f;
#pragma unroll
                for (int j = 0; j < 2; ++j) { const u32x2 w = *(const u32x2*)(YE + (size_t)slot * D + 8 * lane + 512 * j); PF_ACC(v[j], w, gs); } } }
        float sq = 0.f;
#pragma unroll
        for (int j = 0; j < 2; ++j)
#pragma unroll
            for (int e = 0; e < 8; ++e) sq += v[j][e] * v[j][e];
        float rs = 1.0f / sqrtf(wave_sum(sq) * (1.f / D) + 1e-6f);
#pragma unroll
        for (int j = 0; j < 2; ++j) { float* o = OUT + (size_t)tok * D + 8 * lane + 512 * j;
            __builtin_nontemporal_store((f32x4){v[j][0], v[j][1], v[j][2], v[j][3]} * rs * gg[j][0], (f32x4*)o); __builtin_nontemporal_store((f32x4){v[j][4], v[j][5], v[j][6], v[j][7]} * rs * gg[j][1], (f32x4*)(o + 4)); }
        inv0 = inv1; inv1 = inv2; mc = mn; nc = nn;
#pragma unroll
        for (int k = 0; k < 4; ++k) { slc[k] = sln[k]; gtc[k] = gtn[k];
#pragma unroll
            for (int j = 0; j < 2; ++j) rwc[k][j] = rwn[k][j]; }
#pragma unroll
        for (int j = 0; j < 2; ++j) xc[j] = xn[j];
    }
#undef PF_SLOTS
#undef PF_GATES
#undef PF_ROWS
#undef PF_ACC
}

#define XB_TMO      128
#define XB_XCNT(j)  (256  + 64 * (j))
#define XB_XSUB(j)  (1280 + 64 * (j))
#define XB_XGEN(j)  (2304 + 64 * (j))
#define XB_TOP      3328
#define XB_TOPGEN   3392
#define XCD_BAR_WORDS 3456
#define XB_SPIN_CAP (1u << 22)
__device__ __forceinline__ unsigned xb_ld(unsigned* p)              { return __hip_atomic_load(p, __ATOMIC_RELAXED, __HIP_MEMORY_SCOPE_AGENT); }
__device__ __forceinline__ unsigned xb_add(unsigned* p, unsigned v) { return __hip_atomic_fetch_add(p, v, __ATOMIC_RELAXED, __HIP_MEMORY_SCOPE_AGENT); }
__device__ __forceinline__ unsigned xb_xcc_id() { return (unsigned)__builtin_amdgcn_s_getreg((3 << 11) | 20) & 0xFu; }
#define XB_SPIN(cond, bar) do { unsigned _sp = 0; while (cond) { __builtin_amdgcn_s_sleep(1); \
    if ((++_sp & 255u) == 0u) { if (xb_ld(&(bar)[XB_TMO])) break; if (_sp > XB_SPIN_CAP) { atomicAdd(&(bar)[XB_TMO], 1u); break; } } } } while (0)
struct XcdBarrier { unsigned* bar; unsigned x; volatile LAS unsigned* st; int wv; };
__device__ __forceinline__ XcdBarrier xcd_barrier_post(unsigned* bar, volatile LAS unsigned* st, int wv) {
    XcdBarrier b; b.bar = bar; b.x = xb_xcc_id(); b.st = st; b.wv = wv;
    if (threadIdx.x == 0) (void)xb_add(&bar[XB_XCNT(b.x)], 1u);
    return b;
}
__device__ __forceinline__ void xcd_barrier_complete(unsigned* bar, unsigned x, unsigned& nloc, unsigned& nx) {
    const unsigned G = gridDim.x * gridDim.y * gridDim.z;
    unsigned sum, cnt, mine, sp = 0u;
    for (;;) {
        sum = 0u; cnt = 0u; mine = 0u;
#pragma unroll
        for (unsigned j = 0; j < 16; ++j) { const unsigned c = xb_ld(&bar[XB_XCNT(j)]); sum += c; cnt += (c > 0u) ? 1u : 0u; mine = (j == x) ? c : mine; }
        if (sum == G) break;
        __builtin_amdgcn_s_sleep(1);
        if ((++sp & 255u) == 0u) { if (xb_ld(&bar[XB_TMO])) break; if (sp > XB_SPIN_CAP) { atomicAdd(&bar[XB_TMO], 1u); break; } }
    }
    nloc = mine > 0u ? mine : 1u; nx = cnt > 0u ? cnt : 1u;
}
struct XbTicket { unsigned gen, tg; int role; };
__device__ __forceinline__ void xcd_barrier_arrive(const XcdBarrier& b, XbTicket& t) {
    asm volatile("s_waitcnt vmcnt(0)" ::: "memory");
    __syncthreads();
    t.gen = 0u; t.tg = 0u; t.role = 0;
    if (tid_of(b.wv) == 0) {
        unsigned* bar = b.bar;
        __builtin_amdgcn_s_waitcnt(0);
        unsigned nloc = b.st[0], nx = b.st[1];
        if (nloc == 0u) { xcd_barrier_complete(bar, b.x, nloc, nx); b.st[0] = nloc; b.st[1] = nx; }
        const unsigned old = xb_add(&bar[XB_XSUB(b.x)], 1u);
        t.gen = old / nloc;
        if (old + 1u == (t.gen + 1u) * nloc) {
            __builtin_amdgcn_fence(__ATOMIC_RELEASE, "agent");
            asm volatile("s_waitcnt vmcnt(0)" ::: "memory");
            const unsigned og = xb_add(&bar[XB_TOP], 1u);
            t.tg = og / nx;
            t.role = (og + 1u == (t.tg + 1u) * nx) ? 2 : 1;
            if (t.role == 2) xb_add(&bar[XB_TOPGEN], 1u);
        }
    }
}
__device__ __forceinline__ void xcd_barrier_wait(const XcdBarrier& b, const XbTicket& t) {
    if (tid_of(b.wv) == 0) {
        unsigned* bar = b.bar;
        if (t.role != 0) {
            if (t.role == 1) XB_SPIN(xb_ld(&bar[XB_TOPGEN]) == t.tg, bar);
            __builtin_amdgcn_fence(__ATOMIC_ACQUIRE, "agent");
            xb_add(&bar[XB_XGEN(b.x)], 1u);
            asm volatile("s_waitcnt vmcnt(0)" ::: "memory");
        } else {
            XB_SPIN(xb_ld(&bar[XB_XGEN(b.x)]) == t.gen, bar);
            __builtin_amdgcn_fence(__ATOMIC_ACQUIRE, "agent");
            asm volatile("s_waitcnt vmcnt(0)" ::: "memory");
        }
    }
    __syncthreads();
}

#ifndef PH_MASK
#define PH_MASK 0x7ff
#endif
#ifndef REP_MASK
#define REP_MASK 0
#endif
#ifndef P2_MASK
#define P2_MASK 7
#endif
#ifndef P2_REP
#define P2_REP 0
#define P9_REP 0
#endif
constexpr int LDS_MISC = LDS_BYTES - 64;
constexpr int LDS_PTAB = LDS_BYTES - 512;
__device__ __forceinline__ Args load_args(LAS unsigned char* lds, int lo, int hi, int wv) {
    Args r; const LAS u32x2* t = (const LAS u32x2*)(lds + LDS_PTAB);
#pragma unroll
    for (int i = 0; i < 31; ++i) { const u32x2 v = t[i]; const unsigned long long p = ((unsigned long long)(unsigned)__builtin_amdgcn_readfirstlane((int)v.y) << 32) | (unsigned)__builtin_amdgcn_readfirstlane((int)v.x);
        if (i < 29) r.in[i] = (const float*)(const __attribute__((address_space(1))) float*)p; else if (i == 29) r.out = (float*)(__attribute__((address_space(1))) float*)p; else r.ws = (unsigned char*)(__attribute__((address_space(1))) unsigned char*)p; }
    r.ph_lo = lo; r.ph_hi = hi; r.wv = wv; r.zero_ = 0; return r;
}
constexpr size_t WS_CTL = 0, CTL_BYTES = 16384;
__global__ void __launch_bounds__(NTHREADS, 2) mega(Args a0) {
    extern __shared__ __attribute__((aligned(16))) unsigned char lds_raw[];
    LAS unsigned char* lds = (LAS unsigned char*)lds_raw;
    cg::grid_group grid = cg::this_grid();
    const int G = gridDim.x, lo = a0.ph_lo, hi = a0.ph_hi, wv0 = __builtin_amdgcn_readfirstlane((int)threadIdx.x >> 6);
    volatile LAS unsigned* misc = (volatile LAS unsigned*)(lds + LDS_MISC);
    if (threadIdx.x < 16) misc[threadIdx.x] = 0u;
    if (threadIdx.x == 0) { LAS unsigned long long* t = (LAS unsigned long long*)(lds + LDS_PTAB);
#pragma unroll
        for (int i = 0; i < 29; ++i) t[i] = (unsigned long long)a0.in[i];
        t[29] = (unsigned long long)a0.out; t[30] = (unsigned long long)a0.ws; }
    __syncthreads();
    if (lo < -1000) grid.sync();
    XcdBarrier xbar = xcd_barrier_post((unsigned*)(a0.ws + WS_CTL), misc, wv0);
#define IN(k) (((PH_MASK >> (k)) & 1) && lo <= (k) && (k) < hi)
#define NREP(k) (1 + ((REP_MASK >> (k)) & 1))
#define PHASE(k, ...) do { if (IN(k)) { for (int rep_ = 0; rep_ < NREP(k); ++rep_) { { const Args a = load_args(lds, lo, hi, wv0); unsigned char* const ws = a.ws; (void)ws; const bool pre = (rep_ == 0) && ((k) > 0) && IN((k) > 0 ? (k) - 1 : 0); (void)pre; __VA_ARGS__; } \
        if (rep_ + 1 < NREP(k) || IN((k) + 1)) { XbTicket tk_; xcd_barrier_arrive(xbar, tk_); \
            if (rep_ + 1 == NREP(k) && IN((k) + 1)) { const Args a = load_args(lds, lo, hi, wv0); if ((k) + 1 == 2) conv_prestage(a, lds); else if ((k) + 1 == 4) post_prestage(a, lds); else if ((k) + 1 == 6) router_prestage(a, lds); } \
            xcd_barrier_wait(xbar, tk_); } } } } while (0)

    PHASE(0, phase_prep(a, lds, G));

    PHASE(1, {
        pg8::Gemm g{(const bf16_t*)(ws + WS_XH), (const bf16_t*)(ws + WS_WINT), T, IN_PROJ, D, 0, 0};
        pg8::TripleOrder S; S.S0.init(T, IN_PROJ, G, 0, 1); S.A1 = (const bf16_t*)(ws + WS_MEMN); S.B1 = (const bf16_t*)(ws + WS_WKT); S.A2 = (const bf16_t*)(ws + WS_WVT); S.B2 = (const bf16_t*)(ws + WS_MEMN);
        S.n1 = BATCH * NMEM / 256; S.n2 = BATCH * NMEM / 256; S.G = G; S.c = (int)blockIdx.x;
        pg8::EpiBf16x3 E{pg8::EpiBf16{(bf16_t*)(ws + WS_P), CW, (bf16_t*)(ws + WS_Q), (bf16_t*)(ws + WS_PR)}, pg8::EpiBf16{(bf16_t*)(ws + WS_KMEM), 256, nullptr}, pg8::EpiBf16{(bf16_t*)(ws + WS_VT), BATCH * NMEM, nullptr}};
        const int total = S.n1 + S.n2 + S.S0.nwg, rem = total % G, c = (int)blockIdx.x;
        const bool cv = rem ? (c >= rem) : true; const int ncv = rem ? G - rem : G, rank = rem ? c - rem : c;
        const int nitem = 3 * 8192, per = (nitem + ncv * 8 - 1) / (ncv * 8), cut = ((rank & 3) * per / 4) * (ncv * 8);
        if (cv && cut > 0) { expert_prep_items(a, lds, rank * 8 + a.wv, ncv * 8, 0, cut); __syncthreads(); }
        pg8::gemm_phase<pg8::EpiBf16x3, pg8::TripleOrder, false, false, false, true>(lds, g, S, E, nullptr, a.wv);
        if (cv) { __syncthreads(); expert_prep_items(a, lds, rank * 8 + a.wv, ncv * 8, cut, nitem); }
    });

    constexpr int NSCAN = BATCH * NH * 2;
    PHASE(2, {
        for (int r2 = 0; r2 < 1 + ((P2_REP >> 1) & 1); ++r2) conv_stream(a, lds, (int)blockIdx.x, G, pre && r2 == 0);
        for (int u = blockIdx.x; u < 2048; u += G) {
            if (u >= 1024) { for (int r2 = 0; r2 < 1 + ((P2_REP >> 2) & 1); ++r2) prep_unit(a, lds, p2_unit(u - 1024, G)); }
        }
    });

    PHASE(3, {
        int bid = blockIdx.x; int Gp = G; asm volatile("" : "+s"(bid), "+s"(Gp));
        for (int u = bid; u < NSCAN; u += Gp) scan_chunked_unit(a, lds, u);
        if (rep_ == 0) {
            if (Gp > NSCAN) { if (bid >= NSCAN) { for (int u = bid - NSCAN; u < 64; u += Gp - NSCAN) for (int r2 = 0; r2 < 1 + (P2_REP & 1); ++r2) attn_unit(a, lds, u);
                                                 } }
            else { for (int u = bid; u < 64; u += Gp) attn_unit(a, lds, u); }
        }
    });

    PHASE(4, phase_post(a, lds, G, pre));

    PHASE(5, {
        pg8::Gemm g{(const bf16_t*)(ws + WS_MIX), (const bf16_t*)(ws + WS_WOUTT), T, D, D, 0, 0}; pg8::StaticOrder S; S.init(T, D, G, (int)blockIdx.x);
        pg8::EpiResidSS E{a.in[I_X], (bf16_t*)(ws + WS_X1), (float*)(ws + WS_SS)}; pg8::gemm_phase<pg8::EpiResidSS, pg8::StaticOrder, false, true>(lds, g, S, E, nullptr, a.wv);
    });

    PHASE(6, phase_router(a, lds, G, pre));

    PHASE(7, { for (int u = blockIdx.x; u < BATCH * NE; u += G) topk_unit(a, lds, u); });

    PHASE(8, {
        pg8::Gemm g{(const bf16_t*)(ws + WS_H2), (const bf16_t*)(ws + WS_WGUT), NSLOT, 2048, D / 2, 0x7A7A7A7A, 0x7F7F7F7F};     pg8::ExpertOrder S; S.init(32, 8, NE, G, (int)blockIdx.x);
        pg8::EpiSwiGLU E{(bf16_t*)(ws + WS_HID)}; pg8::gemm_phase<pg8::EpiSwiGLU, pg8::ExpertOrder, true, false, true>(lds, g, S, E, (const int*)(ws + WS_ROWTOK), a.wv);
    });

    PHASE(9, {
        pg8::Gemm g{(const bf16_t*)(ws + WS_HID), (const bf16_t*)(ws + WS_WDT), NSLOT, D, FF / 2, 0x7A7A7A7A, 0x7C7C7C7C};     pg8::ExpertOrder S; S.init(32, 4, NE, G, (int)blockIdx.x);
        pg8::EpiGateScale E{(unsigned char*)(ws + WS_YE), (const float*)(ws + WS_ROWGATE)}; pg8::gemm_phase<pg8::EpiGateScale, pg8::ExpertOrder, false, true, true>(lds, g, S, E, nullptr, a.wv);
#if P9_REP
        __syncthreads(); pg8::gemm_phase<pg8::EpiGateScale, pg8::ExpertOrder, false, true, true>(lds, g, S, E, nullptr, a.wv);
#endif
    });

    PHASE(10, phase_final(a, G));
#undef IN
#undef NREP
#undef PHASE
}

#ifndef MK_ONE_LAUNCH
#define MK_ONE_LAUNCH 1
#endif
extern "C" void kernel_launch(void* const* d_in, const int* in_sizes, int n_in, void* d_out, int out_size, void* d_ws, size_t ws_size, hipStream_t stream) {
    static int grid_blocks = 0;
    if (grid_blocks == 0) {
        if (n_in != 29 || out_size != T * D || ws_size < WS_END) { fprintf(stderr, "kernel_launch: unexpected problem: n_in %d out %d ws %zu (need %zu)\n", n_in, out_size, ws_size, (size_t)WS_END); grid_blocks = -1; return; }
        int dev = 0, cus = 0, per_cu = 0;
        if (hipGetDevice(&dev) != hipSuccess || hipDeviceGetAttribute(&cus, hipDeviceAttributeMultiprocessorCount, dev) != hipSuccess) { grid_blocks = -1; return; }
        if (hipFuncSetAttribute((const void*)mega, hipFuncAttributeMaxDynamicSharedMemorySize, LDS_BYTES) != hipSuccess) { fprintf(stderr, "kernel_launch: hipFuncSetAttribute failed\n"); grid_blocks = -1; return; }
        if (hipOccupancyMaxActiveBlocksPerMultiprocessor(&per_cu, (const void*)mega, NTHREADS, LDS_BYTES) != hipSuccess || per_cu < 1) { fprintf(stderr, "kernel_launch: occupancy query says %d blocks per CU\n", per_cu); grid_blocks = -1; return; }
        grid_blocks = cus;
    }
    if (grid_blocks < 0) return;
    if (hipMemsetAsync((char*)d_ws + WS_CTL, 0, CTL_BYTES, stream) != hipSuccess) { fprintf(stderr, "kernel_launch: memset failed\n"); return; }
    Args a{};
    for (int i = 0; i < 29; ++i) a.in[i] = (const float*)d_in[i];
    a.out = (float*)d_out; a.ws = (unsigned char*)d_ws;
#if MK_ONE_LAUNCH
    a.ph_lo = 0; a.ph_hi = NPHASE;
    { void* args[] = {&a}; hipError_t e = hipLaunchCooperativeKernel((const void*)mega, dim3(grid_blocks), dim3(NTHREADS), args, LDS_BYTES, stream);
      if (e != hipSuccess) fprintf(stderr, "cooperative launch failed: %s (grid %d)\n", hipGetErrorString(e), grid_blocks); }
#else
    for (int ph = 0; ph < NPHASE; ++ph) { a.ph_lo = ph; a.ph_hi = ph + 1; void* args[] = {&a};
        hipError_t e = hipLaunchCooperativeKernel((const void*)mega, dim3(grid_blocks), dim3(NTHREADS), args, LDS_BYTES, stream);
        if (e != hipSuccess) { fprintf(stderr, "cooperative launch %d failed: %s (grid %d)\n", ph, hipGetErrorString(e), grid_blocks); break; } }
#endif
}
```
